# Optimizing an MI355X kernel written in HIP

```python
import math
import jax, jax.numpy as jnp
from jax import lax
import numpy as np

D_MODEL = 1024
BATCH = 1
SEQ = 16384
DEPTH = 1
DEC_BATCH = 8
DEC_SEQ = 2048
PAST_LEN = 128

N_META = 16
D_A = 512
HEAD_A = 64
H_A = D_A // HEAD_A
LORA_W = 64
LORA_A = 64
LORA_G = 128
D_B = 512
HEAD_B = 64
H_B = D_B // (2 * HEAD_B)
D_FF = 4 * D_MODEL
Q_BLOCK = 128
NORM_EPS = 1e-6
SUBLN_EPS = 1e-5
GN_EPS = 64e-5
RWKV_COLS = 3 * D_A + LORA_W + LORA_A + LORA_G
ATTN_COLS = 3 * D_B
GATE_COLS = 2 * D_MODEL
D_IN = RWKV_COLS + ATTN_COLS + GATE_COLS

kernel_name = 'hybrid_rwkv7_diffattn_encoder'


def _rmsnorm(x, g, eps=NORM_EPS):
    xf = x.astype(jnp.float32)
    y = xf * lax.rsqrt(jnp.mean(xf * xf, axis=-1, keepdims=True) + eps)
    return (y * g.astype(jnp.float32)).astype(x.dtype)


def _token_shift(p, mu_prev, mu_next):
    prev = jnp.pad(p[:, :-1], ((0, 0), (1, 0), (0, 0)))
    nxt = jnp.pad(p[:, 1:], ((0, 0), (0, 1), (0, 0)))
    return p + mu_prev * (prev - p) + mu_next * (nxt - p)


def _heads_a(z):
    return z.reshape(z.shape[:-1] + (H_A, HEAD_A))


def _orient(z):
    z = jnp.stack([z[0], jnp.flip(z[1], axis=1)])
    return jnp.moveaxis(z, 2, 0)


def _both(z):
    return jnp.broadcast_to(z[None], (2,) + z.shape)


def _rwkv7_bidir(p, w0, w_up, a0, a_up, g_up, k_k, k_a, r_k, ln_w, ln_b):
    B, T, _ = p.shape
    f32 = jnp.float32
    r, k, v, wd, ad, gd = jnp.split(
        p.astype(f32), [D_A, 2 * D_A, 3 * D_A, 3 * D_A + LORA_W, 3 * D_A + LORA_W + LORA_A], axis=-1)
    w_pre = w0[:, None, None, :] + jnp.einsum('btr,drc->dbtc', jnp.tanh(wd), w_up)
    decay = jnp.exp(-jnp.exp(-jax.nn.softplus(-w_pre) - 0.5))
    a = jax.nn.sigmoid(a0[:, None, None, :] + jnp.einsum('btr,drc->dbtc', ad, a_up))
    g = jnp.einsum('btr,rc->btc', jax.nn.sigmoid(gd), g_up)
    kk = _heads_a(k * k_k)
    kk = kk * lax.rsqrt(jnp.maximum(jnp.sum(kk * kk, axis=-1, keepdims=True), 1e-24))
    k_dir = _heads_a(k[None] * (1.0 + (a - 1.0) * k_a))
    rh, vh = _heads_a(r), _heads_a(v)
    xs = (_orient(_both(rh)), _orient(_heads_a(decay)), _orient(k_dir),
          _orient(_both(vh)), _orient(_both(kk)), _orient(_heads_a(a)))

    def step(S, inp):
        r_t, w_t, k_t, v_t, kk_t, a_t = inp
        sa = jnp.einsum('dbhvk,dbhk->dbhv', S, -kk_t)
        S = (S * w_t[..., None, :] + sa[..., None] * (kk_t * a_t)[..., None, :]
             + v_t[..., None] * k_t[..., None, :])
        return S, jnp.einsum('dbhvk,dbhk->dbhv', S, r_t)

    S0 = jnp.zeros((2, B, H_A, HEAD_A, HEAD_A), f32)
    _, ys = lax.scan(step, S0, xs)
    ys = jnp.moveaxis(ys, 0, 2)
    y = ys[0] + jnp.flip(ys[1], axis=1)
    mu = jnp.mean(y, axis=-1, keepdims=True)
    var = jnp.mean(jnp.square(y - mu), axis=-1, keepdims=True)
    y = ((y - mu) * lax.rsqrt(var + GN_EPS)).reshape(B, T, D_A) * ln_w + ln_b
    bonus = jnp.sum(jnp.sum(rh[None] * k_dir * r_k, axis=-1, keepdims=True), axis=0) * vh
    y = (y + bonus.reshape(B, T, D_A)) * g
    return y.astype(p.dtype)


def _diff_attention(p, lam_q1, lam_k1, lam_q2, lam_k2, subln_g, lambda_init):
    B, T, _ = p.shape
    f32 = jnp.float32
    q, k, v = jnp.split(p, [D_B, 2 * D_B], axis=-1)
    q = q.reshape(B, T, H_B, 2, HEAD_B)
    k = k.reshape(B, T, H_B, 2, HEAD_B)
    v = v.reshape(B, T, H_B, 2 * HEAD_B)
    lam = (jnp.exp(jnp.sum(lam_q1.astype(f32) * lam_k1.astype(f32)))
           - jnp.exp(jnp.sum(lam_q2.astype(f32) * lam_k2.astype(f32))) + lambda_init)
    slopes = jnp.exp2(-8.0 * jnp.arange(1, H_B + 1, dtype=f32) / H_B)
    nblk = -(-T // Q_BLOCK)
    t_pad = nblk * Q_BLOCK
    qb = jnp.pad(q, ((0, 0), (0, t_pad - T), (0, 0), (0, 0), (0, 0)))
    qb = jnp.moveaxis(qb.reshape(B, nblk, Q_BLOCK, H_B, 2, HEAD_B), 1, 0)
    qpos = jnp.arange(t_pad, dtype=jnp.int32).reshape(nblk, Q_BLOCK)
    kpos = jnp.arange(T, dtype=jnp.int32)
    scale = HEAD_B ** -0.5

    def block(args):
        q_blk, pos = args
        s = jnp.einsum('bqhmd,bshmd->bhmqs', q_blk, k).astype(f32) * scale
        dist = jnp.abs(pos[:, None] - kpos[None, :]).astype(f32)
        s = s - slopes[None, :, None, None, None] * dist
        prob = jax.nn.softmax(s, axis=-1)
        att = prob[:, :, 0] - lam * prob[:, :, 1]
        return jnp.einsum('bhqs,bshe->bqhe', att.astype(v.dtype), v)

    o = lax.map(block, (qb, qpos))
    o = jnp.moveaxis(o, 0, 1).reshape(B, t_pad, H_B, 2 * HEAD_B)[:, :T]
    o = _rmsnorm(o, subln_g, SUBLN_EPS) * (1.0 - lambda_init)
    return o.reshape(B, T, D_B)


def _trunk(x, weights):
    (meta_tokens, g_mix, w_in, mu_prev, mu_next, w0, w_up, a0, a_up, g_up, k_k, k_a, r_k,
     ln_x_w, ln_x_b, lam_q1, lam_k1, lam_q2, lam_k2, subln_g, w_up_a, w_up_b, w_out,
     g_ffn, w_ff1, w_ff2, g_final) = weights
    B = x.shape[0]
    meta = jnp.broadcast_to(meta_tokens[None].astype(x.dtype), (B, N_META, D_MODEL))
    h = jnp.concatenate([meta, x], axis=1)
    for l in range(DEPTH):
        lambda_init = 0.8 - 0.6 * math.exp(-0.3 * l)
        n = _rmsnorm(h, g_mix[l])
        proj = jnp.einsum('btd,dc->btc', n, w_in[l])
        p_a, p_b, gates = jnp.split(proj, [RWKV_COLS, RWKV_COLS + ATTN_COLS], axis=-1)
        o_a = _rwkv7_bidir(_token_shift(p_a, mu_prev[l], mu_next[l]), w0[l], w_up[l], a0[l],
                           a_up[l], g_up[l], k_k[l], k_a[l], r_k[l], ln_x_w[l], ln_x_b[l])
        o_b = _diff_attention(p_b, lam_q1[l], lam_k1[l], lam_q2[l], lam_k2[l], subln_g[l],
                              lambda_init)
        g_a, g_b = jnp.split(gates, 2, axis=-1)
        merged = (jax.nn.sigmoid(g_a) * jnp.einsum('btc,cd->btd', o_a, w_up_a[l])
                  + jax.nn.sigmoid(g_b) * jnp.einsum('btc,cd->btd', o_b, w_up_b[l]))
        h = h + jnp.einsum('btd,de->bte', merged, w_out[l])
        m = _rmsnorm(h, g_ffn[l])
        hid = jnp.square(jax.nn.relu(jnp.einsum('btd,df->btf', m, w_ff1[l])))
        h = h + jnp.einsum('btf,fd->btd', hid, w_ff2[l])
    return _rmsnorm(h, g_final)[:, N_META:]


def setup_inputs(seed: int = 0) -> dict:
    key = jax.random.key(seed)
    ks = iter(jax.random.split(key, 40))
    f32 = jnp.float32

    def nrm(shape, scale):
        return scale * jax.random.normal(next(ks), shape, f32)

    def uni(shape, lo, hi):
        return jax.random.uniform(next(ks), shape, f32, lo, hi)

    L = DEPTH
    return {
        'x_prompt': nrm((BATCH, SEQ, D_MODEL), 1.0),
        'x_sample': nrm((DEC_BATCH, DEC_SEQ, D_MODEL), 1.0),
        'meta_tokens': nrm((N_META, D_MODEL), 1.0),
        'g_mix': 1.0 + nrm((L, D_MODEL), 0.02),
        'w_in': nrm((L, D_MODEL, D_IN), D_MODEL ** -0.5),
        'mu_prev': uni((L, RWKV_COLS), 0.0, 0.5),
        'mu_next': uni((L, RWKV_COLS), 0.0, 0.5),
        'w0': nrm((L, 2, D_A), 0.5),
        'w_up': nrm((L, 2, LORA_W, D_A), 0.5 * LORA_W ** -0.5),
        'a0': nrm((L, 2, D_A), 0.5),
        'a_up': nrm((L, 2, LORA_A, D_A), LORA_A ** -0.5),
        'g_up': nrm((L, LORA_G, D_A), LORA_G ** -0.5),
        'k_k': 0.85 + nrm((L, D_A), 0.05),
        'k_a': 1.0 + nrm((L, D_A), 0.05),
        'r_k': nrm((L, H_A, HEAD_A), 0.1),
        'ln_x_w': 1.0 + nrm((L, D_A), 0.02),
        'ln_x_b': nrm((L, D_A), 0.02),
        'lam_q1': nrm((L, HEAD_B), 0.1),
        'lam_k1': nrm((L, HEAD_B), 0.1),
        'lam_q2': nrm((L, HEAD_B), 0.1),
        'lam_k2': nrm((L, HEAD_B), 0.1),
        'subln_g': 1.0 + nrm((L, 2 * HEAD_B), 0.02),
        'w_up_a': nrm((L, D_A, D_MODEL), D_A ** -0.5),
        'w_up_b': nrm((L, D_B, D_MODEL), D_B ** -0.5),
        'w_out': nrm((L, D_MODEL, D_MODEL), D_MODEL ** -0.5),
        'g_ffn': 1.0 + nrm((L, D_MODEL), 0.02),
        'w_ff1': nrm((L, D_MODEL, D_FF), D_MODEL ** -0.5),
        'w_ff2': nrm((L, D_FF, D_MODEL), D_FF ** -0.5),
        'g_final': 1.0 + nrm((D_MODEL,), 0.02),
    }


def reference(x_prompt, x_sample, meta_tokens, g_mix, w_in, mu_prev, mu_next, w0, w_up, a0,
              a_up, g_up, k_k, k_a, r_k, ln_x_w, ln_x_b, lam_q1, lam_k1, lam_q2, lam_k2,
              subln_g, w_up_a, w_up_b, w_out, g_ffn, w_ff1, w_ff2, g_final):
    weights = (meta_tokens, g_mix, w_in, mu_prev, mu_next, w0, w_up, a0, a_up, g_up, k_k, k_a,
               r_k, ln_x_w, ln_x_b, lam_q1, lam_k1, lam_q2, lam_k2, subln_g, w_up_a, w_up_b,
               w_out, g_ffn, w_ff1, w_ff2, g_final)
    y_prompt = _trunk(x_prompt, weights)
    y_sample = _trunk(x_sample, weights)
    return (y_prompt, y_sample)
```

```cpp
#include <hip/hip_runtime.h>
#include <hip/hip_cooperative_groups.h>
#include <cstdio>
#include <cstdint>
#include <cmath>
namespace cg = cooperative_groups;
namespace pg8 {
#define PG8_LAS __attribute__((address_space(3)))
typedef unsigned short bf16_t;
typedef short bf16x8 __attribute__((ext_vector_type(8)));
typedef float f32x4 __attribute__((ext_vector_type(4)));
typedef unsigned u32x4 __attribute__((ext_vector_type(4)));
constexpr int BM = 256, BK = 64, HALF = 128, HTB = HALF * BK * 2  , STAGE_BYTES = 8 * HTB, NXCD = 8, WGM = 8;

__host__ __device__ __forceinline__ int lds_byte(int r, int c) { const int st = (r >> 4) * 2 + (c >> 5), rr = r & 15, cc = c & 31, ob = rr * 64 + cc * 2; return st * 1024 + (ob ^ (((ob >> 9) & 1) << 5)); }
__host__ __device__ __forceinline__ void stage_rc(int b, int& R, int& C) { const int st = b / 1024, sb = b % 1024, swz = sb ^ (((sb >> 9) & 1) << 5); R = (st >> 1) * 16 + swz / 64; C = (st & 1) * 32 + (swz % 64) / 2; }
__host__ __device__ __forceinline__ int perm32(int rho) { const int n = rho >> 4, i = rho & 15; return 8 * (i >> 2) + 4 * n + (i & 3); }

struct Unit { int pm, pn; };
struct Gemm { const bf16_t* A; const bf16_t* Bt; int M, N, K; const bf16_t* A2; int pm2; };
__device__ __forceinline__ const char* gemm_abase(const Gemm& g, int pm, size_t tstep) { return pm >= g.pm2 ? (const char*)g.A2 + (size_t)(pm - g.pm2) * tstep : (const char*)g.A + (size_t)pm * tstep; }

struct StaticOrder {
    int nM, nN, nwg, G, c;
    __host__ __device__ void init(int M, int N, int G_, int c_) { nM = M / BM; nN = N / BM; nwg = nM * nN; G = G_; c = c_; }
    __host__ __device__ bool next(int i, Unit& u) const {
        const long L = (long)i * G + c; if (L >= nwg) return false;
        int wgid = (int)L; { const int q = nwg / NXCD, r = nwg % NXCD, xcd = wgid % NXCD, off = wgid / NXCD; wgid = (xcd < r ? xcd * (q + 1) : r * (q + 1) + (xcd - r) * q) + off; }
        const int nig = WGM * nN, gid = wgid / nig, fm = gid * WGM, gsz = (nM - fm) < WGM ? (nM - fm) : WGM;
        u.pm = fm + ((wgid % nig) % gsz); u.pn = (wgid % nig) / gsz; return true;
    }
    __device__ __forceinline__ void a_ready(const Unit&) const {}
    __device__ __forceinline__ void done(const Unit&) const {}
};


template <class Epi, class Sched, bool ALIGN_EPI = false, bool SP2 = false>
__device__ __forceinline__ void gemm_phase(PG8_LAS unsigned char* lds, const Gemm g, const Sched& S, const Epi& E) {
    const int tid = threadIdx.x, wid = __builtin_amdgcn_readfirstlane(tid >> 6), lane = tid & 63, wr = wid >> 2, wc = wid & 3, fr = lane & 15, fq = lane >> 4;
    const int K = g.K, nt = K / BK;
    unsigned voffA[2], voffB[2];
#pragma unroll
    for (int i = 0; i < 2; ++i) { int R, C; stage_rc(tid * 16 + i * 8192, R, C); const int Rb = Epi::PERM ? ((R & ~31) + perm32(R & 31)) : R;
        voffA[i] = (unsigned)(R * K + C) * 2u; voffB[i] = (unsigned)(Rb * K + C) * 2u; }
    const size_t kstep = (size_t)(BK * 2);
    const size_t hstep = (size_t)HALF * K * 2;
    const size_t tstep = 2 * hstep;
    const unsigned ldsw = (unsigned)wid * 1024u;
    const int aoff = lds_byte(wr * 64 + fr, fq * 8), boff = lds_byte(wc * 32 + fr, fq * 8);
#define PG8_SA(b, h) (((b) * 2 + (h)) * HTB)
#define PG8_SB(b, h) ((4 + (b) * 2 + (h)) * HTB)
#define PG8_STAGE(bufoff, gbase, voff) do { _Pragma("unroll") for (int _i = 0; _i < 2; ++_i) \
        __builtin_amdgcn_global_load_lds((const unsigned*)((const char*)(gbase) + (voff)[_i]), (PG8_LAS unsigned*)(lds + (bufoff) + ldsw + _i * 8192), 16, 0, 0); } while (0)
#define PG8_LDA(dst, b, h) do { _Pragma("unroll") for (int m = 0; m < 4; ++m) _Pragma("unroll") for (int k = 0; k < 2; ++k) dst[m][k] = *(const PG8_LAS bf16x8*)(lds + PG8_SA(b, h) + aoff + m * 2048 + k * 1024); } while (0)
#define PG8_LDB(dst, b, h) do { _Pragma("unroll") for (int n = 0; n < 2; ++n) _Pragma("unroll") for (int k = 0; k < 2; ++k) dst[n][k] = *(const PG8_LAS bf16x8*)(lds + PG8_SB(b, h) + boff + n * 2048 + k * 1024); } while (0)
#define PG8_MMA(ai, bj, At, Bt) do { __builtin_amdgcn_s_setprio(1); _Pragma("unroll") for (int m = 0; m < 4; ++m) _Pragma("unroll") for (int n = 0; n < 2; ++n) _Pragma("unroll") for (int k = 0; k < 2; ++k) \
        acc[ai][bj][m][n] = __builtin_amdgcn_mfma_f32_16x16x32_bf16(Bt[n][k], At[m][k], acc[ai][bj][m][n], 0, 0, 0); __builtin_amdgcn_s_setprio(0); } while (0)
#define PG8_WAIT_V(n) asm volatile("s_waitcnt vmcnt(" #n ")" ::: "memory")
#define PG8_WAIT_L(n) asm volatile("s_waitcnt lgkmcnt(" #n ")" ::: "memory")
#define PG8_BAR __builtin_amdgcn_s_barrier()
#define PG8_SCHED __builtin_amdgcn_sched_barrier(0)
    Unit cur, nxt; int ui = 0;
    if (!S.next(0, cur)) return;
    f32x4 acc[2][2][4][2];
#pragma unroll
    for (int a = 0; a < 2; ++a)
#pragma unroll
        for (int b = 0; b < 2; ++b)
#pragma unroll
            for (int m = 0; m < 4; ++m)
#pragma unroll
                for (int n = 0; n < 2; ++n) acc[a][b][m][n] = (f32x4){0.f, 0.f, 0.f, 0.f};
    bf16x8 At[4][2], B0[2][2], B1[2][2];
    const char* cA = gemm_abase(g, cur.pm, tstep); const char* cB = (const char*)g.Bt + (size_t)cur.pn * tstep;
    S.a_ready(cur);
    if constexpr (SP2) {
        PG8_STAGE(PG8_SB(0, 0), cB, voffB); PG8_STAGE(PG8_SB(0, 1), cB + hstep, voffB); PG8_STAGE(PG8_SA(0, 0), cA, voffA); PG8_STAGE(PG8_SA(0, 1), cA + hstep, voffA);
        if (wr == 1) PG8_BAR;
        PG8_WAIT_V(2); PG8_BAR;
        PG8_STAGE(PG8_SB(1, 0), cB + kstep, voffB); PG8_STAGE(PG8_SA(1, 0), cA + kstep, voffA); PG8_STAGE(PG8_SB(1, 1), cB + hstep + kstep, voffB);
        PG8_WAIT_V(6); PG8_BAR;
    } else {
        PG8_STAGE(PG8_SB(0, 0), cB, voffB); PG8_STAGE(PG8_SA(0, 0), cA, voffA); PG8_STAGE(PG8_SB(0, 1), cB + hstep, voffB); PG8_STAGE(PG8_SA(0, 1), cA + hstep, voffA);
        if (wr == 1) PG8_BAR;
        PG8_WAIT_V(4); PG8_BAR;
        PG8_STAGE(PG8_SB(1, 0), cB + kstep, voffB); PG8_STAGE(PG8_SA(1, 0), cA + kstep, voffA); PG8_STAGE(PG8_SB(1, 1), cB + hstep + kstep, voffB);
        PG8_WAIT_V(6); PG8_BAR;
    }
    for (;;) {
        const bool has_next = S.next(ui + 1, nxt);
        const char* nA = has_next ? gemm_abase(g, nxt.pm, tstep) : cA; const char* nB = has_next ? (const char*)g.Bt + (size_t)nxt.pn * tstep : cB;
        for (int t = 0; t < nt; t += 2) {
            const bool last = (t == nt - 2);
            const char* a1 = cA + (size_t)(t + 1) * kstep;
            const char* a2 = last ? nA : cA + (size_t)(t + 2) * kstep; const char* b2 = last ? nB : cB + (size_t)(t + 2) * kstep;
            const char* a3 = a2 + kstep; const char* b3 = b2 + kstep;
            if (last && has_next) S.a_ready(nxt);
            if constexpr (SP2) {
            PG8_LDB(B0, 0, 0); PG8_LDB(B1, 0, 1); PG8_SCHED; PG8_LDA(At, 0, 0); PG8_STAGE(PG8_SA(1, 1), a1 + hstep, voffA);
            PG8_WAIT_V(8); PG8_WAIT_L(0); PG8_BAR; PG8_MMA(0, 0, At, B0); PG8_MMA(0, 1, At, B1); PG8_BAR; PG8_SCHED;
            PG8_LDA(At, 0, 1); PG8_STAGE(PG8_SB(0, 0), b2, voffB); PG8_STAGE(PG8_SB(0, 1), b2 + hstep, voffB); PG8_STAGE(PG8_SA(0, 0), a2, voffA);
            PG8_WAIT_V(8); PG8_WAIT_L(0); PG8_BAR; PG8_MMA(1, 0, At, B0); PG8_MMA(1, 1, At, B1); PG8_BAR; PG8_SCHED;
            PG8_LDB(B0, 1, 0); PG8_LDB(B1, 1, 1); PG8_SCHED; PG8_LDA(At, 1, 0); PG8_STAGE(PG8_SA(0, 1), a2 + hstep, voffA);
            PG8_WAIT_V(8); PG8_WAIT_L(0); PG8_BAR; PG8_MMA(0, 0, At, B0); PG8_MMA(0, 1, At, B1); PG8_BAR; PG8_SCHED;
            PG8_LDA(At, 1, 1); PG8_STAGE(PG8_SB(1, 0), b3, voffB); PG8_STAGE(PG8_SB(1, 1), b3 + hstep, voffB); PG8_STAGE(PG8_SA(1, 0), a3, voffA);
            PG8_WAIT_V(8); PG8_WAIT_L(0); PG8_BAR; PG8_MMA(1, 0, At, B0); PG8_MMA(1, 1, At, B1); PG8_BAR; PG8_SCHED;
            } else {
            PG8_LDB(B0, 0, 0); PG8_SCHED; PG8_LDA(At, 0, 0); PG8_STAGE(PG8_SA(1, 1), a1 + hstep, voffA);
            PG8_WAIT_L(8); PG8_BAR; PG8_WAIT_L(0); PG8_MMA(0, 0, At, B0); PG8_BAR; PG8_SCHED;
            PG8_LDB(B1, 0, 1); PG8_STAGE(PG8_SB(0, 0), b2, voffB);
            PG8_BAR; PG8_WAIT_L(0); PG8_MMA(0, 1, At, B1); PG8_BAR;
            PG8_LDA(At, 0, 1); PG8_STAGE(PG8_SA(0, 0), a2, voffA);
            PG8_BAR; PG8_WAIT_L(0); PG8_MMA(1, 0, At, B0); PG8_BAR; PG8_SCHED;
            PG8_STAGE(PG8_SB(0, 1), b2 + hstep, voffB);
            PG8_WAIT_V(6); PG8_BAR; PG8_MMA(1, 1, At, B1); PG8_BAR;
            PG8_LDB(B0, 1, 0); PG8_SCHED; PG8_LDA(At, 1, 0); PG8_STAGE(PG8_SA(0, 1), a2 + hstep, voffA);
            PG8_WAIT_L(8); PG8_BAR; PG8_WAIT_L(0); PG8_MMA(0, 0, At, B0); PG8_BAR; PG8_SCHED;
            PG8_LDB(B1, 1, 1); PG8_STAGE(PG8_SB(1, 0), b3, voffB);
            PG8_BAR; PG8_WAIT_L(0); PG8_MMA(0, 1, At, B1); PG8_BAR;
            PG8_LDA(At, 1, 1); PG8_STAGE(PG8_SA(1, 0), a3, voffA);
            PG8_BAR; PG8_WAIT_L(0); PG8_MMA(1, 0, At, B0); PG8_BAR; PG8_SCHED;
            PG8_STAGE(PG8_SB(1, 1), b3 + hstep, voffB);
            PG8_WAIT_V(6); PG8_BAR; PG8_MMA(1, 1, At, B1); PG8_BAR;
            }
        }
        if constexpr (ALIGN_EPI) { if (wr == 0) PG8_BAR; }
        if constexpr (!Epi::AFTER_DRAIN) { E(acc, cur, wr, wc, fr, fq); S.done(cur); }
        if (!has_next) break;
#pragma unroll
        for (int a = 0; a < 2; ++a)
#pragma unroll
            for (int b = 0; b < 2; ++b)
#pragma unroll
                for (int m = 0; m < 4; ++m)
#pragma unroll
                    for (int n = 0; n < 2; ++n) acc[a][b][m][n] = (f32x4){0.f, 0.f, 0.f, 0.f};
        cur = nxt; cA = nA; cB = nB; ++ui;
        if constexpr (ALIGN_EPI) { if (wr == 1) PG8_BAR; }
    }
    PG8_WAIT_V(0);
    if constexpr (!ALIGN_EPI) { if (wr == 0) PG8_BAR; }
    PG8_BAR;
    if constexpr (Epi::AFTER_DRAIN) { E.fused(acc, cur, wr, wc, fr, fq, lds, wid, lane); S.done(cur); }
#undef PG8_SA
#undef PG8_SB
#undef PG8_STAGE
#undef PG8_LDA
#undef PG8_LDB
#undef PG8_MMA
#undef PG8_WAIT_V
#undef PG8_WAIT_L
#undef PG8_BAR
#undef PG8_SCHED
}
}

#ifndef PG8_SP2
#define PG8_SP2 true
#endif

#define LAS __attribute__((address_space(3)))
typedef unsigned short bf16;
typedef short bf16x8 __attribute__((ext_vector_type(8)));
typedef float f32x4 __attribute__((ext_vector_type(4)));
typedef float f32x16 __attribute__((ext_vector_type(16)));
typedef unsigned u32x4 __attribute__((ext_vector_type(4)));
typedef unsigned u32x2 __attribute__((ext_vector_type(2)));

constexpr int DM = 1024, NMAIN = 32768, ROWS = 33024, METAROW = 32768, DFF = 4096;
constexpr int NTHREADS = 512;
constexpr int LDS_BYTES = 147456;
constexpr int LDS_ITEM_OFF = LDS_BYTES - 16;
constexpr size_t MiB = 1u << 20;
constexpr size_t WS_CTL = 0, WS_WIN = 1 * MiB, WS_WUPA = 12 * MiB, WS_WUPB = 13 * MiB, WS_WOUT = 14 * MiB, WS_WFF1 = 16 * MiB, WS_WFF2 = 24 * MiB;
constexpr size_t WS_LORA = 32 * MiB, WS_XNMETA = 32 * MiB + 512 * 1024, WS_CB = 33 * MiB, WS_ACT = 36 * MiB;
constexpr size_t ACT_SZ = (size_t)ROWS * 512 * 2, L_SZ = (size_t)ROWS * 256 * 2;
constexpr size_t WS_R = WS_ACT, WS_KA = WS_R + ACT_SZ, WS_VA = WS_KA + ACT_SZ, WS_L = WS_VA + ACT_SZ, WS_Q = WS_L + L_SZ, WS_KB = WS_Q + ACT_SZ, WS_VT = WS_KB + ACT_SZ, WS_END = WS_VT + ACT_SZ;
constexpr size_t WS_GA = WS_KA, WS_GB = WS_KB, WS_MN = WS_ACT, WS_HID = WS_ACT + 64 * MiB;
static_assert(WS_END <= 256 * MiB && WS_HID + 128 * MiB <= 256 * MiB && WS_CB + (size_t)2 * ROWS * 8 * 4 <= WS_ACT, "ws map");
constexpr float LOG2E = 1.4426950408889634f;
constexpr float QSCALE = 0.125f * LOG2E;

struct Params { const float* in[29]; float* out; unsigned char* ws; };
typedef const __attribute__((address_space(4))) Params* KP;
enum { I_XP = 0, I_XS, I_META, I_GMIX, I_WIN, I_MUP, I_MUN, I_W0, I_WUP, I_A0, I_AUP, I_GUP, I_KK, I_KA, I_RK, I_LNW, I_LNB, I_LQ1, I_LK1, I_LQ2, I_LK2, I_SUBG, I_UPA, I_UPB, I_WOUT, I_GFFN, I_FF1, I_FF2, I_GFIN };

__device__ __forceinline__ unsigned cvtpk(float lo, float hi) { unsigned r; asm volatile("v_cvt_pk_bf16_f32 %0, %1, %2" : "=v"(r) : "v"(lo), "v"(hi)); return r; }
__device__ __forceinline__ float bf2f(unsigned short b) { return __uint_as_float(((unsigned)b) << 16); }
__device__ __forceinline__ float bflo(unsigned w) { return __uint_as_float(w << 16); }
__device__ __forceinline__ float bfhi(unsigned w) { return __uint_as_float(w & 0xffff0000u); }
__device__ __forceinline__ void unpack8(const u32x4 v, float* o) { o[0] = bflo(v.x); o[1] = bfhi(v.x); o[2] = bflo(v.y); o[3] = bfhi(v.y); o[4] = bflo(v.z); o[5] = bfhi(v.z); o[6] = bflo(v.w); o[7] = bfhi(v.w); }
__device__ __forceinline__ float wave_sum(float v) {
#pragma unroll
    for (int o = 1; o < 64; o <<= 1) v += __shfl_xor(v, o);
    return v;
}
__device__ __forceinline__ float sigmoidf_(float x) { return 1.0f / (1.0f + __expf(-x)); }
__device__ __forceinline__ int seq_base(int s) { return s == 0 ? 0 : 16384 + (s - 1) * 2048; }
__device__ __forceinline__ int seq_len(int s) { return s == 0 ? 16384 : 2048; }
__device__ __forceinline__ int pos_row(int base, int p) { return p < 16 ? METAROW + p : base + p - 16; }

template <class Op> struct Epi8 {
    static constexpr bool PERM = true, AFTER_DRAIN = false;
    Op op;
    __device__ __forceinline__ void operator()(const pg8::f32x4 (&acc)[2][2][4][2], const pg8::Unit& u, int wr, int wc, int fr, int fq) const {
        const int row0 = u.pm * 256 + wr * 64 + fr, col0 = u.pn * 256 + wc * 32 + 8 * fq;
#pragma unroll
        for (int ai = 0; ai < 2; ++ai)
#pragma unroll
            for (int m = 0; m < 4; ++m)
#pragma unroll
                for (int bj = 0; bj < 2; ++bj) { op.apply(row0 + ai * 128 + m * 16, col0 + bj * 128, u.pn, acc[ai][bj][m][0], acc[ai][bj][m][1]); asm volatile("" ::: "memory"); }
    }
};
__device__ __forceinline__ u32x4 pack8(const f32x4 a, const f32x4 b) { u32x4 w; w.x = cvtpk(a[0], a[1]); w.y = cvtpk(a[2], a[3]); w.z = cvtpk(b[0], b[1]); w.w = cvtpk(b[2], b[3]); return w; }

struct OpProj {
    unsigned char* ws;
    __device__ __forceinline__ void apply(int row, int col, int pn, f32x4 v0, f32x4 v1) const {
        if (pn >= 11) {
            bf16* VT = (bf16*)(ws + WS_VT); const int c = col - 11 * 256;
#pragma unroll
            for (int e = 0; e < 4; ++e) { VT[(size_t)(c + e) * ROWS + row] = (bf16)(cvtpk(v0[e], 0.f) & 0xffffu); VT[(size_t)(c + 4 + e) * ROWS + row] = (bf16)(cvtpk(v1[e], 0.f) & 0xffffu); }
            return;
        }
        bf16* O; int ldc = 512, c;
        if (pn < 2) { O = (bf16*)(ws + WS_R); c = col; }
        else if (pn < 4) { O = (bf16*)(ws + WS_KA); c = col - 512; }
        else if (pn < 6) { O = (bf16*)(ws + WS_VA); c = col - 1024; }
        else if (pn < 7) { O = (bf16*)(ws + WS_L); c = col - 1536; ldc = 256; }
        else if (pn < 9) { O = (bf16*)(ws + WS_Q); c = col - 1792; v0 = v0 * QSCALE; v1 = v1 * QSCALE; }
        else { O = (bf16*)(ws + WS_KB); c = col - 2304; }
        *(u32x4*)(O + (size_t)row * ldc + c) = pack8(v0, v1);
    }
};
struct OpGate {
    unsigned char* ws;
    __device__ __forceinline__ void apply(int row, int col, int pn, f32x4 v0, f32x4 v1) const {
        bf16* O = (bf16*)(ws + (pn < 4 ? WS_GA : WS_GB)); const int c = pn < 4 ? col : col - 1024;
#pragma unroll
        for (int e = 0; e < 4; ++e) { v0[e] = sigmoidf_(v0[e]); v1[e] = sigmoidf_(v1[e]); }
        *(u32x4*)(O + (size_t)row * 1024 + c) = pack8(v0, v1);
    }
};
struct OpUpA {
    unsigned char* ws;
    __device__ __forceinline__ void apply(int row, int col, int pn, f32x4 v0, f32x4 v1) const {
        u32x4* p = (u32x4*)((bf16*)(ws + WS_GA) + (size_t)row * 1024 + col); float g[8]; unpack8(*p, g);
#pragma unroll
        for (int e = 0; e < 4; ++e) { v0[e] *= g[e]; v1[e] *= g[4 + e]; }
        *p = pack8(v0, v1);
    }
};
struct OpUpB {
    unsigned char* ws;
    __device__ __forceinline__ void apply(int row, int col, int pn, f32x4 v0, f32x4 v1) const {
        u32x4* p = (u32x4*)((bf16*)(ws + WS_GB) + (size_t)row * 1024 + col); float g[8], a[8]; unpack8(*p, g);
        unpack8(*(const u32x4*)((const bf16*)(ws + WS_GA) + (size_t)row * 1024 + col), a);
#pragma unroll
        for (int e = 0; e < 4; ++e) { v0[e] = a[e] + v0[e] * g[e]; v1[e] = a[4 + e] + v1[e] * g[4 + e]; }
        *p = pack8(v0, v1);
    }
};
struct OpOut {
    const float* xp; const float* xs; float* out;
    __device__ __forceinline__ void apply(int row, int col, int pn, f32x4 v0, f32x4 v1) const {
        const float* x = (row < 16384 ? xp + (size_t)row * DM : xs + (size_t)(row - 16384) * DM) + col;
        float* o = out + (size_t)row * DM + col;
        *(f32x4*)o = *(const f32x4*)x + v0; *(f32x4*)(o + 4) = *(const f32x4*)(x + 4) + v1;
    }
};
struct OpFF1 {
    bf16* hid;
    __device__ __forceinline__ void apply(int row, int col, int pn, f32x4 v0, f32x4 v1) const {
#pragma unroll
        for (int e = 0; e < 4; ++e) { const float a = fmaxf(v0[e], 0.f), b = fmaxf(v1[e], 0.f); v0[e] = a * a; v1[e] = b * b; }
        *(u32x4*)(hid + (size_t)row * DFF + col) = pack8(v0, v1);
    }
};
struct OpFF2 {
    float* out;
    __device__ __forceinline__ void apply(int row, int col, int pn, f32x4 v0, f32x4 v1) const {
        float* o = out + (size_t)row * DM + col;
        *(f32x4*)o = *(const f32x4*)o + v0; *(f32x4*)(o + 4) = *(const f32x4*)(o + 4) + v1;
    }
};

__device__ __forceinline__ unsigned f2bf_rne(float f) { return cvtpk(f, 0.f) & 0xffffu; }
__device__ __forceinline__ void transpose_item(const float* W, int K, int N, bf16* WT, LAS float* scr, int item, int lane) {
    const int nblk = N / 32, kb = item / nblk, nb = item % nblk, k0 = 64 * kb, n0 = 32 * nb;
#pragma unroll 8
    for (int i = 0; i < 32; ++i) { const int kk = 2 * i + (lane >> 5); scr[kk * 33 + (lane & 31)] = W[(size_t)(k0 + kk) * N + n0 + (lane & 31)]; }
    asm volatile("s_waitcnt vmcnt(0) lgkmcnt(0)" ::: "memory");
    const int c = lane & 7;
#pragma unroll
    for (int j = 0; j < 4; ++j) { const int n = (lane >> 3) + 8 * j; const LAS float* s = scr + (8 * c) * 33 + n;
        u32x4 o; o.x = cvtpk(s[0 * 33], s[1 * 33]); o.y = cvtpk(s[2 * 33], s[3 * 33]); o.z = cvtpk(s[4 * 33], s[5 * 33]); o.w = cvtpk(s[6 * 33], s[7 * 33]);
        *(u32x4*)(WT + (size_t)(n0 + n) * K + k0 + 8 * c) = o; }
    asm volatile("s_waitcnt lgkmcnt(0)" ::: "memory");
}
__device__ __forceinline__ void rms_row_bf16(const float* src, const float* g, bf16* dst, int lane) {
    unsigned long long* o8 = (unsigned long long*)dst + lane;
    if (!src) {
#pragma unroll
        for (int j = 0; j < 4; ++j) o8[64 * j] = 0ull;
        return; }
    const f32x4* xr = (const f32x4*)src + lane; const f32x4* gr = (const f32x4*)g + lane;
    f32x4 v[4]; float s = 0.f;
#pragma unroll
    for (int j = 0; j < 4; ++j) { v[j] = xr[64 * j]; s += (v[j].x * v[j].x + v[j].y * v[j].y) + (v[j].z * v[j].z + v[j].w * v[j].w); }
    const float rstd = rsqrtf(wave_sum(s) * (1.f / DM) + 1e-6f);
#pragma unroll
    for (int j = 0; j < 4; ++j) { const f32x4 gg = gr[64 * j]; const f32x4 y = v[j] * rstd * gg;
        o8[64 * j] = (unsigned long long)cvtpk(y.x, y.y) | ((unsigned long long)cvtpk(y.z, y.w) << 32); }
}
__device__ __forceinline__ void phase_prologue(LAS unsigned char* lds, KP P) {
    const int tid = threadIdx.x, lane = tid & 63, wid = tid >> 6;
    LAS float* scr = (LAS float*)(lds + wid * 16384);
    const int gw = blockIdx.x * 8 + wid, NGW = gridDim.x * 8;
    unsigned char* ws = P->ws;
    constexpr int I_IN = (1024 / 64) * (5376 / 32), I_UP = (512 / 64) * (1024 / 32), I_O = (1024 / 64) * (1024 / 32), I_1 = (1024 / 64) * (4096 / 32), I_2 = (4096 / 64) * (1024 / 32);
    constexpr int I_LW = (64 / 64) * (512 / 32), I_G = (128 / 64) * (512 / 32);
    constexpr int NITEMS = I_IN + 2 * I_UP + I_O + I_1 + I_2 + 4 * I_LW + I_G;
    for (int it = gw; it < NITEMS; it += NGW) {
        int r = it;
        if (r < I_IN) { transpose_item(P->in[I_WIN], 1024, 5376, (bf16*)(ws + WS_WIN), scr, r, lane); continue; } r -= I_IN;
        if (r < I_UP) { transpose_item(P->in[I_UPA], 512, 1024, (bf16*)(ws + WS_WUPA), scr, r, lane); continue; } r -= I_UP;
        if (r < I_UP) { transpose_item(P->in[I_UPB], 512, 1024, (bf16*)(ws + WS_WUPB), scr, r, lane); continue; } r -= I_UP;
        if (r < I_O) { transpose_item(P->in[I_WOUT], 1024, 1024, (bf16*)(ws + WS_WOUT), scr, r, lane); continue; } r -= I_O;
        if (r < I_1) { transpose_item(P->in[I_FF1], 1024, 4096, (bf16*)(ws + WS_WFF1), scr, r, lane); continue; } r -= I_1;
        if (r < I_2) { transpose_item(P->in[I_FF2], 4096, 1024, (bf16*)(ws + WS_WFF2), scr, r, lane); continue; } r -= I_2;
        if (r < 2 * I_LW) { const int d = r / I_LW; transpose_item(P->in[I_WUP] + (size_t)d * 64 * 512, 64, 512, (bf16*)(ws + WS_LORA) + (size_t)d * 512 * 64, scr, r % I_LW, lane); continue; } r -= 2 * I_LW;
        if (r < 2 * I_LW) { const int d = r / I_LW; transpose_item(P->in[I_AUP] + (size_t)d * 64 * 512, 64, 512, (bf16*)(ws + WS_LORA + 131072) + (size_t)d * 512 * 64, scr, r % I_LW, lane); continue; } r -= 2 * I_LW;
        transpose_item(P->in[I_GUP], 128, 512, (bf16*)(ws + WS_LORA + 262144), scr, r, lane);
    }
    bf16* XN = (bf16*)P->out; bf16* XM = (bf16*)(ws + WS_XNMETA);
    for (int m = gw; m < ROWS; m += NGW) {
        const float* src = m < 16384 ? P->in[I_XP] + (size_t)m * DM : m < NMAIN ? P->in[I_XS] + (size_t)(m - 16384) * DM : (m - NMAIN < 16 ? P->in[I_META] + (size_t)(m - NMAIN) * DM : nullptr);
        bf16* dst = m < NMAIN ? XN + (size_t)m * DM : XM + (size_t)(m - NMAIN) * DM;
        rms_row_bf16(src, P->in[I_GMIX], dst, lane);
    }
}

constexpr int AT_KSTR = 272, AT_VSTR = 144, AT_KSZ = 64 * AT_KSTR, AT_BUF = AT_KSZ + 128 * AT_VSTR;
__device__ __forceinline__ f32x16 mfma32(bf16x8 a, bf16x8 b, f32x16 c) { return __builtin_amdgcn_mfma_f32_32x32x16_bf16(a, b, c, 0, 0, 0); }
__device__ __forceinline__ void attn_unit(LAS unsigned char* lds, KP P, int s, int h, int qb, float lam) {
    int tid_ = threadIdx.x; asm volatile("" : "+v"(tid_));
    const int tid = tid_, lane = tid & 63, r32 = lane & 31, hi = lane >> 5, wid = __builtin_amdgcn_readfirstlane(tid >> 6), rg = wid & 3, mp = wid >> 2;
    const int L = seq_len(s), base = seq_base(s), NT = 1 + L / 64;
    unsigned char* ws = P->ws;
    const bf16* KB = (const bf16*)(ws + WS_KB); const bf16* VT = (const bf16*)(ws + WS_VT); bf16* Q = (bf16*)(ws + WS_Q);
    const int qrow = base + qb * 128 + rg * 32 + r32;
    bf16x8 q[4];
#pragma unroll
    for (int d0 = 0; d0 < 4; ++d0) q[d0] = *(const bf16x8*)(Q + (size_t)qrow * 512 + h * 128 + mp * 64 + d0 * 16 + hi * 8);
    f32x16 O[4];
#pragma unroll
    for (int b = 0; b < 4; ++b)
#pragma unroll
        for (int r = 0; r < 16; ++r) O[b][r] = 0.f;
    float mx = -INFINITY, ls = 0.f;
    const float qh = (float)(16 + qb * 128 + rg * 32 + r32 - 4 * hi);
    const float nslope = -exp2f(-2.0f * (float)(h + 1)) * LOG2E;
    const int kr0 = tid >> 4, kc = tid & 15, vn0 = tid >> 3, vc = tid & 7;
    u32x4 kreg[2], vreg[2];
    const unsigned kgo = (unsigned)((kr0 * 512 + h * 128 + kc * 8) * 2), vgo = (unsigned)(((h * 128 + vn0) * ROWS + vc * 8) * 2);
    const unsigned klo = (unsigned)(kr0 * AT_KSTR + kc * 16), vlo = (unsigned)(AT_KSZ + vn0 * AT_VSTR + vc * 16);
#define AT_GLOAD(j) do { const int m0_ = (j) == 0 ? METAROW : base + 64 * ((j) - 1); \
        const unsigned char* kt_ = (const unsigned char*)KB + (size_t)m0_ * 1024; const unsigned char* vt_ = (const unsigned char*)VT + (size_t)m0_ * 2; \
        kreg[0] = *(const u32x4*)(kt_ + kgo); kreg[1] = *(const u32x4*)(kt_ + 32 * 1024 + kgo); \
        vreg[0] = *(const u32x4*)(vt_ + vgo); vreg[1] = *(const u32x4*)(vt_ + (size_t)64 * ROWS * 2 + vgo); } while (0)
#define AT_LSTORE(buf) do { LAS unsigned char* kb_ = lds + (buf) * AT_BUF; \
        *(LAS u32x4*)(kb_ + klo) = kreg[0]; *(LAS u32x4*)(kb_ + klo + 32 * AT_KSTR) = kreg[1]; \
        *(LAS u32x4*)(kb_ + vlo) = vreg[0]; *(LAS u32x4*)(kb_ + vlo + 64 * AT_VSTR) = vreg[1]; } while (0)
    AT_GLOAD(0); AT_LSTORE(0); __syncthreads();
#pragma unroll 1
    for (int j = 0; j < NT; ++j) {
        if (j + 1 < NT) AT_GLOAD(j + 1);
        const LAS unsigned char* Kb = lds + (j & 1) * AT_BUF + mp * 128; const LAS unsigned char* Vb = lds + (j & 1) * AT_BUF + AT_KSZ;
        const float dq = qh - (float)(j == 0 ? 0 : 64 * j - 48);
        f32x16 p0, p1;
#pragma unroll
        for (int r = 0; r < 16; ++r) { p0[r] = 0.f; p1[r] = 0.f; }
#pragma unroll
        for (int d0 = 0; d0 < 4; ++d0) {
            const bf16x8 a0 = *(const LAS bf16x8*)(Kb + r32 * AT_KSTR + d0 * 32 + hi * 16);
            const bf16x8 a1 = *(const LAS bf16x8*)(Kb + (32 + r32) * AT_KSTR + d0 * 32 + hi * 16);
            p0 = mfma32(a0, q[d0], p0); p1 = mfma32(a1, q[d0], p1);
        }
        __builtin_amdgcn_sched_barrier(0);
#pragma unroll
        for (int r = 0; r < 16; ++r) { const float dd = dq - (float)((r & 3) + 8 * (r >> 2)); p0[r] = fmaf(fabsf(dd), nslope, p0[r]); p1[r] = fmaf(fabsf(dd - 32.f), nslope, p1[r]); }
        if (j == 0) {
#pragma unroll
            for (int r = 0; r < 16; ++r) { if ((r & 3) + 8 * (r >> 2) + 4 * hi >= 16) p0[r] = -INFINITY; p1[r] = -INFINITY; }
        }
        float rm = fmaxf(p0[0], p1[0]);
#pragma unroll
        for (int r = 1; r < 16; ++r) rm = fmaxf(rm, fmaxf(p0[r], p1[r]));
        rm = fmaxf(rm, __shfl_xor(rm, 32));
        const float mn = fmaxf(mx, rm);
        if (__any(mn > mx)) {
            const float f = __builtin_amdgcn_exp2f(mx - mn); ls *= f; mx = mn;
#pragma unroll
            for (int b = 0; b < 4; ++b)
#pragma unroll
                for (int r = 0; r < 16; ++r) O[b][r] *= f;
        }
        float sum = 0.f;
#pragma unroll
        for (int r = 0; r < 16; ++r) { p0[r] = __builtin_amdgcn_exp2f(p0[r] - mx); p1[r] = __builtin_amdgcn_exp2f(p1[r] - mx); sum += p0[r] + p1[r]; }
        ls += sum;
        __builtin_amdgcn_sched_barrier(0);
        bf16x8 pf[4];
#pragma unroll
        for (int k2 = 0; k2 < 2; ++k2) {
            u32x4 w0, w1;
            w0.x = cvtpk(p0[8 * k2 + 0], p0[8 * k2 + 1]); w0.y = cvtpk(p0[8 * k2 + 2], p0[8 * k2 + 3]); w0.z = cvtpk(p0[8 * k2 + 4], p0[8 * k2 + 5]); w0.w = cvtpk(p0[8 * k2 + 6], p0[8 * k2 + 7]);
            w1.x = cvtpk(p1[8 * k2 + 0], p1[8 * k2 + 1]); w1.y = cvtpk(p1[8 * k2 + 2], p1[8 * k2 + 3]); w1.z = cvtpk(p1[8 * k2 + 4], p1[8 * k2 + 5]); w1.w = cvtpk(p1[8 * k2 + 6], p1[8 * k2 + 7]);
            pf[k2] = __builtin_bit_cast(bf16x8, w0); pf[2 + k2] = __builtin_bit_cast(bf16x8, w1);
        }
#pragma unroll
        for (int b = 0; b < 4; ++b)
#pragma unroll
            for (int ks = 0; ks < 4; ++ks) {
                const LAS unsigned char* vp = Vb + (b * 32 + r32) * AT_VSTR + ks * 32 + hi * 8;
                const u32x2 lo = *(const LAS u32x2*)vp, hh = *(const LAS u32x2*)(vp + 16);
                u32x4 vv; vv.x = lo.x; vv.y = lo.y; vv.z = hh.x; vv.w = hh.y;
                O[b] = mfma32(__builtin_bit_cast(bf16x8, vv), pf[ks], O[b]);
                if (ks == 3) __builtin_amdgcn_sched_barrier(0);
            }
        if (j + 1 < NT) AT_LSTORE((j + 1) & 1);
        __syncthreads();
    }
#undef AT_GLOAD
#undef AT_LSTORE
    const float lt = ls + __shfl_xor(ls, 32);
    const float inv = (mp ? lam : 1.0f) / lt;
    int lane2 = lane; asm volatile("" : "+v"(lane2));
    const int r32e = lane2 & 31, hie = lane2 >> 5;
    LAS float* ex = (LAS float*)lds + rg * (128 * 32) + hie * 128 + r32e;
    if (mp == 1) {
#pragma unroll
        for (int b = 0; b < 4; ++b)
#pragma unroll
            for (int r = 0; r < 16; ++r) ex[(32 * b + (r & 3) + 8 * (r >> 2)) * 32] = O[b][r] * inv;
    }
    __syncthreads();
    if (mp == 0) {
        float ss = 0.f;
#pragma unroll
        for (int b = 0; b < 4; ++b)
#pragma unroll
            for (int r = 0; r < 16; ++r) { const float o = O[b][r] * inv - ex[(32 * b + (r & 3) + 8 * (r >> 2)) * 32]; O[b][r] = o; ss += o * o; }
        ss += __shfl_xor(ss, 32);
        const float rstd = rsqrtf(ss * (1.0f / 128.0f) + 1e-5f) * 0.8f;
        const float* sg = P->in[I_SUBG] + 4 * hie; bf16* Qo = Q + (size_t)(base + qb * 128 + rg * 32 + r32e) * 512 + h * 128 + 4 * hie;
#pragma unroll
        for (int b = 0; b < 4; ++b)
#pragma unroll
            for (int r4 = 0; r4 < 4; ++r4) {
                const int n = 32 * b + 8 * r4; const f32x4 g = *(const f32x4*)(sg + n);
                u32x2 w; w.x = cvtpk(O[b][4 * r4 + 0] * rstd * g.x, O[b][4 * r4 + 1] * rstd * g.y); w.y = cvtpk(O[b][4 * r4 + 2] * rstd * g.z, O[b][4 * r4 + 3] * rstd * g.w);
                *(u32x2*)(Qo + n) = w;
            }
    }
    __syncthreads();
}

constexpr int SC_R = 0, SC_K = 16384, SC_V = 32768, SC_W = 49152, SC_B = 65536, SC_KK = 81920, SC_Y = 98304, SC_TW = 114688, SC_AD = 123904, SC_MU = 133120;
__device__ __forceinline__ float dpp_add(float v, int ctrl_id) {
    int x = __float_as_int(v), y;
    if (ctrl_id == 0) y = __builtin_amdgcn_update_dpp(x, x, 0xB1, 0xf, 0xf, false);
    else if (ctrl_id == 1) y = __builtin_amdgcn_update_dpp(x, x, 0x4E, 0xf, 0xf, false);
    else if (ctrl_id == 2) y = __builtin_amdgcn_update_dpp(x, x, 0x141, 0xf, 0xf, false);
    else y = __builtin_amdgcn_update_dpp(x, x, 0x140, 0xf, 0xf, false);
    return v + __int_as_float(y);
}
template <int LPR> __device__ __forceinline__ float grp_sum(float v) {
    v = dpp_add(v, 0); v = dpp_add(v, 1); v = dpp_add(v, 2);
    if (LPR == 16) v = dpp_add(v, 3);
    return v;
}
template <int NRP>
__device__ __forceinline__ void scan_unit(LAS unsigned char* lds, KP P, int s, int d, int h, int rp) {
    constexpr int LPR = 8 * NRP, CPL = 64 / LPR, RPB = 64 / NRP;
    int tid_ = threadIdx.x; asm volatile("" : "+v"(tid_));
    const int tid = tid_, lane = tid & 63, wid = __builtin_amdgcn_readfirstlane(tid >> 6);
    const int L = seq_len(s), base = seq_base(s), Ltot = L + 16, nchunk = (Ltot + 63) / 64;
    unsigned char* ws = P->ws;
    const bf16* Rb = (const bf16*)(ws + WS_R); const bf16* KAb = (const bf16*)(ws + WS_KA); const bf16* VAb = (const bf16*)(ws + WS_VA); const bf16* Lb = (const bf16*)(ws + WS_L);
    float* CB = (float*)(ws + WS_CB); bf16* YD = (bf16*)((unsigned char*)P->out + 64 * MiB) + (size_t)d * NMAIN * 512;
    LAS float* fR = (LAS float*)(lds + SC_R); LAS float* fK = (LAS float*)(lds + SC_K); LAS float* fV = (LAS float*)(lds + SC_V); LAS float* fW = (LAS float*)(lds + SC_W);
    LAS float* fB = (LAS float*)(lds + SC_B); LAS float* fKK = (LAS float*)(lds + SC_KK); LAS float* fY = (LAS float*)(lds + SC_Y); LAS float* fMU = (LAS float*)(lds + SC_MU);
    for (int i = tid; i < 640; i += NTHREADS) { const int which = i / 320, jj = i % 320, a = jj >> 6, c = jj & 63; const int gi = a < 3 ? a * 512 + h * 64 + c : 1536 + (a - 3) * 64 + c; fMU[i] = P->in[which ? I_MUN : I_MUP][gi]; }
    const int mat = wid >> 2, ntile = wid & 3;
    const bf16* Wt = (const bf16*)(ws + WS_LORA + (mat ? 131072 : 0)) + ((size_t)d * 512 + h * 64 + ntile * 16 + (lane & 15)) * 64 + (lane >> 4) * 8;
    const bf16x8 bfr0 = *(const bf16x8*)Wt, bfr1 = *(const bf16x8*)(Wt + 32);
    const float bias = P->in[mat ? I_A0 : I_W0][d * 512 + h * 64 + ntile * 16 + (lane & 15)];
    const float kkc = P->in[I_KK][h * 64 + lane], kac = P->in[I_KA][h * 64 + lane], rkc = P->in[I_RK][h * 64 + lane];
    float S[CPL];
#pragma unroll
    for (int j = 0; j < CPL; ++j) S[j] = 0.f;
    const int rowl = lane / LPR, kg = lane % LPR, srow = rp * RPB + wid * (RPB / 8) + rowl;
    const int slot = tid >> 3, cg8 = (tid & 7) * 8;
    u32x4 raw[5][3];
#define SC_LOAD(c) do { const int i_ = 64 * (c) + slot; const int p_ = d ? Ltot - 1 - i_ : i_; const bool ok_ = i_ < Ltot; \
        const bool okp_ = ok_ && p_ > 0, okn_ = ok_ && p_ + 1 < Ltot; \
        const size_t rc_ = ok_ ? (size_t)pos_row(base, p_) : 0, rp_ = okp_ ? (size_t)pos_row(base, p_ - 1) : 0, rn_ = okn_ ? (size_t)pos_row(base, p_ + 1) : 0; \
        const u32x4 z_ = {0u, 0u, 0u, 0u}; \
        _Pragma("unroll") for (int a_ = 0; a_ < 5; ++a_) { const bf16* B_ = a_ == 0 ? Rb : a_ == 1 ? KAb : a_ == 2 ? VAb : Lb; const int ld_ = a_ < 3 ? 512 : 256; \
            const int co_ = (a_ < 3 ? h * 64 : (a_ - 3) * 64) + cg8; \
            raw[a_][0] = okp_ ? *(const u32x4*)(B_ + rp_ * ld_ + co_) : z_; raw[a_][1] = ok_ ? *(const u32x4*)(B_ + rc_ * ld_ + co_) : z_; raw[a_][2] = okn_ ? *(const u32x4*)(B_ + rn_ * ld_ + co_) : z_; } } while (0)
    SC_LOAD(0);
    __syncthreads();
    for (int c = 0; c < nchunk; ++c) {
        const int nvalid = (Ltot - 64 * c) < 64 ? (Ltot - 64 * c) : 64;
#pragma unroll
        for (int a = 0; a < 5; ++a) {
            float pv[8], cv[8], nv[8], o[8]; unpack8(raw[a][0], pv); unpack8(raw[a][1], cv); unpack8(raw[a][2], nv);
#pragma unroll
            for (int e = 0; e < 8; ++e) { const float mp = fMU[a * 64 + cg8 + e], mn = fMU[320 + a * 64 + cg8 + e]; o[e] = cv[e] + mp * (pv[e] - cv[e]) + mn * (nv[e] - cv[e]); }
            if (a < 3) { LAS float* dst = (a == 0 ? fR : a == 1 ? fK : fV) + slot * 64 + cg8; *(LAS f32x4*)dst = (f32x4){o[0], o[1], o[2], o[3]}; *(LAS f32x4*)(dst + 4) = (f32x4){o[4], o[5], o[6], o[7]}; }
            else {
                if (a == 3) {
#pragma unroll
                    for (int e = 0; e < 8; ++e) o[e] = tanhf(o[e]);
                }
                u32x4 w; w.x = cvtpk(o[0], o[1]); w.y = cvtpk(o[2], o[3]); w.z = cvtpk(o[4], o[5]); w.w = cvtpk(o[6], o[7]);
                *(LAS u32x4*)(lds + (a == 3 ? SC_TW : SC_AD) + slot * 144 + cg8 * 2) = w;
            }
        }
        __syncthreads();
        if (c + 1 < nchunk) SC_LOAD(c + 1);
        {
            const LAS unsigned char* Ab = lds + (mat ? SC_AD : SC_TW);
#pragma unroll
            for (int mt = 0; mt < 4; ++mt) {
                const bf16x8 a0 = *(const LAS bf16x8*)(Ab + (mt * 16 + (lane & 15)) * 144 + (lane >> 4) * 16);
                const bf16x8 a1 = *(const LAS bf16x8*)(Ab + (mt * 16 + (lane & 15)) * 144 + 64 + (lane >> 4) * 16);
                f32x4 acc = {0.f, 0.f, 0.f, 0.f};
                acc = __builtin_amdgcn_mfma_f32_16x16x32_bf16(a0, bfr0, acc, 0, 0, 0);
                acc = __builtin_amdgcn_mfma_f32_16x16x32_bf16(a1, bfr1, acc, 0, 0, 0);
#pragma unroll
                for (int rg = 0; rg < 4; ++rg) {
                    const int sl = mt * 16 + (lane >> 4) * 4 + rg, col = ntile * 16 + (lane & 15);
                    const float sg = sigmoidf_(acc[rg] + bias);
                    if (mat == 0) fW[sl * 64 + col] = __expf(-0.6065306597126334f * sg); else fB[sl * 64 + col] = sg;
                }
            }
        }
        __syncthreads();
#pragma unroll
        for (int q8 = 0; q8 < 8; ++q8) {
            const int sl = wid * 8 + q8;
            const float kr = fK[sl * 64 + lane], av = fB[sl * 64 + lane], rv = fR[sl * 64 + lane];
            const float kkv = kr * kkc; const float ssq = wave_sum(kkv * kkv); const float kkn = kkv * rsqrtf(fmaxf(ssq, 1e-24f));
            const float kd = kr * (1.0f + (av - 1.0f) * kac); const float cs = wave_sum(rv * kd * rkc);
            fKK[sl * 64 + lane] = kkn; fB[sl * 64 + lane] = kkn * av; fK[sl * 64 + lane] = kd;
            if (lane == 0 && rp == 0 && sl < nvalid) { const int i2 = 64 * c + sl; const int p2 = d ? Ltot - 1 - i2 : i2; CB[((size_t)d * ROWS + pos_row(base, p2)) * 8 + h] = cs; }
        }
        __syncthreads();
        {
            const LAS float* pk = fKK + kg * CPL; const LAS float* pw = fW + kg * CPL; const LAS float* pb = fB + kg * CPL; const LAS float* pd = fK + kg * CPL; const LAS float* pr = fR + kg * CPL;
#pragma unroll 2
            for (int sl = 0; sl < nvalid; ++sl) {
                float kk_[CPL], w_[CPL], b_[CPL], d_[CPL], r_[CPL];
#pragma unroll
                for (int j = 0; j < CPL; j += 4) {
                    const f32x4 t0 = *(const LAS f32x4*)(pk + sl * 64 + j), t1 = *(const LAS f32x4*)(pw + sl * 64 + j), t2 = *(const LAS f32x4*)(pb + sl * 64 + j), t3 = *(const LAS f32x4*)(pd + sl * 64 + j), t4 = *(const LAS f32x4*)(pr + sl * 64 + j);
#pragma unroll
                    for (int e = 0; e < 4; ++e) { kk_[j + e] = t0[e]; w_[j + e] = t1[e]; b_[j + e] = t2[e]; d_[j + e] = t3[e]; r_[j + e] = t4[e]; }
                }
                const float vv = fV[sl * 64 + srow];
                float pp = 0.f;
#pragma unroll
                for (int j = 0; j < CPL; ++j) pp = fmaf(S[j], kk_[j], pp);
                pp = grp_sum<LPR>(pp);
                float yy = 0.f;
#pragma unroll
                for (int j = 0; j < CPL; ++j) { const float t = fmaf(-pp, b_[j], vv * d_[j]); S[j] = fmaf(S[j], w_[j], t); yy = fmaf(S[j], r_[j], yy); }
                yy = grp_sum<LPR>(yy);
                if (kg == 0) fY[sl * 64 + srow] = yy;
            }
        }
        __syncthreads();
        {
            const int i2 = 64 * c + slot; const int p2 = d ? Ltot - 1 - i2 : i2;
            if (slot < nvalid && p2 >= 16 && (cg8 / RPB) == rp) {
                const LAS float* yp = fY + slot * 64 + cg8; const f32x4 y0 = *(const LAS f32x4*)yp, y1 = *(const LAS f32x4*)(yp + 4);
                *(u32x4*)(YD + (size_t)(base + p2 - 16) * 512 + h * 64 + cg8) = pack8(y0, y1);
            }
        }
    }
#undef SC_LOAD
}

__device__ __forceinline__ void phase_post(LAS unsigned char* lds, KP P) {
    const int tid = threadIdx.x, lane = tid & 63, wid = tid >> 6;
    unsigned char* ws = P->ws;
    const bf16* VAb = (const bf16*)(ws + WS_VA); const bf16* Lb = (const bf16*)(ws + WS_L); bf16* Rb = (bf16*)(ws + WS_R);
    const float* CB = (const float*)(ws + WS_CB); const bf16* YD0 = (const bf16*)((const unsigned char*)P->out + 64 * MiB); const bf16* YD1 = YD0 + (size_t)NMAIN * 512;
    const bf16* GT = (const bf16*)(ws + WS_LORA + 262144);
    LAS float* st = (LAS float*)(lds + 17408);
    const float* mup = P->in[I_MUP]; const float* mun = P->in[I_MUN];
    for (int tile = blockIdx.x; tile < NMAIN / 64; tile += gridDim.x) {
        {
            const int row = tid >> 3, hh = tid & 7, m = tile * 64 + row;
            const int t = m < 16384 ? m : (m - 16384) & 2047, Ls = m < 16384 ? 16384 : 2048;
            float sum = 0.f, sq = 0.f;
#pragma unroll
            for (int i = 0; i < 8; ++i) { float a[8], b[8]; unpack8(*(const u32x4*)(YD0 + (size_t)m * 512 + hh * 64 + i * 8), a); unpack8(*(const u32x4*)(YD1 + (size_t)m * 512 + hh * 64 + i * 8), b);
#pragma unroll
                for (int e = 0; e < 8; ++e) { const float y = a[e] + b[e]; sum += y; sq += y * y; } }
            const float mu = sum * (1.0f / 64.0f); const float var = fmaxf(sq * (1.0f / 64.0f) - mu * mu, 0.f);
            st[(row * 8 + hh) * 2] = mu; st[(row * 8 + hh) * 2 + 1] = rsqrtf(var + 64e-5f);
            const size_t rp_ = t == 0 ? (size_t)(METAROW + 15) : (size_t)(m - 1); const bool okn = t + 1 < Ls;
#pragma unroll
            for (int i = 0; i < 2; ++i) {
                const int c0 = 128 + hh * 16 + i * 8; float pv[8], cv[8], nv[8], o[8];
                unpack8(*(const u32x4*)(Lb + rp_ * 256 + c0), pv); unpack8(*(const u32x4*)(Lb + (size_t)m * 256 + c0), cv);
                if (okn) unpack8(*(const u32x4*)(Lb + (size_t)(m + 1) * 256 + c0), nv); else {
#pragma unroll
                    for (int e = 0; e < 8; ++e) nv[e] = 0.f; }
#pragma unroll
                for (int e = 0; e < 8; ++e) { const float mp = mup[1536 + c0 + e], mn = mun[1536 + c0 + e]; o[e] = sigmoidf_(cv[e] + mp * (pv[e] - cv[e]) + mn * (nv[e] - cv[e])); }
                u32x4 w; w.x = cvtpk(o[0], o[1]); w.y = cvtpk(o[2], o[3]); w.z = cvtpk(o[4], o[5]); w.w = cvtpk(o[6], o[7]);
                *(LAS u32x4*)(lds + row * 272 + (hh * 16 + i * 8) * 2) = w;
            }
        }
        __syncthreads();
#pragma unroll 1
        for (int nt = 0; nt < 4; ++nt) {
            const int col = wid * 64 + nt * 16 + (lane & 15);
            bf16x8 bfr[4];
#pragma unroll
            for (int ks = 0; ks < 4; ++ks) bfr[ks] = *(const bf16x8*)(GT + (size_t)col * 128 + ks * 32 + (lane >> 4) * 8);
            const float lw = P->in[I_LNW][col], lb = P->in[I_LNB][col];
            const float mpv = mup[1024 + col], mnv = mun[1024 + col];
#pragma unroll 1
            for (int mt = 0; mt < 4; ++mt) {
                f32x4 acc = {0.f, 0.f, 0.f, 0.f};
#pragma unroll
                for (int ks = 0; ks < 4; ++ks) { const bf16x8 a = *(const LAS bf16x8*)(lds + (mt * 16 + (lane & 15)) * 272 + ks * 64 + (lane >> 4) * 16); acc = __builtin_amdgcn_mfma_f32_16x16x32_bf16(a, bfr[ks], acc, 0, 0, 0); }
#pragma unroll
                for (int rg = 0; rg < 4; ++rg) {
                    const int row = mt * 16 + (lane >> 4) * 4 + rg, m = tile * 64 + row;
                    const int t = m < 16384 ? m : (m - 16384) & 2047, Ls = m < 16384 ? 16384 : 2048;
                    const float y = bf2f(YD0[(size_t)m * 512 + col]) + bf2f(YD1[(size_t)m * 512 + col]);
                    const float yn = (y - st[(row * 8 + wid) * 2]) * st[(row * 8 + wid) * 2 + 1] * lw + lb;
                    const float vc = bf2f(VAb[(size_t)m * 512 + col]);
                    const float vp = bf2f(VAb[(t == 0 ? (size_t)(METAROW + 15) : (size_t)(m - 1)) * 512 + col]);
                    const float vn = t + 1 < Ls ? bf2f(VAb[(size_t)(m + 1) * 512 + col]) : 0.f;
                    const float vs = vc + mpv * (vp - vc) + mnv * (vn - vc);
                    const float cb = CB[(size_t)m * 8 + wid] + CB[((size_t)ROWS + m) * 8 + wid];
                    Rb[(size_t)m * 512 + col] = (bf16)f2bf_rne((yn + cb * vs) * acc[rg]);
                }
            }
        }
        __syncthreads();
    }
}

__device__ __forceinline__ void phase_rms_bf16(KP P) {
    const int lane = threadIdx.x & 63, wid = threadIdx.x >> 6; const int gw = blockIdx.x * 8 + wid, NGW = gridDim.x * 8;
    bf16* MN = (bf16*)(P->ws + WS_MN);
    for (int m = gw; m < NMAIN; m += NGW) rms_row_bf16(P->out + (size_t)m * DM, P->in[I_GFFN], MN + (size_t)m * DM, lane);
}
__device__ __forceinline__ void phase_final(KP P) {
    const int lane = threadIdx.x & 63, wid = threadIdx.x >> 6; const int gw = blockIdx.x * 8 + wid, NGW = gridDim.x * 8;
    const f32x4* gr = (const f32x4*)P->in[I_GFIN] + lane;
    for (int m = gw; m < NMAIN; m += NGW) {
        f32x4* xr = (f32x4*)(P->out + (size_t)m * DM) + lane; f32x4 v[4]; float s = 0.f;
#pragma unroll
        for (int j = 0; j < 4; ++j) { v[j] = xr[64 * j]; s += (v[j].x * v[j].x + v[j].y * v[j].y) + (v[j].z * v[j].z + v[j].w * v[j].w); }
        const float rstd = rsqrtf(wave_sum(s) * (1.f / DM) + 1e-6f);
#pragma unroll
        for (int j = 0; j < 4; ++j) xr[64 * j] = v[j] * rstd * gr[64 * j];
    }
}

constexpr int NRP_LONG = 2;
constexpr int N_LONG = 16 * NRP_LONG, N_ATT_P = 512, N_ATT_S = 512, N_SHORT = 128, N_ITEMS = N_LONG + N_ATT_P + N_ATT_S + N_SHORT;

template <class Op> __device__ __forceinline__ void run_gemm(LAS unsigned char* lds, const bf16* A, const bf16* Bt, int M, int N, int K, const Op& op, const bf16* A2 = nullptr, int pm2 = 1 << 30) {
    pg8::Gemm g{A, Bt, M, N, K, A2, pm2}; pg8::StaticOrder S; S.init(M, N, (int)gridDim.x, (int)blockIdx.x);
    Epi8<Op> E{op};
    pg8::gemm_phase<Epi8<Op>, pg8::StaticOrder, true, true>(lds, g, S, E);
}

__global__ void __launch_bounds__(NTHREADS) fwd_megakernel(Params Pin) {
    extern __shared__ __attribute__((aligned(16))) unsigned char lds_raw[];
    LAS unsigned char* lds = (LAS unsigned char*)lds_raw;
    cg::grid_group grid = cg::this_grid();
    const int tid = threadIdx.x;
    KP P0 = (KP)__builtin_amdgcn_kernarg_segment_ptr();
#define NEWPHASE KP P = P0; asm volatile("" : "+s"(P)); unsigned char* ws = P->ws; (void)ws;

    { NEWPHASE phase_prologue(lds, P); }
    grid.sync();
    { NEWPHASE run_gemm(lds, (const bf16*)P->out, (const bf16*)(ws + WS_WIN), ROWS, 3328, 1024, OpProj{ws}, (const bf16*)(ws + WS_XNMETA), 128); }
    grid.sync();
    { NEWPHASE
        float lam;
        { const int lane = tid & 63; const float s1 = wave_sum(P->in[I_LQ1][lane] * P->in[I_LK1][lane]), s2 = wave_sum(P->in[I_LQ2][lane] * P->in[I_LK2][lane]); lam = __expf(s1) - __expf(s2) + 0.2f; }
        unsigned* ctr = (unsigned*)(ws + WS_CTL);
        LAS unsigned* slot = (LAS unsigned*)(lds + LDS_ITEM_OFF);
#define FETCH(k, n) if (tid == 0) *slot = atomicAdd(ctr + 64 * (k), 1u); __syncthreads(); const int idx = (int)*slot; __syncthreads(); if (idx >= (n)) break;
#ifndef NO_SCAN
#pragma unroll 1
        for (;;) { FETCH(0, N_LONG) const int u = idx / NRP_LONG; scan_unit<NRP_LONG>(lds, P, 0, u >> 3, u & 7, idx % NRP_LONG); }
#endif
#ifndef NO_ATTN
#pragma unroll 1
        for (;;) { FETCH(1, N_ATT_P + N_ATT_S)
            if (idx < N_ATT_P) attn_unit(lds, P, 0, idx >> 7, idx & 127, lam);
            else { const int a = idx - N_ATT_P; attn_unit(lds, P, 1 + (a >> 6), (a >> 4) & 3, a & 15, lam); } }
#endif
#ifndef NO_SCAN
#pragma unroll 1
        for (;;) { FETCH(2, N_SHORT) scan_unit<1>(lds, P, 1 + (idx >> 4), (idx >> 3) & 1, idx & 7, 0); }
#endif
#undef FETCH
    }
    grid.sync();
#ifndef NO_POST
    { NEWPHASE phase_post(lds, P); }
#endif
    grid.sync();
    { NEWPHASE run_gemm(lds, (const bf16*)P->out, (const bf16*)(ws + WS_WIN) + (size_t)3328 * 1024, NMAIN, 2048, 1024, OpGate{ws}); }
    grid.sync();
    { NEWPHASE run_gemm(lds, (const bf16*)(ws + WS_R), (const bf16*)(ws + WS_WUPA), NMAIN, 1024, 512, OpUpA{ws}); }
    grid.sync();
    { NEWPHASE run_gemm(lds, (const bf16*)(ws + WS_Q), (const bf16*)(ws + WS_WUPB), NMAIN, 1024, 512, OpUpB{ws}); }
    grid.sync();
    { NEWPHASE run_gemm(lds, (const bf16*)(ws + WS_GB), (const bf16*)(ws + WS_WOUT), NMAIN, 1024, 1024, OpOut{P->in[I_XP], P->in[I_XS], P->out}); }
    grid.sync();
    { NEWPHASE phase_rms_bf16(P); }
    grid.sync();
    { NEWPHASE run_gemm(lds, (const bf16*)(ws + WS_MN), (const bf16*)(ws + WS_WFF1), 16384, DFF, 1024, OpFF1{(bf16*)(ws + WS_HID)}); }
    grid.sync();
    { NEWPHASE run_gemm(lds, (const bf16*)(ws + WS_HID), (const bf16*)(ws + WS_WFF2), 16384, 1024, DFF, OpFF2{P->out}); }
    grid.sync();
    { NEWPHASE run_gemm(lds, (const bf16*)(ws + WS_MN) + (size_t)16384 * DM, (const bf16*)(ws + WS_WFF1), 16384, DFF, 1024, OpFF1{(bf16*)(ws + WS_HID)}); }
    grid.sync();
    { NEWPHASE run_gemm(lds, (const bf16*)(ws + WS_HID), (const bf16*)(ws + WS_WFF2), 16384, 1024, DFF, OpFF2{P->out + (size_t)16384 * DM}); }
    grid.sync();
    { NEWPHASE phase_final(P); }
}

extern "C" void kernel_launch(void* const* d_in, const int* in_sizes, int n_in, void* d_out, int out_size, void* d_ws, size_t ws_size, hipStream_t stream) {
    static int grid_blocks = 0;
    if (grid_blocks == 0) {
        int dev = 0, cus = 0, per_cu = 0;
        hipGetDevice(&dev);
        hipDeviceGetAttribute(&cus, hipDeviceAttributeMultiprocessorCount, dev);
        hipFuncSetAttribute((const void*)fwd_megakernel, hipFuncAttributeMaxDynamicSharedMemorySize, LDS_BYTES);
        hipOccupancyMaxActiveBlocksPerMultiprocessor(&per_cu, (const void*)fwd_megakernel, NTHREADS, LDS_BYTES);
        if (per_cu < 1) { fprintf(stderr, "kernel_launch: occupancy query says %d blocks per CU\n", per_cu); per_cu = 1; }
        grid_blocks = cus * per_cu;
        if (n_in != 29 || ws_size < WS_END) fprintf(stderr, "kernel_launch: unexpected n_in %d / ws_size %zu\n", n_in, ws_size);
    }
    hipMemsetAsync((unsigned char*)d_ws + WS_CTL, 0, 4096, stream);
    Params p{};
    for (int i = 0; i < 29; ++i) p.in[i] = (const float*)d_in[i];
    p.out = (float*)d_out; p.ws = (unsigned char*)d_ws;
    void* args[] = {&p};
    hipError_t e = hipLaunchCooperativeKernel((const void*)fwd_megakernel, dim3(grid_blocks), dim3(NTHREADS), args, LDS_BYTES, stream);
    if (e != hipSuccess) fprintf(stderr, "cooperative launch failed: %s (grid %d)\n", hipGetErrorString(e), grid_blocks);
}
```

```cpp
#include <hip/hip_runtime.h>
#include <hip/hip_cooperative_groups.h>
#include <cstdio>
#include <cstdint>
#include <cmath>
namespace cg = cooperative_groups;
__device__ __forceinline__ int fresh_tid() { int t = threadIdx.x; asm volatile("" : "+v"(t)); return t; }
namespace pg8 {
#define PG8_LAS __attribute__((address_space(3)))
typedef unsigned short bf16_t;
typedef short bf16x8 __attribute__((ext_vector_type(8)));
typedef float f32x4 __attribute__((ext_vector_type(4)));
typedef unsigned u32x4 __attribute__((ext_vector_type(4)));
constexpr int BM = 256, BK = 64, HALF = 128, HTB = HALF * BK * 2  , STAGE_BYTES = 8 * HTB, NXCD = 8, WGM = 8;

__host__ __device__ __forceinline__ int lds_byte(int r, int c) { const int st = (r >> 4) * 2 + (c >> 5), rr = r & 15, cc = c & 31, ob = rr * 64 + cc * 2; return st * 1024 + (ob ^ (((ob >> 9) & 1) << 5)); }
__host__ __device__ __forceinline__ void stage_rc(int b, int& R, int& C) { const int st = b / 1024, sb = b % 1024, swz = sb ^ (((sb >> 9) & 1) << 5); R = (st >> 1) * 16 + swz / 64; C = (st & 1) * 32 + (swz % 64) / 2; }
__host__ __device__ __forceinline__ int perm32(int rho) { const int n = rho >> 4, i = rho & 15; return 8 * (i >> 2) + 4 * n + (i & 3); }

struct Unit { int pm, pn; };
struct Gemm { const bf16_t* A; const bf16_t* Bt; int M, N, K; const bf16_t* A2; int pm2; };
__device__ __forceinline__ const char* gemm_abase(const Gemm& g, int pm, size_t tstep) { return pm >= g.pm2 ? (const char*)g.A2 + (size_t)(pm - g.pm2) * tstep : (const char*)g.A + (size_t)pm * tstep; }

struct StaticOrder {
    int nM, nN, nwg, G, c;
    __host__ __device__ void init(int M, int N, int G_, int c_) { nM = M / BM; nN = N / BM; nwg = nM * nN; G = G_; c = c_; }
    __host__ __device__ bool next(int i, Unit& u) const {
        const long L = (long)i * G + c; if (L >= nwg) return false;
        int wgid = (int)L; { const int q = nwg / NXCD, r = nwg % NXCD, xcd = wgid % NXCD, off = wgid / NXCD; wgid = (xcd < r ? xcd * (q + 1) : r * (q + 1) + (xcd - r) * q) + off; }
        const int nig = WGM * nN, gid = wgid / nig, fm = gid * WGM, gsz = (nM - fm) < WGM ? (nM - fm) : WGM;
        u.pm = fm + ((wgid % nig) % gsz); u.pn = (wgid % nig) / gsz; return true;
    }
    __device__ __forceinline__ void a_ready(const Unit&) const {}
    __device__ __forceinline__ void done(const Unit&) const {}
};


template <class Epi, class Sched, bool ALIGN_EPI = false, bool SP2 = false>
__device__ __forceinline__ void gemm_phase(PG8_LAS unsigned char* lds, const Gemm g, const Sched& S, const Epi& E) {
    const int tid = fresh_tid(), wid = __builtin_amdgcn_readfirstlane(tid >> 6), lane = tid & 63, wr = wid >> 2, wc = wid & 3, fr = lane & 15, fq = lane >> 4;
    const int K = g.K, nt = K / BK;
    unsigned voffA[2], voffB[2];
#pragma unroll
    for (int i = 0; i < 2; ++i) { int R, C; stage_rc(tid * 16 + i * 8192, R, C); const int Rb = Epi::PERM ? ((R & ~31) + perm32(R & 31)) : R;
        voffA[i] = (unsigned)(R * K + C) * 2u; voffB[i] = (unsigned)(Rb * K + C) * 2u; }
    const size_t kstep = (size_t)(BK * 2);
    const size_t hstep = (size_t)HALF * K * 2;
    const size_t tstep = 2 * hstep;
    const unsigned ldsw = (unsigned)wid * 1024u;
    const int aoff = lds_byte(wr * 64 + fr, fq * 8), boff = lds_byte(wc * 32 + fr, fq * 8);
#define PG8_SA(b, h) (((b) * 2 + (h)) * HTB)
#define PG8_SB(b, h) ((4 + (b) * 2 + (h)) * HTB)
#define PG8_STAGE(bufoff, gbase, voff) do { _Pragma("unroll") for (int _i = 0; _i < 2; ++_i) \
        __builtin_amdgcn_global_load_lds((const unsigned*)((const char*)(gbase) + (voff)[_i]), (PG8_LAS unsigned*)(lds + (bufoff) + ldsw + _i * 8192), 16, 0, 0); } while (0)
#define PG8_LDA(dst, b, h) do { _Pragma("unroll") for (int m = 0; m < 4; ++m) _Pragma("unroll") for (int k = 0; k < 2; ++k) dst[m][k] = *(const PG8_LAS bf16x8*)(lds + PG8_SA(b, h) + aoff + m * 2048 + k * 1024); } while (0)
#define PG8_LDB(dst, b, h) do { _Pragma("unroll") for (int n = 0; n < 2; ++n) _Pragma("unroll") for (int k = 0; k < 2; ++k) dst[n][k] = *(const PG8_LAS bf16x8*)(lds + PG8_SB(b, h) + boff + n * 2048 + k * 1024); } while (0)
#define PG8_MMA(ai, bj, At, Bt) do { __builtin_amdgcn_s_setprio(1); _Pragma("unroll") for (int m = 0; m < 4; ++m) _Pragma("unroll") for (int n = 0; n < 2; ++n) _Pragma("unroll") for (int k = 0; k < 2; ++k) \
        acc[ai][bj][m][n] = __builtin_amdgcn_mfma_f32_16x16x32_bf16(Bt[n][k], At[m][k], acc[ai][bj][m][n], 0, 0, 0); __builtin_amdgcn_s_setprio(0); } while (0)
#define PG8_WAIT_V(n) asm volatile("s_waitcnt vmcnt(" #n ")" ::: "memory")
#define PG8_WAIT_L(n) asm volatile("s_waitcnt lgkmcnt(" #n ")" ::: "memory")
#define PG8_BAR __builtin_amdgcn_s_barrier()
#define PG8_SCHED __builtin_amdgcn_sched_barrier(0)
    Unit cur, nxt; int ui = 0;
    if (!S.next(0, cur)) return;
    f32x4 acc[2][2][4][2];
#pragma unroll
    for (int a = 0; a < 2; ++a)
#pragma unroll
        for (int b = 0; b < 2; ++b)
#pragma unroll
            for (int m = 0; m < 4; ++m)
#pragma unroll
                for (int n = 0; n < 2; ++n) acc[a][b][m][n] = (f32x4){0.f, 0.f, 0.f, 0.f};
    bf16x8 At[4][2], B0[2][2], B1[2][2];
    const char* cA = gemm_abase(g, cur.pm, tstep); const char* cB = (const char*)g.Bt + (size_t)cur.pn * tstep;
    S.a_ready(cur);
    if constexpr (SP2) {
        PG8_STAGE(PG8_SB(0, 0), cB, voffB); PG8_STAGE(PG8_SB(0, 1), cB + hstep, voffB); PG8_STAGE(PG8_SA(0, 0), cA, voffA); PG8_STAGE(PG8_SA(0, 1), cA + hstep, voffA);
        if (wr == 1) PG8_BAR;
        PG8_WAIT_V(2); PG8_BAR;
        PG8_STAGE(PG8_SB(1, 0), cB + kstep, voffB); PG8_STAGE(PG8_SA(1, 0), cA + kstep, voffA); PG8_STAGE(PG8_SB(1, 1), cB + hstep + kstep, voffB);
        PG8_WAIT_V(6); PG8_BAR;
    } else {
        PG8_STAGE(PG8_SB(0, 0), cB, voffB); PG8_STAGE(PG8_SA(0, 0), cA, voffA); PG8_STAGE(PG8_SB(0, 1), cB + hstep, voffB); PG8_STAGE(PG8_SA(0, 1), cA + hstep, voffA);
        if (wr == 1) PG8_BAR;
        PG8_WAIT_V(4); PG8_BAR;
        PG8_STAGE(PG8_SB(1, 0), cB + kstep, voffB); PG8_STAGE(PG8_SA(1, 0), cA + kstep, voffA); PG8_STAGE(PG8_SB(1, 1), cB + hstep + kstep, voffB);
        PG8_WAIT_V(6); PG8_BAR;
    }
    for (;;) {
        const bool has_next = S.next(ui + 1, nxt);
        const char* nA = has_next ? gemm_abase(g, nxt.pm, tstep) : cA; const char* nB = has_next ? (const char*)g.Bt + (size_t)nxt.pn * tstep : cB;
        for (int t = 0; t < nt; t += 2) {
            const bool last = (t == nt - 2);
            const char* a1 = cA + (size_t)(t + 1) * kstep;
            const char* a2 = last ? nA : cA + (size_t)(t + 2) * kstep; const char* b2 = last ? nB : cB + (size_t)(t + 2) * kstep;
            const char* a3 = a2 + kstep; const char* b3 = b2 + kstep;
            if (last && has_next) S.a_ready(nxt);
            if constexpr (SP2) {
            PG8_LDB(B0, 0, 0); PG8_LDB(B1, 0, 1); PG8_SCHED; PG8_LDA(At, 0, 0); PG8_STAGE(PG8_SA(1, 1), a1 + hstep, voffA);
            PG8_WAIT_V(8); PG8_WAIT_L(0); PG8_BAR; PG8_MMA(0, 0, At, B0); PG8_MMA(0, 1, At, B1); PG8_BAR; PG8_SCHED;
            PG8_LDA(At, 0, 1); PG8_STAGE(PG8_SB(0, 0), b2, voffB); PG8_STAGE(PG8_SB(0, 1), b2 + hstep, voffB); PG8_STAGE(PG8_SA(0, 0), a2, voffA);
            PG8_WAIT_V(8); PG8_WAIT_L(0); PG8_BAR; PG8_MMA(1, 0, At, B0); PG8_MMA(1, 1, At, B1); PG8_BAR; PG8_SCHED;
            PG8_LDB(B0, 1, 0); PG8_LDB(B1, 1, 1); PG8_SCHED; PG8_LDA(At, 1, 0); PG8_STAGE(PG8_SA(0, 1), a2 + hstep, voffA);
            PG8_WAIT_V(8); PG8_WAIT_L(0); PG8_BAR; PG8_MMA(0, 0, At, B0); PG8_MMA(0, 1, At, B1); PG8_BAR; PG8_SCHED;
            PG8_LDA(At, 1, 1); PG8_STAGE(PG8_SB(1, 0), b3, voffB); PG8_STAGE(PG8_SB(1, 1), b3 + hstep, voffB); PG8_STAGE(PG8_SA(1, 0), a3, voffA);
            PG8_WAIT_V(8); PG8_WAIT_L(0); PG8_BAR; PG8_MMA(1, 0, At, B0); PG8_MMA(1, 1, At, B1); PG8_BAR; PG8_SCHED;
            } else {
            PG8_LDB(B0, 0, 0); PG8_SCHED; PG8_LDA(At, 0, 0); PG8_STAGE(PG8_SA(1, 1), a1 + hstep, voffA);
            PG8_WAIT_L(8); PG8_BAR; PG8_WAIT_L(0); PG8_MMA(0, 0, At, B0); PG8_BAR; PG8_SCHED;
            PG8_LDB(B1, 0, 1); PG8_STAGE(PG8_SB(0, 0), b2, voffB);
            PG8_BAR; PG8_WAIT_L(0); PG8_MMA(0, 1, At, B1); PG8_BAR;
            PG8_LDA(At, 0, 1); PG8_STAGE(PG8_SA(0, 0), a2, voffA);
            PG8_BAR; PG8_WAIT_L(0); PG8_MMA(1, 0, At, B0); PG8_BAR; PG8_SCHED;
            PG8_STAGE(PG8_SB(0, 1), b2 + hstep, voffB);
            PG8_WAIT_V(6); PG8_BAR; PG8_MMA(1, 1, At, B1); PG8_BAR;
            PG8_LDB(B0, 1, 0); PG8_SCHED; PG8_LDA(At, 1, 0); PG8_STAGE(PG8_SA(0, 1), a2 + hstep, voffA);
            PG8_WAIT_L(8); PG8_BAR; PG8_WAIT_L(0); PG8_MMA(0, 0, At, B0); PG8_BAR; PG8_SCHED;
            PG8_LDB(B1, 1, 1); PG8_STAGE(PG8_SB(1, 0), b3, voffB);
            PG8_BAR; PG8_WAIT_L(0); PG8_MMA(0, 1, At, B1); PG8_BAR;
            PG8_LDA(At, 1, 1); PG8_STAGE(PG8_SA(1, 0), a3, voffA);
            PG8_BAR; PG8_WAIT_L(0); PG8_MMA(1, 0, At, B0); PG8_BAR; PG8_SCHED;
            PG8_STAGE(PG8_SB(1, 1), b3 + hstep, voffB);
            PG8_WAIT_V(6); PG8_BAR; PG8_MMA(1, 1, At, B1); PG8_BAR;
            }
        }
        if constexpr (ALIGN_EPI) { if (wr == 0) PG8_BAR; }
        if constexpr (!Epi::AFTER_DRAIN) { E(acc, cur, wr, wc, fr, fq); S.done(cur); }
        if (!has_next) break;
#pragma unroll
        for (int a = 0; a < 2; ++a)
#pragma unroll
            for (int b = 0; b < 2; ++b)
#pragma unroll
                for (int m = 0; m < 4; ++m)
#pragma unroll
                    for (int n = 0; n < 2; ++n) acc[a][b][m][n] = (f32x4){0.f, 0.f, 0.f, 0.f};
        cur = nxt; cA = nA; cB = nB; ++ui;
        if constexpr (ALIGN_EPI) { if (wr == 1) PG8_BAR; }
    }
    PG8_WAIT_V(0);
    if constexpr (!ALIGN_EPI) { if (wr == 0) PG8_BAR; }
    PG8_BAR;
    if constexpr (Epi::AFTER_DRAIN) { E.fused(acc, cur, wr, wc, fr, fq, lds, wid, lane); S.done(cur); }
#undef PG8_SA
#undef PG8_SB
#undef PG8_STAGE
#undef PG8_LDA
#undef PG8_LDB
#undef PG8_MMA
#undef PG8_WAIT_V
#undef PG8_WAIT_L
#undef PG8_BAR
#undef PG8_SCHED
}
}

#ifndef PG8_SP2
#define PG8_SP2 true
#endif

#define LAS __attribute__((address_space(3)))
typedef unsigned short bf16;
typedef short bf16x8 __attribute__((ext_vector_type(8)));
typedef float f32x4 __attribute__((ext_vector_type(4)));
typedef float f32x16 __attribute__((ext_vector_type(16)));
typedef unsigned u32x4 __attribute__((ext_vector_type(4)));
typedef unsigned u32x2 __attribute__((ext_vector_type(2)));

constexpr int DM = 1024, NMAIN = 32768, ROWS = 33024, METAROW = 32768, DFF = 4096;
constexpr int NTHREADS = 512;
constexpr int LDS_BYTES = 147456;
constexpr int LDS_ITEM_OFF = LDS_BYTES - 16;
constexpr size_t MiB = 1u << 20;
constexpr size_t WS_CTL = 0, WS_WIN = 1 * MiB, WS_WUPA = 12 * MiB, WS_WUPB = 13 * MiB, WS_WOUT = 14 * MiB, WS_WFF1 = 16 * MiB, WS_WFF2 = 24 * MiB;
constexpr size_t WS_LORA = 32 * MiB, WS_XNMETA = 32 * MiB + 512 * 1024, WS_CB = 33 * MiB, WS_ACT = 36 * MiB;
constexpr size_t ACT_SZ = (size_t)ROWS * 512 * 2, L_SZ = (size_t)ROWS * 256 * 2;
constexpr size_t WS_R = WS_ACT, WS_KA = WS_R + ACT_SZ, WS_VA = WS_KA + ACT_SZ, WS_L = WS_VA + ACT_SZ, WS_Q = WS_L + L_SZ, WS_KB = WS_Q + ACT_SZ, WS_VT = WS_KB + ACT_SZ, WS_END = WS_VT + ACT_SZ;
constexpr size_t WS_GA = WS_KA, WS_GB = WS_KB, WS_MN = WS_ACT, WS_HID = WS_ACT + 64 * MiB;
static_assert(WS_END <= 256 * MiB && WS_HID + 128 * MiB <= 256 * MiB && WS_CB + (size_t)2 * ROWS * 8 * 4 <= WS_ACT, "ws map");
constexpr float LOG2E = 1.4426950408889634f;
constexpr float QSCALE = 0.125f * LOG2E;

struct Params { const float* in[29]; float* out; unsigned char* ws; };
typedef const __attribute__((address_space(4))) Params* KP;
enum { I_XP = 0, I_XS, I_META, I_GMIX, I_WIN, I_MUP, I_MUN, I_W0, I_WUP, I_A0, I_AUP, I_GUP, I_KK, I_KA, I_RK, I_LNW, I_LNB, I_LQ1, I_LK1, I_LQ2, I_LK2, I_SUBG, I_UPA, I_UPB, I_WOUT, I_GFFN, I_FF1, I_FF2, I_GFIN };

__device__ __forceinline__ unsigned cvtpk(float lo, float hi) { unsigned r; asm volatile("v_cvt_pk_bf16_f32 %0, %1, %2" : "=v"(r) : "v"(lo), "v"(hi)); return r; }
__device__ __forceinline__ float bf2f(unsigned short b) { return __uint_as_float(((unsigned)b) << 16); }
__device__ __forceinline__ float bflo(unsigned w) { return __uint_as_float(w << 16); }
__device__ __forceinline__ float bfhi(unsigned w) { return __uint_as_float(w & 0xffff0000u); }
__device__ __forceinline__ void unpack8(const u32x4 v, float* o) { o[0] = bflo(v.x); o[1] = bfhi(v.x); o[2] = bflo(v.y); o[3] = bfhi(v.y); o[4] = bflo(v.z); o[5] = bfhi(v.z); o[6] = bflo(v.w); o[7] = bfhi(v.w); }
__device__ __forceinline__ float wave_sum(float v) {
#pragma unroll
    for (int o = 1; o < 64; o <<= 1) v += __shfl_xor(v, o);
    return v;
}
__device__ __forceinline__ float sigmoidf_(float x) { return 1.0f / (1.0f + __expf(-x)); }
__device__ __forceinline__ int seq_base(int s) { return s == 0 ? 0 : 16384 + (s - 1) * 2048; }
__device__ __forceinline__ int seq_len(int s) { return s == 0 ? 16384 : 2048; }
__device__ __forceinline__ int pos_row(int base, int p) { return p < 16 ? METAROW + p : base + p - 16; }

template <class Op> struct Epi8 {
    static constexpr bool PERM = true, AFTER_DRAIN = false;
    Op op;
    __device__ __forceinline__ void operator()(const pg8::f32x4 (&acc)[2][2][4][2], const pg8::Unit& u, int wr, int wc, int fr, int fq) const {
        const int row0 = u.pm * 256 + wr * 64 + fr, col0 = u.pn * 256 + wc * 32 + 8 * fq;
#pragma unroll
        for (int ai = 0; ai < 2; ++ai)
#pragma unroll
            for (int m = 0; m < 4; ++m)
#pragma unroll
                for (int bj = 0; bj < 2; ++bj) { op.apply(row0 + ai * 128 + m * 16, col0 + bj * 128, u.pn, acc[ai][bj][m][0], acc[ai][bj][m][1]); asm volatile("" ::: "memory"); }
    }
};
__device__ __forceinline__ u32x4 pack8(const f32x4 a, const f32x4 b) { u32x4 w; w.x = cvtpk(a[0], a[1]); w.y = cvtpk(a[2], a[3]); w.z = cvtpk(b[0], b[1]); w.w = cvtpk(b[2], b[3]); return w; }

struct OpProj {
    unsigned char* ws;
    __device__ __forceinline__ void apply(int row, int col, int pn, f32x4 v0, f32x4 v1) const {
        if (pn >= 11) {
            bf16* VT = (bf16*)(ws + WS_VT); const int c = col - 11 * 256;
#pragma unroll
            for (int e = 0; e < 4; ++e) { VT[(size_t)(c + e) * ROWS + row] = (bf16)(cvtpk(v0[e], 0.f) & 0xffffu); VT[(size_t)(c + 4 + e) * ROWS + row] = (bf16)(cvtpk(v1[e], 0.f) & 0xffffu); }
            return;
        }
        bf16* O; int ldc = 512, c;
        if (pn < 2) { O = (bf16*)(ws + WS_R); c = col; }
        else if (pn < 4) { O = (bf16*)(ws + WS_KA); c = col - 512; }
        else if (pn < 6) { O = (bf16*)(ws + WS_VA); c = col - 1024; }
        else if (pn < 7) { O = (bf16*)(ws + WS_L); c = col - 1536; ldc = 256; }
        else if (pn < 9) { O = (bf16*)(ws + WS_Q); c = col - 1792; v0 = v0 * QSCALE; v1 = v1 * QSCALE; }
        else { O = (bf16*)(ws + WS_KB); c = col - 2304; }
        *(u32x4*)(O + (size_t)row * ldc + c) = pack8(v0, v1);
    }
};
struct OpGate {
    unsigned char* ws;
    __device__ __forceinline__ void apply(int row, int col, int pn, f32x4 v0, f32x4 v1) const {
        bf16* O = (bf16*)(ws + (pn < 4 ? WS_GA : WS_GB)); const int c = pn < 4 ? col : col - 1024;
#pragma unroll
        for (int e = 0; e < 4; ++e) { v0[e] = sigmoidf_(v0[e]); v1[e] = sigmoidf_(v1[e]); }
        *(u32x4*)(O + (size_t)row * 1024 + c) = pack8(v0, v1);
    }
};
struct OpUpA {
    unsigned char* ws;
    __device__ __forceinline__ void apply(int row, int col, int pn, f32x4 v0, f32x4 v1) const {
        u32x4* p = (u32x4*)((bf16*)(ws + WS_GA) + (size_t)row * 1024 + col); float g[8]; unpack8(*p, g);
#pragma unroll
        for (int e = 0; e < 4; ++e) { v0[e] *= g[e]; v1[e] *= g[4 + e]; }
        *p = pack8(v0, v1);
    }
};
struct OpUpB {
    unsigned char* ws;
    __device__ __forceinline__ void apply(int row, int col, int pn, f32x4 v0, f32x4 v1) const {
        u32x4* p = (u32x4*)((bf16*)(ws + WS_GB) + (size_t)row * 1024 + col); float g[8], a[8]; unpack8(*p, g);
        unpack8(*(const u32x4*)((const bf16*)(ws + WS_GA) + (size_t)row * 1024 + col), a);
#pragma unroll
        for (int e = 0; e < 4; ++e) { v0[e] = a[e] + v0[e] * g[e]; v1[e] = a[4 + e] + v1[e] * g[4 + e]; }
        *p = pack8(v0, v1);
    }
};
struct OpOut {
    const float* xp; const float* xs; float* out;
    __device__ __forceinline__ void apply(int row, int col, int pn, f32x4 v0, f32x4 v1) const {
        const float* x = (row < 16384 ? xp + (size_t)row * DM : xs + (size_t)(row - 16384) * DM) + col;
        float* o = out + (size_t)row * DM + col;
        *(f32x4*)o = *(const f32x4*)x + v0; *(f32x4*)(o + 4) = *(const f32x4*)(x + 4) + v1;
    }
};
struct OpFF1 {
    bf16* hid;
    __device__ __forceinline__ void apply(int row, int col, int pn, f32x4 v0, f32x4 v1) const {
#pragma unroll
        for (int e = 0; e < 4; ++e) { const float a = fmaxf(v0[e], 0.f), b = fmaxf(v1[e], 0.f); v0[e] = a * a; v1[e] = b * b; }
        *(u32x4*)(hid + (size_t)row * DFF + col) = pack8(v0, v1);
    }
};
struct OpFF2 {
    float* out;
    __device__ __forceinline__ void apply(int row, int col, int pn, f32x4 v0, f32x4 v1) const {
        float* o = out + (size_t)row * DM + col;
        *(f32x4*)o = *(const f32x4*)o + v0; *(f32x4*)(o + 4) = *(const f32x4*)(o + 4) + v1;
    }
};

__device__ __forceinline__ unsigned f2bf_rne(float f) { return cvtpk(f, 0.f) & 0xffffu; }
__device__ __forceinline__ void transpose_item(const float* W, int K, int N, bf16* WT, LAS float* scr, int item, int lane) {
    const int nblk = N / 32, kb = item / nblk, nb = item % nblk, k0 = 64 * kb, n0 = 32 * nb;
#pragma unroll 8
    for (int i = 0; i < 32; ++i) { const int kk = 2 * i + (lane >> 5); scr[kk * 33 + (lane & 31)] = W[(size_t)(k0 + kk) * N + n0 + (lane & 31)]; }
    asm volatile("s_waitcnt vmcnt(0) lgkmcnt(0)" ::: "memory");
    const int c = lane & 7;
#pragma unroll
    for (int j = 0; j < 4; ++j) { const int n = (lane >> 3) + 8 * j; const LAS float* s = scr + (8 * c) * 33 + n;
        u32x4 o; o.x = cvtpk(s[0 * 33], s[1 * 33]); o.y = cvtpk(s[2 * 33], s[3 * 33]); o.z = cvtpk(s[4 * 33], s[5 * 33]); o.w = cvtpk(s[6 * 33], s[7 * 33]);
        *(u32x4*)(WT + (size_t)(n0 + n) * K + k0 + 8 * c) = o; }
    asm volatile("s_waitcnt lgkmcnt(0)" ::: "memory");
}
__device__ __forceinline__ void rms_row_bf16(const float* src, const float* g, bf16* dst, int lane) {
    unsigned long long* o8 = (unsigned long long*)dst + lane;
    if (!src) {
#pragma unroll
        for (int j = 0; j < 4; ++j) o8[64 * j] = 0ull;
        return; }
    const f32x4* xr = (const f32x4*)src + lane; const f32x4* gr = (const f32x4*)g + lane;
    f32x4 v[4]; float s = 0.f;
#pragma unroll
    for (int j = 0; j < 4; ++j) { v[j] = xr[64 * j]; s += (v[j].x * v[j].x + v[j].y * v[j].y) + (v[j].z * v[j].z + v[j].w * v[j].w); }
    const float rstd = rsqrtf(wave_sum(s) * (1.f / DM) + 1e-6f);
#pragma unroll
    for (int j = 0; j < 4; ++j) { const f32x4 gg = gr[64 * j]; const f32x4 y = v[j] * rstd * gg;
        o8[64 * j] = (unsigned long long)cvtpk(y.x, y.y) | ((unsigned long long)cvtpk(y.z, y.w) << 32); }
}
__device__ __forceinline__ void phase_prologue(LAS unsigned char* lds, KP P) {
    const int tid = fresh_tid(), lane = tid & 63, wid = tid >> 6;
    LAS float* scr = (LAS float*)(lds + wid * 16384);
    const int gw = blockIdx.x * 8 + wid, NGW = gridDim.x * 8;
    unsigned char* ws = P->ws;
    constexpr int I_IN = (1024 / 64) * (5376 / 32), I_UP = (512 / 64) * (1024 / 32), I_O = (1024 / 64) * (1024 / 32), I_1 = (1024 / 64) * (4096 / 32), I_2 = (4096 / 64) * (1024 / 32);
    constexpr int I_LW = (64 / 64) * (512 / 32), I_G = (128 / 64) * (512 / 32);
    constexpr int NITEMS = I_IN + 2 * I_UP + I_O + I_1 + I_2 + 4 * I_LW + I_G;
    for (int it = gw; it < NITEMS; it += NGW) {
        int r = it;
        if (r < I_IN) { transpose_item(P->in[I_WIN], 1024, 5376, (bf16*)(ws + WS_WIN), scr, r, lane); continue; } r -= I_IN;
        if (r < I_UP) { transpose_item(P->in[I_UPA], 512, 1024, (bf16*)(ws + WS_WUPA), scr, r, lane); continue; } r -= I_UP;
        if (r < I_UP) { transpose_item(P->in[I_UPB], 512, 1024, (bf16*)(ws + WS_WUPB), scr, r, lane); continue; } r -= I_UP;
        if (r < I_O) { transpose_item(P->in[I_WOUT], 1024, 1024, (bf16*)(ws + WS_WOUT), scr, r, lane); continue; } r -= I_O;
        if (r < I_1) { transpose_item(P->in[I_FF1], 1024, 4096, (bf16*)(ws + WS_WFF1), scr, r, lane); continue; } r -= I_1;
        if (r < I_2) { transpose_item(P->in[I_FF2], 4096, 1024, (bf16*)(ws + WS_WFF2), scr, r, lane); continue; } r -= I_2;
        if (r < 2 * I_LW) { const int d = r / I_LW; transpose_item(P->in[I_WUP] + (size_t)d * 64 * 512, 64, 512, (bf16*)(ws + WS_LORA) + (size_t)d * 512 * 64, scr, r % I_LW, lane); continue; } r -= 2 * I_LW;
        if (r < 2 * I_LW) { const int d = r / I_LW; transpose_item(P->in[I_AUP] + (size_t)d * 64 * 512, 64, 512, (bf16*)(ws + WS_LORA + 131072) + (size_t)d * 512 * 64, scr, r % I_LW, lane); continue; } r -= 2 * I_LW;
        transpose_item(P->in[I_GUP], 128, 512, (bf16*)(ws + WS_LORA + 262144), scr, r, lane);
    }
    bf16* XN = (bf16*)P->out; bf16* XM = (bf16*)(ws + WS_XNMETA);
    for (int m = gw; m < ROWS; m += NGW) {
        const float* src = m < 16384 ? P->in[I_XP] + (size_t)m * DM : m < NMAIN ? P->in[I_XS] + (size_t)(m - 16384) * DM : (m - NMAIN < 16 ? P->in[I_META] + (size_t)(m - NMAIN) * DM : nullptr);
        bf16* dst = m < NMAIN ? XN + (size_t)m * DM : XM + (size_t)(m - NMAIN) * DM;
        rms_row_bf16(src, P->in[I_GMIX], dst, lane);
    }
}

constexpr int AT_KSTR = 272, AT_VSTR = 144, AT_KSZ = 64 * AT_KSTR, AT_BUF = AT_KSZ + 128 * AT_VSTR;
__device__ __forceinline__ f32x16 mfma32(bf16x8 a, bf16x8 b, f32x16 c) { return __builtin_amdgcn_mfma_f32_32x32x16_bf16(a, b, c, 0, 0, 0); }
__device__ __forceinline__ void attn_unit(LAS unsigned char* lds, KP P, int s, int h, int qb, float lam) {
    int tid_ = threadIdx.x; asm volatile("" : "+v"(tid_));
    const int tid = tid_, lane = tid & 63, r32 = lane & 31, hi = lane >> 5, wid = __builtin_amdgcn_readfirstlane(tid >> 6), rg = wid & 3, mp = wid >> 2;
    const int L = seq_len(s), base = seq_base(s), NT = 1 + L / 64;
    unsigned char* ws = P->ws;
    const bf16* KB = (const bf16*)(ws + WS_KB); const bf16* VT = (const bf16*)(ws + WS_VT); bf16* Q = (bf16*)(ws + WS_Q);
    const int qrow = base + qb * 128 + rg * 32 + r32;
    bf16x8 q[4];
#pragma unroll
    for (int d0 = 0; d0 < 4; ++d0) q[d0] = *(const bf16x8*)(Q + (size_t)qrow * 512 + h * 128 + mp * 64 + d0 * 16 + hi * 8);
    f32x16 O[4];
#pragma unroll
    for (int b = 0; b < 4; ++b)
#pragma unroll
        for (int r = 0; r < 16; ++r) O[b][r] = 0.f;
    float mx = -INFINITY, ls = 0.f;
    const float qh = (float)(16 + qb * 128 + rg * 32 + r32 - 4 * hi);
    const float nslope = -exp2f(-2.0f * (float)(h + 1)) * LOG2E;
    const int kr0 = tid >> 4, kc = tid & 15, vn0 = tid >> 3, vc = tid & 7;
    u32x4 kreg[2], vreg[2];
    const unsigned kgo = (unsigned)((kr0 * 512 + h * 128 + kc * 8) * 2), vgo = (unsigned)(((h * 128 + vn0) * ROWS + vc * 8) * 2);
    const unsigned klo = (unsigned)(kr0 * AT_KSTR + kc * 16), vlo = (unsigned)(AT_KSZ + vn0 * AT_VSTR + vc * 16);
#define AT_GLOAD(j) do { const int m0_ = (j) == 0 ? METAROW : base + 64 * ((j) - 1); \
        const unsigned char* kt_ = (const unsigned char*)KB + (size_t)m0_ * 1024; const unsigned char* vt_ = (const unsigned char*)VT + (size_t)m0_ * 2; \
        kreg[0] = *(const u32x4*)(kt_ + kgo); kreg[1] = *(const u32x4*)(kt_ + 32 * 1024 + kgo); \
        vreg[0] = *(const u32x4*)(vt_ + vgo); vreg[1] = *(const u32x4*)(vt_ + (size_t)64 * ROWS * 2 + vgo); } while (0)
#define AT_LSTORE(buf) do { LAS unsigned char* kb_ = lds + (buf) * AT_BUF; \
        *(LAS u32x4*)(kb_ + klo) = kreg[0]; *(LAS u32x4*)(kb_ + klo + 32 * AT_KSTR) = kreg[1]; \
        *(LAS u32x4*)(kb_ + vlo) = vreg[0]; *(LAS u32x4*)(kb_ + vlo + 64 * AT_VSTR) = vreg[1]; } while (0)
    AT_GLOAD(0); AT_LSTORE(0); __syncthreads();
#pragma unroll 1
    for (int j = 0; j < NT; ++j) {
        if (j + 1 < NT) AT_GLOAD(j + 1);
        const LAS unsigned char* Kb = lds + (j & 1) * AT_BUF + mp * 128; const LAS unsigned char* Vb = lds + (j & 1) * AT_BUF + AT_KSZ;
        const float dq = qh - (float)(j == 0 ? 0 : 64 * j - 48);
        f32x16 p0, p1;
#pragma unroll
        for (int r = 0; r < 16; ++r) { p0[r] = 0.f; p1[r] = 0.f; }
#pragma unroll
        for (int d0 = 0; d0 < 4; ++d0) {
            const bf16x8 a0 = *(const LAS bf16x8*)(Kb + r32 * AT_KSTR + d0 * 32 + hi * 16);
            const bf16x8 a1 = *(const LAS bf16x8*)(Kb + (32 + r32) * AT_KSTR + d0 * 32 + hi * 16);
            p0 = mfma32(a0, q[d0], p0); p1 = mfma32(a1, q[d0], p1);
        }
        __builtin_amdgcn_sched_barrier(0);
#pragma unroll
        for (int r = 0; r < 16; ++r) { const float dd = dq - (float)((r & 3) + 8 * (r >> 2)); p0[r] = fmaf(fabsf(dd), nslope, p0[r]); p1[r] = fmaf(fabsf(dd - 32.f), nslope, p1[r]); }
        if (j == 0) {
#pragma unroll
            for (int r = 0; r < 16; ++r) { if ((r & 3) + 8 * (r >> 2) + 4 * hi >= 16) p0[r] = -INFINITY; p1[r] = -INFINITY; }
        }
        float rm = fmaxf(p0[0], p1[0]);
#pragma unroll
        for (int r = 1; r < 16; ++r) rm = fmaxf(rm, fmaxf(p0[r], p1[r]));
        rm = fmaxf(rm, __shfl_xor(rm, 32));
        const float mn = fmaxf(mx, rm);
        if (__any(mn > mx)) {
            const float f = __builtin_amdgcn_exp2f(mx - mn); ls *= f; mx = mn;
#pragma unroll
            for (int b = 0; b < 4; ++b)
#pragma unroll
                for (int r = 0; r < 16; ++r) O[b][r] *= f;
        }
        float sum = 0.f;
#pragma unroll
        for (int r = 0; r < 16; ++r) { p0[r] = __builtin_amdgcn_exp2f(p0[r] - mx); p1[r] = __builtin_amdgcn_exp2f(p1[r] - mx); sum += p0[r] + p1[r]; }
        ls += sum;
        __builtin_amdgcn_sched_barrier(0);
        bf16x8 pf[4];
#pragma unroll
        for (int k2 = 0; k2 < 2; ++k2) {
            u32x4 w0, w1;
            w0.x = cvtpk(p0[8 * k2 + 0], p0[8 * k2 + 1]); w0.y = cvtpk(p0[8 * k2 + 2], p0[8 * k2 + 3]); w0.z = cvtpk(p0[8 * k2 + 4], p0[8 * k2 + 5]); w0.w = cvtpk(p0[8 * k2 + 6], p0[8 * k2 + 7]);
            w1.x = cvtpk(p1[8 * k2 + 0], p1[8 * k2 + 1]); w1.y = cvtpk(p1[8 * k2 + 2], p1[8 * k2 + 3]); w1.z = cvtpk(p1[8 * k2 + 4], p1[8 * k2 + 5]); w1.w = cvtpk(p1[8 * k2 + 6], p1[8 * k2 + 7]);
            pf[k2] = __builtin_bit_cast(bf16x8, w0); pf[2 + k2] = __builtin_bit_cast(bf16x8, w1);
        }
#pragma unroll
        for (int b = 0; b < 4; ++b)
#pragma unroll
            for (int ks = 0; ks < 4; ++ks) {
                const LAS unsigned char* vp = Vb + (b * 32 + r32) * AT_VSTR + ks * 32 + hi * 8;
                const u32x2 lo = *(const LAS u32x2*)vp, hh = *(const LAS u32x2*)(vp + 16);
                u32x4 vv; vv.x = lo.x; vv.y = lo.y; vv.z = hh.x; vv.w = hh.y;
                O[b] = mfma32(__builtin_bit_cast(bf16x8, vv), pf[ks], O[b]);
                if (ks == 3) __builtin_amdgcn_sched_barrier(0);
            }
        if (j + 1 < NT) AT_LSTORE((j + 1) & 1);
        __syncthreads();
    }
#undef AT_GLOAD
#undef AT_LSTORE
    const float lt = ls + __shfl_xor(ls, 32);
    const float inv = (mp ? lam : 1.0f) / lt;
    int lane2 = lane; asm volatile("" : "+v"(lane2));
    const int r32e = lane2 & 31, hie = lane2 >> 5;
    LAS float* ex = (LAS float*)lds + rg * (128 * 32) + hie * 128 + r32e;
    if (mp == 1) {
#pragma unroll
        for (int b = 0; b < 4; ++b)
#pragma unroll
            for (int r = 0; r < 16; ++r) ex[(32 * b + (r & 3) + 8 * (r >> 2)) * 32] = O[b][r] * inv;
    }
    __syncthreads();
    if (mp == 0) {
        float ss = 0.f;
#pragma unroll
        for (int b = 0; b < 4; ++b)
#pragma unroll
            for (int r = 0; r < 16; ++r) { const float o = O[b][r] * inv - ex[(32 * b + (r & 3) + 8 * (r >> 2)) * 32]; O[b][r] = o; ss += o * o; }
        ss += __shfl_xor(ss, 32);
        const float rstd = rsqrtf(ss * (1.0f / 128.0f) + 1e-5f) * 0.8f;
        const float* sg = P->in[I_SUBG] + 4 * hie; bf16* Qo = Q + (size_t)(base + qb * 128 + rg * 32 + r32e) * 512 + h * 128 + 4 * hie;
#pragma unroll
        for (int b = 0; b < 4; ++b)
#pragma unroll
            for (int r4 = 0; r4 < 4; ++r4) {
                const int n = 32 * b + 8 * r4; const f32x4 g = *(const f32x4*)(sg + n);
                u32x2 w; w.x = cvtpk(O[b][4 * r4 + 0] * rstd * g.x, O[b][4 * r4 + 1] * rstd * g.y); w.y = cvtpk(O[b][4 * r4 + 2] * rstd * g.z, O[b][4 * r4 + 3] * rstd * g.w);
                *(u32x2*)(Qo + n) = w;
            }
    }
    __syncthreads();
}

constexpr int SC_R = 0, SC_K = 16384, SC_V = 32768, SC_W = 49152, SC_B = 65536, SC_KK = 81920, SC_Y = 98304, SC_TW = 114688, SC_AD = 123904, SC_MU = 133120;
__device__ __forceinline__ float dpp_add(float v, int ctrl_id) {
    const int x = __float_as_int(v); int y;
    if (ctrl_id == 0) y = __builtin_amdgcn_update_dpp(0, x, 0xB1, 0xf, 0xf, true);
    else if (ctrl_id == 1) y = __builtin_amdgcn_update_dpp(0, x, 0x4E, 0xf, 0xf, true);
    else if (ctrl_id == 2) y = __builtin_amdgcn_update_dpp(0, x, 0x141, 0xf, 0xf, true);
    else y = __builtin_amdgcn_update_dpp(0, x, 0x140, 0xf, 0xf, true);
    return v + __int_as_float(y);
}
template <int LPR> __device__ __forceinline__ float grp_sum(float v) {
    v = dpp_add(v, 0); v = dpp_add(v, 1); v = dpp_add(v, 2);
    if (LPR == 16) v = dpp_add(v, 3);
    return v;
}
#define BAR_LDS() asm volatile("s_waitcnt lgkmcnt(0)\n\ts_barrier" ::: "memory")
__device__ __forceinline__ float fast_sigmoid(float x) { return __builtin_amdgcn_rcpf(1.0f + __builtin_amdgcn_exp2f(-LOG2E * x)); }
__device__ __forceinline__ float fast_tanh(float x) { return 1.0f - 2.0f * __builtin_amdgcn_rcpf(1.0f + __builtin_amdgcn_exp2f(2.0f * LOG2E * x)); }
template <int NRP, int NSW>
__device__ __forceinline__ void scan_unit(LAS unsigned char* lds, KP P, int s, int d, int h, int rp) {
    constexpr int RPB = 64 / NRP, RPW = RPB / NSW, LPR = 64 / RPW, CPL = 64 / LPR;
    static_assert(LPR == 8 || LPR == 16, "scan geometry");
    int tid_ = threadIdx.x; asm volatile("" : "+v"(tid_));
    const int tid = tid_, lane = tid & 63, wid = __builtin_amdgcn_readfirstlane(tid >> 6);
    const int L = seq_len(s), base = seq_base(s), Ltot = L + 16, nchunk = (Ltot + 63) / 64;
    unsigned char* ws = P->ws;
    const bf16* Rb = (const bf16*)(ws + WS_R); const bf16* KAb = (const bf16*)(ws + WS_KA); const bf16* VAb = (const bf16*)(ws + WS_VA); const bf16* Lb = (const bf16*)(ws + WS_L);
    float* CB = (float*)(ws + WS_CB); bf16* YD = (bf16*)((unsigned char*)P->out + 64 * MiB) + (size_t)d * NMAIN * 512;
    LAS float* fR = (LAS float*)(lds + SC_R); LAS float* fK = (LAS float*)(lds + SC_K); LAS float* fV = (LAS float*)(lds + SC_V); LAS float* fW = (LAS float*)(lds + SC_W);
    LAS float* fB = (LAS float*)(lds + SC_B); LAS float* fKK = (LAS float*)(lds + SC_KK); LAS float* fY = (LAS float*)(lds + SC_Y); LAS float* fMU = (LAS float*)(lds + SC_MU);
    for (int i = tid; i < 832; i += NTHREADS) {
        float v;
        if (i < 640) { const int which = i / 320, jj = i % 320, a = jj >> 6, c = jj & 63; const int gi = a < 3 ? a * 512 + h * 64 + c : 1536 + (a - 3) * 64 + c; v = P->in[which ? I_MUN : I_MUP][gi]; }
        else { const int a = (i - 640) >> 6, c = (i - 640) & 63; v = P->in[a == 0 ? I_KK : a == 1 ? I_KA : I_RK][h * 64 + c]; }
        fMU[i] = v;
    }
    const int mat = wid >> 2, ntile = wid & 3;
    const bf16* Wt = (const bf16*)(ws + WS_LORA + (mat ? 131072 : 0)) + ((size_t)d * 512 + h * 64 + ntile * 16 + (lane & 15)) * 64 + (lane >> 4) * 8;
    const bf16x8 bfr0 = *(const bf16x8*)Wt, bfr1 = *(const bf16x8*)(Wt + 32);
    const float bias = P->in[mat ? I_A0 : I_W0][d * 512 + h * 64 + ntile * 16 + (lane & 15)];
    float S[CPL];
#pragma unroll
    for (int j = 0; j < CPL; ++j) S[j] = 0.f;
    const int rowl = lane / LPR, kg = lane % LPR, srow = rp * RPB + wid * RPW + rowl;
    const int slot = tid >> 3, cg8 = (tid & 7) * 8;
    u32x4 raw[5][3];
#define SC_LOAD(c) do { const int i_ = 64 * (c) + slot; const int p_ = d ? Ltot - 1 - i_ : i_; const bool ok_ = i_ < Ltot; \
        const bool okp_ = ok_ && p_ > 0, okn_ = ok_ && p_ + 1 < Ltot; \
        const size_t rc_ = ok_ ? (size_t)pos_row(base, p_) : 0, rp_ = okp_ ? (size_t)pos_row(base, p_ - 1) : 0, rn_ = okn_ ? (size_t)pos_row(base, p_ + 1) : 0; \
        const u32x4 z_ = {0u, 0u, 0u, 0u}; \
        _Pragma("unroll") for (int a_ = 0; a_ < 5; ++a_) { const bf16* B_ = a_ == 0 ? Rb : a_ == 1 ? KAb : a_ == 2 ? VAb : Lb; const int ld_ = a_ < 3 ? 512 : 256; \
            const int co_ = (a_ < 3 ? h * 64 : (a_ - 3) * 64) + cg8; \
            raw[a_][0] = okp_ ? *(const u32x4*)(B_ + rp_ * ld_ + co_) : z_; raw[a_][1] = ok_ ? *(const u32x4*)(B_ + rc_ * ld_ + co_) : z_; raw[a_][2] = okn_ ? *(const u32x4*)(B_ + rn_ * ld_ + co_) : z_; } } while (0)
    SC_LOAD(0);
    BAR_LDS();
    for (int c = 0; c < nchunk; ++c) {
        const int nvalid = (Ltot - 64 * c) < 64 ? (Ltot - 64 * c) : 64;
        float rv[8], kv[8];
#pragma unroll
        for (int a = 0; a < 5; ++a) {
            float pv[8], cv[8], nv[8], o[8]; unpack8(raw[a][0], pv); unpack8(raw[a][1], cv); unpack8(raw[a][2], nv);
            const f32x4 mp0 = *(const LAS f32x4*)(fMU + a * 64 + cg8), mp1 = *(const LAS f32x4*)(fMU + a * 64 + cg8 + 4), mn0 = *(const LAS f32x4*)(fMU + 320 + a * 64 + cg8), mn1 = *(const LAS f32x4*)(fMU + 320 + a * 64 + cg8 + 4);
#pragma unroll
            for (int e = 0; e < 8; ++e) { const float mp = e < 4 ? mp0[e & 3] : mp1[e & 3], mn = e < 4 ? mn0[e & 3] : mn1[e & 3]; o[e] = cv[e] + mp * (pv[e] - cv[e]) + mn * (nv[e] - cv[e]); }
            if (a == 0) {
#pragma unroll
                for (int e = 0; e < 8; ++e) rv[e] = o[e];
                LAS float* dst = fR + slot * 64 + cg8; *(LAS f32x4*)dst = (f32x4){o[0], o[1], o[2], o[3]}; *(LAS f32x4*)(dst + 4) = (f32x4){o[4], o[5], o[6], o[7]};
            } else if (a == 1) {
#pragma unroll
                for (int e = 0; e < 8; ++e) kv[e] = o[e];
            } else if (a == 2) {
                LAS float* dst = fV + slot * 64 + cg8; *(LAS f32x4*)dst = (f32x4){o[0], o[1], o[2], o[3]}; *(LAS f32x4*)(dst + 4) = (f32x4){o[4], o[5], o[6], o[7]};
            } else {
                if (a == 3) {
#pragma unroll
                    for (int e = 0; e < 8; ++e) o[e] = fast_tanh(o[e]);
                }
                u32x4 w; w.x = cvtpk(o[0], o[1]); w.y = cvtpk(o[2], o[3]); w.z = cvtpk(o[4], o[5]); w.w = cvtpk(o[6], o[7]);
                *(LAS u32x4*)(lds + (a == 3 ? SC_TW : SC_AD) + slot * 144 + cg8 * 2) = w;
            }
        }
        BAR_LDS();
        if (c + 1 < nchunk) SC_LOAD(c + 1);
        {
            const LAS unsigned char* Ab = lds + (mat ? SC_AD : SC_TW);
#pragma unroll
            for (int mt = 0; mt < 4; ++mt) {
                const bf16x8 a0 = *(const LAS bf16x8*)(Ab + (mt * 16 + (lane & 15)) * 144 + (lane >> 4) * 16);
                const bf16x8 a1 = *(const LAS bf16x8*)(Ab + (mt * 16 + (lane & 15)) * 144 + 64 + (lane >> 4) * 16);
                f32x4 acc = {0.f, 0.f, 0.f, 0.f};
                acc = __builtin_amdgcn_mfma_f32_16x16x32_bf16(a0, bfr0, acc, 0, 0, 0);
                acc = __builtin_amdgcn_mfma_f32_16x16x32_bf16(a1, bfr1, acc, 0, 0, 0);
#pragma unroll
                for (int rg = 0; rg < 4; ++rg) {
                    const int sl = mt * 16 + (lane >> 4) * 4 + rg, col = ntile * 16 + (lane & 15);
                    const float sg = fast_sigmoid(acc[rg] + bias);
                    if (mat == 0) fW[sl * 64 + col] = __builtin_amdgcn_exp2f(-0.6065306597126334f * LOG2E * sg); else fB[sl * 64 + col] = sg;
                }
            }
        }
        BAR_LDS();
        {
            const f32x4 a0 = *(const LAS f32x4*)(fB + slot * 64 + cg8), a1 = *(const LAS f32x4*)(fB + slot * 64 + cg8 + 4);
            const f32x4 kk0 = *(const LAS f32x4*)(fMU + 640 + cg8), kk1 = *(const LAS f32x4*)(fMU + 640 + cg8 + 4), ka0 = *(const LAS f32x4*)(fMU + 704 + cg8), ka1 = *(const LAS f32x4*)(fMU + 704 + cg8 + 4);
            const f32x4 rk0 = *(const LAS f32x4*)(fMU + 768 + cg8), rk1 = *(const LAS f32x4*)(fMU + 768 + cg8 + 4);
            float kkv[8], kd[8], av[8]; float ssq = 0.f, cs = 0.f;
#pragma unroll
            for (int e = 0; e < 8; ++e) {
                av[e] = e < 4 ? a0[e & 3] : a1[e & 3];
                kkv[e] = kv[e] * (e < 4 ? kk0[e & 3] : kk1[e & 3]); ssq = fmaf(kkv[e], kkv[e], ssq);
                kd[e] = kv[e] * (1.0f + (av[e] - 1.0f) * (e < 4 ? ka0[e & 3] : ka1[e & 3])); cs = fmaf(rv[e] * kd[e], e < 4 ? rk0[e & 3] : rk1[e & 3], cs);
            }
            ssq = grp_sum<8>(ssq); cs = grp_sum<8>(cs);
            const float rs = rsqrtf(fmaxf(ssq, 1e-24f));
#pragma unroll
            for (int e = 0; e < 8; ++e) { kkv[e] *= rs; av[e] *= kkv[e]; }
            LAS float* o1 = fKK + slot * 64 + cg8; *(LAS f32x4*)o1 = (f32x4){kkv[0], kkv[1], kkv[2], kkv[3]}; *(LAS f32x4*)(o1 + 4) = (f32x4){kkv[4], kkv[5], kkv[6], kkv[7]};
            LAS float* o2 = fB + slot * 64 + cg8; *(LAS f32x4*)o2 = (f32x4){av[0], av[1], av[2], av[3]}; *(LAS f32x4*)(o2 + 4) = (f32x4){av[4], av[5], av[6], av[7]};
            LAS float* o3 = fK + slot * 64 + cg8; *(LAS f32x4*)o3 = (f32x4){kd[0], kd[1], kd[2], kd[3]}; *(LAS f32x4*)(o3 + 4) = (f32x4){kd[4], kd[5], kd[6], kd[7]};
            if (cg8 == 0 && rp == 0 && slot < nvalid) { const int i2 = 64 * c + slot; const int p2 = d ? Ltot - 1 - i2 : i2; CB[((size_t)d * ROWS + pos_row(base, p2)) * 8 + h] = cs; }
        }
        BAR_LDS();
        if (wid < NSW) {
            const LAS float* pk = fKK + kg * CPL; const LAS float* pw = fW + kg * CPL; const LAS float* pb = fB + kg * CPL; const LAS float* pd = fK + kg * CPL; const LAS float* pr = fR + kg * CPL;
            const LAS float* pv = fV + srow; LAS float* py = fY + srow;
            f32x4 nk[CPL / 4], nw[CPL / 4], nb[CPL / 4], nd[CPL / 4], nr[CPL / 4]; float nv;
#define SC_FETCH(sl_) do { _Pragma("unroll") for (int j_ = 0; j_ < CPL / 4; ++j_) { nk[j_] = *(const LAS f32x4*)(pk + (sl_) * 64 + 4 * j_); nw[j_] = *(const LAS f32x4*)(pw + (sl_) * 64 + 4 * j_); \
                nb[j_] = *(const LAS f32x4*)(pb + (sl_) * 64 + 4 * j_); nd[j_] = *(const LAS f32x4*)(pd + (sl_) * 64 + 4 * j_); nr[j_] = *(const LAS f32x4*)(pr + (sl_) * 64 + 4 * j_); } nv = pv[(sl_) * 64]; } while (0)
            SC_FETCH(0);
#pragma unroll 2
            for (int sl = 0; sl < nvalid; ++sl) {
                f32x4 ck[CPL / 4], cw[CPL / 4], cb[CPL / 4], cd[CPL / 4], cr[CPL / 4];
#pragma unroll
                for (int j = 0; j < CPL / 4; ++j) { ck[j] = nk[j]; cw[j] = nw[j]; cb[j] = nb[j]; cd[j] = nd[j]; cr[j] = nr[j]; }
                const float vv = nv;
                SC_FETCH(sl + 1 < 64 ? sl + 1 : 63);
                float pp0 = 0.f, pp1 = 0.f;
#pragma unroll
                for (int j = 0; j < CPL / 4; ++j) { pp0 = fmaf(S[4 * j], ck[j][0], pp0); pp1 = fmaf(S[4 * j + 1], ck[j][1], pp1); pp0 = fmaf(S[4 * j + 2], ck[j][2], pp0); pp1 = fmaf(S[4 * j + 3], ck[j][3], pp1); }
                const float pp = grp_sum<LPR>(pp0 + pp1);
                float y0 = 0.f, y1 = 0.f;
#pragma unroll
                for (int j = 0; j < CPL / 4; ++j)
#pragma unroll
                    for (int e = 0; e < 4; ++e) { const float t = fmaf(-pp, cb[j][e], vv * cd[j][e]); S[4 * j + e] = fmaf(S[4 * j + e], cw[j][e], t); if (e & 1) y1 = fmaf(S[4 * j + e], cr[j][e], y1); else y0 = fmaf(S[4 * j + e], cr[j][e], y0); }
                const float yy = grp_sum<LPR>(y0 + y1);
                if (kg == 0) py[sl * 64] = yy;
            }
#undef SC_FETCH
        }
        BAR_LDS();
        {
            const int i2 = 64 * c + slot; const int p2 = d ? Ltot - 1 - i2 : i2;
            if (slot < nvalid && p2 >= 16 && (cg8 / RPB) == rp) {
                const LAS float* yp = fY + slot * 64 + cg8; const f32x4 y0 = *(const LAS f32x4*)yp, y1 = *(const LAS f32x4*)(yp + 4);
                *(u32x4*)(YD + (size_t)(base + p2 - 16) * 512 + h * 64 + cg8) = pack8(y0, y1);
            }
        }
    }
#undef SC_LOAD
}

__device__ __forceinline__ void phase_post(LAS unsigned char* lds, KP P) {
    const int tid = fresh_tid(), lane = tid & 63, wid = tid >> 6;
    unsigned char* ws = P->ws;
    const bf16* VAb = (const bf16*)(ws + WS_VA); const bf16* Lb = (const bf16*)(ws + WS_L); bf16* Rb = (bf16*)(ws + WS_R);
    const float* CB = (const float*)(ws + WS_CB); const bf16* YD0 = (const bf16*)((const unsigned char*)P->out + 64 * MiB); const bf16* YD1 = YD0 + (size_t)NMAIN * 512;
    const bf16* GT = (const bf16*)(ws + WS_LORA + 262144);
    LAS float* st = (LAS float*)(lds + 17408);
    const float* mup = P->in[I_MUP]; const float* mun = P->in[I_MUN];
    for (int tile = blockIdx.x; tile < NMAIN / 64; tile += gridDim.x) {
        {
            const int row = tid >> 3, hh = tid & 7, m = tile * 64 + row;
            const int t = m < 16384 ? m : (m - 16384) & 2047, Ls = m < 16384 ? 16384 : 2048;
            float sum = 0.f, sq = 0.f;
#pragma unroll
            for (int i = 0; i < 8; ++i) { float a[8], b[8]; unpack8(*(const u32x4*)(YD0 + (size_t)m * 512 + hh * 64 + i * 8), a); unpack8(*(const u32x4*)(YD1 + (size_t)m * 512 + hh * 64 + i * 8), b);
#pragma unroll
                for (int e = 0; e < 8; ++e) { const float y = a[e] + b[e]; sum += y; sq += y * y; } }
            const float mu = sum * (1.0f / 64.0f); const float var = fmaxf(sq * (1.0f / 64.0f) - mu * mu, 0.f);
            st[(row * 8 + hh) * 2] = mu; st[(row * 8 + hh) * 2 + 1] = rsqrtf(var + 64e-5f);
            const size_t rp_ = t == 0 ? (size_t)(METAROW + 15) : (size_t)(m - 1); const bool okn = t + 1 < Ls;
#pragma unroll
            for (int i = 0; i < 2; ++i) {
                const int c0 = 128 + hh * 16 + i * 8; float pv[8], cv[8], nv[8], o[8];
                unpack8(*(const u32x4*)(Lb + rp_ * 256 + c0), pv); unpack8(*(const u32x4*)(Lb + (size_t)m * 256 + c0), cv);
                if (okn) unpack8(*(const u32x4*)(Lb + (size_t)(m + 1) * 256 + c0), nv); else {
#pragma unroll
                    for (int e = 0; e < 8; ++e) nv[e] = 0.f; }
#pragma unroll
                for (int e = 0; e < 8; ++e) { const float mp = mup[1536 + c0 + e], mn = mun[1536 + c0 + e]; o[e] = sigmoidf_(cv[e] + mp * (pv[e] - cv[e]) + mn * (nv[e] - cv[e])); }
                u32x4 w; w.x = cvtpk(o[0], o[1]); w.y = cvtpk(o[2], o[3]); w.z = cvtpk(o[4], o[5]); w.w = cvtpk(o[6], o[7]);
                *(LAS u32x4*)(lds + row * 272 + (hh * 16 + i * 8) * 2) = w;
            }
        }
        __syncthreads();
#pragma unroll 1
        for (int nt = 0; nt < 4; ++nt) {
            const int col = wid * 64 + nt * 16 + (lane & 15);
            bf16x8 bfr[4];
#pragma unroll
            for (int ks = 0; ks < 4; ++ks) bfr[ks] = *(const bf16x8*)(GT + (size_t)col * 128 + ks * 32 + (lane >> 4) * 8);
            const float lw = P->in[I_LNW][col], lb = P->in[I_LNB][col];
            const float mpv = mup[1024 + col], mnv = mun[1024 + col];
#pragma unroll 1
            for (int mt = 0; mt < 4; ++mt) {
                f32x4 acc = {0.f, 0.f, 0.f, 0.f};
#pragma unroll
                for (int ks = 0; ks < 4; ++ks) { const bf16x8 a = *(const LAS bf16x8*)(lds + (mt * 16 + (lane & 15)) * 272 + ks * 64 + (lane >> 4) * 16); acc = __builtin_amdgcn_mfma_f32_16x16x32_bf16(a, bfr[ks], acc, 0, 0, 0); }
#pragma unroll
                for (int rg = 0; rg < 4; ++rg) {
                    const int row = mt * 16 + (lane >> 4) * 4 + rg, m = tile * 64 + row;
                    const int t = m < 16384 ? m : (m - 16384) & 2047, Ls = m < 16384 ? 16384 : 2048;
                    const float y = bf2f(YD0[(size_t)m * 512 + col]) + bf2f(YD1[(size_t)m * 512 + col]);
                    const float yn = (y - st[(row * 8 + wid) * 2]) * st[(row * 8 + wid) * 2 + 1] * lw + lb;
                    const float vc = bf2f(VAb[(size_t)m * 512 + col]);
                    const float vp = bf2f(VAb[(t == 0 ? (size_t)(METAROW + 15) : (size_t)(m - 1)) * 512 + col]);
                    const float vn = t + 1 < Ls ? bf2f(VAb[(size_t)(m + 1) * 512 + col]) : 0.f;
                    const float vs = vc + mpv * (vp - vc) + mnv * (vn - vc);
                    const float cb = CB[(size_t)m * 8 + wid] + CB[((size_t)ROWS + m) * 8 + wid];
                    Rb[(size_t)m * 512 + col] = (bf16)f2bf_rne((yn + cb * vs) * acc[rg]);
                }
            }
        }
        __syncthreads();
    }
}

__device__ __forceinline__ void phase_rms_bf16(KP P) {
    const int tid = fresh_tid(), lane = tid & 63, wid = tid >> 6; const int gw = blockIdx.x * 8 + wid, NGW = gridDim.x * 8;
    bf16* MN = (bf16*)(P->ws + WS_MN);
    for (int m = gw; m < NMAIN; m += NGW) rms_row_bf16(P->out + (size_t)m * DM, P->in[I_GFFN], MN + (size_t)m * DM, lane);
}
__device__ __forceinline__ void phase_final(KP P) {
    const int tid = fresh_tid(), lane = tid & 63, wid = tid >> 6; const int gw = blockIdx.x * 8 + wid, NGW = gridDim.x * 8;
    const f32x4* gr = (const f32x4*)P->in[I_GFIN] + lane;
    for (int m = gw; m < NMAIN; m += NGW) {
        f32x4* xr = (f32x4*)(P->out + (size_t)m * DM) + lane; f32x4 v[4]; float s = 0.f;
#pragma unroll
        for (int j = 0; j < 4; ++j) { v[j] = xr[64 * j]; s += (v[j].x * v[j].x + v[j].y * v[j].y) + (v[j].z * v[j].z + v[j].w * v[j].w); }
        const float rstd = rsqrtf(wave_sum(s) * (1.f / DM) + 1e-6f);
#pragma unroll
        for (int j = 0; j < 4; ++j) xr[64 * j] = v[j] * rstd * gr[64 * j];
    }
}

constexpr int NRP_LONG = 4;
constexpr int N_LONG = 16 * NRP_LONG, N_ATT_P = 512, N_ATT_S = 512, N_SHORT = 128, N_ITEMS = N_LONG + N_ATT_P + N_ATT_S + N_SHORT;

template <class Op> __device__ __forceinline__ void run_gemm(LAS unsigned char* lds, const bf16* A, const bf16* Bt, int M, int N, int K, const Op& op, const bf16* A2 = nullptr, int pm2 = 1 << 30) {
    pg8::Gemm g{A, Bt, M, N, K, A2, pm2}; pg8::StaticOrder S; S.init(M, N, (int)gridDim.x, (int)blockIdx.x);
    Epi8<Op> E{op};
    pg8::gemm_phase<Epi8<Op>, pg8::StaticOrder, true, true>(lds, g, S, E);
}

#ifndef PROBE_MASK
#define PROBE_MASK 0
#endif
#ifndef PROBE_MUL
#define PROBE_MUL 1
#endif
#define PH_BEGIN(k) unsigned long long t0_##k = 0; if (PROBE_MASK & (1 << (k))) t0_##k = __builtin_amdgcn_s_memrealtime();
#define PH_END(k) if (PROBE_MASK & (1 << (k))) { const unsigned long long t1_ = __builtin_amdgcn_s_memrealtime(); const unsigned long long dt_ = (t1_ - t0_##k) * PROBE_MUL; while (__builtin_amdgcn_s_memrealtime() - t1_ < dt_) __builtin_amdgcn_s_sleep(8); grid.sync(); }
__global__ void __launch_bounds__(NTHREADS) fwd_megakernel(Params Pin) {
    extern __shared__ __attribute__((aligned(16))) unsigned char lds_raw[];
    LAS unsigned char* lds = (LAS unsigned char*)lds_raw;
    cg::grid_group grid = cg::this_grid();
    KP P0 = (KP)__builtin_amdgcn_kernarg_segment_ptr();
#define NEWPHASE KP P = P0; asm volatile("" : "+s"(P)); unsigned char* ws = P->ws; (void)ws;

    PH_BEGIN(0)
    { NEWPHASE phase_prologue(lds, P); }
    grid.sync();
    PH_END(0)
    PH_BEGIN(1)
    { NEWPHASE run_gemm(lds, (const bf16*)P->out, (const bf16*)(ws + WS_WIN), ROWS, 3328, 1024, OpProj{ws}, (const bf16*)(ws + WS_XNMETA), 128); }
    grid.sync();
    PH_END(1)
    PH_BEGIN(2)
    { NEWPHASE
        const int tid = fresh_tid();
        float lam;
        { const int lane = tid & 63; const float s1 = wave_sum(P->in[I_LQ1][lane] * P->in[I_LK1][lane]), s2 = wave_sum(P->in[I_LQ2][lane] * P->in[I_LK2][lane]); lam = __expf(s1) - __expf(s2) + 0.2f; }
        unsigned* ctr = (unsigned*)(ws + WS_CTL);
        LAS unsigned* slot = (LAS unsigned*)(lds + LDS_ITEM_OFF);
#define FETCH(k, n) if (tid == 0) *slot = atomicAdd(ctr + 64 * (k), 1u); __syncthreads(); const int idx = (int)*slot; __syncthreads(); if (idx >= (n)) break;
#ifndef NO_SCAN
#pragma unroll 1
        for (;;) { FETCH(0, N_LONG) const int u = idx / NRP_LONG; scan_unit<NRP_LONG, 4>(lds, P, 0, u >> 3, u & 7, idx % NRP_LONG); }
#endif
#ifndef NO_ATTN
#pragma unroll 1
        for (;;) { FETCH(1, N_ATT_P + N_ATT_S)
            if (idx < N_ATT_P) attn_unit(lds, P, 0, idx >> 7, idx & 127, lam);
            else { const int a = idx - N_ATT_P; attn_unit(lds, P, 1 + (a >> 6), (a >> 4) & 3, a & 15, lam); } }
#endif
#ifndef NO_SCAN
#pragma unroll 1
        for (;;) { FETCH(2, N_SHORT) scan_unit<1, 8>(lds, P, 1 + (idx >> 4), (idx >> 3) & 1, idx & 7, 0); }
#endif
#undef FETCH
    }
    grid.sync();
    PH_END(2)
#ifndef NO_POST
    PH_BEGIN(3)
    { NEWPHASE phase_post(lds, P); }
#endif
    grid.sync();
    PH_END(3)
    PH_BEGIN(4)
    { NEWPHASE run_gemm(lds, (const bf16*)P->out, (const bf16*)(ws + WS_WIN) + (size_t)3328 * 1024, NMAIN, 2048, 1024, OpGate{ws}); }
    grid.sync();
    PH_END(4)
    PH_BEGIN(5)
    { NEWPHASE run_gemm(lds, (const bf16*)(ws + WS_R), (const bf16*)(ws + WS_WUPA), NMAIN, 1024, 512, OpUpA{ws}); }
    grid.sync();
    PH_END(5)
    PH_BEGIN(6)
    { NEWPHASE run_gemm(lds, (const bf16*)(ws + WS_Q), (const bf16*)(ws + WS_WUPB), NMAIN, 1024, 512, OpUpB{ws}); }
    grid.sync();
    PH_END(6)
    PH_BEGIN(7)
    { NEWPHASE run_gemm(lds, (const bf16*)(ws + WS_GB), (const bf16*)(ws + WS_WOUT), NMAIN, 1024, 1024, OpOut{P->in[I_XP], P->in[I_XS], P->out}); }
    grid.sync();
    PH_END(7)
    PH_BEGIN(8)
    { NEWPHASE phase_rms_bf16(P); }
    grid.sync();
    PH_END(8)
    PH_BEGIN(9)
    { NEWPHASE run_gemm(lds, (const bf16*)(ws + WS_MN), (const bf16*)(ws + WS_WFF1), 16384, DFF, 1024, OpFF1{(bf16*)(ws + WS_HID)}); }
    grid.sync();
    PH_END(9)
    PH_BEGIN(10)
    { NEWPHASE run_gemm(lds, (const bf16*)(ws + WS_HID), (const bf16*)(ws + WS_WFF2), 16384, 1024, DFF, OpFF2{P->out}); }
    grid.sync();
    PH_END(10)
    PH_BEGIN(11)
    { NEWPHASE run_gemm(lds, (const bf16*)(ws + WS_MN) + (size_t)16384 * DM, (const bf16*)(ws + WS_WFF1), 16384, DFF, 1024, OpFF1{(bf16*)(ws + WS_HID)}); }
    grid.sync();
    PH_END(11)
    PH_BEGIN(12)
    { NEWPHASE run_gemm(lds, (const bf16*)(ws + WS_HID), (const bf16*)(ws + WS_WFF2), 16384, 1024, DFF, OpFF2{P->out + (size_t)16384 * DM}); }
    grid.sync();
    PH_END(12)
    PH_BEGIN(13)
    { NEWPHASE phase_final(P); }
}

extern "C" void kernel_launch(void* const* d_in, const int* in_sizes, int n_in, void* d_out, int out_size, void* d_ws, size_t ws_size, hipStream_t stream) {
    static int grid_blocks = 0;
    if (grid_blocks == 0) {
        int dev = 0, cus = 0, per_cu = 0;
        hipGetDevice(&dev);
        hipDeviceGetAttribute(&cus, hipDeviceAttributeMultiprocessorCount, dev);
        hipFuncSetAttribute((const void*)fwd_megakernel, hipFuncAttributeMaxDynamicSharedMemorySize, LDS_BYTES);
        hipOccupancyMaxActiveBlocksPerMultiprocessor(&per_cu, (const void*)fwd_megakernel, NTHREADS, LDS_BYTES);
        if (per_cu < 1) { fprintf(stderr, "kernel_launch: occupancy query says %d blocks per CU\n", per_cu); per_cu = 1; }
        grid_blocks = cus * per_cu;
        if (n_in != 29 || ws_size < WS_END) fprintf(stderr, "kernel_launch: unexpected n_in %d / ws_size %zu\n", n_in, ws_size);
    }
    hipMemsetAsync((unsigned char*)d_ws + WS_CTL, 0, 4096, stream);
    Params p{};
    for (int i = 0; i < 29; ++i) p.in[i] = (const float*)d_in[i];
    p.out = (float*)d_out; p.ws = (unsigned char*)d_ws;
    void* args[] = {&p};
    hipError_t e = hipLaunchCooperativeKernel((const void*)fwd_megakernel, dim3(grid_blocks), dim3(NTHREADS), args, LDS_BYTES, stream);
    if (e != hipSuccess) fprintf(stderr, "cooperative launch failed: %s (grid %d)\n", hipGetErrorString(e), grid_blocks);
}
```

```cpp
#include <hip/hip_runtime.h>
#include <hip/hip_cooperative_groups.h>
#include <cstdio>
#include <cstdint>
#include <cmath>
namespace cg = cooperative_groups;
__device__ __forceinline__ int fresh_tid() { int t = threadIdx.x; asm volatile("" : "+v"(t)); return t; }
namespace pg8 {
#define PG8_LAS __attribute__((address_space(3)))
typedef unsigned short bf16_t;
typedef short bf16x8 __attribute__((ext_vector_type(8)));
typedef float f32x4 __attribute__((ext_vector_type(4)));
typedef unsigned u32x4 __attribute__((ext_vector_type(4)));
constexpr int BM = 256, BK = 64, HALF = 128, HTB = HALF * BK * 2  , STAGE_BYTES = 8 * HTB, NXCD = 8, WGM = 8;

__host__ __device__ __forceinline__ int lds_byte(int r, int c) { const int st = (r >> 4) * 2 + (c >> 5), rr = r & 15, cc = c & 31, ob = rr * 64 + cc * 2; return st * 1024 + (ob ^ (((ob >> 9) & 1) << 5)); }
__host__ __device__ __forceinline__ void stage_rc(int b, int& R, int& C) { const int st = b / 1024, sb = b % 1024, swz = sb ^ (((sb >> 9) & 1) << 5); R = (st >> 1) * 16 + swz / 64; C = (st & 1) * 32 + (swz % 64) / 2; }
__host__ __device__ __forceinline__ int perm32(int rho) { const int n = rho >> 4, i = rho & 15; return 8 * (i >> 2) + 4 * n + (i & 3); }

struct Unit { int pm, pn; };
struct Gemm { const bf16_t* A; const bf16_t* Bt; int M, N, K; const bf16_t* A2; int pm2; };
__device__ __forceinline__ const char* gemm_abase(const Gemm& g, int pm, size_t tstep) { return pm >= g.pm2 ? (const char*)g.A2 + (size_t)(pm - g.pm2) * tstep : (const char*)g.A + (size_t)pm * tstep; }

struct StaticOrder {
    int nM, nN, nwg, G, c;
    __host__ __device__ void init(int M, int N, int G_, int c_) { nM = M / BM; nN = N / BM; nwg = nM * nN; G = G_; c = c_; }
    __host__ __device__ bool next(int i, Unit& u) const {
        const long L = (long)i * G + c; if (L >= nwg) return false;
        int wgid = (int)L; { const int q = nwg / NXCD, r = nwg % NXCD, xcd = wgid % NXCD, off = wgid / NXCD; wgid = (xcd < r ? xcd * (q + 1) : r * (q + 1) + (xcd - r) * q) + off; }
        const int nig = WGM * nN, gid = wgid / nig, fm = gid * WGM, gsz = (nM - fm) < WGM ? (nM - fm) : WGM;
        u.pm = fm + ((wgid % nig) % gsz); u.pn = (wgid % nig) / gsz; return true;
    }
    __device__ __forceinline__ void a_ready(const Unit&) const {}
    __device__ __forceinline__ void done(const Unit&) const {}
};


template <class Epi, class Sched, bool ALIGN_EPI = false, bool SP2 = false>
__device__ __forceinline__ void gemm_phase(PG8_LAS unsigned char* lds, const Gemm g, const Sched& S, const Epi& E) {
    const int tid = fresh_tid(), wid = __builtin_amdgcn_readfirstlane(tid >> 6), lane = tid & 63, wr = wid >> 2, wc = wid & 3, fr = lane & 15, fq = lane >> 4;
    const int K = g.K, nt = K / BK;
    unsigned voffA[2], voffB[2];
#pragma unroll
    for (int i = 0; i < 2; ++i) { int R, C; stage_rc(tid * 16 + i * 8192, R, C); const int Rb = Epi::PERM ? ((R & ~31) + perm32(R & 31)) : R;
        voffA[i] = (unsigned)(R * K + C) * 2u; voffB[i] = (unsigned)(Rb * K + C) * 2u; }
    const size_t kstep = (size_t)(BK * 2);
    const size_t hstep = (size_t)HALF * K * 2;
    const size_t tstep = 2 * hstep;
    const unsigned ldsw = (unsigned)wid * 1024u;
    const int aoff = lds_byte(wr * 64 + fr, fq * 8), boff = lds_byte(wc * 32 + fr, fq * 8);
#define PG8_SA(b, h) (((b) * 2 + (h)) * HTB)
#define PG8_SB(b, h) ((4 + (b) * 2 + (h)) * HTB)
#define PG8_STAGE(bufoff, gbase, voff) do { _Pragma("unroll") for (int _i = 0; _i < 2; ++_i) \
        __builtin_amdgcn_global_load_lds((const unsigned*)((const char*)(gbase) + (voff)[_i]), (PG8_LAS unsigned*)(lds + (bufoff) + ldsw + _i * 8192), 16, 0, 0); } while (0)
#define PG8_LDA(dst, b, h) do { _Pragma("unroll") for (int m = 0; m < 4; ++m) _Pragma("unroll") for (int k = 0; k < 2; ++k) dst[m][k] = *(const PG8_LAS bf16x8*)(lds + PG8_SA(b, h) + aoff + m * 2048 + k * 1024); } while (0)
#define PG8_LDB(dst, b, h) do { _Pragma("unroll") for (int n = 0; n < 2; ++n) _Pragma("unroll") for (int k = 0; k < 2; ++k) dst[n][k] = *(const PG8_LAS bf16x8*)(lds + PG8_SB(b, h) + boff + n * 2048 + k * 1024); } while (0)
#define PG8_MMA(ai, bj, At, Bt) do { __builtin_amdgcn_s_setprio(1); _Pragma("unroll") for (int m = 0; m < 4; ++m) _Pragma("unroll") for (int n = 0; n < 2; ++n) _Pragma("unroll") for (int k = 0; k < 2; ++k) \
        acc[ai][bj][m][n] = __builtin_amdgcn_mfma_f32_16x16x32_bf16(Bt[n][k], At[m][k], acc[ai][bj][m][n], 0, 0, 0); __builtin_amdgcn_s_setprio(0); } while (0)
#define PG8_WAIT_V(n) asm volatile("s_waitcnt vmcnt(" #n ")" ::: "memory")
#define PG8_WAIT_L(n) asm volatile("s_waitcnt lgkmcnt(" #n ")" ::: "memory")
#define PG8_BAR __builtin_amdgcn_s_barrier()
#define PG8_SCHED __builtin_amdgcn_sched_barrier(0)
    Unit cur, nxt; int ui = 0;
    if (!S.next(0, cur)) return;
    f32x4 acc[2][2][4][2];
#pragma unroll
    for (int a = 0; a < 2; ++a)
#pragma unroll
        for (int b = 0; b < 2; ++b)
#pragma unroll
            for (int m = 0; m < 4; ++m)
#pragma unroll
                for (int n = 0; n < 2; ++n) acc[a][b][m][n] = (f32x4){0.f, 0.f, 0.f, 0.f};
    bf16x8 At[4][2], B0[2][2], B1[2][2];
    const char* cA = gemm_abase(g, cur.pm, tstep); const char* cB = (const char*)g.Bt + (size_t)cur.pn * tstep;
    S.a_ready(cur);
    if constexpr (SP2) {
        PG8_STAGE(PG8_SB(0, 0), cB, voffB); PG8_STAGE(PG8_SB(0, 1), cB + hstep, voffB); PG8_STAGE(PG8_SA(0, 0), cA, voffA); PG8_STAGE(PG8_SA(0, 1), cA + hstep, voffA);
        if (wr == 1) PG8_BAR;
        PG8_WAIT_V(2); PG8_BAR;
        PG8_STAGE(PG8_SB(1, 0), cB + kstep, voffB); PG8_STAGE(PG8_SA(1, 0), cA + kstep, voffA); PG8_STAGE(PG8_SB(1, 1), cB + hstep + kstep, voffB);
        PG8_WAIT_V(6); PG8_BAR;
    } else {
        PG8_STAGE(PG8_SB(0, 0), cB, voffB); PG8_STAGE(PG8_SA(0, 0), cA, voffA); PG8_STAGE(PG8_SB(0, 1), cB + hstep, voffB); PG8_STAGE(PG8_SA(0, 1), cA + hstep, voffA);
        if (wr == 1) PG8_BAR;
        PG8_WAIT_V(4); PG8_BAR;
        PG8_STAGE(PG8_SB(1, 0), cB + kstep, voffB); PG8_STAGE(PG8_SA(1, 0), cA + kstep, voffA); PG8_STAGE(PG8_SB(1, 1), cB + hstep + kstep, voffB);
        PG8_WAIT_V(6); PG8_BAR;
    }
    for (;;) {
        const bool has_next = S.next(ui + 1, nxt);
        const char* nA = has_next ? gemm_abase(g, nxt.pm, tstep) : cA; const char* nB = has_next ? (const char*)g.Bt + (size_t)nxt.pn * tstep : cB;
        for (int t = 0; t < nt; t += 2) {
            const bool last = (t == nt - 2);
            const char* a1 = cA + (size_t)(t + 1) * kstep;
            const char* a2 = last ? nA : cA + (size_t)(t + 2) * kstep; const char* b2 = last ? nB : cB + (size_t)(t + 2) * kstep;
            const char* a3 = a2 + kstep; const char* b3 = b2 + kstep;
            if (last && has_next) S.a_ready(nxt);
            if constexpr (SP2) {
            PG8_LDB(B0, 0, 0); PG8_LDB(B1, 0, 1); PG8_SCHED; PG8_LDA(At, 0, 0); PG8_STAGE(PG8_SA(1, 1), a1 + hstep, voffA);
            PG8_WAIT_V(8); PG8_WAIT_L(0); PG8_BAR; PG8_MMA(0, 0, At, B0); PG8_MMA(0, 1, At, B1); PG8_BAR; PG8_SCHED;
            PG8_LDA(At, 0, 1); PG8_STAGE(PG8_SB(0, 0), b2, voffB); PG8_STAGE(PG8_SB(0, 1), b2 + hstep, voffB); PG8_STAGE(PG8_SA(0, 0), a2, voffA);
            PG8_WAIT_V(8); PG8_WAIT_L(0); PG8_BAR; PG8_MMA(1, 0, At, B0); PG8_MMA(1, 1, At, B1); PG8_BAR; PG8_SCHED;
            PG8_LDB(B0, 1, 0); PG8_LDB(B1, 1, 1); PG8_SCHED; PG8_LDA(At, 1, 0); PG8_STAGE(PG8_SA(0, 1), a2 + hstep, voffA);
            PG8_WAIT_V(8); PG8_WAIT_L(0); PG8_BAR; PG8_MMA(0, 0, At, B0); PG8_MMA(0, 1, At, B1); PG8_BAR; PG8_SCHED;
            PG8_LDA(At, 1, 1); PG8_STAGE(PG8_SB(1, 0), b3, voffB); PG8_STAGE(PG8_SB(1, 1), b3 + hstep, voffB); PG8_STAGE(PG8_SA(1, 0), a3, voffA);
            PG8_WAIT_V(8); PG8_WAIT_L(0); PG8_BAR; PG8_MMA(1, 0, At, B0); PG8_MMA(1, 1, At, B1); PG8_BAR; PG8_SCHED;
            } else {
            PG8_LDB(B0, 0, 0); PG8_SCHED; PG8_LDA(At, 0, 0); PG8_STAGE(PG8_SA(1, 1), a1 + hstep, voffA);
            PG8_WAIT_L(8); PG8_BAR; PG8_WAIT_L(0); PG8_MMA(0, 0, At, B0); PG8_BAR; PG8_SCHED;
            PG8_LDB(B1, 0, 1); PG8_STAGE(PG8_SB(0, 0), b2, voffB);
            PG8_BAR; PG8_WAIT_L(0); PG8_MMA(0, 1, At, B1); PG8_BAR;
            PG8_LDA(At, 0, 1); PG8_STAGE(PG8_SA(0, 0), a2, voffA);
            PG8_BAR; PG8_WAIT_L(0); PG8_MMA(1, 0, At, B0); PG8_BAR; PG8_SCHED;
            PG8_STAGE(PG8_SB(0, 1), b2 + hstep, voffB);
            PG8_WAIT_V(6); PG8_BAR; PG8_MMA(1, 1, At, B1); PG8_BAR;
            PG8_LDB(B0, 1, 0); PG8_SCHED; PG8_LDA(At, 1, 0); PG8_STAGE(PG8_SA(0, 1), a2 + hstep, voffA);
            PG8_WAIT_L(8); PG8_BAR; PG8_WAIT_L(0); PG8_MMA(0, 0, At, B0); PG8_BAR; PG8_SCHED;
            PG8_LDB(B1, 1, 1); PG8_STAGE(PG8_SB(1, 0), b3, voffB);
            PG8_BAR; PG8_WAIT_L(0); PG8_MMA(0, 1, At, B1); PG8_BAR;
            PG8_LDA(At, 1, 1); PG8_STAGE(PG8_SA(1, 0), a3, voffA);
            PG8_BAR; PG8_WAIT_L(0); PG8_MMA(1, 0, At, B0); PG8_BAR; PG8_SCHED;
            PG8_STAGE(PG8_SB(1, 1), b3 + hstep, voffB);
            PG8_WAIT_V(6); PG8_BAR; PG8_MMA(1, 1, At, B1); PG8_BAR;
            }
        }
        if constexpr (ALIGN_EPI) { if (wr == 0) PG8_BAR; }
        if constexpr (!Epi::AFTER_DRAIN) { E(acc, cur, wr, wc, fr, fq); S.done(cur); }
        if (!has_next) break;
#pragma unroll
        for (int a = 0; a < 2; ++a)
#pragma unroll
            for (int b = 0; b < 2; ++b)
#pragma unroll
                for (int m = 0; m < 4; ++m)
#pragma unroll
                    for (int n = 0; n < 2; ++n) acc[a][b][m][n] = (f32x4){0.f, 0.f, 0.f, 0.f};
        cur = nxt; cA = nA; cB = nB; ++ui;
        if constexpr (ALIGN_EPI) { if (wr == 1) PG8_BAR; }
    }
    PG8_WAIT_V(0);
    if constexpr (!ALIGN_EPI) { if (wr == 0) PG8_BAR; }
    PG8_BAR;
    if constexpr (Epi::AFTER_DRAIN) { E.fused(acc, cur, wr, wc, fr, fq, lds, wid, lane); S.done(cur); }
#undef PG8_SA
#undef PG8_SB
#undef PG8_STAGE
#undef PG8_LDA
#undef PG8_LDB
#undef PG8_MMA
#undef PG8_WAIT_V
#undef PG8_WAIT_L
#undef PG8_BAR
#undef PG8_SCHED
}
}

#ifndef PG8_SP2
#define PG8_SP2 true
#endif

#define LAS __attribute__((address_space(3)))
typedef unsigned short bf16;
typedef short bf16x8 __attribute__((ext_vector_type(8)));
typedef float f32x4 __attribute__((ext_vector_type(4)));
typedef float f32x16 __attribute__((ext_vector_type(16)));
typedef unsigned u32x4 __attribute__((ext_vector_type(4)));
typedef unsigned u32x2 __attribute__((ext_vector_type(2)));

constexpr int DM = 1024, NMAIN = 32768, ROWS = 33024, METAROW = 32768, DFF = 4096;
constexpr int NTHREADS = 512;
constexpr int LDS_BYTES = 147456;
constexpr int LDS_ITEM_OFF = LDS_BYTES - 16;
constexpr size_t MiB = 1u << 20;
constexpr size_t WS_CTL = 0, WS_WIN = 1 * MiB, WS_WUPA = 12 * MiB, WS_WUPB = 13 * MiB, WS_WOUT = 14 * MiB, WS_WFF1 = 16 * MiB, WS_WFF2 = 24 * MiB;
constexpr size_t WS_LORA = 32 * MiB, WS_XNMETA = 32 * MiB + 512 * 1024, WS_CB = 33 * MiB, WS_ACT = 36 * MiB;
constexpr size_t ACT_SZ = (size_t)ROWS * 512 * 2, L_SZ = (size_t)ROWS * 256 * 2;
constexpr size_t WS_R = WS_ACT, WS_KA = WS_R + ACT_SZ, WS_VA = WS_KA + ACT_SZ, WS_L = WS_VA + ACT_SZ, WS_Q = WS_L + L_SZ, WS_KB = WS_Q + ACT_SZ, WS_VT = WS_KB + ACT_SZ, WS_END = WS_VT + ACT_SZ;
constexpr size_t WS_GA = WS_KA, WS_GB = WS_KB, WS_MN = WS_ACT, WS_HID = WS_ACT + 64 * MiB;
static_assert(WS_END <= 256 * MiB && WS_HID + 128 * MiB <= 256 * MiB && WS_CB + (size_t)2 * ROWS * 8 * 4 <= WS_ACT, "ws map");
constexpr float LOG2E = 1.4426950408889634f;
constexpr float QSCALE = 0.125f * LOG2E;

struct Params { const float* in[29]; float* out; unsigned char* ws; };
typedef const __attribute__((address_space(4))) Params* KP;
enum { I_XP = 0, I_XS, I_META, I_GMIX, I_WIN, I_MUP, I_MUN, I_W0, I_WUP, I_A0, I_AUP, I_GUP, I_KK, I_KA, I_RK, I_LNW, I_LNB, I_LQ1, I_LK1, I_LQ2, I_LK2, I_SUBG, I_UPA, I_UPB, I_WOUT, I_GFFN, I_FF1, I_FF2, I_GFIN };

__device__ __forceinline__ unsigned cvtpk(float lo, float hi) { unsigned r; asm volatile("v_cvt_pk_bf16_f32 %0, %1, %2" : "=v"(r) : "v"(lo), "v"(hi)); return r; }
__device__ __forceinline__ float bf2f(unsigned short b) { return __uint_as_float(((unsigned)b) << 16); }
__device__ __forceinline__ float bflo(unsigned w) { return __uint_as_float(w << 16); }
__device__ __forceinline__ float bfhi(unsigned w) { return __uint_as_float(w & 0xffff0000u); }
__device__ __forceinline__ void unpack8(const u32x4 v, float* o) { o[0] = bflo(v.x); o[1] = bfhi(v.x); o[2] = bflo(v.y); o[3] = bfhi(v.y); o[4] = bflo(v.z); o[5] = bfhi(v.z); o[6] = bflo(v.w); o[7] = bfhi(v.w); }
__device__ __forceinline__ float wave_sum(float v) {
#pragma unroll
    for (int o = 1; o < 64; o <<= 1) v += __shfl_xor(v, o);
    return v;
}
__device__ __forceinline__ float sigmoidf_(float x) { return 1.0f / (1.0f + __expf(-x)); }
__device__ __forceinline__ int seq_base(int s) { return s == 0 ? 0 : 16384 + (s - 1) * 2048; }
__device__ __forceinline__ int seq_len(int s) { return s == 0 ? 16384 : 2048; }
__device__ __forceinline__ int pos_row(int base, int p) { return p < 16 ? METAROW + p : base + p - 16; }

template <class Op> struct Epi8 {
    static constexpr bool PERM = true, AFTER_DRAIN = false;
    Op op;
    __device__ __forceinline__ void operator()(const pg8::f32x4 (&acc)[2][2][4][2], const pg8::Unit& u, int wr, int wc, int fr, int fq) const {
        const int row0 = u.pm * 256 + wr * 64 + fr, col0 = u.pn * 256 + wc * 32 + 8 * fq;
#pragma unroll
        for (int ai = 0; ai < 2; ++ai)
#pragma unroll
            for (int m = 0; m < 4; ++m)
#pragma unroll
                for (int bj = 0; bj < 2; ++bj) { op.apply(row0 + ai * 128 + m * 16, col0 + bj * 128, u.pn, acc[ai][bj][m][0], acc[ai][bj][m][1]); asm volatile("" ::: "memory"); }
    }
};
__device__ __forceinline__ u32x4 pack8(const f32x4 a, const f32x4 b) { u32x4 w; w.x = cvtpk(a[0], a[1]); w.y = cvtpk(a[2], a[3]); w.z = cvtpk(b[0], b[1]); w.w = cvtpk(b[2], b[3]); return w; }

constexpr int CW_KN = 320;
__device__ __forceinline__ float dpp_max16(float v) {
    int x = __float_as_int(v);
    v = fmaxf(v, __int_as_float(__builtin_amdgcn_update_dpp(0, x, 0xB1, 0xf, 0xf, true))); x = __float_as_int(v);
    v = fmaxf(v, __int_as_float(__builtin_amdgcn_update_dpp(0, x, 0x4E, 0xf, 0xf, true))); x = __float_as_int(v);
    v = fmaxf(v, __int_as_float(__builtin_amdgcn_update_dpp(0, x, 0x141, 0xf, 0xf, true))); x = __float_as_int(v);
    v = fmaxf(v, __int_as_float(__builtin_amdgcn_update_dpp(0, x, 0x140, 0xf, 0xf, true)));
    return v;
}
struct OpProj {
    unsigned char* ws;
    __device__ __forceinline__ void apply(int row, int col, int pn, f32x4 v0, f32x4 v1) const {
        if (pn >= 11) {
            bf16* VT = (bf16*)(ws + WS_VT); const int c = col - 11 * 256;
#pragma unroll
            for (int e = 0; e < 4; ++e) { VT[(size_t)(c + e) * ROWS + row] = (bf16)(cvtpk(v0[e], 0.f) & 0xffffu); VT[(size_t)(c + 4 + e) * ROWS + row] = (bf16)(cvtpk(v1[e], 0.f) & 0xffffu); }
            return;
        }
        bf16* O; int ldc = 512, c;
        if (pn < 2) { O = (bf16*)(ws + WS_R); c = col; }
        else if (pn < 4) { O = (bf16*)(ws + WS_KA); c = col - 512; }
        else if (pn < 6) { O = (bf16*)(ws + WS_VA); c = col - 1024; }
        else if (pn < 7) { O = (bf16*)(ws + WS_L); c = col - 1536; ldc = 256; }
        else if (pn < 9) { O = (bf16*)(ws + WS_Q); c = col - 1792; v0 = v0 * QSCALE; v1 = v1 * QSCALE; }
        else { O = (bf16*)(ws + WS_KB); c = col - 2304; }
        const u32x4 w = pack8(v0, v1);
        *(u32x4*)(O + (size_t)row * ldc + c) = w;
        if (pn >= 9) {
            float k8[8]; unpack8(w, k8); float ss = 0.f;
#pragma unroll
            for (int e = 0; e < 8; ++e) ss = fmaf(k8[e], k8[e], ss);
            ss = dpp_max16(ss);
            if ((threadIdx.x & 15) == 0) { const int sidx = row < 16384 ? 0 : row < NMAIN ? 1 + ((row - 16384) >> 11) : 9;
                atomicMax((unsigned*)(ws + WS_CTL) + CW_KN + sidx * 64 + (c >> 3), __float_as_uint(ss)); }
        }
    }
};
struct OpGate {
    unsigned char* ws;
    __device__ __forceinline__ void apply(int row, int col, int pn, f32x4 v0, f32x4 v1) const {
        bf16* O = (bf16*)(ws + (pn < 4 ? WS_GA : WS_GB)); const int c = pn < 4 ? col : col - 1024;
#pragma unroll
        for (int e = 0; e < 4; ++e) { v0[e] = sigmoidf_(v0[e]); v1[e] = sigmoidf_(v1[e]); }
        *(u32x4*)(O + (size_t)row * 1024 + c) = pack8(v0, v1);
    }
};
struct OpUpA {
    unsigned char* ws;
    __device__ __forceinline__ void apply(int row, int col, int pn, f32x4 v0, f32x4 v1) const {
        u32x4* p = (u32x4*)((bf16*)(ws + WS_GA) + (size_t)row * 1024 + col); float g[8]; unpack8(*p, g);
#pragma unroll
        for (int e = 0; e < 4; ++e) { v0[e] *= g[e]; v1[e] *= g[4 + e]; }
        *p = pack8(v0, v1);
    }
};
struct OpUpB {
    unsigned char* ws;
    __device__ __forceinline__ void apply(int row, int col, int pn, f32x4 v0, f32x4 v1) const {
        u32x4* p = (u32x4*)((bf16*)(ws + WS_GB) + (size_t)row * 1024 + col); float g[8], a[8]; unpack8(*p, g);
        unpack8(*(const u32x4*)((const bf16*)(ws + WS_GA) + (size_t)row * 1024 + col), a);
#pragma unroll
        for (int e = 0; e < 4; ++e) { v0[e] = a[e] + v0[e] * g[e]; v1[e] = a[4 + e] + v1[e] * g[4 + e]; }
        *p = pack8(v0, v1);
    }
};
struct OpOut {
    const float* xp; const float* xs; float* out;
    __device__ __forceinline__ void apply(int row, int col, int pn, f32x4 v0, f32x4 v1) const {
        const float* x = (row < 16384 ? xp + (size_t)row * DM : xs + (size_t)(row - 16384) * DM) + col;
        float* o = out + (size_t)row * DM + col;
        *(f32x4*)o = *(const f32x4*)x + v0; *(f32x4*)(o + 4) = *(const f32x4*)(x + 4) + v1;
    }
};
struct OpFF1 {
    bf16* hid;
    __device__ __forceinline__ void apply(int row, int col, int pn, f32x4 v0, f32x4 v1) const {
#pragma unroll
        for (int e = 0; e < 4; ++e) { const float a = fmaxf(v0[e], 0.f), b = fmaxf(v1[e], 0.f); v0[e] = a * a; v1[e] = b * b; }
        *(u32x4*)(hid + (size_t)row * DFF + col) = pack8(v0, v1);
    }
};
struct OpFF2 {
    float* out;
    __device__ __forceinline__ void apply(int row, int col, int pn, f32x4 v0, f32x4 v1) const {
        float* o = out + (size_t)row * DM + col;
        *(f32x4*)o = *(const f32x4*)o + v0; *(f32x4*)(o + 4) = *(const f32x4*)(o + 4) + v1;
    }
};

__device__ __forceinline__ unsigned f2bf_rne(float f) { return cvtpk(f, 0.f) & 0xffffu; }
__device__ __forceinline__ void transpose_item(const float* W, int K, int N, bf16* WT, LAS float* scr, int item, int lane) {
    const int nblk = N / 32, kb = item / nblk, nb = item % nblk, k0 = 64 * kb, n0 = 32 * nb;
#pragma unroll 8
    for (int i = 0; i < 32; ++i) { const int kk = 2 * i + (lane >> 5); scr[kk * 33 + (lane & 31)] = W[(size_t)(k0 + kk) * N + n0 + (lane & 31)]; }
    asm volatile("s_waitcnt vmcnt(0) lgkmcnt(0)" ::: "memory");
    const int c = lane & 7;
#pragma unroll
    for (int j = 0; j < 4; ++j) { const int n = (lane >> 3) + 8 * j; const LAS float* s = scr + (8 * c) * 33 + n;
        u32x4 o; o.x = cvtpk(s[0 * 33], s[1 * 33]); o.y = cvtpk(s[2 * 33], s[3 * 33]); o.z = cvtpk(s[4 * 33], s[5 * 33]); o.w = cvtpk(s[6 * 33], s[7 * 33]);
        *(u32x4*)(WT + (size_t)(n0 + n) * K + k0 + 8 * c) = o; }
    asm volatile("s_waitcnt lgkmcnt(0)" ::: "memory");
}
__device__ __forceinline__ void rms_row_bf16(const float* src, const float* g, bf16* dst, int lane) {
    unsigned long long* o8 = (unsigned long long*)dst + lane;
    if (!src) {
#pragma unroll
        for (int j = 0; j < 4; ++j) o8[64 * j] = 0ull;
        return; }
    const f32x4* xr = (const f32x4*)src + lane; const f32x4* gr = (const f32x4*)g + lane;
    f32x4 v[4]; float s = 0.f;
#pragma unroll
    for (int j = 0; j < 4; ++j) { v[j] = xr[64 * j]; s += (v[j].x * v[j].x + v[j].y * v[j].y) + (v[j].z * v[j].z + v[j].w * v[j].w); }
    const float rstd = rsqrtf(wave_sum(s) * (1.f / DM) + 1e-6f);
#pragma unroll
    for (int j = 0; j < 4; ++j) { const f32x4 gg = gr[64 * j]; const f32x4 y = v[j] * rstd * gg;
        o8[64 * j] = (unsigned long long)cvtpk(y.x, y.y) | ((unsigned long long)cvtpk(y.z, y.w) << 32); }
}
__device__ __forceinline__ void phase_prologue(LAS unsigned char* lds, KP P) {
    const int tid = fresh_tid(), lane = tid & 63, wid = tid >> 6;
    LAS float* scr = (LAS float*)(lds + wid * 16384);
    const int gw = blockIdx.x * 8 + wid, NGW = gridDim.x * 8;
    unsigned char* ws = P->ws;
    constexpr int I_IN = (1024 / 64) * (5376 / 32), I_UP = (512 / 64) * (1024 / 32), I_O = (1024 / 64) * (1024 / 32), I_1 = (1024 / 64) * (4096 / 32), I_2 = (4096 / 64) * (1024 / 32);
    constexpr int I_LW = (64 / 64) * (512 / 32), I_G = (128 / 64) * (512 / 32);
    constexpr int NITEMS = I_IN + 2 * I_UP + I_O + I_1 + I_2 + 4 * I_LW + I_G;
    for (int it = gw; it < NITEMS; it += NGW) {
        int r = it;
        if (r < I_IN) { transpose_item(P->in[I_WIN], 1024, 5376, (bf16*)(ws + WS_WIN), scr, r, lane); continue; } r -= I_IN;
        if (r < I_UP) { transpose_item(P->in[I_UPA], 512, 1024, (bf16*)(ws + WS_WUPA), scr, r, lane); continue; } r -= I_UP;
        if (r < I_UP) { transpose_item(P->in[I_UPB], 512, 1024, (bf16*)(ws + WS_WUPB), scr, r, lane); continue; } r -= I_UP;
        if (r < I_O) { transpose_item(P->in[I_WOUT], 1024, 1024, (bf16*)(ws + WS_WOUT), scr, r, lane); continue; } r -= I_O;
        if (r < I_1) { transpose_item(P->in[I_FF1], 1024, 4096, (bf16*)(ws + WS_WFF1), scr, r, lane); continue; } r -= I_1;
        if (r < I_2) { transpose_item(P->in[I_FF2], 4096, 1024, (bf16*)(ws + WS_WFF2), scr, r, lane); continue; } r -= I_2;
        if (r < 2 * I_LW) { const int d = r / I_LW; transpose_item(P->in[I_WUP] + (size_t)d * 64 * 512, 64, 512, (bf16*)(ws + WS_LORA) + (size_t)d * 512 * 64, scr, r % I_LW, lane); continue; } r -= 2 * I_LW;
        if (r < 2 * I_LW) { const int d = r / I_LW; transpose_item(P->in[I_AUP] + (size_t)d * 64 * 512, 64, 512, (bf16*)(ws + WS_LORA + 131072) + (size_t)d * 512 * 64, scr, r % I_LW, lane); continue; } r -= 2 * I_LW;
        transpose_item(P->in[I_GUP], 128, 512, (bf16*)(ws + WS_LORA + 262144), scr, r, lane);
    }
    bf16* XN = (bf16*)P->out; bf16* XM = (bf16*)(ws + WS_XNMETA);
    for (int m = gw; m < ROWS; m += NGW) {
        const float* src = m < 16384 ? P->in[I_XP] + (size_t)m * DM : m < NMAIN ? P->in[I_XS] + (size_t)(m - 16384) * DM : (m - NMAIN < 16 ? P->in[I_META] + (size_t)(m - NMAIN) * DM : nullptr);
        bf16* dst = m < NMAIN ? XN + (size_t)m * DM : XM + (size_t)(m - NMAIN) * DM;
        rms_row_bf16(src, P->in[I_GMIX], dst, lane);
    }
}

constexpr int AT_KSTR = 272, AT_VSTR = 144, AT_KSZ = 64 * AT_KSTR, AT_BUF = AT_KSZ + 128 * AT_VSTR;
__device__ __forceinline__ f32x16 mfma32(bf16x8 a, bf16x8 b, f32x16 c) { return __builtin_amdgcn_mfma_f32_32x32x16_bf16(a, b, c, 0, 0, 0); }
__device__ __forceinline__ void attn_unit(LAS unsigned char* lds, KP P, int s, int h, int qb, float lam) {
    int tid_ = threadIdx.x; asm volatile("" : "+v"(tid_));
    const int tid = tid_, lane = tid & 63, r32 = lane & 31, hi = lane >> 5, wid = __builtin_amdgcn_readfirstlane(tid >> 6), rg = wid & 3, mp = wid >> 2;
    const int L = seq_len(s), base = seq_base(s), NT = 1 + L / 64;
    unsigned char* ws = P->ws;
    const bf16* KB = (const bf16*)(ws + WS_KB); const bf16* VT = (const bf16*)(ws + WS_VT); bf16* Q = (bf16*)(ws + WS_Q);
    const int qrow = base + qb * 128 + rg * 32 + r32;
    bf16x8 q[4];
#pragma unroll
    for (int d0 = 0; d0 < 4; ++d0) q[d0] = *(const bf16x8*)(Q + (size_t)qrow * 512 + h * 128 + mp * 64 + d0 * 16 + hi * 8);
    f32x16 O[4];
#pragma unroll
    for (int b = 0; b < 4; ++b)
#pragma unroll
        for (int r = 0; r < 16; ++r) O[b][r] = 0.f;
    float mx = -INFINITY, ls = 0.f;
    const float qh = (float)(16 + qb * 128 + rg * 32 + r32 - 4 * hi);
    const float nslope = -exp2f(-2.0f * (float)(h + 1)) * LOG2E;
    const int kr0 = tid >> 4, kc = tid & 15, vn0 = tid >> 3, vc = tid & 7;
    u32x4 kreg[2], vreg[2];
    const unsigned kgo = (unsigned)((kr0 * 512 + h * 128 + kc * 8) * 2), vgo = (unsigned)(((h * 128 + vn0) * ROWS + vc * 8) * 2);
    const unsigned klo = (unsigned)(kr0 * AT_KSTR + kc * 16), vlo = (unsigned)(AT_KSZ + vn0 * AT_VSTR + vc * 16);
#define AT_GLOAD(j) do { const int m0_ = (j) == 0 ? METAROW : base + 64 * ((j) - 1); \
        const unsigned char* kt_ = (const unsigned char*)KB + (size_t)m0_ * 1024; const unsigned char* vt_ = (const unsigned char*)VT + (size_t)m0_ * 2; \
        kreg[0] = *(const u32x4*)(kt_ + kgo); kreg[1] = *(const u32x4*)(kt_ + 32 * 1024 + kgo); \
        vreg[0] = *(const u32x4*)(vt_ + vgo); vreg[1] = *(const u32x4*)(vt_ + (size_t)64 * ROWS * 2 + vgo); } while (0)
#define AT_LSTORE(buf) do { LAS unsigned char* kb_ = lds + (buf) * AT_BUF; \
        *(LAS u32x4*)(kb_ + klo) = kreg[0]; *(LAS u32x4*)(kb_ + klo + 32 * AT_KSTR) = kreg[1]; \
        *(LAS u32x4*)(kb_ + vlo) = vreg[0]; *(LAS u32x4*)(kb_ + vlo + 64 * AT_VSTR) = vreg[1]; } while (0)
    float qn, kn;
    { float ssq = 0.f;
#pragma unroll
      for (int d0 = 0; d0 < 4; ++d0) { float t[8]; unpack8(__builtin_bit_cast(u32x4, q[d0]), t);
#pragma unroll
        for (int e = 0; e < 8; ++e) ssq = fmaf(t[e], t[e], ssq); }
      ssq += __shfl_xor(ssq, 32); qn = sqrtf(ssq) * 1.002f;
      const unsigned* KN = (const unsigned*)(ws + WS_CTL) + CW_KN; float ks = 0.f;
#pragma unroll
      for (int g = 0; g < 8; ++g) ks += fmaxf(__uint_as_float(__hip_atomic_load(KN + s * 64 + h * 16 + mp * 8 + g, __ATOMIC_RELAXED, __HIP_MEMORY_SCOPE_AGENT)), __uint_as_float(__hip_atomic_load(KN + 9 * 64 + h * 16 + mp * 8 + g, __ATOMIC_RELAXED, __HIP_MEMORY_SCOPE_AGENT)));
      kn = sqrtf(ks) * 1.002f; }
    const int jc0 = 1 + qb * 2;
    int jlo = jc0, jhi = jc0 + 1;
    LAS float* red = (LAS float*)(lds + 2 * AT_BUF);
#pragma unroll 1
    for (int ph = 0; ph < 2; ++ph) {
        int nleft, ntl;
        if (ph == 0) { nleft = 0; ntl = 2; }
        else {
            float dneed = (qn * kn - mx + 40.0f) / (-nslope);
#pragma unroll
            for (int o = 1; o < 64; o <<= 1) dneed = fmaxf(dneed, __shfl_xor(dneed, o));
            if (lane == 0) red[wid] = dneed;
            __syncthreads();
            float dm = red[0];
#pragma unroll
            for (int w8 = 1; w8 < 8; ++w8) dm = fmaxf(dm, red[w8]);
            dm = fminf(fmaxf(dm, 0.f), 1.0e6f);
            const int dmax = (int)dm + 1, q0 = 16 + qb * 128;
            const int plo = q0 - dmax, phi = q0 + 127 + dmax;
            jlo = plo < 16 ? 0 : 1 + ((plo - 16) >> 6); jhi = phi >= L + 16 ? NT - 1 : 1 + ((phi - 16) >> 6);
            if (jlo > jc0) jlo = jc0; if (jhi < jc0 + 1) jhi = jc0 + 1;
            nleft = jc0 - jlo; ntl = nleft + (jhi - jc0 - 1);
        }
        if (ntl > 0) {
#define AT_J(t) (ph == 0 ? jc0 + (t) : ((t) < nleft ? jlo + (t) : jc0 + 2 + ((t) - nleft)))
        { const int jf = AT_J(0); AT_GLOAD(jf); } AT_LSTORE(0); __syncthreads();
#pragma unroll 1
        for (int t = 0; t < ntl; ++t) {
            const int j = AT_J(t);
            if (t + 1 < ntl) { const int jn = AT_J(t + 1); AT_GLOAD(jn); }
            const LAS unsigned char* Kb = lds + (t & 1) * AT_BUF + mp * 128; const LAS unsigned char* Vb = lds + (t & 1) * AT_BUF + AT_KSZ;
            const float dq = qh - (float)(j == 0 ? 0 : 64 * j - 48);
            f32x16 p0, p1;
#pragma unroll
            for (int r = 0; r < 16; ++r) { p0[r] = 0.f; p1[r] = 0.f; }
#pragma unroll
            for (int d0 = 0; d0 < 4; ++d0) {
                const bf16x8 a0 = *(const LAS bf16x8*)(Kb + r32 * AT_KSTR + d0 * 32 + hi * 16);
                const bf16x8 a1 = *(const LAS bf16x8*)(Kb + (32 + r32) * AT_KSTR + d0 * 32 + hi * 16);
                p0 = mfma32(a0, q[d0], p0); p1 = mfma32(a1, q[d0], p1);
            }
#pragma unroll
            for (int r = 0; r < 16; ++r) { const float dd = dq - (float)((r & 3) + 8 * (r >> 2)); p0[r] = fmaf(fabsf(dd), nslope, p0[r]); p1[r] = fmaf(fabsf(dd - 32.f), nslope, p1[r]); }
            if (j == 0) {
#pragma unroll
                for (int r = 0; r < 16; ++r) { if ((r & 3) + 8 * (r >> 2) + 4 * hi >= 16) p0[r] = -INFINITY; p1[r] = -INFINITY; }
            }
            float rm = fmaxf(p0[0], p1[0]);
#pragma unroll
            for (int r = 1; r < 16; ++r) rm = fmaxf(rm, fmaxf(p0[r], p1[r]));
            rm = fmaxf(rm, __shfl_xor(rm, 32));
            const float mn = fmaxf(mx, rm);
            if (__any(mn > mx)) {
                const float f = __builtin_amdgcn_exp2f(mx - mn); ls *= f; mx = mn;
#pragma unroll
                for (int b = 0; b < 4; ++b)
#pragma unroll
                    for (int r = 0; r < 16; ++r) O[b][r] *= f;
            }
            float sum = 0.f;
#pragma unroll
            for (int r = 0; r < 16; ++r) { p0[r] = __builtin_amdgcn_exp2f(p0[r] - mx); p1[r] = __builtin_amdgcn_exp2f(p1[r] - mx); sum += p0[r] + p1[r]; }
            ls += sum;
            bf16x8 pf[4];
#pragma unroll
            for (int k2 = 0; k2 < 2; ++k2) {
                u32x4 w0, w1;
                w0.x = cvtpk(p0[8 * k2 + 0], p0[8 * k2 + 1]); w0.y = cvtpk(p0[8 * k2 + 2], p0[8 * k2 + 3]); w0.z = cvtpk(p0[8 * k2 + 4], p0[8 * k2 + 5]); w0.w = cvtpk(p0[8 * k2 + 6], p0[8 * k2 + 7]);
                w1.x = cvtpk(p1[8 * k2 + 0], p1[8 * k2 + 1]); w1.y = cvtpk(p1[8 * k2 + 2], p1[8 * k2 + 3]); w1.z = cvtpk(p1[8 * k2 + 4], p1[8 * k2 + 5]); w1.w = cvtpk(p1[8 * k2 + 6], p1[8 * k2 + 7]);
                pf[k2] = __builtin_bit_cast(bf16x8, w0); pf[2 + k2] = __builtin_bit_cast(bf16x8, w1);
            }
#pragma unroll
            for (int ks = 0; ks < 4; ++ks)
#pragma unroll
                for (int b = 0; b < 4; ++b) {
                    const LAS unsigned char* vp = Vb + (b * 32 + r32) * AT_VSTR + ks * 32 + hi * 8;
                    const u32x2 lo = *(const LAS u32x2*)vp, hh = *(const LAS u32x2*)(vp + 16);
                    u32x4 vv; vv.x = lo.x; vv.y = lo.y; vv.z = hh.x; vv.w = hh.y;
                    O[b] = mfma32(__builtin_bit_cast(bf16x8, vv), pf[ks], O[b]);
                }
            if (t + 1 < ntl) AT_LSTORE((t + 1) & 1);
            __syncthreads();
        }
#undef AT_J
        }
    }
#undef AT_GLOAD
#undef AT_LSTORE
    const float lt = ls + __shfl_xor(ls, 32);
    const float inv = (mp ? lam : 1.0f) / lt;
    int lane2 = lane; asm volatile("" : "+v"(lane2));
    const int r32e = lane2 & 31, hie = lane2 >> 5;
    LAS float* ex = (LAS float*)lds + rg * (128 * 32) + hie * 128 + r32e;
    if (mp == 1) {
#pragma unroll
        for (int b = 0; b < 4; ++b)
#pragma unroll
            for (int r = 0; r < 16; ++r) ex[(32 * b + (r & 3) + 8 * (r >> 2)) * 32] = O[b][r] * inv;
    }
    __syncthreads();
    if (mp == 0) {
        float ss = 0.f;
#pragma unroll
        for (int b = 0; b < 4; ++b)
#pragma unroll
            for (int r = 0; r < 16; ++r) { const float o = O[b][r] * inv - ex[(32 * b + (r & 3) + 8 * (r >> 2)) * 32]; O[b][r] = o; ss += o * o; }
        ss += __shfl_xor(ss, 32);
        const float rstd = rsqrtf(ss * (1.0f / 128.0f) + 1e-5f) * 0.8f;
        const float* sg = P->in[I_SUBG] + 4 * hie; bf16* Qo = Q + (size_t)(base + qb * 128 + rg * 32 + r32e) * 512 + h * 128 + 4 * hie;
#pragma unroll
        for (int b = 0; b < 4; ++b)
#pragma unroll
            for (int r4 = 0; r4 < 4; ++r4) {
                const int n = 32 * b + 8 * r4; const f32x4 g = *(const f32x4*)(sg + n);
                u32x2 w; w.x = cvtpk(O[b][4 * r4 + 0] * rstd * g.x, O[b][4 * r4 + 1] * rstd * g.y); w.y = cvtpk(O[b][4 * r4 + 2] * rstd * g.z, O[b][4 * r4 + 3] * rstd * g.w);
                *(u32x2*)(Qo + n) = w;
            }
    }
    __syncthreads();
}

constexpr int SC_R = 0, SC_K = 16384, SC_V = 32768, SC_W = 49152, SC_B = 65536, SC_KK = 81920, SC_Y = 98304, SC_TW = 114688, SC_AD = 123904, SC_MU = 133120;
__device__ __forceinline__ float dpp_add(float v, int ctrl_id) {
    const int x = __float_as_int(v); int y;
    if (ctrl_id == 0) y = __builtin_amdgcn_update_dpp(0, x, 0xB1, 0xf, 0xf, true);
    else if (ctrl_id == 1) y = __builtin_amdgcn_update_dpp(0, x, 0x4E, 0xf, 0xf, true);
    else if (ctrl_id == 2) y = __builtin_amdgcn_update_dpp(0, x, 0x141, 0xf, 0xf, true);
    else y = __builtin_amdgcn_update_dpp(0, x, 0x140, 0xf, 0xf, true);
    return v + __int_as_float(y);
}
template <int LPR> __device__ __forceinline__ float grp_sum(float v) {
    v = dpp_add(v, 0); v = dpp_add(v, 1); v = dpp_add(v, 2);
    if (LPR == 16) v = dpp_add(v, 3);
    return v;
}
#define BAR_LDS() asm volatile("s_waitcnt lgkmcnt(0)\n\ts_barrier" ::: "memory")
__device__ __forceinline__ float fast_sigmoid(float x) { return __builtin_amdgcn_rcpf(1.0f + __builtin_amdgcn_exp2f(-LOG2E * x)); }
__device__ __forceinline__ float fast_tanh(float x) { return 1.0f - 2.0f * __builtin_amdgcn_rcpf(1.0f + __builtin_amdgcn_exp2f(2.0f * LOG2E * x)); }
template <int NRP, int NSW>
__device__ __forceinline__ void scan_unit(LAS unsigned char* lds, KP P, int s, int d, int h, int rp) {
    constexpr int RPB = 64 / NRP, RPW = RPB / NSW, LPR = 64 / RPW, CPL = 64 / LPR;
    static_assert(LPR == 8 || LPR == 16, "scan geometry");
    int tid_ = threadIdx.x; asm volatile("" : "+v"(tid_));
    const int tid = tid_, lane = tid & 63, wid = __builtin_amdgcn_readfirstlane(tid >> 6);
    const int L = seq_len(s), base = seq_base(s), Ltot = L + 16, nchunk = (Ltot + 63) / 64;
    unsigned char* ws = P->ws;
    const bf16* Rb = (const bf16*)(ws + WS_R); const bf16* KAb = (const bf16*)(ws + WS_KA); const bf16* VAb = (const bf16*)(ws + WS_VA); const bf16* Lb = (const bf16*)(ws + WS_L);
    float* CB = (float*)(ws + WS_CB); bf16* YD = (bf16*)((unsigned char*)P->out + 64 * MiB) + (size_t)d * NMAIN * 512;
    LAS float* fR = (LAS float*)(lds + SC_R); LAS float* fK = (LAS float*)(lds + SC_K); LAS float* fV = (LAS float*)(lds + SC_V); LAS float* fW = (LAS float*)(lds + SC_W);
    LAS float* fB = (LAS float*)(lds + SC_B); LAS float* fKK = (LAS float*)(lds + SC_KK); LAS float* fY = (LAS float*)(lds + SC_Y); LAS float* fMU = (LAS float*)(lds + SC_MU);
    for (int i = tid; i < 832; i += NTHREADS) {
        float v;
        if (i < 640) { const int which = i / 320, jj = i % 320, a = jj >> 6, c = jj & 63; const int gi = a < 3 ? a * 512 + h * 64 + c : 1536 + (a - 3) * 64 + c; v = P->in[which ? I_MUN : I_MUP][gi]; }
        else { const int a = (i - 640) >> 6, c = (i - 640) & 63; v = P->in[a == 0 ? I_KK : a == 1 ? I_KA : I_RK][h * 64 + c]; }
        fMU[i] = v;
    }
    const int mat = wid >> 2, ntile = wid & 3;
    const bf16* Wt = (const bf16*)(ws + WS_LORA + (mat ? 131072 : 0)) + ((size_t)d * 512 + h * 64 + ntile * 16 + (lane & 15)) * 64 + (lane >> 4) * 8;
    const bf16x8 bfr0 = *(const bf16x8*)Wt, bfr1 = *(const bf16x8*)(Wt + 32);
    const float bias = P->in[mat ? I_A0 : I_W0][d * 512 + h * 64 + ntile * 16 + (lane & 15)];
    float S[CPL];
#pragma unroll
    for (int j = 0; j < CPL; ++j) S[j] = 0.f;
    const int rowl = lane / LPR, kg = lane % LPR, srow = rp * RPB + wid * RPW + rowl;
    const int slot = tid >> 3, cg8 = (tid & 7) * 8;
    u32x4 raw[5][3];
#define SC_LOAD(c) do { const int i_ = 64 * (c) + slot; const bool ok_ = i_ < Ltot; const int p_ = ok_ ? (d ? Ltot - 1 - i_ : i_) : 0; \
        const bool okp_ = ok_ && p_ > 0, okn_ = ok_ && p_ + 1 < Ltot; \
        const unsigned rc_ = (unsigned)pos_row(base, p_), rp_ = (unsigned)pos_row(base, okp_ ? p_ - 1 : p_), rn_ = (unsigned)pos_row(base, okn_ ? p_ + 1 : p_); \
        _Pragma("unroll") for (int a_ = 0; a_ < 5; ++a_) { const unsigned char* B_ = (const unsigned char*)(a_ == 0 ? Rb : a_ == 1 ? KAb : a_ == 2 ? VAb : Lb); const unsigned ld_ = a_ < 3 ? 1024u : 512u; \
            const unsigned co_ = (unsigned)(((a_ < 3 ? h * 64 : (a_ - 3) * 64) + cg8) * 2); \
            raw[a_][0] = *(const u32x4*)(B_ + (rp_ * ld_ + co_)); raw[a_][1] = *(const u32x4*)(B_ + (rc_ * ld_ + co_)); raw[a_][2] = *(const u32x4*)(B_ + (rn_ * ld_ + co_)); } \
        if (!(okp_ && okn_)) { const u32x4 z_ = {0u, 0u, 0u, 0u}; \
            _Pragma("unroll") for (int a_ = 0; a_ < 5; ++a_) { if (!okp_) raw[a_][0] = z_; if (!ok_) raw[a_][1] = z_; if (!okn_) raw[a_][2] = z_; } } } while (0)
    SC_LOAD(0);
    BAR_LDS();
    for (int c = 0; c < nchunk; ++c) {
        const int nvalid = (Ltot - 64 * c) < 64 ? (Ltot - 64 * c) : 64;
        float rv[8], kv[8];
#pragma unroll
        for (int a = 0; a < 5; ++a) {
            float pv[8], cv[8], nv[8], o[8]; unpack8(raw[a][0], pv); unpack8(raw[a][1], cv); unpack8(raw[a][2], nv);
            const f32x4 mp0 = *(const LAS f32x4*)(fMU + a * 64 + cg8), mp1 = *(const LAS f32x4*)(fMU + a * 64 + cg8 + 4), mn0 = *(const LAS f32x4*)(fMU + 320 + a * 64 + cg8), mn1 = *(const LAS f32x4*)(fMU + 320 + a * 64 + cg8 + 4);
#pragma unroll
            for (int e = 0; e < 8; ++e) { const float mp = e < 4 ? mp0[e & 3] : mp1[e & 3], mn = e < 4 ? mn0[e & 3] : mn1[e & 3]; o[e] = cv[e] + mp * (pv[e] - cv[e]) + mn * (nv[e] - cv[e]); }
            if (a == 0) {
#pragma unroll
                for (int e = 0; e < 8; ++e) rv[e] = o[e];
                LAS float* dst = fR + slot * 64 + cg8; *(LAS f32x4*)dst = (f32x4){o[0], o[1], o[2], o[3]}; *(LAS f32x4*)(dst + 4) = (f32x4){o[4], o[5], o[6], o[7]};
            } else if (a == 1) {
#pragma unroll
                for (int e = 0; e < 8; ++e) kv[e] = o[e];
            } else if (a == 2) {
                LAS float* dst = fV + slot * 64 + cg8; *(LAS f32x4*)dst = (f32x4){o[0], o[1], o[2], o[3]}; *(LAS f32x4*)(dst + 4) = (f32x4){o[4], o[5], o[6], o[7]};
            } else {
                if (a == 3) {
#pragma unroll
                    for (int e = 0; e < 8; ++e) o[e] = fast_tanh(o[e]);
                }
                u32x4 w; w.x = cvtpk(o[0], o[1]); w.y = cvtpk(o[2], o[3]); w.z = cvtpk(o[4], o[5]); w.w = cvtpk(o[6], o[7]);
                *(LAS u32x4*)(lds + (a == 3 ? SC_TW : SC_AD) + slot * 144 + cg8 * 2) = w;
            }
        }
        BAR_LDS();
        if (c + 1 < nchunk) SC_LOAD(c + 1);
        {
            const LAS unsigned char* Ab = lds + (mat ? SC_AD : SC_TW); LAS float* fWB = mat ? fB : fW;
#pragma unroll
            for (int mt = 0; mt < 4; ++mt) {
                const bf16x8 a0 = *(const LAS bf16x8*)(Ab + (mt * 16 + (lane & 15)) * 144 + (lane >> 4) * 16);
                const bf16x8 a1 = *(const LAS bf16x8*)(Ab + (mt * 16 + (lane & 15)) * 144 + 64 + (lane >> 4) * 16);
                f32x4 acc = {0.f, 0.f, 0.f, 0.f};
                acc = __builtin_amdgcn_mfma_f32_16x16x32_bf16(a0, bfr0, acc, 0, 0, 0);
                acc = __builtin_amdgcn_mfma_f32_16x16x32_bf16(a1, bfr1, acc, 0, 0, 0);
#pragma unroll
                for (int rg = 0; rg < 4; ++rg) {
                    const int sl = mt * 16 + (lane >> 4) * 4 + rg, col = ntile * 16 + (lane & 15);
                    const float sg = fast_sigmoid(acc[rg] + bias); const float dc = __builtin_amdgcn_exp2f(-0.6065306597126334f * LOG2E * sg);
                    fWB[sl * 64 + col] = mat ? sg : dc;
                }
            }
        }
        BAR_LDS();
        {
            const f32x4 a0 = *(const LAS f32x4*)(fB + slot * 64 + cg8), a1 = *(const LAS f32x4*)(fB + slot * 64 + cg8 + 4);
            const f32x4 kk0 = *(const LAS f32x4*)(fMU + 640 + cg8), kk1 = *(const LAS f32x4*)(fMU + 640 + cg8 + 4), ka0 = *(const LAS f32x4*)(fMU + 704 + cg8), ka1 = *(const LAS f32x4*)(fMU + 704 + cg8 + 4);
            const f32x4 rk0 = *(const LAS f32x4*)(fMU + 768 + cg8), rk1 = *(const LAS f32x4*)(fMU + 768 + cg8 + 4);
            float kkv[8], kd[8], av[8]; float ssq = 0.f, cs = 0.f;
#pragma unroll
            for (int e = 0; e < 8; ++e) {
                av[e] = e < 4 ? a0[e & 3] : a1[e & 3];
                kkv[e] = kv[e] * (e < 4 ? kk0[e & 3] : kk1[e & 3]); ssq = fmaf(kkv[e], kkv[e], ssq);
                kd[e] = kv[e] * (1.0f + (av[e] - 1.0f) * (e < 4 ? ka0[e & 3] : ka1[e & 3])); cs = fmaf(rv[e] * kd[e], e < 4 ? rk0[e & 3] : rk1[e & 3], cs);
            }
            ssq = grp_sum<8>(ssq); cs = grp_sum<8>(cs);
            const float rs = rsqrtf(fmaxf(ssq, 1e-24f));
#pragma unroll
            for (int e = 0; e < 8; ++e) { kkv[e] *= rs; av[e] *= kkv[e]; }
            LAS float* o1 = fKK + slot * 64 + cg8; *(LAS f32x4*)o1 = (f32x4){kkv[0], kkv[1], kkv[2], kkv[3]}; *(LAS f32x4*)(o1 + 4) = (f32x4){kkv[4], kkv[5], kkv[6], kkv[7]};
            LAS float* o2 = fB + slot * 64 + cg8; *(LAS f32x4*)o2 = (f32x4){av[0], av[1], av[2], av[3]}; *(LAS f32x4*)(o2 + 4) = (f32x4){av[4], av[5], av[6], av[7]};
            LAS float* o3 = fK + slot * 64 + cg8; *(LAS f32x4*)o3 = (f32x4){kd[0], kd[1], kd[2], kd[3]}; *(LAS f32x4*)(o3 + 4) = (f32x4){kd[4], kd[5], kd[6], kd[7]};
            if (cg8 == 0 && rp == 0 && slot < nvalid) { const int i2 = 64 * c + slot; const int p2 = d ? Ltot - 1 - i2 : i2; CB[((size_t)d * ROWS + pos_row(base, p2)) * 8 + h] = cs; }
        }
        BAR_LDS();
        if (wid < NSW) {
            const LAS float* pk = fKK + kg * CPL; const LAS float* pw = fW + kg * CPL; const LAS float* pb = fB + kg * CPL; const LAS float* pd = fK + kg * CPL; const LAS float* pr = fR + kg * CPL;
            const LAS float* pv = fV + srow; LAS float* py = fY + srow;
            f32x4 nk[CPL / 4], nw[CPL / 4], nb[CPL / 4], nd[CPL / 4], nr[CPL / 4]; float nv;
#define SC_FETCH(sl_) do { _Pragma("unroll") for (int j_ = 0; j_ < CPL / 4; ++j_) { nk[j_] = *(const LAS f32x4*)(pk + (sl_) * 64 + 4 * j_); nw[j_] = *(const LAS f32x4*)(pw + (sl_) * 64 + 4 * j_); \
                nb[j_] = *(const LAS f32x4*)(pb + (sl_) * 64 + 4 * j_); nd[j_] = *(const LAS f32x4*)(pd + (sl_) * 64 + 4 * j_); nr[j_] = *(const LAS f32x4*)(pr + (sl_) * 64 + 4 * j_); } nv = pv[(sl_) * 64]; } while (0)
            SC_FETCH(0);
#pragma unroll 2
            for (int sl = 0; sl < nvalid; ++sl) {
                f32x4 ck[CPL / 4], cw[CPL / 4], cb[CPL / 4], cd[CPL / 4], cr[CPL / 4];
#pragma unroll
                for (int j = 0; j < CPL / 4; ++j) { ck[j] = nk[j]; cw[j] = nw[j]; cb[j] = nb[j]; cd[j] = nd[j]; cr[j] = nr[j]; }
                const float vv = nv;
                SC_FETCH(sl + 1 < 64 ? sl + 1 : 63);
                float pp0 = 0.f, pp1 = 0.f;
#pragma unroll
                for (int j = 0; j < CPL / 4; ++j) { pp0 = fmaf(S[4 * j], ck[j][0], pp0); pp1 = fmaf(S[4 * j + 1], ck[j][1], pp1); pp0 = fmaf(S[4 * j + 2], ck[j][2], pp0); pp1 = fmaf(S[4 * j + 3], ck[j][3], pp1); }
                const float pp = grp_sum<LPR>(pp0 + pp1);
                typedef float f32x2_ __attribute__((ext_vector_type(2)));
                f32x2_ ya = {0.f, 0.f};
#pragma unroll
                for (int j = 0; j < CPL / 4; ++j)
#pragma unroll
                    for (int e = 0; e < 4; e += 2) {
                        const f32x2_ b2 = {cb[j][e], cb[j][e + 1]}, d2 = {cd[j][e], cd[j][e + 1]}, w2 = {cw[j][e], cw[j][e + 1]}, r2 = {cr[j][e], cr[j][e + 1]}; f32x2_ s2 = {S[4 * j + e], S[4 * j + e + 1]};
                        const f32x2_ t2 = d2 * vv - b2 * pp; s2 = s2 * w2 + t2; ya = ya + s2 * r2; S[4 * j + e] = s2.x; S[4 * j + e + 1] = s2.y; }
                const float yy = grp_sum<LPR>(ya.x + ya.y);
                if (kg == 0) py[sl * 64] = yy;
            }
#undef SC_FETCH
        }
        BAR_LDS();
        {
            const int i2 = 64 * c + slot; const int p2 = d ? Ltot - 1 - i2 : i2;
            if (slot < nvalid && p2 >= 16 && (cg8 / RPB) == rp) {
                const LAS float* yp = fY + slot * 64 + cg8; const f32x4 y0 = *(const LAS f32x4*)yp, y1 = *(const LAS f32x4*)(yp + 4);
                *(u32x4*)(YD + (size_t)(base + p2 - 16) * 512 + h * 64 + cg8) = pack8(y0, y1);
            }
        }
    }
#undef SC_LOAD
}

__device__ __forceinline__ void phase_post(LAS unsigned char* lds, KP P) {
    const int tid = fresh_tid(), lane = tid & 63, wid = tid >> 6;
    unsigned char* ws = P->ws;
    const bf16* VAb = (const bf16*)(ws + WS_VA); const bf16* Lb = (const bf16*)(ws + WS_L); bf16* Rb = (bf16*)(ws + WS_R);
    const float* CB = (const float*)(ws + WS_CB); const bf16* YD0 = (const bf16*)((const unsigned char*)P->out + 64 * MiB); const bf16* YD1 = YD0 + (size_t)NMAIN * 512;
    const bf16* GT = (const bf16*)(ws + WS_LORA + 262144);
    LAS float* st = (LAS float*)(lds + 17408);
    const float* mup = P->in[I_MUP]; const float* mun = P->in[I_MUN];
    for (int tile = blockIdx.x; tile < NMAIN / 64; tile += gridDim.x) {
        {
            const int row = tid >> 3, hh = tid & 7, m = tile * 64 + row;
            const int t = m < 16384 ? m : (m - 16384) & 2047, Ls = m < 16384 ? 16384 : 2048;
            float sum = 0.f, sq = 0.f;
#pragma unroll
            for (int i = 0; i < 8; ++i) { float a[8], b[8]; unpack8(*(const u32x4*)(YD0 + (size_t)m * 512 + hh * 64 + i * 8), a); unpack8(*(const u32x4*)(YD1 + (size_t)m * 512 + hh * 64 + i * 8), b);
#pragma unroll
                for (int e = 0; e < 8; ++e) { const float y = a[e] + b[e]; sum += y; sq += y * y; } }
            const float mu = sum * (1.0f / 64.0f); const float var = fmaxf(sq * (1.0f / 64.0f) - mu * mu, 0.f);
            st[(row * 8 + hh) * 2] = mu; st[(row * 8 + hh) * 2 + 1] = rsqrtf(var + 64e-5f);
            const size_t rp_ = t == 0 ? (size_t)(METAROW + 15) : (size_t)(m - 1); const bool okn = t + 1 < Ls;
#pragma unroll
            for (int i = 0; i < 2; ++i) {
                const int c0 = 128 + hh * 16 + i * 8; float pv[8], cv[8], nv[8], o[8];
                unpack8(*(const u32x4*)(Lb + rp_ * 256 + c0), pv); unpack8(*(const u32x4*)(Lb + (size_t)m * 256 + c0), cv);
                if (okn) unpack8(*(const u32x4*)(Lb + (size_t)(m + 1) * 256 + c0), nv); else {
#pragma unroll
                    for (int e = 0; e < 8; ++e) nv[e] = 0.f; }
#pragma unroll
                for (int e = 0; e < 8; ++e) { const float mp = mup[1536 + c0 + e], mn = mun[1536 + c0 + e]; o[e] = sigmoidf_(cv[e] + mp * (pv[e] - cv[e]) + mn * (nv[e] - cv[e])); }
                u32x4 w; w.x = cvtpk(o[0], o[1]); w.y = cvtpk(o[2], o[3]); w.z = cvtpk(o[4], o[5]); w.w = cvtpk(o[6], o[7]);
                *(LAS u32x4*)(lds + row * 272 + (hh * 16 + i * 8) * 2) = w;
            }
        }
        __syncthreads();
#pragma unroll 1
        for (int nt = 0; nt < 4; ++nt) {
            const int col = wid * 64 + nt * 16 + (lane & 15);
            bf16x8 bfr[4];
#pragma unroll
            for (int ks = 0; ks < 4; ++ks) bfr[ks] = *(const bf16x8*)(GT + (size_t)col * 128 + ks * 32 + (lane >> 4) * 8);
            const float lw = P->in[I_LNW][col], lb = P->in[I_LNB][col];
            const float mpv = mup[1024 + col], mnv = mun[1024 + col];
#pragma unroll 1
            for (int mt = 0; mt < 4; ++mt) {
                f32x4 acc = {0.f, 0.f, 0.f, 0.f};
#pragma unroll
                for (int ks = 0; ks < 4; ++ks) { const bf16x8 a = *(const LAS bf16x8*)(lds + (mt * 16 + (lane & 15)) * 272 + ks * 64 + (lane >> 4) * 16); acc = __builtin_amdgcn_mfma_f32_16x16x32_bf16(a, bfr[ks], acc, 0, 0, 0); }
#pragma unroll
                for (int rg = 0; rg < 4; ++rg) {
                    const int row = mt * 16 + (lane >> 4) * 4 + rg, m = tile * 64 + row;
                    const int t = m < 16384 ? m : (m - 16384) & 2047, Ls = m < 16384 ? 16384 : 2048;
                    const float y = bf2f(YD0[(size_t)m * 512 + col]) + bf2f(YD1[(size_t)m * 512 + col]);
                    const float yn = (y - st[(row * 8 + wid) * 2]) * st[(row * 8 + wid) * 2 + 1] * lw + lb;
                    const float vc = bf2f(VAb[(size_t)m * 512 + col]);
                    const float vp = bf2f(VAb[(t == 0 ? (size_t)(METAROW + 15) : (size_t)(m - 1)) * 512 + col]);
                    const float vn = t + 1 < Ls ? bf2f(VAb[(size_t)(m + 1) * 512 + col]) : 0.f;
                    const float vs = vc + mpv * (vp - vc) + mnv * (vn - vc);
                    const float cb = CB[(size_t)m * 8 + wid] + CB[((size_t)ROWS + m) * 8 + wid];
                    Rb[(size_t)m * 512 + col] = (bf16)f2bf_rne((yn + cb * vs) * acc[rg]);
                }
            }
        }
        __syncthreads();
    }
}

__device__ __forceinline__ void phase_rms_bf16(KP P) {
    const int tid = fresh_tid(), lane = tid & 63, wid = tid >> 6; const int gw = blockIdx.x * 8 + wid, NGW = gridDim.x * 8;
    bf16* MN = (bf16*)(P->ws + WS_MN);
    for (int m = gw; m < NMAIN; m += NGW) rms_row_bf16(P->out + (size_t)m * DM, P->in[I_GFFN], MN + (size_t)m * DM, lane);
}
__device__ __forceinline__ void phase_final(KP P) {
    const int tid = fresh_tid(), lane = tid & 63, wid = tid >> 6; const int gw = blockIdx.x * 8 + wid, NGW = gridDim.x * 8;
    const f32x4* gr = (const f32x4*)P->in[I_GFIN] + lane;
    for (int m = gw; m < NMAIN; m += NGW) {
        f32x4* xr = (f32x4*)(P->out + (size_t)m * DM) + lane; f32x4 v[4]; float s = 0.f;
#pragma unroll
        for (int j = 0; j < 4; ++j) { v[j] = xr[64 * j]; s += (v[j].x * v[j].x + v[j].y * v[j].y) + (v[j].z * v[j].z + v[j].w * v[j].w); }
        const float rstd = rsqrtf(wave_sum(s) * (1.f / DM) + 1e-6f);
#pragma unroll
        for (int j = 0; j < 4; ++j) xr[64 * j] = v[j] * rstd * gr[64 * j];
    }
}

constexpr int NRP_LONG = 4;
constexpr int N_LONG = 16 * NRP_LONG, N_ATT_P = 512, N_ATT_S = 512, N_SHORT = 128, N_ITEMS = N_LONG + N_ATT_P + N_ATT_S + N_SHORT;

template <class Op> __device__ __forceinline__ void run_gemm(LAS unsigned char* lds, const bf16* A, const bf16* Bt, int M, int N, int K, const Op& op, const bf16* A2 = nullptr, int pm2 = 1 << 30) {
    pg8::Gemm g{A, Bt, M, N, K, A2, pm2}; pg8::StaticOrder S; S.init(M, N, (int)gridDim.x, (int)blockIdx.x);
    Epi8<Op> E{op};
    pg8::gemm_phase<Epi8<Op>, pg8::StaticOrder, true, true>(lds, g, S, E);
}

#ifndef PROBE_MASK
#define PROBE_MASK 0
#endif
#ifndef PROBE_MUL
#define PROBE_MUL 1
#endif
#define PH_BEGIN(k) unsigned long long t0_##k = 0; if (PROBE_MASK & (1 << (k))) t0_##k = __builtin_amdgcn_s_memrealtime();
#define PH_END(k) if (PROBE_MASK & (1 << (k))) { const unsigned long long t1_ = __builtin_amdgcn_s_memrealtime(); const unsigned long long dt_ = (t1_ - t0_##k) * PROBE_MUL; while (__builtin_amdgcn_s_memrealtime() - t1_ < dt_) __builtin_amdgcn_s_sleep(8); grid.sync(); }
__global__ void __launch_bounds__(NTHREADS) fwd_megakernel(Params Pin) {
    extern __shared__ __attribute__((aligned(16))) unsigned char lds_raw[];
    LAS unsigned char* lds = (LAS unsigned char*)lds_raw;
    cg::grid_group grid = cg::this_grid();
    KP P0 = (KP)__builtin_amdgcn_kernarg_segment_ptr();
#define NEWPHASE KP P = P0; asm volatile("" : "+s"(P)); unsigned char* ws = P->ws; (void)ws;

    PH_BEGIN(0)
    { NEWPHASE phase_prologue(lds, P); }
    grid.sync();
    PH_END(0)
    PH_BEGIN(1)
    { NEWPHASE run_gemm(lds, (const bf16*)P->out, (const bf16*)(ws + WS_WIN), ROWS, 3328, 1024, OpProj{ws}, (const bf16*)(ws + WS_XNMETA), 128); }
    grid.sync();
    PH_END(1)
    PH_BEGIN(2)
    { NEWPHASE
        const int tid = fresh_tid();
        float lam;
        { const int lane = tid & 63; const float s1 = wave_sum(P->in[I_LQ1][lane] * P->in[I_LK1][lane]), s2 = wave_sum(P->in[I_LQ2][lane] * P->in[I_LK2][lane]); lam = __expf(s1) - __expf(s2) + 0.2f; }
        unsigned* ctr = (unsigned*)(ws + WS_CTL);
        LAS unsigned* slot = (LAS unsigned*)(lds + LDS_ITEM_OFF);
#define FETCH(k, n) if (tid == 0) *slot = atomicAdd(ctr + 64 * (k), 1u); __syncthreads(); const int idx = (int)*slot; __syncthreads(); if (idx >= (n)) break;
#ifndef NO_SCAN
#pragma unroll 1
        for (;;) { FETCH(0, N_LONG) const int u = idx / NRP_LONG; scan_unit<NRP_LONG, 4>(lds, P, 0, u >> 3, u & 7, idx % NRP_LONG); }
#endif
#ifndef NO_ATTN
#pragma unroll 1
        for (;;) { FETCH(1, N_ATT_P + N_ATT_S)
            if (idx < N_ATT_P) attn_unit(lds, P, 0, idx >> 7, idx & 127, lam);
            else { const int a = idx - N_ATT_P; attn_unit(lds, P, 1 + (a >> 6), (a >> 4) & 3, a & 15, lam); } }
#endif
#ifndef NO_SCAN
#pragma unroll 1
        for (;;) { FETCH(2, N_SHORT) scan_unit<1, 8>(lds, P, 1 + (idx >> 4), (idx >> 3) & 1, idx & 7, 0); }
#endif
#undef FETCH
    }
    grid.sync();
    PH_END(2)
#ifndef NO_POST
    PH_BEGIN(3)
    { NEWPHASE phase_post(lds, P); }
#endif
    grid.sync();
    PH_END(3)
    PH_BEGIN(4)
    { NEWPHASE run_gemm(lds, (const bf16*)P->out, (const bf16*)(ws + WS_WIN) + (size_t)3328 * 1024, NMAIN, 2048, 1024, OpGate{ws}); }
    grid.sync();
    PH_END(4)
    PH_BEGIN(5)
    { NEWPHASE run_gemm(lds, (const bf16*)(ws + WS_R), (const bf16*)(ws + WS_WUPA), NMAIN, 1024, 512, OpUpA{ws}); }
    grid.sync();
    PH_END(5)
    PH_BEGIN(6)
    { NEWPHASE run_gemm(lds, (const bf16*)(ws + WS_Q), (const bf16*)(ws + WS_WUPB), NMAIN, 1024, 512, OpUpB{ws}); }
    grid.sync();
    PH_END(6)
    PH_BEGIN(7)
    { NEWPHASE run_gemm(lds, (const bf16*)(ws + WS_GB), (const bf16*)(ws + WS_WOUT), NMAIN, 1024, 1024, OpOut{P->in[I_XP], P->in[I_XS], P->out}); }
    grid.sync();
    PH_END(7)
    PH_BEGIN(8)
    { NEWPHASE phase_rms_bf16(P); }
    grid.sync();
    PH_END(8)
    PH_BEGIN(9)
    { NEWPHASE run_gemm(lds, (const bf16*)(ws + WS_MN), (const bf16*)(ws + WS_WFF1), 16384, DFF, 1024, OpFF1{(bf16*)(ws + WS_HID)}); }
    grid.sync();
    PH_END(9)
    PH_BEGIN(10)
    { NEWPHASE run_gemm(lds, (const bf16*)(ws + WS_HID), (const bf16*)(ws + WS_WFF2), 16384, 1024, DFF, OpFF2{P->out}); }
    grid.sync();
    PH_END(10)
    PH_BEGIN(11)
    { NEWPHASE run_gemm(lds, (const bf16*)(ws + WS_MN) + (size_t)16384 * DM, (const bf16*)(ws + WS_WFF1), 16384, DFF, 1024, OpFF1{(bf16*)(ws + WS_HID)}); }
    grid.sync();
    PH_END(11)
    PH_BEGIN(12)
    { NEWPHASE run_gemm(lds, (const bf16*)(ws + WS_HID), (const bf16*)(ws + WS_WFF2), 16384, 1024, DFF, OpFF2{P->out + (size_t)16384 * DM}); }
    grid.sync();
    PH_END(12)
    PH_BEGIN(13)
    { NEWPHASE phase_final(P); }
}

extern "C" void kernel_launch(void* const* d_in, const int* in_sizes, int n_in, void* d_out, int out_size, void* d_ws, size_t ws_size, hipStream_t stream) {
    static int grid_blocks = 0;
    if (grid_blocks == 0) {
        int dev = 0, cus = 0, per_cu = 0;
        hipGetDevice(&dev);
        hipDeviceGetAttribute(&cus, hipDeviceAttributeMultiprocessorCount, dev);
        hipFuncSetAttribute((const void*)fwd_megakernel, hipFuncAttributeMaxDynamicSharedMemorySize, LDS_BYTES);
        hipOccupancyMaxActiveBlocksPerMultiprocessor(&per_cu, (const void*)fwd_megakernel, NTHREADS, LDS_BYTES);
        if (per_cu < 1) { fprintf(stderr, "kernel_launch: occupancy query says %d blocks per CU\n", per_cu); per_cu = 1; }
        grid_blocks = cus * per_cu;
        if (n_in != 29 || ws_size < WS_END) fprintf(stderr, "kernel_launch: unexpected n_in %d / ws_size %zu\n", n_in, ws_size);
    }
    hipMemsetAsync((unsigned char*)d_ws + WS_CTL, 0, 4096, stream);
    Params p{};
    for (int i = 0; i < 29; ++i) p.in[i] = (const float*)d_in[i];
    p.out = (float*)d_out; p.ws = (unsigned char*)d_ws;
    void* args[] = {&p};
    hipError_t e = hipLaunchCooperativeKernel((const void*)fwd_megakernel, dim3(grid_blocks), dim3(NTHREADS), args, LDS_BYTES, stream);
    if (e != hipSuccess) fprintf(stderr, "cooperative launch failed: %s (grid %d)\n", hipGetErrorString(e), grid_blocks);
}
```

```cpp
#include <hip/hip_runtime.h>
#include <hip/hip_cooperative_groups.h>
#include <cstdio>
#include <cstdint>
#include <cmath>
namespace cg = cooperative_groups;
__device__ __forceinline__ int fresh_tid() { int t = threadIdx.x; asm volatile("" : "+v"(t)); return t; }
namespace pg8 {
#define PG8_LAS __attribute__((address_space(3)))
typedef unsigned short bf16_t;
typedef short bf16x8 __attribute__((ext_vector_type(8)));
typedef float f32x4 __attribute__((ext_vector_type(4)));
typedef unsigned u32x4 __attribute__((ext_vector_type(4)));
constexpr int BM = 256, BK = 64, HALF = 128, HTB = HALF * BK * 2  , STAGE_BYTES = 8 * HTB, NXCD = 8, WGM = 8;

__host__ __device__ __forceinline__ int lds_byte(int r, int c) { const int st = (r >> 4) * 2 + (c >> 5), rr = r & 15, cc = c & 31, ob = rr * 64 + cc * 2; return st * 1024 + (ob ^ (((ob >> 9) & 1) << 5)); }
__host__ __device__ __forceinline__ void stage_rc(int b, int& R, int& C) { const int st = b / 1024, sb = b % 1024, swz = sb ^ (((sb >> 9) & 1) << 5); R = (st >> 1) * 16 + swz / 64; C = (st & 1) * 32 + (swz % 64) / 2; }
__host__ __device__ __forceinline__ int perm32(int rho) { const int n = rho >> 4, i = rho & 15; return 8 * (i >> 2) + 4 * n + (i & 3); }

struct Unit { int pm, pn; };
struct Gemm { const bf16_t* A; const bf16_t* Bt; int M, N, K; const bf16_t* A2; int pm2; };
__device__ __forceinline__ const char* gemm_abase(const Gemm& g, int pm, size_t tstep) { return pm >= g.pm2 ? (const char*)g.A2 + (size_t)(pm - g.pm2) * tstep : (const char*)g.A + (size_t)pm * tstep; }

struct StaticOrder {
    int nM, nN, nwg, G, c;
    __host__ __device__ void init(int M, int N, int G_, int c_) { nM = M / BM; nN = N / BM; nwg = nM * nN; G = G_; c = c_; }
    __host__ __device__ bool next(int i, Unit& u) const {
        const long L = (long)i * G + c; if (L >= nwg) return false;
        int wgid = (int)L; { const int q = nwg / NXCD, r = nwg % NXCD, xcd = wgid % NXCD, off = wgid / NXCD; wgid = (xcd < r ? xcd * (q + 1) : r * (q + 1) + (xcd - r) * q) + off; }
        const int nig = WGM * nN, gid = wgid / nig, fm = gid * WGM, gsz = (nM - fm) < WGM ? (nM - fm) : WGM;
        u.pm = fm + ((wgid % nig) % gsz); u.pn = (wgid % nig) / gsz; return true;
    }
    __device__ __forceinline__ void a_ready(const Unit&) const {}
    __device__ __forceinline__ void done(const Unit&) const {}
};


template <class Epi, class Sched, bool ALIGN_EPI = false, bool SP2 = false>
__device__ __forceinline__ void gemm_phase(PG8_LAS unsigned char* lds, const Gemm g, const Sched& S, const Epi& E) {
    const int tid = fresh_tid(), wid = __builtin_amdgcn_readfirstlane(tid >> 6), lane = tid & 63, wr = wid >> 2, wc = wid & 3, fr = lane & 15, fq = lane >> 4;
    const int K = g.K, nt = K / BK;
    unsigned voffA[2], voffB[2];
#pragma unroll
    for (int i = 0; i < 2; ++i) { int R, C; stage_rc(tid * 16 + i * 8192, R, C); const int Rb = Epi::PERM ? ((R & ~31) + perm32(R & 31)) : R;
        voffA[i] = (unsigned)(R * K + C) * 2u; voffB[i] = (unsigned)(Rb * K + C) * 2u; }
    const size_t kstep = (size_t)(BK * 2);
    const size_t hstep = (size_t)HALF * K * 2;
    const size_t tstep = 2 * hstep;
    const unsigned ldsw = (unsigned)wid * 1024u;
    const int aoff = lds_byte(wr * 64 + fr, fq * 8), boff = lds_byte(wc * 32 + fr, fq * 8);
#define PG8_SA(b, h) (((b) * 2 + (h)) * HTB)
#define PG8_SB(b, h) ((4 + (b) * 2 + (h)) * HTB)
#define PG8_STAGE(bufoff, gbase, voff) do { _Pragma("unroll") for (int _i = 0; _i < 2; ++_i) \
        __builtin_amdgcn_global_load_lds((const unsigned*)((const char*)(gbase) + (voff)[_i]), (PG8_LAS unsigned*)(lds + (bufoff) + ldsw + _i * 8192), 16, 0, 0); } while (0)
#define PG8_LDA(dst, b, h) do { _Pragma("unroll") for (int m = 0; m < 4; ++m) _Pragma("unroll") for (int k = 0; k < 2; ++k) dst[m][k] = *(const PG8_LAS bf16x8*)(lds + PG8_SA(b, h) + aoff + m * 2048 + k * 1024); } while (0)
#define PG8_LDB(dst, b, h) do { _Pragma("unroll") for (int n = 0; n < 2; ++n) _Pragma("unroll") for (int k = 0; k < 2; ++k) dst[n][k] = *(const PG8_LAS bf16x8*)(lds + PG8_SB(b, h) + boff + n * 2048 + k * 1024); } while (0)
#define PG8_MMA(ai, bj, At, Bt) do { __builtin_amdgcn_s_setprio(1); _Pragma("unroll") for (int m = 0; m < 4; ++m) _Pragma("unroll") for (int n = 0; n < 2; ++n) _Pragma("unroll") for (int k = 0; k < 2; ++k) \
        acc[ai][bj][m][n] = __builtin_amdgcn_mfma_f32_16x16x32_bf16(Bt[n][k], At[m][k], acc[ai][bj][m][n], 0, 0, 0); __builtin_amdgcn_s_setprio(0); } while (0)
#define PG8_WAIT_V(n) asm volatile("s_waitcnt vmcnt(" #n ")" ::: "memory")
#define PG8_WAIT_L(n) asm volatile("s_waitcnt lgkmcnt(" #n ")" ::: "memory")
#define PG8_BAR __builtin_amdgcn_s_barrier()
#define PG8_SCHED __builtin_amdgcn_sched_barrier(0)
    Unit cur, nxt; int ui = 0;
    if (!S.next(0, cur)) return;
    f32x4 acc[2][2][4][2];
#pragma unroll
    for (int a = 0; a < 2; ++a)
#pragma unroll
        for (int b = 0; b < 2; ++b)
#pragma unroll
            for (int m = 0; m < 4; ++m)
#pragma unroll
                for (int n = 0; n < 2; ++n) acc[a][b][m][n] = (f32x4){0.f, 0.f, 0.f, 0.f};
    bf16x8 At[4][2], B0[2][2], B1[2][2];
    const char* cA = gemm_abase(g, cur.pm, tstep); const char* cB = (const char*)g.Bt + (size_t)cur.pn * tstep;
    S.a_ready(cur);
    if constexpr (SP2) {
        PG8_STAGE(PG8_SB(0, 0), cB, voffB); PG8_STAGE(PG8_SB(0, 1), cB + hstep, voffB); PG8_STAGE(PG8_SA(0, 0), cA, voffA); PG8_STAGE(PG8_SA(0, 1), cA + hstep, voffA);
        if (wr == 1) PG8_BAR;
        PG8_WAIT_V(2); PG8_BAR;
        PG8_STAGE(PG8_SB(1, 0), cB + kstep, voffB); PG8_STAGE(PG8_SA(1, 0), cA + kstep, voffA); PG8_STAGE(PG8_SB(1, 1), cB + hstep + kstep, voffB);
        PG8_WAIT_V(6); PG8_BAR;
    } else {
        PG8_STAGE(PG8_SB(0, 0), cB, voffB); PG8_STAGE(PG8_SA(0, 0), cA, voffA); PG8_STAGE(PG8_SB(0, 1), cB + hstep, voffB); PG8_STAGE(PG8_SA(0, 1), cA + hstep, voffA);
        if (wr == 1) PG8_BAR;
        PG8_WAIT_V(4); PG8_BAR;
        PG8_STAGE(PG8_SB(1, 0), cB + kstep, voffB); PG8_STAGE(PG8_SA(1, 0), cA + kstep, voffA); PG8_STAGE(PG8_SB(1, 1), cB + hstep + kstep, voffB);
        PG8_WAIT_V(6); PG8_BAR;
    }
    for (;;) {
        const bool has_next = S.next(ui + 1, nxt);
        const char* nA = has_next ? gemm_abase(g, nxt.pm, tstep) : cA; const char* nB = has_next ? (const char*)g.Bt + (size_t)nxt.pn * tstep : cB;
        for (int t = 0; t < nt; t += 2) {
            const bool last = (t == nt - 2);
            const char* a1 = cA + (size_t)(t + 1) * kstep;
            const char* a2 = last ? nA : cA + (size_t)(t + 2) * kstep; const char* b2 = last ? nB : cB + (size_t)(t + 2) * kstep;
            const char* a3 = a2 + kstep; const char* b3 = b2 + kstep;
            if (last && has_next) S.a_ready(nxt);
            if constexpr (SP2) {
            PG8_LDB(B0, 0, 0); PG8_LDB(B1, 0, 1); PG8_SCHED; PG8_LDA(At, 0, 0); PG8_STAGE(PG8_SA(1, 1), a1 + hstep, voffA);
            PG8_WAIT_V(8); PG8_WAIT_L(0); PG8_BAR; PG8_MMA(0, 0, At, B0); PG8_MMA(0, 1, At, B1); PG8_BAR; PG8_SCHED;
            PG8_LDA(At, 0, 1); PG8_STAGE(PG8_SB(0, 0), b2, voffB); PG8_STAGE(PG8_SB(0, 1), b2 + hstep, voffB); PG8_STAGE(PG8_SA(0, 0), a2, voffA);
            PG8_WAIT_V(8); PG8_WAIT_L(0); PG8_BAR; PG8_MMA(1, 0, At, B0); PG8_MMA(1, 1, At, B1); PG8_BAR; PG8_SCHED;
            PG8_LDB(B0, 1, 0); PG8_LDB(B1, 1, 1); PG8_SCHED; PG8_LDA(At, 1, 0); PG8_STAGE(PG8_SA(0, 1), a2 + hstep, voffA);
            PG8_WAIT_V(8); PG8_WAIT_L(0); PG8_BAR; PG8_MMA(0, 0, At, B0); PG8_MMA(0, 1, At, B1); PG8_BAR; PG8_SCHED;
            PG8_LDA(At, 1, 1); PG8_STAGE(PG8_SB(1, 0), b3, voffB); PG8_STAGE(PG8_SB(1, 1), b3 + hstep, voffB); PG8_STAGE(PG8_SA(1, 0), a3, voffA);
            PG8_WAIT_V(8); PG8_WAIT_L(0); PG8_BAR; PG8_MMA(1, 0, At, B0); PG8_MMA(1, 1, At, B1); PG8_BAR; PG8_SCHED;
            } else {
            PG8_LDB(B0, 0, 0); PG8_SCHED; PG8_LDA(At, 0, 0); PG8_STAGE(PG8_SA(1, 1), a1 + hstep, voffA);
            PG8_WAIT_L(8); PG8_BAR; PG8_WAIT_L(0); PG8_MMA(0, 0, At, B0); PG8_BAR; PG8_SCHED;
            PG8_LDB(B1, 0, 1); PG8_STAGE(PG8_SB(0, 0), b2, voffB);
            PG8_BAR; PG8_WAIT_L(0); PG8_MMA(0, 1, At, B1); PG8_BAR;
            PG8_LDA(At, 0, 1); PG8_STAGE(PG8_SA(0, 0), a2, voffA);
            PG8_BAR; PG8_WAIT_L(0); PG8_MMA(1, 0, At, B0); PG8_BAR; PG8_SCHED;
            PG8_STAGE(PG8_SB(0, 1), b2 + hstep, voffB);
            PG8_WAIT_V(6); PG8_BAR; PG8_MMA(1, 1, At, B1); PG8_BAR;
            PG8_LDB(B0, 1, 0); PG8_SCHED; PG8_LDA(At, 1, 0); PG8_STAGE(PG8_SA(0, 1), a2 + hstep, voffA);
            PG8_WAIT_L(8); PG8_BAR; PG8_WAIT_L(0); PG8_MMA(0, 0, At, B0); PG8_BAR; PG8_SCHED;
            PG8_LDB(B1, 1, 1); PG8_STAGE(PG8_SB(1, 0), b3, voffB);
            PG8_BAR; PG8_WAIT_L(0); PG8_MMA(0, 1, At, B1); PG8_BAR;
            PG8_LDA(At, 1, 1); PG8_STAGE(PG8_SA(1, 0), a3, voffA);
            PG8_BAR; PG8_WAIT_L(0); PG8_MMA(1, 0, At, B0); PG8_BAR; PG8_SCHED;
            PG8_STAGE(PG8_SB(1, 1), b3 + hstep, voffB);
            PG8_WAIT_V(6); PG8_BAR; PG8_MMA(1, 1, At, B1); PG8_BAR;
            }
        }
        if constexpr (ALIGN_EPI) { if (wr == 0) PG8_BAR; }
        if constexpr (!Epi::AFTER_DRAIN) { E(acc, cur, wr, wc, fr, fq); S.done(cur); }
        if (!has_next) break;
#pragma unroll
        for (int a = 0; a < 2; ++a)
#pragma unroll
            for (int b = 0; b < 2; ++b)
#pragma unroll
                for (int m = 0; m < 4; ++m)
#pragma unroll
                    for (int n = 0; n < 2; ++n) acc[a][b][m][n] = (f32x4){0.f, 0.f, 0.f, 0.f};
        cur = nxt; cA = nA; cB = nB; ++ui;
        if constexpr (ALIGN_EPI) { if (wr == 1) PG8_BAR; }
    }
    PG8_WAIT_V(0);
    if constexpr (!ALIGN_EPI) { if (wr == 0) PG8_BAR; }
    PG8_BAR;
    if constexpr (Epi::AFTER_DRAIN) { E.fused(acc, cur, wr, wc, fr, fq, lds, wid, lane); S.done(cur); }
#undef PG8_SA
#undef PG8_SB
#undef PG8_STAGE
#undef PG8_LDA
#undef PG8_LDB
#undef PG8_MMA
#undef PG8_WAIT_V
#undef PG8_WAIT_L
#undef PG8_BAR
#undef PG8_SCHED
}
}

#ifndef PG8_SP2
#define PG8_SP2 true
#endif

#define LAS __attribute__((address_space(3)))
typedef unsigned short bf16;
typedef short bf16x8 __attribute__((ext_vector_type(8)));
typedef float f32x4 __attribute__((ext_vector_type(4)));
typedef float f32x16 __attribute__((ext_vector_type(16)));
typedef unsigned u32x4 __attribute__((ext_vector_type(4)));
typedef unsigned u32x2 __attribute__((ext_vector_type(2)));

constexpr int DM = 1024, NMAIN = 32768, ROWS = 33024, METAROW = 32768, DFF = 4096;
constexpr int NTHREADS = 512;
constexpr int LDS_BYTES = 147456;
constexpr int LDS_ITEM_OFF = LDS_BYTES - 16;
constexpr size_t MiB = 1u << 20;
constexpr size_t WS_CTL = 0, WS_WIN = 1 * MiB, WS_WUPA = 12 * MiB, WS_WUPB = 13 * MiB, WS_WOUT = 14 * MiB, WS_WFF1 = 16 * MiB, WS_WFF2 = 24 * MiB;
constexpr size_t WS_LORA = 32 * MiB, WS_XNMETA = 32 * MiB + 512 * 1024, WS_CB = 33 * MiB, WS_ACT = 36 * MiB;
constexpr size_t ACT_SZ = (size_t)ROWS * 512 * 2, L_SZ = (size_t)ROWS * 256 * 2;
constexpr size_t WS_R = WS_ACT, WS_KA = WS_R + ACT_SZ, WS_VA = WS_KA + ACT_SZ, WS_L = WS_VA + ACT_SZ, WS_Q = WS_L + L_SZ, WS_KB = WS_Q + ACT_SZ, WS_VT = WS_KB + ACT_SZ, WS_END = WS_VT + ACT_SZ;
constexpr size_t WS_GA = WS_KA, WS_GB = WS_KB, WS_MN = WS_ACT, WS_HID = WS_ACT + 64 * MiB;
static_assert(WS_END <= 256 * MiB && WS_HID + 128 * MiB <= 256 * MiB && WS_CB + (size_t)2 * ROWS * 8 * 4 <= WS_ACT, "ws map");
constexpr float LOG2E = 1.4426950408889634f;
constexpr float QSCALE = 0.125f * LOG2E;

struct Params { const float* in[29]; float* out; unsigned char* ws; };
typedef const __attribute__((address_space(4))) Params* KP;
enum { I_XP = 0, I_XS, I_META, I_GMIX, I_WIN, I_MUP, I_MUN, I_W0, I_WUP, I_A0, I_AUP, I_GUP, I_KK, I_KA, I_RK, I_LNW, I_LNB, I_LQ1, I_LK1, I_LQ2, I_LK2, I_SUBG, I_UPA, I_UPB, I_WOUT, I_GFFN, I_FF1, I_FF2, I_GFIN };

__device__ __forceinline__ unsigned cvtpk(float lo, float hi) { unsigned r; asm volatile("v_cvt_pk_bf16_f32 %0, %1, %2" : "=v"(r) : "v"(lo), "v"(hi)); return r; }
__device__ __forceinline__ float bf2f(unsigned short b) { return __uint_as_float(((unsigned)b) << 16); }
__device__ __forceinline__ float bflo(unsigned w) { return __uint_as_float(w << 16); }
__device__ __forceinline__ float bfhi(unsigned w) { return __uint_as_float(w & 0xffff0000u); }
__device__ __forceinline__ void unpack8(const u32x4 v, float* o) { o[0] = bflo(v.x); o[1] = bfhi(v.x); o[2] = bflo(v.y); o[3] = bfhi(v.y); o[4] = bflo(v.z); o[5] = bfhi(v.z); o[6] = bflo(v.w); o[7] = bfhi(v.w); }
__device__ __forceinline__ float wave_sum(float v) {
#pragma unroll
    for (int o = 1; o < 64; o <<= 1) v += __shfl_xor(v, o);
    return v;
}
__device__ __forceinline__ float sigmoidf_(float x) { return 1.0f / (1.0f + __expf(-x)); }
__device__ __forceinline__ int seq_base(int s) { return s == 0 ? 0 : 16384 + (s - 1) * 2048; }
__device__ __forceinline__ int seq_len(int s) { return s == 0 ? 16384 : 2048; }
__device__ __forceinline__ int pos_row(int base, int p) { return p < 16 ? METAROW + p : base + p - 16; }

template <class Op> struct Epi8 {
    static constexpr bool PERM = true, AFTER_DRAIN = false;
    Op op;
    __device__ __forceinline__ void operator()(const pg8::f32x4 (&acc)[2][2][4][2], const pg8::Unit& u, int wr, int wc, int fr, int fq) const {
        const int row0 = u.pm * 256 + wr * 64 + fr, col0 = u.pn * 256 + wc * 32 + 8 * fq;
#pragma unroll
        for (int ai = 0; ai < 2; ++ai)
#pragma unroll
            for (int m = 0; m < 4; ++m)
#pragma unroll
                for (int bj = 0; bj < 2; ++bj) { op.apply(row0 + ai * 128 + m * 16, col0 + bj * 128, u.pn, acc[ai][bj][m][0], acc[ai][bj][m][1]); asm volatile("" ::: "memory"); }
    }
};
__device__ __forceinline__ u32x4 pack8(const f32x4 a, const f32x4 b) { u32x4 w; w.x = cvtpk(a[0], a[1]); w.y = cvtpk(a[2], a[3]); w.z = cvtpk(b[0], b[1]); w.w = cvtpk(b[2], b[3]); return w; }

constexpr int CW_KN = 320;
__device__ __forceinline__ float dpp_max16(float v) {
    int x = __float_as_int(v);
    v = fmaxf(v, __int_as_float(__builtin_amdgcn_update_dpp(0, x, 0xB1, 0xf, 0xf, true))); x = __float_as_int(v);
    v = fmaxf(v, __int_as_float(__builtin_amdgcn_update_dpp(0, x, 0x4E, 0xf, 0xf, true))); x = __float_as_int(v);
    v = fmaxf(v, __int_as_float(__builtin_amdgcn_update_dpp(0, x, 0x141, 0xf, 0xf, true))); x = __float_as_int(v);
    v = fmaxf(v, __int_as_float(__builtin_amdgcn_update_dpp(0, x, 0x140, 0xf, 0xf, true)));
    return v;
}
struct OpProj {
    unsigned char* ws;
    __device__ __forceinline__ void apply(int row, int col, int pn, f32x4 v0, f32x4 v1) const {
        if (pn >= 11) {
            bf16* VT = (bf16*)(ws + WS_VT); const int c = col - 11 * 256;
#pragma unroll
            for (int e = 0; e < 4; ++e) { VT[(size_t)(c + e) * ROWS + row] = (bf16)(cvtpk(v0[e], 0.f) & 0xffffu); VT[(size_t)(c + 4 + e) * ROWS + row] = (bf16)(cvtpk(v1[e], 0.f) & 0xffffu); }
            return;
        }
        bf16* O; int ldc = 512, c;
        if (pn < 2) { O = (bf16*)(ws + WS_R); c = col; }
        else if (pn < 4) { O = (bf16*)(ws + WS_KA); c = col - 512; }
        else if (pn < 6) { O = (bf16*)(ws + WS_VA); c = col - 1024; }
        else if (pn < 7) { O = (bf16*)(ws + WS_L); c = col - 1536; ldc = 256; }
        else if (pn < 9) { O = (bf16*)(ws + WS_Q); c = col - 1792; v0 = v0 * QSCALE; v1 = v1 * QSCALE; }
        else { O = (bf16*)(ws + WS_KB); c = col - 2304; }
        const u32x4 w = pack8(v0, v1);
        *(u32x4*)(O + (size_t)row * ldc + c) = w;
        if (pn >= 9) {
            float k8[8]; unpack8(w, k8); float ss = 0.f;
#pragma unroll
            for (int e = 0; e < 8; ++e) ss = fmaf(k8[e], k8[e], ss);
            ss = dpp_max16(ss);
            if ((threadIdx.x & 15) == 0) { const int sidx = row < 16384 ? 0 : row < NMAIN ? 1 + ((row - 16384) >> 11) : 9;
                atomicMax((unsigned*)(ws + WS_CTL) + CW_KN + sidx * 64 + (c >> 3), __float_as_uint(ss)); }
        }
    }
};
struct OpGate {
    unsigned char* ws;
    __device__ __forceinline__ void apply(int row, int col, int pn, f32x4 v0, f32x4 v1) const {
        bf16* O = (bf16*)(ws + (pn < 4 ? WS_GA : WS_GB)); const int c = pn < 4 ? col : col - 1024;
#pragma unroll
        for (int e = 0; e < 4; ++e) { v0[e] = sigmoidf_(v0[e]); v1[e] = sigmoidf_(v1[e]); }
        *(u32x4*)(O + (size_t)row * 1024 + c) = pack8(v0, v1);
    }
};
struct OpUpA {
    unsigned char* ws;
    __device__ __forceinline__ void apply(int row, int col, int pn, f32x4 v0, f32x4 v1) const {
        u32x4* p = (u32x4*)((bf16*)(ws + WS_GA) + (size_t)row * 1024 + col); float g[8]; unpack8(*p, g);
#pragma unroll
        for (int e = 0; e < 4; ++e) { v0[e] *= g[e]; v1[e] *= g[4 + e]; }
        *p = pack8(v0, v1);
    }
};
struct OpUpB {
    unsigned char* ws;
    __device__ __forceinline__ void apply(int row, int col, int pn, f32x4 v0, f32x4 v1) const {
        u32x4* p = (u32x4*)((bf16*)(ws + WS_GB) + (size_t)row * 1024 + col); float g[8], a[8]; unpack8(*p, g);
        unpack8(*(const u32x4*)((const bf16*)(ws + WS_GA) + (size_t)row * 1024 + col), a);
#pragma unroll
        for (int e = 0; e < 4; ++e) { v0[e] = a[e] + v0[e] * g[e]; v1[e] = a[4 + e] + v1[e] * g[4 + e]; }
        *p = pack8(v0, v1);
    }
};
struct OpOut {
    const float* xp; const float* xs; float* out;
    __device__ __forceinline__ void apply(int row, int col, int pn, f32x4 v0, f32x4 v1) const {
        const float* x = (row < 16384 ? xp + (size_t)row * DM : xs + (size_t)(row - 16384) * DM) + col;
        float* o = out + (size_t)row * DM + col;
        *(f32x4*)o = *(const f32x4*)x + v0; *(f32x4*)(o + 4) = *(const f32x4*)(x + 4) + v1;
    }
};
struct OpFF1 {
    bf16* hid;
    __device__ __forceinline__ void apply(int row, int col, int pn, f32x4 v0, f32x4 v1) const {
#pragma unroll
        for (int e = 0; e < 4; ++e) { const float a = fmaxf(v0[e], 0.f), b = fmaxf(v1[e], 0.f); v0[e] = a * a; v1[e] = b * b; }
        *(u32x4*)(hid + (size_t)row * DFF + col) = pack8(v0, v1);
    }
};
struct OpFF2 {
    float* out;
    __device__ __forceinline__ void apply(int row, int col, int pn, f32x4 v0, f32x4 v1) const {
        float* o = out + (size_t)row * DM + col;
        *(f32x4*)o = *(const f32x4*)o + v0; *(f32x4*)(o + 4) = *(const f32x4*)(o + 4) + v1;
    }
};

__device__ __forceinline__ unsigned f2bf_rne(float f) { return cvtpk(f, 0.f) & 0xffffu; }
__device__ __forceinline__ void transpose_item(const float* W, int K, int N, bf16* WT, LAS float* scr, int item, int lane) {
    const int nblk = N / 32, kb = item / nblk, nb = item % nblk, k0 = 64 * kb, n0 = 32 * nb;
#pragma unroll 8
    for (int i = 0; i < 32; ++i) { const int kk = 2 * i + (lane >> 5); scr[kk * 33 + (lane & 31)] = W[(size_t)(k0 + kk) * N + n0 + (lane & 31)]; }
    asm volatile("s_waitcnt vmcnt(0) lgkmcnt(0)" ::: "memory");
    const int c = lane & 7;
#pragma unroll
    for (int j = 0; j < 4; ++j) { const int n = (lane >> 3) + 8 * j; const LAS float* s = scr + (8 * c) * 33 + n;
        u32x4 o; o.x = cvtpk(s[0 * 33], s[1 * 33]); o.y = cvtpk(s[2 * 33], s[3 * 33]); o.z = cvtpk(s[4 * 33], s[5 * 33]); o.w = cvtpk(s[6 * 33], s[7 * 33]);
        *(u32x4*)(WT + (size_t)(n0 + n) * K + k0 + 8 * c) = o; }
    asm volatile("s_waitcnt lgkmcnt(0)" ::: "memory");
}
__device__ __forceinline__ void rms_row_bf16(const float* src, const float* g, bf16* dst, int lane) {
    unsigned long long* o8 = (unsigned long long*)dst + lane;
    if (!src) {
#pragma unroll
        for (int j = 0; j < 4; ++j) o8[64 * j] = 0ull;
        return; }
    const f32x4* xr = (const f32x4*)src + lane; const f32x4* gr = (const f32x4*)g + lane;
    f32x4 v[4]; float s = 0.f;
#pragma unroll
    for (int j = 0; j < 4; ++j) { v[j] = xr[64 * j]; s += (v[j].x * v[j].x + v[j].y * v[j].y) + (v[j].z * v[j].z + v[j].w * v[j].w); }
    const float rstd = rsqrtf(wave_sum(s) * (1.f / DM) + 1e-6f);
#pragma unroll
    for (int j = 0; j < 4; ++j) { const f32x4 gg = gr[64 * j]; const f32x4 y = v[j] * rstd * gg;
        o8[64 * j] = (unsigned long long)cvtpk(y.x, y.y) | ((unsigned long long)cvtpk(y.z, y.w) << 32); }
}
__device__ __forceinline__ void phase_prologue(LAS unsigned char* lds, KP P) {
    const int tid = fresh_tid(), lane = tid & 63, wid = tid >> 6;
    LAS float* scr = (LAS float*)(lds + wid * 16384);
    const int gw = blockIdx.x * 8 + wid, NGW = gridDim.x * 8;
    unsigned char* ws = P->ws;
    constexpr int I_IN = (1024 / 64) * (5376 / 32), I_UP = (512 / 64) * (1024 / 32), I_O = (1024 / 64) * (1024 / 32), I_1 = (1024 / 64) * (4096 / 32), I_2 = (4096 / 64) * (1024 / 32);
    constexpr int I_LW = (64 / 64) * (512 / 32), I_G = (128 / 64) * (512 / 32);
    constexpr int NITEMS = I_IN + 2 * I_UP + I_O + I_1 + I_2 + 4 * I_LW + I_G;
    for (int it = gw; it < NITEMS; it += NGW) {
        int r = it;
        if (r < I_IN) { transpose_item(P->in[I_WIN], 1024, 5376, (bf16*)(ws + WS_WIN), scr, r, lane); continue; } r -= I_IN;
        if (r < I_UP) { transpose_item(P->in[I_UPA], 512, 1024, (bf16*)(ws + WS_WUPA), scr, r, lane); continue; } r -= I_UP;
        if (r < I_UP) { transpose_item(P->in[I_UPB], 512, 1024, (bf16*)(ws + WS_WUPB), scr, r, lane); continue; } r -= I_UP;
        if (r < I_O) { transpose_item(P->in[I_WOUT], 1024, 1024, (bf16*)(ws + WS_WOUT), scr, r, lane); continue; } r -= I_O;
        if (r < I_1) { transpose_item(P->in[I_FF1], 1024, 4096, (bf16*)(ws + WS_WFF1), scr, r, lane); continue; } r -= I_1;
        if (r < I_2) { transpose_item(P->in[I_FF2], 4096, 1024, (bf16*)(ws + WS_WFF2), scr, r, lane); continue; } r -= I_2;
        if (r < 2 * I_LW) { const int d = r / I_LW; transpose_item(P->in[I_WUP] + (size_t)d * 64 * 512, 64, 512, (bf16*)(ws + WS_LORA) + (size_t)d * 512 * 64, scr, r % I_LW, lane); continue; } r -= 2 * I_LW;
        if (r < 2 * I_LW) { const int d = r / I_LW; transpose_item(P->in[I_AUP] + (size_t)d * 64 * 512, 64, 512, (bf16*)(ws + WS_LORA + 131072) + (size_t)d * 512 * 64, scr, r % I_LW, lane); continue; } r -= 2 * I_LW;
        transpose_item(P->in[I_GUP], 128, 512, (bf16*)(ws + WS_LORA + 262144), scr, r, lane);
    }
    bf16* XN = (bf16*)P->out; bf16* XM = (bf16*)(ws + WS_XNMETA);
    for (int m = gw; m < ROWS; m += NGW) {
        const float* src = m < 16384 ? P->in[I_XP] + (size_t)m * DM : m < NMAIN ? P->in[I_XS] + (size_t)(m - 16384) * DM : (m - NMAIN < 16 ? P->in[I_META] + (size_t)(m - NMAIN) * DM : nullptr);
        bf16* dst = m < NMAIN ? XN + (size_t)m * DM : XM + (size_t)(m - NMAIN) * DM;
        rms_row_bf16(src, P->in[I_GMIX], dst, lane);
    }
}

constexpr int AT_KSTR = 272, AT_VSTR = 144, AT_KSZ = 64 * AT_KSTR, AT_BUF = AT_KSZ + 128 * AT_VSTR;
__device__ __forceinline__ f32x16 mfma32(bf16x8 a, bf16x8 b, f32x16 c) { return __builtin_amdgcn_mfma_f32_32x32x16_bf16(a, b, c, 0, 0, 0); }
__device__ __forceinline__ void attn_unit(LAS unsigned char* lds, KP P, int s, int h, int qb, float lam) {
    int tid_ = threadIdx.x; asm volatile("" : "+v"(tid_));
    const int tid = tid_, lane = tid & 63, r32 = lane & 31, hi = lane >> 5, wid = __builtin_amdgcn_readfirstlane(tid >> 6), rg = wid & 3, mp = wid >> 2;
    const int L = seq_len(s), base = seq_base(s), NT = 1 + L / 64;
    unsigned char* ws = P->ws;
    const bf16* KB = (const bf16*)(ws + WS_KB); const bf16* VT = (const bf16*)(ws + WS_VT); bf16* Q = (bf16*)(ws + WS_Q);
    const int qrow = base + qb * 128 + rg * 32 + r32;
    bf16x8 q[4];
#pragma unroll
    for (int d0 = 0; d0 < 4; ++d0) q[d0] = *(const bf16x8*)(Q + (size_t)qrow * 512 + h * 128 + mp * 64 + d0 * 16 + hi * 8);
    f32x16 O[4];
#pragma unroll
    for (int b = 0; b < 4; ++b)
#pragma unroll
        for (int r = 0; r < 16; ++r) O[b][r] = 0.f;
    float mx = -INFINITY, ls = 0.f;
    const float qh = (float)(16 + qb * 128 + rg * 32 + r32 - 4 * hi);
    const float nslope = -exp2f(-2.0f * (float)(h + 1)) * LOG2E;
    const int kr0 = tid >> 4, kc = tid & 15, vn0 = tid >> 3, vc = tid & 7;
    u32x4 kreg[2], vreg[2];
    const unsigned kgo = (unsigned)((kr0 * 512 + h * 128 + kc * 8) * 2), vgo = (unsigned)(((h * 128 + vn0) * ROWS + vc * 8) * 2);
    const unsigned klo = (unsigned)(kr0 * AT_KSTR + kc * 16), vlo = (unsigned)(AT_KSZ + vn0 * AT_VSTR + vc * 16);
#define AT_GLOAD(j) do { const int m0_ = (j) == 0 ? METAROW : base + 64 * ((j) - 1); \
        const unsigned char* kt_ = (const unsigned char*)KB + (size_t)m0_ * 1024; const unsigned char* vt_ = (const unsigned char*)VT + (size_t)m0_ * 2; \
        kreg[0] = *(const u32x4*)(kt_ + kgo); kreg[1] = *(const u32x4*)(kt_ + 32 * 1024 + kgo); \
        vreg[0] = *(const u32x4*)(vt_ + vgo); vreg[1] = *(const u32x4*)(vt_ + (size_t)64 * ROWS * 2 + vgo); } while (0)
#define AT_LSTORE(buf) do { LAS unsigned char* kb_ = lds + (buf) * AT_BUF; \
        *(LAS u32x4*)(kb_ + klo) = kreg[0]; *(LAS u32x4*)(kb_ + klo + 32 * AT_KSTR) = kreg[1]; \
        *(LAS u32x4*)(kb_ + vlo) = vreg[0]; *(LAS u32x4*)(kb_ + vlo + 64 * AT_VSTR) = vreg[1]; } while (0)
    float qn, kn;
    { float ssq = 0.f;
#pragma unroll
      for (int d0 = 0; d0 < 4; ++d0) { float t[8]; unpack8(__builtin_bit_cast(u32x4, q[d0]), t);
#pragma unroll
        for (int e = 0; e < 8; ++e) ssq = fmaf(t[e], t[e], ssq); }
      ssq += __shfl_xor(ssq, 32); qn = sqrtf(ssq) * 1.002f;
      const unsigned* KN = (const unsigned*)(ws + WS_CTL) + CW_KN; float ks = 0.f;
#pragma unroll
      for (int g = 0; g < 8; ++g) ks += fmaxf(__uint_as_float(__hip_atomic_load(KN + s * 64 + h * 16 + mp * 8 + g, __ATOMIC_RELAXED, __HIP_MEMORY_SCOPE_AGENT)), __uint_as_float(__hip_atomic_load(KN + 9 * 64 + h * 16 + mp * 8 + g, __ATOMIC_RELAXED, __HIP_MEMORY_SCOPE_AGENT)));
      kn = sqrtf(ks) * 1.002f; }
    const int jc0 = 1 + qb * 2;
    int jlo = jc0, jhi = jc0 + 1;
    LAS float* red = (LAS float*)(lds + 2 * AT_BUF);
#pragma unroll 1
    for (int ph = 0; ph < 2; ++ph) {
        int nleft, ntl;
        if (ph == 0) { nleft = 0; ntl = 2; }
        else {
            float dneed = (qn * kn - mx + 40.0f) / (-nslope);
#pragma unroll
            for (int o = 1; o < 64; o <<= 1) dneed = fmaxf(dneed, __shfl_xor(dneed, o));
            if (lane == 0) red[wid] = dneed;
            __syncthreads();
            float dm = red[0];
#pragma unroll
            for (int w8 = 1; w8 < 8; ++w8) dm = fmaxf(dm, red[w8]);
            dm = fminf(fmaxf(dm, 0.f), 1.0e6f);
            const int dmax = (int)dm + 1, q0 = 16 + qb * 128;
            const int plo = q0 - dmax, phi = q0 + 127 + dmax;
            jlo = plo < 16 ? 0 : 1 + ((plo - 16) >> 6); jhi = phi >= L + 16 ? NT - 1 : 1 + ((phi - 16) >> 6);
            if (jlo > jc0) jlo = jc0; if (jhi < jc0 + 1) jhi = jc0 + 1;
            nleft = jc0 - jlo; ntl = nleft + (jhi - jc0 - 1);
        }
        if (ntl > 0) {
#define AT_J(t) (ph == 0 ? jc0 + (t) : ((t) < nleft ? jlo + (t) : jc0 + 2 + ((t) - nleft)))
        { const int jf = AT_J(0); AT_GLOAD(jf); } AT_LSTORE(0); __syncthreads();
#pragma unroll 1
        for (int t = 0; t < ntl; ++t) {
            const int j = AT_J(t);
            if (t + 1 < ntl) { const int jn = AT_J(t + 1); AT_GLOAD(jn); }
            const LAS unsigned char* Kb = lds + (t & 1) * AT_BUF + mp * 128; const LAS unsigned char* Vb = lds + (t & 1) * AT_BUF + AT_KSZ;
            const float dq = qh - (float)(j == 0 ? 0 : 64 * j - 48);
            f32x16 p0, p1;
#pragma unroll
            for (int r = 0; r < 16; ++r) { p0[r] = 0.f; p1[r] = 0.f; }
#pragma unroll
            for (int d0 = 0; d0 < 4; ++d0) {
                const bf16x8 a0 = *(const LAS bf16x8*)(Kb + r32 * AT_KSTR + d0 * 32 + hi * 16);
                const bf16x8 a1 = *(const LAS bf16x8*)(Kb + (32 + r32) * AT_KSTR + d0 * 32 + hi * 16);
                p0 = mfma32(a0, q[d0], p0); p1 = mfma32(a1, q[d0], p1);
            }
#pragma unroll
            for (int r = 0; r < 16; ++r) { const float dd = dq - (float)((r & 3) + 8 * (r >> 2)); p0[r] = fmaf(fabsf(dd), nslope, p0[r]); p1[r] = fmaf(fabsf(dd - 32.f), nslope, p1[r]); }
            if (j == 0) {
#pragma unroll
                for (int r = 0; r < 16; ++r) { if ((r & 3) + 8 * (r >> 2) + 4 * hi >= 16) p0[r] = -INFINITY; p1[r] = -INFINITY; }
            }
            float rm = fmaxf(p0[0], p1[0]);
#pragma unroll
            for (int r = 1; r < 16; ++r) rm = fmaxf(rm, fmaxf(p0[r], p1[r]));
            rm = fmaxf(rm, __shfl_xor(rm, 32));
            const float mn = fmaxf(mx, rm);
            if (__any(mn > mx)) {
                const float f = __builtin_amdgcn_exp2f(mx - mn); ls *= f; mx = mn;
#pragma unroll
                for (int b = 0; b < 4; ++b)
#pragma unroll
                    for (int r = 0; r < 16; ++r) O[b][r] *= f;
            }
            float sum = 0.f;
#pragma unroll
            for (int r = 0; r < 16; ++r) { p0[r] = __builtin_amdgcn_exp2f(p0[r] - mx); p1[r] = __builtin_amdgcn_exp2f(p1[r] - mx); sum += p0[r] + p1[r]; }
            ls += sum;
            bf16x8 pf[4];
#pragma unroll
            for (int k2 = 0; k2 < 2; ++k2) {
                u32x4 w0, w1;
                w0.x = cvtpk(p0[8 * k2 + 0], p0[8 * k2 + 1]); w0.y = cvtpk(p0[8 * k2 + 2], p0[8 * k2 + 3]); w0.z = cvtpk(p0[8 * k2 + 4], p0[8 * k2 + 5]); w0.w = cvtpk(p0[8 * k2 + 6], p0[8 * k2 + 7]);
                w1.x = cvtpk(p1[8 * k2 + 0], p1[8 * k2 + 1]); w1.y = cvtpk(p1[8 * k2 + 2], p1[8 * k2 + 3]); w1.z = cvtpk(p1[8 * k2 + 4], p1[8 * k2 + 5]); w1.w = cvtpk(p1[8 * k2 + 6], p1[8 * k2 + 7]);
                pf[k2] = __builtin_bit_cast(bf16x8, w0); pf[2 + k2] = __builtin_bit_cast(bf16x8, w1);
            }
#pragma unroll
            for (int ks = 0; ks < 4; ++ks)
#pragma unroll
                for (int b = 0; b < 4; ++b) {
                    const LAS unsigned char* vp = Vb + (b * 32 + r32) * AT_VSTR + ks * 32 + hi * 8;
                    const u32x2 lo = *(const LAS u32x2*)vp, hh = *(const LAS u32x2*)(vp + 16);
                    u32x4 vv; vv.x = lo.x; vv.y = lo.y; vv.z = hh.x; vv.w = hh.y;
                    O[b] = mfma32(__builtin_bit_cast(bf16x8, vv), pf[ks], O[b]);
                }
            if (t + 1 < ntl) AT_LSTORE((t + 1) & 1);
            __syncthreads();
        }
#undef AT_J
        }
    }
#undef AT_GLOAD
#undef AT_LSTORE
    const float lt = ls + __shfl_xor(ls, 32);
    const float inv = (mp ? lam : 1.0f) / lt;
    int lane2 = lane; asm volatile("" : "+v"(lane2));
    const int r32e = lane2 & 31, hie = lane2 >> 5;
    LAS float* ex = (LAS float*)lds + rg * (128 * 32) + hie * 128 + r32e;
    if (mp == 1) {
#pragma unroll
        for (int b = 0; b < 4; ++b)
#pragma unroll
            for (int r = 0; r < 16; ++r) ex[(32 * b + (r & 3) + 8 * (r >> 2)) * 32] = O[b][r] * inv;
    }
    __syncthreads();
    if (mp == 0) {
        float ss = 0.f;
#pragma unroll
        for (int b = 0; b < 4; ++b)
#pragma unroll
            for (int r = 0; r < 16; ++r) { const float o = O[b][r] * inv - ex[(32 * b + (r & 3) + 8 * (r >> 2)) * 32]; O[b][r] = o; ss += o * o; }
        ss += __shfl_xor(ss, 32);
        const float rstd = rsqrtf(ss * (1.0f / 128.0f) + 1e-5f) * 0.8f;
        const float* sg = P->in[I_SUBG] + 4 * hie; bf16* Qo = Q + (size_t)(base + qb * 128 + rg * 32 + r32e) * 512 + h * 128 + 4 * hie;
#pragma unroll
        for (int b = 0; b < 4; ++b)
#pragma unroll
            for (int r4 = 0; r4 < 4; ++r4) {
                const int n = 32 * b + 8 * r4; const f32x4 g = *(const f32x4*)(sg + n);
                u32x2 w; w.x = cvtpk(O[b][4 * r4 + 0] * rstd * g.x, O[b][4 * r4 + 1] * rstd * g.y); w.y = cvtpk(O[b][4 * r4 + 2] * rstd * g.z, O[b][4 * r4 + 3] * rstd * g.w);
                *(u32x2*)(Qo + n) = w;
            }
    }
    __syncthreads();
}

constexpr int SC_R = 0, SC_K = 16384, SC_V = 32768, SC_W = 49152, SC_B = 65536, SC_KK = 81920, SC_Y = 98304, SC_TW = 114688, SC_AD = 123904, SC_MU = 133120;
__device__ __forceinline__ float dpp_add(float v, int ctrl_id) {
    const int x = __float_as_int(v); int y;
    if (ctrl_id == 0) y = __builtin_amdgcn_update_dpp(0, x, 0xB1, 0xf, 0xf, true);
    else if (ctrl_id == 1) y = __builtin_amdgcn_update_dpp(0, x, 0x4E, 0xf, 0xf, true);
    else if (ctrl_id == 2) y = __builtin_amdgcn_update_dpp(0, x, 0x141, 0xf, 0xf, true);
    else y = __builtin_amdgcn_update_dpp(0, x, 0x140, 0xf, 0xf, true);
    return v + __int_as_float(y);
}
template <int LPR> __device__ __forceinline__ float grp_sum(float v) {
    v = dpp_add(v, 0); v = dpp_add(v, 1); v = dpp_add(v, 2);
    if (LPR == 16) v = dpp_add(v, 3);
    return v;
}
#define BAR_LDS() asm volatile("s_waitcnt lgkmcnt(0)\n\ts_barrier" ::: "memory")
__device__ __forceinline__ float fast_sigmoid(float x) { return __builtin_amdgcn_rcpf(1.0f + __builtin_amdgcn_exp2f(-LOG2E * x)); }
__device__ __forceinline__ float fast_tanh(float x) { return 1.0f - 2.0f * __builtin_amdgcn_rcpf(1.0f + __builtin_amdgcn_exp2f(2.0f * LOG2E * x)); }
template <int NRP, int NSW>
__device__ __forceinline__ void scan_unit(LAS unsigned char* lds, KP P, int s, int d, int h, int rp) {
    constexpr int RPB = 64 / NRP, RPW = RPB / NSW, LPR = 64 / RPW, CPL = 64 / LPR;
    static_assert(LPR == 8 || LPR == 16, "scan geometry");
    int tid_ = threadIdx.x; asm volatile("" : "+v"(tid_));
    const int tid = tid_, lane = tid & 63, wid = __builtin_amdgcn_readfirstlane(tid >> 6);
    const int L = seq_len(s), base = seq_base(s), Ltot = L + 16, nchunk = (Ltot + 63) / 64;
    unsigned char* ws = P->ws;
    const bf16* Rb = (const bf16*)(ws + WS_R); const bf16* KAb = (const bf16*)(ws + WS_KA); const bf16* VAb = (const bf16*)(ws + WS_VA); const bf16* Lb = (const bf16*)(ws + WS_L);
    float* CB = (float*)(ws + WS_CB); bf16* YD = (bf16*)((unsigned char*)P->out + 64 * MiB) + (size_t)d * NMAIN * 512;
    LAS float* fR = (LAS float*)(lds + SC_R); LAS float* fK = (LAS float*)(lds + SC_K); LAS float* fV = (LAS float*)(lds + SC_V); LAS float* fW = (LAS float*)(lds + SC_W);
    LAS float* fB = (LAS float*)(lds + SC_B); LAS float* fKK = (LAS float*)(lds + SC_KK); LAS float* fY = (LAS float*)(lds + SC_Y); LAS float* fMU = (LAS float*)(lds + SC_MU);
    for (int i = tid; i < 832; i += NTHREADS) {
        float v;
        if (i < 640) { const int which = i / 320, jj = i % 320, a = jj >> 6, c = jj & 63; const int gi = a < 3 ? a * 512 + h * 64 + c : 1536 + (a - 3) * 64 + c; v = P->in[which ? I_MUN : I_MUP][gi]; }
        else { const int a = (i - 640) >> 6, c = (i - 640) & 63; v = P->in[a == 0 ? I_KK : a == 1 ? I_KA : I_RK][h * 64 + c]; }
        fMU[i] = v;
    }
    const int mat = wid >> 2, ntile = wid & 3;
    const bf16* Wt = (const bf16*)(ws + WS_LORA + (mat ? 131072 : 0)) + ((size_t)d * 512 + h * 64 + ntile * 16 + (lane & 15)) * 64 + (lane >> 4) * 8;
    const bf16x8 bfr0 = *(const bf16x8*)Wt, bfr1 = *(const bf16x8*)(Wt + 32);
    const float bias = P->in[mat ? I_A0 : I_W0][d * 512 + h * 64 + ntile * 16 + (lane & 15)];
    float S[CPL];
#pragma unroll
    for (int j = 0; j < CPL; ++j) S[j] = 0.f;
    const int rowl = lane / LPR, kg = lane % LPR, srow = rp * RPB + wid * RPW + rowl;
    const int slot = tid >> 3, cg8 = (tid & 7) * 8;
    u32x4 raw[5][3];
#define SC_LOAD(c) do { const int i_ = 64 * (c) + slot; const bool ok_ = i_ < Ltot; const int p_ = ok_ ? (d ? Ltot - 1 - i_ : i_) : 0; \
        const bool okp_ = ok_ && p_ > 0, okn_ = ok_ && p_ + 1 < Ltot; \
        const unsigned rc_ = (unsigned)pos_row(base, p_), rp_ = (unsigned)pos_row(base, okp_ ? p_ - 1 : p_), rn_ = (unsigned)pos_row(base, okn_ ? p_ + 1 : p_); \
        _Pragma("unroll") for (int a_ = 0; a_ < 5; ++a_) { const unsigned char* B_ = (const unsigned char*)(a_ == 0 ? Rb : a_ == 1 ? KAb : a_ == 2 ? VAb : Lb); const unsigned ld_ = a_ < 3 ? 1024u : 512u; \
            const unsigned co_ = (unsigned)(((a_ < 3 ? h * 64 : (a_ - 3) * 64) + cg8) * 2); \
            raw[a_][0] = *(const u32x4*)(B_ + (rp_ * ld_ + co_)); raw[a_][1] = *(const u32x4*)(B_ + (rc_ * ld_ + co_)); raw[a_][2] = *(const u32x4*)(B_ + (rn_ * ld_ + co_)); } \
        if (!(okp_ && okn_)) { const u32x4 z_ = {0u, 0u, 0u, 0u}; \
            _Pragma("unroll") for (int a_ = 0; a_ < 5; ++a_) { if (!okp_) raw[a_][0] = z_; if (!ok_) raw[a_][1] = z_; if (!okn_) raw[a_][2] = z_; } } } while (0)
    SC_LOAD(0);
    BAR_LDS();
    for (int c = 0; c < nchunk; ++c) {
        const int nvalid = (Ltot - 64 * c) < 64 ? (Ltot - 64 * c) : 64;
        float rv[8], kv[8];
#pragma unroll
        for (int a = 0; a < 5; ++a) {
            float pv[8], cv[8], nv[8], o[8]; unpack8(raw[a][0], pv); unpack8(raw[a][1], cv); unpack8(raw[a][2], nv);
            const f32x4 mp0 = *(const LAS f32x4*)(fMU + a * 64 + cg8), mp1 = *(const LAS f32x4*)(fMU + a * 64 + cg8 + 4), mn0 = *(const LAS f32x4*)(fMU + 320 + a * 64 + cg8), mn1 = *(const LAS f32x4*)(fMU + 320 + a * 64 + cg8 + 4);
#pragma unroll
            for (int e = 0; e < 8; ++e) { const float mp = e < 4 ? mp0[e & 3] : mp1[e & 3], mn = e < 4 ? mn0[e & 3] : mn1[e & 3]; o[e] = cv[e] + mp * (pv[e] - cv[e]) + mn * (nv[e] - cv[e]); }
            if (a == 0) {
#pragma unroll
                for (int e = 0; e < 8; ++e) rv[e] = o[e];
                LAS float* dst = fR + slot * 64 + cg8; *(LAS f32x4*)dst = (f32x4){o[0], o[1], o[2], o[3]}; *(LAS f32x4*)(dst + 4) = (f32x4){o[4], o[5], o[6], o[7]};
            } else if (a == 1) {
#pragma unroll
                for (int e = 0; e < 8; ++e) kv[e] = o[e];
            } else if (a == 2) {
                LAS float* dst = fV + slot * 64 + cg8; *(LAS f32x4*)dst = (f32x4){o[0], o[1], o[2], o[3]}; *(LAS f32x4*)(dst + 4) = (f32x4){o[4], o[5], o[6], o[7]};
            } else {
                if (a == 3) {
#pragma unroll
                    for (int e = 0; e < 8; ++e) o[e] = fast_tanh(o[e]);
                }
                u32x4 w; w.x = cvtpk(o[0], o[1]); w.y = cvtpk(o[2], o[3]); w.z = cvtpk(o[4], o[5]); w.w = cvtpk(o[6], o[7]);
                *(LAS u32x4*)(lds + (a == 3 ? SC_TW : SC_AD) + slot * 144 + cg8 * 2) = w;
            }
        }
        BAR_LDS();
        if (c + 1 < nchunk) SC_LOAD(c + 1);
        {
            const LAS unsigned char* Ab = lds + (mat ? SC_AD : SC_TW); LAS float* fWB = mat ? fB : fW;
#pragma unroll
            for (int mt = 0; mt < 4; ++mt) {
                const bf16x8 a0 = *(const LAS bf16x8*)(Ab + (mt * 16 + (lane & 15)) * 144 + (lane >> 4) * 16);
                const bf16x8 a1 = *(const LAS bf16x8*)(Ab + (mt * 16 + (lane & 15)) * 144 + 64 + (lane >> 4) * 16);
                f32x4 acc = {0.f, 0.f, 0.f, 0.f};
                acc = __builtin_amdgcn_mfma_f32_16x16x32_bf16(a0, bfr0, acc, 0, 0, 0);
                acc = __builtin_amdgcn_mfma_f32_16x16x32_bf16(a1, bfr1, acc, 0, 0, 0);
#pragma unroll
                for (int rg = 0; rg < 4; ++rg) {
                    const int sl = mt * 16 + (lane >> 4) * 4 + rg, col = ntile * 16 + (lane & 15);
                    const float sg = fast_sigmoid(acc[rg] + bias); const float dc = __builtin_amdgcn_exp2f(-0.6065306597126334f * LOG2E * sg);
                    fWB[sl * 64 + col] = mat ? sg : dc;
                }
            }
        }
        BAR_LDS();
        {
            const f32x4 a0 = *(const LAS f32x4*)(fB + slot * 64 + cg8), a1 = *(const LAS f32x4*)(fB + slot * 64 + cg8 + 4);
            const f32x4 kk0 = *(const LAS f32x4*)(fMU + 640 + cg8), kk1 = *(const LAS f32x4*)(fMU + 640 + cg8 + 4), ka0 = *(const LAS f32x4*)(fMU + 704 + cg8), ka1 = *(const LAS f32x4*)(fMU + 704 + cg8 + 4);
            const f32x4 rk0 = *(const LAS f32x4*)(fMU + 768 + cg8), rk1 = *(const LAS f32x4*)(fMU + 768 + cg8 + 4);
            float kkv[8], kd[8], av[8]; float ssq = 0.f, cs = 0.f;
#pragma unroll
            for (int e = 0; e < 8; ++e) {
                av[e] = e < 4 ? a0[e & 3] : a1[e & 3];
                kkv[e] = kv[e] * (e < 4 ? kk0[e & 3] : kk1[e & 3]); ssq = fmaf(kkv[e], kkv[e], ssq);
                kd[e] = kv[e] * (1.0f + (av[e] - 1.0f) * (e < 4 ? ka0[e & 3] : ka1[e & 3])); cs = fmaf(rv[e] * kd[e], e < 4 ? rk0[e & 3] : rk1[e & 3], cs);
            }
            ssq = grp_sum<8>(ssq); cs = grp_sum<8>(cs);
            const float rs = rsqrtf(fmaxf(ssq, 1e-24f));
#pragma unroll
            for (int e = 0; e < 8; ++e) { kkv[e] *= rs; av[e] *= kkv[e]; }
            LAS float* o1 = fKK + slot * 64 + cg8; *(LAS f32x4*)o1 = (f32x4){kkv[0], kkv[1], kkv[2], kkv[3]}; *(LAS f32x4*)(o1 + 4) = (f32x4){kkv[4], kkv[5], kkv[6], kkv[7]};
            LAS float* o2 = fB + slot * 64 + cg8; *(LAS f32x4*)o2 = (f32x4){av[0], av[1], av[2], av[3]}; *(LAS f32x4*)(o2 + 4) = (f32x4){av[4], av[5], av[6], av[7]};
            LAS float* o3 = fK + slot * 64 + cg8; *(LAS f32x4*)o3 = (f32x4){kd[0], kd[1], kd[2], kd[3]}; *(LAS f32x4*)(o3 + 4) = (f32x4){kd[4], kd[5], kd[6], kd[7]};
            if (cg8 == 0 && rp == 0 && slot < nvalid) { const int i2 = 64 * c + slot; const int p2 = d ? Ltot - 1 - i2 : i2; CB[((size_t)d * ROWS + pos_row(base, p2)) * 8 + h] = cs; }
        }
        BAR_LDS();
        if (wid < NSW) {
            const LAS float* pk = fKK + kg * CPL; const LAS float* pw = fW + kg * CPL; const LAS float* pb = fB + kg * CPL; const LAS float* pd = fK + kg * CPL; const LAS float* pr = fR + kg * CPL;
            const LAS float* pv = fV + srow; LAS float* py = fY + srow;
            f32x4 nk[CPL / 4], nw[CPL / 4], nb[CPL / 4], nd[CPL / 4], nr[CPL / 4]; float nv;
#define SC_FETCH(sl_) do { _Pragma("unroll") for (int j_ = 0; j_ < CPL / 4; ++j_) { nk[j_] = *(const LAS f32x4*)(pk + (sl_) * 64 + 4 * j_); nw[j_] = *(const LAS f32x4*)(pw + (sl_) * 64 + 4 * j_); \
                nb[j_] = *(const LAS f32x4*)(pb + (sl_) * 64 + 4 * j_); nd[j_] = *(const LAS f32x4*)(pd + (sl_) * 64 + 4 * j_); nr[j_] = *(const LAS f32x4*)(pr + (sl_) * 64 + 4 * j_); } nv = pv[(sl_) * 64]; } while (0)
            SC_FETCH(0);
#pragma unroll 4
            for (int sl = 0; sl < nvalid; ++sl) {
                f32x4 ck[CPL / 4], cw[CPL / 4], cb[CPL / 4], cd[CPL / 4], cr[CPL / 4];
#pragma unroll
                for (int j = 0; j < CPL / 4; ++j) { ck[j] = nk[j]; cw[j] = nw[j]; cb[j] = nb[j]; cd[j] = nd[j]; cr[j] = nr[j]; }
                const float vv = nv;
                SC_FETCH(sl + 1 < 64 ? sl + 1 : 63);
                float pp0 = 0.f, pp1 = 0.f;
#pragma unroll
                for (int j = 0; j < CPL / 4; ++j) { pp0 = fmaf(S[4 * j], ck[j][0], pp0); pp1 = fmaf(S[4 * j + 1], ck[j][1], pp1); pp0 = fmaf(S[4 * j + 2], ck[j][2], pp0); pp1 = fmaf(S[4 * j + 3], ck[j][3], pp1); }
                const float pp = grp_sum<LPR>(pp0 + pp1);
                typedef float f32x2_ __attribute__((ext_vector_type(2)));
                f32x2_ ya = {0.f, 0.f};
#pragma unroll
                for (int j = 0; j < CPL / 4; ++j)
#pragma unroll
                    for (int e = 0; e < 4; e += 2) {
                        const f32x2_ b2 = {cb[j][e], cb[j][e + 1]}, d2 = {cd[j][e], cd[j][e + 1]}, w2 = {cw[j][e], cw[j][e + 1]}, r2 = {cr[j][e], cr[j][e + 1]}; f32x2_ s2 = {S[4 * j + e], S[4 * j + e + 1]};
                        const f32x2_ t2 = d2 * vv - b2 * pp; s2 = s2 * w2 + t2; ya = ya + s2 * r2; S[4 * j + e] = s2.x; S[4 * j + e + 1] = s2.y; }
                const float yy = grp_sum<LPR>(ya.x + ya.y);
                if (kg == 0) py[sl * 64] = yy;
            }
#undef SC_FETCH
        }
        BAR_LDS();
        {
            const int i2 = 64 * c + slot; const int p2 = d ? Ltot - 1 - i2 : i2;
            if (slot < nvalid && p2 >= 16 && (cg8 / RPB) == rp) {
                const LAS float* yp = fY + slot * 64 + cg8; const f32x4 y0 = *(const LAS f32x4*)yp, y1 = *(const LAS f32x4*)(yp + 4);
                *(u32x4*)(YD + (size_t)(base + p2 - 16) * 512 + h * 64 + cg8) = pack8(y0, y1);
            }
        }
    }
#undef SC_LOAD
}

__device__ __forceinline__ void phase_post(LAS unsigned char* lds, KP P) {
    const int tid = fresh_tid(), lane = tid & 63, wid = tid >> 6;
    unsigned char* ws = P->ws;
    const bf16* VAb = (const bf16*)(ws + WS_VA); const bf16* Lb = (const bf16*)(ws + WS_L); bf16* Rb = (bf16*)(ws + WS_R);
    const float* CB = (const float*)(ws + WS_CB); const bf16* YD0 = (const bf16*)((const unsigned char*)P->out + 64 * MiB); const bf16* YD1 = YD0 + (size_t)NMAIN * 512;
    const bf16* GT = (const bf16*)(ws + WS_LORA + 262144);
    LAS float* st = (LAS float*)(lds + 17408);
    const float* mup = P->in[I_MUP]; const float* mun = P->in[I_MUN];
    for (int tile = blockIdx.x; tile < NMAIN / 64; tile += gridDim.x) {
        {
            const int row = tid >> 3, hh = tid & 7, m = tile * 64 + row;
            const int t = m < 16384 ? m : (m - 16384) & 2047, Ls = m < 16384 ? 16384 : 2048;
            float sum = 0.f, sq = 0.f;
#pragma unroll
            for (int i = 0; i < 8; ++i) { float a[8], b[8]; unpack8(*(const u32x4*)(YD0 + (size_t)m * 512 + hh * 64 + i * 8), a); unpack8(*(const u32x4*)(YD1 + (size_t)m * 512 + hh * 64 + i * 8), b);
#pragma unroll
                for (int e = 0; e < 8; ++e) { const float y = a[e] + b[e]; sum += y; sq += y * y; } }
            const float mu = sum * (1.0f / 64.0f); const float var = fmaxf(sq * (1.0f / 64.0f) - mu * mu, 0.f);
            st[(row * 8 + hh) * 2] = mu; st[(row * 8 + hh) * 2 + 1] = rsqrtf(var + 64e-5f);
            const size_t rp_ = t == 0 ? (size_t)(METAROW + 15) : (size_t)(m - 1); const bool okn = t + 1 < Ls;
#pragma unroll
            for (int i = 0; i < 2; ++i) {
                const int c0 = 128 + hh * 16 + i * 8; float pv[8], cv[8], nv[8], o[8];
                unpack8(*(const u32x4*)(Lb + rp_ * 256 + c0), pv); unpack8(*(const u32x4*)(Lb + (size_t)m * 256 + c0), cv);
                if (okn) unpack8(*(const u32x4*)(Lb + (size_t)(m + 1) * 256 + c0), nv); else {
#pragma unroll
                    for (int e = 0; e < 8; ++e) nv[e] = 0.f; }
#pragma unroll
                for (int e = 0; e < 8; ++e) { const float mp = mup[1536 + c0 + e], mn = mun[1536 + c0 + e]; o[e] = sigmoidf_(cv[e] + mp * (pv[e] - cv[e]) + mn * (nv[e] - cv[e])); }
                u32x4 w; w.x = cvtpk(o[0], o[1]); w.y = cvtpk(o[2], o[3]); w.z = cvtpk(o[4], o[5]); w.w = cvtpk(o[6], o[7]);
                *(LAS u32x4*)(lds + row * 272 + (hh * 16 + i * 8) * 2) = w;
            }
        }
        __syncthreads();
#pragma unroll 1
        for (int nt = 0; nt < 4; ++nt) {
            const int col = wid * 64 + nt * 16 + (lane & 15);
            bf16x8 bfr[4];
#pragma unroll
            for (int ks = 0; ks < 4; ++ks) bfr[ks] = *(const bf16x8*)(GT + (size_t)col * 128 + ks * 32 + (lane >> 4) * 8);
            const float lw = P->in[I_LNW][col], lb = P->in[I_LNB][col];
            const float mpv = mup[1024 + col], mnv = mun[1024 + col];
#pragma unroll 1
            for (int mt = 0; mt < 4; ++mt) {
                f32x4 acc = {0.f, 0.f, 0.f, 0.f};
#pragma unroll
                for (int ks = 0; ks < 4; ++ks) { const bf16x8 a = *(const LAS bf16x8*)(lds + (mt * 16 + (lane & 15)) * 272 + ks * 64 + (lane >> 4) * 16); acc = __builtin_amdgcn_mfma_f32_16x16x32_bf16(a, bfr[ks], acc, 0, 0, 0); }
#pragma unroll
                for (int rg = 0; rg < 4; ++rg) {
                    const int row = mt * 16 + (lane >> 4) * 4 + rg, m = tile * 64 + row;
                    const int t = m < 16384 ? m : (m - 16384) & 2047, Ls = m < 16384 ? 16384 : 2048;
                    const float y = bf2f(YD0[(size_t)m * 512 + col]) + bf2f(YD1[(size_t)m * 512 + col]);
                    const float yn = (y - st[(row * 8 + wid) * 2]) * st[(row * 8 + wid) * 2 + 1] * lw + lb;
                    const float vc = bf2f(VAb[(size_t)m * 512 + col]);
                    const float vp = bf2f(VAb[(t == 0 ? (size_t)(METAROW + 15) : (size_t)(m - 1)) * 512 + col]);
                    const float vn = t + 1 < Ls ? bf2f(VAb[(size_t)(m + 1) * 512 + col]) : 0.f;
                    const float vs = vc + mpv * (vp - vc) + mnv * (vn - vc);
                    const float cb = CB[(size_t)m * 8 + wid] + CB[((size_t)ROWS + m) * 8 + wid];
                    Rb[(size_t)m * 512 + col] = (bf16)f2bf_rne((yn + cb * vs) * acc[rg]);
                }
            }
        }
        __syncthreads();
    }
}

__device__ __forceinline__ void phase_rms_bf16(KP P) {
    const int tid = fresh_tid(), lane = tid & 63, wid = tid >> 6; const int gw = blockIdx.x * 8 + wid, NGW = gridDim.x * 8;
    bf16* MN = (bf16*)(P->ws + WS_MN);
    for (int m = gw; m < NMAIN; m += NGW) rms_row_bf16(P->out + (size_t)m * DM, P->in[I_GFFN], MN + (size_t)m * DM, lane);
}
__device__ __forceinline__ void phase_final(KP P) {
    const int tid = fresh_tid(), lane = tid & 63, wid = tid >> 6; const int gw = blockIdx.x * 8 + wid, NGW = gridDim.x * 8;
    const f32x4* gr = (const f32x4*)P->in[I_GFIN] + lane;
    for (int m = gw; m < NMAIN; m += NGW) {
        f32x4* xr = (f32x4*)(P->out + (size_t)m * DM) + lane; f32x4 v[4]; float s = 0.f;
#pragma unroll
        for (int j = 0; j < 4; ++j) { v[j] = xr[64 * j]; s += (v[j].x * v[j].x + v[j].y * v[j].y) + (v[j].z * v[j].z + v[j].w * v[j].w); }
        const float rstd = rsqrtf(wave_sum(s) * (1.f / DM) + 1e-6f);
#pragma unroll
        for (int j = 0; j < 4; ++j) xr[64 * j] = v[j] * rstd * gr[64 * j];
    }
}

constexpr int NRP_LONG = 4;
constexpr int N_LONG = 16 * NRP_LONG, N_ATT_P = 512, N_ATT_S = 512, N_SHORT = 128, N_ITEMS = N_LONG + N_ATT_P + N_ATT_S + N_SHORT;

template <class Op> __device__ __forceinline__ void run_gemm(LAS unsigned char* lds, const bf16* A, const bf16* Bt, int M, int N, int K, const Op& op, const bf16* A2 = nullptr, int pm2 = 1 << 30) {
    pg8::Gemm g{A, Bt, M, N, K, A2, pm2}; pg8::StaticOrder S; S.init(M, N, (int)gridDim.x, (int)blockIdx.x);
    Epi8<Op> E{op};
    pg8::gemm_phase<Epi8<Op>, pg8::StaticOrder, true, true>(lds, g, S, E);
}

#ifndef PROBE_MASK
#define PROBE_MASK 0
#endif
#ifndef PROBE_MUL
#define PROBE_MUL 1
#endif
#define PH_BEGIN(k) unsigned long long t0_##k = 0; if (PROBE_MASK & (1 << (k))) t0_##k = __builtin_amdgcn_s_memrealtime();
#define PH_END(k) if (PROBE_MASK & (1 << (k))) { const unsigned long long t1_ = __builtin_amdgcn_s_memrealtime(); const unsigned long long dt_ = (t1_ - t0_##k) * PROBE_MUL; while (__builtin_amdgcn_s_memrealtime() - t1_ < dt_) __builtin_amdgcn_s_sleep(8); grid.sync(); }
__global__ void __launch_bounds__(NTHREADS) fwd_megakernel(Params Pin) {
    extern __shared__ __attribute__((aligned(16))) unsigned char lds_raw[];
    LAS unsigned char* lds = (LAS unsigned char*)lds_raw;
    cg::grid_group grid = cg::this_grid();
    KP P0 = (KP)__builtin_amdgcn_kernarg_segment_ptr();
#define NEWPHASE KP P = P0; asm volatile("" : "+s"(P)); unsigned char* ws = P->ws; (void)ws;

    PH_BEGIN(0)
    { NEWPHASE phase_prologue(lds, P); }
    grid.sync();
    PH_END(0)
    PH_BEGIN(1)
    { NEWPHASE run_gemm(lds, (const bf16*)P->out, (const bf16*)(ws + WS_WIN), ROWS, 3328, 1024, OpProj{ws}, (const bf16*)(ws + WS_XNMETA), 128); }
    grid.sync();
    PH_END(1)
    PH_BEGIN(2)
    { NEWPHASE
        const int tid = fresh_tid();
        float lam;
        { const int lane = tid & 63; const float s1 = wave_sum(P->in[I_LQ1][lane] * P->in[I_LK1][lane]), s2 = wave_sum(P->in[I_LQ2][lane] * P->in[I_LK2][lane]); lam = __expf(s1) - __expf(s2) + 0.2f; }
        unsigned* ctr = (unsigned*)(ws + WS_CTL);
        LAS unsigned* slot = (LAS unsigned*)(lds + LDS_ITEM_OFF);
#define FETCH(k, n) if (tid == 0) *slot = atomicAdd(ctr + 64 * (k), 1u); __syncthreads(); const int idx = (int)*slot; __syncthreads(); if (idx >= (n)) break;
#ifndef NO_SCAN
#pragma unroll 1
        for (;;) { FETCH(0, N_LONG) const int u = idx / NRP_LONG; scan_unit<NRP_LONG, 4>(lds, P, 0, u >> 3, u & 7, idx % NRP_LONG); }
#endif
#ifndef NO_ATTN
#pragma unroll 1
        for (;;) { FETCH(1, N_ATT_P + N_ATT_S)
            if (idx < N_ATT_P) attn_unit(lds, P, 0, idx >> 7, idx & 127, lam);
            else { const int a = idx - N_ATT_P; attn_unit(lds, P, 1 + (a >> 6), (a >> 4) & 3, a & 15, lam); } }
#endif
#ifndef NO_SCAN
#pragma unroll 1
        for (;;) { FETCH(2, N_SHORT) scan_unit<1, 8>(lds, P, 1 + (idx >> 4), (idx >> 3) & 1, idx & 7, 0); }
#endif
#undef FETCH
    }
    grid.sync();
    PH_END(2)
#ifndef NO_POST
    PH_BEGIN(3)
    { NEWPHASE phase_post(lds, P); }
#endif
    grid.sync();
    PH_END(3)
    PH_BEGIN(4)
    { NEWPHASE run_gemm(lds, (const bf16*)P->out, (const bf16*)(ws + WS_WIN) + (size_t)3328 * 1024, NMAIN, 2048, 1024, OpGate{ws}); }
    grid.sync();
    PH_END(4)
    PH_BEGIN(5)
    { NEWPHASE run_gemm(lds, (const bf16*)(ws + WS_R), (const bf16*)(ws + WS_WUPA), NMAIN, 1024, 512, OpUpA{ws}); }
    grid.sync();
    PH_END(5)
    PH_BEGIN(6)
    { NEWPHASE run_gemm(lds, (const bf16*)(ws + WS_Q), (const bf16*)(ws + WS_WUPB), NMAIN, 1024, 512, OpUpB{ws}); }
    grid.sync();
    PH_END(6)
    PH_BEGIN(7)
    { NEWPHASE run_gemm(lds, (const bf16*)(ws + WS_GB), (const bf16*)(ws + WS_WOUT), NMAIN, 1024, 1024, OpOut{P->in[I_XP], P->in[I_XS], P->out}); }
    grid.sync();
    PH_END(7)
    PH_BEGIN(8)
    { NEWPHASE phase_rms_bf16(P); }
    grid.sync();
    PH_END(8)
    PH_BEGIN(9)
    { NEWPHASE run_gemm(lds, (const bf16*)(ws + WS_MN), (const bf16*)(ws + WS_WFF1), 16384, DFF, 1024, OpFF1{(bf16*)(ws + WS_HID)}); }
    grid.sync();
    PH_END(9)
    PH_BEGIN(10)
    { NEWPHASE run_gemm(lds, (const bf16*)(ws + WS_HID), (const bf16*)(ws + WS_WFF2), 16384, 1024, DFF, OpFF2{P->out}); }
    grid.sync();
    PH_END(10)
    PH_BEGIN(11)
    { NEWPHASE run_gemm(lds, (const bf16*)(ws + WS_MN) + (size_t)16384 * DM, (const bf16*)(ws + WS_WFF1), 16384, DFF, 1024, OpFF1{(bf16*)(ws + WS_HID)}); }
    grid.sync();
    PH_END(11)
    PH_BEGIN(12)
    { NEWPHASE run_gemm(lds, (const bf16*)(ws + WS_HID), (const bf16*)(ws + WS_WFF2), 16384, 1024, DFF, OpFF2{P->out + (size_t)16384 * DM}); }
    grid.sync();
    PH_END(12)
    PH_BEGIN(13)
    { NEWPHASE phase_final(P); }
}

extern "C" void kernel_launch(void* const* d_in, const int* in_sizes, int n_in, void* d_out, int out_size, void* d_ws, size_t ws_size, hipStream_t stream) {
    static int grid_blocks = 0;
    if (grid_blocks == 0) {
        int dev = 0, cus = 0, per_cu = 0;
        hipGetDevice(&dev);
        hipDeviceGetAttribute(&cus, hipDeviceAttributeMultiprocessorCount, dev);
        hipFuncSetAttribute((const void*)fwd_megakernel, hipFuncAttributeMaxDynamicSharedMemorySize, LDS_BYTES);
        hipOccupancyMaxActiveBlocksPerMultiprocessor(&per_cu, (const void*)fwd_megakernel, NTHREADS, LDS_BYTES);
        if (per_cu < 1) { fprintf(stderr, "kernel_launch: occupancy query says %d blocks per CU\n", per_cu); per_cu = 1; }
        grid_blocks = cus * per_cu;
        if (n_in != 29 || ws_size < WS_END) fprintf(stderr, "kernel_launch: unexpected n_in %d / ws_size %zu\n", n_in, ws_size);
    }
    hipMemsetAsync((unsigned char*)d_ws + WS_CTL, 0, 4096, stream);
    Params p{};
    for (int i = 0; i < 29; ++i) p.in[i] = (const float*)d_in[i];
    p.out = (float*)d_out; p.ws = (unsigned char*)d_ws;
    void* args[] = {&p};
    hipError_t e = hipLaunchCooperativeKernel((const void*)fwd_megakernel, dim3(grid_blocks), dim3(NTHREADS), args, LDS_BYTES, stream);
    if (e != hipSuccess) fprintf(stderr, "cooperative launch failed: %s (grid %d)\n", hipGetErrorString(e), grid_blocks);
}
```

```cpp
#include <hip/hip_runtime.h>
#include <hip/hip_cooperative_groups.h>
#include <cstdio>
#include <cstdint>
#include <cmath>
namespace cg = cooperative_groups;
__device__ __forceinline__ int fresh_tid() { int t = threadIdx.x; asm volatile("" : "+v"(t)); return t; }
namespace pg8 {
#define PG8_LAS __attribute__((address_space(3)))
typedef unsigned short bf16_t;
typedef short bf16x8 __attribute__((ext_vector_type(8)));
typedef float f32x4 __attribute__((ext_vector_type(4)));
typedef unsigned u32x4 __attribute__((ext_vector_type(4)));
constexpr int BM = 256, BK = 64, HALF = 128, HTB = HALF * BK * 2  , STAGE_BYTES = 8 * HTB, NXCD = 8, WGM = 8;

__host__ __device__ __forceinline__ int lds_byte(int r, int c) { const int st = (r >> 4) * 2 + (c >> 5), rr = r & 15, cc = c & 31, ob = rr * 64 + cc * 2; return st * 1024 + (ob ^ (((ob >> 9) & 1) << 5)); }
__host__ __device__ __forceinline__ void stage_rc(int b, int& R, int& C) { const int st = b / 1024, sb = b % 1024, swz = sb ^ (((sb >> 9) & 1) << 5); R = (st >> 1) * 16 + swz / 64; C = (st & 1) * 32 + (swz % 64) / 2; }
__host__ __device__ __forceinline__ int perm32(int rho) { const int n = rho >> 4, i = rho & 15; return 8 * (i >> 2) + 4 * n + (i & 3); }

struct Unit { int pm, pn; };
struct Gemm { const bf16_t* A; const bf16_t* Bt; int M, N, K; const bf16_t* A2; int pm2; };
__device__ __forceinline__ const char* gemm_abase(const Gemm& g, int pm, size_t tstep) { return pm >= g.pm2 ? (const char*)g.A2 + (size_t)(pm - g.pm2) * tstep : (const char*)g.A + (size_t)pm * tstep; }

struct StaticOrder {
    int nM, nN, nwg, G, c;
    __host__ __device__ void init(int M, int N, int G_, int c_) { nM = M / BM; nN = N / BM; nwg = nM * nN; G = G_; c = c_; }
    __host__ __device__ bool next(int i, Unit& u) const {
        const long L = (long)i * G + c; if (L >= nwg) return false;
        int wgid = (int)L; { const int q = nwg / NXCD, r = nwg % NXCD, xcd = wgid % NXCD, off = wgid / NXCD; wgid = (xcd < r ? xcd * (q + 1) : r * (q + 1) + (xcd - r) * q) + off; }
        const int nig = WGM * nN, gid = wgid / nig, fm = gid * WGM, gsz = (nM - fm) < WGM ? (nM - fm) : WGM;
        u.pm = fm + ((wgid % nig) % gsz); u.pn = (wgid % nig) / gsz; return true;
    }
    __device__ __forceinline__ void a_ready(const Unit&) const {}
    __device__ __forceinline__ void done(const Unit&) const {}
};


template <class Epi, class Sched, bool ALIGN_EPI = false, bool SP2 = false>
__device__ __forceinline__ void gemm_phase(PG8_LAS unsigned char* lds, const Gemm g, const Sched& S, const Epi& E) {
    const int tid = fresh_tid(), wid = __builtin_amdgcn_readfirstlane(tid >> 6), lane = tid & 63, wr = wid >> 2, wc = wid & 3, fr = lane & 15, fq = lane >> 4;
    const int K = g.K, nt = K / BK;
    unsigned voffA[2], voffB[2];
#pragma unroll
    for (int i = 0; i < 2; ++i) { int R, C; stage_rc(tid * 16 + i * 8192, R, C); const int Rb = Epi::PERM ? ((R & ~31) + perm32(R & 31)) : R;
        voffA[i] = (unsigned)(R * K + C) * 2u; voffB[i] = (unsigned)(Rb * K + C) * 2u; }
    const size_t kstep = (size_t)(BK * 2);
    const size_t hstep = (size_t)HALF * K * 2;
    const size_t tstep = 2 * hstep;
    const unsigned ldsw = (unsigned)wid * 1024u;
    const int aoff = lds_byte(wr * 64 + fr, fq * 8), boff = lds_byte(wc * 32 + fr, fq * 8);
#define PG8_SA(b, h) (((b) * 2 + (h)) * HTB)
#define PG8_SB(b, h) ((4 + (b) * 2 + (h)) * HTB)
#define PG8_STAGE(bufoff, gbase, voff) do { _Pragma("unroll") for (int _i = 0; _i < 2; ++_i) \
        __builtin_amdgcn_global_load_lds((const unsigned*)((const char*)(gbase) + (voff)[_i]), (PG8_LAS unsigned*)(lds + (bufoff) + ldsw + _i * 8192), 16, 0, 0); } while (0)
#define PG8_LDA(dst, b, h) do { _Pragma("unroll") for (int m = 0; m < 4; ++m) _Pragma("unroll") for (int k = 0; k < 2; ++k) dst[m][k] = *(const PG8_LAS bf16x8*)(lds + PG8_SA(b, h) + aoff + m * 2048 + k * 1024); } while (0)
#define PG8_LDB(dst, b, h) do { _Pragma("unroll") for (int n = 0; n < 2; ++n) _Pragma("unroll") for (int k = 0; k < 2; ++k) dst[n][k] = *(const PG8_LAS bf16x8*)(lds + PG8_SB(b, h) + boff + n * 2048 + k * 1024); } while (0)
#define PG8_MMA(ai, bj, At, Bt) do { __builtin_amdgcn_s_setprio(1); _Pragma("unroll") for (int m = 0; m < 4; ++m) _Pragma("unroll") for (int n = 0; n < 2; ++n) _Pragma("unroll") for (int k = 0; k < 2; ++k) \
        acc[ai][bj][m][n] = __builtin_amdgcn_mfma_f32_16x16x32_bf16(Bt[n][k], At[m][k], acc[ai][bj][m][n], 0, 0, 0); __builtin_amdgcn_s_setprio(0); } while (0)
#define PG8_WAIT_V(n) asm volatile("s_waitcnt vmcnt(" #n ")" ::: "memory")
#define PG8_WAIT_L(n) asm volatile("s_waitcnt lgkmcnt(" #n ")" ::: "memory")
#define PG8_BAR __builtin_amdgcn_s_barrier()
#define PG8_SCHED __builtin_amdgcn_sched_barrier(0)
    Unit cur, nxt; int ui = 0;
    if (!S.next(0, cur)) return;
    f32x4 acc[2][2][4][2];
#pragma unroll
    for (int a = 0; a < 2; ++a)
#pragma unroll
        for (int b = 0; b < 2; ++b)
#pragma unroll
            for (int m = 0; m < 4; ++m)
#pragma unroll
                for (int n = 0; n < 2; ++n) acc[a][b][m][n] = (f32x4){0.f, 0.f, 0.f, 0.f};
    bf16x8 At[4][2], B0[2][2], B1[2][2];
    const char* cA = gemm_abase(g, cur.pm, tstep); const char* cB = (const char*)g.Bt + (size_t)cur.pn * tstep;
    S.a_ready(cur);
    if constexpr (SP2) {
        PG8_STAGE(PG8_SB(0, 0), cB, voffB); PG8_STAGE(PG8_SB(0, 1), cB + hstep, voffB); PG8_STAGE(PG8_SA(0, 0), cA, voffA); PG8_STAGE(PG8_SA(0, 1), cA + hstep, voffA);
        if (wr == 1) PG8_BAR;
        PG8_WAIT_V(2); PG8_BAR;
        PG8_STAGE(PG8_SB(1, 0), cB + kstep, voffB); PG8_STAGE(PG8_SA(1, 0), cA + kstep, voffA); PG8_STAGE(PG8_SB(1, 1), cB + hstep + kstep, voffB);
        PG8_WAIT_V(6); PG8_BAR;
    } else {
        PG8_STAGE(PG8_SB(0, 0), cB, voffB); PG8_STAGE(PG8_SA(0, 0), cA, voffA); PG8_STAGE(PG8_SB(0, 1), cB + hstep, voffB); PG8_STAGE(PG8_SA(0, 1), cA + hstep, voffA);
        if (wr == 1) PG8_BAR;
        PG8_WAIT_V(4); PG8_BAR;
        PG8_STAGE(PG8_SB(1, 0), cB + kstep, voffB); PG8_STAGE(PG8_SA(1, 0), cA + kstep, voffA); PG8_STAGE(PG8_SB(1, 1), cB + hstep + kstep, voffB);
        PG8_WAIT_V(6); PG8_BAR;
    }
    for (;;) {
        const bool has_next = S.next(ui + 1, nxt);
        const char* nA = has_next ? gemm_abase(g, nxt.pm, tstep) : cA; const char* nB = has_next ? (const char*)g.Bt + (size_t)nxt.pn * tstep : cB;
        for (int t = 0; t < nt; t += 2) {
            const bool last = (t == nt - 2);
            const char* a1 = cA + (size_t)(t + 1) * kstep;
            const char* a2 = last ? nA : cA + (size_t)(t + 2) * kstep; const char* b2 = last ? nB : cB + (size_t)(t + 2) * kstep;
            const char* a3 = a2 + kstep; const char* b3 = b2 + kstep;
            if (last && has_next) S.a_ready(nxt);
            if constexpr (SP2) {
            PG8_LDB(B0, 0, 0); PG8_LDB(B1, 0, 1); PG8_SCHED; PG8_LDA(At, 0, 0); PG8_STAGE(PG8_SA(1, 1), a1 + hstep, voffA);
            PG8_WAIT_V(8); PG8_WAIT_L(0); PG8_BAR; PG8_MMA(0, 0, At, B0); PG8_MMA(0, 1, At, B1); PG8_BAR; PG8_SCHED;
            PG8_LDA(At, 0, 1); PG8_STAGE(PG8_SB(0, 0), b2, voffB); PG8_STAGE(PG8_SB(0, 1), b2 + hstep, voffB); PG8_STAGE(PG8_SA(0, 0), a2, voffA);
            PG8_WAIT_V(8); PG8_WAIT_L(0); PG8_BAR; PG8_MMA(1, 0, At, B0); PG8_MMA(1, 1, At, B1); PG8_BAR; PG8_SCHED;
            PG8_LDB(B0, 1, 0); PG8_LDB(B1, 1, 1); PG8_SCHED; PG8_LDA(At, 1, 0); PG8_STAGE(PG8_SA(0, 1), a2 + hstep, voffA);
            PG8_WAIT_V(8); PG8_WAIT_L(0); PG8_BAR; PG8_MMA(0, 0, At, B0); PG8_MMA(0, 1, At, B1); PG8_BAR; PG8_SCHED;
            PG8_LDA(At, 1, 1); PG8_STAGE(PG8_SB(1, 0), b3, voffB); PG8_STAGE(PG8_SB(1, 1), b3 + hstep, voffB); PG8_STAGE(PG8_SA(1, 0), a3, voffA);
            PG8_WAIT_V(8); PG8_WAIT_L(0); PG8_BAR; PG8_MMA(1, 0, At, B0); PG8_MMA(1, 1, At, B1); PG8_BAR; PG8_SCHED;
            } else {
            PG8_LDB(B0, 0, 0); PG8_SCHED; PG8_LDA(At, 0, 0); PG8_STAGE(PG8_SA(1, 1), a1 + hstep, voffA);
            PG8_WAIT_L(8); PG8_BAR; PG8_WAIT_L(0); PG8_MMA(0, 0, At, B0); PG8_BAR; PG8_SCHED;
            PG8_LDB(B1, 0, 1); PG8_STAGE(PG8_SB(0, 0), b2, voffB);
            PG8_BAR; PG8_WAIT_L(0); PG8_MMA(0, 1, At, B1); PG8_BAR;
            PG8_LDA(At, 0, 1); PG8_STAGE(PG8_SA(0, 0), a2, voffA);
            PG8_BAR; PG8_WAIT_L(0); PG8_MMA(1, 0, At, B0); PG8_BAR; PG8_SCHED;
            PG8_STAGE(PG8_SB(0, 1), b2 + hstep, voffB);
            PG8_WAIT_V(6); PG8_BAR; PG8_MMA(1, 1, At, B1); PG8_BAR;
            PG8_LDB(B0, 1, 0); PG8_SCHED; PG8_LDA(At, 1, 0); PG8_STAGE(PG8_SA(0, 1), a2 + hstep, voffA);
            PG8_WAIT_L(8); PG8_BAR; PG8_WAIT_L(0); PG8_MMA(0, 0, At, B0); PG8_BAR; PG8_SCHED;
            PG8_LDB(B1, 1, 1); PG8_STAGE(PG8_SB(1, 0), b3, voffB);
            PG8_BAR; PG8_WAIT_L(0); PG8_MMA(0, 1, At, B1); PG8_BAR;
            PG8_LDA(At, 1, 1); PG8_STAGE(PG8_SA(1, 0), a3, voffA);
            PG8_BAR; PG8_WAIT_L(0); PG8_MMA(1, 0, At, B0); PG8_BAR; PG8_SCHED;
            PG8_STAGE(PG8_SB(1, 1), b3 + hstep, voffB);
            PG8_WAIT_V(6); PG8_BAR; PG8_MMA(1, 1, At, B1); PG8_BAR;
            }
        }
        if constexpr (ALIGN_EPI) { if (wr == 0) PG8_BAR; }
        if constexpr (!Epi::AFTER_DRAIN) { E(acc, cur, wr, wc, fr, fq); S.done(cur); }
        if (!has_next) break;
#pragma unroll
        for (int a = 0; a < 2; ++a)
#pragma unroll
            for (int b = 0; b < 2; ++b)
#pragma unroll
                for (int m = 0; m < 4; ++m)
#pragma unroll
                    for (int n = 0; n < 2; ++n) acc[a][b][m][n] = (f32x4){0.f, 0.f, 0.f, 0.f};
        cur = nxt; cA = nA; cB = nB; ++ui;
        if constexpr (ALIGN_EPI) { if (wr == 1) PG8_BAR; }
    }
    PG8_WAIT_V(0);
    if constexpr (!ALIGN_EPI) { if (wr == 0) PG8_BAR; }
    PG8_BAR;
    if constexpr (Epi::AFTER_DRAIN) { E.fused(acc, cur, wr, wc, fr, fq, lds, wid, lane); S.done(cur); }
#undef PG8_SA
#undef PG8_SB
#undef PG8_STAGE
#undef PG8_LDA
#undef PG8_LDB
#undef PG8_MMA
#undef PG8_WAIT_V
#undef PG8_WAIT_L
#undef PG8_BAR
#undef PG8_SCHED
}
}

#ifndef PG8_SP2
#define PG8_SP2 true
#endif

#define LAS __attribute__((address_space(3)))
typedef unsigned short bf16;
typedef short bf16x8 __attribute__((ext_vector_type(8)));
typedef float f32x4 __attribute__((ext_vector_type(4)));
typedef float f32x16 __attribute__((ext_vector_type(16)));
typedef unsigned u32x4 __attribute__((ext_vector_type(4)));
typedef unsigned u32x2 __attribute__((ext_vector_type(2)));

constexpr int DM = 1024, NMAIN = 32768, ROWS = 33024, METAROW = 32768, DFF = 4096;
constexpr int NTHREADS = 512;
constexpr int LDS_BYTES = 147456;
constexpr int LDS_ITEM_OFF = LDS_BYTES - 16;
constexpr size_t MiB = 1u << 20;
constexpr size_t WS_CTL = 0, WS_WIN = 1 * MiB, WS_WUPA = 12 * MiB, WS_WUPB = 13 * MiB, WS_WOUT = 14 * MiB, WS_WFF1 = 16 * MiB, WS_WFF2 = 24 * MiB;
constexpr size_t WS_LORA = 32 * MiB, WS_XNMETA = 32 * MiB + 512 * 1024, WS_CB = 33 * MiB, WS_ACT = 36 * MiB;
constexpr size_t ACT_SZ = (size_t)ROWS * 512 * 2, L_SZ = (size_t)ROWS * 256 * 2;
constexpr size_t WS_R = WS_ACT, WS_KA = WS_R + ACT_SZ, WS_VA = WS_KA + ACT_SZ, WS_L = WS_VA + ACT_SZ, WS_Q = WS_L + L_SZ, WS_KB = WS_Q + ACT_SZ, WS_VT = WS_KB + ACT_SZ, WS_END = WS_VT + ACT_SZ;
constexpr size_t WS_GA = WS_KA, WS_GB = WS_KB, WS_MN = WS_ACT, WS_HID = WS_ACT + 64 * MiB;
static_assert(WS_END <= 256 * MiB && WS_HID + 128 * MiB <= 256 * MiB && WS_CB + (size_t)2 * ROWS * 8 * 4 <= WS_ACT, "ws map");
constexpr float LOG2E = 1.4426950408889634f;
constexpr float QSCALE = 0.125f * LOG2E;

struct Params { const float* in[29]; float* out; unsigned char* ws; };
typedef const __attribute__((address_space(4))) Params* KP;
enum { I_XP = 0, I_XS, I_META, I_GMIX, I_WIN, I_MUP, I_MUN, I_W0, I_WUP, I_A0, I_AUP, I_GUP, I_KK, I_KA, I_RK, I_LNW, I_LNB, I_LQ1, I_LK1, I_LQ2, I_LK2, I_SUBG, I_UPA, I_UPB, I_WOUT, I_GFFN, I_FF1, I_FF2, I_GFIN };

__device__ __forceinline__ unsigned cvtpk(float lo, float hi) { unsigned r; asm volatile("v_cvt_pk_bf16_f32 %0, %1, %2" : "=v"(r) : "v"(lo), "v"(hi)); return r; }
__device__ __forceinline__ float bf2f(unsigned short b) { return __uint_as_float(((unsigned)b) << 16); }
__device__ __forceinline__ float bflo(unsigned w) { return __uint_as_float(w << 16); }
__device__ __forceinline__ float bfhi(unsigned w) { return __uint_as_float(w & 0xffff0000u); }
__device__ __forceinline__ void unpack8(const u32x4 v, float* o) { o[0] = bflo(v.x); o[1] = bfhi(v.x); o[2] = bflo(v.y); o[3] = bfhi(v.y); o[4] = bflo(v.z); o[5] = bfhi(v.z); o[6] = bflo(v.w); o[7] = bfhi(v.w); }
__device__ __forceinline__ float wave_sum(float v) {
#pragma unroll
    for (int o = 1; o < 64; o <<= 1) v += __shfl_xor(v, o);
    return v;
}
__device__ __forceinline__ float sigmoidf_(float x) { return 1.0f / (1.0f + __expf(-x)); }
__device__ __forceinline__ int seq_base(int s) { return s == 0 ? 0 : 16384 + (s - 1) * 2048; }
__device__ __forceinline__ int seq_len(int s) { return s == 0 ? 16384 : 2048; }
__device__ __forceinline__ int pos_row(int base, int p) { return p < 16 ? METAROW + p : base + p - 16; }

template <class Op> struct Epi8 {
    static constexpr bool PERM = true, AFTER_DRAIN = false;
    Op op;
    __device__ __forceinline__ void operator()(const pg8::f32x4 (&acc)[2][2][4][2], const pg8::Unit& u, int wr, int wc, int fr, int fq) const {
        const int row0 = u.pm * 256 + wr * 64 + fr, col0 = u.pn * 256 + wc * 32 + 8 * fq;
#pragma unroll
        for (int ai = 0; ai < 2; ++ai)
#pragma unroll
            for (int m = 0; m < 4; ++m)
#pragma unroll
                for (int bj = 0; bj < 2; ++bj) { op.apply(row0 + ai * 128 + m * 16, col0 + bj * 128, u.pn, acc[ai][bj][m][0], acc[ai][bj][m][1]); asm volatile("" ::: "memory"); }
    }
};
__device__ __forceinline__ u32x4 pack8(const f32x4 a, const f32x4 b) { u32x4 w; w.x = cvtpk(a[0], a[1]); w.y = cvtpk(a[2], a[3]); w.z = cvtpk(b[0], b[1]); w.w = cvtpk(b[2], b[3]); return w; }

constexpr int CW_KN = 320;
__device__ __forceinline__ float dpp_max16(float v) {
    int x = __float_as_int(v);
    v = fmaxf(v, __int_as_float(__builtin_amdgcn_update_dpp(0, x, 0xB1, 0xf, 0xf, true))); x = __float_as_int(v);
    v = fmaxf(v, __int_as_float(__builtin_amdgcn_update_dpp(0, x, 0x4E, 0xf, 0xf, true))); x = __float_as_int(v);
    v = fmaxf(v, __int_as_float(__builtin_amdgcn_update_dpp(0, x, 0x141, 0xf, 0xf, true))); x = __float_as_int(v);
    v = fmaxf(v, __int_as_float(__builtin_amdgcn_update_dpp(0, x, 0x140, 0xf, 0xf, true)));
    return v;
}
struct OpProj {
    unsigned char* ws;
    __device__ __forceinline__ void apply(int row, int col, int pn, f32x4 v0, f32x4 v1) const {
        if (pn >= 11) {
            bf16* VT = (bf16*)(ws + WS_VT); const int c = col - 11 * 256;
#pragma unroll
            for (int e = 0; e < 4; ++e) { VT[(size_t)(c + e) * ROWS + row] = (bf16)(cvtpk(v0[e], 0.f) & 0xffffu); VT[(size_t)(c + 4 + e) * ROWS + row] = (bf16)(cvtpk(v1[e], 0.f) & 0xffffu); }
            return;
        }
        bf16* O; int ldc = 512, c;
        if (pn < 2) { O = (bf16*)(ws + WS_R); c = col; }
        else if (pn < 4) { O = (bf16*)(ws + WS_KA); c = col - 512; }
        else if (pn < 6) { O = (bf16*)(ws + WS_VA); c = col - 1024; }
        else if (pn < 7) { O = (bf16*)(ws + WS_L); c = col - 1536; ldc = 256; }
        else if (pn < 9) { O = (bf16*)(ws + WS_Q); c = col - 1792; v0 = v0 * QSCALE; v1 = v1 * QSCALE; }
        else { O = (bf16*)(ws + WS_KB); c = col - 2304; }
        const u32x4 w = pack8(v0, v1);
        *(u32x4*)(O + (size_t)row * ldc + c) = w;
        if (pn >= 9) {
            float k8[8]; unpack8(w, k8); float ss = 0.f;
#pragma unroll
            for (int e = 0; e < 8; ++e) ss = fmaf(k8[e], k8[e], ss);
            ss = dpp_max16(ss);
            if ((threadIdx.x & 15) == 0) { const int sidx = row < 16384 ? 0 : row < NMAIN ? 1 + ((row - 16384) >> 11) : 9;
                atomicMax((unsigned*)(ws + WS_CTL) + CW_KN + sidx * 64 + (c >> 3), __float_as_uint(ss)); }
        }
    }
};
struct OpGate {
    unsigned char* ws;
    __device__ __forceinline__ void apply(int row, int col, int pn, f32x4 v0, f32x4 v1) const {
        bf16* O = (bf16*)(ws + (pn < 4 ? WS_GA : WS_GB)); const int c = pn < 4 ? col : col - 1024;
#pragma unroll
        for (int e = 0; e < 4; ++e) { v0[e] = sigmoidf_(v0[e]); v1[e] = sigmoidf_(v1[e]); }
        *(u32x4*)(O + (size_t)row * 1024 + c) = pack8(v0, v1);
    }
};
struct OpUpA {
    unsigned char* ws;
    __device__ __forceinline__ void apply(int row, int col, int pn, f32x4 v0, f32x4 v1) const {
        u32x4* p = (u32x4*)((bf16*)(ws + WS_GA) + (size_t)row * 1024 + col); float g[8]; unpack8(*p, g);
#pragma unroll
        for (int e = 0; e < 4; ++e) { v0[e] *= g[e]; v1[e] *= g[4 + e]; }
        *p = pack8(v0, v1);
    }
};
struct OpUpB {
    unsigned char* ws;
    __device__ __forceinline__ void apply(int row, int col, int pn, f32x4 v0, f32x4 v1) const {
        u32x4* p = (u32x4*)((bf16*)(ws + WS_GB) + (size_t)row * 1024 + col); float g[8], a[8]; unpack8(*p, g);
        unpack8(*(const u32x4*)((const bf16*)(ws + WS_GA) + (size_t)row * 1024 + col), a);
#pragma unroll
        for (int e = 0; e < 4; ++e) { v0[e] = a[e] + v0[e] * g[e]; v1[e] = a[4 + e] + v1[e] * g[4 + e]; }
        *p = pack8(v0, v1);
    }
};
struct OpOut {
    const float* xp; const float* xs; float* out;
    __device__ __forceinline__ void apply(int row, int col, int pn, f32x4 v0, f32x4 v1) const {
        const float* x = (row < 16384 ? xp + (size_t)row * DM : xs + (size_t)(row - 16384) * DM) + col;
        float* o = out + (size_t)row * DM + col;
        *(f32x4*)o = *(const f32x4*)x + v0; *(f32x4*)(o + 4) = *(const f32x4*)(x + 4) + v1;
    }
};
struct OpFF1 {
    bf16* hid;
    __device__ __forceinline__ void apply(int row, int col, int pn, f32x4 v0, f32x4 v1) const {
#pragma unroll
        for (int e = 0; e < 4; ++e) { const float a = fmaxf(v0[e], 0.f), b = fmaxf(v1[e], 0.f); v0[e] = a * a; v1[e] = b * b; }
        *(u32x4*)(hid + (size_t)row * DFF + col) = pack8(v0, v1);
    }
};
struct OpFF2 {
    float* out;
    __device__ __forceinline__ void apply(int row, int col, int pn, f32x4 v0, f32x4 v1) const {
        float* o = out + (size_t)row * DM + col;
        *(f32x4*)o = *(const f32x4*)o + v0; *(f32x4*)(o + 4) = *(const f32x4*)(o + 4) + v1;
    }
};

__device__ __forceinline__ unsigned f2bf_rne(float f) { return cvtpk(f, 0.f) & 0xffffu; }
__device__ __forceinline__ void transpose_item(const float* W, int K, int N, bf16* WT, LAS float* scr, int item, int lane) {
    const int nblk = N / 32, kb = item / nblk, nb = item % nblk, k0 = 64 * kb, n0 = 32 * nb;
#pragma unroll 8
    for (int i = 0; i < 32; ++i) { const int kk = 2 * i + (lane >> 5); scr[kk * 33 + (lane & 31)] = W[(size_t)(k0 + kk) * N + n0 + (lane & 31)]; }
    asm volatile("s_waitcnt vmcnt(0) lgkmcnt(0)" ::: "memory");
    const int c = lane & 7;
#pragma unroll
    for (int j = 0; j < 4; ++j) { const int n = (lane >> 3) + 8 * j; const LAS float* s = scr + (8 * c) * 33 + n;
        u32x4 o; o.x = cvtpk(s[0 * 33], s[1 * 33]); o.y = cvtpk(s[2 * 33], s[3 * 33]); o.z = cvtpk(s[4 * 33], s[5 * 33]); o.w = cvtpk(s[6 * 33], s[7 * 33]);
        *(u32x4*)(WT + (size_t)(n0 + n) * K + k0 + 8 * c) = o; }
    asm volatile("s_waitcnt lgkmcnt(0)" ::: "memory");
}
__device__ __forceinline__ void rms_row_bf16(const float* src, const float* g, bf16* dst, int lane) {
    unsigned long long* o8 = (unsigned long long*)dst + lane;
    if (!src) {
#pragma unroll
        for (int j = 0; j < 4; ++j) o8[64 * j] = 0ull;
        return; }
    const f32x4* xr = (const f32x4*)src + lane; const f32x4* gr = (const f32x4*)g + lane;
    f32x4 v[4]; float s = 0.f;
#pragma unroll
    for (int j = 0; j < 4; ++j) { v[j] = xr[64 * j]; s += (v[j].x * v[j].x + v[j].y * v[j].y) + (v[j].z * v[j].z + v[j].w * v[j].w); }
    const float rstd = rsqrtf(wave_sum(s) * (1.f / DM) + 1e-6f);
#pragma unroll
    for (int j = 0; j < 4; ++j) { const f32x4 gg = gr[64 * j]; const f32x4 y = v[j] * rstd * gg;
        o8[64 * j] = (unsigned long long)cvtpk(y.x, y.y) | ((unsigned long long)cvtpk(y.z, y.w) << 32); }
}
__device__ __forceinline__ void phase_prologue(LAS unsigned char* lds, KP P) {
    const int tid = fresh_tid(), lane = tid & 63, wid = tid >> 6;
    LAS float* scr = (LAS float*)(lds + wid * 16384);
    const int gw = blockIdx.x * 8 + wid, NGW = gridDim.x * 8;
    unsigned char* ws = P->ws;
    constexpr int I_IN = (1024 / 64) * (5376 / 32), I_UP = (512 / 64) * (1024 / 32), I_O = (1024 / 64) * (1024 / 32), I_1 = (1024 / 64) * (4096 / 32), I_2 = (4096 / 64) * (1024 / 32);
    constexpr int I_LW = (64 / 64) * (512 / 32), I_G = (128 / 64) * (512 / 32);
    constexpr int NITEMS = I_IN + 2 * I_UP + I_O + I_1 + I_2 + 4 * I_LW + I_G;
    for (int it = gw; it < NITEMS; it += NGW) {
        int r = it;
        if (r < I_IN) { transpose_item(P->in[I_WIN], 1024, 5376, (bf16*)(ws + WS_WIN), scr, r, lane); continue; } r -= I_IN;
        if (r < I_UP) { transpose_item(P->in[I_UPA], 512, 1024, (bf16*)(ws + WS_WUPA), scr, r, lane); continue; } r -= I_UP;
        if (r < I_UP) { transpose_item(P->in[I_UPB], 512, 1024, (bf16*)(ws + WS_WUPB), scr, r, lane); continue; } r -= I_UP;
        if (r < I_O) { transpose_item(P->in[I_WOUT], 1024, 1024, (bf16*)(ws + WS_WOUT), scr, r, lane); continue; } r -= I_O;
        if (r < I_1) { transpose_item(P->in[I_FF1], 1024, 4096, (bf16*)(ws + WS_WFF1), scr, r, lane); continue; } r -= I_1;
        if (r < I_2) { transpose_item(P->in[I_FF2], 4096, 1024, (bf16*)(ws + WS_WFF2), scr, r, lane); continue; } r -= I_2;
        if (r < 2 * I_LW) { const int d = r / I_LW; transpose_item(P->in[I_WUP] + (size_t)d * 64 * 512, 64, 512, (bf16*)(ws + WS_LORA) + (size_t)d * 512 * 64, scr, r % I_LW, lane); continue; } r -= 2 * I_LW;
        if (r < 2 * I_LW) { const int d = r / I_LW; transpose_item(P->in[I_AUP] + (size_t)d * 64 * 512, 64, 512, (bf16*)(ws + WS_LORA + 131072) + (size_t)d * 512 * 64, scr, r % I_LW, lane); continue; } r -= 2 * I_LW;
        transpose_item(P->in[I_GUP], 128, 512, (bf16*)(ws + WS_LORA + 262144), scr, r, lane);
    }
    bf16* XN = (bf16*)P->out; bf16* XM = (bf16*)(ws + WS_XNMETA);
    for (int m = gw; m < ROWS; m += NGW) {
        const float* src = m < 16384 ? P->in[I_XP] + (size_t)m * DM : m < NMAIN ? P->in[I_XS] + (size_t)(m - 16384) * DM : (m - NMAIN < 16 ? P->in[I_META] + (size_t)(m - NMAIN) * DM : nullptr);
        bf16* dst = m < NMAIN ? XN + (size_t)m * DM : XM + (size_t)(m - NMAIN) * DM;
        rms_row_bf16(src, P->in[I_GMIX], dst, lane);
    }
}

constexpr int AT_KSTR = 272, AT_VSTR = 144, AT_KSZ = 64 * AT_KSTR, AT_BUF = AT_KSZ + 128 * AT_VSTR;
__device__ __forceinline__ f32x16 mfma32(bf16x8 a, bf16x8 b, f32x16 c) { return __builtin_amdgcn_mfma_f32_32x32x16_bf16(a, b, c, 0, 0, 0); }
__device__ __forceinline__ void attn_unit(LAS unsigned char* lds, KP P, int s, int h, int qb, float lam) {
    int tid_ = threadIdx.x; asm volatile("" : "+v"(tid_));
    const int tid = tid_, lane = tid & 63, r32 = lane & 31, hi = lane >> 5, wid = __builtin_amdgcn_readfirstlane(tid >> 6), rg = wid & 3, mp = wid >> 2;
    const int L = seq_len(s), base = seq_base(s), NT = 1 + L / 64;
    unsigned char* ws = P->ws;
    const bf16* KB = (const bf16*)(ws + WS_KB); const bf16* VT = (const bf16*)(ws + WS_VT); bf16* Q = (bf16*)(ws + WS_Q);
    const int qrow = base + qb * 128 + rg * 32 + r32;
    bf16x8 q[4];
#pragma unroll
    for (int d0 = 0; d0 < 4; ++d0) q[d0] = *(const bf16x8*)(Q + (size_t)qrow * 512 + h * 128 + mp * 64 + d0 * 16 + hi * 8);
    f32x16 O[4];
#pragma unroll
    for (int b = 0; b < 4; ++b)
#pragma unroll
        for (int r = 0; r < 16; ++r) O[b][r] = 0.f;
    float mx = -INFINITY, ls = 0.f;
    const float qh = (float)(16 + qb * 128 + rg * 32 + r32 - 4 * hi);
    const float nslope = -exp2f(-2.0f * (float)(h + 1)) * LOG2E;
    const int kr0 = tid >> 4, kc = tid & 15, vn0 = tid >> 3, vc = tid & 7;
    u32x4 kreg[2], vreg[2];
    const unsigned kgo = (unsigned)((kr0 * 512 + h * 128 + kc * 8) * 2), vgo = (unsigned)(((h * 128 + vn0) * ROWS + vc * 8) * 2);
    const unsigned klo = (unsigned)(kr0 * AT_KSTR + kc * 16), vlo = (unsigned)(AT_KSZ + vn0 * AT_VSTR + vc * 16);
#define AT_GLOAD(j) do { const int m0_ = (j) == 0 ? METAROW : base + 64 * ((j) - 1); \
        const unsigned char* kt_ = (const unsigned char*)KB + (size_t)m0_ * 1024; const unsigned char* vt_ = (const unsigned char*)VT + (size_t)m0_ * 2; \
        kreg[0] = *(const u32x4*)(kt_ + kgo); kreg[1] = *(const u32x4*)(kt_ + 32 * 1024 + kgo); \
        vreg[0] = *(const u32x4*)(vt_ + vgo); vreg[1] = *(const u32x4*)(vt_ + (size_t)64 * ROWS * 2 + vgo); } while (0)
#define AT_LSTORE(buf) do { LAS unsigned char* kb_ = lds + (buf) * AT_BUF; \
        *(LAS u32x4*)(kb_ + klo) = kreg[0]; *(LAS u32x4*)(kb_ + klo + 32 * AT_KSTR) = kreg[1]; \
        *(LAS u32x4*)(kb_ + vlo) = vreg[0]; *(LAS u32x4*)(kb_ + vlo + 64 * AT_VSTR) = vreg[1]; } while (0)
    float qn, kn;
    { float ssq = 0.f;
#pragma unroll
      for (int d0 = 0; d0 < 4; ++d0) { float t[8]; unpack8(__builtin_bit_cast(u32x4, q[d0]), t);
#pragma unroll
        for (int e = 0; e < 8; ++e) ssq = fmaf(t[e], t[e], ssq); }
      ssq += __shfl_xor(ssq, 32); qn = sqrtf(ssq) * 1.002f;
      const unsigned* KN = (const unsigned*)(ws + WS_CTL) + CW_KN; float ks = 0.f;
#pragma unroll
      for (int g = 0; g < 8; ++g) ks += fmaxf(__uint_as_float(__hip_atomic_load(KN + s * 64 + h * 16 + mp * 8 + g, __ATOMIC_RELAXED, __HIP_MEMORY_SCOPE_AGENT)), __uint_as_float(__hip_atomic_load(KN + 9 * 64 + h * 16 + mp * 8 + g, __ATOMIC_RELAXED, __HIP_MEMORY_SCOPE_AGENT)));
      kn = sqrtf(ks) * 1.002f; }
    const int jc0 = 1 + qb * 2;
    int jlo = jc0, jhi = jc0 + 1;
    LAS float* red = (LAS float*)(lds + 2 * AT_BUF);
#pragma unroll 1
    for (int ph = 0; ph < 2; ++ph) {
        int nleft, ntl;
        if (ph == 0) { nleft = 0; ntl = 2; }
        else {
            float dneed = (qn * kn - mx + 40.0f) / (-nslope);
#pragma unroll
            for (int o = 1; o < 64; o <<= 1) dneed = fmaxf(dneed, __shfl_xor(dneed, o));
            if (lane == 0) red[wid] = dneed;
            __syncthreads();
            float dm = red[0];
#pragma unroll
            for (int w8 = 1; w8 < 8; ++w8) dm = fmaxf(dm, red[w8]);
            dm = fminf(fmaxf(dm, 0.f), 1.0e6f);
            const int dmax = (int)dm + 1, q0 = 16 + qb * 128;
            const int plo = q0 - dmax, phi = q0 + 127 + dmax;
            jlo = plo < 16 ? 0 : 1 + ((plo - 16) >> 6); jhi = phi >= L + 16 ? NT - 1 : 1 + ((phi - 16) >> 6);
            if (jlo > jc0) jlo = jc0; if (jhi < jc0 + 1) jhi = jc0 + 1;
            nleft = jc0 - jlo; ntl = nleft + (jhi - jc0 - 1);
        }
        if (ntl > 0) {
#define AT_J(t) (ph == 0 ? jc0 + (t) : ((t) < nleft ? jlo + (t) : jc0 + 2 + ((t) - nleft)))
        { const int jf = AT_J(0); AT_GLOAD(jf); } AT_LSTORE(0); __syncthreads();
#pragma unroll 1
        for (int t = 0; t < ntl; ++t) {
            const int j = AT_J(t);
            if (t + 1 < ntl) { const int jn = AT_J(t + 1); AT_GLOAD(jn); }
            const LAS unsigned char* Kb = lds + (t & 1) * AT_BUF + mp * 128; const LAS unsigned char* Vb = lds + (t & 1) * AT_BUF + AT_KSZ;
            const float dq = qh - (float)(j == 0 ? 0 : 64 * j - 48);
            f32x16 p0, p1;
#pragma unroll
            for (int r = 0; r < 16; ++r) { p0[r] = 0.f; p1[r] = 0.f; }
#pragma unroll
            for (int d0 = 0; d0 < 4; ++d0) {
                const bf16x8 a0 = *(const LAS bf16x8*)(Kb + r32 * AT_KSTR + d0 * 32 + hi * 16);
                const bf16x8 a1 = *(const LAS bf16x8*)(Kb + (32 + r32) * AT_KSTR + d0 * 32 + hi * 16);
                p0 = mfma32(a0, q[d0], p0); p1 = mfma32(a1, q[d0], p1);
            }
#pragma unroll
            for (int r = 0; r < 16; ++r) { const float dd = dq - (float)((r & 3) + 8 * (r >> 2)); p0[r] = fmaf(fabsf(dd), nslope, p0[r]); p1[r] = fmaf(fabsf(dd - 32.f), nslope, p1[r]); }
            if (j == 0) {
#pragma unroll
                for (int r = 0; r < 16; ++r) { if ((r & 3) + 8 * (r >> 2) + 4 * hi >= 16) p0[r] = -INFINITY; p1[r] = -INFINITY; }
            }
            float rm = fmaxf(p0[0], p1[0]);
#pragma unroll
            for (int r = 1; r < 16; ++r) rm = fmaxf(rm, fmaxf(p0[r], p1[r]));
            rm = fmaxf(rm, __shfl_xor(rm, 32));
            const float mn = fmaxf(mx, rm);
            if (__any(mn > mx)) {
                const float f = __builtin_amdgcn_exp2f(mx - mn); ls *= f; mx = mn;
#pragma unroll
                for (int b = 0; b < 4; ++b)
#pragma unroll
                    for (int r = 0; r < 16; ++r) O[b][r] *= f;
            }
            float sum = 0.f;
#pragma unroll
            for (int r = 0; r < 16; ++r) { p0[r] = __builtin_amdgcn_exp2f(p0[r] - mx); p1[r] = __builtin_amdgcn_exp2f(p1[r] - mx); sum += p0[r] + p1[r]; }
            ls += sum;
            bf16x8 pf[4];
#pragma unroll
            for (int k2 = 0; k2 < 2; ++k2) {
                u32x4 w0, w1;
                w0.x = cvtpk(p0[8 * k2 + 0], p0[8 * k2 + 1]); w0.y = cvtpk(p0[8 * k2 + 2], p0[8 * k2 + 3]); w0.z = cvtpk(p0[8 * k2 + 4], p0[8 * k2 + 5]); w0.w = cvtpk(p0[8 * k2 + 6], p0[8 * k2 + 7]);
                w1.x = cvtpk(p1[8 * k2 + 0], p1[8 * k2 + 1]); w1.y = cvtpk(p1[8 * k2 + 2], p1[8 * k2 + 3]); w1.z = cvtpk(p1[8 * k2 + 4], p1[8 * k2 + 5]); w1.w = cvtpk(p1[8 * k2 + 6], p1[8 * k2 + 7]);
                pf[k2] = __builtin_bit_cast(bf16x8, w0); pf[2 + k2] = __builtin_bit_cast(bf16x8, w1);
            }
#pragma unroll
            for (int ks = 0; ks < 4; ++ks)
#pragma unroll
                for (int b = 0; b < 4; ++b) {
                    const LAS unsigned char* vp = Vb + (b * 32 + r32) * AT_VSTR + ks * 32 + hi * 8;
                    const u32x2 lo = *(const LAS u32x2*)vp, hh = *(const LAS u32x2*)(vp + 16);
                    u32x4 vv; vv.x = lo.x; vv.y = lo.y; vv.z = hh.x; vv.w = hh.y;
                    O[b] = mfma32(__builtin_bit_cast(bf16x8, vv), pf[ks], O[b]);
                }
            if (t + 1 < ntl) AT_LSTORE((t + 1) & 1);
            __syncthreads();
        }
#undef AT_J
        }
    }
#undef AT_GLOAD
#undef AT_LSTORE
    const float lt = ls + __shfl_xor(ls, 32);
    const float inv = (mp ? lam : 1.0f) / lt;
    int lane2 = lane; asm volatile("" : "+v"(lane2));
    const int r32e = lane2 & 31, hie = lane2 >> 5;
    LAS float* ex = (LAS float*)lds + rg * (128 * 32) + hie * 128 + r32e;
    if (mp == 1) {
#pragma unroll
        for (int b = 0; b < 4; ++b)
#pragma unroll
            for (int r = 0; r < 16; ++r) ex[(32 * b + (r & 3) + 8 * (r >> 2)) * 32] = O[b][r] * inv;
    }
    __syncthreads();
    if (mp == 0) {
        float ss = 0.f;
#pragma unroll
        for (int b = 0; b < 4; ++b)
#pragma unroll
            for (int r = 0; r < 16; ++r) { const float o = O[b][r] * inv - ex[(32 * b + (r & 3) + 8 * (r >> 2)) * 32]; O[b][r] = o; ss += o * o; }
        ss += __shfl_xor(ss, 32);
        const float rstd = rsqrtf(ss * (1.0f / 128.0f) + 1e-5f) * 0.8f;
        const float* sg = P->in[I_SUBG] + 4 * hie; bf16* Qo = Q + (size_t)(base + qb * 128 + rg * 32 + r32e) * 512 + h * 128 + 4 * hie;
#pragma unroll
        for (int b = 0; b < 4; ++b)
#pragma unroll
            for (int r4 = 0; r4 < 4; ++r4) {
                const int n = 32 * b + 8 * r4; const f32x4 g = *(const f32x4*)(sg + n);
                u32x2 w; w.x = cvtpk(O[b][4 * r4 + 0] * rstd * g.x, O[b][4 * r4 + 1] * rstd * g.y); w.y = cvtpk(O[b][4 * r4 + 2] * rstd * g.z, O[b][4 * r4 + 3] * rstd * g.w);
                *(u32x2*)(Qo + n) = w;
            }
    }
    __syncthreads();
}

constexpr int SC_R = 0, SC_K = 16384, SC_V = 32768, SC_W = 49152, SC_B = 65536, SC_KK = 81920, SC_Y = 98304, SC_TW = 114688, SC_AD = 123904, SC_MU = 133120;
__device__ __forceinline__ float dpp_add(float v, int ctrl_id) {
    const int x = __float_as_int(v); int y;
    if (ctrl_id == 0) y = __builtin_amdgcn_update_dpp(0, x, 0xB1, 0xf, 0xf, true);
    else if (ctrl_id == 1) y = __builtin_amdgcn_update_dpp(0, x, 0x4E, 0xf, 0xf, true);
    else if (ctrl_id == 2) y = __builtin_amdgcn_update_dpp(0, x, 0x141, 0xf, 0xf, true);
    else y = __builtin_amdgcn_update_dpp(0, x, 0x140, 0xf, 0xf, true);
    return v + __int_as_float(y);
}
template <int LPR> __device__ __forceinline__ float grp_sum(float v) {
    v = dpp_add(v, 0); v = dpp_add(v, 1); v = dpp_add(v, 2);
    if (LPR == 16) v = dpp_add(v, 3);
    return v;
}
#define BAR_LDS() asm volatile("s_waitcnt lgkmcnt(0)\n\ts_barrier" ::: "memory")
__device__ __forceinline__ float fast_sigmoid(float x) { return __builtin_amdgcn_rcpf(1.0f + __builtin_amdgcn_exp2f(-LOG2E * x)); }
__device__ __forceinline__ float fast_tanh(float x) { return 1.0f - 2.0f * __builtin_amdgcn_rcpf(1.0f + __builtin_amdgcn_exp2f(2.0f * LOG2E * x)); }
template <int NRP, int NSW>
__device__ __forceinline__ void scan_unit(LAS unsigned char* lds, KP P, int s, int d, int h, int rp) {
    constexpr int RPB = 64 / NRP, RPW = RPB / NSW, LPR = 64 / RPW, CPL = 64 / LPR;
    static_assert(LPR == 8 || LPR == 16, "scan geometry");
    int tid_ = threadIdx.x; asm volatile("" : "+v"(tid_));
    const int tid = tid_, lane = tid & 63, wid = __builtin_amdgcn_readfirstlane(tid >> 6);
    const int L = seq_len(s), base = seq_base(s), Ltot = L + 16, nchunk = (Ltot + 63) / 64;
    unsigned char* ws = P->ws;
    const bf16* Rb = (const bf16*)(ws + WS_R); const bf16* KAb = (const bf16*)(ws + WS_KA); const bf16* VAb = (const bf16*)(ws + WS_VA); const bf16* Lb = (const bf16*)(ws + WS_L);
    float* CB = (float*)(ws + WS_CB); bf16* YD = (bf16*)((unsigned char*)P->out + 64 * MiB) + (size_t)d * NMAIN * 512;
    LAS float* fR = (LAS float*)(lds + SC_R); LAS float* fK = (LAS float*)(lds + SC_K); LAS float* fV = (LAS float*)(lds + SC_V); LAS float* fW = (LAS float*)(lds + SC_W);
    LAS float* fB = (LAS float*)(lds + SC_B); LAS float* fKK = (LAS float*)(lds + SC_KK); LAS float* fY = (LAS float*)(lds + SC_Y); LAS float* fMU = (LAS float*)(lds + SC_MU);
    for (int i = tid; i < 832; i += NTHREADS) {
        float v;
        if (i < 640) { const int which = i / 320, jj = i % 320, a = jj >> 6, c = jj & 63; const int gi = a < 3 ? a * 512 + h * 64 + c : 1536 + (a - 3) * 64 + c; v = P->in[which ? I_MUN : I_MUP][gi]; }
        else { const int a = (i - 640) >> 6, c = (i - 640) & 63; v = P->in[a == 0 ? I_KK : a == 1 ? I_KA : I_RK][h * 64 + c]; }
        fMU[i] = v;
    }
    const int mat = wid >> 2, ntile = wid & 3;
    const bf16* Wt = (const bf16*)(ws + WS_LORA + (mat ? 131072 : 0)) + ((size_t)d * 512 + h * 64 + ntile * 16 + (lane & 15)) * 64 + (lane >> 4) * 8;
    const bf16x8 bfr0 = *(const bf16x8*)Wt, bfr1 = *(const bf16x8*)(Wt + 32);
    const float bias = P->in[mat ? I_A0 : I_W0][d * 512 + h * 64 + ntile * 16 + (lane & 15)];
    float S[CPL];
#pragma unroll
    for (int j = 0; j < CPL; ++j) S[j] = 0.f;
    const int rowl = lane / LPR, kg = lane % LPR, srow = rp * RPB + wid * RPW + rowl;
    const int slot = tid >> 3, cg8 = (tid & 7) * 8;
    u32x4 raw[5][3];
#define SC_LOAD(c) do { const int i_ = 64 * (c) + slot; const bool ok_ = i_ < Ltot; const int p_ = ok_ ? (d ? Ltot - 1 - i_ : i_) : 0; \
        const bool okp_ = ok_ && p_ > 0, okn_ = ok_ && p_ + 1 < Ltot; \
        const unsigned rc_ = (unsigned)pos_row(base, p_), rp_ = (unsigned)pos_row(base, okp_ ? p_ - 1 : p_), rn_ = (unsigned)pos_row(base, okn_ ? p_ + 1 : p_); \
        _Pragma("unroll") for (int a_ = 0; a_ < 5; ++a_) { const unsigned char* B_ = (const unsigned char*)(a_ == 0 ? Rb : a_ == 1 ? KAb : a_ == 2 ? VAb : Lb); const unsigned ld_ = a_ < 3 ? 1024u : 512u; \
            const unsigned co_ = (unsigned)(((a_ < 3 ? h * 64 : (a_ - 3) * 64) + cg8) * 2); \
            raw[a_][0] = *(const u32x4*)(B_ + (rp_ * ld_ + co_)); raw[a_][1] = *(const u32x4*)(B_ + (rc_ * ld_ + co_)); raw[a_][2] = *(const u32x4*)(B_ + (rn_ * ld_ + co_)); } \
        if (!(okp_ && okn_)) { const u32x4 z_ = {0u, 0u, 0u, 0u}; \
            _Pragma("unroll") for (int a_ = 0; a_ < 5; ++a_) { if (!okp_) raw[a_][0] = z_; if (!ok_) raw[a_][1] = z_; if (!okn_) raw[a_][2] = z_; } } } while (0)
    SC_LOAD(0);
    BAR_LDS();
    for (int c = 0; c < nchunk; ++c) {
        const int nvalid = (Ltot - 64 * c) < 64 ? (Ltot - 64 * c) : 64;
        float rv[8], kv[8];
#pragma unroll
        for (int a = 0; a < 5; ++a) {
            float pv[8], cv[8], nv[8], o[8]; unpack8(raw[a][0], pv); unpack8(raw[a][1], cv); unpack8(raw[a][2], nv);
            const f32x4 mp0 = *(const LAS f32x4*)(fMU + a * 64 + cg8), mp1 = *(const LAS f32x4*)(fMU + a * 64 + cg8 + 4), mn0 = *(const LAS f32x4*)(fMU + 320 + a * 64 + cg8), mn1 = *(const LAS f32x4*)(fMU + 320 + a * 64 + cg8 + 4);
#pragma unroll
            for (int e = 0; e < 8; ++e) { const float mp = e < 4 ? mp0[e & 3] : mp1[e & 3], mn = e < 4 ? mn0[e & 3] : mn1[e & 3]; o[e] = cv[e] + mp * (pv[e] - cv[e]) + mn * (nv[e] - cv[e]); }
            if (a == 0) {
#pragma unroll
                for (int e = 0; e < 8; ++e) rv[e] = o[e];
                LAS float* dst = fR + slot * 64 + cg8; *(LAS f32x4*)dst = (f32x4){o[0], o[1], o[2], o[3]}; *(LAS f32x4*)(dst + 4) = (f32x4){o[4], o[5], o[6], o[7]};
            } else if (a == 1) {
#pragma unroll
                for (int e = 0; e < 8; ++e) kv[e] = o[e];
            } else if (a == 2) {
                LAS float* dst = fV + slot * 64 + cg8; *(LAS f32x4*)dst = (f32x4){o[0], o[1], o[2], o[3]}; *(LAS f32x4*)(dst + 4) = (f32x4){o[4], o[5], o[6], o[7]};
            } else {
                if (a == 3) {
#pragma unroll
                    for (int e = 0; e < 8; ++e) o[e] = fast_tanh(o[e]);
                }
                u32x4 w; w.x = cvtpk(o[0], o[1]); w.y = cvtpk(o[2], o[3]); w.z = cvtpk(o[4], o[5]); w.w = cvtpk(o[6], o[7]);
                *(LAS u32x4*)(lds + (a == 3 ? SC_TW : SC_AD) + slot * 144 + cg8 * 2) = w;
            }
        }
        BAR_LDS();
        if (c + 1 < nchunk) SC_LOAD(c + 1);
        {
            const LAS unsigned char* Ab = lds + (mat ? SC_AD : SC_TW); LAS float* fWB = mat ? fB : fW;
#pragma unroll
            for (int mt = 0; mt < 4; ++mt) {
                const bf16x8 a0 = *(const LAS bf16x8*)(Ab + (mt * 16 + (lane & 15)) * 144 + (lane >> 4) * 16);
                const bf16x8 a1 = *(const LAS bf16x8*)(Ab + (mt * 16 + (lane & 15)) * 144 + 64 + (lane >> 4) * 16);
                f32x4 acc = {0.f, 0.f, 0.f, 0.f};
                acc = __builtin_amdgcn_mfma_f32_16x16x32_bf16(a0, bfr0, acc, 0, 0, 0);
                acc = __builtin_amdgcn_mfma_f32_16x16x32_bf16(a1, bfr1, acc, 0, 0, 0);
#pragma unroll
                for (int rg = 0; rg < 4; ++rg) {
                    const int sl = mt * 16 + (lane >> 4) * 4 + rg, col = ntile * 16 + (lane & 15);
                    const float sg = fast_sigmoid(acc[rg] + bias); const float dc = __builtin_amdgcn_exp2f(-0.6065306597126334f * LOG2E * sg);
                    fWB[sl * 64 + col] = mat ? sg : dc;
                }
            }
        }
        BAR_LDS();
        {
            const f32x4 a0 = *(const LAS f32x4*)(fB + slot * 64 + cg8), a1 = *(const LAS f32x4*)(fB + slot * 64 + cg8 + 4);
            const f32x4 kk0 = *(const LAS f32x4*)(fMU + 640 + cg8), kk1 = *(const LAS f32x4*)(fMU + 640 + cg8 + 4), ka0 = *(const LAS f32x4*)(fMU + 704 + cg8), ka1 = *(const LAS f32x4*)(fMU + 704 + cg8 + 4);
            const f32x4 rk0 = *(const LAS f32x4*)(fMU + 768 + cg8), rk1 = *(const LAS f32x4*)(fMU + 768 + cg8 + 4);
            float kkv[8], kd[8], av[8]; float ssq = 0.f, cs = 0.f;
#pragma unroll
            for (int e = 0; e < 8; ++e) {
                av[e] = e < 4 ? a0[e & 3] : a1[e & 3];
                kkv[e] = kv[e] * (e < 4 ? kk0[e & 3] : kk1[e & 3]); ssq = fmaf(kkv[e], kkv[e], ssq);
                kd[e] = kv[e] * (1.0f + (av[e] - 1.0f) * (e < 4 ? ka0[e & 3] : ka1[e & 3])); cs = fmaf(rv[e] * kd[e], e < 4 ? rk0[e & 3] : rk1[e & 3], cs);
            }
            ssq = grp_sum<8>(ssq); cs = grp_sum<8>(cs);
            const float rs = rsqrtf(fmaxf(ssq, 1e-24f));
#pragma unroll
            for (int e = 0; e < 8; ++e) { kkv[e] *= rs; av[e] *= kkv[e]; }
            LAS float* o1 = fKK + slot * 64 + cg8; *(LAS f32x4*)o1 = (f32x4){kkv[0], kkv[1], kkv[2], kkv[3]}; *(LAS f32x4*)(o1 + 4) = (f32x4){kkv[4], kkv[5], kkv[6], kkv[7]};
            LAS float* o2 = fB + slot * 64 + cg8; *(LAS f32x4*)o2 = (f32x4){av[0], av[1], av[2], av[3]}; *(LAS f32x4*)(o2 + 4) = (f32x4){av[4], av[5], av[6], av[7]};
            LAS float* o3 = fK + slot * 64 + cg8; *(LAS f32x4*)o3 = (f32x4){kd[0], kd[1], kd[2], kd[3]}; *(LAS f32x4*)(o3 + 4) = (f32x4){kd[4], kd[5], kd[6], kd[7]};
            if (cg8 == 0 && rp == 0 && slot < nvalid) { const int i2 = 64 * c + slot; const int p2 = d ? Ltot - 1 - i2 : i2; CB[((size_t)d * ROWS + pos_row(base, p2)) * 8 + h] = cs; }
        }
        BAR_LDS();
        if (wid < NSW) {
            const LAS float* pk = fKK + kg * CPL; const LAS float* pw = fW + kg * CPL; const LAS float* pb = fB + kg * CPL; const LAS float* pd = fK + kg * CPL; const LAS float* pr = fR + kg * CPL;
            const LAS float* pv = fV + srow; LAS float* py = fY + srow;
            f32x4 nk[CPL / 4], nw[CPL / 4], nb[CPL / 4], nd[CPL / 4], nr[CPL / 4]; float nv;
#define SC_FETCH(sl_) do { _Pragma("unroll") for (int j_ = 0; j_ < CPL / 4; ++j_) { nk[j_] = *(const LAS f32x4*)(pk + (sl_) * 64 + 4 * j_); nw[j_] = *(const LAS f32x4*)(pw + (sl_) * 64 + 4 * j_); \
                nb[j_] = *(const LAS f32x4*)(pb + (sl_) * 64 + 4 * j_); nd[j_] = *(const LAS f32x4*)(pd + (sl_) * 64 + 4 * j_); nr[j_] = *(const LAS f32x4*)(pr + (sl_) * 64 + 4 * j_); } nv = pv[(sl_) * 64]; } while (0)
            SC_FETCH(0);
#pragma unroll 8
            for (int sl = 0; sl < nvalid; ++sl) {
                f32x4 ck[CPL / 4], cw[CPL / 4], cb[CPL / 4], cd[CPL / 4], cr[CPL / 4];
#pragma unroll
                for (int j = 0; j < CPL / 4; ++j) { ck[j] = nk[j]; cw[j] = nw[j]; cb[j] = nb[j]; cd[j] = nd[j]; cr[j] = nr[j]; }
                const float vv = nv;
                SC_FETCH(sl + 1 < 64 ? sl + 1 : 63);
                float pp0 = 0.f, pp1 = 0.f;
#pragma unroll
                for (int j = 0; j < CPL / 4; ++j) { pp0 = fmaf(S[4 * j], ck[j][0], pp0); pp1 = fmaf(S[4 * j + 1], ck[j][1], pp1); pp0 = fmaf(S[4 * j + 2], ck[j][2], pp0); pp1 = fmaf(S[4 * j + 3], ck[j][3], pp1); }
                const float pp = grp_sum<LPR>(pp0 + pp1);
                typedef float f32x2_ __attribute__((ext_vector_type(2)));
                f32x2_ ya = {0.f, 0.f};
#pragma unroll
                for (int j = 0; j < CPL / 4; ++j)
#pragma unroll
                    for (int e = 0; e < 4; e += 2) {
                        const f32x2_ b2 = {cb[j][e], cb[j][e + 1]}, d2 = {cd[j][e], cd[j][e + 1]}, w2 = {cw[j][e], cw[j][e + 1]}, r2 = {cr[j][e], cr[j][e + 1]}; f32x2_ s2 = {S[4 * j + e], S[4 * j + e + 1]};
                        const f32x2_ t2 = d2 * vv - b2 * pp; s2 = s2 * w2 + t2; ya = ya + s2 * r2; S[4 * j + e] = s2.x; S[4 * j + e + 1] = s2.y; }
                const float yy = grp_sum<LPR>(ya.x + ya.y);
                if (kg == 0) py[sl * 64] = yy;
            }
#undef SC_FETCH
        }
        BAR_LDS();
        {
            const int i2 = 64 * c + slot; const int p2 = d ? Ltot - 1 - i2 : i2;
            if (slot < nvalid && p2 >= 16 && (cg8 / RPB) == rp) {
                const LAS float* yp = fY + slot * 64 + cg8; const f32x4 y0 = *(const LAS f32x4*)yp, y1 = *(const LAS f32x4*)(yp + 4);
                *(u32x4*)(YD + (size_t)(base + p2 - 16) * 512 + h * 64 + cg8) = pack8(y0, y1);
            }
        }
    }
#undef SC_LOAD
}

__device__ __forceinline__ void phase_post(LAS unsigned char* lds, KP P) {
    const int tid = fresh_tid(), lane = tid & 63, wid = tid >> 6;
    unsigned char* ws = P->ws;
    const bf16* VAb = (const bf16*)(ws + WS_VA); const bf16* Lb = (const bf16*)(ws + WS_L); bf16* Rb = (bf16*)(ws + WS_R);
    const float* CB = (const float*)(ws + WS_CB); const bf16* YD0 = (const bf16*)((const unsigned char*)P->out + 64 * MiB); const bf16* YD1 = YD0 + (size_t)NMAIN * 512;
    const bf16* GT = (const bf16*)(ws + WS_LORA + 262144);
    LAS float* st = (LAS float*)(lds + 17408);
    const float* mup = P->in[I_MUP]; const float* mun = P->in[I_MUN];
    for (int tile = blockIdx.x; tile < NMAIN / 64; tile += gridDim.x) {
        {
            const int row = tid >> 3, hh = tid & 7, m = tile * 64 + row;
            const int t = m < 16384 ? m : (m - 16384) & 2047, Ls = m < 16384 ? 16384 : 2048;
            float sum = 0.f, sq = 0.f;
#pragma unroll
            for (int i = 0; i < 8; ++i) { float a[8], b[8]; unpack8(*(const u32x4*)(YD0 + (size_t)m * 512 + hh * 64 + i * 8), a); unpack8(*(const u32x4*)(YD1 + (size_t)m * 512 + hh * 64 + i * 8), b);
#pragma unroll
                for (int e = 0; e < 8; ++e) { const float y = a[e] + b[e]; sum += y; sq += y * y; } }
            const float mu = sum * (1.0f / 64.0f); const float var = fmaxf(sq * (1.0f / 64.0f) - mu * mu, 0.f);
            st[(row * 8 + hh) * 2] = mu; st[(row * 8 + hh) * 2 + 1] = rsqrtf(var + 64e-5f);
            const size_t rp_ = t == 0 ? (size_t)(METAROW + 15) : (size_t)(m - 1); const bool okn = t + 1 < Ls;
#pragma unroll
            for (int i = 0; i < 2; ++i) {
                const int c0 = 128 + hh * 16 + i * 8; float pv[8], cv[8], nv[8], o[8];
                unpack8(*(const u32x4*)(Lb + rp_ * 256 + c0), pv); unpack8(*(const u32x4*)(Lb + (size_t)m * 256 + c0), cv);
                if (okn) unpack8(*(const u32x4*)(Lb + (size_t)(m + 1) * 256 + c0), nv); else {
#pragma unroll
                    for (int e = 0; e < 8; ++e) nv[e] = 0.f; }
#pragma unroll
                for (int e = 0; e < 8; ++e) { const float mp = mup[1536 + c0 + e], mn = mun[1536 + c0 + e]; o[e] = sigmoidf_(cv[e] + mp * (pv[e] - cv[e]) + mn * (nv[e] - cv[e])); }
                u32x4 w; w.x = cvtpk(o[0], o[1]); w.y = cvtpk(o[2], o[3]); w.z = cvtpk(o[4], o[5]); w.w = cvtpk(o[6], o[7]);
                *(LAS u32x4*)(lds + row * 272 + (hh * 16 + i * 8) * 2) = w;
            }
        }
        __syncthreads();
#pragma unroll 1
        for (int nt = 0; nt < 4; ++nt) {
            const int col = wid * 64 + nt * 16 + (lane & 15);
            bf16x8 bfr[4];
#pragma unroll
            for (int ks = 0; ks < 4; ++ks) bfr[ks] = *(const bf16x8*)(GT + (size_t)col * 128 + ks * 32 + (lane >> 4) * 8);
            const float lw = P->in[I_LNW][col], lb = P->in[I_LNB][col];
            const float mpv = mup[1024 + col], mnv = mun[1024 + col];
#pragma unroll 1
            for (int mt = 0; mt < 4; ++mt) {
                f32x4 acc = {0.f, 0.f, 0.f, 0.f};
#pragma unroll
                for (int ks = 0; ks < 4; ++ks) { const bf16x8 a = *(const LAS bf16x8*)(lds + (mt * 16 + (lane & 15)) * 272 + ks * 64 + (lane >> 4) * 16); acc = __builtin_amdgcn_mfma_f32_16x16x32_bf16(a, bfr[ks], acc, 0, 0, 0); }
#pragma unroll
                for (int rg = 0; rg < 4; ++rg) {
                    const int row = mt * 16 + (lane >> 4) * 4 + rg, m = tile * 64 + row;
                    const int t = m < 16384 ? m : (m - 16384) & 2047, Ls = m < 16384 ? 16384 : 2048;
                    const float y = bf2f(YD0[(size_t)m * 512 + col]) + bf2f(YD1[(size_t)m * 512 + col]);
                    const float yn = (y - st[(row * 8 + wid) * 2]) * st[(row * 8 + wid) * 2 + 1] * lw + lb;
                    const float vc = bf2f(VAb[(size_t)m * 512 + col]);
                    const float vp = bf2f(VAb[(t == 0 ? (size_t)(METAROW + 15) : (size_t)(m - 1)) * 512 + col]);
                    const float vn = t + 1 < Ls ? bf2f(VAb[(size_t)(m + 1) * 512 + col]) : 0.f;
                    const float vs = vc + mpv * (vp - vc) + mnv * (vn - vc);
                    const float cb = CB[(size_t)m * 8 + wid] + CB[((size_t)ROWS + m) * 8 + wid];
                    Rb[(size_t)m * 512 + col] = (bf16)f2bf_rne((yn + cb * vs) * acc[rg]);
                }
            }
        }
        __syncthreads();
    }
}

__device__ __forceinline__ void phase_rms_bf16(KP P) {
    const int tid = fresh_tid(), lane = tid & 63, wid = tid >> 6; const int gw = blockIdx.x * 8 + wid, NGW = gridDim.x * 8;
    bf16* MN = (bf16*)(P->ws + WS_MN);
    for (int m = gw; m < NMAIN; m += NGW) rms_row_bf16(P->out + (size_t)m * DM, P->in[I_GFFN], MN + (size_t)m * DM, lane);
}
__device__ __forceinline__ void phase_final(KP P) {
    const int tid = fresh_tid(), lane = tid & 63, wid = tid >> 6; const int gw = blockIdx.x * 8 + wid, NGW = gridDim.x * 8;
    const f32x4* gr = (const f32x4*)P->in[I_GFIN] + lane;
    for (int m = gw; m < NMAIN; m += NGW) {
        f32x4* xr = (f32x4*)(P->out + (size_t)m * DM) + lane; f32x4 v[4]; float s = 0.f;
#pragma unroll
        for (int j = 0; j < 4; ++j) { v[j] = xr[64 * j]; s += (v[j].x * v[j].x + v[j].y * v[j].y) + (v[j].z * v[j].z + v[j].w * v[j].w); }
        const float rstd = rsqrtf(wave_sum(s) * (1.f / DM) + 1e-6f);
#pragma unroll
        for (int j = 0; j < 4; ++j) xr[64 * j] = v[j] * rstd * gr[64 * j];
    }
}

constexpr int NRP_LONG = 4;
constexpr int N_LONG = 16 * NRP_LONG, N_ATT_P = 512, N_ATT_S = 512, N_SHORT = 128, N_ITEMS = N_LONG + N_ATT_P + N_ATT_S + N_SHORT;

template <class Op> __device__ __forceinline__ void run_gemm(LAS unsigned char* lds, const bf16* A, const bf16* Bt, int M, int N, int K, const Op& op, const bf16* A2 = nullptr, int pm2 = 1 << 30) {
    pg8::Gemm g{A, Bt, M, N, K, A2, pm2}; pg8::StaticOrder S; S.init(M, N, (int)gridDim.x, (int)blockIdx.x);
    Epi8<Op> E{op};
    pg8::gemm_phase<Epi8<Op>, pg8::StaticOrder, true, true>(lds, g, S, E);
}

#ifndef PROBE_MASK
#define PROBE_MASK 0
#endif
#ifndef PROBE_MUL
#define PROBE_MUL 1
#endif
#define PH_BEGIN(k) unsigned long long t0_##k = 0; if (PROBE_MASK & (1 << (k))) t0_##k = __builtin_amdgcn_s_memrealtime();
#define PH_END(k) if (PROBE_MASK & (1 << (k))) { const unsigned long long t1_ = __builtin_amdgcn_s_memrealtime(); const unsigned long long dt_ = (t1_ - t0_##k) * PROBE_MUL; while (__builtin_amdgcn_s_memrealtime() - t1_ < dt_) __builtin_amdgcn_s_sleep(8); grid.sync(); }
__global__ void __launch_bounds__(NTHREADS) fwd_megakernel(Params Pin) {
    extern __shared__ __attribute__((aligned(16))) unsigned char lds_raw[];
    LAS unsigned char* lds = (LAS unsigned char*)lds_raw;
    cg::grid_group grid = cg::this_grid();
    KP P0 = (KP)__builtin_amdgcn_kernarg_segment_ptr();
#define NEWPHASE KP P = P0; asm volatile("" : "+s"(P)); unsigned char* ws = P->ws; (void)ws;

    PH_BEGIN(0)
    { NEWPHASE phase_prologue(lds, P); }
    grid.sync();
    PH_END(0)
    PH_BEGIN(1)
    { NEWPHASE run_gemm(lds, (const bf16*)P->out, (const bf16*)(ws + WS_WIN), ROWS, 3328, 1024, OpProj{ws}, (const bf16*)(ws + WS_XNMETA), 128); }
    grid.sync();
    PH_END(1)
    PH_BEGIN(2)
    { NEWPHASE
        const int tid = fresh_tid();
        float lam;
        { const int lane = tid & 63; const float s1 = wave_sum(P->in[I_LQ1][lane] * P->in[I_LK1][lane]), s2 = wave_sum(P->in[I_LQ2][lane] * P->in[I_LK2][lane]); lam = __expf(s1) - __expf(s2) + 0.2f; }
        unsigned* ctr = (unsigned*)(ws + WS_CTL);
        LAS unsigned* slot = (LAS unsigned*)(lds + LDS_ITEM_OFF);
#define FETCH(k, n) if (tid == 0) *slot = atomicAdd(ctr + 64 * (k), 1u); __syncthreads(); const int idx = (int)*slot; __syncthreads(); if (idx >= (n)) break;
#ifndef NO_SCAN
#pragma unroll 1
        for (;;) { FETCH(0, N_LONG) const int u = idx / NRP_LONG; scan_unit<NRP_LONG, 4>(lds, P, 0, u >> 3, u & 7, idx % NRP_LONG); }
#endif
#ifndef NO_ATTN
#pragma unroll 1
        for (;;) { FETCH(1, N_ATT_P + N_ATT_S)
            if (idx < N_ATT_P) attn_unit(lds, P, 0, idx >> 7, idx & 127, lam);
            else { const int a = idx - N_ATT_P; attn_unit(lds, P, 1 + (a >> 6), (a >> 4) & 3, a & 15, lam); } }
#endif
#ifndef NO_SCAN
#pragma unroll 1
        for (;;) { FETCH(2, N_SHORT) scan_unit<1, 8>(lds, P, 1 + (idx >> 4), (idx >> 3) & 1, idx & 7, 0); }
#endif
#undef FETCH
    }
    grid.sync();
    PH_END(2)
#ifndef NO_POST
    PH_BEGIN(3)
    { NEWPHASE phase_post(lds, P); }
#endif
    grid.sync();
    PH_END(3)
    PH_BEGIN(4)
    { NEWPHASE run_gemm(lds, (const bf16*)P->out, (const bf16*)(ws + WS_WIN) + (size_t)3328 * 1024, NMAIN, 2048, 1024, OpGate{ws}); }
    grid.sync();
    PH_END(4)
    PH_BEGIN(5)
    { NEWPHASE run_gemm(lds, (const bf16*)(ws + WS_R), (const bf16*)(ws + WS_WUPA), NMAIN, 1024, 512, OpUpA{ws}); }
    grid.sync();
    PH_END(5)
    PH_BEGIN(6)
    { NEWPHASE run_gemm(lds, (const bf16*)(ws + WS_Q), (const bf16*)(ws + WS_WUPB), NMAIN, 1024, 512, OpUpB{ws}); }
    grid.sync();
    PH_END(6)
    PH_BEGIN(7)
    { NEWPHASE run_gemm(lds, (const bf16*)(ws + WS_GB), (const bf16*)(ws + WS_WOUT), NMAIN, 1024, 1024, OpOut{P->in[I_XP], P->in[I_XS], P->out}); }
    grid.sync();
    PH_END(7)
    PH_BEGIN(8)
    { NEWPHASE phase_rms_bf16(P); }
    grid.sync();
    PH_END(8)
    PH_BEGIN(9)
    { NEWPHASE run_gemm(lds, (const bf16*)(ws + WS_MN), (const bf16*)(ws + WS_WFF1), 16384, DFF, 1024, OpFF1{(bf16*)(ws + WS_HID)}); }
    grid.sync();
    PH_END(9)
    PH_BEGIN(10)
    { NEWPHASE run_gemm(lds, (const bf16*)(ws + WS_HID), (const bf16*)(ws + WS_WFF2), 16384, 1024, DFF, OpFF2{P->out}); }
    grid.sync();
    PH_END(10)
    PH_BEGIN(11)
    { NEWPHASE run_gemm(lds, (const bf16*)(ws + WS_MN) + (size_t)16384 * DM, (const bf16*)(ws + WS_WFF1), 16384, DFF, 1024, OpFF1{(bf16*)(ws + WS_HID)}); }
    grid.sync();
    PH_END(11)
    PH_BEGIN(12)
    { NEWPHASE run_gemm(lds, (const bf16*)(ws + WS_HID), (const bf16*)(ws + WS_WFF2), 16384, 1024, DFF, OpFF2{P->out + (size_t)16384 * DM}); }
    grid.sync();
    PH_END(12)
    PH_BEGIN(13)
    { NEWPHASE phase_final(P); }
}

extern "C" void kernel_launch(void* const* d_in, const int* in_sizes, int n_in, void* d_out, int out_size, void* d_ws, size_t ws_size, hipStream_t stream) {
    static int grid_blocks = 0;
    if (grid_blocks == 0) {
        int dev = 0, cus = 0, per_cu = 0;
        hipGetDevice(&dev);
        hipDeviceGetAttribute(&cus, hipDeviceAttributeMultiprocessorCount, dev);
        hipFuncSetAttribute((const void*)fwd_megakernel, hipFuncAttributeMaxDynamicSharedMemorySize, LDS_BYTES);
        hipOccupancyMaxActiveBlocksPerMultiprocessor(&per_cu, (const void*)fwd_megakernel, NTHREADS, LDS_BYTES);
        if (per_cu < 1) { fprintf(stderr, "kernel_launch: occupancy query says %d blocks per CU\n", per_cu); per_cu = 1; }
        grid_blocks = cus * per_cu;
        if (n_in != 29 || ws_size < WS_END) fprintf(stderr, "kernel_launch: unexpected n_in %d / ws_size %zu\n", n_in, ws_size);
    }
    hipMemsetAsync((unsigned char*)d_ws + WS_CTL, 0, 4096, stream);
    Params p{};
    for (int i = 0; i < 29; ++i) p.in[i] = (const float*)d_in[i];
    p.out = (float*)d_out; p.ws = (unsigned char*)d_ws;
    void* args[] = {&p};
    hipError_t e = hipLaunchCooperativeKernel((const void*)fwd_megakernel, dim3(grid_blocks), dim3(NTHREADS), args, LDS_BYTES, stream);
    if (e != hipSuccess) fprintf(stderr, "cooperative launch failed: %s (grid %d)\n", hipGetErrorString(e), grid_blocks);
}
```

```cpp
#include <hip/hip_runtime.h>
#include <hip/hip_cooperative_groups.h>
#include <cstdio>
#include <cstdint>
#include <cmath>
namespace cg = cooperative_groups;
__device__ __forceinline__ int fresh_tid() { int t = threadIdx.x; asm volatile("" : "+v"(t)); return t; }
namespace pg8 {
#define PG8_LAS __attribute__((address_space(3)))
typedef unsigned short bf16_t;
typedef short bf16x8 __attribute__((ext_vector_type(8)));
typedef float f32x4 __attribute__((ext_vector_type(4)));
typedef unsigned u32x4 __attribute__((ext_vector_type(4)));
constexpr int BM = 256, BK = 64, HALF = 128, HTB = HALF * BK * 2  , STAGE_BYTES = 8 * HTB, NXCD = 8, WGM = 8;

__host__ __device__ __forceinline__ int lds_byte(int r, int c) { const int st = (r >> 4) * 2 + (c >> 5), rr = r & 15, cc = c & 31, ob = rr * 64 + cc * 2; return st * 1024 + (ob ^ (((ob >> 9) & 1) << 5)); }
__host__ __device__ __forceinline__ void stage_rc(int b, int& R, int& C) { const int st = b / 1024, sb = b % 1024, swz = sb ^ (((sb >> 9) & 1) << 5); R = (st >> 1) * 16 + swz / 64; C = (st & 1) * 32 + (swz % 64) / 2; }
__host__ __device__ __forceinline__ int perm32(int rho) { const int n = rho >> 4, i = rho & 15; return 8 * (i >> 2) + 4 * n + (i & 3); }

struct Unit { int pm, pn; };
struct Gemm { const bf16_t* A; const bf16_t* Bt; int M, N, K; const bf16_t* A2; int pm2; };
__device__ __forceinline__ const char* gemm_abase(const Gemm& g, int pm, size_t tstep) { return pm >= g.pm2 ? (const char*)g.A2 + (size_t)(pm - g.pm2) * tstep : (const char*)g.A + (size_t)pm * tstep; }

struct StaticOrder {
    int nM, nN, nwg, G, c;
    __host__ __device__ void init(int M, int N, int G_, int c_) { nM = M / BM; nN = N / BM; nwg = nM * nN; G = G_; c = c_; }
    __host__ __device__ bool next(int i, Unit& u) const {
        const long L = (long)i * G + c; if (L >= nwg) return false;
        int wgid = (int)L; { const int q = nwg / NXCD, r = nwg % NXCD, xcd = wgid % NXCD, off = wgid / NXCD; wgid = (xcd < r ? xcd * (q + 1) : r * (q + 1) + (xcd - r) * q) + off; }
        const int nig = WGM * nN, gid = wgid / nig, fm = gid * WGM, gsz = (nM - fm) < WGM ? (nM - fm) : WGM;
        u.pm = fm + ((wgid % nig) % gsz); u.pn = (wgid % nig) / gsz; return true;
    }
    __device__ __forceinline__ void a_ready(const Unit&) const {}
    __device__ __forceinline__ void done(const Unit&) const {}
};


template <class Epi, class Sched, bool ALIGN_EPI = false, bool SP2 = false>
__device__ __forceinline__ void gemm_phase(PG8_LAS unsigned char* lds, const Gemm g, const Sched& S, const Epi& E) {
    const int tid = fresh_tid(), wid = __builtin_amdgcn_readfirstlane(tid >> 6), lane = tid & 63, wr = wid >> 2, wc = wid & 3, fr = lane & 15, fq = lane >> 4;
    const int K = g.K, nt = K / BK;
    unsigned voffA[2], voffB[2];
#pragma unroll
    for (int i = 0; i < 2; ++i) { int R, C; stage_rc(tid * 16 + i * 8192, R, C); const int Rb = Epi::PERM ? ((R & ~31) + perm32(R & 31)) : R;
        voffA[i] = (unsigned)(R * K + C) * 2u; voffB[i] = (unsigned)(Rb * K + C) * 2u; }
    const size_t kstep = (size_t)(BK * 2);
    const size_t hstep = (size_t)HALF * K * 2;
    const size_t tstep = 2 * hstep;
    const unsigned ldsw = (unsigned)wid * 1024u;
    const int aoff = lds_byte(wr * 64 + fr, fq * 8), boff = lds_byte(wc * 32 + fr, fq * 8);
#define PG8_SA(b, h) (((b) * 2 + (h)) * HTB)
#define PG8_SB(b, h) ((4 + (b) * 2 + (h)) * HTB)
#define PG8_STAGE(bufoff, gbase, voff) do { _Pragma("unroll") for (int _i = 0; _i < 2; ++_i) \
        __builtin_amdgcn_global_load_lds((const unsigned*)((const char*)(gbase) + (voff)[_i]), (PG8_LAS unsigned*)(lds + (bufoff) + ldsw + _i * 8192), 16, 0, 0); } while (0)
#define PG8_LDA(dst, b, h) do { _Pragma("unroll") for (int m = 0; m < 4; ++m) _Pragma("unroll") for (int k = 0; k < 2; ++k) dst[m][k] = *(const PG8_LAS bf16x8*)(lds + PG8_SA(b, h) + aoff + m * 2048 + k * 1024); } while (0)
#define PG8_LDB(dst, b, h) do { _Pragma("unroll") for (int n = 0; n < 2; ++n) _Pragma("unroll") for (int k = 0; k < 2; ++k) dst[n][k] = *(const PG8_LAS bf16x8*)(lds + PG8_SB(b, h) + boff + n * 2048 + k * 1024); } while (0)
#define PG8_MMA(ai, bj, At, Bt) do { __builtin_amdgcn_s_setprio(1); _Pragma("unroll") for (int m = 0; m < 4; ++m) _Pragma("unroll") for (int n = 0; n < 2; ++n) _Pragma("unroll") for (int k = 0; k < 2; ++k) \
        acc[ai][bj][m][n] = __builtin_amdgcn_mfma_f32_16x16x32_bf16(Bt[n][k], At[m][k], acc[ai][bj][m][n], 0, 0, 0); __builtin_amdgcn_s_setprio(0); } while (0)
#define PG8_WAIT_V(n) asm volatile("s_waitcnt vmcnt(" #n ")" ::: "memory")
#define PG8_WAIT_L(n) asm volatile("s_waitcnt lgkmcnt(" #n ")" ::: "memory")
#define PG8_BAR __builtin_amdgcn_s_barrier()
#define PG8_SCHED __builtin_amdgcn_sched_barrier(0)
    Unit cur, nxt; int ui = 0;
    if (!S.next(0, cur)) return;
    f32x4 acc[2][2][4][2];
#pragma unroll
    for (int a = 0; a < 2; ++a)
#pragma unroll
        for (int b = 0; b < 2; ++b)
#pragma unroll
            for (int m = 0; m < 4; ++m)
#pragma unroll
                for (int n = 0; n < 2; ++n) acc[a][b][m][n] = (f32x4){0.f, 0.f, 0.f, 0.f};
    bf16x8 At[4][2], B0[2][2], B1[2][2];
    const char* cA = gemm_abase(g, cur.pm, tstep); const char* cB = (const char*)g.Bt + (size_t)cur.pn * tstep;
    S.a_ready(cur);
    if constexpr (SP2) {
        PG8_STAGE(PG8_SB(0, 0), cB, voffB); PG8_STAGE(PG8_SB(0, 1), cB + hstep, voffB); PG8_STAGE(PG8_SA(0, 0), cA, voffA); PG8_STAGE(PG8_SA(0, 1), cA + hstep, voffA);
        if (wr == 1) PG8_BAR;
        PG8_WAIT_V(2); PG8_BAR;
        PG8_STAGE(PG8_SB(1, 0), cB + kstep, voffB); PG8_STAGE(PG8_SA(1, 0), cA + kstep, voffA); PG8_STAGE(PG8_SB(1, 1), cB + hstep + kstep, voffB);
        PG8_WAIT_V(6); PG8_BAR;
    } else {
        PG8_STAGE(PG8_SB(0, 0), cB, voffB); PG8_STAGE(PG8_SA(0, 0), cA, voffA); PG8_STAGE(PG8_SB(0, 1), cB + hstep, voffB); PG8_STAGE(PG8_SA(0, 1), cA + hstep, voffA);
        if (wr == 1) PG8_BAR;
        PG8_WAIT_V(4); PG8_BAR;
        PG8_STAGE(PG8_SB(1, 0), cB + kstep, voffB); PG8_STAGE(PG8_SA(1, 0), cA + kstep, voffA); PG8_STAGE(PG8_SB(1, 1), cB + hstep + kstep, voffB);
        PG8_WAIT_V(6); PG8_BAR;
    }
    for (;;) {
        const bool has_next = S.next(ui + 1, nxt);
        const char* nA = has_next ? gemm_abase(g, nxt.pm, tstep) : cA; const char* nB = has_next ? (const char*)g.Bt + (size_t)nxt.pn * tstep : cB;
        for (int t = 0; t < nt; t += 2) {
            const bool last = (t == nt - 2);
            const char* a1 = cA + (size_t)(t + 1) * kstep;
            const char* a2 = last ? nA : cA + (size_t)(t + 2) * kstep; const char* b2 = last ? nB : cB + (size_t)(t + 2) * kstep;
            const char* a3 = a2 + kstep; const char* b3 = b2 + kstep;
            if (last && has_next) S.a_ready(nxt);
            if constexpr (SP2) {
            PG8_LDB(B0, 0, 0); PG8_LDB(B1, 0, 1); PG8_SCHED; PG8_LDA(At, 0, 0); PG8_STAGE(PG8_SA(1, 1), a1 + hstep, voffA);
            PG8_WAIT_V(8); PG8_WAIT_L(0); PG8_BAR; PG8_MMA(0, 0, At, B0); PG8_MMA(0, 1, At, B1); PG8_BAR; PG8_SCHED;
            PG8_LDA(At, 0, 1); PG8_STAGE(PG8_SB(0, 0), b2, voffB); PG8_STAGE(PG8_SB(0, 1), b2 + hstep, voffB); PG8_STAGE(PG8_SA(0, 0), a2, voffA);
            PG8_WAIT_V(8); PG8_WAIT_L(0); PG8_BAR; PG8_MMA(1, 0, At, B0); PG8_MMA(1, 1, At, B1); PG8_BAR; PG8_SCHED;
            PG8_LDB(B0, 1, 0); PG8_LDB(B1, 1, 1); PG8_SCHED; PG8_LDA(At, 1, 0); PG8_STAGE(PG8_SA(0, 1), a2 + hstep, voffA);
            PG8_WAIT_V(8); PG8_WAIT_L(0); PG8_BAR; PG8_MMA(0, 0, At, B0); PG8_MMA(0, 1, At, B1); PG8_BAR; PG8_SCHED;
            PG8_LDA(At, 1, 1); PG8_STAGE(PG8_SB(1, 0), b3, voffB); PG8_STAGE(PG8_SB(1, 1), b3 + hstep, voffB); PG8_STAGE(PG8_SA(1, 0), a3, voffA);
            PG8_WAIT_V(8); PG8_WAIT_L(0); PG8_BAR; PG8_MMA(1, 0, At, B0); PG8_MMA(1, 1, At, B1); PG8_BAR; PG8_SCHED;
            } else {
            PG8_LDB(B0, 0, 0); PG8_SCHED; PG8_LDA(At, 0, 0); PG8_STAGE(PG8_SA(1, 1), a1 + hstep, voffA);
            PG8_WAIT_L(8); PG8_BAR; PG8_WAIT_L(0); PG8_MMA(0, 0, At, B0); PG8_BAR; PG8_SCHED;
            PG8_LDB(B1, 0, 1); PG8_STAGE(PG8_SB(0, 0), b2, voffB);
            PG8_BAR; PG8_WAIT_L(0); PG8_MMA(0, 1, At, B1); PG8_BAR;
            PG8_LDA(At, 0, 1); PG8_STAGE(PG8_SA(0, 0), a2, voffA);
            PG8_BAR; PG8_WAIT_L(0); PG8_MMA(1, 0, At, B0); PG8_BAR; PG8_SCHED;
            PG8_STAGE(PG8_SB(0, 1), b2 + hstep, voffB);
            PG8_WAIT_V(6); PG8_BAR; PG8_MMA(1, 1, At, B1); PG8_BAR;
            PG8_LDB(B0, 1, 0); PG8_SCHED; PG8_LDA(At, 1, 0); PG8_STAGE(PG8_SA(0, 1), a2 + hstep, voffA);
            PG8_WAIT_L(8); PG8_BAR; PG8_WAIT_L(0); PG8_MMA(0, 0, At, B0); PG8_BAR; PG8_SCHED;
            PG8_LDB(B1, 1, 1); PG8_STAGE(PG8_SB(1, 0), b3, voffB);
            PG8_BAR; PG8_WAIT_L(0); PG8_MMA(0, 1, At, B1); PG8_BAR;
            PG8_LDA(At, 1, 1); PG8_STAGE(PG8_SA(1, 0), a3, voffA);
            PG8_BAR; PG8_WAIT_L(0); PG8_MMA(1, 0, At, B0); PG8_BAR; PG8_SCHED;
            PG8_STAGE(PG8_SB(1, 1), b3 + hstep, voffB);
            PG8_WAIT_V(6); PG8_BAR; PG8_MMA(1, 1, At, B1); PG8_BAR;
            }
        }
        if constexpr (ALIGN_EPI) { if (wr == 0) PG8_BAR; }
        if constexpr (!Epi::AFTER_DRAIN) { E(acc, cur, wr, wc, fr, fq); S.done(cur); }
        if (!has_next) break;
#pragma unroll
        for (int a = 0; a < 2; ++a)
#pragma unroll
            for (int b = 0; b < 2; ++b)
#pragma unroll
                for (int m = 0; m < 4; ++m)
#pragma unroll
                    for (int n = 0; n < 2; ++n) acc[a][b][m][n] = (f32x4){0.f, 0.f, 0.f, 0.f};
        cur = nxt; cA = nA; cB = nB; ++ui;
        if constexpr (ALIGN_EPI) { if (wr == 1) PG8_BAR; }
    }
    PG8_WAIT_V(0);
    if constexpr (!ALIGN_EPI) { if (wr == 0) PG8_BAR; }
    PG8_BAR;
    if constexpr (Epi::AFTER_DRAIN) { E.fused(acc, cur, wr, wc, fr, fq, lds, wid, lane); S.done(cur); }
#undef PG8_SA
#undef PG8_SB
#undef PG8_STAGE
#undef PG8_LDA
#undef PG8_LDB
#undef PG8_MMA
#undef PG8_WAIT_V
#undef PG8_WAIT_L
#undef PG8_BAR
#undef PG8_SCHED
}
}

#ifndef PG8_SP2
#define PG8_SP2 true
#endif

#define LAS __attribute__((address_space(3)))
typedef unsigned short bf16;
typedef short bf16x8 __attribute__((ext_vector_type(8)));
typedef float f32x4 __attribute__((ext_vector_type(4)));
typedef float f32x16 __attribute__((ext_vector_type(16)));
typedef unsigned u32x4 __attribute__((ext_vector_type(4)));
typedef unsigned u32x2 __attribute__((ext_vector_type(2)));

constexpr int DM = 1024, NMAIN = 32768, ROWS = 33024, METAROW = 32768, DFF = 4096;
constexpr int NTHREADS = 512;
constexpr int LDS_BYTES = 147456;
constexpr int LDS_ITEM_OFF = LDS_BYTES - 16;
constexpr size_t MiB = 1u << 20;
constexpr size_t WS_CTL = 0, WS_WIN = 1 * MiB, WS_WUPA = 12 * MiB, WS_WUPB = 13 * MiB, WS_WOUT = 14 * MiB, WS_WFF1 = 16 * MiB, WS_WFF2 = 24 * MiB;
constexpr size_t WS_LORA = 32 * MiB, WS_XNMETA = 32 * MiB + 512 * 1024, WS_CB = 33 * MiB, WS_ACT = 36 * MiB;
constexpr size_t ACT_SZ = (size_t)ROWS * 512 * 2, L_SZ = (size_t)ROWS * 256 * 2;
constexpr size_t WS_R = WS_ACT, WS_KA = WS_R + ACT_SZ, WS_VA = WS_KA + ACT_SZ, WS_L = WS_VA + ACT_SZ, WS_Q = WS_L + L_SZ, WS_KB = WS_Q + ACT_SZ, WS_VT = WS_KB + ACT_SZ, WS_END = WS_VT + ACT_SZ;
constexpr size_t WS_GA = WS_KA, WS_GB = WS_KB, WS_MN = WS_ACT, WS_HID = WS_ACT + 64 * MiB;
static_assert(WS_END <= 256 * MiB && WS_HID + 128 * MiB <= 256 * MiB && WS_CB + (size_t)2 * ROWS * 8 * 4 <= WS_ACT, "ws map");
constexpr float LOG2E = 1.4426950408889634f;
constexpr float QSCALE = 0.125f * LOG2E;

struct Params { const float* in[29]; float* out; unsigned char* ws; };
typedef const __attribute__((address_space(4))) Params* KP;
enum { I_XP = 0, I_XS, I_META, I_GMIX, I_WIN, I_MUP, I_MUN, I_W0, I_WUP, I_A0, I_AUP, I_GUP, I_KK, I_KA, I_RK, I_LNW, I_LNB, I_LQ1, I_LK1, I_LQ2, I_LK2, I_SUBG, I_UPA, I_UPB, I_WOUT, I_GFFN, I_FF1, I_FF2, I_GFIN };

__device__ __forceinline__ unsigned cvtpk(float lo, float hi) { unsigned r; asm volatile("v_cvt_pk_bf16_f32 %0, %1, %2" : "=v"(r) : "v"(lo), "v"(hi)); return r; }
__device__ __forceinline__ float bf2f(unsigned short b) { return __uint_as_float(((unsigned)b) << 16); }
__device__ __forceinline__ float bflo(unsigned w) { return __uint_as_float(w << 16); }
__device__ __forceinline__ float bfhi(unsigned w) { return __uint_as_float(w & 0xffff0000u); }
__device__ __forceinline__ void unpack8(const u32x4 v, float* o) { o[0] = bflo(v.x); o[1] = bfhi(v.x); o[2] = bflo(v.y); o[3] = bfhi(v.y); o[4] = bflo(v.z); o[5] = bfhi(v.z); o[6] = bflo(v.w); o[7] = bfhi(v.w); }
__device__ __forceinline__ float wave_sum(float v) {
#pragma unroll
    for (int o = 1; o < 64; o <<= 1) v += __shfl_xor(v, o);
    return v;
}
__device__ __forceinline__ float sigmoidf_(float x) { return 1.0f / (1.0f + __expf(-x)); }
__device__ __forceinline__ int seq_base(int s) { return s == 0 ? 0 : 16384 + (s - 1) * 2048; }
__device__ __forceinline__ int seq_len(int s) { return s == 0 ? 16384 : 2048; }
__device__ __forceinline__ int pos_row(int base, int p) { return p < 16 ? METAROW + p : base + p - 16; }

template <class Op> struct Epi8 {
    static constexpr bool PERM = true, AFTER_DRAIN = false;
    Op op;
    __device__ __forceinline__ void operator()(const pg8::f32x4 (&acc)[2][2][4][2], const pg8::Unit& u, int wr, int wc, int fr, int fq) const {
        const int row0 = u.pm * 256 + wr * 64 + fr, col0 = u.pn * 256 + wc * 32 + 8 * fq;
#pragma unroll
        for (int ai = 0; ai < 2; ++ai)
#pragma unroll
            for (int m = 0; m < 4; ++m)
#pragma unroll
                for (int bj = 0; bj < 2; ++bj) { op.apply(row0 + ai * 128 + m * 16, col0 + bj * 128, u.pn, acc[ai][bj][m][0], acc[ai][bj][m][1]); asm volatile("" ::: "memory"); }
    }
};
__device__ __forceinline__ u32x4 pack8(const f32x4 a, const f32x4 b) { u32x4 w; w.x = cvtpk(a[0], a[1]); w.y = cvtpk(a[2], a[3]); w.z = cvtpk(b[0], b[1]); w.w = cvtpk(b[2], b[3]); return w; }

constexpr int CW_KN = 320;
__device__ __forceinline__ float dpp_max16(float v) {
    int x = __float_as_int(v);
    v = fmaxf(v, __int_as_float(__builtin_amdgcn_update_dpp(0, x, 0xB1, 0xf, 0xf, true))); x = __float_as_int(v);
    v = fmaxf(v, __int_as_float(__builtin_amdgcn_update_dpp(0, x, 0x4E, 0xf, 0xf, true))); x = __float_as_int(v);
    v = fmaxf(v, __int_as_float(__builtin_amdgcn_update_dpp(0, x, 0x141, 0xf, 0xf, true))); x = __float_as_int(v);
    v = fmaxf(v, __int_as_float(__builtin_amdgcn_update_dpp(0, x, 0x140, 0xf, 0xf, true)));
    return v;
}
struct OpProj {
    unsigned char* ws;
    __device__ __forceinline__ void apply(int row, int col, int pn, f32x4 v0, f32x4 v1) const {
        if (pn >= 11) {
            bf16* VT = (bf16*)(ws + WS_VT); const int c = col - 11 * 256;
#pragma unroll
            for (int e = 0; e < 4; ++e) { VT[(size_t)(c + e) * ROWS + row] = (bf16)(cvtpk(v0[e], 0.f) & 0xffffu); VT[(size_t)(c + 4 + e) * ROWS + row] = (bf16)(cvtpk(v1[e], 0.f) & 0xffffu); }
            return;
        }
        bf16* O; int ldc = 512, c;
        if (pn < 2) { O = (bf16*)(ws + WS_R); c = col; }
        else if (pn < 4) { O = (bf16*)(ws + WS_KA); c = col - 512; }
        else if (pn < 6) { O = (bf16*)(ws + WS_VA); c = col - 1024; }
        else if (pn < 7) { O = (bf16*)(ws + WS_L); c = col - 1536; ldc = 256; }
        else if (pn < 9) { O = (bf16*)(ws + WS_Q); c = col - 1792; v0 = v0 * QSCALE; v1 = v1 * QSCALE; }
        else { O = (bf16*)(ws + WS_KB); c = col - 2304; }
        const u32x4 w = pack8(v0, v1);
        *(u32x4*)(O + (size_t)row * ldc + c) = w;
        if (pn >= 9) {
            float k8[8]; unpack8(w, k8); float ss = 0.f;
#pragma unroll
            for (int e = 0; e < 8; ++e) ss = fmaf(k8[e], k8[e], ss);
            ss = dpp_max16(ss);
            if ((threadIdx.x & 15) == 0) { const int sidx = row < 16384 ? 0 : row < NMAIN ? 1 + ((row - 16384) >> 11) : 9;
                atomicMax((unsigned*)(ws + WS_CTL) + CW_KN + sidx * 64 + (c >> 3), __float_as_uint(ss)); }
        }
    }
};
struct OpGate {
    unsigned char* ws;
    __device__ __forceinline__ void apply(int row, int col, int pn, f32x4 v0, f32x4 v1) const {
        bf16* O = (bf16*)(ws + (pn < 4 ? WS_GA : WS_GB)); const int c = pn < 4 ? col : col - 1024;
#pragma unroll
        for (int e = 0; e < 4; ++e) { v0[e] = sigmoidf_(v0[e]); v1[e] = sigmoidf_(v1[e]); }
        *(u32x4*)(O + (size_t)row * 1024 + c) = pack8(v0, v1);
    }
};
struct OpUpA {
    unsigned char* ws;
    __device__ __forceinline__ void apply(int row, int col, int pn, f32x4 v0, f32x4 v1) const {
        u32x4* p = (u32x4*)((bf16*)(ws + WS_GA) + (size_t)row * 1024 + col); float g[8]; unpack8(*p, g);
#pragma unroll
        for (int e = 0; e < 4; ++e) { v0[e] *= g[e]; v1[e] *= g[4 + e]; }
        *p = pack8(v0, v1);
    }
};
struct OpUpB {
    unsigned char* ws;
    __device__ __forceinline__ void apply(int row, int col, int pn, f32x4 v0, f32x4 v1) const {
        u32x4* p = (u32x4*)((bf16*)(ws + WS_GB) + (size_t)row * 1024 + col); float g[8], a[8]; unpack8(*p, g);
        unpack8(*(const u32x4*)((const bf16*)(ws + WS_GA) + (size_t)row * 1024 + col), a);
#pragma unroll
        for (int e = 0; e < 4; ++e) { v0[e] = a[e] + v0[e] * g[e]; v1[e] = a[4 + e] + v1[e] * g[4 + e]; }
        *p = pack8(v0, v1);
    }
};
struct OpOut {
    const float* xp; const float* xs; float* out;
    __device__ __forceinline__ void apply(int row, int col, int pn, f32x4 v0, f32x4 v1) const {
        const float* x = (row < 16384 ? xp + (size_t)row * DM : xs + (size_t)(row - 16384) * DM) + col;
        float* o = out + (size_t)row * DM + col;
        *(f32x4*)o = *(const f32x4*)x + v0; *(f32x4*)(o + 4) = *(const f32x4*)(x + 4) + v1;
    }
};
struct OpFF1 {
    bf16* hid;
    __device__ __forceinline__ void apply(int row, int col, int pn, f32x4 v0, f32x4 v1) const {
#pragma unroll
        for (int e = 0; e < 4; ++e) { const float a = fmaxf(v0[e], 0.f), b = fmaxf(v1[e], 0.f); v0[e] = a * a; v1[e] = b * b; }
        *(u32x4*)(hid + (size_t)row * DFF + col) = pack8(v0, v1);
    }
};
struct OpFF2 {
    float* out;
    __device__ __forceinline__ void apply(int row, int col, int pn, f32x4 v0, f32x4 v1) const {
        float* o = out + (size_t)row * DM + col;
        *(f32x4*)o = *(const f32x4*)o + v0; *(f32x4*)(o + 4) = *(const f32x4*)(o + 4) + v1;
    }
};

__device__ __forceinline__ unsigned f2bf_rne(float f) { return cvtpk(f, 0.f) & 0xffffu; }
__device__ __forceinline__ void transpose_item(const float* W, int K, int N, bf16* WT, LAS float* scr, int item, int lane) {
    const int nblk = N / 32, kb = item / nblk, nb = item % nblk, k0 = 64 * kb, n0 = 32 * nb;
#pragma unroll 8
    for (int i = 0; i < 32; ++i) { const int kk = 2 * i + (lane >> 5); scr[kk * 33 + (lane & 31)] = W[(size_t)(k0 + kk) * N + n0 + (lane & 31)]; }
    asm volatile("s_waitcnt vmcnt(0) lgkmcnt(0)" ::: "memory");
    const int c = lane & 7;
#pragma unroll
    for (int j = 0; j < 4; ++j) { const int n = (lane >> 3) + 8 * j; const LAS float* s = scr + (8 * c) * 33 + n;
        u32x4 o; o.x = cvtpk(s[0 * 33], s[1 * 33]); o.y = cvtpk(s[2 * 33], s[3 * 33]); o.z = cvtpk(s[4 * 33], s[5 * 33]); o.w = cvtpk(s[6 * 33], s[7 * 33]);
        *(u32x4*)(WT + (size_t)(n0 + n) * K + k0 + 8 * c) = o; }
    asm volatile("s_waitcnt lgkmcnt(0)" ::: "memory");
}
__device__ __forceinline__ void rms_row_bf16(const float* src, const float* g, bf16* dst, int lane) {
    unsigned long long* o8 = (unsigned long long*)dst + lane;
    if (!src) {
#pragma unroll
        for (int j = 0; j < 4; ++j) o8[64 * j] = 0ull;
        return; }
    const f32x4* xr = (const f32x4*)src + lane; const f32x4* gr = (const f32x4*)g + lane;
    f32x4 v[4]; float s = 0.f;
#pragma unroll
    for (int j = 0; j < 4; ++j) { v[j] = xr[64 * j]; s += (v[j].x * v[j].x + v[j].y * v[j].y) + (v[j].z * v[j].z + v[j].w * v[j].w); }
    const float rstd = rsqrtf(wave_sum(s) * (1.f / DM) + 1e-6f);
#pragma unroll
    for (int j = 0; j < 4; ++j) { const f32x4 gg = gr[64 * j]; const f32x4 y = v[j] * rstd * gg;
        o8[64 * j] = (unsigned long long)cvtpk(y.x, y.y) | ((unsigned long long)cvtpk(y.z, y.w) << 32); }
}
__device__ __forceinline__ void phase_prologue(LAS unsigned char* lds, KP P) {
    const int tid = fresh_tid(), lane = tid & 63, wid = tid >> 6;
    LAS float* scr = (LAS float*)(lds + wid * 16384);
    const int gw = blockIdx.x * 8 + wid, NGW = gridDim.x * 8;
    unsigned char* ws = P->ws;
    constexpr int I_IN = (1024 / 64) * (5376 / 32), I_UP = (512 / 64) * (1024 / 32), I_O = (1024 / 64) * (1024 / 32), I_1 = (1024 / 64) * (4096 / 32), I_2 = (4096 / 64) * (1024 / 32);
    constexpr int I_LW = (64 / 64) * (512 / 32), I_G = (128 / 64) * (512 / 32);
    constexpr int NITEMS = I_IN + 2 * I_UP + I_O + I_1 + I_2 + 4 * I_LW + I_G;
    for (int it = gw; it < NITEMS; it += NGW) {
        int r = it;
        if (r < I_IN) { transpose_item(P->in[I_WIN], 1024, 5376, (bf16*)(ws + WS_WIN), scr, r, lane); continue; } r -= I_IN;
        if (r < I_UP) { transpose_item(P->in[I_UPA], 512, 1024, (bf16*)(ws + WS_WUPA), scr, r, lane); continue; } r -= I_UP;
        if (r < I_UP) { transpose_item(P->in[I_UPB], 512, 1024, (bf16*)(ws + WS_WUPB), scr, r, lane); continue; } r -= I_UP;
        if (r < I_O) { transpose_item(P->in[I_WOUT], 1024, 1024, (bf16*)(ws + WS_WOUT), scr, r, lane); continue; } r -= I_O;
        if (r < I_1) { transpose_item(P->in[I_FF1], 1024, 4096, (bf16*)(ws + WS_WFF1), scr, r, lane); continue; } r -= I_1;
        if (r < I_2) { transpose_item(P->in[I_FF2], 4096, 1024, (bf16*)(ws + WS_WFF2), scr, r, lane); continue; } r -= I_2;
        if (r < 2 * I_LW) { const int d = r / I_LW; transpose_item(P->in[I_WUP] + (size_t)d * 64 * 512, 64, 512, (bf16*)(ws + WS_LORA) + (size_t)d * 512 * 64, scr, r % I_LW, lane); continue; } r -= 2 * I_LW;
        if (r < 2 * I_LW) { const int d = r / I_LW; transpose_item(P->in[I_AUP] + (size_t)d * 64 * 512, 64, 512, (bf16*)(ws + WS_LORA + 131072) + (size_t)d * 512 * 64, scr, r % I_LW, lane); continue; } r -= 2 * I_LW;
        transpose_item(P->in[I_GUP], 128, 512, (bf16*)(ws + WS_LORA + 262144), scr, r, lane);
    }
    bf16* XN = (bf16*)P->out; bf16* XM = (bf16*)(ws + WS_XNMETA);
    for (int m = gw; m < ROWS; m += NGW) {
        const float* src = m < 16384 ? P->in[I_XP] + (size_t)m * DM : m < NMAIN ? P->in[I_XS] + (size_t)(m - 16384) * DM : (m - NMAIN < 16 ? P->in[I_META] + (size_t)(m - NMAIN) * DM : nullptr);
        bf16* dst = m < NMAIN ? XN + (size_t)m * DM : XM + (size_t)(m - NMAIN) * DM;
        rms_row_bf16(src, P->in[I_GMIX], dst, lane);
    }
}

constexpr int AT_KSTR = 272, AT_VSTR = 144, AT_KSZ = 64 * AT_KSTR, AT_BUF = AT_KSZ + 128 * AT_VSTR;
__device__ __forceinline__ f32x16 mfma32(bf16x8 a, bf16x8 b, f32x16 c) { return __builtin_amdgcn_mfma_f32_32x32x16_bf16(a, b, c, 0, 0, 0); }
__device__ __forceinline__ void attn_unit(LAS unsigned char* lds, KP P, int s, int h, int qb, float lam) {
    int tid_ = threadIdx.x; asm volatile("" : "+v"(tid_));
    const int tid = tid_, lane = tid & 63, r32 = lane & 31, hi = lane >> 5, wid = __builtin_amdgcn_readfirstlane(tid >> 6), rg = wid & 3, mp = wid >> 2;
    const int L = seq_len(s), base = seq_base(s), NT = 1 + L / 64;
    unsigned char* ws = P->ws;
    const bf16* KB = (const bf16*)(ws + WS_KB); const bf16* VT = (const bf16*)(ws + WS_VT); bf16* Q = (bf16*)(ws + WS_Q);
    const int qrow = base + qb * 128 + rg * 32 + r32;
    bf16x8 q[4];
#pragma unroll
    for (int d0 = 0; d0 < 4; ++d0) q[d0] = *(const bf16x8*)(Q + (size_t)qrow * 512 + h * 128 + mp * 64 + d0 * 16 + hi * 8);
    f32x16 O[4];
#pragma unroll
    for (int b = 0; b < 4; ++b)
#pragma unroll
        for (int r = 0; r < 16; ++r) O[b][r] = 0.f;
    float mx = -INFINITY, ls = 0.f;
    const float qh = (float)(16 + qb * 128 + rg * 32 + r32 - 4 * hi);
    const float nslope = -exp2f(-2.0f * (float)(h + 1)) * LOG2E;
    const int kr0 = tid >> 4, kc = tid & 15, vn0 = tid >> 3, vc = tid & 7;
    u32x4 kreg[2], vreg[2];
    const unsigned kgo = (unsigned)((kr0 * 512 + h * 128 + kc * 8) * 2), vgo = (unsigned)(((h * 128 + vn0) * ROWS + vc * 8) * 2);
    const unsigned klo = (unsigned)(kr0 * AT_KSTR + kc * 16), vlo = (unsigned)(AT_KSZ + vn0 * AT_VSTR + vc * 16);
#define AT_GLOAD(j) do { const int m0_ = (j) == 0 ? METAROW : base + 64 * ((j) - 1); \
        const unsigned char* kt_ = (const unsigned char*)KB + (size_t)m0_ * 1024; const unsigned char* vt_ = (const unsigned char*)VT + (size_t)m0_ * 2; \
        kreg[0] = *(const u32x4*)(kt_ + kgo); kreg[1] = *(const u32x4*)(kt_ + 32 * 1024 + kgo); \
        vreg[0] = *(const u32x4*)(vt_ + vgo); vreg[1] = *(const u32x4*)(vt_ + (size_t)64 * ROWS * 2 + vgo); } while (0)
#define AT_LSTORE(buf) do { LAS unsigned char* kb_ = lds + (buf) * AT_BUF; \
        *(LAS u32x4*)(kb_ + klo) = kreg[0]; *(LAS u32x4*)(kb_ + klo + 32 * AT_KSTR) = kreg[1]; \
        *(LAS u32x4*)(kb_ + vlo) = vreg[0]; *(LAS u32x4*)(kb_ + vlo + 64 * AT_VSTR) = vreg[1]; } while (0)
    float qn, kn;
    { float ssq = 0.f;
#pragma unroll
      for (int d0 = 0; d0 < 4; ++d0) { float t[8]; unpack8(__builtin_bit_cast(u32x4, q[d0]), t);
#pragma unroll
        for (int e = 0; e < 8; ++e) ssq = fmaf(t[e], t[e], ssq); }
      ssq += __shfl_xor(ssq, 32); qn = sqrtf(ssq) * 1.002f;
      const unsigned* KN = (const unsigned*)(ws + WS_CTL) + CW_KN; float ks = 0.f;
#pragma unroll
      for (int g = 0; g < 8; ++g) ks += fmaxf(__uint_as_float(__hip_atomic_load(KN + s * 64 + h * 16 + mp * 8 + g, __ATOMIC_RELAXED, __HIP_MEMORY_SCOPE_AGENT)), __uint_as_float(__hip_atomic_load(KN + 9 * 64 + h * 16 + mp * 8 + g, __ATOMIC_RELAXED, __HIP_MEMORY_SCOPE_AGENT)));
      kn = sqrtf(ks) * 1.002f; }
    const int jc0 = 1 + qb * 2;
    int jlo = jc0, jhi = jc0 + 1;
    LAS float* red = (LAS float*)(lds + 2 * AT_BUF);
#pragma unroll 1
    for (int ph = 0; ph < 2; ++ph) {
        int nleft, ntl;
        if (ph == 0) { nleft = 0; ntl = 2; }
        else {
            float dneed = (qn * kn - mx + 40.0f) / (-nslope);
#pragma unroll
            for (int o = 1; o < 64; o <<= 1) dneed = fmaxf(dneed, __shfl_xor(dneed, o));
            if (lane == 0) red[wid] = dneed;
            __syncthreads();
            float dm = red[0];
#pragma unroll
            for (int w8 = 1; w8 < 8; ++w8) dm = fmaxf(dm, red[w8]);
            dm = fminf(fmaxf(dm, 0.f), 1.0e6f);
            const int dmax = (int)dm + 1, q0 = 16 + qb * 128;
            const int plo = q0 - dmax, phi = q0 + 127 + dmax;
            jlo = plo < 16 ? 0 : 1 + ((plo - 16) >> 6); jhi = phi >= L + 16 ? NT - 1 : 1 + ((phi - 16) >> 6);
            if (jlo > jc0) jlo = jc0; if (jhi < jc0 + 1) jhi = jc0 + 1;
            nleft = jc0 - jlo; ntl = nleft + (jhi - jc0 - 1);
        }
        if (ntl > 0) {
#define AT_J(t) (ph == 0 ? jc0 + (t) : ((t) < nleft ? jlo + (t) : jc0 + 2 + ((t) - nleft)))
        { const int jf = AT_J(0); AT_GLOAD(jf); } AT_LSTORE(0); __syncthreads();
#pragma unroll 1
        for (int t = 0; t < ntl; ++t) {
            const int j = AT_J(t);
            if (t + 1 < ntl) { const int jn = AT_J(t + 1); AT_GLOAD(jn); }
            const LAS unsigned char* Kb = lds + (t & 1) * AT_BUF + mp * 128; const LAS unsigned char* Vb = lds + (t & 1) * AT_BUF + AT_KSZ;
            const float dq = qh - (float)(j == 0 ? 0 : 64 * j - 48);
            f32x16 p0, p1;
#pragma unroll
            for (int r = 0; r < 16; ++r) { p0[r] = 0.f; p1[r] = 0.f; }
#pragma unroll
            for (int d0 = 0; d0 < 4; ++d0) {
                const bf16x8 a0 = *(const LAS bf16x8*)(Kb + r32 * AT_KSTR + d0 * 32 + hi * 16);
                const bf16x8 a1 = *(const LAS bf16x8*)(Kb + (32 + r32) * AT_KSTR + d0 * 32 + hi * 16);
                p0 = mfma32(a0, q[d0], p0); p1 = mfma32(a1, q[d0], p1);
            }
#pragma unroll
            for (int r = 0; r < 16; ++r) { const float dd = dq - (float)((r & 3) + 8 * (r >> 2)); p0[r] = fmaf(fabsf(dd), nslope, p0[r]); p1[r] = fmaf(fabsf(dd - 32.f), nslope, p1[r]); }
            if (j == 0) {
#pragma unroll
                for (int r = 0; r < 16; ++r) { if ((r & 3) + 8 * (r >> 2) + 4 * hi >= 16) p0[r] = -INFINITY; p1[r] = -INFINITY; }
            }
            float rm = fmaxf(p0[0], p1[0]);
#pragma unroll
            for (int r = 1; r < 16; ++r) rm = fmaxf(rm, fmaxf(p0[r], p1[r]));
            rm = fmaxf(rm, __shfl_xor(rm, 32));
            const float mn = fmaxf(mx, rm);
            if (__any(mn > mx)) {
                const float f = __builtin_amdgcn_exp2f(mx - mn); ls *= f; mx = mn;
#pragma unroll
                for (int b = 0; b < 4; ++b)
#pragma unroll
                    for (int r = 0; r < 16; ++r) O[b][r] *= f;
            }
            float sum = 0.f;
#pragma unroll
            for (int r = 0; r < 16; ++r) { p0[r] = __builtin_amdgcn_exp2f(p0[r] - mx); p1[r] = __builtin_amdgcn_exp2f(p1[r] - mx); sum += p0[r] + p1[r]; }
            ls += sum;
            bf16x8 pf[4];
#pragma unroll
            for (int k2 = 0; k2 < 2; ++k2) {
                u32x4 w0, w1;
                w0.x = cvtpk(p0[8 * k2 + 0], p0[8 * k2 + 1]); w0.y = cvtpk(p0[8 * k2 + 2], p0[8 * k2 + 3]); w0.z = cvtpk(p0[8 * k2 + 4], p0[8 * k2 + 5]); w0.w = cvtpk(p0[8 * k2 + 6], p0[8 * k2 + 7]);
                w1.x = cvtpk(p1[8 * k2 + 0], p1[8 * k2 + 1]); w1.y = cvtpk(p1[8 * k2 + 2], p1[8 * k2 + 3]); w1.z = cvtpk(p1[8 * k2 + 4], p1[8 * k2 + 5]); w1.w = cvtpk(p1[8 * k2 + 6], p1[8 * k2 + 7]);
                pf[k2] = __builtin_bit_cast(bf16x8, w0); pf[2 + k2] = __builtin_bit_cast(bf16x8, w1);
            }
#pragma unroll
            for (int ks = 0; ks < 4; ++ks)
#pragma unroll
                for (int b = 0; b < 4; ++b) {
                    const LAS unsigned char* vp = Vb + (b * 32 + r32) * AT_VSTR + ks * 32 + hi * 8;
                    const u32x2 lo = *(const LAS u32x2*)vp, hh = *(const LAS u32x2*)(vp + 16);
                    u32x4 vv; vv.x = lo.x; vv.y = lo.y; vv.z = hh.x; vv.w = hh.y;
                    O[b] = mfma32(__builtin_bit_cast(bf16x8, vv), pf[ks], O[b]);
                }
            if (t + 1 < ntl) AT_LSTORE((t + 1) & 1);
            __syncthreads();
        }
#undef AT_J
        }
    }
#undef AT_GLOAD
#undef AT_LSTORE
    const float lt = ls + __shfl_xor(ls, 32);
    const float inv = (mp ? lam : 1.0f) / lt;
    int lane2 = lane; asm volatile("" : "+v"(lane2));
    const int r32e = lane2 & 31, hie = lane2 >> 5;
    LAS float* ex = (LAS float*)lds + rg * (128 * 32) + hie * 128 + r32e;
    if (mp == 1) {
#pragma unroll
        for (int b = 0; b < 4; ++b)
#pragma unroll
            for (int r = 0; r < 16; ++r) ex[(32 * b + (r & 3) + 8 * (r >> 2)) * 32] = O[b][r] * inv;
    }
    __syncthreads();
    if (mp == 0) {
        float ss = 0.f;
#pragma unroll
        for (int b = 0; b < 4; ++b)
#pragma unroll
            for (int r = 0; r < 16; ++r) { const float o = O[b][r] * inv - ex[(32 * b + (r & 3) + 8 * (r >> 2)) * 32]; O[b][r] = o; ss += o * o; }
        ss += __shfl_xor(ss, 32);
        const float rstd = rsqrtf(ss * (1.0f / 128.0f) + 1e-5f) * 0.8f;
        const float* sg = P->in[I_SUBG] + 4 * hie; bf16* Qo = Q + (size_t)(base + qb * 128 + rg * 32 + r32e) * 512 + h * 128 + 4 * hie;
#pragma unroll
        for (int b = 0; b < 4; ++b)
#pragma unroll
            for (int r4 = 0; r4 < 4; ++r4) {
                const int n = 32 * b + 8 * r4; const f32x4 g = *(const f32x4*)(sg + n);
                u32x2 w; w.x = cvtpk(O[b][4 * r4 + 0] * rstd * g.x, O[b][4 * r4 + 1] * rstd * g.y); w.y = cvtpk(O[b][4 * r4 + 2] * rstd * g.z, O[b][4 * r4 + 3] * rstd * g.w);
                *(u32x2*)(Qo + n) = w;
            }
    }
    __syncthreads();
}

constexpr int SC_R = 0, SC_K = 16384, SC_V = 32768, SC_W = 49152, SC_B = 65536, SC_KK = 81920, SC_Y = 98304, SC_TW = 114688, SC_AD = 123904, SC_MU = 133120;
__device__ __forceinline__ float dpp_add(float v, int ctrl_id) {
    const int x = __float_as_int(v); int y;
    if (ctrl_id == 0) y = __builtin_amdgcn_update_dpp(0, x, 0xB1, 0xf, 0xf, true);
    else if (ctrl_id == 1) y = __builtin_amdgcn_update_dpp(0, x, 0x4E, 0xf, 0xf, true);
    else if (ctrl_id == 2) y = __builtin_amdgcn_update_dpp(0, x, 0x141, 0xf, 0xf, true);
    else y = __builtin_amdgcn_update_dpp(0, x, 0x140, 0xf, 0xf, true);
    return v + __int_as_float(y);
}
template <int LPR> __device__ __forceinline__ float grp_sum(float v) {
    v = dpp_add(v, 0); v = dpp_add(v, 1); v = dpp_add(v, 2);
    if (LPR == 16) v = dpp_add(v, 3);
    return v;
}
#define BAR_LDS() asm volatile("s_waitcnt lgkmcnt(0)\n\ts_barrier" ::: "memory")
__device__ __forceinline__ float fast_sigmoid(float x) { return __builtin_amdgcn_rcpf(1.0f + __builtin_amdgcn_exp2f(-LOG2E * x)); }
__device__ __forceinline__ float fast_tanh(float x) { return 1.0f - 2.0f * __builtin_amdgcn_rcpf(1.0f + __builtin_amdgcn_exp2f(2.0f * LOG2E * x)); }
template <int NRP, int NSW>
__device__ __forceinline__ void scan_unit(LAS unsigned char* lds, KP P, int s, int d, int h, int rp) {
    constexpr int RPB = 64 / NRP, RPW = RPB / NSW, LPR = 64 / RPW, CPL = 64 / LPR;
    static_assert(LPR == 8 || LPR == 16, "scan geometry");
    int tid_ = threadIdx.x; asm volatile("" : "+v"(tid_));
    const int tid = tid_, lane = tid & 63, wid = __builtin_amdgcn_readfirstlane(tid >> 6);
    const int L = seq_len(s), base = seq_base(s), Ltot = L + 16, nchunk = (Ltot + 63) / 64;
    unsigned char* ws = P->ws;
    const bf16* Rb = (const bf16*)(ws + WS_R); const bf16* KAb = (const bf16*)(ws + WS_KA); const bf16* VAb = (const bf16*)(ws + WS_VA); const bf16* Lb = (const bf16*)(ws + WS_L);
    float* CB = (float*)(ws + WS_CB); bf16* YD = (bf16*)((unsigned char*)P->out + 64 * MiB) + (size_t)d * NMAIN * 512;
    LAS float* fS = (LAS float*)lds; LAS float* fV = (LAS float*)(lds + 81920); LAS float* fY = (LAS float*)(lds + SC_Y); LAS float* fMU = (LAS float*)(lds + SC_MU);
#define SCI(sl_, a_, c_) ((sl_) * 320 + (a_) * 64 + (c_))
    for (int i = tid; i < 832; i += NTHREADS) {
        float v;
        if (i < 640) { const int which = i / 320, jj = i % 320, a = jj >> 6, c = jj & 63; const int gi = a < 3 ? a * 512 + h * 64 + c : 1536 + (a - 3) * 64 + c; v = P->in[which ? I_MUN : I_MUP][gi]; }
        else { const int a = (i - 640) >> 6, c = (i - 640) & 63; v = P->in[a == 0 ? I_KK : a == 1 ? I_KA : I_RK][h * 64 + c]; }
        fMU[i] = v;
    }
    const int mat = wid >> 2, ntile = wid & 3;
    const bf16* Wt = (const bf16*)(ws + WS_LORA + (mat ? 131072 : 0)) + ((size_t)d * 512 + h * 64 + ntile * 16 + (lane & 15)) * 64 + (lane >> 4) * 8;
    const bf16x8 bfr0 = *(const bf16x8*)Wt, bfr1 = *(const bf16x8*)(Wt + 32);
    const float bias = P->in[mat ? I_A0 : I_W0][d * 512 + h * 64 + ntile * 16 + (lane & 15)];
    float S[CPL];
#pragma unroll
    for (int j = 0; j < CPL; ++j) S[j] = 0.f;
    const int rowl = lane / LPR, kg = lane % LPR, srow = rp * RPB + wid * RPW + rowl;
    const int slot = tid >> 3, cg8 = (tid & 7) * 8;
    u32x4 raw[5][3];
#define SC_LOAD(c) do { const int i_ = 64 * (c) + slot; const bool ok_ = i_ < Ltot; const int p_ = ok_ ? (d ? Ltot - 1 - i_ : i_) : 0; \
        const bool okp_ = ok_ && p_ > 0, okn_ = ok_ && p_ + 1 < Ltot; \
        const unsigned rc_ = (unsigned)pos_row(base, p_), rp_ = (unsigned)pos_row(base, okp_ ? p_ - 1 : p_), rn_ = (unsigned)pos_row(base, okn_ ? p_ + 1 : p_); \
        _Pragma("unroll") for (int a_ = 0; a_ < 5; ++a_) { const unsigned char* B_ = (const unsigned char*)(a_ == 0 ? Rb : a_ == 1 ? KAb : a_ == 2 ? VAb : Lb); const unsigned ld_ = a_ < 3 ? 1024u : 512u; \
            const unsigned co_ = (unsigned)(((a_ < 3 ? h * 64 : (a_ - 3) * 64) + cg8) * 2); \
            raw[a_][0] = *(const u32x4*)(B_ + (rp_ * ld_ + co_)); raw[a_][1] = *(const u32x4*)(B_ + (rc_ * ld_ + co_)); raw[a_][2] = *(const u32x4*)(B_ + (rn_ * ld_ + co_)); } \
        if (!(okp_ && okn_)) { const u32x4 z_ = {0u, 0u, 0u, 0u}; \
            _Pragma("unroll") for (int a_ = 0; a_ < 5; ++a_) { if (!okp_) raw[a_][0] = z_; if (!ok_) raw[a_][1] = z_; if (!okn_) raw[a_][2] = z_; } } } while (0)
    SC_LOAD(0);
    BAR_LDS();
    for (int c = 0; c < nchunk; ++c) {
        const int nvalid = (Ltot - 64 * c) < 64 ? (Ltot - 64 * c) : 64;
        float rv[8], kv[8];
#pragma unroll
        for (int a = 0; a < 5; ++a) {
            float pv[8], cv[8], nv[8], o[8]; unpack8(raw[a][0], pv); unpack8(raw[a][1], cv); unpack8(raw[a][2], nv);
            const f32x4 mp0 = *(const LAS f32x4*)(fMU + a * 64 + cg8), mp1 = *(const LAS f32x4*)(fMU + a * 64 + cg8 + 4), mn0 = *(const LAS f32x4*)(fMU + 320 + a * 64 + cg8), mn1 = *(const LAS f32x4*)(fMU + 320 + a * 64 + cg8 + 4);
#pragma unroll
            for (int e = 0; e < 8; ++e) { const float mp = e < 4 ? mp0[e & 3] : mp1[e & 3], mn = e < 4 ? mn0[e & 3] : mn1[e & 3]; o[e] = cv[e] + mp * (pv[e] - cv[e]) + mn * (nv[e] - cv[e]); }
            if (a == 0) {
#pragma unroll
                for (int e = 0; e < 8; ++e) rv[e] = o[e];
                LAS float* dst = fS + SCI(slot, 4, cg8); *(LAS f32x4*)dst = (f32x4){o[0], o[1], o[2], o[3]}; *(LAS f32x4*)(dst + 4) = (f32x4){o[4], o[5], o[6], o[7]};
            } else if (a == 1) {
#pragma unroll
                for (int e = 0; e < 8; ++e) kv[e] = o[e];
            } else if (a == 2) {
                LAS float* dst = fV + slot * 64 + cg8; *(LAS f32x4*)dst = (f32x4){o[0], o[1], o[2], o[3]}; *(LAS f32x4*)(dst + 4) = (f32x4){o[4], o[5], o[6], o[7]};
            } else {
                if (a == 3) {
#pragma unroll
                    for (int e = 0; e < 8; ++e) o[e] = fast_tanh(o[e]);
                }
                u32x4 w; w.x = cvtpk(o[0], o[1]); w.y = cvtpk(o[2], o[3]); w.z = cvtpk(o[4], o[5]); w.w = cvtpk(o[6], o[7]);
                *(LAS u32x4*)(lds + (a == 3 ? SC_TW : SC_AD) + slot * 144 + cg8 * 2) = w;
            }
        }
        BAR_LDS();
        if (c + 1 < nchunk) SC_LOAD(c + 1);
        {
            const LAS unsigned char* Ab = lds + (mat ? SC_AD : SC_TW); LAS float* fWB = fS + (mat ? 128 : 64);
#pragma unroll
            for (int mt = 0; mt < 4; ++mt) {
                const bf16x8 a0 = *(const LAS bf16x8*)(Ab + (mt * 16 + (lane & 15)) * 144 + (lane >> 4) * 16);
                const bf16x8 a1 = *(const LAS bf16x8*)(Ab + (mt * 16 + (lane & 15)) * 144 + 64 + (lane >> 4) * 16);
                f32x4 acc = {0.f, 0.f, 0.f, 0.f};
                acc = __builtin_amdgcn_mfma_f32_16x16x32_bf16(a0, bfr0, acc, 0, 0, 0);
                acc = __builtin_amdgcn_mfma_f32_16x16x32_bf16(a1, bfr1, acc, 0, 0, 0);
#pragma unroll
                for (int rg = 0; rg < 4; ++rg) {
                    const int sl = mt * 16 + (lane >> 4) * 4 + rg, col = ntile * 16 + (lane & 15);
                    const float sg = fast_sigmoid(acc[rg] + bias); const float dc = __builtin_amdgcn_exp2f(-0.6065306597126334f * LOG2E * sg);
                    fWB[sl * 320 + col] = mat ? sg : dc;
                }
            }
        }
        BAR_LDS();
        {
            const f32x4 a0 = *(const LAS f32x4*)(fS + SCI(slot, 2, cg8)), a1 = *(const LAS f32x4*)(fS + SCI(slot, 2, cg8 + 4));
            const f32x4 kk0 = *(const LAS f32x4*)(fMU + 640 + cg8), kk1 = *(const LAS f32x4*)(fMU + 640 + cg8 + 4), ka0 = *(const LAS f32x4*)(fMU + 704 + cg8), ka1 = *(const LAS f32x4*)(fMU + 704 + cg8 + 4);
            const f32x4 rk0 = *(const LAS f32x4*)(fMU + 768 + cg8), rk1 = *(const LAS f32x4*)(fMU + 768 + cg8 + 4);
            float kkv[8], kd[8], av[8]; float ssq = 0.f, cs = 0.f;
#pragma unroll
            for (int e = 0; e < 8; ++e) {
                av[e] = e < 4 ? a0[e & 3] : a1[e & 3];
                kkv[e] = kv[e] * (e < 4 ? kk0[e & 3] : kk1[e & 3]); ssq = fmaf(kkv[e], kkv[e], ssq);
                kd[e] = kv[e] * (1.0f + (av[e] - 1.0f) * (e < 4 ? ka0[e & 3] : ka1[e & 3])); cs = fmaf(rv[e] * kd[e], e < 4 ? rk0[e & 3] : rk1[e & 3], cs);
            }
            ssq = grp_sum<8>(ssq); cs = grp_sum<8>(cs);
            const float rs = rsqrtf(fmaxf(ssq, 1e-24f));
#pragma unroll
            for (int e = 0; e < 8; ++e) { kkv[e] *= rs; av[e] *= kkv[e]; }
            LAS float* o1 = fS + SCI(slot, 0, cg8); *(LAS f32x4*)o1 = (f32x4){kkv[0], kkv[1], kkv[2], kkv[3]}; *(LAS f32x4*)(o1 + 4) = (f32x4){kkv[4], kkv[5], kkv[6], kkv[7]};
            LAS float* o2 = fS + SCI(slot, 2, cg8); *(LAS f32x4*)o2 = (f32x4){av[0], av[1], av[2], av[3]}; *(LAS f32x4*)(o2 + 4) = (f32x4){av[4], av[5], av[6], av[7]};
            LAS float* o3 = fS + SCI(slot, 3, cg8); *(LAS f32x4*)o3 = (f32x4){kd[0], kd[1], kd[2], kd[3]}; *(LAS f32x4*)(o3 + 4) = (f32x4){kd[4], kd[5], kd[6], kd[7]};
            if (cg8 == 0 && rp == 0 && slot < nvalid) { const int i2 = 64 * c + slot; const int p2 = d ? Ltot - 1 - i2 : i2; CB[((size_t)d * ROWS + pos_row(base, p2)) * 8 + h] = cs; }
        }
        BAR_LDS();
        if (wid < NSW) {
            typedef float f32x2_ __attribute__((ext_vector_type(2)));
            constexpr int C4 = CPL / 4;
            const LAS float* ps = fS + kg * CPL; const LAS float* pv = fV + srow; LAS float* py = fY + srow;
            f32x4 nk[C4], nw[C4], nb[C4], nd[C4], nr[C4]; float nv;
#define SC_FETCH(sl_) do { _Pragma("unroll") for (int j_ = 0; j_ < C4; ++j_) { nk[j_] = *(const LAS f32x4*)(ps + (sl_) * 320 + 4 * j_); nw[j_] = *(const LAS f32x4*)(ps + (sl_) * 320 + 64 + 4 * j_); \
                nb[j_] = *(const LAS f32x4*)(ps + (sl_) * 320 + 128 + 4 * j_); nd[j_] = *(const LAS f32x4*)(ps + (sl_) * 320 + 192 + 4 * j_); nr[j_] = *(const LAS f32x4*)(ps + (sl_) * 320 + 256 + 4 * j_); } nv = pv[(sl_) * 64]; } while (0)
            SC_FETCH(0);
            f32x4 rp4[C4];
#pragma unroll
            for (int j = 0; j < C4; ++j) rp4[j] = (f32x4){0.f, 0.f, 0.f, 0.f};
#pragma unroll 8
            for (int sl = 0; sl < nvalid; ++sl) {
                f32x4 ck[C4], cw[C4], cb[C4], cd[C4], cr[C4];
#pragma unroll
                for (int j = 0; j < C4; ++j) { ck[j] = nk[j]; cw[j] = nw[j]; cb[j] = nb[j]; cd[j] = nd[j]; cr[j] = nr[j]; }
                const float vv = nv;
                SC_FETCH(sl + 1 < 64 ? sl + 1 : 63);
                f32x2_ pa = {0.f, 0.f}, ya = {0.f, 0.f};
#pragma unroll
                for (int j = 0; j < C4; ++j)
#pragma unroll
                    for (int e = 0; e < 4; e += 2) { const f32x2_ s2 = {S[4 * j + e], S[4 * j + e + 1]}, k2 = {ck[j][e], ck[j][e + 1]}, r2 = {rp4[j][e], rp4[j][e + 1]}; pa = pa + s2 * k2; ya = ya + s2 * r2; }
                float pp = pa.x + pa.y, yy = ya.x + ya.y;
                pp = dpp_add(pp, 0); yy = dpp_add(yy, 0); pp = dpp_add(pp, 1); yy = dpp_add(yy, 1); pp = dpp_add(pp, 2); yy = dpp_add(yy, 2);
                if (LPR == 16) { pp = dpp_add(pp, 3); yy = dpp_add(yy, 3); }
                py[(sl > 0 ? sl - 1 : 0) * 64] = yy;
#pragma unroll
                for (int j = 0; j < C4; ++j)
#pragma unroll
                    for (int e = 0; e < 4; e += 2) {
                        const f32x2_ b2 = {cb[j][e], cb[j][e + 1]}, d2 = {cd[j][e], cd[j][e + 1]}, w2 = {cw[j][e], cw[j][e + 1]}; f32x2_ s2 = {S[4 * j + e], S[4 * j + e + 1]};
                        const f32x2_ t2 = d2 * vv - b2 * pp; s2 = s2 * w2 + t2; S[4 * j + e] = s2.x; S[4 * j + e + 1] = s2.y; }
#pragma unroll
                for (int j = 0; j < C4; ++j) rp4[j] = cr[j];
            }
            {
                f32x2_ ya = {0.f, 0.f};
#pragma unroll
                for (int j = 0; j < C4; ++j)
#pragma unroll
                    for (int e = 0; e < 4; e += 2) { const f32x2_ s2 = {S[4 * j + e], S[4 * j + e + 1]}, r2 = {rp4[j][e], rp4[j][e + 1]}; ya = ya + s2 * r2; }
                const float yy = grp_sum<LPR>(ya.x + ya.y);
                py[(nvalid - 1) * 64] = yy;
            }
#undef SC_FETCH
        }
        BAR_LDS();
        {
            const int i2 = 64 * c + slot; const int p2 = d ? Ltot - 1 - i2 : i2;
            if (slot < nvalid && p2 >= 16 && (cg8 / RPB) == rp) {
                const LAS float* yp = fY + slot * 64 + cg8; const f32x4 y0 = *(const LAS f32x4*)yp, y1 = *(const LAS f32x4*)(yp + 4);
                *(u32x4*)(YD + (size_t)(base + p2 - 16) * 512 + h * 64 + cg8) = pack8(y0, y1);
            }
        }
    }
#undef SC_LOAD
#undef SCI
}

__device__ __forceinline__ void phase_post(LAS unsigned char* lds, KP P) {
    const int tid = fresh_tid(), lane = tid & 63, wid = tid >> 6;
    unsigned char* ws = P->ws;
    const bf16* VAb = (const bf16*)(ws + WS_VA); const bf16* Lb = (const bf16*)(ws + WS_L); bf16* Rb = (bf16*)(ws + WS_R);
    const float* CB = (const float*)(ws + WS_CB); const bf16* YD0 = (const bf16*)((const unsigned char*)P->out + 64 * MiB); const bf16* YD1 = YD0 + (size_t)NMAIN * 512;
    const bf16* GT = (const bf16*)(ws + WS_LORA + 262144);
    LAS float* st = (LAS float*)(lds + 17408);
    const float* mup = P->in[I_MUP]; const float* mun = P->in[I_MUN];
    for (int tile = blockIdx.x; tile < NMAIN / 64; tile += gridDim.x) {
        {
            const int row = tid >> 3, hh = tid & 7, m = tile * 64 + row;
            const int t = m < 16384 ? m : (m - 16384) & 2047, Ls = m < 16384 ? 16384 : 2048;
            float sum = 0.f, sq = 0.f;
#pragma unroll
            for (int i = 0; i < 8; ++i) { float a[8], b[8]; unpack8(*(const u32x4*)(YD0 + (size_t)m * 512 + hh * 64 + i * 8), a); unpack8(*(const u32x4*)(YD1 + (size_t)m * 512 + hh * 64 + i * 8), b);
#pragma unroll
                for (int e = 0; e < 8; ++e) { const float y = a[e] + b[e]; sum += y; sq += y * y; } }
            const float mu = sum * (1.0f / 64.0f); const float var = fmaxf(sq * (1.0f / 64.0f) - mu * mu, 0.f);
            st[(row * 8 + hh) * 2] = mu; st[(row * 8 + hh) * 2 + 1] = rsqrtf(var + 64e-5f);
            const size_t rp_ = t == 0 ? (size_t)(METAROW + 15) : (size_t)(m - 1); const bool okn = t + 1 < Ls;
#pragma unroll
            for (int i = 0; i < 2; ++i) {
                const int c0 = 128 + hh * 16 + i * 8; float pv[8], cv[8], nv[8], o[8];
                unpack8(*(const u32x4*)(Lb + rp_ * 256 + c0), pv); unpack8(*(const u32x4*)(Lb + (size_t)m * 256 + c0), cv);
                if (okn) unpack8(*(const u32x4*)(Lb + (size_t)(m + 1) * 256 + c0), nv); else {
#pragma unroll
                    for (int e = 0; e < 8; ++e) nv[e] = 0.f; }
#pragma unroll
                for (int e = 0; e < 8; ++e) { const float mp = mup[1536 + c0 + e], mn = mun[1536 + c0 + e]; o[e] = sigmoidf_(cv[e] + mp * (pv[e] - cv[e]) + mn * (nv[e] - cv[e])); }
                u32x4 w; w.x = cvtpk(o[0], o[1]); w.y = cvtpk(o[2], o[3]); w.z = cvtpk(o[4], o[5]); w.w = cvtpk(o[6], o[7]);
                *(LAS u32x4*)(lds + row * 272 + (hh * 16 + i * 8) * 2) = w;
            }
        }
        __syncthreads();
#pragma unroll 1
        for (int nt = 0; nt < 4; ++nt) {
            const int col = wid * 64 + nt * 16 + (lane & 15);
            bf16x8 bfr[4];
#pragma unroll
            for (int ks = 0; ks < 4; ++ks) bfr[ks] = *(const bf16x8*)(GT + (size_t)col * 128 + ks * 32 + (lane >> 4) * 8);
            const float lw = P->in[I_LNW][col], lb = P->in[I_LNB][col];
            const float mpv = mup[1024 + col], mnv = mun[1024 + col];
#pragma unroll 1
            for (int mt = 0; mt < 4; ++mt) {
                f32x4 acc = {0.f, 0.f, 0.f, 0.f};
#pragma unroll
                for (int ks = 0; ks < 4; ++ks) { const bf16x8 a = *(const LAS bf16x8*)(lds + (mt * 16 + (lane & 15)) * 272 + ks * 64 + (lane >> 4) * 16); acc = __builtin_amdgcn_mfma_f32_16x16x32_bf16(a, bfr[ks], acc, 0, 0, 0); }
#pragma unroll
                for (int rg = 0; rg < 4; ++rg) {
                    const int row = mt * 16 + (lane >> 4) * 4 + rg, m = tile * 64 + row;
                    const int t = m < 16384 ? m : (m - 16384) & 2047, Ls = m < 16384 ? 16384 : 2048;
                    const float y = bf2f(YD0[(size_t)m * 512 + col]) + bf2f(YD1[(size_t)m * 512 + col]);
                    const float yn = (y - st[(row * 8 + wid) * 2]) * st[(row * 8 + wid) * 2 + 1] * lw + lb;
                    const float vc = bf2f(VAb[(size_t)m * 512 + col]);
                    const float vp = bf2f(VAb[(t == 0 ? (size_t)(METAROW + 15) : (size_t)(m - 1)) * 512 + col]);
                    const float vn = t + 1 < Ls ? bf2f(VAb[(size_t)(m + 1) * 512 + col]) : 0.f;
                    const float vs = vc + mpv * (vp - vc) + mnv * (vn - vc);
                    const float cb = CB[(size_t)m * 8 + wid] + CB[((size_t)ROWS + m) * 8 + wid];
                    Rb[(size_t)m * 512 + col] = (bf16)f2bf_rne((yn + cb * vs) * acc[rg]);
                }
            }
        }
        __syncthreads();
    }
}

__device__ __forceinline__ void phase_rms_bf16(KP P) {
    const int tid = fresh_tid(), lane = tid & 63, wid = tid >> 6; const int gw = blockIdx.x * 8 + wid, NGW = gridDim.x * 8;
    bf16* MN = (bf16*)(P->ws + WS_MN);
    for (int m = gw; m < NMAIN; m += NGW) rms_row_bf16(P->out + (size_t)m * DM, P->in[I_GFFN], MN + (size_t)m * DM, lane);
}
__device__ __forceinline__ void phase_final(KP P) {
    const int tid = fresh_tid(), lane = tid & 63, wid = tid >> 6; const int gw = blockIdx.x * 8 + wid, NGW = gridDim.x * 8;
    const f32x4* gr = (const f32x4*)P->in[I_GFIN] + lane;
    for (int m = gw; m < NMAIN; m += NGW) {
        f32x4* xr = (f32x4*)(P->out + (size_t)m * DM) + lane; f32x4 v[4]; float s = 0.f;
#pragma unroll
        for (int j = 0; j < 4; ++j) { v[j] = xr[64 * j]; s += (v[j].x * v[j].x + v[j].y * v[j].y) + (v[j].z * v[j].z + v[j].w * v[j].w); }
        const float rstd = rsqrtf(wave_sum(s) * (1.f / DM) + 1e-6f);
#pragma unroll
        for (int j = 0; j < 4; ++j) xr[64 * j] = v[j] * rstd * gr[64 * j];
    }
}

constexpr int NRP_LONG = 4;
constexpr int N_LONG = 16 * NRP_LONG, N_ATT_P = 512, N_ATT_S = 512, N_SHORT = 128, N_ITEMS = N_LONG + N_ATT_P + N_ATT_S + N_SHORT;

template <class Op> __device__ __forceinline__ void run_gemm(LAS unsigned char* lds, const bf16* A, const bf16* Bt, int M, int N, int K, const Op& op, const bf16* A2 = nullptr, int pm2 = 1 << 30) {
    pg8::Gemm g{A, Bt, M, N, K, A2, pm2}; pg8::StaticOrder S; S.init(M, N, (int)gridDim.x, (int)blockIdx.x);
    Epi8<Op> E{op};
    pg8::gemm_phase<Epi8<Op>, pg8::StaticOrder, true, true>(lds, g, S, E);
}

#ifndef PROBE_MASK
#define PROBE_MASK 0
#endif
#ifndef PROBE_MUL
#define PROBE_MUL 1
#endif
#define PH_BEGIN(k) unsigned long long t0_##k = 0; if (PROBE_MASK & (1 << (k))) t0_##k = __builtin_amdgcn_s_memrealtime();
#define PH_END(k) if (PROBE_MASK & (1 << (k))) { const unsigned long long t1_ = __builtin_amdgcn_s_memrealtime(); const unsigned long long dt_ = (t1_ - t0_##k) * PROBE_MUL; while (__builtin_amdgcn_s_memrealtime() - t1_ < dt_) __builtin_amdgcn_s_sleep(8); grid.sync(); }
__global__ void __launch_bounds__(NTHREADS) fwd_megakernel(Params Pin) {
    extern __shared__ __attribute__((aligned(16))) unsigned char lds_raw[];
    LAS unsigned char* lds = (LAS unsigned char*)lds_raw;
    cg::grid_group grid = cg::this_grid();
    KP P0 = (KP)__builtin_amdgcn_kernarg_segment_ptr();
#define NEWPHASE KP P = P0; asm volatile("" : "+s"(P)); unsigned char* ws = P->ws; (void)ws;

    PH_BEGIN(0)
    { NEWPHASE phase_prologue(lds, P); }
    grid.sync();
    PH_END(0)
    PH_BEGIN(1)
    { NEWPHASE run_gemm(lds, (const bf16*)P->out, (const bf16*)(ws + WS_WIN), ROWS, 3328, 1024, OpProj{ws}, (const bf16*)(ws + WS_XNMETA), 128); }
    grid.sync();
    PH_END(1)
    PH_BEGIN(2)
    { NEWPHASE
        const int tid = fresh_tid();
        float lam;
        { const int lane = tid & 63; const float s1 = wave_sum(P->in[I_LQ1][lane] * P->in[I_LK1][lane]), s2 = wave_sum(P->in[I_LQ2][lane] * P->in[I_LK2][lane]); lam = __expf(s1) - __expf(s2) + 0.2f; }
        unsigned* ctr = (unsigned*)(ws + WS_CTL);
        LAS unsigned* slot = (LAS unsigned*)(lds + LDS_ITEM_OFF);
#define FETCH(k, n) if (tid == 0) *slot = atomicAdd(ctr + 64 * (k), 1u); __syncthreads(); const int idx = (int)*slot; __syncthreads(); if (idx >= (n)) break;
#ifndef NO_SCAN
#pragma unroll 1
        for (;;) { FETCH(0, N_LONG) const int u = idx / NRP_LONG; scan_unit<NRP_LONG, 4>(lds, P, 0, u >> 3, u & 7, idx % NRP_LONG); }
#endif
#ifndef NO_ATTN
#pragma unroll 1
        for (;;) { FETCH(1, N_ATT_P + N_ATT_S)
            if (idx < N_ATT_P) attn_unit(lds, P, 0, idx >> 7, idx & 127, lam);
            else { const int a = idx - N_ATT_P; attn_unit(lds, P, 1 + (a >> 6), (a >> 4) & 3, a & 15, lam); } }
#endif
#ifndef NO_SCAN
#pragma unroll 1
        for (;;) { FETCH(2, N_SHORT) scan_unit<1, 8>(lds, P, 1 + (idx >> 4), (idx >> 3) & 1, idx & 7, 0); }
#endif
#undef FETCH
    }
    grid.sync();
    PH_END(2)
#ifndef NO_POST
    PH_BEGIN(3)
    { NEWPHASE phase_post(lds, P); }
#endif
    grid.sync();
    PH_END(3)
    PH_BEGIN(4)
    { NEWPHASE run_gemm(lds, (const bf16*)P->out, (const bf16*)(ws + WS_WIN) + (size_t)3328 * 1024, NMAIN, 2048, 1024, OpGate{ws}); }
    grid.sync();
    PH_END(4)
    PH_BEGIN(5)
    { NEWPHASE run_gemm(lds, (const bf16*)(ws + WS_R), (const bf16*)(ws + WS_WUPA), NMAIN, 1024, 512, OpUpA{ws}); }
    grid.sync();
    PH_END(5)
    PH_BEGIN(6)
    { NEWPHASE run_gemm(lds, (const bf16*)(ws + WS_Q), (const bf16*)(ws + WS_WUPB), NMAIN, 1024, 512, OpUpB{ws}); }
    grid.sync();
    PH_END(6)
    PH_BEGIN(7)
    { NEWPHASE run_gemm(lds, (const bf16*)(ws + WS_GB), (const bf16*)(ws + WS_WOUT), NMAIN, 1024, 1024, OpOut{P->in[I_XP], P->in[I_XS], P->out}); }
    grid.sync();
    PH_END(7)
    PH_BEGIN(8)
    { NEWPHASE phase_rms_bf16(P); }
    grid.sync();
    PH_END(8)
    PH_BEGIN(9)
    { NEWPHASE run_gemm(lds, (const bf16*)(ws + WS_MN), (const bf16*)(ws + WS_WFF1), 16384, DFF, 1024, OpFF1{(bf16*)(ws + WS_HID)}); }
    grid.sync();
    PH_END(9)
    PH_BEGIN(10)
    { NEWPHASE run_gemm(lds, (const bf16*)(ws + WS_HID), (const bf16*)(ws + WS_WFF2), 16384, 1024, DFF, OpFF2{P->out}); }
    grid.sync();
    PH_END(10)
    PH_BEGIN(11)
    { NEWPHASE run_gemm(lds, (const bf16*)(ws + WS_MN) + (size_t)16384 * DM, (const bf16*)(ws + WS_WFF1), 16384, DFF, 1024, OpFF1{(bf16*)(ws + WS_HID)}); }
    grid.sync();
    PH_END(11)
    PH_BEGIN(12)
    { NEWPHASE run_gemm(lds, (const bf16*)(ws + WS_HID), (const bf16*)(ws + WS_WFF2), 16384, 1024, DFF, OpFF2{P->out + (size_t)16384 * DM}); }
    grid.sync();
    PH_END(12)
    PH_BEGIN(13)
    { NEWPHASE phase_final(P); }
}

extern "C" void kernel_launch(void* const* d_in, const int* in_sizes, int n_in, void* d_out, int out_size, void* d_ws, size_t ws_size, hipStream_t stream) {
    static int grid_blocks = 0;
    if (grid_blocks == 0) {
        int dev = 0, cus = 0, per_cu = 0;
        hipGetDevice(&dev);
        hipDeviceGetAttribute(&cus, hipDeviceAttributeMultiprocessorCount, dev);
        hipFuncSetAttribute((const void*)fwd_megakernel, hipFuncAttributeMaxDynamicSharedMemorySize, LDS_BYTES);
        hipOccupancyMaxActiveBlocksPerMultiprocessor(&per_cu, (const void*)fwd_megakernel, NTHREADS, LDS_BYTES);
        if (per_cu < 1) { fprintf(stderr, "kernel_launch: occupancy query says %d blocks per CU\n", per_cu); per_cu = 1; }
        grid_blocks = cus * per_cu;
        if (n_in != 29 || ws_size < WS_END) fprintf(stderr, "kernel_launch: unexpected n_in %d / ws_size %zu\n", n_in, ws_size);
    }
    hipMemsetAsync((unsigned char*)d_ws + WS_CTL, 0, 4096, stream);
    Params p{};
    for (int i = 0; i < 29; ++i) p.in[i] = (const float*)d_in[i];
    p.out = (float*)d_out; p.ws = (unsigned char*)d_ws;
    void* args[] = {&p};
    hipError_t e = hipLaunchCooperativeKernel((const void*)fwd_megakernel, dim3(grid_blocks), dim3(NTHREADS), args, LDS_BYTES, stream);
    if (e != hipSuccess) fprintf(stderr, "cooperative launch failed: %s (grid %d)\n", hipGetErrorString(e), grid_blocks);
}
```

```cpp
#include <hip/hip_runtime.h>
#include <hip/hip_cooperative_groups.h>
#include <cstdio>
#include <cstdint>
#include <cmath>
namespace cg = cooperative_groups;
__device__ __forceinline__ int fresh_tid() { int t = threadIdx.x; asm volatile("" : "+v"(t)); return t; }
namespace pg8 {
#define PG8_LAS __attribute__((address_space(3)))
typedef unsigned short bf16_t;
typedef short bf16x8 __attribute__((ext_vector_type(8)));
typedef float f32x4 __attribute__((ext_vector_type(4)));
typedef unsigned u32x4 __attribute__((ext_vector_type(4)));
constexpr int BM = 256, BK = 64, HALF = 128, HTB = HALF * BK * 2  , STAGE_BYTES = 8 * HTB, NXCD = 8, WGM = 8;

__host__ __device__ __forceinline__ int lds_byte(int r, int c) { const int st = (r >> 4) * 2 + (c >> 5), rr = r & 15, cc = c & 31, ob = rr * 64 + cc * 2; return st * 1024 + (ob ^ (((ob >> 9) & 1) << 5)); }
__host__ __device__ __forceinline__ void stage_rc(int b, int& R, int& C) { const int st = b / 1024, sb = b % 1024, swz = sb ^ (((sb >> 9) & 1) << 5); R = (st >> 1) * 16 + swz / 64; C = (st & 1) * 32 + (swz % 64) / 2; }
__host__ __device__ __forceinline__ int perm32(int rho) { const int n = rho >> 4, i = rho & 15; return 8 * (i >> 2) + 4 * n + (i & 3); }

struct Unit { int pm, pn; };
struct Gemm { const bf16_t* A; const bf16_t* Bt; int M, N, K; const bf16_t* A2; int pm2; };
__device__ __forceinline__ const char* gemm_abase(const Gemm& g, int pm, size_t tstep) { return pm >= g.pm2 ? (const char*)g.A2 + (size_t)(pm - g.pm2) * tstep : (const char*)g.A + (size_t)pm * tstep; }

struct StaticOrder {
    int nM, nN, nwg, G, c;
    __host__ __device__ void init(int M, int N, int G_, int c_) { nM = M / BM; nN = N / BM; nwg = nM * nN; G = G_; c = c_; }
    __host__ __device__ bool next(int i, Unit& u) const {
        const long L = (long)i * G + c; if (L >= nwg) return false;
        int wgid = (int)L; { const int q = nwg / NXCD, r = nwg % NXCD, xcd = wgid % NXCD, off = wgid / NXCD; wgid = (xcd < r ? xcd * (q + 1) : r * (q + 1) + (xcd - r) * q) + off; }
        const int nig = WGM * nN, gid = wgid / nig, fm = gid * WGM, gsz = (nM - fm) < WGM ? (nM - fm) : WGM;
        u.pm = fm + ((wgid % nig) % gsz); u.pn = (wgid % nig) / gsz; return true;
    }
    __device__ __forceinline__ void a_ready(const Unit&) const {}
    __device__ __forceinline__ void done(const Unit&) const {}
};


template <class Epi, class Sched, bool ALIGN_EPI = false, bool SP2 = false>
__device__ __forceinline__ void gemm_phase(PG8_LAS unsigned char* lds, const Gemm g, const Sched& S, const Epi& E) {
    const int tid = fresh_tid(), wid = __builtin_amdgcn_readfirstlane(tid >> 6), lane = tid & 63, wr = wid >> 2, wc = wid & 3, fr = lane & 15, fq = lane >> 4;
    const int K = g.K, nt = K / BK;
    unsigned voffA[2], voffB[2];
#pragma unroll
    for (int i = 0; i < 2; ++i) { int R, C; stage_rc(tid * 16 + i * 8192, R, C); const int Rb = Epi::PERM ? ((R & ~31) + perm32(R & 31)) : R;
        voffA[i] = (unsigned)(R * K + C) * 2u; voffB[i] = (unsigned)(Rb * K + C) * 2u; }
    const size_t kstep = (size_t)(BK * 2);
    const size_t hstep = (size_t)HALF * K * 2;
    const size_t tstep = 2 * hstep;
    const unsigned ldsw = (unsigned)wid * 1024u;
    const int aoff = lds_byte(wr * 64 + fr, fq * 8), boff = lds_byte(wc * 32 + fr, fq * 8);
#define PG8_SA(b, h) (((b) * 2 + (h)) * HTB)
#define PG8_SB(b, h) ((4 + (b) * 2 + (h)) * HTB)
#define PG8_STAGE(bufoff, gbase, voff) do { _Pragma("unroll") for (int _i = 0; _i < 2; ++_i) \
        __builtin_amdgcn_global_load_lds((const unsigned*)((const char*)(gbase) + (voff)[_i]), (PG8_LAS unsigned*)(lds + (bufoff) + ldsw + _i * 8192), 16, 0, 0); } while (0)
#define PG8_LDA(dst, b, h) do { _Pragma("unroll") for (int m = 0; m < 4; ++m) _Pragma("unroll") for (int k = 0; k < 2; ++k) dst[m][k] = *(const PG8_LAS bf16x8*)(lds + PG8_SA(b, h) + aoff + m * 2048 + k * 1024); } while (0)
#define PG8_LDB(dst, b, h) do { _Pragma("unroll") for (int n = 0; n < 2; ++n) _Pragma("unroll") for (int k = 0; k < 2; ++k) dst[n][k] = *(const PG8_LAS bf16x8*)(lds + PG8_SB(b, h) + boff + n * 2048 + k * 1024); } while (0)
#define PG8_MMA(ai, bj, At, Bt) do { __builtin_amdgcn_s_setprio(1); _Pragma("unroll") for (int m = 0; m < 4; ++m) _Pragma("unroll") for (int n = 0; n < 2; ++n) _Pragma("unroll") for (int k = 0; k < 2; ++k) \
        acc[ai][bj][m][n] = __builtin_amdgcn_mfma_f32_16x16x32_bf16(Bt[n][k], At[m][k], acc[ai][bj][m][n], 0, 0, 0); __builtin_amdgcn_s_setprio(0); } while (0)
#define PG8_WAIT_V(n) asm volatile("s_waitcnt vmcnt(" #n ")" ::: "memory")
#define PG8_WAIT_L(n) asm volatile("s_waitcnt lgkmcnt(" #n ")" ::: "memory")
#define PG8_BAR __builtin_amdgcn_s_barrier()
#define PG8_SCHED __builtin_amdgcn_sched_barrier(0)
    Unit cur, nxt; int ui = 0;
    if (!S.next(0, cur)) return;
    f32x4 acc[2][2][4][2];
#pragma unroll
    for (int a = 0; a < 2; ++a)
#pragma unroll
        for (int b = 0; b < 2; ++b)
#pragma unroll
            for (int m = 0; m < 4; ++m)
#pragma unroll
                for (int n = 0; n < 2; ++n) acc[a][b][m][n] = (f32x4){0.f, 0.f, 0.f, 0.f};
    bf16x8 At[4][2], B0[2][2], B1[2][2];
    const char* cA = gemm_abase(g, cur.pm, tstep); const char* cB = (const char*)g.Bt + (size_t)cur.pn * tstep;
    S.a_ready(cur);
    if constexpr (SP2) {
        PG8_STAGE(PG8_SB(0, 0), cB, voffB); PG8_STAGE(PG8_SB(0, 1), cB + hstep, voffB); PG8_STAGE(PG8_SA(0, 0), cA, voffA); PG8_STAGE(PG8_SA(0, 1), cA + hstep, voffA);
        if (wr == 1) PG8_BAR;
        PG8_WAIT_V(2); PG8_BAR;
        PG8_STAGE(PG8_SB(1, 0), cB + kstep, voffB); PG8_STAGE(PG8_SA(1, 0), cA + kstep, voffA); PG8_STAGE(PG8_SB(1, 1), cB + hstep + kstep, voffB);
        PG8_WAIT_V(6); PG8_BAR;
    } else {
        PG8_STAGE(PG8_SB(0, 0), cB, voffB); PG8_STAGE(PG8_SA(0, 0), cA, voffA); PG8_STAGE(PG8_SB(0, 1), cB + hstep, voffB); PG8_STAGE(PG8_SA(0, 1), cA + hstep, voffA);
        if (wr == 1) PG8_BAR;
        PG8_WAIT_V(4); PG8_BAR;
        PG8_STAGE(PG8_SB(1, 0), cB + kstep, voffB); PG8_STAGE(PG8_SA(1, 0), cA + kstep, voffA); PG8_STAGE(PG8_SB(1, 1), cB + hstep + kstep, voffB);
        PG8_WAIT_V(6); PG8_BAR;
    }
    for (;;) {
        const bool has_next = S.next(ui + 1, nxt);
        const char* nA = has_next ? gemm_abase(g, nxt.pm, tstep) : cA; const char* nB = has_next ? (const char*)g.Bt + (size_t)nxt.pn * tstep : cB;
        for (int t = 0; t < nt; t += 2) {
            const bool last = (t == nt - 2);
            const char* a1 = cA + (size_t)(t + 1) * kstep;
            const char* a2 = last ? nA : cA + (size_t)(t + 2) * kstep; const char* b2 = last ? nB : cB + (size_t)(t + 2) * kstep;
            const char* a3 = a2 + kstep; const char* b3 = b2 + kstep;
            if (last && has_next) S.a_ready(nxt);
            if constexpr (SP2) {
            PG8_LDB(B0, 0, 0); PG8_LDB(B1, 0, 1); PG8_SCHED; PG8_LDA(At, 0, 0); PG8_STAGE(PG8_SA(1, 1), a1 + hstep, voffA);
            PG8_WAIT_V(8); PG8_WAIT_L(0); PG8_BAR; PG8_MMA(0, 0, At, B0); PG8_MMA(0, 1, At, B1); PG8_BAR; PG8_SCHED;
            PG8_LDA(At, 0, 1); PG8_STAGE(PG8_SB(0, 0), b2, voffB); PG8_STAGE(PG8_SB(0, 1), b2 + hstep, voffB); PG8_STAGE(PG8_SA(0, 0), a2, voffA);
            PG8_WAIT_V(8); PG8_WAIT_L(0); PG8_BAR; PG8_MMA(1, 0, At, B0); PG8_MMA(1, 1, At, B1); PG8_BAR; PG8_SCHED;
            PG8_LDB(B0, 1, 0); PG8_LDB(B1, 1, 1); PG8_SCHED; PG8_LDA(At, 1, 0); PG8_STAGE(PG8_SA(0, 1), a2 + hstep, voffA);
            PG8_WAIT_V(8); PG8_WAIT_L(0); PG8_BAR; PG8_MMA(0, 0, At, B0); PG8_MMA(0, 1, At, B1); PG8_BAR; PG8_SCHED;
            PG8_LDA(At, 1, 1); PG8_STAGE(PG8_SB(1, 0), b3, voffB); PG8_STAGE(PG8_SB(1, 1), b3 + hstep, voffB); PG8_STAGE(PG8_SA(1, 0), a3, voffA);
            PG8_WAIT_V(8); PG8_WAIT_L(0); PG8_BAR; PG8_MMA(1, 0, At, B0); PG8_MMA(1, 1, At, B1); PG8_BAR; PG8_SCHED;
            } else {
            PG8_LDB(B0, 0, 0); PG8_SCHED; PG8_LDA(At, 0, 0); PG8_STAGE(PG8_SA(1, 1), a1 + hstep, voffA);
            PG8_WAIT_L(8); PG8_BAR; PG8_WAIT_L(0); PG8_MMA(0, 0, At, B0); PG8_BAR; PG8_SCHED;
            PG8_LDB(B1, 0, 1); PG8_STAGE(PG8_SB(0, 0), b2, voffB);
            PG8_BAR; PG8_WAIT_L(0); PG8_MMA(0, 1, At, B1); PG8_BAR;
            PG8_LDA(At, 0, 1); PG8_STAGE(PG8_SA(0, 0), a2, voffA);
            PG8_BAR; PG8_WAIT_L(0); PG8_MMA(1, 0, At, B0); PG8_BAR; PG8_SCHED;
            PG8_STAGE(PG8_SB(0, 1), b2 + hstep, voffB);
            PG8_WAIT_V(6); PG8_BAR; PG8_MMA(1, 1, At, B1); PG8_BAR;
            PG8_LDB(B0, 1, 0); PG8_SCHED; PG8_LDA(At, 1, 0); PG8_STAGE(PG8_SA(0, 1), a2 + hstep, voffA);
            PG8_WAIT_L(8); PG8_BAR; PG8_WAIT_L(0); PG8_MMA(0, 0, At, B0); PG8_BAR; PG8_SCHED;
            PG8_LDB(B1, 1, 1); PG8_STAGE(PG8_SB(1, 0), b3, voffB);
            PG8_BAR; PG8_WAIT_L(0); PG8_MMA(0, 1, At, B1); PG8_BAR;
            PG8_LDA(At, 1, 1); PG8_STAGE(PG8_SA(1, 0), a3, voffA);
            PG8_BAR; PG8_WAIT_L(0); PG8_MMA(1, 0, At, B0); PG8_BAR; PG8_SCHED;
            PG8_STAGE(PG8_SB(1, 1), b3 + hstep, voffB);
            PG8_WAIT_V(6); PG8_BAR; PG8_MMA(1, 1, At, B1); PG8_BAR;
            }
        }
        if constexpr (ALIGN_EPI) { if (wr == 0) PG8_BAR; }
        if constexpr (!Epi::AFTER_DRAIN) { E(acc, cur, wr, wc, fr, fq); S.done(cur); }
        if (!has_next) break;
#pragma unroll
        for (int a = 0; a < 2; ++a)
#pragma unroll
            for (int b = 0; b < 2; ++b)
#pragma unroll
                for (int m = 0; m < 4; ++m)
#pragma unroll
                    for (int n = 0; n < 2; ++n) acc[a][b][m][n] = (f32x4){0.f, 0.f, 0.f, 0.f};
        cur = nxt; cA = nA; cB = nB; ++ui;
        if constexpr (ALIGN_EPI) { if (wr == 1) PG8_BAR; }
    }
    PG8_WAIT_V(0);
    if constexpr (!ALIGN_EPI) { if (wr == 0) PG8_BAR; }
    PG8_BAR;
    if constexpr (Epi::AFTER_DRAIN) { E.fused(acc, cur, wr, wc, fr, fq, lds, wid, lane); S.done(cur); }
#undef PG8_SA
#undef PG8_SB
#undef PG8_STAGE
#undef PG8_LDA
#undef PG8_LDB
#undef PG8_MMA
#undef PG8_WAIT_V
#undef PG8_WAIT_L
#undef PG8_BAR
#undef PG8_SCHED
}
}

#ifndef PG8_SP2
#define PG8_SP2 true
#endif

#define LAS __attribute__((address_space(3)))
typedef unsigned short bf16;
typedef short bf16x8 __attribute__((ext_vector_type(8)));
typedef float f32x4 __attribute__((ext_vector_type(4)));
typedef float f32x16 __attribute__((ext_vector_type(16)));
typedef unsigned u32x4 __attribute__((ext_vector_type(4)));
typedef unsigned u32x2 __attribute__((ext_vector_type(2)));

constexpr int DM = 1024, NMAIN = 32768, ROWS = 33024, METAROW = 32768, DFF = 4096;
constexpr int NTHREADS = 512;
constexpr int LDS_BYTES = 147456;
constexpr int LDS_ITEM_OFF = LDS_BYTES - 16;
constexpr size_t MiB = 1u << 20;
constexpr size_t WS_CTL = 0, WS_WIN = 1 * MiB, WS_WUPA = 12 * MiB, WS_WUPB = 13 * MiB, WS_WOUT = 14 * MiB, WS_WFF1 = 16 * MiB, WS_WFF2 = 24 * MiB;
constexpr size_t WS_LORA = 32 * MiB, WS_XNMETA = 32 * MiB + 512 * 1024, WS_CB = 33 * MiB, WS_ACT = 36 * MiB;
constexpr size_t ACT_SZ = (size_t)ROWS * 512 * 2, L_SZ = (size_t)ROWS * 256 * 2;
constexpr size_t WS_R = WS_ACT, WS_KA = WS_R + ACT_SZ, WS_VA = WS_KA + ACT_SZ, WS_L = WS_VA + ACT_SZ, WS_Q = WS_L + L_SZ, WS_KB = WS_Q + ACT_SZ, WS_VT = WS_KB + ACT_SZ, WS_END = WS_VT + ACT_SZ;
constexpr size_t WS_GA = WS_KA, WS_GB = WS_KB, WS_MN = WS_ACT, WS_HID = WS_ACT + 64 * MiB;
static_assert(WS_END <= 256 * MiB && WS_HID + 128 * MiB <= 256 * MiB && WS_CB + (size_t)2 * ROWS * 8 * 4 <= WS_ACT, "ws map");
constexpr float LOG2E = 1.4426950408889634f;
constexpr float QSCALE = 0.125f * LOG2E;

struct Params { const float* in[29]; float* out; unsigned char* ws; };
typedef const __attribute__((address_space(4))) Params* KP;
enum { I_XP = 0, I_XS, I_META, I_GMIX, I_WIN, I_MUP, I_MUN, I_W0, I_WUP, I_A0, I_AUP, I_GUP, I_KK, I_KA, I_RK, I_LNW, I_LNB, I_LQ1, I_LK1, I_LQ2, I_LK2, I_SUBG, I_UPA, I_UPB, I_WOUT, I_GFFN, I_FF1, I_FF2, I_GFIN };

__device__ __forceinline__ unsigned cvtpk(float lo, float hi) { unsigned r; asm volatile("v_cvt_pk_bf16_f32 %0, %1, %2" : "=v"(r) : "v"(lo), "v"(hi)); return r; }
__device__ __forceinline__ float bf2f(unsigned short b) { return __uint_as_float(((unsigned)b) << 16); }
__device__ __forceinline__ float bflo(unsigned w) { return __uint_as_float(w << 16); }
__device__ __forceinline__ float bfhi(unsigned w) { return __uint_as_float(w & 0xffff0000u); }
__device__ __forceinline__ void unpack8(const u32x4 v, float* o) { o[0] = bflo(v.x); o[1] = bfhi(v.x); o[2] = bflo(v.y); o[3] = bfhi(v.y); o[4] = bflo(v.z); o[5] = bfhi(v.z); o[6] = bflo(v.w); o[7] = bfhi(v.w); }
__device__ __forceinline__ float wave_sum(float v) {
#pragma unroll
    for (int o = 1; o < 64; o <<= 1) v += __shfl_xor(v, o);
    return v;
}
__device__ __forceinline__ float sigmoidf_(float x) { return 1.0f / (1.0f + __expf(-x)); }
__device__ __forceinline__ int seq_base(int s) { return s == 0 ? 0 : 16384 + (s - 1) * 2048; }
__device__ __forceinline__ int seq_len(int s) { return s == 0 ? 16384 : 2048; }
__device__ __forceinline__ int pos_row(int base, int p) { return p < 16 ? METAROW + p : base + p - 16; }

template <class Op> struct Epi8 {
    static constexpr bool PERM = true, AFTER_DRAIN = false;
    Op op;
    __device__ __forceinline__ void operator()(const pg8::f32x4 (&acc)[2][2][4][2], const pg8::Unit& u, int wr, int wc, int fr, int fq) const {
        const int row0 = u.pm * 256 + wr * 64 + fr, col0 = u.pn * 256 + wc * 32 + 8 * fq;
#pragma unroll
        for (int ai = 0; ai < 2; ++ai)
#pragma unroll
            for (int m = 0; m < 4; ++m)
#pragma unroll
                for (int bj = 0; bj < 2; ++bj) { op.apply(row0 + ai * 128 + m * 16, col0 + bj * 128, u.pn, acc[ai][bj][m][0], acc[ai][bj][m][1]); asm volatile("" ::: "memory"); }
    }
};
__device__ __forceinline__ u32x4 pack8(const f32x4 a, const f32x4 b) { u32x4 w; w.x = cvtpk(a[0], a[1]); w.y = cvtpk(a[2], a[3]); w.z = cvtpk(b[0], b[1]); w.w = cvtpk(b[2], b[3]); return w; }

constexpr int CW_KN = 320;
__device__ __forceinline__ float dpp_max16(float v) {
    int x = __float_as_int(v);
    v = fmaxf(v, __int_as_float(__builtin_amdgcn_update_dpp(0, x, 0xB1, 0xf, 0xf, true))); x = __float_as_int(v);
    v = fmaxf(v, __int_as_float(__builtin_amdgcn_update_dpp(0, x, 0x4E, 0xf, 0xf, true))); x = __float_as_int(v);
    v = fmaxf(v, __int_as_float(__builtin_amdgcn_update_dpp(0, x, 0x141, 0xf, 0xf, true))); x = __float_as_int(v);
    v = fmaxf(v, __int_as_float(__builtin_amdgcn_update_dpp(0, x, 0x140, 0xf, 0xf, true)));
    return v;
}
struct OpProj {
    unsigned char* ws;
    __device__ __forceinline__ void apply(int row, int col, int pn, f32x4 v0, f32x4 v1) const {
        if (pn >= 11) {
            bf16* VT = (bf16*)(ws + WS_VT); const int c = col - 11 * 256;
#pragma unroll
            for (int e = 0; e < 4; ++e) { VT[(size_t)(c + e) * ROWS + row] = (bf16)(cvtpk(v0[e], 0.f) & 0xffffu); VT[(size_t)(c + 4 + e) * ROWS + row] = (bf16)(cvtpk(v1[e], 0.f) & 0xffffu); }
            return;
        }
        bf16* O; int ldc = 512, c;
        if (pn < 2) { O = (bf16*)(ws + WS_R); c = col; }
        else if (pn < 4) { O = (bf16*)(ws + WS_KA); c = col - 512; }
        else if (pn < 6) { O = (bf16*)(ws + WS_VA); c = col - 1024; }
        else if (pn < 7) { O = (bf16*)(ws + WS_L); c = col - 1536; ldc = 256; }
        else if (pn < 9) { O = (bf16*)(ws + WS_Q); c = col - 1792; v0 = v0 * QSCALE; v1 = v1 * QSCALE; }
        else { O = (bf16*)(ws + WS_KB); c = col - 2304; }
        const u32x4 w = pack8(v0, v1);
        *(u32x4*)(O + (size_t)row * ldc + c) = w;
        if (pn >= 9) {
            float k8[8]; unpack8(w, k8); float ss = 0.f;
#pragma unroll
            for (int e = 0; e < 8; ++e) ss = fmaf(k8[e], k8[e], ss);
            ss = dpp_max16(ss);
            if ((threadIdx.x & 15) == 0) { const int sidx = row < 16384 ? 0 : row < NMAIN ? 1 + ((row - 16384) >> 11) : 9;
                atomicMax((unsigned*)(ws + WS_CTL) + CW_KN + sidx * 64 + (c >> 3), __float_as_uint(ss)); }
        }
    }
};
struct OpGate {
    unsigned char* ws;
    __device__ __forceinline__ void apply(int row, int col, int pn, f32x4 v0, f32x4 v1) const {
        bf16* O = (bf16*)(ws + (pn < 4 ? WS_GA : WS_GB)); const int c = pn < 4 ? col : col - 1024;
#pragma unroll
        for (int e = 0; e < 4; ++e) { v0[e] = sigmoidf_(v0[e]); v1[e] = sigmoidf_(v1[e]); }
        *(u32x4*)(O + (size_t)row * 1024 + c) = pack8(v0, v1);
    }
};
struct OpUpA {
    unsigned char* ws;
    __device__ __forceinline__ void apply(int row, int col, int pn, f32x4 v0, f32x4 v1) const {
        u32x4* p = (u32x4*)((bf16*)(ws + WS_GA) + (size_t)row * 1024 + col); float g[8]; unpack8(*p, g);
#pragma unroll
        for (int e = 0; e < 4; ++e) { v0[e] *= g[e]; v1[e] *= g[4 + e]; }
        *p = pack8(v0, v1);
    }
};
struct OpUpB {
    unsigned char* ws;
    __device__ __forceinline__ void apply(int row, int col, int pn, f32x4 v0, f32x4 v1) const {
        u32x4* p = (u32x4*)((bf16*)(ws + WS_GB) + (size_t)row * 1024 + col); float g[8], a[8]; unpack8(*p, g);
        unpack8(*(const u32x4*)((const bf16*)(ws + WS_GA) + (size_t)row * 1024 + col), a);
#pragma unroll
        for (int e = 0; e < 4; ++e) { v0[e] = a[e] + v0[e] * g[e]; v1[e] = a[4 + e] + v1[e] * g[4 + e]; }
        *p = pack8(v0, v1);
    }
};
struct OpOut {
    const float* xp; const float* xs; float* out;
    __device__ __forceinline__ void apply(int row, int col, int pn, f32x4 v0, f32x4 v1) const {
        const float* x = (row < 16384 ? xp + (size_t)row * DM : xs + (size_t)(row - 16384) * DM) + col;
        float* o = out + (size_t)row * DM + col;
        *(f32x4*)o = *(const f32x4*)x + v0; *(f32x4*)(o + 4) = *(const f32x4*)(x + 4) + v1;
    }
};
struct OpFF1 {
    bf16* hid;
    __device__ __forceinline__ void apply(int row, int col, int pn, f32x4 v0, f32x4 v1) const {
#pragma unroll
        for (int e = 0; e < 4; ++e) { const float a = fmaxf(v0[e], 0.f), b = fmaxf(v1[e], 0.f); v0[e] = a * a; v1[e] = b * b; }
        *(u32x4*)(hid + (size_t)row * DFF + col) = pack8(v0, v1);
    }
};
struct OpFF2 {
    float* out;
    __device__ __forceinline__ void apply(int row, int col, int pn, f32x4 v0, f32x4 v1) const {
        float* o = out + (size_t)row * DM + col;
        *(f32x4*)o = *(const f32x4*)o + v0; *(f32x4*)(o + 4) = *(const f32x4*)(o + 4) + v1;
    }
};

__device__ __forceinline__ unsigned f2bf_rne(float f) { return cvtpk(f, 0.f) & 0xffffu; }
__device__ __forceinline__ void transpose_item(const float* W, int K, int N, bf16* WT, LAS float* scr, int item, int lane) {
    const int nblk = N / 32, kb = item / nblk, nb = item % nblk, k0 = 64 * kb, n0 = 32 * nb;
#pragma unroll 8
    for (int i = 0; i < 32; ++i) { const int kk = 2 * i + (lane >> 5); scr[kk * 33 + (lane & 31)] = W[(size_t)(k0 + kk) * N + n0 + (lane & 31)]; }
    asm volatile("s_waitcnt vmcnt(0) lgkmcnt(0)" ::: "memory");
    const int c = lane & 7;
#pragma unroll
    for (int j = 0; j < 4; ++j) { const int n = (lane >> 3) + 8 * j; const LAS float* s = scr + (8 * c) * 33 + n;
        u32x4 o; o.x = cvtpk(s[0 * 33], s[1 * 33]); o.y = cvtpk(s[2 * 33], s[3 * 33]); o.z = cvtpk(s[4 * 33], s[5 * 33]); o.w = cvtpk(s[6 * 33], s[7 * 33]);
        *(u32x4*)(WT + (size_t)(n0 + n) * K + k0 + 8 * c) = o; }
    asm volatile("s_waitcnt lgkmcnt(0)" ::: "memory");
}
__device__ __forceinline__ void rms_row_bf16(const float* src, const float* g, bf16* dst, int lane) {
    unsigned long long* o8 = (unsigned long long*)dst + lane;
    if (!src) {
#pragma unroll
        for (int j = 0; j < 4; ++j) o8[64 * j] = 0ull;
        return; }
    const f32x4* xr = (const f32x4*)src + lane; const f32x4* gr = (const f32x4*)g + lane;
    f32x4 v[4]; float s = 0.f;
#pragma unroll
    for (int j = 0; j < 4; ++j) { v[j] = xr[64 * j]; s += (v[j].x * v[j].x + v[j].y * v[j].y) + (v[j].z * v[j].z + v[j].w * v[j].w); }
    const float rstd = rsqrtf(wave_sum(s) * (1.f / DM) + 1e-6f);
#pragma unroll
    for (int j = 0; j < 4; ++j) { const f32x4 gg = gr[64 * j]; const f32x4 y = v[j] * rstd * gg;
        o8[64 * j] = (unsigned long long)cvtpk(y.x, y.y) | ((unsigned long long)cvtpk(y.z, y.w) << 32); }
}
__device__ __forceinline__ void phase_prologue(LAS unsigned char* lds, KP P) {
    const int tid = fresh_tid(), lane = tid & 63, wid = tid >> 6;
    LAS float* scr = (LAS float*)(lds + wid * 16384);
    const int gw = blockIdx.x * 8 + wid, NGW = gridDim.x * 8;
    unsigned char* ws = P->ws;
    constexpr int I_IN = (1024 / 64) * (5376 / 32), I_UP = (512 / 64) * (1024 / 32), I_O = (1024 / 64) * (1024 / 32), I_1 = (1024 / 64) * (4096 / 32), I_2 = (4096 / 64) * (1024 / 32);
    constexpr int I_LW = (64 / 64) * (512 / 32), I_G = (128 / 64) * (512 / 32);
    constexpr int NITEMS = I_IN + 2 * I_UP + I_O + I_1 + I_2 + 4 * I_LW + I_G;
    for (int it = gw; it < NITEMS; it += NGW) {
        int r = it;
        if (r < I_IN) { transpose_item(P->in[I_WIN], 1024, 5376, (bf16*)(ws + WS_WIN), scr, r, lane); continue; } r -= I_IN;
        if (r < I_UP) { transpose_item(P->in[I_UPA], 512, 1024, (bf16*)(ws + WS_WUPA), scr, r, lane); continue; } r -= I_UP;
        if (r < I_UP) { transpose_item(P->in[I_UPB], 512, 1024, (bf16*)(ws + WS_WUPB), scr, r, lane); continue; } r -= I_UP;
        if (r < I_O) { transpose_item(P->in[I_WOUT], 1024, 1024, (bf16*)(ws + WS_WOUT), scr, r, lane); continue; } r -= I_O;
        if (r < I_1) { transpose_item(P->in[I_FF1], 1024, 4096, (bf16*)(ws + WS_WFF1), scr, r, lane); continue; } r -= I_1;
        if (r < I_2) { transpose_item(P->in[I_FF2], 4096, 1024, (bf16*)(ws + WS_WFF2), scr, r, lane); continue; } r -= I_2;
        if (r < 2 * I_LW) { const int d = r / I_LW; transpose_item(P->in[I_WUP] + (size_t)d * 64 * 512, 64, 512, (bf16*)(ws + WS_LORA) + (size_t)d * 512 * 64, scr, r % I_LW, lane); continue; } r -= 2 * I_LW;
        if (r < 2 * I_LW) { const int d = r / I_LW; transpose_item(P->in[I_AUP] + (size_t)d * 64 * 512, 64, 512, (bf16*)(ws + WS_LORA + 131072) + (size_t)d * 512 * 64, scr, r % I_LW, lane); continue; } r -= 2 * I_LW;
        transpose_item(P->in[I_GUP], 128, 512, (bf16*)(ws + WS_LORA + 262144), scr, r, lane);
    }
    bf16* XN = (bf16*)P->out; bf16* XM = (bf16*)(ws + WS_XNMETA);
    for (int m = gw; m < ROWS; m += NGW) {
        const float* src = m < 16384 ? P->in[I_XP] + (size_t)m * DM : m < NMAIN ? P->in[I_XS] + (size_t)(m - 16384) * DM : (m - NMAIN < 16 ? P->in[I_META] + (size_t)(m - NMAIN) * DM : nullptr);
        bf16* dst = m < NMAIN ? XN + (size_t)m * DM : XM + (size_t)(m - NMAIN) * DM;
        rms_row_bf16(src, P->in[I_GMIX], dst, lane);
    }
}

constexpr int AT_KSTR = 272, AT_VSTR = 144, AT_KSZ = 64 * AT_KSTR, AT_BUF = AT_KSZ + 128 * AT_VSTR;
__device__ __forceinline__ f32x16 mfma32(bf16x8 a, bf16x8 b, f32x16 c) { return __builtin_amdgcn_mfma_f32_32x32x16_bf16(a, b, c, 0, 0, 0); }
__device__ __forceinline__ void attn_unit(LAS unsigned char* lds, KP P, int s, int h, int qb, float lam) {
    int tid_ = threadIdx.x; asm volatile("" : "+v"(tid_));
    const int tid = tid_, lane = tid & 63, r32 = lane & 31, hi = lane >> 5, wid = __builtin_amdgcn_readfirstlane(tid >> 6), rg = wid & 3, mp = wid >> 2;
    const int L = seq_len(s), base = seq_base(s), NT = 1 + L / 64;
    unsigned char* ws = P->ws;
    const bf16* KB = (const bf16*)(ws + WS_KB); const bf16* VT = (const bf16*)(ws + WS_VT); bf16* Q = (bf16*)(ws + WS_Q);
    const int qrow = base + qb * 128 + rg * 32 + r32;
    bf16x8 q[4];
#pragma unroll
    for (int d0 = 0; d0 < 4; ++d0) q[d0] = *(const bf16x8*)(Q + (size_t)qrow * 512 + h * 128 + mp * 64 + d0 * 16 + hi * 8);
    f32x16 O[4];
#pragma unroll
    for (int b = 0; b < 4; ++b)
#pragma unroll
        for (int r = 0; r < 16; ++r) O[b][r] = 0.f;
    float mx = -INFINITY, ls = 0.f;
    const float qh = (float)(16 + qb * 128 + rg * 32 + r32 - 4 * hi);
    const float nslope = -exp2f(-2.0f * (float)(h + 1)) * LOG2E;
    const int kr0 = tid >> 4, kc = tid & 15, vn0 = tid >> 3, vc = tid & 7;
    u32x4 kreg[2], vreg[2];
    const unsigned kgo = (unsigned)((kr0 * 512 + h * 128 + kc * 8) * 2), vgo = (unsigned)(((h * 128 + vn0) * ROWS + vc * 8) * 2);
    const unsigned klo = (unsigned)(kr0 * AT_KSTR + kc * 16), vlo = (unsigned)(AT_KSZ + vn0 * AT_VSTR + vc * 16);
#define AT_GLOAD(j) do { const int m0_ = (j) == 0 ? METAROW : base + 64 * ((j) - 1); \
        const unsigned char* kt_ = (const unsigned char*)KB + (size_t)m0_ * 1024; const unsigned char* vt_ = (const unsigned char*)VT + (size_t)m0_ * 2; \
        kreg[0] = *(const u32x4*)(kt_ + kgo); kreg[1] = *(const u32x4*)(kt_ + 32 * 1024 + kgo); \
        vreg[0] = *(const u32x4*)(vt_ + vgo); vreg[1] = *(const u32x4*)(vt_ + (size_t)64 * ROWS * 2 + vgo); } while (0)
#define AT_LSTORE(buf) do { LAS unsigned char* kb_ = lds + (buf) * AT_BUF; \
        *(LAS u32x4*)(kb_ + klo) = kreg[0]; *(LAS u32x4*)(kb_ + klo + 32 * AT_KSTR) = kreg[1]; \
        *(LAS u32x4*)(kb_ + vlo) = vreg[0]; *(LAS u32x4*)(kb_ + vlo + 64 * AT_VSTR) = vreg[1]; } while (0)
    float qn, kn;
    { float ssq = 0.f;
#pragma unroll
      for (int d0 = 0; d0 < 4; ++d0) { float t[8]; unpack8(__builtin_bit_cast(u32x4, q[d0]), t);
#pragma unroll
        for (int e = 0; e < 8; ++e) ssq = fmaf(t[e], t[e], ssq); }
      ssq += __shfl_xor(ssq, 32); qn = sqrtf(ssq) * 1.002f;
      const unsigned* KN = (const unsigned*)(ws + WS_CTL) + CW_KN; float ks = 0.f;
#pragma unroll
      for (int g = 0; g < 8; ++g) ks += fmaxf(__uint_as_float(__hip_atomic_load(KN + s * 64 + h * 16 + mp * 8 + g, __ATOMIC_RELAXED, __HIP_MEMORY_SCOPE_AGENT)), __uint_as_float(__hip_atomic_load(KN + 9 * 64 + h * 16 + mp * 8 + g, __ATOMIC_RELAXED, __HIP_MEMORY_SCOPE_AGENT)));
      kn = sqrtf(ks) * 1.002f; }
    const int jc0 = 1 + qb * 2;
    int jlo = jc0, jhi = jc0 + 1;
    LAS float* red = (LAS float*)(lds + 2 * AT_BUF);
#pragma unroll 1
    for (int ph = 0; ph < 2; ++ph) {
        int nleft, ntl;
        if (ph == 0) { nleft = 0; ntl = 2; }
        else {
            float dneed = (qn * kn - mx + 40.0f) / (-nslope);
#pragma unroll
            for (int o = 1; o < 64; o <<= 1) dneed = fmaxf(dneed, __shfl_xor(dneed, o));
            if (lane == 0) red[wid] = dneed;
            __syncthreads();
            float dm = red[0];
#pragma unroll
            for (int w8 = 1; w8 < 8; ++w8) dm = fmaxf(dm, red[w8]);
            dm = fminf(fmaxf(dm, 0.f), 1.0e6f);
            const int dmax = (int)dm + 1, q0 = 16 + qb * 128;
            const int plo = q0 - dmax, phi = q0 + 127 + dmax;
            jlo = plo < 16 ? 0 : 1 + ((plo - 16) >> 6); jhi = phi >= L + 16 ? NT - 1 : 1 + ((phi - 16) >> 6);
            if (jlo > jc0) jlo = jc0; if (jhi < jc0 + 1) jhi = jc0 + 1;
            nleft = jc0 - jlo; ntl = nleft + (jhi - jc0 - 1);
        }
        if (ntl > 0) {
#define AT_J(t) (ph == 0 ? jc0 + (t) : ((t) < nleft ? jlo + (t) : jc0 + 2 + ((t) - nleft)))
        { const int jf = AT_J(0); AT_GLOAD(jf); } AT_LSTORE(0); __syncthreads();
#pragma unroll 1
        for (int t = 0; t < ntl; ++t) {
            const int j = AT_J(t);
            if (t + 1 < ntl) { const int jn = AT_J(t + 1); AT_GLOAD(jn); }
            const LAS unsigned char* Kb = lds + (t & 1) * AT_BUF + mp * 128; const LAS unsigned char* Vb = lds + (t & 1) * AT_BUF + AT_KSZ;
            const float dq = qh - (float)(j == 0 ? 0 : 64 * j - 48);
            f32x16 p0, p1;
#pragma unroll
            for (int r = 0; r < 16; ++r) { p0[r] = 0.f; p1[r] = 0.f; }
#pragma unroll
            for (int d0 = 0; d0 < 4; ++d0) {
                const bf16x8 a0 = *(const LAS bf16x8*)(Kb + r32 * AT_KSTR + d0 * 32 + hi * 16);
                const bf16x8 a1 = *(const LAS bf16x8*)(Kb + (32 + r32) * AT_KSTR + d0 * 32 + hi * 16);
                p0 = mfma32(a0, q[d0], p0); p1 = mfma32(a1, q[d0], p1);
            }
#pragma unroll
            for (int r = 0; r < 16; ++r) { const float dd = dq - (float)((r & 3) + 8 * (r >> 2)); p0[r] = fmaf(fabsf(dd), nslope, p0[r]); p1[r] = fmaf(fabsf(dd - 32.f), nslope, p1[r]); }
            if (j == 0) {
#pragma unroll
                for (int r = 0; r < 16; ++r) { if ((r & 3) + 8 * (r >> 2) + 4 * hi >= 16) p0[r] = -INFINITY; p1[r] = -INFINITY; }
            }
            float rm = fmaxf(p0[0], p1[0]);
#pragma unroll
            for (int r = 1; r < 16; ++r) rm = fmaxf(rm, fmaxf(p0[r], p1[r]));
            rm = fmaxf(rm, __shfl_xor(rm, 32));
            const float mn = fmaxf(mx, rm);
            if (__any(mn > mx)) {
                const float f = __builtin_amdgcn_exp2f(mx - mn); ls *= f; mx = mn;
#pragma unroll
                for (int b = 0; b < 4; ++b)
#pragma unroll
                    for (int r = 0; r < 16; ++r) O[b][r] *= f;
            }
            float sum = 0.f;
#pragma unroll
            for (int r = 0; r < 16; ++r) { p0[r] = __builtin_amdgcn_exp2f(p0[r] - mx); p1[r] = __builtin_amdgcn_exp2f(p1[r] - mx); sum += p0[r] + p1[r]; }
            ls += sum;
            bf16x8 pf[4];
#pragma unroll
            for (int k2 = 0; k2 < 2; ++k2) {
                u32x4 w0, w1;
                w0.x = cvtpk(p0[8 * k2 + 0], p0[8 * k2 + 1]); w0.y = cvtpk(p0[8 * k2 + 2], p0[8 * k2 + 3]); w0.z = cvtpk(p0[8 * k2 + 4], p0[8 * k2 + 5]); w0.w = cvtpk(p0[8 * k2 + 6], p0[8 * k2 + 7]);
                w1.x = cvtpk(p1[8 * k2 + 0], p1[8 * k2 + 1]); w1.y = cvtpk(p1[8 * k2 + 2], p1[8 * k2 + 3]); w1.z = cvtpk(p1[8 * k2 + 4], p1[8 * k2 + 5]); w1.w = cvtpk(p1[8 * k2 + 6], p1[8 * k2 + 7]);
                pf[k2] = __builtin_bit_cast(bf16x8, w0); pf[2 + k2] = __builtin_bit_cast(bf16x8, w1);
            }
#pragma unroll
            for (int ks = 0; ks < 4; ++ks)
#pragma unroll
                for (int b = 0; b < 4; ++b) {
                    const LAS unsigned char* vp = Vb + (b * 32 + r32) * AT_VSTR + ks * 32 + hi * 8;
                    const u32x2 lo = *(const LAS u32x2*)vp, hh = *(const LAS u32x2*)(vp + 16);
                    u32x4 vv; vv.x = lo.x; vv.y = lo.y; vv.z = hh.x; vv.w = hh.y;
                    O[b] = mfma32(__builtin_bit_cast(bf16x8, vv), pf[ks], O[b]);
                }
            if (t + 1 < ntl) AT_LSTORE((t + 1) & 1);
            __syncthreads();
        }
#undef AT_J
        }
    }
#undef AT_GLOAD
#undef AT_LSTORE
    const float lt = ls + __shfl_xor(ls, 32);
    const float inv = (mp ? lam : 1.0f) / lt;
    int lane2 = lane; asm volatile("" : "+v"(lane2));
    const int r32e = lane2 & 31, hie = lane2 >> 5;
    LAS float* ex = (LAS float*)lds + rg * (128 * 32) + hie * 128 + r32e;
    if (mp == 1) {
#pragma unroll
        for (int b = 0; b < 4; ++b)
#pragma unroll
            for (int r = 0; r < 16; ++r) ex[(32 * b + (r & 3) + 8 * (r >> 2)) * 32] = O[b][r] * inv;
    }
    __syncthreads();
    if (mp == 0) {
        float ss = 0.f;
#pragma unroll
        for (int b = 0; b < 4; ++b)
#pragma unroll
            for (int r = 0; r < 16; ++r) { const float o = O[b][r] * inv - ex[(32 * b + (r & 3) + 8 * (r >> 2)) * 32]; O[b][r] = o; ss += o * o; }
        ss += __shfl_xor(ss, 32);
        const float rstd = rsqrtf(ss * (1.0f / 128.0f) + 1e-5f) * 0.8f;
        const float* sg = P->in[I_SUBG] + 4 * hie; bf16* Qo = Q + (size_t)(base + qb * 128 + rg * 32 + r32e) * 512 + h * 128 + 4 * hie;
#pragma unroll
        for (int b = 0; b < 4; ++b)
#pragma unroll
            for (int r4 = 0; r4 < 4; ++r4) {
                const int n = 32 * b + 8 * r4; const f32x4 g = *(const f32x4*)(sg + n);
                u32x2 w; w.x = cvtpk(O[b][4 * r4 + 0] * rstd * g.x, O[b][4 * r4 + 1] * rstd * g.y); w.y = cvtpk(O[b][4 * r4 + 2] * rstd * g.z, O[b][4 * r4 + 3] * rstd * g.w);
                *(u32x2*)(Qo + n) = w;
            }
    }
    __syncthreads();
}

constexpr int SC_R = 0, SC_K = 16384, SC_V = 32768, SC_W = 49152, SC_B = 65536, SC_KK = 81920, SC_Y = 98304, SC_TW = 114688, SC_AD = 123904, SC_MU = 133120;
__device__ __forceinline__ float dpp_add(float v, int ctrl_id) {
    const int x = __float_as_int(v); int y;
    if (ctrl_id == 0) y = __builtin_amdgcn_update_dpp(0, x, 0xB1, 0xf, 0xf, true);
    else if (ctrl_id == 1) y = __builtin_amdgcn_update_dpp(0, x, 0x4E, 0xf, 0xf, true);
    else if (ctrl_id == 2) y = __builtin_amdgcn_update_dpp(0, x, 0x141, 0xf, 0xf, true);
    else y = __builtin_amdgcn_update_dpp(0, x, 0x140, 0xf, 0xf, true);
    return v + __int_as_float(y);
}
template <int LPR> __device__ __forceinline__ float grp_sum(float v) {
    v = dpp_add(v, 0); v = dpp_add(v, 1); v = dpp_add(v, 2);
    if (LPR == 16) v = dpp_add(v, 3);
    return v;
}
#define BAR_LDS() asm volatile("s_waitcnt lgkmcnt(0)\n\ts_barrier" ::: "memory")
__device__ __forceinline__ float fast_sigmoid(float x) { return __builtin_amdgcn_rcpf(1.0f + __builtin_amdgcn_exp2f(-LOG2E * x)); }
__device__ __forceinline__ float fast_tanh(float x) { return 1.0f - 2.0f * __builtin_amdgcn_rcpf(1.0f + __builtin_amdgcn_exp2f(2.0f * LOG2E * x)); }
template <int NRP, int NSW>
__device__ __forceinline__ void scan_unit(LAS unsigned char* lds, KP P, int s, int d, int h, int rp) {
    constexpr int RPB = 64 / NRP, RPW = RPB / NSW, LPR = 64 / RPW, CPL = 64 / LPR;
    static_assert(LPR == 8 || LPR == 16, "scan geometry");
    int tid_ = threadIdx.x; asm volatile("" : "+v"(tid_));
    const int tid = tid_, lane = tid & 63, wid = __builtin_amdgcn_readfirstlane(tid >> 6);
    const int L = seq_len(s), base = seq_base(s), Ltot = L + 16, nchunk = (Ltot + 63) / 64;
    unsigned char* ws = P->ws;
    const bf16* Rb = (const bf16*)(ws + WS_R); const bf16* KAb = (const bf16*)(ws + WS_KA); const bf16* VAb = (const bf16*)(ws + WS_VA); const bf16* Lb = (const bf16*)(ws + WS_L);
    float* CB = (float*)(ws + WS_CB); bf16* YD = (bf16*)((unsigned char*)P->out + 64 * MiB) + (size_t)d * NMAIN * 512;
    LAS float* fS = (LAS float*)lds; LAS float* fV = (LAS float*)(lds + 81920); LAS float* fY = (LAS float*)(lds + SC_Y); LAS float* fMU = (LAS float*)(lds + SC_MU);
#define SCI(sl_, a_, c_) ((sl_) * 320 + (a_) * 64 + (c_))
    for (int i = tid; i < 832; i += NTHREADS) {
        float v;
        if (i < 640) { const int which = i / 320, jj = i % 320, a = jj >> 6, c = jj & 63; const int gi = a < 3 ? a * 512 + h * 64 + c : 1536 + (a - 3) * 64 + c; v = P->in[which ? I_MUN : I_MUP][gi]; }
        else { const int a = (i - 640) >> 6, c = (i - 640) & 63; v = P->in[a == 0 ? I_KK : a == 1 ? I_KA : I_RK][h * 64 + c]; }
        fMU[i] = v;
    }
    const int mat = wid >> 2, ntile = wid & 3;
    const bf16* Wt = (const bf16*)(ws + WS_LORA + (mat ? 131072 : 0)) + ((size_t)d * 512 + h * 64 + ntile * 16 + (lane & 15)) * 64 + (lane >> 4) * 8;
    const bf16x8 bfr0 = *(const bf16x8*)Wt, bfr1 = *(const bf16x8*)(Wt + 32);
    const float bias = P->in[mat ? I_A0 : I_W0][d * 512 + h * 64 + ntile * 16 + (lane & 15)];
    float S[CPL];
#pragma unroll
    for (int j = 0; j < CPL; ++j) S[j] = 0.f;
    const int rowl = lane / LPR, kg = lane % LPR, srow = rp * RPB + wid * RPW + rowl;
    const int slot = tid >> 3, cg8 = (tid & 7) * 8;
    u32x4 raw[5][3];
#define SC_LOAD(c) do { const int i_ = 64 * (c) + slot; const bool ok_ = i_ < Ltot; const int p_ = ok_ ? (d ? Ltot - 1 - i_ : i_) : 0; \
        const bool okp_ = ok_ && p_ > 0, okn_ = ok_ && p_ + 1 < Ltot; \
        const unsigned rc_ = (unsigned)pos_row(base, p_), rp_ = (unsigned)pos_row(base, okp_ ? p_ - 1 : p_), rn_ = (unsigned)pos_row(base, okn_ ? p_ + 1 : p_); \
        _Pragma("unroll") for (int a_ = 0; a_ < 5; ++a_) { const unsigned char* B_ = (const unsigned char*)(a_ == 0 ? Rb : a_ == 1 ? KAb : a_ == 2 ? VAb : Lb); const unsigned ld_ = a_ < 3 ? 1024u : 512u; \
            const unsigned co_ = (unsigned)(((a_ < 3 ? h * 64 : (a_ - 3) * 64) + cg8) * 2); \
            raw[a_][0] = *(const u32x4*)(B_ + (rp_ * ld_ + co_)); raw[a_][1] = *(const u32x4*)(B_ + (rc_ * ld_ + co_)); raw[a_][2] = *(const u32x4*)(B_ + (rn_ * ld_ + co_)); } \
        if (!(okp_ && okn_)) { const u32x4 z_ = {0u, 0u, 0u, 0u}; \
            _Pragma("unroll") for (int a_ = 0; a_ < 5; ++a_) { if (!okp_) raw[a_][0] = z_; if (!ok_) raw[a_][1] = z_; if (!okn_) raw[a_][2] = z_; } } } while (0)
    SC_LOAD(0);
    BAR_LDS();
    for (int c = 0; c < nchunk; ++c) {
        const int nvalid = (Ltot - 64 * c) < 64 ? (Ltot - 64 * c) : 64;
        float rv[8], kv[8];
#pragma unroll
        for (int a = 0; a < 5; ++a) {
            float pv[8], cv[8], nv[8], o[8]; unpack8(raw[a][0], pv); unpack8(raw[a][1], cv); unpack8(raw[a][2], nv);
            const f32x4 mp0 = *(const LAS f32x4*)(fMU + a * 64 + cg8), mp1 = *(const LAS f32x4*)(fMU + a * 64 + cg8 + 4), mn0 = *(const LAS f32x4*)(fMU + 320 + a * 64 + cg8), mn1 = *(const LAS f32x4*)(fMU + 320 + a * 64 + cg8 + 4);
#pragma unroll
            for (int e = 0; e < 8; ++e) { const float mp = e < 4 ? mp0[e & 3] : mp1[e & 3], mn = e < 4 ? mn0[e & 3] : mn1[e & 3]; o[e] = cv[e] + mp * (pv[e] - cv[e]) + mn * (nv[e] - cv[e]); }
            if (a == 0) {
#pragma unroll
                for (int e = 0; e < 8; ++e) rv[e] = o[e];
                LAS float* dst = fS + SCI(slot, 4, cg8); *(LAS f32x4*)dst = (f32x4){o[0], o[1], o[2], o[3]}; *(LAS f32x4*)(dst + 4) = (f32x4){o[4], o[5], o[6], o[7]};
            } else if (a == 1) {
#pragma unroll
                for (int e = 0; e < 8; ++e) kv[e] = o[e];
            } else if (a == 2) {
                LAS float* dst = fV + slot * 64 + cg8; *(LAS f32x4*)dst = (f32x4){o[0], o[1], o[2], o[3]}; *(LAS f32x4*)(dst + 4) = (f32x4){o[4], o[5], o[6], o[7]};
            } else {
                if (a == 3) {
#pragma unroll
                    for (int e = 0; e < 8; ++e) o[e] = fast_tanh(o[e]);
                }
                u32x4 w; w.x = cvtpk(o[0], o[1]); w.y = cvtpk(o[2], o[3]); w.z = cvtpk(o[4], o[5]); w.w = cvtpk(o[6], o[7]);
                *(LAS u32x4*)(lds + (a == 3 ? SC_TW : SC_AD) + slot * 144 + cg8 * 2) = w;
            }
        }
        BAR_LDS();
        if (c + 1 < nchunk) SC_LOAD(c + 1);
        {
            const LAS unsigned char* Ab = lds + (mat ? SC_AD : SC_TW); LAS float* fWB = fS + (mat ? 128 : 64);
#pragma unroll
            for (int mt = 0; mt < 4; ++mt) {
                const bf16x8 a0 = *(const LAS bf16x8*)(Ab + (mt * 16 + (lane & 15)) * 144 + (lane >> 4) * 16);
                const bf16x8 a1 = *(const LAS bf16x8*)(Ab + (mt * 16 + (lane & 15)) * 144 + 64 + (lane >> 4) * 16);
                f32x4 acc = {0.f, 0.f, 0.f, 0.f};
                acc = __builtin_amdgcn_mfma_f32_16x16x32_bf16(a0, bfr0, acc, 0, 0, 0);
                acc = __builtin_amdgcn_mfma_f32_16x16x32_bf16(a1, bfr1, acc, 0, 0, 0);
#pragma unroll
                for (int rg = 0; rg < 4; ++rg) {
                    const int sl = mt * 16 + (lane >> 4) * 4 + rg, col = ntile * 16 + (lane & 15);
                    const float sg = fast_sigmoid(acc[rg] + bias); const float dc = __builtin_amdgcn_exp2f(-0.6065306597126334f * LOG2E * sg);
                    fWB[sl * 320 + col] = mat ? sg : dc;
                }
            }
        }
        BAR_LDS();
        {
            const f32x4 a0 = *(const LAS f32x4*)(fS + SCI(slot, 2, cg8)), a1 = *(const LAS f32x4*)(fS + SCI(slot, 2, cg8 + 4));
            const f32x4 kk0 = *(const LAS f32x4*)(fMU + 640 + cg8), kk1 = *(const LAS f32x4*)(fMU + 640 + cg8 + 4), ka0 = *(const LAS f32x4*)(fMU + 704 + cg8), ka1 = *(const LAS f32x4*)(fMU + 704 + cg8 + 4);
            const f32x4 rk0 = *(const LAS f32x4*)(fMU + 768 + cg8), rk1 = *(const LAS f32x4*)(fMU + 768 + cg8 + 4);
            float kkv[8], kd[8], av[8]; float ssq = 0.f, cs = 0.f;
#pragma unroll
            for (int e = 0; e < 8; ++e) {
                av[e] = e < 4 ? a0[e & 3] : a1[e & 3];
                kkv[e] = kv[e] * (e < 4 ? kk0[e & 3] : kk1[e & 3]); ssq = fmaf(kkv[e], kkv[e], ssq);
                kd[e] = kv[e] * (1.0f + (av[e] - 1.0f) * (e < 4 ? ka0[e & 3] : ka1[e & 3])); cs = fmaf(rv[e] * kd[e], e < 4 ? rk0[e & 3] : rk1[e & 3], cs);
            }
            ssq = grp_sum<8>(ssq); cs = grp_sum<8>(cs);
            const float rs = rsqrtf(fmaxf(ssq, 1e-24f));
#pragma unroll
            for (int e = 0; e < 8; ++e) { kkv[e] *= rs; av[e] *= kkv[e]; }
            LAS float* o1 = fS + SCI(slot, 0, cg8); *(LAS f32x4*)o1 = (f32x4){kkv[0], kkv[1], kkv[2], kkv[3]}; *(LAS f32x4*)(o1 + 4) = (f32x4){kkv[4], kkv[5], kkv[6], kkv[7]};
            LAS float* o2 = fS + SCI(slot, 2, cg8); *(LAS f32x4*)o2 = (f32x4){av[0], av[1], av[2], av[3]}; *(LAS f32x4*)(o2 + 4) = (f32x4){av[4], av[5], av[6], av[7]};
            LAS float* o3 = fS + SCI(slot, 3, cg8); *(LAS f32x4*)o3 = (f32x4){kd[0], kd[1], kd[2], kd[3]}; *(LAS f32x4*)(o3 + 4) = (f32x4){kd[4], kd[5], kd[6], kd[7]};
            if (cg8 == 0 && rp == 0 && slot < nvalid) { const int i2 = 64 * c + slot; const int p2 = d ? Ltot - 1 - i2 : i2; CB[((size_t)d * ROWS + pos_row(base, p2)) * 8 + h] = cs; }
        }
        BAR_LDS();
        if (wid < NSW) {
            typedef float f32x2_ __attribute__((ext_vector_type(2)));
            constexpr int C4 = CPL / 4;
            const LAS float* ps = fS + kg * CPL; const LAS float* pv = fV + srow; LAS float* py = fY + srow;
            f32x4 nk[C4], nw[C4], nb[C4], nd[C4], nr[C4]; float nv;
#define SC_FETCH(sl_) do { _Pragma("unroll") for (int j_ = 0; j_ < C4; ++j_) { nk[j_] = *(const LAS f32x4*)(ps + (sl_) * 320 + 4 * j_); nw[j_] = *(const LAS f32x4*)(ps + (sl_) * 320 + 64 + 4 * j_); \
                nb[j_] = *(const LAS f32x4*)(ps + (sl_) * 320 + 128 + 4 * j_); nd[j_] = *(const LAS f32x4*)(ps + (sl_) * 320 + 192 + 4 * j_); nr[j_] = *(const LAS f32x4*)(ps + (sl_) * 320 + 256 + 4 * j_); } nv = pv[(sl_) * 64]; } while (0)
            SC_FETCH(0);
            f32x4 rp4[C4];
#pragma unroll
            for (int j = 0; j < C4; ++j) rp4[j] = (f32x4){0.f, 0.f, 0.f, 0.f};
#pragma unroll 8
            for (int sl = 0; sl < nvalid; ++sl) {
                f32x4 ck[C4], cw[C4], cb[C4], cd[C4], cr[C4];
#pragma unroll
                for (int j = 0; j < C4; ++j) { ck[j] = nk[j]; cw[j] = nw[j]; cb[j] = nb[j]; cd[j] = nd[j]; cr[j] = nr[j]; }
                const float vv = nv;
                SC_FETCH(sl + 1 < 64 ? sl + 1 : 63);
                f32x2_ pa = {0.f, 0.f}, ya = {0.f, 0.f};
#pragma unroll
                for (int j = 0; j < C4; ++j)
#pragma unroll
                    for (int e = 0; e < 4; e += 2) { const f32x2_ s2 = {S[4 * j + e], S[4 * j + e + 1]}, k2 = {ck[j][e], ck[j][e + 1]}, r2 = {rp4[j][e], rp4[j][e + 1]}; pa = pa + s2 * k2; ya = ya + s2 * r2; }
                float pp = pa.x + pa.y, yy = ya.x + ya.y;
                pp = dpp_add(pp, 0); yy = dpp_add(yy, 0); pp = dpp_add(pp, 1); yy = dpp_add(yy, 1); pp = dpp_add(pp, 2); yy = dpp_add(yy, 2);
                if (LPR == 16) { pp = dpp_add(pp, 3); yy = dpp_add(yy, 3); }
                py[(sl > 0 ? sl - 1 : 0) * 64] = yy;
#pragma unroll
                for (int j = 0; j < C4; ++j)
#pragma unroll
                    for (int e = 0; e < 4; e += 2) {
                        const f32x2_ b2 = {cb[j][e], cb[j][e + 1]}, d2 = {cd[j][e], cd[j][e + 1]}, w2 = {cw[j][e], cw[j][e + 1]}; f32x2_ s2 = {S[4 * j + e], S[4 * j + e + 1]};
                        const f32x2_ t2 = d2 * vv - b2 * pp; s2 = s2 * w2 + t2; S[4 * j + e] = s2.x; S[4 * j + e + 1] = s2.y; }
#pragma unroll
                for (int j = 0; j < C4; ++j) rp4[j] = cr[j];
            }
            {
                f32x2_ ya = {0.f, 0.f};
#pragma unroll
                for (int j = 0; j < C4; ++j)
#pragma unroll
                    for (int e = 0; e < 4; e += 2) { const f32x2_ s2 = {S[4 * j + e], S[4 * j + e + 1]}, r2 = {rp4[j][e], rp4[j][e + 1]}; ya = ya + s2 * r2; }
                const float yy = grp_sum<LPR>(ya.x + ya.y);
                py[(nvalid - 1) * 64] = yy;
            }
#undef SC_FETCH
        }
        BAR_LDS();
        {
            const int i2 = 64 * c + slot; const int p2 = d ? Ltot - 1 - i2 : i2;
            if (slot < nvalid && p2 >= 16 && (cg8 / RPB) == rp) {
                const LAS float* yp = fY + slot * 64 + cg8; const f32x4 y0 = *(const LAS f32x4*)yp, y1 = *(const LAS f32x4*)(yp + 4);
                *(u32x4*)(YD + (size_t)(base + p2 - 16) * 512 + h * 64 + cg8) = pack8(y0, y1);
            }
        }
    }
#undef SC_LOAD
#undef SCI
}

__device__ __forceinline__ void phase_post(LAS unsigned char* lds, KP P) {
    const int tid = fresh_tid(), lane = tid & 63, wid = tid >> 6;
    unsigned char* ws = P->ws;
    const bf16* VAb = (const bf16*)(ws + WS_VA); const bf16* Lb = (const bf16*)(ws + WS_L); bf16* Rb = (bf16*)(ws + WS_R);
    const float* CB = (const float*)(ws + WS_CB); const bf16* YD0 = (const bf16*)((const unsigned char*)P->out + 64 * MiB); const bf16* YD1 = YD0 + (size_t)NMAIN * 512;
    const bf16* GT = (const bf16*)(ws + WS_LORA + 262144);
    LAS float* st = (LAS float*)(lds + 17408);
    const float* mup = P->in[I_MUP]; const float* mun = P->in[I_MUN];
    for (int tile = blockIdx.x; tile < NMAIN / 64; tile += gridDim.x) {
        {
            const int row = tid >> 3, hh = tid & 7, m = tile * 64 + row;
            const int t = m < 16384 ? m : (m - 16384) & 2047, Ls = m < 16384 ? 16384 : 2048;
            float sum = 0.f, sq = 0.f;
#pragma unroll
            for (int i = 0; i < 8; ++i) { float a[8], b[8]; unpack8(*(const u32x4*)(YD0 + (size_t)m * 512 + hh * 64 + i * 8), a); unpack8(*(const u32x4*)(YD1 + (size_t)m * 512 + hh * 64 + i * 8), b);
#pragma unroll
                for (int e = 0; e < 8; ++e) { const float y = a[e] + b[e]; sum += y; sq += y * y; } }
            const float mu = sum * (1.0f / 64.0f); const float var = fmaxf(sq * (1.0f / 64.0f) - mu * mu, 0.f);
            st[(row * 8 + hh) * 2] = mu; st[(row * 8 + hh) * 2 + 1] = rsqrtf(var + 64e-5f);
            const size_t rp_ = t == 0 ? (size_t)(METAROW + 15) : (size_t)(m - 1); const bool okn = t + 1 < Ls;
#pragma unroll
            for (int i = 0; i < 2; ++i) {
                const int c0 = 128 + hh * 16 + i * 8; float pv[8], cv[8], nv[8], o[8];
                unpack8(*(const u32x4*)(Lb + rp_ * 256 + c0), pv); unpack8(*(const u32x4*)(Lb + (size_t)m * 256 + c0), cv);
                if (okn) unpack8(*(const u32x4*)(Lb + (size_t)(m + 1) * 256 + c0), nv); else {
#pragma unroll
                    for (int e = 0; e < 8; ++e) nv[e] = 0.f; }
#pragma unroll
                for (int e = 0; e < 8; ++e) { const float mp = mup[1536 + c0 + e], mn = mun[1536 + c0 + e]; o[e] = sigmoidf_(cv[e] + mp * (pv[e] - cv[e]) + mn * (nv[e] - cv[e])); }
                u32x4 w; w.x = cvtpk(o[0], o[1]); w.y = cvtpk(o[2], o[3]); w.z = cvtpk(o[4], o[5]); w.w = cvtpk(o[6], o[7]);
                *(LAS u32x4*)(lds + row * 272 + (hh * 16 + i * 8) * 2) = w;
            }
        }
        __syncthreads();
#pragma unroll 1
        for (int nt = 0; nt < 4; ++nt) {
            const int col = wid * 64 + nt * 16 + (lane & 15);
            bf16x8 bfr[4];
#pragma unroll
            for (int ks = 0; ks < 4; ++ks) bfr[ks] = *(const bf16x8*)(GT + (size_t)col * 128 + ks * 32 + (lane >> 4) * 8);
            const float lw = P->in[I_LNW][col], lb = P->in[I_LNB][col];
            const float mpv = mup[1024 + col], mnv = mun[1024 + col];
#pragma unroll 1
            for (int mt = 0; mt < 4; ++mt) {
                f32x4 acc = {0.f, 0.f, 0.f, 0.f};
#pragma unroll
                for (int ks = 0; ks < 4; ++ks) { const bf16x8 a = *(const LAS bf16x8*)(lds + (mt * 16 + (lane & 15)) * 272 + ks * 64 + (lane >> 4) * 16); acc = __builtin_amdgcn_mfma_f32_16x16x32_bf16(a, bfr[ks], acc, 0, 0, 0); }
#pragma unroll
                for (int rg = 0; rg < 4; ++rg) {
                    const int row = mt * 16 + (lane >> 4) * 4 + rg, m = tile * 64 + row;
                    const int t = m < 16384 ? m : (m - 16384) & 2047, Ls = m < 16384 ? 16384 : 2048;
                    const float y = bf2f(YD0[(size_t)m * 512 + col]) + bf2f(YD1[(size_t)m * 512 + col]);
                    const float yn = (y - st[(row * 8 + wid) * 2]) * st[(row * 8 + wid) * 2 + 1] * lw + lb;
                    const float vc = bf2f(VAb[(size_t)m * 512 + col]);
                    const float vp = bf2f(VAb[(t == 0 ? (size_t)(METAROW + 15) : (size_t)(m - 1)) * 512 + col]);
                    const float vn = t + 1 < Ls ? bf2f(VAb[(size_t)(m + 1) * 512 + col]) : 0.f;
                    const float vs = vc + mpv * (vp - vc) + mnv * (vn - vc);
                    const float cb = CB[(size_t)m * 8 + wid] + CB[((size_t)ROWS + m) * 8 + wid];
                    Rb[(size_t)m * 512 + col] = (bf16)f2bf_rne((yn + cb * vs) * acc[rg]);
                }
            }
        }
        __syncthreads();
    }
}

__device__ __forceinline__ void phase_rms_bf16(KP P) {
    const int tid = fresh_tid(), lane = tid & 63, wid = tid >> 6; const int gw = blockIdx.x * 8 + wid, NGW = gridDim.x * 8;
    bf16* MN = (bf16*)(P->ws + WS_MN);
    for (int m = gw; m < NMAIN; m += NGW) rms_row_bf16(P->out + (size_t)m * DM, P->in[I_GFFN], MN + (size_t)m * DM, lane);
}
__device__ __forceinline__ void phase_final(KP P) {
    const int tid = fresh_tid(), lane = tid & 63, wid = tid >> 6; const int gw = blockIdx.x * 8 + wid, NGW = gridDim.x * 8;
    const f32x4* gr = (const f32x4*)P->in[I_GFIN] + lane;
    for (int m = gw; m < NMAIN; m += NGW) {
        f32x4* xr = (f32x4*)(P->out + (size_t)m * DM) + lane; f32x4 v[4]; float s = 0.f;
#pragma unroll
        for (int j = 0; j < 4; ++j) { v[j] = xr[64 * j]; s += (v[j].x * v[j].x + v[j].y * v[j].y) + (v[j].z * v[j].z + v[j].w * v[j].w); }
        const float rstd = rsqrtf(wave_sum(s) * (1.f / DM) + 1e-6f);
#pragma unroll
        for (int j = 0; j < 4; ++j) xr[64 * j] = v[j] * rstd * gr[64 * j];
    }
}

constexpr int NRP_LONG = 4;
constexpr int N_LONG = 16 * NRP_LONG, N_ATT_P = 512, N_ATT_S = 512, N_SHORT = 128, N_ITEMS = N_LONG + N_ATT_P + N_ATT_S + N_SHORT;

template <class Op> __device__ __forceinline__ void run_gemm(LAS unsigned char* lds, const bf16* A, const bf16* Bt, int M, int N, int K, const Op& op, const bf16* A2 = nullptr, int pm2 = 1 << 30) {
    pg8::Gemm g{A, Bt, M, N, K, A2, pm2}; pg8::StaticOrder S; S.init(M, N, (int)gridDim.x, (int)blockIdx.x);
    Epi8<Op> E{op};
    pg8::gemm_phase<Epi8<Op>, pg8::StaticOrder, true, true>(lds, g, S, E);
}

constexpr size_t WS_XBAR = 16384;
#define XB_TMO      128
#define XB_XCNT(j)  (256  + 64 * (j))
#define XB_XSUB(j)  (1280 + 64 * (j))
#define XB_XGEN(j)  (2304 + 64 * (j))
#define XB_TOP      3328
#define XB_TOPGEN   3392
#define XCD_BAR_WORDS 3456
#define XB_SPIN_CAP (1u << 18)
__device__ __forceinline__ unsigned xb_ld(unsigned* p)              { return __hip_atomic_load(p, __ATOMIC_RELAXED, __HIP_MEMORY_SCOPE_AGENT); }
__device__ __forceinline__ unsigned xb_add(unsigned* p, unsigned v) { return __hip_atomic_fetch_add(p, v, __ATOMIC_RELAXED, __HIP_MEMORY_SCOPE_AGENT); }
__device__ __forceinline__ unsigned xb_xcc_id() { return (unsigned)__builtin_amdgcn_s_getreg((3 << 11) | 20) & 0xFu; }
#define XB_SPIN(cond, bar) do { unsigned _sp = 0; while (cond) { __builtin_amdgcn_s_sleep(1); \
    if ((++_sp & 255u) == 0u) { if (xb_ld(&(bar)[XB_TMO])) break; if (_sp > XB_SPIN_CAP) { atomicAdd(&(bar)[XB_TMO], 1u); break; } } } } while (0)
struct XcdBarrier { unsigned* bar; unsigned x; volatile LAS unsigned* st; };
__device__ __forceinline__ XcdBarrier xcd_barrier_post(unsigned* bar, volatile LAS unsigned* st) {
    XcdBarrier b; b.bar = bar; b.x = xb_xcc_id(); b.st = st;
    if (threadIdx.x == 0) (void)xb_add(&bar[XB_XCNT(b.x)], 1u);
    return b;
}
__device__ __forceinline__ void xcd_barrier_complete(unsigned* bar, unsigned x, unsigned& nloc, unsigned& nx) {
    const unsigned G = gridDim.x * gridDim.y * gridDim.z;
    unsigned sum, cnt, mine, sp = 0u;
    for (;;) {
        sum = 0u; cnt = 0u; mine = 0u;
#pragma unroll
        for (unsigned j = 0; j < 16; ++j) { const unsigned c = xb_ld(&bar[XB_XCNT(j)]); sum += c; cnt += (c > 0u) ? 1u : 0u; mine = (j == x) ? c : mine; }
        if (sum == G) break;
        __builtin_amdgcn_s_sleep(1);
        if ((++sp & 255u) == 0u) { if (xb_ld(&bar[XB_TMO])) break; if (sp > XB_SPIN_CAP) { atomicAdd(&bar[XB_TMO], 1u); break; } }
    }
    nloc = mine > 0u ? mine : 1u; nx = cnt > 0u ? cnt : 1u;
}
__device__ __forceinline__ void xcd_barrier(const XcdBarrier& b) {
    asm volatile("s_waitcnt vmcnt(0)" ::: "memory");
    __syncthreads();
    if (threadIdx.x == 0) {
        unsigned* bar = b.bar;
        __builtin_amdgcn_s_waitcnt(0);
        unsigned nloc = b.st[0], nx = b.st[1];
        if (nloc == 0u) { xcd_barrier_complete(bar, b.x, nloc, nx); b.st[0] = nloc; b.st[1] = nx; }
        const unsigned old = xb_add(&bar[XB_XSUB(b.x)], 1u);
        const unsigned gen = old / nloc;
        if (old + 1u == (gen + 1u) * nloc) {
            __builtin_amdgcn_fence(__ATOMIC_RELEASE, "agent");
            asm volatile("s_waitcnt vmcnt(0)" ::: "memory");
            const unsigned og = xb_add(&bar[XB_TOP], 1u);
            const unsigned tg = og / nx;
            if (og + 1u == (tg + 1u) * nx) xb_add(&bar[XB_TOPGEN], 1u);
            else XB_SPIN(xb_ld(&bar[XB_TOPGEN]) == tg, bar);
            __builtin_amdgcn_fence(__ATOMIC_ACQUIRE, "agent");
            xb_add(&bar[XB_XGEN(b.x)], 1u);
            asm volatile("s_waitcnt vmcnt(0)" ::: "memory");
        } else {
            XB_SPIN(xb_ld(&bar[XB_XGEN(b.x)]) == gen, bar);
            __builtin_amdgcn_fence(__ATOMIC_ACQUIRE, "agent");
            asm volatile("s_waitcnt vmcnt(0)" ::: "memory");
        }
    }
    __syncthreads();
}
#ifndef PROBE_MASK
#define PROBE_MASK 0
#endif
#ifndef PROBE_MUL
#define PROBE_MUL 1
#endif
#define PH_BEGIN(k) unsigned long long t0_##k = 0; if (PROBE_MASK & (1 << (k))) t0_##k = __builtin_amdgcn_s_memrealtime();
#define PH_END(k) if (PROBE_MASK & (1 << (k))) { const unsigned long long t1_ = __builtin_amdgcn_s_memrealtime(); const unsigned long long dt_ = (t1_ - t0_##k) * PROBE_MUL; while (__builtin_amdgcn_s_memrealtime() - t1_ < dt_) __builtin_amdgcn_s_sleep(8); xcd_barrier(xbar); }
__global__ void __launch_bounds__(NTHREADS) fwd_megakernel(Params Pin) {
    extern __shared__ __attribute__((aligned(16))) unsigned char lds_raw[];
    LAS unsigned char* lds = (LAS unsigned char*)lds_raw;
    cg::grid_group grid = cg::this_grid();
    KP P0 = (KP)__builtin_amdgcn_kernarg_segment_ptr();
    volatile LAS unsigned* xst = (volatile LAS unsigned*)(lds + LDS_ITEM_OFF + 4);
    if (threadIdx.x == 0) { xst[0] = 0u; xst[1] = 0u; }
    __syncthreads();
    const XcdBarrier xbar = xcd_barrier_post((unsigned*)(P0->ws + WS_XBAR), xst);
#define NEWPHASE KP P = P0; asm volatile("" : "+s"(P)); unsigned char* ws = P->ws; (void)ws;

    PH_BEGIN(0)
    { NEWPHASE phase_prologue(lds, P); }
    grid.sync();
    PH_END(0)
    PH_BEGIN(1)
    { NEWPHASE run_gemm(lds, (const bf16*)P->out, (const bf16*)(ws + WS_WIN), ROWS, 3328, 1024, OpProj{ws}, (const bf16*)(ws + WS_XNMETA), 128); }
    xcd_barrier(xbar);
    PH_END(1)
    PH_BEGIN(2)
    { NEWPHASE
        const int tid = fresh_tid();
        float lam;
        { const int lane = tid & 63; const float s1 = wave_sum(P->in[I_LQ1][lane] * P->in[I_LK1][lane]), s2 = wave_sum(P->in[I_LQ2][lane] * P->in[I_LK2][lane]); lam = __expf(s1) - __expf(s2) + 0.2f; }
        unsigned* ctr = (unsigned*)(ws + WS_CTL);
        LAS unsigned* slot = (LAS unsigned*)(lds + LDS_ITEM_OFF);
#define FETCH(k, n) if (tid == 0) *slot = atomicAdd(ctr + 64 * (k), 1u); __syncthreads(); const int idx = (int)*slot; __syncthreads(); if (idx >= (n)) break;
#ifndef NO_SCAN
#pragma unroll 1
        for (;;) { FETCH(0, N_LONG) const int u = idx / NRP_LONG; scan_unit<NRP_LONG, 4>(lds, P, 0, u >> 3, u & 7, idx % NRP_LONG); }
#endif
#ifndef NO_ATTN
#pragma unroll 1
        for (;;) { FETCH(1, N_ATT_P + N_ATT_S)
            if (idx < N_ATT_P) attn_unit(lds, P, 0, idx >> 7, idx & 127, lam);
            else { const int a = idx - N_ATT_P; attn_unit(lds, P, 1 + (a >> 6), (a >> 4) & 3, a & 15, lam); } }
#endif
#ifndef NO_SCAN
#pragma unroll 1
        for (;;) { FETCH(2, N_SHORT) scan_unit<1, 8>(lds, P, 1 + (idx >> 4), (idx >> 3) & 1, idx & 7, 0); }
#endif
#undef FETCH
    }
    xcd_barrier(xbar);
    PH_END(2)
#ifndef NO_POST
    PH_BEGIN(3)
    { NEWPHASE phase_post(lds, P); }
#endif
    xcd_barrier(xbar);
    PH_END(3)
    PH_BEGIN(4)
    { NEWPHASE run_gemm(lds, (const bf16*)P->out, (const bf16*)(ws + WS_WIN) + (size_t)3328 * 1024, NMAIN, 2048, 1024, OpGate{ws}); }
    xcd_barrier(xbar);
    PH_END(4)
    PH_BEGIN(5)
    { NEWPHASE run_gemm(lds, (const bf16*)(ws + WS_R), (const bf16*)(ws + WS_WUPA), NMAIN, 1024, 512, OpUpA{ws}); }
    PH_END(5)
    PH_BEGIN(6)
    { NEWPHASE run_gemm(lds, (const bf16*)(ws + WS_Q), (const bf16*)(ws + WS_WUPB), NMAIN, 1024, 512, OpUpB{ws}); }
    xcd_barrier(xbar);
    PH_END(6)
    PH_BEGIN(7)
    { NEWPHASE run_gemm(lds, (const bf16*)(ws + WS_GB), (const bf16*)(ws + WS_WOUT), NMAIN, 1024, 1024, OpOut{P->in[I_XP], P->in[I_XS], P->out}); }
    xcd_barrier(xbar);
    PH_END(7)
    PH_BEGIN(8)
    { NEWPHASE phase_rms_bf16(P); }
    xcd_barrier(xbar);
    PH_END(8)
    PH_BEGIN(9)
    { NEWPHASE run_gemm(lds, (const bf16*)(ws + WS_MN), (const bf16*)(ws + WS_WFF1), 16384, DFF, 1024, OpFF1{(bf16*)(ws + WS_HID)}); }
    xcd_barrier(xbar);
    PH_END(9)
    PH_BEGIN(10)
    { NEWPHASE run_gemm(lds, (const bf16*)(ws + WS_HID), (const bf16*)(ws + WS_WFF2), 16384, 1024, DFF, OpFF2{P->out}); }
    xcd_barrier(xbar);
    PH_END(10)
    PH_BEGIN(11)
    { NEWPHASE run_gemm(lds, (const bf16*)(ws + WS_MN) + (size_t)16384 * DM, (const bf16*)(ws + WS_WFF1), 16384, DFF, 1024, OpFF1{(bf16*)(ws + WS_HID)}); }
    xcd_barrier(xbar);
    PH_END(11)
    PH_BEGIN(12)
    { NEWPHASE run_gemm(lds, (const bf16*)(ws + WS_HID), (const bf16*)(ws + WS_WFF2), 16384, 1024, DFF, OpFF2{P->out + (size_t)16384 * DM}); }
    xcd_barrier(xbar);
    PH_END(12)
    PH_BEGIN(13)
    { NEWPHASE phase_final(P); }
}

extern "C" void kernel_launch(void* const* d_in, const int* in_sizes, int n_in, void* d_out, int out_size, void* d_ws, size_t ws_size, hipStream_t stream) {
    static int grid_blocks = 0;
    if (grid_blocks == 0) {
        int dev = 0, cus = 0, per_cu = 0;
        hipGetDevice(&dev);
        hipDeviceGetAttribute(&cus, hipDeviceAttributeMultiprocessorCount, dev);
        hipFuncSetAttribute((const void*)fwd_megakernel, hipFuncAttributeMaxDynamicSharedMemorySize, LDS_BYTES);
        hipOccupancyMaxActiveBlocksPerMultiprocessor(&per_cu, (const void*)fwd_megakernel, NTHREADS, LDS_BYTES);
        if (per_cu < 1) { fprintf(stderr, "kernel_launch: occupancy query says %d blocks per CU\n", per_cu); per_cu = 1; }
        grid_blocks = cus * per_cu;
        if (n_in != 29 || ws_size < WS_END) fprintf(stderr, "kernel_launch: unexpected n_in %d / ws_size %zu\n", n_in, ws_size);
    }
    hipMemsetAsync((unsigned char*)d_ws + WS_CTL, 0, 32768, stream);
    Params p{};
    for (int i = 0; i < 29; ++i) p.in[i] = (const float*)d_in[i];
    p.out = (float*)d_out; p.ws = (unsigned char*)d_ws;
    void* args[] = {&p};
    hipError_t e = hipLaunchCooperativeKernel((const void*)fwd_megakernel, dim3(grid_blocks), dim3(NTHREADS), args, LDS_BYTES, stream);
    if (e != hipSuccess) fprintf(stderr, "cooperative launch failed: %s (grid %d)\n", hipGetErrorString(e), grid_blocks);
}
```

```cpp
#include <hip/hip_runtime.h>
#include <hip/hip_cooperative_groups.h>
#include <cstdio>
#include <cstdint>
#include <cmath>
namespace cg = cooperative_groups;
__device__ __forceinline__ int fresh_tid() { int t = threadIdx.x; asm volatile("" : "+v"(t)); return t; }
namespace pg8 {
#define PG8_LAS __attribute__((address_space(3)))
typedef unsigned short bf16_t;
typedef short bf16x8 __attribute__((ext_vector_type(8)));
typedef float f32x4 __attribute__((ext_vector_type(4)));
typedef unsigned u32x4 __attribute__((ext_vector_type(4)));
constexpr int BM = 256, BK = 64, HALF = 128, HTB = HALF * BK * 2  , STAGE_BYTES = 8 * HTB, NXCD = 8, WGM = 8;

__host__ __device__ __forceinline__ int lds_byte(int r, int c) { const int st = (r >> 4) * 2 + (c >> 5), rr = r & 15, cc = c & 31, ob = rr * 64 + cc * 2; return st * 1024 + (ob ^ (((ob >> 9) & 1) << 5)); }
__host__ __device__ __forceinline__ void stage_rc(int b, int& R, int& C) { const int st = b / 1024, sb = b % 1024, swz = sb ^ (((sb >> 9) & 1) << 5); R = (st >> 1) * 16 + swz / 64; C = (st & 1) * 32 + (swz % 64) / 2; }
__host__ __device__ __forceinline__ int perm32(int rho) { const int n = rho >> 4, i = rho & 15; return 8 * (i >> 2) + 4 * n + (i & 3); }

struct Unit { int pm, pn; };
struct Gemm { const bf16_t* A; const bf16_t* Bt; int M, N, K; const bf16_t* A2; int pm2; };
__device__ __forceinline__ const char* gemm_abase(const Gemm& g, int pm, size_t tstep) { return pm >= g.pm2 ? (const char*)g.A2 + (size_t)(pm - g.pm2) * tstep : (const char*)g.A + (size_t)pm * tstep; }

struct StaticOrder {
    int nM, nN, nwg, G, c;
    __host__ __device__ void init(int M, int N, int G_, int c_) { nM = M / BM; nN = N / BM; nwg = nM * nN; G = G_; c = c_; }
    __host__ __device__ bool next(int i, Unit& u) const {
        const long L = (long)i * G + c; if (L >= nwg) return false;
        int wgid = (int)L; { const int q = nwg / NXCD, r = nwg % NXCD, xcd = wgid % NXCD, off = wgid / NXCD; wgid = (xcd < r ? xcd * (q + 1) : r * (q + 1) + (xcd - r) * q) + off; }
        const int nig = WGM * nN, gid = wgid / nig, fm = gid * WGM, gsz = (nM - fm) < WGM ? (nM - fm) : WGM;
        u.pm = fm + ((wgid % nig) % gsz); u.pn = (wgid % nig) / gsz; return true;
    }
    __device__ __forceinline__ void a_ready(const Unit&) const {}
    __device__ __forceinline__ void done(const Unit&) const {}
};


template <class Epi, class Sched, bool ALIGN_EPI = false, bool SP2 = false>
__device__ __forceinline__ void gemm_phase(PG8_LAS unsigned char* lds, const Gemm g, const Sched& S, const Epi& E) {
    const int tid = fresh_tid(), wid = __builtin_amdgcn_readfirstlane(tid >> 6), lane = tid & 63, wr = wid >> 2, wc = wid & 3, fr = lane & 15, fq = lane >> 4;
    const int K = g.K, nt = K / BK;
    unsigned voffA[2], voffB[2];
#pragma unroll
    for (int i = 0; i < 2; ++i) { int R, C; stage_rc(tid * 16 + i * 8192, R, C); const int Rb = Epi::PERM ? ((R & ~31) + perm32(R & 31)) : R;
        voffA[i] = (unsigned)(R * K + C) * 2u; voffB[i] = (unsigned)(Rb * K + C) * 2u; }
    const size_t kstep = (size_t)(BK * 2);
    const size_t hstep = (size_t)HALF * K * 2;
    const size_t tstep = 2 * hstep;
    const unsigned ldsw = (unsigned)wid * 1024u;
    const int aoff = lds_byte(wr * 64 + fr, fq * 8), boff = lds_byte(wc * 32 + fr, fq * 8);
#define PG8_SA(b, h) (((b) * 2 + (h)) * HTB)
#define PG8_SB(b, h) ((4 + (b) * 2 + (h)) * HTB)
#define PG8_STAGE(bufoff, gbase, voff) do { _Pragma("unroll") for (int _i = 0; _i < 2; ++_i) \
        __builtin_amdgcn_global_load_lds((const unsigned*)((const char*)(gbase) + (voff)[_i]), (PG8_LAS unsigned*)(lds + (bufoff) + ldsw + _i * 8192), 16, 0, 0); } while (0)
#define PG8_LDA(dst, b, h) do { _Pragma("unroll") for (int m = 0; m < 4; ++m) _Pragma("unroll") for (int k = 0; k < 2; ++k) dst[m][k] = *(const PG8_LAS bf16x8*)(lds + PG8_SA(b, h) + aoff + m * 2048 + k * 1024); } while (0)
#define PG8_LDB(dst, b, h) do { _Pragma("unroll") for (int n = 0; n < 2; ++n) _Pragma("unroll") for (int k = 0; k < 2; ++k) dst[n][k] = *(const PG8_LAS bf16x8*)(lds + PG8_SB(b, h) + boff + n * 2048 + k * 1024); } while (0)
#define PG8_MMA(ai, bj, At, Bt) do { __builtin_amdgcn_s_setprio(1); _Pragma("unroll") for (int m = 0; m < 4; ++m) _Pragma("unroll") for (int n = 0; n < 2; ++n) _Pragma("unroll") for (int k = 0; k < 2; ++k) \
        acc[ai][bj][m][n] = __builtin_amdgcn_mfma_f32_16x16x32_bf16(Bt[n][k], At[m][k], acc[ai][bj][m][n], 0, 0, 0); __builtin_amdgcn_s_setprio(0); } while (0)
#define PG8_WAIT_V(n) asm volatile("s_waitcnt vmcnt(" #n ")" ::: "memory")
#define PG8_WAIT_L(n) asm volatile("s_waitcnt lgkmcnt(" #n ")" ::: "memory")
#define PG8_BAR __builtin_amdgcn_s_barrier()
#define PG8_SCHED __builtin_amdgcn_sched_barrier(0)
    Unit cur, nxt; int ui = 0;
    if (!S.next(0, cur)) return;
    f32x4 acc[2][2][4][2];
#pragma unroll
    for (int a = 0; a < 2; ++a)
#pragma unroll
        for (int b = 0; b < 2; ++b)
#pragma unroll
            for (int m = 0; m < 4; ++m)
#pragma unroll
                for (int n = 0; n < 2; ++n) acc[a][b][m][n] = (f32x4){0.f, 0.f, 0.f, 0.f};
    bf16x8 At[4][2], B0[2][2], B1[2][2];
    const char* cA = gemm_abase(g, cur.pm, tstep); const char* cB = (const char*)g.Bt + (size_t)cur.pn * tstep;
    S.a_ready(cur);
    if constexpr (SP2) {
        PG8_STAGE(PG8_SB(0, 0), cB, voffB); PG8_STAGE(PG8_SB(0, 1), cB + hstep, voffB); PG8_STAGE(PG8_SA(0, 0), cA, voffA); PG8_STAGE(PG8_SA(0, 1), cA + hstep, voffA);
        if (wr == 1) PG8_BAR;
        PG8_WAIT_V(2); PG8_BAR;
        PG8_STAGE(PG8_SB(1, 0), cB + kstep, voffB); PG8_STAGE(PG8_SA(1, 0), cA + kstep, voffA); PG8_STAGE(PG8_SB(1, 1), cB + hstep + kstep, voffB);
        PG8_WAIT_V(6); PG8_BAR;
    } else {
        PG8_STAGE(PG8_SB(0, 0), cB, voffB); PG8_STAGE(PG8_SA(0, 0), cA, voffA); PG8_STAGE(PG8_SB(0, 1), cB + hstep, voffB); PG8_STAGE(PG8_SA(0, 1), cA + hstep, voffA);
        if (wr == 1) PG8_BAR;
        PG8_WAIT_V(4); PG8_BAR;
        PG8_STAGE(PG8_SB(1, 0), cB + kstep, voffB); PG8_STAGE(PG8_SA(1, 0), cA + kstep, voffA); PG8_STAGE(PG8_SB(1, 1), cB + hstep + kstep, voffB);
        PG8_WAIT_V(6); PG8_BAR;
    }
    for (;;) {
        const bool has_next = S.next(ui + 1, nxt);
        const char* nA = has_next ? gemm_abase(g, nxt.pm, tstep) : cA; const char* nB = has_next ? (const char*)g.Bt + (size_t)nxt.pn * tstep : cB;
        for (int t = 0; t < nt; t += 2) {
            const bool last = (t == nt - 2);
            const char* a1 = cA + (size_t)(t + 1) * kstep;
            const char* a2 = last ? nA : cA + (size_t)(t + 2) * kstep; const char* b2 = last ? nB : cB + (size_t)(t + 2) * kstep;
            const char* a3 = a2 + kstep; const char* b3 = b2 + kstep;
            if (last && has_next) S.a_ready(nxt);
            if constexpr (SP2) {
            PG8_LDB(B0, 0, 0); PG8_LDB(B1, 0, 1); PG8_SCHED; PG8_LDA(At, 0, 0); PG8_STAGE(PG8_SA(1, 1), a1 + hstep, voffA);
            PG8_WAIT_V(8); PG8_WAIT_L(0); PG8_BAR; PG8_MMA(0, 0, At, B0); PG8_MMA(0, 1, At, B1); PG8_BAR; PG8_SCHED;
            PG8_LDA(At, 0, 1); PG8_STAGE(PG8_SB(0, 0), b2, voffB); PG8_STAGE(PG8_SB(0, 1), b2 + hstep, voffB); PG8_STAGE(PG8_SA(0, 0), a2, voffA);
            PG8_WAIT_V(8); PG8_WAIT_L(0); PG8_BAR; PG8_MMA(1, 0, At, B0); PG8_MMA(1, 1, At, B1); PG8_BAR; PG8_SCHED;
            PG8_LDB(B0, 1, 0); PG8_LDB(B1, 1, 1); PG8_SCHED; PG8_LDA(At, 1, 0); PG8_STAGE(PG8_SA(0, 1), a2 + hstep, voffA);
            PG8_WAIT_V(8); PG8_WAIT_L(0); PG8_BAR; PG8_MMA(0, 0, At, B0); PG8_MMA(0, 1, At, B1); PG8_BAR; PG8_SCHED;
            PG8_LDA(At, 1, 1); PG8_STAGE(PG8_SB(1, 0), b3, voffB); PG8_STAGE(PG8_SB(1, 1), b3 + hstep, voffB); PG8_STAGE(PG8_SA(1, 0), a3, voffA);
            PG8_WAIT_V(8); PG8_WAIT_L(0); PG8_BAR; PG8_MMA(1, 0, At, B0); PG8_MMA(1, 1, At, B1); PG8_BAR; PG8_SCHED;
            } else {
            PG8_LDB(B0, 0, 0); PG8_SCHED; PG8_LDA(At, 0, 0); PG8_STAGE(PG8_SA(1, 1), a1 + hstep, voffA);
            PG8_WAIT_L(8); PG8_BAR; PG8_WAIT_L(0); PG8_MMA(0, 0, At, B0); PG8_BAR; PG8_SCHED;
            PG8_LDB(B1, 0, 1); PG8_STAGE(PG8_SB(0, 0), b2, voffB);
            PG8_BAR; PG8_WAIT_L(0); PG8_MMA(0, 1, At, B1); PG8_BAR;
            PG8_LDA(At, 0, 1); PG8_STAGE(PG8_SA(0, 0), a2, voffA);
            PG8_BAR; PG8_WAIT_L(0); PG8_MMA(1, 0, At, B0); PG8_BAR; PG8_SCHED;
            PG8_STAGE(PG8_SB(0, 1), b2 + hstep, voffB);
            PG8_WAIT_V(6); PG8_BAR; PG8_MMA(1, 1, At, B1); PG8_BAR;
            PG8_LDB(B0, 1, 0); PG8_SCHED; PG8_LDA(At, 1, 0); PG8_STAGE(PG8_SA(0, 1), a2 + hstep, voffA);
            PG8_WAIT_L(8); PG8_BAR; PG8_WAIT_L(0); PG8_MMA(0, 0, At, B0); PG8_BAR; PG8_SCHED;
            PG8_LDB(B1, 1, 1); PG8_STAGE(PG8_SB(1, 0), b3, voffB);
            PG8_BAR; PG8_WAIT_L(0); PG8_MMA(0, 1, At, B1); PG8_BAR;
            PG8_LDA(At, 1, 1); PG8_STAGE(PG8_SA(1, 0), a3, voffA);
            PG8_BAR; PG8_WAIT_L(0); PG8_MMA(1, 0, At, B0); PG8_BAR; PG8_SCHED;
            PG8_STAGE(PG8_SB(1, 1), b3 + hstep, voffB);
            PG8_WAIT_V(6); PG8_BAR; PG8_MMA(1, 1, At, B1); PG8_BAR;
            }
        }
        if constexpr (ALIGN_EPI) { if (wr == 0) PG8_BAR; }
        if constexpr (!Epi::AFTER_DRAIN) { E(acc, cur, wr, wc, fr, fq); S.done(cur); }
        if (!has_next) break;
#pragma unroll
        for (int a = 0; a < 2; ++a)
#pragma unroll
            for (int b = 0; b < 2; ++b)
#pragma unroll
                for (int m = 0; m < 4; ++m)
#pragma unroll
                    for (int n = 0; n < 2; ++n) acc[a][b][m][n] = (f32x4){0.f, 0.f, 0.f, 0.f};
        cur = nxt; cA = nA; cB = nB; ++ui;
        if constexpr (ALIGN_EPI) { if (wr == 1) PG8_BAR; }
    }
    PG8_WAIT_V(0);
    if constexpr (!ALIGN_EPI) { if (wr == 0) PG8_BAR; }
    PG8_BAR;
    if constexpr (Epi::AFTER_DRAIN) { E.fused(acc, cur, wr, wc, fr, fq, lds, wid, lane); S.done(cur); }
#undef PG8_SA
#undef PG8_SB
#undef PG8_STAGE
#undef PG8_LDA
#undef PG8_LDB
#undef PG8_MMA
#undef PG8_WAIT_V
#undef PG8_WAIT_L
#undef PG8_BAR
#undef PG8_SCHED
}
}

#ifndef PG8_SP2
#define PG8_SP2 true
#endif

#define LAS __attribute__((address_space(3)))
typedef unsigned short bf16;
typedef short bf16x8 __attribute__((ext_vector_type(8)));
typedef float f32x4 __attribute__((ext_vector_type(4)));
typedef float f32x16 __attribute__((ext_vector_type(16)));
typedef unsigned u32x4 __attribute__((ext_vector_type(4)));
typedef unsigned u32x2 __attribute__((ext_vector_type(2)));

constexpr int DM = 1024, NMAIN = 32768, ROWS = 33024, METAROW = 32768, DFF = 4096;
constexpr int NTHREADS = 512;
constexpr int LDS_BYTES = 147456;
constexpr int LDS_ITEM_OFF = LDS_BYTES - 16;
constexpr size_t MiB = 1u << 20;
constexpr size_t WS_CTL = 0, WS_WIN = 1 * MiB, WS_WUPA = 12 * MiB, WS_WUPB = 13 * MiB, WS_WOUT = 14 * MiB, WS_WFF1 = 16 * MiB, WS_WFF2 = 24 * MiB;
constexpr size_t WS_LORA = 32 * MiB, WS_XNMETA = 32 * MiB + 512 * 1024, WS_CB = 33 * MiB, WS_ACT = 36 * MiB;
constexpr size_t ACT_SZ = (size_t)ROWS * 512 * 2, L_SZ = (size_t)ROWS * 256 * 2;
constexpr size_t WS_R = WS_ACT, WS_KA = WS_R + ACT_SZ, WS_VA = WS_KA + ACT_SZ, WS_L = WS_VA + ACT_SZ, WS_Q = WS_L + L_SZ, WS_KB = WS_Q + ACT_SZ, WS_VT = WS_KB + ACT_SZ, WS_END = WS_VT + ACT_SZ;
constexpr size_t WS_GA = WS_KA, WS_GB = WS_KB, WS_MN = WS_ACT, WS_HID = WS_ACT + 64 * MiB;
static_assert(WS_END <= 256 * MiB && WS_HID + 128 * MiB <= 256 * MiB && WS_CB + (size_t)2 * ROWS * 8 * 4 <= WS_ACT, "ws map");
constexpr float LOG2E = 1.4426950408889634f;
constexpr float QSCALE = 0.125f * LOG2E;

struct Params { const float* in[29]; float* out; unsigned char* ws; };
typedef const __attribute__((address_space(4))) Params* KP;
enum { I_XP = 0, I_XS, I_META, I_GMIX, I_WIN, I_MUP, I_MUN, I_W0, I_WUP, I_A0, I_AUP, I_GUP, I_KK, I_KA, I_RK, I_LNW, I_LNB, I_LQ1, I_LK1, I_LQ2, I_LK2, I_SUBG, I_UPA, I_UPB, I_WOUT, I_GFFN, I_FF1, I_FF2, I_GFIN };

__device__ __forceinline__ unsigned cvtpk(float lo, float hi) { unsigned r; asm volatile("v_cvt_pk_bf16_f32 %0, %1, %2" : "=v"(r) : "v"(lo), "v"(hi)); return r; }
__device__ __forceinline__ float bf2f(unsigned short b) { return __uint_as_float(((unsigned)b) << 16); }
__device__ __forceinline__ float bflo(unsigned w) { return __uint_as_float(w << 16); }
__device__ __forceinline__ float bfhi(unsigned w) { return __uint_as_float(w & 0xffff0000u); }
__device__ __forceinline__ void unpack8(const u32x4 v, float* o) { o[0] = bflo(v.x); o[1] = bfhi(v.x); o[2] = bflo(v.y); o[3] = bfhi(v.y); o[4] = bflo(v.z); o[5] = bfhi(v.z); o[6] = bflo(v.w); o[7] = bfhi(v.w); }
__device__ __forceinline__ float wave_sum(float v) {
#pragma unroll
    for (int o = 1; o < 64; o <<= 1) v += __shfl_xor(v, o);
    return v;
}
__device__ __forceinline__ float sigmoidf_(float x) { return 1.0f / (1.0f + __expf(-x)); }
__device__ __forceinline__ int seq_base(int s) { return s == 0 ? 0 : 16384 + (s - 1) * 2048; }
__device__ __forceinline__ int seq_len(int s) { return s == 0 ? 16384 : 2048; }
__device__ __forceinline__ int pos_row(int base, int p) { return p < 16 ? METAROW + p : base + p - 16; }

template <class Op> struct Epi8 {
    static constexpr bool PERM = true, AFTER_DRAIN = false;
    Op op;
    __device__ __forceinline__ void operator()(const pg8::f32x4 (&acc)[2][2][4][2], const pg8::Unit& u, int wr, int wc, int fr, int fq) const {
        const int row0 = u.pm * 256 + wr * 64 + fr, col0 = u.pn * 256 + wc * 32 + 8 * fq;
#pragma unroll
        for (int ai = 0; ai < 2; ++ai)
#pragma unroll
            for (int m = 0; m < 4; ++m)
#pragma unroll
                for (int bj = 0; bj < 2; ++bj) { op.apply(row0 + ai * 128 + m * 16, col0 + bj * 128, u.pn, acc[ai][bj][m][0], acc[ai][bj][m][1]); asm volatile("" ::: "memory"); }
    }
};
__device__ __forceinline__ u32x4 pack8(const f32x4 a, const f32x4 b) { u32x4 w; w.x = cvtpk(a[0], a[1]); w.y = cvtpk(a[2], a[3]); w.z = cvtpk(b[0], b[1]); w.w = cvtpk(b[2], b[3]); return w; }

constexpr int CW_KN = 320;
__device__ __forceinline__ float dpp_max16(float v) {
    int x = __float_as_int(v);
    v = fmaxf(v, __int_as_float(__builtin_amdgcn_update_dpp(0, x, 0xB1, 0xf, 0xf, true))); x = __float_as_int(v);
    v = fmaxf(v, __int_as_float(__builtin_amdgcn_update_dpp(0, x, 0x4E, 0xf, 0xf, true))); x = __float_as_int(v);
    v = fmaxf(v, __int_as_float(__builtin_amdgcn_update_dpp(0, x, 0x141, 0xf, 0xf, true))); x = __float_as_int(v);
    v = fmaxf(v, __int_as_float(__builtin_amdgcn_update_dpp(0, x, 0x140, 0xf, 0xf, true)));
    return v;
}
struct OpProj {
    unsigned char* ws;
    __device__ __forceinline__ void apply(int row, int col, int pn, f32x4 v0, f32x4 v1) const {
        if (pn >= 11) {
            bf16* VT = (bf16*)(ws + WS_VT); const int c = col - 11 * 256;
#pragma unroll
            for (int e = 0; e < 4; ++e) { VT[(size_t)(c + e) * ROWS + row] = (bf16)(cvtpk(v0[e], 0.f) & 0xffffu); VT[(size_t)(c + 4 + e) * ROWS + row] = (bf16)(cvtpk(v1[e], 0.f) & 0xffffu); }
            return;
        }
        bf16* O; int ldc = 512, c;
        if (pn < 2) { O = (bf16*)(ws + WS_R); c = col; }
        else if (pn < 4) { O = (bf16*)(ws + WS_KA); c = col - 512; }
        else if (pn < 6) { O = (bf16*)(ws + WS_VA); c = col - 1024; }
        else if (pn < 7) { O = (bf16*)(ws + WS_L); c = col - 1536; ldc = 256; }
        else if (pn < 9) { O = (bf16*)(ws + WS_Q); c = col - 1792; v0 = v0 * QSCALE; v1 = v1 * QSCALE; }
        else { O = (bf16*)(ws + WS_KB); c = col - 2304; }
        const u32x4 w = pack8(v0, v1);
        *(u32x4*)(O + (size_t)row * ldc + c) = w;
        if (pn >= 9) {
            float k8[8]; unpack8(w, k8); float ss = 0.f;
#pragma unroll
            for (int e = 0; e < 8; ++e) ss = fmaf(k8[e], k8[e], ss);
            ss = dpp_max16(ss);
            if ((threadIdx.x & 15) == 0) { const int sidx = row < 16384 ? 0 : row < NMAIN ? 1 + ((row - 16384) >> 11) : 9;
                atomicMax((unsigned*)(ws + WS_CTL) + CW_KN + sidx * 64 + (c >> 3), __float_as_uint(ss)); }
        }
    }
};
struct OpGate {
    unsigned char* ws;
    __device__ __forceinline__ void apply(int row, int col, int pn, f32x4 v0, f32x4 v1) const {
        bf16* O = (bf16*)(ws + (pn < 4 ? WS_GA : WS_GB)); const int c = pn < 4 ? col : col - 1024;
#pragma unroll
        for (int e = 0; e < 4; ++e) { v0[e] = sigmoidf_(v0[e]); v1[e] = sigmoidf_(v1[e]); }
        *(u32x4*)(O + (size_t)row * 1024 + c) = pack8(v0, v1);
    }
};
struct OpUpA {
    unsigned char* ws;
    __device__ __forceinline__ void apply(int row, int col, int pn, f32x4 v0, f32x4 v1) const {
        u32x4* p = (u32x4*)((bf16*)(ws + WS_GA) + (size_t)row * 1024 + col); float g[8]; unpack8(*p, g);
#pragma unroll
        for (int e = 0; e < 4; ++e) { v0[e] *= g[e]; v1[e] *= g[4 + e]; }
        *p = pack8(v0, v1);
    }
};
struct OpUpB {
    unsigned char* ws;
    __device__ __forceinline__ void apply(int row, int col, int pn, f32x4 v0, f32x4 v1) const {
        u32x4* p = (u32x4*)((bf16*)(ws + WS_GB) + (size_t)row * 1024 + col); float g[8], a[8]; unpack8(*p, g);
        unpack8(*(const u32x4*)((const bf16*)(ws + WS_GA) + (size_t)row * 1024 + col), a);
#pragma unroll
        for (int e = 0; e < 4; ++e) { v0[e] = a[e] + v0[e] * g[e]; v1[e] = a[4 + e] + v1[e] * g[4 + e]; }
        *p = pack8(v0, v1);
    }
};
struct OpOut {
    const float* xp; const float* xs; float* out;
    __device__ __forceinline__ void apply(int row, int col, int pn, f32x4 v0, f32x4 v1) const {
        const float* x = (row < 16384 ? xp + (size_t)row * DM : xs + (size_t)(row - 16384) * DM) + col;
        float* o = out + (size_t)row * DM + col;
        *(f32x4*)o = *(const f32x4*)x + v0; *(f32x4*)(o + 4) = *(const f32x4*)(x + 4) + v1;
    }
};
struct OpFF1 {
    bf16* hid;
    __device__ __forceinline__ void apply(int row, int col, int pn, f32x4 v0, f32x4 v1) const {
#pragma unroll
        for (int e = 0; e < 4; ++e) { const float a = fmaxf(v0[e], 0.f), b = fmaxf(v1[e], 0.f); v0[e] = a * a; v1[e] = b * b; }
        *(u32x4*)(hid + (size_t)row * DFF + col) = pack8(v0, v1);
    }
};
struct OpFF2 {
    float* out;
    __device__ __forceinline__ void apply(int row, int col, int pn, f32x4 v0, f32x4 v1) const {
        float* o = out + (size_t)row * DM + col;
        *(f32x4*)o = *(const f32x4*)o + v0; *(f32x4*)(o + 4) = *(const f32x4*)(o + 4) + v1;
    }
};

__device__ __forceinline__ unsigned f2bf_rne(float f) { return cvtpk(f, 0.f) & 0xffffu; }
__device__ __forceinline__ void transpose_item(const float* W, int K, int N, bf16* WT, LAS float* scr, int item, int lane) {
    const int nblk = N / 32, kb = item / nblk, nb = item % nblk, k0 = 64 * kb, n0 = 32 * nb;
#pragma unroll 8
    for (int i = 0; i < 32; ++i) { const int kk = 2 * i + (lane >> 5); scr[kk * 33 + (lane & 31)] = W[(size_t)(k0 + kk) * N + n0 + (lane & 31)]; }
    asm volatile("s_waitcnt vmcnt(0) lgkmcnt(0)" ::: "memory");
    const int c = lane & 7;
#pragma unroll
    for (int j = 0; j < 4; ++j) { const int n = (lane >> 3) + 8 * j; const LAS float* s = scr + (8 * c) * 33 + n;
        u32x4 o; o.x = cvtpk(s[0 * 33], s[1 * 33]); o.y = cvtpk(s[2 * 33], s[3 * 33]); o.z = cvtpk(s[4 * 33], s[5 * 33]); o.w = cvtpk(s[6 * 33], s[7 * 33]);
        *(u32x4*)(WT + (size_t)(n0 + n) * K + k0 + 8 * c) = o; }
    asm volatile("s_waitcnt lgkmcnt(0)" ::: "memory");
}
__device__ __forceinline__ void rms_row_bf16(const float* src, const float* g, bf16* dst, int lane) {
    unsigned long long* o8 = (unsigned long long*)dst + lane;
    if (!src) {
#pragma unroll
        for (int j = 0; j < 4; ++j) o8[64 * j] = 0ull;
        return; }
    const f32x4* xr = (const f32x4*)src + lane; const f32x4* gr = (const f32x4*)g + lane;
    f32x4 v[4]; float s = 0.f;
#pragma unroll
    for (int j = 0; j < 4; ++j) { v[j] = xr[64 * j]; s += (v[j].x * v[j].x + v[j].y * v[j].y) + (v[j].z * v[j].z + v[j].w * v[j].w); }
    const float rstd = rsqrtf(wave_sum(s) * (1.f / DM) + 1e-6f);
#pragma unroll
    for (int j = 0; j < 4; ++j) { const f32x4 gg = gr[64 * j]; const f32x4 y = v[j] * rstd * gg;
        o8[64 * j] = (unsigned long long)cvtpk(y.x, y.y) | ((unsigned long long)cvtpk(y.z, y.w) << 32); }
}
__device__ __forceinline__ void phase_prologue(LAS unsigned char* lds, KP P) {
    const int tid = fresh_tid(), lane = tid & 63, wid = tid >> 6;
    LAS float* scr = (LAS float*)(lds + wid * 16384);
    const int gw = blockIdx.x * 8 + wid, NGW = gridDim.x * 8;
    unsigned char* ws = P->ws;
    constexpr int I_IN = (1024 / 64) * (5376 / 32), I_UP = (512 / 64) * (1024 / 32), I_O = (1024 / 64) * (1024 / 32), I_1 = (1024 / 64) * (4096 / 32), I_2 = (4096 / 64) * (1024 / 32);
    constexpr int I_LW = (64 / 64) * (512 / 32), I_G = (128 / 64) * (512 / 32);
    constexpr int NITEMS = I_IN + 2 * I_UP + I_O + I_1 + I_2 + 4 * I_LW + I_G;
    for (int it = gw; it < NITEMS; it += NGW) {
        int r = it;
        if (r < I_IN) { transpose_item(P->in[I_WIN], 1024, 5376, (bf16*)(ws + WS_WIN), scr, r, lane); continue; } r -= I_IN;
        if (r < I_UP) { transpose_item(P->in[I_UPA], 512, 1024, (bf16*)(ws + WS_WUPA), scr, r, lane); continue; } r -= I_UP;
        if (r < I_UP) { transpose_item(P->in[I_UPB], 512, 1024, (bf16*)(ws + WS_WUPB), scr, r, lane); continue; } r -= I_UP;
        if (r < I_O) { transpose_item(P->in[I_WOUT], 1024, 1024, (bf16*)(ws + WS_WOUT), scr, r, lane); continue; } r -= I_O;
        if (r < I_1) { transpose_item(P->in[I_FF1], 1024, 4096, (bf16*)(ws + WS_WFF1), scr, r, lane); continue; } r -= I_1;
        if (r < I_2) { transpose_item(P->in[I_FF2], 4096, 1024, (bf16*)(ws + WS_WFF2), scr, r, lane); continue; } r -= I_2;
        if (r < 2 * I_LW) { const int d = r / I_LW; transpose_item(P->in[I_WUP] + (size_t)d * 64 * 512, 64, 512, (bf16*)(ws + WS_LORA) + (size_t)d * 512 * 64, scr, r % I_LW, lane); continue; } r -= 2 * I_LW;
        if (r < 2 * I_LW) { const int d = r / I_LW; transpose_item(P->in[I_AUP] + (size_t)d * 64 * 512, 64, 512, (bf16*)(ws + WS_LORA + 131072) + (size_t)d * 512 * 64, scr, r % I_LW, lane); continue; } r -= 2 * I_LW;
        transpose_item(P->in[I_GUP], 128, 512, (bf16*)(ws + WS_LORA + 262144), scr, r, lane);
    }
    bf16* XN = (bf16*)P->out; bf16* XM = (bf16*)(ws + WS_XNMETA);
    for (int m = gw; m < ROWS; m += NGW) {
        const float* src = m < 16384 ? P->in[I_XP] + (size_t)m * DM : m < NMAIN ? P->in[I_XS] + (size_t)(m - 16384) * DM : (m - NMAIN < 16 ? P->in[I_META] + (size_t)(m - NMAIN) * DM : nullptr);
        bf16* dst = m < NMAIN ? XN + (size_t)m * DM : XM + (size_t)(m - NMAIN) * DM;
        rms_row_bf16(src, P->in[I_GMIX], dst, lane);
    }
}

constexpr int AT_KSTR = 272, AT_VSTR = 144, AT_KSZ = 64 * AT_KSTR, AT_BUF = AT_KSZ + 128 * AT_VSTR;
__device__ __forceinline__ f32x16 mfma32(bf16x8 a, bf16x8 b, f32x16 c) { return __builtin_amdgcn_mfma_f32_32x32x16_bf16(a, b, c, 0, 0, 0); }
__device__ __forceinline__ void attn_unit(LAS unsigned char* lds, KP P, int s, int h, int qb, float lam) {
    int tid_ = threadIdx.x; asm volatile("" : "+v"(tid_));
    const int tid = tid_, lane = tid & 63, r32 = lane & 31, hi = lane >> 5, wid = __builtin_amdgcn_readfirstlane(tid >> 6), rg = wid & 3, mp = wid >> 2;
    const int L = seq_len(s), base = seq_base(s), NT = 1 + L / 64;
    unsigned char* ws = P->ws;
    const bf16* KB = (const bf16*)(ws + WS_KB); const bf16* VT = (const bf16*)(ws + WS_VT); bf16* Q = (bf16*)(ws + WS_Q);
    const int qrow = base + qb * 128 + rg * 32 + r32;
    bf16x8 q[4];
#pragma unroll
    for (int d0 = 0; d0 < 4; ++d0) q[d0] = *(const bf16x8*)(Q + (size_t)qrow * 512 + h * 128 + mp * 64 + d0 * 16 + hi * 8);
    f32x16 O[4];
#pragma unroll
    for (int b = 0; b < 4; ++b)
#pragma unroll
        for (int r = 0; r < 16; ++r) O[b][r] = 0.f;
    float mx = -INFINITY, ls = 0.f;
    const float qh = (float)(16 + qb * 128 + rg * 32 + r32 - 4 * hi);
    const float nslope = -exp2f(-2.0f * (float)(h + 1)) * LOG2E;
    const int kr0 = tid >> 4, kc = tid & 15, vn0 = tid >> 3, vc = tid & 7;
    u32x4 kreg[2], vreg[2];
    const unsigned kgo = (unsigned)((kr0 * 512 + h * 128 + kc * 8) * 2), vgo = (unsigned)(((h * 128 + vn0) * ROWS + vc * 8) * 2);
    const unsigned klo = (unsigned)(kr0 * AT_KSTR + kc * 16), vlo = (unsigned)(AT_KSZ + vn0 * AT_VSTR + vc * 16);
#define AT_GLOAD(j) do { const int m0_ = (j) == 0 ? METAROW : base + 64 * ((j) - 1); \
        const unsigned char* kt_ = (const unsigned char*)KB + (size_t)m0_ * 1024; const unsigned char* vt_ = (const unsigned char*)VT + (size_t)m0_ * 2; \
        kreg[0] = *(const u32x4*)(kt_ + kgo); kreg[1] = *(const u32x4*)(kt_ + 32 * 1024 + kgo); \
        vreg[0] = *(const u32x4*)(vt_ + vgo); vreg[1] = *(const u32x4*)(vt_ + (size_t)64 * ROWS * 2 + vgo); } while (0)
#define AT_LSTORE(buf) do { LAS unsigned char* kb_ = lds + (buf) * AT_BUF; \
        *(LAS u32x4*)(kb_ + klo) = kreg[0]; *(LAS u32x4*)(kb_ + klo + 32 * AT_KSTR) = kreg[1]; \
        *(LAS u32x4*)(kb_ + vlo) = vreg[0]; *(LAS u32x4*)(kb_ + vlo + 64 * AT_VSTR) = vreg[1]; } while (0)
    float qn, kn;
    { float ssq = 0.f;
#pragma unroll
      for (int d0 = 0; d0 < 4; ++d0) { float t[8]; unpack8(__builtin_bit_cast(u32x4, q[d0]), t);
#pragma unroll
        for (int e = 0; e < 8; ++e) ssq = fmaf(t[e], t[e], ssq); }
      ssq += __shfl_xor(ssq, 32); qn = sqrtf(ssq) * 1.002f;
      const unsigned* KN = (const unsigned*)(ws + WS_CTL) + CW_KN; float ks = 0.f;
#pragma unroll
      for (int g = 0; g < 8; ++g) ks += fmaxf(__uint_as_float(__hip_atomic_load(KN + s * 64 + h * 16 + mp * 8 + g, __ATOMIC_RELAXED, __HIP_MEMORY_SCOPE_AGENT)), __uint_as_float(__hip_atomic_load(KN + 9 * 64 + h * 16 + mp * 8 + g, __ATOMIC_RELAXED, __HIP_MEMORY_SCOPE_AGENT)));
      kn = sqrtf(ks) * 1.002f; }
    const int jc0 = 1 + qb * 2;
    int jlo = jc0, jhi = jc0 + 1;
    LAS float* red = (LAS float*)(lds + 2 * AT_BUF);
#pragma unroll 1
    for (int ph = 0; ph < 2; ++ph) {
        int nleft, ntl;
        if (ph == 0) { nleft = 0; ntl = 2; }
        else {
            float dneed = (qn * kn - mx + 40.0f) / (-nslope);
#pragma unroll
            for (int o = 1; o < 64; o <<= 1) dneed = fmaxf(dneed, __shfl_xor(dneed, o));
            if (lane == 0) red[wid] = dneed;
            __syncthreads();
            float dm = red[0];
#pragma unroll
            for (int w8 = 1; w8 < 8; ++w8) dm = fmaxf(dm, red[w8]);
            dm = fminf(fmaxf(dm, 0.f), 1.0e6f);
            const int dmax = (int)dm + 1, q0 = 16 + qb * 128;
            const int plo = q0 - dmax, phi = q0 + 127 + dmax;
            jlo = plo < 16 ? 0 : 1 + ((plo - 16) >> 6); jhi = phi >= L + 16 ? NT - 1 : 1 + ((phi - 16) >> 6);
            if (jlo > jc0) jlo = jc0; if (jhi < jc0 + 1) jhi = jc0 + 1;
            nleft = jc0 - jlo; ntl = nleft + (jhi - jc0 - 1);
        }
        if (ntl > 0) {
#define AT_J(t) (ph == 0 ? jc0 + (t) : ((t) < nleft ? jlo + (t) : jc0 + 2 + ((t) - nleft)))
        { const int jf = AT_J(0); AT_GLOAD(jf); } AT_LSTORE(0); __syncthreads();
#pragma unroll 1
        for (int t = 0; t < ntl; ++t) {
            const int j = AT_J(t);
            if (t + 1 < ntl) { const int jn = AT_J(t + 1); AT_GLOAD(jn); }
            const LAS unsigned char* Kb = lds + (t & 1) * AT_BUF + mp * 128; const LAS unsigned char* Vb = lds + (t & 1) * AT_BUF + AT_KSZ;
            const float dq = qh - (float)(j == 0 ? 0 : 64 * j - 48);
            f32x16 p0, p1;
#pragma unroll
            for (int r = 0; r < 16; ++r) { p0[r] = 0.f; p1[r] = 0.f; }
#pragma unroll
            for (int d0 = 0; d0 < 4; ++d0) {
                const bf16x8 a0 = *(const LAS bf16x8*)(Kb + r32 * AT_KSTR + d0 * 32 + hi * 16);
                const bf16x8 a1 = *(const LAS bf16x8*)(Kb + (32 + r32) * AT_KSTR + d0 * 32 + hi * 16);
                p0 = mfma32(a0, q[d0], p0); p1 = mfma32(a1, q[d0], p1);
            }
#pragma unroll
            for (int r = 0; r < 16; ++r) { const float dd = dq - (float)((r & 3) + 8 * (r >> 2)); p0[r] = fmaf(fabsf(dd), nslope, p0[r]); p1[r] = fmaf(fabsf(dd - 32.f), nslope, p1[r]); }
            if (j == 0) {
#pragma unroll
                for (int r = 0; r < 16; ++r) { if ((r & 3) + 8 * (r >> 2) + 4 * hi >= 16) p0[r] = -INFINITY; p1[r] = -INFINITY; }
            }
            float rm = fmaxf(p0[0], p1[0]);
#pragma unroll
            for (int r = 1; r < 16; ++r) rm = fmaxf(rm, fmaxf(p0[r], p1[r]));
            rm = fmaxf(rm, __shfl_xor(rm, 32));
            const float mn = fmaxf(mx, rm);
            if (__any(mn > mx)) {
                const float f = __builtin_amdgcn_exp2f(mx - mn); ls *= f; mx = mn;
#pragma unroll
                for (int b = 0; b < 4; ++b)
#pragma unroll
                    for (int r = 0; r < 16; ++r) O[b][r] *= f;
            }
            float sum = 0.f;
#pragma unroll
            for (int r = 0; r < 16; ++r) { p0[r] = __builtin_amdgcn_exp2f(p0[r] - mx); p1[r] = __builtin_amdgcn_exp2f(p1[r] - mx); sum += p0[r] + p1[r]; }
            ls += sum;
            bf16x8 pf[4];
#pragma unroll
            for (int k2 = 0; k2 < 2; ++k2) {
                u32x4 w0, w1;
                w0.x = cvtpk(p0[8 * k2 + 0], p0[8 * k2 + 1]); w0.y = cvtpk(p0[8 * k2 + 2], p0[8 * k2 + 3]); w0.z = cvtpk(p0[8 * k2 + 4], p0[8 * k2 + 5]); w0.w = cvtpk(p0[8 * k2 + 6], p0[8 * k2 + 7]);
                w1.x = cvtpk(p1[8 * k2 + 0], p1[8 * k2 + 1]); w1.y = cvtpk(p1[8 * k2 + 2], p1[8 * k2 + 3]); w1.z = cvtpk(p1[8 * k2 + 4], p1[8 * k2 + 5]); w1.w = cvtpk(p1[8 * k2 + 6], p1[8 * k2 + 7]);
                pf[k2] = __builtin_bit_cast(bf16x8, w0); pf[2 + k2] = __builtin_bit_cast(bf16x8, w1);
            }
#pragma unroll
            for (int ks = 0; ks < 4; ++ks)
#pragma unroll
                for (int b = 0; b < 4; ++b) {
                    const LAS unsigned char* vp = Vb + (b * 32 + r32) * AT_VSTR + ks * 32 + hi * 8;
                    const u32x2 lo = *(const LAS u32x2*)vp, hh = *(const LAS u32x2*)(vp + 16);
                    u32x4 vv; vv.x = lo.x; vv.y = lo.y; vv.z = hh.x; vv.w = hh.y;
                    O[b] = mfma32(__builtin_bit_cast(bf16x8, vv), pf[ks], O[b]);
                }
            if (t + 1 < ntl) AT_LSTORE((t + 1) & 1);
            __syncthreads();
        }
#undef AT_J
        }
    }
#undef AT_GLOAD
#undef AT_LSTORE
    const float lt = ls + __shfl_xor(ls, 32);
    const float inv = (mp ? lam : 1.0f) / lt;
    int lane2 = lane; asm volatile("" : "+v"(lane2));
    const int r32e = lane2 & 31, hie = lane2 >> 5;
    LAS float* ex = (LAS float*)lds + rg * (128 * 32) + hie * 128 + r32e;
    if (mp == 1) {
#pragma unroll
        for (int b = 0; b < 4; ++b)
#pragma unroll
            for (int r = 0; r < 16; ++r) ex[(32 * b + (r & 3) + 8 * (r >> 2)) * 32] = O[b][r] * inv;
    }
    __syncthreads();
    if (mp == 0) {
        float ss = 0.f;
#pragma unroll
        for (int b = 0; b < 4; ++b)
#pragma unroll
            for (int r = 0; r < 16; ++r) { const float o = O[b][r] * inv - ex[(32 * b + (r & 3) + 8 * (r >> 2)) * 32]; O[b][r] = o; ss += o * o; }
        ss += __shfl_xor(ss, 32);
        const float rstd = rsqrtf(ss * (1.0f / 128.0f) + 1e-5f) * 0.8f;
        const float* sg = P->in[I_SUBG] + 4 * hie; bf16* Qo = Q + (size_t)(base + qb * 128 + rg * 32 + r32e) * 512 + h * 128 + 4 * hie;
#pragma unroll
        for (int b = 0; b < 4; ++b)
#pragma unroll
            for (int r4 = 0; r4 < 4; ++r4) {
                const int n = 32 * b + 8 * r4; const f32x4 g = *(const f32x4*)(sg + n);
                u32x2 w; w.x = cvtpk(O[b][4 * r4 + 0] * rstd * g.x, O[b][4 * r4 + 1] * rstd * g.y); w.y = cvtpk(O[b][4 * r4 + 2] * rstd * g.z, O[b][4 * r4 + 3] * rstd * g.w);
                *(u32x2*)(Qo + n) = w;
            }
    }
    __syncthreads();
}

constexpr int SC_R = 0, SC_K = 16384, SC_V = 32768, SC_W = 49152, SC_B = 65536, SC_KK = 81920, SC_Y = 98304, SC_TW = 114688, SC_AD = 123904, SC_MU = 133120;
__device__ __forceinline__ float dpp_add(float v, int ctrl_id) {
    const int x = __float_as_int(v); int y;
    if (ctrl_id == 0) y = __builtin_amdgcn_update_dpp(0, x, 0xB1, 0xf, 0xf, true);
    else if (ctrl_id == 1) y = __builtin_amdgcn_update_dpp(0, x, 0x4E, 0xf, 0xf, true);
    else if (ctrl_id == 2) y = __builtin_amdgcn_update_dpp(0, x, 0x141, 0xf, 0xf, true);
    else y = __builtin_amdgcn_update_dpp(0, x, 0x140, 0xf, 0xf, true);
    return v + __int_as_float(y);
}
template <int LPR> __device__ __forceinline__ float grp_sum(float v) {
    v = dpp_add(v, 0); v = dpp_add(v, 1); v = dpp_add(v, 2);
    if (LPR == 16) v = dpp_add(v, 3);
    return v;
}
#define BAR_LDS() asm volatile("s_waitcnt lgkmcnt(0)\n\ts_barrier" ::: "memory")
__device__ __forceinline__ float fast_sigmoid(float x) { return __builtin_amdgcn_rcpf(1.0f + __builtin_amdgcn_exp2f(-LOG2E * x)); }
__device__ __forceinline__ float fast_tanh(float x) { return 1.0f - 2.0f * __builtin_amdgcn_rcpf(1.0f + __builtin_amdgcn_exp2f(2.0f * LOG2E * x)); }
template <int NRP, int NSW>
__device__ __forceinline__ void scan_unit(LAS unsigned char* lds, KP P, int s, int d, int h, int rp) {
    constexpr int RPB = 64 / NRP, RPW = RPB / NSW, LPR = 64 / RPW, CPL = 64 / LPR;
    static_assert(LPR == 8 || LPR == 16, "scan geometry");
    int tid_ = threadIdx.x; asm volatile("" : "+v"(tid_));
    const int tid = tid_, lane = tid & 63, wid = __builtin_amdgcn_readfirstlane(tid >> 6);
    const int L = seq_len(s), base = seq_base(s), Ltot = L + 16, nchunk = (Ltot + 63) / 64;
    unsigned char* ws = P->ws;
    const bf16* Rb = (const bf16*)(ws + WS_R); const bf16* KAb = (const bf16*)(ws + WS_KA); const bf16* VAb = (const bf16*)(ws + WS_VA); const bf16* Lb = (const bf16*)(ws + WS_L);
    float* CB = (float*)(ws + WS_CB); bf16* YD = (bf16*)((unsigned char*)P->out + 64 * MiB) + (size_t)d * NMAIN * 512;
    LAS float* fS = (LAS float*)lds; LAS float* fV = (LAS float*)(lds + 81920); LAS float* fY = (LAS float*)(lds + SC_Y); LAS float* fMU = (LAS float*)(lds + SC_MU);
#define SCI(sl_, a_, c_) ((sl_) * 320 + (a_) * 64 + (c_))
    for (int i = tid; i < 832; i += NTHREADS) {
        float v;
        if (i < 640) { const int which = i / 320, jj = i % 320, a = jj >> 6, c = jj & 63; const int gi = a < 3 ? a * 512 + h * 64 + c : 1536 + (a - 3) * 64 + c; v = P->in[which ? I_MUN : I_MUP][gi]; }
        else { const int a = (i - 640) >> 6, c = (i - 640) & 63; v = P->in[a == 0 ? I_KK : a == 1 ? I_KA : I_RK][h * 64 + c]; }
        fMU[i] = v;
    }
    const int mat = wid >> 2, ntile = wid & 3;
    const bf16* Wt = (const bf16*)(ws + WS_LORA + (mat ? 131072 : 0)) + ((size_t)d * 512 + h * 64 + ntile * 16 + (lane & 15)) * 64 + (lane >> 4) * 8;
    const bf16x8 bfr0 = *(const bf16x8*)Wt, bfr1 = *(const bf16x8*)(Wt + 32);
    const float bias = P->in[mat ? I_A0 : I_W0][d * 512 + h * 64 + ntile * 16 + (lane & 15)];
    float S[CPL];
#pragma unroll
    for (int j = 0; j < CPL; ++j) S[j] = 0.f;
    const int rowl = lane / LPR, kg = lane % LPR, srow = rp * RPB + wid * RPW + rowl;
    const int slot = tid >> 3, cg8 = (tid & 7) * 8;
    u32x4 raw[5][3];
#define SC_LOAD(c) do { const int i_ = 64 * (c) + slot; const bool ok_ = i_ < Ltot; const int p_ = d ? Ltot - 1 - i_ : i_; \
        const unsigned zr_ = (unsigned)(METAROW + 64); \
        const unsigned rc_ = ok_ ? (unsigned)pos_row(base, p_) : zr_, rp_ = (ok_ && p_ > 0) ? (unsigned)pos_row(base, p_ - 1) : zr_, rn_ = (ok_ && p_ + 1 < Ltot) ? (unsigned)pos_row(base, p_ + 1) : zr_; \
        _Pragma("unroll") for (int a_ = 0; a_ < 5; ++a_) { const unsigned char* B_ = (const unsigned char*)(a_ == 0 ? Rb : a_ == 1 ? KAb : a_ == 2 ? VAb : Lb); const unsigned ld_ = a_ < 3 ? 1024u : 512u; \
            const unsigned co_ = (unsigned)(((a_ < 3 ? h * 64 : (a_ - 3) * 64) + cg8) * 2); \
            raw[a_][0] = *(const u32x4*)(B_ + (rp_ * ld_ + co_)); raw[a_][1] = *(const u32x4*)(B_ + (rc_ * ld_ + co_)); raw[a_][2] = *(const u32x4*)(B_ + (rn_ * ld_ + co_)); } } while (0)
    SC_LOAD(0);
    BAR_LDS();
    for (int c = 0; c < nchunk; ++c) {
        const int nvalid = (Ltot - 64 * c) < 64 ? (Ltot - 64 * c) : 64;
        float rv[8], kv[8];
#pragma unroll
        for (int a = 0; a < 5; ++a) {
            float pv[8], cv[8], nv[8], o[8]; unpack8(raw[a][0], pv); unpack8(raw[a][1], cv); unpack8(raw[a][2], nv);
            const f32x4 mp0 = *(const LAS f32x4*)(fMU + a * 64 + cg8), mp1 = *(const LAS f32x4*)(fMU + a * 64 + cg8 + 4), mn0 = *(const LAS f32x4*)(fMU + 320 + a * 64 + cg8), mn1 = *(const LAS f32x4*)(fMU + 320 + a * 64 + cg8 + 4);
#pragma unroll
            for (int e = 0; e < 8; ++e) { const float mp = e < 4 ? mp0[e & 3] : mp1[e & 3], mn = e < 4 ? mn0[e & 3] : mn1[e & 3]; o[e] = cv[e] + mp * (pv[e] - cv[e]) + mn * (nv[e] - cv[e]); }
            if (a == 0) {
#pragma unroll
                for (int e = 0; e < 8; ++e) rv[e] = o[e];
                LAS float* dst = fS + SCI(slot, 4, cg8); *(LAS f32x4*)dst = (f32x4){o[0], o[1], o[2], o[3]}; *(LAS f32x4*)(dst + 4) = (f32x4){o[4], o[5], o[6], o[7]};
            } else if (a == 1) {
#pragma unroll
                for (int e = 0; e < 8; ++e) kv[e] = o[e];
            } else if (a == 2) {
                LAS float* dst = fV + slot * 64 + cg8; *(LAS f32x4*)dst = (f32x4){o[0], o[1], o[2], o[3]}; *(LAS f32x4*)(dst + 4) = (f32x4){o[4], o[5], o[6], o[7]};
            } else {
                if (a == 3) {
#pragma unroll
                    for (int e = 0; e < 8; ++e) o[e] = fast_tanh(o[e]);
                }
                u32x4 w; w.x = cvtpk(o[0], o[1]); w.y = cvtpk(o[2], o[3]); w.z = cvtpk(o[4], o[5]); w.w = cvtpk(o[6], o[7]);
                *(LAS u32x4*)(lds + (a == 3 ? SC_TW : SC_AD) + slot * 144 + cg8 * 2) = w;
            }
        }
        BAR_LDS();
        if (c + 1 < nchunk) SC_LOAD(c + 1);
        {
            const LAS unsigned char* Ab = lds + (mat ? SC_AD : SC_TW); LAS float* fWB = fS + (mat ? 128 : 64);
#pragma unroll
            for (int mt = 0; mt < 4; ++mt) {
                const bf16x8 a0 = *(const LAS bf16x8*)(Ab + (mt * 16 + (lane & 15)) * 144 + (lane >> 4) * 16);
                const bf16x8 a1 = *(const LAS bf16x8*)(Ab + (mt * 16 + (lane & 15)) * 144 + 64 + (lane >> 4) * 16);
                f32x4 acc = {0.f, 0.f, 0.f, 0.f};
                acc = __builtin_amdgcn_mfma_f32_16x16x32_bf16(a0, bfr0, acc, 0, 0, 0);
                acc = __builtin_amdgcn_mfma_f32_16x16x32_bf16(a1, bfr1, acc, 0, 0, 0);
#pragma unroll
                for (int rg = 0; rg < 4; ++rg) {
                    const int sl = mt * 16 + (lane >> 4) * 4 + rg, col = ntile * 16 + (lane & 15);
                    const float sg = fast_sigmoid(acc[rg] + bias); const float dc = __builtin_amdgcn_exp2f(-0.6065306597126334f * LOG2E * sg);
                    fWB[sl * 320 + col] = mat ? sg : dc;
                }
            }
        }
        BAR_LDS();
        {
            const f32x4 a0 = *(const LAS f32x4*)(fS + SCI(slot, 2, cg8)), a1 = *(const LAS f32x4*)(fS + SCI(slot, 2, cg8 + 4));
            const f32x4 kk0 = *(const LAS f32x4*)(fMU + 640 + cg8), kk1 = *(const LAS f32x4*)(fMU + 640 + cg8 + 4), ka0 = *(const LAS f32x4*)(fMU + 704 + cg8), ka1 = *(const LAS f32x4*)(fMU + 704 + cg8 + 4);
            const f32x4 rk0 = *(const LAS f32x4*)(fMU + 768 + cg8), rk1 = *(const LAS f32x4*)(fMU + 768 + cg8 + 4);
            float kkv[8], kd[8], av[8]; float ssq = 0.f, cs = 0.f;
#pragma unroll
            for (int e = 0; e < 8; ++e) {
                av[e] = e < 4 ? a0[e & 3] : a1[e & 3];
                kkv[e] = kv[e] * (e < 4 ? kk0[e & 3] : kk1[e & 3]); ssq = fmaf(kkv[e], kkv[e], ssq);
                kd[e] = kv[e] * (1.0f + (av[e] - 1.0f) * (e < 4 ? ka0[e & 3] : ka1[e & 3])); cs = fmaf(rv[e] * kd[e], e < 4 ? rk0[e & 3] : rk1[e & 3], cs);
            }
            ssq = grp_sum<8>(ssq); cs = grp_sum<8>(cs);
            const float rs = rsqrtf(fmaxf(ssq, 1e-24f));
#pragma unroll
            for (int e = 0; e < 8; ++e) { kkv[e] *= rs; av[e] *= kkv[e]; }
            LAS float* o1 = fS + SCI(slot, 0, cg8); *(LAS f32x4*)o1 = (f32x4){kkv[0], kkv[1], kkv[2], kkv[3]}; *(LAS f32x4*)(o1 + 4) = (f32x4){kkv[4], kkv[5], kkv[6], kkv[7]};
            LAS float* o2 = fS + SCI(slot, 2, cg8); *(LAS f32x4*)o2 = (f32x4){av[0], av[1], av[2], av[3]}; *(LAS f32x4*)(o2 + 4) = (f32x4){av[4], av[5], av[6], av[7]};
            LAS float* o3 = fS + SCI(slot, 3, cg8); *(LAS f32x4*)o3 = (f32x4){kd[0], kd[1], kd[2], kd[3]}; *(LAS f32x4*)(o3 + 4) = (f32x4){kd[4], kd[5], kd[6], kd[7]};
            if (cg8 == 0 && rp == 0 && slot < nvalid) { const int i2 = 64 * c + slot; const int p2 = d ? Ltot - 1 - i2 : i2; CB[((size_t)d * ROWS + pos_row(base, p2)) * 8 + h] = cs; }
        }
        BAR_LDS();
        if (wid < NSW) {
            typedef float f32x2_ __attribute__((ext_vector_type(2)));
            constexpr int C4 = CPL / 4;
            const LAS float* ps = fS + kg * CPL; const LAS float* pv = fV + srow; LAS float* py = fY + srow;
            f32x4 nk[C4], nw[C4], nb[C4], nd[C4], nr[C4]; float nv;
#define SC_FETCH(sl_) do { _Pragma("unroll") for (int j_ = 0; j_ < C4; ++j_) { nk[j_] = *(const LAS f32x4*)(ps + (sl_) * 320 + 4 * j_); nw[j_] = *(const LAS f32x4*)(ps + (sl_) * 320 + 64 + 4 * j_); \
                nb[j_] = *(const LAS f32x4*)(ps + (sl_) * 320 + 128 + 4 * j_); nd[j_] = *(const LAS f32x4*)(ps + (sl_) * 320 + 192 + 4 * j_); nr[j_] = *(const LAS f32x4*)(ps + (sl_) * 320 + 256 + 4 * j_); } nv = pv[(sl_) * 64]; } while (0)
            SC_FETCH(0);
            f32x4 rp4[C4];
#pragma unroll
            for (int j = 0; j < C4; ++j) rp4[j] = (f32x4){0.f, 0.f, 0.f, 0.f};
#pragma unroll 8
            for (int sl = 0; sl < nvalid; ++sl) {
                f32x4 ck[C4], cw[C4], cb[C4], cd[C4], cr[C4];
#pragma unroll
                for (int j = 0; j < C4; ++j) { ck[j] = nk[j]; cw[j] = nw[j]; cb[j] = nb[j]; cd[j] = nd[j]; cr[j] = nr[j]; }
                const float vv = nv;
                SC_FETCH(sl + 1 < 64 ? sl + 1 : 63);
                f32x2_ pa = {0.f, 0.f}, ya = {0.f, 0.f};
#pragma unroll
                for (int j = 0; j < C4; ++j)
#pragma unroll
                    for (int e = 0; e < 4; e += 2) { const f32x2_ s2 = {S[4 * j + e], S[4 * j + e + 1]}, k2 = {ck[j][e], ck[j][e + 1]}, r2 = {rp4[j][e], rp4[j][e + 1]}; pa = pa + s2 * k2; ya = ya + s2 * r2; }
                float pp = pa.x + pa.y, yy = ya.x + ya.y;
                pp = dpp_add(pp, 0); yy = dpp_add(yy, 0); pp = dpp_add(pp, 1); yy = dpp_add(yy, 1); pp = dpp_add(pp, 2); yy = dpp_add(yy, 2);
                if (LPR == 16) { pp = dpp_add(pp, 3); yy = dpp_add(yy, 3); }
                py[(sl > 0 ? sl - 1 : 0) * 64] = yy;
#pragma unroll
                for (int j = 0; j < C4; ++j)
#pragma unroll
                    for (int e = 0; e < 4; e += 2) {
                        const f32x2_ b2 = {cb[j][e], cb[j][e + 1]}, d2 = {cd[j][e], cd[j][e + 1]}, w2 = {cw[j][e], cw[j][e + 1]}; f32x2_ s2 = {S[4 * j + e], S[4 * j + e + 1]};
                        const f32x2_ t2 = d2 * vv - b2 * pp; s2 = s2 * w2 + t2; S[4 * j + e] = s2.x; S[4 * j + e + 1] = s2.y; }
#pragma unroll
                for (int j = 0; j < C4; ++j) rp4[j] = cr[j];
            }
            {
                f32x2_ ya = {0.f, 0.f};
#pragma unroll
                for (int j = 0; j < C4; ++j)
#pragma unroll
                    for (int e = 0; e < 4; e += 2) { const f32x2_ s2 = {S[4 * j + e], S[4 * j + e + 1]}, r2 = {rp4[j][e], rp4[j][e + 1]}; ya = ya + s2 * r2; }
                const float yy = grp_sum<LPR>(ya.x + ya.y);
                py[(nvalid - 1) * 64] = yy;
            }
#undef SC_FETCH
        }
        BAR_LDS();
        {
            const int i2 = 64 * c + slot; const int p2 = d ? Ltot - 1 - i2 : i2;
            if (slot < nvalid && p2 >= 16 && (cg8 / RPB) == rp) {
                const LAS float* yp = fY + slot * 64 + cg8; const f32x4 y0 = *(const LAS f32x4*)yp, y1 = *(const LAS f32x4*)(yp + 4);
                *(u32x4*)(YD + (size_t)(base + p2 - 16) * 512 + h * 64 + cg8) = pack8(y0, y1);
            }
        }
    }
#undef SC_LOAD
#undef SCI
}

__device__ __forceinline__ void phase_post(LAS unsigned char* lds, KP P) {
    const int tid = fresh_tid(), lane = tid & 63, wid = tid >> 6;
    unsigned char* ws = P->ws;
    const bf16* VAb = (const bf16*)(ws + WS_VA); const bf16* Lb = (const bf16*)(ws + WS_L); bf16* Rb = (bf16*)(ws + WS_R);
    const float* CB = (const float*)(ws + WS_CB); const bf16* YD0 = (const bf16*)((const unsigned char*)P->out + 64 * MiB); const bf16* YD1 = YD0 + (size_t)NMAIN * 512;
    const bf16* GT = (const bf16*)(ws + WS_LORA + 262144);
    LAS float* st = (LAS float*)(lds + 17408);
    const float* mup = P->in[I_MUP]; const float* mun = P->in[I_MUN];
    for (int tile = blockIdx.x; tile < NMAIN / 64; tile += gridDim.x) {
        {
            const int row = tid >> 3, hh = tid & 7, m = tile * 64 + row;
            const int t = m < 16384 ? m : (m - 16384) & 2047, Ls = m < 16384 ? 16384 : 2048;
            float sum = 0.f, sq = 0.f;
#pragma unroll
            for (int i = 0; i < 8; ++i) { float a[8], b[8]; unpack8(*(const u32x4*)(YD0 + (size_t)m * 512 + hh * 64 + i * 8), a); unpack8(*(const u32x4*)(YD1 + (size_t)m * 512 + hh * 64 + i * 8), b);
#pragma unroll
                for (int e = 0; e < 8; ++e) { const float y = a[e] + b[e]; sum += y; sq += y * y; } }
            const float mu = sum * (1.0f / 64.0f); const float var = fmaxf(sq * (1.0f / 64.0f) - mu * mu, 0.f);
            st[(row * 8 + hh) * 2] = mu; st[(row * 8 + hh) * 2 + 1] = rsqrtf(var + 64e-5f);
            const size_t rp_ = t == 0 ? (size_t)(METAROW + 15) : (size_t)(m - 1); const bool okn = t + 1 < Ls;
#pragma unroll
            for (int i = 0; i < 2; ++i) {
                const int c0 = 128 + hh * 16 + i * 8; float pv[8], cv[8], nv[8], o[8];
                unpack8(*(const u32x4*)(Lb + rp_ * 256 + c0), pv); unpack8(*(const u32x4*)(Lb + (size_t)m * 256 + c0), cv);
                if (okn) unpack8(*(const u32x4*)(Lb + (size_t)(m + 1) * 256 + c0), nv); else {
#pragma unroll
                    for (int e = 0; e < 8; ++e) nv[e] = 0.f; }
#pragma unroll
                for (int e = 0; e < 8; ++e) { const float mp = mup[1536 + c0 + e], mn = mun[1536 + c0 + e]; o[e] = sigmoidf_(cv[e] + mp * (pv[e] - cv[e]) + mn * (nv[e] - cv[e])); }
                u32x4 w; w.x = cvtpk(o[0], o[1]); w.y = cvtpk(o[2], o[3]); w.z = cvtpk(o[4], o[5]); w.w = cvtpk(o[6], o[7]);
                *(LAS u32x4*)(lds + row * 272 + (hh * 16 + i * 8) * 2) = w;
            }
        }
        __syncthreads();
#pragma unroll 1
        for (int nt = 0; nt < 4; ++nt) {
            const int col = wid * 64 + nt * 16 + (lane & 15);
            bf16x8 bfr[4];
#pragma unroll
            for (int ks = 0; ks < 4; ++ks) bfr[ks] = *(const bf16x8*)(GT + (size_t)col * 128 + ks * 32 + (lane >> 4) * 8);
            const float lw = P->in[I_LNW][col], lb = P->in[I_LNB][col];
            const float mpv = mup[1024 + col], mnv = mun[1024 + col];
#pragma unroll 1
            for (int mt = 0; mt < 4; ++mt) {
                f32x4 acc = {0.f, 0.f, 0.f, 0.f};
#pragma unroll
                for (int ks = 0; ks < 4; ++ks) { const bf16x8 a = *(const LAS bf16x8*)(lds + (mt * 16 + (lane & 15)) * 272 + ks * 64 + (lane >> 4) * 16); acc = __builtin_amdgcn_mfma_f32_16x16x32_bf16(a, bfr[ks], acc, 0, 0, 0); }
#pragma unroll
                for (int rg = 0; rg < 4; ++rg) {
                    const int row = mt * 16 + (lane >> 4) * 4 + rg, m = tile * 64 + row;
                    const int t = m < 16384 ? m : (m - 16384) & 2047, Ls = m < 16384 ? 16384 : 2048;
                    const float y = bf2f(YD0[(size_t)m * 512 + col]) + bf2f(YD1[(size_t)m * 512 + col]);
                    const float yn = (y - st[(row * 8 + wid) * 2]) * st[(row * 8 + wid) * 2 + 1] * lw + lb;
                    const float vc = bf2f(VAb[(size_t)m * 512 + col]);
                    const float vp = bf2f(VAb[(t == 0 ? (size_t)(METAROW + 15) : (size_t)(m - 1)) * 512 + col]);
                    const float vn = t + 1 < Ls ? bf2f(VAb[(size_t)(m + 1) * 512 + col]) : 0.f;
                    const float vs = vc + mpv * (vp - vc) + mnv * (vn - vc);
                    const float cb = CB[(size_t)m * 8 + wid] + CB[((size_t)ROWS + m) * 8 + wid];
                    Rb[(size_t)m * 512 + col] = (bf16)f2bf_rne((yn + cb * vs) * acc[rg]);
                }
            }
        }
        __syncthreads();
    }
}

__device__ __forceinline__ void phase_rms_bf16(KP P) {
    const int tid = fresh_tid(), lane = tid & 63, wid = tid >> 6; const int gw = blockIdx.x * 8 + wid, NGW = gridDim.x * 8;
    bf16* MN = (bf16*)(P->ws + WS_MN);
    for (int m = gw; m < NMAIN; m += NGW) rms_row_bf16(P->out + (size_t)m * DM, P->in[I_GFFN], MN + (size_t)m * DM, lane);
}
__device__ __forceinline__ void phase_final(KP P) {
    const int tid = fresh_tid(), lane = tid & 63, wid = tid >> 6; const int gw = blockIdx.x * 8 + wid, NGW = gridDim.x * 8;
    const f32x4* gr = (const f32x4*)P->in[I_GFIN] + lane;
    for (int m = gw; m < NMAIN; m += NGW) {
        f32x4* xr = (f32x4*)(P->out + (size_t)m * DM) + lane; f32x4 v[4]; float s = 0.f;
#pragma unroll
        for (int j = 0; j < 4; ++j) { v[j] = xr[64 * j]; s += (v[j].x * v[j].x + v[j].y * v[j].y) + (v[j].z * v[j].z + v[j].w * v[j].w); }
        const float rstd = rsqrtf(wave_sum(s) * (1.f / DM) + 1e-6f);
#pragma unroll
        for (int j = 0; j < 4; ++j) xr[64 * j] = v[j] * rstd * gr[64 * j];
    }
}

constexpr int NRP_LONG = 4;
constexpr int N_LONG = 16 * NRP_LONG, N_ATT_P = 512, N_ATT_S = 512, N_SHORT = 128, N_ITEMS = N_LONG + N_ATT_P + N_ATT_S + N_SHORT;

template <class Op> __device__ __forceinline__ void run_gemm(LAS unsigned char* lds, const bf16* A, const bf16* Bt, int M, int N, int K, const Op& op, const bf16* A2 = nullptr, int pm2 = 1 << 30) {
    pg8::Gemm g{A, Bt, M, N, K, A2, pm2}; pg8::StaticOrder S; S.init(M, N, (int)gridDim.x, (int)blockIdx.x);
    Epi8<Op> E{op};
    pg8::gemm_phase<Epi8<Op>, pg8::StaticOrder, true, true>(lds, g, S, E);
}

constexpr size_t WS_XBAR = 16384;
#define XB_TMO      128
#define XB_XCNT(j)  (256  + 64 * (j))
#define XB_XSUB(j)  (1280 + 64 * (j))
#define XB_XGEN(j)  (2304 + 64 * (j))
#define XB_TOP      3328
#define XB_TOPGEN   3392
#define XCD_BAR_WORDS 3456
#define XB_SPIN_CAP (1u << 18)
__device__ __forceinline__ unsigned xb_ld(unsigned* p)              { return __hip_atomic_load(p, __ATOMIC_RELAXED, __HIP_MEMORY_SCOPE_AGENT); }
__device__ __forceinline__ unsigned xb_add(unsigned* p, unsigned v) { return __hip_atomic_fetch_add(p, v, __ATOMIC_RELAXED, __HIP_MEMORY_SCOPE_AGENT); }
__device__ __forceinline__ unsigned xb_xcc_id() { return (unsigned)__builtin_amdgcn_s_getreg((3 << 11) | 20) & 0xFu; }
#define XB_SPIN(cond, bar) do { unsigned _sp = 0; while (cond) { __builtin_amdgcn_s_sleep(1); \
    if ((++_sp & 255u) == 0u) { if (xb_ld(&(bar)[XB_TMO])) break; if (_sp > XB_SPIN_CAP) { atomicAdd(&(bar)[XB_TMO], 1u); break; } } } } while (0)
struct XcdBarrier { unsigned* bar; unsigned x; volatile LAS unsigned* st; };
__device__ __forceinline__ XcdBarrier xcd_barrier_post(unsigned* bar, volatile LAS unsigned* st) {
    XcdBarrier b; b.bar = bar; b.x = xb_xcc_id(); b.st = st;
    if (threadIdx.x == 0) (void)xb_add(&bar[XB_XCNT(b.x)], 1u);
    return b;
}
__device__ __forceinline__ void xcd_barrier_complete(unsigned* bar, unsigned x, unsigned& nloc, unsigned& nx) {
    const unsigned G = gridDim.x * gridDim.y * gridDim.z;
    unsigned sum, cnt, mine, sp = 0u;
    for (;;) {
        sum = 0u; cnt = 0u; mine = 0u;
#pragma unroll
        for (unsigned j = 0; j < 16; ++j) { const unsigned c = xb_ld(&bar[XB_XCNT(j)]); sum += c; cnt += (c > 0u) ? 1u : 0u; mine = (j == x) ? c : mine; }
        if (sum == G) break;
        __builtin_amdgcn_s_sleep(1);
        if ((++sp & 255u) == 0u) { if (xb_ld(&bar[XB_TMO])) break; if (sp > XB_SPIN_CAP) { atomicAdd(&bar[XB_TMO], 1u); break; } }
    }
    nloc = mine > 0u ? mine : 1u; nx = cnt > 0u ? cnt : 1u;
}
__device__ __forceinline__ void xcd_barrier(const XcdBarrier& b) {
    asm volatile("s_waitcnt vmcnt(0)" ::: "memory");
    __syncthreads();
    if (threadIdx.x == 0) {
        unsigned* bar = b.bar;
        __builtin_amdgcn_s_waitcnt(0);
        unsigned nloc = b.st[0], nx = b.st[1];
        if (nloc == 0u) { xcd_barrier_complete(bar, b.x, nloc, nx); b.st[0] = nloc; b.st[1] = nx; }
        const unsigned old = xb_add(&bar[XB_XSUB(b.x)], 1u);
        const unsigned gen = old / nloc;
        if (old + 1u == (gen + 1u) * nloc) {
            __builtin_amdgcn_fence(__ATOMIC_RELEASE, "agent");
            asm volatile("s_waitcnt vmcnt(0)" ::: "memory");
            const unsigned og = xb_add(&bar[XB_TOP], 1u);
            const unsigned tg = og / nx;
            if (og + 1u == (tg + 1u) * nx) xb_add(&bar[XB_TOPGEN], 1u);
            else XB_SPIN(xb_ld(&bar[XB_TOPGEN]) == tg, bar);
            __builtin_amdgcn_fence(__ATOMIC_ACQUIRE, "agent");
            xb_add(&bar[XB_XGEN(b.x)], 1u);
            asm volatile("s_waitcnt vmcnt(0)" ::: "memory");
        } else {
            XB_SPIN(xb_ld(&bar[XB_XGEN(b.x)]) == gen, bar);
            __builtin_amdgcn_fence(__ATOMIC_ACQUIRE, "agent");
            asm volatile("s_waitcnt vmcnt(0)" ::: "memory");
        }
    }
    __syncthreads();
}
#ifndef PROBE_MASK
#define PROBE_MASK 0
#endif
#ifndef PROBE_MUL
#define PROBE_MUL 1
#endif
#define PH_BEGIN(k) unsigned long long t0_##k = 0; if (PROBE_MASK & (1 << (k))) t0_##k = __builtin_amdgcn_s_memrealtime();
#define PH_END(k) if (PROBE_MASK & (1 << (k))) { const unsigned long long t1_ = __builtin_amdgcn_s_memrealtime(); const unsigned long long dt_ = (t1_ - t0_##k) * PROBE_MUL; while (__builtin_amdgcn_s_memrealtime() - t1_ < dt_) __builtin_amdgcn_s_sleep(8); xcd_barrier(xbar); }
__global__ void __launch_bounds__(NTHREADS) fwd_megakernel(Params Pin) {
    extern __shared__ __attribute__((aligned(16))) unsigned char lds_raw[];
    LAS unsigned char* lds = (LAS unsigned char*)lds_raw;
    cg::grid_group grid = cg::this_grid();
    KP P0 = (KP)__builtin_amdgcn_kernarg_segment_ptr();
    volatile LAS unsigned* xst = (volatile LAS unsigned*)(lds + LDS_ITEM_OFF + 4);
    if (threadIdx.x == 0) { xst[0] = 0u; xst[1] = 0u; }
    __syncthreads();
    const XcdBarrier xbar = xcd_barrier_post((unsigned*)(P0->ws + WS_XBAR), xst);
#define NEWPHASE KP P = P0; asm volatile("" : "+s"(P)); unsigned char* ws = P->ws; (void)ws;

    PH_BEGIN(0)
    { NEWPHASE phase_prologue(lds, P); }
    grid.sync();
    PH_END(0)
    PH_BEGIN(1)
    { NEWPHASE run_gemm(lds, (const bf16*)P->out, (const bf16*)(ws + WS_WIN), ROWS, 3328, 1024, OpProj{ws}, (const bf16*)(ws + WS_XNMETA), 128); }
    xcd_barrier(xbar);
    PH_END(1)
    PH_BEGIN(2)
    { NEWPHASE
        const int tid = fresh_tid();
        float lam;
        { const int lane = tid & 63; const float s1 = wave_sum(P->in[I_LQ1][lane] * P->in[I_LK1][lane]), s2 = wave_sum(P->in[I_LQ2][lane] * P->in[I_LK2][lane]); lam = __expf(s1) - __expf(s2) + 0.2f; }
        unsigned* ctr = (unsigned*)(ws + WS_CTL);
        LAS unsigned* slot = (LAS unsigned*)(lds + LDS_ITEM_OFF);
#define FETCH(k, n) if (tid == 0) *slot = atomicAdd(ctr + 64 * (k), 1u); __syncthreads(); const int idx = (int)*slot; __syncthreads(); if (idx >= (n)) break;
#ifndef NO_SCAN
#pragma unroll 1
        for (;;) { FETCH(0, N_LONG) const int u = idx / NRP_LONG; scan_unit<NRP_LONG, 4>(lds, P, 0, u >> 3, u & 7, idx % NRP_LONG); }
#endif
#ifndef NO_ATTN
#pragma unroll 1
        for (;;) { FETCH(1, N_ATT_P + N_ATT_S)
            if (idx < N_ATT_P) attn_unit(lds, P, 0, idx >> 7, idx & 127, lam);
            else { const int a = idx - N_ATT_P; attn_unit(lds, P, 1 + (a >> 6), (a >> 4) & 3, a & 15, lam); } }
#endif
#ifndef NO_SCAN
#pragma unroll 1
        for (;;) { FETCH(2, N_SHORT) scan_unit<1, 8>(lds, P, 1 + (idx >> 4), (idx >> 3) & 1, idx & 7, 0); }
#endif
#undef FETCH
    }
    xcd_barrier(xbar);
    PH_END(2)
#ifndef NO_POST
    PH_BEGIN(3)
    { NEWPHASE phase_post(lds, P); }
#endif
    xcd_barrier(xbar);
    PH_END(3)
    PH_BEGIN(4)
    { NEWPHASE run_gemm(lds, (const bf16*)P->out, (const bf16*)(ws + WS_WIN) + (size_t)3328 * 1024, NMAIN, 2048, 1024, OpGate{ws}); }
    xcd_barrier(xbar);
    PH_END(4)
    PH_BEGIN(5)
    { NEWPHASE run_gemm(lds, (const bf16*)(ws + WS_R), (const bf16*)(ws + WS_WUPA), NMAIN, 1024, 512, OpUpA{ws}); }
    PH_END(5)
    PH_BEGIN(6)
    { NEWPHASE run_gemm(lds, (const bf16*)(ws + WS_Q), (const bf16*)(ws + WS_WUPB), NMAIN, 1024, 512, OpUpB{ws}); }
    xcd_barrier(xbar);
    PH_END(6)
    PH_BEGIN(7)
    { NEWPHASE run_gemm(lds, (const bf16*)(ws + WS_GB), (const bf16*)(ws + WS_WOUT), NMAIN, 1024, 1024, OpOut{P->in[I_XP], P->in[I_XS], P->out}); }
    xcd_barrier(xbar);
    PH_END(7)
    PH_BEGIN(8)
    { NEWPHASE phase_rms_bf16(P); }
    xcd_barrier(xbar);
    PH_END(8)
    PH_BEGIN(9)
    { NEWPHASE run_gemm(lds, (const bf16*)(ws + WS_MN), (const bf16*)(ws + WS_WFF1), 16384, DFF, 1024, OpFF1{(bf16*)(ws + WS_HID)}); }
    xcd_barrier(xbar);
    PH_END(9)
    PH_BEGIN(10)
    { NEWPHASE run_gemm(lds, (const bf16*)(ws + WS_HID), (const bf16*)(ws + WS_WFF2), 16384, 1024, DFF, OpFF2{P->out}); }
    xcd_barrier(xbar);
    PH_END(10)
    PH_BEGIN(11)
    { NEWPHASE run_gemm(lds, (const bf16*)(ws + WS_MN) + (size_t)16384 * DM, (const bf16*)(ws + WS_WFF1), 16384, DFF, 1024, OpFF1{(bf16*)(ws + WS_HID)}); }
    xcd_barrier(xbar);
    PH_END(11)
    PH_BEGIN(12)
    { NEWPHASE run_gemm(lds, (const bf16*)(ws + WS_HID), (const bf16*)(ws + WS_WFF2), 16384, 1024, DFF, OpFF2{P->out + (size_t)16384 * DM}); }
    xcd_barrier(xbar);
    PH_END(12)
    PH_BEGIN(13)
    { NEWPHASE phase_final(P); }
}

extern "C" void kernel_launch(void* const* d_in, const int* in_sizes, int n_in, void* d_out, int out_size, void* d_ws, size_t ws_size, hipStream_t stream) {
    static int grid_blocks = 0;
    if (grid_blocks == 0) {
        int dev = 0, cus = 0, per_cu = 0;
        hipGetDevice(&dev);
        hipDeviceGetAttribute(&cus, hipDeviceAttributeMultiprocessorCount, dev);
        hipFuncSetAttribute((const void*)fwd_megakernel, hipFuncAttributeMaxDynamicSharedMemorySize, LDS_BYTES);
        hipOccupancyMaxActiveBlocksPerMultiprocessor(&per_cu, (const void*)fwd_megakernel, NTHREADS, LDS_BYTES);
        if (per_cu < 1) { fprintf(stderr, "kernel_launch: occupancy query says %d blocks per CU\n", per_cu); per_cu = 1; }
        grid_blocks = cus * per_cu;
        if (n_in != 29 || ws_size < WS_END) fprintf(stderr, "kernel_launch: unexpected n_in %d / ws_size %zu\n", n_in, ws_size);
    }
    hipMemsetAsync((unsigned char*)d_ws + WS_CTL, 0, 32768, stream);
    Params p{};
    for (int i = 0; i < 29; ++i) p.in[i] = (const float*)d_in[i];
    p.out = (float*)d_out; p.ws = (unsigned char*)d_ws;
    void* args[] = {&p};
    hipError_t e = hipLaunchCooperativeKernel((const void*)fwd_megakernel, dim3(grid_blocks), dim3(NTHREADS), args, LDS_BYTES, stream);
    if (e != hipSuccess) fprintf(stderr, "cooperative launch failed: %s (grid %d)\n", hipGetErrorString(e), grid_blocks);
}
```

```cpp
#include <hip/hip_runtime.h>
#include <hip/hip_cooperative_groups.h>
#include <cstdio>
#include <cstdint>
#include <cmath>
namespace cg = cooperative_groups;
__device__ __forceinline__ int fresh_tid() { int t = threadIdx.x; asm volatile("" : "+v"(t)); return t; }
namespace pg8 {
#define PG8_LAS __attribute__((address_space(3)))
typedef unsigned short bf16_t;
typedef short bf16x8 __attribute__((ext_vector_type(8)));
typedef float f32x4 __attribute__((ext_vector_type(4)));
typedef unsigned u32x4 __attribute__((ext_vector_type(4)));
constexpr int BM = 256, BK = 64, HALF = 128, HTB = HALF * BK * 2  , STAGE_BYTES = 8 * HTB, NXCD = 8, WGM = 8;

__host__ __device__ __forceinline__ int lds_byte(int r, int c) { const int st = (r >> 4) * 2 + (c >> 5), rr = r & 15, cc = c & 31, ob = rr * 64 + cc * 2; return st * 1024 + (ob ^ (((ob >> 9) & 1) << 5)); }
__host__ __device__ __forceinline__ void stage_rc(int b, int& R, int& C) { const int st = b / 1024, sb = b % 1024, swz = sb ^ (((sb >> 9) & 1) << 5); R = (st >> 1) * 16 + swz / 64; C = (st & 1) * 32 + (swz % 64) / 2; }
__host__ __device__ __forceinline__ int perm32(int rho) { const int n = rho >> 4, i = rho & 15; return 8 * (i >> 2) + 4 * n + (i & 3); }

struct Unit { int pm, pn; };
struct Gemm { const bf16_t* A; const bf16_t* Bt; int M, N, K; const bf16_t* A2; int pm2; };
__device__ __forceinline__ const char* gemm_abase(const Gemm& g, int pm, size_t tstep) { return pm >= g.pm2 ? (const char*)g.A2 + (size_t)(pm - g.pm2) * tstep : (const char*)g.A + (size_t)pm * tstep; }

struct StaticOrder {
    int nM, nN, nwg, G, c;
    __host__ __device__ void init(int M, int N, int G_, int c_) { nM = M / BM; nN = N / BM; nwg = nM * nN; G = G_; c = c_; }
    __host__ __device__ bool next(int i, Unit& u) const {
        const long L = (long)i * G + c; if (L >= nwg) return false;
        int wgid = (int)L; { const int q = nwg / NXCD, r = nwg % NXCD, xcd = wgid % NXCD, off = wgid / NXCD; wgid = (xcd < r ? xcd * (q + 1) : r * (q + 1) + (xcd - r) * q) + off; }
        const int nig = WGM * nN, gid = wgid / nig, fm = gid * WGM, gsz = (nM - fm) < WGM ? (nM - fm) : WGM;
        u.pm = fm + ((wgid % nig) % gsz); u.pn = (wgid % nig) / gsz; return true;
    }
    __device__ __forceinline__ void a_ready(const Unit&) const {}
    __device__ __forceinline__ void done(const Unit&) const {}
};


template <class Epi, class Sched, bool ALIGN_EPI = false, bool SP2 = false>
__device__ __forceinline__ void gemm_phase(PG8_LAS unsigned char* lds, const Gemm g, const Sched& S, const Epi& E) {
    const int tid = fresh_tid(), wid = __builtin_amdgcn_readfirstlane(tid >> 6), lane = tid & 63, wr = wid >> 2, wc = wid & 3, fr = lane & 15, fq = lane >> 4;
    const int K = g.K, nt = K / BK;
    unsigned voffA[2], voffB[2];
#pragma unroll
    for (int i = 0; i < 2; ++i) { int R, C; stage_rc(tid * 16 + i * 8192, R, C); const int Rb = Epi::PERM ? ((R & ~31) + perm32(R & 31)) : R;
        voffA[i] = (unsigned)(R * K + C) * 2u; voffB[i] = (unsigned)(Rb * K + C) * 2u; }
    const size_t kstep = (size_t)(BK * 2);
    const size_t hstep = (size_t)HALF * K * 2;
    const size_t tstep = 2 * hstep;
    const unsigned ldsw = (unsigned)wid * 1024u;
    const int aoff = lds_byte(wr * 64 + fr, fq * 8), boff = lds_byte(wc * 32 + fr, fq * 8);
#define PG8_SA(b, h) (((b) * 2 + (h)) * HTB)
#define PG8_SB(b, h) ((4 + (b) * 2 + (h)) * HTB)
#define PG8_STAGE(bufoff, gbase, voff) do { _Pragma("unroll") for (int _i = 0; _i < 2; ++_i) \
        __builtin_amdgcn_global_load_lds((const unsigned*)((const char*)(gbase) + (voff)[_i]), (PG8_LAS unsigned*)(lds + (bufoff) + ldsw + _i * 8192), 16, 0, 0); } while (0)
#define PG8_LDA(dst, b, h) do { _Pragma("unroll") for (int m = 0; m < 4; ++m) _Pragma("unroll") for (int k = 0; k < 2; ++k) dst[m][k] = *(const PG8_LAS bf16x8*)(lds + PG8_SA(b, h) + aoff + m * 2048 + k * 1024); } while (0)
#define PG8_LDB(dst, b, h) do { _Pragma("unroll") for (int n = 0; n < 2; ++n) _Pragma("unroll") for (int k = 0; k < 2; ++k) dst[n][k] = *(const PG8_LAS bf16x8*)(lds + PG8_SB(b, h) + boff + n * 2048 + k * 1024); } while (0)
#define PG8_MMA(ai, bj, At, Bt) do { __builtin_amdgcn_s_setprio(1); _Pragma("unroll") for (int m = 0; m < 4; ++m) _Pragma("unroll") for (int n = 0; n < 2; ++n) _Pragma("unroll") for (int k = 0; k < 2; ++k) \
        acc[ai][bj][m][n] = __builtin_amdgcn_mfma_f32_16x16x32_bf16(Bt[n][k], At[m][k], acc[ai][bj][m][n], 0, 0, 0); __builtin_amdgcn_s_setprio(0); } while (0)
#define PG8_WAIT_V(n) asm volatile("s_waitcnt vmcnt(" #n ")" ::: "memory")
#define PG8_WAIT_L(n) asm volatile("s_waitcnt lgkmcnt(" #n ")" ::: "memory")
#define PG8_BAR __builtin_amdgcn_s_barrier()
#define PG8_SCHED __builtin_amdgcn_sched_barrier(0)
    Unit cur, nxt; int ui = 0;
    if (!S.next(0, cur)) return;
    f32x4 acc[2][2][4][2];
#pragma unroll
    for (int a = 0; a < 2; ++a)
#pragma unroll
        for (int b = 0; b < 2; ++b)
#pragma unroll
            for (int m = 0; m < 4; ++m)
#pragma unroll
                for (int n = 0; n < 2; ++n) acc[a][b][m][n] = (f32x4){0.f, 0.f, 0.f, 0.f};
    bf16x8 At[4][2], B0[2][2], B1[2][2];
    const char* cA = gemm_abase(g, cur.pm, tstep); const char* cB = (const char*)g.Bt + (size_t)cur.pn * tstep;
    S.a_ready(cur);
    if constexpr (SP2) {
        PG8_STAGE(PG8_SB(0, 0), cB, voffB); PG8_STAGE(PG8_SB(0, 1), cB + hstep, voffB); PG8_STAGE(PG8_SA(0, 0), cA, voffA); PG8_STAGE(PG8_SA(0, 1), cA + hstep, voffA);
        if (wr == 1) PG8_BAR;
        PG8_WAIT_V(2); PG8_BAR;
        PG8_STAGE(PG8_SB(1, 0), cB + kstep, voffB); PG8_STAGE(PG8_SA(1, 0), cA + kstep, voffA); PG8_STAGE(PG8_SB(1, 1), cB + hstep + kstep, voffB);
        PG8_WAIT_V(6); PG8_BAR;
    } else {
        PG8_STAGE(PG8_SB(0, 0), cB, voffB); PG8_STAGE(PG8_SA(0, 0), cA, voffA); PG8_STAGE(PG8_SB(0, 1), cB + hstep, voffB); PG8_STAGE(PG8_SA(0, 1), cA + hstep, voffA);
        if (wr == 1) PG8_BAR;
        PG8_WAIT_V(4); PG8_BAR;
        PG8_STAGE(PG8_SB(1, 0), cB + kstep, voffB); PG8_STAGE(PG8_SA(1, 0), cA + kstep, voffA); PG8_STAGE(PG8_SB(1, 1), cB + hstep + kstep, voffB);
        PG8_WAIT_V(6); PG8_BAR;
    }
    for (;;) {
        const bool has_next = S.next(ui + 1, nxt);
        const char* nA = has_next ? gemm_abase(g, nxt.pm, tstep) : cA; const char* nB = has_next ? (const char*)g.Bt + (size_t)nxt.pn * tstep : cB;
        for (int t = 0; t < nt; t += 2) {
            const bool last = (t == nt - 2);
            const char* a1 = cA + (size_t)(t + 1) * kstep;
            const char* a2 = last ? nA : cA + (size_t)(t + 2) * kstep; const char* b2 = last ? nB : cB + (size_t)(t + 2) * kstep;
            const char* a3 = a2 + kstep; const char* b3 = b2 + kstep;
            if (last && has_next) S.a_ready(nxt);
            if constexpr (SP2) {
            PG8_LDB(B0, 0, 0); PG8_LDB(B1, 0, 1); PG8_SCHED; PG8_LDA(At, 0, 0); PG8_STAGE(PG8_SA(1, 1), a1 + hstep, voffA);
            PG8_WAIT_V(8); PG8_WAIT_L(0); PG8_BAR; PG8_MMA(0, 0, At, B0); PG8_MMA(0, 1, At, B1); PG8_BAR; PG8_SCHED;
            PG8_LDA(At, 0, 1); PG8_STAGE(PG8_SB(0, 0), b2, voffB); PG8_STAGE(PG8_SB(0, 1), b2 + hstep, voffB); PG8_STAGE(PG8_SA(0, 0), a2, voffA);
            PG8_WAIT_V(8); PG8_WAIT_L(0); PG8_BAR; PG8_MMA(1, 0, At, B0); PG8_MMA(1, 1, At, B1); PG8_BAR; PG8_SCHED;
            PG8_LDB(B0, 1, 0); PG8_LDB(B1, 1, 1); PG8_SCHED; PG8_LDA(At, 1, 0); PG8_STAGE(PG8_SA(0, 1), a2 + hstep, voffA);
            PG8_WAIT_V(8); PG8_WAIT_L(0); PG8_BAR; PG8_MMA(0, 0, At, B0); PG8_MMA(0, 1, At, B1); PG8_BAR; PG8_SCHED;
            PG8_LDA(At, 1, 1); PG8_STAGE(PG8_SB(1, 0), b3, voffB); PG8_STAGE(PG8_SB(1, 1), b3 + hstep, voffB); PG8_STAGE(PG8_SA(1, 0), a3, voffA);
            PG8_WAIT_V(8); PG8_WAIT_L(0); PG8_BAR; PG8_MMA(1, 0, At, B0); PG8_MMA(1, 1, At, B1); PG8_BAR; PG8_SCHED;
            } else {
            PG8_LDB(B0, 0, 0); PG8_SCHED; PG8_LDA(At, 0, 0); PG8_STAGE(PG8_SA(1, 1), a1 + hstep, voffA);
            PG8_WAIT_L(8); PG8_BAR; PG8_WAIT_L(0); PG8_MMA(0, 0, At, B0); PG8_BAR; PG8_SCHED;
            PG8_LDB(B1, 0, 1); PG8_STAGE(PG8_SB(0, 0), b2, voffB);
            PG8_BAR; PG8_WAIT_L(0); PG8_MMA(0, 1, At, B1); PG8_BAR;
            PG8_LDA(At, 0, 1); PG8_STAGE(PG8_SA(0, 0), a2, voffA);
            PG8_BAR; PG8_WAIT_L(0); PG8_MMA(1, 0, At, B0); PG8_BAR; PG8_SCHED;
            PG8_STAGE(PG8_SB(0, 1), b2 + hstep, voffB);
            PG8_WAIT_V(6); PG8_BAR; PG8_MMA(1, 1, At, B1); PG8_BAR;
            PG8_LDB(B0, 1, 0); PG8_SCHED; PG8_LDA(At, 1, 0); PG8_STAGE(PG8_SA(0, 1), a2 + hstep, voffA);
            PG8_WAIT_L(8); PG8_BAR; PG8_WAIT_L(0); PG8_MMA(0, 0, At, B0); PG8_BAR; PG8_SCHED;
            PG8_LDB(B1, 1, 1); PG8_STAGE(PG8_SB(1, 0), b3, voffB);
            PG8_BAR; PG8_WAIT_L(0); PG8_MMA(0, 1, At, B1); PG8_BAR;
            PG8_LDA(At, 1, 1); PG8_STAGE(PG8_SA(1, 0), a3, voffA);
            PG8_BAR; PG8_WAIT_L(0); PG8_MMA(1, 0, At, B0); PG8_BAR; PG8_SCHED;
            PG8_STAGE(PG8_SB(1, 1), b3 + hstep, voffB);
            PG8_WAIT_V(6); PG8_BAR; PG8_MMA(1, 1, At, B1); PG8_BAR;
            }
        }
        if constexpr (ALIGN_EPI) { if (wr == 0) PG8_BAR; }
        if constexpr (!Epi::AFTER_DRAIN) { E(acc, cur, wr, wc, fr, fq); S.done(cur); }
        if (!has_next) break;
#pragma unroll
        for (int a = 0; a < 2; ++a)
#pragma unroll
            for (int b = 0; b < 2; ++b)
#pragma unroll
                for (int m = 0; m < 4; ++m)
#pragma unroll
                    for (int n = 0; n < 2; ++n) acc[a][b][m][n] = (f32x4){0.f, 0.f, 0.f, 0.f};
        cur = nxt; cA = nA; cB = nB; ++ui;
        if constexpr (ALIGN_EPI) { if (wr == 1) PG8_BAR; }
    }
    PG8_WAIT_V(0);
    if constexpr (!ALIGN_EPI) { if (wr == 0) PG8_BAR; }
    PG8_BAR;
    if constexpr (Epi::AFTER_DRAIN) { E.fused(acc, cur, wr, wc, fr, fq, lds, wid, lane); S.done(cur); }
#undef PG8_SA
#undef PG8_SB
#undef PG8_STAGE
#undef PG8_LDA
#undef PG8_LDB
#undef PG8_MMA
#undef PG8_WAIT_V
#undef PG8_WAIT_L
#undef PG8_BAR
#undef PG8_SCHED
}
}

#ifndef PG8_SP2
#define PG8_SP2 true
#endif

#define LAS __attribute__((address_space(3)))
typedef unsigned short bf16;
typedef short bf16x8 __attribute__((ext_vector_type(8)));
typedef float f32x4 __attribute__((ext_vector_type(4)));
typedef float f32x16 __attribute__((ext_vector_type(16)));
typedef unsigned u32x4 __attribute__((ext_vector_type(4)));
typedef unsigned u32x2 __attribute__((ext_vector_type(2)));

constexpr int DM = 1024, NMAIN = 32768, ROWS = 33024, METAROW = 32768, DFF = 4096;
constexpr int NTHREADS = 512;
constexpr int LDS_BYTES = 147456;
constexpr int LDS_ITEM_OFF = LDS_BYTES - 16;
constexpr size_t MiB = 1u << 20;
constexpr size_t WS_CTL = 0, WS_WIN = 1 * MiB, WS_WUPA = 12 * MiB, WS_WUPB = 13 * MiB, WS_WOUT = 14 * MiB, WS_WFF1 = 16 * MiB, WS_WFF2 = 24 * MiB;
constexpr size_t WS_LORA = 32 * MiB, WS_XNMETA = 32 * MiB + 512 * 1024, WS_CB = 33 * MiB, WS_ACT = 36 * MiB;
constexpr size_t ACT_SZ = (size_t)ROWS * 512 * 2, L_SZ = (size_t)ROWS * 256 * 2;
constexpr size_t WS_R = WS_ACT, WS_KA = WS_R + ACT_SZ, WS_VA = WS_KA + ACT_SZ, WS_L = WS_VA + ACT_SZ, WS_Q = WS_L + L_SZ, WS_KB = WS_Q + ACT_SZ, WS_VT = WS_KB + ACT_SZ, WS_END = WS_VT + ACT_SZ;
constexpr size_t WS_GA = WS_KA, WS_GB = WS_KB, WS_MN = WS_ACT, WS_HID = WS_ACT + 64 * MiB;
static_assert(WS_END <= 256 * MiB && WS_HID + 128 * MiB <= 256 * MiB && WS_CB + (size_t)2 * ROWS * 8 * 4 <= WS_ACT, "ws map");
constexpr float LOG2E = 1.4426950408889634f;
constexpr float QSCALE = 0.125f * LOG2E;

struct Params { const float* in[29]; float* out; unsigned char* ws; };
typedef const __attribute__((address_space(4))) Params* KP;
enum { I_XP = 0, I_XS, I_META, I_GMIX, I_WIN, I_MUP, I_MUN, I_W0, I_WUP, I_A0, I_AUP, I_GUP, I_KK, I_KA, I_RK, I_LNW, I_LNB, I_LQ1, I_LK1, I_LQ2, I_LK2, I_SUBG, I_UPA, I_UPB, I_WOUT, I_GFFN, I_FF1, I_FF2, I_GFIN };

__device__ __forceinline__ unsigned cvtpk(float lo, float hi) { unsigned r; asm volatile("v_cvt_pk_bf16_f32 %0, %1, %2" : "=v"(r) : "v"(lo), "v"(hi)); return r; }
__device__ __forceinline__ float bf2f(unsigned short b) { return __uint_as_float(((unsigned)b) << 16); }
__device__ __forceinline__ float bflo(unsigned w) { return __uint_as_float(w << 16); }
__device__ __forceinline__ float bfhi(unsigned w) { return __uint_as_float(w & 0xffff0000u); }
__device__ __forceinline__ void unpack8(const u32x4 v, float* o) { o[0] = bflo(v.x); o[1] = bfhi(v.x); o[2] = bflo(v.y); o[3] = bfhi(v.y); o[4] = bflo(v.z); o[5] = bfhi(v.z); o[6] = bflo(v.w); o[7] = bfhi(v.w); }
__device__ __forceinline__ float wave_sum(float v) {
#pragma unroll
    for (int o = 1; o < 64; o <<= 1) v += __shfl_xor(v, o);
    return v;
}
__device__ __forceinline__ float sigmoidf_(float x) { return 1.0f / (1.0f + __expf(-x)); }
__device__ __forceinline__ int seq_base(int s) { return s == 0 ? 0 : 16384 + (s - 1) * 2048; }
__device__ __forceinline__ int seq_len(int s) { return s == 0 ? 16384 : 2048; }
__device__ __forceinline__ int pos_row(int base, int p) { return p < 16 ? METAROW + p : base + p - 16; }

template <class Op> struct Epi8 {
    static constexpr bool PERM = true, AFTER_DRAIN = false;
    Op op;
    __device__ __forceinline__ void operator()(const pg8::f32x4 (&acc)[2][2][4][2], const pg8::Unit& u, int wr, int wc, int fr, int fq) const {
        const int row0 = u.pm * 256 + wr * 64 + fr, col0 = u.pn * 256 + wc * 32 + 8 * fq;
#pragma unroll
        for (int ai = 0; ai < 2; ++ai)
#pragma unroll
            for (int m = 0; m < 4; ++m)
#pragma unroll
                for (int bj = 0; bj < 2; ++bj) { op.apply(row0 + ai * 128 + m * 16, col0 + bj * 128, u.pn, acc[ai][bj][m][0], acc[ai][bj][m][1]); asm volatile("" ::: "memory"); }
    }
};
__device__ __forceinline__ u32x4 pack8(const f32x4 a, const f32x4 b) { u32x4 w; w.x = cvtpk(a[0], a[1]); w.y = cvtpk(a[2], a[3]); w.z = cvtpk(b[0], b[1]); w.w = cvtpk(b[2], b[3]); return w; }

constexpr int CW_KN = 320;
__device__ __forceinline__ float dpp_max16(float v) {
    int x = __float_as_int(v);
    v = fmaxf(v, __int_as_float(__builtin_amdgcn_update_dpp(0, x, 0xB1, 0xf, 0xf, true))); x = __float_as_int(v);
    v = fmaxf(v, __int_as_float(__builtin_amdgcn_update_dpp(0, x, 0x4E, 0xf, 0xf, true))); x = __float_as_int(v);
    v = fmaxf(v, __int_as_float(__builtin_amdgcn_update_dpp(0, x, 0x141, 0xf, 0xf, true))); x = __float_as_int(v);
    v = fmaxf(v, __int_as_float(__builtin_amdgcn_update_dpp(0, x, 0x140, 0xf, 0xf, true)));
    return v;
}
struct OpProj {
    unsigned char* ws;
    __device__ __forceinline__ void apply(int row, int col, int pn, f32x4 v0, f32x4 v1) const {
        if (pn >= 11) {
            bf16* VT = (bf16*)(ws + WS_VT); const int c = col - 11 * 256;
#pragma unroll
            for (int e = 0; e < 4; ++e) { VT[(size_t)(c + e) * ROWS + row] = (bf16)(cvtpk(v0[e], 0.f) & 0xffffu); VT[(size_t)(c + 4 + e) * ROWS + row] = (bf16)(cvtpk(v1[e], 0.f) & 0xffffu); }
            return;
        }
        bf16* O; int ldc = 512, c;
        if (pn < 2) { O = (bf16*)(ws + WS_R); c = col; }
        else if (pn < 4) { O = (bf16*)(ws + WS_KA); c = col - 512; }
        else if (pn < 6) { O = (bf16*)(ws + WS_VA); c = col - 1024; }
        else if (pn < 7) { O = (bf16*)(ws + WS_L); c = col - 1536; ldc = 256; }
        else if (pn < 9) { O = (bf16*)(ws + WS_Q); c = col - 1792; v0 = v0 * QSCALE; v1 = v1 * QSCALE; }
        else { O = (bf16*)(ws + WS_KB); c = col - 2304; }
        const u32x4 w = pack8(v0, v1);
        *(u32x4*)(O + (size_t)row * ldc + c) = w;
        if (pn >= 9) {
            float k8[8]; unpack8(w, k8); float ss = 0.f;
#pragma unroll
            for (int e = 0; e < 8; ++e) ss = fmaf(k8[e], k8[e], ss);
            ss = dpp_max16(ss);
            if ((threadIdx.x & 15) == 0) { const int sidx = row < 16384 ? 0 : row < NMAIN ? 1 + ((row - 16384) >> 11) : 9;
                atomicMax((unsigned*)(ws + WS_CTL) + CW_KN + sidx * 64 + (c >> 3), __float_as_uint(ss)); }
        }
    }
};
struct OpGate {
    unsigned char* ws;
    __device__ __forceinline__ void apply(int row, int col, int pn, f32x4 v0, f32x4 v1) const {
        bf16* O = (bf16*)(ws + (pn < 4 ? WS_GA : WS_GB)); const int c = pn < 4 ? col : col - 1024;
#pragma unroll
        for (int e = 0; e < 4; ++e) { v0[e] = sigmoidf_(v0[e]); v1[e] = sigmoidf_(v1[e]); }
        *(u32x4*)(O + (size_t)row * 1024 + c) = pack8(v0, v1);
    }
};
struct OpUpA {
    unsigned char* ws;
    __device__ __forceinline__ void apply(int row, int col, int pn, f32x4 v0, f32x4 v1) const {
        u32x4* p = (u32x4*)((bf16*)(ws + WS_GA) + (size_t)row * 1024 + col); float g[8]; unpack8(*p, g);
#pragma unroll
        for (int e = 0; e < 4; ++e) { v0[e] *= g[e]; v1[e] *= g[4 + e]; }
        *p = pack8(v0, v1);
    }
};
struct OpUpB {
    unsigned char* ws;
    __device__ __forceinline__ void apply(int row, int col, int pn, f32x4 v0, f32x4 v1) const {
        u32x4* p = (u32x4*)((bf16*)(ws + WS_GB) + (size_t)row * 1024 + col); float g[8], a[8]; unpack8(*p, g);
        unpack8(*(const u32x4*)((const bf16*)(ws + WS_GA) + (size_t)row * 1024 + col), a);
#pragma unroll
        for (int e = 0; e < 4; ++e) { v0[e] = a[e] + v0[e] * g[e]; v1[e] = a[4 + e] + v1[e] * g[4 + e]; }
        *p = pack8(v0, v1);
    }
};
struct OpOut {
    const float* xp; const float* xs; float* out;
    __device__ __forceinline__ void apply(int row, int col, int pn, f32x4 v0, f32x4 v1) const {
        const float* x = (row < 16384 ? xp + (size_t)row * DM : xs + (size_t)(row - 16384) * DM) + col;
        float* o = out + (size_t)row * DM + col;
        *(f32x4*)o = *(const f32x4*)x + v0; *(f32x4*)(o + 4) = *(const f32x4*)(x + 4) + v1;
    }
};
struct OpFF1 {
    bf16* hid;
    __device__ __forceinline__ void apply(int row, int col, int pn, f32x4 v0, f32x4 v1) const {
#pragma unroll
        for (int e = 0; e < 4; ++e) { const float a = fmaxf(v0[e], 0.f), b = fmaxf(v1[e], 0.f); v0[e] = a * a; v1[e] = b * b; }
        *(u32x4*)(hid + (size_t)row * DFF + col) = pack8(v0, v1);
    }
};
struct OpFF2 {
    float* out;
    __device__ __forceinline__ void apply(int row, int col, int pn, f32x4 v0, f32x4 v1) const {
        float* o = out + (size_t)row * DM + col;
        *(f32x4*)o = *(const f32x4*)o + v0; *(f32x4*)(o + 4) = *(const f32x4*)(o + 4) + v1;
    }
};

__device__ __forceinline__ unsigned f2bf_rne(float f) { return cvtpk(f, 0.f) & 0xffffu; }
__device__ __forceinline__ void transpose_item(const float* W, int K, int N, bf16* WT, LAS float* scr, int item, int lane) {
    const int nblk = N / 32, kb = item / nblk, nb = item % nblk, k0 = 64 * kb, n0 = 32 * nb;
#pragma unroll 8
    for (int i = 0; i < 32; ++i) { const int kk = 2 * i + (lane >> 5); scr[kk * 33 + (lane & 31)] = W[(size_t)(k0 + kk) * N + n0 + (lane & 31)]; }
    asm volatile("s_waitcnt vmcnt(0) lgkmcnt(0)" ::: "memory");
    const int c = lane & 7;
#pragma unroll
    for (int j = 0; j < 4; ++j) { const int n = (lane >> 3) + 8 * j; const LAS float* s = scr + (8 * c) * 33 + n;
        u32x4 o; o.x = cvtpk(s[0 * 33], s[1 * 33]); o.y = cvtpk(s[2 * 33], s[3 * 33]); o.z = cvtpk(s[4 * 33], s[5 * 33]); o.w = cvtpk(s[6 * 33], s[7 * 33]);
        *(u32x4*)(WT + (size_t)(n0 + n) * K + k0 + 8 * c) = o; }
    asm volatile("s_waitcnt lgkmcnt(0)" ::: "memory");
}
__device__ __forceinline__ void rms_row_bf16(const float* src, const float* g, bf16* dst, int lane) {
    unsigned long long* o8 = (unsigned long long*)dst + lane;
    if (!src) {
#pragma unroll
        for (int j = 0; j < 4; ++j) o8[64 * j] = 0ull;
        return; }
    const f32x4* xr = (const f32x4*)src + lane; const f32x4* gr = (const f32x4*)g + lane;
    f32x4 v[4]; float s = 0.f;
#pragma unroll
    for (int j = 0; j < 4; ++j) { v[j] = xr[64 * j]; s += (v[j].x * v[j].x + v[j].y * v[j].y) + (v[j].z * v[j].z + v[j].w * v[j].w); }
    const float rstd = rsqrtf(wave_sum(s) * (1.f / DM) + 1e-6f);
#pragma unroll
    for (int j = 0; j < 4; ++j) { const f32x4 gg = gr[64 * j]; const f32x4 y = v[j] * rstd * gg;
        o8[64 * j] = (unsigned long long)cvtpk(y.x, y.y) | ((unsigned long long)cvtpk(y.z, y.w) << 32); }
}
__device__ __forceinline__ void phase_prologue(LAS unsigned char* lds, KP P) {
    const int tid = fresh_tid(), lane = tid & 63, wid = tid >> 6;
    LAS float* scr = (LAS float*)(lds + wid * 16384);
    const int gw = blockIdx.x * 8 + wid, NGW = gridDim.x * 8;
    unsigned char* ws = P->ws;
    constexpr int I_IN = (1024 / 64) * (5376 / 32), I_UP = (512 / 64) * (1024 / 32), I_O = (1024 / 64) * (1024 / 32), I_1 = (1024 / 64) * (4096 / 32), I_2 = (4096 / 64) * (1024 / 32);
    constexpr int I_LW = (64 / 64) * (512 / 32), I_G = (128 / 64) * (512 / 32);
    constexpr int NITEMS = I_IN + 2 * I_UP + I_O + I_1 + I_2 + 4 * I_LW + I_G;
    for (int it = gw; it < NITEMS; it += NGW) {
        int r = it;
        if (r < I_IN) { transpose_item(P->in[I_WIN], 1024, 5376, (bf16*)(ws + WS_WIN), scr, r, lane); continue; } r -= I_IN;
        if (r < I_UP) { transpose_item(P->in[I_UPA], 512, 1024, (bf16*)(ws + WS_WUPA), scr, r, lane); continue; } r -= I_UP;
        if (r < I_UP) { transpose_item(P->in[I_UPB], 512, 1024, (bf16*)(ws + WS_WUPB), scr, r, lane); continue; } r -= I_UP;
        if (r < I_O) { transpose_item(P->in[I_WOUT], 1024, 1024, (bf16*)(ws + WS_WOUT), scr, r, lane); continue; } r -= I_O;
        if (r < I_1) { transpose_item(P->in[I_FF1], 1024, 4096, (bf16*)(ws + WS_WFF1), scr, r, lane); continue; } r -= I_1;
        if (r < I_2) { transpose_item(P->in[I_FF2], 4096, 1024, (bf16*)(ws + WS_WFF2), scr, r, lane); continue; } r -= I_2;
        if (r < 2 * I_LW) { const int d = r / I_LW; transpose_item(P->in[I_WUP] + (size_t)d * 64 * 512, 64, 512, (bf16*)(ws + WS_LORA) + (size_t)d * 512 * 64, scr, r % I_LW, lane); continue; } r -= 2 * I_LW;
        if (r < 2 * I_LW) { const int d = r / I_LW; transpose_item(P->in[I_AUP] + (size_t)d * 64 * 512, 64, 512, (bf16*)(ws + WS_LORA + 131072) + (size_t)d * 512 * 64, scr, r % I_LW, lane); continue; } r -= 2 * I_LW;
        transpose_item(P->in[I_GUP], 128, 512, (bf16*)(ws + WS_LORA + 262144), scr, r, lane);
    }
    bf16* XN = (bf16*)P->out; bf16* XM = (bf16*)(ws + WS_XNMETA);
    for (int m = gw; m < ROWS; m += NGW) {
        const float* src = m < 16384 ? P->in[I_XP] + (size_t)m * DM : m < NMAIN ? P->in[I_XS] + (size_t)(m - 16384) * DM : (m - NMAIN < 16 ? P->in[I_META] + (size_t)(m - NMAIN) * DM : nullptr);
        bf16* dst = m < NMAIN ? XN + (size_t)m * DM : XM + (size_t)(m - NMAIN) * DM;
        rms_row_bf16(src, P->in[I_GMIX], dst, lane);
    }
}

constexpr int AT_KSTR = 272, AT_VSTR = 144, AT_KSZ = 64 * AT_KSTR, AT_BUF = AT_KSZ + 128 * AT_VSTR;
__device__ __forceinline__ f32x16 mfma32(bf16x8 a, bf16x8 b, f32x16 c) { return __builtin_amdgcn_mfma_f32_32x32x16_bf16(a, b, c, 0, 0, 0); }
__device__ __forceinline__ void attn_unit(LAS unsigned char* lds, KP P, int s, int h, int qb, float lam) {
    int tid_ = threadIdx.x; asm volatile("" : "+v"(tid_));
    const int tid = tid_, lane = tid & 63, r32 = lane & 31, hi = lane >> 5, wid = __builtin_amdgcn_readfirstlane(tid >> 6), rg = wid & 3, mp = wid >> 2;
    const int L = seq_len(s), base = seq_base(s), NT = 1 + L / 64;
    unsigned char* ws = P->ws;
    const bf16* KB = (const bf16*)(ws + WS_KB); const bf16* VT = (const bf16*)(ws + WS_VT); bf16* Q = (bf16*)(ws + WS_Q);
    const int qrow = base + qb * 128 + rg * 32 + r32;
    bf16x8 q[4];
#pragma unroll
    for (int d0 = 0; d0 < 4; ++d0) q[d0] = *(const bf16x8*)(Q + (size_t)qrow * 512 + h * 128 + mp * 64 + d0 * 16 + hi * 8);
    f32x16 O[4];
#pragma unroll
    for (int b = 0; b < 4; ++b)
#pragma unroll
        for (int r = 0; r < 16; ++r) O[b][r] = 0.f;
    float mx = -INFINITY, ls = 0.f;
    const float qh = (float)(16 + qb * 128 + rg * 32 + r32 - 4 * hi);
    const float nslope = -exp2f(-2.0f * (float)(h + 1)) * LOG2E;
    const int kr0 = tid >> 4, kc = tid & 15, vn0 = tid >> 3, vc = tid & 7;
    u32x4 kreg[2], vreg[2];
    const unsigned kgo = (unsigned)((kr0 * 512 + h * 128 + kc * 8) * 2), vgo = (unsigned)(((h * 128 + vn0) * ROWS + vc * 8) * 2);
    const unsigned klo = (unsigned)(kr0 * AT_KSTR + kc * 16), vlo = (unsigned)(AT_KSZ + vn0 * AT_VSTR + vc * 16);
#define AT_GLOAD(j) do { const int m0_ = (j) == 0 ? METAROW : base + 64 * ((j) - 1); \
        const unsigned char* kt_ = (const unsigned char*)KB + (size_t)m0_ * 1024; const unsigned char* vt_ = (const unsigned char*)VT + (size_t)m0_ * 2; \
        kreg[0] = *(const u32x4*)(kt_ + kgo); kreg[1] = *(const u32x4*)(kt_ + 32 * 1024 + kgo); \
        vreg[0] = *(const u32x4*)(vt_ + vgo); vreg[1] = *(const u32x4*)(vt_ + (size_t)64 * ROWS * 2 + vgo); } while (0)
#define AT_LSTORE(buf) do { LAS unsigned char* kb_ = lds + (buf) * AT_BUF; \
        *(LAS u32x4*)(kb_ + klo) = kreg[0]; *(LAS u32x4*)(kb_ + klo + 32 * AT_KSTR) = kreg[1]; \
        *(LAS u32x4*)(kb_ + vlo) = vreg[0]; *(LAS u32x4*)(kb_ + vlo + 64 * AT_VSTR) = vreg[1]; } while (0)
    float qn, kn;
    { float ssq = 0.f;
#pragma unroll
      for (int d0 = 0; d0 < 4; ++d0) { float t[8]; unpack8(__builtin_bit_cast(u32x4, q[d0]), t);
#pragma unroll
        for (int e = 0; e < 8; ++e) ssq = fmaf(t[e], t[e], ssq); }
      ssq += __shfl_xor(ssq, 32); qn = sqrtf(ssq) * 1.002f;
      const unsigned* KN = (const unsigned*)(ws + WS_CTL) + CW_KN; float ks = 0.f;
#pragma unroll
      for (int g = 0; g < 8; ++g) ks += fmaxf(__uint_as_float(__hip_atomic_load(KN + s * 64 + h * 16 + mp * 8 + g, __ATOMIC_RELAXED, __HIP_MEMORY_SCOPE_AGENT)), __uint_as_float(__hip_atomic_load(KN + 9 * 64 + h * 16 + mp * 8 + g, __ATOMIC_RELAXED, __HIP_MEMORY_SCOPE_AGENT)));
      kn = sqrtf(ks) * 1.002f; }
    const int jc0 = 1 + qb * 2;
    int jlo = jc0, jhi = jc0 + 1;
    LAS float* red = (LAS float*)(lds + 2 * AT_BUF);
#pragma unroll 1
    for (int ph = 0; ph < 2; ++ph) {
        int nleft, ntl;
        if (ph == 0) { nleft = 0; ntl = 2; }
        else {
            float dneed = (qn * kn - mx + 40.0f) / (-nslope);
#pragma unroll
            for (int o = 1; o < 64; o <<= 1) dneed = fmaxf(dneed, __shfl_xor(dneed, o));
            if (lane == 0) red[wid] = dneed;
            __syncthreads();
            float dm = red[0];
#pragma unroll
            for (int w8 = 1; w8 < 8; ++w8) dm = fmaxf(dm, red[w8]);
            dm = fminf(fmaxf(dm, 0.f), 1.0e6f);
            const int dmax = (int)dm + 1, q0 = 16 + qb * 128;
            const int plo = q0 - dmax, phi = q0 + 127 + dmax;
            jlo = plo < 16 ? 0 : 1 + ((plo - 16) >> 6); jhi = phi >= L + 16 ? NT - 1 : 1 + ((phi - 16) >> 6);
            if (jlo > jc0) jlo = jc0; if (jhi < jc0 + 1) jhi = jc0 + 1;
            nleft = jc0 - jlo; ntl = nleft + (jhi - jc0 - 1);
        }
        if (ntl > 0) {
#define AT_J(t) (ph == 0 ? jc0 + (t) : ((t) < nleft ? jlo + (t) : jc0 + 2 + ((t) - nleft)))
        { const int jf = AT_J(0); AT_GLOAD(jf); } AT_LSTORE(0); __syncthreads();
#pragma unroll 1
        for (int t = 0; t < ntl; ++t) {
            const int j = AT_J(t);
            if (t + 1 < ntl) { const int jn = AT_J(t + 1); AT_GLOAD(jn); }
            const LAS unsigned char* Kb = lds + (t & 1) * AT_BUF + mp * 128; const LAS unsigned char* Vb = lds + (t & 1) * AT_BUF + AT_KSZ;
            const float dq = qh - (float)(j == 0 ? 0 : 64 * j - 48);
            f32x16 p0, p1;
#pragma unroll
            for (int r = 0; r < 16; ++r) { p0[r] = 0.f; p1[r] = 0.f; }
#pragma unroll
            for (int d0 = 0; d0 < 4; ++d0) {
                const bf16x8 a0 = *(const LAS bf16x8*)(Kb + r32 * AT_KSTR + d0 * 32 + hi * 16);
                const bf16x8 a1 = *(const LAS bf16x8*)(Kb + (32 + r32) * AT_KSTR + d0 * 32 + hi * 16);
                p0 = mfma32(a0, q[d0], p0); p1 = mfma32(a1, q[d0], p1);
            }
#pragma unroll
            for (int r = 0; r < 16; ++r) { const float dd = dq - (float)((r & 3) + 8 * (r >> 2)); p0[r] = fmaf(fabsf(dd), nslope, p0[r]); p1[r] = fmaf(fabsf(dd - 32.f), nslope, p1[r]); }
            if (j == 0) {
#pragma unroll
                for (int r = 0; r < 16; ++r) { if ((r & 3) + 8 * (r >> 2) + 4 * hi >= 16) p0[r] = -INFINITY; p1[r] = -INFINITY; }
            }
            float rm = fmaxf(p0[0], p1[0]);
#pragma unroll
            for (int r = 1; r < 16; ++r) rm = fmaxf(rm, fmaxf(p0[r], p1[r]));
            rm = fmaxf(rm, __shfl_xor(rm, 32));
            const float mn = fmaxf(mx, rm);
            if (__any(mn > mx)) {
                const float f = __builtin_amdgcn_exp2f(mx - mn); ls *= f; mx = mn;
#pragma unroll
                for (int b = 0; b < 4; ++b)
#pragma unroll
                    for (int r = 0; r < 16; ++r) O[b][r] *= f;
            }
            float sum = 0.f;
#pragma unroll
            for (int r = 0; r < 16; ++r) { p0[r] = __builtin_amdgcn_exp2f(p0[r] - mx); p1[r] = __builtin_amdgcn_exp2f(p1[r] - mx); sum += p0[r] + p1[r]; }
            ls += sum;
            bf16x8 pf[4];
#pragma unroll
            for (int k2 = 0; k2 < 2; ++k2) {
                u32x4 w0, w1;
                w0.x = cvtpk(p0[8 * k2 + 0], p0[8 * k2 + 1]); w0.y = cvtpk(p0[8 * k2 + 2], p0[8 * k2 + 3]); w0.z = cvtpk(p0[8 * k2 + 4], p0[8 * k2 + 5]); w0.w = cvtpk(p0[8 * k2 + 6], p0[8 * k2 + 7]);
                w1.x = cvtpk(p1[8 * k2 + 0], p1[8 * k2 + 1]); w1.y = cvtpk(p1[8 * k2 + 2], p1[8 * k2 + 3]); w1.z = cvtpk(p1[8 * k2 + 4], p1[8 * k2 + 5]); w1.w = cvtpk(p1[8 * k2 + 6], p1[8 * k2 + 7]);
                pf[k2] = __builtin_bit_cast(bf16x8, w0); pf[2 + k2] = __builtin_bit_cast(bf16x8, w1);
            }
#pragma unroll
            for (int ks = 0; ks < 4; ++ks)
#pragma unroll
                for (int b = 0; b < 4; ++b) {
                    const LAS unsigned char* vp = Vb + (b * 32 + r32) * AT_VSTR + ks * 32 + hi * 8;
                    const u32x2 lo = *(const LAS u32x2*)vp, hh = *(const LAS u32x2*)(vp + 16);
                    u32x4 vv; vv.x = lo.x; vv.y = lo.y; vv.z = hh.x; vv.w = hh.y;
                    O[b] = mfma32(__builtin_bit_cast(bf16x8, vv), pf[ks], O[b]);
                }
            if (t + 1 < ntl) AT_LSTORE((t + 1) & 1);
            __syncthreads();
        }
#undef AT_J
        }
    }
#undef AT_GLOAD
#undef AT_LSTORE
    const float lt = ls + __shfl_xor(ls, 32);
    const float inv = (mp ? lam : 1.0f) / lt;
    int lane2 = lane; asm volatile("" : "+v"(lane2));
    const int r32e = lane2 & 31, hie = lane2 >> 5;
    LAS float* ex = (LAS float*)lds + rg * (128 * 32) + hie * 128 + r32e;
    if (mp == 1) {
#pragma unroll
        for (int b = 0; b < 4; ++b)
#pragma unroll
            for (int r = 0; r < 16; ++r) ex[(32 * b + (r & 3) + 8 * (r >> 2)) * 32] = O[b][r] * inv;
    }
    __syncthreads();
    if (mp == 0) {
        float ss = 0.f;
#pragma unroll
        for (int b = 0; b < 4; ++b)
#pragma unroll
            for (int r = 0; r < 16; ++r) { const float o = O[b][r] * inv - ex[(32 * b + (r & 3) + 8 * (r >> 2)) * 32]; O[b][r] = o; ss += o * o; }
        ss += __shfl_xor(ss, 32);
        const float rstd = rsqrtf(ss * (1.0f / 128.0f) + 1e-5f) * 0.8f;
        const float* sg = P->in[I_SUBG] + 4 * hie; bf16* Qo = Q + (size_t)(base + qb * 128 + rg * 32 + r32e) * 512 + h * 128 + 4 * hie;
#pragma unroll
        for (int b = 0; b < 4; ++b)
#pragma unroll
            for (int r4 = 0; r4 < 4; ++r4) {
                const int n = 32 * b + 8 * r4; const f32x4 g = *(const f32x4*)(sg + n);
                u32x2 w; w.x = cvtpk(O[b][4 * r4 + 0] * rstd * g.x, O[b][4 * r4 + 1] * rstd * g.y); w.y = cvtpk(O[b][4 * r4 + 2] * rstd * g.z, O[b][4 * r4 + 3] * rstd * g.w);
                *(u32x2*)(Qo + n) = w;
            }
    }
    __syncthreads();
}

constexpr int SC_R = 0, SC_K = 16384, SC_V = 32768, SC_W = 49152, SC_B = 65536, SC_KK = 81920, SC_Y = 98304, SC_TW = 114688, SC_AD = 123904, SC_MU = 133120;
__device__ __forceinline__ float dpp_add(float v, int ctrl_id) {
    const int x = __float_as_int(v); int y;
    if (ctrl_id == 0) y = __builtin_amdgcn_update_dpp(0, x, 0xB1, 0xf, 0xf, true);
    else if (ctrl_id == 1) y = __builtin_amdgcn_update_dpp(0, x, 0x4E, 0xf, 0xf, true);
    else if (ctrl_id == 2) y = __builtin_amdgcn_update_dpp(0, x, 0x141, 0xf, 0xf, true);
    else y = __builtin_amdgcn_update_dpp(0, x, 0x140, 0xf, 0xf, true);
    return v + __int_as_float(y);
}
template <int LPR> __device__ __forceinline__ float grp_sum(float v) {
    v = dpp_add(v, 0); v = dpp_add(v, 1); v = dpp_add(v, 2);
    if (LPR == 16) v = dpp_add(v, 3);
    return v;
}
#define BAR_LDS() asm volatile("s_waitcnt lgkmcnt(0)\n\ts_barrier" ::: "memory")
__device__ __forceinline__ float fast_sigmoid(float x) { return __builtin_amdgcn_rcpf(1.0f + __builtin_amdgcn_exp2f(-LOG2E * x)); }
__device__ __forceinline__ float fast_tanh(float x) { return 1.0f - 2.0f * __builtin_amdgcn_rcpf(1.0f + __builtin_amdgcn_exp2f(2.0f * LOG2E * x)); }
template <int NRP, int NSW>
__device__ __forceinline__ void scan_unit(LAS unsigned char* lds, KP P, int s, int d, int h, int rp) {
    constexpr int RPB = 64 / NRP, RPW = RPB / NSW, LPR = 64 / RPW, CPL = 64 / LPR;
    static_assert(LPR == 8 || LPR == 16, "scan geometry");
    int tid_ = threadIdx.x; asm volatile("" : "+v"(tid_));
    const int tid = tid_, lane = tid & 63, wid = __builtin_amdgcn_readfirstlane(tid >> 6);
    const int L = seq_len(s), base = seq_base(s), Ltot = L + 16, nchunk = (Ltot + 63) / 64;
    unsigned char* ws = P->ws;
    const bf16* Rb = (const bf16*)(ws + WS_R); const bf16* KAb = (const bf16*)(ws + WS_KA); const bf16* VAb = (const bf16*)(ws + WS_VA); const bf16* Lb = (const bf16*)(ws + WS_L);
    float* CB = (float*)(ws + WS_CB); bf16* YD = (bf16*)((unsigned char*)P->out + 64 * MiB) + (size_t)d * NMAIN * 512;
    LAS float* fS = (LAS float*)lds; LAS float* fV = (LAS float*)(lds + 81920); LAS float* fY = (LAS float*)(lds + SC_Y); LAS float* fMU = (LAS float*)(lds + SC_MU);
#define SCI(sl_, a_, c_) ((sl_) * 320 + (a_) * 64 + (c_))
    for (int i = tid; i < 832; i += NTHREADS) {
        float v;
        if (i < 640) { const int which = i / 320, jj = i % 320, a = jj >> 6, c = jj & 63; const int gi = a < 3 ? a * 512 + h * 64 + c : 1536 + (a - 3) * 64 + c; v = P->in[which ? I_MUN : I_MUP][gi]; }
        else { const int a = (i - 640) >> 6, c = (i - 640) & 63; v = P->in[a == 0 ? I_KK : a == 1 ? I_KA : I_RK][h * 64 + c]; }
        fMU[i] = v;
    }
    const int mat = wid >> 2, ntile = wid & 3;
    const bf16* Wt = (const bf16*)(ws + WS_LORA + (mat ? 131072 : 0)) + ((size_t)d * 512 + h * 64 + ntile * 16 + (lane & 15)) * 64 + (lane >> 4) * 8;
    const bf16x8 bfr0 = *(const bf16x8*)Wt, bfr1 = *(const bf16x8*)(Wt + 32);
    const float bias = P->in[mat ? I_A0 : I_W0][d * 512 + h * 64 + ntile * 16 + (lane & 15)];
    float S[CPL];
#pragma unroll
    for (int j = 0; j < CPL; ++j) S[j] = 0.f;
    const int rowl = lane / LPR, kg = lane % LPR, srow = rp * RPB + wid * RPW + rowl;
    const int slot = tid >> 3, cg8 = (tid & 7) * 8;
    u32x4 raw[5][3];
#define SC_LOAD(c) do { const int i_ = 64 * (c) + slot; const bool ok_ = i_ < Ltot; const int p_ = d ? Ltot - 1 - i_ : i_; \
        const unsigned zr_ = (unsigned)(METAROW + 64); \
        const unsigned rc_ = ok_ ? (unsigned)pos_row(base, p_) : zr_, rp_ = (ok_ && p_ > 0) ? (unsigned)pos_row(base, p_ - 1) : zr_, rn_ = (ok_ && p_ + 1 < Ltot) ? (unsigned)pos_row(base, p_ + 1) : zr_; \
        _Pragma("unroll") for (int a_ = 0; a_ < 5; ++a_) { const unsigned char* B_ = (const unsigned char*)(a_ == 0 ? Rb : a_ == 1 ? KAb : a_ == 2 ? VAb : Lb); const unsigned ld_ = a_ < 3 ? 1024u : 512u; \
            const unsigned co_ = (unsigned)(((a_ < 3 ? h * 64 : (a_ - 3) * 64) + cg8) * 2); \
            raw[a_][0] = *(const u32x4*)(B_ + (rp_ * ld_ + co_)); raw[a_][1] = *(const u32x4*)(B_ + (rc_ * ld_ + co_)); raw[a_][2] = *(const u32x4*)(B_ + (rn_ * ld_ + co_)); } } while (0)
    SC_LOAD(0);
    BAR_LDS();
    for (int c = 0; c < nchunk; ++c) {
        const int nvalid = (Ltot - 64 * c) < 64 ? (Ltot - 64 * c) : 64;
        float rv[8], kv[8];
#pragma unroll
        for (int a = 0; a < 5; ++a) {
            float pv[8], cv[8], nv[8], o[8]; unpack8(raw[a][0], pv); unpack8(raw[a][1], cv); unpack8(raw[a][2], nv);
            const f32x4 mp0 = *(const LAS f32x4*)(fMU + a * 64 + cg8), mp1 = *(const LAS f32x4*)(fMU + a * 64 + cg8 + 4), mn0 = *(const LAS f32x4*)(fMU + 320 + a * 64 + cg8), mn1 = *(const LAS f32x4*)(fMU + 320 + a * 64 + cg8 + 4);
#pragma unroll
            for (int e = 0; e < 8; ++e) { const float mp = e < 4 ? mp0[e & 3] : mp1[e & 3], mn = e < 4 ? mn0[e & 3] : mn1[e & 3]; o[e] = cv[e] + mp * (pv[e] - cv[e]) + mn * (nv[e] - cv[e]); }
            if (a == 0) {
#pragma unroll
                for (int e = 0; e < 8; ++e) rv[e] = o[e];
                LAS float* dst = fS + SCI(slot, 4, cg8); *(LAS f32x4*)dst = (f32x4){o[0], o[1], o[2], o[3]}; *(LAS f32x4*)(dst + 4) = (f32x4){o[4], o[5], o[6], o[7]};
            } else if (a == 1) {
#pragma unroll
                for (int e = 0; e < 8; ++e) kv[e] = o[e];
            } else if (a == 2) {
                LAS float* dst = fV + slot * 64 + cg8; *(LAS f32x4*)dst = (f32x4){o[0], o[1], o[2], o[3]}; *(LAS f32x4*)(dst + 4) = (f32x4){o[4], o[5], o[6], o[7]};
            } else {
                if (a == 3) {
#pragma unroll
                    for (int e = 0; e < 8; ++e) o[e] = fast_tanh(o[e]);
                }
                u32x4 w; w.x = cvtpk(o[0], o[1]); w.y = cvtpk(o[2], o[3]); w.z = cvtpk(o[4], o[5]); w.w = cvtpk(o[6], o[7]);
                *(LAS u32x4*)(lds + (a == 3 ? SC_TW : SC_AD) + slot * 144 + cg8 * 2) = w;
            }
        }
        BAR_LDS();
        if (c + 1 < nchunk) SC_LOAD(c + 1);
        {
            const LAS unsigned char* Ab = lds + (mat ? SC_AD : SC_TW); LAS float* fWB = fS + (mat ? 128 : 64);
#pragma unroll
            for (int mt = 0; mt < 4; ++mt) {
                const bf16x8 a0 = *(const LAS bf16x8*)(Ab + (mt * 16 + (lane & 15)) * 144 + (lane >> 4) * 16);
                const bf16x8 a1 = *(const LAS bf16x8*)(Ab + (mt * 16 + (lane & 15)) * 144 + 64 + (lane >> 4) * 16);
                f32x4 acc = {0.f, 0.f, 0.f, 0.f};
                acc = __builtin_amdgcn_mfma_f32_16x16x32_bf16(a0, bfr0, acc, 0, 0, 0);
                acc = __builtin_amdgcn_mfma_f32_16x16x32_bf16(a1, bfr1, acc, 0, 0, 0);
#pragma unroll
                for (int rg = 0; rg < 4; ++rg) {
                    const int sl = mt * 16 + (lane >> 4) * 4 + rg, col = ntile * 16 + (lane & 15);
                    const float sg = fast_sigmoid(acc[rg] + bias); const float dc = __builtin_amdgcn_exp2f(-0.6065306597126334f * LOG2E * sg);
                    fWB[sl * 320 + col] = mat ? sg : dc;
                }
            }
        }
        BAR_LDS();
        {
            const f32x4 a0 = *(const LAS f32x4*)(fS + SCI(slot, 2, cg8)), a1 = *(const LAS f32x4*)(fS + SCI(slot, 2, cg8 + 4));
            const f32x4 kk0 = *(const LAS f32x4*)(fMU + 640 + cg8), kk1 = *(const LAS f32x4*)(fMU + 640 + cg8 + 4), ka0 = *(const LAS f32x4*)(fMU + 704 + cg8), ka1 = *(const LAS f32x4*)(fMU + 704 + cg8 + 4);
            const f32x4 rk0 = *(const LAS f32x4*)(fMU + 768 + cg8), rk1 = *(const LAS f32x4*)(fMU + 768 + cg8 + 4);
            float kkv[8], kd[8], av[8]; float ssq = 0.f, cs = 0.f;
#pragma unroll
            for (int e = 0; e < 8; ++e) {
                av[e] = e < 4 ? a0[e & 3] : a1[e & 3];
                kkv[e] = kv[e] * (e < 4 ? kk0[e & 3] : kk1[e & 3]); ssq = fmaf(kkv[e], kkv[e], ssq);
                kd[e] = kv[e] * (1.0f + (av[e] - 1.0f) * (e < 4 ? ka0[e & 3] : ka1[e & 3])); cs = fmaf(rv[e] * kd[e], e < 4 ? rk0[e & 3] : rk1[e & 3], cs);
            }
            ssq = grp_sum<8>(ssq); cs = grp_sum<8>(cs);
            const float rs = rsqrtf(fmaxf(ssq, 1e-24f));
#pragma unroll
            for (int e = 0; e < 8; ++e) { kkv[e] *= rs; av[e] *= kkv[e]; }
            LAS float* o1 = fS + SCI(slot, 0, cg8); *(LAS f32x4*)o1 = (f32x4){kkv[0], kkv[1], kkv[2], kkv[3]}; *(LAS f32x4*)(o1 + 4) = (f32x4){kkv[4], kkv[5], kkv[6], kkv[7]};
            LAS float* o2 = fS + SCI(slot, 2, cg8); *(LAS f32x4*)o2 = (f32x4){av[0], av[1], av[2], av[3]}; *(LAS f32x4*)(o2 + 4) = (f32x4){av[4], av[5], av[6], av[7]};
            LAS float* o3 = fS + SCI(slot, 3, cg8); *(LAS f32x4*)o3 = (f32x4){kd[0], kd[1], kd[2], kd[3]}; *(LAS f32x4*)(o3 + 4) = (f32x4){kd[4], kd[5], kd[6], kd[7]};
            if (cg8 == 0 && rp == 0 && slot < nvalid) { const int i2 = 64 * c + slot; const int p2 = d ? Ltot - 1 - i2 : i2; CB[((size_t)d * ROWS + pos_row(base, p2)) * 8 + h] = cs; }
        }
        BAR_LDS();
        if (wid < NSW) {
            typedef float f32x2_ __attribute__((ext_vector_type(2)));
            constexpr int C4 = CPL / 4;
            const LAS float* ps = fS + kg * CPL; const LAS float* pv = fV + srow; LAS float* py = fY + srow;
            f32x4 nk[C4], nw[C4], nb[C4], nd[C4], nr[C4]; float nv;
#define SC_FETCH(sl_) do { _Pragma("unroll") for (int j_ = 0; j_ < C4; ++j_) { nk[j_] = *(const LAS f32x4*)(ps + (sl_) * 320 + 4 * j_); nw[j_] = *(const LAS f32x4*)(ps + (sl_) * 320 + 64 + 4 * j_); \
                nb[j_] = *(const LAS f32x4*)(ps + (sl_) * 320 + 128 + 4 * j_); nd[j_] = *(const LAS f32x4*)(ps + (sl_) * 320 + 192 + 4 * j_); nr[j_] = *(const LAS f32x4*)(ps + (sl_) * 320 + 256 + 4 * j_); } nv = pv[(sl_) * 64]; } while (0)
            SC_FETCH(0);
            f32x4 rp4[C4];
#pragma unroll
            for (int j = 0; j < C4; ++j) rp4[j] = (f32x4){0.f, 0.f, 0.f, 0.f};
#pragma unroll 16
            for (int sl = 0; sl < nvalid; ++sl) {
                f32x4 ck[C4], cw[C4], cb[C4], cd[C4], cr[C4];
#pragma unroll
                for (int j = 0; j < C4; ++j) { ck[j] = nk[j]; cw[j] = nw[j]; cb[j] = nb[j]; cd[j] = nd[j]; cr[j] = nr[j]; }
                const float vv = nv;
                SC_FETCH(sl + 1 < 64 ? sl + 1 : 63);
                f32x2_ pa = {0.f, 0.f}, ya = {0.f, 0.f};
#pragma unroll
                for (int j = 0; j < C4; ++j)
#pragma unroll
                    for (int e = 0; e < 4; e += 2) { const f32x2_ s2 = {S[4 * j + e], S[4 * j + e + 1]}, k2 = {ck[j][e], ck[j][e + 1]}, r2 = {rp4[j][e], rp4[j][e + 1]}; pa = pa + s2 * k2; ya = ya + s2 * r2; }
                float pp = pa.x + pa.y, yy = ya.x + ya.y;
                pp = dpp_add(pp, 0); yy = dpp_add(yy, 0); pp = dpp_add(pp, 1); yy = dpp_add(yy, 1); pp = dpp_add(pp, 2); yy = dpp_add(yy, 2);
                if (LPR == 16) { pp = dpp_add(pp, 3); yy = dpp_add(yy, 3); }
                py[(sl > 0 ? sl - 1 : 0) * 64] = yy;
#pragma unroll
                for (int j = 0; j < C4; ++j)
#pragma unroll
                    for (int e = 0; e < 4; e += 2) {
                        const f32x2_ b2 = {cb[j][e], cb[j][e + 1]}, d2 = {cd[j][e], cd[j][e + 1]}, w2 = {cw[j][e], cw[j][e + 1]}; f32x2_ s2 = {S[4 * j + e], S[4 * j + e + 1]};
                        const f32x2_ t2 = d2 * vv - b2 * pp; s2 = s2 * w2 + t2; S[4 * j + e] = s2.x; S[4 * j + e + 1] = s2.y; }
#pragma unroll
                for (int j = 0; j < C4; ++j) rp4[j] = cr[j];
            }
            {
                f32x2_ ya = {0.f, 0.f};
#pragma unroll
                for (int j = 0; j < C4; ++j)
#pragma unroll
                    for (int e = 0; e < 4; e += 2) { const f32x2_ s2 = {S[4 * j + e], S[4 * j + e + 1]}, r2 = {rp4[j][e], rp4[j][e + 1]}; ya = ya + s2 * r2; }
                const float yy = grp_sum<LPR>(ya.x + ya.y);
                py[(nvalid - 1) * 64] = yy;
            }
#undef SC_FETCH
        }
        BAR_LDS();
        {
            const int i2 = 64 * c + slot; const int p2 = d ? Ltot - 1 - i2 : i2;
            if (slot < nvalid && p2 >= 16 && (cg8 / RPB) == rp) {
                const LAS float* yp = fY + slot * 64 + cg8; const f32x4 y0 = *(const LAS f32x4*)yp, y1 = *(const LAS f32x4*)(yp + 4);
                *(u32x4*)(YD + (size_t)(base + p2 - 16) * 512 + h * 64 + cg8) = pack8(y0, y1);
            }
        }
    }
#undef SC_LOAD
#undef SCI
}

__device__ __forceinline__ void phase_post(LAS unsigned char* lds, KP P) {
    const int tid = fresh_tid(), lane = tid & 63, wid = tid >> 6;
    unsigned char* ws = P->ws;
    const bf16* VAb = (const bf16*)(ws + WS_VA); const bf16* Lb = (const bf16*)(ws + WS_L); bf16* Rb = (bf16*)(ws + WS_R);
    const float* CB = (const float*)(ws + WS_CB); const bf16* YD0 = (const bf16*)((const unsigned char*)P->out + 64 * MiB); const bf16* YD1 = YD0 + (size_t)NMAIN * 512;
    const bf16* GT = (const bf16*)(ws + WS_LORA + 262144);
    LAS float* st = (LAS float*)(lds + 17408);
    const float* mup = P->in[I_MUP]; const float* mun = P->in[I_MUN];
    for (int tile = blockIdx.x; tile < NMAIN / 64; tile += gridDim.x) {
        {
            const int row = tid >> 3, hh = tid & 7, m = tile * 64 + row;
            const int t = m < 16384 ? m : (m - 16384) & 2047, Ls = m < 16384 ? 16384 : 2048;
            float sum = 0.f, sq = 0.f;
#pragma unroll
            for (int i = 0; i < 8; ++i) { float a[8], b[8]; unpack8(*(const u32x4*)(YD0 + (size_t)m * 512 + hh * 64 + i * 8), a); unpack8(*(const u32x4*)(YD1 + (size_t)m * 512 + hh * 64 + i * 8), b);
#pragma unroll
                for (int e = 0; e < 8; ++e) { const float y = a[e] + b[e]; sum += y; sq += y * y; } }
            const float mu = sum * (1.0f / 64.0f); const float var = fmaxf(sq * (1.0f / 64.0f) - mu * mu, 0.f);
            st[(row * 8 + hh) * 2] = mu; st[(row * 8 + hh) * 2 + 1] = rsqrtf(var + 64e-5f);
            const size_t rp_ = t == 0 ? (size_t)(METAROW + 15) : (size_t)(m - 1); const bool okn = t + 1 < Ls;
#pragma unroll
            for (int i = 0; i < 2; ++i) {
                const int c0 = 128 + hh * 16 + i * 8; float pv[8], cv[8], nv[8], o[8];
                unpack8(*(const u32x4*)(Lb + rp_ * 256 + c0), pv); unpack8(*(const u32x4*)(Lb + (size_t)m * 256 + c0), cv);
                if (okn) unpack8(*(const u32x4*)(Lb + (size_t)(m + 1) * 256 + c0), nv); else {
#pragma unroll
                    for (int e = 0; e < 8; ++e) nv[e] = 0.f; }
#pragma unroll
                for (int e = 0; e < 8; ++e) { const float mp = mup[1536 + c0 + e], mn = mun[1536 + c0 + e]; o[e] = sigmoidf_(cv[e] + mp * (pv[e] - cv[e]) + mn * (nv[e] - cv[e])); }
                u32x4 w; w.x = cvtpk(o[0], o[1]); w.y = cvtpk(o[2], o[3]); w.z = cvtpk(o[4], o[5]); w.w = cvtpk(o[6], o[7]);
                *(LAS u32x4*)(lds + row * 272 + (hh * 16 + i * 8) * 2) = w;
            }
        }
        __syncthreads();
#pragma unroll 1
        for (int nt = 0; nt < 4; ++nt) {
            const int col = wid * 64 + nt * 16 + (lane & 15);
            bf16x8 bfr[4];
#pragma unroll
            for (int ks = 0; ks < 4; ++ks) bfr[ks] = *(const bf16x8*)(GT + (size_t)col * 128 + ks * 32 + (lane >> 4) * 8);
            const float lw = P->in[I_LNW][col], lb = P->in[I_LNB][col];
            const float mpv = mup[1024 + col], mnv = mun[1024 + col];
#pragma unroll 1
            for (int mt = 0; mt < 4; ++mt) {
                f32x4 acc = {0.f, 0.f, 0.f, 0.f};
#pragma unroll
                for (int ks = 0; ks < 4; ++ks) { const bf16x8 a = *(const LAS bf16x8*)(lds + (mt * 16 + (lane & 15)) * 272 + ks * 64 + (lane >> 4) * 16); acc = __builtin_amdgcn_mfma_f32_16x16x32_bf16(a, bfr[ks], acc, 0, 0, 0); }
#pragma unroll
                for (int rg = 0; rg < 4; ++rg) {
                    const int row = mt * 16 + (lane >> 4) * 4 + rg, m = tile * 64 + row;
                    const int t = m < 16384 ? m : (m - 16384) & 2047, Ls = m < 16384 ? 16384 : 2048;
                    const float y = bf2f(YD0[(size_t)m * 512 + col]) + bf2f(YD1[(size_t)m * 512 + col]);
                    const float yn = (y - st[(row * 8 + wid) * 2]) * st[(row * 8 + wid) * 2 + 1] * lw + lb;
                    const float vc = bf2f(VAb[(size_t)m * 512 + col]);
                    const float vp = bf2f(VAb[(t == 0 ? (size_t)(METAROW + 15) : (size_t)(m - 1)) * 512 + col]);
                    const float vn = t + 1 < Ls ? bf2f(VAb[(size_t)(m + 1) * 512 + col]) : 0.f;
                    const float vs = vc + mpv * (vp - vc) + mnv * (vn - vc);
                    const float cb = CB[(size_t)m * 8 + wid] + CB[((size_t)ROWS + m) * 8 + wid];
                    Rb[(size_t)m * 512 + col] = (bf16)f2bf_rne((yn + cb * vs) * acc[rg]);
                }
            }
        }
        __syncthreads();
    }
}

__device__ __forceinline__ void phase_rms_bf16(KP P) {
    const int tid = fresh_tid(), lane = tid & 63, wid = tid >> 6; const int gw = blockIdx.x * 8 + wid, NGW = gridDim.x * 8;
    bf16* MN = (bf16*)(P->ws + WS_MN);
    for (int m = gw; m < NMAIN; m += NGW) rms_row_bf16(P->out + (size_t)m * DM, P->in[I_GFFN], MN + (size_t)m * DM, lane);
}
__device__ __forceinline__ void phase_final(KP P) {
    const int tid = fresh_tid(), lane = tid & 63, wid = tid >> 6; const int gw = blockIdx.x * 8 + wid, NGW = gridDim.x * 8;
    const f32x4* gr = (const f32x4*)P->in[I_GFIN] + lane;
    for (int m = gw; m < NMAIN; m += NGW) {
        f32x4* xr = (f32x4*)(P->out + (size_t)m * DM) + lane; f32x4 v[4]; float s = 0.f;
#pragma unroll
        for (int j = 0; j < 4; ++j) { v[j] = xr[64 * j]; s += (v[j].x * v[j].x + v[j].y * v[j].y) + (v[j].z * v[j].z + v[j].w * v[j].w); }
        const float rstd = rsqrtf(wave_sum(s) * (1.f / DM) + 1e-6f);
#pragma unroll
        for (int j = 0; j < 4; ++j) xr[64 * j] = v[j] * rstd * gr[64 * j];
    }
}

constexpr int NRP_LONG = 4;
constexpr int N_LONG = 16 * NRP_LONG, N_ATT_P = 512, N_ATT_S = 512, N_SHORT = 128, N_ITEMS = N_LONG + N_ATT_P + N_ATT_S + N_SHORT;

template <class Op> __device__ __forceinline__ void run_gemm(LAS unsigned char* lds, const bf16* A, const bf16* Bt, int M, int N, int K, const Op& op, const bf16* A2 = nullptr, int pm2 = 1 << 30) {
    pg8::Gemm g{A, Bt, M, N, K, A2, pm2}; pg8::StaticOrder S; S.init(M, N, (int)gridDim.x, (int)blockIdx.x);
    Epi8<Op> E{op};
    pg8::gemm_phase<Epi8<Op>, pg8::StaticOrder, true, true>(lds, g, S, E);
}

constexpr size_t WS_XBAR = 16384;
#define XB_TMO      128
#define XB_XCNT(j)  (256  + 64 * (j))
#define XB_XSUB(j)  (1280 + 64 * (j))
#define XB_XGEN(j)  (2304 + 64 * (j))
#define XB_TOP      3328
#define XB_TOPGEN   3392
#define XCD_BAR_WORDS 3456
#define XB_SPIN_CAP (1u << 18)
__device__ __forceinline__ unsigned xb_ld(unsigned* p)              { return __hip_atomic_load(p, __ATOMIC_RELAXED, __HIP_MEMORY_SCOPE_AGENT); }
__device__ __forceinline__ unsigned xb_add(unsigned* p, unsigned v) { return __hip_atomic_fetch_add(p, v, __ATOMIC_RELAXED, __HIP_MEMORY_SCOPE_AGENT); }
__device__ __forceinline__ unsigned xb_xcc_id() { return (unsigned)__builtin_amdgcn_s_getreg((3 << 11) | 20) & 0xFu; }
#define XB_SPIN(cond, bar) do { unsigned _sp = 0; while (cond) { __builtin_amdgcn_s_sleep(1); \
    if ((++_sp & 255u) == 0u) { if (xb_ld(&(bar)[XB_TMO])) break; if (_sp > XB_SPIN_CAP) { atomicAdd(&(bar)[XB_TMO], 1u); break; } } } } while (0)
struct XcdBarrier { unsigned* bar; unsigned x; volatile LAS unsigned* st; };
__device__ __forceinline__ XcdBarrier xcd_barrier_post(unsigned* bar, volatile LAS unsigned* st) {
    XcdBarrier b; b.bar = bar; b.x = xb_xcc_id(); b.st = st;
    if (threadIdx.x == 0) (void)xb_add(&bar[XB_XCNT(b.x)], 1u);
    return b;
}
__device__ __forceinline__ void xcd_barrier_complete(unsigned* bar, unsigned x, unsigned& nloc, unsigned& nx) {
    const unsigned G = gridDim.x * gridDim.y * gridDim.z;
    unsigned sum, cnt, mine, sp = 0u;
    for (;;) {
        sum = 0u; cnt = 0u; mine = 0u;
#pragma unroll
        for (unsigned j = 0; j < 16; ++j) { const unsigned c = xb_ld(&bar[XB_XCNT(j)]); sum += c; cnt += (c > 0u) ? 1u : 0u; mine = (j == x) ? c : mine; }
        if (sum == G) break;
        __builtin_amdgcn_s_sleep(1);
        if ((++sp & 255u) == 0u) { if (xb_ld(&bar[XB_TMO])) break; if (sp > XB_SPIN_CAP) { atomicAdd(&bar[XB_TMO], 1u); break; } }
    }
    nloc = mine > 0u ? mine : 1u; nx = cnt > 0u ? cnt : 1u;
}
__device__ __forceinline__ void xcd_barrier(const XcdBarrier& b) {
    asm volatile("s_waitcnt vmcnt(0)" ::: "memory");
    __syncthreads();
    if (threadIdx.x == 0) {
        unsigned* bar = b.bar;
        __builtin_amdgcn_s_waitcnt(0);
        unsigned nloc = b.st[0], nx = b.st[1];
        if (nloc == 0u) { xcd_barrier_complete(bar, b.x, nloc, nx); b.st[0] = nloc; b.st[1] = nx; }
        const unsigned old = xb_add(&bar[XB_XSUB(b.x)], 1u);
        const unsigned gen = old / nloc;
        if (old + 1u == (gen + 1u) * nloc) {
            __builtin_amdgcn_fence(__ATOMIC_RELEASE, "agent");
            asm volatile("s_waitcnt vmcnt(0)" ::: "memory");
            const unsigned og = xb_add(&bar[XB_TOP], 1u);
            const unsigned tg = og / nx;
            if (og + 1u == (tg + 1u) * nx) xb_add(&bar[XB_TOPGEN], 1u);
            else XB_SPIN(xb_ld(&bar[XB_TOPGEN]) == tg, bar);
            __builtin_amdgcn_fence(__ATOMIC_ACQUIRE, "agent");
            xb_add(&bar[XB_XGEN(b.x)], 1u);
            asm volatile("s_waitcnt vmcnt(0)" ::: "memory");
        } else {
            XB_SPIN(xb_ld(&bar[XB_XGEN(b.x)]) == gen, bar);
            __builtin_amdgcn_fence(__ATOMIC_ACQUIRE, "agent");
            asm volatile("s_waitcnt vmcnt(0)" ::: "memory");
        }
    }
    __syncthreads();
}
#ifndef PROBE_MASK
#define PROBE_MASK 0
#endif
#ifndef PROBE_MUL
#define PROBE_MUL 1
#endif
#define PH_BEGIN(k) unsigned long long t0_##k = 0; if (PROBE_MASK & (1 << (k))) t0_##k = __builtin_amdgcn_s_memrealtime();
#define PH_END(k) if (PROBE_MASK & (1 << (k))) { const unsigned long long t1_ = __builtin_amdgcn_s_memrealtime(); const unsigned long long dt_ = (t1_ - t0_##k) * PROBE_MUL; while (__builtin_amdgcn_s_memrealtime() - t1_ < dt_) __builtin_amdgcn_s_sleep(8); xcd_barrier(xbar); }
__global__ void __launch_bounds__(NTHREADS) fwd_megakernel(Params Pin) {
    extern __shared__ __attribute__((aligned(16))) unsigned char lds_raw[];
    LAS unsigned char* lds = (LAS unsigned char*)lds_raw;
    cg::grid_group grid = cg::this_grid();
    KP P0 = (KP)__builtin_amdgcn_kernarg_segment_ptr();
    volatile LAS unsigned* xst = (volatile LAS unsigned*)(lds + LDS_ITEM_OFF + 4);
    if (threadIdx.x == 0) { xst[0] = 0u; xst[1] = 0u; }
    __syncthreads();
    const XcdBarrier xbar = xcd_barrier_post((unsigned*)(P0->ws + WS_XBAR), xst);
#define NEWPHASE KP P = P0; asm volatile("" : "+s"(P)); unsigned char* ws = P->ws; (void)ws;

    PH_BEGIN(0)
    { NEWPHASE phase_prologue(lds, P); }
    grid.sync();
    PH_END(0)
    PH_BEGIN(1)
    { NEWPHASE run_gemm(lds, (const bf16*)P->out, (const bf16*)(ws + WS_WIN), ROWS, 3328, 1024, OpProj{ws}, (const bf16*)(ws + WS_XNMETA), 128); }
    xcd_barrier(xbar);
    PH_END(1)
    PH_BEGIN(2)
    { NEWPHASE
        const int tid = fresh_tid();
        float lam;
        { const int lane = tid & 63; const float s1 = wave_sum(P->in[I_LQ1][lane] * P->in[I_LK1][lane]), s2 = wave_sum(P->in[I_LQ2][lane] * P->in[I_LK2][lane]); lam = __expf(s1) - __expf(s2) + 0.2f; }
        unsigned* ctr = (unsigned*)(ws + WS_CTL);
        LAS unsigned* slot = (LAS unsigned*)(lds + LDS_ITEM_OFF);
#define FETCH(k, n) if (tid == 0) *slot = atomicAdd(ctr + 64 * (k), 1u); __syncthreads(); const int idx = (int)*slot; __syncthreads(); if (idx >= (n)) break;
#ifndef NO_SCAN
#pragma unroll 1
        for (;;) { FETCH(0, N_LONG) const int u = idx / NRP_LONG; scan_unit<NRP_LONG, 4>(lds, P, 0, u >> 3, u & 7, idx % NRP_LONG); }
#endif
#ifndef NO_ATTN
#pragma unroll 1
        for (;;) { FETCH(1, N_ATT_P + N_ATT_S)
            if (idx < N_ATT_P) attn_unit(lds, P, 0, idx >> 7, idx & 127, lam);
            else { const int a = idx - N_ATT_P; attn_unit(lds, P, 1 + (a >> 6), (a >> 4) & 3, a & 15, lam); } }
#endif
#ifndef NO_SCAN
#pragma unroll 1
        for (;;) { FETCH(2, N_SHORT) scan_unit<1, 8>(lds, P, 1 + (idx >> 4), (idx >> 3) & 1, idx & 7, 0); }
#endif
#undef FETCH
    }
    xcd_barrier(xbar);
    PH_END(2)
#ifndef NO_POST
    PH_BEGIN(3)
    { NEWPHASE phase_post(lds, P); }
#endif
    xcd_barrier(xbar);
    PH_END(3)
    PH_BEGIN(4)
    { NEWPHASE run_gemm(lds, (const bf16*)P->out, (const bf16*)(ws + WS_WIN) + (size_t)3328 * 1024, NMAIN, 2048, 1024, OpGate{ws}); }
    xcd_barrier(xbar);
    PH_END(4)
    PH_BEGIN(5)
    { NEWPHASE run_gemm(lds, (const bf16*)(ws + WS_R), (const bf16*)(ws + WS_WUPA), NMAIN, 1024, 512, OpUpA{ws}); }
    PH_END(5)
    PH_BEGIN(6)
    { NEWPHASE run_gemm(lds, (const bf16*)(ws + WS_Q), (const bf16*)(ws + WS_WUPB), NMAIN, 1024, 512, OpUpB{ws}); }
    xcd_barrier(xbar);
    PH_END(6)
    PH_BEGIN(7)
    { NEWPHASE run_gemm(lds, (const bf16*)(ws + WS_GB), (const bf16*)(ws + WS_WOUT), NMAIN, 1024, 1024, OpOut{P->in[I_XP], P->in[I_XS], P->out}); }
    xcd_barrier(xbar);
    PH_END(7)
    PH_BEGIN(8)
    { NEWPHASE phase_rms_bf16(P); }
    xcd_barrier(xbar);
    PH_END(8)
    PH_BEGIN(9)
    { NEWPHASE run_gemm(lds, (const bf16*)(ws + WS_MN), (const bf16*)(ws + WS_WFF1), 16384, DFF, 1024, OpFF1{(bf16*)(ws + WS_HID)}); }
    xcd_barrier(xbar);
    PH_END(9)
    PH_BEGIN(10)
    { NEWPHASE run_gemm(lds, (const bf16*)(ws + WS_HID), (const bf16*)(ws + WS_WFF2), 16384, 1024, DFF, OpFF2{P->out}); }
    xcd_barrier(xbar);
    PH_END(10)
    PH_BEGIN(11)
    { NEWPHASE run_gemm(lds, (const bf16*)(ws + WS_MN) + (size_t)16384 * DM, (const bf16*)(ws + WS_WFF1), 16384, DFF, 1024, OpFF1{(bf16*)(ws + WS_HID)}); }
    xcd_barrier(xbar);
    PH_END(11)
    PH_BEGIN(12)
    { NEWPHASE run_gemm(lds, (const bf16*)(ws + WS_HID), (const bf16*)(ws + WS_WFF2), 16384, 1024, DFF, OpFF2{P->out + (size_t)16384 * DM}); }
    xcd_barrier(xbar);
    PH_END(12)
    PH_BEGIN(13)
    { NEWPHASE phase_final(P); }
}

extern "C" void kernel_launch(void* const* d_in, const int* in_sizes, int n_in, void* d_out, int out_size, void* d_ws, size_t ws_size, hipStream_t stream) {
    static int grid_blocks = 0;
    if (grid_blocks == 0) {
        int dev = 0, cus = 0, per_cu = 0;
        hipGetDevice(&dev);
        hipDeviceGetAttribute(&cus, hipDeviceAttributeMultiprocessorCount, dev);
        hipFuncSetAttribute((const void*)fwd_megakernel, hipFuncAttributeMaxDynamicSharedMemorySize, LDS_BYTES);
        hipOccupancyMaxActiveBlocksPerMultiprocessor(&per_cu, (const void*)fwd_megakernel, NTHREADS, LDS_BYTES);
        if (per_cu < 1) { fprintf(stderr, "kernel_launch: occupancy query says %d blocks per CU\n", per_cu); per_cu = 1; }
        grid_blocks = cus * per_cu;
        if (n_in != 29 || ws_size < WS_END) fprintf(stderr, "kernel_launch: unexpected n_in %d / ws_size %zu\n", n_in, ws_size);
    }
    hipMemsetAsync((unsigned char*)d_ws + WS_CTL, 0, 32768, stream);
    Params p{};
    for (int i = 0; i < 29; ++i) p.in[i] = (const float*)d_in[i];
    p.out = (float*)d_out; p.ws = (unsigned char*)d_ws;
    void* args[] = {&p};
    hipError_t e = hipLaunchCooperativeKernel((const void*)fwd_megakernel, dim3(grid_blocks), dim3(NTHREADS), args, LDS_BYTES, stream);
    if (e != hipSuccess) fprintf(stderr, "cooperative launch failed: %s (grid %d)\n", hipGetErrorString(e), grid_blocks);
}
```

```cpp
#include <hip/hip_runtime.h>
#include <hip/hip_cooperative_groups.h>
#include <cstdio>
#include <cstdint>
#include <cmath>
namespace cg = cooperative_groups;
__device__ __forceinline__ int fresh_tid() { int t = threadIdx.x; asm volatile("" : "+v"(t)); return t; }
namespace pg8 {
#define PG8_LAS __attribute__((address_space(3)))
typedef unsigned short bf16_t;
typedef short bf16x8 __attribute__((ext_vector_type(8)));
typedef float f32x4 __attribute__((ext_vector_type(4)));
typedef unsigned u32x4 __attribute__((ext_vector_type(4)));
constexpr int BM = 256, BK = 64, HALF = 128, HTB = HALF * BK * 2  , STAGE_BYTES = 8 * HTB, NXCD = 8, WGM = 8;

__host__ __device__ __forceinline__ int lds_byte(int r, int c) { const int st = (r >> 4) * 2 + (c >> 5), rr = r & 15, cc = c & 31, ob = rr * 64 + cc * 2; return st * 1024 + (ob ^ (((ob >> 9) & 1) << 5)); }
__host__ __device__ __forceinline__ void stage_rc(int b, int& R, int& C) { const int st = b / 1024, sb = b % 1024, swz = sb ^ (((sb >> 9) & 1) << 5); R = (st >> 1) * 16 + swz / 64; C = (st & 1) * 32 + (swz % 64) / 2; }
__host__ __device__ __forceinline__ int perm32(int rho) { const int n = rho >> 4, i = rho & 15; return 8 * (i >> 2) + 4 * n + (i & 3); }

struct Unit { int pm, pn; };
struct Gemm { const bf16_t* A; const bf16_t* Bt; int M, N, K; const bf16_t* A2; int pm2; };
__device__ __forceinline__ const char* gemm_abase(const Gemm& g, int pm, size_t tstep) { return pm >= g.pm2 ? (const char*)g.A2 + (size_t)(pm - g.pm2) * tstep : (const char*)g.A + (size_t)pm * tstep; }

struct StaticOrder {
    int nM, nN, nwg, G, c;
    __host__ __device__ void init(int M, int N, int G_, int c_) { nM = M / BM; nN = N / BM; nwg = nM * nN; G = G_; c = c_; }
    __host__ __device__ bool next(int i, Unit& u) const {
        const long L = (long)i * G + c; if (L >= nwg) return false;
        int wgid = (int)L; { const int q = nwg / NXCD, r = nwg % NXCD, xcd = wgid % NXCD, off = wgid / NXCD; wgid = (xcd < r ? xcd * (q + 1) : r * (q + 1) + (xcd - r) * q) + off; }
        const int nig = WGM * nN, gid = wgid / nig, fm = gid * WGM, gsz = (nM - fm) < WGM ? (nM - fm) : WGM;
        u.pm = fm + ((wgid % nig) % gsz); u.pn = (wgid % nig) / gsz; return true;
    }
    __device__ __forceinline__ void a_ready(const Unit&) const {}
    __device__ __forceinline__ void done(const Unit&) const {}
};


template <class Epi, class Sched, bool ALIGN_EPI = false, bool SP2 = false>
__device__ __forceinline__ void gemm_phase(PG8_LAS unsigned char* lds, const Gemm g, const Sched& S, const Epi& E) {
    const int tid = fresh_tid(), wid = __builtin_amdgcn_readfirstlane(tid >> 6), lane = tid & 63, wr = wid >> 2, wc = wid & 3, fr = lane & 15, fq = lane >> 4;
    const int K = g.K, nt = K / BK;
    unsigned voffA[2], voffB[2];
#pragma unroll
    for (int i = 0; i < 2; ++i) { int R, C; stage_rc(tid * 16 + i * 8192, R, C); const int Rb = Epi::PERM ? ((R & ~31) + perm32(R & 31)) : R;
        voffA[i] = (unsigned)(R * K + C) * 2u; voffB[i] = (unsigned)(Rb * K + C) * 2u; }
    const size_t kstep = (size_t)(BK * 2);
    const size_t hstep = (size_t)HALF * K * 2;
    const size_t tstep = 2 * hstep;
    const unsigned ldsw = (unsigned)wid * 1024u;
    const int aoff = lds_byte(wr * 64 + fr, fq * 8), boff = lds_byte(wc * 32 + fr, fq * 8);
#define PG8_SA(b, h) (((b) * 2 + (h)) * HTB)
#define PG8_SB(b, h) ((4 + (b) * 2 + (h)) * HTB)
#define PG8_STAGE(bufoff, gbase, voff) do { _Pragma("unroll") for (int _i = 0; _i < 2; ++_i) \
        __builtin_amdgcn_global_load_lds((const unsigned*)((const char*)(gbase) + (voff)[_i]), (PG8_LAS unsigned*)(lds + (bufoff) + ldsw + _i * 8192), 16, 0, 0); } while (0)
#define PG8_LDA(dst, b, h) do { _Pragma("unroll") for (int m = 0; m < 4; ++m) _Pragma("unroll") for (int k = 0; k < 2; ++k) dst[m][k] = *(const PG8_LAS bf16x8*)(lds + PG8_SA(b, h) + aoff + m * 2048 + k * 1024); } while (0)
#define PG8_LDB(dst, b, h) do { _Pragma("unroll") for (int n = 0; n < 2; ++n) _Pragma("unroll") for (int k = 0; k < 2; ++k) dst[n][k] = *(const PG8_LAS bf16x8*)(lds + PG8_SB(b, h) + boff + n * 2048 + k * 1024); } while (0)
#define PG8_MMA(ai, bj, At, Bt) do { __builtin_amdgcn_s_setprio(1); _Pragma("unroll") for (int m = 0; m < 4; ++m) _Pragma("unroll") for (int n = 0; n < 2; ++n) _Pragma("unroll") for (int k = 0; k < 2; ++k) \
        acc[ai][bj][m][n] = __builtin_amdgcn_mfma_f32_16x16x32_bf16(Bt[n][k], At[m][k], acc[ai][bj][m][n], 0, 0, 0); __builtin_amdgcn_s_setprio(0); } while (0)
#define PG8_WAIT_V(n) asm volatile("s_waitcnt vmcnt(" #n ")" ::: "memory")
#define PG8_WAIT_L(n) asm volatile("s_waitcnt lgkmcnt(" #n ")" ::: "memory")
#define PG8_BAR __builtin_amdgcn_s_barrier()
#define PG8_SCHED __builtin_amdgcn_sched_barrier(0)
    Unit cur, nxt; int ui = 0;
    if (!S.next(0, cur)) return;
    f32x4 acc[2][2][4][2];
#pragma unroll
    for (int a = 0; a < 2; ++a)
#pragma unroll
        for (int b = 0; b < 2; ++b)
#pragma unroll
            for (int m = 0; m < 4; ++m)
#pragma unroll
                for (int n = 0; n < 2; ++n) acc[a][b][m][n] = (f32x4){0.f, 0.f, 0.f, 0.f};
    bf16x8 At[4][2], B0[2][2], B1[2][2];
    const char* cA = gemm_abase(g, cur.pm, tstep); const char* cB = (const char*)g.Bt + (size_t)cur.pn * tstep;
    S.a_ready(cur);
    if constexpr (SP2) {
        PG8_STAGE(PG8_SB(0, 0), cB, voffB); PG8_STAGE(PG8_SB(0, 1), cB + hstep, voffB); PG8_STAGE(PG8_SA(0, 0), cA, voffA); PG8_STAGE(PG8_SA(0, 1), cA + hstep, voffA);
        if (wr == 1) PG8_BAR;
        PG8_WAIT_V(2); PG8_BAR;
        PG8_STAGE(PG8_SB(1, 0), cB + kstep, voffB); PG8_STAGE(PG8_SA(1, 0), cA + kstep, voffA); PG8_STAGE(PG8_SB(1, 1), cB + hstep + kstep, voffB);
        PG8_WAIT_V(6); PG8_BAR;
    } else {
        PG8_STAGE(PG8_SB(0, 0), cB, voffB); PG8_STAGE(PG8_SA(0, 0), cA, voffA); PG8_STAGE(PG8_SB(0, 1), cB + hstep, voffB); PG8_STAGE(PG8_SA(0, 1), cA + hstep, voffA);
        if (wr == 1) PG8_BAR;
        PG8_WAIT_V(4); PG8_BAR;
        PG8_STAGE(PG8_SB(1, 0), cB + kstep, voffB); PG8_STAGE(PG8_SA(1, 0), cA + kstep, voffA); PG8_STAGE(PG8_SB(1, 1), cB + hstep + kstep, voffB);
        PG8_WAIT_V(6); PG8_BAR;
    }
    for (;;) {
        const bool has_next = S.next(ui + 1, nxt);
        const char* nA = has_next ? gemm_abase(g, nxt.pm, tstep) : cA; const char* nB = has_next ? (const char*)g.Bt + (size_t)nxt.pn * tstep : cB;
        for (int t = 0; t < nt; t += 2) {
            const bool last = (t == nt - 2);
            const char* a1 = cA + (size_t)(t + 1) * kstep;
            const char* a2 = last ? nA : cA + (size_t)(t + 2) * kstep; const char* b2 = last ? nB : cB + (size_t)(t + 2) * kstep;
            const char* a3 = a2 + kstep; const char* b3 = b2 + kstep;
            if (last && has_next) S.a_ready(nxt);
            if constexpr (SP2) {
            PG8_LDB(B0, 0, 0); PG8_LDB(B1, 0, 1); PG8_SCHED; PG8_LDA(At, 0, 0); PG8_STAGE(PG8_SA(1, 1), a1 + hstep, voffA);
            PG8_WAIT_V(8); PG8_WAIT_L(0); PG8_BAR; PG8_MMA(0, 0, At, B0); PG8_MMA(0, 1, At, B1); PG8_BAR; PG8_SCHED;
            PG8_LDA(At, 0, 1); PG8_STAGE(PG8_SB(0, 0), b2, voffB); PG8_STAGE(PG8_SB(0, 1), b2 + hstep, voffB); PG8_STAGE(PG8_SA(0, 0), a2, voffA);
            PG8_WAIT_V(8); PG8_WAIT_L(0); PG8_BAR; PG8_MMA(1, 0, At, B0); PG8_MMA(1, 1, At, B1); PG8_BAR; PG8_SCHED;
            PG8_LDB(B0, 1, 0); PG8_LDB(B1, 1, 1); PG8_SCHED; PG8_LDA(At, 1, 0); PG8_STAGE(PG8_SA(0, 1), a2 + hstep, voffA);
            PG8_WAIT_V(8); PG8_WAIT_L(0); PG8_BAR; PG8_MMA(0, 0, At, B0); PG8_MMA(0, 1, At, B1); PG8_BAR; PG8_SCHED;
            PG8_LDA(At, 1, 1); PG8_STAGE(PG8_SB(1, 0), b3, voffB); PG8_STAGE(PG8_SB(1, 1), b3 + hstep, voffB); PG8_STAGE(PG8_SA(1, 0), a3, voffA);
            PG8_WAIT_V(8); PG8_WAIT_L(0); PG8_BAR; PG8_MMA(1, 0, At, B0); PG8_MMA(1, 1, At, B1); PG8_BAR; PG8_SCHED;
            } else {
            PG8_LDB(B0, 0, 0); PG8_SCHED; PG8_LDA(At, 0, 0); PG8_STAGE(PG8_SA(1, 1), a1 + hstep, voffA);
            PG8_WAIT_L(8); PG8_BAR; PG8_WAIT_L(0); PG8_MMA(0, 0, At, B0); PG8_BAR; PG8_SCHED;
            PG8_LDB(B1, 0, 1); PG8_STAGE(PG8_SB(0, 0), b2, voffB);
            PG8_BAR; PG8_WAIT_L(0); PG8_MMA(0, 1, At, B1); PG8_BAR;
            PG8_LDA(At, 0, 1); PG8_STAGE(PG8_SA(0, 0), a2, voffA);
            PG8_BAR; PG8_WAIT_L(0); PG8_MMA(1, 0, At, B0); PG8_BAR; PG8_SCHED;
            PG8_STAGE(PG8_SB(0, 1), b2 + hstep, voffB);
            PG8_WAIT_V(6); PG8_BAR; PG8_MMA(1, 1, At, B1); PG8_BAR;
            PG8_LDB(B0, 1, 0); PG8_SCHED; PG8_LDA(At, 1, 0); PG8_STAGE(PG8_SA(0, 1), a2 + hstep, voffA);
            PG8_WAIT_L(8); PG8_BAR; PG8_WAIT_L(0); PG8_MMA(0, 0, At, B0); PG8_BAR; PG8_SCHED;
            PG8_LDB(B1, 1, 1); PG8_STAGE(PG8_SB(1, 0), b3, voffB);
            PG8_BAR; PG8_WAIT_L(0); PG8_MMA(0, 1, At, B1); PG8_BAR;
            PG8_LDA(At, 1, 1); PG8_STAGE(PG8_SA(1, 0), a3, voffA);
            PG8_BAR; PG8_WAIT_L(0); PG8_MMA(1, 0, At, B0); PG8_BAR; PG8_SCHED;
            PG8_STAGE(PG8_SB(1, 1), b3 + hstep, voffB);
            PG8_WAIT_V(6); PG8_BAR; PG8_MMA(1, 1, At, B1); PG8_BAR;
            }
        }
        if constexpr (ALIGN_EPI) { if (wr == 0) PG8_BAR; }
        if constexpr (!Epi::AFTER_DRAIN) { E(acc, cur, wr, wc, fr, fq); S.done(cur); }
        if (!has_next) break;
#pragma unroll
        for (int a = 0; a < 2; ++a)
#pragma unroll
            for (int b = 0; b < 2; ++b)
#pragma unroll
                for (int m = 0; m < 4; ++m)
#pragma unroll
                    for (int n = 0; n < 2; ++n) acc[a][b][m][n] = (f32x4){0.f, 0.f, 0.f, 0.f};
        cur = nxt; cA = nA; cB = nB; ++ui;
        if constexpr (ALIGN_EPI) { if (wr == 1) PG8_BAR; }
    }
    PG8_WAIT_V(0);
    if constexpr (!ALIGN_EPI) { if (wr == 0) PG8_BAR; }
    PG8_BAR;
    if constexpr (Epi::AFTER_DRAIN) { E.fused(acc, cur, wr, wc, fr, fq, lds, wid, lane); S.done(cur); }
#undef PG8_SA
#undef PG8_SB
#undef PG8_STAGE
#undef PG8_LDA
#undef PG8_LDB
#undef PG8_MMA
#undef PG8_WAIT_V
#undef PG8_WAIT_L
#undef PG8_BAR
#undef PG8_SCHED
}
}

#ifndef PG8_SP2
#define PG8_SP2 true
#endif

#define LAS __attribute__((address_space(3)))
typedef unsigned short bf16;
typedef short bf16x8 __attribute__((ext_vector_type(8)));
typedef float f32x4 __attribute__((ext_vector_type(4)));
typedef float f32x16 __attribute__((ext_vector_type(16)));
typedef unsigned u32x4 __attribute__((ext_vector_type(4)));
typedef unsigned u32x2 __attribute__((ext_vector_type(2)));

constexpr int DM = 1024, NMAIN = 32768, ROWS = 33024, METAROW = 32768, DFF = 4096;
constexpr int NTHREADS = 512;
constexpr int LDS_BYTES = 147456;
constexpr int LDS_ITEM_OFF = LDS_BYTES - 16;
constexpr size_t MiB = 1u << 20;
constexpr size_t WS_CTL = 0, WS_WIN = 1 * MiB, WS_WUPA = 12 * MiB, WS_WUPB = 13 * MiB, WS_WOUT = 14 * MiB, WS_WFF1 = 16 * MiB, WS_WFF2 = 24 * MiB;
constexpr size_t WS_LORA = 32 * MiB, WS_XNMETA = 32 * MiB + 512 * 1024, WS_CB = 33 * MiB, WS_ACT = 36 * MiB;
constexpr size_t ACT_SZ = (size_t)ROWS * 512 * 2, L_SZ = (size_t)ROWS * 256 * 2;
constexpr size_t WS_R = WS_ACT, WS_KA = WS_R + ACT_SZ, WS_VA = WS_KA + ACT_SZ, WS_L = WS_VA + ACT_SZ, WS_Q = WS_L + L_SZ, WS_KB = WS_Q + ACT_SZ, WS_VT = WS_KB + ACT_SZ, WS_END = WS_VT + ACT_SZ;
constexpr size_t WS_GA = WS_KA, WS_GB = WS_KB, WS_MN = WS_ACT, WS_HID = WS_ACT + 64 * MiB;
static_assert(WS_END <= 256 * MiB && WS_HID + 128 * MiB <= 256 * MiB && WS_CB + (size_t)2 * ROWS * 8 * 4 <= WS_ACT, "ws map");
constexpr float LOG2E = 1.4426950408889634f;
constexpr float QSCALE = 0.125f * LOG2E;

struct Params { const float* in[29]; float* out; unsigned char* ws; };
typedef const __attribute__((address_space(4))) Params* KP;
enum { I_XP = 0, I_XS, I_META, I_GMIX, I_WIN, I_MUP, I_MUN, I_W0, I_WUP, I_A0, I_AUP, I_GUP, I_KK, I_KA, I_RK, I_LNW, I_LNB, I_LQ1, I_LK1, I_LQ2, I_LK2, I_SUBG, I_UPA, I_UPB, I_WOUT, I_GFFN, I_FF1, I_FF2, I_GFIN };

__device__ __forceinline__ unsigned cvtpk(float lo, float hi) { unsigned r; asm volatile("v_cvt_pk_bf16_f32 %0, %1, %2" : "=v"(r) : "v"(lo), "v"(hi)); return r; }
__device__ __forceinline__ float bf2f(unsigned short b) { return __uint_as_float(((unsigned)b) << 16); }
__device__ __forceinline__ float bflo(unsigned w) { return __uint_as_float(w << 16); }
__device__ __forceinline__ float bfhi(unsigned w) { return __uint_as_float(w & 0xffff0000u); }
__device__ __forceinline__ void unpack8(const u32x4 v, float* o) { o[0] = bflo(v.x); o[1] = bfhi(v.x); o[2] = bflo(v.y); o[3] = bfhi(v.y); o[4] = bflo(v.z); o[5] = bfhi(v.z); o[6] = bflo(v.w); o[7] = bfhi(v.w); }
__device__ __forceinline__ float wave_sum(float v) {
#pragma unroll
    for (int o = 1; o < 64; o <<= 1) v += __shfl_xor(v, o);
    return v;
}
__device__ __forceinline__ float sigmoidf_(float x) { return 1.0f / (1.0f + __expf(-x)); }
__device__ __forceinline__ int seq_base(int s) { return s == 0 ? 0 : 16384 + (s - 1) * 2048; }
__device__ __forceinline__ int seq_len(int s) { return s == 0 ? 16384 : 2048; }
__device__ __forceinline__ int pos_row(int base, int p) { return p < 16 ? METAROW + p : base + p - 16; }

template <class Op> struct Epi8 {
    static constexpr bool PERM = true, AFTER_DRAIN = false;
    Op op;
    __device__ __forceinline__ void operator()(const pg8::f32x4 (&acc)[2][2][4][2], const pg8::Unit& u, int wr, int wc, int fr, int fq) const {
        const int row0 = u.pm * 256 + wr * 64 + fr, col0 = u.pn * 256 + wc * 32 + 8 * fq;
#pragma unroll
        for (int ai = 0; ai < 2; ++ai)
#pragma unroll
            for (int m = 0; m < 4; ++m)
#pragma unroll
                for (int bj = 0; bj < 2; ++bj) { op.apply(row0 + ai * 128 + m * 16, col0 + bj * 128, u.pn, acc[ai][bj][m][0], acc[ai][bj][m][1]); asm volatile("" ::: "memory"); }
    }
};
__device__ __forceinline__ u32x4 pack8(const f32x4 a, const f32x4 b) { u32x4 w; w.x = cvtpk(a[0], a[1]); w.y = cvtpk(a[2], a[3]); w.z = cvtpk(b[0], b[1]); w.w = cvtpk(b[2], b[3]); return w; }

constexpr int CW_KN = 320;
__device__ __forceinline__ float dpp_max16(float v) {
    int x = __float_as_int(v);
    v = fmaxf(v, __int_as_float(__builtin_amdgcn_update_dpp(0, x, 0xB1, 0xf, 0xf, true))); x = __float_as_int(v);
    v = fmaxf(v, __int_as_float(__builtin_amdgcn_update_dpp(0, x, 0x4E, 0xf, 0xf, true))); x = __float_as_int(v);
    v = fmaxf(v, __int_as_float(__builtin_amdgcn_update_dpp(0, x, 0x141, 0xf, 0xf, true))); x = __float_as_int(v);
    v = fmaxf(v, __int_as_float(__builtin_amdgcn_update_dpp(0, x, 0x140, 0xf, 0xf, true)));
    return v;
}
struct OpProj {
    unsigned char* ws;
    __device__ __forceinline__ void apply(int row, int col, int pn, f32x4 v0, f32x4 v1) const {
        if (pn >= 11) {
            bf16* VT = (bf16*)(ws + WS_VT); const int c = col - 11 * 256;
#pragma unroll
            for (int e = 0; e < 4; ++e) { VT[(size_t)(c + e) * ROWS + row] = (bf16)(cvtpk(v0[e], 0.f) & 0xffffu); VT[(size_t)(c + 4 + e) * ROWS + row] = (bf16)(cvtpk(v1[e], 0.f) & 0xffffu); }
            return;
        }
        bf16* O; int ldc = 512, c;
        if (pn < 2) { O = (bf16*)(ws + WS_R); c = col; }
        else if (pn < 4) { O = (bf16*)(ws + WS_KA); c = col - 512; }
        else if (pn < 6) { O = (bf16*)(ws + WS_VA); c = col - 1024; }
        else if (pn < 7) { O = (bf16*)(ws + WS_L); c = col - 1536; ldc = 256; }
        else if (pn < 9) { O = (bf16*)(ws + WS_Q); c = col - 1792; v0 = v0 * QSCALE; v1 = v1 * QSCALE; }
        else { O = (bf16*)(ws + WS_KB); c = col - 2304; }
        const u32x4 w = pack8(v0, v1);
        *(u32x4*)(O + (size_t)row * ldc + c) = w;
        if (pn >= 9) {
            float k8[8]; unpack8(w, k8); float ss = 0.f;
#pragma unroll
            for (int e = 0; e < 8; ++e) ss = fmaf(k8[e], k8[e], ss);
            ss = dpp_max16(ss);
            if ((threadIdx.x & 15) == 0) { const int sidx = row < 16384 ? 0 : row < NMAIN ? 1 + ((row - 16384) >> 11) : 9;
                atomicMax((unsigned*)(ws + WS_CTL) + CW_KN + sidx * 64 + (c >> 3), __float_as_uint(ss)); }
        }
    }
};
struct OpGate {
    bf16* O;
    __device__ __forceinline__ void apply(int row, int col, int pn, f32x4 v0, f32x4 v1) const {
        const int c = col;
#pragma unroll
        for (int e = 0; e < 4; ++e) { v0[e] = sigmoidf_(v0[e]); v1[e] = sigmoidf_(v1[e]); }
        *(u32x4*)(O + (size_t)row * 1024 + c) = pack8(v0, v1);
    }
};
struct OpUpA {
    unsigned char* ws;
    __device__ __forceinline__ void apply(int row, int col, int pn, f32x4 v0, f32x4 v1) const {
        u32x4* p = (u32x4*)((bf16*)(ws + WS_GA) + (size_t)row * 1024 + col); float g[8]; unpack8(*p, g);
#pragma unroll
        for (int e = 0; e < 4; ++e) { v0[e] *= g[e]; v1[e] *= g[4 + e]; }
        *p = pack8(v0, v1);
    }
};
struct OpUpB {
    unsigned char* ws;
    __device__ __forceinline__ void apply(int row, int col, int pn, f32x4 v0, f32x4 v1) const {
        u32x4* p = (u32x4*)((bf16*)(ws + WS_GB) + (size_t)row * 1024 + col); float g[8], a[8]; unpack8(*p, g);
        unpack8(*(const u32x4*)((const bf16*)(ws + WS_GA) + (size_t)row * 1024 + col), a);
#pragma unroll
        for (int e = 0; e < 4; ++e) { v0[e] = a[e] + v0[e] * g[e]; v1[e] = a[4 + e] + v1[e] * g[4 + e]; }
        *p = pack8(v0, v1);
    }
};
struct OpOut {
    const float* xp; const float* xs; float* out;
    __device__ __forceinline__ void apply(int row, int col, int pn, f32x4 v0, f32x4 v1) const {
        const float* x = (row < 16384 ? xp + (size_t)row * DM : xs + (size_t)(row - 16384) * DM) + col;
        float* o = out + (size_t)row * DM + col;
        *(f32x4*)o = *(const f32x4*)x + v0; *(f32x4*)(o + 4) = *(const f32x4*)(x + 4) + v1;
    }
};
struct OpFF1 {
    bf16* hid;
    __device__ __forceinline__ void apply(int row, int col, int pn, f32x4 v0, f32x4 v1) const {
#pragma unroll
        for (int e = 0; e < 4; ++e) { const float a = fmaxf(v0[e], 0.f), b = fmaxf(v1[e], 0.f); v0[e] = a * a; v1[e] = b * b; }
        *(u32x4*)(hid + (size_t)row * DFF + col) = pack8(v0, v1);
    }
};
struct OpFF2 {
    float* out;
    __device__ __forceinline__ void apply(int row, int col, int pn, f32x4 v0, f32x4 v1) const {
        float* o = out + (size_t)row * DM + col;
        *(f32x4*)o = *(const f32x4*)o + v0; *(f32x4*)(o + 4) = *(const f32x4*)(o + 4) + v1;
    }
};

__device__ __forceinline__ unsigned f2bf_rne(float f) { return cvtpk(f, 0.f) & 0xffffu; }
__device__ __forceinline__ void transpose_item(const float* W, int K, int N, bf16* WT, LAS float* scr, int item, int lane) {
    const int nblk = N / 32, kb = item / nblk, nb = item % nblk, k0 = 64 * kb, n0 = 32 * nb;
#pragma unroll 8
    for (int i = 0; i < 32; ++i) { const int kk = 2 * i + (lane >> 5); scr[kk * 33 + (lane & 31)] = W[(size_t)(k0 + kk) * N + n0 + (lane & 31)]; }
    asm volatile("s_waitcnt vmcnt(0) lgkmcnt(0)" ::: "memory");
    const int c = lane & 7;
#pragma unroll
    for (int j = 0; j < 4; ++j) { const int n = (lane >> 3) + 8 * j; const LAS float* s = scr + (8 * c) * 33 + n;
        u32x4 o; o.x = cvtpk(s[0 * 33], s[1 * 33]); o.y = cvtpk(s[2 * 33], s[3 * 33]); o.z = cvtpk(s[4 * 33], s[5 * 33]); o.w = cvtpk(s[6 * 33], s[7 * 33]);
        *(u32x4*)(WT + (size_t)(n0 + n) * K + k0 + 8 * c) = o; }
    asm volatile("s_waitcnt lgkmcnt(0)" ::: "memory");
}
__device__ __forceinline__ void rms_row_bf16(const float* src, const float* g, bf16* dst, int lane) {
    unsigned long long* o8 = (unsigned long long*)dst + lane;
    if (!src) {
#pragma unroll
        for (int j = 0; j < 4; ++j) o8[64 * j] = 0ull;
        return; }
    const f32x4* xr = (const f32x4*)src + lane; const f32x4* gr = (const f32x4*)g + lane;
    f32x4 v[4]; float s = 0.f;
#pragma unroll
    for (int j = 0; j < 4; ++j) { v[j] = xr[64 * j]; s += (v[j].x * v[j].x + v[j].y * v[j].y) + (v[j].z * v[j].z + v[j].w * v[j].w); }
    const float rstd = rsqrtf(wave_sum(s) * (1.f / DM) + 1e-6f);
#pragma unroll
    for (int j = 0; j < 4; ++j) { const f32x4 gg = gr[64 * j]; const f32x4 y = v[j] * rstd * gg;
        o8[64 * j] = (unsigned long long)cvtpk(y.x, y.y) | ((unsigned long long)cvtpk(y.z, y.w) << 32); }
}
__device__ __forceinline__ void phase_prologue(LAS unsigned char* lds, KP P) {
    const int tid = fresh_tid(), lane = tid & 63, wid = tid >> 6;
    LAS float* scr = (LAS float*)(lds + wid * 16384);
    const int gw = blockIdx.x * 8 + wid, NGW = gridDim.x * 8;
    unsigned char* ws = P->ws;
    constexpr int I_IN = (1024 / 64) * (5376 / 32), I_UP = (512 / 64) * (1024 / 32), I_O = (1024 / 64) * (1024 / 32), I_1 = (1024 / 64) * (4096 / 32), I_2 = (4096 / 64) * (1024 / 32);
    constexpr int I_LW = (64 / 64) * (512 / 32), I_G = (128 / 64) * (512 / 32);
    constexpr int NITEMS = I_IN + 2 * I_UP + I_O + I_1 + I_2 + 4 * I_LW + I_G;
    for (int it = gw; it < NITEMS; it += NGW) {
        int r = it;
        if (r < I_IN) { transpose_item(P->in[I_WIN], 1024, 5376, (bf16*)(ws + WS_WIN), scr, r, lane); continue; } r -= I_IN;
        if (r < I_UP) { transpose_item(P->in[I_UPA], 512, 1024, (bf16*)(ws + WS_WUPA), scr, r, lane); continue; } r -= I_UP;
        if (r < I_UP) { transpose_item(P->in[I_UPB], 512, 1024, (bf16*)(ws + WS_WUPB), scr, r, lane); continue; } r -= I_UP;
        if (r < I_O) { transpose_item(P->in[I_WOUT], 1024, 1024, (bf16*)(ws + WS_WOUT), scr, r, lane); continue; } r -= I_O;
        if (r < I_1) { transpose_item(P->in[I_FF1], 1024, 4096, (bf16*)(ws + WS_WFF1), scr, r, lane); continue; } r -= I_1;
        if (r < I_2) { transpose_item(P->in[I_FF2], 4096, 1024, (bf16*)(ws + WS_WFF2), scr, r, lane); continue; } r -= I_2;
        if (r < 2 * I_LW) { const int d = r / I_LW; transpose_item(P->in[I_WUP] + (size_t)d * 64 * 512, 64, 512, (bf16*)(ws + WS_LORA) + (size_t)d * 512 * 64, scr, r % I_LW, lane); continue; } r -= 2 * I_LW;
        if (r < 2 * I_LW) { const int d = r / I_LW; transpose_item(P->in[I_AUP] + (size_t)d * 64 * 512, 64, 512, (bf16*)(ws + WS_LORA + 131072) + (size_t)d * 512 * 64, scr, r % I_LW, lane); continue; } r -= 2 * I_LW;
        transpose_item(P->in[I_GUP], 128, 512, (bf16*)(ws + WS_LORA + 262144), scr, r, lane);
    }
    bf16* XN = (bf16*)P->out; bf16* XM = (bf16*)(ws + WS_XNMETA);
    for (int m = gw; m < ROWS; m += NGW) {
        const float* src = m < 16384 ? P->in[I_XP] + (size_t)m * DM : m < NMAIN ? P->in[I_XS] + (size_t)(m - 16384) * DM : (m - NMAIN < 16 ? P->in[I_META] + (size_t)(m - NMAIN) * DM : nullptr);
        bf16* dst = m < NMAIN ? XN + (size_t)m * DM : XM + (size_t)(m - NMAIN) * DM;
        rms_row_bf16(src, P->in[I_GMIX], dst, lane);
    }
}

constexpr int AT_KSTR = 272, AT_VSTR = 144, AT_KSZ = 64 * AT_KSTR, AT_BUF = AT_KSZ + 128 * AT_VSTR;
__device__ __forceinline__ f32x16 mfma32(bf16x8 a, bf16x8 b, f32x16 c) { return __builtin_amdgcn_mfma_f32_32x32x16_bf16(a, b, c, 0, 0, 0); }
__device__ __forceinline__ void attn_unit(LAS unsigned char* lds, KP P, int s, int h, int qb, float lam) {
    int tid_ = threadIdx.x; asm volatile("" : "+v"(tid_));
    const int tid = tid_, lane = tid & 63, r32 = lane & 31, hi = lane >> 5, wid = __builtin_amdgcn_readfirstlane(tid >> 6), rg = wid & 3, mp = wid >> 2;
    const int L = seq_len(s), base = seq_base(s), NT = 1 + L / 64;
    unsigned char* ws = P->ws;
    const bf16* KB = (const bf16*)(ws + WS_KB); const bf16* VT = (const bf16*)(ws + WS_VT); bf16* Q = (bf16*)(ws + WS_Q);
    const int qrow = base + qb * 128 + rg * 32 + r32;
    bf16x8 q[4];
#pragma unroll
    for (int d0 = 0; d0 < 4; ++d0) q[d0] = *(const bf16x8*)(Q + (size_t)qrow * 512 + h * 128 + mp * 64 + d0 * 16 + hi * 8);
    f32x16 O[4];
#pragma unroll
    for (int b = 0; b < 4; ++b)
#pragma unroll
        for (int r = 0; r < 16; ++r) O[b][r] = 0.f;
    float mx = -INFINITY, ls = 0.f;
    const float qh = (float)(16 + qb * 128 + rg * 32 + r32 - 4 * hi);
    const float nslope = -exp2f(-2.0f * (float)(h + 1)) * LOG2E;
    const int kr0 = tid >> 4, kc = tid & 15, vn0 = tid >> 3, vc = tid & 7;
    u32x4 kreg[2], vreg[2];
    const unsigned kgo = (unsigned)((kr0 * 512 + h * 128 + kc * 8) * 2), vgo = (unsigned)(((h * 128 + vn0) * ROWS + vc * 8) * 2);
    const unsigned klo = (unsigned)(kr0 * AT_KSTR + kc * 16), vlo = (unsigned)(AT_KSZ + vn0 * AT_VSTR + vc * 16);
#define AT_GLOAD(j) do { const int m0_ = (j) == 0 ? METAROW : base + 64 * ((j) - 1); \
        const unsigned char* kt_ = (const unsigned char*)KB + (size_t)m0_ * 1024; const unsigned char* vt_ = (const unsigned char*)VT + (size_t)m0_ * 2; \
        kreg[0] = *(const u32x4*)(kt_ + kgo); kreg[1] = *(const u32x4*)(kt_ + 32 * 1024 + kgo); \
        vreg[0] = *(const u32x4*)(vt_ + vgo); vreg[1] = *(const u32x4*)(vt_ + (size_t)64 * ROWS * 2 + vgo); } while (0)
#define AT_LSTORE(buf) do { LAS unsigned char* kb_ = lds + (buf) * AT_BUF; \
        *(LAS u32x4*)(kb_ + klo) = kreg[0]; *(LAS u32x4*)(kb_ + klo + 32 * AT_KSTR) = kreg[1]; \
        *(LAS u32x4*)(kb_ + vlo) = vreg[0]; *(LAS u32x4*)(kb_ + vlo + 64 * AT_VSTR) = vreg[1]; } while (0)
    float qn, kn;
    { float ssq = 0.f;
#pragma unroll
      for (int d0 = 0; d0 < 4; ++d0) { float t[8]; unpack8(__builtin_bit_cast(u32x4, q[d0]), t);
#pragma unroll
        for (int e = 0; e < 8; ++e) ssq = fmaf(t[e], t[e], ssq); }
      ssq += __shfl_xor(ssq, 32); qn = sqrtf(ssq) * 1.002f;
      const unsigned* KN = (const unsigned*)(ws + WS_CTL) + CW_KN; float ks = 0.f;
#pragma unroll
      for (int g = 0; g < 8; ++g) ks += fmaxf(__uint_as_float(__hip_atomic_load(KN + s * 64 + h * 16 + mp * 8 + g, __ATOMIC_RELAXED, __HIP_MEMORY_SCOPE_AGENT)), __uint_as_float(__hip_atomic_load(KN + 9 * 64 + h * 16 + mp * 8 + g, __ATOMIC_RELAXED, __HIP_MEMORY_SCOPE_AGENT)));
      kn = sqrtf(ks) * 1.002f; }
    const int jc0 = 1 + qb * 2;
    int jlo = jc0, jhi = jc0 + 1;
    LAS float* red = (LAS float*)(lds + 2 * AT_BUF);
#pragma unroll 1
    for (int ph = 0; ph < 2; ++ph) {
        int nleft, ntl;
        if (ph == 0) { nleft = 0; ntl = 2; }
        else {
            float dneed = (qn * kn - mx + 40.0f) / (-nslope);
#pragma unroll
            for (int o = 1; o < 64; o <<= 1) dneed = fmaxf(dneed, __shfl_xor(dneed, o));
            if (lane == 0) red[wid] = dneed;
            __syncthreads();
            float dm = red[0];
#pragma unroll
            for (int w8 = 1; w8 < 8; ++w8) dm = fmaxf(dm, red[w8]);
            dm = fminf(fmaxf(dm, 0.f), 1.0e6f);
            const int dmax = (int)dm + 1, q0 = 16 + qb * 128;
            const int plo = q0 - dmax, phi = q0 + 127 + dmax;
            jlo = plo < 16 ? 0 : 1 + ((plo - 16) >> 6); jhi = phi >= L + 16 ? NT - 1 : 1 + ((phi - 16) >> 6);
            if (jlo > jc0) jlo = jc0; if (jhi < jc0 + 1) jhi = jc0 + 1;
            nleft = jc0 - jlo; ntl = nleft + (jhi - jc0 - 1);
        }
        if (ntl > 0) {
#define AT_J(t) (ph == 0 ? jc0 + (t) : ((t) < nleft ? jlo + (t) : jc0 + 2 + ((t) - nleft)))
        { const int jf = AT_J(0); AT_GLOAD(jf); } AT_LSTORE(0); __syncthreads();
#pragma unroll 1
        for (int t = 0; t < ntl; ++t) {
            const int j = AT_J(t);
            if (t + 1 < ntl) { const int jn = AT_J(t + 1); AT_GLOAD(jn); }
            const LAS unsigned char* Kb = lds + (t & 1) * AT_BUF + mp * 128; const LAS unsigned char* Vb = lds + (t & 1) * AT_BUF + AT_KSZ;
            const float dq = qh - (float)(j == 0 ? 0 : 64 * j - 48);
            f32x16 p0, p1;
#pragma unroll
            for (int r = 0; r < 16; ++r) { p0[r] = 0.f; p1[r] = 0.f; }
#pragma unroll
            for (int d0 = 0; d0 < 4; ++d0) {
                const bf16x8 a0 = *(const LAS bf16x8*)(Kb + r32 * AT_KSTR + d0 * 32 + hi * 16);
                const bf16x8 a1 = *(const LAS bf16x8*)(Kb + (32 + r32) * AT_KSTR + d0 * 32 + hi * 16);
                p0 = mfma32(a0, q[d0], p0); p1 = mfma32(a1, q[d0], p1);
            }
#pragma unroll
            for (int r = 0; r < 16; ++r) { const float dd = dq - (float)((r & 3) + 8 * (r >> 2)); p0[r] = fmaf(fabsf(dd), nslope, p0[r]); p1[r] = fmaf(fabsf(dd - 32.f), nslope, p1[r]); }
            if (j == 0) {
#pragma unroll
                for (int r = 0; r < 16; ++r) { if ((r & 3) + 8 * (r >> 2) + 4 * hi >= 16) p0[r] = -INFINITY; p1[r] = -INFINITY; }
            }
            float rm = fmaxf(p0[0], p1[0]);
#pragma unroll
            for (int r = 1; r < 16; ++r) rm = fmaxf(rm, fmaxf(p0[r], p1[r]));
            rm = fmaxf(rm, __shfl_xor(rm, 32));
            const float mn = fmaxf(mx, rm);
            if (__any(mn > mx)) {
                const float f = __builtin_amdgcn_exp2f(mx - mn); ls *= f; mx = mn;
#pragma unroll
                for (int b = 0; b < 4; ++b)
#pragma unroll
                    for (int r = 0; r < 16; ++r) O[b][r] *= f;
            }
            float sum = 0.f;
#pragma unroll
            for (int r = 0; r < 16; ++r) { p0[r] = __builtin_amdgcn_exp2f(p0[r] - mx); p1[r] = __builtin_amdgcn_exp2f(p1[r] - mx); sum += p0[r] + p1[r]; }
            ls += sum;
            bf16x8 pf[4];
#pragma unroll
            for (int k2 = 0; k2 < 2; ++k2) {
                u32x4 w0, w1;
                w0.x = cvtpk(p0[8 * k2 + 0], p0[8 * k2 + 1]); w0.y = cvtpk(p0[8 * k2 + 2], p0[8 * k2 + 3]); w0.z = cvtpk(p0[8 * k2 + 4], p0[8 * k2 + 5]); w0.w = cvtpk(p0[8 * k2 + 6], p0[8 * k2 + 7]);
                w1.x = cvtpk(p1[8 * k2 + 0], p1[8 * k2 + 1]); w1.y = cvtpk(p1[8 * k2 + 2], p1[8 * k2 + 3]); w1.z = cvtpk(p1[8 * k2 + 4], p1[8 * k2 + 5]); w1.w = cvtpk(p1[8 * k2 + 6], p1[8 * k2 + 7]);
                pf[k2] = __builtin_bit_cast(bf16x8, w0); pf[2 + k2] = __builtin_bit_cast(bf16x8, w1);
            }
#pragma unroll
            for (int ks = 0; ks < 4; ++ks)
#pragma unroll
                for (int b = 0; b < 4; ++b) {
                    const LAS unsigned char* vp = Vb + (b * 32 + r32) * AT_VSTR + ks * 32 + hi * 8;
                    const u32x2 lo = *(const LAS u32x2*)vp, hh = *(const LAS u32x2*)(vp + 16);
                    u32x4 vv; vv.x = lo.x; vv.y = lo.y; vv.z = hh.x; vv.w = hh.y;
                    O[b] = mfma32(__builtin_bit_cast(bf16x8, vv), pf[ks], O[b]);
                }
            if (t + 1 < ntl) AT_LSTORE((t + 1) & 1);
            __syncthreads();
        }
#undef AT_J
        }
    }
#undef AT_GLOAD
#undef AT_LSTORE
    const float lt = ls + __shfl_xor(ls, 32);
    const float inv = (mp ? lam : 1.0f) / lt;
    int lane2 = lane; asm volatile("" : "+v"(lane2));
    const int r32e = lane2 & 31, hie = lane2 >> 5;
    LAS float* ex = (LAS float*)lds + rg * (128 * 32) + hie * 128 + r32e;
    if (mp == 1) {
#pragma unroll
        for (int b = 0; b < 4; ++b)
#pragma unroll
            for (int r = 0; r < 16; ++r) ex[(32 * b + (r & 3) + 8 * (r >> 2)) * 32] = O[b][r] * inv;
    }
    __syncthreads();
    if (mp == 0) {
        float ss = 0.f;
#pragma unroll
        for (int b = 0; b < 4; ++b)
#pragma unroll
            for (int r = 0; r < 16; ++r) { const float o = O[b][r] * inv - ex[(32 * b + (r & 3) + 8 * (r >> 2)) * 32]; O[b][r] = o; ss += o * o; }
        ss += __shfl_xor(ss, 32);
        const float rstd = rsqrtf(ss * (1.0f / 128.0f) + 1e-5f) * 0.8f;
        const float* sg = P->in[I_SUBG] + 4 * hie; bf16* Qo = Q + (size_t)(base + qb * 128 + rg * 32 + r32e) * 512 + h * 128 + 4 * hie;
#pragma unroll
        for (int b = 0; b < 4; ++b)
#pragma unroll
            for (int r4 = 0; r4 < 4; ++r4) {
                const int n = 32 * b + 8 * r4; const f32x4 g = *(const f32x4*)(sg + n);
                u32x2 w; w.x = cvtpk(O[b][4 * r4 + 0] * rstd * g.x, O[b][4 * r4 + 1] * rstd * g.y); w.y = cvtpk(O[b][4 * r4 + 2] * rstd * g.z, O[b][4 * r4 + 3] * rstd * g.w);
                *(u32x2*)(Qo + n) = w;
            }
    }
    __syncthreads();
}

constexpr int SC_R = 0, SC_K = 16384, SC_V = 32768, SC_W = 49152, SC_B = 65536, SC_KK = 81920, SC_Y = 98304, SC_TW = 114688, SC_AD = 123904, SC_MU = 133120;
__device__ __forceinline__ float dpp_add(float v, int ctrl_id) {
    const int x = __float_as_int(v); int y;
    if (ctrl_id == 0) y = __builtin_amdgcn_update_dpp(0, x, 0xB1, 0xf, 0xf, true);
    else if (ctrl_id == 1) y = __builtin_amdgcn_update_dpp(0, x, 0x4E, 0xf, 0xf, true);
    else if (ctrl_id == 2) y = __builtin_amdgcn_update_dpp(0, x, 0x141, 0xf, 0xf, true);
    else y = __builtin_amdgcn_update_dpp(0, x, 0x140, 0xf, 0xf, true);
    return v + __int_as_float(y);
}
template <int LPR> __device__ __forceinline__ float grp_sum(float v) {
    v = dpp_add(v, 0); v = dpp_add(v, 1); v = dpp_add(v, 2);
    if (LPR == 16) v = dpp_add(v, 3);
    return v;
}
#define BAR_LDS() asm volatile("s_waitcnt lgkmcnt(0)\n\ts_barrier" ::: "memory")
__device__ __forceinline__ float fast_sigmoid(float x) { return __builtin_amdgcn_rcpf(1.0f + __builtin_amdgcn_exp2f(-LOG2E * x)); }
__device__ __forceinline__ float fast_tanh(float x) { return 1.0f - 2.0f * __builtin_amdgcn_rcpf(1.0f + __builtin_amdgcn_exp2f(2.0f * LOG2E * x)); }
template <int NRP, int NSW>
__device__ __forceinline__ void scan_unit(LAS unsigned char* lds, KP P, int s, int d, int h, int rp) {
    constexpr int RPB = 64 / NRP, RPW = RPB / NSW, LPR = 64 / RPW, CPL = 64 / LPR;
    static_assert(LPR == 8 || LPR == 16, "scan geometry");
    int tid_ = threadIdx.x; asm volatile("" : "+v"(tid_));
    const int tid = tid_, lane = tid & 63, wid = __builtin_amdgcn_readfirstlane(tid >> 6);
    const int L = seq_len(s), base = seq_base(s), Ltot = L + 16, nchunk = (Ltot + 63) / 64;
    unsigned char* ws = P->ws;
    const bf16* Rb = (const bf16*)(ws + WS_R); const bf16* KAb = (const bf16*)(ws + WS_KA); const bf16* VAb = (const bf16*)(ws + WS_VA); const bf16* Lb = (const bf16*)(ws + WS_L);
    float* CB = (float*)(ws + WS_CB); bf16* YD = (bf16*)((unsigned char*)P->out + 64 * MiB) + (size_t)d * NMAIN * 512;
    LAS float* fS = (LAS float*)lds; LAS float* fV = (LAS float*)(lds + 81920); LAS float* fY = (LAS float*)(lds + SC_Y); LAS float* fMU = (LAS float*)(lds + SC_MU);
#define SCI(sl_, a_, c_) ((sl_) * 320 + (a_) * 64 + (c_))
    for (int i = tid; i < 832; i += NTHREADS) {
        float v;
        if (i < 640) { const int which = i / 320, jj = i % 320, a = jj >> 6, c = jj & 63; const int gi = a < 3 ? a * 512 + h * 64 + c : 1536 + (a - 3) * 64 + c; v = P->in[which ? I_MUN : I_MUP][gi]; }
        else { const int a = (i - 640) >> 6, c = (i - 640) & 63; v = P->in[a == 0 ? I_KK : a == 1 ? I_KA : I_RK][h * 64 + c]; }
        fMU[i] = v;
    }
    const int mat = wid >> 2, ntile = wid & 3;
    const bf16* Wt = (const bf16*)(ws + WS_LORA + (mat ? 131072 : 0)) + ((size_t)d * 512 + h * 64 + ntile * 16 + (lane & 15)) * 64 + (lane >> 4) * 8;
    const bf16x8 bfr0 = *(const bf16x8*)Wt, bfr1 = *(const bf16x8*)(Wt + 32);
    const float bias = P->in[mat ? I_A0 : I_W0][d * 512 + h * 64 + ntile * 16 + (lane & 15)];
    float S[CPL];
#pragma unroll
    for (int j = 0; j < CPL; ++j) S[j] = 0.f;
    const int rowl = lane / LPR, kg = lane % LPR, srow = rp * RPB + wid * RPW + rowl;
    const int slot = tid >> 3, cg8 = (tid & 7) * 8;
    u32x4 raw[5][3];
#define SC_LOAD(c) do { const int i_ = 64 * (c) + slot; const bool ok_ = i_ < Ltot; const int p_ = d ? Ltot - 1 - i_ : i_; \
        const unsigned zr_ = (unsigned)(METAROW + 64); \
        const unsigned rc_ = ok_ ? (unsigned)pos_row(base, p_) : zr_, rp_ = (ok_ && p_ > 0) ? (unsigned)pos_row(base, p_ - 1) : zr_, rn_ = (ok_ && p_ + 1 < Ltot) ? (unsigned)pos_row(base, p_ + 1) : zr_; \
        _Pragma("unroll") for (int a_ = 0; a_ < 5; ++a_) { const unsigned char* B_ = (const unsigned char*)(a_ == 0 ? Rb : a_ == 1 ? KAb : a_ == 2 ? VAb : Lb); const unsigned ld_ = a_ < 3 ? 1024u : 512u; \
            const unsigned co_ = (unsigned)(((a_ < 3 ? h * 64 : (a_ - 3) * 64) + cg8) * 2); \
            raw[a_][0] = *(const u32x4*)(B_ + (rp_ * ld_ + co_)); raw[a_][1] = *(const u32x4*)(B_ + (rc_ * ld_ + co_)); raw[a_][2] = *(const u32x4*)(B_ + (rn_ * ld_ + co_)); } } while (0)
    SC_LOAD(0);
    BAR_LDS();
    for (int c = 0; c < nchunk; ++c) {
        const int nvalid = (Ltot - 64 * c) < 64 ? (Ltot - 64 * c) : 64;
        float rv[8], kv[8];
#pragma unroll
        for (int a = 0; a < 5; ++a) {
            float pv[8], cv[8], nv[8], o[8]; unpack8(raw[a][0], pv); unpack8(raw[a][1], cv); unpack8(raw[a][2], nv);
            const f32x4 mp0 = *(const LAS f32x4*)(fMU + a * 64 + cg8), mp1 = *(const LAS f32x4*)(fMU + a * 64 + cg8 + 4), mn0 = *(const LAS f32x4*)(fMU + 320 + a * 64 + cg8), mn1 = *(const LAS f32x4*)(fMU + 320 + a * 64 + cg8 + 4);
#pragma unroll
            for (int e = 0; e < 8; ++e) { const float mp = e < 4 ? mp0[e & 3] : mp1[e & 3], mn = e < 4 ? mn0[e & 3] : mn1[e & 3]; o[e] = cv[e] + mp * (pv[e] - cv[e]) + mn * (nv[e] - cv[e]); }
            if (a == 0) {
#pragma unroll
                for (int e = 0; e < 8; ++e) rv[e] = o[e];
                LAS float* dst = fS + SCI(slot, 4, cg8); *(LAS f32x4*)dst = (f32x4){o[0], o[1], o[2], o[3]}; *(LAS f32x4*)(dst + 4) = (f32x4){o[4], o[5], o[6], o[7]};
            } else if (a == 1) {
#pragma unroll
                for (int e = 0; e < 8; ++e) kv[e] = o[e];
            } else if (a == 2) {
                LAS float* dst = fV + slot * 64 + cg8; *(LAS f32x4*)dst = (f32x4){o[0], o[1], o[2], o[3]}; *(LAS f32x4*)(dst + 4) = (f32x4){o[4], o[5], o[6], o[7]};
            } else {
                if (a == 3) {
#pragma unroll
                    for (int e = 0; e < 8; ++e) o[e] = fast_tanh(o[e]);
                }
                u32x4 w; w.x = cvtpk(o[0], o[1]); w.y = cvtpk(o[2], o[3]); w.z = cvtpk(o[4], o[5]); w.w = cvtpk(o[6], o[7]);
                *(LAS u32x4*)(lds + (a == 3 ? SC_TW : SC_AD) + slot * 144 + cg8 * 2) = w;
            }
        }
        BAR_LDS();
        if (c + 1 < nchunk) SC_LOAD(c + 1);
        {
            const LAS unsigned char* Ab = lds + (mat ? SC_AD : SC_TW); LAS float* fWB = fS + (mat ? 128 : 64);
#pragma unroll
            for (int mt = 0; mt < 4; ++mt) {
                const bf16x8 a0 = *(const LAS bf16x8*)(Ab + (mt * 16 + (lane & 15)) * 144 + (lane >> 4) * 16);
                const bf16x8 a1 = *(const LAS bf16x8*)(Ab + (mt * 16 + (lane & 15)) * 144 + 64 + (lane >> 4) * 16);
                f32x4 acc = {0.f, 0.f, 0.f, 0.f};
                acc = __builtin_amdgcn_mfma_f32_16x16x32_bf16(a0, bfr0, acc, 0, 0, 0);
                acc = __builtin_amdgcn_mfma_f32_16x16x32_bf16(a1, bfr1, acc, 0, 0, 0);
#pragma unroll
                for (int rg = 0; rg < 4; ++rg) {
                    const int sl = mt * 16 + (lane >> 4) * 4 + rg, col = ntile * 16 + (lane & 15);
                    const float sg = fast_sigmoid(acc[rg] + bias); const float dc = __builtin_amdgcn_exp2f(-0.6065306597126334f * LOG2E * sg);
                    fWB[sl * 320 + col] = mat ? sg : dc;
                }
            }
        }
        BAR_LDS();
        {
            const f32x4 a0 = *(const LAS f32x4*)(fS + SCI(slot, 2, cg8)), a1 = *(const LAS f32x4*)(fS + SCI(slot, 2, cg8 + 4));
            const f32x4 kk0 = *(const LAS f32x4*)(fMU + 640 + cg8), kk1 = *(const LAS f32x4*)(fMU + 640 + cg8 + 4), ka0 = *(const LAS f32x4*)(fMU + 704 + cg8), ka1 = *(const LAS f32x4*)(fMU + 704 + cg8 + 4);
            const f32x4 rk0 = *(const LAS f32x4*)(fMU + 768 + cg8), rk1 = *(const LAS f32x4*)(fMU + 768 + cg8 + 4);
            float kkv[8], kd[8], av[8]; float ssq = 0.f, cs = 0.f;
#pragma unroll
            for (int e = 0; e < 8; ++e) {
                av[e] = e < 4 ? a0[e & 3] : a1[e & 3];
                kkv[e] = kv[e] * (e < 4 ? kk0[e & 3] : kk1[e & 3]); ssq = fmaf(kkv[e], kkv[e], ssq);
                kd[e] = kv[e] * (1.0f + (av[e] - 1.0f) * (e < 4 ? ka0[e & 3] : ka1[e & 3])); cs = fmaf(rv[e] * kd[e], e < 4 ? rk0[e & 3] : rk1[e & 3], cs);
            }
            ssq = grp_sum<8>(ssq); cs = grp_sum<8>(cs);
            const float rs = rsqrtf(fmaxf(ssq, 1e-24f));
#pragma unroll
            for (int e = 0; e < 8; ++e) { kkv[e] *= rs; av[e] *= kkv[e]; }
            LAS float* o1 = fS + SCI(slot, 0, cg8); *(LAS f32x4*)o1 = (f32x4){kkv[0], kkv[1], kkv[2], kkv[3]}; *(LAS f32x4*)(o1 + 4) = (f32x4){kkv[4], kkv[5], kkv[6], kkv[7]};
            LAS float* o2 = fS + SCI(slot, 2, cg8); *(LAS f32x4*)o2 = (f32x4){av[0], av[1], av[2], av[3]}; *(LAS f32x4*)(o2 + 4) = (f32x4){av[4], av[5], av[6], av[7]};
            LAS float* o3 = fS + SCI(slot, 3, cg8); *(LAS f32x4*)o3 = (f32x4){kd[0], kd[1], kd[2], kd[3]}; *(LAS f32x4*)(o3 + 4) = (f32x4){kd[4], kd[5], kd[6], kd[7]};
            if (cg8 == 0 && rp == 0 && slot < nvalid) { const int i2 = 64 * c + slot; const int p2 = d ? Ltot - 1 - i2 : i2; CB[((size_t)d * ROWS + pos_row(base, p2)) * 8 + h] = cs; }
        }
        BAR_LDS();
        if (wid < NSW) {
            typedef float f32x2_ __attribute__((ext_vector_type(2)));
            constexpr int C4 = CPL / 4;
            const LAS float* ps = fS + kg * CPL; const LAS float* pv = fV + srow; LAS float* py = fY + srow;
            f32x4 nk[C4], nw[C4], nb[C4], nd[C4], nr[C4]; float nv;
#define SC_FETCH(sl_) do { _Pragma("unroll") for (int j_ = 0; j_ < C4; ++j_) { nk[j_] = *(const LAS f32x4*)(ps + (sl_) * 320 + 4 * j_); nw[j_] = *(const LAS f32x4*)(ps + (sl_) * 320 + 64 + 4 * j_); \
                nb[j_] = *(const LAS f32x4*)(ps + (sl_) * 320 + 128 + 4 * j_); nd[j_] = *(const LAS f32x4*)(ps + (sl_) * 320 + 192 + 4 * j_); nr[j_] = *(const LAS f32x4*)(ps + (sl_) * 320 + 256 + 4 * j_); } nv = pv[(sl_) * 64]; } while (0)
            SC_FETCH(0);
            f32x4 rp4[C4];
#pragma unroll
            for (int j = 0; j < C4; ++j) rp4[j] = (f32x4){0.f, 0.f, 0.f, 0.f};
#pragma unroll 16
            for (int sl = 0; sl < nvalid; ++sl) {
                f32x4 ck[C4], cw[C4], cb[C4], cd[C4], cr[C4];
#pragma unroll
                for (int j = 0; j < C4; ++j) { ck[j] = nk[j]; cw[j] = nw[j]; cb[j] = nb[j]; cd[j] = nd[j]; cr[j] = nr[j]; }
                const float vv = nv;
                SC_FETCH(sl + 1 < 64 ? sl + 1 : 63);
                f32x2_ pa = {0.f, 0.f}, ya = {0.f, 0.f};
#pragma unroll
                for (int j = 0; j < C4; ++j)
#pragma unroll
                    for (int e = 0; e < 4; e += 2) { const f32x2_ s2 = {S[4 * j + e], S[4 * j + e + 1]}, k2 = {ck[j][e], ck[j][e + 1]}, r2 = {rp4[j][e], rp4[j][e + 1]}; pa = pa + s2 * k2; ya = ya + s2 * r2; }
                float pp = pa.x + pa.y, yy = ya.x + ya.y;
                pp = dpp_add(pp, 0); yy = dpp_add(yy, 0); pp = dpp_add(pp, 1); yy = dpp_add(yy, 1); pp = dpp_add(pp, 2); yy = dpp_add(yy, 2);
                if (LPR == 16) { pp = dpp_add(pp, 3); yy = dpp_add(yy, 3); }
                py[(sl > 0 ? sl - 1 : 0) * 64] = yy;
#pragma unroll
                for (int j = 0; j < C4; ++j)
#pragma unroll
                    for (int e = 0; e < 4; e += 2) {
                        const f32x2_ b2 = {cb[j][e], cb[j][e + 1]}, d2 = {cd[j][e], cd[j][e + 1]}, w2 = {cw[j][e], cw[j][e + 1]}; f32x2_ s2 = {S[4 * j + e], S[4 * j + e + 1]};
                        const f32x2_ t2 = d2 * vv - b2 * pp; s2 = s2 * w2 + t2; S[4 * j + e] = s2.x; S[4 * j + e + 1] = s2.y; }
#pragma unroll
                for (int j = 0; j < C4; ++j) rp4[j] = cr[j];
            }
            {
                f32x2_ ya = {0.f, 0.f};
#pragma unroll
                for (int j = 0; j < C4; ++j)
#pragma unroll
                    for (int e = 0; e < 4; e += 2) { const f32x2_ s2 = {S[4 * j + e], S[4 * j + e + 1]}, r2 = {rp4[j][e], rp4[j][e + 1]}; ya = ya + s2 * r2; }
                const float yy = grp_sum<LPR>(ya.x + ya.y);
                py[(nvalid - 1) * 64] = yy;
            }
#undef SC_FETCH
        }
        BAR_LDS();
        {
            const int i2 = 64 * c + slot; const int p2 = d ? Ltot - 1 - i2 : i2;
            if (slot < nvalid && p2 >= 16 && (cg8 / RPB) == rp) {
                const LAS float* yp = fY + slot * 64 + cg8; const f32x4 y0 = *(const LAS f32x4*)yp, y1 = *(const LAS f32x4*)(yp + 4);
                *(u32x4*)(YD + (size_t)(base + p2 - 16) * 512 + h * 64 + cg8) = pack8(y0, y1);
            }
        }
    }
#undef SC_LOAD
#undef SCI
}

__device__ __forceinline__ void phase_post(LAS unsigned char* lds, KP P) {
    const int tid = fresh_tid(), lane = tid & 63, wid = tid >> 6;
    unsigned char* ws = P->ws;
    const bf16* VAb = (const bf16*)(ws + WS_VA); const bf16* Lb = (const bf16*)(ws + WS_L); bf16* Rb = (bf16*)(ws + WS_R);
    const float* CB = (const float*)(ws + WS_CB); const bf16* YD0 = (const bf16*)((const unsigned char*)P->out + 64 * MiB); const bf16* YD1 = YD0 + (size_t)NMAIN * 512;
    const bf16* GT = (const bf16*)(ws + WS_LORA + 262144);
    LAS float* st = (LAS float*)(lds + 17408);
    const float* mup = P->in[I_MUP]; const float* mun = P->in[I_MUN];
    for (int tile = blockIdx.x; tile < NMAIN / 64; tile += gridDim.x) {
        {
            const int row = tid >> 3, hh = tid & 7, m = tile * 64 + row;
            const int t = m < 16384 ? m : (m - 16384) & 2047, Ls = m < 16384 ? 16384 : 2048;
            float sum = 0.f, sq = 0.f;
#pragma unroll
            for (int i = 0; i < 8; ++i) { float a[8], b[8]; unpack8(*(const u32x4*)(YD0 + (size_t)m * 512 + hh * 64 + i * 8), a); unpack8(*(const u32x4*)(YD1 + (size_t)m * 512 + hh * 64 + i * 8), b);
#pragma unroll
                for (int e = 0; e < 8; ++e) { const float y = a[e] + b[e]; sum += y; sq += y * y; } }
            const float mu = sum * (1.0f / 64.0f); const float var = fmaxf(sq * (1.0f / 64.0f) - mu * mu, 0.f);
            st[(row * 8 + hh) * 2] = mu; st[(row * 8 + hh) * 2 + 1] = rsqrtf(var + 64e-5f);
            const size_t rp_ = t == 0 ? (size_t)(METAROW + 15) : (size_t)(m - 1); const bool okn = t + 1 < Ls;
#pragma unroll
            for (int i = 0; i < 2; ++i) {
                const int c0 = 128 + hh * 16 + i * 8; float pv[8], cv[8], nv[8], o[8];
                unpack8(*(const u32x4*)(Lb + rp_ * 256 + c0), pv); unpack8(*(const u32x4*)(Lb + (size_t)m * 256 + c0), cv);
                if (okn) unpack8(*(const u32x4*)(Lb + (size_t)(m + 1) * 256 + c0), nv); else {
#pragma unroll
                    for (int e = 0; e < 8; ++e) nv[e] = 0.f; }
#pragma unroll
                for (int e = 0; e < 8; ++e) { const float mp = mup[1536 + c0 + e], mn = mun[1536 + c0 + e]; o[e] = sigmoidf_(cv[e] + mp * (pv[e] - cv[e]) + mn * (nv[e] - cv[e])); }
                u32x4 w; w.x = cvtpk(o[0], o[1]); w.y = cvtpk(o[2], o[3]); w.z = cvtpk(o[4], o[5]); w.w = cvtpk(o[6], o[7]);
                *(LAS u32x4*)(lds + row * 272 + (hh * 16 + i * 8) * 2) = w;
            }
        }
        __syncthreads();
#pragma unroll 1
        for (int nt = 0; nt < 4; ++nt) {
            const int col = wid * 64 + nt * 16 + (lane & 15);
            bf16x8 bfr[4];
#pragma unroll
            for (int ks = 0; ks < 4; ++ks) bfr[ks] = *(const bf16x8*)(GT + (size_t)col * 128 + ks * 32 + (lane >> 4) * 8);
            const float lw = P->in[I_LNW][col], lb = P->in[I_LNB][col];
            const float mpv = mup[1024 + col], mnv = mun[1024 + col];
#pragma unroll 1
            for (int mt = 0; mt < 4; ++mt) {
                f32x4 acc = {0.f, 0.f, 0.f, 0.f};
#pragma unroll
                for (int ks = 0; ks < 4; ++ks) { const bf16x8 a = *(const LAS bf16x8*)(lds + (mt * 16 + (lane & 15)) * 272 + ks * 64 + (lane >> 4) * 16); acc = __builtin_amdgcn_mfma_f32_16x16x32_bf16(a, bfr[ks], acc, 0, 0, 0); }
#pragma unroll
                for (int rg = 0; rg < 4; ++rg) {
                    const int row = mt * 16 + (lane >> 4) * 4 + rg, m = tile * 64 + row;
                    const int t = m < 16384 ? m : (m - 16384) & 2047, Ls = m < 16384 ? 16384 : 2048;
                    const float y = bf2f(YD0[(size_t)m * 512 + col]) + bf2f(YD1[(size_t)m * 512 + col]);
                    const float yn = (y - st[(row * 8 + wid) * 2]) * st[(row * 8 + wid) * 2 + 1] * lw + lb;
                    const float vc = bf2f(VAb[(size_t)m * 512 + col]);
                    const float vp = bf2f(VAb[(t == 0 ? (size_t)(METAROW + 15) : (size_t)(m - 1)) * 512 + col]);
                    const float vn = t + 1 < Ls ? bf2f(VAb[(size_t)(m + 1) * 512 + col]) : 0.f;
                    const float vs = vc + mpv * (vp - vc) + mnv * (vn - vc);
                    const float cb = CB[(size_t)m * 8 + wid] + CB[((size_t)ROWS + m) * 8 + wid];
                    Rb[(size_t)m * 512 + col] = (bf16)f2bf_rne((yn + cb * vs) * acc[rg]);
                }
            }
        }
        __syncthreads();
    }
}

__device__ __forceinline__ void phase_rms_bf16(KP P) {
    const int tid = fresh_tid(), lane = tid & 63, wid = tid >> 6; const int gw = blockIdx.x * 8 + wid, NGW = gridDim.x * 8;
    bf16* MN = (bf16*)(P->ws + WS_MN);
    for (int m = gw; m < NMAIN; m += NGW) rms_row_bf16(P->out + (size_t)m * DM, P->in[I_GFFN], MN + (size_t)m * DM, lane);
}
__device__ __forceinline__ void phase_final(KP P) {
    const int tid = fresh_tid(), lane = tid & 63, wid = tid >> 6; const int gw = blockIdx.x * 8 + wid, NGW = gridDim.x * 8;
    const f32x4* gr = (const f32x4*)P->in[I_GFIN] + lane;
    for (int m = gw; m < NMAIN; m += NGW) {
        f32x4* xr = (f32x4*)(P->out + (size_t)m * DM) + lane; f32x4 v[4]; float s = 0.f;
#pragma unroll
        for (int j = 0; j < 4; ++j) { v[j] = xr[64 * j]; s += (v[j].x * v[j].x + v[j].y * v[j].y) + (v[j].z * v[j].z + v[j].w * v[j].w); }
        const float rstd = rsqrtf(wave_sum(s) * (1.f / DM) + 1e-6f);
#pragma unroll
        for (int j = 0; j < 4; ++j) xr[64 * j] = v[j] * rstd * gr[64 * j];
    }
}

constexpr int NRP_LONG = 4;
constexpr int N_LONG = 16 * NRP_LONG, N_ATT_P = 512, N_ATT_S = 512, N_SHORT = 128, N_ITEMS = N_LONG + N_ATT_P + N_ATT_S + N_SHORT;

template <class Op> __device__ __forceinline__ void run_gemm(LAS unsigned char* lds, const bf16* A, const bf16* Bt, int M, int N, int K, const Op& op, const bf16* A2 = nullptr, int pm2 = 1 << 30) {
    pg8::Gemm g{A, Bt, M, N, K, A2, pm2}; pg8::StaticOrder S; S.init(M, N, (int)gridDim.x, (int)blockIdx.x);
    Epi8<Op> E{op};
    pg8::gemm_phase<Epi8<Op>, pg8::StaticOrder, true, true>(lds, g, S, E);
}

constexpr size_t WS_XBAR = 16384;
#define XB_TMO      128
#define XB_XCNT(j)  (256  + 64 * (j))
#define XB_XSUB(j)  (1280 + 64 * (j))
#define XB_XGEN(j)  (2304 + 64 * (j))
#define XB_TOP      3328
#define XB_TOPGEN   3392
#define XCD_BAR_WORDS 3456
#define XB_SPIN_CAP (1u << 18)
__device__ __forceinline__ unsigned xb_ld(unsigned* p)              { return __hip_atomic_load(p, __ATOMIC_RELAXED, __HIP_MEMORY_SCOPE_AGENT); }
__device__ __forceinline__ unsigned xb_add(unsigned* p, unsigned v) { return __hip_atomic_fetch_add(p, v, __ATOMIC_RELAXED, __HIP_MEMORY_SCOPE_AGENT); }
__device__ __forceinline__ unsigned xb_xcc_id() { return (unsigned)__builtin_amdgcn_s_getreg((3 << 11) | 20) & 0xFu; }
#define XB_SPIN(cond, bar) do { unsigned _sp = 0; while (cond) { __builtin_amdgcn_s_sleep(1); \
    if ((++_sp & 255u) == 0u) { if (xb_ld(&(bar)[XB_TMO])) break; if (_sp > XB_SPIN_CAP) { atomicAdd(&(bar)[XB_TMO], 1u); break; } } } } while (0)
struct XcdBarrier { unsigned* bar; unsigned x; volatile LAS unsigned* st; };
__device__ __forceinline__ XcdBarrier xcd_barrier_post(unsigned* bar, volatile LAS unsigned* st) {
    XcdBarrier b; b.bar = bar; b.x = xb_xcc_id(); b.st = st;
    if (threadIdx.x == 0) (void)xb_add(&bar[XB_XCNT(b.x)], 1u);
    return b;
}
__device__ __forceinline__ void xcd_barrier_complete(unsigned* bar, unsigned x, unsigned& nloc, unsigned& nx) {
    const unsigned G = gridDim.x * gridDim.y * gridDim.z;
    unsigned sum, cnt, mine, sp = 0u;
    for (;;) {
        sum = 0u; cnt = 0u; mine = 0u;
#pragma unroll
        for (unsigned j = 0; j < 16; ++j) { const unsigned c = xb_ld(&bar[XB_XCNT(j)]); sum += c; cnt += (c > 0u) ? 1u : 0u; mine = (j == x) ? c : mine; }
        if (sum == G) break;
        __builtin_amdgcn_s_sleep(1);
        if ((++sp & 255u) == 0u) { if (xb_ld(&bar[XB_TMO])) break; if (sp > XB_SPIN_CAP) { atomicAdd(&bar[XB_TMO], 1u); break; } }
    }
    nloc = mine > 0u ? mine : 1u; nx = cnt > 0u ? cnt : 1u;
}
__device__ __forceinline__ void xcd_barrier(const XcdBarrier& b) {
    asm volatile("s_waitcnt vmcnt(0)" ::: "memory");
    __syncthreads();
    if (threadIdx.x == 0) {
        unsigned* bar = b.bar;
        __builtin_amdgcn_s_waitcnt(0);
        unsigned nloc = b.st[0], nx = b.st[1];
        if (nloc == 0u) { xcd_barrier_complete(bar, b.x, nloc, nx); b.st[0] = nloc; b.st[1] = nx; }
        const unsigned old = xb_add(&bar[XB_XSUB(b.x)], 1u);
        const unsigned gen = old / nloc;
        if (old + 1u == (gen + 1u) * nloc) {
            __builtin_amdgcn_fence(__ATOMIC_RELEASE, "agent");
            asm volatile("s_waitcnt vmcnt(0)" ::: "memory");
            const unsigned og = xb_add(&bar[XB_TOP], 1u);
            const unsigned tg = og / nx;
            if (og + 1u == (tg + 1u) * nx) xb_add(&bar[XB_TOPGEN], 1u);
            else XB_SPIN(xb_ld(&bar[XB_TOPGEN]) == tg, bar);
            __builtin_amdgcn_fence(__ATOMIC_ACQUIRE, "agent");
            xb_add(&bar[XB_XGEN(b.x)], 1u);
            asm volatile("s_waitcnt vmcnt(0)" ::: "memory");
        } else {
            XB_SPIN(xb_ld(&bar[XB_XGEN(b.x)]) == gen, bar);
            __builtin_amdgcn_fence(__ATOMIC_ACQUIRE, "agent");
            asm volatile("s_waitcnt vmcnt(0)" ::: "memory");
        }
    }
    __syncthreads();
}
#ifndef PROBE_MASK
#define PROBE_MASK 0
#endif
#ifndef PROBE_MUL
#define PROBE_MUL 1
#endif
#define PH_BEGIN(k) unsigned long long t0_##k = 0; if (PROBE_MASK & (1 << (k))) t0_##k = __builtin_amdgcn_s_memrealtime();
#define PH_END(k) if (PROBE_MASK & (1 << (k))) { const unsigned long long t1_ = __builtin_amdgcn_s_memrealtime(); const unsigned long long dt_ = (t1_ - t0_##k) * PROBE_MUL; while (__builtin_amdgcn_s_memrealtime() - t1_ < dt_) __builtin_amdgcn_s_sleep(8); xcd_barrier(xbar); }
__global__ void __launch_bounds__(NTHREADS) fwd_megakernel(Params Pin) {
    extern __shared__ __attribute__((aligned(16))) unsigned char lds_raw[];
    LAS unsigned char* lds = (LAS unsigned char*)lds_raw;
    cg::grid_group grid = cg::this_grid();
    KP P0 = (KP)__builtin_amdgcn_kernarg_segment_ptr();
    volatile LAS unsigned* xst = (volatile LAS unsigned*)(lds + LDS_ITEM_OFF + 4);
    if (threadIdx.x == 0) { xst[0] = 0u; xst[1] = 0u; }
    __syncthreads();
    const XcdBarrier xbar = xcd_barrier_post((unsigned*)(P0->ws + WS_XBAR), xst);
#define NEWPHASE KP P = P0; asm volatile("" : "+s"(P)); unsigned char* ws = P->ws; (void)ws;

    PH_BEGIN(0)
    { NEWPHASE phase_prologue(lds, P); }
    grid.sync();
    PH_END(0)
    PH_BEGIN(1)
    { NEWPHASE run_gemm(lds, (const bf16*)P->out, (const bf16*)(ws + WS_WIN), ROWS, 3328, 1024, OpProj{ws}, (const bf16*)(ws + WS_XNMETA), 128); }
    xcd_barrier(xbar);
    PH_END(1)
    PH_BEGIN(2)
    { NEWPHASE
        const int tid = fresh_tid();
        float lam;
        { const int lane = tid & 63; const float s1 = wave_sum(P->in[I_LQ1][lane] * P->in[I_LK1][lane]), s2 = wave_sum(P->in[I_LQ2][lane] * P->in[I_LK2][lane]); lam = __expf(s1) - __expf(s2) + 0.2f; }
        unsigned* ctr = (unsigned*)(ws + WS_CTL);
        LAS unsigned* slot = (LAS unsigned*)(lds + LDS_ITEM_OFF);
#define FETCH(k, n) if (tid == 0) *slot = atomicAdd(ctr + 64 * (k), 1u); __syncthreads(); const int idx = (int)*slot; __syncthreads(); if (idx >= (n)) break;
#ifndef NO_SCAN
#pragma unroll 1
        for (;;) { FETCH(0, N_LONG) const int u = idx / NRP_LONG; scan_unit<NRP_LONG, 4>(lds, P, 0, u >> 3, u & 7, idx % NRP_LONG); }
#endif
#ifndef NO_ATTN
#pragma unroll 1
        for (;;) { FETCH(1, N_ATT_P + N_ATT_S)
            if (idx < N_ATT_P) attn_unit(lds, P, 0, idx >> 7, idx & 127, lam);
            else { const int a = idx - N_ATT_P; attn_unit(lds, P, 1 + (a >> 6), (a >> 4) & 3, a & 15, lam); } }
#endif
#ifndef NO_SCAN
#pragma unroll 1
        for (;;) { FETCH(2, N_SHORT) scan_unit<1, 8>(lds, P, 1 + (idx >> 4), (idx >> 3) & 1, idx & 7, 0); }
#endif
#undef FETCH
    }
    xcd_barrier(xbar);
    PH_END(2)
#ifndef NO_POST
    PH_BEGIN(3)
    { NEWPHASE phase_post(lds, P); }
#endif
    xcd_barrier(xbar);
    PH_END(3)
    PH_BEGIN(4)
    { NEWPHASE run_gemm(lds, (const bf16*)P->out, (const bf16*)(ws + WS_WIN) + (size_t)3328 * 1024, NMAIN, 1024, 1024, OpGate{(bf16*)(ws + WS_GA)}); }
    { NEWPHASE run_gemm(lds, (const bf16*)P->out, (const bf16*)(ws + WS_WIN) + (size_t)4352 * 1024, NMAIN, 1024, 1024, OpGate{(bf16*)(ws + WS_GB)}); }

    PH_END(4)
    PH_BEGIN(5)
    { NEWPHASE run_gemm(lds, (const bf16*)(ws + WS_R), (const bf16*)(ws + WS_WUPA), NMAIN, 1024, 512, OpUpA{ws}); }
    PH_END(5)
    PH_BEGIN(6)
    { NEWPHASE run_gemm(lds, (const bf16*)(ws + WS_Q), (const bf16*)(ws + WS_WUPB), NMAIN, 1024, 512, OpUpB{ws}); }
    xcd_barrier(xbar);
    PH_END(6)
    PH_BEGIN(7)
    { NEWPHASE run_gemm(lds, (const bf16*)(ws + WS_GB), (const bf16*)(ws + WS_WOUT), NMAIN, 1024, 1024, OpOut{P->in[I_XP], P->in[I_XS], P->out}); }
    xcd_barrier(xbar);
    PH_END(7)
    PH_BEGIN(8)
    { NEWPHASE phase_rms_bf16(P); }
    xcd_barrier(xbar);
    PH_END(8)
    PH_BEGIN(9)
    { NEWPHASE run_gemm(lds, (const bf16*)(ws + WS_MN), (const bf16*)(ws + WS_WFF1), 16384, DFF, 1024, OpFF1{(bf16*)(ws + WS_HID)}); }
    xcd_barrier(xbar);
    PH_END(9)
    PH_BEGIN(10)
    { NEWPHASE run_gemm(lds, (const bf16*)(ws + WS_HID), (const bf16*)(ws + WS_WFF2), 16384, 1024, DFF, OpFF2{P->out}); }
    xcd_barrier(xbar);
    PH_END(10)
    PH_BEGIN(11)
    { NEWPHASE run_gemm(lds, (const bf16*)(ws + WS_MN) + (size_t)16384 * DM, (const bf16*)(ws + WS_WFF1), 16384, DFF, 1024, OpFF1{(bf16*)(ws + WS_HID)}); }
    xcd_barrier(xbar);
    PH_END(11)
    PH_BEGIN(12)
    { NEWPHASE run_gemm(lds, (const bf16*)(ws + WS_HID), (const bf16*)(ws + WS_WFF2), 16384, 1024, DFF, OpFF2{P->out + (size_t)16384 * DM}); }
    xcd_barrier(xbar);
    PH_END(12)
    PH_BEGIN(13)
    { NEWPHASE phase_final(P); }
}

extern "C" void kernel_launch(void* const* d_in, const int* in_sizes, int n_in, void* d_out, int out_size, void* d_ws, size_t ws_size, hipStream_t stream) {
    static int grid_blocks = 0;
    if (grid_blocks == 0) {
        int dev = 0, cus = 0, per_cu = 0;
        hipGetDevice(&dev);
        hipDeviceGetAttribute(&cus, hipDeviceAttributeMultiprocessorCount, dev);
        hipFuncSetAttribute((const void*)fwd_megakernel, hipFuncAttributeMaxDynamicSharedMemorySize, LDS_BYTES);
        hipOccupancyMaxActiveBlocksPerMultiprocessor(&per_cu, (const void*)fwd_megakernel, NTHREADS, LDS_BYTES);
        if (per_cu < 1) { fprintf(stderr, "kernel_launch: occupancy query says %d blocks per CU\n", per_cu); per_cu = 1; }
        grid_blocks = cus * per_cu;
        if (n_in != 29 || ws_size < WS_END) fprintf(stderr, "kernel_launch: unexpected n_in %d / ws_size %zu\n", n_in, ws_size);
    }
    hipMemsetAsync((unsigned char*)d_ws + WS_CTL, 0, 32768, stream);
    Params p{};
    for (int i = 0; i < 29; ++i) p.in[i] = (const float*)d_in[i];
    p.out = (float*)d_out; p.ws = (unsigned char*)d_ws;
    void* args[] = {&p};
    hipError_t e = hipLaunchCooperativeKernel((const void*)fwd_megakernel, dim3(grid_blocks), dim3(NTHREADS), args, LDS_BYTES, stream);
    if (e != hipSuccess) fprintf(stderr, "cooperative launch failed: %s (grid %d)\n", hipGetErrorString(e), grid_blocks);
}
```

```cpp
#include <hip/hip_runtime.h>
#include <hip/hip_cooperative_groups.h>
#include <cstdio>
#include <cstdint>
#include <cmath>
namespace cg = cooperative_groups;
__device__ __forceinline__ int fresh_tid() { int t = threadIdx.x; asm volatile("" : "+v"(t)); return t; }
namespace pg8 {
#define PG8_LAS __attribute__((address_space(3)))
typedef unsigned short bf16_t;
typedef short bf16x8 __attribute__((ext_vector_type(8)));
typedef float f32x4 __attribute__((ext_vector_type(4)));
typedef unsigned u32x4 __attribute__((ext_vector_type(4)));
constexpr int BM = 256, BK = 64, HALF = 128, HTB = HALF * BK * 2  , STAGE_BYTES = 8 * HTB, NXCD = 8, WGM = 8;

__host__ __device__ __forceinline__ int lds_byte(int r, int c) { const int st = (r >> 4) * 2 + (c >> 5), rr = r & 15, cc = c & 31, ob = rr * 64 + cc * 2; return st * 1024 + (ob ^ (((ob >> 9) & 1) << 5)); }
__host__ __device__ __forceinline__ void stage_rc(int b, int& R, int& C) { const int st = b / 1024, sb = b % 1024, swz = sb ^ (((sb >> 9) & 1) << 5); R = (st >> 1) * 16 + swz / 64; C = (st & 1) * 32 + (swz % 64) / 2; }
__host__ __device__ __forceinline__ int perm32(int rho) { const int n = rho >> 4, i = rho & 15; return 8 * (i >> 2) + 4 * n + (i & 3); }

struct Unit { int pm, pn; };
struct Gemm { const bf16_t* A; const bf16_t* Bt; int M, N, K; const bf16_t* A2; int pm2; };
__device__ __forceinline__ const char* gemm_abase(const Gemm& g, int pm, size_t tstep) { return pm >= g.pm2 ? (const char*)g.A2 + (size_t)(pm - g.pm2) * tstep : (const char*)g.A + (size_t)pm * tstep; }

struct StaticOrder {
    int nM, nN, nwg, G, c;
    __host__ __device__ void init(int M, int N, int G_, int c_) { nM = M / BM; nN = N / BM; nwg = nM * nN; G = G_; c = c_; }
    __host__ __device__ bool next(int i, Unit& u) const {
        const long L = (long)i * G + c; if (L >= nwg) return false;
        int wgid = (int)L; { const int q = nwg / NXCD, r = nwg % NXCD, xcd = wgid % NXCD, off = wgid / NXCD; wgid = (xcd < r ? xcd * (q + 1) : r * (q + 1) + (xcd - r) * q) + off; }
        const int nig = WGM * nN, gid = wgid / nig, fm = gid * WGM, gsz = (nM - fm) < WGM ? (nM - fm) : WGM;
        u.pm = fm + ((wgid % nig) % gsz); u.pn = (wgid % nig) / gsz; return true;
    }
    __device__ __forceinline__ void a_ready(const Unit&) const {}
    __device__ __forceinline__ void done(const Unit&) const {}
};


template <class Epi, class Sched, bool ALIGN_EPI = false, bool SP2 = false>
__device__ __forceinline__ void gemm_phase(PG8_LAS unsigned char* lds, const Gemm g, const Sched& S, const Epi& E) {
    const int tid = fresh_tid(), wid = __builtin_amdgcn_readfirstlane(tid >> 6), lane = tid & 63, wr = wid >> 2, wc = wid & 3, fr = lane & 15, fq = lane >> 4;
    const int K = g.K, nt = K / BK;
    unsigned voffA[2], voffB[2];
#pragma unroll
    for (int i = 0; i < 2; ++i) { int R, C; stage_rc(tid * 16 + i * 8192, R, C); const int Rb = Epi::PERM ? ((R & ~31) + perm32(R & 31)) : R;
        voffA[i] = (unsigned)(R * K + C) * 2u; voffB[i] = (unsigned)(Rb * K + C) * 2u; }
    const size_t kstep = (size_t)(BK * 2);
    const size_t hstep = (size_t)HALF * K * 2;
    const size_t tstep = 2 * hstep;
    const unsigned ldsw = (unsigned)wid * 1024u;
    const int aoff = lds_byte(wr * 64 + fr, fq * 8), boff = lds_byte(wc * 32 + fr, fq * 8);
#define PG8_SA(b, h) (((b) * 2 + (h)) * HTB)
#define PG8_SB(b, h) ((4 + (b) * 2 + (h)) * HTB)
#define PG8_STAGE(bufoff, gbase, voff) do { _Pragma("unroll") for (int _i = 0; _i < 2; ++_i) \
        __builtin_amdgcn_global_load_lds((const unsigned*)((const char*)(gbase) + (voff)[_i]), (PG8_LAS unsigned*)(lds + (bufoff) + ldsw + _i * 8192), 16, 0, 0); } while (0)
#define PG8_LDA(dst, b, h) do { _Pragma("unroll") for (int m = 0; m < 4; ++m) _Pragma("unroll") for (int k = 0; k < 2; ++k) dst[m][k] = *(const PG8_LAS bf16x8*)(lds + PG8_SA(b, h) + aoff + m * 2048 + k * 1024); } while (0)
#define PG8_LDB(dst, b, h) do { _Pragma("unroll") for (int n = 0; n < 2; ++n) _Pragma("unroll") for (int k = 0; k < 2; ++k) dst[n][k] = *(const PG8_LAS bf16x8*)(lds + PG8_SB(b, h) + boff + n * 2048 + k * 1024); } while (0)
#define PG8_MMA(ai, bj, At, Bt) do { __builtin_amdgcn_s_setprio(1); _Pragma("unroll") for (int m = 0; m < 4; ++m) _Pragma("unroll") for (int n = 0; n < 2; ++n) _Pragma("unroll") for (int k = 0; k < 2; ++k) \
        acc[ai][bj][m][n] = __builtin_amdgcn_mfma_f32_16x16x32_bf16(Bt[n][k], At[m][k], acc[ai][bj][m][n], 0, 0, 0); __builtin_amdgcn_s_setprio(0); } while (0)
#define PG8_WAIT_V(n) asm volatile("s_waitcnt vmcnt(" #n ")" ::: "memory")
#define PG8_WAIT_L(n) asm volatile("s_waitcnt lgkmcnt(" #n ")" ::: "memory")
#define PG8_BAR __builtin_amdgcn_s_barrier()
#define PG8_SCHED __builtin_amdgcn_sched_barrier(0)
    Unit cur, nxt; int ui = 0;
    if (!S.next(0, cur)) return;
    f32x4 acc[2][2][4][2];
#pragma unroll
    for (int a = 0; a < 2; ++a)
#pragma unroll
        for (int b = 0; b < 2; ++b)
#pragma unroll
            for (int m = 0; m < 4; ++m)
#pragma unroll
                for (int n = 0; n < 2; ++n) acc[a][b][m][n] = (f32x4){0.f, 0.f, 0.f, 0.f};
    bf16x8 At[4][2], B0[2][2], B1[2][2];
    const char* cA = gemm_abase(g, cur.pm, tstep); const char* cB = (const char*)g.Bt + (size_t)cur.pn * tstep;
    S.a_ready(cur);
    if constexpr (SP2) {
        PG8_STAGE(PG8_SB(0, 0), cB, voffB); PG8_STAGE(PG8_SB(0, 1), cB + hstep, voffB); PG8_STAGE(PG8_SA(0, 0), cA, voffA); PG8_STAGE(PG8_SA(0, 1), cA + hstep, voffA);
        if (wr == 1) PG8_BAR;
        PG8_WAIT_V(2); PG8_BAR;
        PG8_STAGE(PG8_SB(1, 0), cB + kstep, voffB); PG8_STAGE(PG8_SA(1, 0), cA + kstep, voffA); PG8_STAGE(PG8_SB(1, 1), cB + hstep + kstep, voffB);
        PG8_WAIT_V(6); PG8_BAR;
    } else {
        PG8_STAGE(PG8_SB(0, 0), cB, voffB); PG8_STAGE(PG8_SA(0, 0), cA, voffA); PG8_STAGE(PG8_SB(0, 1), cB + hstep, voffB); PG8_STAGE(PG8_SA(0, 1), cA + hstep, voffA);
        if (wr == 1) PG8_BAR;
        PG8_WAIT_V(4); PG8_BAR;
        PG8_STAGE(PG8_SB(1, 0), cB + kstep, voffB); PG8_STAGE(PG8_SA(1, 0), cA + kstep, voffA); PG8_STAGE(PG8_SB(1, 1), cB + hstep + kstep, voffB);
        PG8_WAIT_V(6); PG8_BAR;
    }
    for (;;) {
        const bool has_next = S.next(ui + 1, nxt);
        const char* nA = has_next ? gemm_abase(g, nxt.pm, tstep) : cA; const char* nB = has_next ? (const char*)g.Bt + (size_t)nxt.pn * tstep : cB;
        for (int t = 0; t < nt; t += 2) {
            const bool last = (t == nt - 2);
            const char* a1 = cA + (size_t)(t + 1) * kstep;
            const char* a2 = last ? nA : cA + (size_t)(t + 2) * kstep; const char* b2 = last ? nB : cB + (size_t)(t + 2) * kstep;
            const char* a3 = a2 + kstep; const char* b3 = b2 + kstep;
            if (last && has_next) S.a_ready(nxt);
            if constexpr (SP2) {
            PG8_LDB(B0, 0, 0); PG8_LDB(B1, 0, 1); PG8_SCHED; PG8_LDA(At, 0, 0); PG8_STAGE(PG8_SA(1, 1), a1 + hstep, voffA);
            PG8_WAIT_V(8); PG8_WAIT_L(0); PG8_BAR; PG8_MMA(0, 0, At, B0); PG8_MMA(0, 1, At, B1); PG8_BAR; PG8_SCHED;
            PG8_LDA(At, 0, 1); PG8_STAGE(PG8_SB(0, 0), b2, voffB); PG8_STAGE(PG8_SB(0, 1), b2 + hstep, voffB); PG8_STAGE(PG8_SA(0, 0), a2, voffA);
            PG8_WAIT_V(8); PG8_WAIT_L(0); PG8_BAR; PG8_MMA(1, 0, At, B0); PG8_MMA(1, 1, At, B1); PG8_BAR; PG8_SCHED;
            PG8_LDB(B0, 1, 0); PG8_LDB(B1, 1, 1); PG8_SCHED; PG8_LDA(At, 1, 0); PG8_STAGE(PG8_SA(0, 1), a2 + hstep, voffA);
            PG8_WAIT_V(8); PG8_WAIT_L(0); PG8_BAR; PG8_MMA(0, 0, At, B0); PG8_MMA(0, 1, At, B1); PG8_BAR; PG8_SCHED;
            PG8_LDA(At, 1, 1); PG8_STAGE(PG8_SB(1, 0), b3, voffB); PG8_STAGE(PG8_SB(1, 1), b3 + hstep, voffB); PG8_STAGE(PG8_SA(1, 0), a3, voffA);
            PG8_WAIT_V(8); PG8_WAIT_L(0); PG8_BAR; PG8_MMA(1, 0, At, B0); PG8_MMA(1, 1, At, B1); PG8_BAR; PG8_SCHED;
            } else {
            PG8_LDB(B0, 0, 0); PG8_SCHED; PG8_LDA(At, 0, 0); PG8_STAGE(PG8_SA(1, 1), a1 + hstep, voffA);
            PG8_WAIT_L(8); PG8_BAR; PG8_WAIT_L(0); PG8_MMA(0, 0, At, B0); PG8_BAR; PG8_SCHED;
            PG8_LDB(B1, 0, 1); PG8_STAGE(PG8_SB(0, 0), b2, voffB);
            PG8_BAR; PG8_WAIT_L(0); PG8_MMA(0, 1, At, B1); PG8_BAR;
            PG8_LDA(At, 0, 1); PG8_STAGE(PG8_SA(0, 0), a2, voffA);
            PG8_BAR; PG8_WAIT_L(0); PG8_MMA(1, 0, At, B0); PG8_BAR; PG8_SCHED;
            PG8_STAGE(PG8_SB(0, 1), b2 + hstep, voffB);
            PG8_WAIT_V(6); PG8_BAR; PG8_MMA(1, 1, At, B1); PG8_BAR;
            PG8_LDB(B0, 1, 0); PG8_SCHED; PG8_LDA(At, 1, 0); PG8_STAGE(PG8_SA(0, 1), a2 + hstep, voffA);
            PG8_WAIT_L(8); PG8_BAR; PG8_WAIT_L(0); PG8_MMA(0, 0, At, B0); PG8_BAR; PG8_SCHED;
            PG8_LDB(B1, 1, 1); PG8_STAGE(PG8_SB(1, 0), b3, voffB);
            PG8_BAR; PG8_WAIT_L(0); PG8_MMA(0, 1, At, B1); PG8_BAR;
            PG8_LDA(At, 1, 1); PG8_STAGE(PG8_SA(1, 0), a3, voffA);
            PG8_BAR; PG8_WAIT_L(0); PG8_MMA(1, 0, At, B0); PG8_BAR; PG8_SCHED;
            PG8_STAGE(PG8_SB(1, 1), b3 + hstep, voffB);
            PG8_WAIT_V(6); PG8_BAR; PG8_MMA(1, 1, At, B1); PG8_BAR;
            }
        }
        if constexpr (ALIGN_EPI) { if (wr == 0) PG8_BAR; }
        if constexpr (!Epi::AFTER_DRAIN) { E(acc, cur, wr, wc, fr, fq); S.done(cur); }
        if (!has_next) break;
#pragma unroll
        for (int a = 0; a < 2; ++a)
#pragma unroll
            for (int b = 0; b < 2; ++b)
#pragma unroll
                for (int m = 0; m < 4; ++m)
#pragma unroll
                    for (int n = 0; n < 2; ++n) acc[a][b][m][n] = (f32x4){0.f, 0.f, 0.f, 0.f};
        cur = nxt; cA = nA; cB = nB; ++ui;
        if constexpr (ALIGN_EPI) { if (wr == 1) PG8_BAR; }
    }
    PG8_WAIT_V(0);
    if constexpr (!ALIGN_EPI) { if (wr == 0) PG8_BAR; }
    PG8_BAR;
    if constexpr (Epi::AFTER_DRAIN) { E.fused(acc, cur, wr, wc, fr, fq, lds, wid, lane); S.done(cur); }
#undef PG8_SA
#undef PG8_SB
#undef PG8_STAGE
#undef PG8_LDA
#undef PG8_LDB
#undef PG8_MMA
#undef PG8_WAIT_V
#undef PG8_WAIT_L
#undef PG8_BAR
#undef PG8_SCHED
}
}

#ifndef PG8_SP2
#define PG8_SP2 true
#endif

#define LAS __attribute__((address_space(3)))
typedef unsigned short bf16;
typedef short bf16x8 __attribute__((ext_vector_type(8)));
typedef float f32x4 __attribute__((ext_vector_type(4)));
typedef float f32x16 __attribute__((ext_vector_type(16)));
typedef unsigned u32x4 __attribute__((ext_vector_type(4)));
typedef unsigned u32x2 __attribute__((ext_vector_type(2)));

constexpr int DM = 1024, NMAIN = 32768, ROWS = 33024, METAROW = 32768, DFF = 4096;
constexpr int NTHREADS = 512;
constexpr int LDS_BYTES = 147456;
constexpr int LDS_ITEM_OFF = LDS_BYTES - 16;
constexpr size_t MiB = 1u << 20;
constexpr size_t WS_CTL = 0, WS_WIN = 1 * MiB, WS_WUPA = 12 * MiB, WS_WUPB = 13 * MiB, WS_WOUT = 14 * MiB, WS_WFF1 = 16 * MiB, WS_WFF2 = 24 * MiB;
constexpr size_t WS_LORA = 32 * MiB, WS_XNMETA = 32 * MiB + 512 * 1024, WS_CB = 33 * MiB, WS_ACT = 36 * MiB;
constexpr size_t ACT_SZ = (size_t)ROWS * 512 * 2, L_SZ = (size_t)ROWS * 256 * 2;
constexpr size_t WS_R = WS_ACT, WS_KA = WS_R + ACT_SZ, WS_VA = WS_KA + ACT_SZ, WS_L = WS_VA + ACT_SZ, WS_Q = WS_L + L_SZ, WS_KB = WS_Q + ACT_SZ, WS_VT = WS_KB + ACT_SZ, WS_END = WS_VT + ACT_SZ;
constexpr size_t WS_GA = WS_KA, WS_GB = WS_KB, WS_MN = WS_ACT, WS_HID = WS_ACT + 64 * MiB;
constexpr size_t WS_HALO = WS_END;
constexpr int HALO_ROW = 3584;
static_assert(WS_HALO + (size_t)(NMAIN / 64) * 2 * HALO_ROW <= 256 * MiB, "halo buffer");
static_assert(WS_END <= 256 * MiB && WS_HID + 128 * MiB <= 256 * MiB && WS_CB + (size_t)2 * ROWS * 8 * 4 <= WS_ACT, "ws map");
constexpr float LOG2E = 1.4426950408889634f;
constexpr float QSCALE = 0.125f * LOG2E;

struct Params { const float* in[29]; float* out; unsigned char* ws; };
typedef const __attribute__((address_space(4))) Params* KP;
enum { I_XP = 0, I_XS, I_META, I_GMIX, I_WIN, I_MUP, I_MUN, I_W0, I_WUP, I_A0, I_AUP, I_GUP, I_KK, I_KA, I_RK, I_LNW, I_LNB, I_LQ1, I_LK1, I_LQ2, I_LK2, I_SUBG, I_UPA, I_UPB, I_WOUT, I_GFFN, I_FF1, I_FF2, I_GFIN };

__device__ __forceinline__ unsigned cvtpk(float lo, float hi) { unsigned r; asm volatile("v_cvt_pk_bf16_f32 %0, %1, %2" : "=v"(r) : "v"(lo), "v"(hi)); return r; }
__device__ __forceinline__ float bf2f(unsigned short b) { return __uint_as_float(((unsigned)b) << 16); }
__device__ __forceinline__ float bflo(unsigned w) { return __uint_as_float(w << 16); }
__device__ __forceinline__ float bfhi(unsigned w) { return __uint_as_float(w & 0xffff0000u); }
__device__ __forceinline__ void unpack8(const u32x4 v, float* o) { o[0] = bflo(v.x); o[1] = bfhi(v.x); o[2] = bflo(v.y); o[3] = bfhi(v.y); o[4] = bflo(v.z); o[5] = bfhi(v.z); o[6] = bflo(v.w); o[7] = bfhi(v.w); }
__device__ __forceinline__ float wave_sum(float v) {
#pragma unroll
    for (int o = 1; o < 64; o <<= 1) v += __shfl_xor(v, o);
    return v;
}
__device__ __forceinline__ float sigmoidf_(float x) { return 1.0f / (1.0f + __expf(-x)); }
__device__ __forceinline__ int seq_base(int s) { return s == 0 ? 0 : 16384 + (s - 1) * 2048; }
__device__ __forceinline__ int seq_len(int s) { return s == 0 ? 16384 : 2048; }
__device__ __forceinline__ int pos_row(int base, int p) { return p < 16 ? METAROW + p : base + p - 16; }

template <class Op> struct Epi8 {
    static constexpr bool PERM = true, AFTER_DRAIN = false;
    Op op;
    __device__ __forceinline__ void operator()(const pg8::f32x4 (&acc)[2][2][4][2], const pg8::Unit& u, int wr, int wc, int fr, int fq) const {
        const int row0 = u.pm * 256 + wr * 64 + fr, col0 = u.pn * 256 + wc * 32 + 8 * fq;
#pragma unroll
        for (int ai = 0; ai < 2; ++ai)
#pragma unroll
            for (int m = 0; m < 4; ++m)
#pragma unroll
                for (int bj = 0; bj < 2; ++bj) { op.apply(row0 + ai * 128 + m * 16, col0 + bj * 128, u.pn, acc[ai][bj][m][0], acc[ai][bj][m][1]); asm volatile("" ::: "memory"); }
    }
};
__device__ __forceinline__ u32x4 pack8(const f32x4 a, const f32x4 b) { u32x4 w; w.x = cvtpk(a[0], a[1]); w.y = cvtpk(a[2], a[3]); w.z = cvtpk(b[0], b[1]); w.w = cvtpk(b[2], b[3]); return w; }

constexpr int CW_KN = 320;
__device__ __forceinline__ float dpp_max16(float v) {
    int x = __float_as_int(v);
    v = fmaxf(v, __int_as_float(__builtin_amdgcn_update_dpp(0, x, 0xB1, 0xf, 0xf, true))); x = __float_as_int(v);
    v = fmaxf(v, __int_as_float(__builtin_amdgcn_update_dpp(0, x, 0x4E, 0xf, 0xf, true))); x = __float_as_int(v);
    v = fmaxf(v, __int_as_float(__builtin_amdgcn_update_dpp(0, x, 0x141, 0xf, 0xf, true))); x = __float_as_int(v);
    v = fmaxf(v, __int_as_float(__builtin_amdgcn_update_dpp(0, x, 0x140, 0xf, 0xf, true)));
    return v;
}
struct OpProj {
    unsigned char* ws;
    __device__ __forceinline__ void apply(int row, int col, int pn, f32x4 v0, f32x4 v1) const {
        if (pn >= 11) {
            bf16* VT = (bf16*)(ws + WS_VT); const int c = col - 11 * 256;
#pragma unroll
            for (int e = 0; e < 4; ++e) { VT[(size_t)(c + e) * ROWS + row] = (bf16)(cvtpk(v0[e], 0.f) & 0xffffu); VT[(size_t)(c + 4 + e) * ROWS + row] = (bf16)(cvtpk(v1[e], 0.f) & 0xffffu); }
            return;
        }
        bf16* O; int ldc = 512, c;
        if (pn < 2) { O = (bf16*)(ws + WS_R); c = col; }
        else if (pn < 4) { O = (bf16*)(ws + WS_KA); c = col - 512; }
        else if (pn < 6) { O = (bf16*)(ws + WS_VA); c = col - 1024; }
        else if (pn < 7) { O = (bf16*)(ws + WS_L); c = col - 1536; ldc = 256; }
        else if (pn < 9) { O = (bf16*)(ws + WS_Q); c = col - 1792; v0 = v0 * QSCALE; v1 = v1 * QSCALE; }
        else { O = (bf16*)(ws + WS_KB); c = col - 2304; }
        const u32x4 w = pack8(v0, v1);
        *(u32x4*)(O + (size_t)row * ldc + c) = w;
        if (pn >= 9) {
            float k8[8]; unpack8(w, k8); float ss = 0.f;
#pragma unroll
            for (int e = 0; e < 8; ++e) ss = fmaf(k8[e], k8[e], ss);
            ss = dpp_max16(ss);
            if ((threadIdx.x & 15) == 0) { const int sidx = row < 16384 ? 0 : row < NMAIN ? 1 + ((row - 16384) >> 11) : 9;
                atomicMax((unsigned*)(ws + WS_CTL) + CW_KN + sidx * 64 + (c >> 3), __float_as_uint(ss)); }
        }
    }
};
struct OpGate {
    bf16* O;
    __device__ __forceinline__ void apply(int row, int col, int pn, f32x4 v0, f32x4 v1) const {
        const int c = col;
#pragma unroll
        for (int e = 0; e < 4; ++e) { v0[e] = sigmoidf_(v0[e]); v1[e] = sigmoidf_(v1[e]); }
        *(u32x4*)(O + (size_t)row * 1024 + c) = pack8(v0, v1);
    }
};
struct OpUpA {
    unsigned char* ws;
    __device__ __forceinline__ void apply(int row, int col, int pn, f32x4 v0, f32x4 v1) const {
        u32x4* p = (u32x4*)((bf16*)(ws + WS_GA) + (size_t)row * 1024 + col); float g[8]; unpack8(*p, g);
#pragma unroll
        for (int e = 0; e < 4; ++e) { v0[e] *= g[e]; v1[e] *= g[4 + e]; }
        *p = pack8(v0, v1);
    }
};
struct OpUpB {
    unsigned char* ws;
    __device__ __forceinline__ void apply(int row, int col, int pn, f32x4 v0, f32x4 v1) const {
        u32x4* p = (u32x4*)((bf16*)(ws + WS_GB) + (size_t)row * 1024 + col); float g[8], a[8]; unpack8(*p, g);
        unpack8(*(const u32x4*)((const bf16*)(ws + WS_GA) + (size_t)row * 1024 + col), a);
#pragma unroll
        for (int e = 0; e < 4; ++e) { v0[e] = a[e] + v0[e] * g[e]; v1[e] = a[4 + e] + v1[e] * g[4 + e]; }
        *p = pack8(v0, v1);
    }
};
struct OpOut {
    const float* xp; const float* xs; float* out;
    __device__ __forceinline__ void apply(int row, int col, int pn, f32x4 v0, f32x4 v1) const {
        const float* x = (row < 16384 ? xp + (size_t)row * DM : xs + (size_t)(row - 16384) * DM) + col;
        float* o = out + (size_t)row * DM + col;
        *(f32x4*)o = *(const f32x4*)x + v0; *(f32x4*)(o + 4) = *(const f32x4*)(x + 4) + v1;
    }
};
struct OpFF1 {
    bf16* hid;
    __device__ __forceinline__ void apply(int row, int col, int pn, f32x4 v0, f32x4 v1) const {
#pragma unroll
        for (int e = 0; e < 4; ++e) { const float a = fmaxf(v0[e], 0.f), b = fmaxf(v1[e], 0.f); v0[e] = a * a; v1[e] = b * b; }
        *(u32x4*)(hid + (size_t)row * DFF + col) = pack8(v0, v1);
    }
};
struct OpFF2 {
    float* out;
    __device__ __forceinline__ void apply(int row, int col, int pn, f32x4 v0, f32x4 v1) const {
        float* o = out + (size_t)row * DM + col;
        *(f32x4*)o = *(const f32x4*)o + v0; *(f32x4*)(o + 4) = *(const f32x4*)(o + 4) + v1;
    }
};

__device__ __forceinline__ unsigned f2bf_rne(float f) { return cvtpk(f, 0.f) & 0xffffu; }
__device__ __forceinline__ void transpose_item(const float* W, int K, int N, bf16* WT, LAS float* scr, int item, int lane) {
    const int nblk = N / 32, kb = item / nblk, nb = item % nblk, k0 = 64 * kb, n0 = 32 * nb;
#pragma unroll 8
    for (int i = 0; i < 32; ++i) { const int kk = 2 * i + (lane >> 5); scr[kk * 33 + (lane & 31)] = W[(size_t)(k0 + kk) * N + n0 + (lane & 31)]; }
    asm volatile("s_waitcnt vmcnt(0) lgkmcnt(0)" ::: "memory");
    const int c = lane & 7;
#pragma unroll
    for (int j = 0; j < 4; ++j) { const int n = (lane >> 3) + 8 * j; const LAS float* s = scr + (8 * c) * 33 + n;
        u32x4 o; o.x = cvtpk(s[0 * 33], s[1 * 33]); o.y = cvtpk(s[2 * 33], s[3 * 33]); o.z = cvtpk(s[4 * 33], s[5 * 33]); o.w = cvtpk(s[6 * 33], s[7 * 33]);
        *(u32x4*)(WT + (size_t)(n0 + n) * K + k0 + 8 * c) = o; }
    asm volatile("s_waitcnt lgkmcnt(0)" ::: "memory");
}
__device__ __forceinline__ void rms_row_bf16(const float* src, const float* g, bf16* dst, int lane) {
    unsigned long long* o8 = (unsigned long long*)dst + lane;
    if (!src) {
#pragma unroll
        for (int j = 0; j < 4; ++j) o8[64 * j] = 0ull;
        return; }
    const f32x4* xr = (const f32x4*)src + lane; const f32x4* gr = (const f32x4*)g + lane;
    f32x4 v[4]; float s = 0.f;
#pragma unroll
    for (int j = 0; j < 4; ++j) { v[j] = xr[64 * j]; s += (v[j].x * v[j].x + v[j].y * v[j].y) + (v[j].z * v[j].z + v[j].w * v[j].w); }
    const float rstd = rsqrtf(wave_sum(s) * (1.f / DM) + 1e-6f);
#pragma unroll
    for (int j = 0; j < 4; ++j) { const f32x4 gg = gr[64 * j]; const f32x4 y = v[j] * rstd * gg;
        o8[64 * j] = (unsigned long long)cvtpk(y.x, y.y) | ((unsigned long long)cvtpk(y.z, y.w) << 32); }
}
__device__ __forceinline__ void phase_prologue(LAS unsigned char* lds, KP P) {
    const int tid = fresh_tid(), lane = tid & 63, wid = tid >> 6;
    LAS float* scr = (LAS float*)(lds + wid * 16384);
    const int gw = blockIdx.x * 8 + wid, NGW = gridDim.x * 8;
    unsigned char* ws = P->ws;
    constexpr int I_IN = (1024 / 64) * (5376 / 32), I_UP = (512 / 64) * (1024 / 32), I_O = (1024 / 64) * (1024 / 32), I_1 = (1024 / 64) * (4096 / 32), I_2 = (4096 / 64) * (1024 / 32);
    constexpr int I_LW = (64 / 64) * (512 / 32), I_G = (128 / 64) * (512 / 32);
    constexpr int NITEMS = I_IN + 2 * I_UP + I_O + I_1 + I_2 + 4 * I_LW + I_G;
    for (int it = gw; it < NITEMS; it += NGW) {
        int r = it;
        if (r < I_IN) { transpose_item(P->in[I_WIN], 1024, 5376, (bf16*)(ws + WS_WIN), scr, r, lane); continue; } r -= I_IN;
        if (r < I_UP) { transpose_item(P->in[I_UPA], 512, 1024, (bf16*)(ws + WS_WUPA), scr, r, lane); continue; } r -= I_UP;
        if (r < I_UP) { transpose_item(P->in[I_UPB], 512, 1024, (bf16*)(ws + WS_WUPB), scr, r, lane); continue; } r -= I_UP;
        if (r < I_O) { transpose_item(P->in[I_WOUT], 1024, 1024, (bf16*)(ws + WS_WOUT), scr, r, lane); continue; } r -= I_O;
        if (r < I_1) { transpose_item(P->in[I_FF1], 1024, 4096, (bf16*)(ws + WS_WFF1), scr, r, lane); continue; } r -= I_1;
        if (r < I_2) { transpose_item(P->in[I_FF2], 4096, 1024, (bf16*)(ws + WS_WFF2), scr, r, lane); continue; } r -= I_2;
        if (r < 2 * I_LW) { const int d = r / I_LW; transpose_item(P->in[I_WUP] + (size_t)d * 64 * 512, 64, 512, (bf16*)(ws + WS_LORA) + (size_t)d * 512 * 64, scr, r % I_LW, lane); continue; } r -= 2 * I_LW;
        if (r < 2 * I_LW) { const int d = r / I_LW; transpose_item(P->in[I_AUP] + (size_t)d * 64 * 512, 64, 512, (bf16*)(ws + WS_LORA + 131072) + (size_t)d * 512 * 64, scr, r % I_LW, lane); continue; } r -= 2 * I_LW;
        transpose_item(P->in[I_GUP], 128, 512, (bf16*)(ws + WS_LORA + 262144), scr, r, lane);
    }
    bf16* XN = (bf16*)P->out; bf16* XM = (bf16*)(ws + WS_XNMETA);
    for (int m = gw; m < ROWS; m += NGW) {
        const float* src = m < 16384 ? P->in[I_XP] + (size_t)m * DM : m < NMAIN ? P->in[I_XS] + (size_t)(m - 16384) * DM : (m - NMAIN < 16 ? P->in[I_META] + (size_t)(m - NMAIN) * DM : nullptr);
        bf16* dst = m < NMAIN ? XN + (size_t)m * DM : XM + (size_t)(m - NMAIN) * DM;
        rms_row_bf16(src, P->in[I_GMIX], dst, lane);
    }
}

constexpr int AT_KSTR = 272, AT_VSTR = 144, AT_KSZ = 64 * AT_KSTR, AT_BUF = AT_KSZ + 128 * AT_VSTR;
__device__ __forceinline__ f32x16 mfma32(bf16x8 a, bf16x8 b, f32x16 c) { return __builtin_amdgcn_mfma_f32_32x32x16_bf16(a, b, c, 0, 0, 0); }
__device__ __forceinline__ void attn_unit(LAS unsigned char* lds, KP P, int s, int h, int qb, float lam) {
    int tid_ = threadIdx.x; asm volatile("" : "+v"(tid_));
    const int tid = tid_, lane = tid & 63, r32 = lane & 31, hi = lane >> 5, wid = __builtin_amdgcn_readfirstlane(tid >> 6), rg = wid & 3, mp = wid >> 2;
    const int L = seq_len(s), base = seq_base(s), NT = 1 + L / 64;
    unsigned char* ws = P->ws;
    const bf16* KB = (const bf16*)(ws + WS_KB); const bf16* VT = (const bf16*)(ws + WS_VT); bf16* Q = (bf16*)(ws + WS_Q);
    const int qrow = base + qb * 128 + rg * 32 + r32;
    bf16x8 q[4];
#pragma unroll
    for (int d0 = 0; d0 < 4; ++d0) q[d0] = *(const bf16x8*)(Q + (size_t)qrow * 512 + h * 128 + mp * 64 + d0 * 16 + hi * 8);
    f32x16 O[4];
#pragma unroll
    for (int b = 0; b < 4; ++b)
#pragma unroll
        for (int r = 0; r < 16; ++r) O[b][r] = 0.f;
    float mx = -INFINITY, ls = 0.f;
    const float qh = (float)(16 + qb * 128 + rg * 32 + r32 - 4 * hi);
    const float nslope = -exp2f(-2.0f * (float)(h + 1)) * LOG2E;
    const int kr0 = tid >> 4, kc = tid & 15, vn0 = tid >> 3, vc = tid & 7;
    u32x4 kreg[2], vreg[2];
    const unsigned kgo = (unsigned)((kr0 * 512 + h * 128 + kc * 8) * 2), vgo = (unsigned)(((h * 128 + vn0) * ROWS + vc * 8) * 2);
    const unsigned klo = (unsigned)(kr0 * AT_KSTR + kc * 16), vlo = (unsigned)(AT_KSZ + vn0 * AT_VSTR + vc * 16);
#define AT_GLOAD(j) do { const int m0_ = (j) == 0 ? METAROW : base + 64 * ((j) - 1); \
        const unsigned char* kt_ = (const unsigned char*)KB + (size_t)m0_ * 1024; const unsigned char* vt_ = (const unsigned char*)VT + (size_t)m0_ * 2; \
        kreg[0] = *(const u32x4*)(kt_ + kgo); kreg[1] = *(const u32x4*)(kt_ + 32 * 1024 + kgo); \
        vreg[0] = *(const u32x4*)(vt_ + vgo); vreg[1] = *(const u32x4*)(vt_ + (size_t)64 * ROWS * 2 + vgo); } while (0)
#define AT_LSTORE(buf) do { LAS unsigned char* kb_ = lds + (buf) * AT_BUF; \
        *(LAS u32x4*)(kb_ + klo) = kreg[0]; *(LAS u32x4*)(kb_ + klo + 32 * AT_KSTR) = kreg[1]; \
        *(LAS u32x4*)(kb_ + vlo) = vreg[0]; *(LAS u32x4*)(kb_ + vlo + 64 * AT_VSTR) = vreg[1]; } while (0)
    float qn, kn;
    { float ssq = 0.f;
#pragma unroll
      for (int d0 = 0; d0 < 4; ++d0) { float t[8]; unpack8(__builtin_bit_cast(u32x4, q[d0]), t);
#pragma unroll
        for (int e = 0; e < 8; ++e) ssq = fmaf(t[e], t[e], ssq); }
      ssq += __shfl_xor(ssq, 32); qn = sqrtf(ssq) * 1.002f;
      const unsigned* KN = (const unsigned*)(ws + WS_CTL) + CW_KN; float ks = 0.f;
#pragma unroll
      for (int g = 0; g < 8; ++g) ks += fmaxf(__uint_as_float(__hip_atomic_load(KN + s * 64 + h * 16 + mp * 8 + g, __ATOMIC_RELAXED, __HIP_MEMORY_SCOPE_AGENT)), __uint_as_float(__hip_atomic_load(KN + 9 * 64 + h * 16 + mp * 8 + g, __ATOMIC_RELAXED, __HIP_MEMORY_SCOPE_AGENT)));
      kn = sqrtf(ks) * 1.002f; }
    const int jc0 = 1 + qb * 2;
    int jlo = jc0, jhi = jc0 + 1;
    LAS float* red = (LAS float*)(lds + 2 * AT_BUF);
#pragma unroll 1
    for (int ph = 0; ph < 2; ++ph) {
        int nleft, ntl;
        if (ph == 0) { nleft = 0; ntl = 2; }
        else {
            float dneed = (qn * kn - mx + 40.0f) / (-nslope);
#pragma unroll
            for (int o = 1; o < 64; o <<= 1) dneed = fmaxf(dneed, __shfl_xor(dneed, o));
            if (lane == 0) red[wid] = dneed;
            __syncthreads();
            float dm = red[0];
#pragma unroll
            for (int w8 = 1; w8 < 8; ++w8) dm = fmaxf(dm, red[w8]);
            dm = fminf(fmaxf(dm, 0.f), 1.0e6f);
            const int dmax = (int)dm + 1, q0 = 16 + qb * 128;
            const int plo = q0 - dmax, phi = q0 + 127 + dmax;
            jlo = plo < 16 ? 0 : 1 + ((plo - 16) >> 6); jhi = phi >= L + 16 ? NT - 1 : 1 + ((phi - 16) >> 6);
            if (jlo > jc0) jlo = jc0; if (jhi < jc0 + 1) jhi = jc0 + 1;
            nleft = jc0 - jlo; ntl = nleft + (jhi - jc0 - 1);
        }
        if (ntl > 0) {
#define AT_J(t) (ph == 0 ? jc0 + (t) : ((t) < nleft ? jlo + (t) : jc0 + 2 + ((t) - nleft)))
        { const int jf = AT_J(0); AT_GLOAD(jf); } AT_LSTORE(0); __syncthreads();
#pragma unroll 1
        for (int t = 0; t < ntl; ++t) {
            const int j = AT_J(t);
            if (t + 1 < ntl) { const int jn = AT_J(t + 1); AT_GLOAD(jn); }
            const LAS unsigned char* Kb = lds + (t & 1) * AT_BUF + mp * 128; const LAS unsigned char* Vb = lds + (t & 1) * AT_BUF + AT_KSZ;
            const float dq = qh - (float)(j == 0 ? 0 : 64 * j - 48);
            f32x16 p0, p1;
#pragma unroll
            for (int r = 0; r < 16; ++r) { p0[r] = 0.f; p1[r] = 0.f; }
#pragma unroll
            for (int d0 = 0; d0 < 4; ++d0) {
                const bf16x8 a0 = *(const LAS bf16x8*)(Kb + r32 * AT_KSTR + d0 * 32 + hi * 16);
                const bf16x8 a1 = *(const LAS bf16x8*)(Kb + (32 + r32) * AT_KSTR + d0 * 32 + hi * 16);
                p0 = mfma32(a0, q[d0], p0); p1 = mfma32(a1, q[d0], p1);
            }
#pragma unroll
            for (int r = 0; r < 16; ++r) { const float dd = dq - (float)((r & 3) + 8 * (r >> 2)); p0[r] = fmaf(fabsf(dd), nslope, p0[r]); p1[r] = fmaf(fabsf(dd - 32.f), nslope, p1[r]); }
            if (j == 0) {
#pragma unroll
                for (int r = 0; r < 16; ++r) { if ((r & 3) + 8 * (r >> 2) + 4 * hi >= 16) p0[r] = -INFINITY; p1[r] = -INFINITY; }
            }
            float rm = fmaxf(p0[0], p1[0]);
#pragma unroll
            for (int r = 1; r < 16; ++r) rm = fmaxf(rm, fmaxf(p0[r], p1[r]));
            rm = fmaxf(rm, __shfl_xor(rm, 32));
            const float mn = fmaxf(mx, rm);
            if (__any(mn > mx)) {
                const float f = __builtin_amdgcn_exp2f(mx - mn); ls *= f; mx = mn;
#pragma unroll
                for (int b = 0; b < 4; ++b)
#pragma unroll
                    for (int r = 0; r < 16; ++r) O[b][r] *= f;
            }
            float sum = 0.f;
#pragma unroll
            for (int r = 0; r < 16; ++r) { p0[r] = __builtin_amdgcn_exp2f(p0[r] - mx); p1[r] = __builtin_amdgcn_exp2f(p1[r] - mx); sum += p0[r] + p1[r]; }
            ls += sum;
            bf16x8 pf[4];
#pragma unroll
            for (int k2 = 0; k2 < 2; ++k2) {
                u32x4 w0, w1;
                w0.x = cvtpk(p0[8 * k2 + 0], p0[8 * k2 + 1]); w0.y = cvtpk(p0[8 * k2 + 2], p0[8 * k2 + 3]); w0.z = cvtpk(p0[8 * k2 + 4], p0[8 * k2 + 5]); w0.w = cvtpk(p0[8 * k2 + 6], p0[8 * k2 + 7]);
                w1.x = cvtpk(p1[8 * k2 + 0], p1[8 * k2 + 1]); w1.y = cvtpk(p1[8 * k2 + 2], p1[8 * k2 + 3]); w1.z = cvtpk(p1[8 * k2 + 4], p1[8 * k2 + 5]); w1.w = cvtpk(p1[8 * k2 + 6], p1[8 * k2 + 7]);
                pf[k2] = __builtin_bit_cast(bf16x8, w0); pf[2 + k2] = __builtin_bit_cast(bf16x8, w1);
            }
#pragma unroll
            for (int ks = 0; ks < 4; ++ks)
#pragma unroll
                for (int b = 0; b < 4; ++b) {
                    const LAS unsigned char* vp = Vb + (b * 32 + r32) * AT_VSTR + ks * 32 + hi * 8;
                    const u32x2 lo = *(const LAS u32x2*)vp, hh = *(const LAS u32x2*)(vp + 16);
                    u32x4 vv; vv.x = lo.x; vv.y = lo.y; vv.z = hh.x; vv.w = hh.y;
                    O[b] = mfma32(__builtin_bit_cast(bf16x8, vv), pf[ks], O[b]);
                }
            if (t + 1 < ntl) AT_LSTORE((t + 1) & 1);
            __syncthreads();
        }
#undef AT_J
        }
    }
#undef AT_GLOAD
#undef AT_LSTORE
    const float lt = ls + __shfl_xor(ls, 32);
    const float inv = (mp ? lam : 1.0f) / lt;
    int lane2 = lane; asm volatile("" : "+v"(lane2));
    const int r32e = lane2 & 31, hie = lane2 >> 5;
    LAS float* ex = (LAS float*)lds + rg * (128 * 32) + hie * 128 + r32e;
    if (mp == 1) {
#pragma unroll
        for (int b = 0; b < 4; ++b)
#pragma unroll
            for (int r = 0; r < 16; ++r) ex[(32 * b + (r & 3) + 8 * (r >> 2)) * 32] = O[b][r] * inv;
    }
    __syncthreads();
    if (mp == 0) {
        float ss = 0.f;
#pragma unroll
        for (int b = 0; b < 4; ++b)
#pragma unroll
            for (int r = 0; r < 16; ++r) { const float o = O[b][r] * inv - ex[(32 * b + (r & 3) + 8 * (r >> 2)) * 32]; O[b][r] = o; ss += o * o; }
        ss += __shfl_xor(ss, 32);
        const float rstd = rsqrtf(ss * (1.0f / 128.0f) + 1e-5f) * 0.8f;
        const float* sg = P->in[I_SUBG] + 4 * hie; bf16* Qo = Q + (size_t)(base + qb * 128 + rg * 32 + r32e) * 512 + h * 128 + 4 * hie;
#pragma unroll
        for (int b = 0; b < 4; ++b)
#pragma unroll
            for (int r4 = 0; r4 < 4; ++r4) {
                const int n = 32 * b + 8 * r4; const f32x4 g = *(const f32x4*)(sg + n);
                u32x2 w; w.x = cvtpk(O[b][4 * r4 + 0] * rstd * g.x, O[b][4 * r4 + 1] * rstd * g.y); w.y = cvtpk(O[b][4 * r4 + 2] * rstd * g.z, O[b][4 * r4 + 3] * rstd * g.w);
                *(u32x2*)(Qo + n) = w;
            }
    }
    __syncthreads();
}

constexpr int SC_R = 0, SC_K = 16384, SC_V = 32768, SC_W = 49152, SC_B = 65536, SC_KK = 81920, SC_Y = 98304, SC_TW = 114688, SC_AD = 123904, SC_MU = 133120;
__device__ __forceinline__ float dpp_add(float v, int ctrl_id) {
    const int x = __float_as_int(v); int y;
    if (ctrl_id == 0) y = __builtin_amdgcn_update_dpp(0, x, 0xB1, 0xf, 0xf, true);
    else if (ctrl_id == 1) y = __builtin_amdgcn_update_dpp(0, x, 0x4E, 0xf, 0xf, true);
    else if (ctrl_id == 2) y = __builtin_amdgcn_update_dpp(0, x, 0x141, 0xf, 0xf, true);
    else y = __builtin_amdgcn_update_dpp(0, x, 0x140, 0xf, 0xf, true);
    return v + __int_as_float(y);
}
template <int LPR> __device__ __forceinline__ float grp_sum(float v) {
    v = dpp_add(v, 0); v = dpp_add(v, 1); v = dpp_add(v, 2);
    if (LPR == 16) v = dpp_add(v, 3);
    return v;
}
#define BAR_LDS() asm volatile("s_waitcnt lgkmcnt(0)\n\ts_barrier" ::: "memory")
__device__ __forceinline__ float fast_sigmoid(float x) { return __builtin_amdgcn_rcpf(1.0f + __builtin_amdgcn_exp2f(-LOG2E * x)); }
__device__ __forceinline__ float fast_tanh(float x) { return 1.0f - 2.0f * __builtin_amdgcn_rcpf(1.0f + __builtin_amdgcn_exp2f(2.0f * LOG2E * x)); }
template <int NRP, int NSW>
__device__ __forceinline__ void scan_unit(LAS unsigned char* lds, KP P, int s, int d, int h, int rp) {
    constexpr int RPB = 64 / NRP, RPW = RPB / NSW, LPR = 64 / RPW, CPL = 64 / LPR;
    static_assert(LPR == 8 || LPR == 16, "scan geometry");
    int tid_ = threadIdx.x; asm volatile("" : "+v"(tid_));
    const int tid = tid_, lane = tid & 63, wid = __builtin_amdgcn_readfirstlane(tid >> 6);
    const int L = seq_len(s), base = seq_base(s), Ltot = L + 16, nchunk = (Ltot + 63) / 64;
    unsigned char* ws = P->ws;
    const bf16* Rb = (const bf16*)(ws + WS_R); const bf16* KAb = (const bf16*)(ws + WS_KA); const bf16* VAb = (const bf16*)(ws + WS_VA); const bf16* Lb = (const bf16*)(ws + WS_L);
    float* CB = (float*)(ws + WS_CB); bf16* YD = (bf16*)((unsigned char*)P->out + 64 * MiB) + (size_t)d * NMAIN * 512;
    LAS float* fS = (LAS float*)lds; LAS float* fV = (LAS float*)(lds + 81920); LAS float* fY = (LAS float*)(lds + SC_Y); LAS float* fMU = (LAS float*)(lds + SC_MU);
#define SCI(sl_, a_, c_) ((sl_) * 320 + (a_) * 64 + (c_))
    for (int i = tid; i < 832; i += NTHREADS) {
        float v;
        if (i < 640) { const int which = i / 320, jj = i % 320, a = jj >> 6, c = jj & 63; const int gi = a < 3 ? a * 512 + h * 64 + c : 1536 + (a - 3) * 64 + c; v = P->in[which ? I_MUN : I_MUP][gi]; }
        else { const int a = (i - 640) >> 6, c = (i - 640) & 63; v = P->in[a == 0 ? I_KK : a == 1 ? I_KA : I_RK][h * 64 + c]; }
        fMU[i] = v;
    }
    const int mat = wid >> 2, ntile = wid & 3;
    const bf16* Wt = (const bf16*)(ws + WS_LORA + (mat ? 131072 : 0)) + ((size_t)d * 512 + h * 64 + ntile * 16 + (lane & 15)) * 64 + (lane >> 4) * 8;
    const bf16x8 bfr0 = *(const bf16x8*)Wt, bfr1 = *(const bf16x8*)(Wt + 32);
    const float bias = P->in[mat ? I_A0 : I_W0][d * 512 + h * 64 + ntile * 16 + (lane & 15)];
    float S[CPL];
#pragma unroll
    for (int j = 0; j < CPL; ++j) S[j] = 0.f;
    const int rowl = lane / LPR, kg = lane % LPR, srow = rp * RPB + wid * RPW + rowl;
    const int slot = tid >> 3, cg8 = (tid & 7) * 8;
    u32x4 raw[5][3];
#define SC_META(c) (d ? ((c) == nchunk - 1) : ((c) == 0))
    const unsigned char* HALO0 = ws + WS_HALO + (size_t)(base >> 6) * 2 * HALO_ROW;
#define SC_LOAD(c) do { const int i_ = 64 * (c) + slot; const bool ok_ = i_ < Ltot; const int p_ = d ? Ltot - 1 - i_ : i_; \
        const unsigned zr_ = (unsigned)(METAROW + 64); \
        if (!SC_META(c)) { const unsigned rc_ = ok_ ? (unsigned)(base + p_ - 16) : zr_; \
            _Pragma("unroll") for (int a_ = 0; a_ < 5; ++a_) { const unsigned char* B_ = (const unsigned char*)(a_ == 0 ? Rb : a_ == 1 ? KAb : a_ == 2 ? VAb : Lb); const unsigned ld_ = a_ < 3 ? 1024u : 512u; \
                const unsigned co_ = (unsigned)(((a_ < 3 ? h * 64 : (a_ - 3) * 64) + cg8) * 2); raw[a_][1] = *(const u32x4*)(B_ + (rc_ * ld_ + co_)); } \
        } else { const bool me_ = ok_ && p_ < 16; const bool hn_ = me_ && p_ == 15; \
            const unsigned rc_ = ok_ ? (unsigned)pos_row(base, p_) : zr_, rp_ = (me_ && p_ > 0) ? (unsigned)(METAROW + p_ - 1) : zr_, rn_ = (me_ && p_ < 15) ? (unsigned)(METAROW + p_ + 1) : zr_; \
            _Pragma("unroll") for (int a_ = 0; a_ < 5; ++a_) { const unsigned char* B_ = (const unsigned char*)(a_ == 0 ? Rb : a_ == 1 ? KAb : a_ == 2 ? VAb : Lb); const unsigned ld_ = a_ < 3 ? 1024u : 512u; \
                const unsigned co_ = (unsigned)(((a_ < 3 ? h * 64 : (a_ - 3) * 64) + cg8) * 2); \
                const unsigned ho_ = (unsigned)(((a_ < 3 ? a_ * 512 + h * 64 : 1536 + (a_ - 3) * 64) + cg8) * 2); \
                raw[a_][0] = *(const u32x4*)(B_ + (rp_ * ld_ + co_)); raw[a_][1] = *(const u32x4*)(B_ + (rc_ * ld_ + co_)); \
                const unsigned char* np_ = hn_ ? HALO0 + ho_ : B_ + (rn_ * ld_ + co_); raw[a_][2] = *(const u32x4*)np_; } } } while (0)
    SC_LOAD(0);
    BAR_LDS();
    for (int c = 0; c < nchunk; ++c) {
        const int nvalid = (Ltot - 64 * c) < 64 ? (Ltot - 64 * c) : 64;
        float rv[8], kv[8];
        if (!SC_META(c)) {
            float vv8[8]; unpack8(raw[0][1], rv); unpack8(raw[1][1], kv); unpack8(raw[2][1], vv8);
            { LAS float* dst = fS + SCI(slot, 4, cg8); *(LAS f32x4*)dst = (f32x4){rv[0], rv[1], rv[2], rv[3]}; *(LAS f32x4*)(dst + 4) = (f32x4){rv[4], rv[5], rv[6], rv[7]}; }
            { LAS float* dst = fV + slot * 64 + cg8; *(LAS f32x4*)dst = (f32x4){vv8[0], vv8[1], vv8[2], vv8[3]}; *(LAS f32x4*)(dst + 4) = (f32x4){vv8[4], vv8[5], vv8[6], vv8[7]}; }
            *(LAS u32x4*)(lds + SC_TW + slot * 144 + cg8 * 2) = raw[3][1];
            *(LAS u32x4*)(lds + SC_AD + slot * 144 + cg8 * 2) = raw[4][1];
        } else {
            const int i1 = 64 * c + slot; const int p1 = d ? Ltot - 1 - i1 : i1; const bool me1 = i1 < Ltot && p1 < 16; const float fm = me1 ? 1.0f : 0.0f;
#pragma unroll
            for (int a = 0; a < 5; ++a) {
                float pv[8], cv[8], nv[8], o[8]; unpack8(raw[a][0], pv); unpack8(raw[a][1], cv); unpack8(raw[a][2], nv);
                const f32x4 mp0 = *(const LAS f32x4*)(fMU + a * 64 + cg8), mp1 = *(const LAS f32x4*)(fMU + a * 64 + cg8 + 4), mn0 = *(const LAS f32x4*)(fMU + 320 + a * 64 + cg8), mn1 = *(const LAS f32x4*)(fMU + 320 + a * 64 + cg8 + 4);
#pragma unroll
                for (int e = 0; e < 8; ++e) { const float mp = fm * (e < 4 ? mp0[e & 3] : mp1[e & 3]), mn = fm * (e < 4 ? mn0[e & 3] : mn1[e & 3]); o[e] = cv[e] + mp * (pv[e] - cv[e]) + mn * (nv[e] - cv[e]); }
                if (a == 0) {
#pragma unroll
                    for (int e = 0; e < 8; ++e) rv[e] = o[e];
                    LAS float* dst = fS + SCI(slot, 4, cg8); *(LAS f32x4*)dst = (f32x4){o[0], o[1], o[2], o[3]}; *(LAS f32x4*)(dst + 4) = (f32x4){o[4], o[5], o[6], o[7]};
                } else if (a == 1) {
#pragma unroll
                    for (int e = 0; e < 8; ++e) kv[e] = o[e];
                } else if (a == 2) {
                    LAS float* dst = fV + slot * 64 + cg8; *(LAS f32x4*)dst = (f32x4){o[0], o[1], o[2], o[3]}; *(LAS f32x4*)(dst + 4) = (f32x4){o[4], o[5], o[6], o[7]};
                } else {
                    if (a == 3) {
#pragma unroll
                        for (int e = 0; e < 8; ++e) o[e] = me1 ? fast_tanh(o[e]) : o[e];
                    }
                    u32x4 w; w.x = cvtpk(o[0], o[1]); w.y = cvtpk(o[2], o[3]); w.z = cvtpk(o[4], o[5]); w.w = cvtpk(o[6], o[7]);
                    *(LAS u32x4*)(lds + (a == 3 ? SC_TW : SC_AD) + slot * 144 + cg8 * 2) = w;
                }
            }
        }
        BAR_LDS();
        if (c + 1 < nchunk) SC_LOAD(c + 1);
        {
            const LAS unsigned char* Ab = lds + (mat ? SC_AD : SC_TW); LAS float* fWB = fS + (mat ? 128 : 64);
#pragma unroll
            for (int mt = 0; mt < 4; ++mt) {
                const bf16x8 a0 = *(const LAS bf16x8*)(Ab + (mt * 16 + (lane & 15)) * 144 + (lane >> 4) * 16);
                const bf16x8 a1 = *(const LAS bf16x8*)(Ab + (mt * 16 + (lane & 15)) * 144 + 64 + (lane >> 4) * 16);
                f32x4 acc = {0.f, 0.f, 0.f, 0.f};
                acc = __builtin_amdgcn_mfma_f32_16x16x32_bf16(a0, bfr0, acc, 0, 0, 0);
                acc = __builtin_amdgcn_mfma_f32_16x16x32_bf16(a1, bfr1, acc, 0, 0, 0);
#pragma unroll
                for (int rg = 0; rg < 4; ++rg) {
                    const int sl = mt * 16 + (lane >> 4) * 4 + rg, col = ntile * 16 + (lane & 15);
                    const float sg = fast_sigmoid(acc[rg] + bias); const float dc = __builtin_amdgcn_exp2f(-0.6065306597126334f * LOG2E * sg);
                    fWB[sl * 320 + col] = mat ? sg : dc;
                }
            }
        }
        BAR_LDS();
        {
            const f32x4 a0 = *(const LAS f32x4*)(fS + SCI(slot, 2, cg8)), a1 = *(const LAS f32x4*)(fS + SCI(slot, 2, cg8 + 4));
            const f32x4 kk0 = *(const LAS f32x4*)(fMU + 640 + cg8), kk1 = *(const LAS f32x4*)(fMU + 640 + cg8 + 4), ka0 = *(const LAS f32x4*)(fMU + 704 + cg8), ka1 = *(const LAS f32x4*)(fMU + 704 + cg8 + 4);
            const f32x4 rk0 = *(const LAS f32x4*)(fMU + 768 + cg8), rk1 = *(const LAS f32x4*)(fMU + 768 + cg8 + 4);
            float kkv[8], kd[8], av[8]; float ssq = 0.f, cs = 0.f;
#pragma unroll
            for (int e = 0; e < 8; ++e) {
                av[e] = e < 4 ? a0[e & 3] : a1[e & 3];
                kkv[e] = kv[e] * (e < 4 ? kk0[e & 3] : kk1[e & 3]); ssq = fmaf(kkv[e], kkv[e], ssq);
                kd[e] = kv[e] * (1.0f + (av[e] - 1.0f) * (e < 4 ? ka0[e & 3] : ka1[e & 3])); cs = fmaf(rv[e] * kd[e], e < 4 ? rk0[e & 3] : rk1[e & 3], cs);
            }
            ssq = grp_sum<8>(ssq); cs = grp_sum<8>(cs);
            const float rs = rsqrtf(fmaxf(ssq, 1e-24f));
#pragma unroll
            for (int e = 0; e < 8; ++e) { kkv[e] *= rs; av[e] *= kkv[e]; }
            LAS float* o1 = fS + SCI(slot, 0, cg8); *(LAS f32x4*)o1 = (f32x4){kkv[0], kkv[1], kkv[2], kkv[3]}; *(LAS f32x4*)(o1 + 4) = (f32x4){kkv[4], kkv[5], kkv[6], kkv[7]};
            LAS float* o2 = fS + SCI(slot, 2, cg8); *(LAS f32x4*)o2 = (f32x4){av[0], av[1], av[2], av[3]}; *(LAS f32x4*)(o2 + 4) = (f32x4){av[4], av[5], av[6], av[7]};
            LAS float* o3 = fS + SCI(slot, 3, cg8); *(LAS f32x4*)o3 = (f32x4){kd[0], kd[1], kd[2], kd[3]}; *(LAS f32x4*)(o3 + 4) = (f32x4){kd[4], kd[5], kd[6], kd[7]};
            if (cg8 == 0 && rp == 0 && slot < nvalid) { const int i2 = 64 * c + slot; const int p2 = d ? Ltot - 1 - i2 : i2; CB[((size_t)d * ROWS + pos_row(base, p2)) * 8 + h] = cs; }
        }
        BAR_LDS();
        if (wid < NSW) {
            typedef float f32x2_ __attribute__((ext_vector_type(2)));
            constexpr int C4 = CPL / 4;
            const LAS float* ps = fS + kg * CPL; const LAS float* pv = fV + srow; LAS float* py = fY + srow;
            f32x4 nk[C4], nw[C4], nb[C4], nd[C4], nr[C4]; float nv;
#define SC_FETCH(sl_) do { _Pragma("unroll") for (int j_ = 0; j_ < C4; ++j_) { nk[j_] = *(const LAS f32x4*)(ps + (sl_) * 320 + 4 * j_); nw[j_] = *(const LAS f32x4*)(ps + (sl_) * 320 + 64 + 4 * j_); \
                nb[j_] = *(const LAS f32x4*)(ps + (sl_) * 320 + 128 + 4 * j_); nd[j_] = *(const LAS f32x4*)(ps + (sl_) * 320 + 192 + 4 * j_); nr[j_] = *(const LAS f32x4*)(ps + (sl_) * 320 + 256 + 4 * j_); } nv = pv[(sl_) * 64]; } while (0)
            SC_FETCH(0);
            f32x4 rp4[C4];
#pragma unroll
            for (int j = 0; j < C4; ++j) rp4[j] = (f32x4){0.f, 0.f, 0.f, 0.f};
#pragma unroll 16
            for (int sl = 0; sl < nvalid; ++sl) {
                f32x4 ck[C4], cw[C4], cb[C4], cd[C4], cr[C4];
#pragma unroll
                for (int j = 0; j < C4; ++j) { ck[j] = nk[j]; cw[j] = nw[j]; cb[j] = nb[j]; cd[j] = nd[j]; cr[j] = nr[j]; }
                const float vv = nv;
                SC_FETCH(sl + 1 < 64 ? sl + 1 : 63);
                f32x2_ pa = {0.f, 0.f}, ya = {0.f, 0.f};
#pragma unroll
                for (int j = 0; j < C4; ++j)
#pragma unroll
                    for (int e = 0; e < 4; e += 2) { const f32x2_ s2 = {S[4 * j + e], S[4 * j + e + 1]}, k2 = {ck[j][e], ck[j][e + 1]}, r2 = {rp4[j][e], rp4[j][e + 1]}; pa = pa + s2 * k2; ya = ya + s2 * r2; }
                float pp = pa.x + pa.y, yy = ya.x + ya.y;
                pp = dpp_add(pp, 0); yy = dpp_add(yy, 0); pp = dpp_add(pp, 1); yy = dpp_add(yy, 1); pp = dpp_add(pp, 2); yy = dpp_add(yy, 2);
                if (LPR == 16) { pp = dpp_add(pp, 3); yy = dpp_add(yy, 3); }
                py[(sl > 0 ? sl - 1 : 0) * 64] = yy;
#pragma unroll
                for (int j = 0; j < C4; ++j)
#pragma unroll
                    for (int e = 0; e < 4; e += 2) {
                        const f32x2_ b2 = {cb[j][e], cb[j][e + 1]}, d2 = {cd[j][e], cd[j][e + 1]}, w2 = {cw[j][e], cw[j][e + 1]}; f32x2_ s2 = {S[4 * j + e], S[4 * j + e + 1]};
                        const f32x2_ t2 = d2 * vv - b2 * pp; s2 = s2 * w2 + t2; S[4 * j + e] = s2.x; S[4 * j + e + 1] = s2.y; }
#pragma unroll
                for (int j = 0; j < C4; ++j) rp4[j] = cr[j];
            }
            {
                f32x2_ ya = {0.f, 0.f};
#pragma unroll
                for (int j = 0; j < C4; ++j)
#pragma unroll
                    for (int e = 0; e < 4; e += 2) { const f32x2_ s2 = {S[4 * j + e], S[4 * j + e + 1]}, r2 = {rp4[j][e], rp4[j][e + 1]}; ya = ya + s2 * r2; }
                const float yy = grp_sum<LPR>(ya.x + ya.y);
                py[(nvalid - 1) * 64] = yy;
            }
#undef SC_FETCH
        }
        BAR_LDS();
        {
            const int i2 = 64 * c + slot; const int p2 = d ? Ltot - 1 - i2 : i2;
            if (slot < nvalid && p2 >= 16 && (cg8 / RPB) == rp) {
                const LAS float* yp = fY + slot * 64 + cg8; const f32x4 y0 = *(const LAS f32x4*)yp, y1 = *(const LAS f32x4*)(yp + 4);
                *(u32x4*)(YD + (size_t)(base + p2 - 16) * 512 + h * 64 + cg8) = pack8(y0, y1);
            }
        }
    }
#undef SC_LOAD
#undef SC_META
#undef SCI
}

__device__ __forceinline__ void rwkv_colmap(unsigned char* ws, int c0, bf16*& buf, int& ld, int& col) {
    if (c0 < 512) { buf = (bf16*)(ws + WS_R); ld = 512; col = c0; }
    else if (c0 < 1024) { buf = (bf16*)(ws + WS_KA); ld = 512; col = c0 - 512; }
    else if (c0 < 1536) { buf = (bf16*)(ws + WS_VA); ld = 512; col = c0 - 1024; }
    else { buf = (bf16*)(ws + WS_L); ld = 256; col = c0 - 1536; }
}
__device__ __forceinline__ void phase_halo(KP P) {
    const int tid = fresh_tid(), lane = tid & 63, wid = tid >> 6; const int gw = blockIdx.x * 8 + wid, NGW = gridDim.x * 8;
    unsigned char* ws = P->ws;
    for (int r = gw; r < (NMAIN / 64) * 2; r += NGW) {
        const int m = (r >> 1) * 64 + ((r & 1) ? 63 : 0);
        for (int j = lane; j < 224; j += 64) { bf16* buf; int ld, col; rwkv_colmap(ws, j * 8, buf, ld, col);
            *(u32x4*)(ws + WS_HALO + (size_t)r * HALO_ROW + j * 16) = *(const u32x4*)(buf + (size_t)m * ld + col); }
    }
}
__device__ __forceinline__ void phase_shift(LAS unsigned char* lds, KP P) {
    const int tid = fresh_tid(), slot = tid >> 3, cg = tid & 7;
    unsigned char* ws = P->ws; const float* mup = P->in[I_MUP]; const float* mun = P->in[I_MUN];
    for (int tile = blockIdx.x; tile < NMAIN / 64; tile += gridDim.x) {
        const int m0 = tile * 64, m = m0 + slot;
        const int ks = m0 < 16384 ? tile : ((m0 - 16384) & 2047) >> 6; const bool first = ks == 0, last = ks == (m0 < 16384 ? 255 : 31);
#pragma unroll 1
        for (int pass = 0; pass < 4; ++pass) {
#pragma unroll
            for (int i = 0; i < 7; ++i) { const int j = cg + 8 * i; bf16* buf; int ld, col; rwkv_colmap(ws, (pass * 56 + j) * 8, buf, ld, col);
                *(LAS u32x4*)(lds + (slot * 56 + j) * 16) = *(const u32x4*)(buf + (size_t)m * ld + col); }
            __syncthreads();
#pragma unroll
            for (int i = 0; i < 7; ++i) {
                const int j = cg + 8 * i, c0 = (pass * 56 + j) * 8; bf16* buf; int ld, col; rwkv_colmap(ws, c0, buf, ld, col);
                const u32x4 z = {0u, 0u, 0u, 0u};
                const u32x4 cu = *(const LAS u32x4*)(lds + (slot * 56 + j) * 16);
                u32x4 pu, nu;
                if (slot > 0) pu = *(const LAS u32x4*)(lds + ((slot - 1) * 56 + j) * 16);
                else pu = first ? *(const u32x4*)(buf + (size_t)(METAROW + 15) * ld + col) : *(const u32x4*)(ws + WS_HALO + (size_t)((tile - 1) * 2 + 1) * HALO_ROW + c0 * 2);
                if (slot < 63) nu = *(const LAS u32x4*)(lds + ((slot + 1) * 56 + j) * 16);
                else nu = last ? z : *(const u32x4*)(ws + WS_HALO + (size_t)((tile + 1) * 2) * HALO_ROW + c0 * 2);
                float pv[8], cv[8], nv[8], o[8]; unpack8(pu, pv); unpack8(cu, cv); unpack8(nu, nv);
                const f32x4 mp0 = *(const f32x4*)(mup + c0), mp1 = *(const f32x4*)(mup + c0 + 4), mn0 = *(const f32x4*)(mun + c0), mn1 = *(const f32x4*)(mun + c0 + 4);
#pragma unroll
                for (int e = 0; e < 8; ++e) { const float mp = e < 4 ? mp0[e & 3] : mp1[e & 3], mn = e < 4 ? mn0[e & 3] : mn1[e & 3]; o[e] = cv[e] + mp * (pv[e] - cv[e]) + mn * (nv[e] - cv[e]); }
                if (c0 >= 1536 && c0 < 1600) {
#pragma unroll
                    for (int e = 0; e < 8; ++e) o[e] = fast_tanh(o[e]);
                }
                u32x4 w; w.x = cvtpk(o[0], o[1]); w.y = cvtpk(o[2], o[3]); w.z = cvtpk(o[4], o[5]); w.w = cvtpk(o[6], o[7]);
                *(u32x4*)(buf + (size_t)m * ld + col) = w;
            }
            __syncthreads();
        }
    }
}

__device__ __forceinline__ void phase_post(LAS unsigned char* lds, KP P) {
    const int tid = fresh_tid(), lane = tid & 63, wid = tid >> 6;
    unsigned char* ws = P->ws;
    const bf16* VAb = (const bf16*)(ws + WS_VA); const bf16* Lb = (const bf16*)(ws + WS_L); bf16* Rb = (bf16*)(ws + WS_R);
    const float* CB = (const float*)(ws + WS_CB); const bf16* YD0 = (const bf16*)((const unsigned char*)P->out + 64 * MiB); const bf16* YD1 = YD0 + (size_t)NMAIN * 512;
    const bf16* GT = (const bf16*)(ws + WS_LORA + 262144);
    LAS float* st = (LAS float*)(lds + 17408);
    const float* mup = P->in[I_MUP]; const float* mun = P->in[I_MUN];
    for (int tile = blockIdx.x; tile < NMAIN / 64; tile += gridDim.x) {
        {
            const int row = tid >> 3, hh = tid & 7, m = tile * 64 + row;
            const int t = m < 16384 ? m : (m - 16384) & 2047, Ls = m < 16384 ? 16384 : 2048;
            float sum = 0.f, sq = 0.f;
#pragma unroll
            for (int i = 0; i < 8; ++i) { float a[8], b[8]; unpack8(*(const u32x4*)(YD0 + (size_t)m * 512 + hh * 64 + i * 8), a); unpack8(*(const u32x4*)(YD1 + (size_t)m * 512 + hh * 64 + i * 8), b);
#pragma unroll
                for (int e = 0; e < 8; ++e) { const float y = a[e] + b[e]; sum += y; sq += y * y; } }
            const float mu = sum * (1.0f / 64.0f); const float var = fmaxf(sq * (1.0f / 64.0f) - mu * mu, 0.f);
            st[(row * 8 + hh) * 2] = mu; st[(row * 8 + hh) * 2 + 1] = rsqrtf(var + 64e-5f);
#pragma unroll
            for (int i = 0; i < 2; ++i) {
                const int c0 = 128 + hh * 16 + i * 8; float cv[8], o[8];
                unpack8(*(const u32x4*)(Lb + (size_t)m * 256 + c0), cv);
#pragma unroll
                for (int e = 0; e < 8; ++e) o[e] = sigmoidf_(cv[e]);
                u32x4 w; w.x = cvtpk(o[0], o[1]); w.y = cvtpk(o[2], o[3]); w.z = cvtpk(o[4], o[5]); w.w = cvtpk(o[6], o[7]);
                *(LAS u32x4*)(lds + row * 272 + (hh * 16 + i * 8) * 2) = w;
            }
        }
        __syncthreads();
#pragma unroll 1
        for (int nt = 0; nt < 4; ++nt) {
            const int col = wid * 64 + nt * 16 + (lane & 15);
            bf16x8 bfr[4];
#pragma unroll
            for (int ks = 0; ks < 4; ++ks) bfr[ks] = *(const bf16x8*)(GT + (size_t)col * 128 + ks * 32 + (lane >> 4) * 8);
            const float lw = P->in[I_LNW][col], lb = P->in[I_LNB][col];
            const float mpv = mup[1024 + col], mnv = mun[1024 + col];
#pragma unroll 1
            for (int mt = 0; mt < 4; ++mt) {
                f32x4 acc = {0.f, 0.f, 0.f, 0.f};
#pragma unroll
                for (int ks = 0; ks < 4; ++ks) { const bf16x8 a = *(const LAS bf16x8*)(lds + (mt * 16 + (lane & 15)) * 272 + ks * 64 + (lane >> 4) * 16); acc = __builtin_amdgcn_mfma_f32_16x16x32_bf16(a, bfr[ks], acc, 0, 0, 0); }
#pragma unroll
                for (int rg = 0; rg < 4; ++rg) {
                    const int row = mt * 16 + (lane >> 4) * 4 + rg, m = tile * 64 + row;
                    const int t = m < 16384 ? m : (m - 16384) & 2047, Ls = m < 16384 ? 16384 : 2048;
                    const float y = bf2f(YD0[(size_t)m * 512 + col]) + bf2f(YD1[(size_t)m * 512 + col]);
                    const float yn = (y - st[(row * 8 + wid) * 2]) * st[(row * 8 + wid) * 2 + 1] * lw + lb;
                    const float vs = bf2f(VAb[(size_t)m * 512 + col]);
                    const float cb = CB[(size_t)m * 8 + wid] + CB[((size_t)ROWS + m) * 8 + wid];
                    Rb[(size_t)m * 512 + col] = (bf16)f2bf_rne((yn + cb * vs) * acc[rg]);
                }
            }
        }
        __syncthreads();
    }
}

__device__ __forceinline__ void phase_rms_bf16(KP P) {
    const int tid = fresh_tid(), lane = tid & 63, wid = tid >> 6; const int gw = blockIdx.x * 8 + wid, NGW = gridDim.x * 8;
    bf16* MN = (bf16*)(P->ws + WS_MN);
    for (int m = gw; m < NMAIN; m += NGW) rms_row_bf16(P->out + (size_t)m * DM, P->in[I_GFFN], MN + (size_t)m * DM, lane);
}
__device__ __forceinline__ void phase_final(KP P) {
    const int tid = fresh_tid(), lane = tid & 63, wid = tid >> 6; const int gw = blockIdx.x * 8 + wid, NGW = gridDim.x * 8;
    const f32x4* gr = (const f32x4*)P->in[I_GFIN] + lane;
    for (int m = gw; m < NMAIN; m += NGW) {
        f32x4* xr = (f32x4*)(P->out + (size_t)m * DM) + lane; f32x4 v[4]; float s = 0.f;
#pragma unroll
        for (int j = 0; j < 4; ++j) { v[j] = xr[64 * j]; s += (v[j].x * v[j].x + v[j].y * v[j].y) + (v[j].z * v[j].z + v[j].w * v[j].w); }
        const float rstd = rsqrtf(wave_sum(s) * (1.f / DM) + 1e-6f);
#pragma unroll
        for (int j = 0; j < 4; ++j) xr[64 * j] = v[j] * rstd * gr[64 * j];
    }
}

constexpr int NRP_LONG = 4;
constexpr int N_LONG = 16 * NRP_LONG, N_ATT_P = 512, N_ATT_S = 512, N_SHORT = 128, N_ITEMS = N_LONG + N_ATT_P + N_ATT_S + N_SHORT;

template <class Op> __device__ __forceinline__ void run_gemm(LAS unsigned char* lds, const bf16* A, const bf16* Bt, int M, int N, int K, const Op& op, const bf16* A2 = nullptr, int pm2 = 1 << 30) {
    pg8::Gemm g{A, Bt, M, N, K, A2, pm2}; pg8::StaticOrder S; S.init(M, N, (int)gridDim.x, (int)blockIdx.x);
    Epi8<Op> E{op};
    pg8::gemm_phase<Epi8<Op>, pg8::StaticOrder, true, true>(lds, g, S, E);
}

constexpr size_t WS_XBAR = 16384;
#define XB_TMO      128
#define XB_XCNT(j)  (256  + 64 * (j))
#define XB_XSUB(j)  (1280 + 64 * (j))
#define XB_XGEN(j)  (2304 + 64 * (j))
#define XB_TOP      3328
#define XB_TOPGEN   3392
#define XCD_BAR_WORDS 3456
#define XB_SPIN_CAP (1u << 18)
__device__ __forceinline__ unsigned xb_ld(unsigned* p)              { return __hip_atomic_load(p, __ATOMIC_RELAXED, __HIP_MEMORY_SCOPE_AGENT); }
__device__ __forceinline__ unsigned xb_add(unsigned* p, unsigned v) { return __hip_atomic_fetch_add(p, v, __ATOMIC_RELAXED, __HIP_MEMORY_SCOPE_AGENT); }
__device__ __forceinline__ unsigned xb_xcc_id() { return (unsigned)__builtin_amdgcn_s_getreg((3 << 11) | 20) & 0xFu; }
#define XB_SPIN(cond, bar) do { unsigned _sp = 0; while (cond) { __builtin_amdgcn_s_sleep(1); \
    if ((++_sp & 255u) == 0u) { if (xb_ld(&(bar)[XB_TMO])) break; if (_sp > XB_SPIN_CAP) { atomicAdd(&(bar)[XB_TMO], 1u); break; } } } } while (0)
struct XcdBarrier { unsigned* bar; unsigned x; volatile LAS unsigned* st; };
__device__ __forceinline__ XcdBarrier xcd_barrier_post(unsigned* bar, volatile LAS unsigned* st) {
    XcdBarrier b; b.bar = bar; b.x = xb_xcc_id(); b.st = st;
    if (threadIdx.x == 0) (void)xb_add(&bar[XB_XCNT(b.x)], 1u);
    return b;
}
__device__ __forceinline__ void xcd_barrier_complete(unsigned* bar, unsigned x, unsigned& nloc, unsigned& nx) {
    const unsigned G = gridDim.x * gridDim.y * gridDim.z;
    unsigned sum, cnt, mine, sp = 0u;
    for (;;) {
        sum = 0u; cnt = 0u; mine = 0u;
#pragma unroll
        for (unsigned j = 0; j < 16; ++j) { const unsigned c = xb_ld(&bar[XB_XCNT(j)]); sum += c; cnt += (c > 0u) ? 1u : 0u; mine = (j == x) ? c : mine; }
        if (sum == G) break;
        __builtin_amdgcn_s_sleep(1);
        if ((++sp & 255u) == 0u) { if (xb_ld(&bar[XB_TMO])) break; if (sp > XB_SPIN_CAP) { atomicAdd(&bar[XB_TMO], 1u); break; } }
    }
    nloc = mine > 0u ? mine : 1u; nx = cnt > 0u ? cnt : 1u;
}
__device__ __forceinline__ void xcd_barrier(const XcdBarrier& b) {
    asm volatile("s_waitcnt vmcnt(0)" ::: "memory");
    __syncthreads();
    if (threadIdx.x == 0) {
        unsigned* bar = b.bar;
        __builtin_amdgcn_s_waitcnt(0);
        unsigned nloc = b.st[0], nx = b.st[1];
        if (nloc == 0u) { xcd_barrier_complete(bar, b.x, nloc, nx); b.st[0] = nloc; b.st[1] = nx; }
        const unsigned old = xb_add(&bar[XB_XSUB(b.x)], 1u);
        const unsigned gen = old / nloc;
        if (old + 1u == (gen + 1u) * nloc) {
            __builtin_amdgcn_fence(__ATOMIC_RELEASE, "agent");
            asm volatile("s_waitcnt vmcnt(0)" ::: "memory");
            const unsigned og = xb_add(&bar[XB_TOP], 1u);
            const unsigned tg = og / nx;
            if (og + 1u == (tg + 1u) * nx) xb_add(&bar[XB_TOPGEN], 1u);
            else XB_SPIN(xb_ld(&bar[XB_TOPGEN]) == tg, bar);
            __builtin_amdgcn_fence(__ATOMIC_ACQUIRE, "agent");
            xb_add(&bar[XB_XGEN(b.x)], 1u);
            asm volatile("s_waitcnt vmcnt(0)" ::: "memory");
        } else {
            XB_SPIN(xb_ld(&bar[XB_XGEN(b.x)]) == gen, bar);
            __builtin_amdgcn_fence(__ATOMIC_ACQUIRE, "agent");
            asm volatile("s_waitcnt vmcnt(0)" ::: "memory");
        }
    }
    __syncthreads();
}
#ifndef PROBE_MASK
#define PROBE_MASK 0
#endif
#ifndef PROBE_MUL
#define PROBE_MUL 1
#endif
#define PH_BEGIN(k) unsigned long long t0_##k = 0; if (PROBE_MASK & (1 << (k))) t0_##k = __builtin_amdgcn_s_memrealtime();
#define PH_END(k) if (PROBE_MASK & (1 << (k))) { const unsigned long long t1_ = __builtin_amdgcn_s_memrealtime(); const unsigned long long dt_ = (t1_ - t0_##k) * PROBE_MUL; while (__builtin_amdgcn_s_memrealtime() - t1_ < dt_) __builtin_amdgcn_s_sleep(8); xcd_barrier(xbar); }
__global__ void __launch_bounds__(NTHREADS) fwd_megakernel(Params Pin) {
    extern __shared__ __attribute__((aligned(16))) unsigned char lds_raw[];
    LAS unsigned char* lds = (LAS unsigned char*)lds_raw;
    cg::grid_group grid = cg::this_grid();
    KP P0 = (KP)__builtin_amdgcn_kernarg_segment_ptr();
    volatile LAS unsigned* xst = (volatile LAS unsigned*)(lds + LDS_ITEM_OFF + 4);
    if (threadIdx.x == 0) { xst[0] = 0u; xst[1] = 0u; }
    __syncthreads();
    const XcdBarrier xbar = xcd_barrier_post((unsigned*)(P0->ws + WS_XBAR), xst);
#define NEWPHASE KP P = P0; asm volatile("" : "+s"(P)); unsigned char* ws = P->ws; (void)ws;

    PH_BEGIN(0)
    { NEWPHASE phase_prologue(lds, P); }
    grid.sync();
    PH_END(0)
    PH_BEGIN(1)
    { NEWPHASE run_gemm(lds, (const bf16*)P->out, (const bf16*)(ws + WS_WIN), ROWS, 3328, 1024, OpProj{ws}, (const bf16*)(ws + WS_XNMETA), 128); }
    xcd_barrier(xbar);
    PH_END(1)
    { NEWPHASE phase_halo(P); }
    xcd_barrier(xbar);
    { NEWPHASE phase_shift(lds, P); }
    xcd_barrier(xbar);
    PH_BEGIN(2)
    { NEWPHASE
        const int tid = fresh_tid();
        float lam;
        { const int lane = tid & 63; const float s1 = wave_sum(P->in[I_LQ1][lane] * P->in[I_LK1][lane]), s2 = wave_sum(P->in[I_LQ2][lane] * P->in[I_LK2][lane]); lam = __expf(s1) - __expf(s2) + 0.2f; }
        unsigned* ctr = (unsigned*)(ws + WS_CTL);
        LAS unsigned* slot = (LAS unsigned*)(lds + LDS_ITEM_OFF);
#define FETCH(k, n) if (tid == 0) *slot = atomicAdd(ctr + 64 * (k), 1u); __syncthreads(); const int idx = (int)*slot; __syncthreads(); if (idx >= (n)) break;
#ifndef NO_SCAN
#pragma unroll 1
        for (;;) { FETCH(0, N_LONG) const int u = idx / NRP_LONG; scan_unit<NRP_LONG, 4>(lds, P, 0, u >> 3, u & 7, idx % NRP_LONG); }
#endif
#ifndef NO_ATTN
#pragma unroll 1
        for (;;) { FETCH(1, N_ATT_P + N_ATT_S)
            if (idx < N_ATT_P) attn_unit(lds, P, 0, idx >> 7, idx & 127, lam);
            else { const int a = idx - N_ATT_P; attn_unit(lds, P, 1 + (a >> 6), (a >> 4) & 3, a & 15, lam); } }
#endif
#ifndef NO_SCAN
#pragma unroll 1
        for (;;) { FETCH(2, N_SHORT) scan_unit<1, 8>(lds, P, 1 + (idx >> 4), (idx >> 3) & 1, idx & 7, 0); }
#endif
#undef FETCH
    }
    xcd_barrier(xbar);
    PH_END(2)
#ifndef NO_POST
    PH_BEGIN(3)
    { NEWPHASE phase_post(lds, P); }
#endif
    xcd_barrier(xbar);
    PH_END(3)
    PH_BEGIN(4)
    { NEWPHASE run_gemm(lds, (const bf16*)P->out, (const bf16*)(ws + WS_WIN) + (size_t)3328 * 1024, NMAIN, 1024, 1024, OpGate{(bf16*)(ws + WS_GA)}); }
    { NEWPHASE run_gemm(lds, (const bf16*)P->out, (const bf16*)(ws + WS_WIN) + (size_t)4352 * 1024, NMAIN, 1024, 1024, OpGate{(bf16*)(ws + WS_GB)}); }

    PH_END(4)
    PH_BEGIN(5)
    { NEWPHASE run_gemm(lds, (const bf16*)(ws + WS_R), (const bf16*)(ws + WS_WUPA), NMAIN, 1024, 512, OpUpA{ws}); }
    PH_END(5)
    PH_BEGIN(6)
    { NEWPHASE run_gemm(lds, (const bf16*)(ws + WS_Q), (const bf16*)(ws + WS_WUPB), NMAIN, 1024, 512, OpUpB{ws}); }
    xcd_barrier(xbar);
    PH_END(6)
    PH_BEGIN(7)
    { NEWPHASE run_gemm(lds, (const bf16*)(ws + WS_GB), (const bf16*)(ws + WS_WOUT), NMAIN, 1024, 1024, OpOut{P->in[I_XP], P->in[I_XS], P->out}); }
    xcd_barrier(xbar);
    PH_END(7)
    PH_BEGIN(8)
    { NEWPHASE phase_rms_bf16(P); }
    xcd_barrier(xbar);
    PH_END(8)
    PH_BEGIN(9)
    { NEWPHASE run_gemm(lds, (const bf16*)(ws + WS_MN), (const bf16*)(ws + WS_WFF1), 16384, DFF, 1024, OpFF1{(bf16*)(ws + WS_HID)}); }
    xcd_barrier(xbar);
    PH_END(9)
    PH_BEGIN(10)
    { NEWPHASE run_gemm(lds, (const bf16*)(ws + WS_HID), (const bf16*)(ws + WS_WFF2), 16384, 1024, DFF, OpFF2{P->out}); }
    xcd_barrier(xbar);
    PH_END(10)
    PH_BEGIN(11)
    { NEWPHASE run_gemm(lds, (const bf16*)(ws + WS_MN) + (size_t)16384 * DM, (const bf16*)(ws + WS_WFF1), 16384, DFF, 1024, OpFF1{(bf16*)(ws + WS_HID)}); }
    xcd_barrier(xbar);
    PH_END(11)
    PH_BEGIN(12)
    { NEWPHASE run_gemm(lds, (const bf16*)(ws + WS_HID), (const bf16*)(ws + WS_WFF2), 16384, 1024, DFF, OpFF2{P->out + (size_t)16384 * DM}); }
    xcd_barrier(xbar);
    PH_END(12)
    PH_BEGIN(13)
    { NEWPHASE phase_final(P); }
}

extern "C" void kernel_launch(void* const* d_in, const int* in_sizes, int n_in, void* d_out, int out_size, void* d_ws, size_t ws_size, hipStream_t stream) {
    static int grid_blocks = 0;
    if (grid_blocks == 0) {
        int dev = 0, cus = 0, per_cu = 0;
        hipGetDevice(&dev);
        hipDeviceGetAttribute(&cus, hipDeviceAttributeMultiprocessorCount, dev);
        hipFuncSetAttribute((const void*)fwd_megakernel, hipFuncAttributeMaxDynamicSharedMemorySize, LDS_BYTES);
        hipOccupancyMaxActiveBlocksPerMultiprocessor(&per_cu, (const void*)fwd_megakernel, NTHREADS, LDS_BYTES);
        if (per_cu < 1) { fprintf(stderr, "kernel_launch: occupancy query says %d blocks per CU\n", per_cu); per_cu = 1; }
        grid_blocks = cus * per_cu;
        if (n_in != 29 || ws_size < WS_END) fprintf(stderr, "kernel_launch: unexpected n_in %d / ws_size %zu\n", n_in, ws_size);
    }
    hipMemsetAsync((unsigned char*)d_ws + WS_CTL, 0, 32768, stream);
    Params p{};
    for (int i = 0; i < 29; ++i) p.in[i] = (const float*)d_in[i];
    p.out = (float*)d_out; p.ws = (unsigned char*)d_ws;
    void* args[] = {&p};
    hipError_t e = hipLaunchCooperativeKernel((const void*)fwd_megakernel, dim3(grid_blocks), dim3(NTHREADS), args, LDS_BYTES, stream);
    if (e != hipSuccess) fprintf(stderr, "cooperative launch failed: %s (grid %d)\n", hipGetErrorString(e), grid_blocks);
}
```

```cpp
#include <hip/hip_runtime.h>
#include <hip/hip_cooperative_groups.h>
#include <cstdio>
#include <cstdint>
#include <cmath>
namespace cg = cooperative_groups;
__device__ __forceinline__ int fresh_tid() { int t = threadIdx.x; asm volatile("" : "+v"(t)); return t; }
namespace pg8 {
#define PG8_LAS __attribute__((address_space(3)))
typedef unsigned short bf16_t;
typedef short bf16x8 __attribute__((ext_vector_type(8)));
typedef float f32x4 __attribute__((ext_vector_type(4)));
typedef unsigned u32x4 __attribute__((ext_vector_type(4)));
constexpr int BM = 256, BK = 64, HALF = 128, HTB = HALF * BK * 2  , STAGE_BYTES = 8 * HTB, NXCD = 8, WGM = 8;

__host__ __device__ __forceinline__ int lds_byte(int r, int c) { const int st = (r >> 4) * 2 + (c >> 5), rr = r & 15, cc = c & 31, ob = rr * 64 + cc * 2; return st * 1024 + (ob ^ (((ob >> 9) & 1) << 5)); }
__host__ __device__ __forceinline__ void stage_rc(int b, int& R, int& C) { const int st = b / 1024, sb = b % 1024, swz = sb ^ (((sb >> 9) & 1) << 5); R = (st >> 1) * 16 + swz / 64; C = (st & 1) * 32 + (swz % 64) / 2; }
__host__ __device__ __forceinline__ int perm32(int rho) { const int n = rho >> 4, i = rho & 15; return 8 * (i >> 2) + 4 * n + (i & 3); }

struct Unit { int pm, pn; };
struct Gemm { const bf16_t* A; const bf16_t* Bt; int M, N, K; const bf16_t* A2; int pm2; };
__device__ __forceinline__ const char* gemm_abase(const Gemm& g, int pm, size_t tstep) { return pm >= g.pm2 ? (const char*)g.A2 + (size_t)(pm - g.pm2) * tstep : (const char*)g.A + (size_t)pm * tstep; }

struct StaticOrder {
    int nM, nN, nwg, G, c;
    __host__ __device__ void init(int M, int N, int G_, int c_) { nM = M / BM; nN = N / BM; nwg = nM * nN; G = G_; c = c_; }
    __host__ __device__ bool next(int i, Unit& u) const {
        const long L = (long)i * G + c; if (L >= nwg) return false;
        int wgid = (int)L; { const int q = nwg / NXCD, r = nwg % NXCD, xcd = wgid % NXCD, off = wgid / NXCD; wgid = (xcd < r ? xcd * (q + 1) : r * (q + 1) + (xcd - r) * q) + off; }
        const int nig = WGM * nN, gid = wgid / nig, fm = gid * WGM, gsz = (nM - fm) < WGM ? (nM - fm) : WGM;
        u.pm = fm + ((wgid % nig) % gsz); u.pn = (wgid % nig) / gsz; return true;
    }
    __device__ __forceinline__ void a_ready(const Unit&) const {}
    __device__ __forceinline__ void done(const Unit&) const {}
};


template <class Epi, class Sched, bool ALIGN_EPI = false, bool SP2 = false>
__device__ __forceinline__ void gemm_phase(PG8_LAS unsigned char* lds, const Gemm g, const Sched& S, const Epi& E) {
    const int tid = fresh_tid(), wid = __builtin_amdgcn_readfirstlane(tid >> 6), lane = tid & 63, wr = wid >> 2, wc = wid & 3, fr = lane & 15, fq = lane >> 4;
    const int K = g.K, nt = K / BK;
    unsigned voffA[2], voffB[2];
#pragma unroll
    for (int i = 0; i < 2; ++i) { int R, C; stage_rc(tid * 16 + i * 8192, R, C); const int Rb = Epi::PERM ? ((R & ~31) + perm32(R & 31)) : R;
        voffA[i] = (unsigned)(R * K + C) * 2u; voffB[i] = (unsigned)(Rb * K + C) * 2u; }
    const size_t kstep = (size_t)(BK * 2);
    const size_t hstep = (size_t)HALF * K * 2;
    const size_t tstep = 2 * hstep;
    const unsigned ldsw = (unsigned)wid * 1024u;
    const int aoff = lds_byte(wr * 64 + fr, fq * 8), boff = lds_byte(wc * 32 + fr, fq * 8);
#define PG8_SA(b, h) (((b) * 2 + (h)) * HTB)
#define PG8_SB(b, h) ((4 + (b) * 2 + (h)) * HTB)
#define PG8_STAGE(bufoff, gbase, voff) do { _Pragma("unroll") for (int _i = 0; _i < 2; ++_i) \
        __builtin_amdgcn_global_load_lds((const unsigned*)((const char*)(gbase) + (voff)[_i]), (PG8_LAS unsigned*)(lds + (bufoff) + ldsw + _i * 8192), 16, 0, 0); } while (0)
#define PG8_LDA(dst, b, h) do { _Pragma("unroll") for (int m = 0; m < 4; ++m) _Pragma("unroll") for (int k = 0; k < 2; ++k) dst[m][k] = *(const PG8_LAS bf16x8*)(lds + PG8_SA(b, h) + aoff + m * 2048 + k * 1024); } while (0)
#define PG8_LDB(dst, b, h) do { _Pragma("unroll") for (int n = 0; n < 2; ++n) _Pragma("unroll") for (int k = 0; k < 2; ++k) dst[n][k] = *(const PG8_LAS bf16x8*)(lds + PG8_SB(b, h) + boff + n * 2048 + k * 1024); } while (0)
#define PG8_MMA(ai, bj, At, Bt) do { __builtin_amdgcn_s_setprio(1); _Pragma("unroll") for (int m = 0; m < 4; ++m) _Pragma("unroll") for (int n = 0; n < 2; ++n) _Pragma("unroll") for (int k = 0; k < 2; ++k) \
        acc[ai][bj][m][n] = __builtin_amdgcn_mfma_f32_16x16x32_bf16(Bt[n][k], At[m][k], acc[ai][bj][m][n], 0, 0, 0); __builtin_amdgcn_s_setprio(0); } while (0)
#define PG8_WAIT_V(n) asm volatile("s_waitcnt vmcnt(" #n ")" ::: "memory")
#define PG8_WAIT_L(n) asm volatile("s_waitcnt lgkmcnt(" #n ")" ::: "memory")
#define PG8_BAR __builtin_amdgcn_s_barrier()
#define PG8_SCHED __builtin_amdgcn_sched_barrier(0)
    Unit cur, nxt; int ui = 0;
    if (!S.next(0, cur)) return;
    f32x4 acc[2][2][4][2];
#pragma unroll
    for (int a = 0; a < 2; ++a)
#pragma unroll
        for (int b = 0; b < 2; ++b)
#pragma unroll
            for (int m = 0; m < 4; ++m)
#pragma unroll
                for (int n = 0; n < 2; ++n) acc[a][b][m][n] = (f32x4){0.f, 0.f, 0.f, 0.f};
    bf16x8 At[4][2], B0[2][2], B1[2][2];
    const char* cA = gemm_abase(g, cur.pm, tstep); const char* cB = (const char*)g.Bt + (size_t)cur.pn * tstep;
    S.a_ready(cur);
    if constexpr (SP2) {
        PG8_STAGE(PG8_SB(0, 0), cB, voffB); PG8_STAGE(PG8_SB(0, 1), cB + hstep, voffB); PG8_STAGE(PG8_SA(0, 0), cA, voffA); PG8_STAGE(PG8_SA(0, 1), cA + hstep, voffA);
        if (wr == 1) PG8_BAR;
        PG8_WAIT_V(2); PG8_BAR;
        PG8_STAGE(PG8_SB(1, 0), cB + kstep, voffB); PG8_STAGE(PG8_SA(1, 0), cA + kstep, voffA); PG8_STAGE(PG8_SB(1, 1), cB + hstep + kstep, voffB);
        PG8_WAIT_V(6); PG8_BAR;
    } else {
        PG8_STAGE(PG8_SB(0, 0), cB, voffB); PG8_STAGE(PG8_SA(0, 0), cA, voffA); PG8_STAGE(PG8_SB(0, 1), cB + hstep, voffB); PG8_STAGE(PG8_SA(0, 1), cA + hstep, voffA);
        if (wr == 1) PG8_BAR;
        PG8_WAIT_V(4); PG8_BAR;
        PG8_STAGE(PG8_SB(1, 0), cB + kstep, voffB); PG8_STAGE(PG8_SA(1, 0), cA + kstep, voffA); PG8_STAGE(PG8_SB(1, 1), cB + hstep + kstep, voffB);
        PG8_WAIT_V(6); PG8_BAR;
    }
    for (;;) {
        const bool has_next = S.next(ui + 1, nxt);
        const char* nA = has_next ? gemm_abase(g, nxt.pm, tstep) : cA; const char* nB = has_next ? (const char*)g.Bt + (size_t)nxt.pn * tstep : cB;
        for (int t = 0; t < nt; t += 2) {
            const bool last = (t == nt - 2);
            const char* a1 = cA + (size_t)(t + 1) * kstep;
            const char* a2 = last ? nA : cA + (size_t)(t + 2) * kstep; const char* b2 = last ? nB : cB + (size_t)(t + 2) * kstep;
            const char* a3 = a2 + kstep; const char* b3 = b2 + kstep;
            if (last && has_next) S.a_ready(nxt);
            if constexpr (SP2) {
            PG8_LDB(B0, 0, 0); PG8_LDB(B1, 0, 1); PG8_SCHED; PG8_LDA(At, 0, 0); PG8_STAGE(PG8_SA(1, 1), a1 + hstep, voffA);
            PG8_WAIT_V(8); PG8_WAIT_L(0); PG8_BAR; PG8_MMA(0, 0, At, B0); PG8_MMA(0, 1, At, B1); PG8_BAR; PG8_SCHED;
            PG8_LDA(At, 0, 1); PG8_STAGE(PG8_SB(0, 0), b2, voffB); PG8_STAGE(PG8_SB(0, 1), b2 + hstep, voffB); PG8_STAGE(PG8_SA(0, 0), a2, voffA);
            PG8_WAIT_V(8); PG8_WAIT_L(0); PG8_BAR; PG8_MMA(1, 0, At, B0); PG8_MMA(1, 1, At, B1); PG8_BAR; PG8_SCHED;
            PG8_LDB(B0, 1, 0); PG8_LDB(B1, 1, 1); PG8_SCHED; PG8_LDA(At, 1, 0); PG8_STAGE(PG8_SA(0, 1), a2 + hstep, voffA);
            PG8_WAIT_V(8); PG8_WAIT_L(0); PG8_BAR; PG8_MMA(0, 0, At, B0); PG8_MMA(0, 1, At, B1); PG8_BAR; PG8_SCHED;
            PG8_LDA(At, 1, 1); PG8_STAGE(PG8_SB(1, 0), b3, voffB); PG8_STAGE(PG8_SB(1, 1), b3 + hstep, voffB); PG8_STAGE(PG8_SA(1, 0), a3, voffA);
            PG8_WAIT_V(8); PG8_WAIT_L(0); PG8_BAR; PG8_MMA(1, 0, At, B0); PG8_MMA(1, 1, At, B1); PG8_BAR; PG8_SCHED;
            } else {
            PG8_LDB(B0, 0, 0); PG8_SCHED; PG8_LDA(At, 0, 0); PG8_STAGE(PG8_SA(1, 1), a1 + hstep, voffA);
            PG8_WAIT_L(8); PG8_BAR; PG8_WAIT_L(0); PG8_MMA(0, 0, At, B0); PG8_BAR; PG8_SCHED;
            PG8_LDB(B1, 0, 1); PG8_STAGE(PG8_SB(0, 0), b2, voffB);
            PG8_BAR; PG8_WAIT_L(0); PG8_MMA(0, 1, At, B1); PG8_BAR;
            PG8_LDA(At, 0, 1); PG8_STAGE(PG8_SA(0, 0), a2, voffA);
            PG8_BAR; PG8_WAIT_L(0); PG8_MMA(1, 0, At, B0); PG8_BAR; PG8_SCHED;
            PG8_STAGE(PG8_SB(0, 1), b2 + hstep, voffB);
            PG8_WAIT_V(6); PG8_BAR; PG8_MMA(1, 1, At, B1); PG8_BAR;
            PG8_LDB(B0, 1, 0); PG8_SCHED; PG8_LDA(At, 1, 0); PG8_STAGE(PG8_SA(0, 1), a2 + hstep, voffA);
            PG8_WAIT_L(8); PG8_BAR; PG8_WAIT_L(0); PG8_MMA(0, 0, At, B0); PG8_BAR; PG8_SCHED;
            PG8_LDB(B1, 1, 1); PG8_STAGE(PG8_SB(1, 0), b3, voffB);
            PG8_BAR; PG8_WAIT_L(0); PG8_MMA(0, 1, At, B1); PG8_BAR;
            PG8_LDA(At, 1, 1); PG8_STAGE(PG8_SA(1, 0), a3, voffA);
            PG8_BAR; PG8_WAIT_L(0); PG8_MMA(1, 0, At, B0); PG8_BAR; PG8_SCHED;
            PG8_STAGE(PG8_SB(1, 1), b3 + hstep, voffB);
            PG8_WAIT_V(6); PG8_BAR; PG8_MMA(1, 1, At, B1); PG8_BAR;
            }
        }
        if constexpr (ALIGN_EPI) { if (wr == 0) PG8_BAR; }
        if constexpr (!Epi::AFTER_DRAIN) { E(acc, cur, wr, wc, fr, fq); S.done(cur); }
        if (!has_next) break;
#pragma unroll
        for (int a = 0; a < 2; ++a)
#pragma unroll
            for (int b = 0; b < 2; ++b)
#pragma unroll
                for (int m = 0; m < 4; ++m)
#pragma unroll
                    for (int n = 0; n < 2; ++n) acc[a][b][m][n] = (f32x4){0.f, 0.f, 0.f, 0.f};
        cur = nxt; cA = nA; cB = nB; ++ui;
        if constexpr (ALIGN_EPI) { if (wr == 1) PG8_BAR; }
    }
    PG8_WAIT_V(0);
    if constexpr (!ALIGN_EPI) { if (wr == 0) PG8_BAR; }
    PG8_BAR;
    if constexpr (Epi::AFTER_DRAIN) { E.fused(acc, cur, wr, wc, fr, fq, lds, wid, lane); S.done(cur); }
#undef PG8_SA
#undef PG8_SB
#undef PG8_STAGE
#undef PG8_LDA
#undef PG8_LDB
#undef PG8_MMA
#undef PG8_WAIT_V
#undef PG8_WAIT_L
#undef PG8_BAR
#undef PG8_SCHED
}
}

#ifndef PG8_SP2
#define PG8_SP2 true
#endif

#define LAS __attribute__((address_space(3)))
typedef unsigned short bf16;
typedef short bf16x8 __attribute__((ext_vector_type(8)));
typedef float f32x4 __attribute__((ext_vector_type(4)));
typedef float f32x16 __attribute__((ext_vector_type(16)));
typedef unsigned u32x4 __attribute__((ext_vector_type(4)));
typedef unsigned u32x2 __attribute__((ext_vector_type(2)));

constexpr int DM = 1024, NMAIN = 32768, ROWS = 33024, METAROW = 32768, DFF = 4096;
constexpr int NTHREADS = 512;
constexpr int LDS_BYTES = 147456;
constexpr int LDS_ITEM_OFF = LDS_BYTES - 16;
constexpr size_t MiB = 1u << 20;
constexpr size_t WS_CTL = 0, WS_WIN = 1 * MiB, WS_WUPA = 12 * MiB, WS_WUPB = 13 * MiB, WS_WOUT = 14 * MiB, WS_WFF1 = 16 * MiB, WS_WFF2 = 24 * MiB;
constexpr size_t WS_LORA = 32 * MiB, WS_XNMETA = 32 * MiB + 512 * 1024, WS_CB = 33 * MiB, WS_ACT = 36 * MiB;
constexpr size_t ACT_SZ = (size_t)ROWS * 512 * 2, L_SZ = (size_t)ROWS * 256 * 2;
constexpr size_t WS_R = WS_ACT, WS_KA = WS_R + ACT_SZ, WS_VA = WS_KA + ACT_SZ, WS_L = WS_VA + ACT_SZ, WS_Q = WS_L + L_SZ, WS_KB = WS_Q + ACT_SZ, WS_VT = WS_KB + ACT_SZ, WS_END = WS_VT + ACT_SZ;
constexpr size_t WS_GA = WS_KA, WS_GB = WS_KB, WS_MN = WS_ACT, WS_HID = WS_ACT + 64 * MiB;
constexpr size_t WS_HALO = WS_END;
constexpr int HALO_ROW = 3584;
static_assert(WS_HALO + (size_t)(NMAIN / 64) * 2 * HALO_ROW <= 256 * MiB, "halo buffer");
static_assert(WS_END <= 256 * MiB && WS_HID + 128 * MiB <= 256 * MiB && WS_CB + (size_t)2 * ROWS * 8 * 4 <= WS_ACT, "ws map");
constexpr float LOG2E = 1.4426950408889634f;
constexpr float QSCALE = 0.125f * LOG2E;

struct Params { const float* in[29]; float* out; unsigned char* ws; };
typedef const __attribute__((address_space(4))) Params* KP;
enum { I_XP = 0, I_XS, I_META, I_GMIX, I_WIN, I_MUP, I_MUN, I_W0, I_WUP, I_A0, I_AUP, I_GUP, I_KK, I_KA, I_RK, I_LNW, I_LNB, I_LQ1, I_LK1, I_LQ2, I_LK2, I_SUBG, I_UPA, I_UPB, I_WOUT, I_GFFN, I_FF1, I_FF2, I_GFIN };

__device__ __forceinline__ unsigned cvtpk(float lo, float hi) { unsigned r; asm volatile("v_cvt_pk_bf16_f32 %0, %1, %2" : "=v"(r) : "v"(lo), "v"(hi)); return r; }
__device__ __forceinline__ float bf2f(unsigned short b) { return __uint_as_float(((unsigned)b) << 16); }
__device__ __forceinline__ float bflo(unsigned w) { return __uint_as_float(w << 16); }
__device__ __forceinline__ float bfhi(unsigned w) { return __uint_as_float(w & 0xffff0000u); }
__device__ __forceinline__ void unpack8(const u32x4 v, float* o) { o[0] = bflo(v.x); o[1] = bfhi(v.x); o[2] = bflo(v.y); o[3] = bfhi(v.y); o[4] = bflo(v.z); o[5] = bfhi(v.z); o[6] = bflo(v.w); o[7] = bfhi(v.w); }
__device__ __forceinline__ float wave_sum(float v) {
#pragma unroll
    for (int o = 1; o < 64; o <<= 1) v += __shfl_xor(v, o);
    return v;
}
__device__ __forceinline__ float sigmoidf_(float x) { return 1.0f / (1.0f + __expf(-x)); }
__device__ __forceinline__ int seq_base(int s) { return s == 0 ? 0 : 16384 + (s - 1) * 2048; }
__device__ __forceinline__ int seq_len(int s) { return s == 0 ? 16384 : 2048; }
__device__ __forceinline__ int pos_row(int base, int p) { return p < 16 ? METAROW + p : base + p - 16; }

template <class Op> struct Epi8 {
    static constexpr bool PERM = true, AFTER_DRAIN = false;
    Op op;
    __device__ __forceinline__ void operator()(const pg8::f32x4 (&acc)[2][2][4][2], const pg8::Unit& u, int wr, int wc, int fr, int fq) const {
        const int row0 = u.pm * 256 + wr * 64 + fr, col0 = u.pn * 256 + wc * 32 + 8 * fq;
#pragma unroll
        for (int ai = 0; ai < 2; ++ai)
#pragma unroll
            for (int m = 0; m < 4; ++m)
#pragma unroll
                for (int bj = 0; bj < 2; ++bj) { op.apply(row0 + ai * 128 + m * 16, col0 + bj * 128, u.pn, acc[ai][bj][m][0], acc[ai][bj][m][1]); asm volatile("" ::: "memory"); }
    }
};
__device__ __forceinline__ u32x4 pack8(const f32x4 a, const f32x4 b) { u32x4 w; w.x = cvtpk(a[0], a[1]); w.y = cvtpk(a[2], a[3]); w.z = cvtpk(b[0], b[1]); w.w = cvtpk(b[2], b[3]); return w; }

constexpr int CW_KN = 320;
__device__ __forceinline__ float dpp_max16(float v) {
    int x = __float_as_int(v);
    v = fmaxf(v, __int_as_float(__builtin_amdgcn_update_dpp(0, x, 0xB1, 0xf, 0xf, true))); x = __float_as_int(v);
    v = fmaxf(v, __int_as_float(__builtin_amdgcn_update_dpp(0, x, 0x4E, 0xf, 0xf, true))); x = __float_as_int(v);
    v = fmaxf(v, __int_as_float(__builtin_amdgcn_update_dpp(0, x, 0x141, 0xf, 0xf, true))); x = __float_as_int(v);
    v = fmaxf(v, __int_as_float(__builtin_amdgcn_update_dpp(0, x, 0x140, 0xf, 0xf, true)));
    return v;
}
struct OpProj {
    unsigned char* ws;
    __device__ __forceinline__ void apply(int row, int col, int pn, f32x4 v0, f32x4 v1) const {
        if (pn >= 11) {
            bf16* VT = (bf16*)(ws + WS_VT); const int c = col - 11 * 256;
#pragma unroll
            for (int e = 0; e < 4; ++e) { VT[(size_t)(c + e) * ROWS + row] = (bf16)(cvtpk(v0[e], 0.f) & 0xffffu); VT[(size_t)(c + 4 + e) * ROWS + row] = (bf16)(cvtpk(v1[e], 0.f) & 0xffffu); }
            return;
        }
        bf16* O; int ldc = 512, c;
        if (pn < 2) { O = (bf16*)(ws + WS_R); c = col; }
        else if (pn < 4) { O = (bf16*)(ws + WS_KA); c = col - 512; }
        else if (pn < 6) { O = (bf16*)(ws + WS_VA); c = col - 1024; }
        else if (pn < 7) { O = (bf16*)(ws + WS_L); c = col - 1536; ldc = 256; }
        else if (pn < 9) { O = (bf16*)(ws + WS_Q); c = col - 1792; v0 = v0 * QSCALE; v1 = v1 * QSCALE; }
        else { O = (bf16*)(ws + WS_KB); c = col - 2304; }
        const u32x4 w = pack8(v0, v1);
        *(u32x4*)(O + (size_t)row * ldc + c) = w;
        if (pn >= 9) {
            float k8[8]; unpack8(w, k8); float ss = 0.f;
#pragma unroll
            for (int e = 0; e < 8; ++e) ss = fmaf(k8[e], k8[e], ss);
            ss = dpp_max16(ss);
            if ((threadIdx.x & 15) == 0) { const int sidx = row < 16384 ? 0 : row < NMAIN ? 1 + ((row - 16384) >> 11) : 9;
                atomicMax((unsigned*)(ws + WS_CTL) + CW_KN + sidx * 64 + (c >> 3), __float_as_uint(ss)); }
        }
    }
};
struct OpGate {
    bf16* O;
    __device__ __forceinline__ void apply(int row, int col, int pn, f32x4 v0, f32x4 v1) const {
        const int c = col;
#pragma unroll
        for (int e = 0; e < 4; ++e) { v0[e] = sigmoidf_(v0[e]); v1[e] = sigmoidf_(v1[e]); }
        *(u32x4*)(O + (size_t)row * 1024 + c) = pack8(v0, v1);
    }
};
struct OpUpA {
    unsigned char* ws;
    __device__ __forceinline__ void apply(int row, int col, int pn, f32x4 v0, f32x4 v1) const {
        u32x4* p = (u32x4*)((bf16*)(ws + WS_GA) + (size_t)row * 1024 + col); float g[8]; unpack8(*p, g);
#pragma unroll
        for (int e = 0; e < 4; ++e) { v0[e] *= g[e]; v1[e] *= g[4 + e]; }
        *p = pack8(v0, v1);
    }
};
struct OpUpB {
    unsigned char* ws;
    __device__ __forceinline__ void apply(int row, int col, int pn, f32x4 v0, f32x4 v1) const {
        u32x4* p = (u32x4*)((bf16*)(ws + WS_GB) + (size_t)row * 1024 + col); float g[8], a[8]; unpack8(*p, g);
        unpack8(*(const u32x4*)((const bf16*)(ws + WS_GA) + (size_t)row * 1024 + col), a);
#pragma unroll
        for (int e = 0; e < 4; ++e) { v0[e] = a[e] + v0[e] * g[e]; v1[e] = a[4 + e] + v1[e] * g[4 + e]; }
        *p = pack8(v0, v1);
    }
};
struct OpOut {
    const float* xp; const float* xs; float* out;
    __device__ __forceinline__ void apply(int row, int col, int pn, f32x4 v0, f32x4 v1) const {
        const float* x = (row < 16384 ? xp + (size_t)row * DM : xs + (size_t)(row - 16384) * DM) + col;
        float* o = out + (size_t)row * DM + col;
        *(f32x4*)o = *(const f32x4*)x + v0; *(f32x4*)(o + 4) = *(const f32x4*)(x + 4) + v1;
    }
};
struct OpFF1 {
    bf16* hid;
    __device__ __forceinline__ void apply(int row, int col, int pn, f32x4 v0, f32x4 v1) const {
#pragma unroll
        for (int e = 0; e < 4; ++e) { const float a = fmaxf(v0[e], 0.f), b = fmaxf(v1[e], 0.f); v0[e] = a * a; v1[e] = b * b; }
        *(u32x4*)(hid + (size_t)row * DFF + col) = pack8(v0, v1);
    }
};
struct OpFF2 {
    float* out;
    __device__ __forceinline__ void apply(int row, int col, int pn, f32x4 v0, f32x4 v1) const {
        float* o = out + (size_t)row * DM + col;
        *(f32x4*)o = *(const f32x4*)o + v0; *(f32x4*)(o + 4) = *(const f32x4*)(o + 4) + v1;
    }
};

__device__ __forceinline__ unsigned f2bf_rne(float f) { return cvtpk(f, 0.f) & 0xffffu; }
__device__ __forceinline__ void transpose_item(const float* W, int K, int N, bf16* WT, LAS float* scr, int item, int lane) {
    const int nblk = N / 32, kb = item / nblk, nb = item % nblk, k0 = 64 * kb, n0 = 32 * nb;
#pragma unroll 8
    for (int i = 0; i < 32; ++i) { const int kk = 2 * i + (lane >> 5); scr[kk * 33 + (lane & 31)] = W[(size_t)(k0 + kk) * N + n0 + (lane & 31)]; }
    asm volatile("s_waitcnt vmcnt(0) lgkmcnt(0)" ::: "memory");
    const int c = lane & 7;
#pragma unroll
    for (int j = 0; j < 4; ++j) { const int n = (lane >> 3) + 8 * j; const LAS float* s = scr + (8 * c) * 33 + n;
        u32x4 o; o.x = cvtpk(s[0 * 33], s[1 * 33]); o.y = cvtpk(s[2 * 33], s[3 * 33]); o.z = cvtpk(s[4 * 33], s[5 * 33]); o.w = cvtpk(s[6 * 33], s[7 * 33]);
        *(u32x4*)(WT + (size_t)(n0 + n) * K + k0 + 8 * c) = o; }
    asm volatile("s_waitcnt lgkmcnt(0)" ::: "memory");
}
__device__ __forceinline__ void rms_row_bf16(const float* src, const float* g, bf16* dst, int lane) {
    unsigned long long* o8 = (unsigned long long*)dst + lane;
    if (!src) {
#pragma unroll
        for (int j = 0; j < 4; ++j) o8[64 * j] = 0ull;
        return; }
    const f32x4* xr = (const f32x4*)src + lane; const f32x4* gr = (const f32x4*)g + lane;
    f32x4 v[4]; float s = 0.f;
#pragma unroll
    for (int j = 0; j < 4; ++j) { v[j] = xr[64 * j]; s += (v[j].x * v[j].x + v[j].y * v[j].y) + (v[j].z * v[j].z + v[j].w * v[j].w); }
    const float rstd = rsqrtf(wave_sum(s) * (1.f / DM) + 1e-6f);
#pragma unroll
    for (int j = 0; j < 4; ++j) { const f32x4 gg = gr[64 * j]; const f32x4 y = v[j] * rstd * gg;
        o8[64 * j] = (unsigned long long)cvtpk(y.x, y.y) | ((unsigned long long)cvtpk(y.z, y.w) << 32); }
}
__device__ __forceinline__ void phase_prologue(LAS unsigned char* lds, KP P) {
    const int tid = fresh_tid(), lane = tid & 63, wid = tid >> 6;
    LAS float* scr = (LAS float*)(lds + wid * 16384);
    const int gw = blockIdx.x * 8 + wid, NGW = gridDim.x * 8;
    unsigned char* ws = P->ws;
    constexpr int I_IN = (1024 / 64) * (5376 / 32), I_UP = (512 / 64) * (1024 / 32), I_O = (1024 / 64) * (1024 / 32), I_1 = (1024 / 64) * (4096 / 32), I_2 = (4096 / 64) * (1024 / 32);
    constexpr int I_LW = (64 / 64) * (512 / 32), I_G = (128 / 64) * (512 / 32);
    constexpr int NITEMS = I_IN + 2 * I_UP + I_O + I_1 + I_2 + 4 * I_LW + I_G;
    for (int it = gw; it < NITEMS; it += NGW) {
        int r = it;
        if (r < I_IN) { transpose_item(P->in[I_WIN], 1024, 5376, (bf16*)(ws + WS_WIN), scr, r, lane); continue; } r -= I_IN;
        if (r < I_UP) { transpose_item(P->in[I_UPA], 512, 1024, (bf16*)(ws + WS_WUPA), scr, r, lane); continue; } r -= I_UP;
        if (r < I_UP) { transpose_item(P->in[I_UPB], 512, 1024, (bf16*)(ws + WS_WUPB), scr, r, lane); continue; } r -= I_UP;
        if (r < I_O) { transpose_item(P->in[I_WOUT], 1024, 1024, (bf16*)(ws + WS_WOUT), scr, r, lane); continue; } r -= I_O;
        if (r < I_1) { transpose_item(P->in[I_FF1], 1024, 4096, (bf16*)(ws + WS_WFF1), scr, r, lane); continue; } r -= I_1;
        if (r < I_2) { transpose_item(P->in[I_FF2], 4096, 1024, (bf16*)(ws + WS_WFF2), scr, r, lane); continue; } r -= I_2;
        if (r < 2 * I_LW) { const int d = r / I_LW; transpose_item(P->in[I_WUP] + (size_t)d * 64 * 512, 64, 512, (bf16*)(ws + WS_LORA) + (size_t)d * 512 * 64, scr, r % I_LW, lane); continue; } r -= 2 * I_LW;
        if (r < 2 * I_LW) { const int d = r / I_LW; transpose_item(P->in[I_AUP] + (size_t)d * 64 * 512, 64, 512, (bf16*)(ws + WS_LORA + 131072) + (size_t)d * 512 * 64, scr, r % I_LW, lane); continue; } r -= 2 * I_LW;
        transpose_item(P->in[I_GUP], 128, 512, (bf16*)(ws + WS_LORA + 262144), scr, r, lane);
    }
    bf16* XN = (bf16*)P->out; bf16* XM = (bf16*)(ws + WS_XNMETA);
    for (int m = gw; m < ROWS; m += NGW) {
        const float* src = m < 16384 ? P->in[I_XP] + (size_t)m * DM : m < NMAIN ? P->in[I_XS] + (size_t)(m - 16384) * DM : (m - NMAIN < 16 ? P->in[I_META] + (size_t)(m - NMAIN) * DM : nullptr);
        bf16* dst = m < NMAIN ? XN + (size_t)m * DM : XM + (size_t)(m - NMAIN) * DM;
        rms_row_bf16(src, P->in[I_GMIX], dst, lane);
    }
}

constexpr int AT_KSTR = 272, AT_VSTR = 144, AT_KSZ = 64 * AT_KSTR, AT_BUF = AT_KSZ + 128 * AT_VSTR;
__device__ __forceinline__ f32x16 mfma32(bf16x8 a, bf16x8 b, f32x16 c) { return __builtin_amdgcn_mfma_f32_32x32x16_bf16(a, b, c, 0, 0, 0); }
__device__ __forceinline__ void attn_unit(LAS unsigned char* lds, KP P, int s, int h, int qb, float lam) {
    int tid_ = threadIdx.x; asm volatile("" : "+v"(tid_));
    const int tid = tid_, lane = tid & 63, r32 = lane & 31, hi = lane >> 5, wid = __builtin_amdgcn_readfirstlane(tid >> 6), rg = wid & 3, mp = wid >> 2;
    const int L = seq_len(s), base = seq_base(s), NT = 1 + L / 64;
    unsigned char* ws = P->ws;
    const bf16* KB = (const bf16*)(ws + WS_KB); const bf16* VT = (const bf16*)(ws + WS_VT); bf16* Q = (bf16*)(ws + WS_Q);
    const int qrow = base + qb * 128 + rg * 32 + r32;
    bf16x8 q[4];
#pragma unroll
    for (int d0 = 0; d0 < 4; ++d0) q[d0] = *(const bf16x8*)(Q + (size_t)qrow * 512 + h * 128 + mp * 64 + d0 * 16 + hi * 8);
    f32x16 O[4];
#pragma unroll
    for (int b = 0; b < 4; ++b)
#pragma unroll
        for (int r = 0; r < 16; ++r) O[b][r] = 0.f;
    float mx = -INFINITY, ls = 0.f;
    const float qh = (float)(16 + qb * 128 + rg * 32 + r32 - 4 * hi);
    const float nslope = -exp2f(-2.0f * (float)(h + 1)) * LOG2E;
    const int kr0 = tid >> 4, kc = tid & 15, vn0 = tid >> 3, vc = tid & 7;
    u32x4 kreg[2], vreg[2];
    const unsigned kgo = (unsigned)((kr0 * 512 + h * 128 + kc * 8) * 2), vgo = (unsigned)(((h * 128 + vn0) * ROWS + vc * 8) * 2);
    const unsigned klo = (unsigned)(kr0 * AT_KSTR + kc * 16), vlo = (unsigned)(AT_KSZ + vn0 * AT_VSTR + vc * 16);
#define AT_GLOAD(j) do { const int m0_ = (j) == 0 ? METAROW : base + 64 * ((j) - 1); \
        const unsigned char* kt_ = (const unsigned char*)KB + (size_t)m0_ * 1024; const unsigned char* vt_ = (const unsigned char*)VT + (size_t)m0_ * 2; \
        kreg[0] = *(const u32x4*)(kt_ + kgo); kreg[1] = *(const u32x4*)(kt_ + 32 * 1024 + kgo); \
        vreg[0] = *(const u32x4*)(vt_ + vgo); vreg[1] = *(const u32x4*)(vt_ + (size_t)64 * ROWS * 2 + vgo); } while (0)
#define AT_LSTORE(buf) do { LAS unsigned char* kb_ = lds + (buf) * AT_BUF; \
        *(LAS u32x4*)(kb_ + klo) = kreg[0]; *(LAS u32x4*)(kb_ + klo + 32 * AT_KSTR) = kreg[1]; \
        *(LAS u32x4*)(kb_ + vlo) = vreg[0]; *(LAS u32x4*)(kb_ + vlo + 64 * AT_VSTR) = vreg[1]; } while (0)
    float qn, kn;
    { float ssq = 0.f;
#pragma unroll
      for (int d0 = 0; d0 < 4; ++d0) { float t[8]; unpack8(__builtin_bit_cast(u32x4, q[d0]), t);
#pragma unroll
        for (int e = 0; e < 8; ++e) ssq = fmaf(t[e], t[e], ssq); }
      ssq += __shfl_xor(ssq, 32); qn = sqrtf(ssq) * 1.002f;
      const unsigned* KN = (const unsigned*)(ws + WS_CTL) + CW_KN; float ks = 0.f;
#pragma unroll
      for (int g = 0; g < 8; ++g) ks += fmaxf(__uint_as_float(__hip_atomic_load(KN + s * 64 + h * 16 + mp * 8 + g, __ATOMIC_RELAXED, __HIP_MEMORY_SCOPE_AGENT)), __uint_as_float(__hip_atomic_load(KN + 9 * 64 + h * 16 + mp * 8 + g, __ATOMIC_RELAXED, __HIP_MEMORY_SCOPE_AGENT)));
      kn = sqrtf(ks) * 1.002f; }
    const int jc0 = 1 + qb * 2;
    int jlo = jc0, jhi = jc0 + 1;
    LAS float* red = (LAS float*)(lds + 2 * AT_BUF);
#pragma unroll 1
    for (int ph = 0; ph < 2; ++ph) {
        int nleft, ntl;
        if (ph == 0) { nleft = 0; ntl = 2; }
        else {
            float dneed = (qn * kn - mx + 40.0f) / (-nslope);
#pragma unroll
            for (int o = 1; o < 64; o <<= 1) dneed = fmaxf(dneed, __shfl_xor(dneed, o));
            if (lane == 0) red[wid] = dneed;
            __syncthreads();
            float dm = red[0];
#pragma unroll
            for (int w8 = 1; w8 < 8; ++w8) dm = fmaxf(dm, red[w8]);
            dm = fminf(fmaxf(dm, 0.f), 1.0e6f);
            const int dmax = (int)dm + 1, q0 = 16 + qb * 128;
            const int plo = q0 - dmax, phi = q0 + 127 + dmax;
            jlo = plo < 16 ? 0 : 1 + ((plo - 16) >> 6); jhi = phi >= L + 16 ? NT - 1 : 1 + ((phi - 16) >> 6);
            if (jlo > jc0) jlo = jc0; if (jhi < jc0 + 1) jhi = jc0 + 1;
            nleft = jc0 - jlo; ntl = nleft + (jhi - jc0 - 1);
        }
        if (ntl > 0) {
#define AT_J(t) (ph == 0 ? jc0 + (t) : ((t) < nleft ? jlo + (t) : jc0 + 2 + ((t) - nleft)))
        { const int jf = AT_J(0); AT_GLOAD(jf); } AT_LSTORE(0); __syncthreads();
#pragma unroll 1
        for (int t = 0; t < ntl; ++t) {
            const int j = AT_J(t);
            if (t + 1 < ntl) { const int jn = AT_J(t + 1); AT_GLOAD(jn); }
            const LAS unsigned char* Kb = lds + (t & 1) * AT_BUF + mp * 128; const LAS unsigned char* Vb = lds + (t & 1) * AT_BUF + AT_KSZ;
            const float dq = qh - (float)(j == 0 ? 0 : 64 * j - 48);
            f32x16 p0, p1;
#pragma unroll
            for (int r = 0; r < 16; ++r) { p0[r] = 0.f; p1[r] = 0.f; }
            {
                bf16x8 ka[4], kb[4];
#pragma unroll
                for (int d0 = 0; d0 < 4; ++d0) { ka[d0] = *(const LAS bf16x8*)(Kb + r32 * AT_KSTR + d0 * 32 + hi * 16); kb[d0] = *(const LAS bf16x8*)(Kb + (32 + r32) * AT_KSTR + d0 * 32 + hi * 16); }
                __builtin_amdgcn_sched_barrier(0);
#pragma unroll
                for (int d0 = 0; d0 < 4; ++d0) { p0 = mfma32(ka[d0], q[d0], p0); p1 = mfma32(kb[d0], q[d0], p1); }
            }
#pragma unroll
            for (int r = 0; r < 16; ++r) { const float dd = dq - (float)((r & 3) + 8 * (r >> 2)); p0[r] = fmaf(fabsf(dd), nslope, p0[r]); p1[r] = fmaf(fabsf(dd - 32.f), nslope, p1[r]); }
            if (j == 0) {
#pragma unroll
                for (int r = 0; r < 16; ++r) { if ((r & 3) + 8 * (r >> 2) + 4 * hi >= 16) p0[r] = -INFINITY; p1[r] = -INFINITY; }
            }
            float rm = fmaxf(p0[0], p1[0]);
#pragma unroll
            for (int r = 1; r < 16; ++r) rm = fmaxf(rm, fmaxf(p0[r], p1[r]));
            rm = fmaxf(rm, __shfl_xor(rm, 32));
            if (__any(rm > mx - 38.0f)) {
            const float mn = fmaxf(mx, rm);
            if (__any(mn > mx)) {
                const float f = __builtin_amdgcn_exp2f(mx - mn); ls *= f; mx = mn;
#pragma unroll
                for (int b = 0; b < 4; ++b)
#pragma unroll
                    for (int r = 0; r < 16; ++r) O[b][r] *= f;
            }
            float sum = 0.f;
#pragma unroll
            for (int r = 0; r < 16; ++r) { p0[r] = __builtin_amdgcn_exp2f(p0[r] - mx); p1[r] = __builtin_amdgcn_exp2f(p1[r] - mx); sum += p0[r] + p1[r]; }
            ls += sum;
            bf16x8 pf[4];
#pragma unroll
            for (int k2 = 0; k2 < 2; ++k2) {
                u32x4 w0, w1;
                w0.x = cvtpk(p0[8 * k2 + 0], p0[8 * k2 + 1]); w0.y = cvtpk(p0[8 * k2 + 2], p0[8 * k2 + 3]); w0.z = cvtpk(p0[8 * k2 + 4], p0[8 * k2 + 5]); w0.w = cvtpk(p0[8 * k2 + 6], p0[8 * k2 + 7]);
                w1.x = cvtpk(p1[8 * k2 + 0], p1[8 * k2 + 1]); w1.y = cvtpk(p1[8 * k2 + 2], p1[8 * k2 + 3]); w1.z = cvtpk(p1[8 * k2 + 4], p1[8 * k2 + 5]); w1.w = cvtpk(p1[8 * k2 + 6], p1[8 * k2 + 7]);
                pf[k2] = __builtin_bit_cast(bf16x8, w0); pf[2 + k2] = __builtin_bit_cast(bf16x8, w1);
            }
            {
                u32x4 vcur[4], vnxt[4];
#define AT_VLOAD(dst, ks_) do { _Pragma("unroll") for (int b_ = 0; b_ < 4; ++b_) { const LAS unsigned char* vp_ = Vb + (b_ * 32 + r32) * AT_VSTR + (ks_) * 32 + hi * 8; \
                    const u32x2 lo_ = *(const LAS u32x2*)vp_, hh_ = *(const LAS u32x2*)(vp_ + 16); dst[b_].x = lo_.x; dst[b_].y = lo_.y; dst[b_].z = hh_.x; dst[b_].w = hh_.y; } } while (0)
                AT_VLOAD(vcur, 0);
#pragma unroll
                for (int ks = 0; ks < 4; ++ks) {
                    if (ks < 3) AT_VLOAD(vnxt, ks + 1);
                    __builtin_amdgcn_sched_barrier(0);
#pragma unroll
                    for (int b = 0; b < 4; ++b) O[b] = mfma32(__builtin_bit_cast(bf16x8, vcur[b]), pf[ks], O[b]);
                    __builtin_amdgcn_sched_barrier(0);
#pragma unroll
                    for (int b = 0; b < 4; ++b) vcur[b] = vnxt[b];
                }
#undef AT_VLOAD
            }
            }
            if (t + 1 < ntl) AT_LSTORE((t + 1) & 1);
            __syncthreads();
        }
#undef AT_J
        }
    }
#undef AT_GLOAD
#undef AT_LSTORE
    const float lt = ls + __shfl_xor(ls, 32);
    const float inv = (mp ? lam : 1.0f) / lt;
    int lane2 = lane; asm volatile("" : "+v"(lane2));
    const int r32e = lane2 & 31, hie = lane2 >> 5;
    LAS float* ex = (LAS float*)lds + rg * (128 * 32) + hie * 128 + r32e;
    if (mp == 1) {
#pragma unroll
        for (int b = 0; b < 4; ++b)
#pragma unroll
            for (int r = 0; r < 16; ++r) ex[(32 * b + (r & 3) + 8 * (r >> 2)) * 32] = O[b][r] * inv;
    }
    __syncthreads();
    if (mp == 0) {
        float ss = 0.f;
#pragma unroll
        for (int b = 0; b < 4; ++b)
#pragma unroll
            for (int r = 0; r < 16; ++r) { const float o = O[b][r] * inv - ex[(32 * b + (r & 3) + 8 * (r >> 2)) * 32]; O[b][r] = o; ss += o * o; }
        ss += __shfl_xor(ss, 32);
        const float rstd = rsqrtf(ss * (1.0f / 128.0f) + 1e-5f) * 0.8f;
        const float* sg = P->in[I_SUBG] + 4 * hie; bf16* Qo = Q + (size_t)(base + qb * 128 + rg * 32 + r32e) * 512 + h * 128 + 4 * hie;
#pragma unroll
        for (int b = 0; b < 4; ++b)
#pragma unroll
            for (int r4 = 0; r4 < 4; ++r4) {
                const int n = 32 * b + 8 * r4; const f32x4 g = *(const f32x4*)(sg + n);
                u32x2 w; w.x = cvtpk(O[b][4 * r4 + 0] * rstd * g.x, O[b][4 * r4 + 1] * rstd * g.y); w.y = cvtpk(O[b][4 * r4 + 2] * rstd * g.z, O[b][4 * r4 + 3] * rstd * g.w);
                *(u32x2*)(Qo + n) = w;
            }
    }
    __syncthreads();
}

constexpr int SC_R = 0, SC_K = 16384, SC_V = 32768, SC_W = 49152, SC_B = 65536, SC_KK = 81920, SC_Y = 98304, SC_TW = 114688, SC_AD = 123904, SC_MU = 133120;
__device__ __forceinline__ float dpp_add(float v, int ctrl_id) {
    const int x = __float_as_int(v); int y;
    if (ctrl_id == 0) y = __builtin_amdgcn_update_dpp(0, x, 0xB1, 0xf, 0xf, true);
    else if (ctrl_id == 1) y = __builtin_amdgcn_update_dpp(0, x, 0x4E, 0xf, 0xf, true);
    else if (ctrl_id == 2) y = __builtin_amdgcn_update_dpp(0, x, 0x141, 0xf, 0xf, true);
    else y = __builtin_amdgcn_update_dpp(0, x, 0x140, 0xf, 0xf, true);
    return v + __int_as_float(y);
}
template <int LPR> __device__ __forceinline__ float grp_sum(float v) {
    v = dpp_add(v, 0); v = dpp_add(v, 1); v = dpp_add(v, 2);
    if (LPR == 16) v = dpp_add(v, 3);
    return v;
}
#define BAR_LDS() asm volatile("s_waitcnt lgkmcnt(0)\n\ts_barrier" ::: "memory")
__device__ __forceinline__ float fast_sigmoid(float x) { return __builtin_amdgcn_rcpf(1.0f + __builtin_amdgcn_exp2f(-LOG2E * x)); }
__device__ __forceinline__ float fast_tanh(float x) { return 1.0f - 2.0f * __builtin_amdgcn_rcpf(1.0f + __builtin_amdgcn_exp2f(2.0f * LOG2E * x)); }
template <int NRP, int NSW>
__device__ __forceinline__ void scan_unit(LAS unsigned char* lds, KP P, int s, int d, int h, int rp) {
    constexpr int RPB = 64 / NRP, RPW = RPB / NSW, LPR = 64 / RPW, CPL = 64 / LPR;
    static_assert(LPR == 8 || LPR == 16, "scan geometry");
    int tid_ = threadIdx.x; asm volatile("" : "+v"(tid_));
    const int tid = tid_, lane = tid & 63, wid = __builtin_amdgcn_readfirstlane(tid >> 6);
    const int L = seq_len(s), base = seq_base(s), Ltot = L + 16, nchunk = (Ltot + 63) / 64;
    unsigned char* ws = P->ws;
    const bf16* Rb = (const bf16*)(ws + WS_R); const bf16* KAb = (const bf16*)(ws + WS_KA); const bf16* VAb = (const bf16*)(ws + WS_VA); const bf16* Lb = (const bf16*)(ws + WS_L);
    float* CB = (float*)(ws + WS_CB); bf16* YD = (bf16*)((unsigned char*)P->out + 64 * MiB) + (size_t)d * NMAIN * 512;
    LAS float* fS = (LAS float*)lds; LAS float* fV = (LAS float*)(lds + 81920); LAS float* fY = (LAS float*)(lds + SC_Y); LAS float* fMU = (LAS float*)(lds + SC_MU);
#define SCI(sl_, a_, c_) ((sl_) * 320 + (a_) * 64 + (c_))
    for (int i = tid; i < 832; i += NTHREADS) {
        float v;
        if (i < 640) { const int which = i / 320, jj = i % 320, a = jj >> 6, c = jj & 63; const int gi = a < 3 ? a * 512 + h * 64 + c : 1536 + (a - 3) * 64 + c; v = P->in[which ? I_MUN : I_MUP][gi]; }
        else { const int a = (i - 640) >> 6, c = (i - 640) & 63; v = P->in[a == 0 ? I_KK : a == 1 ? I_KA : I_RK][h * 64 + c]; }
        fMU[i] = v;
    }
    const int mat = wid >> 2, ntile = wid & 3;
    const bf16* Wt = (const bf16*)(ws + WS_LORA + (mat ? 131072 : 0)) + ((size_t)d * 512 + h * 64 + ntile * 16 + (lane & 15)) * 64 + (lane >> 4) * 8;
    const bf16x8 bfr0 = *(const bf16x8*)Wt, bfr1 = *(const bf16x8*)(Wt + 32);
    const float bias = P->in[mat ? I_A0 : I_W0][d * 512 + h * 64 + ntile * 16 + (lane & 15)];
    float S[CPL];
#pragma unroll
    for (int j = 0; j < CPL; ++j) S[j] = 0.f;
    const int rowl = lane / LPR, kg = lane % LPR, srow = rp * RPB + wid * RPW + rowl;
    const int slot = tid >> 3, cg8 = (tid & 7) * 8;
    u32x4 raw[5][3];
#define SC_META(c) (d ? ((c) == nchunk - 1) : ((c) == 0))
    const unsigned char* HALO0 = ws + WS_HALO + (size_t)(base >> 6) * 2 * HALO_ROW;
#define SC_LOAD(c) do { const int i_ = 64 * (c) + slot; const bool ok_ = i_ < Ltot; const int p_ = d ? Ltot - 1 - i_ : i_; \
        const unsigned zr_ = (unsigned)(METAROW + 64); \
        if (!SC_META(c)) { const unsigned rc_ = ok_ ? (unsigned)(base + p_ - 16) : zr_; \
            _Pragma("unroll") for (int a_ = 0; a_ < 5; ++a_) { const unsigned char* B_ = (const unsigned char*)(a_ == 0 ? Rb : a_ == 1 ? KAb : a_ == 2 ? VAb : Lb); const unsigned ld_ = a_ < 3 ? 1024u : 512u; \
                const unsigned co_ = (unsigned)(((a_ < 3 ? h * 64 : (a_ - 3) * 64) + cg8) * 2); raw[a_][1] = *(const u32x4*)(B_ + (rc_ * ld_ + co_)); } \
        } else { const bool me_ = ok_ && p_ < 16; const bool hn_ = me_ && p_ == 15; \
            const unsigned rc_ = ok_ ? (unsigned)pos_row(base, p_) : zr_, rp_ = (me_ && p_ > 0) ? (unsigned)(METAROW + p_ - 1) : zr_, rn_ = (me_ && p_ < 15) ? (unsigned)(METAROW + p_ + 1) : zr_; \
            _Pragma("unroll") for (int a_ = 0; a_ < 5; ++a_) { const unsigned char* B_ = (const unsigned char*)(a_ == 0 ? Rb : a_ == 1 ? KAb : a_ == 2 ? VAb : Lb); const unsigned ld_ = a_ < 3 ? 1024u : 512u; \
                const unsigned co_ = (unsigned)(((a_ < 3 ? h * 64 : (a_ - 3) * 64) + cg8) * 2); \
                const unsigned ho_ = (unsigned)(((a_ < 3 ? a_ * 512 + h * 64 : 1536 + (a_ - 3) * 64) + cg8) * 2); \
                raw[a_][0] = *(const u32x4*)(B_ + (rp_ * ld_ + co_)); raw[a_][1] = *(const u32x4*)(B_ + (rc_ * ld_ + co_)); \
                const unsigned char* np_ = hn_ ? HALO0 + ho_ : B_ + (rn_ * ld_ + co_); raw[a_][2] = *(const u32x4*)np_; } } } while (0)
    SC_LOAD(0);
    BAR_LDS();
    for (int c = 0; c < nchunk; ++c) {
        const int nvalid = (Ltot - 64 * c) < 64 ? (Ltot - 64 * c) : 64;
        float rv[8], kv[8];
        if (!SC_META(c)) {
            float vv8[8]; unpack8(raw[0][1], rv); unpack8(raw[1][1], kv); unpack8(raw[2][1], vv8);
            { LAS float* dst = fS + SCI(slot, 4, cg8); *(LAS f32x4*)dst = (f32x4){rv[0], rv[1], rv[2], rv[3]}; *(LAS f32x4*)(dst + 4) = (f32x4){rv[4], rv[5], rv[6], rv[7]}; }
            { LAS float* dst = fV + slot * 64 + cg8; *(LAS f32x4*)dst = (f32x4){vv8[0], vv8[1], vv8[2], vv8[3]}; *(LAS f32x4*)(dst + 4) = (f32x4){vv8[4], vv8[5], vv8[6], vv8[7]}; }
            *(LAS u32x4*)(lds + SC_TW + slot * 144 + cg8 * 2) = raw[3][1];
            *(LAS u32x4*)(lds + SC_AD + slot * 144 + cg8 * 2) = raw[4][1];
        } else {
            const int i1 = 64 * c + slot; const int p1 = d ? Ltot - 1 - i1 : i1; const bool me1 = i1 < Ltot && p1 < 16; const float fm = me1 ? 1.0f : 0.0f;
#pragma unroll
            for (int a = 0; a < 5; ++a) {
                float pv[8], cv[8], nv[8], o[8]; unpack8(raw[a][0], pv); unpack8(raw[a][1], cv); unpack8(raw[a][2], nv);
                const f32x4 mp0 = *(const LAS f32x4*)(fMU + a * 64 + cg8), mp1 = *(const LAS f32x4*)(fMU + a * 64 + cg8 + 4), mn0 = *(const LAS f32x4*)(fMU + 320 + a * 64 + cg8), mn1 = *(const LAS f32x4*)(fMU + 320 + a * 64 + cg8 + 4);
#pragma unroll
                for (int e = 0; e < 8; ++e) { const float mp = fm * (e < 4 ? mp0[e & 3] : mp1[e & 3]), mn = fm * (e < 4 ? mn0[e & 3] : mn1[e & 3]); o[e] = cv[e] + mp * (pv[e] - cv[e]) + mn * (nv[e] - cv[e]); }
                if (a == 0) {
#pragma unroll
                    for (int e = 0; e < 8; ++e) rv[e] = o[e];
                    LAS float* dst = fS + SCI(slot, 4, cg8); *(LAS f32x4*)dst = (f32x4){o[0], o[1], o[2], o[3]}; *(LAS f32x4*)(dst + 4) = (f32x4){o[4], o[5], o[6], o[7]};
                } else if (a == 1) {
#pragma unroll
                    for (int e = 0; e < 8; ++e) kv[e] = o[e];
                } else if (a == 2) {
                    LAS float* dst = fV + slot * 64 + cg8; *(LAS f32x4*)dst = (f32x4){o[0], o[1], o[2], o[3]}; *(LAS f32x4*)(dst + 4) = (f32x4){o[4], o[5], o[6], o[7]};
                } else {
                    if (a == 3) {
#pragma unroll
                        for (int e = 0; e < 8; ++e) o[e] = me1 ? fast_tanh(o[e]) : o[e];
                    }
                    u32x4 w; w.x = cvtpk(o[0], o[1]); w.y = cvtpk(o[2], o[3]); w.z = cvtpk(o[4], o[5]); w.w = cvtpk(o[6], o[7]);
                    *(LAS u32x4*)(lds + (a == 3 ? SC_TW : SC_AD) + slot * 144 + cg8 * 2) = w;
                }
            }
        }
        BAR_LDS();
        if (c + 1 < nchunk) SC_LOAD(c + 1);
        {
            const LAS unsigned char* Ab = lds + (mat ? SC_AD : SC_TW); LAS float* fWB = fS + (mat ? 128 : 64);
#pragma unroll
            for (int mt = 0; mt < 4; ++mt) {
                const bf16x8 a0 = *(const LAS bf16x8*)(Ab + (mt * 16 + (lane & 15)) * 144 + (lane >> 4) * 16);
                const bf16x8 a1 = *(const LAS bf16x8*)(Ab + (mt * 16 + (lane & 15)) * 144 + 64 + (lane >> 4) * 16);
                f32x4 acc = {0.f, 0.f, 0.f, 0.f};
                acc = __builtin_amdgcn_mfma_f32_16x16x32_bf16(a0, bfr0, acc, 0, 0, 0);
                acc = __builtin_amdgcn_mfma_f32_16x16x32_bf16(a1, bfr1, acc, 0, 0, 0);
#pragma unroll
                for (int rg = 0; rg < 4; ++rg) {
                    const int sl = mt * 16 + (lane >> 4) * 4 + rg, col = ntile * 16 + (lane & 15);
                    const float sg = fast_sigmoid(acc[rg] + bias); const float dc = __builtin_amdgcn_exp2f(-0.6065306597126334f * LOG2E * sg);
                    fWB[sl * 320 + col] = mat ? sg : dc;
                }
            }
        }
        BAR_LDS();
        {
            const f32x4 a0 = *(const LAS f32x4*)(fS + SCI(slot, 2, cg8)), a1 = *(const LAS f32x4*)(fS + SCI(slot, 2, cg8 + 4));
            const f32x4 kk0 = *(const LAS f32x4*)(fMU + 640 + cg8), kk1 = *(const LAS f32x4*)(fMU + 640 + cg8 + 4), ka0 = *(const LAS f32x4*)(fMU + 704 + cg8), ka1 = *(const LAS f32x4*)(fMU + 704 + cg8 + 4);
            const f32x4 rk0 = *(const LAS f32x4*)(fMU + 768 + cg8), rk1 = *(const LAS f32x4*)(fMU + 768 + cg8 + 4);
            float kkv[8], kd[8], av[8]; float ssq = 0.f, cs = 0.f;
#pragma unroll
            for (int e = 0; e < 8; ++e) {
                av[e] = e < 4 ? a0[e & 3] : a1[e & 3];
                kkv[e] = kv[e] * (e < 4 ? kk0[e & 3] : kk1[e & 3]); ssq = fmaf(kkv[e], kkv[e], ssq);
                kd[e] = kv[e] * (1.0f + (av[e] - 1.0f) * (e < 4 ? ka0[e & 3] : ka1[e & 3])); cs = fmaf(rv[e] * kd[e], e < 4 ? rk0[e & 3] : rk1[e & 3], cs);
            }
            ssq = grp_sum<8>(ssq); cs = grp_sum<8>(cs);
            const float rs = rsqrtf(fmaxf(ssq, 1e-24f));
#pragma unroll
            for (int e = 0; e < 8; ++e) { kkv[e] *= rs; av[e] *= kkv[e]; }
            LAS float* o1 = fS + SCI(slot, 0, cg8); *(LAS f32x4*)o1 = (f32x4){kkv[0], kkv[1], kkv[2], kkv[3]}; *(LAS f32x4*)(o1 + 4) = (f32x4){kkv[4], kkv[5], kkv[6], kkv[7]};
            LAS float* o2 = fS + SCI(slot, 2, cg8); *(LAS f32x4*)o2 = (f32x4){av[0], av[1], av[2], av[3]}; *(LAS f32x4*)(o2 + 4) = (f32x4){av[4], av[5], av[6], av[7]};
            LAS float* o3 = fS + SCI(slot, 3, cg8); *(LAS f32x4*)o3 = (f32x4){kd[0], kd[1], kd[2], kd[3]}; *(LAS f32x4*)(o3 + 4) = (f32x4){kd[4], kd[5], kd[6], kd[7]};
            if (cg8 == 0 && rp == 0 && slot < nvalid) { const int i2 = 64 * c + slot; const int p2 = d ? Ltot - 1 - i2 : i2; CB[((size_t)d * ROWS + pos_row(base, p2)) * 8 + h] = cs; }
        }
        BAR_LDS();
        if (wid < NSW) {
            typedef float f32x2_ __attribute__((ext_vector_type(2)));
            constexpr int C4 = CPL / 4;
            const LAS float* ps = fS + kg * CPL; const LAS float* pv = fV + srow; LAS float* py = fY + srow;
            f32x4 nk[C4], nw[C4], nb[C4], nd[C4], nr[C4]; float nv;
#define SC_FETCH(sl_) do { _Pragma("unroll") for (int j_ = 0; j_ < C4; ++j_) { nk[j_] = *(const LAS f32x4*)(ps + (sl_) * 320 + 4 * j_); nw[j_] = *(const LAS f32x4*)(ps + (sl_) * 320 + 64 + 4 * j_); \
                nb[j_] = *(const LAS f32x4*)(ps + (sl_) * 320 + 128 + 4 * j_); nd[j_] = *(const LAS f32x4*)(ps + (sl_) * 320 + 192 + 4 * j_); nr[j_] = *(const LAS f32x4*)(ps + (sl_) * 320 + 256 + 4 * j_); } nv = pv[(sl_) * 64]; } while (0)
            SC_FETCH(0);
            f32x4 rp4[C4];
#pragma unroll
            for (int j = 0; j < C4; ++j) rp4[j] = (f32x4){0.f, 0.f, 0.f, 0.f};
#pragma unroll 16
            for (int sl = 0; sl < nvalid; ++sl) {
                f32x4 ck[C4], cw[C4], cb[C4], cd[C4], cr[C4];
#pragma unroll
                for (int j = 0; j < C4; ++j) { ck[j] = nk[j]; cw[j] = nw[j]; cb[j] = nb[j]; cd[j] = nd[j]; cr[j] = nr[j]; }
                const float vv = nv;
                SC_FETCH(sl + 1 < 64 ? sl + 1 : 63);
                f32x2_ pa = {0.f, 0.f}, ya = {0.f, 0.f};
#pragma unroll
                for (int j = 0; j < C4; ++j)
#pragma unroll
                    for (int e = 0; e < 4; e += 2) { const f32x2_ s2 = {S[4 * j + e], S[4 * j + e + 1]}, k2 = {ck[j][e], ck[j][e + 1]}, r2 = {rp4[j][e], rp4[j][e + 1]}; pa = pa + s2 * k2; ya = ya + s2 * r2; }
                float pp = pa.x + pa.y, yy = ya.x + ya.y;
                pp = dpp_add(pp, 0); yy = dpp_add(yy, 0); pp = dpp_add(pp, 1); yy = dpp_add(yy, 1); pp = dpp_add(pp, 2); yy = dpp_add(yy, 2);
                if (LPR == 16) { pp = dpp_add(pp, 3); yy = dpp_add(yy, 3); }
                py[(sl > 0 ? sl - 1 : 0) * 64] = yy;
#pragma unroll
                for (int j = 0; j < C4; ++j)
#pragma unroll
                    for (int e = 0; e < 4; e += 2) {
                        const f32x2_ b2 = {cb[j][e], cb[j][e + 1]}, d2 = {cd[j][e], cd[j][e + 1]}, w2 = {cw[j][e], cw[j][e + 1]}; f32x2_ s2 = {S[4 * j + e], S[4 * j + e + 1]};
                        const f32x2_ t2 = d2 * vv - b2 * pp; s2 = s2 * w2 + t2; S[4 * j + e] = s2.x; S[4 * j + e + 1] = s2.y; }
#pragma unroll
                for (int j = 0; j < C4; ++j) rp4[j] = cr[j];
            }
            {
                f32x2_ ya = {0.f, 0.f};
#pragma unroll
                for (int j = 0; j < C4; ++j)
#pragma unroll
                    for (int e = 0; e < 4; e += 2) { const f32x2_ s2 = {S[4 * j + e], S[4 * j + e + 1]}, r2 = {rp4[j][e], rp4[j][e + 1]}; ya = ya + s2 * r2; }
                const float yy = grp_sum<LPR>(ya.x + ya.y);
                py[(nvalid - 1) * 64] = yy;
            }
#undef SC_FETCH
        }
        BAR_LDS();
        {
            const int i2 = 64 * c + slot; const int p2 = d ? Ltot - 1 - i2 : i2;
            if (slot < nvalid && p2 >= 16 && (cg8 / RPB) == rp) {
                const LAS float* yp = fY + slot * 64 + cg8; const f32x4 y0 = *(const LAS f32x4*)yp, y1 = *(const LAS f32x4*)(yp + 4);
                *(u32x4*)(YD + (size_t)(base + p2 - 16) * 512 + h * 64 + cg8) = pack8(y0, y1);
            }
        }
    }
#undef SC_LOAD
#undef SC_META
#undef SCI
}

__device__ __forceinline__ void rwkv_colmap(unsigned char* ws, int c0, bf16*& buf, int& ld, int& col) {
    if (c0 < 512) { buf = (bf16*)(ws + WS_R); ld = 512; col = c0; }
    else if (c0 < 1024) { buf = (bf16*)(ws + WS_KA); ld = 512; col = c0 - 512; }
    else if (c0 < 1536) { buf = (bf16*)(ws + WS_VA); ld = 512; col = c0 - 1024; }
    else { buf = (bf16*)(ws + WS_L); ld = 256; col = c0 - 1536; }
}
__device__ __forceinline__ void phase_halo(KP P) {
    const int tid = fresh_tid(), lane = tid & 63, wid = tid >> 6; const int gw = blockIdx.x * 8 + wid, NGW = gridDim.x * 8;
    unsigned char* ws = P->ws;
    for (int r = gw; r < (NMAIN / 64) * 2; r += NGW) {
        const int m = (r >> 1) * 64 + ((r & 1) ? 63 : 0);
        for (int j = lane; j < 224; j += 64) { bf16* buf; int ld, col; rwkv_colmap(ws, j * 8, buf, ld, col);
            *(u32x4*)(ws + WS_HALO + (size_t)r * HALO_ROW + j * 16) = *(const u32x4*)(buf + (size_t)m * ld + col); }
    }
}
__device__ __forceinline__ void phase_shift(LAS unsigned char* lds, KP P) {
    const int tid = fresh_tid(), slot = tid >> 3, cg = tid & 7;
    unsigned char* ws = P->ws; const float* mup = P->in[I_MUP]; const float* mun = P->in[I_MUN];
    for (int tile = blockIdx.x; tile < NMAIN / 64; tile += gridDim.x) {
        const int m0 = tile * 64, m = m0 + slot;
        const int ks = m0 < 16384 ? tile : ((m0 - 16384) & 2047) >> 6; const bool first = ks == 0, last = ks == (m0 < 16384 ? 255 : 31);
#pragma unroll 1
        for (int pass = 0; pass < 4; ++pass) {
#pragma unroll
            for (int i = 0; i < 7; ++i) { const int j = cg + 8 * i; bf16* buf; int ld, col; rwkv_colmap(ws, (pass * 56 + j) * 8, buf, ld, col);
                *(LAS u32x4*)(lds + (slot * 56 + j) * 16) = *(const u32x4*)(buf + (size_t)m * ld + col); }
            __syncthreads();
#pragma unroll
            for (int i = 0; i < 7; ++i) {
                const int j = cg + 8 * i, c0 = (pass * 56 + j) * 8; bf16* buf; int ld, col; rwkv_colmap(ws, c0, buf, ld, col);
                const u32x4 z = {0u, 0u, 0u, 0u};
                const u32x4 cu = *(const LAS u32x4*)(lds + (slot * 56 + j) * 16);
                u32x4 pu, nu;
                if (slot > 0) pu = *(const LAS u32x4*)(lds + ((slot - 1) * 56 + j) * 16);
                else pu = first ? *(const u32x4*)(buf + (size_t)(METAROW + 15) * ld + col) : *(const u32x4*)(ws + WS_HALO + (size_t)((tile - 1) * 2 + 1) * HALO_ROW + c0 * 2);
                if (slot < 63) nu = *(const LAS u32x4*)(lds + ((slot + 1) * 56 + j) * 16);
                else nu = last ? z : *(const u32x4*)(ws + WS_HALO + (size_t)((tile + 1) * 2) * HALO_ROW + c0 * 2);
                float pv[8], cv[8], nv[8], o[8]; unpack8(pu, pv); unpack8(cu, cv); unpack8(nu, nv);
                const f32x4 mp0 = *(const f32x4*)(mup + c0), mp1 = *(const f32x4*)(mup + c0 + 4), mn0 = *(const f32x4*)(mun + c0), mn1 = *(const f32x4*)(mun + c0 + 4);
#pragma unroll
                for (int e = 0; e < 8; ++e) { const float mp = e < 4 ? mp0[e & 3] : mp1[e & 3], mn = e < 4 ? mn0[e & 3] : mn1[e & 3]; o[e] = cv[e] + mp * (pv[e] - cv[e]) + mn * (nv[e] - cv[e]); }
                if (c0 >= 1536 && c0 < 1600) {
#pragma unroll
                    for (int e = 0; e < 8; ++e) o[e] = fast_tanh(o[e]);
                }
                u32x4 w; w.x = cvtpk(o[0], o[1]); w.y = cvtpk(o[2], o[3]); w.z = cvtpk(o[4], o[5]); w.w = cvtpk(o[6], o[7]);
                *(u32x4*)(buf + (size_t)m * ld + col) = w;
            }
            __syncthreads();
        }
    }
}

__device__ __forceinline__ void phase_post(LAS unsigned char* lds, KP P) {
    const int tid = fresh_tid(), lane = tid & 63, wid = tid >> 6;
    unsigned char* ws = P->ws;
    const bf16* VAb = (const bf16*)(ws + WS_VA); const bf16* Lb = (const bf16*)(ws + WS_L); bf16* Rb = (bf16*)(ws + WS_R);
    const float* CB = (const float*)(ws + WS_CB); const bf16* YD0 = (const bf16*)((const unsigned char*)P->out + 64 * MiB); const bf16* YD1 = YD0 + (size_t)NMAIN * 512;
    const bf16* GT = (const bf16*)(ws + WS_LORA + 262144);
    LAS float* st = (LAS float*)(lds + 17408);
    const float* mup = P->in[I_MUP]; const float* mun = P->in[I_MUN];
    for (int tile = blockIdx.x; tile < NMAIN / 64; tile += gridDim.x) {
        {
            const int row = tid >> 3, hh = tid & 7, m = tile * 64 + row;
            const int t = m < 16384 ? m : (m - 16384) & 2047, Ls = m < 16384 ? 16384 : 2048;
            float sum = 0.f, sq = 0.f;
#pragma unroll
            for (int i = 0; i < 8; ++i) { float a[8], b[8]; unpack8(*(const u32x4*)(YD0 + (size_t)m * 512 + hh * 64 + i * 8), a); unpack8(*(const u32x4*)(YD1 + (size_t)m * 512 + hh * 64 + i * 8), b);
#pragma unroll
                for (int e = 0; e < 8; ++e) { const float y = a[e] + b[e]; sum += y; sq += y * y; } }
            const float mu = sum * (1.0f / 64.0f); const float var = fmaxf(sq * (1.0f / 64.0f) - mu * mu, 0.f);
            st[(row * 8 + hh) * 2] = mu; st[(row * 8 + hh) * 2 + 1] = rsqrtf(var + 64e-5f);
#pragma unroll
            for (int i = 0; i < 2; ++i) {
                const int c0 = 128 + hh * 16 + i * 8; float cv[8], o[8];
                unpack8(*(const u32x4*)(Lb + (size_t)m * 256 + c0), cv);
#pragma unroll
                for (int e = 0; e < 8; ++e) o[e] = sigmoidf_(cv[e]);
                u32x4 w; w.x = cvtpk(o[0], o[1]); w.y = cvtpk(o[2], o[3]); w.z = cvtpk(o[4], o[5]); w.w = cvtpk(o[6], o[7]);
                *(LAS u32x4*)(lds + row * 272 + (hh * 16 + i * 8) * 2) = w;
            }
        }
        __syncthreads();
#pragma unroll 1
        for (int nt = 0; nt < 4; ++nt) {
            const int col = wid * 64 + nt * 16 + (lane & 15);
            bf16x8 bfr[4];
#pragma unroll
            for (int ks = 0; ks < 4; ++ks) bfr[ks] = *(const bf16x8*)(GT + (size_t)col * 128 + ks * 32 + (lane >> 4) * 8);
            const float lw = P->in[I_LNW][col], lb = P->in[I_LNB][col];
            const float mpv = mup[1024 + col], mnv = mun[1024 + col];
#pragma unroll 1
            for (int mt = 0; mt < 4; ++mt) {
                f32x4 acc = {0.f, 0.f, 0.f, 0.f};
#pragma unroll
                for (int ks = 0; ks < 4; ++ks) { const bf16x8 a = *(const LAS bf16x8*)(lds + (mt * 16 + (lane & 15)) * 272 + ks * 64 + (lane >> 4) * 16); acc = __builtin_amdgcn_mfma_f32_16x16x32_bf16(a, bfr[ks], acc, 0, 0, 0); }
#pragma unroll
                for (int rg = 0; rg < 4; ++rg) {
                    const int row = mt * 16 + (lane >> 4) * 4 + rg, m = tile * 64 + row;
                    const int t = m < 16384 ? m : (m - 16384) & 2047, Ls = m < 16384 ? 16384 : 2048;
                    const float y = bf2f(YD0[(size_t)m * 512 + col]) + bf2f(YD1[(size_t)m * 512 + col]);
                    const float yn = (y - st[(row * 8 + wid) * 2]) * st[(row * 8 + wid) * 2 + 1] * lw + lb;
                    const float vs = bf2f(VAb[(size_t)m * 512 + col]);
                    const float cb = CB[(size_t)m * 8 + wid] + CB[((size_t)ROWS + m) * 8 + wid];
                    Rb[(size_t)m * 512 + col] = (bf16)f2bf_rne((yn + cb * vs) * acc[rg]);
                }
            }
        }
        __syncthreads();
    }
}

__device__ __forceinline__ void phase_rms_bf16(KP P) {
    const int tid = fresh_tid(), lane = tid & 63, wid = tid >> 6; const int gw = blockIdx.x * 8 + wid, NGW = gridDim.x * 8;
    bf16* MN = (bf16*)(P->ws + WS_MN);
    for (int m = gw; m < NMAIN; m += NGW) rms_row_bf16(P->out + (size_t)m * DM, P->in[I_GFFN], MN + (size_t)m * DM, lane);
}
__device__ __forceinline__ void phase_final(KP P) {
    const int tid = fresh_tid(), lane = tid & 63, wid = tid >> 6; const int gw = blockIdx.x * 8 + wid, NGW = gridDim.x * 8;
    const f32x4* gr = (const f32x4*)P->in[I_GFIN] + lane;
    for (int m = gw; m < NMAIN; m += NGW) {
        f32x4* xr = (f32x4*)(P->out + (size_t)m * DM) + lane; f32x4 v[4]; float s = 0.f;
#pragma unroll
        for (int j = 0; j < 4; ++j) { v[j] = xr[64 * j]; s += (v[j].x * v[j].x + v[j].y * v[j].y) + (v[j].z * v[j].z + v[j].w * v[j].w); }
        const float rstd = rsqrtf(wave_sum(s) * (1.f / DM) + 1e-6f);
#pragma unroll
        for (int j = 0; j < 4; ++j) xr[64 * j] = v[j] * rstd * gr[64 * j];
    }
}

constexpr int NRP_LONG = 4;
constexpr int N_LONG = 16 * NRP_LONG, N_ATT_P = 512, N_ATT_S = 512, N_SHORT = 128, N_ITEMS = N_LONG + N_ATT_P + N_ATT_S + N_SHORT;

template <class Op> __device__ __forceinline__ void run_gemm(LAS unsigned char* lds, const bf16* A, const bf16* Bt, int M, int N, int K, const Op& op, const bf16* A2 = nullptr, int pm2 = 1 << 30) {
    pg8::Gemm g{A, Bt, M, N, K, A2, pm2}; pg8::StaticOrder S; S.init(M, N, (int)gridDim.x, (int)blockIdx.x);
    Epi8<Op> E{op};
    pg8::gemm_phase<Epi8<Op>, pg8::StaticOrder, true, true>(lds, g, S, E);
}

constexpr size_t WS_XBAR = 16384;
#define XB_TMO      128
#define XB_XCNT(j)  (256  + 64 * (j))
#define XB_XSUB(j)  (1280 + 64 * (j))
#define XB_XGEN(j)  (2304 + 64 * (j))
#define XB_TOP      3328
#define XB_TOPGEN   3392
#define XCD_BAR_WORDS 3456
#define XB_SPIN_CAP (1u << 18)
__device__ __forceinline__ unsigned xb_ld(unsigned* p)              { return __hip_atomic_load(p, __ATOMIC_RELAXED, __HIP_MEMORY_SCOPE_AGENT); }
__device__ __forceinline__ unsigned xb_add(unsigned* p, unsigned v) { return __hip_atomic_fetch_add(p, v, __ATOMIC_RELAXED, __HIP_MEMORY_SCOPE_AGENT); }
__device__ __forceinline__ unsigned xb_xcc_id() { return (unsigned)__builtin_amdgcn_s_getreg((3 << 11) | 20) & 0xFu; }
#define XB_SPIN(cond, bar) do { unsigned _sp = 0; while (cond) { __builtin_amdgcn_s_sleep(1); \
    if ((++_sp & 255u) == 0u) { if (xb_ld(&(bar)[XB_TMO])) break; if (_sp > XB_SPIN_CAP) { atomicAdd(&(bar)[XB_TMO], 1u); break; } } } } while (0)
struct XcdBarrier { unsigned* bar; unsigned x; volatile LAS unsigned* st; };
__device__ __forceinline__ XcdBarrier xcd_barrier_post(unsigned* bar, volatile LAS unsigned* st) {
    XcdBarrier b; b.bar = bar; b.x = xb_xcc_id(); b.st = st;
    if (threadIdx.x == 0) (void)xb_add(&bar[XB_XCNT(b.x)], 1u);
    return b;
}
__device__ __forceinline__ void xcd_barrier_complete(unsigned* bar, unsigned x, unsigned& nloc, unsigned& nx) {
    const unsigned G = gridDim.x * gridDim.y * gridDim.z;
    unsigned sum, cnt, mine, sp = 0u;
    for (;;) {
        sum = 0u; cnt = 0u; mine = 0u;
#pragma unroll
        for (unsigned j = 0; j < 16; ++j) { const unsigned c = xb_ld(&bar[XB_XCNT(j)]); sum += c; cnt += (c > 0u) ? 1u : 0u; mine = (j == x) ? c : mine; }
        if (sum == G) break;
        __builtin_amdgcn_s_sleep(1);
        if ((++sp & 255u) == 0u) { if (xb_ld(&bar[XB_TMO])) break; if (sp > XB_SPIN_CAP) { atomicAdd(&bar[XB_TMO], 1u); break; } }
    }
    nloc = mine > 0u ? mine : 1u; nx = cnt > 0u ? cnt : 1u;
}
__device__ __forceinline__ void xcd_barrier(const XcdBarrier& b) {
    asm volatile("s_waitcnt vmcnt(0)" ::: "memory");
    __syncthreads();
    if (threadIdx.x == 0) {
        unsigned* bar = b.bar;
        __builtin_amdgcn_s_waitcnt(0);
        unsigned nloc = b.st[0], nx = b.st[1];
        if (nloc == 0u) { xcd_barrier_complete(bar, b.x, nloc, nx); b.st[0] = nloc; b.st[1] = nx; }
        const unsigned old = xb_add(&bar[XB_XSUB(b.x)], 1u);
        const unsigned gen = old / nloc;
        if (old + 1u == (gen + 1u) * nloc) {
            __builtin_amdgcn_fence(__ATOMIC_RELEASE, "agent");
            asm volatile("s_waitcnt vmcnt(0)" ::: "memory");
            const unsigned og = xb_add(&bar[XB_TOP], 1u);
            const unsigned tg = og / nx;
            if (og + 1u == (tg + 1u) * nx) xb_add(&bar[XB_TOPGEN], 1u);
            else XB_SPIN(xb_ld(&bar[XB_TOPGEN]) == tg, bar);
            __builtin_amdgcn_fence(__ATOMIC_ACQUIRE, "agent");
            xb_add(&bar[XB_XGEN(b.x)], 1u);
            asm volatile("s_waitcnt vmcnt(0)" ::: "memory");
        } else {
            XB_SPIN(xb_ld(&bar[XB_XGEN(b.x)]) == gen, bar);
            __builtin_amdgcn_fence(__ATOMIC_ACQUIRE, "agent");
            asm volatile("s_waitcnt vmcnt(0)" ::: "memory");
        }
    }
    __syncthreads();
}
#ifndef PROBE_MASK
#define PROBE_MASK 0
#endif
#ifndef PROBE_MUL
#define PROBE_MUL 1
#endif
#define PH_BEGIN(k) unsigned long long t0_##k = 0; if (PROBE_MASK & (1 << (k))) t0_##k = __builtin_amdgcn_s_memrealtime();
#define PH_END(k) if (PROBE_MASK & (1 << (k))) { const unsigned long long t1_ = __builtin_amdgcn_s_memrealtime(); const unsigned long long dt_ = (t1_ - t0_##k) * PROBE_MUL; while (__builtin_amdgcn_s_memrealtime() - t1_ < dt_) __builtin_amdgcn_s_sleep(8); xcd_barrier(xbar); }
__global__ void __launch_bounds__(NTHREADS) fwd_megakernel(Params Pin) {
    extern __shared__ __attribute__((aligned(16))) unsigned char lds_raw[];
    LAS unsigned char* lds = (LAS unsigned char*)lds_raw;
    cg::grid_group grid = cg::this_grid();
    KP P0 = (KP)__builtin_amdgcn_kernarg_segment_ptr();
    volatile LAS unsigned* xst = (volatile LAS unsigned*)(lds + LDS_ITEM_OFF + 4);
    if (threadIdx.x == 0) { xst[0] = 0u; xst[1] = 0u; }
    __syncthreads();
    const XcdBarrier xbar = xcd_barrier_post((unsigned*)(P0->ws + WS_XBAR), xst);
#define NEWPHASE KP P = P0; asm volatile("" : "+s"(P)); unsigned char* ws = P->ws; (void)ws;

    PH_BEGIN(0)
    { NEWPHASE phase_prologue(lds, P); }
    grid.sync();
    PH_END(0)
    PH_BEGIN(1)
    { NEWPHASE run_gemm(lds, (const bf16*)P->out, (const bf16*)(ws + WS_WIN), ROWS, 3328, 1024, OpProj{ws}, (const bf16*)(ws + WS_XNMETA), 128); }
    xcd_barrier(xbar);
    PH_END(1)
    { NEWPHASE phase_halo(P); }
    xcd_barrier(xbar);
    { NEWPHASE phase_shift(lds, P); }
    xcd_barrier(xbar);
    PH_BEGIN(2)
    { NEWPHASE
        const int tid = fresh_tid();
        float lam;
        { const int lane = tid & 63; const float s1 = wave_sum(P->in[I_LQ1][lane] * P->in[I_LK1][lane]), s2 = wave_sum(P->in[I_LQ2][lane] * P->in[I_LK2][lane]); lam = __expf(s1) - __expf(s2) + 0.2f; }
        unsigned* ctr = (unsigned*)(ws + WS_CTL);
        LAS unsigned* slot = (LAS unsigned*)(lds + LDS_ITEM_OFF);
#define FETCH(k, n) if (tid == 0) *slot = atomicAdd(ctr + 64 * (k), 1u); __syncthreads(); const int idx = (int)*slot; __syncthreads(); if (idx >= (n)) break;
#ifndef NO_SCAN
#pragma unroll 1
        for (;;) { FETCH(0, N_LONG) const int u = idx / NRP_LONG; scan_unit<NRP_LONG, 4>(lds, P, 0, u >> 3, u & 7, idx % NRP_LONG); }
#endif
#ifndef NO_ATTN
#pragma unroll 1
        for (;;) { FETCH(1, N_ATT_P + N_ATT_S)
            if (idx < N_ATT_P) attn_unit(lds, P, 0, idx >> 7, idx & 127, lam);
            else { const int a = idx - N_ATT_P; attn_unit(lds, P, 1 + (a >> 6), (a >> 4) & 3, a & 15, lam); } }
#endif
#ifndef NO_SCAN
#pragma unroll 1
        for (;;) { FETCH(2, N_SHORT) scan_unit<1, 8>(lds, P, 1 + (idx >> 4), (idx >> 3) & 1, idx & 7, 0); }
#endif
#undef FETCH
    }
    xcd_barrier(xbar);
    PH_END(2)
#ifndef NO_POST
    PH_BEGIN(3)
    { NEWPHASE phase_post(lds, P); }
#endif
    xcd_barrier(xbar);
    PH_END(3)
    PH_BEGIN(4)
    { NEWPHASE run_gemm(lds, (const bf16*)P->out, (const bf16*)(ws + WS_WIN) + (size_t)3328 * 1024, NMAIN, 1024, 1024, OpGate{(bf16*)(ws + WS_GA)}); }
    { NEWPHASE run_gemm(lds, (const bf16*)P->out, (const bf16*)(ws + WS_WIN) + (size_t)4352 * 1024, NMAIN, 1024, 1024, OpGate{(bf16*)(ws + WS_GB)}); }

    PH_END(4)
    PH_BEGIN(5)
    { NEWPHASE run_gemm(lds, (const bf16*)(ws + WS_R), (const bf16*)(ws + WS_WUPA), NMAIN, 1024, 512, OpUpA{ws}); }
    PH_END(5)
    PH_BEGIN(6)
    { NEWPHASE run_gemm(lds, (const bf16*)(ws + WS_Q), (const bf16*)(ws + WS_WUPB), NMAIN, 1024, 512, OpUpB{ws}); }
    xcd_barrier(xbar);
    PH_END(6)
    PH_BEGIN(7)
    { NEWPHASE run_gemm(lds, (const bf16*)(ws + WS_GB), (const bf16*)(ws + WS_WOUT), NMAIN, 1024, 1024, OpOut{P->in[I_XP], P->in[I_XS], P->out}); }
    xcd_barrier(xbar);
    PH_END(7)
    PH_BEGIN(8)
    { NEWPHASE phase_rms_bf16(P); }
    xcd_barrier(xbar);
    PH_END(8)
    PH_BEGIN(9)
    { NEWPHASE run_gemm(lds, (const bf16*)(ws + WS_MN), (const bf16*)(ws + WS_WFF1), 16384, DFF, 1024, OpFF1{(bf16*)(ws + WS_HID)}); }
    xcd_barrier(xbar);
    PH_END(9)
    PH_BEGIN(10)
    { NEWPHASE run_gemm(lds, (const bf16*)(ws + WS_HID), (const bf16*)(ws + WS_WFF2), 16384, 1024, DFF, OpFF2{P->out}); }
    xcd_barrier(xbar);
    PH_END(10)
    PH_BEGIN(11)
    { NEWPHASE run_gemm(lds, (const bf16*)(ws + WS_MN) + (size_t)16384 * DM, (const bf16*)(ws + WS_WFF1), 16384, DFF, 1024, OpFF1{(bf16*)(ws + WS_HID)}); }
    xcd_barrier(xbar);
    PH_END(11)
    PH_BEGIN(12)
    { NEWPHASE run_gemm(lds, (const bf16*)(ws + WS_HID), (const bf16*)(ws + WS_WFF2), 16384, 1024, DFF, OpFF2{P->out + (size_t)16384 * DM}); }
    xcd_barrier(xbar);
    PH_END(12)
    PH_BEGIN(13)
    { NEWPHASE phase_final(P); }
}

extern "C" void kernel_launch(void* const* d_in, const int* in_sizes, int n_in, void* d_out, int out_size, void* d_ws, size_t ws_size, hipStream_t stream) {
    static int grid_blocks = 0;
    if (grid_blocks == 0) {
        int dev = 0, cus = 0, per_cu = 0;
        hipGetDevice(&dev);
        hipDeviceGetAttribute(&cus, hipDeviceAttributeMultiprocessorCount, dev);
        hipFuncSetAttribute((const void*)fwd_megakernel, hipFuncAttributeMaxDynamicSharedMemorySize, LDS_BYTES);
        hipOccupancyMaxActiveBlocksPerMultiprocessor(&per_cu, (const void*)fwd_megakernel, NTHREADS, LDS_BYTES);
        if (per_cu < 1) { fprintf(stderr, "kernel_launch: occupancy query says %d blocks per CU\n", per_cu); per_cu = 1; }
        grid_blocks = cus * per_cu;
        if (n_in != 29 || ws_size < WS_END) fprintf(stderr, "kernel_launch: unexpected n_in %d / ws_size %zu\n", n_in, ws_size);
    }
    hipMemsetAsync((unsigned char*)d_ws + WS_CTL, 0, 32768, stream);
    Params p{};
    for (int i = 0; i < 29; ++i) p.in[i] = (const float*)d_in[i];
    p.out = (float*)d_out; p.ws = (unsigned char*)d_ws;
    void* args[] = {&p};
    hipError_t e = hipLaunchCooperativeKernel((const void*)fwd_megakernel, dim3(grid_blocks), dim3(NTHREADS), args, LDS_BYTES, stream);
    if (e != hipSuccess) fprintf(stderr, "cooperative launch failed: %s (grid %d)\n", hipGetErrorString(e), grid_blocks);
}
```

```cpp
#include <hip/hip_runtime.h>
#include <hip/hip_cooperative_groups.h>
#include <cstdio>
#include <cstdint>
#include <cmath>
namespace cg = cooperative_groups;
__device__ __forceinline__ int fresh_tid() { int t = threadIdx.x; asm volatile("" : "+v"(t)); return t; }
namespace pg8 {
#define PG8_LAS __attribute__((address_space(3)))
typedef unsigned short bf16_t;
typedef short bf16x8 __attribute__((ext_vector_type(8)));
typedef float f32x4 __attribute__((ext_vector_type(4)));
typedef unsigned u32x4 __attribute__((ext_vector_type(4)));
constexpr int BM = 256, BK = 64, HALF = 128, HTB = HALF * BK * 2  , STAGE_BYTES = 8 * HTB, NXCD = 8, WGM = 8;

__host__ __device__ __forceinline__ int lds_byte(int r, int c) { const int st = (r >> 4) * 2 + (c >> 5), rr = r & 15, cc = c & 31, ob = rr * 64 + cc * 2; return st * 1024 + (ob ^ (((ob >> 9) & 1) << 5)); }
__host__ __device__ __forceinline__ void stage_rc(int b, int& R, int& C) { const int st = b / 1024, sb = b % 1024, swz = sb ^ (((sb >> 9) & 1) << 5); R = (st >> 1) * 16 + swz / 64; C = (st & 1) * 32 + (swz % 64) / 2; }
__host__ __device__ __forceinline__ int perm32(int rho) { const int n = rho >> 4, i = rho & 15; return 8 * (i >> 2) + 4 * n + (i & 3); }

struct Unit { int pm, pn; };
struct Gemm { const bf16_t* A; const bf16_t* Bt; int M, N, K; const bf16_t* A2; int pm2; };
__device__ __forceinline__ const char* gemm_abase(const Gemm& g, int pm, size_t tstep) { return pm >= g.pm2 ? (const char*)g.A2 + (size_t)(pm - g.pm2) * tstep : (const char*)g.A + (size_t)pm * tstep; }

struct StaticOrder {
    int nM, nN, nwg, G, c;
    __host__ __device__ void init(int M, int N, int G_, int c_) { nM = M / BM; nN = N / BM; nwg = nM * nN; G = G_; c = c_; }
    __host__ __device__ bool next(int i, Unit& u) const {
        const long L = (long)i * G + c; if (L >= nwg) return false;
        int wgid = (int)L; { const int q = nwg / NXCD, r = nwg % NXCD, xcd = wgid % NXCD, off = wgid / NXCD; wgid = (xcd < r ? xcd * (q + 1) : r * (q + 1) + (xcd - r) * q) + off; }
        const int nig = WGM * nN, gid = wgid / nig, fm = gid * WGM, gsz = (nM - fm) < WGM ? (nM - fm) : WGM;
        u.pm = fm + ((wgid % nig) % gsz); u.pn = (wgid % nig) / gsz; return true;
    }
    __device__ __forceinline__ void a_ready(const Unit&) const {}
    __device__ __forceinline__ void done(const Unit&) const {}
};


template <class Epi, class Sched, bool ALIGN_EPI = false, bool SP2 = false>
__device__ __forceinline__ void gemm_phase(PG8_LAS unsigned char* lds, const Gemm g, const Sched& S, const Epi& E) {
    const int tid = fresh_tid(), wid = __builtin_amdgcn_readfirstlane(tid >> 6), lane = tid & 63, wr = wid >> 2, wc = wid & 3, fr = lane & 15, fq = lane >> 4;
    const int K = g.K, nt = K / BK;
    unsigned voffA[2], voffB[2];
#pragma unroll
    for (int i = 0; i < 2; ++i) { int R, C; stage_rc(tid * 16 + i * 8192, R, C); const int Rb = Epi::PERM ? ((R & ~31) + perm32(R & 31)) : R;
        voffA[i] = (unsigned)(R * K + C) * 2u; voffB[i] = (unsigned)(Rb * K + C) * 2u; }
    const size_t kstep = (size_t)(BK * 2);
    const size_t hstep = (size_t)HALF * K * 2;
    const size_t tstep = 2 * hstep;
    const unsigned ldsw = (unsigned)wid * 1024u;
    const int aoff = lds_byte(wr * 64 + fr, fq * 8), boff = lds_byte(wc * 32 + fr, fq * 8);
#define PG8_SA(b, h) (((b) * 2 + (h)) * HTB)
#define PG8_SB(b, h) ((4 + (b) * 2 + (h)) * HTB)
#define PG8_STAGE(bufoff, gbase, voff) do { _Pragma("unroll") for (int _i = 0; _i < 2; ++_i) \
        __builtin_amdgcn_global_load_lds((const unsigned*)((const char*)(gbase) + (voff)[_i]), (PG8_LAS unsigned*)(lds + (bufoff) + ldsw + _i * 8192), 16, 0, 0); } while (0)
#define PG8_LDA(dst, b, h) do { _Pragma("unroll") for (int m = 0; m < 4; ++m) _Pragma("unroll") for (int k = 0; k < 2; ++k) dst[m][k] = *(const PG8_LAS bf16x8*)(lds + PG8_SA(b, h) + aoff + m * 2048 + k * 1024); } while (0)
#define PG8_LDB(dst, b, h) do { _Pragma("unroll") for (int n = 0; n < 2; ++n) _Pragma("unroll") for (int k = 0; k < 2; ++k) dst[n][k] = *(const PG8_LAS bf16x8*)(lds + PG8_SB(b, h) + boff + n * 2048 + k * 1024); } while (0)
#define PG8_MMA(ai, bj, At, Bt) do { __builtin_amdgcn_s_setprio(1); _Pragma("unroll") for (int m = 0; m < 4; ++m) _Pragma("unroll") for (int n = 0; n < 2; ++n) _Pragma("unroll") for (int k = 0; k < 2; ++k) \
        acc[ai][bj][m][n] = __builtin_amdgcn_mfma_f32_16x16x32_bf16(Bt[n][k], At[m][k], acc[ai][bj][m][n], 0, 0, 0); __builtin_amdgcn_s_setprio(0); } while (0)
#define PG8_WAIT_V(n) asm volatile("s_waitcnt vmcnt(" #n ")" ::: "memory")
#define PG8_WAIT_L(n) asm volatile("s_waitcnt lgkmcnt(" #n ")" ::: "memory")
#define PG8_BAR __builtin_amdgcn_s_barrier()
#define PG8_SCHED __builtin_amdgcn_sched_barrier(0)
    Unit cur, nxt; int ui = 0;
    if (!S.next(0, cur)) return;
    f32x4 acc[2][2][4][2];
#pragma unroll
    for (int a = 0; a < 2; ++a)
#pragma unroll
        for (int b = 0; b < 2; ++b)
#pragma unroll
            for (int m = 0; m < 4; ++m)
#pragma unroll
                for (int n = 0; n < 2; ++n) acc[a][b][m][n] = (f32x4){0.f, 0.f, 0.f, 0.f};
    bf16x8 At[4][2], B0[2][2], B1[2][2];
    const char* cA = gemm_abase(g, cur.pm, tstep); const char* cB = (const char*)g.Bt + (size_t)cur.pn * tstep;
    S.a_ready(cur);
    if constexpr (SP2) {
        PG8_STAGE(PG8_SB(0, 0), cB, voffB); PG8_STAGE(PG8_SB(0, 1), cB + hstep, voffB); PG8_STAGE(PG8_SA(0, 0), cA, voffA); PG8_STAGE(PG8_SA(0, 1), cA + hstep, voffA);
        if (wr == 1) PG8_BAR;
        PG8_WAIT_V(2); PG8_BAR;
        PG8_STAGE(PG8_SB(1, 0), cB + kstep, voffB); PG8_STAGE(PG8_SA(1, 0), cA + kstep, voffA); PG8_STAGE(PG8_SB(1, 1), cB + hstep + kstep, voffB);
        PG8_WAIT_V(6); PG8_BAR;
    } else {
        PG8_STAGE(PG8_SB(0, 0), cB, voffB); PG8_STAGE(PG8_SA(0, 0), cA, voffA); PG8_STAGE(PG8_SB(0, 1), cB + hstep, voffB); PG8_STAGE(PG8_SA(0, 1), cA + hstep, voffA);
        if (wr == 1) PG8_BAR;
        PG8_WAIT_V(4); PG8_BAR;
        PG8_STAGE(PG8_SB(1, 0), cB + kstep, voffB); PG8_STAGE(PG8_SA(1, 0), cA + kstep, voffA); PG8_STAGE(PG8_SB(1, 1), cB + hstep + kstep, voffB);
        PG8_WAIT_V(6); PG8_BAR;
    }
    for (;;) {
        const bool has_next = S.next(ui + 1, nxt);
        const char* nA = has_next ? gemm_abase(g, nxt.pm, tstep) : cA; const char* nB = has_next ? (const char*)g.Bt + (size_t)nxt.pn * tstep : cB;
        for (int t = 0; t < nt; t += 2) {
            const bool last = (t == nt - 2);
            const char* a1 = cA + (size_t)(t + 1) * kstep;
            const char* a2 = last ? nA : cA + (size_t)(t + 2) * kstep; const char* b2 = last ? nB : cB + (size_t)(t + 2) * kstep;
            const char* a3 = a2 + kstep; const char* b3 = b2 + kstep;
            if (last && has_next) S.a_ready(nxt);
            if constexpr (SP2) {
            PG8_LDB(B0, 0, 0); PG8_LDB(B1, 0, 1); PG8_SCHED; PG8_LDA(At, 0, 0); PG8_STAGE(PG8_SA(1, 1), a1 + hstep, voffA);
            PG8_WAIT_V(8); PG8_WAIT_L(0); PG8_BAR; PG8_MMA(0, 0, At, B0); PG8_MMA(0, 1, At, B1); PG8_BAR; PG8_SCHED;
            PG8_LDA(At, 0, 1); PG8_STAGE(PG8_SB(0, 0), b2, voffB); PG8_STAGE(PG8_SB(0, 1), b2 + hstep, voffB); PG8_STAGE(PG8_SA(0, 0), a2, voffA);
            PG8_WAIT_V(8); PG8_WAIT_L(0); PG8_BAR; PG8_MMA(1, 0, At, B0); PG8_MMA(1, 1, At, B1); PG8_BAR; PG8_SCHED;
            PG8_LDB(B0, 1, 0); PG8_LDB(B1, 1, 1); PG8_SCHED; PG8_LDA(At, 1, 0); PG8_STAGE(PG8_SA(0, 1), a2 + hstep, voffA);
            PG8_WAIT_V(8); PG8_WAIT_L(0); PG8_BAR; PG8_MMA(0, 0, At, B0); PG8_MMA(0, 1, At, B1); PG8_BAR; PG8_SCHED;
            PG8_LDA(At, 1, 1); PG8_STAGE(PG8_SB(1, 0), b3, voffB); PG8_STAGE(PG8_SB(1, 1), b3 + hstep, voffB); PG8_STAGE(PG8_SA(1, 0), a3, voffA);
            PG8_WAIT_V(8); PG8_WAIT_L(0); PG8_BAR; PG8_MMA(1, 0, At, B0); PG8_MMA(1, 1, At, B1); PG8_BAR; PG8_SCHED;
            } else {
            PG8_LDB(B0, 0, 0); PG8_SCHED; PG8_LDA(At, 0, 0); PG8_STAGE(PG8_SA(1, 1), a1 + hstep, voffA);
            PG8_WAIT_L(8); PG8_BAR; PG8_WAIT_L(0); PG8_MMA(0, 0, At, B0); PG8_BAR; PG8_SCHED;
            PG8_LDB(B1, 0, 1); PG8_STAGE(PG8_SB(0, 0), b2, voffB);
            PG8_BAR; PG8_WAIT_L(0); PG8_MMA(0, 1, At, B1); PG8_BAR;
            PG8_LDA(At, 0, 1); PG8_STAGE(PG8_SA(0, 0), a2, voffA);
            PG8_BAR; PG8_WAIT_L(0); PG8_MMA(1, 0, At, B0); PG8_BAR; PG8_SCHED;
            PG8_STAGE(PG8_SB(0, 1), b2 + hstep, voffB);
            PG8_WAIT_V(6); PG8_BAR; PG8_MMA(1, 1, At, B1); PG8_BAR;
            PG8_LDB(B0, 1, 0); PG8_SCHED; PG8_LDA(At, 1, 0); PG8_STAGE(PG8_SA(0, 1), a2 + hstep, voffA);
            PG8_WAIT_L(8); PG8_BAR; PG8_WAIT_L(0); PG8_MMA(0, 0, At, B0); PG8_BAR; PG8_SCHED;
            PG8_LDB(B1, 1, 1); PG8_STAGE(PG8_SB(1, 0), b3, voffB);
            PG8_BAR; PG8_WAIT_L(0); PG8_MMA(0, 1, At, B1); PG8_BAR;
            PG8_LDA(At, 1, 1); PG8_STAGE(PG8_SA(1, 0), a3, voffA);
            PG8_BAR; PG8_WAIT_L(0); PG8_MMA(1, 0, At, B0); PG8_BAR; PG8_SCHED;
            PG8_STAGE(PG8_SB(1, 1), b3 + hstep, voffB);
            PG8_WAIT_V(6); PG8_BAR; PG8_MMA(1, 1, At, B1); PG8_BAR;
            }
        }
        if constexpr (ALIGN_EPI) { if (wr == 0) PG8_BAR; }
        if constexpr (!Epi::AFTER_DRAIN) { E(acc, cur, wr, wc, fr, fq); S.done(cur); }
        if (!has_next) break;
#pragma unroll
        for (int a = 0; a < 2; ++a)
#pragma unroll
            for (int b = 0; b < 2; ++b)
#pragma unroll
                for (int m = 0; m < 4; ++m)
#pragma unroll
                    for (int n = 0; n < 2; ++n) acc[a][b][m][n] = (f32x4){0.f, 0.f, 0.f, 0.f};
        cur = nxt; cA = nA; cB = nB; ++ui;
        if constexpr (ALIGN_EPI) { if (wr == 1) PG8_BAR; }
    }
    PG8_WAIT_V(0);
    if constexpr (!ALIGN_EPI) { if (wr == 0) PG8_BAR; }
    PG8_BAR;
    if constexpr (Epi::AFTER_DRAIN) { E.fused(acc, cur, wr, wc, fr, fq, lds, wid, lane); S.done(cur); }
#undef PG8_SA
#undef PG8_SB
#undef PG8_STAGE
#undef PG8_LDA
#undef PG8_LDB
#undef PG8_MMA
#undef PG8_WAIT_V
#undef PG8_WAIT_L
#undef PG8_BAR
#undef PG8_SCHED
}
}

#ifndef PG8_SP2
#define PG8_SP2 true
#endif

#define LAS __attribute__((address_space(3)))
typedef unsigned short bf16;
typedef short bf16x8 __attribute__((ext_vector_type(8)));
typedef float f32x4 __attribute__((ext_vector_type(4)));
typedef float f32x16 __attribute__((ext_vector_type(16)));
typedef unsigned u32x4 __attribute__((ext_vector_type(4)));
typedef unsigned u32x2 __attribute__((ext_vector_type(2)));

constexpr int DM = 1024, NMAIN = 32768, ROWS = 33024, METAROW = 32768, DFF = 4096;
constexpr int NTHREADS = 512;
constexpr int LDS_BYTES = 147456;
constexpr int LDS_ITEM_OFF = LDS_BYTES - 16;
constexpr size_t MiB = 1u << 20;
constexpr size_t WS_CTL = 0, WS_WIN = 1 * MiB, WS_WUPA = 12 * MiB, WS_WUPB = 13 * MiB, WS_WOUT = 14 * MiB, WS_WFF1 = 16 * MiB, WS_WFF2 = 24 * MiB;
constexpr size_t WS_LORA = 32 * MiB, WS_XNMETA = 32 * MiB + 512 * 1024, WS_CB = 33 * MiB, WS_ACT = 36 * MiB;
constexpr size_t ACT_SZ = (size_t)ROWS * 512 * 2, L_SZ = (size_t)ROWS * 256 * 2;
constexpr size_t WS_R = WS_ACT, WS_KA = WS_R + ACT_SZ, WS_VA = WS_KA + ACT_SZ, WS_L = WS_VA + ACT_SZ, WS_Q = WS_L + L_SZ, WS_KB = WS_Q + ACT_SZ, WS_VT = WS_KB + ACT_SZ, WS_END = WS_VT + ACT_SZ;
constexpr size_t WS_GA = WS_KA, WS_GB = WS_KB, WS_MN = WS_ACT, WS_HID = WS_ACT + 64 * MiB;
constexpr size_t WS_HALO = WS_END;
constexpr int HALO_ROW = 3584;
static_assert(WS_HALO + (size_t)(NMAIN / 64) * 2 * HALO_ROW <= 256 * MiB, "halo buffer");
static_assert(WS_END <= 256 * MiB && WS_HID + 128 * MiB <= 256 * MiB && WS_CB + (size_t)2 * ROWS * 8 * 4 <= WS_ACT, "ws map");
constexpr float LOG2E = 1.4426950408889634f;
constexpr float QSCALE = 0.125f * LOG2E;

struct Params { const float* in[29]; float* out; unsigned char* ws; };
typedef const __attribute__((address_space(4))) Params* KP;
enum { I_XP = 0, I_XS, I_META, I_GMIX, I_WIN, I_MUP, I_MUN, I_W0, I_WUP, I_A0, I_AUP, I_GUP, I_KK, I_KA, I_RK, I_LNW, I_LNB, I_LQ1, I_LK1, I_LQ2, I_LK2, I_SUBG, I_UPA, I_UPB, I_WOUT, I_GFFN, I_FF1, I_FF2, I_GFIN };

__device__ __forceinline__ unsigned cvtpk(float lo, float hi) { unsigned r; asm volatile("v_cvt_pk_bf16_f32 %0, %1, %2" : "=v"(r) : "v"(lo), "v"(hi)); return r; }
__device__ __forceinline__ float bf2f(unsigned short b) { return __uint_as_float(((unsigned)b) << 16); }
__device__ __forceinline__ float bflo(unsigned w) { return __uint_as_float(w << 16); }
__device__ __forceinline__ float bfhi(unsigned w) { return __uint_as_float(w & 0xffff0000u); }
__device__ __forceinline__ void unpack8(const u32x4 v, float* o) { o[0] = bflo(v.x); o[1] = bfhi(v.x); o[2] = bflo(v.y); o[3] = bfhi(v.y); o[4] = bflo(v.z); o[5] = bfhi(v.z); o[6] = bflo(v.w); o[7] = bfhi(v.w); }
__device__ __forceinline__ float wave_sum(float v) {
#pragma unroll
    for (int o = 1; o < 64; o <<= 1) v += __shfl_xor(v, o);
    return v;
}
__device__ __forceinline__ float sigmoidf_(float x) { return 1.0f / (1.0f + __expf(-x)); }
__device__ __forceinline__ int seq_base(int s) { return s == 0 ? 0 : 16384 + (s - 1) * 2048; }
__device__ __forceinline__ int seq_len(int s) { return s == 0 ? 16384 : 2048; }
__device__ __forceinline__ int pos_row(int base, int p) { return p < 16 ? METAROW + p : base + p - 16; }

template <class Op> struct Epi8 {
    static constexpr bool PERM = true, AFTER_DRAIN = false;
    Op op;
    __device__ __forceinline__ void operator()(const pg8::f32x4 (&acc)[2][2][4][2], const pg8::Unit& u, int wr, int wc, int fr, int fq) const {
        const int row0 = u.pm * 256 + wr * 64 + fr, col0 = u.pn * 256 + wc * 32 + 8 * fq;
#pragma unroll
        for (int ai = 0; ai < 2; ++ai)
#pragma unroll
            for (int m = 0; m < 4; ++m)
#pragma unroll
                for (int bj = 0; bj < 2; ++bj) { op.apply(row0 + ai * 128 + m * 16, col0 + bj * 128, u.pn, acc[ai][bj][m][0], acc[ai][bj][m][1]); asm volatile("" ::: "memory"); }
    }
};
__device__ __forceinline__ u32x4 pack8(const f32x4 a, const f32x4 b) { u32x4 w; w.x = cvtpk(a[0], a[1]); w.y = cvtpk(a[2], a[3]); w.z = cvtpk(b[0], b[1]); w.w = cvtpk(b[2], b[3]); return w; }

constexpr int CW_KN = 320;
__device__ __forceinline__ float dpp_max16(float v) {
    int x = __float_as_int(v);
    v = fmaxf(v, __int_as_float(__builtin_amdgcn_update_dpp(0, x, 0xB1, 0xf, 0xf, true))); x = __float_as_int(v);
    v = fmaxf(v, __int_as_float(__builtin_amdgcn_update_dpp(0, x, 0x4E, 0xf, 0xf, true))); x = __float_as_int(v);
    v = fmaxf(v, __int_as_float(__builtin_amdgcn_update_dpp(0, x, 0x141, 0xf, 0xf, true))); x = __float_as_int(v);
    v = fmaxf(v, __int_as_float(__builtin_amdgcn_update_dpp(0, x, 0x140, 0xf, 0xf, true)));
    return v;
}
struct OpProj {
    unsigned char* ws;
    __device__ __forceinline__ void apply(int row, int col, int pn, f32x4 v0, f32x4 v1) const {
        if (pn >= 11) {
            bf16* VT = (bf16*)(ws + WS_VT); const int c = col - 11 * 256;
#pragma unroll
            for (int e = 0; e < 4; ++e) { VT[(size_t)(c + e) * ROWS + row] = (bf16)(cvtpk(v0[e], 0.f) & 0xffffu); VT[(size_t)(c + 4 + e) * ROWS + row] = (bf16)(cvtpk(v1[e], 0.f) & 0xffffu); }
            return;
        }
        bf16* O; int ldc = 512, c;
        if (pn < 2) { O = (bf16*)(ws + WS_R); c = col; }
        else if (pn < 4) { O = (bf16*)(ws + WS_KA); c = col - 512; }
        else if (pn < 6) { O = (bf16*)(ws + WS_VA); c = col - 1024; }
        else if (pn < 7) { O = (bf16*)(ws + WS_L); c = col - 1536; ldc = 256; }
        else if (pn < 9) { O = (bf16*)(ws + WS_Q); c = col - 1792; v0 = v0 * QSCALE; v1 = v1 * QSCALE; }
        else { O = (bf16*)(ws + WS_KB); c = col - 2304; }
        const u32x4 w = pack8(v0, v1);
        *(u32x4*)(O + (size_t)row * ldc + c) = w;
        if (pn >= 9) {
            float k8[8]; unpack8(w, k8); float ss = 0.f;
#pragma unroll
            for (int e = 0; e < 8; ++e) ss = fmaf(k8[e], k8[e], ss);
            ss = dpp_max16(ss);
            if ((threadIdx.x & 15) == 0) { const int sidx = row < 16384 ? 0 : row < NMAIN ? 1 + ((row - 16384) >> 11) : 9;
                atomicMax((unsigned*)(ws + WS_CTL) + CW_KN + sidx * 64 + (c >> 3), __float_as_uint(ss)); }
        }
    }
};
struct OpGate {
    bf16* O;
    __device__ __forceinline__ void apply(int row, int col, int pn, f32x4 v0, f32x4 v1) const {
        const int c = col;
#pragma unroll
        for (int e = 0; e < 4; ++e) { v0[e] = sigmoidf_(v0[e]); v1[e] = sigmoidf_(v1[e]); }
        *(u32x4*)(O + (size_t)row * 1024 + c) = pack8(v0, v1);
    }
};
struct OpUpA {
    unsigned char* ws;
    __device__ __forceinline__ void apply(int row, int col, int pn, f32x4 v0, f32x4 v1) const {
        u32x4* p = (u32x4*)((bf16*)(ws + WS_GA) + (size_t)row * 1024 + col); float g[8]; unpack8(*p, g);
#pragma unroll
        for (int e = 0; e < 4; ++e) { v0[e] *= g[e]; v1[e] *= g[4 + e]; }
        *p = pack8(v0, v1);
    }
};
struct OpUpB {
    unsigned char* ws;
    __device__ __forceinline__ void apply(int row, int col, int pn, f32x4 v0, f32x4 v1) const {
        u32x4* p = (u32x4*)((bf16*)(ws + WS_GB) + (size_t)row * 1024 + col); float g[8], a[8]; unpack8(*p, g);
        unpack8(*(const u32x4*)((const bf16*)(ws + WS_GA) + (size_t)row * 1024 + col), a);
#pragma unroll
        for (int e = 0; e < 4; ++e) { v0[e] = a[e] + v0[e] * g[e]; v1[e] = a[4 + e] + v1[e] * g[4 + e]; }
        *p = pack8(v0, v1);
    }
};
struct OpOut {
    const float* xp; const float* xs; float* out;
    __device__ __forceinline__ void apply(int row, int col, int pn, f32x4 v0, f32x4 v1) const {
        const float* x = (row < 16384 ? xp + (size_t)row * DM : xs + (size_t)(row - 16384) * DM) + col;
        float* o = out + (size_t)row * DM + col;
        *(f32x4*)o = *(const f32x4*)x + v0; *(f32x4*)(o + 4) = *(const f32x4*)(x + 4) + v1;
    }
};
struct OpFF1 {
    bf16* hid;
    __device__ __forceinline__ void apply(int row, int col, int pn, f32x4 v0, f32x4 v1) const {
#pragma unroll
        for (int e = 0; e < 4; ++e) { const float a = fmaxf(v0[e], 0.f), b = fmaxf(v1[e], 0.f); v0[e] = a * a; v1[e] = b * b; }
        *(u32x4*)(hid + (size_t)row * DFF + col) = pack8(v0, v1);
    }
};
struct OpFF2 {
    float* out;
    __device__ __forceinline__ void apply(int row, int col, int pn, f32x4 v0, f32x4 v1) const {
        float* o = out + (size_t)row * DM + col;
        *(f32x4*)o = *(const f32x4*)o + v0; *(f32x4*)(o + 4) = *(const f32x4*)(o + 4) + v1;
    }
};

__device__ __forceinline__ unsigned f2bf_rne(float f) { return cvtpk(f, 0.f) & 0xffffu; }
__device__ __forceinline__ void transpose_item(const float* W, int K, int N, bf16* WT, LAS float* scr, int item, int lane) {
    const int nblk = N / 32, kb = item / nblk, nb = item % nblk, k0 = 64 * kb, n0 = 32 * nb;
#pragma unroll 8
    for (int i = 0; i < 32; ++i) { const int kk = 2 * i + (lane >> 5); scr[kk * 33 + (lane & 31)] = W[(size_t)(k0 + kk) * N + n0 + (lane & 31)]; }
    asm volatile("s_waitcnt vmcnt(0) lgkmcnt(0)" ::: "memory");
    const int c = lane & 7;
#pragma unroll
    for (int j = 0; j < 4; ++j) { const int n = (lane >> 3) + 8 * j; const LAS float* s = scr + (8 * c) * 33 + n;
        u32x4 o; o.x = cvtpk(s[0 * 33], s[1 * 33]); o.y = cvtpk(s[2 * 33], s[3 * 33]); o.z = cvtpk(s[4 * 33], s[5 * 33]); o.w = cvtpk(s[6 * 33], s[7 * 33]);
        *(u32x4*)(WT + (size_t)(n0 + n) * K + k0 + 8 * c) = o; }
    asm volatile("s_waitcnt lgkmcnt(0)" ::: "memory");
}
__device__ __forceinline__ void rms_row_bf16(const float* src, const float* g, bf16* dst, int lane) {
    unsigned long long* o8 = (unsigned long long*)dst + lane;
    if (!src) {
#pragma unroll
        for (int j = 0; j < 4; ++j) o8[64 * j] = 0ull;
        return; }
    const f32x4* xr = (const f32x4*)src + lane; const f32x4* gr = (const f32x4*)g + lane;
    f32x4 v[4]; float s = 0.f;
#pragma unroll
    for (int j = 0; j < 4; ++j) { v[j] = xr[64 * j]; s += (v[j].x * v[j].x + v[j].y * v[j].y) + (v[j].z * v[j].z + v[j].w * v[j].w); }
    const float rstd = rsqrtf(wave_sum(s) * (1.f / DM) + 1e-6f);
#pragma unroll
    for (int j = 0; j < 4; ++j) { const f32x4 gg = gr[64 * j]; const f32x4 y = v[j] * rstd * gg;
        o8[64 * j] = (unsigned long long)cvtpk(y.x, y.y) | ((unsigned long long)cvtpk(y.z, y.w) << 32); }
}
__device__ __forceinline__ void phase_prologue(LAS unsigned char* lds, KP P) {
    const int tid = fresh_tid(), lane = tid & 63, wid = tid >> 6;
    LAS float* scr = (LAS float*)(lds + wid * 16384);
    const int gw = blockIdx.x * 8 + wid, NGW = gridDim.x * 8;
    unsigned char* ws = P->ws;
    constexpr int I_IN = (1024 / 64) * (5376 / 32), I_UP = (512 / 64) * (1024 / 32), I_O = (1024 / 64) * (1024 / 32), I_1 = (1024 / 64) * (4096 / 32), I_2 = (4096 / 64) * (1024 / 32);
    constexpr int I_LW = (64 / 64) * (512 / 32), I_G = (128 / 64) * (512 / 32);
    constexpr int NITEMS = I_IN + 2 * I_UP + I_O + I_1 + I_2 + 4 * I_LW + I_G;
    for (int it = gw; it < NITEMS; it += NGW) {
        int r = it;
        if (r < I_IN) { transpose_item(P->in[I_WIN], 1024, 5376, (bf16*)(ws + WS_WIN), scr, r, lane); continue; } r -= I_IN;
        if (r < I_UP) { transpose_item(P->in[I_UPA], 512, 1024, (bf16*)(ws + WS_WUPA), scr, r, lane); continue; } r -= I_UP;
        if (r < I_UP) { transpose_item(P->in[I_UPB], 512, 1024, (bf16*)(ws + WS_WUPB), scr, r, lane); continue; } r -= I_UP;
        if (r < I_O) { transpose_item(P->in[I_WOUT], 1024, 1024, (bf16*)(ws + WS_WOUT), scr, r, lane); continue; } r -= I_O;
        if (r < I_1) { transpose_item(P->in[I_FF1], 1024, 4096, (bf16*)(ws + WS_WFF1), scr, r, lane); continue; } r -= I_1;
        if (r < I_2) { transpose_item(P->in[I_FF2], 4096, 1024, (bf16*)(ws + WS_WFF2), scr, r, lane); continue; } r -= I_2;
        if (r < 2 * I_LW) { const int d = r / I_LW; transpose_item(P->in[I_WUP] + (size_t)d * 64 * 512, 64, 512, (bf16*)(ws + WS_LORA) + (size_t)d * 512 * 64, scr, r % I_LW, lane); continue; } r -= 2 * I_LW;
        if (r < 2 * I_LW) { const int d = r / I_LW; transpose_item(P->in[I_AUP] + (size_t)d * 64 * 512, 64, 512, (bf16*)(ws + WS_LORA + 131072) + (size_t)d * 512 * 64, scr, r % I_LW, lane); continue; } r -= 2 * I_LW;
        transpose_item(P->in[I_GUP], 128, 512, (bf16*)(ws + WS_LORA + 262144), scr, r, lane);
    }
    bf16* XN = (bf16*)P->out; bf16* XM = (bf16*)(ws + WS_XNMETA);
    for (int m = gw; m < ROWS; m += NGW) {
        const float* src = m < 16384 ? P->in[I_XP] + (size_t)m * DM : m < NMAIN ? P->in[I_XS] + (size_t)(m - 16384) * DM : (m - NMAIN < 16 ? P->in[I_META] + (size_t)(m - NMAIN) * DM : nullptr);
        bf16* dst = m < NMAIN ? XN + (size_t)m * DM : XM + (size_t)(m - NMAIN) * DM;
        rms_row_bf16(src, P->in[I_GMIX], dst, lane);
    }
}

constexpr int AT_KSTR = 272, AT_VSTR = 144, AT_KSZ = 64 * AT_KSTR, AT_BUF = AT_KSZ + 128 * AT_VSTR;
__device__ __forceinline__ f32x16 mfma32(bf16x8 a, bf16x8 b, f32x16 c) { return __builtin_amdgcn_mfma_f32_32x32x16_bf16(a, b, c, 0, 0, 0); }
__device__ __forceinline__ void attn_unit(LAS unsigned char* lds, KP P, int s, int h, int qb, float lam) {
    int tid_ = threadIdx.x; asm volatile("" : "+v"(tid_));
    const int tid = tid_, lane = tid & 63, r32 = lane & 31, hi = lane >> 5, wid = __builtin_amdgcn_readfirstlane(tid >> 6), rg = wid & 3, mp = wid >> 2;
    const int L = seq_len(s), base = seq_base(s), NT = 1 + L / 64;
    unsigned char* ws = P->ws;
    const bf16* KB = (const bf16*)(ws + WS_KB); const bf16* VT = (const bf16*)(ws + WS_VT); bf16* Q = (bf16*)(ws + WS_Q);
    const int qrow = base + qb * 128 + rg * 32 + r32;
    bf16x8 q[4];
#pragma unroll
    for (int d0 = 0; d0 < 4; ++d0) q[d0] = *(const bf16x8*)(Q + (size_t)qrow * 512 + h * 128 + mp * 64 + d0 * 16 + hi * 8);
    f32x16 O[4];
#pragma unroll
    for (int b = 0; b < 4; ++b)
#pragma unroll
        for (int r = 0; r < 16; ++r) O[b][r] = 0.f;
    float mx = -INFINITY, ls = 0.f;
    const float qh = (float)(16 + qb * 128 + rg * 32 + r32 - 4 * hi);
    const float nslope = -exp2f(-2.0f * (float)(h + 1)) * LOG2E;
    const int kr0 = tid >> 4, kc = tid & 15, vn0 = tid >> 3, vc = tid & 7;
    u32x4 kreg[2], vreg[2];
    const unsigned kgo = (unsigned)((kr0 * 512 + h * 128 + kc * 8) * 2), vgo = (unsigned)(((h * 128 + vn0) * ROWS + vc * 8) * 2);
    const unsigned klo = (unsigned)(kr0 * AT_KSTR + kc * 16), vlo = (unsigned)(AT_KSZ + vn0 * AT_VSTR + vc * 16);
#define AT_GLOAD(j) do { const int m0_ = (j) == 0 ? METAROW : base + 64 * ((j) - 1); \
        const unsigned char* kt_ = (const unsigned char*)KB + (size_t)m0_ * 1024; const unsigned char* vt_ = (const unsigned char*)VT + (size_t)m0_ * 2; \
        kreg[0] = *(const u32x4*)(kt_ + kgo); kreg[1] = *(const u32x4*)(kt_ + 32 * 1024 + kgo); \
        vreg[0] = *(const u32x4*)(vt_ + vgo); vreg[1] = *(const u32x4*)(vt_ + (size_t)64 * ROWS * 2 + vgo); } while (0)
#define AT_LSTORE(buf) do { LAS unsigned char* kb_ = lds + (buf) * AT_BUF; \
        *(LAS u32x4*)(kb_ + klo) = kreg[0]; *(LAS u32x4*)(kb_ + klo + 32 * AT_KSTR) = kreg[1]; \
        *(LAS u32x4*)(kb_ + vlo) = vreg[0]; *(LAS u32x4*)(kb_ + vlo + 64 * AT_VSTR) = vreg[1]; } while (0)
    float qn, kn;
    { float ssq = 0.f;
#pragma unroll
      for (int d0 = 0; d0 < 4; ++d0) { float t[8]; unpack8(__builtin_bit_cast(u32x4, q[d0]), t);
#pragma unroll
        for (int e = 0; e < 8; ++e) ssq = fmaf(t[e], t[e], ssq); }
      ssq += __shfl_xor(ssq, 32); qn = sqrtf(ssq) * 1.002f;
      const unsigned* KN = (const unsigned*)(ws + WS_CTL) + CW_KN; float ks = 0.f;
#pragma unroll
      for (int g = 0; g < 8; ++g) ks += fmaxf(__uint_as_float(__hip_atomic_load(KN + s * 64 + h * 16 + mp * 8 + g, __ATOMIC_RELAXED, __HIP_MEMORY_SCOPE_AGENT)), __uint_as_float(__hip_atomic_load(KN + 9 * 64 + h * 16 + mp * 8 + g, __ATOMIC_RELAXED, __HIP_MEMORY_SCOPE_AGENT)));
      kn = sqrtf(ks) * 1.002f; }
    const int jc0 = 1 + qb * 2;
    int jlo = jc0, jhi = jc0 + 1;
    LAS float* red = (LAS float*)(lds + 2 * AT_BUF);
#pragma unroll 1
    for (int ph = 0; ph < 2; ++ph) {
        int nleft, ntl;
        if (ph == 0) { nleft = 0; ntl = 2; }
        else {
            float dneed = (qn * kn - mx + 40.0f) / (-nslope);
#pragma unroll
            for (int o = 1; o < 64; o <<= 1) dneed = fmaxf(dneed, __shfl_xor(dneed, o));
            if (lane == 0) red[wid] = dneed;
            __syncthreads();
            float dm = red[0];
#pragma unroll
            for (int w8 = 1; w8 < 8; ++w8) dm = fmaxf(dm, red[w8]);
            dm = fminf(fmaxf(dm, 0.f), 1.0e6f);
            const int dmax = (int)dm + 1, q0 = 16 + qb * 128;
            const int plo = q0 - dmax, phi = q0 + 127 + dmax;
            jlo = plo < 16 ? 0 : 1 + ((plo - 16) >> 6); jhi = phi >= L + 16 ? NT - 1 : 1 + ((phi - 16) >> 6);
            if (jlo > jc0) jlo = jc0; if (jhi < jc0 + 1) jhi = jc0 + 1;
            nleft = jc0 - jlo; ntl = nleft + (jhi - jc0 - 1);
        }
        if (ntl > 0) {
#define AT_J(t) (ph == 0 ? jc0 + (t) : ((t) < nleft ? jlo + (t) : jc0 + 2 + ((t) - nleft)))
        { const int jf = AT_J(0); AT_GLOAD(jf); } AT_LSTORE(0); __syncthreads();
#pragma unroll 1
        for (int t = 0; t < ntl; ++t) {
            const int j = AT_J(t);
            if (t + 1 < ntl) { const int jn = AT_J(t + 1); AT_GLOAD(jn); }
            const LAS unsigned char* Kb = lds + (t & 1) * AT_BUF + mp * 128; const LAS unsigned char* Vb = lds + (t & 1) * AT_BUF + AT_KSZ;
            const float dq = qh - (float)(j == 0 ? 0 : 64 * j - 48);
            f32x16 p0, p1;
#pragma unroll
            for (int r = 0; r < 16; ++r) { p0[r] = 0.f; p1[r] = 0.f; }
            {
                bf16x8 ka[4], kb[4];
#pragma unroll
                for (int d0 = 0; d0 < 4; ++d0) { ka[d0] = *(const LAS bf16x8*)(Kb + r32 * AT_KSTR + d0 * 32 + hi * 16); kb[d0] = *(const LAS bf16x8*)(Kb + (32 + r32) * AT_KSTR + d0 * 32 + hi * 16); }
                __builtin_amdgcn_sched_barrier(0);
#pragma unroll
                for (int d0 = 0; d0 < 4; ++d0) { p0 = mfma32(ka[d0], q[d0], p0); p1 = mfma32(kb[d0], q[d0], p1); }
            }
#pragma unroll
            for (int r = 0; r < 16; ++r) { const float dd = dq - (float)((r & 3) + 8 * (r >> 2)); p0[r] = fmaf(fabsf(dd), nslope, p0[r]); p1[r] = fmaf(fabsf(dd - 32.f), nslope, p1[r]); }
            if (j == 0) {
#pragma unroll
                for (int r = 0; r < 16; ++r) { if ((r & 3) + 8 * (r >> 2) + 4 * hi >= 16) p0[r] = -INFINITY; p1[r] = -INFINITY; }
            }
            float rm = fmaxf(p0[0], p1[0]);
#pragma unroll
            for (int r = 1; r < 16; ++r) rm = fmaxf(rm, fmaxf(p0[r], p1[r]));
            rm = fmaxf(rm, __shfl_xor(rm, 32));
            if (__any(rm > mx - 38.0f)) {
            const float mn = fmaxf(mx, rm);
            if (__any(mn > mx)) {
                const float f = __builtin_amdgcn_exp2f(mx - mn); ls *= f; mx = mn;
#pragma unroll
                for (int b = 0; b < 4; ++b)
#pragma unroll
                    for (int r = 0; r < 16; ++r) O[b][r] *= f;
            }
            float sum = 0.f;
#pragma unroll
            for (int r = 0; r < 16; ++r) { p0[r] = __builtin_amdgcn_exp2f(p0[r] - mx); p1[r] = __builtin_amdgcn_exp2f(p1[r] - mx); sum += p0[r] + p1[r]; }
            ls += sum;
            bf16x8 pf[4];
#pragma unroll
            for (int k2 = 0; k2 < 2; ++k2) {
                u32x4 w0, w1;
                w0.x = cvtpk(p0[8 * k2 + 0], p0[8 * k2 + 1]); w0.y = cvtpk(p0[8 * k2 + 2], p0[8 * k2 + 3]); w0.z = cvtpk(p0[8 * k2 + 4], p0[8 * k2 + 5]); w0.w = cvtpk(p0[8 * k2 + 6], p0[8 * k2 + 7]);
                w1.x = cvtpk(p1[8 * k2 + 0], p1[8 * k2 + 1]); w1.y = cvtpk(p1[8 * k2 + 2], p1[8 * k2 + 3]); w1.z = cvtpk(p1[8 * k2 + 4], p1[8 * k2 + 5]); w1.w = cvtpk(p1[8 * k2 + 6], p1[8 * k2 + 7]);
                pf[k2] = __builtin_bit_cast(bf16x8, w0); pf[2 + k2] = __builtin_bit_cast(bf16x8, w1);
            }
            {
                u32x4 vcur[4], vnxt[4];
#define AT_VLOAD(dst, ks_) do { _Pragma("unroll") for (int b_ = 0; b_ < 4; ++b_) { const LAS unsigned char* vp_ = Vb + (b_ * 32 + r32) * AT_VSTR + (ks_) * 32 + hi * 8; \
                    const u32x2 lo_ = *(const LAS u32x2*)vp_, hh_ = *(const LAS u32x2*)(vp_ + 16); dst[b_].x = lo_.x; dst[b_].y = lo_.y; dst[b_].z = hh_.x; dst[b_].w = hh_.y; } } while (0)
                AT_VLOAD(vcur, 0);
#pragma unroll
                for (int ks = 0; ks < 4; ++ks) {
                    if (ks < 3) AT_VLOAD(vnxt, ks + 1);
                    __builtin_amdgcn_sched_barrier(0);
#pragma unroll
                    for (int b = 0; b < 4; ++b) O[b] = mfma32(__builtin_bit_cast(bf16x8, vcur[b]), pf[ks], O[b]);
                    __builtin_amdgcn_sched_barrier(0);
#pragma unroll
                    for (int b = 0; b < 4; ++b) vcur[b] = vnxt[b];
                }
#undef AT_VLOAD
            }
            }
            if (t + 1 < ntl) AT_LSTORE((t + 1) & 1);
            __syncthreads();
        }
#undef AT_J
        }
    }
#undef AT_GLOAD
#undef AT_LSTORE
    const float lt = ls + __shfl_xor(ls, 32);
    const float inv = (mp ? lam : 1.0f) / lt;
    int lane2 = lane; asm volatile("" : "+v"(lane2));
    const int r32e = lane2 & 31, hie = lane2 >> 5;
    LAS float* ex = (LAS float*)lds + rg * (128 * 32) + hie * 128 + r32e;
    if (mp == 1) {
#pragma unroll
        for (int b = 0; b < 4; ++b)
#pragma unroll
            for (int r = 0; r < 16; ++r) ex[(32 * b + (r & 3) + 8 * (r >> 2)) * 32] = O[b][r] * inv;
    }
    __syncthreads();
    if (mp == 0) {
        float ss = 0.f;
#pragma unroll
        for (int b = 0; b < 4; ++b)
#pragma unroll
            for (int r = 0; r < 16; ++r) { const float o = O[b][r] * inv - ex[(32 * b + (r & 3) + 8 * (r >> 2)) * 32]; O[b][r] = o; ss += o * o; }
        ss += __shfl_xor(ss, 32);
        const float rstd = rsqrtf(ss * (1.0f / 128.0f) + 1e-5f) * 0.8f;
        const float* sg = P->in[I_SUBG] + 4 * hie; bf16* Qo = Q + (size_t)(base + qb * 128 + rg * 32 + r32e) * 512 + h * 128 + 4 * hie;
#pragma unroll
        for (int b = 0; b < 4; ++b)
#pragma unroll
            for (int r4 = 0; r4 < 4; ++r4) {
                const int n = 32 * b + 8 * r4; const f32x4 g = *(const f32x4*)(sg + n);
                u32x2 w; w.x = cvtpk(O[b][4 * r4 + 0] * rstd * g.x, O[b][4 * r4 + 1] * rstd * g.y); w.y = cvtpk(O[b][4 * r4 + 2] * rstd * g.z, O[b][4 * r4 + 3] * rstd * g.w);
                *(u32x2*)(Qo + n) = w;
            }
    }
    __syncthreads();
}

constexpr int SC_R = 0, SC_K = 16384, SC_V = 32768, SC_W = 49152, SC_B = 65536, SC_KK = 81920, SC_Y = 98304, SC_TW = 114688, SC_AD = 123904, SC_MU = 133120;
__device__ __forceinline__ float dpp_add(float v, int ctrl_id) {
    const int x = __float_as_int(v); int y;
    if (ctrl_id == 0) y = __builtin_amdgcn_update_dpp(0, x, 0xB1, 0xf, 0xf, true);
    else if (ctrl_id == 1) y = __builtin_amdgcn_update_dpp(0, x, 0x4E, 0xf, 0xf, true);
    else if (ctrl_id == 2) y = __builtin_amdgcn_update_dpp(0, x, 0x141, 0xf, 0xf, true);
    else y = __builtin_amdgcn_update_dpp(0, x, 0x140, 0xf, 0xf, true);
    return v + __int_as_float(y);
}
template <int LPR> __device__ __forceinline__ float grp_sum(float v) {
    v = dpp_add(v, 0); v = dpp_add(v, 1); v = dpp_add(v, 2);
    if (LPR == 16) v = dpp_add(v, 3);
    return v;
}
#define BAR_LDS() asm volatile("s_waitcnt lgkmcnt(0)\n\ts_barrier" ::: "memory")
__device__ __forceinline__ float fast_sigmoid(float x) { return __builtin_amdgcn_rcpf(1.0f + __builtin_amdgcn_exp2f(-LOG2E * x)); }
__device__ __forceinline__ float fast_tanh(float x) { return 1.0f - 2.0f * __builtin_amdgcn_rcpf(1.0f + __builtin_amdgcn_exp2f(2.0f * LOG2E * x)); }
template <int NRP, int NSW>
__device__ __forceinline__ void scan_unit(LAS unsigned char* lds, KP P, int s, int d, int h, int rp) {
    constexpr int RPB = 64 / NRP, RPW = RPB / NSW, LPR = 64 / RPW, CPL = 64 / LPR;
    static_assert(LPR == 8 || LPR == 16, "scan geometry");
    constexpr bool YDB = (RPB == 16) && (NSW == 4);
    constexpr int YST = YDB ? RPB : 64;
    int tid_ = threadIdx.x; asm volatile("" : "+v"(tid_));
    const int tid = tid_, lane = tid & 63, wid = __builtin_amdgcn_readfirstlane(tid >> 6);
    const int L = seq_len(s), base = seq_base(s), Ltot = L + 16, nchunk = (Ltot + 63) / 64;
    unsigned char* ws = P->ws;
    const bf16* Rb = (const bf16*)(ws + WS_R); const bf16* KAb = (const bf16*)(ws + WS_KA); const bf16* VAb = (const bf16*)(ws + WS_VA); const bf16* Lb = (const bf16*)(ws + WS_L);
    float* CB = (float*)(ws + WS_CB); bf16* YD = (bf16*)((unsigned char*)P->out + 64 * MiB) + (size_t)d * NMAIN * 512;
    LAS float* fS = (LAS float*)lds; LAS float* fV = (LAS float*)(lds + 81920); LAS float* fY = (LAS float*)(lds + SC_Y); LAS float* fMU = (LAS float*)(lds + SC_MU);
#define SCI(sl_, a_, c_) ((sl_) * 320 + (a_) * 64 + (c_))
    for (int i = tid; i < 832; i += NTHREADS) {
        float v;
        if (i < 640) { const int which = i / 320, jj = i % 320, a = jj >> 6, c = jj & 63; const int gi = a < 3 ? a * 512 + h * 64 + c : 1536 + (a - 3) * 64 + c; v = P->in[which ? I_MUN : I_MUP][gi]; }
        else { const int a = (i - 640) >> 6, c = (i - 640) & 63; v = P->in[a == 0 ? I_KK : a == 1 ? I_KA : I_RK][h * 64 + c]; }
        fMU[i] = v;
    }
    const int mat = wid >> 2, ntile = wid & 3;
    const bf16* Wt = (const bf16*)(ws + WS_LORA + (mat ? 131072 : 0)) + ((size_t)d * 512 + h * 64 + ntile * 16 + (lane & 15)) * 64 + (lane >> 4) * 8;
    const bf16x8 bfr0 = *(const bf16x8*)Wt, bfr1 = *(const bf16x8*)(Wt + 32);
    const float bias = P->in[mat ? I_A0 : I_W0][d * 512 + h * 64 + ntile * 16 + (lane & 15)];
    float S[CPL];
#pragma unroll
    for (int j = 0; j < CPL; ++j) S[j] = 0.f;
    const int rowl = lane / LPR, kg = lane % LPR, srow = rp * RPB + wid * RPW + rowl;
    const int slot = tid >> 3, cg8 = (tid & 7) * 8;
    u32x4 raw[5][3];
#define SC_META(c) (d ? ((c) == nchunk - 1) : ((c) == 0))
    const unsigned char* HALO0 = ws + WS_HALO + (size_t)(base >> 6) * 2 * HALO_ROW;
#define SC_LOAD(c) do { const int i_ = 64 * (c) + slot; const bool ok_ = i_ < Ltot; const int p_ = d ? Ltot - 1 - i_ : i_; \
        const unsigned zr_ = (unsigned)(METAROW + 64); \
        if (!SC_META(c)) { const unsigned rc_ = ok_ ? (unsigned)(base + p_ - 16) : zr_; \
            _Pragma("unroll") for (int a_ = 0; a_ < 5; ++a_) { const unsigned char* B_ = (const unsigned char*)(a_ == 0 ? Rb : a_ == 1 ? KAb : a_ == 2 ? VAb : Lb); const unsigned ld_ = a_ < 3 ? 1024u : 512u; \
                const unsigned co_ = (unsigned)(((a_ < 3 ? h * 64 : (a_ - 3) * 64) + cg8) * 2); raw[a_][1] = *(const u32x4*)(B_ + (rc_ * ld_ + co_)); } \
        } else { const bool me_ = ok_ && p_ < 16; const bool hn_ = me_ && p_ == 15; \
            const unsigned rc_ = ok_ ? (unsigned)pos_row(base, p_) : zr_, rp_ = (me_ && p_ > 0) ? (unsigned)(METAROW + p_ - 1) : zr_, rn_ = (me_ && p_ < 15) ? (unsigned)(METAROW + p_ + 1) : zr_; \
            _Pragma("unroll") for (int a_ = 0; a_ < 5; ++a_) { const unsigned char* B_ = (const unsigned char*)(a_ == 0 ? Rb : a_ == 1 ? KAb : a_ == 2 ? VAb : Lb); const unsigned ld_ = a_ < 3 ? 1024u : 512u; \
                const unsigned co_ = (unsigned)(((a_ < 3 ? h * 64 : (a_ - 3) * 64) + cg8) * 2); \
                const unsigned ho_ = (unsigned)(((a_ < 3 ? a_ * 512 + h * 64 : 1536 + (a_ - 3) * 64) + cg8) * 2); \
                raw[a_][0] = *(const u32x4*)(B_ + (rp_ * ld_ + co_)); raw[a_][1] = *(const u32x4*)(B_ + (rc_ * ld_ + co_)); \
                const unsigned char* np_ = hn_ ? HALO0 + ho_ : B_ + (rn_ * ld_ + co_); raw[a_][2] = *(const u32x4*)np_; } } } while (0)
    SC_LOAD(0);
    BAR_LDS();
    for (int c = 0; c < nchunk; ++c) {
        const int nvalid = (Ltot - 64 * c) < 64 ? (Ltot - 64 * c) : 64;
        float rv[8], kv[8];
        if (!SC_META(c)) {
            float vv8[8]; unpack8(raw[0][1], rv); unpack8(raw[1][1], kv); unpack8(raw[2][1], vv8);
            { LAS float* dst = fS + SCI(slot, 4, cg8); *(LAS f32x4*)dst = (f32x4){rv[0], rv[1], rv[2], rv[3]}; *(LAS f32x4*)(dst + 4) = (f32x4){rv[4], rv[5], rv[6], rv[7]}; }
            { LAS float* dst = fV + slot * 64 + cg8; *(LAS f32x4*)dst = (f32x4){vv8[0], vv8[1], vv8[2], vv8[3]}; *(LAS f32x4*)(dst + 4) = (f32x4){vv8[4], vv8[5], vv8[6], vv8[7]}; }
            *(LAS u32x4*)(lds + SC_TW + slot * 144 + cg8 * 2) = raw[3][1];
            *(LAS u32x4*)(lds + SC_AD + slot * 144 + cg8 * 2) = raw[4][1];
        } else {
            const int i1 = 64 * c + slot; const int p1 = d ? Ltot - 1 - i1 : i1; const bool me1 = i1 < Ltot && p1 < 16; const float fm = me1 ? 1.0f : 0.0f;
#pragma unroll
            for (int a = 0; a < 5; ++a) {
                float pv[8], cv[8], nv[8], o[8]; unpack8(raw[a][0], pv); unpack8(raw[a][1], cv); unpack8(raw[a][2], nv);
                const f32x4 mp0 = *(const LAS f32x4*)(fMU + a * 64 + cg8), mp1 = *(const LAS f32x4*)(fMU + a * 64 + cg8 + 4), mn0 = *(const LAS f32x4*)(fMU + 320 + a * 64 + cg8), mn1 = *(const LAS f32x4*)(fMU + 320 + a * 64 + cg8 + 4);
#pragma unroll
                for (int e = 0; e < 8; ++e) { const float mp = fm * (e < 4 ? mp0[e & 3] : mp1[e & 3]), mn = fm * (e < 4 ? mn0[e & 3] : mn1[e & 3]); o[e] = cv[e] + mp * (pv[e] - cv[e]) + mn * (nv[e] - cv[e]); }
                if (a == 0) {
#pragma unroll
                    for (int e = 0; e < 8; ++e) rv[e] = o[e];
                    LAS float* dst = fS + SCI(slot, 4, cg8); *(LAS f32x4*)dst = (f32x4){o[0], o[1], o[2], o[3]}; *(LAS f32x4*)(dst + 4) = (f32x4){o[4], o[5], o[6], o[7]};
                } else if (a == 1) {
#pragma unroll
                    for (int e = 0; e < 8; ++e) kv[e] = o[e];
                } else if (a == 2) {
                    LAS float* dst = fV + slot * 64 + cg8; *(LAS f32x4*)dst = (f32x4){o[0], o[1], o[2], o[3]}; *(LAS f32x4*)(dst + 4) = (f32x4){o[4], o[5], o[6], o[7]};
                } else {
                    if (a == 3) {
#pragma unroll
                        for (int e = 0; e < 8; ++e) o[e] = me1 ? fast_tanh(o[e]) : o[e];
                    }
                    u32x4 w; w.x = cvtpk(o[0], o[1]); w.y = cvtpk(o[2], o[3]); w.z = cvtpk(o[4], o[5]); w.w = cvtpk(o[6], o[7]);
                    *(LAS u32x4*)(lds + (a == 3 ? SC_TW : SC_AD) + slot * 144 + cg8 * 2) = w;
                }
            }
        }
        BAR_LDS();
        if (c + 1 < nchunk) SC_LOAD(c + 1);
        {
            const LAS unsigned char* Ab = lds + (mat ? SC_AD : SC_TW); LAS float* fWB = fS + (mat ? 128 : 64);
#pragma unroll
            for (int mt = 0; mt < 4; ++mt) {
                const bf16x8 a0 = *(const LAS bf16x8*)(Ab + (mt * 16 + (lane & 15)) * 144 + (lane >> 4) * 16);
                const bf16x8 a1 = *(const LAS bf16x8*)(Ab + (mt * 16 + (lane & 15)) * 144 + 64 + (lane >> 4) * 16);
                f32x4 acc = {0.f, 0.f, 0.f, 0.f};
                acc = __builtin_amdgcn_mfma_f32_16x16x32_bf16(a0, bfr0, acc, 0, 0, 0);
                acc = __builtin_amdgcn_mfma_f32_16x16x32_bf16(a1, bfr1, acc, 0, 0, 0);
#pragma unroll
                for (int rg = 0; rg < 4; ++rg) {
                    const int sl = mt * 16 + (lane >> 4) * 4 + rg, col = ntile * 16 + (lane & 15);
                    const float sg = fast_sigmoid(acc[rg] + bias); const float dc = __builtin_amdgcn_exp2f(-0.6065306597126334f * LOG2E * sg);
                    fWB[sl * 320 + col] = mat ? sg : dc;
                }
            }
        }
        BAR_LDS();
        {
            const f32x4 a0 = *(const LAS f32x4*)(fS + SCI(slot, 2, cg8)), a1 = *(const LAS f32x4*)(fS + SCI(slot, 2, cg8 + 4));
            const f32x4 kk0 = *(const LAS f32x4*)(fMU + 640 + cg8), kk1 = *(const LAS f32x4*)(fMU + 640 + cg8 + 4), ka0 = *(const LAS f32x4*)(fMU + 704 + cg8), ka1 = *(const LAS f32x4*)(fMU + 704 + cg8 + 4);
            const f32x4 rk0 = *(const LAS f32x4*)(fMU + 768 + cg8), rk1 = *(const LAS f32x4*)(fMU + 768 + cg8 + 4);
            float kkv[8], kd[8], av[8]; float ssq = 0.f, cs = 0.f;
#pragma unroll
            for (int e = 0; e < 8; ++e) {
                av[e] = e < 4 ? a0[e & 3] : a1[e & 3];
                kkv[e] = kv[e] * (e < 4 ? kk0[e & 3] : kk1[e & 3]); ssq = fmaf(kkv[e], kkv[e], ssq);
                kd[e] = kv[e] * (1.0f + (av[e] - 1.0f) * (e < 4 ? ka0[e & 3] : ka1[e & 3])); cs = fmaf(rv[e] * kd[e], e < 4 ? rk0[e & 3] : rk1[e & 3], cs);
            }
            ssq = grp_sum<8>(ssq); cs = grp_sum<8>(cs);
            const float rs = rsqrtf(fmaxf(ssq, 1e-24f));
#pragma unroll
            for (int e = 0; e < 8; ++e) { kkv[e] *= rs; av[e] *= kkv[e]; }
            LAS float* o1 = fS + SCI(slot, 0, cg8); *(LAS f32x4*)o1 = (f32x4){kkv[0], kkv[1], kkv[2], kkv[3]}; *(LAS f32x4*)(o1 + 4) = (f32x4){kkv[4], kkv[5], kkv[6], kkv[7]};
            LAS float* o2 = fS + SCI(slot, 2, cg8); *(LAS f32x4*)o2 = (f32x4){av[0], av[1], av[2], av[3]}; *(LAS f32x4*)(o2 + 4) = (f32x4){av[4], av[5], av[6], av[7]};
            LAS float* o3 = fS + SCI(slot, 3, cg8); *(LAS f32x4*)o3 = (f32x4){kd[0], kd[1], kd[2], kd[3]}; *(LAS f32x4*)(o3 + 4) = (f32x4){kd[4], kd[5], kd[6], kd[7]};
            if (cg8 == 0 && rp == 0 && slot < nvalid) { const int i2 = 64 * c + slot; const int p2 = d ? Ltot - 1 - i2 : i2; CB[((size_t)d * ROWS + pos_row(base, p2)) * 8 + h] = cs; }
        }
        BAR_LDS();
#define SC_STORE_Y(cc_) do { const int t5_ = tid - 256; if (t5_ >= 0 && t5_ < 128) { const int sl5_ = t5_ >> 1, hf_ = t5_ & 1; const int i5_ = 64 * (cc_) + sl5_; const int p5_ = d ? Ltot - 1 - i5_ : i5_; \
            if (i5_ < Ltot && p5_ >= 16) { const LAS float* yp_ = fY + ((cc_) & 1) * 1024 + sl5_ * 16 + hf_ * 8; const f32x4 y0_ = *(const LAS f32x4*)yp_, y1_ = *(const LAS f32x4*)(yp_ + 4); \
                *(u32x4*)(YD + (size_t)(base + p5_ - 16) * 512 + h * 64 + rp * 16 + hf_ * 8) = pack8(y0_, y1_); } } } while (0)
        if (YDB && wid >= NSW && c > 0) SC_STORE_Y(c - 1);
        if (wid < NSW) {
            typedef float f32x2_ __attribute__((ext_vector_type(2)));
            constexpr int C4 = CPL / 4;
            const LAS float* ps = fS + kg * CPL; const LAS float* pv = fV + srow;
            LAS float* py = YDB ? fY + (c & 1) * 1024 + (srow - rp * RPB) : fY + srow;
            f32x4 nk[C4], nw[C4], nb[C4], nd[C4], nr[C4]; float nv;
#define SC_FETCH(sl_) do { _Pragma("unroll") for (int j_ = 0; j_ < C4; ++j_) { nk[j_] = *(const LAS f32x4*)(ps + (sl_) * 320 + 4 * j_); nw[j_] = *(const LAS f32x4*)(ps + (sl_) * 320 + 64 + 4 * j_); \
                nb[j_] = *(const LAS f32x4*)(ps + (sl_) * 320 + 128 + 4 * j_); nd[j_] = *(const LAS f32x4*)(ps + (sl_) * 320 + 192 + 4 * j_); nr[j_] = *(const LAS f32x4*)(ps + (sl_) * 320 + 256 + 4 * j_); } nv = pv[(sl_) * 64]; } while (0)
            SC_FETCH(0);
            f32x4 rp4[C4];
#pragma unroll
            for (int j = 0; j < C4; ++j) rp4[j] = (f32x4){0.f, 0.f, 0.f, 0.f};
#pragma unroll 16
            for (int sl = 0; sl < nvalid; ++sl) {
                f32x4 ck[C4], cw[C4], cb[C4], cd[C4], cr[C4];
#pragma unroll
                for (int j = 0; j < C4; ++j) { ck[j] = nk[j]; cw[j] = nw[j]; cb[j] = nb[j]; cd[j] = nd[j]; cr[j] = nr[j]; }
                const float vv = nv;
                SC_FETCH(sl + 1 < 64 ? sl + 1 : 63);
                f32x2_ pa = {0.f, 0.f}, ya = {0.f, 0.f};
#pragma unroll
                for (int j = 0; j < C4; ++j)
#pragma unroll
                    for (int e = 0; e < 4; e += 2) { const f32x2_ s2 = {S[4 * j + e], S[4 * j + e + 1]}, k2 = {ck[j][e], ck[j][e + 1]}, r2 = {rp4[j][e], rp4[j][e + 1]}; pa = pa + s2 * k2; ya = ya + s2 * r2; }
                float pp = pa.x + pa.y, yy = ya.x + ya.y;
                pp = dpp_add(pp, 0); yy = dpp_add(yy, 0); pp = dpp_add(pp, 1); yy = dpp_add(yy, 1); pp = dpp_add(pp, 2); yy = dpp_add(yy, 2);
                if (LPR == 16) { pp = dpp_add(pp, 3); yy = dpp_add(yy, 3); }
                py[(sl > 0 ? sl - 1 : 0) * YST] = yy;
#pragma unroll
                for (int j = 0; j < C4; ++j)
#pragma unroll
                    for (int e = 0; e < 4; e += 2) {
                        const f32x2_ b2 = {cb[j][e], cb[j][e + 1]}, d2 = {cd[j][e], cd[j][e + 1]}, w2 = {cw[j][e], cw[j][e + 1]}; f32x2_ s2 = {S[4 * j + e], S[4 * j + e + 1]};
                        const f32x2_ t2 = d2 * vv - b2 * pp; s2 = s2 * w2 + t2; S[4 * j + e] = s2.x; S[4 * j + e + 1] = s2.y; }
#pragma unroll
                for (int j = 0; j < C4; ++j) rp4[j] = cr[j];
            }
            {
                f32x2_ ya = {0.f, 0.f};
#pragma unroll
                for (int j = 0; j < C4; ++j)
#pragma unroll
                    for (int e = 0; e < 4; e += 2) { const f32x2_ s2 = {S[4 * j + e], S[4 * j + e + 1]}, r2 = {rp4[j][e], rp4[j][e + 1]}; ya = ya + s2 * r2; }
                const float yy = grp_sum<LPR>(ya.x + ya.y);
                py[(nvalid - 1) * YST] = yy;
            }
#undef SC_FETCH
        }
        BAR_LDS();
        {
            const int i2 = 64 * c + slot; const int p2 = d ? Ltot - 1 - i2 : i2;
            if (!YDB && slot < nvalid && p2 >= 16 && (cg8 / RPB) == rp) {
                const LAS float* yp = fY + slot * 64 + cg8; const f32x4 y0 = *(const LAS f32x4*)yp, y1 = *(const LAS f32x4*)(yp + 4);
                *(u32x4*)(YD + (size_t)(base + p2 - 16) * 512 + h * 64 + cg8) = pack8(y0, y1);
            }
        }
    }
    if (YDB) SC_STORE_Y(nchunk - 1);
#undef SC_STORE_Y
#undef SC_LOAD
#undef SC_META
#undef SCI
}

__device__ __forceinline__ void rwkv_colmap(unsigned char* ws, int c0, bf16*& buf, int& ld, int& col) {
    if (c0 < 512) { buf = (bf16*)(ws + WS_R); ld = 512; col = c0; }
    else if (c0 < 1024) { buf = (bf16*)(ws + WS_KA); ld = 512; col = c0 - 512; }
    else if (c0 < 1536) { buf = (bf16*)(ws + WS_VA); ld = 512; col = c0 - 1024; }
    else { buf = (bf16*)(ws + WS_L); ld = 256; col = c0 - 1536; }
}
__device__ __forceinline__ void phase_halo(KP P) {
    const int tid = fresh_tid(), lane = tid & 63, wid = tid >> 6; const int gw = blockIdx.x * 8 + wid, NGW = gridDim.x * 8;
    unsigned char* ws = P->ws;
    for (int r = gw; r < (NMAIN / 64) * 2; r += NGW) {
        const int m = (r >> 1) * 64 + ((r & 1) ? 63 : 0);
        for (int j = lane; j < 224; j += 64) { bf16* buf; int ld, col; rwkv_colmap(ws, j * 8, buf, ld, col);
            *(u32x4*)(ws + WS_HALO + (size_t)r * HALO_ROW + j * 16) = *(const u32x4*)(buf + (size_t)m * ld + col); }
    }
}
__device__ __forceinline__ void phase_shift(LAS unsigned char* lds, KP P) {
    const int tid = fresh_tid(), slot = tid >> 3, cg = tid & 7;
    unsigned char* ws = P->ws; const float* mup = P->in[I_MUP]; const float* mun = P->in[I_MUN];
    for (int tile = blockIdx.x; tile < NMAIN / 64; tile += gridDim.x) {
        const int m0 = tile * 64, m = m0 + slot;
        const int ks = m0 < 16384 ? tile : ((m0 - 16384) & 2047) >> 6; const bool first = ks == 0, last = ks == (m0 < 16384 ? 255 : 31);
#pragma unroll 1
        for (int pass = 0; pass < 4; ++pass) {
#pragma unroll
            for (int i = 0; i < 7; ++i) { const int j = cg + 8 * i; bf16* buf; int ld, col; rwkv_colmap(ws, (pass * 56 + j) * 8, buf, ld, col);
                *(LAS u32x4*)(lds + (slot * 56 + j) * 16) = *(const u32x4*)(buf + (size_t)m * ld + col); }
            __syncthreads();
#pragma unroll
            for (int i = 0; i < 7; ++i) {
                const int j = cg + 8 * i, c0 = (pass * 56 + j) * 8; bf16* buf; int ld, col; rwkv_colmap(ws, c0, buf, ld, col);
                const u32x4 z = {0u, 0u, 0u, 0u};
                const u32x4 cu = *(const LAS u32x4*)(lds + (slot * 56 + j) * 16);
                u32x4 pu, nu;
                if (slot > 0) pu = *(const LAS u32x4*)(lds + ((slot - 1) * 56 + j) * 16);
                else pu = first ? *(const u32x4*)(buf + (size_t)(METAROW + 15) * ld + col) : *(const u32x4*)(ws + WS_HALO + (size_t)((tile - 1) * 2 + 1) * HALO_ROW + c0 * 2);
                if (slot < 63) nu = *(const LAS u32x4*)(lds + ((slot + 1) * 56 + j) * 16);
                else nu = last ? z : *(const u32x4*)(ws + WS_HALO + (size_t)((tile + 1) * 2) * HALO_ROW + c0 * 2);
                float pv[8], cv[8], nv[8], o[8]; unpack8(pu, pv); unpack8(cu, cv); unpack8(nu, nv);
                const f32x4 mp0 = *(const f32x4*)(mup + c0), mp1 = *(const f32x4*)(mup + c0 + 4), mn0 = *(const f32x4*)(mun + c0), mn1 = *(const f32x4*)(mun + c0 + 4);
#pragma unroll
                for (int e = 0; e < 8; ++e) { const float mp = e < 4 ? mp0[e & 3] : mp1[e & 3], mn = e < 4 ? mn0[e & 3] : mn1[e & 3]; o[e] = cv[e] + mp * (pv[e] - cv[e]) + mn * (nv[e] - cv[e]); }
                if (c0 >= 1536 && c0 < 1600) {
#pragma unroll
                    for (int e = 0; e < 8; ++e) o[e] = fast_tanh(o[e]);
                }
                u32x4 w; w.x = cvtpk(o[0], o[1]); w.y = cvtpk(o[2], o[3]); w.z = cvtpk(o[4], o[5]); w.w = cvtpk(o[6], o[7]);
                *(u32x4*)(buf + (size_t)m * ld + col) = w;
            }
            __syncthreads();
        }
    }
}

__device__ __forceinline__ void phase_post(LAS unsigned char* lds, KP P) {
    const int tid = fresh_tid(), lane = tid & 63, wid = tid >> 6;
    unsigned char* ws = P->ws;
    const bf16* VAb = (const bf16*)(ws + WS_VA); const bf16* Lb = (const bf16*)(ws + WS_L); bf16* Rb = (bf16*)(ws + WS_R);
    const float* CB = (const float*)(ws + WS_CB); const bf16* YD0 = (const bf16*)((const unsigned char*)P->out + 64 * MiB); const bf16* YD1 = YD0 + (size_t)NMAIN * 512;
    const bf16* GT = (const bf16*)(ws + WS_LORA + 262144);
    LAS float* st = (LAS float*)(lds + 17408);
    const float* mup = P->in[I_MUP]; const float* mun = P->in[I_MUN];
    for (int tile = blockIdx.x; tile < NMAIN / 64; tile += gridDim.x) {
        {
            const int row = tid >> 3, hh = tid & 7, m = tile * 64 + row;
            const int t = m < 16384 ? m : (m - 16384) & 2047, Ls = m < 16384 ? 16384 : 2048;
            float sum = 0.f, sq = 0.f;
#pragma unroll
            for (int i = 0; i < 8; ++i) { float a[8], b[8]; unpack8(*(const u32x4*)(YD0 + (size_t)m * 512 + hh * 64 + i * 8), a); unpack8(*(const u32x4*)(YD1 + (size_t)m * 512 + hh * 64 + i * 8), b);
#pragma unroll
                for (int e = 0; e < 8; ++e) { const float y = a[e] + b[e]; sum += y; sq += y * y; } }
            const float mu = sum * (1.0f / 64.0f); const float var = fmaxf(sq * (1.0f / 64.0f) - mu * mu, 0.f);
            st[(row * 8 + hh) * 2] = mu; st[(row * 8 + hh) * 2 + 1] = rsqrtf(var + 64e-5f);
#pragma unroll
            for (int i = 0; i < 2; ++i) {
                const int c0 = 128 + hh * 16 + i * 8; float cv[8], o[8];
                unpack8(*(const u32x4*)(Lb + (size_t)m * 256 + c0), cv);
#pragma unroll
                for (int e = 0; e < 8; ++e) o[e] = sigmoidf_(cv[e]);
                u32x4 w; w.x = cvtpk(o[0], o[1]); w.y = cvtpk(o[2], o[3]); w.z = cvtpk(o[4], o[5]); w.w = cvtpk(o[6], o[7]);
                *(LAS u32x4*)(lds + row * 272 + (hh * 16 + i * 8) * 2) = w;
            }
        }
        __syncthreads();
#pragma unroll 1
        for (int nt = 0; nt < 4; ++nt) {
            const int col = wid * 64 + nt * 16 + (lane & 15);
            bf16x8 bfr[4];
#pragma unroll
            for (int ks = 0; ks < 4; ++ks) bfr[ks] = *(const bf16x8*)(GT + (size_t)col * 128 + ks * 32 + (lane >> 4) * 8);
            const float lw = P->in[I_LNW][col], lb = P->in[I_LNB][col];
            const float mpv = mup[1024 + col], mnv = mun[1024 + col];
#pragma unroll 1
            for (int mt = 0; mt < 4; ++mt) {
                f32x4 acc = {0.f, 0.f, 0.f, 0.f};
#pragma unroll
                for (int ks = 0; ks < 4; ++ks) { const bf16x8 a = *(const LAS bf16x8*)(lds + (mt * 16 + (lane & 15)) * 272 + ks * 64 + (lane >> 4) * 16); acc = __builtin_amdgcn_mfma_f32_16x16x32_bf16(a, bfr[ks], acc, 0, 0, 0); }
#pragma unroll
                for (int rg = 0; rg < 4; ++rg) {
                    const int row = mt * 16 + (lane >> 4) * 4 + rg, m = tile * 64 + row;
                    const int t = m < 16384 ? m : (m - 16384) & 2047, Ls = m < 16384 ? 16384 : 2048;
                    const float y = bf2f(YD0[(size_t)m * 512 + col]) + bf2f(YD1[(size_t)m * 512 + col]);
                    const float yn = (y - st[(row * 8 + wid) * 2]) * st[(row * 8 + wid) * 2 + 1] * lw + lb;
                    const float vs = bf2f(VAb[(size_t)m * 512 + col]);
                    const float cb = CB[(size_t)m * 8 + wid] + CB[((size_t)ROWS + m) * 8 + wid];
                    Rb[(size_t)m * 512 + col] = (bf16)f2bf_rne((yn + cb * vs) * acc[rg]);
                }
            }
        }
        __syncthreads();
    }
}

__device__ __forceinline__ void phase_rms_bf16(KP P) {
    const int tid = fresh_tid(), lane = tid & 63, wid = tid >> 6; const int gw = blockIdx.x * 8 + wid, NGW = gridDim.x * 8;
    bf16* MN = (bf16*)(P->ws + WS_MN);
    for (int m = gw; m < NMAIN; m += NGW) rms_row_bf16(P->out + (size_t)m * DM, P->in[I_GFFN], MN + (size_t)m * DM, lane);
}
__device__ __forceinline__ void phase_final(KP P) {
    const int tid = fresh_tid(), lane = tid & 63, wid = tid >> 6; const int gw = blockIdx.x * 8 + wid, NGW = gridDim.x * 8;
    const f32x4* gr = (const f32x4*)P->in[I_GFIN] + lane;
    for (int m = gw; m < NMAIN; m += NGW) {
        f32x4* xr = (f32x4*)(P->out + (size_t)m * DM) + lane; f32x4 v[4]; float s = 0.f;
#pragma unroll
        for (int j = 0; j < 4; ++j) { v[j] = xr[64 * j]; s += (v[j].x * v[j].x + v[j].y * v[j].y) + (v[j].z * v[j].z + v[j].w * v[j].w); }
        const float rstd = rsqrtf(wave_sum(s) * (1.f / DM) + 1e-6f);
#pragma unroll
        for (int j = 0; j < 4; ++j) xr[64 * j] = v[j] * rstd * gr[64 * j];
    }
}

constexpr int NRP_LONG = 4;
constexpr int N_LONG = 16 * NRP_LONG, N_ATT_P = 512, N_ATT_S = 512, N_SHORT = 128, N_ITEMS = N_LONG + N_ATT_P + N_ATT_S + N_SHORT;

template <class Op> __device__ __forceinline__ void run_gemm(LAS unsigned char* lds, const bf16* A, const bf16* Bt, int M, int N, int K, const Op& op, const bf16* A2 = nullptr, int pm2 = 1 << 30) {
    pg8::Gemm g{A, Bt, M, N, K, A2, pm2}; pg8::StaticOrder S; S.init(M, N, (int)gridDim.x, (int)blockIdx.x);
    Epi8<Op> E{op};
    pg8::gemm_phase<Epi8<Op>, pg8::StaticOrder, true, true>(lds, g, S, E);
}

constexpr size_t WS_XBAR = 16384;
#define XB_TMO      128
#define XB_XCNT(j)  (256  + 64 * (j))
#define XB_XSUB(j)  (1280 + 64 * (j))
#define XB_XGEN(j)  (2304 + 64 * (j))
#define XB_TOP      3328
#define XB_TOPGEN   3392
#define XCD_BAR_WORDS 3456
#define XB_SPIN_CAP (1u << 18)
__device__ __forceinline__ unsigned xb_ld(unsigned* p)              { return __hip_atomic_load(p, __ATOMIC_RELAXED, __HIP_MEMORY_SCOPE_AGENT); }
__device__ __forceinline__ unsigned xb_add(unsigned* p, unsigned v) { return __hip_atomic_fetch_add(p, v, __ATOMIC_RELAXED, __HIP_MEMORY_SCOPE_AGENT); }
__device__ __forceinline__ unsigned xb_xcc_id() { return (unsigned)__builtin_amdgcn_s_getreg((3 << 11) | 20) & 0xFu; }
#define XB_SPIN(cond, bar) do { unsigned _sp = 0; while (cond) { __builtin_amdgcn_s_sleep(1); \
    if ((++_sp & 255u) == 0u) { if (xb_ld(&(bar)[XB_TMO])) break; if (_sp > XB_SPIN_CAP) { atomicAdd(&(bar)[XB_TMO], 1u); break; } } } } while (0)
struct XcdBarrier { unsigned* bar; unsigned x; volatile LAS unsigned* st; };
__device__ __forceinline__ XcdBarrier xcd_barrier_post(unsigned* bar, volatile LAS unsigned* st) {
    XcdBarrier b; b.bar = bar; b.x = xb_xcc_id(); b.st = st;
    if (threadIdx.x == 0) (void)xb_add(&bar[XB_XCNT(b.x)], 1u);
    return b;
}
__device__ __forceinline__ void xcd_barrier_complete(unsigned* bar, unsigned x, unsigned& nloc, unsigned& nx) {
    const unsigned G = gridDim.x * gridDim.y * gridDim.z;
    unsigned sum, cnt, mine, sp = 0u;
    for (;;) {
        sum = 0u; cnt = 0u; mine = 0u;
#pragma unroll
        for (unsigned j = 0; j < 16; ++j) { const unsigned c = xb_ld(&bar[XB_XCNT(j)]); sum += c; cnt += (c > 0u) ? 1u : 0u; mine = (j == x) ? c : mine; }
        if (sum == G) break;
        __builtin_amdgcn_s_sleep(1);
        if ((++sp & 255u) == 0u) { if (xb_ld(&bar[XB_TMO])) break; if (sp > XB_SPIN_CAP) { atomicAdd(&bar[XB_TMO], 1u); break; } }
    }
    nloc = mine > 0u ? mine : 1u; nx = cnt > 0u ? cnt : 1u;
}
__device__ __forceinline__ void xcd_barrier(const XcdBarrier& b) {
    asm volatile("s_waitcnt vmcnt(0)" ::: "memory");
    __syncthreads();
    if (threadIdx.x == 0) {
        unsigned* bar = b.bar;
        __builtin_amdgcn_s_waitcnt(0);
        unsigned nloc = b.st[0], nx = b.st[1];
        if (nloc == 0u) { xcd_barrier_complete(bar, b.x, nloc, nx); b.st[0] = nloc; b.st[1] = nx; }
        const unsigned old = xb_add(&bar[XB_XSUB(b.x)], 1u);
        const unsigned gen = old / nloc;
        if (old + 1u == (gen + 1u) * nloc) {
            __builtin_amdgcn_fence(__ATOMIC_RELEASE, "agent");
            asm volatile("s_waitcnt vmcnt(0)" ::: "memory");
            const unsigned og = xb_add(&bar[XB_TOP], 1u);
            const unsigned tg = og / nx;
            if (og + 1u == (tg + 1u) * nx) xb_add(&bar[XB_TOPGEN], 1u);
            else XB_SPIN(xb_ld(&bar[XB_TOPGEN]) == tg, bar);
            __builtin_amdgcn_fence(__ATOMIC_ACQUIRE, "agent");
            xb_add(&bar[XB_XGEN(b.x)], 1u);
            asm volatile("s_waitcnt vmcnt(0)" ::: "memory");
        } else {
            XB_SPIN(xb_ld(&bar[XB_XGEN(b.x)]) == gen, bar);
            __builtin_amdgcn_fence(__ATOMIC_ACQUIRE, "agent");
            asm volatile("s_waitcnt vmcnt(0)" ::: "memory");
        }
    }
    __syncthreads();
}
#ifndef PROBE_MASK
#define PROBE_MASK 0
#endif
#ifndef PROBE_MUL
#define PROBE_MUL 1
#endif
#define PH_BEGIN(k) unsigned long long t0_##k = 0; if (PROBE_MASK & (1 << (k))) t0_##k = __builtin_amdgcn_s_memrealtime();
#define PH_END(k) if (PROBE_MASK & (1 << (k))) { const unsigned long long t1_ = __builtin_amdgcn_s_memrealtime(); const unsigned long long dt_ = (t1_ - t0_##k) * PROBE_MUL; while (__builtin_amdgcn_s_memrealtime() - t1_ < dt_) __builtin_amdgcn_s_sleep(8); xcd_barrier(xbar); }
__global__ void __launch_bounds__(NTHREADS) fwd_megakernel(Params Pin) {
    extern __shared__ __attribute__((aligned(16))) unsigned char lds_raw[];
    LAS unsigned char* lds = (LAS unsigned char*)lds_raw;
    cg::grid_group grid = cg::this_grid();
    KP P0 = (KP)__builtin_amdgcn_kernarg_segment_ptr();
    volatile LAS unsigned* xst = (volatile LAS unsigned*)(lds + LDS_ITEM_OFF + 4);
    if (threadIdx.x == 0) { xst[0] = 0u; xst[1] = 0u; }
    __syncthreads();
    const XcdBarrier xbar = xcd_barrier_post((unsigned*)(P0->ws + WS_XBAR), xst);
#define NEWPHASE KP P = P0; asm volatile("" : "+s"(P)); unsigned char* ws = P->ws; (void)ws;

    PH_BEGIN(0)
    { NEWPHASE phase_prologue(lds, P); }
    grid.sync();
    PH_END(0)
    PH_BEGIN(1)
    { NEWPHASE run_gemm(lds, (const bf16*)P->out, (const bf16*)(ws + WS_WIN), ROWS, 3328, 1024, OpProj{ws}, (const bf16*)(ws + WS_XNMETA), 128); }
    xcd_barrier(xbar);
    PH_END(1)
    { NEWPHASE phase_halo(P); }
    xcd_barrier(xbar);
    { NEWPHASE phase_shift(lds, P); }
    xcd_barrier(xbar);
    PH_BEGIN(2)
    { NEWPHASE
        const int tid = fresh_tid();
        float lam;
        { const int lane = tid & 63; const float s1 = wave_sum(P->in[I_LQ1][lane] * P->in[I_LK1][lane]), s2 = wave_sum(P->in[I_LQ2][lane] * P->in[I_LK2][lane]); lam = __expf(s1) - __expf(s2) + 0.2f; }
        unsigned* ctr = (unsigned*)(ws + WS_CTL);
        LAS unsigned* slot = (LAS unsigned*)(lds + LDS_ITEM_OFF);
#define FETCH(k, n) if (tid == 0) *slot = atomicAdd(ctr + 64 * (k), 1u); __syncthreads(); const int idx = (int)*slot; __syncthreads(); if (idx >= (n)) break;
#ifndef NO_SCAN
#pragma unroll 1
        for (;;) { FETCH(0, N_LONG) const int u = idx / NRP_LONG; scan_unit<NRP_LONG, 4>(lds, P, 0, u >> 3, u & 7, idx % NRP_LONG); }
#endif
#ifndef NO_ATTN
#pragma unroll 1
        for (;;) { FETCH(1, N_ATT_P + N_ATT_S)
            if (idx < N_ATT_P) attn_unit(lds, P, 0, idx >> 7, idx & 127, lam);
            else { const int a = idx - N_ATT_P; attn_unit(lds, P, 1 + (a >> 6), (a >> 4) & 3, a & 15, lam); } }
#endif
#ifndef NO_SCAN
#pragma unroll 1
        for (;;) { FETCH(2, N_SHORT) scan_unit<1, 8>(lds, P, 1 + (idx >> 4), (idx >> 3) & 1, idx & 7, 0); }
#endif
#undef FETCH
    }
    xcd_barrier(xbar);
    PH_END(2)
#ifndef NO_POST
    PH_BEGIN(3)
    { NEWPHASE phase_post(lds, P); }
#endif
    xcd_barrier(xbar);
    PH_END(3)
    PH_BEGIN(4)
    { NEWPHASE run_gemm(lds, (const bf16*)P->out, (const bf16*)(ws + WS_WIN) + (size_t)3328 * 1024, NMAIN, 1024, 1024, OpGate{(bf16*)(ws + WS_GA)}); }
    { NEWPHASE run_gemm(lds, (const bf16*)P->out, (const bf16*)(ws + WS_WIN) + (size_t)4352 * 1024, NMAIN, 1024, 1024, OpGate{(bf16*)(ws + WS_GB)}); }

    PH_END(4)
    PH_BEGIN(5)
    { NEWPHASE run_gemm(lds, (const bf16*)(ws + WS_R), (const bf16*)(ws + WS_WUPA), NMAIN, 1024, 512, OpUpA{ws}); }
    PH_END(5)
    PH_BEGIN(6)
    { NEWPHASE run_gemm(lds, (const bf16*)(ws + WS_Q), (const bf16*)(ws + WS_WUPB), NMAIN, 1024, 512, OpUpB{ws}); }
    xcd_barrier(xbar);
    PH_END(6)
    PH_BEGIN(7)
    { NEWPHASE run_gemm(lds, (const bf16*)(ws + WS_GB), (const bf16*)(ws + WS_WOUT), NMAIN, 1024, 1024, OpOut{P->in[I_XP], P->in[I_XS], P->out}); }
    xcd_barrier(xbar);
    PH_END(7)
    PH_BEGIN(8)
    { NEWPHASE phase_rms_bf16(P); }
    xcd_barrier(xbar);
    PH_END(8)
    PH_BEGIN(9)
    { NEWPHASE run_gemm(lds, (const bf16*)(ws + WS_MN), (const bf16*)(ws + WS_WFF1), 16384, DFF, 1024, OpFF1{(bf16*)(ws + WS_HID)}); }
    xcd_barrier(xbar);
    PH_END(9)
    PH_BEGIN(10)
    { NEWPHASE run_gemm(lds, (const bf16*)(ws + WS_HID), (const bf16*)(ws + WS_WFF2), 16384, 1024, DFF, OpFF2{P->out}); }
    xcd_barrier(xbar);
    PH_END(10)
    PH_BEGIN(11)
    { NEWPHASE run_gemm(lds, (const bf16*)(ws + WS_MN) + (size_t)16384 * DM, (const bf16*)(ws + WS_WFF1), 16384, DFF, 1024, OpFF1{(bf16*)(ws + WS_HID)}); }
    xcd_barrier(xbar);
    PH_END(11)
    PH_BEGIN(12)
    { NEWPHASE run_gemm(lds, (const bf16*)(ws + WS_HID), (const bf16*)(ws + WS_WFF2), 16384, 1024, DFF, OpFF2{P->out + (size_t)16384 * DM}); }
    xcd_barrier(xbar);
    PH_END(12)
    PH_BEGIN(13)
    { NEWPHASE phase_final(P); }
}

extern "C" void kernel_launch(void* const* d_in, const int* in_sizes, int n_in, void* d_out, int out_size, void* d_ws, size_t ws_size, hipStream_t stream) {
    static int grid_blocks = 0;
    if (grid_blocks == 0) {
        int dev = 0, cus = 0, per_cu = 0;
        hipGetDevice(&dev);
        hipDeviceGetAttribute(&cus, hipDeviceAttributeMultiprocessorCount, dev);
        hipFuncSetAttribute((const void*)fwd_megakernel, hipFuncAttributeMaxDynamicSharedMemorySize, LDS_BYTES);
        hipOccupancyMaxActiveBlocksPerMultiprocessor(&per_cu, (const void*)fwd_megakernel, NTHREADS, LDS_BYTES);
        if (per_cu < 1) { fprintf(stderr, "kernel_launch: occupancy query says %d blocks per CU\n", per_cu); per_cu = 1; }
        grid_blocks = cus * per_cu;
        if (n_in != 29 || ws_size < WS_END) fprintf(stderr, "kernel_launch: unexpected n_in %d / ws_size %zu\n", n_in, ws_size);
    }
    hipMemsetAsync((unsigned char*)d_ws + WS_CTL, 0, 32768, stream);
    Params p{};
    for (int i = 0; i < 29; ++i) p.in[i] = (const float*)d_in[i];
    p.out = (float*)d_out; p.ws = (unsigned char*)d_ws;
    void* args[] = {&p};
    hipError_t e = hipLaunchCooperativeKernel((const void*)fwd_megakernel, dim3(grid_blocks), dim3(NTHREADS), args, LDS_BYTES, stream);
    if (e != hipSuccess) fprintf(stderr, "cooperative launch failed: %s (grid %d)\n", hipGetErrorString(e), grid_blocks);
}
```

```cpp
#include <hip/hip_runtime.h>
#include <hip/hip_cooperative_groups.h>
#include <cstdio>
#include <cstdint>
#include <cmath>
namespace cg = cooperative_groups;
__device__ __forceinline__ int fresh_tid() { int t = threadIdx.x; asm volatile("" : "+v"(t)); return t; }
namespace pg8 {
#define PG8_LAS __attribute__((address_space(3)))
typedef unsigned short bf16_t;
typedef short bf16x8 __attribute__((ext_vector_type(8)));
typedef float f32x4 __attribute__((ext_vector_type(4)));
typedef unsigned u32x4 __attribute__((ext_vector_type(4)));
constexpr int BM = 256, BK = 64, HALF = 128, HTB = HALF * BK * 2  , STAGE_BYTES = 8 * HTB, NXCD = 8, WGM = 8;

__host__ __device__ __forceinline__ int lds_byte(int r, int c) { const int st = (r >> 4) * 2 + (c >> 5), rr = r & 15, cc = c & 31, ob = rr * 64 + cc * 2; return st * 1024 + (ob ^ (((ob >> 9) & 1) << 5)); }
__host__ __device__ __forceinline__ void stage_rc(int b, int& R, int& C) { const int st = b / 1024, sb = b % 1024, swz = sb ^ (((sb >> 9) & 1) << 5); R = (st >> 1) * 16 + swz / 64; C = (st & 1) * 32 + (swz % 64) / 2; }
__host__ __device__ __forceinline__ int perm32(int rho) { const int n = rho >> 4, i = rho & 15; return 8 * (i >> 2) + 4 * n + (i & 3); }

struct Unit { int pm, pn; };
struct Gemm { const bf16_t* A; const bf16_t* Bt; int M, N, K; const bf16_t* A2; int pm2; };
__device__ __forceinline__ const char* gemm_abase(const Gemm& g, int pm, size_t tstep) { return pm >= g.pm2 ? (const char*)g.A2 + (size_t)(pm - g.pm2) * tstep : (const char*)g.A + (size_t)pm * tstep; }

struct StaticOrder {
    int nM, nN, nwg, G, c;
    __host__ __device__ void init(int M, int N, int G_, int c_) { nM = M / BM; nN = N / BM; nwg = nM * nN; G = G_; c = c_; }
    __host__ __device__ bool next(int i, Unit& u) const {
        const long L = (long)i * G + c; if (L >= nwg) return false;
        int wgid = (int)L; { const int q = nwg / NXCD, r = nwg % NXCD, xcd = wgid % NXCD, off = wgid / NXCD; wgid = (xcd < r ? xcd * (q + 1) : r * (q + 1) + (xcd - r) * q) + off; }
        const int nig = WGM * nN, gid = wgid / nig, fm = gid * WGM, gsz = (nM - fm) < WGM ? (nM - fm) : WGM;
        u.pm = fm + ((wgid % nig) % gsz); u.pn = (wgid % nig) / gsz; return true;
    }
    __device__ __forceinline__ void a_ready(const Unit&) const {}
    __device__ __forceinline__ void done(const Unit&) const {}
};


template <class Epi, class Sched, bool ALIGN_EPI = false, bool SP2 = false>
__device__ __forceinline__ void gemm_phase(PG8_LAS unsigned char* lds, const Gemm g, const Sched& S, const Epi& E) {
    const int tid = fresh_tid(), wid = __builtin_amdgcn_readfirstlane(tid >> 6), lane = tid & 63, wr = wid >> 2, wc = wid & 3, fr = lane & 15, fq = lane >> 4;
    const int K = g.K, nt = K / BK;
    unsigned voffA[2], voffB[2];
#pragma unroll
    for (int i = 0; i < 2; ++i) { int R, C; stage_rc(tid * 16 + i * 8192, R, C); const int Rb = Epi::PERM ? ((R & ~31) + perm32(R & 31)) : R;
        voffA[i] = (unsigned)(R * K + C) * 2u; voffB[i] = (unsigned)(Rb * K + C) * 2u; }
    const size_t kstep = (size_t)(BK * 2);
    const size_t hstep = (size_t)HALF * K * 2;
    const size_t tstep = 2 * hstep;
    const unsigned ldsw = (unsigned)wid * 1024u;
    const int aoff = lds_byte(wr * 64 + fr, fq * 8), boff = lds_byte(wc * 32 + fr, fq * 8);
#define PG8_SA(b, h) (((b) * 2 + (h)) * HTB)
#define PG8_SB(b, h) ((4 + (b) * 2 + (h)) * HTB)
#define PG8_STAGE(bufoff, gbase, voff) do { _Pragma("unroll") for (int _i = 0; _i < 2; ++_i) \
        __builtin_amdgcn_global_load_lds((const unsigned*)((const char*)(gbase) + (voff)[_i]), (PG8_LAS unsigned*)(lds + (bufoff) + ldsw + _i * 8192), 16, 0, 0); } while (0)
#define PG8_LDA(dst, b, h) do { _Pragma("unroll") for (int m = 0; m < 4; ++m) _Pragma("unroll") for (int k = 0; k < 2; ++k) dst[m][k] = *(const PG8_LAS bf16x8*)(lds + PG8_SA(b, h) + aoff + m * 2048 + k * 1024); } while (0)
#define PG8_LDB(dst, b, h) do { _Pragma("unroll") for (int n = 0; n < 2; ++n) _Pragma("unroll") for (int k = 0; k < 2; ++k) dst[n][k] = *(const PG8_LAS bf16x8*)(lds + PG8_SB(b, h) + boff + n * 2048 + k * 1024); } while (0)
#define PG8_MMA(ai, bj, At, Bt) do { __builtin_amdgcn_s_setprio(1); _Pragma("unroll") for (int m = 0; m < 4; ++m) _Pragma("unroll") for (int n = 0; n < 2; ++n) _Pragma("unroll") for (int k = 0; k < 2; ++k) \
        acc[ai][bj][m][n] = __builtin_amdgcn_mfma_f32_16x16x32_bf16(Bt[n][k], At[m][k], acc[ai][bj][m][n], 0, 0, 0); __builtin_amdgcn_s_setprio(0); } while (0)
#define PG8_WAIT_V(n) asm volatile("s_waitcnt vmcnt(" #n ")" ::: "memory")
#define PG8_WAIT_L(n) asm volatile("s_waitcnt lgkmcnt(" #n ")" ::: "memory")
#define PG8_BAR __builtin_amdgcn_s_barrier()
#define PG8_SCHED __builtin_amdgcn_sched_barrier(0)
    Unit cur, nxt; int ui = 0;
    if (!S.next(0, cur)) return;
    f32x4 acc[2][2][4][2];
#pragma unroll
    for (int a = 0; a < 2; ++a)
#pragma unroll
        for (int b = 0; b < 2; ++b)
#pragma unroll
            for (int m = 0; m < 4; ++m)
#pragma unroll
                for (int n = 0; n < 2; ++n) acc[a][b][m][n] = (f32x4){0.f, 0.f, 0.f, 0.f};
    bf16x8 At[4][2], B0[2][2], B1[2][2];
    const char* cA = gemm_abase(g, cur.pm, tstep); const char* cB = (const char*)g.Bt + (size_t)cur.pn * tstep;
    S.a_ready(cur);
    if constexpr (SP2) {
        PG8_STAGE(PG8_SB(0, 0), cB, voffB); PG8_STAGE(PG8_SB(0, 1), cB + hstep, voffB); PG8_STAGE(PG8_SA(0, 0), cA, voffA); PG8_STAGE(PG8_SA(0, 1), cA + hstep, voffA);
        if (wr == 1) PG8_BAR;
        PG8_WAIT_V(2); PG8_BAR;
        PG8_STAGE(PG8_SB(1, 0), cB + kstep, voffB); PG8_STAGE(PG8_SA(1, 0), cA + kstep, voffA); PG8_STAGE(PG8_SB(1, 1), cB + hstep + kstep, voffB);
        PG8_WAIT_V(6); PG8_BAR;
    } else {
        PG8_STAGE(PG8_SB(0, 0), cB, voffB); PG8_STAGE(PG8_SA(0, 0), cA, voffA); PG8_STAGE(PG8_SB(0, 1), cB + hstep, voffB); PG8_STAGE(PG8_SA(0, 1), cA + hstep, voffA);
        if (wr == 1) PG8_BAR;
        PG8_WAIT_V(4); PG8_BAR;
        PG8_STAGE(PG8_SB(1, 0), cB + kstep, voffB); PG8_STAGE(PG8_SA(1, 0), cA + kstep, voffA); PG8_STAGE(PG8_SB(1, 1), cB + hstep + kstep, voffB);
        PG8_WAIT_V(6); PG8_BAR;
    }
    for (;;) {
        const bool has_next = S.next(ui + 1, nxt);
        const char* nA = has_next ? gemm_abase(g, nxt.pm, tstep) : cA; const char* nB = has_next ? (const char*)g.Bt + (size_t)nxt.pn * tstep : cB;
        for (int t = 0; t < nt; t += 2) {
            const bool last = (t == nt - 2);
            const char* a1 = cA + (size_t)(t + 1) * kstep;
            const char* a2 = last ? nA : cA + (size_t)(t + 2) * kstep; const char* b2 = last ? nB : cB + (size_t)(t + 2) * kstep;
            const char* a3 = a2 + kstep; const char* b3 = b2 + kstep;
            if (last && has_next) S.a_ready(nxt);
            if constexpr (SP2) {
            PG8_LDB(B0, 0, 0); PG8_LDB(B1, 0, 1); PG8_SCHED; PG8_LDA(At, 0, 0); PG8_STAGE(PG8_SA(1, 1), a1 + hstep, voffA);
            PG8_WAIT_V(8); PG8_WAIT_L(0); PG8_BAR; PG8_MMA(0, 0, At, B0); PG8_MMA(0, 1, At, B1); PG8_BAR; PG8_SCHED;
            PG8_LDA(At, 0, 1); PG8_STAGE(PG8_SB(0, 0), b2, voffB); PG8_STAGE(PG8_SB(0, 1), b2 + hstep, voffB); PG8_STAGE(PG8_SA(0, 0), a2, voffA);
            PG8_WAIT_V(8); PG8_WAIT_L(0); PG8_BAR; PG8_MMA(1, 0, At, B0); PG8_MMA(1, 1, At, B1); PG8_BAR; PG8_SCHED;
            PG8_LDB(B0, 1, 0); PG8_LDB(B1, 1, 1); PG8_SCHED; PG8_LDA(At, 1, 0); PG8_STAGE(PG8_SA(0, 1), a2 + hstep, voffA);
            PG8_WAIT_V(8); PG8_WAIT_L(0); PG8_BAR; PG8_MMA(0, 0, At, B0); PG8_MMA(0, 1, At, B1); PG8_BAR; PG8_SCHED;
            PG8_LDA(At, 1, 1); PG8_STAGE(PG8_SB(1, 0), b3, voffB); PG8_STAGE(PG8_SB(1, 1), b3 + hstep, voffB); PG8_STAGE(PG8_SA(1, 0), a3, voffA);
            PG8_WAIT_V(8); PG8_WAIT_L(0); PG8_BAR; PG8_MMA(1, 0, At, B0); PG8_MMA(1, 1, At, B1); PG8_BAR; PG8_SCHED;
            } else {
            PG8_LDB(B0, 0, 0); PG8_SCHED; PG8_LDA(At, 0, 0); PG8_STAGE(PG8_SA(1, 1), a1 + hstep, voffA);
            PG8_WAIT_L(8); PG8_BAR; PG8_WAIT_L(0); PG8_MMA(0, 0, At, B0); PG8_BAR; PG8_SCHED;
            PG8_LDB(B1, 0, 1); PG8_STAGE(PG8_SB(0, 0), b2, voffB);
            PG8_BAR; PG8_WAIT_L(0); PG8_MMA(0, 1, At, B1); PG8_BAR;
            PG8_LDA(At, 0, 1); PG8_STAGE(PG8_SA(0, 0), a2, voffA);
            PG8_BAR; PG8_WAIT_L(0); PG8_MMA(1, 0, At, B0); PG8_BAR; PG8_SCHED;
            PG8_STAGE(PG8_SB(0, 1), b2 + hstep, voffB);
            PG8_WAIT_V(6); PG8_BAR; PG8_MMA(1, 1, At, B1); PG8_BAR;
            PG8_LDB(B0, 1, 0); PG8_SCHED; PG8_LDA(At, 1, 0); PG8_STAGE(PG8_SA(0, 1), a2 + hstep, voffA);
            PG8_WAIT_L(8); PG8_BAR; PG8_WAIT_L(0); PG8_MMA(0, 0, At, B0); PG8_BAR; PG8_SCHED;
            PG8_LDB(B1, 1, 1); PG8_STAGE(PG8_SB(1, 0), b3, voffB);
            PG8_BAR; PG8_WAIT_L(0); PG8_MMA(0, 1, At, B1); PG8_BAR;
            PG8_LDA(At, 1, 1); PG8_STAGE(PG8_SA(1, 0), a3, voffA);
            PG8_BAR; PG8_WAIT_L(0); PG8_MMA(1, 0, At, B0); PG8_BAR; PG8_SCHED;
            PG8_STAGE(PG8_SB(1, 1), b3 + hstep, voffB);
            PG8_WAIT_V(6); PG8_BAR; PG8_MMA(1, 1, At, B1); PG8_BAR;
            }
        }
        if constexpr (ALIGN_EPI) { if (wr == 0) PG8_BAR; }
        if constexpr (!Epi::AFTER_DRAIN) { E(acc, cur, wr, wc, fr, fq); S.done(cur); }
        if (!has_next) break;
#pragma unroll
        for (int a = 0; a < 2; ++a)
#pragma unroll
            for (int b = 0; b < 2; ++b)
#pragma unroll
                for (int m = 0; m < 4; ++m)
#pragma unroll
                    for (int n = 0; n < 2; ++n) acc[a][b][m][n] = (f32x4){0.f, 0.f, 0.f, 0.f};
        cur = nxt; cA = nA; cB = nB; ++ui;
        if constexpr (ALIGN_EPI) { if (wr == 1) PG8_BAR; }
    }
    PG8_WAIT_V(0);
    if constexpr (!ALIGN_EPI) { if (wr == 0) PG8_BAR; }
    PG8_BAR;
    if constexpr (Epi::AFTER_DRAIN) { E.fused(acc, cur, wr, wc, fr, fq, lds, wid, lane); S.done(cur); }
#undef PG8_SA
#undef PG8_SB
#undef PG8_STAGE
#undef PG8_LDA
#undef PG8_LDB
#undef PG8_MMA
#undef PG8_WAIT_V
#undef PG8_WAIT_L
#undef PG8_BAR
#undef PG8_SCHED
}
}

#ifndef PG8_SP2
#define PG8_SP2 true
#endif

#define LAS __attribute__((address_space(3)))
typedef unsigned short bf16;
typedef short bf16x8 __attribute__((ext_vector_type(8)));
typedef float f32x4 __attribute__((ext_vector_type(4)));
typedef float f32x16 __attribute__((ext_vector_type(16)));
typedef unsigned u32x4 __attribute__((ext_vector_type(4)));
typedef unsigned u32x2 __attribute__((ext_vector_type(2)));

constexpr int DM = 1024, NMAIN = 32768, ROWS = 33024, METAROW = 32768, DFF = 4096;
constexpr int NTHREADS = 512;
constexpr int LDS_BYTES = 147456;
constexpr int LDS_ITEM_OFF = LDS_BYTES - 16;
constexpr size_t MiB = 1u << 20;
constexpr size_t WS_CTL = 0, WS_WIN = 1 * MiB, WS_WUPA = 12 * MiB, WS_WUPB = 13 * MiB, WS_WOUT = 14 * MiB, WS_WFF1 = 16 * MiB, WS_WFF2 = 24 * MiB;
constexpr size_t WS_LORA = 32 * MiB, WS_XNMETA = 32 * MiB + 512 * 1024, WS_CB = 33 * MiB, WS_ACT = 36 * MiB;
constexpr size_t ACT_SZ = (size_t)ROWS * 512 * 2, L_SZ = (size_t)ROWS * 256 * 2;
constexpr size_t WS_R = WS_ACT, WS_KA = WS_R + ACT_SZ, WS_VA = WS_KA + ACT_SZ, WS_L = WS_VA + ACT_SZ, WS_Q = WS_L + L_SZ, WS_KB = WS_Q + ACT_SZ, WS_VT = WS_KB + ACT_SZ, WS_END = WS_VT + ACT_SZ;
constexpr size_t WS_GA = WS_KA, WS_GB = WS_KB, WS_MN = WS_ACT, WS_HID = WS_ACT + 64 * MiB;
constexpr size_t WS_HALO = WS_END;
constexpr int HALO_ROW = 3584;
static_assert(WS_HALO + (size_t)(NMAIN / 64) * 2 * HALO_ROW <= 256 * MiB, "halo buffer");
static_assert(WS_END <= 256 * MiB && WS_HID + 128 * MiB <= 256 * MiB && WS_CB + (size_t)2 * ROWS * 8 * 4 <= WS_ACT, "ws map");
constexpr float LOG2E = 1.4426950408889634f;
constexpr float QSCALE = 0.125f * LOG2E;

struct Params { const float* in[29]; float* out; unsigned char* ws; };
typedef const __attribute__((address_space(4))) Params* KP;
enum { I_XP = 0, I_XS, I_META, I_GMIX, I_WIN, I_MUP, I_MUN, I_W0, I_WUP, I_A0, I_AUP, I_GUP, I_KK, I_KA, I_RK, I_LNW, I_LNB, I_LQ1, I_LK1, I_LQ2, I_LK2, I_SUBG, I_UPA, I_UPB, I_WOUT, I_GFFN, I_FF1, I_FF2, I_GFIN };

__device__ __forceinline__ unsigned cvtpk(float lo, float hi) { unsigned r; asm volatile("v_cvt_pk_bf16_f32 %0, %1, %2" : "=v"(r) : "v"(lo), "v"(hi)); return r; }
__device__ __forceinline__ float bf2f(unsigned short b) { return __uint_as_float(((unsigned)b) << 16); }
__device__ __forceinline__ float bflo(unsigned w) { return __uint_as_float(w << 16); }
__device__ __forceinline__ float bfhi(unsigned w) { return __uint_as_float(w & 0xffff0000u); }
__device__ __forceinline__ void unpack8(const u32x4 v, float* o) { o[0] = bflo(v.x); o[1] = bfhi(v.x); o[2] = bflo(v.y); o[3] = bfhi(v.y); o[4] = bflo(v.z); o[5] = bfhi(v.z); o[6] = bflo(v.w); o[7] = bfhi(v.w); }
__device__ __forceinline__ float wave_sum(float v) {
#pragma unroll
    for (int o = 1; o < 64; o <<= 1) v += __shfl_xor(v, o);
    return v;
}
__device__ __forceinline__ float sigmoidf_(float x) { return 1.0f / (1.0f + __expf(-x)); }
__device__ __forceinline__ int seq_base(int s) { return s == 0 ? 0 : 16384 + (s - 1) * 2048; }
__device__ __forceinline__ int seq_len(int s) { return s == 0 ? 16384 : 2048; }
__device__ __forceinline__ int pos_row(int base, int p) { return p < 16 ? METAROW + p : base + p - 16; }

template <class Op> struct Epi8 {
    static constexpr bool PERM = true, AFTER_DRAIN = false;
    Op op;
    __device__ __forceinline__ void operator()(const pg8::f32x4 (&acc)[2][2][4][2], const pg8::Unit& u, int wr, int wc, int fr, int fq) const {
        const int row0 = u.pm * 256 + wr * 64 + fr, col0 = u.pn * 256 + wc * 32 + 8 * fq;
#pragma unroll
        for (int ai = 0; ai < 2; ++ai)
#pragma unroll
            for (int m = 0; m < 4; ++m)
#pragma unroll
                for (int bj = 0; bj < 2; ++bj) { op.apply(row0 + ai * 128 + m * 16, col0 + bj * 128, u.pn, acc[ai][bj][m][0], acc[ai][bj][m][1]); asm volatile("" ::: "memory"); }
    }
};
__device__ __forceinline__ u32x4 pack8(const f32x4 a, const f32x4 b) { u32x4 w; w.x = cvtpk(a[0], a[1]); w.y = cvtpk(a[2], a[3]); w.z = cvtpk(b[0], b[1]); w.w = cvtpk(b[2], b[3]); return w; }

constexpr int CW_KN = 320;
__device__ __forceinline__ float dpp_max16(float v) {
    int x = __float_as_int(v);
    v = fmaxf(v, __int_as_float(__builtin_amdgcn_update_dpp(0, x, 0xB1, 0xf, 0xf, true))); x = __float_as_int(v);
    v = fmaxf(v, __int_as_float(__builtin_amdgcn_update_dpp(0, x, 0x4E, 0xf, 0xf, true))); x = __float_as_int(v);
    v = fmaxf(v, __int_as_float(__builtin_amdgcn_update_dpp(0, x, 0x141, 0xf, 0xf, true))); x = __float_as_int(v);
    v = fmaxf(v, __int_as_float(__builtin_amdgcn_update_dpp(0, x, 0x140, 0xf, 0xf, true)));
    return v;
}
struct OpProj {
    unsigned char* ws;
    __device__ __forceinline__ void apply(int row, int col, int pn, f32x4 v0, f32x4 v1) const {
        if (pn >= 11) {
            bf16* VT = (bf16*)(ws + WS_VT); const int c = col - 11 * 256;
#pragma unroll
            for (int e = 0; e < 4; ++e) { VT[(size_t)(c + e) * ROWS + row] = (bf16)(cvtpk(v0[e], 0.f) & 0xffffu); VT[(size_t)(c + 4 + e) * ROWS + row] = (bf16)(cvtpk(v1[e], 0.f) & 0xffffu); }
            return;
        }
        bf16* O; int ldc = 512, c;
        if (pn < 2) { O = (bf16*)(ws + WS_R); c = col; }
        else if (pn < 4) { O = (bf16*)(ws + WS_KA); c = col - 512; }
        else if (pn < 6) { O = (bf16*)(ws + WS_VA); c = col - 1024; }
        else if (pn < 7) { O = (bf16*)(ws + WS_L); c = col - 1536; ldc = 256; }
        else if (pn < 9) { O = (bf16*)(ws + WS_Q); c = col - 1792; v0 = v0 * QSCALE; v1 = v1 * QSCALE; }
        else { O = (bf16*)(ws + WS_KB); c = col - 2304; }
        const u32x4 w = pack8(v0, v1);
        *(u32x4*)(O + (size_t)row * ldc + c) = w;
        if (pn >= 9) {
            float k8[8]; unpack8(w, k8); float ss = 0.f;
#pragma unroll
            for (int e = 0; e < 8; ++e) ss = fmaf(k8[e], k8[e], ss);
            ss = dpp_max16(ss);
            if ((threadIdx.x & 15) == 0) { const int sidx = row < 16384 ? 0 : row < NMAIN ? 1 + ((row - 16384) >> 11) : 9;
                atomicMax((unsigned*)(ws + WS_CTL) + CW_KN + sidx * 64 + (c >> 3), __float_as_uint(ss)); }
        }
    }
};
struct OpGate {
    bf16* O;
    __device__ __forceinline__ void apply(int row, int col, int pn, f32x4 v0, f32x4 v1) const {
        const int c = col;
#pragma unroll
        for (int e = 0; e < 4; ++e) { v0[e] = sigmoidf_(v0[e]); v1[e] = sigmoidf_(v1[e]); }
        *(u32x4*)(O + (size_t)row * 1024 + c) = pack8(v0, v1);
    }
};
struct OpUpA {
    unsigned char* ws;
    __device__ __forceinline__ void apply(int row, int col, int pn, f32x4 v0, f32x4 v1) const {
        u32x4* p = (u32x4*)((bf16*)(ws + WS_GA) + (size_t)row * 1024 + col); float g[8]; unpack8(*p, g);
#pragma unroll
        for (int e = 0; e < 4; ++e) { v0[e] *= g[e]; v1[e] *= g[4 + e]; }
        *p = pack8(v0, v1);
    }
};
struct OpUpB {
    unsigned char* ws;
    __device__ __forceinline__ void apply(int row, int col, int pn, f32x4 v0, f32x4 v1) const {
        u32x4* p = (u32x4*)((bf16*)(ws + WS_GB) + (size_t)row * 1024 + col); float g[8], a[8]; unpack8(*p, g);
        unpack8(*(const u32x4*)((const bf16*)(ws + WS_GA) + (size_t)row * 1024 + col), a);
#pragma unroll
        for (int e = 0; e < 4; ++e) { v0[e] = a[e] + v0[e] * g[e]; v1[e] = a[4 + e] + v1[e] * g[4 + e]; }
        *p = pack8(v0, v1);
    }
};
struct OpOut {
    const float* xp; const float* xs; float* out;
    __device__ __forceinline__ void apply(int row, int col, int pn, f32x4 v0, f32x4 v1) const {
        const float* x = (row < 16384 ? xp + (size_t)row * DM : xs + (size_t)(row - 16384) * DM) + col;
        float* o = out + (size_t)row * DM + col;
        *(f32x4*)o = *(const f32x4*)x + v0; *(f32x4*)(o + 4) = *(const f32x4*)(x + 4) + v1;
    }
};
struct OpFF1 {
    bf16* hid;
    __device__ __forceinline__ void apply(int row, int col, int pn, f32x4 v0, f32x4 v1) const {
#pragma unroll
        for (int e = 0; e < 4; ++e) { const float a = fmaxf(v0[e], 0.f), b = fmaxf(v1[e], 0.f); v0[e] = a * a; v1[e] = b * b; }
        *(u32x4*)(hid + (size_t)row * DFF + col) = pack8(v0, v1);
    }
};
struct OpFF2 {
    float* out;
    __device__ __forceinline__ void apply(int row, int col, int pn, f32x4 v0, f32x4 v1) const {
        float* o = out + (size_t)row * DM + col;
        *(f32x4*)o = *(const f32x4*)o + v0; *(f32x4*)(o + 4) = *(const f32x4*)(o + 4) + v1;
    }
};

__device__ __forceinline__ unsigned f2bf_rne(float f) { return cvtpk(f, 0.f) & 0xffffu; }
__device__ __forceinline__ void transpose_item(const float* W, int K, int N, bf16* WT, LAS float* scr, int item, int lane) {
    const int nblk = N / 32, kb = item / nblk, nb = item % nblk, k0 = 64 * kb, n0 = 32 * nb;
#pragma unroll 8
    for (int i = 0; i < 32; ++i) { const int kk = 2 * i + (lane >> 5); scr[kk * 33 + (lane & 31)] = W[(size_t)(k0 + kk) * N + n0 + (lane & 31)]; }
    asm volatile("s_waitcnt vmcnt(0) lgkmcnt(0)" ::: "memory");
    const int c = lane & 7;
#pragma unroll
    for (int j = 0; j < 4; ++j) { const int n = (lane >> 3) + 8 * j; const LAS float* s = scr + (8 * c) * 33 + n;
        u32x4 o; o.x = cvtpk(s[0 * 33], s[1 * 33]); o.y = cvtpk(s[2 * 33], s[3 * 33]); o.z = cvtpk(s[4 * 33], s[5 * 33]); o.w = cvtpk(s[6 * 33], s[7 * 33]);
        *(u32x4*)(WT + (size_t)(n0 + n) * K + k0 + 8 * c) = o; }
    asm volatile("s_waitcnt lgkmcnt(0)" ::: "memory");
}
__device__ __forceinline__ void rms_row_bf16(const float* src, const float* g, bf16* dst, int lane) {
    unsigned long long* o8 = (unsigned long long*)dst + lane;
    if (!src) {
#pragma unroll
        for (int j = 0; j < 4; ++j) o8[64 * j] = 0ull;
        return; }
    const f32x4* xr = (const f32x4*)src + lane; const f32x4* gr = (const f32x4*)g + lane;
    f32x4 v[4]; float s = 0.f;
#pragma unroll
    for (int j = 0; j < 4; ++j) { v[j] = xr[64 * j]; s += (v[j].x * v[j].x + v[j].y * v[j].y) + (v[j].z * v[j].z + v[j].w * v[j].w); }
    const float rstd = rsqrtf(wave_sum(s) * (1.f / DM) + 1e-6f);
#pragma unroll
    for (int j = 0; j < 4; ++j) { const f32x4 gg = gr[64 * j]; const f32x4 y = v[j] * rstd * gg;
        o8[64 * j] = (unsigned long long)cvtpk(y.x, y.y) | ((unsigned long long)cvtpk(y.z, y.w) << 32); }
}
__device__ __forceinline__ void phase_prologue(LAS unsigned char* lds, KP P) {
    const int tid = fresh_tid(), lane = tid & 63, wid = tid >> 6;
    LAS float* scr = (LAS float*)(lds + wid * 16384);
    const int gw = blockIdx.x * 8 + wid, NGW = gridDim.x * 8;
    unsigned char* ws = P->ws;
    constexpr int I_IN = (1024 / 64) * (5376 / 32), I_UP = (512 / 64) * (1024 / 32), I_O = (1024 / 64) * (1024 / 32), I_1 = (1024 / 64) * (4096 / 32), I_2 = (4096 / 64) * (1024 / 32);
    constexpr int I_LW = (64 / 64) * (512 / 32), I_G = (128 / 64) * (512 / 32);
    constexpr int NITEMS = I_IN + 2 * I_UP + I_O + I_1 + I_2 + 4 * I_LW + I_G;
    for (int it = gw; it < NITEMS; it += NGW) {
        int r = it;
        if (r < I_IN) { transpose_item(P->in[I_WIN], 1024, 5376, (bf16*)(ws + WS_WIN), scr, r, lane); continue; } r -= I_IN;
        if (r < I_UP) { transpose_item(P->in[I_UPA], 512, 1024, (bf16*)(ws + WS_WUPA), scr, r, lane); continue; } r -= I_UP;
        if (r < I_UP) { transpose_item(P->in[I_UPB], 512, 1024, (bf16*)(ws + WS_WUPB), scr, r, lane); continue; } r -= I_UP;
        if (r < I_O) { transpose_item(P->in[I_WOUT], 1024, 1024, (bf16*)(ws + WS_WOUT), scr, r, lane); continue; } r -= I_O;
        if (r < I_1) { transpose_item(P->in[I_FF1], 1024, 4096, (bf16*)(ws + WS_WFF1), scr, r, lane); continue; } r -= I_1;
        if (r < I_2) { transpose_item(P->in[I_FF2], 4096, 1024, (bf16*)(ws + WS_WFF2), scr, r, lane); continue; } r -= I_2;
        if (r < 2 * I_LW) { const int d = r / I_LW; transpose_item(P->in[I_WUP] + (size_t)d * 64 * 512, 64, 512, (bf16*)(ws + WS_LORA) + (size_t)d * 512 * 64, scr, r % I_LW, lane); continue; } r -= 2 * I_LW;
        if (r < 2 * I_LW) { const int d = r / I_LW; transpose_item(P->in[I_AUP] + (size_t)d * 64 * 512, 64, 512, (bf16*)(ws + WS_LORA + 131072) + (size_t)d * 512 * 64, scr, r % I_LW, lane); continue; } r -= 2 * I_LW;
        transpose_item(P->in[I_GUP], 128, 512, (bf16*)(ws + WS_LORA + 262144), scr, r, lane);
    }
    bf16* XN = (bf16*)P->out; bf16* XM = (bf16*)(ws + WS_XNMETA);
    for (int m = gw; m < ROWS; m += NGW) {
        const float* src = m < 16384 ? P->in[I_XP] + (size_t)m * DM : m < NMAIN ? P->in[I_XS] + (size_t)(m - 16384) * DM : (m - NMAIN < 16 ? P->in[I_META] + (size_t)(m - NMAIN) * DM : nullptr);
        bf16* dst = m < NMAIN ? XN + (size_t)m * DM : XM + (size_t)(m - NMAIN) * DM;
        rms_row_bf16(src, P->in[I_GMIX], dst, lane);
    }
}

constexpr int AT_KSTR = 272, AT_VSTR = 144, AT_KSZ = 64 * AT_KSTR, AT_BUF = AT_KSZ + 128 * AT_VSTR;
__device__ __forceinline__ f32x16 mfma32(bf16x8 a, bf16x8 b, f32x16 c) { return __builtin_amdgcn_mfma_f32_32x32x16_bf16(a, b, c, 0, 0, 0); }
__device__ __forceinline__ void attn_unit(LAS unsigned char* lds, KP P, int s, int h, int qb, float lam) {
    int tid_ = threadIdx.x; asm volatile("" : "+v"(tid_));
    const int tid = tid_, lane = tid & 63, r32 = lane & 31, hi = lane >> 5, wid = __builtin_amdgcn_readfirstlane(tid >> 6), rg = wid & 3, mp = wid >> 2;
    const int L = seq_len(s), base = seq_base(s), NT = 1 + L / 64;
    unsigned char* ws = P->ws;
    const bf16* KB = (const bf16*)(ws + WS_KB); const bf16* VT = (const bf16*)(ws + WS_VT); bf16* Q = (bf16*)(ws + WS_Q);
    const int qrow = base + qb * 128 + rg * 32 + r32;
    bf16x8 q[4];
#pragma unroll
    for (int d0 = 0; d0 < 4; ++d0) q[d0] = *(const bf16x8*)(Q + (size_t)qrow * 512 + h * 128 + mp * 64 + d0 * 16 + hi * 8);
    f32x16 O[4];
#pragma unroll
    for (int b = 0; b < 4; ++b)
#pragma unroll
        for (int r = 0; r < 16; ++r) O[b][r] = 0.f;
    float mx = -INFINITY, ls = 0.f;
    const float qh = (float)(16 + qb * 128 + rg * 32 + r32 - 4 * hi);
    const float nslope = -exp2f(-2.0f * (float)(h + 1)) * LOG2E;
    const int kr0 = tid >> 4, kc = tid & 15, vn0 = tid >> 3, vc = tid & 7;
    u32x4 kreg[2], vreg[2];
    const unsigned kgo = (unsigned)((kr0 * 512 + h * 128 + kc * 8) * 2), vgo = (unsigned)(((h * 128 + vn0) * ROWS + vc * 8) * 2);
    const unsigned klo = (unsigned)(kr0 * AT_KSTR + kc * 16), vlo = (unsigned)(AT_KSZ + vn0 * AT_VSTR + vc * 16);
#define AT_GLOAD(j) do { const int m0_ = (j) == 0 ? METAROW : base + 64 * ((j) - 1); \
        const unsigned char* kt_ = (const unsigned char*)KB + (size_t)m0_ * 1024; const unsigned char* vt_ = (const unsigned char*)VT + (size_t)m0_ * 2; \
        kreg[0] = *(const u32x4*)(kt_ + kgo); kreg[1] = *(const u32x4*)(kt_ + 32 * 1024 + kgo); \
        vreg[0] = *(const u32x4*)(vt_ + vgo); vreg[1] = *(const u32x4*)(vt_ + (size_t)64 * ROWS * 2 + vgo); } while (0)
#define AT_LSTORE(buf) do { LAS unsigned char* kb_ = lds + (buf) * AT_BUF; \
        *(LAS u32x4*)(kb_ + klo) = kreg[0]; *(LAS u32x4*)(kb_ + klo + 32 * AT_KSTR) = kreg[1]; \
        *(LAS u32x4*)(kb_ + vlo) = vreg[0]; *(LAS u32x4*)(kb_ + vlo + 64 * AT_VSTR) = vreg[1]; } while (0)
    float qn, kn;
    { float ssq = 0.f;
#pragma unroll
      for (int d0 = 0; d0 < 4; ++d0) { float t[8]; unpack8(__builtin_bit_cast(u32x4, q[d0]), t);
#pragma unroll
        for (int e = 0; e < 8; ++e) ssq = fmaf(t[e], t[e], ssq); }
      ssq += __shfl_xor(ssq, 32); qn = sqrtf(ssq) * 1.002f;
      const unsigned* KN = (const unsigned*)(ws + WS_CTL) + CW_KN; float ks = 0.f;
#pragma unroll
      for (int g = 0; g < 8; ++g) ks += fmaxf(__uint_as_float(__hip_atomic_load(KN + s * 64 + h * 16 + mp * 8 + g, __ATOMIC_RELAXED, __HIP_MEMORY_SCOPE_AGENT)), __uint_as_float(__hip_atomic_load(KN + 9 * 64 + h * 16 + mp * 8 + g, __ATOMIC_RELAXED, __HIP_MEMORY_SCOPE_AGENT)));
      kn = sqrtf(ks) * 1.002f; }
    const int jc0 = 1 + qb * 2;
    int jlo = jc0, jhi = jc0 + 1;
    LAS float* red = (LAS float*)(lds + 2 * AT_BUF);
#pragma unroll 1
    for (int ph = 0; ph < 2; ++ph) {
        int nleft, ntl;
        if (ph == 0) { nleft = 0; ntl = 2; }
        else {
            float dneed = (qn * kn - mx + 40.0f) / (-nslope);
#pragma unroll
            for (int o = 1; o < 64; o <<= 1) dneed = fmaxf(dneed, __shfl_xor(dneed, o));
            if (lane == 0) red[wid] = dneed;
            __syncthreads();
            float dm = red[0];
#pragma unroll
            for (int w8 = 1; w8 < 8; ++w8) dm = fmaxf(dm, red[w8]);
            dm = fminf(fmaxf(dm, 0.f), 1.0e6f);
            const int dmax = (int)dm + 1, q0 = 16 + qb * 128;
            const int plo = q0 - dmax, phi = q0 + 127 + dmax;
            jlo = plo < 16 ? 0 : 1 + ((plo - 16) >> 6); jhi = phi >= L + 16 ? NT - 1 : 1 + ((phi - 16) >> 6);
            if (jlo > jc0) jlo = jc0; if (jhi < jc0 + 1) jhi = jc0 + 1;
            nleft = jc0 - jlo; ntl = nleft + (jhi - jc0 - 1);
        }
        if (ntl > 0) {
#define AT_J(t) (ph == 0 ? jc0 + (t) : ((t) < nleft ? jlo + (t) : jc0 + 2 + ((t) - nleft)))
        { const int jf = AT_J(0); AT_GLOAD(jf); } AT_LSTORE(0); __syncthreads();
#pragma unroll 1
        for (int t = 0; t < ntl; ++t) {
            const int j = AT_J(t);
            if (t + 1 < ntl) { const int jn = AT_J(t + 1); AT_GLOAD(jn); }
            const LAS unsigned char* Kb = lds + (t & 1) * AT_BUF + mp * 128; const LAS unsigned char* Vb = lds + (t & 1) * AT_BUF + AT_KSZ;
            const float dq = qh - (float)(j == 0 ? 0 : 64 * j - 48);
            f32x16 p0, p1;
#pragma unroll
            for (int r = 0; r < 16; ++r) { p0[r] = 0.f; p1[r] = 0.f; }
            {
                bf16x8 ka[4], kb[4];
#pragma unroll
                for (int d0 = 0; d0 < 4; ++d0) { ka[d0] = *(const LAS bf16x8*)(Kb + r32 * AT_KSTR + d0 * 32 + hi * 16); kb[d0] = *(const LAS bf16x8*)(Kb + (32 + r32) * AT_KSTR + d0 * 32 + hi * 16); }
                __builtin_amdgcn_sched_barrier(0);
#pragma unroll
                for (int d0 = 0; d0 < 4; ++d0) { p0 = mfma32(ka[d0], q[d0], p0); p1 = mfma32(kb[d0], q[d0], p1); }
            }
#pragma unroll
            for (int r = 0; r < 16; ++r) { const float dd = dq - (float)((r & 3) + 8 * (r >> 2)); p0[r] = fmaf(fabsf(dd), nslope, p0[r]); p1[r] = fmaf(fabsf(dd - 32.f), nslope, p1[r]); }
            if (j == 0) {
#pragma unroll
                for (int r = 0; r < 16; ++r) { if ((r & 3) + 8 * (r >> 2) + 4 * hi >= 16) p0[r] = -INFINITY; p1[r] = -INFINITY; }
            }
            float rm = fmaxf(p0[0], p1[0]);
#pragma unroll
            for (int r = 1; r < 16; ++r) rm = fmaxf(rm, fmaxf(p0[r], p1[r]));
            rm = fmaxf(rm, __shfl_xor(rm, 32));
            if (__any(rm > mx - 38.0f)) {
            const float mn = fmaxf(mx, rm);
            if (__any(mn > mx)) {
                const float f = __builtin_amdgcn_exp2f(mx - mn); ls *= f; mx = mn;
#pragma unroll
                for (int b = 0; b < 4; ++b)
#pragma unroll
                    for (int r = 0; r < 16; ++r) O[b][r] *= f;
            }
            float sum = 0.f;
#pragma unroll
            for (int r = 0; r < 16; ++r) { p0[r] = __builtin_amdgcn_exp2f(p0[r] - mx); p1[r] = __builtin_amdgcn_exp2f(p1[r] - mx); sum += p0[r] + p1[r]; }
            ls += sum;
            bf16x8 pf[4];
#pragma unroll
            for (int k2 = 0; k2 < 2; ++k2) {
                u32x4 w0, w1;
                w0.x = cvtpk(p0[8 * k2 + 0], p0[8 * k2 + 1]); w0.y = cvtpk(p0[8 * k2 + 2], p0[8 * k2 + 3]); w0.z = cvtpk(p0[8 * k2 + 4], p0[8 * k2 + 5]); w0.w = cvtpk(p0[8 * k2 + 6], p0[8 * k2 + 7]);
                w1.x = cvtpk(p1[8 * k2 + 0], p1[8 * k2 + 1]); w1.y = cvtpk(p1[8 * k2 + 2], p1[8 * k2 + 3]); w1.z = cvtpk(p1[8 * k2 + 4], p1[8 * k2 + 5]); w1.w = cvtpk(p1[8 * k2 + 6], p1[8 * k2 + 7]);
                pf[k2] = __builtin_bit_cast(bf16x8, w0); pf[2 + k2] = __builtin_bit_cast(bf16x8, w1);
            }
            {
                u32x4 vcur[4], vnxt[4];
#define AT_VLOAD(dst, ks_) do { _Pragma("unroll") for (int b_ = 0; b_ < 4; ++b_) { const LAS unsigned char* vp_ = Vb + (b_ * 32 + r32) * AT_VSTR + (ks_) * 32 + hi * 8; \
                    const u32x2 lo_ = *(const LAS u32x2*)vp_, hh_ = *(const LAS u32x2*)(vp_ + 16); dst[b_].x = lo_.x; dst[b_].y = lo_.y; dst[b_].z = hh_.x; dst[b_].w = hh_.y; } } while (0)
                AT_VLOAD(vcur, 0);
#pragma unroll
                for (int ks = 0; ks < 4; ++ks) {
                    if (ks < 3) AT_VLOAD(vnxt, ks + 1);
                    __builtin_amdgcn_sched_barrier(0);
#pragma unroll
                    for (int b = 0; b < 4; ++b) O[b] = mfma32(__builtin_bit_cast(bf16x8, vcur[b]), pf[ks], O[b]);
                    __builtin_amdgcn_sched_barrier(0);
#pragma unroll
                    for (int b = 0; b < 4; ++b) vcur[b] = vnxt[b];
                }
#undef AT_VLOAD
            }
            }
            if (t + 1 < ntl) AT_LSTORE((t + 1) & 1);
            __syncthreads();
        }
#undef AT_J
        }
    }
#undef AT_GLOAD
#undef AT_LSTORE
    const float lt = ls + __shfl_xor(ls, 32);
    const float inv = (mp ? lam : 1.0f) / lt;
    int lane2 = lane; asm volatile("" : "+v"(lane2));
    const int r32e = lane2 & 31, hie = lane2 >> 5;
    LAS float* ex = (LAS float*)lds + rg * (128 * 32) + hie * 128 + r32e;
    if (mp == 1) {
#pragma unroll
        for (int b = 0; b < 4; ++b)
#pragma unroll
            for (int r = 0; r < 16; ++r) ex[(32 * b + (r & 3) + 8 * (r >> 2)) * 32] = O[b][r] * inv;
    }
    __syncthreads();
    if (mp == 0) {
        float ss = 0.f;
#pragma unroll
        for (int b = 0; b < 4; ++b)
#pragma unroll
            for (int r = 0; r < 16; ++r) { const float o = O[b][r] * inv - ex[(32 * b + (r & 3) + 8 * (r >> 2)) * 32]; O[b][r] = o; ss += o * o; }
        ss += __shfl_xor(ss, 32);
        const float rstd = rsqrtf(ss * (1.0f / 128.0f) + 1e-5f) * 0.8f;
        const float* sg = P->in[I_SUBG] + 4 * hie; bf16* Qo = Q + (size_t)(base + qb * 128 + rg * 32 + r32e) * 512 + h * 128 + 4 * hie;
#pragma unroll
        for (int b = 0; b < 4; ++b)
#pragma unroll
            for (int r4 = 0; r4 < 4; ++r4) {
                const int n = 32 * b + 8 * r4; const f32x4 g = *(const f32x4*)(sg + n);
                u32x2 w; w.x = cvtpk(O[b][4 * r4 + 0] * rstd * g.x, O[b][4 * r4 + 1] * rstd * g.y); w.y = cvtpk(O[b][4 * r4 + 2] * rstd * g.z, O[b][4 * r4 + 3] * rstd * g.w);
                *(u32x2*)(Qo + n) = w;
            }
    }
    __syncthreads();
}

constexpr int SC_R = 0, SC_K = 16384, SC_V = 32768, SC_W = 49152, SC_B = 65536, SC_KK = 81920, SC_Y = 98304, SC_TW = 114688, SC_AD = 123904, SC_MU = 133120;
__device__ __forceinline__ float dpp_add(float v, int ctrl_id) {
    const int x = __float_as_int(v); int y;
    if (ctrl_id == 0) y = __builtin_amdgcn_update_dpp(0, x, 0xB1, 0xf, 0xf, true);
    else if (ctrl_id == 1) y = __builtin_amdgcn_update_dpp(0, x, 0x4E, 0xf, 0xf, true);
    else if (ctrl_id == 2) y = __builtin_amdgcn_update_dpp(0, x, 0x141, 0xf, 0xf, true);
    else y = __builtin_amdgcn_update_dpp(0, x, 0x140, 0xf, 0xf, true);
    return v + __int_as_float(y);
}
template <int LPR> __device__ __forceinline__ float grp_sum(float v) {
    v = dpp_add(v, 0); v = dpp_add(v, 1); v = dpp_add(v, 2);
    if (LPR == 16) v = dpp_add(v, 3);
    return v;
}
#define BAR_LDS() asm volatile("s_waitcnt lgkmcnt(0)\n\ts_barrier" ::: "memory")
__device__ __forceinline__ float fast_sigmoid(float x) { return __builtin_amdgcn_rcpf(1.0f + __builtin_amdgcn_exp2f(-LOG2E * x)); }
__device__ __forceinline__ float fast_tanh(float x) { return 1.0f - 2.0f * __builtin_amdgcn_rcpf(1.0f + __builtin_amdgcn_exp2f(2.0f * LOG2E * x)); }
template <int NRP, int NSW>
__device__ __forceinline__ void scan_unit(LAS unsigned char* lds, KP P, int s, int d, int h, int rp) {
    constexpr int RPB = 64 / NRP, RPW = RPB / NSW, LPR = 64 / RPW, CPL = 64 / LPR;
    static_assert(LPR == 8 || LPR == 16, "scan geometry");
    constexpr bool YDB = (RPB == 16) && (NSW == 4);
    constexpr int YST = YDB ? RPB : 64;
    int tid_ = threadIdx.x; asm volatile("" : "+v"(tid_));
    const int tid = tid_, lane = tid & 63, wid = __builtin_amdgcn_readfirstlane(tid >> 6);
    const int L = seq_len(s), base = seq_base(s), Ltot = L + 16, nchunk = (Ltot + 63) / 64;
    unsigned char* ws = P->ws;
    const bf16* Rb = (const bf16*)(ws + WS_R); const bf16* KAb = (const bf16*)(ws + WS_KA); const bf16* VAb = (const bf16*)(ws + WS_VA); const bf16* Lb = (const bf16*)(ws + WS_L);
    float* CB = (float*)(ws + WS_CB); bf16* YD = (bf16*)((unsigned char*)P->out + 64 * MiB) + (size_t)d * NMAIN * 512;
    LAS float* fS = (LAS float*)lds; LAS float* fV = (LAS float*)(lds + 81920); LAS float* fY = (LAS float*)(lds + SC_Y); LAS float* fMU = (LAS float*)(lds + SC_MU);
#define SCI(sl_, a_, c_) ((sl_) * 320 + (a_) * 64 + (c_))
    for (int i = tid; i < 832; i += NTHREADS) {
        float v;
        if (i < 640) { const int which = i / 320, jj = i % 320, a = jj >> 6, c = jj & 63; const int gi = a < 3 ? a * 512 + h * 64 + c : 1536 + (a - 3) * 64 + c; v = P->in[which ? I_MUN : I_MUP][gi]; }
        else { const int a = (i - 640) >> 6, c = (i - 640) & 63; v = P->in[a == 0 ? I_KK : a == 1 ? I_KA : I_RK][h * 64 + c]; }
        fMU[i] = v;
    }
    const int mat = wid >> 2, ntile = wid & 3;
    const bf16* Wt = (const bf16*)(ws + WS_LORA + (mat ? 131072 : 0)) + ((size_t)d * 512 + h * 64 + ntile * 16 + (lane & 15)) * 64 + (lane >> 4) * 8;
    const bf16x8 bfr0 = *(const bf16x8*)Wt, bfr1 = *(const bf16x8*)(Wt + 32);
    const float bias = P->in[mat ? I_A0 : I_W0][d * 512 + h * 64 + ntile * 16 + (lane & 15)];
    float S[CPL];
#pragma unroll
    for (int j = 0; j < CPL; ++j) S[j] = 0.f;
    const int rowl = lane / LPR, kg = lane % LPR, srow = rp * RPB + wid * RPW + rowl;
    const int slot = tid >> 3, cg8 = (tid & 7) * 8;
    u32x4 raw[5][3];
#define SC_META(c) (d ? ((c) == nchunk - 1) : ((c) == 0))
    const unsigned char* HALO0 = ws + WS_HALO + (size_t)(base >> 6) * 2 * HALO_ROW;
#define SC_LOAD(c) do { const int i_ = 64 * (c) + slot; const bool ok_ = i_ < Ltot; const int p_ = d ? Ltot - 1 - i_ : i_; \
        const unsigned zr_ = (unsigned)(METAROW + 64); \
        if (!SC_META(c)) { const unsigned rc_ = ok_ ? (unsigned)(base + p_ - 16) : zr_; \
            _Pragma("unroll") for (int a_ = 0; a_ < 5; ++a_) { const unsigned char* B_ = (const unsigned char*)(a_ == 0 ? Rb : a_ == 1 ? KAb : a_ == 2 ? VAb : Lb); const unsigned ld_ = a_ < 3 ? 1024u : 512u; \
                const unsigned co_ = (unsigned)(((a_ < 3 ? h * 64 : (a_ - 3) * 64) + cg8) * 2); raw[a_][1] = *(const u32x4*)(B_ + (rc_ * ld_ + co_)); } \
        } else { const bool me_ = ok_ && p_ < 16; const bool hn_ = me_ && p_ == 15; \
            const unsigned rc_ = ok_ ? (unsigned)pos_row(base, p_) : zr_, rp_ = (me_ && p_ > 0) ? (unsigned)(METAROW + p_ - 1) : zr_, rn_ = (me_ && p_ < 15) ? (unsigned)(METAROW + p_ + 1) : zr_; \
            _Pragma("unroll") for (int a_ = 0; a_ < 5; ++a_) { const unsigned char* B_ = (const unsigned char*)(a_ == 0 ? Rb : a_ == 1 ? KAb : a_ == 2 ? VAb : Lb); const unsigned ld_ = a_ < 3 ? 1024u : 512u; \
                const unsigned co_ = (unsigned)(((a_ < 3 ? h * 64 : (a_ - 3) * 64) + cg8) * 2); \
                const unsigned ho_ = (unsigned)(((a_ < 3 ? a_ * 512 + h * 64 : 1536 + (a_ - 3) * 64) + cg8) * 2); \
                raw[a_][0] = *(const u32x4*)(B_ + (rp_ * ld_ + co_)); raw[a_][1] = *(const u32x4*)(B_ + (rc_ * ld_ + co_)); \
                const unsigned char* np_ = hn_ ? HALO0 + ho_ : B_ + (rn_ * ld_ + co_); raw[a_][2] = *(const u32x4*)np_; } } } while (0)
    SC_LOAD(0);
    BAR_LDS();
    for (int c = 0; c < nchunk; ++c) {
        const int nvalid = (Ltot - 64 * c) < 64 ? (Ltot - 64 * c) : 64;
        float rv[8], kv[8];
        if (!SC_META(c)) {
            float vv8[8]; unpack8(raw[0][1], rv); unpack8(raw[1][1], kv); unpack8(raw[2][1], vv8);
            { LAS float* dst = fS + SCI(slot, 4, cg8); *(LAS f32x4*)dst = (f32x4){rv[0], rv[1], rv[2], rv[3]}; *(LAS f32x4*)(dst + 4) = (f32x4){rv[4], rv[5], rv[6], rv[7]}; }
            { LAS float* dst = fV + slot * 64 + cg8; *(LAS f32x4*)dst = (f32x4){vv8[0], vv8[1], vv8[2], vv8[3]}; *(LAS f32x4*)(dst + 4) = (f32x4){vv8[4], vv8[5], vv8[6], vv8[7]}; }
            *(LAS u32x4*)(lds + SC_TW + slot * 144 + cg8 * 2) = raw[3][1];
            *(LAS u32x4*)(lds + SC_AD + slot * 144 + cg8 * 2) = raw[4][1];
        } else {
            const int i1 = 64 * c + slot; const int p1 = d ? Ltot - 1 - i1 : i1; const bool me1 = i1 < Ltot && p1 < 16; const float fm = me1 ? 1.0f : 0.0f;
#pragma unroll
            for (int a = 0; a < 5; ++a) {
                float pv[8], cv[8], nv[8], o[8]; unpack8(raw[a][0], pv); unpack8(raw[a][1], cv); unpack8(raw[a][2], nv);
                const f32x4 mp0 = *(const LAS f32x4*)(fMU + a * 64 + cg8), mp1 = *(const LAS f32x4*)(fMU + a * 64 + cg8 + 4), mn0 = *(const LAS f32x4*)(fMU + 320 + a * 64 + cg8), mn1 = *(const LAS f32x4*)(fMU + 320 + a * 64 + cg8 + 4);
#pragma unroll
                for (int e = 0; e < 8; ++e) { const float mp = fm * (e < 4 ? mp0[e & 3] : mp1[e & 3]), mn = fm * (e < 4 ? mn0[e & 3] : mn1[e & 3]); o[e] = cv[e] + mp * (pv[e] - cv[e]) + mn * (nv[e] - cv[e]); }
                if (a == 0) {
#pragma unroll
                    for (int e = 0; e < 8; ++e) rv[e] = o[e];
                    LAS float* dst = fS + SCI(slot, 4, cg8); *(LAS f32x4*)dst = (f32x4){o[0], o[1], o[2], o[3]}; *(LAS f32x4*)(dst + 4) = (f32x4){o[4], o[5], o[6], o[7]};
                } else if (a == 1) {
#pragma unroll
                    for (int e = 0; e < 8; ++e) kv[e] = o[e];
                } else if (a == 2) {
                    LAS float* dst = fV + slot * 64 + cg8; *(LAS f32x4*)dst = (f32x4){o[0], o[1], o[2], o[3]}; *(LAS f32x4*)(dst + 4) = (f32x4){o[4], o[5], o[6], o[7]};
                } else {
                    if (a == 3) {
#pragma unroll
                        for (int e = 0; e < 8; ++e) o[e] = me1 ? fast_tanh(o[e]) : o[e];
                    }
                    u32x4 w; w.x = cvtpk(o[0], o[1]); w.y = cvtpk(o[2], o[3]); w.z = cvtpk(o[4], o[5]); w.w = cvtpk(o[6], o[7]);
                    *(LAS u32x4*)(lds + (a == 3 ? SC_TW : SC_AD) + slot * 144 + cg8 * 2) = w;
                }
            }
        }
        BAR_LDS();
        if (c + 1 < nchunk) SC_LOAD(c + 1);
        {
            const LAS unsigned char* Ab = lds + (mat ? SC_AD : SC_TW); LAS float* fWB = fS + (mat ? 128 : 64);
#pragma unroll
            for (int mt = 0; mt < 4; ++mt) {
                const bf16x8 a0 = *(const LAS bf16x8*)(Ab + (mt * 16 + (lane & 15)) * 144 + (lane >> 4) * 16);
                const bf16x8 a1 = *(const LAS bf16x8*)(Ab + (mt * 16 + (lane & 15)) * 144 + 64 + (lane >> 4) * 16);
                f32x4 acc = {0.f, 0.f, 0.f, 0.f};
                acc = __builtin_amdgcn_mfma_f32_16x16x32_bf16(a0, bfr0, acc, 0, 0, 0);
                acc = __builtin_amdgcn_mfma_f32_16x16x32_bf16(a1, bfr1, acc, 0, 0, 0);
#pragma unroll
                for (int rg = 0; rg < 4; ++rg) {
                    const int sl = mt * 16 + (lane >> 4) * 4 + rg, col = ntile * 16 + (lane & 15);
                    const float sg = fast_sigmoid(acc[rg] + bias); const float dc = __builtin_amdgcn_exp2f(-0.6065306597126334f * LOG2E * sg);
                    fWB[sl * 320 + col] = mat ? sg : dc;
                }
            }
        }
        BAR_LDS();
        {
            const f32x4 a0 = *(const LAS f32x4*)(fS + SCI(slot, 2, cg8)), a1 = *(const LAS f32x4*)(fS + SCI(slot, 2, cg8 + 4));
            const f32x4 kk0 = *(const LAS f32x4*)(fMU + 640 + cg8), kk1 = *(const LAS f32x4*)(fMU + 640 + cg8 + 4), ka0 = *(const LAS f32x4*)(fMU + 704 + cg8), ka1 = *(const LAS f32x4*)(fMU + 704 + cg8 + 4);
            const f32x4 rk0 = *(const LAS f32x4*)(fMU + 768 + cg8), rk1 = *(const LAS f32x4*)(fMU + 768 + cg8 + 4);
            float kkv[8], kd[8], av[8]; float ssq = 0.f, cs = 0.f;
#pragma unroll
            for (int e = 0; e < 8; ++e) {
                av[e] = e < 4 ? a0[e & 3] : a1[e & 3];
                kkv[e] = kv[e] * (e < 4 ? kk0[e & 3] : kk1[e & 3]); ssq = fmaf(kkv[e], kkv[e], ssq);
                kd[e] = kv[e] * (1.0f + (av[e] - 1.0f) * (e < 4 ? ka0[e & 3] : ka1[e & 3])); cs = fmaf(rv[e] * kd[e], e < 4 ? rk0[e & 3] : rk1[e & 3], cs);
            }
            ssq = grp_sum<8>(ssq); cs = grp_sum<8>(cs);
            const float rs = rsqrtf(fmaxf(ssq, 1e-24f));
#pragma unroll
            for (int e = 0; e < 8; ++e) { kkv[e] *= rs; av[e] *= kkv[e]; }
            LAS float* o1 = fS + SCI(slot, 0, cg8); *(LAS f32x4*)o1 = (f32x4){kkv[0], kkv[1], kkv[2], kkv[3]}; *(LAS f32x4*)(o1 + 4) = (f32x4){kkv[4], kkv[5], kkv[6], kkv[7]};
            LAS float* o2 = fS + SCI(slot, 2, cg8); *(LAS f32x4*)o2 = (f32x4){av[0], av[1], av[2], av[3]}; *(LAS f32x4*)(o2 + 4) = (f32x4){av[4], av[5], av[6], av[7]};
            LAS float* o3 = fS + SCI(slot, 3, cg8); *(LAS f32x4*)o3 = (f32x4){kd[0], kd[1], kd[2], kd[3]}; *(LAS f32x4*)(o3 + 4) = (f32x4){kd[4], kd[5], kd[6], kd[7]};
            if (cg8 == 0 && rp == 0 && slot < nvalid) { const int i2 = 64 * c + slot; const int p2 = d ? Ltot - 1 - i2 : i2; CB[((size_t)d * ROWS + pos_row(base, p2)) * 8 + h] = cs; }
        }
        BAR_LDS();
#define SC_STORE_Y(cc_) do { const int t5_ = tid - 256; if (t5_ >= 0 && t5_ < 128) { const int sl5_ = t5_ >> 1, hf_ = t5_ & 1; const int i5_ = 64 * (cc_) + sl5_; const int p5_ = d ? Ltot - 1 - i5_ : i5_; \
            if (i5_ < Ltot && p5_ >= 16) { const LAS float* yp_ = fY + ((cc_) & 1) * 1024 + sl5_ * 16 + hf_ * 8; const f32x4 y0_ = *(const LAS f32x4*)yp_, y1_ = *(const LAS f32x4*)(yp_ + 4); \
                *(u32x4*)(YD + (size_t)(base + p5_ - 16) * 512 + h * 64 + rp * 16 + hf_ * 8) = pack8(y0_, y1_); } } } while (0)
        if (YDB && wid >= NSW && c > 0) SC_STORE_Y(c - 1);
        if (wid < NSW) {
            typedef float f32x2_ __attribute__((ext_vector_type(2)));
            constexpr int C4 = CPL / 4;
            const LAS float* ps = fS + kg * CPL; const LAS float* pv = fV + srow;
            LAS float* py = YDB ? fY + (c & 1) * 1024 + (srow - rp * RPB) : fY + srow;
            f32x4 nk[C4], nw[C4], nb[C4], nd[C4], nr[C4]; float nv;
#define SC_FETCH(sl_) do { _Pragma("unroll") for (int j_ = 0; j_ < C4; ++j_) { nk[j_] = *(const LAS f32x4*)(ps + (sl_) * 320 + 4 * j_); nw[j_] = *(const LAS f32x4*)(ps + (sl_) * 320 + 64 + 4 * j_); \
                nb[j_] = *(const LAS f32x4*)(ps + (sl_) * 320 + 128 + 4 * j_); nd[j_] = *(const LAS f32x4*)(ps + (sl_) * 320 + 192 + 4 * j_); nr[j_] = *(const LAS f32x4*)(ps + (sl_) * 320 + 256 + 4 * j_); } nv = pv[(sl_) * 64]; } while (0)
            SC_FETCH(0);
            f32x4 rp4[C4];
#pragma unroll
            for (int j = 0; j < C4; ++j) rp4[j] = (f32x4){0.f, 0.f, 0.f, 0.f};
#pragma unroll 16
            for (int sl = 0; sl < nvalid; ++sl) {
                f32x4 ck[C4], cw[C4], cb[C4], cd[C4], cr[C4];
#pragma unroll
                for (int j = 0; j < C4; ++j) { ck[j] = nk[j]; cw[j] = nw[j]; cb[j] = nb[j]; cd[j] = nd[j]; cr[j] = nr[j]; }
                const float vv = nv;
                SC_FETCH(sl + 1 < 64 ? sl + 1 : 63);
                f32x2_ pa = {0.f, 0.f}, ya = {0.f, 0.f};
#pragma unroll
                for (int j = 0; j < C4; ++j)
#pragma unroll
                    for (int e = 0; e < 4; e += 2) { const f32x2_ s2 = {S[4 * j + e], S[4 * j + e + 1]}, k2 = {ck[j][e], ck[j][e + 1]}, r2 = {rp4[j][e], rp4[j][e + 1]}; pa = pa + s2 * k2; ya = ya + s2 * r2; }
                float pp = pa.x + pa.y, yy = ya.x + ya.y;
                pp = dpp_add(pp, 0); yy = dpp_add(yy, 0); pp = dpp_add(pp, 1); yy = dpp_add(yy, 1); pp = dpp_add(pp, 2); yy = dpp_add(yy, 2);
                if (LPR == 16) { pp = dpp_add(pp, 3); yy = dpp_add(yy, 3); }
                py[(sl > 0 ? sl - 1 : 0) * YST] = yy;
#pragma unroll
                for (int j = 0; j < C4; ++j)
#pragma unroll
                    for (int e = 0; e < 4; e += 2) {
                        const f32x2_ b2 = {cb[j][e], cb[j][e + 1]}, d2 = {cd[j][e], cd[j][e + 1]}, w2 = {cw[j][e], cw[j][e + 1]}; f32x2_ s2 = {S[4 * j + e], S[4 * j + e + 1]};
                        const f32x2_ t2 = d2 * vv - b2 * pp; s2 = s2 * w2 + t2; S[4 * j + e] = s2.x; S[4 * j + e + 1] = s2.y; }
#pragma unroll
                for (int j = 0; j < C4; ++j) rp4[j] = cr[j];
            }
            {
                f32x2_ ya = {0.f, 0.f};
#pragma unroll
                for (int j = 0; j < C4; ++j)
#pragma unroll
                    for (int e = 0; e < 4; e += 2) { const f32x2_ s2 = {S[4 * j + e], S[4 * j + e + 1]}, r2 = {rp4[j][e], rp4[j][e + 1]}; ya = ya + s2 * r2; }
                const float yy = grp_sum<LPR>(ya.x + ya.y);
                py[(nvalid - 1) * YST] = yy;
            }
#undef SC_FETCH
        }
        BAR_LDS();
        {
            const int i2 = 64 * c + slot; const int p2 = d ? Ltot - 1 - i2 : i2;
            if (!YDB && slot < nvalid && p2 >= 16 && (cg8 / RPB) == rp) {
                const LAS float* yp = fY + slot * 64 + cg8; const f32x4 y0 = *(const LAS f32x4*)yp, y1 = *(const LAS f32x4*)(yp + 4);
                *(u32x4*)(YD + (size_t)(base + p2 - 16) * 512 + h * 64 + cg8) = pack8(y0, y1);
            }
        }
    }
    if (YDB) SC_STORE_Y(nchunk - 1);
#undef SC_STORE_Y
#undef SC_LOAD
#undef SC_META
#undef SCI
}

constexpr int SL_FV = 81920, SL_FY = 86016, SL_TW = 90112, SL_AD = 94720, SL_AS = 99328, SL_MU = 107520;
__device__ __forceinline__ void scan_long(LAS unsigned char* lds, KP P, int s, int d, int h, int rp) {
    int tid_ = threadIdx.x; asm volatile("" : "+v"(tid_));
    const int tid = tid_, lane = tid & 63, wid = __builtin_amdgcn_readfirstlane(tid >> 6);
    const int L = seq_len(s), base = seq_base(s), Ltot = L + 16, nhalf = (Ltot + 31) / 32;
    unsigned char* ws = P->ws;
    const bf16* Rb = (const bf16*)(ws + WS_R); const bf16* KAb = (const bf16*)(ws + WS_KA); const bf16* VAb = (const bf16*)(ws + WS_VA); const bf16* Lb = (const bf16*)(ws + WS_L);
    float* CB = (float*)(ws + WS_CB); bf16* YD = (bf16*)((unsigned char*)P->out + 64 * MiB) + (size_t)d * NMAIN * 512;
    LAS float* fS = (LAS float*)lds; LAS float* fV = (LAS float*)(lds + SL_FV); LAS float* fY = (LAS float*)(lds + SL_FY); LAS float* fAS = (LAS float*)(lds + SL_AS); LAS float* fMU = (LAS float*)(lds + SL_MU);
    for (int i = tid; i < 832; i += NTHREADS) {
        float v;
        if (i < 640) { const int which = i / 320, jj = i % 320, a = jj >> 6, c = jj & 63; const int gi = a < 3 ? a * 512 + h * 64 + c : 1536 + (a - 3) * 64 + c; v = P->in[which ? I_MUN : I_MUP][gi]; }
        else { const int a = (i - 640) >> 6, c = (i - 640) & 63; v = P->in[a == 0 ? I_KK : a == 1 ? I_KA : I_RK][h * 64 + c]; }
        fMU[i] = v;
    }
    const bool scanner = wid < 4; const int pw = wid & 3;
    const int sl8 = lane >> 3, cg8 = (lane & 7) * 8, slot = pw * 8 + sl8;
    const int rowl = lane >> 4, kg = lane & 15, srl = pw * 4 + rowl;
    const unsigned char* HALO0 = ws + WS_HALO + (size_t)(base >> 6) * 2 * HALO_ROW;
    u32x4 raw[5][3];
#define SL_META(hc) (d ? ((hc) == nhalf - 1) : ((hc) == 0))
#define SL_LOAD(hc) do { const int i_ = 32 * (hc) + slot; const bool ok_ = i_ < Ltot; const int p_ = d ? Ltot - 1 - i_ : i_; \
        const unsigned zr_ = (unsigned)(METAROW + 64); \
        if (!SL_META(hc)) { const unsigned rc_ = ok_ ? (unsigned)(base + p_ - 16) : zr_; \
            _Pragma("unroll") for (int a_ = 0; a_ < 5; ++a_) { const unsigned char* B_ = (const unsigned char*)(a_ == 0 ? Rb : a_ == 1 ? KAb : a_ == 2 ? VAb : Lb); const unsigned ld_ = a_ < 3 ? 1024u : 512u; \
                const unsigned co_ = (unsigned)(((a_ < 3 ? h * 64 : (a_ - 3) * 64) + cg8) * 2); raw[a_][1] = *(const u32x4*)(B_ + (rc_ * ld_ + co_)); } \
        } else { const bool me_ = ok_ && p_ < 16; const bool hn_ = me_ && p_ == 15; \
            const unsigned rc_ = ok_ ? (unsigned)pos_row(base, p_) : zr_, rp_ = (me_ && p_ > 0) ? (unsigned)(METAROW + p_ - 1) : zr_, rn_ = (me_ && p_ < 15) ? (unsigned)(METAROW + p_ + 1) : zr_; \
            _Pragma("unroll") for (int a_ = 0; a_ < 5; ++a_) { const unsigned char* B_ = (const unsigned char*)(a_ == 0 ? Rb : a_ == 1 ? KAb : a_ == 2 ? VAb : Lb); const unsigned ld_ = a_ < 3 ? 1024u : 512u; \
                const unsigned co_ = (unsigned)(((a_ < 3 ? h * 64 : (a_ - 3) * 64) + cg8) * 2); \
                const unsigned ho_ = (unsigned)(((a_ < 3 ? a_ * 512 + h * 64 : 1536 + (a_ - 3) * 64) + cg8) * 2); \
                raw[a_][0] = *(const u32x4*)(B_ + (rp_ * ld_ + co_)); raw[a_][1] = *(const u32x4*)(B_ + (rc_ * ld_ + co_)); \
                const unsigned char* np_ = hn_ ? HALO0 + ho_ : B_ + (rn_ * ld_ + co_); raw[a_][2] = *(const u32x4*)np_; } } } while (0)
    constexpr int SL_WB = 110848;
    for (int i = tid; i < 1024; i += NTHREADS) { const int m2 = i >> 9, n = (i >> 3) & 63, ch = i & 7;
        *(LAS u32x4*)(lds + SL_WB + m2 * 9216 + n * 144 + ch * 16) = *(const u32x4*)((const bf16*)(ws + WS_LORA + (m2 ? 131072 : 0)) + ((size_t)d * 512 + h * 64 + n) * 64 + ch * 8); }
    float bias[2][4];
#pragma unroll
    for (int mt_ = 0; mt_ < 2; ++mt_)
#pragma unroll
        for (int nt = 0; nt < 4; ++nt) bias[mt_][nt] = P->in[mt_ ? I_A0 : I_W0][d * 512 + h * 64 + nt * 16 + (lane & 15)];
    float S[4] = {0.f, 0.f, 0.f, 0.f};
#define SL_PREP(hc, buf) do { \
        const bool meta_ = SL_META(hc); const int i1_ = 32 * (hc) + slot; const int p1_ = d ? Ltot - 1 - i1_ : i1_; const bool ok1_ = i1_ < Ltot; \
        LAS float* fSb_ = fS + (buf) * 10240 + slot * 320; float rv[8], kv[8]; \
        if (!meta_) { float vv8[8]; unpack8(raw[0][1], rv); unpack8(raw[1][1], kv); unpack8(raw[2][1], vv8); \
            *(LAS f32x4*)(fSb_ + 256 + cg8) = (f32x4){rv[0], rv[1], rv[2], rv[3]}; *(LAS f32x4*)(fSb_ + 256 + cg8 + 4) = (f32x4){rv[4], rv[5], rv[6], rv[7]}; \
            if ((cg8 >> 4) == rp) { LAS float* dv_ = fV + (buf) * 512 + slot * 16 + (cg8 & 15); *(LAS f32x4*)dv_ = (f32x4){vv8[0], vv8[1], vv8[2], vv8[3]}; *(LAS f32x4*)(dv_ + 4) = (f32x4){vv8[4], vv8[5], vv8[6], vv8[7]}; } \
            *(LAS u32x4*)(lds + SL_TW + slot * 144 + cg8 * 2) = raw[3][1]; *(LAS u32x4*)(lds + SL_AD + slot * 144 + cg8 * 2) = raw[4][1]; \
        } else { const bool me1_ = ok1_ && p1_ < 16; const float fm_ = me1_ ? 1.0f : 0.0f; \
            _Pragma("unroll") for (int a = 0; a < 5; ++a) { \
                float pv_[8], cv_[8], nv_[8], o_[8]; unpack8(raw[a][0], pv_); unpack8(raw[a][1], cv_); unpack8(raw[a][2], nv_); \
                _Pragma("unroll") for (int e = 0; e < 8; ++e) { const float mp_ = fm_ * fMU[a * 64 + cg8 + e], mn_ = fm_ * fMU[320 + a * 64 + cg8 + e]; o_[e] = cv_[e] + mp_ * (pv_[e] - cv_[e]) + mn_ * (nv_[e] - cv_[e]); } \
                if (a == 0) { _Pragma("unroll") for (int e = 0; e < 8; ++e) rv[e] = o_[e]; \
                    *(LAS f32x4*)(fSb_ + 256 + cg8) = (f32x4){o_[0], o_[1], o_[2], o_[3]}; *(LAS f32x4*)(fSb_ + 256 + cg8 + 4) = (f32x4){o_[4], o_[5], o_[6], o_[7]}; } \
                else if (a == 1) { _Pragma("unroll") for (int e = 0; e < 8; ++e) kv[e] = o_[e]; } \
                else if (a == 2) { if ((cg8 >> 4) == rp) { LAS float* dv_ = fV + (buf) * 512 + slot * 16 + (cg8 & 15); *(LAS f32x4*)dv_ = (f32x4){o_[0], o_[1], o_[2], o_[3]}; *(LAS f32x4*)(dv_ + 4) = (f32x4){o_[4], o_[5], o_[6], o_[7]}; } } \
                else { if (a == 3) { _Pragma("unroll") for (int e = 0; e < 8; ++e) o_[e] = me1_ ? fast_tanh(o_[e]) : o_[e]; } \
                    u32x4 w_; w_.x = cvtpk(o_[0], o_[1]); w_.y = cvtpk(o_[2], o_[3]); w_.z = cvtpk(o_[4], o_[5]); w_.w = cvtpk(o_[6], o_[7]); \
                    *(LAS u32x4*)(lds + (a == 3 ? SL_TW : SL_AD) + slot * 144 + cg8 * 2) = w_; } } } \
        asm volatile("s_waitcnt lgkmcnt(0)" ::: "memory"); \
          \
        { f32x4 acc_[2][4]; \
          _Pragma("unroll") for (int m2 = 0; m2 < 2; ++m2) { const LAS unsigned char* Ab_ = lds + (m2 ? SL_AD : SL_TW) + (pw * 8 + (lane & 15)) * 144 + (lane >> 4) * 16; \
              const bf16x8 a0_ = *(const LAS bf16x8*)Ab_, a1_ = *(const LAS bf16x8*)(Ab_ + 64); \
              _Pragma("unroll") for (int nt = 0; nt < 4; ++nt) { f32x4 z_ = {0.f, 0.f, 0.f, 0.f}; const LAS unsigned char* Bb_ = lds + SL_WB + m2 * 9216 + (nt * 16 + (lane & 15)) * 144 + (lane >> 4) * 16; \
                  z_ = __builtin_amdgcn_mfma_f32_16x16x32_bf16(a0_, *(const LAS bf16x8*)Bb_, z_, 0, 0, 0); acc_[m2][nt] = __builtin_amdgcn_mfma_f32_16x16x32_bf16(a1_, *(const LAS bf16x8*)(Bb_ + 64), z_, 0, 0, 0); } } \
          if (lane < 32) { \
              _Pragma("unroll") for (int nt = 0; nt < 4; ++nt) _Pragma("unroll") for (int rg = 0; rg < 4; ++rg) { const int row_ = (lane >> 4) * 4 + rg, col_ = nt * 16 + (lane & 15); \
                  const float sw_ = fast_sigmoid(acc_[0][nt][rg] + bias[0][nt]); fS[(buf) * 10240 + (pw * 8 + row_) * 320 + 64 + col_] = __builtin_amdgcn_exp2f(-0.6065306597126334f * LOG2E * sw_); \
                  fAS[pw * 512 + row_ * 64 + col_] = fast_sigmoid(acc_[1][nt][rg] + bias[1][nt]); } } } \
        asm volatile("s_waitcnt lgkmcnt(0)" ::: "memory"); \
          \
        { const f32x4 a0 = *(const LAS f32x4*)(fAS + pw * 512 + sl8 * 64 + cg8), a1 = *(const LAS f32x4*)(fAS + pw * 512 + sl8 * 64 + cg8 + 4); \
          const f32x4 kk0 = *(const LAS f32x4*)(fMU + 640 + cg8), kk1 = *(const LAS f32x4*)(fMU + 640 + cg8 + 4), ka0 = *(const LAS f32x4*)(fMU + 704 + cg8), ka1 = *(const LAS f32x4*)(fMU + 704 + cg8 + 4); \
          const f32x4 rk0 = *(const LAS f32x4*)(fMU + 768 + cg8), rk1 = *(const LAS f32x4*)(fMU + 768 + cg8 + 4); \
          float kkv[8], kd[8], av[8]; float ssq = 0.f, cs = 0.f; \
          _Pragma("unroll") for (int e = 0; e < 8; ++e) { av[e] = e < 4 ? a0[e & 3] : a1[e & 3]; \
              kkv[e] = kv[e] * (e < 4 ? kk0[e & 3] : kk1[e & 3]); ssq = fmaf(kkv[e], kkv[e], ssq); \
              kd[e] = kv[e] * (1.0f + (av[e] - 1.0f) * (e < 4 ? ka0[e & 3] : ka1[e & 3])); cs = fmaf(rv[e] * kd[e], e < 4 ? rk0[e & 3] : rk1[e & 3], cs); } \
          ssq = grp_sum<8>(ssq); cs = grp_sum<8>(cs); \
          const float rs = rsqrtf(fmaxf(ssq, 1e-24f)); \
          _Pragma("unroll") for (int e = 0; e < 8; ++e) { kkv[e] *= rs; av[e] *= kkv[e]; } \
          *(LAS f32x4*)(fSb_ + cg8) = (f32x4){kkv[0], kkv[1], kkv[2], kkv[3]}; *(LAS f32x4*)(fSb_ + cg8 + 4) = (f32x4){kkv[4], kkv[5], kkv[6], kkv[7]}; \
          *(LAS f32x4*)(fSb_ + 128 + cg8) = (f32x4){av[0], av[1], av[2], av[3]}; *(LAS f32x4*)(fSb_ + 128 + cg8 + 4) = (f32x4){av[4], av[5], av[6], av[7]}; \
          *(LAS f32x4*)(fSb_ + 192 + cg8) = (f32x4){kd[0], kd[1], kd[2], kd[3]}; *(LAS f32x4*)(fSb_ + 192 + cg8 + 4) = (f32x4){kd[4], kd[5], kd[6], kd[7]}; \
          if (cg8 == 0 && rp == 0 && ok1_) CB[((size_t)d * ROWS + pos_row(base, p1_)) * 8 + h] = cs; } } while (0)
#define SL_STORE_Y(hc, buf) do { const int sl5_ = lane >> 1, hf_ = lane & 1; const int i5_ = 32 * (hc) + sl5_; const int p5_ = d ? Ltot - 1 - i5_ : i5_; \
        if (i5_ < Ltot && p5_ >= 16) { const LAS float* yp_ = fY + (buf) * 512 + sl5_ * 16 + hf_ * 8; const f32x4 y0_ = *(const LAS f32x4*)yp_, y1_ = *(const LAS f32x4*)(yp_ + 4); \
            *(u32x4*)(YD + (size_t)(base + p5_ - 16) * 512 + h * 64 + rp * 16 + hf_ * 8) = pack8(y0_, y1_); } } while (0)
    BAR_LDS();
    if (!scanner) { SL_LOAD(0); SL_PREP(0, 0); if (nhalf > 1) SL_LOAD(1); }
    BAR_LDS();
#pragma unroll 1
    for (int hc = 0; hc < nhalf; ++hc) {
        if (scanner) {
            typedef float f32x2_ __attribute__((ext_vector_type(2)));
            const int nvalid = (Ltot - 32 * hc) < 32 ? (Ltot - 32 * hc) : 32, buf = hc & 1;
            const LAS float* ps = fS + buf * 10240 + kg * 4; const LAS float* pv = fV + buf * 512 + srl; LAS float* py = fY + buf * 512 + srl;
            f32x4 nk, nw, nb, nd, nr; float nv;
#define SL_FETCH(sl_) do { nk = *(const LAS f32x4*)(ps + (sl_) * 320); nw = *(const LAS f32x4*)(ps + (sl_) * 320 + 64); nb = *(const LAS f32x4*)(ps + (sl_) * 320 + 128); \
                nd = *(const LAS f32x4*)(ps + (sl_) * 320 + 192); nr = *(const LAS f32x4*)(ps + (sl_) * 320 + 256); nv = pv[(sl_) * 16]; } while (0)
            SL_FETCH(0);
            f32x4 rp4 = {0.f, 0.f, 0.f, 0.f};
#pragma unroll 16
            for (int sl = 0; sl < nvalid; ++sl) {
                const f32x4 ck = nk, cw = nw, cb = nb, cd = nd, cr = nr; const float vv = nv;
                SL_FETCH(sl + 1 < 32 ? sl + 1 : 31);
                f32x2_ pa = {0.f, 0.f}, ya = {0.f, 0.f};
#pragma unroll
                for (int e = 0; e < 4; e += 2) { const f32x2_ s2 = {S[e], S[e + 1]}, k2 = {ck[e], ck[e + 1]}, r2 = {rp4[e], rp4[e + 1]}; pa = pa + s2 * k2; ya = ya + s2 * r2; }
                float pp = pa.x + pa.y, yy = ya.x + ya.y;
                pp = dpp_add(pp, 0); yy = dpp_add(yy, 0); pp = dpp_add(pp, 1); yy = dpp_add(yy, 1); pp = dpp_add(pp, 2); yy = dpp_add(yy, 2); pp = dpp_add(pp, 3); yy = dpp_add(yy, 3);
                py[(sl > 0 ? sl - 1 : 0) * 16] = yy;
#pragma unroll
                for (int e = 0; e < 4; e += 2) { const f32x2_ b2 = {cb[e], cb[e + 1]}, d2 = {cd[e], cd[e + 1]}, w2 = {cw[e], cw[e + 1]}; f32x2_ s2 = {S[e], S[e + 1]};
                    const f32x2_ t2 = d2 * vv - b2 * pp; s2 = s2 * w2 + t2; S[e] = s2.x; S[e + 1] = s2.y; }
                rp4 = cr;
            }
            { f32x2_ ya = {0.f, 0.f};
#pragma unroll
              for (int e = 0; e < 4; e += 2) { const f32x2_ s2 = {S[e], S[e + 1]}, r2 = {rp4[e], rp4[e + 1]}; ya = ya + s2 * r2; }
              const float yy = grp_sum<16>(ya.x + ya.y); py[(nvalid - 1) * 16] = yy; }
#undef SL_FETCH
        } else {
            if (hc > 0 && pw == 0) SL_STORE_Y(hc - 1, (hc - 1) & 1);
            if (hc + 1 < nhalf) { SL_PREP(hc + 1, (hc + 1) & 1); if (hc + 2 < nhalf) SL_LOAD(hc + 2); }
        }
        BAR_LDS();
    }
    if (!scanner && pw == 0) SL_STORE_Y(nhalf - 1, (nhalf - 1) & 1);
#undef SL_STORE_Y
#undef SL_PREP
#undef SL_LOAD
#undef SL_META
}

__device__ __forceinline__ void rwkv_colmap(unsigned char* ws, int c0, bf16*& buf, int& ld, int& col) {
    if (c0 < 512) { buf = (bf16*)(ws + WS_R); ld = 512; col = c0; }
    else if (c0 < 1024) { buf = (bf16*)(ws + WS_KA); ld = 512; col = c0 - 512; }
    else if (c0 < 1536) { buf = (bf16*)(ws + WS_VA); ld = 512; col = c0 - 1024; }
    else { buf = (bf16*)(ws + WS_L); ld = 256; col = c0 - 1536; }
}
__device__ __forceinline__ void phase_halo(KP P) {
    const int tid = fresh_tid(), lane = tid & 63, wid = tid >> 6; const int gw = blockIdx.x * 8 + wid, NGW = gridDim.x * 8;
    unsigned char* ws = P->ws;
    for (int r = gw; r < (NMAIN / 64) * 2; r += NGW) {
        const int m = (r >> 1) * 64 + ((r & 1) ? 63 : 0);
        for (int j = lane; j < 224; j += 64) { bf16* buf; int ld, col; rwkv_colmap(ws, j * 8, buf, ld, col);
            *(u32x4*)(ws + WS_HALO + (size_t)r * HALO_ROW + j * 16) = *(const u32x4*)(buf + (size_t)m * ld + col); }
    }
}
__device__ __forceinline__ void phase_shift(LAS unsigned char* lds, KP P) {
    const int tid = fresh_tid(), slot = tid >> 3, cg = tid & 7;
    unsigned char* ws = P->ws; const float* mup = P->in[I_MUP]; const float* mun = P->in[I_MUN];
    for (int tile = blockIdx.x; tile < NMAIN / 64; tile += gridDim.x) {
        const int m0 = tile * 64, m = m0 + slot;
        const int ks = m0 < 16384 ? tile : ((m0 - 16384) & 2047) >> 6; const bool first = ks == 0, last = ks == (m0 < 16384 ? 255 : 31);
#pragma unroll 1
        for (int pass = 0; pass < 4; ++pass) {
#pragma unroll
            for (int i = 0; i < 7; ++i) { const int j = cg + 8 * i; bf16* buf; int ld, col; rwkv_colmap(ws, (pass * 56 + j) * 8, buf, ld, col);
                *(LAS u32x4*)(lds + (slot * 56 + j) * 16) = *(const u32x4*)(buf + (size_t)m * ld + col); }
            __syncthreads();
#pragma unroll
            for (int i = 0; i < 7; ++i) {
                const int j = cg + 8 * i, c0 = (pass * 56 + j) * 8; bf16* buf; int ld, col; rwkv_colmap(ws, c0, buf, ld, col);
                const u32x4 z = {0u, 0u, 0u, 0u};
                const u32x4 cu = *(const LAS u32x4*)(lds + (slot * 56 + j) * 16);
                u32x4 pu, nu;
                if (slot > 0) pu = *(const LAS u32x4*)(lds + ((slot - 1) * 56 + j) * 16);
                else pu = first ? *(const u32x4*)(buf + (size_t)(METAROW + 15) * ld + col) : *(const u32x4*)(ws + WS_HALO + (size_t)((tile - 1) * 2 + 1) * HALO_ROW + c0 * 2);
                if (slot < 63) nu = *(const LAS u32x4*)(lds + ((slot + 1) * 56 + j) * 16);
                else nu = last ? z : *(const u32x4*)(ws + WS_HALO + (size_t)((tile + 1) * 2) * HALO_ROW + c0 * 2);
                float pv[8], cv[8], nv[8], o[8]; unpack8(pu, pv); unpack8(cu, cv); unpack8(nu, nv);
                const f32x4 mp0 = *(const f32x4*)(mup + c0), mp1 = *(const f32x4*)(mup + c0 + 4), mn0 = *(const f32x4*)(mun + c0), mn1 = *(const f32x4*)(mun + c0 + 4);
#pragma unroll
                for (int e = 0; e < 8; ++e) { const float mp = e < 4 ? mp0[e & 3] : mp1[e & 3], mn = e < 4 ? mn0[e & 3] : mn1[e & 3]; o[e] = cv[e] + mp * (pv[e] - cv[e]) + mn * (nv[e] - cv[e]); }
                if (c0 >= 1536 && c0 < 1600) {
#pragma unroll
                    for (int e = 0; e < 8; ++e) o[e] = fast_tanh(o[e]);
                }
                u32x4 w; w.x = cvtpk(o[0], o[1]); w.y = cvtpk(o[2], o[3]); w.z = cvtpk(o[4], o[5]); w.w = cvtpk(o[6], o[7]);
                *(u32x4*)(buf + (size_t)m * ld + col) = w;
            }
            __syncthreads();
        }
    }
}

__device__ __forceinline__ void phase_post(LAS unsigned char* lds, KP P) {
    const int tid = fresh_tid(), lane = tid & 63, wid = tid >> 6;
    unsigned char* ws = P->ws;
    const bf16* VAb = (const bf16*)(ws + WS_VA); const bf16* Lb = (const bf16*)(ws + WS_L); bf16* Rb = (bf16*)(ws + WS_R);
    const float* CB = (const float*)(ws + WS_CB); const bf16* YD0 = (const bf16*)((const unsigned char*)P->out + 64 * MiB); const bf16* YD1 = YD0 + (size_t)NMAIN * 512;
    const bf16* GT = (const bf16*)(ws + WS_LORA + 262144);
    LAS float* st = (LAS float*)(lds + 17408);
    const float* mup = P->in[I_MUP]; const float* mun = P->in[I_MUN];
    for (int tile = blockIdx.x; tile < NMAIN / 64; tile += gridDim.x) {
        {
            const int row = tid >> 3, hh = tid & 7, m = tile * 64 + row;
            const int t = m < 16384 ? m : (m - 16384) & 2047, Ls = m < 16384 ? 16384 : 2048;
            float sum = 0.f, sq = 0.f;
#pragma unroll
            for (int i = 0; i < 8; ++i) { float a[8], b[8]; unpack8(*(const u32x4*)(YD0 + (size_t)m * 512 + hh * 64 + i * 8), a); unpack8(*(const u32x4*)(YD1 + (size_t)m * 512 + hh * 64 + i * 8), b);
#pragma unroll
                for (int e = 0; e < 8; ++e) { const float y = a[e] + b[e]; sum += y; sq += y * y; } }
            const float mu = sum * (1.0f / 64.0f); const float var = fmaxf(sq * (1.0f / 64.0f) - mu * mu, 0.f);
            st[(row * 8 + hh) * 2] = mu; st[(row * 8 + hh) * 2 + 1] = rsqrtf(var + 64e-5f);
#pragma unroll
            for (int i = 0; i < 2; ++i) {
                const int c0 = 128 + hh * 16 + i * 8; float cv[8], o[8];
                unpack8(*(const u32x4*)(Lb + (size_t)m * 256 + c0), cv);
#pragma unroll
                for (int e = 0; e < 8; ++e) o[e] = sigmoidf_(cv[e]);
                u32x4 w; w.x = cvtpk(o[0], o[1]); w.y = cvtpk(o[2], o[3]); w.z = cvtpk(o[4], o[5]); w.w = cvtpk(o[6], o[7]);
                *(LAS u32x4*)(lds + row * 272 + (hh * 16 + i * 8) * 2) = w;
            }
        }
        __syncthreads();
#pragma unroll 1
        for (int nt = 0; nt < 4; ++nt) {
            const int col = wid * 64 + nt * 16 + (lane & 15);
            bf16x8 bfr[4];
#pragma unroll
            for (int ks = 0; ks < 4; ++ks) bfr[ks] = *(const bf16x8*)(GT + (size_t)col * 128 + ks * 32 + (lane >> 4) * 8);
            const float lw = P->in[I_LNW][col], lb = P->in[I_LNB][col];
            const float mpv = mup[1024 + col], mnv = mun[1024 + col];
#pragma unroll 1
            for (int mt = 0; mt < 4; ++mt) {
                f32x4 acc = {0.f, 0.f, 0.f, 0.f};
#pragma unroll
                for (int ks = 0; ks < 4; ++ks) { const bf16x8 a = *(const LAS bf16x8*)(lds + (mt * 16 + (lane & 15)) * 272 + ks * 64 + (lane >> 4) * 16); acc = __builtin_amdgcn_mfma_f32_16x16x32_bf16(a, bfr[ks], acc, 0, 0, 0); }
#pragma unroll
                for (int rg = 0; rg < 4; ++rg) {
                    const int row = mt * 16 + (lane >> 4) * 4 + rg, m = tile * 64 + row;
                    const int t = m < 16384 ? m : (m - 16384) & 2047, Ls = m < 16384 ? 16384 : 2048;
                    const float y = bf2f(YD0[(size_t)m * 512 + col]) + bf2f(YD1[(size_t)m * 512 + col]);
                    const float yn = (y - st[(row * 8 + wid) * 2]) * st[(row * 8 + wid) * 2 + 1] * lw + lb;
                    const float vs = bf2f(VAb[(size_t)m * 512 + col]);
                    const float cb = CB[(size_t)m * 8 + wid] + CB[((size_t)ROWS + m) * 8 + wid];
                    Rb[(size_t)m * 512 + col] = (bf16)f2bf_rne((yn + cb * vs) * acc[rg]);
                }
            }
        }
        __syncthreads();
    }
}

__device__ __forceinline__ void phase_rms_bf16(KP P) {
    const int tid = fresh_tid(), lane = tid & 63, wid = tid >> 6; const int gw = blockIdx.x * 8 + wid, NGW = gridDim.x * 8;
    bf16* MN = (bf16*)(P->ws + WS_MN);
    for (int m = gw; m < NMAIN; m += NGW) rms_row_bf16(P->out + (size_t)m * DM, P->in[I_GFFN], MN + (size_t)m * DM, lane);
}
__device__ __forceinline__ void phase_final(KP P) {
    const int tid = fresh_tid(), lane = tid & 63, wid = tid >> 6; const int gw = blockIdx.x * 8 + wid, NGW = gridDim.x * 8;
    const f32x4* gr = (const f32x4*)P->in[I_GFIN] + lane;
    for (int m = gw; m < NMAIN; m += NGW) {
        f32x4* xr = (f32x4*)(P->out + (size_t)m * DM) + lane; f32x4 v[4]; float s = 0.f;
#pragma unroll
        for (int j = 0; j < 4; ++j) { v[j] = xr[64 * j]; s += (v[j].x * v[j].x + v[j].y * v[j].y) + (v[j].z * v[j].z + v[j].w * v[j].w); }
        const float rstd = rsqrtf(wave_sum(s) * (1.f / DM) + 1e-6f);
#pragma unroll
        for (int j = 0; j < 4; ++j) xr[64 * j] = v[j] * rstd * gr[64 * j];
    }
}

constexpr int NRP_LONG = 4;
constexpr int N_LONG = 16 * NRP_LONG, N_ATT_P = 512, N_ATT_S = 512, N_SHORT = 128, N_ITEMS = N_LONG + N_ATT_P + N_ATT_S + N_SHORT;

template <class Op> __device__ __forceinline__ void run_gemm(LAS unsigned char* lds, const bf16* A, const bf16* Bt, int M, int N, int K, const Op& op, const bf16* A2 = nullptr, int pm2 = 1 << 30) {
    pg8::Gemm g{A, Bt, M, N, K, A2, pm2}; pg8::StaticOrder S; S.init(M, N, (int)gridDim.x, (int)blockIdx.x);
    Epi8<Op> E{op};
    pg8::gemm_phase<Epi8<Op>, pg8::StaticOrder, true, true>(lds, g, S, E);
}

constexpr size_t WS_XBAR = 16384;
#define XB_TMO      128
#define XB_XCNT(j)  (256  + 64 * (j))
#define XB_XSUB(j)  (1280 + 64 * (j))
#define XB_XGEN(j)  (2304 + 64 * (j))
#define XB_TOP      3328
#define XB_TOPGEN   3392
#define XCD_BAR_WORDS 3456
#define XB_SPIN_CAP (1u << 18)
__device__ __forceinline__ unsigned xb_ld(unsigned* p)              { return __hip_atomic_load(p, __ATOMIC_RELAXED, __HIP_MEMORY_SCOPE_AGENT); }
__device__ __forceinline__ unsigned xb_add(unsigned* p, unsigned v) { return __hip_atomic_fetch_add(p, v, __ATOMIC_RELAXED, __HIP_MEMORY_SCOPE_AGENT); }
__device__ __forceinline__ unsigned xb_xcc_id() { return (unsigned)__builtin_amdgcn_s_getreg((3 << 11) | 20) & 0xFu; }
#define XB_SPIN(cond, bar) do { unsigned _sp = 0; while (cond) { __builtin_amdgcn_s_sleep(1); \
    if ((++_sp & 255u) == 0u) { if (xb_ld(&(bar)[XB_TMO])) break; if (_sp > XB_SPIN_CAP) { atomicAdd(&(bar)[XB_TMO], 1u); break; } } } } while (0)
struct XcdBarrier { unsigned* bar; unsigned x; volatile LAS unsigned* st; };
__device__ __forceinline__ XcdBarrier xcd_barrier_post(unsigned* bar, volatile LAS unsigned* st) {
    XcdBarrier b; b.bar = bar; b.x = xb_xcc_id(); b.st = st;
    if (threadIdx.x == 0) (void)xb_add(&bar[XB_XCNT(b.x)], 1u);
    return b;
}
__device__ __forceinline__ void xcd_barrier_complete(unsigned* bar, unsigned x, unsigned& nloc, unsigned& nx) {
    const unsigned G = gridDim.x * gridDim.y * gridDim.z;
    unsigned sum, cnt, mine, sp = 0u;
    for (;;) {
        sum = 0u; cnt = 0u; mine = 0u;
#pragma unroll
        for (unsigned j = 0; j < 16; ++j) { const unsigned c = xb_ld(&bar[XB_XCNT(j)]); sum += c; cnt += (c > 0u) ? 1u : 0u; mine = (j == x) ? c : mine; }
        if (sum == G) break;
        __builtin_amdgcn_s_sleep(1);
        if ((++sp & 255u) == 0u) { if (xb_ld(&bar[XB_TMO])) break; if (sp > XB_SPIN_CAP) { atomicAdd(&bar[XB_TMO], 1u); break; } }
    }
    nloc = mine > 0u ? mine : 1u; nx = cnt > 0u ? cnt : 1u;
}
__device__ __forceinline__ void xcd_barrier(const XcdBarrier& b) {
    asm volatile("s_waitcnt vmcnt(0)" ::: "memory");
    __syncthreads();
    if (threadIdx.x == 0) {
        unsigned* bar = b.bar;
        __builtin_amdgcn_s_waitcnt(0);
        unsigned nloc = b.st[0], nx = b.st[1];
        if (nloc == 0u) { xcd_barrier_complete(bar, b.x, nloc, nx); b.st[0] = nloc; b.st[1] = nx; }
        const unsigned old = xb_add(&bar[XB_XSUB(b.x)], 1u);
        const unsigned gen = old / nloc;
        if (old + 1u == (gen + 1u) * nloc) {
            __builtin_amdgcn_fence(__ATOMIC_RELEASE, "agent");
            asm volatile("s_waitcnt vmcnt(0)" ::: "memory");
            const unsigned og = xb_add(&bar[XB_TOP], 1u);
            const unsigned tg = og / nx;
            if (og + 1u == (tg + 1u) * nx) xb_add(&bar[XB_TOPGEN], 1u);
            else XB_SPIN(xb_ld(&bar[XB_TOPGEN]) == tg, bar);
            __builtin_amdgcn_fence(__ATOMIC_ACQUIRE, "agent");
            xb_add(&bar[XB_XGEN(b.x)], 1u);
            asm volatile("s_waitcnt vmcnt(0)" ::: "memory");
        } else {
            XB_SPIN(xb_ld(&bar[XB_XGEN(b.x)]) == gen, bar);
            __builtin_amdgcn_fence(__ATOMIC_ACQUIRE, "agent");
            asm volatile("s_waitcnt vmcnt(0)" ::: "memory");
        }
    }
    __syncthreads();
}
#ifndef PROBE_MASK
#define PROBE_MASK 0
#endif
#ifndef PROBE_MUL
#define PROBE_MUL 1
#endif
#define PH_BEGIN(k) unsigned long long t0_##k = 0; if (PROBE_MASK & (1 << (k))) t0_##k = __builtin_amdgcn_s_memrealtime();
#define PH_END(k) if (PROBE_MASK & (1 << (k))) { const unsigned long long t1_ = __builtin_amdgcn_s_memrealtime(); const unsigned long long dt_ = (t1_ - t0_##k) * PROBE_MUL; while (__builtin_amdgcn_s_memrealtime() - t1_ < dt_) __builtin_amdgcn_s_sleep(8); xcd_barrier(xbar); }
__global__ void __launch_bounds__(NTHREADS) fwd_megakernel(Params Pin) {
    extern __shared__ __attribute__((aligned(16))) unsigned char lds_raw[];
    LAS unsigned char* lds = (LAS unsigned char*)lds_raw;
    cg::grid_group grid = cg::this_grid();
    KP P0 = (KP)__builtin_amdgcn_kernarg_segment_ptr();
    volatile LAS unsigned* xst = (volatile LAS unsigned*)(lds + LDS_ITEM_OFF + 4);
    if (threadIdx.x == 0) { xst[0] = 0u; xst[1] = 0u; }
    __syncthreads();
    const XcdBarrier xbar = xcd_barrier_post((unsigned*)(P0->ws + WS_XBAR), xst);
#define NEWPHASE KP P = P0; asm volatile("" : "+s"(P)); unsigned char* ws = P->ws; (void)ws;

    PH_BEGIN(0)
    { NEWPHASE phase_prologue(lds, P); }
    grid.sync();
    PH_END(0)
    PH_BEGIN(1)
    { NEWPHASE run_gemm(lds, (const bf16*)P->out, (const bf16*)(ws + WS_WIN), ROWS, 3328, 1024, OpProj{ws}, (const bf16*)(ws + WS_XNMETA), 128); }
    xcd_barrier(xbar);
    PH_END(1)
    { NEWPHASE phase_halo(P); }
    xcd_barrier(xbar);
    { NEWPHASE phase_shift(lds, P); }
    xcd_barrier(xbar);
    PH_BEGIN(2)
    { NEWPHASE
        const int tid = fresh_tid();
        float lam;
        { const int lane = tid & 63; const float s1 = wave_sum(P->in[I_LQ1][lane] * P->in[I_LK1][lane]), s2 = wave_sum(P->in[I_LQ2][lane] * P->in[I_LK2][lane]); lam = __expf(s1) - __expf(s2) + 0.2f; }
        unsigned* ctr = (unsigned*)(ws + WS_CTL);
        LAS unsigned* slot = (LAS unsigned*)(lds + LDS_ITEM_OFF);
#define FETCH(k, n) if (tid == 0) *slot = atomicAdd(ctr + 64 * (k), 1u); __syncthreads(); const int idx = (int)*slot; __syncthreads(); if (idx >= (n)) break;
#ifndef NO_SCAN
#pragma unroll 1
        for (;;) { FETCH(0, N_LONG) const int u = idx / NRP_LONG; scan_long(lds, P, 0, u >> 3, u & 7, idx % NRP_LONG); }
#endif
#ifndef NO_ATTN
#pragma unroll 1
        for (;;) { FETCH(1, N_ATT_P + N_ATT_S)
            if (idx < N_ATT_P) attn_unit(lds, P, 0, idx >> 7, idx & 127, lam);
            else { const int a = idx - N_ATT_P; attn_unit(lds, P, 1 + (a >> 6), (a >> 4) & 3, a & 15, lam); } }
#endif
#ifndef NO_SCAN
#pragma unroll 1
        for (;;) { FETCH(2, N_SHORT) scan_unit<1, 8>(lds, P, 1 + (idx >> 4), (idx >> 3) & 1, idx & 7, 0); }
#endif
#undef FETCH
    }
    xcd_barrier(xbar);
    PH_END(2)
#ifndef NO_POST
    PH_BEGIN(3)
    { NEWPHASE phase_post(lds, P); }
#endif
    xcd_barrier(xbar);
    PH_END(3)
    PH_BEGIN(4)
    { NEWPHASE run_gemm(lds, (const bf16*)P->out, (const bf16*)(ws + WS_WIN) + (size_t)3328 * 1024, NMAIN, 1024, 1024, OpGate{(bf16*)(ws + WS_GA)}); }
    { NEWPHASE run_gemm(lds, (const bf16*)P->out, (const bf16*)(ws + WS_WIN) + (size_t)4352 * 1024, NMAIN, 1024, 1024, OpGate{(bf16*)(ws + WS_GB)}); }

    PH_END(4)
    PH_BEGIN(5)
    { NEWPHASE run_gemm(lds, (const bf16*)(ws + WS_R), (const bf16*)(ws + WS_WUPA), NMAIN, 1024, 512, OpUpA{ws}); }
    PH_END(5)
    PH_BEGIN(6)
    { NEWPHASE run_gemm(lds, (const bf16*)(ws + WS_Q), (const bf16*)(ws + WS_WUPB), NMAIN, 1024, 512, OpUpB{ws}); }
    xcd_barrier(xbar);
    PH_END(6)
    PH_BEGIN(7)
    { NEWPHASE run_gemm(lds, (const bf16*)(ws + WS_GB), (const bf16*)(ws + WS_WOUT), NMAIN, 1024, 1024, OpOut{P->in[I_XP], P->in[I_XS], P->out}); }
    xcd_barrier(xbar);
    PH_END(7)
    PH_BEGIN(8)
    { NEWPHASE phase_rms_bf16(P); }
    xcd_barrier(xbar);
    PH_END(8)
    PH_BEGIN(9)
    { NEWPHASE run_gemm(lds, (const bf16*)(ws + WS_MN), (const bf16*)(ws + WS_WFF1), 16384, DFF, 1024, OpFF1{(bf16*)(ws + WS_HID)}); }
    xcd_barrier(xbar);
    PH_END(9)
    PH_BEGIN(10)
    { NEWPHASE run_gemm(lds, (const bf16*)(ws + WS_HID), (const bf16*)(ws + WS_WFF2), 16384, 1024, DFF, OpFF2{P->out}); }
    xcd_barrier(xbar);
    PH_END(10)
    PH_BEGIN(11)
    { NEWPHASE run_gemm(lds, (const bf16*)(ws + WS_MN) + (size_t)16384 * DM, (const bf16*)(ws + WS_WFF1), 16384, DFF, 1024, OpFF1{(bf16*)(ws + WS_HID)}); }
    xcd_barrier(xbar);
    PH_END(11)
    PH_BEGIN(12)
    { NEWPHASE run_gemm(lds, (const bf16*)(ws + WS_HID), (const bf16*)(ws + WS_WFF2), 16384, 1024, DFF, OpFF2{P->out + (size_t)16384 * DM}); }
    xcd_barrier(xbar);
    PH_END(12)
    PH_BEGIN(13)
    { NEWPHASE phase_final(P); }
}

extern "C" void kernel_launch(void* const* d_in, const int* in_sizes, int n_in, void* d_out, int out_size, void* d_ws, size_t ws_size, hipStream_t stream) {
    static int grid_blocks = 0;
    if (grid_blocks == 0) {
        int dev = 0, cus = 0, per_cu = 0;
        hipGetDevice(&dev);
        hipDeviceGetAttribute(&cus, hipDeviceAttributeMultiprocessorCount, dev);
        hipFuncSetAttribute((const void*)fwd_megakernel, hipFuncAttributeMaxDynamicSharedMemorySize, LDS_BYTES);
        hipOccupancyMaxActiveBlocksPerMultiprocessor(&per_cu, (const void*)fwd_megakernel, NTHREADS, LDS_BYTES);
        if (per_cu < 1) { fprintf(stderr, "kernel_launch: occupancy query says %d blocks per CU\n", per_cu); per_cu = 1; }
        grid_blocks = cus * per_cu;
        if (n_in != 29 || ws_size < WS_END) fprintf(stderr, "kernel_launch: unexpected n_in %d / ws_size %zu\n", n_in, ws_size);
    }
    hipMemsetAsync((unsigned char*)d_ws + WS_CTL, 0, 32768, stream);
    Params p{};
    for (int i = 0; i < 29; ++i) p.in[i] = (const float*)d_in[i];
    p.out = (float*)d_out; p.ws = (unsigned char*)d_ws;
    void* args[] = {&p};
    hipError_t e = hipLaunchCooperativeKernel((const void*)fwd_megakernel, dim3(grid_blocks), dim3(NTHREADS), args, LDS_BYTES, stream);
    if (e != hipSuccess) fprintf(stderr, "cooperative launch failed: %s (grid %d)\n", hipGetErrorString(e), grid_blocks);
}
```

```cpp
#include <hip/hip_runtime.h>
#include <hip/hip_cooperative_groups.h>
#include <cstdio>
#include <cstdint>
#include <cmath>
namespace cg = cooperative_groups;
__device__ __forceinline__ int fresh_tid() { int t = threadIdx.x; asm volatile("" : "+v"(t)); return t; }
namespace pg8 {
#define PG8_LAS __attribute__((address_space(3)))
typedef unsigned short bf16_t;
typedef short bf16x8 __attribute__((ext_vector_type(8)));
typedef float f32x4 __attribute__((ext_vector_type(4)));
typedef unsigned u32x4 __attribute__((ext_vector_type(4)));
constexpr int BM = 256, BK = 64, HALF = 128, HTB = HALF * BK * 2  , STAGE_BYTES = 8 * HTB, NXCD = 8, WGM = 8;

__host__ __device__ __forceinline__ int lds_byte(int r, int c) { const int st = (r >> 4) * 2 + (c >> 5), rr = r & 15, cc = c & 31, ob = rr * 64 + cc * 2; return st * 1024 + (ob ^ (((ob >> 9) & 1) << 5)); }
__host__ __device__ __forceinline__ void stage_rc(int b, int& R, int& C) { const int st = b / 1024, sb = b % 1024, swz = sb ^ (((sb >> 9) & 1) << 5); R = (st >> 1) * 16 + swz / 64; C = (st & 1) * 32 + (swz % 64) / 2; }
__host__ __device__ __forceinline__ int perm32(int rho) { const int n = rho >> 4, i = rho & 15; return 8 * (i >> 2) + 4 * n + (i & 3); }

struct Unit { int pm, pn; };
struct Gemm { const bf16_t* A; const bf16_t* Bt; int M, N, K; const bf16_t* A2; int pm2; };
__device__ __forceinline__ const char* gemm_abase(const Gemm& g, int pm, size_t tstep) { return pm >= g.pm2 ? (const char*)g.A2 + (size_t)(pm - g.pm2) * tstep : (const char*)g.A + (size_t)pm * tstep; }

struct StaticOrder {
    int nM, nN, nwg, G, c;
    __host__ __device__ void init(int M, int N, int G_, int c_) { nM = M / BM; nN = N / BM; nwg = nM * nN; G = G_; c = c_; }
    __host__ __device__ bool next(int i, Unit& u) const {
        const long L = (long)i * G + c; if (L >= nwg) return false;
        int wgid = (int)L; { const int q = nwg / NXCD, r = nwg % NXCD, xcd = wgid % NXCD, off = wgid / NXCD; wgid = (xcd < r ? xcd * (q + 1) : r * (q + 1) + (xcd - r) * q) + off; }
        const int nig = WGM * nN, gid = wgid / nig, fm = gid * WGM, gsz = (nM - fm) < WGM ? (nM - fm) : WGM;
        u.pm = fm + ((wgid % nig) % gsz); u.pn = (wgid % nig) / gsz; return true;
    }
    __device__ __forceinline__ void a_ready(const Unit&) const {}
    __device__ __forceinline__ void done(const Unit&) const {}
};


template <class Epi, class Sched, bool ALIGN_EPI = false, bool SP2 = false>
__device__ __forceinline__ void gemm_phase(PG8_LAS unsigned char* lds, const Gemm g, const Sched& S, const Epi& E) {
    const int tid = fresh_tid(), wid = __builtin_amdgcn_readfirstlane(tid >> 6), lane = tid & 63, wr = wid >> 2, wc = wid & 3, fr = lane & 15, fq = lane >> 4;
    const int K = g.K, nt = K / BK;
    unsigned voffA[2], voffB[2];
#pragma unroll
    for (int i = 0; i < 2; ++i) { int R, C; stage_rc(tid * 16 + i * 8192, R, C); const int Rb = Epi::PERM ? ((R & ~31) + perm32(R & 31)) : R;
        voffA[i] = (unsigned)(R * K + C) * 2u; voffB[i] = (unsigned)(Rb * K + C) * 2u; }
    const size_t kstep = (size_t)(BK * 2);
    const size_t hstep = (size_t)HALF * K * 2;
    const size_t tstep = 2 * hstep;
    const unsigned ldsw = (unsigned)wid * 1024u;
    const int aoff = lds_byte(wr * 64 + fr, fq * 8), boff = lds_byte(wc * 32 + fr, fq * 8);
#define PG8_SA(b, h) (((b) * 2 + (h)) * HTB)
#define PG8_SB(b, h) ((4 + (b) * 2 + (h)) * HTB)
#define PG8_STAGE(bufoff, gbase, voff) do { _Pragma("unroll") for (int _i = 0; _i < 2; ++_i) \
        __builtin_amdgcn_global_load_lds((const unsigned*)((const char*)(gbase) + (voff)[_i]), (PG8_LAS unsigned*)(lds + (bufoff) + ldsw + _i * 8192), 16, 0, 0); } while (0)
#define PG8_LDA(dst, b, h) do { _Pragma("unroll") for (int m = 0; m < 4; ++m) _Pragma("unroll") for (int k = 0; k < 2; ++k) dst[m][k] = *(const PG8_LAS bf16x8*)(lds + PG8_SA(b, h) + aoff + m * 2048 + k * 1024); } while (0)
#define PG8_LDB(dst, b, h) do { _Pragma("unroll") for (int n = 0; n < 2; ++n) _Pragma("unroll") for (int k = 0; k < 2; ++k) dst[n][k] = *(const PG8_LAS bf16x8*)(lds + PG8_SB(b, h) + boff + n * 2048 + k * 1024); } while (0)
#define PG8_MMA(ai, bj, At, Bt) do { __builtin_amdgcn_s_setprio(1); _Pragma("unroll") for (int m = 0; m < 4; ++m) _Pragma("unroll") for (int n = 0; n < 2; ++n) _Pragma("unroll") for (int k = 0; k < 2; ++k) \
        acc[ai][bj][m][n] = __builtin_amdgcn_mfma_f32_16x16x32_bf16(Bt[n][k], At[m][k], acc[ai][bj][m][n], 0, 0, 0); __builtin_amdgcn_s_setprio(0); } while (0)
#define PG8_WAIT_V(n) asm volatile("s_waitcnt vmcnt(" #n ")" ::: "memory")
#define PG8_WAIT_L(n) asm volatile("s_waitcnt lgkmcnt(" #n ")" ::: "memory")
#define PG8_BAR __builtin_amdgcn_s_barrier()
#define PG8_SCHED __builtin_amdgcn_sched_barrier(0)
    Unit cur, nxt; int ui = 0;
    if (!S.next(0, cur)) return;
    f32x4 acc[2][2][4][2];
#pragma unroll
    for (int a = 0; a < 2; ++a)
#pragma unroll
        for (int b = 0; b < 2; ++b)
#pragma unroll
            for (int m = 0; m < 4; ++m)
#pragma unroll
                for (int n = 0; n < 2; ++n) acc[a][b][m][n] = (f32x4){0.f, 0.f, 0.f, 0.f};
    bf16x8 At[4][2], B0[2][2], B1[2][2];
    const char* cA = gemm_abase(g, cur.pm, tstep); const char* cB = (const char*)g.Bt + (size_t)cur.pn * tstep;
    S.a_ready(cur);
    if constexpr (SP2) {
        PG8_STAGE(PG8_SB(0, 0), cB, voffB); PG8_STAGE(PG8_SB(0, 1), cB + hstep, voffB); PG8_STAGE(PG8_SA(0, 0), cA, voffA); PG8_STAGE(PG8_SA(0, 1), cA + hstep, voffA);
        if (wr == 1) PG8_BAR;
        PG8_WAIT_V(2); PG8_BAR;
        PG8_STAGE(PG8_SB(1, 0), cB + kstep, voffB); PG8_STAGE(PG8_SA(1, 0), cA + kstep, voffA); PG8_STAGE(PG8_SB(1, 1), cB + hstep + kstep, voffB);
        PG8_WAIT_V(6); PG8_BAR;
    } else {
        PG8_STAGE(PG8_SB(0, 0), cB, voffB); PG8_STAGE(PG8_SA(0, 0), cA, voffA); PG8_STAGE(PG8_SB(0, 1), cB + hstep, voffB); PG8_STAGE(PG8_SA(0, 1), cA + hstep, voffA);
        if (wr == 1) PG8_BAR;
        PG8_WAIT_V(4); PG8_BAR;
        PG8_STAGE(PG8_SB(1, 0), cB + kstep, voffB); PG8_STAGE(PG8_SA(1, 0), cA + kstep, voffA); PG8_STAGE(PG8_SB(1, 1), cB + hstep + kstep, voffB);
        PG8_WAIT_V(6); PG8_BAR;
    }
    for (;;) {
        const bool has_next = S.next(ui + 1, nxt);
        const char* nA = has_next ? gemm_abase(g, nxt.pm, tstep) : cA; const char* nB = has_next ? (const char*)g.Bt + (size_t)nxt.pn * tstep : cB;
        for (int t = 0; t < nt; t += 2) {
            const bool last = (t == nt - 2);
            const char* a1 = cA + (size_t)(t + 1) * kstep;
            const char* a2 = last ? nA : cA + (size_t)(t + 2) * kstep; const char* b2 = last ? nB : cB + (size_t)(t + 2) * kstep;
            const char* a3 = a2 + kstep; const char* b3 = b2 + kstep;
            if (last && has_next) S.a_ready(nxt);
            if constexpr (SP2) {
            PG8_LDB(B0, 0, 0); PG8_LDB(B1, 0, 1); PG8_SCHED; PG8_LDA(At, 0, 0); PG8_STAGE(PG8_SA(1, 1), a1 + hstep, voffA);
            PG8_WAIT_V(8); PG8_WAIT_L(0); PG8_BAR; PG8_MMA(0, 0, At, B0); PG8_MMA(0, 1, At, B1); PG8_BAR; PG8_SCHED;
            PG8_LDA(At, 0, 1); PG8_STAGE(PG8_SB(0, 0), b2, voffB); PG8_STAGE(PG8_SB(0, 1), b2 + hstep, voffB); PG8_STAGE(PG8_SA(0, 0), a2, voffA);
            PG8_WAIT_V(8); PG8_WAIT_L(0); PG8_BAR; PG8_MMA(1, 0, At, B0); PG8_MMA(1, 1, At, B1); PG8_BAR; PG8_SCHED;
            PG8_LDB(B0, 1, 0); PG8_LDB(B1, 1, 1); PG8_SCHED; PG8_LDA(At, 1, 0); PG8_STAGE(PG8_SA(0, 1), a2 + hstep, voffA);
            PG8_WAIT_V(8); PG8_WAIT_L(0); PG8_BAR; PG8_MMA(0, 0, At, B0); PG8_MMA(0, 1, At, B1); PG8_BAR; PG8_SCHED;
            PG8_LDA(At, 1, 1); PG8_STAGE(PG8_SB(1, 0), b3, voffB); PG8_STAGE(PG8_SB(1, 1), b3 + hstep, voffB); PG8_STAGE(PG8_SA(1, 0), a3, voffA);
            PG8_WAIT_V(8); PG8_WAIT_L(0); PG8_BAR; PG8_MMA(1, 0, At, B0); PG8_MMA(1, 1, At, B1); PG8_BAR; PG8_SCHED;
            } else {
            PG8_LDB(B0, 0, 0); PG8_SCHED; PG8_LDA(At, 0, 0); PG8_STAGE(PG8_SA(1, 1), a1 + hstep, voffA);
            PG8_WAIT_L(8); PG8_BAR; PG8_WAIT_L(0); PG8_MMA(0, 0, At, B0); PG8_BAR; PG8_SCHED;
            PG8_LDB(B1, 0, 1); PG8_STAGE(PG8_SB(0, 0), b2, voffB);
            PG8_BAR; PG8_WAIT_L(0); PG8_MMA(0, 1, At, B1); PG8_BAR;
            PG8_LDA(At, 0, 1); PG8_STAGE(PG8_SA(0, 0), a2, voffA);
            PG8_BAR; PG8_WAIT_L(0); PG8_MMA(1, 0, At, B0); PG8_BAR; PG8_SCHED;
            PG8_STAGE(PG8_SB(0, 1), b2 + hstep, voffB);
            PG8_WAIT_V(6); PG8_BAR; PG8_MMA(1, 1, At, B1); PG8_BAR;
            PG8_LDB(B0, 1, 0); PG8_SCHED; PG8_LDA(At, 1, 0); PG8_STAGE(PG8_SA(0, 1), a2 + hstep, voffA);
            PG8_WAIT_L(8); PG8_BAR; PG8_WAIT_L(0); PG8_MMA(0, 0, At, B0); PG8_BAR; PG8_SCHED;
            PG8_LDB(B1, 1, 1); PG8_STAGE(PG8_SB(1, 0), b3, voffB);
            PG8_BAR; PG8_WAIT_L(0); PG8_MMA(0, 1, At, B1); PG8_BAR;
            PG8_LDA(At, 1, 1); PG8_STAGE(PG8_SA(1, 0), a3, voffA);
            PG8_BAR; PG8_WAIT_L(0); PG8_MMA(1, 0, At, B0); PG8_BAR; PG8_SCHED;
            PG8_STAGE(PG8_SB(1, 1), b3 + hstep, voffB);
            PG8_WAIT_V(6); PG8_BAR; PG8_MMA(1, 1, At, B1); PG8_BAR;
            }
        }
        if constexpr (ALIGN_EPI) { if (wr == 0) PG8_BAR; }
        if constexpr (!Epi::AFTER_DRAIN) { E(acc, cur, wr, wc, fr, fq); S.done(cur); }
        if (!has_next) break;
#pragma unroll
        for (int a = 0; a < 2; ++a)
#pragma unroll
            for (int b = 0; b < 2; ++b)
#pragma unroll
                for (int m = 0; m < 4; ++m)
#pragma unroll
                    for (int n = 0; n < 2; ++n) acc[a][b][m][n] = (f32x4){0.f, 0.f, 0.f, 0.f};
        cur = nxt; cA = nA; cB = nB; ++ui;
        if constexpr (ALIGN_EPI) { if (wr == 1) PG8_BAR; }
    }
    PG8_WAIT_V(0);
    if constexpr (!ALIGN_EPI) { if (wr == 0) PG8_BAR; }
    PG8_BAR;
    if constexpr (Epi::AFTER_DRAIN) { E.fused(acc, cur, wr, wc, fr, fq, lds, wid, lane); S.done(cur); }
#undef PG8_SA
#undef PG8_SB
#undef PG8_STAGE
#undef PG8_LDA
#undef PG8_LDB
#undef PG8_MMA
#undef PG8_WAIT_V
#undef PG8_WAIT_L
#undef PG8_BAR
#undef PG8_SCHED
}
}

#ifndef PG8_SP2
#define PG8_SP2 true
#endif

#define LAS __attribute__((address_space(3)))
typedef unsigned short bf16;
typedef short bf16x8 __attribute__((ext_vector_type(8)));
typedef float f32x4 __attribute__((ext_vector_type(4)));
typedef float f32x16 __attribute__((ext_vector_type(16)));
typedef unsigned u32x4 __attribute__((ext_vector_type(4)));
typedef unsigned u32x2 __attribute__((ext_vector_type(2)));

constexpr int DM = 1024, NMAIN = 32768, ROWS = 33024, METAROW = 32768, DFF = 4096;
constexpr int NTHREADS = 512;
constexpr int LDS_BYTES = 147456;
constexpr int LDS_ITEM_OFF = LDS_BYTES - 16;
constexpr size_t MiB = 1u << 20;
constexpr size_t WS_CTL = 0, WS_WIN = 1 * MiB, WS_WUPA = 12 * MiB, WS_WUPB = 13 * MiB, WS_WOUT = 14 * MiB, WS_WFF1 = 16 * MiB, WS_WFF2 = 24 * MiB;
constexpr size_t WS_LORA = 32 * MiB, WS_XNMETA = 32 * MiB + 512 * 1024, WS_CB = 33 * MiB, WS_ACT = 36 * MiB;
constexpr size_t ACT_SZ = (size_t)ROWS * 512 * 2, L_SZ = (size_t)ROWS * 256 * 2;
constexpr size_t WS_R = WS_ACT, WS_KA = WS_R + ACT_SZ, WS_VA = WS_KA + ACT_SZ, WS_L = WS_VA + ACT_SZ, WS_Q = WS_L + L_SZ, WS_KB = WS_Q + ACT_SZ, WS_VT = WS_KB + ACT_SZ, WS_END = WS_VT + ACT_SZ;
constexpr size_t WS_GA = WS_KA, WS_GB = WS_KB, WS_MN = WS_ACT, WS_HID = WS_ACT + 64 * MiB;
constexpr size_t WS_HALO = WS_END;
constexpr int HALO_ROW = 3584;
static_assert(WS_HALO + (size_t)(NMAIN / 64) * 2 * HALO_ROW <= 256 * MiB, "halo buffer");
static_assert(WS_END <= 256 * MiB && WS_HID + 128 * MiB <= 256 * MiB && WS_CB + (size_t)2 * ROWS * 8 * 4 <= WS_ACT, "ws map");
constexpr float LOG2E = 1.4426950408889634f;
constexpr float QSCALE = 0.125f * LOG2E;

struct Params { const float* in[29]; float* out; unsigned char* ws; };
typedef const __attribute__((address_space(4))) Params* KP;
enum { I_XP = 0, I_XS, I_META, I_GMIX, I_WIN, I_MUP, I_MUN, I_W0, I_WUP, I_A0, I_AUP, I_GUP, I_KK, I_KA, I_RK, I_LNW, I_LNB, I_LQ1, I_LK1, I_LQ2, I_LK2, I_SUBG, I_UPA, I_UPB, I_WOUT, I_GFFN, I_FF1, I_FF2, I_GFIN };

__device__ __forceinline__ unsigned cvtpk(float lo, float hi) { unsigned r; asm volatile("v_cvt_pk_bf16_f32 %0, %1, %2" : "=v"(r) : "v"(lo), "v"(hi)); return r; }
__device__ __forceinline__ float bf2f(unsigned short b) { return __uint_as_float(((unsigned)b) << 16); }
__device__ __forceinline__ float bflo(unsigned w) { return __uint_as_float(w << 16); }
__device__ __forceinline__ float bfhi(unsigned w) { return __uint_as_float(w & 0xffff0000u); }
__device__ __forceinline__ void unpack8(const u32x4 v, float* o) { o[0] = bflo(v.x); o[1] = bfhi(v.x); o[2] = bflo(v.y); o[3] = bfhi(v.y); o[4] = bflo(v.z); o[5] = bfhi(v.z); o[6] = bflo(v.w); o[7] = bfhi(v.w); }
__device__ __forceinline__ float wave_sum(float v) {
#pragma unroll
    for (int o = 1; o < 64; o <<= 1) v += __shfl_xor(v, o);
    return v;
}
__device__ __forceinline__ float sigmoidf_(float x) { return 1.0f / (1.0f + __expf(-x)); }
__device__ __forceinline__ int seq_base(int s) { return s == 0 ? 0 : 16384 + (s - 1) * 2048; }
__device__ __forceinline__ int seq_len(int s) { return s == 0 ? 16384 : 2048; }
__device__ __forceinline__ int pos_row(int base, int p) { return p < 16 ? METAROW + p : base + p - 16; }

template <class Op> struct Epi8 {
    static constexpr bool PERM = true, AFTER_DRAIN = false;
    Op op;
    __device__ __forceinline__ void operator()(const pg8::f32x4 (&acc)[2][2][4][2], const pg8::Unit& u, int wr, int wc, int fr, int fq) const {
        const int row0 = u.pm * 256 + wr * 64 + fr, col0 = u.pn * 256 + wc * 32 + 8 * fq;
#pragma unroll
        for (int ai = 0; ai < 2; ++ai)
#pragma unroll
            for (int m = 0; m < 4; ++m)
#pragma unroll
                for (int bj = 0; bj < 2; ++bj) { op.apply(row0 + ai * 128 + m * 16, col0 + bj * 128, u.pn, acc[ai][bj][m][0], acc[ai][bj][m][1]); asm volatile("" ::: "memory"); }
    }
};
__device__ __forceinline__ u32x4 pack8(const f32x4 a, const f32x4 b) { u32x4 w; w.x = cvtpk(a[0], a[1]); w.y = cvtpk(a[2], a[3]); w.z = cvtpk(b[0], b[1]); w.w = cvtpk(b[2], b[3]); return w; }

constexpr int CW_KN = 320;
__device__ __forceinline__ float dpp_max16(float v) {
    int x = __float_as_int(v);
    v = fmaxf(v, __int_as_float(__builtin_amdgcn_update_dpp(0, x, 0xB1, 0xf, 0xf, true))); x = __float_as_int(v);
    v = fmaxf(v, __int_as_float(__builtin_amdgcn_update_dpp(0, x, 0x4E, 0xf, 0xf, true))); x = __float_as_int(v);
    v = fmaxf(v, __int_as_float(__builtin_amdgcn_update_dpp(0, x, 0x141, 0xf, 0xf, true))); x = __float_as_int(v);
    v = fmaxf(v, __int_as_float(__builtin_amdgcn_update_dpp(0, x, 0x140, 0xf, 0xf, true)));
    return v;
}
struct OpProj {
    unsigned char* ws;
    __device__ __forceinline__ void apply(int row, int col, int pn, f32x4 v0, f32x4 v1) const {
        if (pn >= 11) {
            bf16* VT = (bf16*)(ws + WS_VT); const int c = col - 11 * 256;
#pragma unroll
            for (int e = 0; e < 4; ++e) { bf16* vt = VT + ((size_t)(row >> 6) * 512 + c) * 64 + (row & 63);
                vt[e * 64] = (bf16)(cvtpk(v0[e], 0.f) & 0xffffu); vt[(4 + e) * 64] = (bf16)(cvtpk(v1[e], 0.f) & 0xffffu); }
            return;
        }
        bf16* O; int ldc = 512, c;
        if (pn < 2) { O = (bf16*)(ws + WS_R); c = col; }
        else if (pn < 4) { O = (bf16*)(ws + WS_KA); c = col - 512; }
        else if (pn < 6) { O = (bf16*)(ws + WS_VA); c = col - 1024; }
        else if (pn < 7) { O = (bf16*)(ws + WS_L); c = col - 1536; ldc = 256; }
        else if (pn < 9) { O = (bf16*)(ws + WS_Q); c = col - 1792; v0 = v0 * QSCALE; v1 = v1 * QSCALE; }
        else { O = (bf16*)(ws + WS_KB); c = col - 2304; }
        const u32x4 w = pack8(v0, v1);
        *(u32x4*)(O + (size_t)row * ldc + c) = w;
        if (pn >= 9) {
            float k8[8]; unpack8(w, k8); float ss = 0.f;
#pragma unroll
            for (int e = 0; e < 8; ++e) ss = fmaf(k8[e], k8[e], ss);
            ss = dpp_max16(ss);
            if ((threadIdx.x & 15) == 0) { const int sidx = row < 16384 ? 0 : row < NMAIN ? 1 + ((row - 16384) >> 11) : 9;
                atomicMax((unsigned*)(ws + WS_CTL) + CW_KN + sidx * 64 + (c >> 3), __float_as_uint(ss)); }
        }
    }
};
struct OpGate {
    bf16* O;
    __device__ __forceinline__ void apply(int row, int col, int pn, f32x4 v0, f32x4 v1) const {
        const int c = col;
#pragma unroll
        for (int e = 0; e < 4; ++e) { v0[e] = sigmoidf_(v0[e]); v1[e] = sigmoidf_(v1[e]); }
        *(u32x4*)(O + (size_t)row * 1024 + c) = pack8(v0, v1);
    }
};
struct OpUpA {
    unsigned char* ws;
    __device__ __forceinline__ void apply(int row, int col, int pn, f32x4 v0, f32x4 v1) const {
        u32x4* p = (u32x4*)((bf16*)(ws + WS_GA) + (size_t)row * 1024 + col); float g[8]; unpack8(*p, g);
#pragma unroll
        for (int e = 0; e < 4; ++e) { v0[e] *= g[e]; v1[e] *= g[4 + e]; }
        *p = pack8(v0, v1);
    }
};
struct OpUpB {
    unsigned char* ws;
    __device__ __forceinline__ void apply(int row, int col, int pn, f32x4 v0, f32x4 v1) const {
        u32x4* p = (u32x4*)((bf16*)(ws + WS_GB) + (size_t)row * 1024 + col); float g[8], a[8]; unpack8(*p, g);
        unpack8(*(const u32x4*)((const bf16*)(ws + WS_GA) + (size_t)row * 1024 + col), a);
#pragma unroll
        for (int e = 0; e < 4; ++e) { v0[e] = a[e] + v0[e] * g[e]; v1[e] = a[4 + e] + v1[e] * g[4 + e]; }
        *p = pack8(v0, v1);
    }
};
struct OpOut {
    const float* xp; const float* xs; float* out;
    __device__ __forceinline__ void apply(int row, int col, int pn, f32x4 v0, f32x4 v1) const {
        const float* x = (row < 16384 ? xp + (size_t)row * DM : xs + (size_t)(row - 16384) * DM) + col;
        float* o = out + (size_t)row * DM + col;
        *(f32x4*)o = *(const f32x4*)x + v0; *(f32x4*)(o + 4) = *(const f32x4*)(x + 4) + v1;
    }
};
struct OpFF1 {
    bf16* hid;
    __device__ __forceinline__ void apply(int row, int col, int pn, f32x4 v0, f32x4 v1) const {
#pragma unroll
        for (int e = 0; e < 4; ++e) { const float a = fmaxf(v0[e], 0.f), b = fmaxf(v1[e], 0.f); v0[e] = a * a; v1[e] = b * b; }
        *(u32x4*)(hid + (size_t)row * DFF + col) = pack8(v0, v1);
    }
};
struct OpFF2 {
    float* out;
    __device__ __forceinline__ void apply(int row, int col, int pn, f32x4 v0, f32x4 v1) const {
        float* o = out + (size_t)row * DM + col;
        *(f32x4*)o = *(const f32x4*)o + v0; *(f32x4*)(o + 4) = *(const f32x4*)(o + 4) + v1;
    }
};

__device__ __forceinline__ unsigned f2bf_rne(float f) { return cvtpk(f, 0.f) & 0xffffu; }
__device__ __forceinline__ void transpose_item(const float* W, int K, int N, bf16* WT, LAS float* scr, int item, int lane) {
    const int nblk = N / 32, kb = item / nblk, nb = item % nblk, k0 = 64 * kb, n0 = 32 * nb;
#pragma unroll 8
    for (int i = 0; i < 32; ++i) { const int kk = 2 * i + (lane >> 5); scr[kk * 33 + (lane & 31)] = W[(size_t)(k0 + kk) * N + n0 + (lane & 31)]; }
    asm volatile("s_waitcnt vmcnt(0) lgkmcnt(0)" ::: "memory");
    const int c = lane & 7;
#pragma unroll
    for (int j = 0; j < 4; ++j) { const int n = (lane >> 3) + 8 * j; const LAS float* s = scr + (8 * c) * 33 + n;
        u32x4 o; o.x = cvtpk(s[0 * 33], s[1 * 33]); o.y = cvtpk(s[2 * 33], s[3 * 33]); o.z = cvtpk(s[4 * 33], s[5 * 33]); o.w = cvtpk(s[6 * 33], s[7 * 33]);
        *(u32x4*)(WT + (size_t)(n0 + n) * K + k0 + 8 * c) = o; }
    asm volatile("s_waitcnt lgkmcnt(0)" ::: "memory");
}
__device__ __forceinline__ void rms_row_bf16(const float* src, const float* g, bf16* dst, int lane) {
    unsigned long long* o8 = (unsigned long long*)dst + lane;
    if (!src) {
#pragma unroll
        for (int j = 0; j < 4; ++j) o8[64 * j] = 0ull;
        return; }
    const f32x4* xr = (const f32x4*)src + lane; const f32x4* gr = (const f32x4*)g + lane;
    f32x4 v[4]; float s = 0.f;
#pragma unroll
    for (int j = 0; j < 4; ++j) { v[j] = xr[64 * j]; s += (v[j].x * v[j].x + v[j].y * v[j].y) + (v[j].z * v[j].z + v[j].w * v[j].w); }
    const float rstd = rsqrtf(wave_sum(s) * (1.f / DM) + 1e-6f);
#pragma unroll
    for (int j = 0; j < 4; ++j) { const f32x4 gg = gr[64 * j]; const f32x4 y = v[j] * rstd * gg;
        o8[64 * j] = (unsigned long long)cvtpk(y.x, y.y) | ((unsigned long long)cvtpk(y.z, y.w) << 32); }
}
__device__ __forceinline__ void phase_prologue(LAS unsigned char* lds, KP P) {
    const int tid = fresh_tid(), lane = tid & 63, wid = tid >> 6;
    LAS float* scr = (LAS float*)(lds + wid * 16384);
    const int gw = blockIdx.x * 8 + wid, NGW = gridDim.x * 8;
    unsigned char* ws = P->ws;
    constexpr int I_IN = (1024 / 64) * (5376 / 32), I_UP = (512 / 64) * (1024 / 32), I_O = (1024 / 64) * (1024 / 32), I_1 = (1024 / 64) * (4096 / 32), I_2 = (4096 / 64) * (1024 / 32);
    constexpr int I_LW = (64 / 64) * (512 / 32), I_G = (128 / 64) * (512 / 32);
    constexpr int NITEMS = I_IN + 2 * I_UP + I_O + I_1 + I_2 + 4 * I_LW + I_G;
    for (int it = gw; it < NITEMS; it += NGW) {
        int r = it;
        if (r < I_IN) { transpose_item(P->in[I_WIN], 1024, 5376, (bf16*)(ws + WS_WIN), scr, r, lane); continue; } r -= I_IN;
        if (r < I_UP) { transpose_item(P->in[I_UPA], 512, 1024, (bf16*)(ws + WS_WUPA), scr, r, lane); continue; } r -= I_UP;
        if (r < I_UP) { transpose_item(P->in[I_UPB], 512, 1024, (bf16*)(ws + WS_WUPB), scr, r, lane); continue; } r -= I_UP;
        if (r < I_O) { transpose_item(P->in[I_WOUT], 1024, 1024, (bf16*)(ws + WS_WOUT), scr, r, lane); continue; } r -= I_O;
        if (r < I_1) { transpose_item(P->in[I_FF1], 1024, 4096, (bf16*)(ws + WS_WFF1), scr, r, lane); continue; } r -= I_1;
        if (r < I_2) { transpose_item(P->in[I_FF2], 4096, 1024, (bf16*)(ws + WS_WFF2), scr, r, lane); continue; } r -= I_2;
        if (r < 2 * I_LW) { const int d = r / I_LW; transpose_item(P->in[I_WUP] + (size_t)d * 64 * 512, 64, 512, (bf16*)(ws + WS_LORA) + (size_t)d * 512 * 64, scr, r % I_LW, lane); continue; } r -= 2 * I_LW;
        if (r < 2 * I_LW) { const int d = r / I_LW; transpose_item(P->in[I_AUP] + (size_t)d * 64 * 512, 64, 512, (bf16*)(ws + WS_LORA + 131072) + (size_t)d * 512 * 64, scr, r % I_LW, lane); continue; } r -= 2 * I_LW;
        transpose_item(P->in[I_GUP], 128, 512, (bf16*)(ws + WS_LORA + 262144), scr, r, lane);
    }
    bf16* XN = (bf16*)P->out; bf16* XM = (bf16*)(ws + WS_XNMETA);
    for (int m = gw; m < ROWS; m += NGW) {
        const float* src = m < 16384 ? P->in[I_XP] + (size_t)m * DM : m < NMAIN ? P->in[I_XS] + (size_t)(m - 16384) * DM : (m - NMAIN < 16 ? P->in[I_META] + (size_t)(m - NMAIN) * DM : nullptr);
        bf16* dst = m < NMAIN ? XN + (size_t)m * DM : XM + (size_t)(m - NMAIN) * DM;
        rms_row_bf16(src, P->in[I_GMIX], dst, lane);
    }
}

constexpr int AT_KSTR = 272, AT_VSTR = 144, AT_KSZ = 64 * AT_KSTR, AT_BUF = AT_KSZ + 128 * AT_VSTR;
__device__ __forceinline__ f32x16 mfma32(bf16x8 a, bf16x8 b, f32x16 c) { return __builtin_amdgcn_mfma_f32_32x32x16_bf16(a, b, c, 0, 0, 0); }
__device__ __forceinline__ void attn_unit(LAS unsigned char* lds, KP P, int s, int h, int qb, float lam) {
    int tid_ = threadIdx.x; asm volatile("" : "+v"(tid_));
    const int tid = tid_, lane = tid & 63, r32 = lane & 31, hi = lane >> 5, wid = __builtin_amdgcn_readfirstlane(tid >> 6), rg = wid & 3, mp = wid >> 2;
    const int L = seq_len(s), base = seq_base(s), NT = 1 + L / 64;
    unsigned char* ws = P->ws;
    const bf16* KB = (const bf16*)(ws + WS_KB); const bf16* VT = (const bf16*)(ws + WS_VT); bf16* Q = (bf16*)(ws + WS_Q);
    const int qrow = base + qb * 128 + rg * 32 + r32;
    bf16x8 q[4];
#pragma unroll
    for (int d0 = 0; d0 < 4; ++d0) q[d0] = *(const bf16x8*)(Q + (size_t)qrow * 512 + h * 128 + mp * 64 + d0 * 16 + hi * 8);
    f32x16 O[4];
#pragma unroll
    for (int b = 0; b < 4; ++b)
#pragma unroll
        for (int r = 0; r < 16; ++r) O[b][r] = 0.f;
    float mx = -INFINITY, ls = 0.f;
    const float qh = (float)(16 + qb * 128 + rg * 32 + r32 - 4 * hi);
    const float nslope = -exp2f(-2.0f * (float)(h + 1)) * LOG2E;
    const int kr0 = tid >> 4, kc = tid & 15, vn0 = tid >> 3, vc = tid & 7;
    u32x4 kreg[2], vreg[2];
    const unsigned kgo = (unsigned)((kr0 * 512 + h * 128 + kc * 8) * 2), vgo = (unsigned)(((h * 128 + vn0) * 64 + vc * 8) * 2);
    const unsigned klo = (unsigned)(kr0 * AT_KSTR + kc * 16), vlo = (unsigned)(AT_KSZ + vn0 * AT_VSTR + vc * 16);
#define AT_GLOAD(j) do { const int m0_ = (j) == 0 ? METAROW : base + 64 * ((j) - 1); \
        const unsigned char* kt_ = (const unsigned char*)KB + (size_t)m0_ * 1024; const unsigned char* vt_ = (const unsigned char*)VT + (size_t)(m0_ >> 6) * (512 * 64 * 2); \
        kreg[0] = *(const u32x4*)(kt_ + kgo); kreg[1] = *(const u32x4*)(kt_ + 32 * 1024 + kgo); \
        vreg[0] = *(const u32x4*)(vt_ + vgo); vreg[1] = *(const u32x4*)(vt_ + 64 * 64 * 2 + vgo); } while (0)
#define AT_LSTORE(buf) do { LAS unsigned char* kb_ = lds + (buf) * AT_BUF; \
        *(LAS u32x4*)(kb_ + klo) = kreg[0]; *(LAS u32x4*)(kb_ + klo + 32 * AT_KSTR) = kreg[1]; \
        *(LAS u32x4*)(kb_ + vlo) = vreg[0]; *(LAS u32x4*)(kb_ + vlo + 64 * AT_VSTR) = vreg[1]; } while (0)
    float qn, kn;
    { float ssq = 0.f;
#pragma unroll
      for (int d0 = 0; d0 < 4; ++d0) { float t[8]; unpack8(__builtin_bit_cast(u32x4, q[d0]), t);
#pragma unroll
        for (int e = 0; e < 8; ++e) ssq = fmaf(t[e], t[e], ssq); }
      ssq += __shfl_xor(ssq, 32); qn = sqrtf(ssq) * 1.002f;
      const unsigned* KN = (const unsigned*)(ws + WS_CTL) + CW_KN; float ks = 0.f;
#pragma unroll
      for (int g = 0; g < 8; ++g) ks += fmaxf(__uint_as_float(__hip_atomic_load(KN + s * 64 + h * 16 + mp * 8 + g, __ATOMIC_RELAXED, __HIP_MEMORY_SCOPE_AGENT)), __uint_as_float(__hip_atomic_load(KN + 9 * 64 + h * 16 + mp * 8 + g, __ATOMIC_RELAXED, __HIP_MEMORY_SCOPE_AGENT)));
      kn = sqrtf(ks) * 1.002f; }
    const int jc0 = 1 + qb * 2;
    int jlo = jc0, jhi = jc0 + 1;
    LAS float* red = (LAS float*)(lds + 2 * AT_BUF);
#pragma unroll 1
    for (int ph = 0; ph < 2; ++ph) {
        int nleft, ntl;
        if (ph == 0) { nleft = 0; ntl = 2; }
        else {
            float dneed = (qn * kn - mx + 40.0f) / (-nslope);
#pragma unroll
            for (int o = 1; o < 64; o <<= 1) dneed = fmaxf(dneed, __shfl_xor(dneed, o));
            if (lane == 0) red[wid] = dneed;
            __syncthreads();
            float dm = red[0];
#pragma unroll
            for (int w8 = 1; w8 < 8; ++w8) dm = fmaxf(dm, red[w8]);
            dm = fminf(fmaxf(dm, 0.f), 1.0e6f);
            const int dmax = (int)dm + 1, q0 = 16 + qb * 128;
            const int plo = q0 - dmax, phi = q0 + 127 + dmax;
            jlo = plo < 16 ? 0 : 1 + ((plo - 16) >> 6); jhi = phi >= L + 16 ? NT - 1 : 1 + ((phi - 16) >> 6);
            if (jlo > jc0) jlo = jc0; if (jhi < jc0 + 1) jhi = jc0 + 1;
            nleft = jc0 - jlo; ntl = nleft + (jhi - jc0 - 1);
        }
        if (ntl > 0) {
#define AT_J(t) (ph == 0 ? jc0 + (t) : ((t) < nleft ? jlo + (t) : jc0 + 2 + ((t) - nleft)))
        { const int jf = AT_J(0); AT_GLOAD(jf); } AT_LSTORE(0); __syncthreads();
#pragma unroll 1
        for (int t = 0; t < ntl; ++t) {
            const int j = AT_J(t);
            if (t + 1 < ntl) { const int jn = AT_J(t + 1); AT_GLOAD(jn); }
            const LAS unsigned char* Kb = lds + (t & 1) * AT_BUF + mp * 128; const LAS unsigned char* Vb = lds + (t & 1) * AT_BUF + AT_KSZ;
            const float dq = qh - (float)(j == 0 ? 0 : 64 * j - 48);
            f32x16 p0, p1;
#pragma unroll
            for (int r = 0; r < 16; ++r) { p0[r] = 0.f; p1[r] = 0.f; }
            {
                bf16x8 ka[4], kb[4];
#pragma unroll
                for (int d0 = 0; d0 < 4; ++d0) { ka[d0] = *(const LAS bf16x8*)(Kb + r32 * AT_KSTR + d0 * 32 + hi * 16); kb[d0] = *(const LAS bf16x8*)(Kb + (32 + r32) * AT_KSTR + d0 * 32 + hi * 16); }
                __builtin_amdgcn_sched_barrier(0);
#pragma unroll
                for (int d0 = 0; d0 < 4; ++d0) { p0 = mfma32(ka[d0], q[d0], p0); p1 = mfma32(kb[d0], q[d0], p1); }
            }
#pragma unroll
            for (int r = 0; r < 16; ++r) { const float dd = dq - (float)((r & 3) + 8 * (r >> 2)); p0[r] = fmaf(fabsf(dd), nslope, p0[r]); p1[r] = fmaf(fabsf(dd - 32.f), nslope, p1[r]); }
            if (j == 0) {
#pragma unroll
                for (int r = 0; r < 16; ++r) { if ((r & 3) + 8 * (r >> 2) + 4 * hi >= 16) p0[r] = -INFINITY; p1[r] = -INFINITY; }
            }
            float rm = fmaxf(p0[0], p1[0]);
#pragma unroll
            for (int r = 1; r < 16; ++r) rm = fmaxf(rm, fmaxf(p0[r], p1[r]));
            rm = fmaxf(rm, __shfl_xor(rm, 32));
            if (__any(rm > mx - 38.0f)) {
            const float mn = fmaxf(mx, rm);
            if (__any(mn > mx)) {
                const float f = __builtin_amdgcn_exp2f(mx - mn); ls *= f; mx = mn;
#pragma unroll
                for (int b = 0; b < 4; ++b)
#pragma unroll
                    for (int r = 0; r < 16; ++r) O[b][r] *= f;
            }
            float sum = 0.f;
#pragma unroll
            for (int r = 0; r < 16; ++r) { p0[r] = __builtin_amdgcn_exp2f(p0[r] - mx); p1[r] = __builtin_amdgcn_exp2f(p1[r] - mx); sum += p0[r] + p1[r]; }
            ls += sum;
            bf16x8 pf[4];
#pragma unroll
            for (int k2 = 0; k2 < 2; ++k2) {
                u32x4 w0, w1;
                w0.x = cvtpk(p0[8 * k2 + 0], p0[8 * k2 + 1]); w0.y = cvtpk(p0[8 * k2 + 2], p0[8 * k2 + 3]); w0.z = cvtpk(p0[8 * k2 + 4], p0[8 * k2 + 5]); w0.w = cvtpk(p0[8 * k2 + 6], p0[8 * k2 + 7]);
                w1.x = cvtpk(p1[8 * k2 + 0], p1[8 * k2 + 1]); w1.y = cvtpk(p1[8 * k2 + 2], p1[8 * k2 + 3]); w1.z = cvtpk(p1[8 * k2 + 4], p1[8 * k2 + 5]); w1.w = cvtpk(p1[8 * k2 + 6], p1[8 * k2 + 7]);
                pf[k2] = __builtin_bit_cast(bf16x8, w0); pf[2 + k2] = __builtin_bit_cast(bf16x8, w1);
            }
            {
                u32x4 vcur[4], vnxt[4];
#define AT_VLOAD(dst, ks_) do { _Pragma("unroll") for (int b_ = 0; b_ < 4; ++b_) { const LAS unsigned char* vp_ = Vb + (b_ * 32 + r32) * AT_VSTR + (ks_) * 32 + hi * 8; \
                    const u32x2 lo_ = *(const LAS u32x2*)vp_, hh_ = *(const LAS u32x2*)(vp_ + 16); dst[b_].x = lo_.x; dst[b_].y = lo_.y; dst[b_].z = hh_.x; dst[b_].w = hh_.y; } } while (0)
                AT_VLOAD(vcur, 0);
#pragma unroll
                for (int ks = 0; ks < 4; ++ks) {
                    if (ks < 3) AT_VLOAD(vnxt, ks + 1);
                    __builtin_amdgcn_sched_barrier(0);
#pragma unroll
                    for (int b = 0; b < 4; ++b) O[b] = mfma32(__builtin_bit_cast(bf16x8, vcur[b]), pf[ks], O[b]);
                    __builtin_amdgcn_sched_barrier(0);
#pragma unroll
                    for (int b = 0; b < 4; ++b) vcur[b] = vnxt[b];
                }
#undef AT_VLOAD
            }
            }
            if (t + 1 < ntl) AT_LSTORE((t + 1) & 1);
            __syncthreads();
        }
#undef AT_J
        }
    }
#undef AT_GLOAD
#undef AT_LSTORE
    const float lt = ls + __shfl_xor(ls, 32);
    const float inv = (mp ? lam : 1.0f) / lt;
    int lane2 = lane; asm volatile("" : "+v"(lane2));
    const int r32e = lane2 & 31, hie = lane2 >> 5;
    LAS float* ex = (LAS float*)lds + rg * (128 * 32) + hie * 128 + r32e;
    if (mp == 1) {
#pragma unroll
        for (int b = 0; b < 4; ++b)
#pragma unroll
            for (int r = 0; r < 16; ++r) ex[(32 * b + (r & 3) + 8 * (r >> 2)) * 32] = O[b][r] * inv;
    }
    __syncthreads();
    if (mp == 0) {
        float ss = 0.f;
#pragma unroll
        for (int b = 0; b < 4; ++b)
#pragma unroll
            for (int r = 0; r < 16; ++r) { const float o = O[b][r] * inv - ex[(32 * b + (r & 3) + 8 * (r >> 2)) * 32]; O[b][r] = o; ss += o * o; }
        ss += __shfl_xor(ss, 32);
        const float rstd = rsqrtf(ss * (1.0f / 128.0f) + 1e-5f) * 0.8f;
        const float* sg = P->in[I_SUBG] + 4 * hie; bf16* Qo = Q + (size_t)(base + qb * 128 + rg * 32 + r32e) * 512 + h * 128 + 4 * hie;
#pragma unroll
        for (int b = 0; b < 4; ++b)
#pragma unroll
            for (int r4 = 0; r4 < 4; ++r4) {
                const int n = 32 * b + 8 * r4; const f32x4 g = *(const f32x4*)(sg + n);
                u32x2 w; w.x = cvtpk(O[b][4 * r4 + 0] * rstd * g.x, O[b][4 * r4 + 1] * rstd * g.y); w.y = cvtpk(O[b][4 * r4 + 2] * rstd * g.z, O[b][4 * r4 + 3] * rstd * g.w);
                *(u32x2*)(Qo + n) = w;
            }
    }
    __syncthreads();
}

constexpr int SC_R = 0, SC_K = 16384, SC_V = 32768, SC_W = 49152, SC_B = 65536, SC_KK = 81920, SC_Y = 98304, SC_TW = 114688, SC_AD = 123904, SC_MU = 133120;
__device__ __forceinline__ float dpp_add(float v, int ctrl_id) {
    const int x = __float_as_int(v); int y;
    if (ctrl_id == 0) y = __builtin_amdgcn_update_dpp(0, x, 0xB1, 0xf, 0xf, true);
    else if (ctrl_id == 1) y = __builtin_amdgcn_update_dpp(0, x, 0x4E, 0xf, 0xf, true);
    else if (ctrl_id == 2) y = __builtin_amdgcn_update_dpp(0, x, 0x141, 0xf, 0xf, true);
    else y = __builtin_amdgcn_update_dpp(0, x, 0x140, 0xf, 0xf, true);
    return v + __int_as_float(y);
}
template <int LPR> __device__ __forceinline__ float grp_sum(float v) {
    v = dpp_add(v, 0); v = dpp_add(v, 1); v = dpp_add(v, 2);
    if (LPR == 16) v = dpp_add(v, 3);
    return v;
}
#define BAR_LDS() asm volatile("s_waitcnt lgkmcnt(0)\n\ts_barrier" ::: "memory")
__device__ __forceinline__ float fast_sigmoid(float x) { return __builtin_amdgcn_rcpf(1.0f + __builtin_amdgcn_exp2f(-LOG2E * x)); }
__device__ __forceinline__ float fast_tanh(float x) { return 1.0f - 2.0f * __builtin_amdgcn_rcpf(1.0f + __builtin_amdgcn_exp2f(2.0f * LOG2E * x)); }
template <int NRP, int NSW>
__device__ __forceinline__ void scan_unit(LAS unsigned char* lds, KP P, int s, int d, int h, int rp) {
    constexpr int RPB = 64 / NRP, RPW = RPB / NSW, LPR = 64 / RPW, CPL = 64 / LPR;
    static_assert(LPR == 8 || LPR == 16, "scan geometry");
    constexpr bool YDB = (RPB == 16) && (NSW == 4);
    constexpr int YST = YDB ? RPB : 64;
    int tid_ = threadIdx.x; asm volatile("" : "+v"(tid_));
    const int tid = tid_, lane = tid & 63, wid = __builtin_amdgcn_readfirstlane(tid >> 6);
    const int L = seq_len(s), base = seq_base(s), Ltot = L + 16, nchunk = (Ltot + 63) / 64;
    unsigned char* ws = P->ws;
    const bf16* Rb = (const bf16*)(ws + WS_R); const bf16* KAb = (const bf16*)(ws + WS_KA); const bf16* VAb = (const bf16*)(ws + WS_VA); const bf16* Lb = (const bf16*)(ws + WS_L);
    float* CB = (float*)(ws + WS_CB); bf16* YD = (bf16*)((unsigned char*)P->out + 64 * MiB) + (size_t)d * NMAIN * 512;
    LAS float* fS = (LAS float*)lds; LAS float* fV = (LAS float*)(lds + 81920); LAS float* fY = (LAS float*)(lds + SC_Y); LAS float* fMU = (LAS float*)(lds + SC_MU);
#define SCI(sl_, a_, c_) ((sl_) * 320 + (a_) * 64 + (c_))
    for (int i = tid; i < 832; i += NTHREADS) {
        float v;
        if (i < 640) { const int which = i / 320, jj = i % 320, a = jj >> 6, c = jj & 63; const int gi = a < 3 ? a * 512 + h * 64 + c : 1536 + (a - 3) * 64 + c; v = P->in[which ? I_MUN : I_MUP][gi]; }
        else { const int a = (i - 640) >> 6, c = (i - 640) & 63; v = P->in[a == 0 ? I_KK : a == 1 ? I_KA : I_RK][h * 64 + c]; }
        fMU[i] = v;
    }
    const int mat = wid >> 2, ntile = wid & 3;
    const bf16* Wt = (const bf16*)(ws + WS_LORA + (mat ? 131072 : 0)) + ((size_t)d * 512 + h * 64 + ntile * 16 + (lane & 15)) * 64 + (lane >> 4) * 8;
    const bf16x8 bfr0 = *(const bf16x8*)Wt, bfr1 = *(const bf16x8*)(Wt + 32);
    const float bias = P->in[mat ? I_A0 : I_W0][d * 512 + h * 64 + ntile * 16 + (lane & 15)];
    float S[CPL];
#pragma unroll
    for (int j = 0; j < CPL; ++j) S[j] = 0.f;
    const int rowl = lane / LPR, kg = lane % LPR, srow = rp * RPB + wid * RPW + rowl;
    const int slot = tid >> 3, cg8 = (tid & 7) * 8;
    u32x4 raw[5][3];
#define SC_META(c) (d ? ((c) == nchunk - 1) : ((c) == 0))
    const unsigned char* HALO0 = ws + WS_HALO + (size_t)(base >> 6) * 2 * HALO_ROW;
#define SC_LOAD(c) do { const int i_ = 64 * (c) + slot; const bool ok_ = i_ < Ltot; const int p_ = d ? Ltot - 1 - i_ : i_; \
        const unsigned zr_ = (unsigned)(METAROW + 64); \
        if (!SC_META(c)) { const unsigned rc_ = ok_ ? (unsigned)(base + p_ - 16) : zr_; \
            _Pragma("unroll") for (int a_ = 0; a_ < 5; ++a_) { const unsigned char* B_ = (const unsigned char*)(a_ == 0 ? Rb : a_ == 1 ? KAb : a_ == 2 ? VAb : Lb); const unsigned ld_ = a_ < 3 ? 1024u : 512u; \
                const unsigned co_ = (unsigned)(((a_ < 3 ? h * 64 : (a_ - 3) * 64) + cg8) * 2); raw[a_][1] = *(const u32x4*)(B_ + (rc_ * ld_ + co_)); } \
        } else { const bool me_ = ok_ && p_ < 16; const bool hn_ = me_ && p_ == 15; \
            const unsigned rc_ = ok_ ? (unsigned)pos_row(base, p_) : zr_, rp_ = (me_ && p_ > 0) ? (unsigned)(METAROW + p_ - 1) : zr_, rn_ = (me_ && p_ < 15) ? (unsigned)(METAROW + p_ + 1) : zr_; \
            _Pragma("unroll") for (int a_ = 0; a_ < 5; ++a_) { const unsigned char* B_ = (const unsigned char*)(a_ == 0 ? Rb : a_ == 1 ? KAb : a_ == 2 ? VAb : Lb); const unsigned ld_ = a_ < 3 ? 1024u : 512u; \
                const unsigned co_ = (unsigned)(((a_ < 3 ? h * 64 : (a_ - 3) * 64) + cg8) * 2); \
                const unsigned ho_ = (unsigned)(((a_ < 3 ? a_ * 512 + h * 64 : 1536 + (a_ - 3) * 64) + cg8) * 2); \
                raw[a_][0] = *(const u32x4*)(B_ + (rp_ * ld_ + co_)); raw[a_][1] = *(const u32x4*)(B_ + (rc_ * ld_ + co_)); \
                const unsigned char* np_ = hn_ ? HALO0 + ho_ : B_ + (rn_ * ld_ + co_); raw[a_][2] = *(const u32x4*)np_; } } } while (0)
    SC_LOAD(0);
    BAR_LDS();
    for (int c = 0; c < nchunk; ++c) {
        const int nvalid = (Ltot - 64 * c) < 64 ? (Ltot - 64 * c) : 64;
        float rv[8], kv[8];
        if (!SC_META(c)) {
            float vv8[8]; unpack8(raw[0][1], rv); unpack8(raw[1][1], kv); unpack8(raw[2][1], vv8);
            { LAS float* dst = fS + SCI(slot, 4, cg8); *(LAS f32x4*)dst = (f32x4){rv[0], rv[1], rv[2], rv[3]}; *(LAS f32x4*)(dst + 4) = (f32x4){rv[4], rv[5], rv[6], rv[7]}; }
            { LAS float* dst = fV + slot * 64 + cg8; *(LAS f32x4*)dst = (f32x4){vv8[0], vv8[1], vv8[2], vv8[3]}; *(LAS f32x4*)(dst + 4) = (f32x4){vv8[4], vv8[5], vv8[6], vv8[7]}; }
            *(LAS u32x4*)(lds + SC_TW + slot * 144 + cg8 * 2) = raw[3][1];
            *(LAS u32x4*)(lds + SC_AD + slot * 144 + cg8 * 2) = raw[4][1];
        } else {
            const int i1 = 64 * c + slot; const int p1 = d ? Ltot - 1 - i1 : i1; const bool me1 = i1 < Ltot && p1 < 16; const float fm = me1 ? 1.0f : 0.0f;
#pragma unroll
            for (int a = 0; a < 5; ++a) {
                float pv[8], cv[8], nv[8], o[8]; unpack8(raw[a][0], pv); unpack8(raw[a][1], cv); unpack8(raw[a][2], nv);
                const f32x4 mp0 = *(const LAS f32x4*)(fMU + a * 64 + cg8), mp1 = *(const LAS f32x4*)(fMU + a * 64 + cg8 + 4), mn0 = *(const LAS f32x4*)(fMU + 320 + a * 64 + cg8), mn1 = *(const LAS f32x4*)(fMU + 320 + a * 64 + cg8 + 4);
#pragma unroll
                for (int e = 0; e < 8; ++e) { const float mp = fm * (e < 4 ? mp0[e & 3] : mp1[e & 3]), mn = fm * (e < 4 ? mn0[e & 3] : mn1[e & 3]); o[e] = cv[e] + mp * (pv[e] - cv[e]) + mn * (nv[e] - cv[e]); }
                if (a == 0) {
#pragma unroll
                    for (int e = 0; e < 8; ++e) rv[e] = o[e];
                    LAS float* dst = fS + SCI(slot, 4, cg8); *(LAS f32x4*)dst = (f32x4){o[0], o[1], o[2], o[3]}; *(LAS f32x4*)(dst + 4) = (f32x4){o[4], o[5], o[6], o[7]};
                } else if (a == 1) {
#pragma unroll
                    for (int e = 0; e < 8; ++e) kv[e] = o[e];
                } else if (a == 2) {
                    LAS float* dst = fV + slot * 64 + cg8; *(LAS f32x4*)dst = (f32x4){o[0], o[1], o[2], o[3]}; *(LAS f32x4*)(dst + 4) = (f32x4){o[4], o[5], o[6], o[7]};
                } else {
                    if (a == 3) {
#pragma unroll
                        for (int e = 0; e < 8; ++e) o[e] = me1 ? fast_tanh(o[e]) : o[e];
                    }
                    u32x4 w; w.x = cvtpk(o[0], o[1]); w.y = cvtpk(o[2], o[3]); w.z = cvtpk(o[4], o[5]); w.w = cvtpk(o[6], o[7]);
                    *(LAS u32x4*)(lds + (a == 3 ? SC_TW : SC_AD) + slot * 144 + cg8 * 2) = w;
                }
            }
        }
        BAR_LDS();
        if (c + 1 < nchunk) SC_LOAD(c + 1);
        {
            const LAS unsigned char* Ab = lds + (mat ? SC_AD : SC_TW); LAS float* fWB = fS + (mat ? 128 : 64);
#pragma unroll
            for (int mt = 0; mt < 4; ++mt) {
                const bf16x8 a0 = *(const LAS bf16x8*)(Ab + (mt * 16 + (lane & 15)) * 144 + (lane >> 4) * 16);
                const bf16x8 a1 = *(const LAS bf16x8*)(Ab + (mt * 16 + (lane & 15)) * 144 + 64 + (lane >> 4) * 16);
                f32x4 acc = {0.f, 0.f, 0.f, 0.f};
                acc = __builtin_amdgcn_mfma_f32_16x16x32_bf16(a0, bfr0, acc, 0, 0, 0);
                acc = __builtin_amdgcn_mfma_f32_16x16x32_bf16(a1, bfr1, acc, 0, 0, 0);
#pragma unroll
                for (int rg = 0; rg < 4; ++rg) {
                    const int sl = mt * 16 + (lane >> 4) * 4 + rg, col = ntile * 16 + (lane & 15);
                    const float sg = fast_sigmoid(acc[rg] + bias); const float dc = __builtin_amdgcn_exp2f(-0.6065306597126334f * LOG2E * sg);
                    fWB[sl * 320 + col] = mat ? sg : dc;
                }
            }
        }
        BAR_LDS();
        {
            const f32x4 a0 = *(const LAS f32x4*)(fS + SCI(slot, 2, cg8)), a1 = *(const LAS f32x4*)(fS + SCI(slot, 2, cg8 + 4));
            const f32x4 kk0 = *(const LAS f32x4*)(fMU + 640 + cg8), kk1 = *(const LAS f32x4*)(fMU + 640 + cg8 + 4), ka0 = *(const LAS f32x4*)(fMU + 704 + cg8), ka1 = *(const LAS f32x4*)(fMU + 704 + cg8 + 4);
            const f32x4 rk0 = *(const LAS f32x4*)(fMU + 768 + cg8), rk1 = *(const LAS f32x4*)(fMU + 768 + cg8 + 4);
            float kkv[8], kd[8], av[8]; float ssq = 0.f, cs = 0.f;
#pragma unroll
            for (int e = 0; e < 8; ++e) {
                av[e] = e < 4 ? a0[e & 3] : a1[e & 3];
                kkv[e] = kv[e] * (e < 4 ? kk0[e & 3] : kk1[e & 3]); ssq = fmaf(kkv[e], kkv[e], ssq);
                kd[e] = kv[e] * (1.0f + (av[e] - 1.0f) * (e < 4 ? ka0[e & 3] : ka1[e & 3])); cs = fmaf(rv[e] * kd[e], e < 4 ? rk0[e & 3] : rk1[e & 3], cs);
            }
            ssq = grp_sum<8>(ssq); cs = grp_sum<8>(cs);
            const float rs = rsqrtf(fmaxf(ssq, 1e-24f));
#pragma unroll
            for (int e = 0; e < 8; ++e) { kkv[e] *= rs; av[e] *= kkv[e]; }
            LAS float* o1 = fS + SCI(slot, 0, cg8); *(LAS f32x4*)o1 = (f32x4){kkv[0], kkv[1], kkv[2], kkv[3]}; *(LAS f32x4*)(o1 + 4) = (f32x4){kkv[4], kkv[5], kkv[6], kkv[7]};
            LAS float* o2 = fS + SCI(slot, 2, cg8); *(LAS f32x4*)o2 = (f32x4){av[0], av[1], av[2], av[3]}; *(LAS f32x4*)(o2 + 4) = (f32x4){av[4], av[5], av[6], av[7]};
            LAS float* o3 = fS + SCI(slot, 3, cg8); *(LAS f32x4*)o3 = (f32x4){kd[0], kd[1], kd[2], kd[3]}; *(LAS f32x4*)(o3 + 4) = (f32x4){kd[4], kd[5], kd[6], kd[7]};
            if (cg8 == 0 && rp == 0 && slot < nvalid) { const int i2 = 64 * c + slot; const int p2 = d ? Ltot - 1 - i2 : i2; CB[((size_t)d * ROWS + pos_row(base, p2)) * 8 + h] = cs; }
        }
        BAR_LDS();
#define SC_STORE_Y(cc_) do { const int t5_ = tid - 256; if (t5_ >= 0 && t5_ < 128) { const int sl5_ = t5_ >> 1, hf_ = t5_ & 1; const int i5_ = 64 * (cc_) + sl5_; const int p5_ = d ? Ltot - 1 - i5_ : i5_; \
            if (i5_ < Ltot && p5_ >= 16) { const LAS float* yp_ = fY + ((cc_) & 1) * 1024 + sl5_ * 16 + hf_ * 8; const f32x4 y0_ = *(const LAS f32x4*)yp_, y1_ = *(const LAS f32x4*)(yp_ + 4); \
                *(u32x4*)(YD + (size_t)(base + p5_ - 16) * 512 + h * 64 + rp * 16 + hf_ * 8) = pack8(y0_, y1_); } } } while (0)
        if (YDB && wid >= NSW && c > 0) SC_STORE_Y(c - 1);
        if (wid < NSW) {
            typedef float f32x2_ __attribute__((ext_vector_type(2)));
            constexpr int C4 = CPL / 4;
            const LAS float* ps = fS + kg * CPL; const LAS float* pv = fV + srow;
            LAS float* py = YDB ? fY + (c & 1) * 1024 + (srow - rp * RPB) : fY + srow;
            f32x4 nk[C4], nw[C4], nb[C4], nd[C4], nr[C4]; float nv;
#define SC_FETCH(sl_) do { _Pragma("unroll") for (int j_ = 0; j_ < C4; ++j_) { nk[j_] = *(const LAS f32x4*)(ps + (sl_) * 320 + 4 * j_); nw[j_] = *(const LAS f32x4*)(ps + (sl_) * 320 + 64 + 4 * j_); \
                nb[j_] = *(const LAS f32x4*)(ps + (sl_) * 320 + 128 + 4 * j_); nd[j_] = *(const LAS f32x4*)(ps + (sl_) * 320 + 192 + 4 * j_); nr[j_] = *(const LAS f32x4*)(ps + (sl_) * 320 + 256 + 4 * j_); } nv = pv[(sl_) * 64]; } while (0)
            SC_FETCH(0);
            f32x4 rp4[C4];
#pragma unroll
            for (int j = 0; j < C4; ++j) rp4[j] = (f32x4){0.f, 0.f, 0.f, 0.f};
#pragma unroll 16
            for (int sl = 0; sl < nvalid; ++sl) {
                f32x4 ck[C4], cw[C4], cb[C4], cd[C4], cr[C4];
#pragma unroll
                for (int j = 0; j < C4; ++j) { ck[j] = nk[j]; cw[j] = nw[j]; cb[j] = nb[j]; cd[j] = nd[j]; cr[j] = nr[j]; }
                const float vv = nv;
                SC_FETCH(sl + 1 < 64 ? sl + 1 : 63);
                f32x2_ pa = {0.f, 0.f}, ya = {0.f, 0.f};
#pragma unroll
                for (int j = 0; j < C4; ++j)
#pragma unroll
                    for (int e = 0; e < 4; e += 2) { const f32x2_ s2 = {S[4 * j + e], S[4 * j + e + 1]}, k2 = {ck[j][e], ck[j][e + 1]}, r2 = {rp4[j][e], rp4[j][e + 1]}; pa = pa + s2 * k2; ya = ya + s2 * r2; }
                float pp = pa.x + pa.y, yy = ya.x + ya.y;
                pp = dpp_add(pp, 0); yy = dpp_add(yy, 0); pp = dpp_add(pp, 1); yy = dpp_add(yy, 1); pp = dpp_add(pp, 2); yy = dpp_add(yy, 2);
                if (LPR == 16) { pp = dpp_add(pp, 3); yy = dpp_add(yy, 3); }
                py[(sl > 0 ? sl - 1 : 0) * YST] = yy;
#pragma unroll
                for (int j = 0; j < C4; ++j)
#pragma unroll
                    for (int e = 0; e < 4; e += 2) {
                        const f32x2_ b2 = {cb[j][e], cb[j][e + 1]}, d2 = {cd[j][e], cd[j][e + 1]}, w2 = {cw[j][e], cw[j][e + 1]}; f32x2_ s2 = {S[4 * j + e], S[4 * j + e + 1]};
                        const f32x2_ t2 = d2 * vv - b2 * pp; s2 = s2 * w2 + t2; S[4 * j + e] = s2.x; S[4 * j + e + 1] = s2.y; }
#pragma unroll
                for (int j = 0; j < C4; ++j) rp4[j] = cr[j];
            }
            {
                f32x2_ ya = {0.f, 0.f};
#pragma unroll
                for (int j = 0; j < C4; ++j)
#pragma unroll
                    for (int e = 0; e < 4; e += 2) { const f32x2_ s2 = {S[4 * j + e], S[4 * j + e + 1]}, r2 = {rp4[j][e], rp4[j][e + 1]}; ya = ya + s2 * r2; }
                const float yy = grp_sum<LPR>(ya.x + ya.y);
                py[(nvalid - 1) * YST] = yy;
            }
#undef SC_FETCH
        }
        BAR_LDS();
        {
            const int i2 = 64 * c + slot; const int p2 = d ? Ltot - 1 - i2 : i2;
            if (!YDB && slot < nvalid && p2 >= 16 && (cg8 / RPB) == rp) {
                const LAS float* yp = fY + slot * 64 + cg8; const f32x4 y0 = *(const LAS f32x4*)yp, y1 = *(const LAS f32x4*)(yp + 4);
                *(u32x4*)(YD + (size_t)(base + p2 - 16) * 512 + h * 64 + cg8) = pack8(y0, y1);
            }
        }
    }
    if (YDB) SC_STORE_Y(nchunk - 1);
#undef SC_STORE_Y
#undef SC_LOAD
#undef SC_META
#undef SCI
}

constexpr int SL_FV = 81920, SL_FY = 86016, SL_TW = 90112, SL_AD = 94720, SL_AS = 99328, SL_MU = 107520;
__device__ __forceinline__ void scan_long(LAS unsigned char* lds, KP P, int s, int d, int h, int rp) {
    int tid_ = threadIdx.x; asm volatile("" : "+v"(tid_));
    const int tid = tid_, lane = tid & 63, wid = __builtin_amdgcn_readfirstlane(tid >> 6);
    const int L = seq_len(s), base = seq_base(s), Ltot = L + 16, nhalf = (Ltot + 31) / 32;
    unsigned char* ws = P->ws;
    const bf16* Rb = (const bf16*)(ws + WS_R); const bf16* KAb = (const bf16*)(ws + WS_KA); const bf16* VAb = (const bf16*)(ws + WS_VA); const bf16* Lb = (const bf16*)(ws + WS_L);
    float* CB = (float*)(ws + WS_CB); bf16* YD = (bf16*)((unsigned char*)P->out + 64 * MiB) + (size_t)d * NMAIN * 512;
    LAS float* fS = (LAS float*)lds; LAS float* fV = (LAS float*)(lds + SL_FV); LAS float* fY = (LAS float*)(lds + SL_FY); LAS float* fAS = (LAS float*)(lds + SL_AS); LAS float* fMU = (LAS float*)(lds + SL_MU);
    for (int i = tid; i < 832; i += NTHREADS) {
        float v;
        if (i < 640) { const int which = i / 320, jj = i % 320, a = jj >> 6, c = jj & 63; const int gi = a < 3 ? a * 512 + h * 64 + c : 1536 + (a - 3) * 64 + c; v = P->in[which ? I_MUN : I_MUP][gi]; }
        else { const int a = (i - 640) >> 6, c = (i - 640) & 63; v = P->in[a == 0 ? I_KK : a == 1 ? I_KA : I_RK][h * 64 + c]; }
        fMU[i] = v;
    }
    const bool scanner = wid < 4; const int pw = wid & 3;
    const int sl8 = lane >> 3, cg8 = (lane & 7) * 8, slot = pw * 8 + sl8;
    const int rowl = lane >> 4, kg = lane & 15, srl = pw * 4 + rowl;
    const unsigned char* HALO0 = ws + WS_HALO + (size_t)(base >> 6) * 2 * HALO_ROW;
    u32x4 raw[5][3];
#define SL_META(hc) (d ? ((hc) == nhalf - 1) : ((hc) == 0))
#define SL_LOAD(hc) do { const int i_ = 32 * (hc) + slot; const bool ok_ = i_ < Ltot; const int p_ = d ? Ltot - 1 - i_ : i_; \
        const unsigned zr_ = (unsigned)(METAROW + 64); \
        if (!SL_META(hc)) { const unsigned rc_ = ok_ ? (unsigned)(base + p_ - 16) : zr_; \
            _Pragma("unroll") for (int a_ = 0; a_ < 5; ++a_) { const unsigned char* B_ = (const unsigned char*)(a_ == 0 ? Rb : a_ == 1 ? KAb : a_ == 2 ? VAb : Lb); const unsigned ld_ = a_ < 3 ? 1024u : 512u; \
                const unsigned co_ = (unsigned)(((a_ < 3 ? h * 64 : (a_ - 3) * 64) + cg8) * 2); raw[a_][1] = *(const u32x4*)(B_ + (rc_ * ld_ + co_)); } \
        } else { const bool me_ = ok_ && p_ < 16; const bool hn_ = me_ && p_ == 15; \
            const unsigned rc_ = ok_ ? (unsigned)pos_row(base, p_) : zr_, rp_ = (me_ && p_ > 0) ? (unsigned)(METAROW + p_ - 1) : zr_, rn_ = (me_ && p_ < 15) ? (unsigned)(METAROW + p_ + 1) : zr_; \
            _Pragma("unroll") for (int a_ = 0; a_ < 5; ++a_) { const unsigned char* B_ = (const unsigned char*)(a_ == 0 ? Rb : a_ == 1 ? KAb : a_ == 2 ? VAb : Lb); const unsigned ld_ = a_ < 3 ? 1024u : 512u; \
                const unsigned co_ = (unsigned)(((a_ < 3 ? h * 64 : (a_ - 3) * 64) + cg8) * 2); \
                const unsigned ho_ = (unsigned)(((a_ < 3 ? a_ * 512 + h * 64 : 1536 + (a_ - 3) * 64) + cg8) * 2); \
                raw[a_][0] = *(const u32x4*)(B_ + (rp_ * ld_ + co_)); raw[a_][1] = *(const u32x4*)(B_ + (rc_ * ld_ + co_)); \
                const unsigned char* np_ = hn_ ? HALO0 + ho_ : B_ + (rn_ * ld_ + co_); raw[a_][2] = *(const u32x4*)np_; } } } while (0)
    constexpr int SL_WB = 110848;
    for (int i = tid; i < 1024; i += NTHREADS) { const int m2 = i >> 9, n = (i >> 3) & 63, ch = i & 7;
        *(LAS u32x4*)(lds + SL_WB + m2 * 9216 + n * 144 + ch * 16) = *(const u32x4*)((const bf16*)(ws + WS_LORA + (m2 ? 131072 : 0)) + ((size_t)d * 512 + h * 64 + n) * 64 + ch * 8); }
    float bias[2][4];
#pragma unroll
    for (int mt_ = 0; mt_ < 2; ++mt_)
#pragma unroll
        for (int nt = 0; nt < 4; ++nt) bias[mt_][nt] = P->in[mt_ ? I_A0 : I_W0][d * 512 + h * 64 + nt * 16 + (lane & 15)];
    float S[4] = {0.f, 0.f, 0.f, 0.f};
#define SL_PREP(hc, buf) do { \
        const bool meta_ = SL_META(hc); const int i1_ = 32 * (hc) + slot; const int p1_ = d ? Ltot - 1 - i1_ : i1_; const bool ok1_ = i1_ < Ltot; \
        LAS float* fSb_ = fS + (buf) * 10240 + slot * 320; float rv[8], kv[8]; \
        if (!meta_) { float vv8[8]; unpack8(raw[0][1], rv); unpack8(raw[1][1], kv); unpack8(raw[2][1], vv8); \
            *(LAS f32x4*)(fSb_ + 256 + cg8) = (f32x4){rv[0], rv[1], rv[2], rv[3]}; *(LAS f32x4*)(fSb_ + 256 + cg8 + 4) = (f32x4){rv[4], rv[5], rv[6], rv[7]}; \
            if ((cg8 >> 4) == rp) { LAS float* dv_ = fV + (buf) * 512 + slot * 16 + (cg8 & 15); *(LAS f32x4*)dv_ = (f32x4){vv8[0], vv8[1], vv8[2], vv8[3]}; *(LAS f32x4*)(dv_ + 4) = (f32x4){vv8[4], vv8[5], vv8[6], vv8[7]}; } \
            *(LAS u32x4*)(lds + SL_TW + slot * 144 + cg8 * 2) = raw[3][1]; *(LAS u32x4*)(lds + SL_AD + slot * 144 + cg8 * 2) = raw[4][1]; \
        } else { const bool me1_ = ok1_ && p1_ < 16; const float fm_ = me1_ ? 1.0f : 0.0f; \
            _Pragma("unroll") for (int a = 0; a < 5; ++a) { \
                float pv_[8], cv_[8], nv_[8], o_[8]; unpack8(raw[a][0], pv_); unpack8(raw[a][1], cv_); unpack8(raw[a][2], nv_); \
                _Pragma("unroll") for (int e = 0; e < 8; ++e) { const float mp_ = fm_ * fMU[a * 64 + cg8 + e], mn_ = fm_ * fMU[320 + a * 64 + cg8 + e]; o_[e] = cv_[e] + mp_ * (pv_[e] - cv_[e]) + mn_ * (nv_[e] - cv_[e]); } \
                if (a == 0) { _Pragma("unroll") for (int e = 0; e < 8; ++e) rv[e] = o_[e]; \
                    *(LAS f32x4*)(fSb_ + 256 + cg8) = (f32x4){o_[0], o_[1], o_[2], o_[3]}; *(LAS f32x4*)(fSb_ + 256 + cg8 + 4) = (f32x4){o_[4], o_[5], o_[6], o_[7]}; } \
                else if (a == 1) { _Pragma("unroll") for (int e = 0; e < 8; ++e) kv[e] = o_[e]; } \
                else if (a == 2) { if ((cg8 >> 4) == rp) { LAS float* dv_ = fV + (buf) * 512 + slot * 16 + (cg8 & 15); *(LAS f32x4*)dv_ = (f32x4){o_[0], o_[1], o_[2], o_[3]}; *(LAS f32x4*)(dv_ + 4) = (f32x4){o_[4], o_[5], o_[6], o_[7]}; } } \
                else { if (a == 3) { _Pragma("unroll") for (int e = 0; e < 8; ++e) o_[e] = me1_ ? fast_tanh(o_[e]) : o_[e]; } \
                    u32x4 w_; w_.x = cvtpk(o_[0], o_[1]); w_.y = cvtpk(o_[2], o_[3]); w_.z = cvtpk(o_[4], o_[5]); w_.w = cvtpk(o_[6], o_[7]); \
                    *(LAS u32x4*)(lds + (a == 3 ? SL_TW : SL_AD) + slot * 144 + cg8 * 2) = w_; } } } \
        asm volatile("s_waitcnt lgkmcnt(0)" ::: "memory"); \
          \
        { f32x4 acc_[2][4]; \
          _Pragma("unroll") for (int m2 = 0; m2 < 2; ++m2) { const LAS unsigned char* Ab_ = lds + (m2 ? SL_AD : SL_TW) + (pw * 8 + (lane & 15)) * 144 + (lane >> 4) * 16; \
              const bf16x8 a0_ = *(const LAS bf16x8*)Ab_, a1_ = *(const LAS bf16x8*)(Ab_ + 64); \
              _Pragma("unroll") for (int nt = 0; nt < 4; ++nt) { f32x4 z_ = {0.f, 0.f, 0.f, 0.f}; const LAS unsigned char* Bb_ = lds + SL_WB + m2 * 9216 + (nt * 16 + (lane & 15)) * 144 + (lane >> 4) * 16; \
                  z_ = __builtin_amdgcn_mfma_f32_16x16x32_bf16(a0_, *(const LAS bf16x8*)Bb_, z_, 0, 0, 0); acc_[m2][nt] = __builtin_amdgcn_mfma_f32_16x16x32_bf16(a1_, *(const LAS bf16x8*)(Bb_ + 64), z_, 0, 0, 0); } } \
          if (lane < 32) { \
              _Pragma("unroll") for (int nt = 0; nt < 4; ++nt) _Pragma("unroll") for (int rg = 0; rg < 4; ++rg) { const int row_ = (lane >> 4) * 4 + rg, col_ = nt * 16 + (lane & 15); \
                  const float sw_ = fast_sigmoid(acc_[0][nt][rg] + bias[0][nt]); fS[(buf) * 10240 + (pw * 8 + row_) * 320 + 64 + col_] = __builtin_amdgcn_exp2f(-0.6065306597126334f * LOG2E * sw_); \
                  fAS[pw * 512 + row_ * 64 + col_] = fast_sigmoid(acc_[1][nt][rg] + bias[1][nt]); } } } \
        asm volatile("s_waitcnt lgkmcnt(0)" ::: "memory"); \
          \
        { const f32x4 a0 = *(const LAS f32x4*)(fAS + pw * 512 + sl8 * 64 + cg8), a1 = *(const LAS f32x4*)(fAS + pw * 512 + sl8 * 64 + cg8 + 4); \
          const f32x4 kk0 = *(const LAS f32x4*)(fMU + 640 + cg8), kk1 = *(const LAS f32x4*)(fMU + 640 + cg8 + 4), ka0 = *(const LAS f32x4*)(fMU + 704 + cg8), ka1 = *(const LAS f32x4*)(fMU + 704 + cg8 + 4); \
          const f32x4 rk0 = *(const LAS f32x4*)(fMU + 768 + cg8), rk1 = *(const LAS f32x4*)(fMU + 768 + cg8 + 4); \
          float kkv[8], kd[8], av[8]; float ssq = 0.f, cs = 0.f; \
          _Pragma("unroll") for (int e = 0; e < 8; ++e) { av[e] = e < 4 ? a0[e & 3] : a1[e & 3]; \
              kkv[e] = kv[e] * (e < 4 ? kk0[e & 3] : kk1[e & 3]); ssq = fmaf(kkv[e], kkv[e], ssq); \
              kd[e] = kv[e] * (1.0f + (av[e] - 1.0f) * (e < 4 ? ka0[e & 3] : ka1[e & 3])); cs = fmaf(rv[e] * kd[e], e < 4 ? rk0[e & 3] : rk1[e & 3], cs); } \
          ssq = grp_sum<8>(ssq); cs = grp_sum<8>(cs); \
          const float rs = rsqrtf(fmaxf(ssq, 1e-24f)); \
          _Pragma("unroll") for (int e = 0; e < 8; ++e) { kkv[e] *= rs; av[e] *= kkv[e]; } \
          *(LAS f32x4*)(fSb_ + cg8) = (f32x4){kkv[0], kkv[1], kkv[2], kkv[3]}; *(LAS f32x4*)(fSb_ + cg8 + 4) = (f32x4){kkv[4], kkv[5], kkv[6], kkv[7]}; \
          *(LAS f32x4*)(fSb_ + 128 + cg8) = (f32x4){av[0], av[1], av[2], av[3]}; *(LAS f32x4*)(fSb_ + 128 + cg8 + 4) = (f32x4){av[4], av[5], av[6], av[7]}; \
          *(LAS f32x4*)(fSb_ + 192 + cg8) = (f32x4){kd[0], kd[1], kd[2], kd[3]}; *(LAS f32x4*)(fSb_ + 192 + cg8 + 4) = (f32x4){kd[4], kd[5], kd[6], kd[7]}; \
          if (cg8 == 0 && rp == 0 && ok1_) CB[((size_t)d * ROWS + pos_row(base, p1_)) * 8 + h] = cs; } } while (0)
#define SL_STORE_Y(hc, buf) do { const int sl5_ = lane >> 1, hf_ = lane & 1; const int i5_ = 32 * (hc) + sl5_; const int p5_ = d ? Ltot - 1 - i5_ : i5_; \
        if (i5_ < Ltot && p5_ >= 16) { const LAS float* yp_ = fY + (buf) * 512 + sl5_ * 16 + hf_ * 8; const f32x4 y0_ = *(const LAS f32x4*)yp_, y1_ = *(const LAS f32x4*)(yp_ + 4); \
            *(u32x4*)(YD + (size_t)(base + p5_ - 16) * 512 + h * 64 + rp * 16 + hf_ * 8) = pack8(y0_, y1_); } } while (0)
    BAR_LDS();
    if (!scanner) { SL_LOAD(0); SL_PREP(0, 0); if (nhalf > 1) SL_LOAD(1); }
    BAR_LDS();
#pragma unroll 1
    for (int hc = 0; hc < nhalf; ++hc) {
        if (scanner) {
            typedef float f32x2_ __attribute__((ext_vector_type(2)));
            const int nvalid = (Ltot - 32 * hc) < 32 ? (Ltot - 32 * hc) : 32, buf = hc & 1;
            const LAS float* ps = fS + buf * 10240 + kg * 4; const LAS float* pv = fV + buf * 512 + srl; LAS float* py = fY + buf * 512 + srl;
            f32x4 nk, nw, nb, nd, nr; float nv;
#define SL_FETCH(sl_) do { nk = *(const LAS f32x4*)(ps + (sl_) * 320); nw = *(const LAS f32x4*)(ps + (sl_) * 320 + 64); nb = *(const LAS f32x4*)(ps + (sl_) * 320 + 128); \
                nd = *(const LAS f32x4*)(ps + (sl_) * 320 + 192); nr = *(const LAS f32x4*)(ps + (sl_) * 320 + 256); nv = pv[(sl_) * 16]; } while (0)
            SL_FETCH(0);
            f32x4 rp4 = {0.f, 0.f, 0.f, 0.f};
#pragma unroll 16
            for (int sl = 0; sl < nvalid; ++sl) {
                const f32x4 ck = nk, cw = nw, cb = nb, cd = nd, cr = nr; const float vv = nv;
                SL_FETCH(sl + 1 < 32 ? sl + 1 : 31);
                f32x2_ pa = {0.f, 0.f}, ya = {0.f, 0.f};
#pragma unroll
                for (int e = 0; e < 4; e += 2) { const f32x2_ s2 = {S[e], S[e + 1]}, k2 = {ck[e], ck[e + 1]}, r2 = {rp4[e], rp4[e + 1]}; pa = pa + s2 * k2; ya = ya + s2 * r2; }
                float pp = pa.x + pa.y, yy = ya.x + ya.y;
                pp = dpp_add(pp, 0); yy = dpp_add(yy, 0); pp = dpp_add(pp, 1); yy = dpp_add(yy, 1); pp = dpp_add(pp, 2); yy = dpp_add(yy, 2); pp = dpp_add(pp, 3); yy = dpp_add(yy, 3);
                py[(sl > 0 ? sl - 1 : 0) * 16] = yy;
#pragma unroll
                for (int e = 0; e < 4; e += 2) { const f32x2_ b2 = {cb[e], cb[e + 1]}, d2 = {cd[e], cd[e + 1]}, w2 = {cw[e], cw[e + 1]}; f32x2_ s2 = {S[e], S[e + 1]};
                    const f32x2_ t2 = d2 * vv - b2 * pp; s2 = s2 * w2 + t2; S[e] = s2.x; S[e + 1] = s2.y; }
                rp4 = cr;
            }
            { f32x2_ ya = {0.f, 0.f};
#pragma unroll
              for (int e = 0; e < 4; e += 2) { const f32x2_ s2 = {S[e], S[e + 1]}, r2 = {rp4[e], rp4[e + 1]}; ya = ya + s2 * r2; }
              const float yy = grp_sum<16>(ya.x + ya.y); py[(nvalid - 1) * 16] = yy; }
#undef SL_FETCH
        } else {
            if (hc > 0 && pw == 0) SL_STORE_Y(hc - 1, (hc - 1) & 1);
            if (hc + 1 < nhalf) { SL_PREP(hc + 1, (hc + 1) & 1); if (hc + 2 < nhalf) SL_LOAD(hc + 2); }
        }
        BAR_LDS();
    }
    if (!scanner && pw == 0) SL_STORE_Y(nhalf - 1, (nhalf - 1) & 1);
#undef SL_STORE_Y
#undef SL_PREP
#undef SL_LOAD
#undef SL_META
}

__device__ __forceinline__ void rwkv_colmap(unsigned char* ws, int c0, bf16*& buf, int& ld, int& col) {
    if (c0 < 512) { buf = (bf16*)(ws + WS_R); ld = 512; col = c0; }
    else if (c0 < 1024) { buf = (bf16*)(ws + WS_KA); ld = 512; col = c0 - 512; }
    else if (c0 < 1536) { buf = (bf16*)(ws + WS_VA); ld = 512; col = c0 - 1024; }
    else { buf = (bf16*)(ws + WS_L); ld = 256; col = c0 - 1536; }
}
__device__ __forceinline__ void phase_halo(KP P) {
    const int tid = fresh_tid(), lane = tid & 63, wid = tid >> 6; const int gw = blockIdx.x * 8 + wid, NGW = gridDim.x * 8;
    unsigned char* ws = P->ws;
    for (int r = gw; r < (NMAIN / 64) * 2; r += NGW) {
        const int m = (r >> 1) * 64 + ((r & 1) ? 63 : 0);
        for (int j = lane; j < 224; j += 64) { bf16* buf; int ld, col; rwkv_colmap(ws, j * 8, buf, ld, col);
            *(u32x4*)(ws + WS_HALO + (size_t)r * HALO_ROW + j * 16) = *(const u32x4*)(buf + (size_t)m * ld + col); }
    }
}
__device__ __forceinline__ void phase_shift(LAS unsigned char* lds, KP P) {
    const int tid = fresh_tid(), slot = tid >> 3, cg = tid & 7;
    unsigned char* ws = P->ws; const float* mup = P->in[I_MUP]; const float* mun = P->in[I_MUN];
    for (int tile = blockIdx.x; tile < NMAIN / 64; tile += gridDim.x) {
        const int m0 = tile * 64, m = m0 + slot;
        const int ks = m0 < 16384 ? tile : ((m0 - 16384) & 2047) >> 6; const bool first = ks == 0, last = ks == (m0 < 16384 ? 255 : 31);
#pragma unroll 1
        for (int pass = 0; pass < 4; ++pass) {
#pragma unroll
            for (int i = 0; i < 7; ++i) { const int j = cg + 8 * i; bf16* buf; int ld, col; rwkv_colmap(ws, (pass * 56 + j) * 8, buf, ld, col);
                *(LAS u32x4*)(lds + (slot * 56 + j) * 16) = *(const u32x4*)(buf + (size_t)m * ld + col); }
            __syncthreads();
#pragma unroll
            for (int i = 0; i < 7; ++i) {
                const int j = cg + 8 * i, c0 = (pass * 56 + j) * 8; bf16* buf; int ld, col; rwkv_colmap(ws, c0, buf, ld, col);
                const u32x4 z = {0u, 0u, 0u, 0u};
                const u32x4 cu = *(const LAS u32x4*)(lds + (slot * 56 + j) * 16);
                u32x4 pu, nu;
                if (slot > 0) pu = *(const LAS u32x4*)(lds + ((slot - 1) * 56 + j) * 16);
                else pu = first ? *(const u32x4*)(buf + (size_t)(METAROW + 15) * ld + col) : *(const u32x4*)(ws + WS_HALO + (size_t)((tile - 1) * 2 + 1) * HALO_ROW + c0 * 2);
                if (slot < 63) nu = *(const LAS u32x4*)(lds + ((slot + 1) * 56 + j) * 16);
                else nu = last ? z : *(const u32x4*)(ws + WS_HALO + (size_t)((tile + 1) * 2) * HALO_ROW + c0 * 2);
                float pv[8], cv[8], nv[8], o[8]; unpack8(pu, pv); unpack8(cu, cv); unpack8(nu, nv);
                const f32x4 mp0 = *(const f32x4*)(mup + c0), mp1 = *(const f32x4*)(mup + c0 + 4), mn0 = *(const f32x4*)(mun + c0), mn1 = *(const f32x4*)(mun + c0 + 4);
#pragma unroll
                for (int e = 0; e < 8; ++e) { const float mp = e < 4 ? mp0[e & 3] : mp1[e & 3], mn = e < 4 ? mn0[e & 3] : mn1[e & 3]; o[e] = cv[e] + mp * (pv[e] - cv[e]) + mn * (nv[e] - cv[e]); }
                if (c0 >= 1536 && c0 < 1600) {
#pragma unroll
                    for (int e = 0; e < 8; ++e) o[e] = fast_tanh(o[e]);
                }
                u32x4 w; w.x = cvtpk(o[0], o[1]); w.y = cvtpk(o[2], o[3]); w.z = cvtpk(o[4], o[5]); w.w = cvtpk(o[6], o[7]);
                *(u32x4*)(buf + (size_t)m * ld + col) = w;
            }
            __syncthreads();
        }
    }
}

__device__ __forceinline__ void phase_post(LAS unsigned char* lds, KP P) {
    const int tid = fresh_tid(), lane = tid & 63, wid = tid >> 6;
    unsigned char* ws = P->ws;
    const bf16* VAb = (const bf16*)(ws + WS_VA); const bf16* Lb = (const bf16*)(ws + WS_L); bf16* Rb = (bf16*)(ws + WS_R);
    const float* CB = (const float*)(ws + WS_CB); const bf16* YD0 = (const bf16*)((const unsigned char*)P->out + 64 * MiB); const bf16* YD1 = YD0 + (size_t)NMAIN * 512;
    const bf16* GT = (const bf16*)(ws + WS_LORA + 262144);
    LAS float* st = (LAS float*)(lds + 17408);
    const float* mup = P->in[I_MUP]; const float* mun = P->in[I_MUN];
    for (int tile = blockIdx.x; tile < NMAIN / 64; tile += gridDim.x) {
        {
            const int row = tid >> 3, hh = tid & 7, m = tile * 64 + row;
            const int t = m < 16384 ? m : (m - 16384) & 2047, Ls = m < 16384 ? 16384 : 2048;
            float sum = 0.f, sq = 0.f;
#pragma unroll
            for (int i = 0; i < 8; ++i) { float a[8], b[8]; unpack8(*(const u32x4*)(YD0 + (size_t)m * 512 + hh * 64 + i * 8), a); unpack8(*(const u32x4*)(YD1 + (size_t)m * 512 + hh * 64 + i * 8), b);
#pragma unroll
                for (int e = 0; e < 8; ++e) { const float y = a[e] + b[e]; sum += y; sq += y * y; } }
            const float mu = sum * (1.0f / 64.0f); const float var = fmaxf(sq * (1.0f / 64.0f) - mu * mu, 0.f);
            st[(row * 8 + hh) * 2] = mu; st[(row * 8 + hh) * 2 + 1] = rsqrtf(var + 64e-5f);
#pragma unroll
            for (int i = 0; i < 2; ++i) {
                const int c0 = 128 + hh * 16 + i * 8; float cv[8], o[8];
                unpack8(*(const u32x4*)(Lb + (size_t)m * 256 + c0), cv);
#pragma unroll
                for (int e = 0; e < 8; ++e) o[e] = sigmoidf_(cv[e]);
                u32x4 w; w.x = cvtpk(o[0], o[1]); w.y = cvtpk(o[2], o[3]); w.z = cvtpk(o[4], o[5]); w.w = cvtpk(o[6], o[7]);
                *(LAS u32x4*)(lds + row * 272 + (hh * 16 + i * 8) * 2) = w;
            }
        }
        __syncthreads();
#pragma unroll 1
        for (int nt = 0; nt < 4; ++nt) {
            const int col = wid * 64 + nt * 16 + (lane & 15);
            bf16x8 bfr[4];
#pragma unroll
            for (int ks = 0; ks < 4; ++ks) bfr[ks] = *(const bf16x8*)(GT + (size_t)col * 128 + ks * 32 + (lane >> 4) * 8);
            const float lw = P->in[I_LNW][col], lb = P->in[I_LNB][col];
            const float mpv = mup[1024 + col], mnv = mun[1024 + col];
#pragma unroll 1
            for (int mt = 0; mt < 4; ++mt) {
                f32x4 acc = {0.f, 0.f, 0.f, 0.f};
#pragma unroll
                for (int ks = 0; ks < 4; ++ks) { const bf16x8 a = *(const LAS bf16x8*)(lds + (mt * 16 + (lane & 15)) * 272 + ks * 64 + (lane >> 4) * 16); acc = __builtin_amdgcn_mfma_f32_16x16x32_bf16(a, bfr[ks], acc, 0, 0, 0); }
#pragma unroll
                for (int rg = 0; rg < 4; ++rg) {
                    const int row = mt * 16 + (lane >> 4) * 4 + rg, m = tile * 64 + row;
                    const int t = m < 16384 ? m : (m - 16384) & 2047, Ls = m < 16384 ? 16384 : 2048;
                    const float y = bf2f(YD0[(size_t)m * 512 + col]) + bf2f(YD1[(size_t)m * 512 + col]);
                    const float yn = (y - st[(row * 8 + wid) * 2]) * st[(row * 8 + wid) * 2 + 1] * lw + lb;
                    const float vs = bf2f(VAb[(size_t)m * 512 + col]);
                    const float cb = CB[(size_t)m * 8 + wid] + CB[((size_t)ROWS + m) * 8 + wid];
                    Rb[(size_t)m * 512 + col] = (bf16)f2bf_rne((yn + cb * vs) * acc[rg]);
                }
            }
        }
        __syncthreads();
    }
}

__device__ __forceinline__ void phase_rms_bf16(KP P) {
    const int tid = fresh_tid(), lane = tid & 63, wid = tid >> 6; const int gw = blockIdx.x * 8 + wid, NGW = gridDim.x * 8;
    bf16* MN = (bf16*)(P->ws + WS_MN);
    for (int m = gw; m < NMAIN; m += NGW) rms_row_bf16(P->out + (size_t)m * DM, P->in[I_GFFN], MN + (size_t)m * DM, lane);
}
__device__ __forceinline__ void phase_final(KP P) {
    const int tid = fresh_tid(), lane = tid & 63, wid = tid >> 6; const int gw = blockIdx.x * 8 + wid, NGW = gridDim.x * 8;
    const f32x4* gr = (const f32x4*)P->in[I_GFIN] + lane;
    for (int m = gw; m < NMAIN; m += NGW) {
        f32x4* xr = (f32x4*)(P->out + (size_t)m * DM) + lane; f32x4 v[4]; float s = 0.f;
#pragma unroll
        for (int j = 0; j < 4; ++j) { v[j] = xr[64 * j]; s += (v[j].x * v[j].x + v[j].y * v[j].y) + (v[j].z * v[j].z + v[j].w * v[j].w); }
        const float rstd = rsqrtf(wave_sum(s) * (1.f / DM) + 1e-6f);
#pragma unroll
        for (int j = 0; j < 4; ++j) xr[64 * j] = v[j] * rstd * gr[64 * j];
    }
}

constexpr int NRP_LONG = 4;
constexpr int N_LONG = 16 * NRP_LONG, N_ATT_P = 512, N_ATT_S = 512, N_SHORT = 128, N_ITEMS = N_LONG + N_ATT_P + N_ATT_S + N_SHORT;

template <class Op> __device__ __forceinline__ void run_gemm(LAS unsigned char* lds, const bf16* A, const bf16* Bt, int M, int N, int K, const Op& op, const bf16* A2 = nullptr, int pm2 = 1 << 30) {
    pg8::Gemm g{A, Bt, M, N, K, A2, pm2}; pg8::StaticOrder S; S.init(M, N, (int)gridDim.x, (int)blockIdx.x);
    Epi8<Op> E{op};
    pg8::gemm_phase<Epi8<Op>, pg8::StaticOrder, true, true>(lds, g, S, E);
}

constexpr size_t WS_XBAR = 16384;
#define XB_TMO      128
#define XB_XCNT(j)  (256  + 64 * (j))
#define XB_XSUB(j)  (1280 + 64 * (j))
#define XB_XGEN(j)  (2304 + 64 * (j))
#define XB_TOP      3328
#define XB_TOPGEN   3392
#define XCD_BAR_WORDS 3456
#define XB_SPIN_CAP (1u << 18)
__device__ __forceinline__ unsigned xb_ld(unsigned* p)              { return __hip_atomic_load(p, __ATOMIC_RELAXED, __HIP_MEMORY_SCOPE_AGENT); }
__device__ __forceinline__ unsigned xb_add(unsigned* p, unsigned v) { return __hip_atomic_fetch_add(p, v, __ATOMIC_RELAXED, __HIP_MEMORY_SCOPE_AGENT); }
__device__ __forceinline__ unsigned xb_xcc_id() { return (unsigned)__builtin_amdgcn_s_getreg((3 << 11) | 20) & 0xFu; }
#define XB_SPIN(cond, bar) do { unsigned _sp = 0; while (cond) { __builtin_amdgcn_s_sleep(1); \
    if ((++_sp & 255u) == 0u) { if (xb_ld(&(bar)[XB_TMO])) break; if (_sp > XB_SPIN_CAP) { atomicAdd(&(bar)[XB_TMO], 1u); break; } } } } while (0)
struct XcdBarrier { unsigned* bar; unsigned x; volatile LAS unsigned* st; };
__device__ __forceinline__ XcdBarrier xcd_barrier_post(unsigned* bar, volatile LAS unsigned* st) {
    XcdBarrier b; b.bar = bar; b.x = xb_xcc_id(); b.st = st;
    if (threadIdx.x == 0) (void)xb_add(&bar[XB_XCNT(b.x)], 1u);
    return b;
}
__device__ __forceinline__ void xcd_barrier_complete(unsigned* bar, unsigned x, unsigned& nloc, unsigned& nx) {
    const unsigned G = gridDim.x * gridDim.y * gridDim.z;
    unsigned sum, cnt, mine, sp = 0u;
    for (;;) {
        sum = 0u; cnt = 0u; mine = 0u;
#pragma unroll
        for (unsigned j = 0; j < 16; ++j) { const unsigned c = xb_ld(&bar[XB_XCNT(j)]); sum += c; cnt += (c > 0u) ? 1u : 0u; mine = (j == x) ? c : mine; }
        if (sum == G) break;
        __builtin_amdgcn_s_sleep(1);
        if ((++sp & 255u) == 0u) { if (xb_ld(&bar[XB_TMO])) break; if (sp > XB_SPIN_CAP) { atomicAdd(&bar[XB_TMO], 1u); break; } }
    }
    nloc = mine > 0u ? mine : 1u; nx = cnt > 0u ? cnt : 1u;
}
__device__ __forceinline__ void xcd_barrier(const XcdBarrier& b) {
    asm volatile("s_waitcnt vmcnt(0)" ::: "memory");
    __syncthreads();
    if (threadIdx.x == 0) {
        unsigned* bar = b.bar;
        __builtin_amdgcn_s_waitcnt(0);
        unsigned nloc = b.st[0], nx = b.st[1];
        if (nloc == 0u) { xcd_barrier_complete(bar, b.x, nloc, nx); b.st[0] = nloc; b.st[1] = nx; }
        const unsigned old = xb_add(&bar[XB_XSUB(b.x)], 1u);
        const unsigned gen = old / nloc;
        if (old + 1u == (gen + 1u) * nloc) {
            __builtin_amdgcn_fence(__ATOMIC_RELEASE, "agent");
            asm volatile("s_waitcnt vmcnt(0)" ::: "memory");
            const unsigned og = xb_add(&bar[XB_TOP], 1u);
            const unsigned tg = og / nx;
            if (og + 1u == (tg + 1u) * nx) xb_add(&bar[XB_TOPGEN], 1u);
            else XB_SPIN(xb_ld(&bar[XB_TOPGEN]) == tg, bar);
            __builtin_amdgcn_fence(__ATOMIC_ACQUIRE, "agent");
            xb_add(&bar[XB_XGEN(b.x)], 1u);
            asm volatile("s_waitcnt vmcnt(0)" ::: "memory");
        } else {
            XB_SPIN(xb_ld(&bar[XB_XGEN(b.x)]) == gen, bar);
            __builtin_amdgcn_fence(__ATOMIC_ACQUIRE, "agent");
            asm volatile("s_waitcnt vmcnt(0)" ::: "memory");
        }
    }
    __syncthreads();
}
#ifndef PROBE_MASK
#define PROBE_MASK 0
#endif
#ifndef PROBE_MUL
#define PROBE_MUL 1
#endif
#define PH_BEGIN(k) unsigned long long t0_##k = 0; if (PROBE_MASK & (1 << (k))) t0_##k = __builtin_amdgcn_s_memrealtime();
#define PH_END(k) if (PROBE_MASK & (1 << (k))) { const unsigned long long t1_ = __builtin_amdgcn_s_memrealtime(); const unsigned long long dt_ = (t1_ - t0_##k) * PROBE_MUL; while (__builtin_amdgcn_s_memrealtime() - t1_ < dt_) __builtin_amdgcn_s_sleep(8); xcd_barrier(xbar); }
__global__ void __launch_bounds__(NTHREADS) fwd_megakernel(Params Pin) {
    extern __shared__ __attribute__((aligned(16))) unsigned char lds_raw[];
    LAS unsigned char* lds = (LAS unsigned char*)lds_raw;
    cg::grid_group grid = cg::this_grid();
    KP P0 = (KP)__builtin_amdgcn_kernarg_segment_ptr();
    volatile LAS unsigned* xst = (volatile LAS unsigned*)(lds + LDS_ITEM_OFF + 4);
    if (threadIdx.x == 0) { xst[0] = 0u; xst[1] = 0u; }
    __syncthreads();
    const XcdBarrier xbar = xcd_barrier_post((unsigned*)(P0->ws + WS_XBAR), xst);
#define NEWPHASE KP P = P0; asm volatile("" : "+s"(P)); unsigned char* ws = P->ws; (void)ws;

    PH_BEGIN(0)
    { NEWPHASE phase_prologue(lds, P); }
    grid.sync();
    PH_END(0)
    PH_BEGIN(1)
    { NEWPHASE run_gemm(lds, (const bf16*)P->out, (const bf16*)(ws + WS_WIN), ROWS, 3328, 1024, OpProj{ws}, (const bf16*)(ws + WS_XNMETA), 128); }
    xcd_barrier(xbar);
    PH_END(1)
    { NEWPHASE phase_halo(P); }
    xcd_barrier(xbar);
    { NEWPHASE phase_shift(lds, P); }
    xcd_barrier(xbar);
    PH_BEGIN(2)
    { NEWPHASE
        const int tid = fresh_tid();
        float lam;
        { const int lane = tid & 63; const float s1 = wave_sum(P->in[I_LQ1][lane] * P->in[I_LK1][lane]), s2 = wave_sum(P->in[I_LQ2][lane] * P->in[I_LK2][lane]); lam = __expf(s1) - __expf(s2) + 0.2f; }
        unsigned* ctr = (unsigned*)(ws + WS_CTL);
        LAS unsigned* slot = (LAS unsigned*)(lds + LDS_ITEM_OFF);
#define FETCH(k, n) if (tid == 0) *slot = atomicAdd(ctr + 64 * (k), 1u); __syncthreads(); const int idx = (int)*slot; __syncthreads(); if (idx >= (n)) break;
#ifndef NO_SCAN
#pragma unroll 1
        for (;;) { FETCH(0, N_LONG) const int u = idx / NRP_LONG; scan_long(lds, P, 0, u >> 3, u & 7, idx % NRP_LONG); }
#endif
#ifndef NO_ATTN
#pragma unroll 1
        for (;;) { FETCH(1, N_ATT_P + N_ATT_S)
            if (idx < N_ATT_P) attn_unit(lds, P, 0, idx >> 7, idx & 127, lam);
            else { const int a = idx - N_ATT_P; attn_unit(lds, P, 1 + (a >> 6), (a >> 4) & 3, a & 15, lam); } }
#endif
#ifndef NO_SCAN
#pragma unroll 1
        for (;;) { FETCH(2, N_SHORT) scan_unit<1, 8>(lds, P, 1 + (idx >> 4), (idx >> 3) & 1, idx & 7, 0); }
#endif
#undef FETCH
    }
    xcd_barrier(xbar);
    PH_END(2)
#ifndef NO_POST
    PH_BEGIN(3)
    { NEWPHASE phase_post(lds, P); }
#endif
    xcd_barrier(xbar);
    PH_END(3)
    PH_BEGIN(4)
    { NEWPHASE run_gemm(lds, (const bf16*)P->out, (const bf16*)(ws + WS_WIN) + (size_t)3328 * 1024, NMAIN, 1024, 1024, OpGate{(bf16*)(ws + WS_GA)}); }
    { NEWPHASE run_gemm(lds, (const bf16*)P->out, (const bf16*)(ws + WS_WIN) + (size_t)4352 * 1024, NMAIN, 1024, 1024, OpGate{(bf16*)(ws + WS_GB)}); }

    PH_END(4)
    PH_BEGIN(5)
    { NEWPHASE run_gemm(lds, (const bf16*)(ws + WS_R), (const bf16*)(ws + WS_WUPA), NMAIN, 1024, 512, OpUpA{ws}); }
    PH_END(5)
    PH_BEGIN(6)
    { NEWPHASE run_gemm(lds, (const bf16*)(ws + WS_Q), (const bf16*)(ws + WS_WUPB), NMAIN, 1024, 512, OpUpB{ws}); }
    xcd_barrier(xbar);
    PH_END(6)
    PH_BEGIN(7)
    { NEWPHASE run_gemm(lds, (const bf16*)(ws + WS_GB), (const bf16*)(ws + WS_WOUT), NMAIN, 1024, 1024, OpOut{P->in[I_XP], P->in[I_XS], P->out}); }
    xcd_barrier(xbar);
    PH_END(7)
    PH_BEGIN(8)
    { NEWPHASE phase_rms_bf16(P); }
    xcd_barrier(xbar);
    PH_END(8)
    PH_BEGIN(9)
    { NEWPHASE run_gemm(lds, (const bf16*)(ws + WS_MN), (const bf16*)(ws + WS_WFF1), 16384, DFF, 1024, OpFF1{(bf16*)(ws + WS_HID)}); }
    xcd_barrier(xbar);
    PH_END(9)
    PH_BEGIN(10)
    { NEWPHASE run_gemm(lds, (const bf16*)(ws + WS_HID), (const bf16*)(ws + WS_WFF2), 16384, 1024, DFF, OpFF2{P->out}); }
    xcd_barrier(xbar);
    PH_END(10)
    PH_BEGIN(11)
    { NEWPHASE run_gemm(lds, (const bf16*)(ws + WS_MN) + (size_t)16384 * DM, (const bf16*)(ws + WS_WFF1), 16384, DFF, 1024, OpFF1{(bf16*)(ws + WS_HID)}); }
    xcd_barrier(xbar);
    PH_END(11)
    PH_BEGIN(12)
    { NEWPHASE run_gemm(lds, (const bf16*)(ws + WS_HID), (const bf16*)(ws + WS_WFF2), 16384, 1024, DFF, OpFF2{P->out + (size_t)16384 * DM}); }
    xcd_barrier(xbar);
    PH_END(12)
    PH_BEGIN(13)
    { NEWPHASE phase_final(P); }
}

extern "C" void kernel_launch(void* const* d_in, const int* in_sizes, int n_in, void* d_out, int out_size, void* d_ws, size_t ws_size, hipStream_t stream) {
    static int grid_blocks = 0;
    if (grid_blocks == 0) {
        int dev = 0, cus = 0, per_cu = 0;
        hipGetDevice(&dev);
        hipDeviceGetAttribute(&cus, hipDeviceAttributeMultiprocessorCount, dev);
        hipFuncSetAttribute((const void*)fwd_megakernel, hipFuncAttributeMaxDynamicSharedMemorySize, LDS_BYTES);
        hipOccupancyMaxActiveBlocksPerMultiprocessor(&per_cu, (const void*)fwd_megakernel, NTHREADS, LDS_BYTES);
        if (per_cu < 1) { fprintf(stderr, "kernel_launch: occupancy query says %d blocks per CU\n", per_cu); per_cu = 1; }
        grid_blocks = cus * per_cu;
        if (n_in != 29 || ws_size < WS_END) fprintf(stderr, "kernel_launch: unexpected n_in %d / ws_size %zu\n", n_in, ws_size);
    }
    hipMemsetAsync((unsigned char*)d_ws + WS_CTL, 0, 32768, stream);
    Params p{};
    for (int i = 0; i < 29; ++i) p.in[i] = (const float*)d_in[i];
    p.out = (float*)d_out; p.ws = (unsigned char*)d_ws;
    void* args[] = {&p};
    hipError_t e = hipLaunchCooperativeKernel((const void*)fwd_megakernel, dim3(grid_blocks), dim3(NTHREADS), args, LDS_BYTES, stream);
    if (e != hipSuccess) fprintf(stderr, "cooperative launch failed: %s (grid %d)\n", hipGetErrorString(e), grid_blocks);
}
```

```cpp
#include <hip/hip_runtime.h>
#include <hip/hip_cooperative_groups.h>
#include <cstdio>
#include <cstdint>
#include <cmath>
namespace cg = cooperative_groups;
__device__ __forceinline__ int fresh_tid() { int t = threadIdx.x; asm volatile("" : "+v"(t)); return t; }
namespace pg8 {
#define PG8_LAS __attribute__((address_space(3)))
typedef unsigned short bf16_t;
typedef short bf16x8 __attribute__((ext_vector_type(8)));
typedef float f32x4 __attribute__((ext_vector_type(4)));
typedef unsigned u32x4 __attribute__((ext_vector_type(4)));
constexpr int BM = 256, BK = 64, HALF = 128, HTB = HALF * BK * 2  , STAGE_BYTES = 8 * HTB, NXCD = 8, WGM = 8;

__host__ __device__ __forceinline__ int lds_byte(int r, int c) { const int st = (r >> 4) * 2 + (c >> 5), rr = r & 15, cc = c & 31, ob = rr * 64 + cc * 2; return st * 1024 + (ob ^ (((ob >> 9) & 1) << 5)); }
__host__ __device__ __forceinline__ void stage_rc(int b, int& R, int& C) { const int st = b / 1024, sb = b % 1024, swz = sb ^ (((sb >> 9) & 1) << 5); R = (st >> 1) * 16 + swz / 64; C = (st & 1) * 32 + (swz % 64) / 2; }
__host__ __device__ __forceinline__ int perm32(int rho) { const int n = rho >> 4, i = rho & 15; return 8 * (i >> 2) + 4 * n + (i & 3); }

struct Unit { int pm, pn; };
struct Gemm { const bf16_t* A; const bf16_t* Bt; int M, N, K; const bf16_t* A2; int pm2; };
__device__ __forceinline__ const char* gemm_abase(const Gemm& g, int pm, size_t tstep) { return pm >= g.pm2 ? (const char*)g.A2 + (size_t)(pm - g.pm2) * tstep : (const char*)g.A + (size_t)pm * tstep; }

struct StaticOrder {
    int nM, nN, nwg, G, c;
    __host__ __device__ void init(int M, int N, int G_, int c_) { nM = M / BM; nN = N / BM; nwg = nM * nN; G = G_; c = c_; }
    __host__ __device__ bool next(int i, Unit& u) const {
        const long L = (long)i * G + c; if (L >= nwg) return false;
        int wgid = (int)L; { const int q = nwg / NXCD, r = nwg % NXCD, xcd = wgid % NXCD, off = wgid / NXCD; wgid = (xcd < r ? xcd * (q + 1) : r * (q + 1) + (xcd - r) * q) + off; }
        const int nig = WGM * nN, gid = wgid / nig, fm = gid * WGM, gsz = (nM - fm) < WGM ? (nM - fm) : WGM;
        u.pm = fm + ((wgid % nig) % gsz); u.pn = (wgid % nig) / gsz; return true;
    }
    __device__ __forceinline__ void a_ready(const Unit&) const {}
    __device__ __forceinline__ void done(const Unit&) const {}
};


template <class Epi, class Sched, bool ALIGN_EPI = false, bool SP2 = false>
__device__ __forceinline__ void gemm_phase(PG8_LAS unsigned char* lds, const Gemm g, const Sched& S, const Epi& E) {
    const int tid = fresh_tid(), wid = __builtin_amdgcn_readfirstlane(tid >> 6), lane = tid & 63, wr = wid >> 2, wc = wid & 3, fr = lane & 15, fq = lane >> 4;
    const int K = g.K, nt = K / BK;
    unsigned voffA[2], voffB[2];
#pragma unroll
    for (int i = 0; i < 2; ++i) { int R, C; stage_rc(tid * 16 + i * 8192, R, C); const int Rb = Epi::PERM ? ((R & ~31) + perm32(R & 31)) : R;
        voffA[i] = (unsigned)(R * K + C) * 2u; voffB[i] = (unsigned)(Rb * K + C) * 2u; }
    const size_t kstep = (size_t)(BK * 2);
    const size_t hstep = (size_t)HALF * K * 2;
    const size_t tstep = 2 * hstep;
    const unsigned ldsw = (unsigned)wid * 1024u;
    const int aoff = lds_byte(wr * 64 + fr, fq * 8), boff = lds_byte(wc * 32 + fr, fq * 8);
#define PG8_SA(b, h) (((b) * 2 + (h)) * HTB)
#define PG8_SB(b, h) ((4 + (b) * 2 + (h)) * HTB)
#define PG8_STAGE(bufoff, gbase, voff) do { _Pragma("unroll") for (int _i = 0; _i < 2; ++_i) \
        __builtin_amdgcn_global_load_lds((const unsigned*)((const char*)(gbase) + (voff)[_i]), (PG8_LAS unsigned*)(lds + (bufoff) + ldsw + _i * 8192), 16, 0, 0); } while (0)
#define PG8_LDA(dst, b, h) do { _Pragma("unroll") for (int m = 0; m < 4; ++m) _Pragma("unroll") for (int k = 0; k < 2; ++k) dst[m][k] = *(const PG8_LAS bf16x8*)(lds + PG8_SA(b, h) + aoff + m * 2048 + k * 1024); } while (0)
#define PG8_LDB(dst, b, h) do { _Pragma("unroll") for (int n = 0; n < 2; ++n) _Pragma("unroll") for (int k = 0; k < 2; ++k) dst[n][k] = *(const PG8_LAS bf16x8*)(lds + PG8_SB(b, h) + boff + n * 2048 + k * 1024); } while (0)
#define PG8_MMA(ai, bj, At, Bt) do { __builtin_amdgcn_s_setprio(1); _Pragma("unroll") for (int m = 0; m < 4; ++m) _Pragma("unroll") for (int n = 0; n < 2; ++n) _Pragma("unroll") for (int k = 0; k < 2; ++k) \
        acc[ai][bj][m][n] = __builtin_amdgcn_mfma_f32_16x16x32_bf16(Bt[n][k], At[m][k], acc[ai][bj][m][n], 0, 0, 0); __builtin_amdgcn_s_setprio(0); } while (0)
#define PG8_WAIT_V(n) asm volatile("s_waitcnt vmcnt(" #n ")" ::: "memory")
#define PG8_WAIT_L(n) asm volatile("s_waitcnt lgkmcnt(" #n ")" ::: "memory")
#define PG8_BAR __builtin_amdgcn_s_barrier()
#define PG8_SCHED __builtin_amdgcn_sched_barrier(0)
    Unit cur, nxt; int ui = 0;
    if (!S.next(0, cur)) return;
    f32x4 acc[2][2][4][2];
#pragma unroll
    for (int a = 0; a < 2; ++a)
#pragma unroll
        for (int b = 0; b < 2; ++b)
#pragma unroll
            for (int m = 0; m < 4; ++m)
#pragma unroll
                for (int n = 0; n < 2; ++n) acc[a][b][m][n] = (f32x4){0.f, 0.f, 0.f, 0.f};
    bf16x8 At[4][2], B0[2][2], B1[2][2];
    const char* cA = gemm_abase(g, cur.pm, tstep); const char* cB = (const char*)g.Bt + (size_t)cur.pn * tstep;
    S.a_ready(cur);
    if constexpr (SP2) {
        PG8_STAGE(PG8_SB(0, 0), cB, voffB); PG8_STAGE(PG8_SB(0, 1), cB + hstep, voffB); PG8_STAGE(PG8_SA(0, 0), cA, voffA); PG8_STAGE(PG8_SA(0, 1), cA + hstep, voffA);
        if (wr == 1) PG8_BAR;
        PG8_WAIT_V(2); PG8_BAR;
        PG8_STAGE(PG8_SB(1, 0), cB + kstep, voffB); PG8_STAGE(PG8_SA(1, 0), cA + kstep, voffA); PG8_STAGE(PG8_SB(1, 1), cB + hstep + kstep, voffB);
        PG8_WAIT_V(6); PG8_BAR;
    } else {
        PG8_STAGE(PG8_SB(0, 0), cB, voffB); PG8_STAGE(PG8_SA(0, 0), cA, voffA); PG8_STAGE(PG8_SB(0, 1), cB + hstep, voffB); PG8_STAGE(PG8_SA(0, 1), cA + hstep, voffA);
        if (wr == 1) PG8_BAR;
        PG8_WAIT_V(4); PG8_BAR;
        PG8_STAGE(PG8_SB(1, 0), cB + kstep, voffB); PG8_STAGE(PG8_SA(1, 0), cA + kstep, voffA); PG8_STAGE(PG8_SB(1, 1), cB + hstep + kstep, voffB);
        PG8_WAIT_V(6); PG8_BAR;
    }
    for (;;) {
        const bool has_next = S.next(ui + 1, nxt);
        const char* nA = has_next ? gemm_abase(g, nxt.pm, tstep) : cA; const char* nB = has_next ? (const char*)g.Bt + (size_t)nxt.pn * tstep : cB;
        for (int t = 0; t < nt; t += 2) {
            const bool last = (t == nt - 2);
            const char* a1 = cA + (size_t)(t + 1) * kstep;
            const char* a2 = last ? nA : cA + (size_t)(t + 2) * kstep; const char* b2 = last ? nB : cB + (size_t)(t + 2) * kstep;
            const char* a3 = a2 + kstep; const char* b3 = b2 + kstep;
            if (last && has_next) S.a_ready(nxt);
            if constexpr (SP2) {
            PG8_LDB(B0, 0, 0); PG8_LDB(B1, 0, 1); PG8_SCHED; PG8_LDA(At, 0, 0); PG8_STAGE(PG8_SA(1, 1), a1 + hstep, voffA);
            PG8_WAIT_V(8); PG8_WAIT_L(0); PG8_BAR; PG8_MMA(0, 0, At, B0); PG8_MMA(0, 1, At, B1); PG8_BAR; PG8_SCHED;
            PG8_LDA(At, 0, 1); PG8_STAGE(PG8_SB(0, 0), b2, voffB); PG8_STAGE(PG8_SB(0, 1), b2 + hstep, voffB); PG8_STAGE(PG8_SA(0, 0), a2, voffA);
            PG8_WAIT_V(8); PG8_WAIT_L(0); PG8_BAR; PG8_MMA(1, 0, At, B0); PG8_MMA(1, 1, At, B1); PG8_BAR; PG8_SCHED;
            PG8_LDB(B0, 1, 0); PG8_LDB(B1, 1, 1); PG8_SCHED; PG8_LDA(At, 1, 0); PG8_STAGE(PG8_SA(0, 1), a2 + hstep, voffA);
            PG8_WAIT_V(8); PG8_WAIT_L(0); PG8_BAR; PG8_MMA(0, 0, At, B0); PG8_MMA(0, 1, At, B1); PG8_BAR; PG8_SCHED;
            PG8_LDA(At, 1, 1); PG8_STAGE(PG8_SB(1, 0), b3, voffB); PG8_STAGE(PG8_SB(1, 1), b3 + hstep, voffB); PG8_STAGE(PG8_SA(1, 0), a3, voffA);
            PG8_WAIT_V(8); PG8_WAIT_L(0); PG8_BAR; PG8_MMA(1, 0, At, B0); PG8_MMA(1, 1, At, B1); PG8_BAR; PG8_SCHED;
            } else {
            PG8_LDB(B0, 0, 0); PG8_SCHED; PG8_LDA(At, 0, 0); PG8_STAGE(PG8_SA(1, 1), a1 + hstep, voffA);
            PG8_WAIT_L(8); PG8_BAR; PG8_WAIT_L(0); PG8_MMA(0, 0, At, B0); PG8_BAR; PG8_SCHED;
            PG8_LDB(B1, 0, 1); PG8_STAGE(PG8_SB(0, 0), b2, voffB);
            PG8_BAR; PG8_WAIT_L(0); PG8_MMA(0, 1, At, B1); PG8_BAR;
            PG8_LDA(At, 0, 1); PG8_STAGE(PG8_SA(0, 0), a2, voffA);
            PG8_BAR; PG8_WAIT_L(0); PG8_MMA(1, 0, At, B0); PG8_BAR; PG8_SCHED;
            PG8_STAGE(PG8_SB(0, 1), b2 + hstep, voffB);
            PG8_WAIT_V(6); PG8_BAR; PG8_MMA(1, 1, At, B1); PG8_BAR;
            PG8_LDB(B0, 1, 0); PG8_SCHED; PG8_LDA(At, 1, 0); PG8_STAGE(PG8_SA(0, 1), a2 + hstep, voffA);
            PG8_WAIT_L(8); PG8_BAR; PG8_WAIT_L(0); PG8_MMA(0, 0, At, B0); PG8_BAR; PG8_SCHED;
            PG8_LDB(B1, 1, 1); PG8_STAGE(PG8_SB(1, 0), b3, voffB);
            PG8_BAR; PG8_WAIT_L(0); PG8_MMA(0, 1, At, B1); PG8_BAR;
            PG8_LDA(At, 1, 1); PG8_STAGE(PG8_SA(1, 0), a3, voffA);
            PG8_BAR; PG8_WAIT_L(0); PG8_MMA(1, 0, At, B0); PG8_BAR; PG8_SCHED;
            PG8_STAGE(PG8_SB(1, 1), b3 + hstep, voffB);
            PG8_WAIT_V(6); PG8_BAR; PG8_MMA(1, 1, At, B1); PG8_BAR;
            }
        }
        if constexpr (ALIGN_EPI) { if (wr == 0) PG8_BAR; }
        if constexpr (!Epi::AFTER_DRAIN) { E(acc, cur, wr, wc, fr, fq); S.done(cur); }
        if (!has_next) break;
#pragma unroll
        for (int a = 0; a < 2; ++a)
#pragma unroll
            for (int b = 0; b < 2; ++b)
#pragma unroll
                for (int m = 0; m < 4; ++m)
#pragma unroll
                    for (int n = 0; n < 2; ++n) acc[a][b][m][n] = (f32x4){0.f, 0.f, 0.f, 0.f};
        cur = nxt; cA = nA; cB = nB; ++ui;
        if constexpr (ALIGN_EPI) { if (wr == 1) PG8_BAR; }
    }
    PG8_WAIT_V(0);
    if constexpr (!ALIGN_EPI) { if (wr == 0) PG8_BAR; }
    PG8_BAR;
    if constexpr (Epi::AFTER_DRAIN) { E.fused(acc, cur, wr, wc, fr, fq, lds, wid, lane); S.done(cur); }
#undef PG8_SA
#undef PG8_SB
#undef PG8_STAGE
#undef PG8_LDA
#undef PG8_LDB
#undef PG8_MMA
#undef PG8_WAIT_V
#undef PG8_WAIT_L
#undef PG8_BAR
#undef PG8_SCHED
}
}

#ifndef PG8_SP2
#define PG8_SP2 true
#endif

#define LAS __attribute__((address_space(3)))
typedef unsigned short bf16;
typedef short bf16x8 __attribute__((ext_vector_type(8)));
typedef float f32x4 __attribute__((ext_vector_type(4)));
typedef float f32x16 __attribute__((ext_vector_type(16)));
typedef unsigned u32x4 __attribute__((ext_vector_type(4)));
typedef unsigned u32x2 __attribute__((ext_vector_type(2)));

constexpr int DM = 1024, NMAIN = 32768, ROWS = 33024, METAROW = 32768, DFF = 4096;
constexpr int NTHREADS = 512;
constexpr int LDS_BYTES = 147456;
constexpr int LDS_ITEM_OFF = LDS_BYTES - 16;
constexpr size_t MiB = 1u << 20;
constexpr size_t WS_CTL = 0, WS_WIN = 1 * MiB, WS_WUPA = 12 * MiB, WS_WUPB = 13 * MiB, WS_WOUT = 14 * MiB, WS_WFF1 = 16 * MiB, WS_WFF2 = 24 * MiB;
constexpr size_t WS_LORA = 32 * MiB, WS_XNMETA = 32 * MiB + 512 * 1024, WS_CB = 33 * MiB, WS_ACT = 36 * MiB;
constexpr size_t ACT_SZ = (size_t)ROWS * 512 * 2, L_SZ = (size_t)ROWS * 256 * 2;
constexpr size_t WS_R = WS_ACT, WS_KA = WS_R + ACT_SZ, WS_VA = WS_KA + ACT_SZ, WS_L = WS_VA + ACT_SZ, WS_Q = WS_L + L_SZ, WS_KB = WS_Q + ACT_SZ, WS_VT = WS_KB + ACT_SZ, WS_END = WS_VT + ACT_SZ;
constexpr size_t WS_GA = WS_KA, WS_GB = WS_KB, WS_MN = WS_ACT, WS_HID = WS_ACT + 64 * MiB;
constexpr size_t WS_HALO = WS_END;
constexpr int HALO_ROW = 3584;
static_assert(WS_HALO + (size_t)(NMAIN / 64) * 2 * HALO_ROW <= 256 * MiB, "halo buffer");
static_assert(WS_END <= 256 * MiB && WS_HID + 128 * MiB <= 256 * MiB && WS_CB + (size_t)2 * ROWS * 8 * 4 <= WS_ACT, "ws map");
constexpr float LOG2E = 1.4426950408889634f;
constexpr float QSCALE = 0.125f * LOG2E;

struct Params { const float* in[29]; float* out; unsigned char* ws; };
typedef const __attribute__((address_space(4))) Params* KP;
enum { I_XP = 0, I_XS, I_META, I_GMIX, I_WIN, I_MUP, I_MUN, I_W0, I_WUP, I_A0, I_AUP, I_GUP, I_KK, I_KA, I_RK, I_LNW, I_LNB, I_LQ1, I_LK1, I_LQ2, I_LK2, I_SUBG, I_UPA, I_UPB, I_WOUT, I_GFFN, I_FF1, I_FF2, I_GFIN };

typedef float cvt_f32x2 __attribute__((ext_vector_type(2))); typedef __bf16 cvt_bf16x2 __attribute__((ext_vector_type(2)));
__device__ __forceinline__ unsigned cvtpk(float lo, float hi) { const cvt_f32x2 v = {lo, hi}; const cvt_bf16x2 b = __builtin_convertvector(v, cvt_bf16x2); return __builtin_bit_cast(unsigned, b); }
__device__ __forceinline__ float bf2f(unsigned short b) { return __uint_as_float(((unsigned)b) << 16); }
__device__ __forceinline__ float bflo(unsigned w) { return __uint_as_float(w << 16); }
__device__ __forceinline__ float bfhi(unsigned w) { return __uint_as_float(w & 0xffff0000u); }
__device__ __forceinline__ void unpack8(const u32x4 v, float* o) { o[0] = bflo(v.x); o[1] = bfhi(v.x); o[2] = bflo(v.y); o[3] = bfhi(v.y); o[4] = bflo(v.z); o[5] = bfhi(v.z); o[6] = bflo(v.w); o[7] = bfhi(v.w); }
__device__ __forceinline__ float wave_sum(float v) {
#pragma unroll
    for (int o = 1; o < 64; o <<= 1) v += __shfl_xor(v, o);
    return v;
}
__device__ __forceinline__ float sigmoidf_(float x) { return __builtin_amdgcn_rcpf(1.0f + __builtin_amdgcn_exp2f(-LOG2E * x)); }
__device__ __forceinline__ int seq_base(int s) { return s == 0 ? 0 : 16384 + (s - 1) * 2048; }
__device__ __forceinline__ int seq_len(int s) { return s == 0 ? 16384 : 2048; }
__device__ __forceinline__ int pos_row(int base, int p) { return p < 16 ? METAROW + p : base + p - 16; }

template <class Op> struct Epi8 {
    static constexpr bool PERM = true, AFTER_DRAIN = false;
    Op op;
    __device__ __forceinline__ void operator()(const pg8::f32x4 (&acc)[2][2][4][2], const pg8::Unit& u, int wr, int wc, int fr, int fq) const {
        const int row0 = u.pm * 256 + wr * 64 + fr, col0 = u.pn * 256 + wc * 32 + 8 * fq;
#pragma unroll
        for (int ai = 0; ai < 2; ++ai)
#pragma unroll
            for (int m = 0; m < 4; ++m)
#pragma unroll
                for (int bj = 0; bj < 2; ++bj) { op.apply(row0 + ai * 128 + m * 16, col0 + bj * 128, u.pn, acc[ai][bj][m][0], acc[ai][bj][m][1]); asm volatile("" ::: "memory"); }
    }
};
__device__ __forceinline__ u32x4 pack8(const f32x4 a, const f32x4 b) { u32x4 w; w.x = cvtpk(a[0], a[1]); w.y = cvtpk(a[2], a[3]); w.z = cvtpk(b[0], b[1]); w.w = cvtpk(b[2], b[3]); return w; }

constexpr int CW_KN = 320;
__device__ __forceinline__ float dpp_max16(float v) {
    int x = __float_as_int(v);
    v = fmaxf(v, __int_as_float(__builtin_amdgcn_update_dpp(0, x, 0xB1, 0xf, 0xf, true))); x = __float_as_int(v);
    v = fmaxf(v, __int_as_float(__builtin_amdgcn_update_dpp(0, x, 0x4E, 0xf, 0xf, true))); x = __float_as_int(v);
    v = fmaxf(v, __int_as_float(__builtin_amdgcn_update_dpp(0, x, 0x141, 0xf, 0xf, true))); x = __float_as_int(v);
    v = fmaxf(v, __int_as_float(__builtin_amdgcn_update_dpp(0, x, 0x140, 0xf, 0xf, true)));
    return v;
}
struct OpProj {
    unsigned char* ws;
    __device__ __forceinline__ void apply(int row, int col, int pn, f32x4 v0, f32x4 v1) const {
        if (pn >= 11) {
            bf16* VT = (bf16*)(ws + WS_VT); const int c = col - 11 * 256;
#pragma unroll
            for (int e = 0; e < 4; ++e) { bf16* vt = VT + ((size_t)(row >> 6) * 512 + c) * 64 + (row & 63);
                vt[e * 64] = (bf16)(cvtpk(v0[e], 0.f) & 0xffffu); vt[(4 + e) * 64] = (bf16)(cvtpk(v1[e], 0.f) & 0xffffu); }
            return;
        }
        bf16* O; int ldc = 512, c;
        if (pn < 2) { O = (bf16*)(ws + WS_R); c = col; }
        else if (pn < 4) { O = (bf16*)(ws + WS_KA); c = col - 512; }
        else if (pn < 6) { O = (bf16*)(ws + WS_VA); c = col - 1024; }
        else if (pn < 7) { O = (bf16*)(ws + WS_L); c = col - 1536; ldc = 256; }
        else if (pn < 9) { O = (bf16*)(ws + WS_Q); c = col - 1792; v0 = v0 * QSCALE; v1 = v1 * QSCALE; }
        else { O = (bf16*)(ws + WS_KB); c = col - 2304; }
        const u32x4 w = pack8(v0, v1);
        *(u32x4*)(O + (size_t)row * ldc + c) = w;
        if (pn >= 9) {
            float k8[8]; unpack8(w, k8); float ss = 0.f;
#pragma unroll
            for (int e = 0; e < 8; ++e) ss = fmaf(k8[e], k8[e], ss);
            ss = dpp_max16(ss);
            if ((threadIdx.x & 15) == 0) { const int sidx = row < 16384 ? 0 : row < NMAIN ? 1 + ((row - 16384) >> 11) : 9;
                atomicMax((unsigned*)(ws + WS_CTL) + CW_KN + sidx * 64 + (c >> 3), __float_as_uint(ss)); }
        }
    }
};
struct OpGate {
    bf16* O;
    __device__ __forceinline__ void apply(int row, int col, int pn, f32x4 v0, f32x4 v1) const {
        const int c = col;
#pragma unroll
        for (int e = 0; e < 4; ++e) { v0[e] = sigmoidf_(v0[e]); v1[e] = sigmoidf_(v1[e]); }
        *(u32x4*)(O + (size_t)row * 1024 + c) = pack8(v0, v1);
    }
};
struct OpUpA {
    unsigned char* ws;
    __device__ __forceinline__ void apply(int row, int col, int pn, f32x4 v0, f32x4 v1) const {
        u32x4* p = (u32x4*)((bf16*)(ws + WS_GA) + (size_t)row * 1024 + col); float g[8]; unpack8(*p, g);
#pragma unroll
        for (int e = 0; e < 4; ++e) { v0[e] *= g[e]; v1[e] *= g[4 + e]; }
        *p = pack8(v0, v1);
    }
};
struct OpUpB {
    unsigned char* ws;
    __device__ __forceinline__ void apply(int row, int col, int pn, f32x4 v0, f32x4 v1) const {
        u32x4* p = (u32x4*)((bf16*)(ws + WS_GB) + (size_t)row * 1024 + col); float g[8], a[8]; unpack8(*p, g);
        unpack8(*(const u32x4*)((const bf16*)(ws + WS_GA) + (size_t)row * 1024 + col), a);
#pragma unroll
        for (int e = 0; e < 4; ++e) { v0[e] = a[e] + v0[e] * g[e]; v1[e] = a[4 + e] + v1[e] * g[4 + e]; }
        *p = pack8(v0, v1);
    }
};
struct OpOut {
    const float* xp; const float* xs; float* out;
    __device__ __forceinline__ void apply(int row, int col, int pn, f32x4 v0, f32x4 v1) const {
        const float* x = (row < 16384 ? xp + (size_t)row * DM : xs + (size_t)(row - 16384) * DM) + col;
        float* o = out + (size_t)row * DM + col;
        *(f32x4*)o = *(const f32x4*)x + v0; *(f32x4*)(o + 4) = *(const f32x4*)(x + 4) + v1;
    }
};
struct OpFF1 {
    bf16* hid;
    __device__ __forceinline__ void apply(int row, int col, int pn, f32x4 v0, f32x4 v1) const {
#pragma unroll
        for (int e = 0; e < 4; ++e) { const float a = fmaxf(v0[e], 0.f), b = fmaxf(v1[e], 0.f); v0[e] = a * a; v1[e] = b * b; }
        *(u32x4*)(hid + (size_t)row * DFF + col) = pack8(v0, v1);
    }
};
struct OpFF2 {
    float* out;
    __device__ __forceinline__ void apply(int row, int col, int pn, f32x4 v0, f32x4 v1) const {
        float* o = out + (size_t)row * DM + col;
        *(f32x4*)o = *(const f32x4*)o + v0; *(f32x4*)(o + 4) = *(const f32x4*)(o + 4) + v1;
    }
};

__device__ __forceinline__ unsigned f2bf_rne(float f) { return cvtpk(f, 0.f) & 0xffffu; }
__device__ __forceinline__ void transpose_item(const float* W, int K, int N, bf16* WT, LAS float* scr, int item, int lane) {
    const int nblk = N / 32, kb = item / nblk, nb = item % nblk, k0 = 64 * kb, n0 = 32 * nb;
#pragma unroll 8
    for (int i = 0; i < 32; ++i) { const int kk = 2 * i + (lane >> 5); scr[kk * 33 + (lane & 31)] = W[(size_t)(k0 + kk) * N + n0 + (lane & 31)]; }
    asm volatile("s_waitcnt vmcnt(0) lgkmcnt(0)" ::: "memory");
    const int c = lane & 7;
#pragma unroll
    for (int j = 0; j < 4; ++j) { const int n = (lane >> 3) + 8 * j; const LAS float* s = scr + (8 * c) * 33 + n;
        u32x4 o; o.x = cvtpk(s[0 * 33], s[1 * 33]); o.y = cvtpk(s[2 * 33], s[3 * 33]); o.z = cvtpk(s[4 * 33], s[5 * 33]); o.w = cvtpk(s[6 * 33], s[7 * 33]);
        *(u32x4*)(WT + (size_t)(n0 + n) * K + k0 + 8 * c) = o; }
    asm volatile("s_waitcnt lgkmcnt(0)" ::: "memory");
}
__device__ __forceinline__ void rms_row_bf16(const float* src, const float* g, bf16* dst, int lane) {
    unsigned long long* o8 = (unsigned long long*)dst + lane;
    if (!src) {
#pragma unroll
        for (int j = 0; j < 4; ++j) o8[64 * j] = 0ull;
        return; }
    const f32x4* xr = (const f32x4*)src + lane; const f32x4* gr = (const f32x4*)g + lane;
    f32x4 v[4]; float s = 0.f;
#pragma unroll
    for (int j = 0; j < 4; ++j) { v[j] = xr[64 * j]; s += (v[j].x * v[j].x + v[j].y * v[j].y) + (v[j].z * v[j].z + v[j].w * v[j].w); }
    const float rstd = rsqrtf(wave_sum(s) * (1.f / DM) + 1e-6f);
#pragma unroll
    for (int j = 0; j < 4; ++j) { const f32x4 gg = gr[64 * j]; const f32x4 y = v[j] * rstd * gg;
        o8[64 * j] = (unsigned long long)cvtpk(y.x, y.y) | ((unsigned long long)cvtpk(y.z, y.w) << 32); }
}
__device__ __forceinline__ void phase_prologue(LAS unsigned char* lds, KP P) {
    const int tid = fresh_tid(), lane = tid & 63, wid = tid >> 6;
    LAS float* scr = (LAS float*)(lds + wid * 16384);
    const int gw = blockIdx.x * 8 + wid, NGW = gridDim.x * 8;
    unsigned char* ws = P->ws;
    constexpr int I_IN = (1024 / 64) * (5376 / 32), I_UP = (512 / 64) * (1024 / 32), I_O = (1024 / 64) * (1024 / 32), I_1 = (1024 / 64) * (4096 / 32), I_2 = (4096 / 64) * (1024 / 32);
    constexpr int I_LW = (64 / 64) * (512 / 32), I_G = (128 / 64) * (512 / 32);
    constexpr int NITEMS = I_IN + 2 * I_UP + I_O + I_1 + I_2 + 4 * I_LW + I_G;
    for (int it = gw; it < NITEMS; it += NGW) {
        int r = it;
        if (r < I_IN) { transpose_item(P->in[I_WIN], 1024, 5376, (bf16*)(ws + WS_WIN), scr, r, lane); continue; } r -= I_IN;
        if (r < I_UP) { transpose_item(P->in[I_UPA], 512, 1024, (bf16*)(ws + WS_WUPA), scr, r, lane); continue; } r -= I_UP;
        if (r < I_UP) { transpose_item(P->in[I_UPB], 512, 1024, (bf16*)(ws + WS_WUPB), scr, r, lane); continue; } r -= I_UP;
        if (r < I_O) { transpose_item(P->in[I_WOUT], 1024, 1024, (bf16*)(ws + WS_WOUT), scr, r, lane); continue; } r -= I_O;
        if (r < I_1) { transpose_item(P->in[I_FF1], 1024, 4096, (bf16*)(ws + WS_WFF1), scr, r, lane); continue; } r -= I_1;
        if (r < I_2) { transpose_item(P->in[I_FF2], 4096, 1024, (bf16*)(ws + WS_WFF2), scr, r, lane); continue; } r -= I_2;
        if (r < 2 * I_LW) { const int d = r / I_LW; transpose_item(P->in[I_WUP] + (size_t)d * 64 * 512, 64, 512, (bf16*)(ws + WS_LORA) + (size_t)d * 512 * 64, scr, r % I_LW, lane); continue; } r -= 2 * I_LW;
        if (r < 2 * I_LW) { const int d = r / I_LW; transpose_item(P->in[I_AUP] + (size_t)d * 64 * 512, 64, 512, (bf16*)(ws + WS_LORA + 131072) + (size_t)d * 512 * 64, scr, r % I_LW, lane); continue; } r -= 2 * I_LW;
        transpose_item(P->in[I_GUP], 128, 512, (bf16*)(ws + WS_LORA + 262144), scr, r, lane);
    }
    bf16* XN = (bf16*)P->out; bf16* XM = (bf16*)(ws + WS_XNMETA);
    for (int m = gw; m < ROWS; m += NGW) {
        const float* src = m < 16384 ? P->in[I_XP] + (size_t)m * DM : m < NMAIN ? P->in[I_XS] + (size_t)(m - 16384) * DM : (m - NMAIN < 16 ? P->in[I_META] + (size_t)(m - NMAIN) * DM : nullptr);
        bf16* dst = m < NMAIN ? XN + (size_t)m * DM : XM + (size_t)(m - NMAIN) * DM;
        rms_row_bf16(src, P->in[I_GMIX], dst, lane);
    }
}

constexpr int AT_KSTR = 272, AT_VSTR = 144, AT_KSZ = 64 * AT_KSTR, AT_BUF = AT_KSZ + 128 * AT_VSTR;
__device__ __forceinline__ f32x16 mfma32(bf16x8 a, bf16x8 b, f32x16 c) { return __builtin_amdgcn_mfma_f32_32x32x16_bf16(a, b, c, 0, 0, 0); }
__device__ __forceinline__ void attn_unit(LAS unsigned char* lds, KP P, int s, int h, int qb, float lam) {
    int tid_ = threadIdx.x; asm volatile("" : "+v"(tid_));
    const int tid = tid_, lane = tid & 63, r32 = lane & 31, hi = lane >> 5, wid = __builtin_amdgcn_readfirstlane(tid >> 6), rg = wid & 3, mp = wid >> 2;
    const int L = seq_len(s), base = seq_base(s), NT = 1 + L / 64;
    unsigned char* ws = P->ws;
    const bf16* KB = (const bf16*)(ws + WS_KB); const bf16* VT = (const bf16*)(ws + WS_VT); bf16* Q = (bf16*)(ws + WS_Q);
    const int qrow = base + qb * 128 + rg * 32 + r32;
    bf16x8 q[4];
#pragma unroll
    for (int d0 = 0; d0 < 4; ++d0) q[d0] = *(const bf16x8*)(Q + (size_t)qrow * 512 + h * 128 + mp * 64 + d0 * 16 + hi * 8);
    f32x16 O[4];
#pragma unroll
    for (int b = 0; b < 4; ++b)
#pragma unroll
        for (int r = 0; r < 16; ++r) O[b][r] = 0.f;
    float mx = -INFINITY, ls = 0.f;
    const float qh = (float)(16 + qb * 128 + rg * 32 + r32 - 4 * hi);
    const float nslope = -exp2f(-2.0f * (float)(h + 1)) * LOG2E;
    const int kr0 = tid >> 4, kc = tid & 15, vn0 = tid >> 3, vc = tid & 7;
    u32x4 kreg[2], vreg[2];
    const unsigned kgo = (unsigned)((kr0 * 512 + h * 128 + kc * 8) * 2), vgo = (unsigned)(((h * 128 + vn0) * 64 + vc * 8) * 2);
    const unsigned klo = (unsigned)(kr0 * AT_KSTR + kc * 16), vlo = (unsigned)(AT_KSZ + vn0 * AT_VSTR + vc * 16);
#define AT_GLOAD(j) do { const int m0_ = (j) == 0 ? METAROW : base + 64 * ((j) - 1); \
        const unsigned char* kt_ = (const unsigned char*)KB + (size_t)m0_ * 1024; const unsigned char* vt_ = (const unsigned char*)VT + (size_t)(m0_ >> 6) * (512 * 64 * 2); \
        kreg[0] = *(const u32x4*)(kt_ + kgo); kreg[1] = *(const u32x4*)(kt_ + 32 * 1024 + kgo); \
        vreg[0] = *(const u32x4*)(vt_ + vgo); vreg[1] = *(const u32x4*)(vt_ + 64 * 64 * 2 + vgo); } while (0)
#define AT_LSTORE(buf) do { LAS unsigned char* kb_ = lds + (buf) * AT_BUF; \
        *(LAS u32x4*)(kb_ + klo) = kreg[0]; *(LAS u32x4*)(kb_ + klo + 32 * AT_KSTR) = kreg[1]; \
        *(LAS u32x4*)(kb_ + vlo) = vreg[0]; *(LAS u32x4*)(kb_ + vlo + 64 * AT_VSTR) = vreg[1]; } while (0)
    float qn, kn;
    { float ssq = 0.f;
#pragma unroll
      for (int d0 = 0; d0 < 4; ++d0) { float t[8]; unpack8(__builtin_bit_cast(u32x4, q[d0]), t);
#pragma unroll
        for (int e = 0; e < 8; ++e) ssq = fmaf(t[e], t[e], ssq); }
      ssq += __shfl_xor(ssq, 32); qn = sqrtf(ssq) * 1.002f;
      const unsigned* KN = (const unsigned*)(ws + WS_CTL) + CW_KN; float ks = 0.f;
#pragma unroll
      for (int g = 0; g < 8; ++g) ks += fmaxf(__uint_as_float(__hip_atomic_load(KN + s * 64 + h * 16 + mp * 8 + g, __ATOMIC_RELAXED, __HIP_MEMORY_SCOPE_AGENT)), __uint_as_float(__hip_atomic_load(KN + 9 * 64 + h * 16 + mp * 8 + g, __ATOMIC_RELAXED, __HIP_MEMORY_SCOPE_AGENT)));
      kn = sqrtf(ks) * 1.002f; }
    const int jc0 = 1 + qb * 2;
    int jlo = jc0, jhi = jc0 + 1;
    LAS float* red = (LAS float*)(lds + 2 * AT_BUF);
#pragma unroll 1
    for (int ph = 0; ph < 2; ++ph) {
        int nleft, ntl;
        if (ph == 0) { nleft = 0; ntl = 2; }
        else {
            float dneed = (qn * kn - mx + 40.0f) / (-nslope);
#pragma unroll
            for (int o = 1; o < 64; o <<= 1) dneed = fmaxf(dneed, __shfl_xor(dneed, o));
            if (lane == 0) red[wid] = dneed;
            __syncthreads();
            float dm = red[0];
#pragma unroll
            for (int w8 = 1; w8 < 8; ++w8) dm = fmaxf(dm, red[w8]);
            dm = fminf(fmaxf(dm, 0.f), 1.0e6f);
            const int dmax = (int)dm + 1, q0 = 16 + qb * 128;
            const int plo = q0 - dmax, phi = q0 + 127 + dmax;
            jlo = plo < 16 ? 0 : 1 + ((plo - 16) >> 6); jhi = phi >= L + 16 ? NT - 1 : 1 + ((phi - 16) >> 6);
            if (jlo > jc0) jlo = jc0; if (jhi < jc0 + 1) jhi = jc0 + 1;
            nleft = jc0 - jlo; ntl = nleft + (jhi - jc0 - 1);
        }
        if (ntl > 0) {
#define AT_J(t) (ph == 0 ? jc0 + (t) : ((t) < nleft ? jlo + (t) : jc0 + 2 + ((t) - nleft)))
        { const int jf = AT_J(0); AT_GLOAD(jf); } AT_LSTORE(0); __syncthreads();
#pragma unroll 1
        for (int t = 0; t < ntl; ++t) {
            const int j = AT_J(t);
            if (t + 1 < ntl) { const int jn = AT_J(t + 1); AT_GLOAD(jn); }
            const LAS unsigned char* Kb = lds + (t & 1) * AT_BUF + mp * 128; const LAS unsigned char* Vb = lds + (t & 1) * AT_BUF + AT_KSZ;
            const float dq = qh - (float)(j == 0 ? 0 : 64 * j - 48);
            f32x16 p0, p1;
#pragma unroll
            for (int r = 0; r < 16; ++r) { p0[r] = 0.f; p1[r] = 0.f; }
            {
                bf16x8 ka[4], kb[4];
#pragma unroll
                for (int d0 = 0; d0 < 4; ++d0) { ka[d0] = *(const LAS bf16x8*)(Kb + r32 * AT_KSTR + d0 * 32 + hi * 16); kb[d0] = *(const LAS bf16x8*)(Kb + (32 + r32) * AT_KSTR + d0 * 32 + hi * 16); }
                __builtin_amdgcn_sched_barrier(0);
#pragma unroll
                for (int d0 = 0; d0 < 4; ++d0) { p0 = mfma32(ka[d0], q[d0], p0); p1 = mfma32(kb[d0], q[d0], p1); }
            }
#pragma unroll
            for (int r = 0; r < 16; ++r) { const float dd = dq - (float)((r & 3) + 8 * (r >> 2)); p0[r] = fmaf(fabsf(dd), nslope, p0[r]); p1[r] = fmaf(fabsf(dd - 32.f), nslope, p1[r]); }
            if (j == 0) {
#pragma unroll
                for (int r = 0; r < 16; ++r) { if ((r & 3) + 8 * (r >> 2) + 4 * hi >= 16) p0[r] = -INFINITY; p1[r] = -INFINITY; }
            }
            float rm = fmaxf(p0[0], p1[0]);
#pragma unroll
            for (int r = 1; r < 16; ++r) rm = fmaxf(rm, fmaxf(p0[r], p1[r]));
            rm = fmaxf(rm, __shfl_xor(rm, 32));
            if (__any(rm > mx - 38.0f)) {
            const float mn = fmaxf(mx, rm);
            if (__any(mn > mx)) {
                const float f = __builtin_amdgcn_exp2f(mx - mn); ls *= f; mx = mn;
#pragma unroll
                for (int b = 0; b < 4; ++b)
#pragma unroll
                    for (int r = 0; r < 16; ++r) O[b][r] *= f;
            }
            float sum = 0.f;
#pragma unroll
            for (int r = 0; r < 16; ++r) { p0[r] = __builtin_amdgcn_exp2f(p0[r] - mx); p1[r] = __builtin_amdgcn_exp2f(p1[r] - mx); sum += p0[r] + p1[r]; }
            ls += sum;
            bf16x8 pf[4];
#pragma unroll
            for (int k2 = 0; k2 < 2; ++k2) {
                u32x4 w0, w1;
                w0.x = cvtpk(p0[8 * k2 + 0], p0[8 * k2 + 1]); w0.y = cvtpk(p0[8 * k2 + 2], p0[8 * k2 + 3]); w0.z = cvtpk(p0[8 * k2 + 4], p0[8 * k2 + 5]); w0.w = cvtpk(p0[8 * k2 + 6], p0[8 * k2 + 7]);
                w1.x = cvtpk(p1[8 * k2 + 0], p1[8 * k2 + 1]); w1.y = cvtpk(p1[8 * k2 + 2], p1[8 * k2 + 3]); w1.z = cvtpk(p1[8 * k2 + 4], p1[8 * k2 + 5]); w1.w = cvtpk(p1[8 * k2 + 6], p1[8 * k2 + 7]);
                pf[k2] = __builtin_bit_cast(bf16x8, w0); pf[2 + k2] = __builtin_bit_cast(bf16x8, w1);
            }
            {
                u32x4 vcur[4], vnxt[4];
#define AT_VLOAD(dst, ks_) do { _Pragma("unroll") for (int b_ = 0; b_ < 4; ++b_) { const LAS unsigned char* vp_ = Vb + (b_ * 32 + r32) * AT_VSTR + (ks_) * 32 + hi * 8; \
                    const u32x2 lo_ = *(const LAS u32x2*)vp_, hh_ = *(const LAS u32x2*)(vp_ + 16); dst[b_].x = lo_.x; dst[b_].y = lo_.y; dst[b_].z = hh_.x; dst[b_].w = hh_.y; } } while (0)
                AT_VLOAD(vcur, 0);
#pragma unroll
                for (int ks = 0; ks < 4; ++ks) {
                    if (ks < 3) AT_VLOAD(vnxt, ks + 1);
                    __builtin_amdgcn_sched_barrier(0);
#pragma unroll
                    for (int b = 0; b < 4; ++b) O[b] = mfma32(__builtin_bit_cast(bf16x8, vcur[b]), pf[ks], O[b]);
                    __builtin_amdgcn_sched_barrier(0);
#pragma unroll
                    for (int b = 0; b < 4; ++b) vcur[b] = vnxt[b];
                }
#undef AT_VLOAD
            }
            }
            if (t + 1 < ntl) AT_LSTORE((t + 1) & 1);
            __syncthreads();
        }
#undef AT_J
        }
    }
#undef AT_GLOAD
#undef AT_LSTORE
    const float lt = ls + __shfl_xor(ls, 32);
    const float inv = (mp ? lam : 1.0f) / lt;
    int lane2 = lane; asm volatile("" : "+v"(lane2));
    const int r32e = lane2 & 31, hie = lane2 >> 5;
    LAS float* ex = (LAS float*)lds + rg * (128 * 32) + hie * 128 + r32e;
    if (mp == 1) {
#pragma unroll
        for (int b = 0; b < 4; ++b)
#pragma unroll
            for (int r = 0; r < 16; ++r) ex[(32 * b + (r & 3) + 8 * (r >> 2)) * 32] = O[b][r] * inv;
    }
    __syncthreads();
    if (mp == 0) {
        float ss = 0.f;
#pragma unroll
        for (int b = 0; b < 4; ++b)
#pragma unroll
            for (int r = 0; r < 16; ++r) { const float o = O[b][r] * inv - ex[(32 * b + (r & 3) + 8 * (r >> 2)) * 32]; O[b][r] = o; ss += o * o; }
        ss += __shfl_xor(ss, 32);
        const float rstd = rsqrtf(ss * (1.0f / 128.0f) + 1e-5f) * 0.8f;
        const float* sg = P->in[I_SUBG] + 4 * hie; bf16* Qo = Q + (size_t)(base + qb * 128 + rg * 32 + r32e) * 512 + h * 128 + 4 * hie;
#pragma unroll
        for (int b = 0; b < 4; ++b)
#pragma unroll
            for (int r4 = 0; r4 < 4; ++r4) {
                const int n = 32 * b + 8 * r4; const f32x4 g = *(const f32x4*)(sg + n);
                u32x2 w; w.x = cvtpk(O[b][4 * r4 + 0] * rstd * g.x, O[b][4 * r4 + 1] * rstd * g.y); w.y = cvtpk(O[b][4 * r4 + 2] * rstd * g.z, O[b][4 * r4 + 3] * rstd * g.w);
                *(u32x2*)(Qo + n) = w;
            }
    }
    __syncthreads();
}

constexpr int SC_R = 0, SC_K = 16384, SC_V = 32768, SC_W = 49152, SC_B = 65536, SC_KK = 81920, SC_Y = 98304, SC_TW = 114688, SC_AD = 123904, SC_MU = 133120;
__device__ __forceinline__ float dpp_add(float v, int ctrl_id) {
    const int x = __float_as_int(v); int y;
    if (ctrl_id == 0) y = __builtin_amdgcn_update_dpp(0, x, 0xB1, 0xf, 0xf, true);
    else if (ctrl_id == 1) y = __builtin_amdgcn_update_dpp(0, x, 0x4E, 0xf, 0xf, true);
    else if (ctrl_id == 2) y = __builtin_amdgcn_update_dpp(0, x, 0x141, 0xf, 0xf, true);
    else y = __builtin_amdgcn_update_dpp(0, x, 0x140, 0xf, 0xf, true);
    return v + __int_as_float(y);
}
template <int LPR> __device__ __forceinline__ float grp_sum(float v) {
    v = dpp_add(v, 0); v = dpp_add(v, 1); v = dpp_add(v, 2);
    if (LPR == 16) v = dpp_add(v, 3);
    return v;
}
#define BAR_LDS() asm volatile("s_waitcnt lgkmcnt(0)\n\ts_barrier" ::: "memory")
__device__ __forceinline__ float fast_sigmoid(float x) { return __builtin_amdgcn_rcpf(1.0f + __builtin_amdgcn_exp2f(-LOG2E * x)); }
__device__ __forceinline__ float fast_tanh(float x) { return 1.0f - 2.0f * __builtin_amdgcn_rcpf(1.0f + __builtin_amdgcn_exp2f(2.0f * LOG2E * x)); }
template <int NRP, int NSW>
__device__ __forceinline__ void scan_unit(LAS unsigned char* lds, KP P, int s, int d, int h, int rp) {
    constexpr int RPB = 64 / NRP, RPW = RPB / NSW, LPR = 64 / RPW, CPL = 64 / LPR;
    static_assert(LPR == 8 || LPR == 16, "scan geometry");
    constexpr bool YDB = (RPB == 16) && (NSW == 4);
    constexpr int YST = YDB ? RPB : 64;
    int tid_ = threadIdx.x; asm volatile("" : "+v"(tid_));
    const int tid = tid_, lane = tid & 63, wid = __builtin_amdgcn_readfirstlane(tid >> 6);
    const int L = seq_len(s), base = seq_base(s), Ltot = L + 16, nchunk = (Ltot + 63) / 64;
    unsigned char* ws = P->ws;
    const bf16* Rb = (const bf16*)(ws + WS_R); const bf16* KAb = (const bf16*)(ws + WS_KA); const bf16* VAb = (const bf16*)(ws + WS_VA); const bf16* Lb = (const bf16*)(ws + WS_L);
    float* CB = (float*)(ws + WS_CB); bf16* YD = (bf16*)((unsigned char*)P->out + 64 * MiB) + (size_t)d * NMAIN * 512;
    LAS float* fS = (LAS float*)lds; LAS float* fV = (LAS float*)(lds + 81920); LAS float* fY = (LAS float*)(lds + SC_Y); LAS float* fMU = (LAS float*)(lds + SC_MU);
#define SCI(sl_, a_, c_) ((sl_) * 320 + (a_) * 64 + (c_))
    for (int i = tid; i < 832; i += NTHREADS) {
        float v;
        if (i < 640) { const int which = i / 320, jj = i % 320, a = jj >> 6, c = jj & 63; const int gi = a < 3 ? a * 512 + h * 64 + c : 1536 + (a - 3) * 64 + c; v = P->in[which ? I_MUN : I_MUP][gi]; }
        else { const int a = (i - 640) >> 6, c = (i - 640) & 63; v = P->in[a == 0 ? I_KK : a == 1 ? I_KA : I_RK][h * 64 + c]; }
        fMU[i] = v;
    }
    const int mat = wid >> 2, ntile = wid & 3;
    const bf16* Wt = (const bf16*)(ws + WS_LORA + (mat ? 131072 : 0)) + ((size_t)d * 512 + h * 64 + ntile * 16 + (lane & 15)) * 64 + (lane >> 4) * 8;
    const bf16x8 bfr0 = *(const bf16x8*)Wt, bfr1 = *(const bf16x8*)(Wt + 32);
    const float bias = P->in[mat ? I_A0 : I_W0][d * 512 + h * 64 + ntile * 16 + (lane & 15)];
    float S[CPL];
#pragma unroll
    for (int j = 0; j < CPL; ++j) S[j] = 0.f;
    const int rowl = lane / LPR, kg = lane % LPR, srow = rp * RPB + wid * RPW + rowl;
    const int slot = tid >> 3, cg8 = (tid & 7) * 8;
    u32x4 raw[5][3];
#define SC_META(c) (d ? ((c) == nchunk - 1) : ((c) == 0))
    const unsigned char* HALO0 = ws + WS_HALO + (size_t)(base >> 6) * 2 * HALO_ROW;
#define SC_LOAD(c) do { const int i_ = 64 * (c) + slot; const bool ok_ = i_ < Ltot; const int p_ = d ? Ltot - 1 - i_ : i_; \
        const unsigned zr_ = (unsigned)(METAROW + 64); \
        if (!SC_META(c)) { const unsigned rc_ = ok_ ? (unsigned)(base + p_ - 16) : zr_; \
            _Pragma("unroll") for (int a_ = 0; a_ < 5; ++a_) { const unsigned char* B_ = (const unsigned char*)(a_ == 0 ? Rb : a_ == 1 ? KAb : a_ == 2 ? VAb : Lb); const unsigned ld_ = a_ < 3 ? 1024u : 512u; \
                const unsigned co_ = (unsigned)(((a_ < 3 ? h * 64 : (a_ - 3) * 64) + cg8) * 2); raw[a_][1] = *(const u32x4*)(B_ + (rc_ * ld_ + co_)); } \
        } else { const bool me_ = ok_ && p_ < 16; const bool hn_ = me_ && p_ == 15; \
            const unsigned rc_ = ok_ ? (unsigned)pos_row(base, p_) : zr_, rp_ = (me_ && p_ > 0) ? (unsigned)(METAROW + p_ - 1) : zr_, rn_ = (me_ && p_ < 15) ? (unsigned)(METAROW + p_ + 1) : zr_; \
            _Pragma("unroll") for (int a_ = 0; a_ < 5; ++a_) { const unsigned char* B_ = (const unsigned char*)(a_ == 0 ? Rb : a_ == 1 ? KAb : a_ == 2 ? VAb : Lb); const unsigned ld_ = a_ < 3 ? 1024u : 512u; \
                const unsigned co_ = (unsigned)(((a_ < 3 ? h * 64 : (a_ - 3) * 64) + cg8) * 2); \
                const unsigned ho_ = (unsigned)(((a_ < 3 ? a_ * 512 + h * 64 : 1536 + (a_ - 3) * 64) + cg8) * 2); \
                raw[a_][0] = *(const u32x4*)(B_ + (rp_ * ld_ + co_)); raw[a_][1] = *(const u32x4*)(B_ + (rc_ * ld_ + co_)); \
                const unsigned char* np_ = hn_ ? HALO0 + ho_ : B_ + (rn_ * ld_ + co_); raw[a_][2] = *(const u32x4*)np_; } } } while (0)
    SC_LOAD(0);
    BAR_LDS();
    for (int c = 0; c < nchunk; ++c) {
        const int nvalid = (Ltot - 64 * c) < 64 ? (Ltot - 64 * c) : 64;
        float rv[8], kv[8];
        if (!SC_META(c)) {
            float vv8[8]; unpack8(raw[0][1], rv); unpack8(raw[1][1], kv); unpack8(raw[2][1], vv8);
            { LAS float* dst = fS + SCI(slot, 4, cg8); *(LAS f32x4*)dst = (f32x4){rv[0], rv[1], rv[2], rv[3]}; *(LAS f32x4*)(dst + 4) = (f32x4){rv[4], rv[5], rv[6], rv[7]}; }
            { LAS float* dst = fV + slot * 64 + cg8; *(LAS f32x4*)dst = (f32x4){vv8[0], vv8[1], vv8[2], vv8[3]}; *(LAS f32x4*)(dst + 4) = (f32x4){vv8[4], vv8[5], vv8[6], vv8[7]}; }
            *(LAS u32x4*)(lds + SC_TW + slot * 144 + cg8 * 2) = raw[3][1];
            *(LAS u32x4*)(lds + SC_AD + slot * 144 + cg8 * 2) = raw[4][1];
        } else {
            const int i1 = 64 * c + slot; const int p1 = d ? Ltot - 1 - i1 : i1; const bool me1 = i1 < Ltot && p1 < 16; const float fm = me1 ? 1.0f : 0.0f;
#pragma unroll
            for (int a = 0; a < 5; ++a) {
                float pv[8], cv[8], nv[8], o[8]; unpack8(raw[a][0], pv); unpack8(raw[a][1], cv); unpack8(raw[a][2], nv);
                const f32x4 mp0 = *(const LAS f32x4*)(fMU + a * 64 + cg8), mp1 = *(const LAS f32x4*)(fMU + a * 64 + cg8 + 4), mn0 = *(const LAS f32x4*)(fMU + 320 + a * 64 + cg8), mn1 = *(const LAS f32x4*)(fMU + 320 + a * 64 + cg8 + 4);
#pragma unroll
                for (int e = 0; e < 8; ++e) { const float mp = fm * (e < 4 ? mp0[e & 3] : mp1[e & 3]), mn = fm * (e < 4 ? mn0[e & 3] : mn1[e & 3]); o[e] = cv[e] + mp * (pv[e] - cv[e]) + mn * (nv[e] - cv[e]); }
                if (a == 0) {
#pragma unroll
                    for (int e = 0; e < 8; ++e) rv[e] = o[e];
                    LAS float* dst = fS + SCI(slot, 4, cg8); *(LAS f32x4*)dst = (f32x4){o[0], o[1], o[2], o[3]}; *(LAS f32x4*)(dst + 4) = (f32x4){o[4], o[5], o[6], o[7]};
                } else if (a == 1) {
#pragma unroll
                    for (int e = 0; e < 8; ++e) kv[e] = o[e];
                } else if (a == 2) {
                    LAS float* dst = fV + slot * 64 + cg8; *(LAS f32x4*)dst = (f32x4){o[0], o[1], o[2], o[3]}; *(LAS f32x4*)(dst + 4) = (f32x4){o[4], o[5], o[6], o[7]};
                } else {
                    if (a == 3) {
#pragma unroll
                        for (int e = 0; e < 8; ++e) o[e] = me1 ? fast_tanh(o[e]) : o[e];
                    }
                    u32x4 w; w.x = cvtpk(o[0], o[1]); w.y = cvtpk(o[2], o[3]); w.z = cvtpk(o[4], o[5]); w.w = cvtpk(o[6], o[7]);
                    *(LAS u32x4*)(lds + (a == 3 ? SC_TW : SC_AD) + slot * 144 + cg8 * 2) = w;
                }
            }
        }
        BAR_LDS();
        if (c + 1 < nchunk) SC_LOAD(c + 1);
        {
            const LAS unsigned char* Ab = lds + (mat ? SC_AD : SC_TW); LAS float* fWB = fS + (mat ? 128 : 64);
#pragma unroll
            for (int mt = 0; mt < 4; ++mt) {
                const bf16x8 a0 = *(const LAS bf16x8*)(Ab + (mt * 16 + (lane & 15)) * 144 + (lane >> 4) * 16);
                const bf16x8 a1 = *(const LAS bf16x8*)(Ab + (mt * 16 + (lane & 15)) * 144 + 64 + (lane >> 4) * 16);
                f32x4 acc = {0.f, 0.f, 0.f, 0.f};
                acc = __builtin_amdgcn_mfma_f32_16x16x32_bf16(a0, bfr0, acc, 0, 0, 0);
                acc = __builtin_amdgcn_mfma_f32_16x16x32_bf16(a1, bfr1, acc, 0, 0, 0);
#pragma unroll
                for (int rg = 0; rg < 4; ++rg) {
                    const int sl = mt * 16 + (lane >> 4) * 4 + rg, col = ntile * 16 + (lane & 15);
                    const float sg = fast_sigmoid(acc[rg] + bias); const float dc = __builtin_amdgcn_exp2f(-0.6065306597126334f * LOG2E * sg);
                    fWB[sl * 320 + col] = mat ? sg : dc;
                }
            }
        }
        BAR_LDS();
        {
            const f32x4 a0 = *(const LAS f32x4*)(fS + SCI(slot, 2, cg8)), a1 = *(const LAS f32x4*)(fS + SCI(slot, 2, cg8 + 4));
            const f32x4 kk0 = *(const LAS f32x4*)(fMU + 640 + cg8), kk1 = *(const LAS f32x4*)(fMU + 640 + cg8 + 4), ka0 = *(const LAS f32x4*)(fMU + 704 + cg8), ka1 = *(const LAS f32x4*)(fMU + 704 + cg8 + 4);
            const f32x4 rk0 = *(const LAS f32x4*)(fMU + 768 + cg8), rk1 = *(const LAS f32x4*)(fMU + 768 + cg8 + 4);
            float kkv[8], kd[8], av[8]; float ssq = 0.f, cs = 0.f;
#pragma unroll
            for (int e = 0; e < 8; ++e) {
                av[e] = e < 4 ? a0[e & 3] : a1[e & 3];
                kkv[e] = kv[e] * (e < 4 ? kk0[e & 3] : kk1[e & 3]); ssq = fmaf(kkv[e], kkv[e], ssq);
                kd[e] = kv[e] * (1.0f + (av[e] - 1.0f) * (e < 4 ? ka0[e & 3] : ka1[e & 3])); cs = fmaf(rv[e] * kd[e], e < 4 ? rk0[e & 3] : rk1[e & 3], cs);
            }
            ssq = grp_sum<8>(ssq); cs = grp_sum<8>(cs);
            const float rs = rsqrtf(fmaxf(ssq, 1e-24f));
#pragma unroll
            for (int e = 0; e < 8; ++e) { kkv[e] *= rs; av[e] *= kkv[e]; }
            LAS float* o1 = fS + SCI(slot, 0, cg8); *(LAS f32x4*)o1 = (f32x4){kkv[0], kkv[1], kkv[2], kkv[3]}; *(LAS f32x4*)(o1 + 4) = (f32x4){kkv[4], kkv[5], kkv[6], kkv[7]};
            LAS float* o2 = fS + SCI(slot, 2, cg8); *(LAS f32x4*)o2 = (f32x4){av[0], av[1], av[2], av[3]}; *(LAS f32x4*)(o2 + 4) = (f32x4){av[4], av[5], av[6], av[7]};
            LAS float* o3 = fS + SCI(slot, 3, cg8); *(LAS f32x4*)o3 = (f32x4){kd[0], kd[1], kd[2], kd[3]}; *(LAS f32x4*)(o3 + 4) = (f32x4){kd[4], kd[5], kd[6], kd[7]};
            if (cg8 == 0 && rp == 0 && slot < nvalid) { const int i2 = 64 * c + slot; const int p2 = d ? Ltot - 1 - i2 : i2; CB[((size_t)d * ROWS + pos_row(base, p2)) * 8 + h] = cs; }
        }
        BAR_LDS();
#define SC_STORE_Y(cc_) do { const int t5_ = tid - 256; if (t5_ >= 0 && t5_ < 128) { const int sl5_ = t5_ >> 1, hf_ = t5_ & 1; const int i5_ = 64 * (cc_) + sl5_; const int p5_ = d ? Ltot - 1 - i5_ : i5_; \
            if (i5_ < Ltot && p5_ >= 16) { const LAS float* yp_ = fY + ((cc_) & 1) * 1024 + sl5_ * 16 + hf_ * 8; const f32x4 y0_ = *(const LAS f32x4*)yp_, y1_ = *(const LAS f32x4*)(yp_ + 4); \
                *(u32x4*)(YD + (size_t)(base + p5_ - 16) * 512 + h * 64 + rp * 16 + hf_ * 8) = pack8(y0_, y1_); } } } while (0)
        if (YDB && wid >= NSW && c > 0) SC_STORE_Y(c - 1);
        if (wid < NSW) {
            typedef float f32x2_ __attribute__((ext_vector_type(2)));
            constexpr int C4 = CPL / 4;
            const LAS float* ps = fS + kg * CPL; const LAS float* pv = fV + srow;
            LAS float* py = YDB ? fY + (c & 1) * 1024 + (srow - rp * RPB) : fY + srow;
            f32x4 nk[C4], nw[C4], nb[C4], nd[C4], nr[C4]; float nv;
#define SC_FETCH(sl_) do { _Pragma("unroll") for (int j_ = 0; j_ < C4; ++j_) { nk[j_] = *(const LAS f32x4*)(ps + (sl_) * 320 + 4 * j_); nw[j_] = *(const LAS f32x4*)(ps + (sl_) * 320 + 64 + 4 * j_); \
                nb[j_] = *(const LAS f32x4*)(ps + (sl_) * 320 + 128 + 4 * j_); nd[j_] = *(const LAS f32x4*)(ps + (sl_) * 320 + 192 + 4 * j_); nr[j_] = *(const LAS f32x4*)(ps + (sl_) * 320 + 256 + 4 * j_); } nv = pv[(sl_) * 64]; } while (0)
            SC_FETCH(0);
            f32x4 rp4[C4];
#pragma unroll
            for (int j = 0; j < C4; ++j) rp4[j] = (f32x4){0.f, 0.f, 0.f, 0.f};
#pragma unroll 16
            for (int sl = 0; sl < nvalid; ++sl) {
                f32x4 ck[C4], cw[C4], cb[C4], cd[C4], cr[C4];
#pragma unroll
                for (int j = 0; j < C4; ++j) { ck[j] = nk[j]; cw[j] = nw[j]; cb[j] = nb[j]; cd[j] = nd[j]; cr[j] = nr[j]; }
                const float vv = nv;
                SC_FETCH(sl + 1 < 64 ? sl + 1 : 63);
                f32x2_ pa = {0.f, 0.f}, ya = {0.f, 0.f};
#pragma unroll
                for (int j = 0; j < C4; ++j)
#pragma unroll
                    for (int e = 0; e < 4; e += 2) { const f32x2_ s2 = {S[4 * j + e], S[4 * j + e + 1]}, k2 = {ck[j][e], ck[j][e + 1]}, r2 = {rp4[j][e], rp4[j][e + 1]}; pa = pa + s2 * k2; ya = ya + s2 * r2; }
                float pp = pa.x + pa.y, yy = ya.x + ya.y;
                pp = dpp_add(pp, 0); yy = dpp_add(yy, 0); pp = dpp_add(pp, 1); yy = dpp_add(yy, 1); pp = dpp_add(pp, 2); yy = dpp_add(yy, 2);
                if (LPR == 16) { pp = dpp_add(pp, 3); yy = dpp_add(yy, 3); }
                py[(sl > 0 ? sl - 1 : 0) * YST] = yy;
#pragma unroll
                for (int j = 0; j < C4; ++j)
#pragma unroll
                    for (int e = 0; e < 4; e += 2) {
                        const f32x2_ b2 = {cb[j][e], cb[j][e + 1]}, d2 = {cd[j][e], cd[j][e + 1]}, w2 = {cw[j][e], cw[j][e + 1]}; f32x2_ s2 = {S[4 * j + e], S[4 * j + e + 1]};
                        const f32x2_ t2 = d2 * vv - b2 * pp; s2 = s2 * w2 + t2; S[4 * j + e] = s2.x; S[4 * j + e + 1] = s2.y; }
#pragma unroll
                for (int j = 0; j < C4; ++j) rp4[j] = cr[j];
            }
            {
                f32x2_ ya = {0.f, 0.f};
#pragma unroll
                for (int j = 0; j < C4; ++j)
#pragma unroll
                    for (int e = 0; e < 4; e += 2) { const f32x2_ s2 = {S[4 * j + e], S[4 * j + e + 1]}, r2 = {rp4[j][e], rp4[j][e + 1]}; ya = ya + s2 * r2; }
                const float yy = grp_sum<LPR>(ya.x + ya.y);
                py[(nvalid - 1) * YST] = yy;
            }
#undef SC_FETCH
        }
        BAR_LDS();
        {
            const int i2 = 64 * c + slot; const int p2 = d ? Ltot - 1 - i2 : i2;
            if (!YDB && slot < nvalid && p2 >= 16 && (cg8 / RPB) == rp) {
                const LAS float* yp = fY + slot * 64 + cg8; const f32x4 y0 = *(const LAS f32x4*)yp, y1 = *(const LAS f32x4*)(yp + 4);
                *(u32x4*)(YD + (size_t)(base + p2 - 16) * 512 + h * 64 + cg8) = pack8(y0, y1);
            }
        }
    }
    if (YDB) SC_STORE_Y(nchunk - 1);
#undef SC_STORE_Y
#undef SC_LOAD
#undef SC_META
#undef SCI
}

constexpr int SL_FV = 81920, SL_FY = 86016, SL_TW = 90112, SL_AD = 94720, SL_AS = 99328, SL_MU = 107520;
__device__ __forceinline__ void scan_long(LAS unsigned char* lds, KP P, int s, int d, int h, int rp) {
    int tid_ = threadIdx.x; asm volatile("" : "+v"(tid_));
    const int tid = tid_, lane = tid & 63, wid = __builtin_amdgcn_readfirstlane(tid >> 6);
    const int L = seq_len(s), base = seq_base(s), Ltot = L + 16, nhalf = (Ltot + 31) / 32;
    unsigned char* ws = P->ws;
    const bf16* Rb = (const bf16*)(ws + WS_R); const bf16* KAb = (const bf16*)(ws + WS_KA); const bf16* VAb = (const bf16*)(ws + WS_VA); const bf16* Lb = (const bf16*)(ws + WS_L);
    float* CB = (float*)(ws + WS_CB); bf16* YD = (bf16*)((unsigned char*)P->out + 64 * MiB) + (size_t)d * NMAIN * 512;
    LAS float* fS = (LAS float*)lds; LAS float* fV = (LAS float*)(lds + SL_FV); LAS float* fY = (LAS float*)(lds + SL_FY); LAS float* fAS = (LAS float*)(lds + SL_AS); LAS float* fMU = (LAS float*)(lds + SL_MU);
    for (int i = tid; i < 832; i += NTHREADS) {
        float v;
        if (i < 640) { const int which = i / 320, jj = i % 320, a = jj >> 6, c = jj & 63; const int gi = a < 3 ? a * 512 + h * 64 + c : 1536 + (a - 3) * 64 + c; v = P->in[which ? I_MUN : I_MUP][gi]; }
        else { const int a = (i - 640) >> 6, c = (i - 640) & 63; v = P->in[a == 0 ? I_KK : a == 1 ? I_KA : I_RK][h * 64 + c]; }
        fMU[i] = v;
    }
    const bool scanner = wid < 4; const int pw = wid & 3;
    const int sl8 = lane >> 3, cg8 = (lane & 7) * 8, slot = pw * 8 + sl8;
    const int rowl = lane >> 4, kg = lane & 15, srl = pw * 4 + rowl;
    const unsigned char* HALO0 = ws + WS_HALO + (size_t)(base >> 6) * 2 * HALO_ROW;
    u32x4 raw[5][3];
#define SL_META(hc) (d ? ((hc) == nhalf - 1) : ((hc) == 0))
#define SL_LOAD(hc) do { const int i_ = 32 * (hc) + slot; const bool ok_ = i_ < Ltot; const int p_ = d ? Ltot - 1 - i_ : i_; \
        const unsigned zr_ = (unsigned)(METAROW + 64); \
        if (!SL_META(hc)) { const unsigned rc_ = ok_ ? (unsigned)(base + p_ - 16) : zr_; \
            _Pragma("unroll") for (int a_ = 0; a_ < 5; ++a_) { const unsigned char* B_ = (const unsigned char*)(a_ == 0 ? Rb : a_ == 1 ? KAb : a_ == 2 ? VAb : Lb); const unsigned ld_ = a_ < 3 ? 1024u : 512u; \
                const unsigned co_ = (unsigned)(((a_ < 3 ? h * 64 : (a_ - 3) * 64) + cg8) * 2); raw[a_][1] = *(const u32x4*)(B_ + (rc_ * ld_ + co_)); } \
        } else { const bool me_ = ok_ && p_ < 16; const bool hn_ = me_ && p_ == 15; \
            const unsigned rc_ = ok_ ? (unsigned)pos_row(base, p_) : zr_, rp_ = (me_ && p_ > 0) ? (unsigned)(METAROW + p_ - 1) : zr_, rn_ = (me_ && p_ < 15) ? (unsigned)(METAROW + p_ + 1) : zr_; \
            _Pragma("unroll") for (int a_ = 0; a_ < 5; ++a_) { const unsigned char* B_ = (const unsigned char*)(a_ == 0 ? Rb : a_ == 1 ? KAb : a_ == 2 ? VAb : Lb); const unsigned ld_ = a_ < 3 ? 1024u : 512u; \
                const unsigned co_ = (unsigned)(((a_ < 3 ? h * 64 : (a_ - 3) * 64) + cg8) * 2); \
                const unsigned ho_ = (unsigned)(((a_ < 3 ? a_ * 512 + h * 64 : 1536 + (a_ - 3) * 64) + cg8) * 2); \
                raw[a_][0] = *(const u32x4*)(B_ + (rp_ * ld_ + co_)); raw[a_][1] = *(const u32x4*)(B_ + (rc_ * ld_ + co_)); \
                const unsigned char* np_ = hn_ ? HALO0 + ho_ : B_ + (rn_ * ld_ + co_); raw[a_][2] = *(const u32x4*)np_; } } } while (0)
    constexpr int SL_WB = 110848;
    for (int i = tid; i < 1024; i += NTHREADS) { const int m2 = i >> 9, n = (i >> 3) & 63, ch = i & 7;
        *(LAS u32x4*)(lds + SL_WB + m2 * 9216 + n * 144 + ch * 16) = *(const u32x4*)((const bf16*)(ws + WS_LORA + (m2 ? 131072 : 0)) + ((size_t)d * 512 + h * 64 + n) * 64 + ch * 8); }
    float bias[2][4];
#pragma unroll
    for (int mt_ = 0; mt_ < 2; ++mt_)
#pragma unroll
        for (int nt = 0; nt < 4; ++nt) bias[mt_][nt] = P->in[mt_ ? I_A0 : I_W0][d * 512 + h * 64 + nt * 16 + (lane & 15)];
    float S[4] = {0.f, 0.f, 0.f, 0.f};
#define SL_PREP(hc, buf) do { \
        const bool meta_ = SL_META(hc); const int i1_ = 32 * (hc) + slot; const int p1_ = d ? Ltot - 1 - i1_ : i1_; const bool ok1_ = i1_ < Ltot; \
        LAS float* fSb_ = fS + (buf) * 10240 + slot * 320; float rv[8], kv[8]; \
        if (!meta_) { float vv8[8]; unpack8(raw[0][1], rv); unpack8(raw[1][1], kv); unpack8(raw[2][1], vv8); \
            *(LAS f32x4*)(fSb_ + 256 + cg8) = (f32x4){rv[0], rv[1], rv[2], rv[3]}; *(LAS f32x4*)(fSb_ + 256 + cg8 + 4) = (f32x4){rv[4], rv[5], rv[6], rv[7]}; \
            if ((cg8 >> 4) == rp) { LAS float* dv_ = fV + (buf) * 512 + slot * 16 + (cg8 & 15); *(LAS f32x4*)dv_ = (f32x4){vv8[0], vv8[1], vv8[2], vv8[3]}; *(LAS f32x4*)(dv_ + 4) = (f32x4){vv8[4], vv8[5], vv8[6], vv8[7]}; } \
            *(LAS u32x4*)(lds + SL_TW + slot * 144 + cg8 * 2) = raw[3][1]; *(LAS u32x4*)(lds + SL_AD + slot * 144 + cg8 * 2) = raw[4][1]; \
        } else { const bool me1_ = ok1_ && p1_ < 16; const float fm_ = me1_ ? 1.0f : 0.0f; \
            _Pragma("unroll") for (int a = 0; a < 5; ++a) { \
                float pv_[8], cv_[8], nv_[8], o_[8]; unpack8(raw[a][0], pv_); unpack8(raw[a][1], cv_); unpack8(raw[a][2], nv_); \
                _Pragma("unroll") for (int e = 0; e < 8; ++e) { const float mp_ = fm_ * fMU[a * 64 + cg8 + e], mn_ = fm_ * fMU[320 + a * 64 + cg8 + e]; o_[e] = cv_[e] + mp_ * (pv_[e] - cv_[e]) + mn_ * (nv_[e] - cv_[e]); } \
                if (a == 0) { _Pragma("unroll") for (int e = 0; e < 8; ++e) rv[e] = o_[e]; \
                    *(LAS f32x4*)(fSb_ + 256 + cg8) = (f32x4){o_[0], o_[1], o_[2], o_[3]}; *(LAS f32x4*)(fSb_ + 256 + cg8 + 4) = (f32x4){o_[4], o_[5], o_[6], o_[7]}; } \
                else if (a == 1) { _Pragma("unroll") for (int e = 0; e < 8; ++e) kv[e] = o_[e]; } \
                else if (a == 2) { if ((cg8 >> 4) == rp) { LAS float* dv_ = fV + (buf) * 512 + slot * 16 + (cg8 & 15); *(LAS f32x4*)dv_ = (f32x4){o_[0], o_[1], o_[2], o_[3]}; *(LAS f32x4*)(dv_ + 4) = (f32x4){o_[4], o_[5], o_[6], o_[7]}; } } \
                else { if (a == 3) { _Pragma("unroll") for (int e = 0; e < 8; ++e) o_[e] = me1_ ? fast_tanh(o_[e]) : o_[e]; } \
                    u32x4 w_; w_.x = cvtpk(o_[0], o_[1]); w_.y = cvtpk(o_[2], o_[3]); w_.z = cvtpk(o_[4], o_[5]); w_.w = cvtpk(o_[6], o_[7]); \
                    *(LAS u32x4*)(lds + (a == 3 ? SL_TW : SL_AD) + slot * 144 + cg8 * 2) = w_; } } } \
        asm volatile("s_waitcnt lgkmcnt(0)" ::: "memory"); \
          \
        { f32x4 acc_[2][4]; \
          _Pragma("unroll") for (int m2 = 0; m2 < 2; ++m2) { const LAS unsigned char* Ab_ = lds + (m2 ? SL_AD : SL_TW) + (pw * 8 + (lane & 15)) * 144 + (lane >> 4) * 16; \
              const bf16x8 a0_ = *(const LAS bf16x8*)Ab_, a1_ = *(const LAS bf16x8*)(Ab_ + 64); \
              _Pragma("unroll") for (int nt = 0; nt < 4; ++nt) { f32x4 z_ = {0.f, 0.f, 0.f, 0.f}; const LAS unsigned char* Bb_ = lds + SL_WB + m2 * 9216 + (nt * 16 + (lane & 15)) * 144 + (lane >> 4) * 16; \
                  z_ = __builtin_amdgcn_mfma_f32_16x16x32_bf16(a0_, *(const LAS bf16x8*)Bb_, z_, 0, 0, 0); acc_[m2][nt] = __builtin_amdgcn_mfma_f32_16x16x32_bf16(a1_, *(const LAS bf16x8*)(Bb_ + 64), z_, 0, 0, 0); } } \
          if (lane < 32) { \
              _Pragma("unroll") for (int nt = 0; nt < 4; ++nt) _Pragma("unroll") for (int rg = 0; rg < 4; ++rg) { const int row_ = (lane >> 4) * 4 + rg, col_ = nt * 16 + (lane & 15); \
                  const float sw_ = fast_sigmoid(acc_[0][nt][rg] + bias[0][nt]); fS[(buf) * 10240 + (pw * 8 + row_) * 320 + 64 + col_] = __builtin_amdgcn_exp2f(-0.6065306597126334f * LOG2E * sw_); \
                  fAS[pw * 512 + row_ * 64 + col_] = fast_sigmoid(acc_[1][nt][rg] + bias[1][nt]); } } } \
        asm volatile("s_waitcnt lgkmcnt(0)" ::: "memory"); \
          \
        { const f32x4 a0 = *(const LAS f32x4*)(fAS + pw * 512 + sl8 * 64 + cg8), a1 = *(const LAS f32x4*)(fAS + pw * 512 + sl8 * 64 + cg8 + 4); \
          const f32x4 kk0 = *(const LAS f32x4*)(fMU + 640 + cg8), kk1 = *(const LAS f32x4*)(fMU + 640 + cg8 + 4), ka0 = *(const LAS f32x4*)(fMU + 704 + cg8), ka1 = *(const LAS f32x4*)(fMU + 704 + cg8 + 4); \
          const f32x4 rk0 = *(const LAS f32x4*)(fMU + 768 + cg8), rk1 = *(const LAS f32x4*)(fMU + 768 + cg8 + 4); \
          float kkv[8], kd[8], av[8]; float ssq = 0.f, cs = 0.f; \
          _Pragma("unroll") for (int e = 0; e < 8; ++e) { av[e] = e < 4 ? a0[e & 3] : a1[e & 3]; \
              kkv[e] = kv[e] * (e < 4 ? kk0[e & 3] : kk1[e & 3]); ssq = fmaf(kkv[e], kkv[e], ssq); \
              kd[e] = kv[e] * (1.0f + (av[e] - 1.0f) * (e < 4 ? ka0[e & 3] : ka1[e & 3])); cs = fmaf(rv[e] * kd[e], e < 4 ? rk0[e & 3] : rk1[e & 3], cs); } \
          ssq = grp_sum<8>(ssq); cs = grp_sum<8>(cs); \
          const float rs = rsqrtf(fmaxf(ssq, 1e-24f)); \
          _Pragma("unroll") for (int e = 0; e < 8; ++e) { kkv[e] *= rs; av[e] *= kkv[e]; } \
          *(LAS f32x4*)(fSb_ + cg8) = (f32x4){kkv[0], kkv[1], kkv[2], kkv[3]}; *(LAS f32x4*)(fSb_ + cg8 + 4) = (f32x4){kkv[4], kkv[5], kkv[6], kkv[7]}; \
          *(LAS f32x4*)(fSb_ + 128 + cg8) = (f32x4){av[0], av[1], av[2], av[3]}; *(LAS f32x4*)(fSb_ + 128 + cg8 + 4) = (f32x4){av[4], av[5], av[6], av[7]}; \
          *(LAS f32x4*)(fSb_ + 192 + cg8) = (f32x4){kd[0], kd[1], kd[2], kd[3]}; *(LAS f32x4*)(fSb_ + 192 + cg8 + 4) = (f32x4){kd[4], kd[5], kd[6], kd[7]}; \
          if (cg8 == 0 && rp == 0 && ok1_) CB[((size_t)d * ROWS + pos_row(base, p1_)) * 8 + h] = cs; } } while (0)
#define SL_STORE_Y(hc, buf) do { const int sl5_ = lane >> 1, hf_ = lane & 1; const int i5_ = 32 * (hc) + sl5_; const int p5_ = d ? Ltot - 1 - i5_ : i5_; \
        if (i5_ < Ltot && p5_ >= 16) { const LAS float* yp_ = fY + (buf) * 512 + sl5_ * 16 + hf_ * 8; const f32x4 y0_ = *(const LAS f32x4*)yp_, y1_ = *(const LAS f32x4*)(yp_ + 4); \
            *(u32x4*)(YD + (size_t)(base + p5_ - 16) * 512 + h * 64 + rp * 16 + hf_ * 8) = pack8(y0_, y1_); } } while (0)
    BAR_LDS();
    if (!scanner) { SL_LOAD(0); SL_PREP(0, 0); if (nhalf > 1) SL_LOAD(1); }
    BAR_LDS();
#pragma unroll 1
    for (int hc = 0; hc < nhalf; ++hc) {
        if (scanner) {
            typedef float f32x2_ __attribute__((ext_vector_type(2)));
            const int nvalid = (Ltot - 32 * hc) < 32 ? (Ltot - 32 * hc) : 32, buf = hc & 1;
            const LAS float* ps = fS + buf * 10240 + kg * 4; const LAS float* pv = fV + buf * 512 + srl; LAS float* py = fY + buf * 512 + srl;
            f32x4 nk, nw, nb, nd, nr; float nv;
#define SL_FETCH(sl_) do { nk = *(const LAS f32x4*)(ps + (sl_) * 320); nw = *(const LAS f32x4*)(ps + (sl_) * 320 + 64); nb = *(const LAS f32x4*)(ps + (sl_) * 320 + 128); \
                nd = *(const LAS f32x4*)(ps + (sl_) * 320 + 192); nr = *(const LAS f32x4*)(ps + (sl_) * 320 + 256); nv = pv[(sl_) * 16]; } while (0)
            SL_FETCH(0);
            f32x4 rp4 = {0.f, 0.f, 0.f, 0.f};
#pragma unroll 16
            for (int sl = 0; sl < nvalid; ++sl) {
                const f32x4 ck = nk, cw = nw, cb = nb, cd = nd, cr = nr; const float vv = nv;
                SL_FETCH(sl + 1 < 32 ? sl + 1 : 31);
                f32x2_ pa = {0.f, 0.f}, ya = {0.f, 0.f};
#pragma unroll
                for (int e = 0; e < 4; e += 2) { const f32x2_ s2 = {S[e], S[e + 1]}, k2 = {ck[e], ck[e + 1]}, r2 = {rp4[e], rp4[e + 1]}; pa = pa + s2 * k2; ya = ya + s2 * r2; }
                float pp = pa.x + pa.y, yy = ya.x + ya.y;
                pp = dpp_add(pp, 0); yy = dpp_add(yy, 0); pp = dpp_add(pp, 1); yy = dpp_add(yy, 1); pp = dpp_add(pp, 2); yy = dpp_add(yy, 2); pp = dpp_add(pp, 3); yy = dpp_add(yy, 3);
                py[(sl > 0 ? sl - 1 : 0) * 16] = yy;
#pragma unroll
                for (int e = 0; e < 4; e += 2) { const f32x2_ b2 = {cb[e], cb[e + 1]}, d2 = {cd[e], cd[e + 1]}, w2 = {cw[e], cw[e + 1]}; f32x2_ s2 = {S[e], S[e + 1]};
                    const f32x2_ t2 = d2 * vv - b2 * pp; s2 = s2 * w2 + t2; S[e] = s2.x; S[e + 1] = s2.y; }
                rp4 = cr;
            }
            { f32x2_ ya = {0.f, 0.f};
#pragma unroll
              for (int e = 0; e < 4; e += 2) { const f32x2_ s2 = {S[e], S[e + 1]}, r2 = {rp4[e], rp4[e + 1]}; ya = ya + s2 * r2; }
              const float yy = grp_sum<16>(ya.x + ya.y); py[(nvalid - 1) * 16] = yy; }
#undef SL_FETCH
        } else {
            if (hc > 0 && pw == 0) SL_STORE_Y(hc - 1, (hc - 1) & 1);
            if (hc + 1 < nhalf) { SL_PREP(hc + 1, (hc + 1) & 1); if (hc + 2 < nhalf) SL_LOAD(hc + 2); }
        }
        BAR_LDS();
    }
    if (!scanner && pw == 0) SL_STORE_Y(nhalf - 1, (nhalf - 1) & 1);
#undef SL_STORE_Y
#undef SL_PREP
#undef SL_LOAD
#undef SL_META
}

__device__ __forceinline__ void rwkv_colmap(unsigned char* ws, int c0, bf16*& buf, int& ld, int& col) {
    if (c0 < 512) { buf = (bf16*)(ws + WS_R); ld = 512; col = c0; }
    else if (c0 < 1024) { buf = (bf16*)(ws + WS_KA); ld = 512; col = c0 - 512; }
    else if (c0 < 1536) { buf = (bf16*)(ws + WS_VA); ld = 512; col = c0 - 1024; }
    else { buf = (bf16*)(ws + WS_L); ld = 256; col = c0 - 1536; }
}
__device__ __forceinline__ void phase_halo(KP P) {
    const int tid = fresh_tid(), lane = tid & 63, wid = tid >> 6; const int gw = blockIdx.x * 8 + wid, NGW = gridDim.x * 8;
    unsigned char* ws = P->ws;
    for (int r = gw; r < (NMAIN / 64) * 2; r += NGW) {
        const int m = (r >> 1) * 64 + ((r & 1) ? 63 : 0);
        for (int j = lane; j < 224; j += 64) { bf16* buf; int ld, col; rwkv_colmap(ws, j * 8, buf, ld, col);
            *(u32x4*)(ws + WS_HALO + (size_t)r * HALO_ROW + j * 16) = *(const u32x4*)(buf + (size_t)m * ld + col); }
    }
}
__device__ __forceinline__ void phase_shift(LAS unsigned char* lds, KP P) {
    const int tid = fresh_tid(), slot = tid >> 3, cg = tid & 7;
    unsigned char* ws = P->ws; const float* mup = P->in[I_MUP]; const float* mun = P->in[I_MUN];
    for (int tile = blockIdx.x; tile < NMAIN / 64; tile += gridDim.x) {
        const int m0 = tile * 64, m = m0 + slot;
        const int ks = m0 < 16384 ? tile : ((m0 - 16384) & 2047) >> 6; const bool first = ks == 0, last = ks == (m0 < 16384 ? 255 : 31);
#pragma unroll 1
        for (int pass = 0; pass < 4; ++pass) {
#pragma unroll
            for (int i = 0; i < 7; ++i) { const int j = cg + 8 * i; bf16* buf; int ld, col; rwkv_colmap(ws, (pass * 56 + j) * 8, buf, ld, col);
                *(LAS u32x4*)(lds + (slot * 56 + j) * 16) = *(const u32x4*)(buf + (size_t)m * ld + col); }
            __syncthreads();
#pragma unroll
            for (int i = 0; i < 7; ++i) {
                const int j = cg + 8 * i, c0 = (pass * 56 + j) * 8; bf16* buf; int ld, col; rwkv_colmap(ws, c0, buf, ld, col);
                const u32x4 z = {0u, 0u, 0u, 0u};
                const u32x4 cu = *(const LAS u32x4*)(lds + (slot * 56 + j) * 16);
                u32x4 pu, nu;
                if (slot > 0) pu = *(const LAS u32x4*)(lds + ((slot - 1) * 56 + j) * 16);
                else pu = first ? *(const u32x4*)(buf + (size_t)(METAROW + 15) * ld + col) : *(const u32x4*)(ws + WS_HALO + (size_t)((tile - 1) * 2 + 1) * HALO_ROW + c0 * 2);
                if (slot < 63) nu = *(const LAS u32x4*)(lds + ((slot + 1) * 56 + j) * 16);
                else nu = last ? z : *(const u32x4*)(ws + WS_HALO + (size_t)((tile + 1) * 2) * HALO_ROW + c0 * 2);
                float pv[8], cv[8], nv[8], o[8]; unpack8(pu, pv); unpack8(cu, cv); unpack8(nu, nv);
                const f32x4 mp0 = *(const f32x4*)(mup + c0), mp1 = *(const f32x4*)(mup + c0 + 4), mn0 = *(const f32x4*)(mun + c0), mn1 = *(const f32x4*)(mun + c0 + 4);
#pragma unroll
                for (int e = 0; e < 8; ++e) { const float mp = e < 4 ? mp0[e & 3] : mp1[e & 3], mn = e < 4 ? mn0[e & 3] : mn1[e & 3]; o[e] = cv[e] + mp * (pv[e] - cv[e]) + mn * (nv[e] - cv[e]); }
                if (c0 >= 1536 && c0 < 1600) {
#pragma unroll
                    for (int e = 0; e < 8; ++e) o[e] = fast_tanh(o[e]);
                }
                u32x4 w; w.x = cvtpk(o[0], o[1]); w.y = cvtpk(o[2], o[3]); w.z = cvtpk(o[4], o[5]); w.w = cvtpk(o[6], o[7]);
                *(u32x4*)(buf + (size_t)m * ld + col) = w;
            }
            __syncthreads();
        }
    }
}

__device__ __forceinline__ void phase_post(LAS unsigned char* lds, KP P) {
    const int tid = fresh_tid(), lane = tid & 63, wid = tid >> 6;
    unsigned char* ws = P->ws;
    const bf16* VAb = (const bf16*)(ws + WS_VA); const bf16* Lb = (const bf16*)(ws + WS_L); bf16* Rb = (bf16*)(ws + WS_R);
    const float* CB = (const float*)(ws + WS_CB); const bf16* YD0 = (const bf16*)((const unsigned char*)P->out + 64 * MiB); const bf16* YD1 = YD0 + (size_t)NMAIN * 512;
    const bf16* GT = (const bf16*)(ws + WS_LORA + 262144);
    LAS float* st = (LAS float*)(lds + 17408);
    const float* mup = P->in[I_MUP]; const float* mun = P->in[I_MUN];
    for (int tile = blockIdx.x; tile < NMAIN / 64; tile += gridDim.x) {
        {
            const int row = tid >> 3, hh = tid & 7, m = tile * 64 + row;
            const int t = m < 16384 ? m : (m - 16384) & 2047, Ls = m < 16384 ? 16384 : 2048;
            float sum = 0.f, sq = 0.f;
#pragma unroll
            for (int i = 0; i < 8; ++i) { float a[8], b[8]; unpack8(*(const u32x4*)(YD0 + (size_t)m * 512 + hh * 64 + i * 8), a); unpack8(*(const u32x4*)(YD1 + (size_t)m * 512 + hh * 64 + i * 8), b);
#pragma unroll
                for (int e = 0; e < 8; ++e) { const float y = a[e] + b[e]; sum += y; sq += y * y; } }
            const float mu = sum * (1.0f / 64.0f); const float var = fmaxf(sq * (1.0f / 64.0f) - mu * mu, 0.f);
            st[(row * 8 + hh) * 2] = mu; st[(row * 8 + hh) * 2 + 1] = rsqrtf(var + 64e-5f);
#pragma unroll
            for (int i = 0; i < 2; ++i) {
                const int c0 = 128 + hh * 16 + i * 8; float cv[8], o[8];
                unpack8(*(const u32x4*)(Lb + (size_t)m * 256 + c0), cv);
#pragma unroll
                for (int e = 0; e < 8; ++e) o[e] = sigmoidf_(cv[e]);
                u32x4 w; w.x = cvtpk(o[0], o[1]); w.y = cvtpk(o[2], o[3]); w.z = cvtpk(o[4], o[5]); w.w = cvtpk(o[6], o[7]);
                *(LAS u32x4*)(lds + row * 272 + (hh * 16 + i * 8) * 2) = w;
            }
        }
        __syncthreads();
#pragma unroll 1
        for (int nt = 0; nt < 4; ++nt) {
            const int col = wid * 64 + nt * 16 + (lane & 15);
            bf16x8 bfr[4];
#pragma unroll
            for (int ks = 0; ks < 4; ++ks) bfr[ks] = *(const bf16x8*)(GT + (size_t)col * 128 + ks * 32 + (lane >> 4) * 8);
            const float lw = P->in[I_LNW][col], lb = P->in[I_LNB][col];
            const float mpv = mup[1024 + col], mnv = mun[1024 + col];
#pragma unroll 1
            for (int mt = 0; mt < 4; ++mt) {
                f32x4 acc = {0.f, 0.f, 0.f, 0.f};
#pragma unroll
                for (int ks = 0; ks < 4; ++ks) { const bf16x8 a = *(const LAS bf16x8*)(lds + (mt * 16 + (lane & 15)) * 272 + ks * 64 + (lane >> 4) * 16); acc = __builtin_amdgcn_mfma_f32_16x16x32_bf16(a, bfr[ks], acc, 0, 0, 0); }
#pragma unroll
                for (int rg = 0; rg < 4; ++rg) {
                    const int row = mt * 16 + (lane >> 4) * 4 + rg, m = tile * 64 + row;
                    const int t = m < 16384 ? m : (m - 16384) & 2047, Ls = m < 16384 ? 16384 : 2048;
                    const float y = bf2f(YD0[(size_t)m * 512 + col]) + bf2f(YD1[(size_t)m * 512 + col]);
                    const float yn = (y - st[(row * 8 + wid) * 2]) * st[(row * 8 + wid) * 2 + 1] * lw + lb;
                    const float vs = bf2f(VAb[(size_t)m * 512 + col]);
                    const float cb = CB[(size_t)m * 8 + wid] + CB[((size_t)ROWS + m) * 8 + wid];
                    Rb[(size_t)m * 512 + col] = (bf16)f2bf_rne((yn + cb * vs) * acc[rg]);
                }
            }
        }
        __syncthreads();
    }
}

__device__ __forceinline__ void phase_rms_bf16(KP P) {
    const int tid = fresh_tid(), lane = tid & 63, wid = tid >> 6; const int gw = blockIdx.x * 8 + wid, NGW = gridDim.x * 8;
    bf16* MN = (bf16*)(P->ws + WS_MN);
    for (int m = gw; m < NMAIN; m += NGW) rms_row_bf16(P->out + (size_t)m * DM, P->in[I_GFFN], MN + (size_t)m * DM, lane);
}
__device__ __forceinline__ void phase_final(KP P) {
    const int tid = fresh_tid(), lane = tid & 63, wid = tid >> 6; const int gw = blockIdx.x * 8 + wid, NGW = gridDim.x * 8;
    const f32x4* gr = (const f32x4*)P->in[I_GFIN] + lane;
    for (int m = gw; m < NMAIN; m += NGW) {
        f32x4* xr = (f32x4*)(P->out + (size_t)m * DM) + lane; f32x4 v[4]; float s = 0.f;
#pragma unroll
        for (int j = 0; j < 4; ++j) { v[j] = xr[64 * j]; s += (v[j].x * v[j].x + v[j].y * v[j].y) + (v[j].z * v[j].z + v[j].w * v[j].w); }
        const float rstd = rsqrtf(wave_sum(s) * (1.f / DM) + 1e-6f);
#pragma unroll
        for (int j = 0; j < 4; ++j) xr[64 * j] = v[j] * rstd * gr[64 * j];
    }
}

constexpr int NRP_LONG = 4;
constexpr int N_LONG = 16 * NRP_LONG, N_ATT_P = 512, N_ATT_S = 512, N_SHORT = 128, N_ITEMS = N_LONG + N_ATT_P + N_ATT_S + N_SHORT;

template <class Op> __device__ __forceinline__ void run_gemm(LAS unsigned char* lds, const bf16* A, const bf16* Bt, int M, int N, int K, const Op& op, const bf16* A2 = nullptr, int pm2 = 1 << 30) {
    pg8::Gemm g{A, Bt, M, N, K, A2, pm2}; pg8::StaticOrder S; S.init(M, N, (int)gridDim.x, (int)blockIdx.x);
    Epi8<Op> E{op};
    pg8::gemm_phase<Epi8<Op>, pg8::StaticOrder, true, true>(lds, g, S, E);
}

constexpr size_t WS_XBAR = 16384;
#define XB_TMO      128
#define XB_XCNT(j)  (256  + 64 * (j))
#define XB_XSUB(j)  (1280 + 64 * (j))
#define XB_XGEN(j)  (2304 + 64 * (j))
#define XB_TOP      3328
#define XB_TOPGEN   3392
#define XCD_BAR_WORDS 3456
#define XB_SPIN_CAP (1u << 18)
__device__ __forceinline__ unsigned xb_ld(unsigned* p)              { return __hip_atomic_load(p, __ATOMIC_RELAXED, __HIP_MEMORY_SCOPE_AGENT); }
__device__ __forceinline__ unsigned xb_add(unsigned* p, unsigned v) { return __hip_atomic_fetch_add(p, v, __ATOMIC_RELAXED, __HIP_MEMORY_SCOPE_AGENT); }
__device__ __forceinline__ unsigned xb_xcc_id() { return (unsigned)__builtin_amdgcn_s_getreg((3 << 11) | 20) & 0xFu; }
#define XB_SPIN(cond, bar) do { unsigned _sp = 0; while (cond) { __builtin_amdgcn_s_sleep(1); \
    if ((++_sp & 255u) == 0u) { if (xb_ld(&(bar)[XB_TMO])) break; if (_sp > XB_SPIN_CAP) { atomicAdd(&(bar)[XB_TMO], 1u); break; } } } } while (0)
struct XcdBarrier { unsigned* bar; unsigned x; volatile LAS unsigned* st; };
__device__ __forceinline__ XcdBarrier xcd_barrier_post(unsigned* bar, volatile LAS unsigned* st) {
    XcdBarrier b; b.bar = bar; b.x = xb_xcc_id(); b.st = st;
    if (threadIdx.x == 0) (void)xb_add(&bar[XB_XCNT(b.x)], 1u);
    return b;
}
__device__ __forceinline__ void xcd_barrier_complete(unsigned* bar, unsigned x, unsigned& nloc, unsigned& nx) {
    const unsigned G = gridDim.x * gridDim.y * gridDim.z;
    unsigned sum, cnt, mine, sp = 0u;
    for (;;) {
        sum = 0u; cnt = 0u; mine = 0u;
#pragma unroll
        for (unsigned j = 0; j < 16; ++j) { const unsigned c = xb_ld(&bar[XB_XCNT(j)]); sum += c; cnt += (c > 0u) ? 1u : 0u; mine = (j == x) ? c : mine; }
        if (sum == G) break;
        __builtin_amdgcn_s_sleep(1);
        if ((++sp & 255u) == 0u) { if (xb_ld(&bar[XB_TMO])) break; if (sp > XB_SPIN_CAP) { atomicAdd(&bar[XB_TMO], 1u); break; } }
    }
    nloc = mine > 0u ? mine : 1u; nx = cnt > 0u ? cnt : 1u;
}
__device__ __forceinline__ void xcd_barrier(const XcdBarrier& b) {
    asm volatile("s_waitcnt vmcnt(0)" ::: "memory");
    __syncthreads();
    if (threadIdx.x == 0) {
        unsigned* bar = b.bar;
        __builtin_amdgcn_s_waitcnt(0);
        unsigned nloc = b.st[0], nx = b.st[1];
        if (nloc == 0u) { xcd_barrier_complete(bar, b.x, nloc, nx); b.st[0] = nloc; b.st[1] = nx; }
        const unsigned old = xb_add(&bar[XB_XSUB(b.x)], 1u);
        const unsigned gen = old / nloc;
        if (old + 1u == (gen + 1u) * nloc) {
            __builtin_amdgcn_fence(__ATOMIC_RELEASE, "agent");
            asm volatile("s_waitcnt vmcnt(0)" ::: "memory");
            const unsigned og = xb_add(&bar[XB_TOP], 1u);
            const unsigned tg = og / nx;
            if (og + 1u == (tg + 1u) * nx) xb_add(&bar[XB_TOPGEN], 1u);
            else XB_SPIN(xb_ld(&bar[XB_TOPGEN]) == tg, bar);
            __builtin_amdgcn_fence(__ATOMIC_ACQUIRE, "agent");
            xb_add(&bar[XB_XGEN(b.x)], 1u);
            asm volatile("s_waitcnt vmcnt(0)" ::: "memory");
        } else {
            XB_SPIN(xb_ld(&bar[XB_XGEN(b.x)]) == gen, bar);
            __builtin_amdgcn_fence(__ATOMIC_ACQUIRE, "agent");
            asm volatile("s_waitcnt vmcnt(0)" ::: "memory");
        }
    }
    __syncthreads();
}
#ifndef PROBE_MASK
#define PROBE_MASK 0
#endif
#ifndef PROBE_MUL
#define PROBE_MUL 1
#endif
#define PH_BEGIN(k) unsigned long long t0_##k = 0; if (PROBE_MASK & (1 << (k))) t0_##k = __builtin_amdgcn_s_memrealtime();
#define PH_END(k) if (PROBE_MASK & (1 << (k))) { const unsigned long long t1_ = __builtin_amdgcn_s_memrealtime(); const unsigned long long dt_ = (t1_ - t0_##k) * PROBE_MUL; while (__builtin_amdgcn_s_memrealtime() - t1_ < dt_) __builtin_amdgcn_s_sleep(8); xcd_barrier(xbar); }
__global__ void __launch_bounds__(NTHREADS) fwd_megakernel(Params Pin) {
    extern __shared__ __attribute__((aligned(16))) unsigned char lds_raw[];
    LAS unsigned char* lds = (LAS unsigned char*)lds_raw;
    cg::grid_group grid = cg::this_grid();
    KP P0 = (KP)__builtin_amdgcn_kernarg_segment_ptr();
    volatile LAS unsigned* xst = (volatile LAS unsigned*)(lds + LDS_ITEM_OFF + 4);
    if (threadIdx.x == 0) { xst[0] = 0u; xst[1] = 0u; }
    __syncthreads();
    const XcdBarrier xbar = xcd_barrier_post((unsigned*)(P0->ws + WS_XBAR), xst);
#define NEWPHASE KP P = P0; asm volatile("" : "+s"(P)); unsigned char* ws = P->ws; (void)ws;

    PH_BEGIN(0)
    { NEWPHASE phase_prologue(lds, P); }
    grid.sync();
    PH_END(0)
    PH_BEGIN(1)
    { NEWPHASE run_gemm(lds, (const bf16*)P->out, (const bf16*)(ws + WS_WIN), ROWS, 3328, 1024, OpProj{ws}, (const bf16*)(ws + WS_XNMETA), 128); }
    xcd_barrier(xbar);
    PH_END(1)
    { NEWPHASE phase_halo(P); }
    xcd_barrier(xbar);
    { NEWPHASE phase_shift(lds, P); }
    xcd_barrier(xbar);
    PH_BEGIN(2)
    { NEWPHASE
        const int tid = fresh_tid();
        float lam;
        { const int lane = tid & 63; const float s1 = wave_sum(P->in[I_LQ1][lane] * P->in[I_LK1][lane]), s2 = wave_sum(P->in[I_LQ2][lane] * P->in[I_LK2][lane]); lam = __expf(s1) - __expf(s2) + 0.2f; }
        unsigned* ctr = (unsigned*)(ws + WS_CTL);
        LAS unsigned* slot = (LAS unsigned*)(lds + LDS_ITEM_OFF);
#define FETCH(k, n) if (tid == 0) *slot = atomicAdd(ctr + 64 * (k), 1u); __syncthreads(); const int idx = (int)*slot; __syncthreads(); if (idx >= (n)) break;
#ifndef NO_SCAN
#pragma unroll 1
        for (;;) { FETCH(0, N_LONG) const int u = idx / NRP_LONG; scan_long(lds, P, 0, u >> 3, u & 7, idx % NRP_LONG); }
#endif
#ifndef NO_ATTN
#pragma unroll 1
        for (;;) { FETCH(1, N_ATT_P + N_ATT_S)
            if (idx < N_ATT_P) attn_unit(lds, P, 0, idx >> 7, idx & 127, lam);
            else { const int a = idx - N_ATT_P; attn_unit(lds, P, 1 + (a >> 6), (a >> 4) & 3, a & 15, lam); } }
#endif
#ifndef NO_SCAN
#pragma unroll 1
        for (;;) { FETCH(2, N_SHORT) scan_unit<1, 8>(lds, P, 1 + (idx >> 4), (idx >> 3) & 1, idx & 7, 0); }
#endif
#undef FETCH
    }
    xcd_barrier(xbar);
    PH_END(2)
#ifndef NO_POST
    PH_BEGIN(3)
    { NEWPHASE phase_post(lds, P); }
#endif
    xcd_barrier(xbar);
    PH_END(3)
    PH_BEGIN(4)
    { NEWPHASE run_gemm(lds, (const bf16*)P->out, (const bf16*)(ws + WS_WIN) + (size_t)3328 * 1024, NMAIN, 1024, 1024, OpGate{(bf16*)(ws + WS_GA)}); }
    { NEWPHASE run_gemm(lds, (const bf16*)P->out, (const bf16*)(ws + WS_WIN) + (size_t)4352 * 1024, NMAIN, 1024, 1024, OpGate{(bf16*)(ws + WS_GB)}); }

    PH_END(4)
    PH_BEGIN(5)
    { NEWPHASE run_gemm(lds, (const bf16*)(ws + WS_R), (const bf16*)(ws + WS_WUPA), NMAIN, 1024, 512, OpUpA{ws}); }
    PH_END(5)
    PH_BEGIN(6)
    { NEWPHASE run_gemm(lds, (const bf16*)(ws + WS_Q), (const bf16*)(ws + WS_WUPB), NMAIN, 1024, 512, OpUpB{ws}); }
    xcd_barrier(xbar);
    PH_END(6)
    PH_BEGIN(7)
    { NEWPHASE run_gemm(lds, (const bf16*)(ws + WS_GB), (const bf16*)(ws + WS_WOUT), NMAIN, 1024, 1024, OpOut{P->in[I_XP], P->in[I_XS], P->out}); }
    xcd_barrier(xbar);
    PH_END(7)
    PH_BEGIN(8)
    { NEWPHASE phase_rms_bf16(P); }
    xcd_barrier(xbar);
    PH_END(8)
    PH_BEGIN(9)
    { NEWPHASE run_gemm(lds, (const bf16*)(ws + WS_MN), (const bf16*)(ws + WS_WFF1), 16384, DFF, 1024, OpFF1{(bf16*)(ws + WS_HID)}); }
    xcd_barrier(xbar);
    PH_END(9)
    PH_BEGIN(10)
    { NEWPHASE run_gemm(lds, (const bf16*)(ws + WS_HID), (const bf16*)(ws + WS_WFF2), 16384, 1024, DFF, OpFF2{P->out}); }
    xcd_barrier(xbar);
    PH_END(10)
    PH_BEGIN(11)
    { NEWPHASE run_gemm(lds, (const bf16*)(ws + WS_MN) + (size_t)16384 * DM, (const bf16*)(ws + WS_WFF1), 16384, DFF, 1024, OpFF1{(bf16*)(ws + WS_HID)}); }
    xcd_barrier(xbar);
    PH_END(11)
    PH_BEGIN(12)
    { NEWPHASE run_gemm(lds, (const bf16*)(ws + WS_HID), (const bf16*)(ws + WS_WFF2), 16384, 1024, DFF, OpFF2{P->out + (size_t)16384 * DM}); }
    xcd_barrier(xbar);
    PH_END(12)
    PH_BEGIN(13)
    { NEWPHASE phase_final(P); }
}

extern "C" void kernel_launch(void* const* d_in, const int* in_sizes, int n_in, void* d_out, int out_size, void* d_ws, size_t ws_size, hipStream_t stream) {
    static int grid_blocks = 0;
    if (grid_blocks == 0) {
        int dev = 0, cus = 0, per_cu = 0;
        hipGetDevice(&dev);
        hipDeviceGetAttribute(&cus, hipDeviceAttributeMultiprocessorCount, dev);
        hipFuncSetAttribute((const void*)fwd_megakernel, hipFuncAttributeMaxDynamicSharedMemorySize, LDS_BYTES);
        hipOccupancyMaxActiveBlocksPerMultiprocessor(&per_cu, (const void*)fwd_megakernel, NTHREADS, LDS_BYTES);
        if (per_cu < 1) { fprintf(stderr, "kernel_launch: occupancy query says %d blocks per CU\n", per_cu); per_cu = 1; }
        grid_blocks = cus * per_cu;
        if (n_in != 29 || ws_size < WS_END) fprintf(stderr, "kernel_launch: unexpected n_in %d / ws_size %zu\n", n_in, ws_size);
    }
    hipMemsetAsync((unsigned char*)d_ws + WS_CTL, 0, 32768, stream);
    Params p{};
    for (int i = 0; i < 29; ++i) p.in[i] = (const float*)d_in[i];
    p.out = (float*)d_out; p.ws = (unsigned char*)d_ws;
    void* args[] = {&p};
    hipError_t e = hipLaunchCooperativeKernel((const void*)fwd_megakernel, dim3(grid_blocks), dim3(NTHREADS), args, LDS_BYTES, stream);
    if (e != hipSuccess) fprintf(stderr, "cooperative launch failed: %s (grid %d)\n", hipGetErrorString(e), grid_blocks);
}
```

```cpp
#include <hip/hip_runtime.h>
#include <hip/hip_cooperative_groups.h>
#include <cstdio>
#include <cstdint>
#include <cmath>
namespace cg = cooperative_groups;
__device__ __forceinline__ int fresh_tid() { int t = threadIdx.x; asm volatile("" : "+v"(t)); return t; }
namespace pg8 {
#define PG8_LAS __attribute__((address_space(3)))
typedef unsigned short bf16_t;
typedef short bf16x8 __attribute__((ext_vector_type(8)));
typedef float f32x4 __attribute__((ext_vector_type(4)));
typedef unsigned u32x4 __attribute__((ext_vector_type(4)));
constexpr int BM = 256, BK = 64, HALF = 128, HTB = HALF * BK * 2  , STAGE_BYTES = 8 * HTB, NXCD = 8, WGM = 8;

__host__ __device__ __forceinline__ int lds_byte(int r, int c) { const int st = (r >> 4) * 2 + (c >> 5), rr = r & 15, cc = c & 31, ob = rr * 64 + cc * 2; return st * 1024 + (ob ^ (((ob >> 9) & 1) << 5)); }
__host__ __device__ __forceinline__ void stage_rc(int b, int& R, int& C) { const int st = b / 1024, sb = b % 1024, swz = sb ^ (((sb >> 9) & 1) << 5); R = (st >> 1) * 16 + swz / 64; C = (st & 1) * 32 + (swz % 64) / 2; }
__host__ __device__ __forceinline__ int perm32(int rho) { const int n = rho >> 4, i = rho & 15; return 8 * (i >> 2) + 4 * n + (i & 3); }

struct Unit { int pm, pn; };
struct Gemm { const bf16_t* A; const bf16_t* Bt; int M, N, K; const bf16_t* A2; int pm2; };
__device__ __forceinline__ const char* gemm_abase(const Gemm& g, int pm, size_t tstep) { return pm >= g.pm2 ? (const char*)g.A2 + (size_t)(pm - g.pm2) * tstep : (const char*)g.A + (size_t)pm * tstep; }

struct StaticOrder {
    int nM, nN, nwg, G, c;
    __host__ __device__ void init(int M, int N, int G_, int c_) { nM = M / BM; nN = N / BM; nwg = nM * nN; G = G_; c = c_; }
    __host__ __device__ bool next(int i, Unit& u) const {
        const long L = (long)i * G + c; if (L >= nwg) return false;
        int wgid = (int)L; { const int q = nwg / NXCD, r = nwg % NXCD, xcd = wgid % NXCD, off = wgid / NXCD; wgid = (xcd < r ? xcd * (q + 1) : r * (q + 1) + (xcd - r) * q) + off; }
        const int nig = WGM * nN, gid = wgid / nig, fm = gid * WGM, gsz = (nM - fm) < WGM ? (nM - fm) : WGM;
        u.pm = fm + ((wgid % nig) % gsz); u.pn = (wgid % nig) / gsz; return true;
    }
    __device__ __forceinline__ void a_ready(const Unit&) const {}
    __device__ __forceinline__ void done(const Unit&) const {}
};


template <class Epi, class Sched, bool ALIGN_EPI = false, bool SP2 = false>
__device__ __forceinline__ void gemm_phase(PG8_LAS unsigned char* lds, const Gemm g, const Sched& S, const Epi& E) {
    const int tid = fresh_tid(), wid = __builtin_amdgcn_readfirstlane(tid >> 6), lane = tid & 63, wr = wid >> 2, wc = wid & 3, fr = lane & 15, fq = lane >> 4;
    const int K = g.K, nt = K / BK;
    unsigned voffA[2], voffB[2];
#pragma unroll
    for (int i = 0; i < 2; ++i) { int R, C; stage_rc(tid * 16 + i * 8192, R, C); const int Rb = Epi::PERM ? ((R & ~31) + perm32(R & 31)) : R;
        voffA[i] = (unsigned)(R * K + C) * 2u; voffB[i] = (unsigned)(Rb * K + C) * 2u; }
    const size_t kstep = (size_t)(BK * 2);
    const size_t hstep = (size_t)HALF * K * 2;
    const size_t tstep = 2 * hstep;
    const unsigned ldsw = (unsigned)wid * 1024u;
    const int aoff = lds_byte(wr * 64 + fr, fq * 8), boff = lds_byte(wc * 32 + fr, fq * 8);
#define PG8_SA(b, h) (((b) * 2 + (h)) * HTB)
#define PG8_SB(b, h) ((4 + (b) * 2 + (h)) * HTB)
#define PG8_STAGE(bufoff, gbase, voff) do { _Pragma("unroll") for (int _i = 0; _i < 2; ++_i) \
        __builtin_amdgcn_global_load_lds((const unsigned*)((const char*)(gbase) + (voff)[_i]), (PG8_LAS unsigned*)(lds + (bufoff) + ldsw + _i * 8192), 16, 0, 0); } while (0)
#define PG8_LDA(dst, b, h) do { _Pragma("unroll") for (int m = 0; m < 4; ++m) _Pragma("unroll") for (int k = 0; k < 2; ++k) dst[m][k] = *(const PG8_LAS bf16x8*)(lds + PG8_SA(b, h) + aoff + m * 2048 + k * 1024); } while (0)
#define PG8_LDB(dst, b, h) do { _Pragma("unroll") for (int n = 0; n < 2; ++n) _Pragma("unroll") for (int k = 0; k < 2; ++k) dst[n][k] = *(const PG8_LAS bf16x8*)(lds + PG8_SB(b, h) + boff + n * 2048 + k * 1024); } while (0)
#define PG8_MMA(ai, bj, At, Bt) do { __builtin_amdgcn_s_setprio(1); _Pragma("unroll") for (int m = 0; m < 4; ++m) _Pragma("unroll") for (int n = 0; n < 2; ++n) _Pragma("unroll") for (int k = 0; k < 2; ++k) \
        acc[ai][bj][m][n] = __builtin_amdgcn_mfma_f32_16x16x32_bf16(Bt[n][k], At[m][k], acc[ai][bj][m][n], 0, 0, 0); __builtin_amdgcn_s_setprio(0); } while (0)
#define PG8_WAIT_V(n) asm volatile("s_waitcnt vmcnt(" #n ")" ::: "memory")
#define PG8_WAIT_L(n) asm volatile("s_waitcnt lgkmcnt(" #n ")" ::: "memory")
#define PG8_BAR __builtin_amdgcn_s_barrier()
#define PG8_SCHED __builtin_amdgcn_sched_barrier(0)
    Unit cur, nxt; int ui = 0;
    if (!S.next(0, cur)) return;
    f32x4 acc[2][2][4][2];
#pragma unroll
    for (int a = 0; a < 2; ++a)
#pragma unroll
        for (int b = 0; b < 2; ++b)
#pragma unroll
            for (int m = 0; m < 4; ++m)
#pragma unroll
                for (int n = 0; n < 2; ++n) acc[a][b][m][n] = (f32x4){0.f, 0.f, 0.f, 0.f};
    bf16x8 At[4][2], B0[2][2], B1[2][2];
    const char* cA = gemm_abase(g, cur.pm, tstep); const char* cB = (const char*)g.Bt + (size_t)cur.pn * tstep;
    S.a_ready(cur);
    if constexpr (SP2) {
        PG8_STAGE(PG8_SB(0, 0), cB, voffB); PG8_STAGE(PG8_SB(0, 1), cB + hstep, voffB); PG8_STAGE(PG8_SA(0, 0), cA, voffA); PG8_STAGE(PG8_SA(0, 1), cA + hstep, voffA);
        if (wr == 1) PG8_BAR;
        PG8_WAIT_V(2); PG8_BAR;
        PG8_STAGE(PG8_SB(1, 0), cB + kstep, voffB); PG8_STAGE(PG8_SA(1, 0), cA + kstep, voffA); PG8_STAGE(PG8_SB(1, 1), cB + hstep + kstep, voffB);
        PG8_WAIT_V(6); PG8_BAR;
    } else {
        PG8_STAGE(PG8_SB(0, 0), cB, voffB); PG8_STAGE(PG8_SA(0, 0), cA, voffA); PG8_STAGE(PG8_SB(0, 1), cB + hstep, voffB); PG8_STAGE(PG8_SA(0, 1), cA + hstep, voffA);
        if (wr == 1) PG8_BAR;
        PG8_WAIT_V(4); PG8_BAR;
        PG8_STAGE(PG8_SB(1, 0), cB + kstep, voffB); PG8_STAGE(PG8_SA(1, 0), cA + kstep, voffA); PG8_STAGE(PG8_SB(1, 1), cB + hstep + kstep, voffB);
        PG8_WAIT_V(6); PG8_BAR;
    }
    for (;;) {
        const bool has_next = S.next(ui + 1, nxt);
        const char* nA = has_next ? gemm_abase(g, nxt.pm, tstep) : cA; const char* nB = has_next ? (const char*)g.Bt + (size_t)nxt.pn * tstep : cB;
        for (int t = 0; t < nt; t += 2) {
            const bool last = (t == nt - 2);
            const char* a1 = cA + (size_t)(t + 1) * kstep;
            const char* a2 = last ? nA : cA + (size_t)(t + 2) * kstep; const char* b2 = last ? nB : cB + (size_t)(t + 2) * kstep;
            const char* a3 = a2 + kstep; const char* b3 = b2 + kstep;
            if (last && has_next) S.a_ready(nxt);
            if constexpr (SP2) {
            PG8_LDB(B0, 0, 0); PG8_LDB(B1, 0, 1); PG8_SCHED; PG8_LDA(At, 0, 0); PG8_STAGE(PG8_SA(1, 1), a1 + hstep, voffA);
            PG8_WAIT_V(8); PG8_WAIT_L(0); PG8_BAR; PG8_MMA(0, 0, At, B0); PG8_MMA(0, 1, At, B1); PG8_BAR; PG8_SCHED;
            PG8_LDA(At, 0, 1); PG8_STAGE(PG8_SB(0, 0), b2, voffB); PG8_STAGE(PG8_SB(0, 1), b2 + hstep, voffB); PG8_STAGE(PG8_SA(0, 0), a2, voffA);
            PG8_WAIT_V(8); PG8_WAIT_L(0); PG8_BAR; PG8_MMA(1, 0, At, B0); PG8_MMA(1, 1, At, B1); PG8_BAR; PG8_SCHED;
            PG8_LDB(B0, 1, 0); PG8_LDB(B1, 1, 1); PG8_SCHED; PG8_LDA(At, 1, 0); PG8_STAGE(PG8_SA(0, 1), a2 + hstep, voffA);
            PG8_WAIT_V(8); PG8_WAIT_L(0); PG8_BAR; PG8_MMA(0, 0, At, B0); PG8_MMA(0, 1, At, B1); PG8_BAR; PG8_SCHED;
            PG8_LDA(At, 1, 1); PG8_STAGE(PG8_SB(1, 0), b3, voffB); PG8_STAGE(PG8_SB(1, 1), b3 + hstep, voffB); PG8_STAGE(PG8_SA(1, 0), a3, voffA);
            PG8_WAIT_V(8); PG8_WAIT_L(0); PG8_BAR; PG8_MMA(1, 0, At, B0); PG8_MMA(1, 1, At, B1); PG8_BAR; PG8_SCHED;
            } else {
            PG8_LDB(B0, 0, 0); PG8_SCHED; PG8_LDA(At, 0, 0); PG8_STAGE(PG8_SA(1, 1), a1 + hstep, voffA);
            PG8_WAIT_L(8); PG8_BAR; PG8_WAIT_L(0); PG8_MMA(0, 0, At, B0); PG8_BAR; PG8_SCHED;
            PG8_LDB(B1, 0, 1); PG8_STAGE(PG8_SB(0, 0), b2, voffB);
            PG8_BAR; PG8_WAIT_L(0); PG8_MMA(0, 1, At, B1); PG8_BAR;
            PG8_LDA(At, 0, 1); PG8_STAGE(PG8_SA(0, 0), a2, voffA);
            PG8_BAR; PG8_WAIT_L(0); PG8_MMA(1, 0, At, B0); PG8_BAR; PG8_SCHED;
            PG8_STAGE(PG8_SB(0, 1), b2 + hstep, voffB);
            PG8_WAIT_V(6); PG8_BAR; PG8_MMA(1, 1, At, B1); PG8_BAR;
            PG8_LDB(B0, 1, 0); PG8_SCHED; PG8_LDA(At, 1, 0); PG8_STAGE(PG8_SA(0, 1), a2 + hstep, voffA);
            PG8_WAIT_L(8); PG8_BAR; PG8_WAIT_L(0); PG8_MMA(0, 0, At, B0); PG8_BAR; PG8_SCHED;
            PG8_LDB(B1, 1, 1); PG8_STAGE(PG8_SB(1, 0), b3, voffB);
            PG8_BAR; PG8_WAIT_L(0); PG8_MMA(0, 1, At, B1); PG8_BAR;
            PG8_LDA(At, 1, 1); PG8_STAGE(PG8_SA(1, 0), a3, voffA);
            PG8_BAR; PG8_WAIT_L(0); PG8_MMA(1, 0, At, B0); PG8_BAR; PG8_SCHED;
            PG8_STAGE(PG8_SB(1, 1), b3 + hstep, voffB);
            PG8_WAIT_V(6); PG8_BAR; PG8_MMA(1, 1, At, B1); PG8_BAR;
            }
        }
        if constexpr (ALIGN_EPI) { if (wr == 0) PG8_BAR; }
        if constexpr (!Epi::AFTER_DRAIN) { E(acc, cur, wr, wc, fr, fq); S.done(cur); }
        if (!has_next) break;
#pragma unroll
        for (int a = 0; a < 2; ++a)
#pragma unroll
            for (int b = 0; b < 2; ++b)
#pragma unroll
                for (int m = 0; m < 4; ++m)
#pragma unroll
                    for (int n = 0; n < 2; ++n) acc[a][b][m][n] = (f32x4){0.f, 0.f, 0.f, 0.f};
        cur = nxt; cA = nA; cB = nB; ++ui;
        if constexpr (ALIGN_EPI) { if (wr == 1) PG8_BAR; }
    }
    PG8_WAIT_V(0);
    if constexpr (!ALIGN_EPI) { if (wr == 0) PG8_BAR; }
    PG8_BAR;
    if constexpr (Epi::AFTER_DRAIN) { E.fused(acc, cur, wr, wc, fr, fq, lds, wid, lane); S.done(cur); }
#undef PG8_SA
#undef PG8_SB
#undef PG8_STAGE
#undef PG8_LDA
#undef PG8_LDB
#undef PG8_MMA
#undef PG8_WAIT_V
#undef PG8_WAIT_L
#undef PG8_BAR
#undef PG8_SCHED
}
}

#ifndef PG8_SP2
#define PG8_SP2 true
#endif

#define LAS __attribute__((address_space(3)))
typedef unsigned short bf16;
typedef short bf16x8 __attribute__((ext_vector_type(8)));
typedef float f32x4 __attribute__((ext_vector_type(4)));
typedef float f32x16 __attribute__((ext_vector_type(16)));
typedef unsigned u32x4 __attribute__((ext_vector_type(4)));
typedef unsigned u32x2 __attribute__((ext_vector_type(2)));

constexpr int DM = 1024, NMAIN = 32768, ROWS = 33024, METAROW = 32768, DFF = 4096;
constexpr int NTHREADS = 512;
constexpr int LDS_BYTES = 147456;
constexpr int LDS_ITEM_OFF = LDS_BYTES - 16;
constexpr size_t MiB = 1u << 20;
constexpr size_t WS_CTL = 0, WS_WIN = 1 * MiB, WS_WUPA = 12 * MiB, WS_WUPB = 13 * MiB, WS_WOUT = 14 * MiB, WS_WFF1 = 16 * MiB, WS_WFF2 = 24 * MiB;
constexpr size_t WS_LORA = 32 * MiB, WS_XNMETA = 32 * MiB + 512 * 1024, WS_CB = 33 * MiB, WS_ACT = 36 * MiB;
constexpr size_t ACT_SZ = (size_t)ROWS * 512 * 2, L_SZ = (size_t)ROWS * 256 * 2;
constexpr size_t WS_R = WS_ACT, WS_KA = WS_R + ACT_SZ, WS_VA = WS_KA + ACT_SZ, WS_L = WS_VA + ACT_SZ, WS_Q = WS_L + L_SZ, WS_KB = WS_Q + ACT_SZ, WS_VT = WS_KB + ACT_SZ, WS_END = WS_VT + ACT_SZ;
constexpr size_t WS_GA = WS_KA, WS_GB = WS_KB, WS_MN = WS_ACT, WS_HID = WS_ACT + 64 * MiB;
constexpr size_t WS_SS = 65536;
constexpr size_t WS_HALO = WS_END;
constexpr int HALO_ROW = 3584;
static_assert(WS_HALO + (size_t)(NMAIN / 64) * 2 * HALO_ROW <= 256 * MiB, "halo buffer");
static_assert(WS_END <= 256 * MiB && WS_HID + 128 * MiB <= 256 * MiB && WS_CB + (size_t)2 * ROWS * 8 * 4 <= WS_ACT, "ws map");
constexpr float LOG2E = 1.4426950408889634f;
constexpr float QSCALE = 0.125f * LOG2E;

struct Params { const float* in[29]; float* out; unsigned char* ws; };
typedef const __attribute__((address_space(4))) Params* KP;
enum { I_XP = 0, I_XS, I_META, I_GMIX, I_WIN, I_MUP, I_MUN, I_W0, I_WUP, I_A0, I_AUP, I_GUP, I_KK, I_KA, I_RK, I_LNW, I_LNB, I_LQ1, I_LK1, I_LQ2, I_LK2, I_SUBG, I_UPA, I_UPB, I_WOUT, I_GFFN, I_FF1, I_FF2, I_GFIN };

typedef float cvt_f32x2 __attribute__((ext_vector_type(2))); typedef __bf16 cvt_bf16x2 __attribute__((ext_vector_type(2)));
__device__ __forceinline__ unsigned cvtpk(float lo, float hi) { const cvt_f32x2 v = {lo, hi}; const cvt_bf16x2 b = __builtin_convertvector(v, cvt_bf16x2); return __builtin_bit_cast(unsigned, b); }
__device__ __forceinline__ float bf2f(unsigned short b) { return __uint_as_float(((unsigned)b) << 16); }
__device__ __forceinline__ float bflo(unsigned w) { return __uint_as_float(w << 16); }
__device__ __forceinline__ float bfhi(unsigned w) { return __uint_as_float(w & 0xffff0000u); }
__device__ __forceinline__ void unpack8(const u32x4 v, float* o) { o[0] = bflo(v.x); o[1] = bfhi(v.x); o[2] = bflo(v.y); o[3] = bfhi(v.y); o[4] = bflo(v.z); o[5] = bfhi(v.z); o[6] = bflo(v.w); o[7] = bfhi(v.w); }
__device__ __forceinline__ float wave_sum(float v) {
#pragma unroll
    for (int o = 1; o < 64; o <<= 1) v += __shfl_xor(v, o);
    return v;
}
__device__ __forceinline__ float sigmoidf_(float x) { return __builtin_amdgcn_rcpf(1.0f + __builtin_amdgcn_exp2f(-LOG2E * x)); }
__device__ __forceinline__ int seq_base(int s) { return s == 0 ? 0 : 16384 + (s - 1) * 2048; }
__device__ __forceinline__ int seq_len(int s) { return s == 0 ? 16384 : 2048; }
__device__ __forceinline__ int pos_row(int base, int p) { return p < 16 ? METAROW + p : base + p - 16; }

template <class Op> struct Epi8 {
    static constexpr bool PERM = true, AFTER_DRAIN = false;
    Op op;
    __device__ __forceinline__ void operator()(const pg8::f32x4 (&acc)[2][2][4][2], const pg8::Unit& u, int wr, int wc, int fr, int fq) const {
        const int row0 = u.pm * 256 + wr * 64 + fr, col0 = u.pn * 256 + wc * 32 + 8 * fq;
#pragma unroll
        for (int ai = 0; ai < 2; ++ai)
#pragma unroll
            for (int m = 0; m < 4; ++m)
#pragma unroll
                for (int bj = 0; bj < 2; ++bj) { op.apply(row0 + ai * 128 + m * 16, col0 + bj * 128, u.pn, acc[ai][bj][m][0], acc[ai][bj][m][1]); asm volatile("" ::: "memory"); }
    }
};
__device__ __forceinline__ u32x4 pack8(const f32x4 a, const f32x4 b) { u32x4 w; w.x = cvtpk(a[0], a[1]); w.y = cvtpk(a[2], a[3]); w.z = cvtpk(b[0], b[1]); w.w = cvtpk(b[2], b[3]); return w; }

constexpr int CW_KN = 320;
__device__ __forceinline__ float dpp_max16(float v) {
    int x = __float_as_int(v);
    v = fmaxf(v, __int_as_float(__builtin_amdgcn_update_dpp(0, x, 0xB1, 0xf, 0xf, true))); x = __float_as_int(v);
    v = fmaxf(v, __int_as_float(__builtin_amdgcn_update_dpp(0, x, 0x4E, 0xf, 0xf, true))); x = __float_as_int(v);
    v = fmaxf(v, __int_as_float(__builtin_amdgcn_update_dpp(0, x, 0x141, 0xf, 0xf, true))); x = __float_as_int(v);
    v = fmaxf(v, __int_as_float(__builtin_amdgcn_update_dpp(0, x, 0x140, 0xf, 0xf, true)));
    return v;
}
struct OpProj {
    unsigned char* ws;
    __device__ __forceinline__ void apply(int row, int col, int pn, f32x4 v0, f32x4 v1) const {
        if (pn >= 11) {
            bf16* VT = (bf16*)(ws + WS_VT); const int c = col - 11 * 256;
#pragma unroll
            for (int e = 0; e < 4; ++e) { bf16* vt = VT + ((size_t)(row >> 6) * 512 + c) * 64 + (row & 63);
                vt[e * 64] = (bf16)(cvtpk(v0[e], 0.f) & 0xffffu); vt[(4 + e) * 64] = (bf16)(cvtpk(v1[e], 0.f) & 0xffffu); }
            return;
        }
        bf16* O; int ldc = 512, c;
        if (pn < 2) { O = (bf16*)(ws + WS_R); c = col; }
        else if (pn < 4) { O = (bf16*)(ws + WS_KA); c = col - 512; }
        else if (pn < 6) { O = (bf16*)(ws + WS_VA); c = col - 1024; }
        else if (pn < 7) { O = (bf16*)(ws + WS_L); c = col - 1536; ldc = 256; }
        else if (pn < 9) { O = (bf16*)(ws + WS_Q); c = col - 1792; v0 = v0 * QSCALE; v1 = v1 * QSCALE; }
        else { O = (bf16*)(ws + WS_KB); c = col - 2304; }
        const u32x4 w = pack8(v0, v1);
        *(u32x4*)(O + (size_t)row * ldc + c) = w;
        if (pn >= 9) {
            float k8[8]; unpack8(w, k8); float ss = 0.f;
#pragma unroll
            for (int e = 0; e < 8; ++e) ss = fmaf(k8[e], k8[e], ss);
            ss = dpp_max16(ss);
            if ((threadIdx.x & 15) == 0) { const int sidx = row < 16384 ? 0 : row < NMAIN ? 1 + ((row - 16384) >> 11) : 9;
                atomicMax((unsigned*)(ws + WS_CTL) + CW_KN + sidx * 64 + (c >> 3), __float_as_uint(ss)); }
        }
    }
};
struct OpGate {
    bf16* O;
    __device__ __forceinline__ void apply(int row, int col, int pn, f32x4 v0, f32x4 v1) const {
        const int c = col;
#pragma unroll
        for (int e = 0; e < 4; ++e) { v0[e] = sigmoidf_(v0[e]); v1[e] = sigmoidf_(v1[e]); }
        *(u32x4*)(O + (size_t)row * 1024 + c) = pack8(v0, v1);
    }
};
struct OpUpA {
    unsigned char* ws;
    __device__ __forceinline__ void apply(int row, int col, int pn, f32x4 v0, f32x4 v1) const {
        u32x4* p = (u32x4*)((bf16*)(ws + WS_GA) + (size_t)row * 1024 + col); float g[8]; unpack8(*p, g);
#pragma unroll
        for (int e = 0; e < 4; ++e) { v0[e] *= g[e]; v1[e] *= g[4 + e]; }
        *p = pack8(v0, v1);
    }
};
struct OpUpB {
    unsigned char* ws;
    __device__ __forceinline__ void apply(int row, int col, int pn, f32x4 v0, f32x4 v1) const {
        u32x4* p = (u32x4*)((bf16*)(ws + WS_GB) + (size_t)row * 1024 + col); float g[8], a[8]; unpack8(*p, g);
        unpack8(*(const u32x4*)((const bf16*)(ws + WS_GA) + (size_t)row * 1024 + col), a);
#pragma unroll
        for (int e = 0; e < 4; ++e) { v0[e] = a[e] + v0[e] * g[e]; v1[e] = a[4 + e] + v1[e] * g[4 + e]; }
        *p = pack8(v0, v1);
    }
};
struct OpOut {
    const float* xp; const float* xs; float* out; const float* gf; bf16* mn; float* ss;
    __device__ __forceinline__ void apply(int row, int col, int pn, f32x4 v0, f32x4 v1) const {
        const float* x = (row < 16384 ? xp + (size_t)row * DM : xs + (size_t)(row - 16384) * DM) + col;
        float* o = out + (size_t)row * DM + col;
        const f32x4 h0 = *(const f32x4*)x + v0, h1 = *(const f32x4*)(x + 4) + v1;
        *(f32x4*)o = h0; *(f32x4*)(o + 4) = h1;
        const f32x4 g0 = *(const f32x4*)(gf + col), g1 = *(const f32x4*)(gf + col + 4);
        *(u32x4*)(mn + (size_t)row * DM + col) = pack8(h0 * g0, h1 * g1);
        float q = (h0[0] * h0[0] + h0[1] * h0[1]) + (h0[2] * h0[2] + h0[3] * h0[3]) + (h1[0] * h1[0] + h1[1] * h1[1]) + (h1[2] * h1[2] + h1[3] * h1[3]);
        { const auto r = __builtin_amdgcn_permlane16_swap(__float_as_uint(q), __float_as_uint(q), false, false); q = __uint_as_float(r[0]) + __uint_as_float(r[1]); }
        { const auto r = __builtin_amdgcn_permlane32_swap(__float_as_uint(q), __float_as_uint(q), false, false); q = __uint_as_float(r[0]) + __uint_as_float(r[1]); }
        if ((threadIdx.x & 63) < 16) atomicAdd(ss + row, q);
    }
};
struct OpFF1 {
    bf16* hid; const float* ss;
    __device__ __forceinline__ void apply(int row, int col, int pn, f32x4 v0, f32x4 v1) const {
        const float rs2 = __builtin_amdgcn_rcpf(ss[row] * (1.0f / DM) + 1e-6f);
#pragma unroll
        for (int e = 0; e < 4; ++e) { const float a = fmaxf(v0[e], 0.f), b = fmaxf(v1[e], 0.f); v0[e] = a * a * rs2; v1[e] = b * b * rs2; }
        *(u32x4*)(hid + (size_t)row * DFF + col) = pack8(v0, v1);
    }
};
struct OpFF2 {
    float* out;
    __device__ __forceinline__ void apply(int row, int col, int pn, f32x4 v0, f32x4 v1) const {
        float* o = out + (size_t)row * DM + col;
        *(f32x4*)o = *(const f32x4*)o + v0; *(f32x4*)(o + 4) = *(const f32x4*)(o + 4) + v1;
    }
};

__device__ __forceinline__ unsigned f2bf_rne(float f) { return cvtpk(f, 0.f) & 0xffffu; }
__device__ __forceinline__ void transpose_item(const float* W, int K, int N, bf16* WT, LAS float* scr, int item, int lane) {
    const int nblk = N / 32, kb = item / nblk, nb = item % nblk, k0 = 64 * kb, n0 = 32 * nb;
#pragma unroll 8
    for (int i = 0; i < 32; ++i) { const int kk = 2 * i + (lane >> 5); scr[kk * 33 + (lane & 31)] = W[(size_t)(k0 + kk) * N + n0 + (lane & 31)]; }
    asm volatile("s_waitcnt vmcnt(0) lgkmcnt(0)" ::: "memory");
    const int c = lane & 7;
#pragma unroll
    for (int j = 0; j < 4; ++j) { const int n = (lane >> 3) + 8 * j; const LAS float* s = scr + (8 * c) * 33 + n;
        u32x4 o; o.x = cvtpk(s[0 * 33], s[1 * 33]); o.y = cvtpk(s[2 * 33], s[3 * 33]); o.z = cvtpk(s[4 * 33], s[5 * 33]); o.w = cvtpk(s[6 * 33], s[7 * 33]);
        *(u32x4*)(WT + (size_t)(n0 + n) * K + k0 + 8 * c) = o; }
    asm volatile("s_waitcnt lgkmcnt(0)" ::: "memory");
}
__device__ __forceinline__ void rms_row_bf16(const float* src, const float* g, bf16* dst, int lane) {
    unsigned long long* o8 = (unsigned long long*)dst + lane;
    if (!src) {
#pragma unroll
        for (int j = 0; j < 4; ++j) o8[64 * j] = 0ull;
        return; }
    const f32x4* xr = (const f32x4*)src + lane; const f32x4* gr = (const f32x4*)g + lane;
    f32x4 v[4]; float s = 0.f;
#pragma unroll
    for (int j = 0; j < 4; ++j) { v[j] = xr[64 * j]; s += (v[j].x * v[j].x + v[j].y * v[j].y) + (v[j].z * v[j].z + v[j].w * v[j].w); }
    const float rstd = rsqrtf(wave_sum(s) * (1.f / DM) + 1e-6f);
#pragma unroll
    for (int j = 0; j < 4; ++j) { const f32x4 gg = gr[64 * j]; const f32x4 y = v[j] * rstd * gg;
        o8[64 * j] = (unsigned long long)cvtpk(y.x, y.y) | ((unsigned long long)cvtpk(y.z, y.w) << 32); }
}
__device__ __forceinline__ void phase_prologue(LAS unsigned char* lds, KP P) {
    const int tid = fresh_tid(), lane = tid & 63, wid = tid >> 6;
    LAS float* scr = (LAS float*)(lds + wid * 16384);
    const int gw = blockIdx.x * 8 + wid, NGW = gridDim.x * 8;
    unsigned char* ws = P->ws;
    constexpr int I_IN = (1024 / 64) * (5376 / 32), I_UP = (512 / 64) * (1024 / 32), I_O = (1024 / 64) * (1024 / 32), I_1 = (1024 / 64) * (4096 / 32), I_2 = (4096 / 64) * (1024 / 32);
    constexpr int I_LW = (64 / 64) * (512 / 32), I_G = (128 / 64) * (512 / 32);
    constexpr int NITEMS = I_IN + 2 * I_UP + I_O + I_1 + I_2 + 4 * I_LW + I_G;
    for (int it = gw; it < NITEMS; it += NGW) {
        int r = it;
        if (r < I_IN) { transpose_item(P->in[I_WIN], 1024, 5376, (bf16*)(ws + WS_WIN), scr, r, lane); continue; } r -= I_IN;
        if (r < I_UP) { transpose_item(P->in[I_UPA], 512, 1024, (bf16*)(ws + WS_WUPA), scr, r, lane); continue; } r -= I_UP;
        if (r < I_UP) { transpose_item(P->in[I_UPB], 512, 1024, (bf16*)(ws + WS_WUPB), scr, r, lane); continue; } r -= I_UP;
        if (r < I_O) { transpose_item(P->in[I_WOUT], 1024, 1024, (bf16*)(ws + WS_WOUT), scr, r, lane); continue; } r -= I_O;
        if (r < I_1) { transpose_item(P->in[I_FF1], 1024, 4096, (bf16*)(ws + WS_WFF1), scr, r, lane); continue; } r -= I_1;
        if (r < I_2) { transpose_item(P->in[I_FF2], 4096, 1024, (bf16*)(ws + WS_WFF2), scr, r, lane); continue; } r -= I_2;
        if (r < 2 * I_LW) { const int d = r / I_LW; transpose_item(P->in[I_WUP] + (size_t)d * 64 * 512, 64, 512, (bf16*)(ws + WS_LORA) + (size_t)d * 512 * 64, scr, r % I_LW, lane); continue; } r -= 2 * I_LW;
        if (r < 2 * I_LW) { const int d = r / I_LW; transpose_item(P->in[I_AUP] + (size_t)d * 64 * 512, 64, 512, (bf16*)(ws + WS_LORA + 131072) + (size_t)d * 512 * 64, scr, r % I_LW, lane); continue; } r -= 2 * I_LW;
        transpose_item(P->in[I_GUP], 128, 512, (bf16*)(ws + WS_LORA + 262144), scr, r, lane);
    }
    bf16* XN = (bf16*)P->out; bf16* XM = (bf16*)(ws + WS_XNMETA);
    for (int m = gw; m < ROWS; m += NGW) {
        const float* src = m < 16384 ? P->in[I_XP] + (size_t)m * DM : m < NMAIN ? P->in[I_XS] + (size_t)(m - 16384) * DM : (m - NMAIN < 16 ? P->in[I_META] + (size_t)(m - NMAIN) * DM : nullptr);
        bf16* dst = m < NMAIN ? XN + (size_t)m * DM : XM + (size_t)(m - NMAIN) * DM;
        rms_row_bf16(src, P->in[I_GMIX], dst, lane);
    }
}

constexpr int AT_KSTR = 272, AT_VSTR = 144, AT_KSZ = 64 * AT_KSTR, AT_BUF = AT_KSZ + 128 * AT_VSTR;
__device__ __forceinline__ f32x16 mfma32(bf16x8 a, bf16x8 b, f32x16 c) { return __builtin_amdgcn_mfma_f32_32x32x16_bf16(a, b, c, 0, 0, 0); }
__device__ __forceinline__ void attn_unit(LAS unsigned char* lds, KP P, int s, int h, int qb, float lam) {
    int tid_ = threadIdx.x; asm volatile("" : "+v"(tid_));
    const int tid = tid_, lane = tid & 63, r32 = lane & 31, hi = lane >> 5, wid = __builtin_amdgcn_readfirstlane(tid >> 6), rg = wid & 3, mp = wid >> 2;
    const int L = seq_len(s), base = seq_base(s), NT = 1 + L / 64;
    unsigned char* ws = P->ws;
    const bf16* KB = (const bf16*)(ws + WS_KB); const bf16* VT = (const bf16*)(ws + WS_VT); bf16* Q = (bf16*)(ws + WS_Q);
    const int qrow = base + qb * 128 + rg * 32 + r32;
    bf16x8 q[4];
#pragma unroll
    for (int d0 = 0; d0 < 4; ++d0) q[d0] = *(const bf16x8*)(Q + (size_t)qrow * 512 + h * 128 + mp * 64 + d0 * 16 + hi * 8);
    f32x16 O[4];
#pragma unroll
    for (int b = 0; b < 4; ++b)
#pragma unroll
        for (int r = 0; r < 16; ++r) O[b][r] = 0.f;
    float mx = -INFINITY, ls = 0.f;
    const float qh = (float)(16 + qb * 128 + rg * 32 + r32 - 4 * hi);
    const float nslope = -exp2f(-2.0f * (float)(h + 1)) * LOG2E;
    const int kr0 = tid >> 4, kc = tid & 15, vn0 = tid >> 3, vc = tid & 7;
    u32x4 kreg[2], vreg[2];
    const unsigned kgo = (unsigned)((kr0 * 512 + h * 128 + kc * 8) * 2), vgo = (unsigned)(((h * 128 + vn0) * 64 + vc * 8) * 2);
    const unsigned klo = (unsigned)(kr0 * AT_KSTR + kc * 16), vlo = (unsigned)(AT_KSZ + vn0 * AT_VSTR + vc * 16);
#define AT_GLOAD(j) do { const int m0_ = (j) == 0 ? METAROW : base + 64 * ((j) - 1); \
        const unsigned char* kt_ = (const unsigned char*)KB + (size_t)m0_ * 1024; const unsigned char* vt_ = (const unsigned char*)VT + (size_t)(m0_ >> 6) * (512 * 64 * 2); \
        kreg[0] = *(const u32x4*)(kt_ + kgo); kreg[1] = *(const u32x4*)(kt_ + 32 * 1024 + kgo); \
        vreg[0] = *(const u32x4*)(vt_ + vgo); vreg[1] = *(const u32x4*)(vt_ + 64 * 64 * 2 + vgo); } while (0)
#define AT_LSTORE(buf) do { LAS unsigned char* kb_ = lds + (buf) * AT_BUF; \
        *(LAS u32x4*)(kb_ + klo) = kreg[0]; *(LAS u32x4*)(kb_ + klo + 32 * AT_KSTR) = kreg[1]; \
        *(LAS u32x4*)(kb_ + vlo) = vreg[0]; *(LAS u32x4*)(kb_ + vlo + 64 * AT_VSTR) = vreg[1]; } while (0)
    float qn, kn;
    { float ssq = 0.f;
#pragma unroll
      for (int d0 = 0; d0 < 4; ++d0) { float t[8]; unpack8(__builtin_bit_cast(u32x4, q[d0]), t);
#pragma unroll
        for (int e = 0; e < 8; ++e) ssq = fmaf(t[e], t[e], ssq); }
      ssq += __shfl_xor(ssq, 32); qn = sqrtf(ssq) * 1.002f;
      const unsigned* KN = (const unsigned*)(ws + WS_CTL) + CW_KN; float ks = 0.f;
#pragma unroll
      for (int g = 0; g < 8; ++g) ks += fmaxf(__uint_as_float(__hip_atomic_load(KN + s * 64 + h * 16 + mp * 8 + g, __ATOMIC_RELAXED, __HIP_MEMORY_SCOPE_AGENT)), __uint_as_float(__hip_atomic_load(KN + 9 * 64 + h * 16 + mp * 8 + g, __ATOMIC_RELAXED, __HIP_MEMORY_SCOPE_AGENT)));
      kn = sqrtf(ks) * 1.002f; }
    const int jc0 = 1 + qb * 2;
    int jlo = jc0, jhi = jc0 + 1;
    LAS float* red = (LAS float*)(lds + 2 * AT_BUF);
#pragma unroll 1
    for (int ph = 0; ph < 2; ++ph) {
        int nleft, ntl;
        if (ph == 0) { nleft = 0; ntl = 2; }
        else {
            float dneed = (qn * kn - mx + 40.0f) / (-nslope);
#pragma unroll
            for (int o = 1; o < 64; o <<= 1) dneed = fmaxf(dneed, __shfl_xor(dneed, o));
            if (lane == 0) red[wid] = dneed;
            __syncthreads();
            float dm = red[0];
#pragma unroll
            for (int w8 = 1; w8 < 8; ++w8) dm = fmaxf(dm, red[w8]);
            dm = fminf(fmaxf(dm, 0.f), 1.0e6f);
            const int dmax = (int)dm + 1, q0 = 16 + qb * 128;
            const int plo = q0 - dmax, phi = q0 + 127 + dmax;
            jlo = plo < 16 ? 0 : 1 + ((plo - 16) >> 6); jhi = phi >= L + 16 ? NT - 1 : 1 + ((phi - 16) >> 6);
            if (jlo > jc0) jlo = jc0; if (jhi < jc0 + 1) jhi = jc0 + 1;
            nleft = jc0 - jlo; ntl = nleft + (jhi - jc0 - 1);
        }
        if (ntl > 0) {
#define AT_J(t) (ph == 0 ? jc0 + (t) : ((t) < nleft ? jlo + (t) : jc0 + 2 + ((t) - nleft)))
        { const int jf = AT_J(0); AT_GLOAD(jf); } AT_LSTORE(0); __syncthreads();
#pragma unroll 1
        for (int t = 0; t < ntl; ++t) {
            const int j = AT_J(t);
            if (t + 1 < ntl) { const int jn = AT_J(t + 1); AT_GLOAD(jn); }
            const LAS unsigned char* Kb = lds + (t & 1) * AT_BUF + mp * 128; const LAS unsigned char* Vb = lds + (t & 1) * AT_BUF + AT_KSZ;
            const float dq = qh - (float)(j == 0 ? 0 : 64 * j - 48);
            f32x16 p0, p1;
#pragma unroll
            for (int r = 0; r < 16; ++r) { p0[r] = 0.f; p1[r] = 0.f; }
            {
                bf16x8 ka[4], kb[4];
#pragma unroll
                for (int d0 = 0; d0 < 4; ++d0) { ka[d0] = *(const LAS bf16x8*)(Kb + r32 * AT_KSTR + d0 * 32 + hi * 16); kb[d0] = *(const LAS bf16x8*)(Kb + (32 + r32) * AT_KSTR + d0 * 32 + hi * 16); }
                __builtin_amdgcn_sched_barrier(0);
#pragma unroll
                for (int d0 = 0; d0 < 4; ++d0) { p0 = mfma32(ka[d0], q[d0], p0); p1 = mfma32(kb[d0], q[d0], p1); }
            }
#pragma unroll
            for (int r = 0; r < 16; ++r) { const float dd = dq - (float)((r & 3) + 8 * (r >> 2)); p0[r] = fmaf(fabsf(dd), nslope, p0[r]); p1[r] = fmaf(fabsf(dd - 32.f), nslope, p1[r]); }
            if (j == 0) {
#pragma unroll
                for (int r = 0; r < 16; ++r) { if ((r & 3) + 8 * (r >> 2) + 4 * hi >= 16) p0[r] = -INFINITY; p1[r] = -INFINITY; }
            }
            float rm = fmaxf(p0[0], p1[0]);
#pragma unroll
            for (int r = 1; r < 16; ++r) rm = fmaxf(rm, fmaxf(p0[r], p1[r]));
            rm = fmaxf(rm, __shfl_xor(rm, 32));
            if (__any(rm > mx - 38.0f)) {
            const float mn = fmaxf(mx, rm);
            if (__any(mn > mx)) {
                const float f = __builtin_amdgcn_exp2f(mx - mn); ls *= f; mx = mn;
#pragma unroll
                for (int b = 0; b < 4; ++b)
#pragma unroll
                    for (int r = 0; r < 16; ++r) O[b][r] *= f;
            }
            float sum = 0.f;
#pragma unroll
            for (int r = 0; r < 16; ++r) { p0[r] = __builtin_amdgcn_exp2f(p0[r] - mx); p1[r] = __builtin_amdgcn_exp2f(p1[r] - mx); sum += p0[r] + p1[r]; }
            ls += sum;
            bf16x8 pf[4];
#pragma unroll
            for (int k2 = 0; k2 < 2; ++k2) {
                u32x4 w0, w1;
                w0.x = cvtpk(p0[8 * k2 + 0], p0[8 * k2 + 1]); w0.y = cvtpk(p0[8 * k2 + 2], p0[8 * k2 + 3]); w0.z = cvtpk(p0[8 * k2 + 4], p0[8 * k2 + 5]); w0.w = cvtpk(p0[8 * k2 + 6], p0[8 * k2 + 7]);
                w1.x = cvtpk(p1[8 * k2 + 0], p1[8 * k2 + 1]); w1.y = cvtpk(p1[8 * k2 + 2], p1[8 * k2 + 3]); w1.z = cvtpk(p1[8 * k2 + 4], p1[8 * k2 + 5]); w1.w = cvtpk(p1[8 * k2 + 6], p1[8 * k2 + 7]);
                pf[k2] = __builtin_bit_cast(bf16x8, w0); pf[2 + k2] = __builtin_bit_cast(bf16x8, w1);
            }
            {
                u32x4 vcur[4], vnxt[4];
#define AT_VLOAD(dst, ks_) do { _Pragma("unroll") for (int b_ = 0; b_ < 4; ++b_) { const LAS unsigned char* vp_ = Vb + (b_ * 32 + r32) * AT_VSTR + (ks_) * 32 + hi * 8; \
                    const u32x2 lo_ = *(const LAS u32x2*)vp_, hh_ = *(const LAS u32x2*)(vp_ + 16); dst[b_].x = lo_.x; dst[b_].y = lo_.y; dst[b_].z = hh_.x; dst[b_].w = hh_.y; } } while (0)
                AT_VLOAD(vcur, 0);
#pragma unroll
                for (int ks = 0; ks < 4; ++ks) {
                    if (ks < 3) AT_VLOAD(vnxt, ks + 1);
                    __builtin_amdgcn_sched_barrier(0);
#pragma unroll
                    for (int b = 0; b < 4; ++b) O[b] = mfma32(__builtin_bit_cast(bf16x8, vcur[b]), pf[ks], O[b]);
                    __builtin_amdgcn_sched_barrier(0);
#pragma unroll
                    for (int b = 0; b < 4; ++b) vcur[b] = vnxt[b];
                }
#undef AT_VLOAD
            }
            }
            if (t + 1 < ntl) AT_LSTORE((t + 1) & 1);
            __syncthreads();
        }
#undef AT_J
        }
    }
#undef AT_GLOAD
#undef AT_LSTORE
    const float lt = ls + __shfl_xor(ls, 32);
    const float inv = (mp ? lam : 1.0f) / lt;
    int lane2 = lane; asm volatile("" : "+v"(lane2));
    const int r32e = lane2 & 31, hie = lane2 >> 5;
    LAS float* ex = (LAS float*)lds + rg * (128 * 32) + hie * 128 + r32e;
    if (mp == 1) {
#pragma unroll
        for (int b = 0; b < 4; ++b)
#pragma unroll
            for (int r = 0; r < 16; ++r) ex[(32 * b + (r & 3) + 8 * (r >> 2)) * 32] = O[b][r] * inv;
    }
    __syncthreads();
    if (mp == 0) {
        float ss = 0.f;
#pragma unroll
        for (int b = 0; b < 4; ++b)
#pragma unroll
            for (int r = 0; r < 16; ++r) { const float o = O[b][r] * inv - ex[(32 * b + (r & 3) + 8 * (r >> 2)) * 32]; O[b][r] = o; ss += o * o; }
        ss += __shfl_xor(ss, 32);
        const float rstd = rsqrtf(ss * (1.0f / 128.0f) + 1e-5f) * 0.8f;
        const float* sg = P->in[I_SUBG] + 4 * hie; bf16* Qo = Q + (size_t)(base + qb * 128 + rg * 32 + r32e) * 512 + h * 128 + 4 * hie;
#pragma unroll
        for (int b = 0; b < 4; ++b)
#pragma unroll
            for (int r4 = 0; r4 < 4; ++r4) {
                const int n = 32 * b + 8 * r4; const f32x4 g = *(const f32x4*)(sg + n);
                u32x2 w; w.x = cvtpk(O[b][4 * r4 + 0] * rstd * g.x, O[b][4 * r4 + 1] * rstd * g.y); w.y = cvtpk(O[b][4 * r4 + 2] * rstd * g.z, O[b][4 * r4 + 3] * rstd * g.w);
                *(u32x2*)(Qo + n) = w;
            }
    }
    __syncthreads();
}

constexpr int SC_R = 0, SC_K = 16384, SC_V = 32768, SC_W = 49152, SC_B = 65536, SC_KK = 81920, SC_Y = 98304, SC_TW = 114688, SC_AD = 123904, SC_MU = 133120;
__device__ __forceinline__ float dpp_add(float v, int ctrl_id) {
    const int x = __float_as_int(v); int y;
    if (ctrl_id == 0) y = __builtin_amdgcn_update_dpp(0, x, 0xB1, 0xf, 0xf, true);
    else if (ctrl_id == 1) y = __builtin_amdgcn_update_dpp(0, x, 0x4E, 0xf, 0xf, true);
    else if (ctrl_id == 2) y = __builtin_amdgcn_update_dpp(0, x, 0x141, 0xf, 0xf, true);
    else y = __builtin_amdgcn_update_dpp(0, x, 0x140, 0xf, 0xf, true);
    return v + __int_as_float(y);
}
template <int LPR> __device__ __forceinline__ float grp_sum(float v) {
    v = dpp_add(v, 0); v = dpp_add(v, 1); v = dpp_add(v, 2);
    if (LPR == 16) v = dpp_add(v, 3);
    return v;
}
#define BAR_LDS() asm volatile("s_waitcnt lgkmcnt(0)\n\ts_barrier" ::: "memory")
__device__ __forceinline__ float fast_sigmoid(float x) { return __builtin_amdgcn_rcpf(1.0f + __builtin_amdgcn_exp2f(-LOG2E * x)); }
__device__ __forceinline__ float fast_tanh(float x) { return 1.0f - 2.0f * __builtin_amdgcn_rcpf(1.0f + __builtin_amdgcn_exp2f(2.0f * LOG2E * x)); }
template <int NRP, int NSW>
__device__ __forceinline__ void scan_unit(LAS unsigned char* lds, KP P, int s, int d, int h, int rp) {
    constexpr int RPB = 64 / NRP, RPW = RPB / NSW, LPR = 64 / RPW, CPL = 64 / LPR;
    static_assert(LPR == 8 || LPR == 16, "scan geometry");
    constexpr bool YDB = (RPB == 16) && (NSW == 4);
    constexpr int YST = YDB ? RPB : 64;
    int tid_ = threadIdx.x; asm volatile("" : "+v"(tid_));
    const int tid = tid_, lane = tid & 63, wid = __builtin_amdgcn_readfirstlane(tid >> 6);
    const int L = seq_len(s), base = seq_base(s), Ltot = L + 16, nchunk = (Ltot + 63) / 64;
    unsigned char* ws = P->ws;
    const bf16* Rb = (const bf16*)(ws + WS_R); const bf16* KAb = (const bf16*)(ws + WS_KA); const bf16* VAb = (const bf16*)(ws + WS_VA); const bf16* Lb = (const bf16*)(ws + WS_L);
    float* CB = (float*)(ws + WS_CB); bf16* YD = (bf16*)((unsigned char*)P->out + 64 * MiB) + (size_t)d * NMAIN * 512;
    LAS float* fS = (LAS float*)lds; LAS float* fV = (LAS float*)(lds + 81920); LAS float* fY = (LAS float*)(lds + SC_Y); LAS float* fMU = (LAS float*)(lds + SC_MU);
#define SCI(sl_, a_, c_) ((sl_) * 320 + (a_) * 64 + (c_))
    for (int i = tid; i < 832; i += NTHREADS) {
        float v;
        if (i < 640) { const int which = i / 320, jj = i % 320, a = jj >> 6, c = jj & 63; const int gi = a < 3 ? a * 512 + h * 64 + c : 1536 + (a - 3) * 64 + c; v = P->in[which ? I_MUN : I_MUP][gi]; }
        else { const int a = (i - 640) >> 6, c = (i - 640) & 63; v = P->in[a == 0 ? I_KK : a == 1 ? I_KA : I_RK][h * 64 + c]; }
        fMU[i] = v;
    }
    const int mat = wid >> 2, ntile = wid & 3;
    const bf16* Wt = (const bf16*)(ws + WS_LORA + (mat ? 131072 : 0)) + ((size_t)d * 512 + h * 64 + ntile * 16 + (lane & 15)) * 64 + (lane >> 4) * 8;
    const bf16x8 bfr0 = *(const bf16x8*)Wt, bfr1 = *(const bf16x8*)(Wt + 32);
    const float bias = P->in[mat ? I_A0 : I_W0][d * 512 + h * 64 + ntile * 16 + (lane & 15)];
    float S[CPL];
#pragma unroll
    for (int j = 0; j < CPL; ++j) S[j] = 0.f;
    const int rowl = lane / LPR, kg = lane % LPR, srow = rp * RPB + wid * RPW + rowl;
    const int slot = tid >> 3, cg8 = (tid & 7) * 8;
    u32x4 raw[5][3];
#define SC_META(c) (d ? ((c) == nchunk - 1) : ((c) == 0))
    const unsigned char* HALO0 = ws + WS_HALO + (size_t)(base >> 6) * 2 * HALO_ROW;
#define SC_LOAD(c) do { const int i_ = 64 * (c) + slot; const bool ok_ = i_ < Ltot; const int p_ = d ? Ltot - 1 - i_ : i_; \
        const unsigned zr_ = (unsigned)(METAROW + 64); \
        if (!SC_META(c)) { const unsigned rc_ = ok_ ? (unsigned)(base + p_ - 16) : zr_; \
            _Pragma("unroll") for (int a_ = 0; a_ < 5; ++a_) { const unsigned char* B_ = (const unsigned char*)(a_ == 0 ? Rb : a_ == 1 ? KAb : a_ == 2 ? VAb : Lb); const unsigned ld_ = a_ < 3 ? 1024u : 512u; \
                const unsigned co_ = (unsigned)(((a_ < 3 ? h * 64 : (a_ - 3) * 64) + cg8) * 2); raw[a_][1] = *(const u32x4*)(B_ + (rc_ * ld_ + co_)); } \
        } else { const bool me_ = ok_ && p_ < 16; const bool hn_ = me_ && p_ == 15; \
            const unsigned rc_ = ok_ ? (unsigned)pos_row(base, p_) : zr_, rp_ = (me_ && p_ > 0) ? (unsigned)(METAROW + p_ - 1) : zr_, rn_ = (me_ && p_ < 15) ? (unsigned)(METAROW + p_ + 1) : zr_; \
            _Pragma("unroll") for (int a_ = 0; a_ < 5; ++a_) { const unsigned char* B_ = (const unsigned char*)(a_ == 0 ? Rb : a_ == 1 ? KAb : a_ == 2 ? VAb : Lb); const unsigned ld_ = a_ < 3 ? 1024u : 512u; \
                const unsigned co_ = (unsigned)(((a_ < 3 ? h * 64 : (a_ - 3) * 64) + cg8) * 2); \
                const unsigned ho_ = (unsigned)(((a_ < 3 ? a_ * 512 + h * 64 : 1536 + (a_ - 3) * 64) + cg8) * 2); \
                raw[a_][0] = *(const u32x4*)(B_ + (rp_ * ld_ + co_)); raw[a_][1] = *(const u32x4*)(B_ + (rc_ * ld_ + co_)); \
                const unsigned char* np_ = hn_ ? HALO0 + ho_ : B_ + (rn_ * ld_ + co_); raw[a_][2] = *(const u32x4*)np_; } } } while (0)
    SC_LOAD(0);
    BAR_LDS();
    for (int c = 0; c < nchunk; ++c) {
        const int nvalid = (Ltot - 64 * c) < 64 ? (Ltot - 64 * c) : 64;
        float rv[8], kv[8];
        if (!SC_META(c)) {
            float vv8[8]; unpack8(raw[0][1], rv); unpack8(raw[1][1], kv); unpack8(raw[2][1], vv8);
            { LAS float* dst = fS + SCI(slot, 4, cg8); *(LAS f32x4*)dst = (f32x4){rv[0], rv[1], rv[2], rv[3]}; *(LAS f32x4*)(dst + 4) = (f32x4){rv[4], rv[5], rv[6], rv[7]}; }
            { LAS float* dst = fV + slot * 64 + cg8; *(LAS f32x4*)dst = (f32x4){vv8[0], vv8[1], vv8[2], vv8[3]}; *(LAS f32x4*)(dst + 4) = (f32x4){vv8[4], vv8[5], vv8[6], vv8[7]}; }
            *(LAS u32x4*)(lds + SC_TW + slot * 144 + cg8 * 2) = raw[3][1];
            *(LAS u32x4*)(lds + SC_AD + slot * 144 + cg8 * 2) = raw[4][1];
        } else {
            const int i1 = 64 * c + slot; const int p1 = d ? Ltot - 1 - i1 : i1; const bool me1 = i1 < Ltot && p1 < 16; const float fm = me1 ? 1.0f : 0.0f;
#pragma unroll
            for (int a = 0; a < 5; ++a) {
                float pv[8], cv[8], nv[8], o[8]; unpack8(raw[a][0], pv); unpack8(raw[a][1], cv); unpack8(raw[a][2], nv);
                const f32x4 mp0 = *(const LAS f32x4*)(fMU + a * 64 + cg8), mp1 = *(const LAS f32x4*)(fMU + a * 64 + cg8 + 4), mn0 = *(const LAS f32x4*)(fMU + 320 + a * 64 + cg8), mn1 = *(const LAS f32x4*)(fMU + 320 + a * 64 + cg8 + 4);
#pragma unroll
                for (int e = 0; e < 8; ++e) { const float mp = fm * (e < 4 ? mp0[e & 3] : mp1[e & 3]), mn = fm * (e < 4 ? mn0[e & 3] : mn1[e & 3]); o[e] = cv[e] + mp * (pv[e] - cv[e]) + mn * (nv[e] - cv[e]); }
                if (a == 0) {
#pragma unroll
                    for (int e = 0; e < 8; ++e) rv[e] = o[e];
                    LAS float* dst = fS + SCI(slot, 4, cg8); *(LAS f32x4*)dst = (f32x4){o[0], o[1], o[2], o[3]}; *(LAS f32x4*)(dst + 4) = (f32x4){o[4], o[5], o[6], o[7]};
                } else if (a == 1) {
#pragma unroll
                    for (int e = 0; e < 8; ++e) kv[e] = o[e];
                } else if (a == 2) {
                    LAS float* dst = fV + slot * 64 + cg8; *(LAS f32x4*)dst = (f32x4){o[0], o[1], o[2], o[3]}; *(LAS f32x4*)(dst + 4) = (f32x4){o[4], o[5], o[6], o[7]};
                } else {
                    if (a == 3) {
#pragma unroll
                        for (int e = 0; e < 8; ++e) o[e] = me1 ? fast_tanh(o[e]) : o[e];
                    }
                    u32x4 w; w.x = cvtpk(o[0], o[1]); w.y = cvtpk(o[2], o[3]); w.z = cvtpk(o[4], o[5]); w.w = cvtpk(o[6], o[7]);
                    *(LAS u32x4*)(lds + (a == 3 ? SC_TW : SC_AD) + slot * 144 + cg8 * 2) = w;
                }
            }
        }
        BAR_LDS();
        if (c + 1 < nchunk) SC_LOAD(c + 1);
        {
            const LAS unsigned char* Ab = lds + (mat ? SC_AD : SC_TW); LAS float* fWB = fS + (mat ? 128 : 64);
#pragma unroll
            for (int mt = 0; mt < 4; ++mt) {
                const bf16x8 a0 = *(const LAS bf16x8*)(Ab + (mt * 16 + (lane & 15)) * 144 + (lane >> 4) * 16);
                const bf16x8 a1 = *(const LAS bf16x8*)(Ab + (mt * 16 + (lane & 15)) * 144 + 64 + (lane >> 4) * 16);
                f32x4 acc = {0.f, 0.f, 0.f, 0.f};
                acc = __builtin_amdgcn_mfma_f32_16x16x32_bf16(a0, bfr0, acc, 0, 0, 0);
                acc = __builtin_amdgcn_mfma_f32_16x16x32_bf16(a1, bfr1, acc, 0, 0, 0);
#pragma unroll
                for (int rg = 0; rg < 4; ++rg) {
                    const int sl = mt * 16 + (lane >> 4) * 4 + rg, col = ntile * 16 + (lane & 15);
                    const float sg = fast_sigmoid(acc[rg] + bias); const float dc = __builtin_amdgcn_exp2f(-0.6065306597126334f * LOG2E * sg);
                    fWB[sl * 320 + col] = mat ? sg : dc;
                }
            }
        }
        BAR_LDS();
        {
            const f32x4 a0 = *(const LAS f32x4*)(fS + SCI(slot, 2, cg8)), a1 = *(const LAS f32x4*)(fS + SCI(slot, 2, cg8 + 4));
            const f32x4 kk0 = *(const LAS f32x4*)(fMU + 640 + cg8), kk1 = *(const LAS f32x4*)(fMU + 640 + cg8 + 4), ka0 = *(const LAS f32x4*)(fMU + 704 + cg8), ka1 = *(const LAS f32x4*)(fMU + 704 + cg8 + 4);
            const f32x4 rk0 = *(const LAS f32x4*)(fMU + 768 + cg8), rk1 = *(const LAS f32x4*)(fMU + 768 + cg8 + 4);
            float kkv[8], kd[8], av[8]; float ssq = 0.f, cs = 0.f;
#pragma unroll
            for (int e = 0; e < 8; ++e) {
                av[e] = e < 4 ? a0[e & 3] : a1[e & 3];
                kkv[e] = kv[e] * (e < 4 ? kk0[e & 3] : kk1[e & 3]); ssq = fmaf(kkv[e], kkv[e], ssq);
                kd[e] = kv[e] * (1.0f + (av[e] - 1.0f) * (e < 4 ? ka0[e & 3] : ka1[e & 3])); cs = fmaf(rv[e] * kd[e], e < 4 ? rk0[e & 3] : rk1[e & 3], cs);
            }
            ssq = grp_sum<8>(ssq); cs = grp_sum<8>(cs);
            const float rs = rsqrtf(fmaxf(ssq, 1e-24f));
#pragma unroll
            for (int e = 0; e < 8; ++e) { kkv[e] *= rs; av[e] *= kkv[e]; }
            LAS float* o1 = fS + SCI(slot, 0, cg8); *(LAS f32x4*)o1 = (f32x4){kkv[0], kkv[1], kkv[2], kkv[3]}; *(LAS f32x4*)(o1 + 4) = (f32x4){kkv[4], kkv[5], kkv[6], kkv[7]};
            LAS float* o2 = fS + SCI(slot, 2, cg8); *(LAS f32x4*)o2 = (f32x4){av[0], av[1], av[2], av[3]}; *(LAS f32x4*)(o2 + 4) = (f32x4){av[4], av[5], av[6], av[7]};
            LAS float* o3 = fS + SCI(slot, 3, cg8); *(LAS f32x4*)o3 = (f32x4){kd[0], kd[1], kd[2], kd[3]}; *(LAS f32x4*)(o3 + 4) = (f32x4){kd[4], kd[5], kd[6], kd[7]};
            if (cg8 == 0 && rp == 0 && slot < nvalid) { const int i2 = 64 * c + slot; const int p2 = d ? Ltot - 1 - i2 : i2; CB[((size_t)d * ROWS + pos_row(base, p2)) * 8 + h] = cs; }
        }
        BAR_LDS();
#define SC_STORE_Y(cc_) do { const int t5_ = tid - 256; if (t5_ >= 0 && t5_ < 128) { const int sl5_ = t5_ >> 1, hf_ = t5_ & 1; const int i5_ = 64 * (cc_) + sl5_; const int p5_ = d ? Ltot - 1 - i5_ : i5_; \
            if (i5_ < Ltot && p5_ >= 16) { const LAS float* yp_ = fY + ((cc_) & 1) * 1024 + sl5_ * 16 + hf_ * 8; const f32x4 y0_ = *(const LAS f32x4*)yp_, y1_ = *(const LAS f32x4*)(yp_ + 4); \
                *(u32x4*)(YD + (size_t)(base + p5_ - 16) * 512 + h * 64 + rp * 16 + hf_ * 8) = pack8(y0_, y1_); } } } while (0)
        if (YDB && wid >= NSW && c > 0) SC_STORE_Y(c - 1);
        if (wid < NSW) {
            typedef float f32x2_ __attribute__((ext_vector_type(2)));
            constexpr int C4 = CPL / 4;
            const LAS float* ps = fS + kg * CPL; const LAS float* pv = fV + srow;
            LAS float* py = YDB ? fY + (c & 1) * 1024 + (srow - rp * RPB) : fY + srow;
            f32x4 nk[C4], nw[C4], nb[C4], nd[C4], nr[C4]; float nv;
#define SC_FETCH(sl_) do { _Pragma("unroll") for (int j_ = 0; j_ < C4; ++j_) { nk[j_] = *(const LAS f32x4*)(ps + (sl_) * 320 + 4 * j_); nw[j_] = *(const LAS f32x4*)(ps + (sl_) * 320 + 64 + 4 * j_); \
                nb[j_] = *(const LAS f32x4*)(ps + (sl_) * 320 + 128 + 4 * j_); nd[j_] = *(const LAS f32x4*)(ps + (sl_) * 320 + 192 + 4 * j_); nr[j_] = *(const LAS f32x4*)(ps + (sl_) * 320 + 256 + 4 * j_); } nv = pv[(sl_) * 64]; } while (0)
            SC_FETCH(0);
            f32x4 rp4[C4];
#pragma unroll
            for (int j = 0; j < C4; ++j) rp4[j] = (f32x4){0.f, 0.f, 0.f, 0.f};
#pragma unroll 16
            for (int sl = 0; sl < nvalid; ++sl) {
                f32x4 ck[C4], cw[C4], cb[C4], cd[C4], cr[C4];
#pragma unroll
                for (int j = 0; j < C4; ++j) { ck[j] = nk[j]; cw[j] = nw[j]; cb[j] = nb[j]; cd[j] = nd[j]; cr[j] = nr[j]; }
                const float vv = nv;
                SC_FETCH(sl + 1 < 64 ? sl + 1 : 63);
                f32x2_ pa = {0.f, 0.f}, ya = {0.f, 0.f};
#pragma unroll
                for (int j = 0; j < C4; ++j)
#pragma unroll
                    for (int e = 0; e < 4; e += 2) { const f32x2_ s2 = {S[4 * j + e], S[4 * j + e + 1]}, k2 = {ck[j][e], ck[j][e + 1]}, r2 = {rp4[j][e], rp4[j][e + 1]}; pa = pa + s2 * k2; ya = ya + s2 * r2; }
                float pp = pa.x + pa.y, yy = ya.x + ya.y;
                pp = dpp_add(pp, 0); yy = dpp_add(yy, 0); pp = dpp_add(pp, 1); yy = dpp_add(yy, 1); pp = dpp_add(pp, 2); yy = dpp_add(yy, 2);
                if (LPR == 16) { pp = dpp_add(pp, 3); yy = dpp_add(yy, 3); }
                py[(sl > 0 ? sl - 1 : 0) * YST] = yy;
#pragma unroll
                for (int j = 0; j < C4; ++j)
#pragma unroll
                    for (int e = 0; e < 4; e += 2) {
                        const f32x2_ b2 = {cb[j][e], cb[j][e + 1]}, d2 = {cd[j][e], cd[j][e + 1]}, w2 = {cw[j][e], cw[j][e + 1]}; f32x2_ s2 = {S[4 * j + e], S[4 * j + e + 1]};
                        const f32x2_ t2 = d2 * vv - b2 * pp; s2 = s2 * w2 + t2; S[4 * j + e] = s2.x; S[4 * j + e + 1] = s2.y; }
#pragma unroll
                for (int j = 0; j < C4; ++j) rp4[j] = cr[j];
            }
            {
                f32x2_ ya = {0.f, 0.f};
#pragma unroll
                for (int j = 0; j < C4; ++j)
#pragma unroll
                    for (int e = 0; e < 4; e += 2) { const f32x2_ s2 = {S[4 * j + e], S[4 * j + e + 1]}, r2 = {rp4[j][e], rp4[j][e + 1]}; ya = ya + s2 * r2; }
                const float yy = grp_sum<LPR>(ya.x + ya.y);
                py[(nvalid - 1) * YST] = yy;
            }
#undef SC_FETCH
        }
        BAR_LDS();
        {
            const int i2 = 64 * c + slot; const int p2 = d ? Ltot - 1 - i2 : i2;
            if (!YDB && slot < nvalid && p2 >= 16 && (cg8 / RPB) == rp) {
                const LAS float* yp = fY + slot * 64 + cg8; const f32x4 y0 = *(const LAS f32x4*)yp, y1 = *(const LAS f32x4*)(yp + 4);
                *(u32x4*)(YD + (size_t)(base + p2 - 16) * 512 + h * 64 + cg8) = pack8(y0, y1);
            }
        }
    }
    if (YDB) SC_STORE_Y(nchunk - 1);
#undef SC_STORE_Y
#undef SC_LOAD
#undef SC_META
#undef SCI
}

constexpr int SL_FV = 81920, SL_FY = 86016, SL_TW = 90112, SL_AD = 94720, SL_AS = 99328, SL_MU = 107520;
__device__ __forceinline__ void scan_long(LAS unsigned char* lds, KP P, int s, int d, int h, int rp) {
    int tid_ = threadIdx.x; asm volatile("" : "+v"(tid_));
    const int tid = tid_, lane = tid & 63, wid = __builtin_amdgcn_readfirstlane(tid >> 6);
    const int L = seq_len(s), base = seq_base(s), Ltot = L + 16, nhalf = (Ltot + 31) / 32;
    unsigned char* ws = P->ws;
    const bf16* Rb = (const bf16*)(ws + WS_R); const bf16* KAb = (const bf16*)(ws + WS_KA); const bf16* VAb = (const bf16*)(ws + WS_VA); const bf16* Lb = (const bf16*)(ws + WS_L);
    float* CB = (float*)(ws + WS_CB); bf16* YD = (bf16*)((unsigned char*)P->out + 64 * MiB) + (size_t)d * NMAIN * 512;
    LAS float* fS = (LAS float*)lds; LAS float* fV = (LAS float*)(lds + SL_FV); LAS float* fY = (LAS float*)(lds + SL_FY); LAS float* fAS = (LAS float*)(lds + SL_AS); LAS float* fMU = (LAS float*)(lds + SL_MU);
    for (int i = tid; i < 832; i += NTHREADS) {
        float v;
        if (i < 640) { const int which = i / 320, jj = i % 320, a = jj >> 6, c = jj & 63; const int gi = a < 3 ? a * 512 + h * 64 + c : 1536 + (a - 3) * 64 + c; v = P->in[which ? I_MUN : I_MUP][gi]; }
        else { const int a = (i - 640) >> 6, c = (i - 640) & 63; v = P->in[a == 0 ? I_KK : a == 1 ? I_KA : I_RK][h * 64 + c]; }
        fMU[i] = v;
    }
    const bool scanner = wid < 4; const int pw = wid & 3;
    const int sl8 = lane >> 3, cg8 = (lane & 7) * 8, slot = pw * 8 + sl8;
    const int rowl = lane >> 4, kg = lane & 15, srl = pw * 4 + rowl;
    const unsigned char* HALO0 = ws + WS_HALO + (size_t)(base >> 6) * 2 * HALO_ROW;
    u32x4 raw[5][3];
#define SL_META(hc) (d ? ((hc) == nhalf - 1) : ((hc) == 0))
#define SL_LOAD(hc) do { const int i_ = 32 * (hc) + slot; const bool ok_ = i_ < Ltot; const int p_ = d ? Ltot - 1 - i_ : i_; \
        const unsigned zr_ = (unsigned)(METAROW + 64); \
        if (!SL_META(hc)) { const unsigned rc_ = ok_ ? (unsigned)(base + p_ - 16) : zr_; \
            _Pragma("unroll") for (int a_ = 0; a_ < 5; ++a_) { const unsigned char* B_ = (const unsigned char*)(a_ == 0 ? Rb : a_ == 1 ? KAb : a_ == 2 ? VAb : Lb); const unsigned ld_ = a_ < 3 ? 1024u : 512u; \
                const unsigned co_ = (unsigned)(((a_ < 3 ? h * 64 : (a_ - 3) * 64) + cg8) * 2); raw[a_][1] = *(const u32x4*)(B_ + (rc_ * ld_ + co_)); } \
        } else { const bool me_ = ok_ && p_ < 16; const bool hn_ = me_ && p_ == 15; \
            const unsigned rc_ = ok_ ? (unsigned)pos_row(base, p_) : zr_, rp_ = (me_ && p_ > 0) ? (unsigned)(METAROW + p_ - 1) : zr_, rn_ = (me_ && p_ < 15) ? (unsigned)(METAROW + p_ + 1) : zr_; \
            _Pragma("unroll") for (int a_ = 0; a_ < 5; ++a_) { const unsigned char* B_ = (const unsigned char*)(a_ == 0 ? Rb : a_ == 1 ? KAb : a_ == 2 ? VAb : Lb); const unsigned ld_ = a_ < 3 ? 1024u : 512u; \
                const unsigned co_ = (unsigned)(((a_ < 3 ? h * 64 : (a_ - 3) * 64) + cg8) * 2); \
                const unsigned ho_ = (unsigned)(((a_ < 3 ? a_ * 512 + h * 64 : 1536 + (a_ - 3) * 64) + cg8) * 2); \
                raw[a_][0] = *(const u32x4*)(B_ + (rp_ * ld_ + co_)); raw[a_][1] = *(const u32x4*)(B_ + (rc_ * ld_ + co_)); \
                const unsigned char* np_ = hn_ ? HALO0 + ho_ : B_ + (rn_ * ld_ + co_); raw[a_][2] = *(const u32x4*)np_; } } } while (0)
    constexpr int SL_WB = 110848;
    for (int i = tid; i < 1024; i += NTHREADS) { const int m2 = i >> 9, n = (i >> 3) & 63, ch = i & 7;
        *(LAS u32x4*)(lds + SL_WB + m2 * 9216 + n * 144 + ch * 16) = *(const u32x4*)((const bf16*)(ws + WS_LORA + (m2 ? 131072 : 0)) + ((size_t)d * 512 + h * 64 + n) * 64 + ch * 8); }
    float bias[2][4];
#pragma unroll
    for (int mt_ = 0; mt_ < 2; ++mt_)
#pragma unroll
        for (int nt = 0; nt < 4; ++nt) bias[mt_][nt] = P->in[mt_ ? I_A0 : I_W0][d * 512 + h * 64 + nt * 16 + (lane & 15)];
    float S[4] = {0.f, 0.f, 0.f, 0.f};
#define SL_PREP(hc, buf) do { \
        const bool meta_ = SL_META(hc); const int i1_ = 32 * (hc) + slot; const int p1_ = d ? Ltot - 1 - i1_ : i1_; const bool ok1_ = i1_ < Ltot; \
        LAS float* fSb_ = fS + (buf) * 10240 + slot * 320; float rv[8], kv[8]; \
        if (!meta_) { float vv8[8]; unpack8(raw[0][1], rv); unpack8(raw[1][1], kv); unpack8(raw[2][1], vv8); \
            *(LAS f32x4*)(fSb_ + 256 + cg8) = (f32x4){rv[0], rv[1], rv[2], rv[3]}; *(LAS f32x4*)(fSb_ + 256 + cg8 + 4) = (f32x4){rv[4], rv[5], rv[6], rv[7]}; \
            if ((cg8 >> 4) == rp) { LAS float* dv_ = fV + (buf) * 512 + slot * 16 + (cg8 & 15); *(LAS f32x4*)dv_ = (f32x4){vv8[0], vv8[1], vv8[2], vv8[3]}; *(LAS f32x4*)(dv_ + 4) = (f32x4){vv8[4], vv8[5], vv8[6], vv8[7]}; } \
            *(LAS u32x4*)(lds + SL_TW + slot * 144 + cg8 * 2) = raw[3][1]; *(LAS u32x4*)(lds + SL_AD + slot * 144 + cg8 * 2) = raw[4][1]; \
        } else { const bool me1_ = ok1_ && p1_ < 16; const float fm_ = me1_ ? 1.0f : 0.0f; \
            _Pragma("unroll") for (int a = 0; a < 5; ++a) { \
                float pv_[8], cv_[8], nv_[8], o_[8]; unpack8(raw[a][0], pv_); unpack8(raw[a][1], cv_); unpack8(raw[a][2], nv_); \
                _Pragma("unroll") for (int e = 0; e < 8; ++e) { const float mp_ = fm_ * fMU[a * 64 + cg8 + e], mn_ = fm_ * fMU[320 + a * 64 + cg8 + e]; o_[e] = cv_[e] + mp_ * (pv_[e] - cv_[e]) + mn_ * (nv_[e] - cv_[e]); } \
                if (a == 0) { _Pragma("unroll") for (int e = 0; e < 8; ++e) rv[e] = o_[e]; \
                    *(LAS f32x4*)(fSb_ + 256 + cg8) = (f32x4){o_[0], o_[1], o_[2], o_[3]}; *(LAS f32x4*)(fSb_ + 256 + cg8 + 4) = (f32x4){o_[4], o_[5], o_[6], o_[7]}; } \
                else if (a == 1) { _Pragma("unroll") for (int e = 0; e < 8; ++e) kv[e] = o_[e]; } \
                else if (a == 2) { if ((cg8 >> 4) == rp) { LAS float* dv_ = fV + (buf) * 512 + slot * 16 + (cg8 & 15); *(LAS f32x4*)dv_ = (f32x4){o_[0], o_[1], o_[2], o_[3]}; *(LAS f32x4*)(dv_ + 4) = (f32x4){o_[4], o_[5], o_[6], o_[7]}; } } \
                else { if (a == 3) { _Pragma("unroll") for (int e = 0; e < 8; ++e) o_[e] = me1_ ? fast_tanh(o_[e]) : o_[e]; } \
                    u32x4 w_; w_.x = cvtpk(o_[0], o_[1]); w_.y = cvtpk(o_[2], o_[3]); w_.z = cvtpk(o_[4], o_[5]); w_.w = cvtpk(o_[6], o_[7]); \
                    *(LAS u32x4*)(lds + (a == 3 ? SL_TW : SL_AD) + slot * 144 + cg8 * 2) = w_; } } } \
        asm volatile("s_waitcnt lgkmcnt(0)" ::: "memory"); \
          \
        { f32x4 acc_[2][4]; \
          _Pragma("unroll") for (int m2 = 0; m2 < 2; ++m2) { const LAS unsigned char* Ab_ = lds + (m2 ? SL_AD : SL_TW) + (pw * 8 + (lane & 15)) * 144 + (lane >> 4) * 16; \
              const bf16x8 a0_ = *(const LAS bf16x8*)Ab_, a1_ = *(const LAS bf16x8*)(Ab_ + 64); \
              _Pragma("unroll") for (int nt = 0; nt < 4; ++nt) { f32x4 z_ = {0.f, 0.f, 0.f, 0.f}; const LAS unsigned char* Bb_ = lds + SL_WB + m2 * 9216 + (nt * 16 + (lane & 15)) * 144 + (lane >> 4) * 16; \
                  z_ = __builtin_amdgcn_mfma_f32_16x16x32_bf16(a0_, *(const LAS bf16x8*)Bb_, z_, 0, 0, 0); acc_[m2][nt] = __builtin_amdgcn_mfma_f32_16x16x32_bf16(a1_, *(const LAS bf16x8*)(Bb_ + 64), z_, 0, 0, 0); } } \
          if (lane < 32) { \
              _Pragma("unroll") for (int nt = 0; nt < 4; ++nt) _Pragma("unroll") for (int rg = 0; rg < 4; ++rg) { const int row_ = (lane >> 4) * 4 + rg, col_ = nt * 16 + (lane & 15); \
                  const float sw_ = fast_sigmoid(acc_[0][nt][rg] + bias[0][nt]); fS[(buf) * 10240 + (pw * 8 + row_) * 320 + 64 + col_] = __builtin_amdgcn_exp2f(-0.6065306597126334f * LOG2E * sw_); \
                  fAS[pw * 512 + row_ * 64 + col_] = fast_sigmoid(acc_[1][nt][rg] + bias[1][nt]); } } } \
        asm volatile("s_waitcnt lgkmcnt(0)" ::: "memory"); \
          \
        { const f32x4 a0 = *(const LAS f32x4*)(fAS + pw * 512 + sl8 * 64 + cg8), a1 = *(const LAS f32x4*)(fAS + pw * 512 + sl8 * 64 + cg8 + 4); \
          const f32x4 kk0 = *(const LAS f32x4*)(fMU + 640 + cg8), kk1 = *(const LAS f32x4*)(fMU + 640 + cg8 + 4), ka0 = *(const LAS f32x4*)(fMU + 704 + cg8), ka1 = *(const LAS f32x4*)(fMU + 704 + cg8 + 4); \
          const f32x4 rk0 = *(const LAS f32x4*)(fMU + 768 + cg8), rk1 = *(const LAS f32x4*)(fMU + 768 + cg8 + 4); \
          float kkv[8], kd[8], av[8]; float ssq = 0.f, cs = 0.f; \
          _Pragma("unroll") for (int e = 0; e < 8; ++e) { av[e] = e < 4 ? a0[e & 3] : a1[e & 3]; \
              kkv[e] = kv[e] * (e < 4 ? kk0[e & 3] : kk1[e & 3]); ssq = fmaf(kkv[e], kkv[e], ssq); \
              kd[e] = kv[e] * (1.0f + (av[e] - 1.0f) * (e < 4 ? ka0[e & 3] : ka1[e & 3])); cs = fmaf(rv[e] * kd[e], e < 4 ? rk0[e & 3] : rk1[e & 3], cs); } \
          ssq = grp_sum<8>(ssq); cs = grp_sum<8>(cs); \
          const float rs = rsqrtf(fmaxf(ssq, 1e-24f)); \
          _Pragma("unroll") for (int e = 0; e < 8; ++e) { kkv[e] *= rs; av[e] *= kkv[e]; } \
          *(LAS f32x4*)(fSb_ + cg8) = (f32x4){kkv[0], kkv[1], kkv[2], kkv[3]}; *(LAS f32x4*)(fSb_ + cg8 + 4) = (f32x4){kkv[4], kkv[5], kkv[6], kkv[7]}; \
          *(LAS f32x4*)(fSb_ + 128 + cg8) = (f32x4){av[0], av[1], av[2], av[3]}; *(LAS f32x4*)(fSb_ + 128 + cg8 + 4) = (f32x4){av[4], av[5], av[6], av[7]}; \
          *(LAS f32x4*)(fSb_ + 192 + cg8) = (f32x4){kd[0], kd[1], kd[2], kd[3]}; *(LAS f32x4*)(fSb_ + 192 + cg8 + 4) = (f32x4){kd[4], kd[5], kd[6], kd[7]}; \
          if (cg8 == 0 && rp == 0 && ok1_) CB[((size_t)d * ROWS + pos_row(base, p1_)) * 8 + h] = cs; } } while (0)
#define SL_STORE_Y(hc, buf) do { const int sl5_ = lane >> 1, hf_ = lane & 1; const int i5_ = 32 * (hc) + sl5_; const int p5_ = d ? Ltot - 1 - i5_ : i5_; \
        if (i5_ < Ltot && p5_ >= 16) { const LAS float* yp_ = fY + (buf) * 512 + sl5_ * 16 + hf_ * 8; const f32x4 y0_ = *(const LAS f32x4*)yp_, y1_ = *(const LAS f32x4*)(yp_ + 4); \
            *(u32x4*)(YD + (size_t)(base + p5_ - 16) * 512 + h * 64 + rp * 16 + hf_ * 8) = pack8(y0_, y1_); } } while (0)
    BAR_LDS();
    if (!scanner) { SL_LOAD(0); SL_PREP(0, 0); if (nhalf > 1) SL_LOAD(1); }
    BAR_LDS();
#pragma unroll 1
    for (int hc = 0; hc < nhalf; ++hc) {
        if (scanner) {
            typedef float f32x2_ __attribute__((ext_vector_type(2)));
            const int nvalid = (Ltot - 32 * hc) < 32 ? (Ltot - 32 * hc) : 32, buf = hc & 1;
            const LAS float* ps = fS + buf * 10240 + kg * 4; const LAS float* pv = fV + buf * 512 + srl; LAS float* py = fY + buf * 512 + srl;
            f32x4 nk, nw, nb, nd, nr; float nv;
#define SL_FETCH(sl_) do { nk = *(const LAS f32x4*)(ps + (sl_) * 320); nw = *(const LAS f32x4*)(ps + (sl_) * 320 + 64); nb = *(const LAS f32x4*)(ps + (sl_) * 320 + 128); \
                nd = *(const LAS f32x4*)(ps + (sl_) * 320 + 192); nr = *(const LAS f32x4*)(ps + (sl_) * 320 + 256); nv = pv[(sl_) * 16]; } while (0)
            SL_FETCH(0);
            f32x4 rp4 = {0.f, 0.f, 0.f, 0.f};
#pragma unroll 16
            for (int sl = 0; sl < nvalid; ++sl) {
                const f32x4 ck = nk, cw = nw, cb = nb, cd = nd, cr = nr; const float vv = nv;
                SL_FETCH(sl + 1 < 32 ? sl + 1 : 31);
                f32x2_ pa = {0.f, 0.f}, ya = {0.f, 0.f};
#pragma unroll
                for (int e = 0; e < 4; e += 2) { const f32x2_ s2 = {S[e], S[e + 1]}, k2 = {ck[e], ck[e + 1]}, r2 = {rp4[e], rp4[e + 1]}; pa = pa + s2 * k2; ya = ya + s2 * r2; }
                float pp = pa.x + pa.y, yy = ya.x + ya.y;
                pp = dpp_add(pp, 0); yy = dpp_add(yy, 0); pp = dpp_add(pp, 1); yy = dpp_add(yy, 1); pp = dpp_add(pp, 2); yy = dpp_add(yy, 2); pp = dpp_add(pp, 3); yy = dpp_add(yy, 3);
                py[(sl > 0 ? sl - 1 : 0) * 16] = yy;
#pragma unroll
                for (int e = 0; e < 4; e += 2) { const f32x2_ b2 = {cb[e], cb[e + 1]}, d2 = {cd[e], cd[e + 1]}, w2 = {cw[e], cw[e + 1]}; f32x2_ s2 = {S[e], S[e + 1]};
                    const f32x2_ t2 = d2 * vv - b2 * pp; s2 = s2 * w2 + t2; S[e] = s2.x; S[e + 1] = s2.y; }
                rp4 = cr;
            }
            { f32x2_ ya = {0.f, 0.f};
#pragma unroll
              for (int e = 0; e < 4; e += 2) { const f32x2_ s2 = {S[e], S[e + 1]}, r2 = {rp4[e], rp4[e + 1]}; ya = ya + s2 * r2; }
              const float yy = grp_sum<16>(ya.x + ya.y); py[(nvalid - 1) * 16] = yy; }
#undef SL_FETCH
        } else {
            if (hc > 0 && pw == 0) SL_STORE_Y(hc - 1, (hc - 1) & 1);
            if (hc + 1 < nhalf) { SL_PREP(hc + 1, (hc + 1) & 1); if (hc + 2 < nhalf) SL_LOAD(hc + 2); }
        }
        BAR_LDS();
    }
    if (!scanner && pw == 0) SL_STORE_Y(nhalf - 1, (nhalf - 1) & 1);
#undef SL_STORE_Y
#undef SL_PREP
#undef SL_LOAD
#undef SL_META
}

__device__ __forceinline__ void rwkv_colmap(unsigned char* ws, int c0, bf16*& buf, int& ld, int& col) {
    if (c0 < 512) { buf = (bf16*)(ws + WS_R); ld = 512; col = c0; }
    else if (c0 < 1024) { buf = (bf16*)(ws + WS_KA); ld = 512; col = c0 - 512; }
    else if (c0 < 1536) { buf = (bf16*)(ws + WS_VA); ld = 512; col = c0 - 1024; }
    else { buf = (bf16*)(ws + WS_L); ld = 256; col = c0 - 1536; }
}
__device__ __forceinline__ void phase_halo(KP P) {
    const int tid = fresh_tid(), lane = tid & 63, wid = tid >> 6; const int gw = blockIdx.x * 8 + wid, NGW = gridDim.x * 8;
    unsigned char* ws = P->ws;
    for (int r = gw; r < (NMAIN / 64) * 2; r += NGW) {
        const int m = (r >> 1) * 64 + ((r & 1) ? 63 : 0);
        for (int j = lane; j < 224; j += 64) { bf16* buf; int ld, col; rwkv_colmap(ws, j * 8, buf, ld, col);
            *(u32x4*)(ws + WS_HALO + (size_t)r * HALO_ROW + j * 16) = *(const u32x4*)(buf + (size_t)m * ld + col); }
    }
}
__device__ __forceinline__ void phase_shift(LAS unsigned char* lds, KP P) {
    const int tid = fresh_tid(), slot = tid >> 3, cg = tid & 7;
    unsigned char* ws = P->ws; const float* mup = P->in[I_MUP]; const float* mun = P->in[I_MUN];
    for (int tile = blockIdx.x; tile < NMAIN / 64; tile += gridDim.x) {
        const int m0 = tile * 64, m = m0 + slot;
        const int ks = m0 < 16384 ? tile : ((m0 - 16384) & 2047) >> 6; const bool first = ks == 0, last = ks == (m0 < 16384 ? 255 : 31);
#pragma unroll 1
        for (int pass = 0; pass < 4; ++pass) {
#pragma unroll
            for (int i = 0; i < 7; ++i) { const int j = cg + 8 * i; bf16* buf; int ld, col; rwkv_colmap(ws, (pass * 56 + j) * 8, buf, ld, col);
                *(LAS u32x4*)(lds + (slot * 56 + j) * 16) = *(const u32x4*)(buf + (size_t)m * ld + col); }
            __syncthreads();
#pragma unroll
            for (int i = 0; i < 7; ++i) {
                const int j = cg + 8 * i, c0 = (pass * 56 + j) * 8; bf16* buf; int ld, col; rwkv_colmap(ws, c0, buf, ld, col);
                const u32x4 z = {0u, 0u, 0u, 0u};
                const u32x4 cu = *(const LAS u32x4*)(lds + (slot * 56 + j) * 16);
                u32x4 pu, nu;
                if (slot > 0) pu = *(const LAS u32x4*)(lds + ((slot - 1) * 56 + j) * 16);
                else pu = first ? *(const u32x4*)(buf + (size_t)(METAROW + 15) * ld + col) : *(const u32x4*)(ws + WS_HALO + (size_t)((tile - 1) * 2 + 1) * HALO_ROW + c0 * 2);
                if (slot < 63) nu = *(const LAS u32x4*)(lds + ((slot + 1) * 56 + j) * 16);
                else nu = last ? z : *(const u32x4*)(ws + WS_HALO + (size_t)((tile + 1) * 2) * HALO_ROW + c0 * 2);
                float pv[8], cv[8], nv[8], o[8]; unpack8(pu, pv); unpack8(cu, cv); unpack8(nu, nv);
                const f32x4 mp0 = *(const f32x4*)(mup + c0), mp1 = *(const f32x4*)(mup + c0 + 4), mn0 = *(const f32x4*)(mun + c0), mn1 = *(const f32x4*)(mun + c0 + 4);
#pragma unroll
                for (int e = 0; e < 8; ++e) { const float mp = e < 4 ? mp0[e & 3] : mp1[e & 3], mn = e < 4 ? mn0[e & 3] : mn1[e & 3]; o[e] = cv[e] + mp * (pv[e] - cv[e]) + mn * (nv[e] - cv[e]); }
                if (c0 >= 1536 && c0 < 1600) {
#pragma unroll
                    for (int e = 0; e < 8; ++e) o[e] = fast_tanh(o[e]);
                }
                u32x4 w; w.x = cvtpk(o[0], o[1]); w.y = cvtpk(o[2], o[3]); w.z = cvtpk(o[4], o[5]); w.w = cvtpk(o[6], o[7]);
                *(u32x4*)(buf + (size_t)m * ld + col) = w;
            }
            __syncthreads();
        }
    }
}

__device__ __forceinline__ void phase_post(LAS unsigned char* lds, KP P) {
    const int tid = fresh_tid(), lane = tid & 63, wid = tid >> 6;
    unsigned char* ws = P->ws;
    const bf16* VAb = (const bf16*)(ws + WS_VA); const bf16* Lb = (const bf16*)(ws + WS_L); bf16* Rb = (bf16*)(ws + WS_R);
    const float* CB = (const float*)(ws + WS_CB); const bf16* YD0 = (const bf16*)((const unsigned char*)P->out + 64 * MiB); const bf16* YD1 = YD0 + (size_t)NMAIN * 512;
    const bf16* GT = (const bf16*)(ws + WS_LORA + 262144);
    LAS float* st = (LAS float*)(lds + 17408);
    const float* mup = P->in[I_MUP]; const float* mun = P->in[I_MUN];
    for (int tile = blockIdx.x; tile < NMAIN / 64; tile += gridDim.x) {
        {
            const int row = tid >> 3, hh = tid & 7, m = tile * 64 + row;
            const int t = m < 16384 ? m : (m - 16384) & 2047, Ls = m < 16384 ? 16384 : 2048;
            float sum = 0.f, sq = 0.f;
#pragma unroll
            for (int i = 0; i < 8; ++i) { float a[8], b[8]; unpack8(*(const u32x4*)(YD0 + (size_t)m * 512 + hh * 64 + i * 8), a); unpack8(*(const u32x4*)(YD1 + (size_t)m * 512 + hh * 64 + i * 8), b);
#pragma unroll
                for (int e = 0; e < 8; ++e) { const float y = a[e] + b[e]; sum += y; sq += y * y; } }
            const float mu = sum * (1.0f / 64.0f); const float var = fmaxf(sq * (1.0f / 64.0f) - mu * mu, 0.f);
            st[(row * 8 + hh) * 2] = mu; st[(row * 8 + hh) * 2 + 1] = rsqrtf(var + 64e-5f);
#pragma unroll
            for (int i = 0; i < 2; ++i) {
                const int c0 = 128 + hh * 16 + i * 8; float cv[8], o[8];
                unpack8(*(const u32x4*)(Lb + (size_t)m * 256 + c0), cv);
#pragma unroll
                for (int e = 0; e < 8; ++e) o[e] = sigmoidf_(cv[e]);
                u32x4 w; w.x = cvtpk(o[0], o[1]); w.y = cvtpk(o[2], o[3]); w.z = cvtpk(o[4], o[5]); w.w = cvtpk(o[6], o[7]);
                *(LAS u32x4*)(lds + row * 272 + (hh * 16 + i * 8) * 2) = w;
            }
        }
        __syncthreads();
#pragma unroll 1
        for (int nt = 0; nt < 4; ++nt) {
            const int col = wid * 64 + nt * 16 + (lane & 15);
            bf16x8 bfr[4];
#pragma unroll
            for (int ks = 0; ks < 4; ++ks) bfr[ks] = *(const bf16x8*)(GT + (size_t)col * 128 + ks * 32 + (lane >> 4) * 8);
            const float lw = P->in[I_LNW][col], lb = P->in[I_LNB][col];
            const float mpv = mup[1024 + col], mnv = mun[1024 + col];
#pragma unroll 1
            for (int mt = 0; mt < 4; ++mt) {
                f32x4 acc = {0.f, 0.f, 0.f, 0.f};
#pragma unroll
                for (int ks = 0; ks < 4; ++ks) { const bf16x8 a = *(const LAS bf16x8*)(lds + (mt * 16 + (lane & 15)) * 272 + ks * 64 + (lane >> 4) * 16); acc = __builtin_amdgcn_mfma_f32_16x16x32_bf16(a, bfr[ks], acc, 0, 0, 0); }
#pragma unroll
                for (int rg = 0; rg < 4; ++rg) {
                    const int row = mt * 16 + (lane >> 4) * 4 + rg, m = tile * 64 + row;
                    const int t = m < 16384 ? m : (m - 16384) & 2047, Ls = m < 16384 ? 16384 : 2048;
                    const float y = bf2f(YD0[(size_t)m * 512 + col]) + bf2f(YD1[(size_t)m * 512 + col]);
                    const float yn = (y - st[(row * 8 + wid) * 2]) * st[(row * 8 + wid) * 2 + 1] * lw + lb;
                    const float vs = bf2f(VAb[(size_t)m * 512 + col]);
                    const float cb = CB[(size_t)m * 8 + wid] + CB[((size_t)ROWS + m) * 8 + wid];
                    Rb[(size_t)m * 512 + col] = (bf16)f2bf_rne((yn + cb * vs) * acc[rg]);
                }
            }
        }
        __syncthreads();
    }
}

__device__ __forceinline__ void phase_rms_bf16(KP P) {
    const int tid = fresh_tid(), lane = tid & 63, wid = tid >> 6; const int gw = blockIdx.x * 8 + wid, NGW = gridDim.x * 8;
    bf16* MN = (bf16*)(P->ws + WS_MN);
    for (int m = gw; m < NMAIN; m += NGW) rms_row_bf16(P->out + (size_t)m * DM, P->in[I_GFFN], MN + (size_t)m * DM, lane);
}
__device__ __forceinline__ void phase_final(KP P) {
    const int tid = fresh_tid(), lane = tid & 63, wid = tid >> 6; const int gw = blockIdx.x * 8 + wid, NGW = gridDim.x * 8;
    const f32x4* gr = (const f32x4*)P->in[I_GFIN] + lane;
    for (int m = gw; m < NMAIN; m += NGW) {
        f32x4* xr = (f32x4*)(P->out + (size_t)m * DM) + lane; f32x4 v[4]; float s = 0.f;
#pragma unroll
        for (int j = 0; j < 4; ++j) { v[j] = xr[64 * j]; s += (v[j].x * v[j].x + v[j].y * v[j].y) + (v[j].z * v[j].z + v[j].w * v[j].w); }
        const float rstd = rsqrtf(wave_sum(s) * (1.f / DM) + 1e-6f);
#pragma unroll
        for (int j = 0; j < 4; ++j) xr[64 * j] = v[j] * rstd * gr[64 * j];
    }
}

constexpr int NRP_LONG = 4;
constexpr int N_LONG = 16 * NRP_LONG, N_ATT_P = 512, N_ATT_S = 512, N_SHORT = 128, N_ITEMS = N_LONG + N_ATT_P + N_ATT_S + N_SHORT;

template <class Op> __device__ __forceinline__ void run_gemm(LAS unsigned char* lds, const bf16* A, const bf16* Bt, int M, int N, int K, const Op& op, const bf16* A2 = nullptr, int pm2 = 1 << 30) {
    pg8::Gemm g{A, Bt, M, N, K, A2, pm2}; pg8::StaticOrder S; S.init(M, N, (int)gridDim.x, (int)blockIdx.x);
    Epi8<Op> E{op};
    pg8::gemm_phase<Epi8<Op>, pg8::StaticOrder, true, true>(lds, g, S, E);
}

constexpr size_t WS_XBAR = 16384;
#define XB_TMO      128
#define XB_XCNT(j)  (256  + 64 * (j))
#define XB_XSUB(j)  (1280 + 64 * (j))
#define XB_XGEN(j)  (2304 + 64 * (j))
#define XB_TOP      3328
#define XB_TOPGEN   3392
#define XCD_BAR_WORDS 3456
#define XB_SPIN_CAP (1u << 18)
__device__ __forceinline__ unsigned xb_ld(unsigned* p)              { return __hip_atomic_load(p, __ATOMIC_RELAXED, __HIP_MEMORY_SCOPE_AGENT); }
__device__ __forceinline__ unsigned xb_add(unsigned* p, unsigned v) { return __hip_atomic_fetch_add(p, v, __ATOMIC_RELAXED, __HIP_MEMORY_SCOPE_AGENT); }
__device__ __forceinline__ unsigned xb_xcc_id() { return (unsigned)__builtin_amdgcn_s_getreg((3 << 11) | 20) & 0xFu; }
#define XB_SPIN(cond, bar) do { unsigned _sp = 0; while (cond) { __builtin_amdgcn_s_sleep(1); \
    if ((++_sp & 255u) == 0u) { if (xb_ld(&(bar)[XB_TMO])) break; if (_sp > XB_SPIN_CAP) { atomicAdd(&(bar)[XB_TMO], 1u); break; } } } } while (0)
struct XcdBarrier { unsigned* bar; unsigned x; volatile LAS unsigned* st; };
__device__ __forceinline__ XcdBarrier xcd_barrier_post(unsigned* bar, volatile LAS unsigned* st) {
    XcdBarrier b; b.bar = bar; b.x = xb_xcc_id(); b.st = st;
    if (threadIdx.x == 0) (void)xb_add(&bar[XB_XCNT(b.x)], 1u);
    return b;
}
__device__ __forceinline__ void xcd_barrier_complete(unsigned* bar, unsigned x, unsigned& nloc, unsigned& nx) {
    const unsigned G = gridDim.x * gridDim.y * gridDim.z;
    unsigned sum, cnt, mine, sp = 0u;
    for (;;) {
        sum = 0u; cnt = 0u; mine = 0u;
#pragma unroll
        for (unsigned j = 0; j < 16; ++j) { const unsigned c = xb_ld(&bar[XB_XCNT(j)]); sum += c; cnt += (c > 0u) ? 1u : 0u; mine = (j == x) ? c : mine; }
        if (sum == G) break;
        __builtin_amdgcn_s_sleep(1);
        if ((++sp & 255u) == 0u) { if (xb_ld(&bar[XB_TMO])) break; if (sp > XB_SPIN_CAP) { atomicAdd(&bar[XB_TMO], 1u); break; } }
    }
    nloc = mine > 0u ? mine : 1u; nx = cnt > 0u ? cnt : 1u;
}
__device__ __forceinline__ void xcd_barrier(const XcdBarrier& b) {
    asm volatile("s_waitcnt vmcnt(0)" ::: "memory");
    __syncthreads();
    if (threadIdx.x == 0) {
        unsigned* bar = b.bar;
        __builtin_amdgcn_s_waitcnt(0);
        unsigned nloc = b.st[0], nx = b.st[1];
        if (nloc == 0u) { xcd_barrier_complete(bar, b.x, nloc, nx); b.st[0] = nloc; b.st[1] = nx; }
        const unsigned old = xb_add(&bar[XB_XSUB(b.x)], 1u);
        const unsigned gen = old / nloc;
        if (old + 1u == (gen + 1u) * nloc) {
            __builtin_amdgcn_fence(__ATOMIC_RELEASE, "agent");
            asm volatile("s_waitcnt vmcnt(0)" ::: "memory");
            const unsigned og = xb_add(&bar[XB_TOP], 1u);
            const unsigned tg = og / nx;
            if (og + 1u == (tg + 1u) * nx) xb_add(&bar[XB_TOPGEN], 1u);
            else XB_SPIN(xb_ld(&bar[XB_TOPGEN]) == tg, bar);
            __builtin_amdgcn_fence(__ATOMIC_ACQUIRE, "agent");
            xb_add(&bar[XB_XGEN(b.x)], 1u);
            asm volatile("s_waitcnt vmcnt(0)" ::: "memory");
        } else {
            XB_SPIN(xb_ld(&bar[XB_XGEN(b.x)]) == gen, bar);
            __builtin_amdgcn_fence(__ATOMIC_ACQUIRE, "agent");
            asm volatile("s_waitcnt vmcnt(0)" ::: "memory");
        }
    }
    __syncthreads();
}
#ifndef PROBE_MASK
#define PROBE_MASK 0
#endif
#ifndef PROBE_MUL
#define PROBE_MUL 1
#endif
#define PH_BEGIN(k) unsigned long long t0_##k = 0; if (PROBE_MASK & (1 << (k))) t0_##k = __builtin_amdgcn_s_memrealtime();
#define PH_END(k) if (PROBE_MASK & (1 << (k))) { const unsigned long long t1_ = __builtin_amdgcn_s_memrealtime(); const unsigned long long dt_ = (t1_ - t0_##k) * PROBE_MUL; while (__builtin_amdgcn_s_memrealtime() - t1_ < dt_) __builtin_amdgcn_s_sleep(8); xcd_barrier(xbar); }
__global__ void __launch_bounds__(NTHREADS) fwd_megakernel(Params Pin) {
    extern __shared__ __attribute__((aligned(16))) unsigned char lds_raw[];
    LAS unsigned char* lds = (LAS unsigned char*)lds_raw;
    cg::grid_group grid = cg::this_grid();
    KP P0 = (KP)__builtin_amdgcn_kernarg_segment_ptr();
    volatile LAS unsigned* xst = (volatile LAS unsigned*)(lds + LDS_ITEM_OFF + 4);
    if (threadIdx.x == 0) { xst[0] = 0u; xst[1] = 0u; }
    __syncthreads();
    const XcdBarrier xbar = xcd_barrier_post((unsigned*)(P0->ws + WS_XBAR), xst);
#define NEWPHASE KP P = P0; asm volatile("" : "+s"(P)); unsigned char* ws = P->ws; (void)ws;

    PH_BEGIN(0)
    { NEWPHASE phase_prologue(lds, P); }
    grid.sync();
    PH_END(0)
    PH_BEGIN(1)
    { NEWPHASE run_gemm(lds, (const bf16*)P->out, (const bf16*)(ws + WS_WIN), ROWS, 3328, 1024, OpProj{ws}, (const bf16*)(ws + WS_XNMETA), 128); }
    xcd_barrier(xbar);
    PH_END(1)
    { NEWPHASE phase_halo(P); }
    xcd_barrier(xbar);
    { NEWPHASE phase_shift(lds, P); }
    xcd_barrier(xbar);
    PH_BEGIN(2)
    { NEWPHASE
        const int tid = fresh_tid();
        float lam;
        { const int lane = tid & 63; const float s1 = wave_sum(P->in[I_LQ1][lane] * P->in[I_LK1][lane]), s2 = wave_sum(P->in[I_LQ2][lane] * P->in[I_LK2][lane]); lam = __expf(s1) - __expf(s2) + 0.2f; }
        unsigned* ctr = (unsigned*)(ws + WS_CTL);
        LAS unsigned* slot = (LAS unsigned*)(lds + LDS_ITEM_OFF);
#define FETCH(k, n) if (tid == 0) *slot = atomicAdd(ctr + 64 * (k), 1u); __syncthreads(); const int idx = (int)*slot; __syncthreads(); if (idx >= (n)) break;
#ifndef NO_SCAN
#pragma unroll 1
        for (;;) { FETCH(0, N_LONG) const int u = idx / NRP_LONG; scan_long(lds, P, 0, u >> 3, u & 7, idx % NRP_LONG); }
#endif
#ifndef NO_ATTN
#pragma unroll 1
        for (;;) { FETCH(1, N_ATT_P + N_ATT_S)
            if (idx < N_ATT_P) attn_unit(lds, P, 0, idx >> 7, idx & 127, lam);
            else { const int a = idx - N_ATT_P; attn_unit(lds, P, 1 + (a >> 6), (a >> 4) & 3, a & 15, lam); } }
#endif
#ifndef NO_SCAN
#pragma unroll 1
        for (;;) { FETCH(2, N_SHORT) scan_unit<1, 8>(lds, P, 1 + (idx >> 4), (idx >> 3) & 1, idx & 7, 0); }
#endif
#undef FETCH
    }
    xcd_barrier(xbar);
    PH_END(2)
#ifndef NO_POST
    PH_BEGIN(3)
    { NEWPHASE phase_post(lds, P); }
#endif
    xcd_barrier(xbar);
    PH_END(3)
    PH_BEGIN(4)
    { NEWPHASE run_gemm(lds, (const bf16*)P->out, (const bf16*)(ws + WS_WIN) + (size_t)3328 * 1024, NMAIN, 1024, 1024, OpGate{(bf16*)(ws + WS_GA)}); }
    { NEWPHASE run_gemm(lds, (const bf16*)P->out, (const bf16*)(ws + WS_WIN) + (size_t)4352 * 1024, NMAIN, 1024, 1024, OpGate{(bf16*)(ws + WS_GB)}); }

    PH_END(4)
    PH_BEGIN(5)
    { NEWPHASE run_gemm(lds, (const bf16*)(ws + WS_R), (const bf16*)(ws + WS_WUPA), NMAIN, 1024, 512, OpUpA{ws}); }
    PH_END(5)
    PH_BEGIN(6)
    { NEWPHASE run_gemm(lds, (const bf16*)(ws + WS_Q), (const bf16*)(ws + WS_WUPB), NMAIN, 1024, 512, OpUpB{ws}); }
    xcd_barrier(xbar);
    PH_END(6)
    PH_BEGIN(7)
    { NEWPHASE run_gemm(lds, (const bf16*)(ws + WS_GB), (const bf16*)(ws + WS_WOUT), NMAIN, 1024, 1024, OpOut{P->in[I_XP], P->in[I_XS], P->out, P->in[I_GFFN], (bf16*)(ws + WS_MN), (float*)(ws + WS_SS)}); }
    xcd_barrier(xbar);
    PH_END(7)
    PH_BEGIN(9)
    { NEWPHASE run_gemm(lds, (const bf16*)(ws + WS_MN), (const bf16*)(ws + WS_WFF1), 16384, DFF, 1024, OpFF1{(bf16*)(ws + WS_HID), (const float*)(ws + WS_SS)}); }
    xcd_barrier(xbar);
    PH_END(9)
    PH_BEGIN(10)
    { NEWPHASE run_gemm(lds, (const bf16*)(ws + WS_HID), (const bf16*)(ws + WS_WFF2), 16384, 1024, DFF, OpFF2{P->out}); }
    xcd_barrier(xbar);
    PH_END(10)
    PH_BEGIN(11)
    { NEWPHASE run_gemm(lds, (const bf16*)(ws + WS_MN) + (size_t)16384 * DM, (const bf16*)(ws + WS_WFF1), 16384, DFF, 1024, OpFF1{(bf16*)(ws + WS_HID), (const float*)(ws + WS_SS) + 16384}); }
    xcd_barrier(xbar);
    PH_END(11)
    PH_BEGIN(12)
    { NEWPHASE run_gemm(lds, (const bf16*)(ws + WS_HID), (const bf16*)(ws + WS_WFF2), 16384, 1024, DFF, OpFF2{P->out + (size_t)16384 * DM}); }
    xcd_barrier(xbar);
    PH_END(12)
    PH_BEGIN(13)
    { NEWPHASE phase_final(P); }
}

extern "C" void kernel_launch(void* const* d_in, const int* in_sizes, int n_in, void* d_out, int out_size, void* d_ws, size_t ws_size, hipStream_t stream) {
    static int grid_blocks = 0;
    if (grid_blocks == 0) {
        int dev = 0, cus = 0, per_cu = 0;
        hipGetDevice(&dev);
        hipDeviceGetAttribute(&cus, hipDeviceAttributeMultiprocessorCount, dev);
        hipFuncSetAttribute((const void*)fwd_megakernel, hipFuncAttributeMaxDynamicSharedMemorySize, LDS_BYTES);
        hipOccupancyMaxActiveBlocksPerMultiprocessor(&per_cu, (const void*)fwd_megakernel, NTHREADS, LDS_BYTES);
        if (per_cu < 1) { fprintf(stderr, "kernel_launch: occupancy query says %d blocks per CU\n", per_cu); per_cu = 1; }
        grid_blocks = cus * per_cu;
        if (n_in != 29 || ws_size < WS_END) fprintf(stderr, "kernel_launch: unexpected n_in %d / ws_size %zu\n", n_in, ws_size);
    }
    hipMemsetAsync((unsigned char*)d_ws + WS_CTL, 0, 196608, stream);
    Params p{};
    for (int i = 0; i < 29; ++i) p.in[i] = (const float*)d_in[i];
    p.out = (float*)d_out; p.ws = (unsigned char*)d_ws;
    void* args[] = {&p};
    hipError_t e = hipLaunchCooperativeKernel((const void*)fwd_megakernel, dim3(grid_blocks), dim3(NTHREADS), args, LDS_BYTES, stream);
    if (e != hipSuccess) fprintf(stderr, "cooperative launch failed: %s (grid %d)\n", hipGetErrorString(e), grid_blocks);
}
```

```cpp
#include <hip/hip_runtime.h>
#include <hip/hip_cooperative_groups.h>
#include <cstdio>
#include <cstdint>
#include <cmath>
namespace cg = cooperative_groups;
__device__ __forceinline__ int fresh_tid() { int t = threadIdx.x; asm volatile("" : "+v"(t)); return t; }
namespace pg8 {
#define PG8_LAS __attribute__((address_space(3)))
typedef unsigned short bf16_t;
typedef short bf16x8 __attribute__((ext_vector_type(8)));
typedef float f32x4 __attribute__((ext_vector_type(4)));
typedef unsigned u32x4 __attribute__((ext_vector_type(4)));
constexpr int BM = 256, BK = 64, HALF = 128, HTB = HALF * BK * 2  , STAGE_BYTES = 8 * HTB, NXCD = 8, WGM = 8;

__host__ __device__ __forceinline__ int lds_byte(int r, int c) { const int st = (r >> 4) * 2 + (c >> 5), rr = r & 15, cc = c & 31, ob = rr * 64 + cc * 2; return st * 1024 + (ob ^ (((ob >> 9) & 1) << 5)); }
__host__ __device__ __forceinline__ void stage_rc(int b, int& R, int& C) { const int st = b / 1024, sb = b % 1024, swz = sb ^ (((sb >> 9) & 1) << 5); R = (st >> 1) * 16 + swz / 64; C = (st & 1) * 32 + (swz % 64) / 2; }
__host__ __device__ __forceinline__ int perm32(int rho) { const int n = rho >> 4, i = rho & 15; return 8 * (i >> 2) + 4 * n + (i & 3); }

struct Unit { int pm, pn; };
struct Gemm { const bf16_t* A; const bf16_t* Bt; int M, N, K; const bf16_t* A2; int pm2; };
__device__ __forceinline__ const char* gemm_abase(const Gemm& g, int pm, size_t tstep) { return pm >= g.pm2 ? (const char*)g.A2 + (size_t)(pm - g.pm2) * tstep : (const char*)g.A + (size_t)pm * tstep; }

struct StaticOrder {
    int nM, nN, nwg, G, c;
    __host__ __device__ void init(int M, int N, int G_, int c_) { nM = M / BM; nN = N / BM; nwg = nM * nN; G = G_; c = c_; }
    __host__ __device__ bool next(int i, Unit& u) const {
        const long L = (long)i * G + c; if (L >= nwg) return false;
        int wgid = (int)L; { const int q = nwg / NXCD, r = nwg % NXCD, xcd = wgid % NXCD, off = wgid / NXCD; wgid = (xcd < r ? xcd * (q + 1) : r * (q + 1) + (xcd - r) * q) + off; }
        const int nig = WGM * nN, gid = wgid / nig, fm = gid * WGM, gsz = (nM - fm) < WGM ? (nM - fm) : WGM;
        u.pm = fm + ((wgid % nig) % gsz); u.pn = (wgid % nig) / gsz; return true;
    }
    __device__ __forceinline__ void a_ready(const Unit&) const {}
    __device__ __forceinline__ void done(const Unit&) const {}
};


template <class Epi, class Sched, bool ALIGN_EPI = false, bool SP2 = false>
__device__ __forceinline__ void gemm_phase(PG8_LAS unsigned char* lds, const Gemm g, const Sched& S, const Epi& E) {
    const int tid = fresh_tid(), wid = __builtin_amdgcn_readfirstlane(tid >> 6), lane = tid & 63, wr = wid >> 2, wc = wid & 3, fr = lane & 15, fq = lane >> 4;
    const int K = g.K, nt = K / BK;
    unsigned voffA[2], voffB[2];
#pragma unroll
    for (int i = 0; i < 2; ++i) { int R, C; stage_rc(tid * 16 + i * 8192, R, C); const int Rb = Epi::PERM ? ((R & ~31) + perm32(R & 31)) : R;
        voffA[i] = (unsigned)(R * K + C) * 2u; voffB[i] = (unsigned)(Rb * K + C) * 2u; }
    const size_t kstep = (size_t)(BK * 2);
    const size_t hstep = (size_t)HALF * K * 2;
    const size_t tstep = 2 * hstep;
    const unsigned ldsw = (unsigned)wid * 1024u;
    const int aoff = lds_byte(wr * 64 + fr, fq * 8), boff = lds_byte(wc * 32 + fr, fq * 8);
#define PG8_SA(b, h) (((b) * 2 + (h)) * HTB)
#define PG8_SB(b, h) ((4 + (b) * 2 + (h)) * HTB)
#define PG8_STAGE(bufoff, gbase, voff) do { _Pragma("unroll") for (int _i = 0; _i < 2; ++_i) \
        __builtin_amdgcn_global_load_lds((const unsigned*)((const char*)(gbase) + (voff)[_i]), (PG8_LAS unsigned*)(lds + (bufoff) + ldsw + _i * 8192), 16, 0, 0); } while (0)
#define PG8_LDA(dst, b, h) do { _Pragma("unroll") for (int m = 0; m < 4; ++m) _Pragma("unroll") for (int k = 0; k < 2; ++k) dst[m][k] = *(const PG8_LAS bf16x8*)(lds + PG8_SA(b, h) + aoff + m * 2048 + k * 1024); } while (0)
#define PG8_LDB(dst, b, h) do { _Pragma("unroll") for (int n = 0; n < 2; ++n) _Pragma("unroll") for (int k = 0; k < 2; ++k) dst[n][k] = *(const PG8_LAS bf16x8*)(lds + PG8_SB(b, h) + boff + n * 2048 + k * 1024); } while (0)
#define PG8_MMA(ai, bj, At, Bt) do { __builtin_amdgcn_s_setprio(1); _Pragma("unroll") for (int m = 0; m < 4; ++m) _Pragma("unroll") for (int n = 0; n < 2; ++n) _Pragma("unroll") for (int k = 0; k < 2; ++k) \
        acc[ai][bj][m][n] = __builtin_amdgcn_mfma_f32_16x16x32_bf16(Bt[n][k], At[m][k], acc[ai][bj][m][n], 0, 0, 0); __builtin_amdgcn_s_setprio(0); } while (0)
#define PG8_WAIT_V(n) asm volatile("s_waitcnt vmcnt(" #n ")" ::: "memory")
#define PG8_WAIT_L(n) asm volatile("s_waitcnt lgkmcnt(" #n ")" ::: "memory")
#define PG8_BAR __builtin_amdgcn_s_barrier()
#define PG8_SCHED __builtin_amdgcn_sched_barrier(0)
    Unit cur, nxt; int ui = 0;
    if (!S.next(0, cur)) return;
    f32x4 acc[2][2][4][2];
#pragma unroll
    for (int a = 0; a < 2; ++a)
#pragma unroll
        for (int b = 0; b < 2; ++b)
#pragma unroll
            for (int m = 0; m < 4; ++m)
#pragma unroll
                for (int n = 0; n < 2; ++n) acc[a][b][m][n] = (f32x4){0.f, 0.f, 0.f, 0.f};
    bf16x8 At[4][2], B0[2][2], B1[2][2];
    const char* cA = gemm_abase(g, cur.pm, tstep); const char* cB = (const char*)g.Bt + (size_t)cur.pn * tstep;
    S.a_ready(cur);
    if constexpr (SP2) {
        PG8_STAGE(PG8_SB(0, 0), cB, voffB); PG8_STAGE(PG8_SB(0, 1), cB + hstep, voffB); PG8_STAGE(PG8_SA(0, 0), cA, voffA); PG8_STAGE(PG8_SA(0, 1), cA + hstep, voffA);
        if (wr == 1) PG8_BAR;
        PG8_WAIT_V(2); PG8_BAR;
        PG8_STAGE(PG8_SB(1, 0), cB + kstep, voffB); PG8_STAGE(PG8_SA(1, 0), cA + kstep, voffA); PG8_STAGE(PG8_SB(1, 1), cB + hstep + kstep, voffB);
        PG8_WAIT_V(6); PG8_BAR;
    } else {
        PG8_STAGE(PG8_SB(0, 0), cB, voffB); PG8_STAGE(PG8_SA(0, 0), cA, voffA); PG8_STAGE(PG8_SB(0, 1), cB + hstep, voffB); PG8_STAGE(PG8_SA(0, 1), cA + hstep, voffA);
        if (wr == 1) PG8_BAR;
        PG8_WAIT_V(4); PG8_BAR;
        PG8_STAGE(PG8_SB(1, 0), cB + kstep, voffB); PG8_STAGE(PG8_SA(1, 0), cA + kstep, voffA); PG8_STAGE(PG8_SB(1, 1), cB + hstep + kstep, voffB);
        PG8_WAIT_V(6); PG8_BAR;
    }
    for (;;) {
        const bool has_next = S.next(ui + 1, nxt);
        const char* nA = has_next ? gemm_abase(g, nxt.pm, tstep) : cA; const char* nB = has_next ? (const char*)g.Bt + (size_t)nxt.pn * tstep : cB;
        for (int t = 0; t < nt; t += 2) {
            const bool last = (t == nt - 2);
            const char* a1 = cA + (size_t)(t + 1) * kstep;
            const char* a2 = last ? nA : cA + (size_t)(t + 2) * kstep; const char* b2 = last ? nB : cB + (size_t)(t + 2) * kstep;
            const char* a3 = a2 + kstep; const char* b3 = b2 + kstep;
            if (last && has_next) S.a_ready(nxt);
            if constexpr (SP2) {
            PG8_LDB(B0, 0, 0); PG8_LDB(B1, 0, 1); PG8_SCHED; PG8_LDA(At, 0, 0); PG8_STAGE(PG8_SA(1, 1), a1 + hstep, voffA);
            PG8_WAIT_V(8); PG8_WAIT_L(0); PG8_BAR; PG8_MMA(0, 0, At, B0); PG8_MMA(0, 1, At, B1); PG8_BAR; PG8_SCHED;
            PG8_LDA(At, 0, 1); PG8_STAGE(PG8_SB(0, 0), b2, voffB); PG8_STAGE(PG8_SB(0, 1), b2 + hstep, voffB); PG8_STAGE(PG8_SA(0, 0), a2, voffA);
            PG8_WAIT_V(8); PG8_WAIT_L(0); PG8_BAR; PG8_MMA(1, 0, At, B0); PG8_MMA(1, 1, At, B1); PG8_BAR; PG8_SCHED;
            PG8_LDB(B0, 1, 0); PG8_LDB(B1, 1, 1); PG8_SCHED; PG8_LDA(At, 1, 0); PG8_STAGE(PG8_SA(0, 1), a2 + hstep, voffA);
            PG8_WAIT_V(8); PG8_WAIT_L(0); PG8_BAR; PG8_MMA(0, 0, At, B0); PG8_MMA(0, 1, At, B1); PG8_BAR; PG8_SCHED;
            PG8_LDA(At, 1, 1); PG8_STAGE(PG8_SB(1, 0), b3, voffB); PG8_STAGE(PG8_SB(1, 1), b3 + hstep, voffB); PG8_STAGE(PG8_SA(1, 0), a3, voffA);
            PG8_WAIT_V(8); PG8_WAIT_L(0); PG8_BAR; PG8_MMA(1, 0, At, B0); PG8_MMA(1, 1, At, B1); PG8_BAR; PG8_SCHED;
            } else {
            PG8_LDB(B0, 0, 0); PG8_SCHED; PG8_LDA(At, 0, 0); PG8_STAGE(PG8_SA(1, 1), a1 + hstep, voffA);
            PG8_WAIT_L(8); PG8_BAR; PG8_WAIT_L(0); PG8_MMA(0, 0, At, B0); PG8_BAR; PG8_SCHED;
            PG8_LDB(B1, 0, 1); PG8_STAGE(PG8_SB(0, 0), b2, voffB);
            PG8_BAR; PG8_WAIT_L(0); PG8_MMA(0, 1, At, B1); PG8_BAR;
            PG8_LDA(At, 0, 1); PG8_STAGE(PG8_SA(0, 0), a2, voffA);
            PG8_BAR; PG8_WAIT_L(0); PG8_MMA(1, 0, At, B0); PG8_BAR; PG8_SCHED;
            PG8_STAGE(PG8_SB(0, 1), b2 + hstep, voffB);
            PG8_WAIT_V(6); PG8_BAR; PG8_MMA(1, 1, At, B1); PG8_BAR;
            PG8_LDB(B0, 1, 0); PG8_SCHED; PG8_LDA(At, 1, 0); PG8_STAGE(PG8_SA(0, 1), a2 + hstep, voffA);
            PG8_WAIT_L(8); PG8_BAR; PG8_WAIT_L(0); PG8_MMA(0, 0, At, B0); PG8_BAR; PG8_SCHED;
            PG8_LDB(B1, 1, 1); PG8_STAGE(PG8_SB(1, 0), b3, voffB);
            PG8_BAR; PG8_WAIT_L(0); PG8_MMA(0, 1, At, B1); PG8_BAR;
            PG8_LDA(At, 1, 1); PG8_STAGE(PG8_SA(1, 0), a3, voffA);
            PG8_BAR; PG8_WAIT_L(0); PG8_MMA(1, 0, At, B0); PG8_BAR; PG8_SCHED;
            PG8_STAGE(PG8_SB(1, 1), b3 + hstep, voffB);
            PG8_WAIT_V(6); PG8_BAR; PG8_MMA(1, 1, At, B1); PG8_BAR;
            }
        }
        if constexpr (ALIGN_EPI) { if (wr == 0) PG8_BAR; }
        if constexpr (!Epi::AFTER_DRAIN) { E(acc, cur, wr, wc, fr, fq); S.done(cur); }
        if (!has_next) break;
#pragma unroll
        for (int a = 0; a < 2; ++a)
#pragma unroll
            for (int b = 0; b < 2; ++b)
#pragma unroll
                for (int m = 0; m < 4; ++m)
#pragma unroll
                    for (int n = 0; n < 2; ++n) acc[a][b][m][n] = (f32x4){0.f, 0.f, 0.f, 0.f};
        cur = nxt; cA = nA; cB = nB; ++ui;
        if constexpr (ALIGN_EPI) { if (wr == 1) PG8_BAR; }
    }
    PG8_WAIT_V(0);
    if constexpr (!ALIGN_EPI) { if (wr == 0) PG8_BAR; }
    PG8_BAR;
    if constexpr (Epi::AFTER_DRAIN) { E.fused(acc, cur, wr, wc, fr, fq, lds, wid, lane); S.done(cur); }
#undef PG8_SA
#undef PG8_SB
#undef PG8_STAGE
#undef PG8_LDA
#undef PG8_LDB
#undef PG8_MMA
#undef PG8_WAIT_V
#undef PG8_WAIT_L
#undef PG8_BAR
#undef PG8_SCHED
}
}

#ifndef PG8_SP2
#define PG8_SP2 true
#endif

#define LAS __attribute__((address_space(3)))
typedef unsigned short bf16;
typedef short bf16x8 __attribute__((ext_vector_type(8)));
typedef float f32x4 __attribute__((ext_vector_type(4)));
typedef float f32x16 __attribute__((ext_vector_type(16)));
typedef unsigned u32x4 __attribute__((ext_vector_type(4)));
typedef unsigned u32x2 __attribute__((ext_vector_type(2)));

constexpr int DM = 1024, NMAIN = 32768, ROWS = 33024, METAROW = 32768, DFF = 4096;
constexpr int NTHREADS = 512;
constexpr int LDS_BYTES = 147456;
constexpr int LDS_ITEM_OFF = LDS_BYTES - 16;
constexpr size_t MiB = 1u << 20;
constexpr size_t WS_CTL = 0, WS_WIN = 1 * MiB, WS_WUPA = 12 * MiB, WS_WUPB = 13 * MiB, WS_WOUT = 14 * MiB, WS_WFF1 = 16 * MiB, WS_WFF2 = 24 * MiB;
constexpr size_t WS_LORA = 32 * MiB, WS_XNMETA = 32 * MiB + 512 * 1024, WS_CB = 33 * MiB, WS_ACT = 36 * MiB;
constexpr size_t ACT_SZ = (size_t)ROWS * 512 * 2, L_SZ = (size_t)ROWS * 256 * 2;
constexpr size_t WS_R = WS_ACT, WS_KA = WS_R + ACT_SZ, WS_VA = WS_KA + ACT_SZ, WS_L = WS_VA + ACT_SZ, WS_Q = WS_L + L_SZ, WS_KB = WS_Q + ACT_SZ, WS_VT = WS_KB + ACT_SZ, WS_END = WS_VT + ACT_SZ;
constexpr size_t WS_GA = WS_KA, WS_GB = WS_KB, WS_MN = WS_ACT, WS_HID = WS_ACT + 64 * MiB;
constexpr size_t WS_SS = 65536;
constexpr size_t WS_HALO = WS_END;
constexpr int HALO_ROW = 3584;
static_assert(WS_HALO + (size_t)(NMAIN / 64) * 2 * HALO_ROW <= 256 * MiB, "halo buffer");
static_assert(WS_END <= 256 * MiB && WS_HID + 128 * MiB <= 256 * MiB && WS_CB + (size_t)2 * ROWS * 8 * 4 <= WS_ACT, "ws map");
constexpr float LOG2E = 1.4426950408889634f;
constexpr float QSCALE = 0.125f * LOG2E;

struct Params { const float* in[29]; float* out; unsigned char* ws; };
typedef const __attribute__((address_space(4))) Params* KP;
enum { I_XP = 0, I_XS, I_META, I_GMIX, I_WIN, I_MUP, I_MUN, I_W0, I_WUP, I_A0, I_AUP, I_GUP, I_KK, I_KA, I_RK, I_LNW, I_LNB, I_LQ1, I_LK1, I_LQ2, I_LK2, I_SUBG, I_UPA, I_UPB, I_WOUT, I_GFFN, I_FF1, I_FF2, I_GFIN };

typedef float cvt_f32x2 __attribute__((ext_vector_type(2))); typedef __bf16 cvt_bf16x2 __attribute__((ext_vector_type(2)));
__device__ __forceinline__ unsigned cvtpk(float lo, float hi) { const cvt_f32x2 v = {lo, hi}; const cvt_bf16x2 b = __builtin_convertvector(v, cvt_bf16x2); return __builtin_bit_cast(unsigned, b); }
__device__ __forceinline__ float bf2f(unsigned short b) { return __uint_as_float(((unsigned)b) << 16); }
__device__ __forceinline__ float bflo(unsigned w) { return __uint_as_float(w << 16); }
__device__ __forceinline__ float bfhi(unsigned w) { return __uint_as_float(w & 0xffff0000u); }
__device__ __forceinline__ void unpack8(const u32x4 v, float* o) { o[0] = bflo(v.x); o[1] = bfhi(v.x); o[2] = bflo(v.y); o[3] = bfhi(v.y); o[4] = bflo(v.z); o[5] = bfhi(v.z); o[6] = bflo(v.w); o[7] = bfhi(v.w); }
__device__ __forceinline__ float wave_sum(float v) {
#pragma unroll
    for (int o = 1; o < 64; o <<= 1) v += __shfl_xor(v, o);
    return v;
}
__device__ __forceinline__ float sigmoidf_(float x) { return __builtin_amdgcn_rcpf(1.0f + __builtin_amdgcn_exp2f(-LOG2E * x)); }
__device__ __forceinline__ int seq_base(int s) { return s == 0 ? 0 : 16384 + (s - 1) * 2048; }
__device__ __forceinline__ int seq_len(int s) { return s == 0 ? 16384 : 2048; }
__device__ __forceinline__ int pos_row(int base, int p) { return p < 16 ? METAROW + p : base + p - 16; }

template <class Op> struct Epi8 {
    static constexpr bool PERM = true, AFTER_DRAIN = false;
    Op op;
    __device__ __forceinline__ void operator()(const pg8::f32x4 (&acc)[2][2][4][2], const pg8::Unit& u, int wr, int wc, int fr, int fq) const {
        const int row0 = u.pm * 256 + wr * 64 + fr, col0 = u.pn * 256 + wc * 32 + 8 * fq;
#pragma unroll
        for (int ai = 0; ai < 2; ++ai)
#pragma unroll
            for (int m = 0; m < 4; ++m)
#pragma unroll
                for (int bj = 0; bj < 2; ++bj) { op.apply(row0 + ai * 128 + m * 16, col0 + bj * 128, u.pn, acc[ai][bj][m][0], acc[ai][bj][m][1]); asm volatile("" ::: "memory"); }
    }
};
__device__ __forceinline__ u32x4 pack8(const f32x4 a, const f32x4 b) { u32x4 w; w.x = cvtpk(a[0], a[1]); w.y = cvtpk(a[2], a[3]); w.z = cvtpk(b[0], b[1]); w.w = cvtpk(b[2], b[3]); return w; }

constexpr int CW_KN = 320;
__device__ __forceinline__ float dpp_max16(float v) {
    int x = __float_as_int(v);
    v = fmaxf(v, __int_as_float(__builtin_amdgcn_update_dpp(0, x, 0xB1, 0xf, 0xf, true))); x = __float_as_int(v);
    v = fmaxf(v, __int_as_float(__builtin_amdgcn_update_dpp(0, x, 0x4E, 0xf, 0xf, true))); x = __float_as_int(v);
    v = fmaxf(v, __int_as_float(__builtin_amdgcn_update_dpp(0, x, 0x141, 0xf, 0xf, true))); x = __float_as_int(v);
    v = fmaxf(v, __int_as_float(__builtin_amdgcn_update_dpp(0, x, 0x140, 0xf, 0xf, true)));
    return v;
}
struct OpProj {
    unsigned char* ws;
    __device__ __forceinline__ void apply(int row, int col, int pn, f32x4 v0, f32x4 v1) const {
        if (pn >= 11) {
            bf16* VT = (bf16*)(ws + WS_VT); const int c = col - 11 * 256;
#pragma unroll
            for (int e = 0; e < 4; ++e) { bf16* vt = VT + ((size_t)(row >> 6) * 512 + c) * 64 + (row & 63);
                vt[e * 64] = (bf16)(cvtpk(v0[e], 0.f) & 0xffffu); vt[(4 + e) * 64] = (bf16)(cvtpk(v1[e], 0.f) & 0xffffu); }
            return;
        }
        bf16* O; int ldc = 512, c;
        if (pn < 2) { O = (bf16*)(ws + WS_R); c = col; }
        else if (pn < 4) { O = (bf16*)(ws + WS_KA); c = col - 512; }
        else if (pn < 6) { O = (bf16*)(ws + WS_VA); c = col - 1024; }
        else if (pn < 7) { O = (bf16*)(ws + WS_L); c = col - 1536; ldc = 256; }
        else if (pn < 9) { O = (bf16*)(ws + WS_Q); c = col - 1792; v0 = v0 * QSCALE; v1 = v1 * QSCALE; }
        else { O = (bf16*)(ws + WS_KB); c = col - 2304; }
        const u32x4 w = pack8(v0, v1);
        *(u32x4*)(O + (size_t)row * ldc + c) = w;
        if (pn >= 9) {
            float k8[8]; unpack8(w, k8); float ss = 0.f;
#pragma unroll
            for (int e = 0; e < 8; ++e) ss = fmaf(k8[e], k8[e], ss);
            ss = dpp_max16(ss);
            if ((threadIdx.x & 15) == 0) { const int sidx = row < 16384 ? 0 : row < NMAIN ? 1 + ((row - 16384) >> 11) : 9;
                atomicMax((unsigned*)(ws + WS_CTL) + CW_KN + sidx * 64 + (c >> 3), __float_as_uint(ss)); }
        }
    }
};
struct OpGate {
    bf16* O;
    __device__ __forceinline__ void apply(int row, int col, int pn, f32x4 v0, f32x4 v1) const {
        const int c = col;
#pragma unroll
        for (int e = 0; e < 4; ++e) { v0[e] = sigmoidf_(v0[e]); v1[e] = sigmoidf_(v1[e]); }
        *(u32x4*)(O + (size_t)row * 1024 + c) = pack8(v0, v1);
    }
};
struct OpUpA {
    unsigned char* ws;
    __device__ __forceinline__ void apply(int row, int col, int pn, f32x4 v0, f32x4 v1) const {
        u32x4* p = (u32x4*)((bf16*)(ws + WS_GA) + (size_t)row * 1024 + col); float g[8]; unpack8(*p, g);
#pragma unroll
        for (int e = 0; e < 4; ++e) { v0[e] *= g[e]; v1[e] *= g[4 + e]; }
        *p = pack8(v0, v1);
    }
};
struct OpUpB {
    unsigned char* ws;
    __device__ __forceinline__ void apply(int row, int col, int pn, f32x4 v0, f32x4 v1) const {
        u32x4* p = (u32x4*)((bf16*)(ws + WS_GB) + (size_t)row * 1024 + col); float g[8], a[8]; unpack8(*p, g);
        unpack8(*(const u32x4*)((const bf16*)(ws + WS_GA) + (size_t)row * 1024 + col), a);
#pragma unroll
        for (int e = 0; e < 4; ++e) { v0[e] = a[e] + v0[e] * g[e]; v1[e] = a[4 + e] + v1[e] * g[4 + e]; }
        *p = pack8(v0, v1);
    }
};
struct OpOut {
    const float* xp; const float* xs; float* out; const float* gf; bf16* mn; float* ss;
    __device__ __forceinline__ void apply(int row, int col, int pn, f32x4 v0, f32x4 v1) const {
        const float* x = (row < 16384 ? xp + (size_t)row * DM : xs + (size_t)(row - 16384) * DM) + col;
        float* o = out + (size_t)row * DM + col;
        const f32x4 h0 = *(const f32x4*)x + v0, h1 = *(const f32x4*)(x + 4) + v1;
        *(f32x4*)o = h0; *(f32x4*)(o + 4) = h1;
        const f32x4 g0 = *(const f32x4*)(gf + col), g1 = *(const f32x4*)(gf + col + 4);
        *(u32x4*)(mn + (size_t)row * DM + col) = pack8(h0 * g0, h1 * g1);
        float q = (h0[0] * h0[0] + h0[1] * h0[1]) + (h0[2] * h0[2] + h0[3] * h0[3]) + (h1[0] * h1[0] + h1[1] * h1[1]) + (h1[2] * h1[2] + h1[3] * h1[3]);
        { const auto r = __builtin_amdgcn_permlane16_swap(__float_as_uint(q), __float_as_uint(q), false, false); q = __uint_as_float(r[0]) + __uint_as_float(r[1]); }
        { const auto r = __builtin_amdgcn_permlane32_swap(__float_as_uint(q), __float_as_uint(q), false, false); q = __uint_as_float(r[0]) + __uint_as_float(r[1]); }
        if ((threadIdx.x & 63) < 16) atomicAdd(ss + row, q);
    }
};
struct OpFF1 {
    bf16* hid; const float* ss;
    __device__ __forceinline__ void apply(int row, int col, int pn, f32x4 v0, f32x4 v1) const {
        const float rs2 = __builtin_amdgcn_rcpf(ss[row] * (1.0f / DM) + 1e-6f);
#pragma unroll
        for (int e = 0; e < 4; ++e) { const float a = fmaxf(v0[e], 0.f), b = fmaxf(v1[e], 0.f); v0[e] = a * a * rs2; v1[e] = b * b * rs2; }
        *(u32x4*)(hid + (size_t)row * DFF + col) = pack8(v0, v1);
    }
};
struct OpFF2 {
    float* out;
    __device__ __forceinline__ void apply(int row, int col, int pn, f32x4 v0, f32x4 v1) const {
        float* o = out + (size_t)row * DM + col;
        *(f32x4*)o = *(const f32x4*)o + v0; *(f32x4*)(o + 4) = *(const f32x4*)(o + 4) + v1;
    }
};

__device__ __forceinline__ unsigned f2bf_rne(float f) { return cvtpk(f, 0.f) & 0xffffu; }
__device__ __forceinline__ void transpose_item(const float* W, int K, int N, bf16* WT, LAS float* scr, int item, int lane) {
    const int nblk = N / 32, kb = item / nblk, nb = item % nblk, k0 = 64 * kb, n0 = 32 * nb;
#pragma unroll 8
    for (int i = 0; i < 32; ++i) { const int kk = 2 * i + (lane >> 5); scr[kk * 33 + (lane & 31)] = W[(size_t)(k0 + kk) * N + n0 + (lane & 31)]; }
    asm volatile("s_waitcnt vmcnt(0) lgkmcnt(0)" ::: "memory");
    const int c = lane & 7;
#pragma unroll
    for (int j = 0; j < 4; ++j) { const int n = (lane >> 3) + 8 * j; const LAS float* s = scr + (8 * c) * 33 + n;
        u32x4 o; o.x = cvtpk(s[0 * 33], s[1 * 33]); o.y = cvtpk(s[2 * 33], s[3 * 33]); o.z = cvtpk(s[4 * 33], s[5 * 33]); o.w = cvtpk(s[6 * 33], s[7 * 33]);
        *(u32x4*)(WT + (size_t)(n0 + n) * K + k0 + 8 * c) = o; }
    asm volatile("s_waitcnt lgkmcnt(0)" ::: "memory");
}
__device__ __forceinline__ void rms_row_bf16(const float* src, const float* g, bf16* dst, int lane) {
    unsigned long long* o8 = (unsigned long long*)dst + lane;
    if (!src) {
#pragma unroll
        for (int j = 0; j < 4; ++j) o8[64 * j] = 0ull;
        return; }
    const f32x4* xr = (const f32x4*)src + lane; const f32x4* gr = (const f32x4*)g + lane;
    f32x4 v[4]; float s = 0.f;
#pragma unroll
    for (int j = 0; j < 4; ++j) { v[j] = xr[64 * j]; s += (v[j].x * v[j].x + v[j].y * v[j].y) + (v[j].z * v[j].z + v[j].w * v[j].w); }
    const float rstd = rsqrtf(wave_sum(s) * (1.f / DM) + 1e-6f);
#pragma unroll
    for (int j = 0; j < 4; ++j) { const f32x4 gg = gr[64 * j]; const f32x4 y = v[j] * rstd * gg;
        o8[64 * j] = (unsigned long long)cvtpk(y.x, y.y) | ((unsigned long long)cvtpk(y.z, y.w) << 32); }
}
__device__ __forceinline__ void phase_prologue(LAS unsigned char* lds, KP P) {
    const int tid = fresh_tid(), lane = tid & 63, wid = tid >> 6;
    LAS float* scr = (LAS float*)(lds + wid * 16384);
    const int gw = blockIdx.x * 8 + wid, NGW = gridDim.x * 8;
    unsigned char* ws = P->ws;
    constexpr int I_IN = (1024 / 64) * (5376 / 32), I_UP = (512 / 64) * (1024 / 32), I_O = (1024 / 64) * (1024 / 32), I_1 = (1024 / 64) * (4096 / 32), I_2 = (4096 / 64) * (1024 / 32);
    constexpr int I_LW = (64 / 64) * (512 / 32), I_G = (128 / 64) * (512 / 32);
    constexpr int NITEMS = I_IN + 2 * I_UP + I_O + I_1 + I_2 + 4 * I_LW + I_G;
    for (int it = gw; it < NITEMS; it += NGW) {
        int r = it;
        if (r < I_IN) { transpose_item(P->in[I_WIN], 1024, 5376, (bf16*)(ws + WS_WIN), scr, r, lane); continue; } r -= I_IN;
        if (r < I_UP) { transpose_item(P->in[I_UPA], 512, 1024, (bf16*)(ws + WS_WUPA), scr, r, lane); continue; } r -= I_UP;
        if (r < I_UP) { transpose_item(P->in[I_UPB], 512, 1024, (bf16*)(ws + WS_WUPB), scr, r, lane); continue; } r -= I_UP;
        if (r < I_O) { transpose_item(P->in[I_WOUT], 1024, 1024, (bf16*)(ws + WS_WOUT), scr, r, lane); continue; } r -= I_O;
        if (r < I_1) { transpose_item(P->in[I_FF1], 1024, 4096, (bf16*)(ws + WS_WFF1), scr, r, lane); continue; } r -= I_1;
        if (r < I_2) { transpose_item(P->in[I_FF2], 4096, 1024, (bf16*)(ws + WS_WFF2), scr, r, lane); continue; } r -= I_2;
        if (r < 2 * I_LW) { const int d = r / I_LW; transpose_item(P->in[I_WUP] + (size_t)d * 64 * 512, 64, 512, (bf16*)(ws + WS_LORA) + (size_t)d * 512 * 64, scr, r % I_LW, lane); continue; } r -= 2 * I_LW;
        if (r < 2 * I_LW) { const int d = r / I_LW; transpose_item(P->in[I_AUP] + (size_t)d * 64 * 512, 64, 512, (bf16*)(ws + WS_LORA + 131072) + (size_t)d * 512 * 64, scr, r % I_LW, lane); continue; } r -= 2 * I_LW;
        transpose_item(P->in[I_GUP], 128, 512, (bf16*)(ws + WS_LORA + 262144), scr, r, lane);
    }
    bf16* XN = (bf16*)P->out; bf16* XM = (bf16*)(ws + WS_XNMETA);
    for (int m = gw; m < ROWS; m += NGW) {
        const float* src = m < 16384 ? P->in[I_XP] + (size_t)m * DM : m < NMAIN ? P->in[I_XS] + (size_t)(m - 16384) * DM : (m - NMAIN < 16 ? P->in[I_META] + (size_t)(m - NMAIN) * DM : nullptr);
        bf16* dst = m < NMAIN ? XN + (size_t)m * DM : XM + (size_t)(m - NMAIN) * DM;
        rms_row_bf16(src, P->in[I_GMIX], dst, lane);
    }
}

constexpr int AT_KSTR = 272, AT_VSTR = 144, AT_KSZ = 64 * AT_KSTR, AT_BUF = AT_KSZ + 128 * AT_VSTR;
__device__ __forceinline__ f32x16 mfma32(bf16x8 a, bf16x8 b, f32x16 c) { return __builtin_amdgcn_mfma_f32_32x32x16_bf16(a, b, c, 0, 0, 0); }
__device__ __forceinline__ void attn_unit(LAS unsigned char* lds, KP P, int s, int h, int qb, float lam) {
    int tid_ = threadIdx.x; asm volatile("" : "+v"(tid_));
    const int tid = tid_, lane = tid & 63, r32 = lane & 31, hi = lane >> 5, wid = __builtin_amdgcn_readfirstlane(tid >> 6), rg = wid & 3, mp = wid >> 2;
    const int L = seq_len(s), base = seq_base(s), NT = 1 + L / 64;
    unsigned char* ws = P->ws;
    const bf16* KB = (const bf16*)(ws + WS_KB); const bf16* VT = (const bf16*)(ws + WS_VT); bf16* Q = (bf16*)(ws + WS_Q);
    const int qrow = base + qb * 128 + rg * 32 + r32;
    bf16x8 q[4];
#pragma unroll
    for (int d0 = 0; d0 < 4; ++d0) q[d0] = *(const bf16x8*)(Q + (size_t)qrow * 512 + h * 128 + mp * 64 + d0 * 16 + hi * 8);
    f32x16 O[4];
#pragma unroll
    for (int b = 0; b < 4; ++b)
#pragma unroll
        for (int r = 0; r < 16; ++r) O[b][r] = 0.f;
    float mx = -INFINITY, ls = 0.f;
    const float qh = (float)(16 + qb * 128 + rg * 32 + r32 - 4 * hi);
    const float nslope = -exp2f(-2.0f * (float)(h + 1)) * LOG2E;
    const int kr0 = tid >> 4, kc = tid & 15, vn0 = tid >> 3, vc = tid & 7;
    u32x4 kreg[2], vreg[2];
    const unsigned kgo = (unsigned)((kr0 * 512 + h * 128 + kc * 8) * 2), vgo = (unsigned)(((h * 128 + vn0) * 64 + vc * 8) * 2);
    const unsigned klo = (unsigned)(kr0 * AT_KSTR + kc * 16), vlo = (unsigned)(AT_KSZ + vn0 * AT_VSTR + vc * 16);
#define AT_GLOAD(j) do { const int m0_ = (j) == 0 ? METAROW : base + 64 * ((j) - 1); \
        const unsigned char* kt_ = (const unsigned char*)KB + (size_t)m0_ * 1024; const unsigned char* vt_ = (const unsigned char*)VT + (size_t)(m0_ >> 6) * (512 * 64 * 2); \
        kreg[0] = *(const u32x4*)(kt_ + kgo); kreg[1] = *(const u32x4*)(kt_ + 32 * 1024 + kgo); \
        vreg[0] = *(const u32x4*)(vt_ + vgo); vreg[1] = *(const u32x4*)(vt_ + 64 * 64 * 2 + vgo); } while (0)
#define AT_LSTORE(buf) do { LAS unsigned char* kb_ = lds + (buf) * AT_BUF; \
        *(LAS u32x4*)(kb_ + klo) = kreg[0]; *(LAS u32x4*)(kb_ + klo + 32 * AT_KSTR) = kreg[1]; \
        *(LAS u32x4*)(kb_ + vlo) = vreg[0]; *(LAS u32x4*)(kb_ + vlo + 64 * AT_VSTR) = vreg[1]; } while (0)
    float qn, kn;
    { float ssq = 0.f;
#pragma unroll
      for (int d0 = 0; d0 < 4; ++d0) { float t[8]; unpack8(__builtin_bit_cast(u32x4, q[d0]), t);
#pragma unroll
        for (int e = 0; e < 8; ++e) ssq = fmaf(t[e], t[e], ssq); }
      ssq += __shfl_xor(ssq, 32); qn = sqrtf(ssq) * 1.002f;
      const unsigned* KN = (const unsigned*)(ws + WS_CTL) + CW_KN; float ks = 0.f;
#pragma unroll
      for (int g = 0; g < 8; ++g) ks += fmaxf(__uint_as_float(__hip_atomic_load(KN + s * 64 + h * 16 + mp * 8 + g, __ATOMIC_RELAXED, __HIP_MEMORY_SCOPE_AGENT)), __uint_as_float(__hip_atomic_load(KN + 9 * 64 + h * 16 + mp * 8 + g, __ATOMIC_RELAXED, __HIP_MEMORY_SCOPE_AGENT)));
      kn = sqrtf(ks) * 1.002f; }
    const int jc0 = 1 + qb * 2;
    int jlo = jc0, jhi = jc0 + 1;
    LAS float* red = (LAS float*)(lds + 2 * AT_BUF);
#pragma unroll 1
    for (int ph = 0; ph < 2; ++ph) {
        int nleft, ntl;
        if (ph == 0) { nleft = 0; ntl = 2; }
        else {
            float dneed = (qn * kn - mx + 40.0f) / (-nslope);
#pragma unroll
            for (int o = 1; o < 64; o <<= 1) dneed = fmaxf(dneed, __shfl_xor(dneed, o));
            if (lane == 0) red[wid] = dneed;
            __syncthreads();
            float dm = red[0];
#pragma unroll
            for (int w8 = 1; w8 < 8; ++w8) dm = fmaxf(dm, red[w8]);
            dm = fminf(fmaxf(dm, 0.f), 1.0e6f);
            const int dmax = (int)dm + 1, q0 = 16 + qb * 128;
            const int plo = q0 - dmax, phi = q0 + 127 + dmax;
            jlo = plo < 16 ? 0 : 1 + ((plo - 16) >> 6); jhi = phi >= L + 16 ? NT - 1 : 1 + ((phi - 16) >> 6);
            if (jlo > jc0) jlo = jc0; if (jhi < jc0 + 1) jhi = jc0 + 1;
            nleft = jc0 - jlo; ntl = nleft + (jhi - jc0 - 1);
        }
        if (ntl > 0) {
#define AT_J(t) (ph == 0 ? jc0 + (t) : ((t) < nleft ? jlo + (t) : jc0 + 2 + ((t) - nleft)))
        { const int jf = AT_J(0); AT_GLOAD(jf); } AT_LSTORE(0); __syncthreads();
#pragma unroll 1
        for (int t = 0; t < ntl; ++t) {
            const int j = AT_J(t);
            if (t + 1 < ntl) { const int jn = AT_J(t + 1); AT_GLOAD(jn); }
            const LAS unsigned char* Kb = lds + (t & 1) * AT_BUF + mp * 128; const LAS unsigned char* Vb = lds + (t & 1) * AT_BUF + AT_KSZ;
            const float dq = qh - (float)(j == 0 ? 0 : 64 * j - 48);
            f32x16 p0, p1;
#pragma unroll
            for (int r = 0; r < 16; ++r) { p0[r] = 0.f; p1[r] = 0.f; }
            {
                bf16x8 ka[4], kb[4];
#pragma unroll
                for (int d0 = 0; d0 < 4; ++d0) { ka[d0] = *(const LAS bf16x8*)(Kb + r32 * AT_KSTR + d0 * 32 + hi * 16); kb[d0] = *(const LAS bf16x8*)(Kb + (32 + r32) * AT_KSTR + d0 * 32 + hi * 16); }
                __builtin_amdgcn_sched_barrier(0);
#pragma unroll
                for (int d0 = 0; d0 < 4; ++d0) { p0 = mfma32(ka[d0], q[d0], p0); p1 = mfma32(kb[d0], q[d0], p1); }
            }
#pragma unroll
            for (int r = 0; r < 16; ++r) { const float dd = dq - (float)((r & 3) + 8 * (r >> 2)); p0[r] = fmaf(fabsf(dd), nslope, p0[r]); p1[r] = fmaf(fabsf(dd - 32.f), nslope, p1[r]); }
            if (j == 0) {
#pragma unroll
                for (int r = 0; r < 16; ++r) { if ((r & 3) + 8 * (r >> 2) + 4 * hi >= 16) p0[r] = -INFINITY; p1[r] = -INFINITY; }
            }
            float rm = fmaxf(p0[0], p1[0]);
#pragma unroll
            for (int r = 1; r < 16; ++r) rm = fmaxf(rm, fmaxf(p0[r], p1[r]));
            rm = fmaxf(rm, __shfl_xor(rm, 32));
            if (__any(rm > mx - 38.0f)) {
            const float mn = fmaxf(mx, rm);
            if (__any(mn > mx)) {
                const float f = __builtin_amdgcn_exp2f(mx - mn); ls *= f; mx = mn;
#pragma unroll
                for (int b = 0; b < 4; ++b)
#pragma unroll
                    for (int r = 0; r < 16; ++r) O[b][r] *= f;
            }
            float sum = 0.f;
#pragma unroll
            for (int r = 0; r < 16; ++r) { p0[r] = __builtin_amdgcn_exp2f(p0[r] - mx); p1[r] = __builtin_amdgcn_exp2f(p1[r] - mx); sum += p0[r] + p1[r]; }
            ls += sum;
            bf16x8 pf[4];
#pragma unroll
            for (int k2 = 0; k2 < 2; ++k2) {
                u32x4 w0, w1;
                w0.x = cvtpk(p0[8 * k2 + 0], p0[8 * k2 + 1]); w0.y = cvtpk(p0[8 * k2 + 2], p0[8 * k2 + 3]); w0.z = cvtpk(p0[8 * k2 + 4], p0[8 * k2 + 5]); w0.w = cvtpk(p0[8 * k2 + 6], p0[8 * k2 + 7]);
                w1.x = cvtpk(p1[8 * k2 + 0], p1[8 * k2 + 1]); w1.y = cvtpk(p1[8 * k2 + 2], p1[8 * k2 + 3]); w1.z = cvtpk(p1[8 * k2 + 4], p1[8 * k2 + 5]); w1.w = cvtpk(p1[8 * k2 + 6], p1[8 * k2 + 7]);
                pf[k2] = __builtin_bit_cast(bf16x8, w0); pf[2 + k2] = __builtin_bit_cast(bf16x8, w1);
            }
            {
                u32x4 vcur[4], vnxt[4];
#define AT_VLOAD(dst, ks_) do { _Pragma("unroll") for (int b_ = 0; b_ < 4; ++b_) { const LAS unsigned char* vp_ = Vb + (b_ * 32 + r32) * AT_VSTR + (ks_) * 32 + hi * 8; \
                    const u32x2 lo_ = *(const LAS u32x2*)vp_, hh_ = *(const LAS u32x2*)(vp_ + 16); dst[b_].x = lo_.x; dst[b_].y = lo_.y; dst[b_].z = hh_.x; dst[b_].w = hh_.y; } } while (0)
                AT_VLOAD(vcur, 0);
#pragma unroll
                for (int ks = 0; ks < 4; ++ks) {
                    if (ks < 3) AT_VLOAD(vnxt, ks + 1);
                    __builtin_amdgcn_sched_barrier(0);
#pragma unroll
                    for (int b = 0; b < 4; ++b) O[b] = mfma32(__builtin_bit_cast(bf16x8, vcur[b]), pf[ks], O[b]);
                    __builtin_amdgcn_sched_barrier(0);
#pragma unroll
                    for (int b = 0; b < 4; ++b) vcur[b] = vnxt[b];
                }
#undef AT_VLOAD
            }
            }
            if (t + 1 < ntl) AT_LSTORE((t + 1) & 1);
            __syncthreads();
        }
#undef AT_J
        }
    }
#undef AT_GLOAD
#undef AT_LSTORE
    const float lt = ls + __shfl_xor(ls, 32);
    const float inv = (mp ? lam : 1.0f) / lt;
    int lane2 = lane; asm volatile("" : "+v"(lane2));
    const int r32e = lane2 & 31, hie = lane2 >> 5;
    LAS float* ex = (LAS float*)lds + rg * (128 * 32) + hie * 128 + r32e;
    if (mp == 1) {
#pragma unroll
        for (int b = 0; b < 4; ++b)
#pragma unroll
            for (int r = 0; r < 16; ++r) ex[(32 * b + (r & 3) + 8 * (r >> 2)) * 32] = O[b][r] * inv;
    }
    __syncthreads();
    if (mp == 0) {
        float ss = 0.f;
#pragma unroll
        for (int b = 0; b < 4; ++b)
#pragma unroll
            for (int r = 0; r < 16; ++r) { const float o = O[b][r] * inv - ex[(32 * b + (r & 3) + 8 * (r >> 2)) * 32]; O[b][r] = o; ss += o * o; }
        ss += __shfl_xor(ss, 32);
        const float rstd = rsqrtf(ss * (1.0f / 128.0f) + 1e-5f) * 0.8f;
        const float* sg = P->in[I_SUBG] + 4 * hie; bf16* Qo = Q + (size_t)(base + qb * 128 + rg * 32 + r32e) * 512 + h * 128 + 4 * hie;
#pragma unroll
        for (int b = 0; b < 4; ++b)
#pragma unroll
            for (int r4 = 0; r4 < 4; ++r4) {
                const int n = 32 * b + 8 * r4; const f32x4 g = *(const f32x4*)(sg + n);
                u32x2 w; w.x = cvtpk(O[b][4 * r4 + 0] * rstd * g.x, O[b][4 * r4 + 1] * rstd * g.y); w.y = cvtpk(O[b][4 * r4 + 2] * rstd * g.z, O[b][4 * r4 + 3] * rstd * g.w);
                *(u32x2*)(Qo + n) = w;
            }
    }
    __syncthreads();
}

constexpr int SC_R = 0, SC_K = 16384, SC_V = 32768, SC_W = 49152, SC_B = 65536, SC_KK = 81920, SC_Y = 98304, SC_TW = 114688, SC_AD = 123904, SC_MU = 133120;
__device__ __forceinline__ float dpp_add(float v, int ctrl_id) {
    const int x = __float_as_int(v); int y;
    if (ctrl_id == 0) y = __builtin_amdgcn_update_dpp(0, x, 0xB1, 0xf, 0xf, true);
    else if (ctrl_id == 1) y = __builtin_amdgcn_update_dpp(0, x, 0x4E, 0xf, 0xf, true);
    else if (ctrl_id == 2) y = __builtin_amdgcn_update_dpp(0, x, 0x141, 0xf, 0xf, true);
    else y = __builtin_amdgcn_update_dpp(0, x, 0x140, 0xf, 0xf, true);
    return v + __int_as_float(y);
}
template <int LPR> __device__ __forceinline__ float grp_sum(float v) {
    v = dpp_add(v, 0); v = dpp_add(v, 1); v = dpp_add(v, 2);
    if (LPR == 16) v = dpp_add(v, 3);
    return v;
}
#define BAR_LDS() asm volatile("s_waitcnt lgkmcnt(0)\n\ts_barrier" ::: "memory")
__device__ __forceinline__ float fast_sigmoid(float x) { return __builtin_amdgcn_rcpf(1.0f + __builtin_amdgcn_exp2f(-LOG2E * x)); }
__device__ __forceinline__ float fast_tanh(float x) { return 1.0f - 2.0f * __builtin_amdgcn_rcpf(1.0f + __builtin_amdgcn_exp2f(2.0f * LOG2E * x)); }
template <int NRP, int NSW>
__device__ __forceinline__ void scan_unit(LAS unsigned char* lds, KP P, int s, int d, int h, int rp) {
    constexpr int RPB = 64 / NRP, RPW = RPB / NSW, LPR = 64 / RPW, CPL = 64 / LPR;
    static_assert(LPR == 8 || LPR == 16, "scan geometry");
    constexpr bool YDB = (RPB == 16) && (NSW == 4);
    constexpr int YST = YDB ? RPB : 64;
    int tid_ = threadIdx.x; asm volatile("" : "+v"(tid_));
    const int tid = tid_, lane = tid & 63, wid = __builtin_amdgcn_readfirstlane(tid >> 6);
    const int L = seq_len(s), base = seq_base(s), Ltot = L + 16, nchunk = (Ltot + 63) / 64;
    unsigned char* ws = P->ws;
    const bf16* Rb = (const bf16*)(ws + WS_R); const bf16* KAb = (const bf16*)(ws + WS_KA); const bf16* VAb = (const bf16*)(ws + WS_VA); const bf16* Lb = (const bf16*)(ws + WS_L);
    float* CB = (float*)(ws + WS_CB); bf16* YD = (bf16*)((unsigned char*)P->out + 64 * MiB) + (size_t)d * NMAIN * 512;
    LAS float* fS = (LAS float*)lds; LAS float* fV = (LAS float*)(lds + 81920); LAS float* fY = (LAS float*)(lds + SC_Y); LAS float* fMU = (LAS float*)(lds + SC_MU);
#define SCI(sl_, a_, c_) ((sl_) * 320 + (a_) * 64 + (c_))
    for (int i = tid; i < 832; i += NTHREADS) {
        float v;
        if (i < 640) { const int which = i / 320, jj = i % 320, a = jj >> 6, c = jj & 63; const int gi = a < 3 ? a * 512 + h * 64 + c : 1536 + (a - 3) * 64 + c; v = P->in[which ? I_MUN : I_MUP][gi]; }
        else { const int a = (i - 640) >> 6, c = (i - 640) & 63; v = P->in[a == 0 ? I_KK : a == 1 ? I_KA : I_RK][h * 64 + c]; }
        fMU[i] = v;
    }
    const int mat = wid >> 2, ntile = wid & 3;
    const bf16* Wt = (const bf16*)(ws + WS_LORA + (mat ? 131072 : 0)) + ((size_t)d * 512 + h * 64 + ntile * 16 + (lane & 15)) * 64 + (lane >> 4) * 8;
    const bf16x8 bfr0 = *(const bf16x8*)Wt, bfr1 = *(const bf16x8*)(Wt + 32);
    const float bias = P->in[mat ? I_A0 : I_W0][d * 512 + h * 64 + ntile * 16 + (lane & 15)];
    float S[CPL];
#pragma unroll
    for (int j = 0; j < CPL; ++j) S[j] = 0.f;
    const int rowl = lane / LPR, kg = lane % LPR, srow = rp * RPB + wid * RPW + rowl;
    const int slot = tid >> 3, cg8 = (tid & 7) * 8;
    u32x4 raw[5][3];
#define SC_META(c) (d ? ((c) == nchunk - 1) : ((c) == 0))
    const unsigned char* HALO0 = ws + WS_HALO + (size_t)(base >> 6) * 2 * HALO_ROW;
#define SC_LOAD(c) do { const int i_ = 64 * (c) + slot; const bool ok_ = i_ < Ltot; const int p_ = d ? Ltot - 1 - i_ : i_; \
        const unsigned zr_ = (unsigned)(METAROW + 64); \
        if (!SC_META(c)) { const unsigned rc_ = ok_ ? (unsigned)(base + p_ - 16) : zr_; \
            _Pragma("unroll") for (int a_ = 0; a_ < 5; ++a_) { const unsigned char* B_ = (const unsigned char*)(a_ == 0 ? Rb : a_ == 1 ? KAb : a_ == 2 ? VAb : Lb); const unsigned ld_ = a_ < 3 ? 1024u : 512u; \
                const unsigned co_ = (unsigned)(((a_ < 3 ? h * 64 : (a_ - 3) * 64) + cg8) * 2); raw[a_][1] = *(const u32x4*)(B_ + (rc_ * ld_ + co_)); } \
        } else { const bool me_ = ok_ && p_ < 16; const bool hn_ = me_ && p_ == 15; \
            const unsigned rc_ = ok_ ? (unsigned)pos_row(base, p_) : zr_, rp_ = (me_ && p_ > 0) ? (unsigned)(METAROW + p_ - 1) : zr_, rn_ = (me_ && p_ < 15) ? (unsigned)(METAROW + p_ + 1) : zr_; \
            _Pragma("unroll") for (int a_ = 0; a_ < 5; ++a_) { const unsigned char* B_ = (const unsigned char*)(a_ == 0 ? Rb : a_ == 1 ? KAb : a_ == 2 ? VAb : Lb); const unsigned ld_ = a_ < 3 ? 1024u : 512u; \
                const unsigned co_ = (unsigned)(((a_ < 3 ? h * 64 : (a_ - 3) * 64) + cg8) * 2); \
                const unsigned ho_ = (unsigned)(((a_ < 3 ? a_ * 512 + h * 64 : 1536 + (a_ - 3) * 64) + cg8) * 2); \
                raw[a_][0] = *(const u32x4*)(B_ + (rp_ * ld_ + co_)); raw[a_][1] = *(const u32x4*)(B_ + (rc_ * ld_ + co_)); \
                const unsigned char* np_ = hn_ ? HALO0 + ho_ : B_ + (rn_ * ld_ + co_); raw[a_][2] = *(const u32x4*)np_; } } } while (0)
    SC_LOAD(0);
    BAR_LDS();
    for (int c = 0; c < nchunk; ++c) {
        const int nvalid = (Ltot - 64 * c) < 64 ? (Ltot - 64 * c) : 64;
        float rv[8], kv[8];
        if (!SC_META(c)) {
            float vv8[8]; unpack8(raw[0][1], rv); unpack8(raw[1][1], kv); unpack8(raw[2][1], vv8);
            { LAS float* dst = fS + SCI(slot, 4, cg8); *(LAS f32x4*)dst = (f32x4){rv[0], rv[1], rv[2], rv[3]}; *(LAS f32x4*)(dst + 4) = (f32x4){rv[4], rv[5], rv[6], rv[7]}; }
            { LAS float* dst = fV + slot * 64 + cg8; *(LAS f32x4*)dst = (f32x4){vv8[0], vv8[1], vv8[2], vv8[3]}; *(LAS f32x4*)(dst + 4) = (f32x4){vv8[4], vv8[5], vv8[6], vv8[7]}; }
            *(LAS u32x4*)(lds + SC_TW + slot * 144 + cg8 * 2) = raw[3][1];
            *(LAS u32x4*)(lds + SC_AD + slot * 144 + cg8 * 2) = raw[4][1];
        } else {
            const int i1 = 64 * c + slot; const int p1 = d ? Ltot - 1 - i1 : i1; const bool me1 = i1 < Ltot && p1 < 16; const float fm = me1 ? 1.0f : 0.0f;
#pragma unroll
            for (int a = 0; a < 5; ++a) {
                float pv[8], cv[8], nv[8], o[8]; unpack8(raw[a][0], pv); unpack8(raw[a][1], cv); unpack8(raw[a][2], nv);
                const f32x4 mp0 = *(const LAS f32x4*)(fMU + a * 64 + cg8), mp1 = *(const LAS f32x4*)(fMU + a * 64 + cg8 + 4), mn0 = *(const LAS f32x4*)(fMU + 320 + a * 64 + cg8), mn1 = *(const LAS f32x4*)(fMU + 320 + a * 64 + cg8 + 4);
#pragma unroll
                for (int e = 0; e < 8; ++e) { const float mp = fm * (e < 4 ? mp0[e & 3] : mp1[e & 3]), mn = fm * (e < 4 ? mn0[e & 3] : mn1[e & 3]); o[e] = cv[e] + mp * (pv[e] - cv[e]) + mn * (nv[e] - cv[e]); }
                if (a == 0) {
#pragma unroll
                    for (int e = 0; e < 8; ++e) rv[e] = o[e];
                    LAS float* dst = fS + SCI(slot, 4, cg8); *(LAS f32x4*)dst = (f32x4){o[0], o[1], o[2], o[3]}; *(LAS f32x4*)(dst + 4) = (f32x4){o[4], o[5], o[6], o[7]};
                } else if (a == 1) {
#pragma unroll
                    for (int e = 0; e < 8; ++e) kv[e] = o[e];
                } else if (a == 2) {
                    LAS float* dst = fV + slot * 64 + cg8; *(LAS f32x4*)dst = (f32x4){o[0], o[1], o[2], o[3]}; *(LAS f32x4*)(dst + 4) = (f32x4){o[4], o[5], o[6], o[7]};
                } else {
                    if (a == 3) {
#pragma unroll
                        for (int e = 0; e < 8; ++e) o[e] = me1 ? fast_tanh(o[e]) : o[e];
                    }
                    u32x4 w; w.x = cvtpk(o[0], o[1]); w.y = cvtpk(o[2], o[3]); w.z = cvtpk(o[4], o[5]); w.w = cvtpk(o[6], o[7]);
                    *(LAS u32x4*)(lds + (a == 3 ? SC_TW : SC_AD) + slot * 144 + cg8 * 2) = w;
                }
            }
        }
        BAR_LDS();
        if (c + 1 < nchunk) SC_LOAD(c + 1);
        {
            const LAS unsigned char* Ab = lds + (mat ? SC_AD : SC_TW); LAS float* fWB = fS + (mat ? 128 : 64);
#pragma unroll
            for (int mt = 0; mt < 4; ++mt) {
                const bf16x8 a0 = *(const LAS bf16x8*)(Ab + (mt * 16 + (lane & 15)) * 144 + (lane >> 4) * 16);
                const bf16x8 a1 = *(const LAS bf16x8*)(Ab + (mt * 16 + (lane & 15)) * 144 + 64 + (lane >> 4) * 16);
                f32x4 acc = {0.f, 0.f, 0.f, 0.f};
                acc = __builtin_amdgcn_mfma_f32_16x16x32_bf16(a0, bfr0, acc, 0, 0, 0);
                acc = __builtin_amdgcn_mfma_f32_16x16x32_bf16(a1, bfr1, acc, 0, 0, 0);
#pragma unroll
                for (int rg = 0; rg < 4; ++rg) {
                    const int sl = mt * 16 + (lane >> 4) * 4 + rg, col = ntile * 16 + (lane & 15);
                    const float sg = fast_sigmoid(acc[rg] + bias); const float dc = __builtin_amdgcn_exp2f(-0.6065306597126334f * LOG2E * sg);
                    fWB[sl * 320 + col] = mat ? sg : dc;
                }
            }
        }
        BAR_LDS();
        {
            const f32x4 a0 = *(const LAS f32x4*)(fS + SCI(slot, 2, cg8)), a1 = *(const LAS f32x4*)(fS + SCI(slot, 2, cg8 + 4));
            const f32x4 kk0 = *(const LAS f32x4*)(fMU + 640 + cg8), kk1 = *(const LAS f32x4*)(fMU + 640 + cg8 + 4), ka0 = *(const LAS f32x4*)(fMU + 704 + cg8), ka1 = *(const LAS f32x4*)(fMU + 704 + cg8 + 4);
            const f32x4 rk0 = *(const LAS f32x4*)(fMU + 768 + cg8), rk1 = *(const LAS f32x4*)(fMU + 768 + cg8 + 4);
            float kkv[8], kd[8], av[8]; float ssq = 0.f, cs = 0.f;
#pragma unroll
            for (int e = 0; e < 8; ++e) {
                av[e] = e < 4 ? a0[e & 3] : a1[e & 3];
                kkv[e] = kv[e] * (e < 4 ? kk0[e & 3] : kk1[e & 3]); ssq = fmaf(kkv[e], kkv[e], ssq);
                kd[e] = kv[e] * (1.0f + (av[e] - 1.0f) * (e < 4 ? ka0[e & 3] : ka1[e & 3])); cs = fmaf(rv[e] * kd[e], e < 4 ? rk0[e & 3] : rk1[e & 3], cs);
            }
            ssq = grp_sum<8>(ssq); cs = grp_sum<8>(cs);
            const float rs = rsqrtf(fmaxf(ssq, 1e-24f));
#pragma unroll
            for (int e = 0; e < 8; ++e) { kkv[e] *= rs; av[e] *= kkv[e]; }
            LAS float* o1 = fS + SCI(slot, 0, cg8); *(LAS f32x4*)o1 = (f32x4){kkv[0], kkv[1], kkv[2], kkv[3]}; *(LAS f32x4*)(o1 + 4) = (f32x4){kkv[4], kkv[5], kkv[6], kkv[7]};
            LAS float* o2 = fS + SCI(slot, 2, cg8); *(LAS f32x4*)o2 = (f32x4){av[0], av[1], av[2], av[3]}; *(LAS f32x4*)(o2 + 4) = (f32x4){av[4], av[5], av[6], av[7]};
            LAS float* o3 = fS + SCI(slot, 3, cg8); *(LAS f32x4*)o3 = (f32x4){kd[0], kd[1], kd[2], kd[3]}; *(LAS f32x4*)(o3 + 4) = (f32x4){kd[4], kd[5], kd[6], kd[7]};
            if (cg8 == 0 && rp == 0 && slot < nvalid) { const int i2 = 64 * c + slot; const int p2 = d ? Ltot - 1 - i2 : i2; CB[((size_t)d * ROWS + pos_row(base, p2)) * 8 + h] = cs; }
        }
        BAR_LDS();
#define SC_STORE_Y(cc_) do { const int t5_ = tid - 256; if (t5_ >= 0 && t5_ < 128) { const int sl5_ = t5_ >> 1, hf_ = t5_ & 1; const int i5_ = 64 * (cc_) + sl5_; const int p5_ = d ? Ltot - 1 - i5_ : i5_; \
            if (i5_ < Ltot && p5_ >= 16) { const LAS float* yp_ = fY + ((cc_) & 1) * 1024 + sl5_ * 16 + hf_ * 8; const f32x4 y0_ = *(const LAS f32x4*)yp_, y1_ = *(const LAS f32x4*)(yp_ + 4); \
                *(u32x4*)(YD + (size_t)(base + p5_ - 16) * 512 + h * 64 + rp * 16 + hf_ * 8) = pack8(y0_, y1_); } } } while (0)
        if (YDB && wid >= NSW && c > 0) SC_STORE_Y(c - 1);
        if (wid < NSW) {
            typedef float f32x2_ __attribute__((ext_vector_type(2)));
            constexpr int C4 = CPL / 4;
            const LAS float* ps = fS + kg * CPL; const LAS float* pv = fV + srow;
            LAS float* py = YDB ? fY + (c & 1) * 1024 + (srow - rp * RPB) : fY + srow;
            f32x4 nk[C4], nw[C4], nb[C4], nd[C4], nr[C4]; float nv;
#define SC_FETCH(sl_) do { _Pragma("unroll") for (int j_ = 0; j_ < C4; ++j_) { nk[j_] = *(const LAS f32x4*)(ps + (sl_) * 320 + 4 * j_); nw[j_] = *(const LAS f32x4*)(ps + (sl_) * 320 + 64 + 4 * j_); \
                nb[j_] = *(const LAS f32x4*)(ps + (sl_) * 320 + 128 + 4 * j_); nd[j_] = *(const LAS f32x4*)(ps + (sl_) * 320 + 192 + 4 * j_); nr[j_] = *(const LAS f32x4*)(ps + (sl_) * 320 + 256 + 4 * j_); } nv = pv[(sl_) * 64]; } while (0)
            SC_FETCH(0);
            f32x4 rp4[C4];
#pragma unroll
            for (int j = 0; j < C4; ++j) rp4[j] = (f32x4){0.f, 0.f, 0.f, 0.f};
#pragma unroll 16
            for (int sl = 0; sl < nvalid; ++sl) {
                f32x4 ck[C4], cw[C4], cb[C4], cd[C4], cr[C4];
#pragma unroll
                for (int j = 0; j < C4; ++j) { ck[j] = nk[j]; cw[j] = nw[j]; cb[j] = nb[j]; cd[j] = nd[j]; cr[j] = nr[j]; }
                const float vv = nv;
                SC_FETCH(sl + 1 < 64 ? sl + 1 : 63);
                f32x2_ pa = {0.f, 0.f}, ya = {0.f, 0.f};
#pragma unroll
                for (int j = 0; j < C4; ++j)
#pragma unroll
                    for (int e = 0; e < 4; e += 2) { const f32x2_ s2 = {S[4 * j + e], S[4 * j + e + 1]}, k2 = {ck[j][e], ck[j][e + 1]}, r2 = {rp4[j][e], rp4[j][e + 1]}; pa = pa + s2 * k2; ya = ya + s2 * r2; }
                float pp = pa.x + pa.y, yy = ya.x + ya.y;
                pp = dpp_add(pp, 0); yy = dpp_add(yy, 0); pp = dpp_add(pp, 1); yy = dpp_add(yy, 1); pp = dpp_add(pp, 2); yy = dpp_add(yy, 2);
                if (LPR == 16) { pp = dpp_add(pp, 3); yy = dpp_add(yy, 3); }
                py[(sl > 0 ? sl - 1 : 0) * YST] = yy;
#pragma unroll
                for (int j = 0; j < C4; ++j)
#pragma unroll
                    for (int e = 0; e < 4; e += 2) {
                        const f32x2_ b2 = {cb[j][e], cb[j][e + 1]}, d2 = {cd[j][e], cd[j][e + 1]}, w2 = {cw[j][e], cw[j][e + 1]}; f32x2_ s2 = {S[4 * j + e], S[4 * j + e + 1]};
                        const f32x2_ t2 = d2 * vv - b2 * pp; s2 = s2 * w2 + t2; S[4 * j + e] = s2.x; S[4 * j + e + 1] = s2.y; }
#pragma unroll
                for (int j = 0; j < C4; ++j) rp4[j] = cr[j];
            }
            {
                f32x2_ ya = {0.f, 0.f};
#pragma unroll
                for (int j = 0; j < C4; ++j)
#pragma unroll
                    for (int e = 0; e < 4; e += 2) { const f32x2_ s2 = {S[4 * j + e], S[4 * j + e + 1]}, r2 = {rp4[j][e], rp4[j][e + 1]}; ya = ya + s2 * r2; }
                const float yy = grp_sum<LPR>(ya.x + ya.y);
                py[(nvalid - 1) * YST] = yy;
            }
#undef SC_FETCH
        }
        BAR_LDS();
        {
            const int i2 = 64 * c + slot; const int p2 = d ? Ltot - 1 - i2 : i2;
            if (!YDB && slot < nvalid && p2 >= 16 && (cg8 / RPB) == rp) {
                const LAS float* yp = fY + slot * 64 + cg8; const f32x4 y0 = *(const LAS f32x4*)yp, y1 = *(const LAS f32x4*)(yp + 4);
                *(u32x4*)(YD + (size_t)(base + p2 - 16) * 512 + h * 64 + cg8) = pack8(y0, y1);
            }
        }
    }
    if (YDB) SC_STORE_Y(nchunk - 1);
#undef SC_STORE_Y
#undef SC_LOAD
#undef SC_META
#undef SCI
}

constexpr int SL_FV = 81920, SL_FY = 86016, SL_TW = 90112, SL_AD = 94720, SL_AS = 99328, SL_MU = 107520;
__device__ __forceinline__ void scan_long(LAS unsigned char* lds, KP P, int s, int d, int h, int rp) {
    int tid_ = threadIdx.x; asm volatile("" : "+v"(tid_));
    const int tid = tid_, lane = tid & 63, wid = __builtin_amdgcn_readfirstlane(tid >> 6);
    const int L = seq_len(s), base = seq_base(s), Ltot = L + 16, nhalf = (Ltot + 31) / 32;
    unsigned char* ws = P->ws;
    const bf16* Rb = (const bf16*)(ws + WS_R); const bf16* KAb = (const bf16*)(ws + WS_KA); const bf16* VAb = (const bf16*)(ws + WS_VA); const bf16* Lb = (const bf16*)(ws + WS_L);
    float* CB = (float*)(ws + WS_CB); bf16* YD = (bf16*)((unsigned char*)P->out + 64 * MiB) + (size_t)d * NMAIN * 512;
    LAS float* fS = (LAS float*)lds; LAS float* fV = (LAS float*)(lds + SL_FV); LAS float* fY = (LAS float*)(lds + SL_FY); LAS float* fAS = (LAS float*)(lds + SL_AS); LAS float* fMU = (LAS float*)(lds + SL_MU);
    for (int i = tid; i < 832; i += NTHREADS) {
        float v;
        if (i < 640) { const int which = i / 320, jj = i % 320, a = jj >> 6, c = jj & 63; const int gi = a < 3 ? a * 512 + h * 64 + c : 1536 + (a - 3) * 64 + c; v = P->in[which ? I_MUN : I_MUP][gi]; }
        else { const int a = (i - 640) >> 6, c = (i - 640) & 63; v = P->in[a == 0 ? I_KK : a == 1 ? I_KA : I_RK][h * 64 + c]; }
        fMU[i] = v;
    }
    const bool scanner = wid < 4; const int pw = wid & 3;
    const int sl8 = lane >> 3, cg8 = (lane & 7) * 8, slot = pw * 8 + sl8;
    const int rowl = lane >> 4, kg = lane & 15, srl = pw * 4 + rowl;
    const unsigned char* HALO0 = ws + WS_HALO + (size_t)(base >> 6) * 2 * HALO_ROW;
    u32x4 raw[5][3];
#define SL_META(hc) (d ? ((hc) == nhalf - 1) : ((hc) == 0))
#define SL_LOAD(hc) do { const int i_ = 32 * (hc) + slot; const bool ok_ = i_ < Ltot; const int p_ = d ? Ltot - 1 - i_ : i_; \
        const unsigned zr_ = (unsigned)(METAROW + 64); \
        if (!SL_META(hc)) { const unsigned rc_ = ok_ ? (unsigned)(base + p_ - 16) : zr_; \
            _Pragma("unroll") for (int a_ = 0; a_ < 5; ++a_) { const unsigned char* B_ = (const unsigned char*)(a_ == 0 ? Rb : a_ == 1 ? KAb : a_ == 2 ? VAb : Lb); const unsigned ld_ = a_ < 3 ? 1024u : 512u; \
                const unsigned co_ = (unsigned)(((a_ < 3 ? h * 64 : (a_ - 3) * 64) + cg8) * 2); raw[a_][1] = *(const u32x4*)(B_ + (rc_ * ld_ + co_)); } \
        } else { const bool me_ = ok_ && p_ < 16; const bool hn_ = me_ && p_ == 15; \
            const unsigned rc_ = ok_ ? (unsigned)pos_row(base, p_) : zr_, rp_ = (me_ && p_ > 0) ? (unsigned)(METAROW + p_ - 1) : zr_, rn_ = (me_ && p_ < 15) ? (unsigned)(METAROW + p_ + 1) : zr_; \
            _Pragma("unroll") for (int a_ = 0; a_ < 5; ++a_) { const unsigned char* B_ = (const unsigned char*)(a_ == 0 ? Rb : a_ == 1 ? KAb : a_ == 2 ? VAb : Lb); const unsigned ld_ = a_ < 3 ? 1024u : 512u; \
                const unsigned co_ = (unsigned)(((a_ < 3 ? h * 64 : (a_ - 3) * 64) + cg8) * 2); \
                const unsigned ho_ = (unsigned)(((a_ < 3 ? a_ * 512 + h * 64 : 1536 + (a_ - 3) * 64) + cg8) * 2); \
                raw[a_][0] = *(const u32x4*)(B_ + (rp_ * ld_ + co_)); raw[a_][1] = *(const u32x4*)(B_ + (rc_ * ld_ + co_)); \
                const unsigned char* np_ = hn_ ? HALO0 + ho_ : B_ + (rn_ * ld_ + co_); raw[a_][2] = *(const u32x4*)np_; } } } while (0)
    constexpr int SL_WB = 110848;
    for (int i = tid; i < 1024; i += NTHREADS) { const int m2 = i >> 9, n = (i >> 3) & 63, ch = i & 7;
        *(LAS u32x4*)(lds + SL_WB + m2 * 9216 + n * 144 + ch * 16) = *(const u32x4*)((const bf16*)(ws + WS_LORA + (m2 ? 131072 : 0)) + ((size_t)d * 512 + h * 64 + n) * 64 + ch * 8); }
    float bias[2][4];
#pragma unroll
    for (int mt_ = 0; mt_ < 2; ++mt_)
#pragma unroll
        for (int nt = 0; nt < 4; ++nt) bias[mt_][nt] = P->in[mt_ ? I_A0 : I_W0][d * 512 + h * 64 + nt * 16 + (lane & 15)];
    float S[4] = {0.f, 0.f, 0.f, 0.f};
#define SL_PREP(hc, buf) do { \
        const bool meta_ = SL_META(hc); const int i1_ = 32 * (hc) + slot; const int p1_ = d ? Ltot - 1 - i1_ : i1_; const bool ok1_ = i1_ < Ltot; \
        LAS float* fSb_ = fS + (buf) * 10240 + slot * 320; float rv[8], kv[8]; \
        if (!meta_) { float vv8[8]; unpack8(raw[0][1], rv); unpack8(raw[1][1], kv); unpack8(raw[2][1], vv8); \
            *(LAS f32x4*)(fSb_ + 256 + cg8) = (f32x4){rv[0], rv[1], rv[2], rv[3]}; *(LAS f32x4*)(fSb_ + 256 + cg8 + 4) = (f32x4){rv[4], rv[5], rv[6], rv[7]}; \
            if ((cg8 >> 4) == rp) { LAS float* dv_ = fV + (buf) * 512 + slot * 16 + (cg8 & 15); *(LAS f32x4*)dv_ = (f32x4){vv8[0], vv8[1], vv8[2], vv8[3]}; *(LAS f32x4*)(dv_ + 4) = (f32x4){vv8[4], vv8[5], vv8[6], vv8[7]}; } \
            *(LAS u32x4*)(lds + SL_TW + slot * 144 + cg8 * 2) = raw[3][1]; *(LAS u32x4*)(lds + SL_AD + slot * 144 + cg8 * 2) = raw[4][1]; \
        } else { const bool me1_ = ok1_ && p1_ < 16; const float fm_ = me1_ ? 1.0f : 0.0f; \
            _Pragma("unroll") for (int a = 0; a < 5; ++a) { \
                float pv_[8], cv_[8], nv_[8], o_[8]; unpack8(raw[a][0], pv_); unpack8(raw[a][1], cv_); unpack8(raw[a][2], nv_); \
                _Pragma("unroll") for (int e = 0; e < 8; ++e) { const float mp_ = fm_ * fMU[a * 64 + cg8 + e], mn_ = fm_ * fMU[320 + a * 64 + cg8 + e]; o_[e] = cv_[e] + mp_ * (pv_[e] - cv_[e]) + mn_ * (nv_[e] - cv_[e]); } \
                if (a == 0) { _Pragma("unroll") for (int e = 0; e < 8; ++e) rv[e] = o_[e]; \
                    *(LAS f32x4*)(fSb_ + 256 + cg8) = (f32x4){o_[0], o_[1], o_[2], o_[3]}; *(LAS f32x4*)(fSb_ + 256 + cg8 + 4) = (f32x4){o_[4], o_[5], o_[6], o_[7]}; } \
                else if (a == 1) { _Pragma("unroll") for (int e = 0; e < 8; ++e) kv[e] = o_[e]; } \
                else if (a == 2) { if ((cg8 >> 4) == rp) { LAS float* dv_ = fV + (buf) * 512 + slot * 16 + (cg8 & 15); *(LAS f32x4*)dv_ = (f32x4){o_[0], o_[1], o_[2], o_[3]}; *(LAS f32x4*)(dv_ + 4) = (f32x4){o_[4], o_[5], o_[6], o_[7]}; } } \
                else { if (a == 3) { _Pragma("unroll") for (int e = 0; e < 8; ++e) o_[e] = me1_ ? fast_tanh(o_[e]) : o_[e]; } \
                    u32x4 w_; w_.x = cvtpk(o_[0], o_[1]); w_.y = cvtpk(o_[2], o_[3]); w_.z = cvtpk(o_[4], o_[5]); w_.w = cvtpk(o_[6], o_[7]); \
                    *(LAS u32x4*)(lds + (a == 3 ? SL_TW : SL_AD) + slot * 144 + cg8 * 2) = w_; } } } \
        asm volatile("s_waitcnt lgkmcnt(0)" ::: "memory"); \
          \
        { f32x4 acc_[2][4]; \
          _Pragma("unroll") for (int m2 = 0; m2 < 2; ++m2) { const LAS unsigned char* Ab_ = lds + (m2 ? SL_AD : SL_TW) + (pw * 8 + (lane & 15)) * 144 + (lane >> 4) * 16; \
              const bf16x8 a0_ = *(const LAS bf16x8*)Ab_, a1_ = *(const LAS bf16x8*)(Ab_ + 64); \
              _Pragma("unroll") for (int nt = 0; nt < 4; ++nt) { f32x4 z_ = {0.f, 0.f, 0.f, 0.f}; const LAS unsigned char* Bb_ = lds + SL_WB + m2 * 9216 + (nt * 16 + (lane & 15)) * 144 + (lane >> 4) * 16; \
                  z_ = __builtin_amdgcn_mfma_f32_16x16x32_bf16(a0_, *(const LAS bf16x8*)Bb_, z_, 0, 0, 0); acc_[m2][nt] = __builtin_amdgcn_mfma_f32_16x16x32_bf16(a1_, *(const LAS bf16x8*)(Bb_ + 64), z_, 0, 0, 0); } } \
          if (lane < 32) { \
              _Pragma("unroll") for (int nt = 0; nt < 4; ++nt) _Pragma("unroll") for (int rg = 0; rg < 4; ++rg) { const int row_ = (lane >> 4) * 4 + rg, col_ = nt * 16 + (lane & 15); \
                  const float sw_ = fast_sigmoid(acc_[0][nt][rg] + bias[0][nt]); fS[(buf) * 10240 + (pw * 8 + row_) * 320 + 64 + col_] = __builtin_amdgcn_exp2f(-0.6065306597126334f * LOG2E * sw_); \
                  fAS[pw * 512 + row_ * 64 + col_] = fast_sigmoid(acc_[1][nt][rg] + bias[1][nt]); } } } \
        asm volatile("s_waitcnt lgkmcnt(0)" ::: "memory"); \
          \
        { const f32x4 a0 = *(const LAS f32x4*)(fAS + pw * 512 + sl8 * 64 + cg8), a1 = *(const LAS f32x4*)(fAS + pw * 512 + sl8 * 64 + cg8 + 4); \
          const f32x4 kk0 = *(const LAS f32x4*)(fMU + 640 + cg8), kk1 = *(const LAS f32x4*)(fMU + 640 + cg8 + 4), ka0 = *(const LAS f32x4*)(fMU + 704 + cg8), ka1 = *(const LAS f32x4*)(fMU + 704 + cg8 + 4); \
          const f32x4 rk0 = *(const LAS f32x4*)(fMU + 768 + cg8), rk1 = *(const LAS f32x4*)(fMU + 768 + cg8 + 4); \
          float kkv[8], kd[8], av[8]; float ssq = 0.f, cs = 0.f; \
          _Pragma("unroll") for (int e = 0; e < 8; ++e) { av[e] = e < 4 ? a0[e & 3] : a1[e & 3]; \
              kkv[e] = kv[e] * (e < 4 ? kk0[e & 3] : kk1[e & 3]); ssq = fmaf(kkv[e], kkv[e], ssq); \
              kd[e] = kv[e] * (1.0f + (av[e] - 1.0f) * (e < 4 ? ka0[e & 3] : ka1[e & 3])); cs = fmaf(rv[e] * kd[e], e < 4 ? rk0[e & 3] : rk1[e & 3], cs); } \
          ssq = grp_sum<8>(ssq); cs = grp_sum<8>(cs); \
          const float rs = rsqrtf(fmaxf(ssq, 1e-24f)); \
          _Pragma("unroll") for (int e = 0; e < 8; ++e) { kkv[e] *= rs; av[e] *= kkv[e]; } \
          *(LAS f32x4*)(fSb_ + cg8) = (f32x4){kkv[0], kkv[1], kkv[2], kkv[3]}; *(LAS f32x4*)(fSb_ + cg8 + 4) = (f32x4){kkv[4], kkv[5], kkv[6], kkv[7]}; \
          *(LAS f32x4*)(fSb_ + 128 + cg8) = (f32x4){av[0], av[1], av[2], av[3]}; *(LAS f32x4*)(fSb_ + 128 + cg8 + 4) = (f32x4){av[4], av[5], av[6], av[7]}; \
          *(LAS f32x4*)(fSb_ + 192 + cg8) = (f32x4){kd[0], kd[1], kd[2], kd[3]}; *(LAS f32x4*)(fSb_ + 192 + cg8 + 4) = (f32x4){kd[4], kd[5], kd[6], kd[7]}; \
          if (cg8 == 0 && rp == 0 && ok1_) CB[((size_t)d * ROWS + pos_row(base, p1_)) * 8 + h] = cs; } } while (0)
#define SL_STORE_Y(hc, buf) do { const int sl5_ = lane >> 1, hf_ = lane & 1; const int i5_ = 32 * (hc) + sl5_; const int p5_ = d ? Ltot - 1 - i5_ : i5_; \
        if (i5_ < Ltot && p5_ >= 16) { const LAS float* yp_ = fY + (buf) * 512 + sl5_ * 16 + hf_ * 8; const f32x4 y0_ = *(const LAS f32x4*)yp_, y1_ = *(const LAS f32x4*)(yp_ + 4); \
            *(u32x4*)(YD + (size_t)(base + p5_ - 16) * 512 + h * 64 + rp * 16 + hf_ * 8) = pack8(y0_, y1_); } } while (0)
    BAR_LDS();
    if (!scanner) { SL_LOAD(0); SL_PREP(0, 0); if (nhalf > 1) SL_LOAD(1); }
    BAR_LDS();
#pragma unroll 1
    for (int hc = 0; hc < nhalf; ++hc) {
        if (scanner) {
            typedef float f32x2_ __attribute__((ext_vector_type(2)));
            const int nvalid = (Ltot - 32 * hc) < 32 ? (Ltot - 32 * hc) : 32, buf = hc & 1;
            const LAS float* ps = fS + buf * 10240 + kg * 4; const LAS float* pv = fV + buf * 512 + srl; LAS float* py = fY + buf * 512 + srl;
            f32x4 nk, nw, nb, nd, nr; float nv;
#define SL_FETCH(sl_) do { nk = *(const LAS f32x4*)(ps + (sl_) * 320); nw = *(const LAS f32x4*)(ps + (sl_) * 320 + 64); nb = *(const LAS f32x4*)(ps + (sl_) * 320 + 128); \
                nd = *(const LAS f32x4*)(ps + (sl_) * 320 + 192); nr = *(const LAS f32x4*)(ps + (sl_) * 320 + 256); nv = pv[(sl_) * 16]; } while (0)
            SL_FETCH(0);
            f32x4 rp4 = {0.f, 0.f, 0.f, 0.f};
            if (nvalid == 32) {
#pragma unroll
            for (int sl = 0; sl < 32; ++sl) {
                const f32x4 ck = nk, cw = nw, cb = nb, cd = nd, cr = nr; const float vv = nv;
                SL_FETCH(sl + 1 < 32 ? sl + 1 : 31);
                f32x2_ pa = {0.f, 0.f}, ya = {0.f, 0.f};
#pragma unroll
                for (int e = 0; e < 4; e += 2) { const f32x2_ s2 = {S[e], S[e + 1]}, k2 = {ck[e], ck[e + 1]}, r2 = {rp4[e], rp4[e + 1]}; pa = pa + s2 * k2; ya = ya + s2 * r2; }
                float pp = pa.x + pa.y, yy = ya.x + ya.y;
                pp = dpp_add(pp, 0); yy = dpp_add(yy, 0); pp = dpp_add(pp, 1); yy = dpp_add(yy, 1); pp = dpp_add(pp, 2); yy = dpp_add(yy, 2); pp = dpp_add(pp, 3); yy = dpp_add(yy, 3);
                py[(sl > 0 ? sl - 1 : 0) * 16] = yy;
#pragma unroll
                for (int e = 0; e < 4; e += 2) { const f32x2_ b2 = {cb[e], cb[e + 1]}, d2 = {cd[e], cd[e + 1]}, w2 = {cw[e], cw[e + 1]}; f32x2_ s2 = {S[e], S[e + 1]};
                    const f32x2_ t2 = d2 * vv - b2 * pp; s2 = s2 * w2 + t2; S[e] = s2.x; S[e + 1] = s2.y; }
                rp4 = cr;
            }
            } else {
#pragma unroll 16
            for (int sl = 0; sl < nvalid; ++sl) {
                const f32x4 ck = nk, cw = nw, cb = nb, cd = nd, cr = nr; const float vv = nv;
                SL_FETCH(sl + 1 < 32 ? sl + 1 : 31);
                f32x2_ pa = {0.f, 0.f}, ya = {0.f, 0.f};
#pragma unroll
                for (int e = 0; e < 4; e += 2) { const f32x2_ s2 = {S[e], S[e + 1]}, k2 = {ck[e], ck[e + 1]}, r2 = {rp4[e], rp4[e + 1]}; pa = pa + s2 * k2; ya = ya + s2 * r2; }
                float pp = pa.x + pa.y, yy = ya.x + ya.y;
                pp = dpp_add(pp, 0); yy = dpp_add(yy, 0); pp = dpp_add(pp, 1); yy = dpp_add(yy, 1); pp = dpp_add(pp, 2); yy = dpp_add(yy, 2); pp = dpp_add(pp, 3); yy = dpp_add(yy, 3);
                py[(sl > 0 ? sl - 1 : 0) * 16] = yy;
#pragma unroll
                for (int e = 0; e < 4; e += 2) { const f32x2_ b2 = {cb[e], cb[e + 1]}, d2 = {cd[e], cd[e + 1]}, w2 = {cw[e], cw[e + 1]}; f32x2_ s2 = {S[e], S[e + 1]};
                    const f32x2_ t2 = d2 * vv - b2 * pp; s2 = s2 * w2 + t2; S[e] = s2.x; S[e + 1] = s2.y; }
                rp4 = cr;
            }
            }
            { f32x2_ ya = {0.f, 0.f};
#pragma unroll
              for (int e = 0; e < 4; e += 2) { const f32x2_ s2 = {S[e], S[e + 1]}, r2 = {rp4[e], rp4[e + 1]}; ya = ya + s2 * r2; }
              const float yy = grp_sum<16>(ya.x + ya.y); py[(nvalid - 1) * 16] = yy; }
#undef SL_FETCH
        } else {
            if (hc > 0 && pw == 0) SL_STORE_Y(hc - 1, (hc - 1) & 1);
            if (hc + 1 < nhalf) { SL_PREP(hc + 1, (hc + 1) & 1); if (hc + 2 < nhalf) SL_LOAD(hc + 2); }
        }
        BAR_LDS();
    }
    if (!scanner && pw == 0) SL_STORE_Y(nhalf - 1, (nhalf - 1) & 1);
#undef SL_STORE_Y
#undef SL_PREP
#undef SL_LOAD
#undef SL_META
}

__device__ __forceinline__ void rwkv_colmap(unsigned char* ws, int c0, bf16*& buf, int& ld, int& col) {
    if (c0 < 512) { buf = (bf16*)(ws + WS_R); ld = 512; col = c0; }
    else if (c0 < 1024) { buf = (bf16*)(ws + WS_KA); ld = 512; col = c0 - 512; }
    else if (c0 < 1536) { buf = (bf16*)(ws + WS_VA); ld = 512; col = c0 - 1024; }
    else { buf = (bf16*)(ws + WS_L); ld = 256; col = c0 - 1536; }
}
__device__ __forceinline__ void phase_halo(KP P) {
    const int tid = fresh_tid(), lane = tid & 63, wid = tid >> 6; const int gw = blockIdx.x * 8 + wid, NGW = gridDim.x * 8;
    unsigned char* ws = P->ws;
    for (int r = gw; r < (NMAIN / 64) * 2; r += NGW) {
        const int m = (r >> 1) * 64 + ((r & 1) ? 63 : 0);
        for (int j = lane; j < 224; j += 64) { bf16* buf; int ld, col; rwkv_colmap(ws, j * 8, buf, ld, col);
            *(u32x4*)(ws + WS_HALO + (size_t)r * HALO_ROW + j * 16) = *(const u32x4*)(buf + (size_t)m * ld + col); }
    }
}
__device__ __forceinline__ void phase_shift(LAS unsigned char* lds, KP P) {
    const int tid = fresh_tid(), slot = tid >> 3, cg = tid & 7;
    unsigned char* ws = P->ws; const float* mup = P->in[I_MUP]; const float* mun = P->in[I_MUN];
    for (int tile = blockIdx.x; tile < NMAIN / 64; tile += gridDim.x) {
        const int m0 = tile * 64, m = m0 + slot;
        const int ks = m0 < 16384 ? tile : ((m0 - 16384) & 2047) >> 6; const bool first = ks == 0, last = ks == (m0 < 16384 ? 255 : 31);
#pragma unroll 1
        for (int pass = 0; pass < 4; ++pass) {
#pragma unroll
            for (int i = 0; i < 7; ++i) { const int j = cg + 8 * i; bf16* buf; int ld, col; rwkv_colmap(ws, (pass * 56 + j) * 8, buf, ld, col);
                *(LAS u32x4*)(lds + (slot * 56 + j) * 16) = *(const u32x4*)(buf + (size_t)m * ld + col); }
            __syncthreads();
#pragma unroll
            for (int i = 0; i < 7; ++i) {
                const int j = cg + 8 * i, c0 = (pass * 56 + j) * 8; bf16* buf; int ld, col; rwkv_colmap(ws, c0, buf, ld, col);
                const u32x4 z = {0u, 0u, 0u, 0u};
                const u32x4 cu = *(const LAS u32x4*)(lds + (slot * 56 + j) * 16);
                u32x4 pu, nu;
                if (slot > 0) pu = *(const LAS u32x4*)(lds + ((slot - 1) * 56 + j) * 16);
                else pu = first ? *(const u32x4*)(buf + (size_t)(METAROW + 15) * ld + col) : *(const u32x4*)(ws + WS_HALO + (size_t)((tile - 1) * 2 + 1) * HALO_ROW + c0 * 2);
                if (slot < 63) nu = *(const LAS u32x4*)(lds + ((slot + 1) * 56 + j) * 16);
                else nu = last ? z : *(const u32x4*)(ws + WS_HALO + (size_t)((tile + 1) * 2) * HALO_ROW + c0 * 2);
                float pv[8], cv[8], nv[8], o[8]; unpack8(pu, pv); unpack8(cu, cv); unpack8(nu, nv);
                const f32x4 mp0 = *(const f32x4*)(mup + c0), mp1 = *(const f32x4*)(mup + c0 + 4), mn0 = *(const f32x4*)(mun + c0), mn1 = *(const f32x4*)(mun + c0 + 4);
#pragma unroll
                for (int e = 0; e < 8; ++e) { const float mp = e < 4 ? mp0[e & 3] : mp1[e & 3], mn = e < 4 ? mn0[e & 3] : mn1[e & 3]; o[e] = cv[e] + mp * (pv[e] - cv[e]) + mn * (nv[e] - cv[e]); }
                if (c0 >= 1536 && c0 < 1600) {
#pragma unroll
                    for (int e = 0; e < 8; ++e) o[e] = fast_tanh(o[e]);
                }
                u32x4 w; w.x = cvtpk(o[0], o[1]); w.y = cvtpk(o[2], o[3]); w.z = cvtpk(o[4], o[5]); w.w = cvtpk(o[6], o[7]);
                *(u32x4*)(buf + (size_t)m * ld + col) = w;
            }
            __syncthreads();
        }
    }
}

__device__ __forceinline__ void phase_post(LAS unsigned char* lds, KP P) {
    const int tid = fresh_tid(), lane = tid & 63, wid = tid >> 6;
    unsigned char* ws = P->ws;
    const bf16* VAb = (const bf16*)(ws + WS_VA); const bf16* Lb = (const bf16*)(ws + WS_L); bf16* Rb = (bf16*)(ws + WS_R);
    const float* CB = (const float*)(ws + WS_CB); const bf16* YD0 = (const bf16*)((const unsigned char*)P->out + 64 * MiB); const bf16* YD1 = YD0 + (size_t)NMAIN * 512;
    const bf16* GT = (const bf16*)(ws + WS_LORA + 262144);
    LAS float* st = (LAS float*)(lds + 17408);
    const float* mup = P->in[I_MUP]; const float* mun = P->in[I_MUN];
    for (int tile = blockIdx.x; tile < NMAIN / 64; tile += gridDim.x) {
        {
            const int row = tid >> 3, hh = tid & 7, m = tile * 64 + row;
            const int t = m < 16384 ? m : (m - 16384) & 2047, Ls = m < 16384 ? 16384 : 2048;
            float sum = 0.f, sq = 0.f;
#pragma unroll
            for (int i = 0; i < 8; ++i) { float a[8], b[8]; unpack8(*(const u32x4*)(YD0 + (size_t)m * 512 + hh * 64 + i * 8), a); unpack8(*(const u32x4*)(YD1 + (size_t)m * 512 + hh * 64 + i * 8), b);
#pragma unroll
                for (int e = 0; e < 8; ++e) { const float y = a[e] + b[e]; sum += y; sq += y * y; } }
            const float mu = sum * (1.0f / 64.0f); const float var = fmaxf(sq * (1.0f / 64.0f) - mu * mu, 0.f);
            st[(row * 8 + hh) * 2] = mu; st[(row * 8 + hh) * 2 + 1] = rsqrtf(var + 64e-5f);
#pragma unroll
            for (int i = 0; i < 2; ++i) {
                const int c0 = 128 + hh * 16 + i * 8; float cv[8], o[8];
                unpack8(*(const u32x4*)(Lb + (size_t)m * 256 + c0), cv);
#pragma unroll
                for (int e = 0; e < 8; ++e) o[e] = sigmoidf_(cv[e]);
                u32x4 w; w.x = cvtpk(o[0], o[1]); w.y = cvtpk(o[2], o[3]); w.z = cvtpk(o[4], o[5]); w.w = cvtpk(o[6], o[7]);
                *(LAS u32x4*)(lds + row * 272 + (hh * 16 + i * 8) * 2) = w;
            }
        }
        __syncthreads();
#pragma unroll 1
        for (int nt = 0; nt < 4; ++nt) {
            const int col = wid * 64 + nt * 16 + (lane & 15);
            bf16x8 bfr[4];
#pragma unroll
            for (int ks = 0; ks < 4; ++ks) bfr[ks] = *(const bf16x8*)(GT + (size_t)col * 128 + ks * 32 + (lane >> 4) * 8);
            const float lw = P->in[I_LNW][col], lb = P->in[I_LNB][col];
            const float mpv = mup[1024 + col], mnv = mun[1024 + col];
#pragma unroll 1
            for (int mt = 0; mt < 4; ++mt) {
                f32x4 acc = {0.f, 0.f, 0.f, 0.f};
#pragma unroll
                for (int ks = 0; ks < 4; ++ks) { const bf16x8 a = *(const LAS bf16x8*)(lds + (mt * 16 + (lane & 15)) * 272 + ks * 64 + (lane >> 4) * 16); acc = __builtin_amdgcn_mfma_f32_16x16x32_bf16(a, bfr[ks], acc, 0, 0, 0); }
#pragma unroll
                for (int rg = 0; rg < 4; ++rg) {
                    const int row = mt * 16 + (lane >> 4) * 4 + rg, m = tile * 64 + row;
                    const int t = m < 16384 ? m : (m - 16384) & 2047, Ls = m < 16384 ? 16384 : 2048;
                    const float y = bf2f(YD0[(size_t)m * 512 + col]) + bf2f(YD1[(size_t)m * 512 + col]);
                    const float yn = (y - st[(row * 8 + wid) * 2]) * st[(row * 8 + wid) * 2 + 1] * lw + lb;
                    const float vs = bf2f(VAb[(size_t)m * 512 + col]);
                    const float cb = CB[(size_t)m * 8 + wid] + CB[((size_t)ROWS + m) * 8 + wid];
                    Rb[(size_t)m * 512 + col] = (bf16)f2bf_rne((yn + cb * vs) * acc[rg]);
                }
            }
        }
        __syncthreads();
    }
}

__device__ __forceinline__ void phase_rms_bf16(KP P) {
    const int tid = fresh_tid(), lane = tid & 63, wid = tid >> 6; const int gw = blockIdx.x * 8 + wid, NGW = gridDim.x * 8;
    bf16* MN = (bf16*)(P->ws + WS_MN);
    for (int m = gw; m < NMAIN; m += NGW) rms_row_bf16(P->out + (size_t)m * DM, P->in[I_GFFN], MN + (size_t)m * DM, lane);
}
__device__ __forceinline__ void phase_final(KP P) {
    const int tid = fresh_tid(), lane = tid & 63, wid = tid >> 6; const int gw = blockIdx.x * 8 + wid, NGW = gridDim.x * 8;
    const f32x4* gr = (const f32x4*)P->in[I_GFIN] + lane;
    for (int m = gw; m < NMAIN; m += NGW) {
        f32x4* xr = (f32x4*)(P->out + (size_t)m * DM) + lane; f32x4 v[4]; float s = 0.f;
#pragma unroll
        for (int j = 0; j < 4; ++j) { v[j] = xr[64 * j]; s += (v[j].x * v[j].x + v[j].y * v[j].y) + (v[j].z * v[j].z + v[j].w * v[j].w); }
        const float rstd = rsqrtf(wave_sum(s) * (1.f / DM) + 1e-6f);
#pragma unroll
        for (int j = 0; j < 4; ++j) xr[64 * j] = v[j] * rstd * gr[64 * j];
    }
}

constexpr int NRP_LONG = 4;
constexpr int N_LONG = 16 * NRP_LONG, N_ATT_P = 512, N_ATT_S = 512, N_SHORT = 128, N_ITEMS = N_LONG + N_ATT_P + N_ATT_S + N_SHORT;

template <class Op> __device__ __forceinline__ void run_gemm(LAS unsigned char* lds, const bf16* A, const bf16* Bt, int M, int N, int K, const Op& op, const bf16* A2 = nullptr, int pm2 = 1 << 30) {
    pg8::Gemm g{A, Bt, M, N, K, A2, pm2}; pg8::StaticOrder S; S.init(M, N, (int)gridDim.x, (int)blockIdx.x);
    Epi8<Op> E{op};
    pg8::gemm_phase<Epi8<Op>, pg8::StaticOrder, true, true>(lds, g, S, E);
}

constexpr size_t WS_XBAR = 16384;
#define XB_TMO      128
#define XB_XCNT(j)  (256  + 64 * (j))
#define XB_XSUB(j)  (1280 + 64 * (j))
#define XB_XGEN(j)  (2304 + 64 * (j))
#define XB_TOP      3328
#define XB_TOPGEN   3392
#define XCD_BAR_WORDS 3456
#define XB_SPIN_CAP (1u << 18)
__device__ __forceinline__ unsigned xb_ld(unsigned* p)              { return __hip_atomic_load(p, __ATOMIC_RELAXED, __HIP_MEMORY_SCOPE_AGENT); }
__device__ __forceinline__ unsigned xb_add(unsigned* p, unsigned v) { return __hip_atomic_fetch_add(p, v, __ATOMIC_RELAXED, __HIP_MEMORY_SCOPE_AGENT); }
__device__ __forceinline__ unsigned xb_xcc_id() { return (unsigned)__builtin_amdgcn_s_getreg((3 << 11) | 20) & 0xFu; }
#define XB_SPIN(cond, bar) do { unsigned _sp = 0; while (cond) { __builtin_amdgcn_s_sleep(1); \
    if ((++_sp & 255u) == 0u) { if (xb_ld(&(bar)[XB_TMO])) break; if (_sp > XB_SPIN_CAP) { atomicAdd(&(bar)[XB_TMO], 1u); break; } } } } while (0)
struct XcdBarrier { unsigned* bar; unsigned x; volatile LAS unsigned* st; };
__device__ __forceinline__ XcdBarrier xcd_barrier_post(unsigned* bar, volatile LAS unsigned* st) {
    XcdBarrier b; b.bar = bar; b.x = xb_xcc_id(); b.st = st;
    if (threadIdx.x == 0) (void)xb_add(&bar[XB_XCNT(b.x)], 1u);
    return b;
}
__device__ __forceinline__ void xcd_barrier_complete(unsigned* bar, unsigned x, unsigned& nloc, unsigned& nx) {
    const unsigned G = gridDim.x * gridDim.y * gridDim.z;
    unsigned sum, cnt, mine, sp = 0u;
    for (;;) {
        sum = 0u; cnt = 0u; mine = 0u;
#pragma unroll
        for (unsigned j = 0; j < 16; ++j) { const unsigned c = xb_ld(&bar[XB_XCNT(j)]); sum += c; cnt += (c > 0u) ? 1u : 0u; mine = (j == x) ? c : mine; }
        if (sum == G) break;
        __builtin_amdgcn_s_sleep(1);
        if ((++sp & 255u) == 0u) { if (xb_ld(&bar[XB_TMO])) break; if (sp > XB_SPIN_CAP) { atomicAdd(&bar[XB_TMO], 1u); break; } }
    }
    nloc = mine > 0u ? mine : 1u; nx = cnt > 0u ? cnt : 1u;
}
__device__ __forceinline__ void xcd_barrier(const XcdBarrier& b) {
    asm volatile("s_waitcnt vmcnt(0)" ::: "memory");
    __syncthreads();
    if (threadIdx.x == 0) {
        unsigned* bar = b.bar;
        __builtin_amdgcn_s_waitcnt(0);
        unsigned nloc = b.st[0], nx = b.st[1];
        if (nloc == 0u) { xcd_barrier_complete(bar, b.x, nloc, nx); b.st[0] = nloc; b.st[1] = nx; }
        const unsigned old = xb_add(&bar[XB_XSUB(b.x)], 1u);
        const unsigned gen = old / nloc;
        if (old + 1u == (gen + 1u) * nloc) {
            __builtin_amdgcn_fence(__ATOMIC_RELEASE, "agent");
            asm volatile("s_waitcnt vmcnt(0)" ::: "memory");
            const unsigned og = xb_add(&bar[XB_TOP], 1u);
            const unsigned tg = og / nx;
            if (og + 1u == (tg + 1u) * nx) xb_add(&bar[XB_TOPGEN], 1u);
            else XB_SPIN(xb_ld(&bar[XB_TOPGEN]) == tg, bar);
            __builtin_amdgcn_fence(__ATOMIC_ACQUIRE, "agent");
            xb_add(&bar[XB_XGEN(b.x)], 1u);
            asm volatile("s_waitcnt vmcnt(0)" ::: "memory");
        } else {
            XB_SPIN(xb_ld(&bar[XB_XGEN(b.x)]) == gen, bar);
            __builtin_amdgcn_fence(__ATOMIC_ACQUIRE, "agent");
            asm volatile("s_waitcnt vmcnt(0)" ::: "memory");
        }
    }
    __syncthreads();
}
#ifndef PROBE_MASK
#define PROBE_MASK 0
#endif
#ifndef PROBE_MUL
#define PROBE_MUL 1
#endif
#define PH_BEGIN(k) unsigned long long t0_##k = 0; if (PROBE_MASK & (1 << (k))) t0_##k = __builtin_amdgcn_s_memrealtime();
#define PH_END(k) if (PROBE_MASK & (1 << (k))) { const unsigned long long t1_ = __builtin_amdgcn_s_memrealtime(); const unsigned long long dt_ = (t1_ - t0_##k) * PROBE_MUL; while (__builtin_amdgcn_s_memrealtime() - t1_ < dt_) __builtin_amdgcn_s_sleep(8); xcd_barrier(xbar); }
__global__ void __launch_bounds__(NTHREADS) fwd_megakernel(Params Pin) {
    extern __shared__ __attribute__((aligned(16))) unsigned char lds_raw[];
    LAS unsigned char* lds = (LAS unsigned char*)lds_raw;
    cg::grid_group grid = cg::this_grid();
    KP P0 = (KP)__builtin_amdgcn_kernarg_segment_ptr();
    volatile LAS unsigned* xst = (volatile LAS unsigned*)(lds + LDS_ITEM_OFF + 4);
    if (threadIdx.x == 0) { xst[0] = 0u; xst[1] = 0u; }
    __syncthreads();
    const XcdBarrier xbar = xcd_barrier_post((unsigned*)(P0->ws + WS_XBAR), xst);
#define NEWPHASE KP P = P0; asm volatile("" : "+s"(P)); unsigned char* ws = P->ws; (void)ws;

    PH_BEGIN(0)
    { NEWPHASE phase_prologue(lds, P); }
    grid.sync();
    PH_END(0)
    PH_BEGIN(1)
    { NEWPHASE run_gemm(lds, (const bf16*)P->out, (const bf16*)(ws + WS_WIN), ROWS, 3328, 1024, OpProj{ws}, (const bf16*)(ws + WS_XNMETA), 128); }
    xcd_barrier(xbar);
    PH_END(1)
    { NEWPHASE phase_halo(P); }
    xcd_barrier(xbar);
    { NEWPHASE phase_shift(lds, P); }
    xcd_barrier(xbar);
    PH_BEGIN(2)
    { NEWPHASE
        const int tid = fresh_tid();
        float lam;
        { const int lane = tid & 63; const float s1 = wave_sum(P->in[I_LQ1][lane] * P->in[I_LK1][lane]), s2 = wave_sum(P->in[I_LQ2][lane] * P->in[I_LK2][lane]); lam = __expf(s1) - __expf(s2) + 0.2f; }
        unsigned* ctr = (unsigned*)(ws + WS_CTL);
        LAS unsigned* slot = (LAS unsigned*)(lds + LDS_ITEM_OFF);
#define FETCH(k, n) if (tid == 0) *slot = atomicAdd(ctr + 64 * (k), 1u); __syncthreads(); const int idx = (int)*slot; __syncthreads(); if (idx >= (n)) break;
#ifndef NO_SCAN
#pragma unroll 1
        for (;;) { FETCH(0, N_LONG) const int u = idx / NRP_LONG; scan_long(lds, P, 0, u >> 3, u & 7, idx % NRP_LONG); }
#endif
#ifndef NO_ATTN
#pragma unroll 1
        for (;;) { FETCH(1, N_ATT_P + N_ATT_S)
            if (idx < N_ATT_P) attn_unit(lds, P, 0, idx >> 7, idx & 127, lam);
            else { const int a = idx - N_ATT_P; attn_unit(lds, P, 1 + (a >> 6), (a >> 4) & 3, a & 15, lam); } }
#endif
#ifndef NO_SCAN
#pragma unroll 1
        for (;;) { FETCH(2, N_SHORT) scan_unit<1, 8>(lds, P, 1 + (idx >> 4), (idx >> 3) & 1, idx & 7, 0); }
#endif
#undef FETCH
    }
    xcd_barrier(xbar);
    PH_END(2)
#ifndef NO_POST
    PH_BEGIN(3)
    { NEWPHASE phase_post(lds, P); }
#endif
    xcd_barrier(xbar);
    PH_END(3)
    PH_BEGIN(4)
    { NEWPHASE run_gemm(lds, (const bf16*)P->out, (const bf16*)(ws + WS_WIN) + (size_t)3328 * 1024, NMAIN, 1024, 1024, OpGate{(bf16*)(ws + WS_GA)}); }
    { NEWPHASE run_gemm(lds, (const bf16*)P->out, (const bf16*)(ws + WS_WIN) + (size_t)4352 * 1024, NMAIN, 1024, 1024, OpGate{(bf16*)(ws + WS_GB)}); }

    PH_END(4)
    PH_BEGIN(5)
    { NEWPHASE run_gemm(lds, (const bf16*)(ws + WS_R), (const bf16*)(ws + WS_WUPA), NMAIN, 1024, 512, OpUpA{ws}); }
    PH_END(5)
    PH_BEGIN(6)
    { NEWPHASE run_gemm(lds, (const bf16*)(ws + WS_Q), (const bf16*)(ws + WS_WUPB), NMAIN, 1024, 512, OpUpB{ws}); }
    xcd_barrier(xbar);
    PH_END(6)
    PH_BEGIN(7)
    { NEWPHASE run_gemm(lds, (const bf16*)(ws + WS_GB), (const bf16*)(ws + WS_WOUT), NMAIN, 1024, 1024, OpOut{P->in[I_XP], P->in[I_XS], P->out, P->in[I_GFFN], (bf16*)(ws + WS_MN), (float*)(ws + WS_SS)}); }
    xcd_barrier(xbar);
    PH_END(7)
    PH_BEGIN(9)
    { NEWPHASE run_gemm(lds, (const bf16*)(ws + WS_MN), (const bf16*)(ws + WS_WFF1), 16384, DFF, 1024, OpFF1{(bf16*)(ws + WS_HID), (const float*)(ws + WS_SS)}); }
    xcd_barrier(xbar);
    PH_END(9)
    PH_BEGIN(10)
    { NEWPHASE run_gemm(lds, (const bf16*)(ws + WS_HID), (const bf16*)(ws + WS_WFF2), 16384, 1024, DFF, OpFF2{P->out}); }
    xcd_barrier(xbar);
    PH_END(10)
    PH_BEGIN(11)
    { NEWPHASE run_gemm(lds, (const bf16*)(ws + WS_MN) + (size_t)16384 * DM, (const bf16*)(ws + WS_WFF1), 16384, DFF, 1024, OpFF1{(bf16*)(ws + WS_HID), (const float*)(ws + WS_SS) + 16384}); }
    xcd_barrier(xbar);
    PH_END(11)
    PH_BEGIN(12)
    { NEWPHASE run_gemm(lds, (const bf16*)(ws + WS_HID), (const bf16*)(ws + WS_WFF2), 16384, 1024, DFF, OpFF2{P->out + (size_t)16384 * DM}); }
    xcd_barrier(xbar);
    PH_END(12)
    PH_BEGIN(13)
    { NEWPHASE phase_final(P); }
}

extern "C" void kernel_launch(void* const* d_in, const int* in_sizes, int n_in, void* d_out, int out_size, void* d_ws, size_t ws_size, hipStream_t stream) {
    static int grid_blocks = 0;
    if (grid_blocks == 0) {
        int dev = 0, cus = 0, per_cu = 0;
        hipGetDevice(&dev);
        hipDeviceGetAttribute(&cus, hipDeviceAttributeMultiprocessorCount, dev);
        hipFuncSetAttribute((const void*)fwd_megakernel, hipFuncAttributeMaxDynamicSharedMemorySize, LDS_BYTES);
        hipOccupancyMaxActiveBlocksPerMultiprocessor(&per_cu, (const void*)fwd_megakernel, NTHREADS, LDS_BYTES);
        if (per_cu < 1) { fprintf(stderr, "kernel_launch: occupancy query says %d blocks per CU\n", per_cu); per_cu = 1; }
        grid_blocks = cus * per_cu;
        if (n_in != 29 || ws_size < WS_END) fprintf(stderr, "kernel_launch: unexpected n_in %d / ws_size %zu\n", n_in, ws_size);
    }
    hipMemsetAsync((unsigned char*)d_ws + WS_CTL, 0, 196608, stream);
    Params p{};
    for (int i = 0; i < 29; ++i) p.in[i] = (const float*)d_in[i];
    p.out = (float*)d_out; p.ws = (unsigned char*)d_ws;
    void* args[] = {&p};
    hipError_t e = hipLaunchCooperativeKernel((const void*)fwd_megakernel, dim3(grid_blocks), dim3(NTHREADS), args, LDS_BYTES, stream);
    if (e != hipSuccess) fprintf(stderr, "cooperative launch failed: %s (grid %d)\n", hipGetErrorString(e), grid_blocks);
}
```

```cpp
#include <hip/hip_runtime.h>
#include <hip/hip_cooperative_groups.h>
#include <cstdio>
#include <cstdint>
#include <cmath>
namespace cg = cooperative_groups;
__device__ __forceinline__ int fresh_tid() { int t = threadIdx.x; asm volatile("" : "+v"(t)); return t; }
namespace pg8 {
#define PG8_LAS __attribute__((address_space(3)))
typedef unsigned short bf16_t;
typedef short bf16x8 __attribute__((ext_vector_type(8)));
typedef float f32x4 __attribute__((ext_vector_type(4)));
typedef unsigned u32x4 __attribute__((ext_vector_type(4)));
constexpr int BM = 256, BK = 64, HALF = 128, HTB = HALF * BK * 2  , STAGE_BYTES = 8 * HTB, NXCD = 8, WGM = 8;

__host__ __device__ __forceinline__ int lds_byte(int r, int c) { const int st = (r >> 4) * 2 + (c >> 5), rr = r & 15, cc = c & 31, ob = rr * 64 + cc * 2; return st * 1024 + (ob ^ (((ob >> 9) & 1) << 5)); }
__host__ __device__ __forceinline__ void stage_rc(int b, int& R, int& C) { const int st = b / 1024, sb = b % 1024, swz = sb ^ (((sb >> 9) & 1) << 5); R = (st >> 1) * 16 + swz / 64; C = (st & 1) * 32 + (swz % 64) / 2; }
__host__ __device__ __forceinline__ int perm32(int rho) { const int n = rho >> 4, i = rho & 15; return 8 * (i >> 2) + 4 * n + (i & 3); }

struct Unit { int pm, pn; };
struct Gemm { const bf16_t* A; const bf16_t* Bt; int M, N, K; const bf16_t* A2; int pm2; };
__device__ __forceinline__ const char* gemm_abase(const Gemm& g, int pm, size_t tstep) { return pm >= g.pm2 ? (const char*)g.A2 + (size_t)(pm - g.pm2) * tstep : (const char*)g.A + (size_t)pm * tstep; }

struct StaticOrder {
    int nM, nN, nwg, G, c;
    __host__ __device__ void init(int M, int N, int G_, int c_) { nM = M / BM; nN = N / BM; nwg = nM * nN; G = G_; c = c_; }
    __host__ __device__ bool next(int i, Unit& u) const {
        const long L = (long)i * G + c; if (L >= nwg) return false;
        int wgid = (int)L; { const int q = nwg / NXCD, r = nwg % NXCD, xcd = wgid % NXCD, off = wgid / NXCD; wgid = (xcd < r ? xcd * (q + 1) : r * (q + 1) + (xcd - r) * q) + off; }
        const int nig = WGM * nN, gid = wgid / nig, fm = gid * WGM, gsz = (nM - fm) < WGM ? (nM - fm) : WGM;
        u.pm = fm + ((wgid % nig) % gsz); u.pn = (wgid % nig) / gsz; return true;
    }
    __device__ __forceinline__ void a_ready(const Unit&) const {}
    __device__ __forceinline__ void done(const Unit&) const {}
};


template <class Epi, class Sched, bool ALIGN_EPI = false, bool SP2 = false>
__device__ __forceinline__ void gemm_phase(PG8_LAS unsigned char* lds, const Gemm g, const Sched& S, const Epi& E) {
    const int tid = fresh_tid(), wid = __builtin_amdgcn_readfirstlane(tid >> 6), lane = tid & 63, wr = wid >> 2, wc = wid & 3, fr = lane & 15, fq = lane >> 4;
    const int K = g.K, nt = K / BK;
    unsigned voffA[2], voffB[2];
#pragma unroll
    for (int i = 0; i < 2; ++i) { int R, C; stage_rc(tid * 16 + i * 8192, R, C); const int Rb = Epi::PERM ? ((R & ~31) + perm32(R & 31)) : R;
        voffA[i] = (unsigned)(R * K + C) * 2u; voffB[i] = (unsigned)(Rb * K + C) * 2u; }
    const size_t kstep = (size_t)(BK * 2);
    const size_t hstep = (size_t)HALF * K * 2;
    const size_t tstep = 2 * hstep;
    const unsigned ldsw = (unsigned)wid * 1024u;
    const int aoff = lds_byte(wr * 64 + fr, fq * 8), boff = lds_byte(wc * 32 + fr, fq * 8);
#define PG8_SA(b, h) (((b) * 2 + (h)) * HTB)
#define PG8_SB(b, h) ((4 + (b) * 2 + (h)) * HTB)
#define PG8_STAGE(bufoff, gbase, voff) do { _Pragma("unroll") for (int _i = 0; _i < 2; ++_i) \
        __builtin_amdgcn_global_load_lds((const unsigned*)((const char*)(gbase) + (voff)[_i]), (PG8_LAS unsigned*)(lds + (bufoff) + ldsw + _i * 8192), 16, 0, 0); } while (0)
#define PG8_LDA(dst, b, h) do { _Pragma("unroll") for (int m = 0; m < 4; ++m) _Pragma("unroll") for (int k = 0; k < 2; ++k) dst[m][k] = *(const PG8_LAS bf16x8*)(lds + PG8_SA(b, h) + aoff + m * 2048 + k * 1024); } while (0)
#define PG8_LDB(dst, b, h) do { _Pragma("unroll") for (int n = 0; n < 2; ++n) _Pragma("unroll") for (int k = 0; k < 2; ++k) dst[n][k] = *(const PG8_LAS bf16x8*)(lds + PG8_SB(b, h) + boff + n * 2048 + k * 1024); } while (0)
#define PG8_MMA(ai, bj, At, Bt) do { __builtin_amdgcn_s_setprio(1); _Pragma("unroll") for (int m = 0; m < 4; ++m) _Pragma("unroll") for (int n = 0; n < 2; ++n) _Pragma("unroll") for (int k = 0; k < 2; ++k) \
        acc[ai][bj][m][n] = __builtin_amdgcn_mfma_f32_16x16x32_bf16(Bt[n][k], At[m][k], acc[ai][bj][m][n], 0, 0, 0); __builtin_amdgcn_s_setprio(0); } while (0)
#define PG8_WAIT_V(n) asm volatile("s_waitcnt vmcnt(" #n ")" ::: "memory")
#define PG8_WAIT_L(n) asm volatile("s_waitcnt lgkmcnt(" #n ")" ::: "memory")
#define PG8_BAR __builtin_amdgcn_s_barrier()
#define PG8_SCHED __builtin_amdgcn_sched_barrier(0)
    Unit cur, nxt; int ui = 0;
    if (!S.next(0, cur)) return;
    f32x4 acc[2][2][4][2];
#pragma unroll
    for (int a = 0; a < 2; ++a)
#pragma unroll
        for (int b = 0; b < 2; ++b)
#pragma unroll
            for (int m = 0; m < 4; ++m)
#pragma unroll
                for (int n = 0; n < 2; ++n) acc[a][b][m][n] = (f32x4){0.f, 0.f, 0.f, 0.f};
    bf16x8 At[4][2], B0[2][2], B1[2][2];
    const char* cA = gemm_abase(g, cur.pm, tstep); const char* cB = (const char*)g.Bt + (size_t)cur.pn * tstep;
    S.a_ready(cur);
    if constexpr (SP2) {
        PG8_STAGE(PG8_SB(0, 0), cB, voffB); PG8_STAGE(PG8_SB(0, 1), cB + hstep, voffB); PG8_STAGE(PG8_SA(0, 0), cA, voffA); PG8_STAGE(PG8_SA(0, 1), cA + hstep, voffA);
        if (wr == 1) PG8_BAR;
        PG8_WAIT_V(2); PG8_BAR;
        PG8_STAGE(PG8_SB(1, 0), cB + kstep, voffB); PG8_STAGE(PG8_SA(1, 0), cA + kstep, voffA); PG8_STAGE(PG8_SB(1, 1), cB + hstep + kstep, voffB);
        PG8_WAIT_V(6); PG8_BAR;
    } else {
        PG8_STAGE(PG8_SB(0, 0), cB, voffB); PG8_STAGE(PG8_SA(0, 0), cA, voffA); PG8_STAGE(PG8_SB(0, 1), cB + hstep, voffB); PG8_STAGE(PG8_SA(0, 1), cA + hstep, voffA);
        if (wr == 1) PG8_BAR;
        PG8_WAIT_V(4); PG8_BAR;
        PG8_STAGE(PG8_SB(1, 0), cB + kstep, voffB); PG8_STAGE(PG8_SA(1, 0), cA + kstep, voffA); PG8_STAGE(PG8_SB(1, 1), cB + hstep + kstep, voffB);
        PG8_WAIT_V(6); PG8_BAR;
    }
    for (;;) {
        const bool has_next = S.next(ui + 1, nxt);
        const char* nA = has_next ? gemm_abase(g, nxt.pm, tstep) : cA; const char* nB = has_next ? (const char*)g.Bt + (size_t)nxt.pn * tstep : cB;
        for (int t = 0; t < nt; t += 2) {
            const bool last = (t == nt - 2);
            const char* a1 = cA + (size_t)(t + 1) * kstep;
            const char* a2 = last ? nA : cA + (size_t)(t + 2) * kstep; const char* b2 = last ? nB : cB + (size_t)(t + 2) * kstep;
            const char* a3 = a2 + kstep; const char* b3 = b2 + kstep;
            if (last && has_next) S.a_ready(nxt);
            if constexpr (SP2) {
            PG8_LDB(B0, 0, 0); PG8_LDB(B1, 0, 1); PG8_SCHED; PG8_LDA(At, 0, 0); PG8_STAGE(PG8_SA(1, 1), a1 + hstep, voffA);
            PG8_WAIT_V(8); PG8_WAIT_L(0); PG8_BAR; PG8_MMA(0, 0, At, B0); PG8_MMA(0, 1, At, B1); PG8_BAR; PG8_SCHED;
            PG8_LDA(At, 0, 1); PG8_STAGE(PG8_SB(0, 0), b2, voffB); PG8_STAGE(PG8_SB(0, 1), b2 + hstep, voffB); PG8_STAGE(PG8_SA(0, 0), a2, voffA);
            PG8_WAIT_V(8); PG8_WAIT_L(0); PG8_BAR; PG8_MMA(1, 0, At, B0); PG8_MMA(1, 1, At, B1); PG8_BAR; PG8_SCHED;
            PG8_LDB(B0, 1, 0); PG8_LDB(B1, 1, 1); PG8_SCHED; PG8_LDA(At, 1, 0); PG8_STAGE(PG8_SA(0, 1), a2 + hstep, voffA);
            PG8_WAIT_V(8); PG8_WAIT_L(0); PG8_BAR; PG8_MMA(0, 0, At, B0); PG8_MMA(0, 1, At, B1); PG8_BAR; PG8_SCHED;
            PG8_LDA(At, 1, 1); PG8_STAGE(PG8_SB(1, 0), b3, voffB); PG8_STAGE(PG8_SB(1, 1), b3 + hstep, voffB); PG8_STAGE(PG8_SA(1, 0), a3, voffA);
            PG8_WAIT_V(8); PG8_WAIT_L(0); PG8_BAR; PG8_MMA(1, 0, At, B0); PG8_MMA(1, 1, At, B1); PG8_BAR; PG8_SCHED;
            } else {
            PG8_LDB(B0, 0, 0); PG8_SCHED; PG8_LDA(At, 0, 0); PG8_STAGE(PG8_SA(1, 1), a1 + hstep, voffA);
            PG8_WAIT_L(8); PG8_BAR; PG8_WAIT_L(0); PG8_MMA(0, 0, At, B0); PG8_BAR; PG8_SCHED;
            PG8_LDB(B1, 0, 1); PG8_STAGE(PG8_SB(0, 0), b2, voffB);
            PG8_BAR; PG8_WAIT_L(0); PG8_MMA(0, 1, At, B1); PG8_BAR;
            PG8_LDA(At, 0, 1); PG8_STAGE(PG8_SA(0, 0), a2, voffA);
            PG8_BAR; PG8_WAIT_L(0); PG8_MMA(1, 0, At, B0); PG8_BAR; PG8_SCHED;
            PG8_STAGE(PG8_SB(0, 1), b2 + hstep, voffB);
            PG8_WAIT_V(6); PG8_BAR; PG8_MMA(1, 1, At, B1); PG8_BAR;
            PG8_LDB(B0, 1, 0); PG8_SCHED; PG8_LDA(At, 1, 0); PG8_STAGE(PG8_SA(0, 1), a2 + hstep, voffA);
            PG8_WAIT_L(8); PG8_BAR; PG8_WAIT_L(0); PG8_MMA(0, 0, At, B0); PG8_BAR; PG8_SCHED;
            PG8_LDB(B1, 1, 1); PG8_STAGE(PG8_SB(1, 0), b3, voffB);
            PG8_BAR; PG8_WAIT_L(0); PG8_MMA(0, 1, At, B1); PG8_BAR;
            PG8_LDA(At, 1, 1); PG8_STAGE(PG8_SA(1, 0), a3, voffA);
            PG8_BAR; PG8_WAIT_L(0); PG8_MMA(1, 0, At, B0); PG8_BAR; PG8_SCHED;
            PG8_STAGE(PG8_SB(1, 1), b3 + hstep, voffB);
            PG8_WAIT_V(6); PG8_BAR; PG8_MMA(1, 1, At, B1); PG8_BAR;
            }
        }
        if constexpr (ALIGN_EPI) { if (wr == 0) PG8_BAR; }
        if constexpr (!Epi::AFTER_DRAIN) { E(acc, cur, wr, wc, fr, fq); S.done(cur); }
        if (!has_next) break;
#pragma unroll
        for (int a = 0; a < 2; ++a)
#pragma unroll
            for (int b = 0; b < 2; ++b)
#pragma unroll
                for (int m = 0; m < 4; ++m)
#pragma unroll
                    for (int n = 0; n < 2; ++n) acc[a][b][m][n] = (f32x4){0.f, 0.f, 0.f, 0.f};
        cur = nxt; cA = nA; cB = nB; ++ui;
        if constexpr (ALIGN_EPI) { if (wr == 1) PG8_BAR; }
    }
    PG8_WAIT_V(0);
    if constexpr (!ALIGN_EPI) { if (wr == 0) PG8_BAR; }
    PG8_BAR;
    if constexpr (Epi::AFTER_DRAIN) { E.fused(acc, cur, wr, wc, fr, fq, lds, wid, lane); S.done(cur); }
#undef PG8_SA
#undef PG8_SB
#undef PG8_STAGE
#undef PG8_LDA
#undef PG8_LDB
#undef PG8_MMA
#undef PG8_WAIT_V
#undef PG8_WAIT_L
#undef PG8_BAR
#undef PG8_SCHED
}
}

#ifndef PG8_SP2
#define PG8_SP2 true
#endif

#define LAS __attribute__((address_space(3)))
typedef unsigned short bf16;
typedef short bf16x8 __attribute__((ext_vector_type(8)));
typedef float f32x4 __attribute__((ext_vector_type(4)));
typedef float f32x16 __attribute__((ext_vector_type(16)));
typedef unsigned u32x4 __attribute__((ext_vector_type(4)));
typedef unsigned u32x2 __attribute__((ext_vector_type(2)));

constexpr int DM = 1024, NMAIN = 32768, ROWS = 33024, METAROW = 32768, DFF = 4096;
constexpr int NTHREADS = 512;
constexpr int LDS_BYTES = 147456;
constexpr int LDS_ITEM_OFF = LDS_BYTES - 16;
constexpr size_t MiB = 1u << 20;
constexpr size_t WS_CTL = 0, WS_WIN = 1 * MiB, WS_WUPA = 12 * MiB, WS_WUPB = 13 * MiB, WS_WOUT = 14 * MiB, WS_WFF1 = 16 * MiB, WS_WFF2 = 24 * MiB;
constexpr size_t WS_LORA = 32 * MiB, WS_XNMETA = 32 * MiB + 512 * 1024, WS_CB = 33 * MiB, WS_ACT = 36 * MiB;
constexpr size_t ACT_SZ = (size_t)ROWS * 512 * 2, L_SZ = (size_t)ROWS * 256 * 2;
constexpr size_t WS_R = WS_ACT, WS_KA = WS_R + ACT_SZ, WS_VA = WS_KA + ACT_SZ, WS_L = WS_VA + ACT_SZ, WS_Q = WS_L + L_SZ, WS_KB = WS_Q + ACT_SZ, WS_VT = WS_KB + ACT_SZ, WS_END = WS_VT + ACT_SZ;
constexpr size_t WS_GA = WS_KA, WS_GB = WS_KB, WS_MN = WS_ACT, WS_HID = WS_ACT + 64 * MiB;
constexpr size_t WS_SS = 65536;
constexpr size_t WS_HALO = WS_END;
constexpr int HALO_ROW = 3584;
static_assert(WS_HALO + (size_t)(NMAIN / 64) * 2 * HALO_ROW <= 256 * MiB, "halo buffer");
static_assert(WS_END <= 256 * MiB && WS_HID + 128 * MiB <= 256 * MiB && WS_CB + (size_t)2 * ROWS * 8 * 4 <= WS_ACT, "ws map");
constexpr float LOG2E = 1.4426950408889634f;
constexpr float QSCALE = 0.125f * LOG2E;

struct Params { const float* in[29]; float* out; unsigned char* ws; };
typedef const __attribute__((address_space(4))) Params* KP;
enum { I_XP = 0, I_XS, I_META, I_GMIX, I_WIN, I_MUP, I_MUN, I_W0, I_WUP, I_A0, I_AUP, I_GUP, I_KK, I_KA, I_RK, I_LNW, I_LNB, I_LQ1, I_LK1, I_LQ2, I_LK2, I_SUBG, I_UPA, I_UPB, I_WOUT, I_GFFN, I_FF1, I_FF2, I_GFIN };

typedef float cvt_f32x2 __attribute__((ext_vector_type(2))); typedef __bf16 cvt_bf16x2 __attribute__((ext_vector_type(2)));
__device__ __forceinline__ unsigned cvtpk(float lo, float hi) { const cvt_f32x2 v = {lo, hi}; const cvt_bf16x2 b = __builtin_convertvector(v, cvt_bf16x2); return __builtin_bit_cast(unsigned, b); }
__device__ __forceinline__ float bf2f(unsigned short b) { return __uint_as_float(((unsigned)b) << 16); }
__device__ __forceinline__ float bflo(unsigned w) { return __uint_as_float(w << 16); }
__device__ __forceinline__ float bfhi(unsigned w) { return __uint_as_float(w & 0xffff0000u); }
__device__ __forceinline__ void unpack8(const u32x4 v, float* o) { o[0] = bflo(v.x); o[1] = bfhi(v.x); o[2] = bflo(v.y); o[3] = bfhi(v.y); o[4] = bflo(v.z); o[5] = bfhi(v.z); o[6] = bflo(v.w); o[7] = bfhi(v.w); }
__device__ __forceinline__ float wave_sum(float v) {
#pragma unroll
    for (int o = 1; o < 64; o <<= 1) v += __shfl_xor(v, o);
    return v;
}
__device__ __forceinline__ float sigmoidf_(float x) { return __builtin_amdgcn_rcpf(1.0f + __builtin_amdgcn_exp2f(-LOG2E * x)); }
__device__ __forceinline__ int seq_base(int s) { return s == 0 ? 0 : 16384 + (s - 1) * 2048; }
__device__ __forceinline__ int seq_len(int s) { return s == 0 ? 16384 : 2048; }
__device__ __forceinline__ int pos_row(int base, int p) { return p < 16 ? METAROW + p : base + p - 16; }

template <class Op> struct Epi8 {
    static constexpr bool PERM = true, AFTER_DRAIN = false;
    Op op;
    __device__ __forceinline__ void operator()(const pg8::f32x4 (&acc)[2][2][4][2], const pg8::Unit& u, int wr, int wc, int fr, int fq) const {
        const int row0 = u.pm * 256 + wr * 64 + fr, col0 = u.pn * 256 + wc * 32 + 8 * fq;
#pragma unroll
        for (int ai = 0; ai < 2; ++ai)
#pragma unroll
            for (int m = 0; m < 4; ++m)
#pragma unroll
                for (int bj = 0; bj < 2; ++bj) { op.apply(row0 + ai * 128 + m * 16, col0 + bj * 128, u.pn, acc[ai][bj][m][0], acc[ai][bj][m][1]); asm volatile("" ::: "memory"); }
    }
};
__device__ __forceinline__ u32x4 pack8(const f32x4 a, const f32x4 b) { u32x4 w; w.x = cvtpk(a[0], a[1]); w.y = cvtpk(a[2], a[3]); w.z = cvtpk(b[0], b[1]); w.w = cvtpk(b[2], b[3]); return w; }

constexpr int CW_KN = 320;
__device__ __forceinline__ float dpp_max16(float v) {
    int x = __float_as_int(v);
    v = fmaxf(v, __int_as_float(__builtin_amdgcn_update_dpp(0, x, 0xB1, 0xf, 0xf, true))); x = __float_as_int(v);
    v = fmaxf(v, __int_as_float(__builtin_amdgcn_update_dpp(0, x, 0x4E, 0xf, 0xf, true))); x = __float_as_int(v);
    v = fmaxf(v, __int_as_float(__builtin_amdgcn_update_dpp(0, x, 0x141, 0xf, 0xf, true))); x = __float_as_int(v);
    v = fmaxf(v, __int_as_float(__builtin_amdgcn_update_dpp(0, x, 0x140, 0xf, 0xf, true)));
    return v;
}
struct OpProj {
    unsigned char* ws;
    __device__ __forceinline__ void apply(int row, int col, int pn, f32x4 v0, f32x4 v1) const {
        if (pn >= 11) {
            bf16* VT = (bf16*)(ws + WS_VT); const int c = col - 11 * 256;
#pragma unroll
            for (int e = 0; e < 4; ++e) { bf16* vt = VT + ((size_t)(row >> 6) * 512 + c) * 64 + (row & 63);
                vt[e * 64] = (bf16)(cvtpk(v0[e], 0.f) & 0xffffu); vt[(4 + e) * 64] = (bf16)(cvtpk(v1[e], 0.f) & 0xffffu); }
            return;
        }
        bf16* O; int ldc = 512, c;
        if (pn < 2) { O = (bf16*)(ws + WS_R); c = col; }
        else if (pn < 4) { O = (bf16*)(ws + WS_KA); c = col - 512; }
        else if (pn < 6) { O = (bf16*)(ws + WS_VA); c = col - 1024; }
        else if (pn < 7) { O = (bf16*)(ws + WS_L); c = col - 1536; ldc = 256; }
        else if (pn < 9) { O = (bf16*)(ws + WS_Q); c = col - 1792; v0 = v0 * QSCALE; v1 = v1 * QSCALE; }
        else { O = (bf16*)(ws + WS_KB); c = col - 2304; }
        const u32x4 w = pack8(v0, v1);
        *(u32x4*)(O + (size_t)row * ldc + c) = w;
        if (pn >= 9) {
            float k8[8]; unpack8(w, k8); float ss = 0.f;
#pragma unroll
            for (int e = 0; e < 8; ++e) ss = fmaf(k8[e], k8[e], ss);
            ss = dpp_max16(ss);
            if ((threadIdx.x & 15) == 0) { const int sidx = row < 16384 ? 0 : row < NMAIN ? 1 + ((row - 16384) >> 11) : 9;
                atomicMax((unsigned*)(ws + WS_CTL) + CW_KN + sidx * 64 + (c >> 3), __float_as_uint(ss)); }
        }
    }
};
struct OpGate {
    bf16* O;
    __device__ __forceinline__ void apply(int row, int col, int pn, f32x4 v0, f32x4 v1) const {
        const int c = col;
#pragma unroll
        for (int e = 0; e < 4; ++e) { v0[e] = sigmoidf_(v0[e]); v1[e] = sigmoidf_(v1[e]); }
        *(u32x4*)(O + (size_t)row * 1024 + c) = pack8(v0, v1);
    }
};
struct OpUpA {
    unsigned char* ws;
    __device__ __forceinline__ void apply(int row, int col, int pn, f32x4 v0, f32x4 v1) const {
        u32x4* p = (u32x4*)((bf16*)(ws + WS_GA) + (size_t)row * 1024 + col); float g[8]; unpack8(*p, g);
#pragma unroll
        for (int e = 0; e < 4; ++e) { v0[e] *= g[e]; v1[e] *= g[4 + e]; }
        *p = pack8(v0, v1);
    }
};
struct OpUpB {
    unsigned char* ws;
    __device__ __forceinline__ void apply(int row, int col, int pn, f32x4 v0, f32x4 v1) const {
        u32x4* p = (u32x4*)((bf16*)(ws + WS_GB) + (size_t)row * 1024 + col); float g[8], a[8]; unpack8(*p, g);
        unpack8(*(const u32x4*)((const bf16*)(ws + WS_GA) + (size_t)row * 1024 + col), a);
#pragma unroll
        for (int e = 0; e < 4; ++e) { v0[e] = a[e] + v0[e] * g[e]; v1[e] = a[4 + e] + v1[e] * g[4 + e]; }
        *p = pack8(v0, v1);
    }
};
struct OpOut {
    const float* xp; const float* xs; float* out; const float* gf; bf16* mn; float* ss;
    __device__ __forceinline__ void apply(int row, int col, int pn, f32x4 v0, f32x4 v1) const {
        const float* x = (row < 16384 ? xp + (size_t)row * DM : xs + (size_t)(row - 16384) * DM) + col;
        float* o = out + (size_t)row * DM + col;
        const f32x4 h0 = *(const f32x4*)x + v0, h1 = *(const f32x4*)(x + 4) + v1;
        *(f32x4*)o = h0; *(f32x4*)(o + 4) = h1;
        const f32x4 g0 = *(const f32x4*)(gf + col), g1 = *(const f32x4*)(gf + col + 4);
        *(u32x4*)(mn + (size_t)row * DM + col) = pack8(h0 * g0, h1 * g1);
        float q = (h0[0] * h0[0] + h0[1] * h0[1]) + (h0[2] * h0[2] + h0[3] * h0[3]) + (h1[0] * h1[0] + h1[1] * h1[1]) + (h1[2] * h1[2] + h1[3] * h1[3]);
        { const auto r = __builtin_amdgcn_permlane16_swap(__float_as_uint(q), __float_as_uint(q), false, false); q = __uint_as_float(r[0]) + __uint_as_float(r[1]); }
        { const auto r = __builtin_amdgcn_permlane32_swap(__float_as_uint(q), __float_as_uint(q), false, false); q = __uint_as_float(r[0]) + __uint_as_float(r[1]); }
        if ((threadIdx.x & 63) < 16) atomicAdd(ss + row, q);
    }
};
struct OpFF1 {
    bf16* hid; const float* ss;
    __device__ __forceinline__ void apply(int row, int col, int pn, f32x4 v0, f32x4 v1) const {
        const float rs2 = __builtin_amdgcn_rcpf(ss[row] * (1.0f / DM) + 1e-6f);
#pragma unroll
        for (int e = 0; e < 4; ++e) { const float a = fmaxf(v0[e], 0.f), b = fmaxf(v1[e], 0.f); v0[e] = a * a * rs2; v1[e] = b * b * rs2; }
        *(u32x4*)(hid + (size_t)row * DFF + col) = pack8(v0, v1);
    }
};
struct OpFF2 {
    float* out;
    __device__ __forceinline__ void apply(int row, int col, int pn, f32x4 v0, f32x4 v1) const {
        float* o = out + (size_t)row * DM + col;
        *(f32x4*)o = *(const f32x4*)o + v0; *(f32x4*)(o + 4) = *(const f32x4*)(o + 4) + v1;
    }
};

__device__ __forceinline__ unsigned f2bf_rne(float f) { return cvtpk(f, 0.f) & 0xffffu; }
__device__ __forceinline__ void transpose_item(const float* W, int K, int N, bf16* WT, LAS float* scr, int item, int lane) {
    const int nblk = N / 32, kb = item / nblk, nb = item % nblk, k0 = 64 * kb, n0 = 32 * nb;
#pragma unroll 8
    for (int i = 0; i < 32; ++i) { const int kk = 2 * i + (lane >> 5); scr[kk * 33 + (lane & 31)] = W[(size_t)(k0 + kk) * N + n0 + (lane & 31)]; }
    asm volatile("s_waitcnt vmcnt(0) lgkmcnt(0)" ::: "memory");
    const int c = lane & 7;
#pragma unroll
    for (int j = 0; j < 4; ++j) { const int n = (lane >> 3) + 8 * j; const LAS float* s = scr + (8 * c) * 33 + n;
        u32x4 o; o.x = cvtpk(s[0 * 33], s[1 * 33]); o.y = cvtpk(s[2 * 33], s[3 * 33]); o.z = cvtpk(s[4 * 33], s[5 * 33]); o.w = cvtpk(s[6 * 33], s[7 * 33]);
        *(u32x4*)(WT + (size_t)(n0 + n) * K + k0 + 8 * c) = o; }
    asm volatile("s_waitcnt lgkmcnt(0)" ::: "memory");
}
__device__ __forceinline__ void rms_row_bf16(const float* src, const float* g, bf16* dst, int lane) {
    unsigned long long* o8 = (unsigned long long*)dst + lane;
    if (!src) {
#pragma unroll
        for (int j = 0; j < 4; ++j) o8[64 * j] = 0ull;
        return; }
    const f32x4* xr = (const f32x4*)src + lane; const f32x4* gr = (const f32x4*)g + lane;
    f32x4 v[4]; float s = 0.f;
#pragma unroll
    for (int j = 0; j < 4; ++j) { v[j] = xr[64 * j]; s += (v[j].x * v[j].x + v[j].y * v[j].y) + (v[j].z * v[j].z + v[j].w * v[j].w); }
    const float rstd = rsqrtf(wave_sum(s) * (1.f / DM) + 1e-6f);
#pragma unroll
    for (int j = 0; j < 4; ++j) { const f32x4 gg = gr[64 * j]; const f32x4 y = v[j] * rstd * gg;
        o8[64 * j] = (unsigned long long)cvtpk(y.x, y.y) | ((unsigned long long)cvtpk(y.z, y.w) << 32); }
}
__device__ __forceinline__ void phase_prologue(LAS unsigned char* lds, KP P) {
    const int tid = fresh_tid(), lane = tid & 63, wid = tid >> 6;
    LAS float* scr = (LAS float*)(lds + wid * 16384);
    const int gw = blockIdx.x * 8 + wid, NGW = gridDim.x * 8;
    unsigned char* ws = P->ws;
    constexpr int I_IN = (1024 / 64) * (5376 / 32), I_UP = (512 / 64) * (1024 / 32), I_O = (1024 / 64) * (1024 / 32), I_1 = (1024 / 64) * (4096 / 32), I_2 = (4096 / 64) * (1024 / 32);
    constexpr int I_LW = (64 / 64) * (512 / 32), I_G = (128 / 64) * (512 / 32);
    constexpr int NITEMS = I_IN + 2 * I_UP + I_O + I_1 + I_2 + 4 * I_LW + I_G;
    for (int it = gw; it < NITEMS; it += NGW) {
        int r = it;
        if (r < I_IN) { transpose_item(P->in[I_WIN], 1024, 5376, (bf16*)(ws + WS_WIN), scr, r, lane); continue; } r -= I_IN;
        if (r < I_UP) { transpose_item(P->in[I_UPA], 512, 1024, (bf16*)(ws + WS_WUPA), scr, r, lane); continue; } r -= I_UP;
        if (r < I_UP) { transpose_item(P->in[I_UPB], 512, 1024, (bf16*)(ws + WS_WUPB), scr, r, lane); continue; } r -= I_UP;
        if (r < I_O) { transpose_item(P->in[I_WOUT], 1024, 1024, (bf16*)(ws + WS_WOUT), scr, r, lane); continue; } r -= I_O;
        if (r < I_1) { transpose_item(P->in[I_FF1], 1024, 4096, (bf16*)(ws + WS_WFF1), scr, r, lane); continue; } r -= I_1;
        if (r < I_2) { transpose_item(P->in[I_FF2], 4096, 1024, (bf16*)(ws + WS_WFF2), scr, r, lane); continue; } r -= I_2;
        if (r < 2 * I_LW) { const int d = r / I_LW; transpose_item(P->in[I_WUP] + (size_t)d * 64 * 512, 64, 512, (bf16*)(ws + WS_LORA) + (size_t)d * 512 * 64, scr, r % I_LW, lane); continue; } r -= 2 * I_LW;
        if (r < 2 * I_LW) { const int d = r / I_LW; transpose_item(P->in[I_AUP] + (size_t)d * 64 * 512, 64, 512, (bf16*)(ws + WS_LORA + 131072) + (size_t)d * 512 * 64, scr, r % I_LW, lane); continue; } r -= 2 * I_LW;
        transpose_item(P->in[I_GUP], 128, 512, (bf16*)(ws + WS_LORA + 262144), scr, r, lane);
    }
    bf16* XN = (bf16*)P->out; bf16* XM = (bf16*)(ws + WS_XNMETA);
    for (int m = gw; m < ROWS; m += NGW) {
        const float* src = m < 16384 ? P->in[I_XP] + (size_t)m * DM : m < NMAIN ? P->in[I_XS] + (size_t)(m - 16384) * DM : (m - NMAIN < 16 ? P->in[I_META] + (size_t)(m - NMAIN) * DM : nullptr);
        bf16* dst = m < NMAIN ? XN + (size_t)m * DM : XM + (size_t)(m - NMAIN) * DM;
        rms_row_bf16(src, P->in[I_GMIX], dst, lane);
    }
}

constexpr int AT_KSTR = 272, AT_VSTR = 144, AT_KSZ = 64 * AT_KSTR, AT_BUF = AT_KSZ + 128 * AT_VSTR;
__device__ __forceinline__ f32x16 mfma32(bf16x8 a, bf16x8 b, f32x16 c) { return __builtin_amdgcn_mfma_f32_32x32x16_bf16(a, b, c, 0, 0, 0); }
__device__ __forceinline__ void attn_unit(LAS unsigned char* lds, KP P, int s, int h, int qb, float lam) {
    int tid_ = threadIdx.x; asm volatile("" : "+v"(tid_));
    const int tid = tid_, lane = tid & 63, r32 = lane & 31, hi = lane >> 5, wid = __builtin_amdgcn_readfirstlane(tid >> 6), rg = wid & 3, mp = wid >> 2;
    const int L = seq_len(s), base = seq_base(s), NT = 1 + L / 64;
    unsigned char* ws = P->ws;
    const bf16* KB = (const bf16*)(ws + WS_KB); const bf16* VT = (const bf16*)(ws + WS_VT); bf16* Q = (bf16*)(ws + WS_Q);
    const int qrow = base + qb * 128 + rg * 32 + r32;
    bf16x8 q[4];
#pragma unroll
    for (int d0 = 0; d0 < 4; ++d0) q[d0] = *(const bf16x8*)(Q + (size_t)qrow * 512 + h * 128 + mp * 64 + d0 * 16 + hi * 8);
    f32x16 O[4];
#pragma unroll
    for (int b = 0; b < 4; ++b)
#pragma unroll
        for (int r = 0; r < 16; ++r) O[b][r] = 0.f;
    float mx = -INFINITY, ls = 0.f;
    const float qh = (float)(16 + qb * 128 + rg * 32 + r32 - 4 * hi);
    const float nslope = -exp2f(-2.0f * (float)(h + 1)) * LOG2E;
    const int kr0 = tid >> 4, kc = tid & 15, vn0 = tid >> 3, vc = tid & 7;
    u32x4 kreg[2], vreg[2];
    const unsigned kgo = (unsigned)((kr0 * 512 + h * 128 + kc * 8) * 2), vgo = (unsigned)(((h * 128 + vn0) * 64 + vc * 8) * 2);
    const unsigned klo = (unsigned)(kr0 * AT_KSTR + kc * 16), vlo = (unsigned)(AT_KSZ + vn0 * AT_VSTR + vc * 16);
#define AT_GLOAD(j) do { const int m0_ = (j) == 0 ? METAROW : base + 64 * ((j) - 1); \
        const unsigned char* kt_ = (const unsigned char*)KB + (size_t)m0_ * 1024; const unsigned char* vt_ = (const unsigned char*)VT + (size_t)(m0_ >> 6) * (512 * 64 * 2); \
        kreg[0] = *(const u32x4*)(kt_ + kgo); kreg[1] = *(const u32x4*)(kt_ + 32 * 1024 + kgo); \
        vreg[0] = *(const u32x4*)(vt_ + vgo); vreg[1] = *(const u32x4*)(vt_ + 64 * 64 * 2 + vgo); } while (0)
#define AT_LSTORE(buf) do { LAS unsigned char* kb_ = lds + (buf) * AT_BUF; \
        *(LAS u32x4*)(kb_ + klo) = kreg[0]; *(LAS u32x4*)(kb_ + klo + 32 * AT_KSTR) = kreg[1]; \
        *(LAS u32x4*)(kb_ + vlo) = vreg[0]; *(LAS u32x4*)(kb_ + vlo + 64 * AT_VSTR) = vreg[1]; } while (0)
    float qn, kn;
    { float ssq = 0.f;
#pragma unroll
      for (int d0 = 0; d0 < 4; ++d0) { float t[8]; unpack8(__builtin_bit_cast(u32x4, q[d0]), t);
#pragma unroll
        for (int e = 0; e < 8; ++e) ssq = fmaf(t[e], t[e], ssq); }
      ssq += __shfl_xor(ssq, 32); qn = sqrtf(ssq) * 1.002f;
      const unsigned* KN = (const unsigned*)(ws + WS_CTL) + CW_KN; float ks = 0.f;
#pragma unroll
      for (int g = 0; g < 8; ++g) ks += fmaxf(__uint_as_float(__hip_atomic_load(KN + s * 64 + h * 16 + mp * 8 + g, __ATOMIC_RELAXED, __HIP_MEMORY_SCOPE_AGENT)), __uint_as_float(__hip_atomic_load(KN + 9 * 64 + h * 16 + mp * 8 + g, __ATOMIC_RELAXED, __HIP_MEMORY_SCOPE_AGENT)));
      kn = sqrtf(ks) * 1.002f; }
    const int jc0 = 1 + qb * 2;
    int jlo = jc0, jhi = jc0 + 1;
    LAS float* red = (LAS float*)(lds + 2 * AT_BUF);
#pragma unroll 1
    for (int ph = 0; ph < 2; ++ph) {
        int nleft, ntl;
        if (ph == 0) { nleft = 0; ntl = 2; }
        else {
            float dneed = (qn * kn - mx + 40.0f) / (-nslope);
#pragma unroll
            for (int o = 1; o < 64; o <<= 1) dneed = fmaxf(dneed, __shfl_xor(dneed, o));
            if (lane == 0) red[wid] = dneed;
            __syncthreads();
            float dm = red[0];
#pragma unroll
            for (int w8 = 1; w8 < 8; ++w8) dm = fmaxf(dm, red[w8]);
            dm = fminf(fmaxf(dm, 0.f), 1.0e6f);
            const int dmax = (int)dm + 1, q0 = 16 + qb * 128;
            const int plo = q0 - dmax, phi = q0 + 127 + dmax;
            jlo = plo < 16 ? 0 : 1 + ((plo - 16) >> 6); jhi = phi >= L + 16 ? NT - 1 : 1 + ((phi - 16) >> 6);
            if (jlo > jc0) jlo = jc0; if (jhi < jc0 + 1) jhi = jc0 + 1;
            nleft = jc0 - jlo; ntl = nleft + (jhi - jc0 - 1);
        }
        if (ntl > 0) {
#define AT_J(t) (ph == 0 ? jc0 + (t) : ((t) < nleft ? jlo + (t) : jc0 + 2 + ((t) - nleft)))
        { const int jf = AT_J(0); AT_GLOAD(jf); } AT_LSTORE(0); __syncthreads();
#pragma unroll 1
        for (int t = 0; t < ntl; ++t) {
            const int j = AT_J(t);
            if (t + 1 < ntl) { const int jn = AT_J(t + 1); AT_GLOAD(jn); }
            const LAS unsigned char* Kb = lds + (t & 1) * AT_BUF + mp * 128; const LAS unsigned char* Vb = lds + (t & 1) * AT_BUF + AT_KSZ;
            const float dq = qh - (float)(j == 0 ? 0 : 64 * j - 48);
            f32x16 p0, p1;
#pragma unroll
            for (int r = 0; r < 16; ++r) { p0[r] = 0.f; p1[r] = 0.f; }
            {
                bf16x8 ka[4], kb[4];
#pragma unroll
                for (int d0 = 0; d0 < 4; ++d0) { ka[d0] = *(const LAS bf16x8*)(Kb + r32 * AT_KSTR + d0 * 32 + hi * 16); kb[d0] = *(const LAS bf16x8*)(Kb + (32 + r32) * AT_KSTR + d0 * 32 + hi * 16); }
                __builtin_amdgcn_sched_barrier(0);
#pragma unroll
                for (int d0 = 0; d0 < 4; ++d0) { p0 = mfma32(ka[d0], q[d0], p0); p1 = mfma32(kb[d0], q[d0], p1); }
            }
#pragma unroll
            for (int r = 0; r < 16; ++r) { const float dd = dq - (float)((r & 3) + 8 * (r >> 2)); p0[r] = fmaf(fabsf(dd), nslope, p0[r]); p1[r] = fmaf(fabsf(dd - 32.f), nslope, p1[r]); }
            if (j == 0) {
#pragma unroll
                for (int r = 0; r < 16; ++r) { if ((r & 3) + 8 * (r >> 2) + 4 * hi >= 16) p0[r] = -INFINITY; p1[r] = -INFINITY; }
            }
            float rm = fmaxf(p0[0], p1[0]);
#pragma unroll
            for (int r = 1; r < 16; ++r) rm = fmaxf(rm, fmaxf(p0[r], p1[r]));
            rm = fmaxf(rm, __shfl_xor(rm, 32));
            if (__any(rm > mx - 38.0f)) {
            const float mn = fmaxf(mx, rm);
            if (__any(mn > mx)) {
                const float f = __builtin_amdgcn_exp2f(mx - mn); ls *= f; mx = mn;
#pragma unroll
                for (int b = 0; b < 4; ++b)
#pragma unroll
                    for (int r = 0; r < 16; ++r) O[b][r] *= f;
            }
            float sum = 0.f;
#pragma unroll
            for (int r = 0; r < 16; ++r) { p0[r] = __builtin_amdgcn_exp2f(p0[r] - mx); p1[r] = __builtin_amdgcn_exp2f(p1[r] - mx); sum += p0[r] + p1[r]; }
            ls += sum;
            bf16x8 pf[4];
#pragma unroll
            for (int k2 = 0; k2 < 2; ++k2) {
                u32x4 w0, w1;
                w0.x = cvtpk(p0[8 * k2 + 0], p0[8 * k2 + 1]); w0.y = cvtpk(p0[8 * k2 + 2], p0[8 * k2 + 3]); w0.z = cvtpk(p0[8 * k2 + 4], p0[8 * k2 + 5]); w0.w = cvtpk(p0[8 * k2 + 6], p0[8 * k2 + 7]);
                w1.x = cvtpk(p1[8 * k2 + 0], p1[8 * k2 + 1]); w1.y = cvtpk(p1[8 * k2 + 2], p1[8 * k2 + 3]); w1.z = cvtpk(p1[8 * k2 + 4], p1[8 * k2 + 5]); w1.w = cvtpk(p1[8 * k2 + 6], p1[8 * k2 + 7]);
                pf[k2] = __builtin_bit_cast(bf16x8, w0); pf[2 + k2] = __builtin_bit_cast(bf16x8, w1);
            }
            {
                u32x4 vcur[4], vnxt[4];
#define AT_VLOAD(dst, ks_) do { _Pragma("unroll") for (int b_ = 0; b_ < 4; ++b_) { const LAS unsigned char* vp_ = Vb + (b_ * 32 + r32) * AT_VSTR + (ks_) * 32 + hi * 8; \
                    const u32x2 lo_ = *(const LAS u32x2*)vp_, hh_ = *(const LAS u32x2*)(vp_ + 16); dst[b_].x = lo_.x; dst[b_].y = lo_.y; dst[b_].z = hh_.x; dst[b_].w = hh_.y; } } while (0)
                AT_VLOAD(vcur, 0);
#pragma unroll
                for (int ks = 0; ks < 4; ++ks) {
                    if (ks < 3) AT_VLOAD(vnxt, ks + 1);
                    __builtin_amdgcn_sched_barrier(0);
#pragma unroll
                    for (int b = 0; b < 4; ++b) O[b] = mfma32(__builtin_bit_cast(bf16x8, vcur[b]), pf[ks], O[b]);
                    __builtin_amdgcn_sched_barrier(0);
#pragma unroll
                    for (int b = 0; b < 4; ++b) vcur[b] = vnxt[b];
                }
#undef AT_VLOAD
            }
            }
            if (t + 1 < ntl) AT_LSTORE((t + 1) & 1);
            __syncthreads();
        }
#undef AT_J
        }
    }
#undef AT_GLOAD
#undef AT_LSTORE
    const float lt = ls + __shfl_xor(ls, 32);
    const float inv = (mp ? lam : 1.0f) / lt;
    int lane2 = lane; asm volatile("" : "+v"(lane2));
    const int r32e = lane2 & 31, hie = lane2 >> 5;
    LAS float* ex = (LAS float*)lds + rg * (128 * 32) + hie * 128 + r32e;
    if (mp == 1) {
#pragma unroll
        for (int b = 0; b < 4; ++b)
#pragma unroll
            for (int r = 0; r < 16; ++r) ex[(32 * b + (r & 3) + 8 * (r >> 2)) * 32] = O[b][r] * inv;
    }
    __syncthreads();
    if (mp == 0) {
        float ss = 0.f;
#pragma unroll
        for (int b = 0; b < 4; ++b)
#pragma unroll
            for (int r = 0; r < 16; ++r) { const float o = O[b][r] * inv - ex[(32 * b + (r & 3) + 8 * (r >> 2)) * 32]; O[b][r] = o; ss += o * o; }
        ss += __shfl_xor(ss, 32);
        const float rstd = rsqrtf(ss * (1.0f / 128.0f) + 1e-5f) * 0.8f;
        const float* sg = P->in[I_SUBG] + 4 * hie; bf16* Qo = Q + (size_t)(base + qb * 128 + rg * 32 + r32e) * 512 + h * 128 + 4 * hie;
#pragma unroll
        for (int b = 0; b < 4; ++b)
#pragma unroll
            for (int r4 = 0; r4 < 4; ++r4) {
                const int n = 32 * b + 8 * r4; const f32x4 g = *(const f32x4*)(sg + n);
                u32x2 w; w.x = cvtpk(O[b][4 * r4 + 0] * rstd * g.x, O[b][4 * r4 + 1] * rstd * g.y); w.y = cvtpk(O[b][4 * r4 + 2] * rstd * g.z, O[b][4 * r4 + 3] * rstd * g.w);
                *(u32x2*)(Qo + n) = w;
            }
    }
    __syncthreads();
}

constexpr int SC_R = 0, SC_K = 16384, SC_V = 32768, SC_W = 49152, SC_B = 65536, SC_KK = 81920, SC_Y = 98304, SC_TW = 114688, SC_AD = 123904, SC_MU = 133120;
__device__ __forceinline__ float dpp_add(float v, int ctrl_id) {
    const int x = __float_as_int(v); int y;
    if (ctrl_id == 0) y = __builtin_amdgcn_update_dpp(0, x, 0xB1, 0xf, 0xf, true);
    else if (ctrl_id == 1) y = __builtin_amdgcn_update_dpp(0, x, 0x4E, 0xf, 0xf, true);
    else if (ctrl_id == 2) y = __builtin_amdgcn_update_dpp(0, x, 0x141, 0xf, 0xf, true);
    else y = __builtin_amdgcn_update_dpp(0, x, 0x140, 0xf, 0xf, true);
    return v + __int_as_float(y);
}
template <int LPR> __device__ __forceinline__ float grp_sum(float v) {
    v = dpp_add(v, 0); v = dpp_add(v, 1); v = dpp_add(v, 2);
    if (LPR == 16) v = dpp_add(v, 3);
    return v;
}
#define BAR_LDS() asm volatile("s_waitcnt lgkmcnt(0)\n\ts_barrier" ::: "memory")
__device__ __forceinline__ float fast_sigmoid(float x) { return __builtin_amdgcn_rcpf(1.0f + __builtin_amdgcn_exp2f(-LOG2E * x)); }
__device__ __forceinline__ float fast_tanh(float x) { return 1.0f - 2.0f * __builtin_amdgcn_rcpf(1.0f + __builtin_amdgcn_exp2f(2.0f * LOG2E * x)); }
template <int NRP, int NSW>
__device__ __forceinline__ void scan_unit(LAS unsigned char* lds, KP P, int s, int d, int h, int rp) {
    constexpr int RPB = 64 / NRP, RPW = RPB / NSW, LPR = 64 / RPW, CPL = 64 / LPR;
    static_assert(LPR == 8 || LPR == 16, "scan geometry");
    constexpr bool YDB = (RPB == 16) && (NSW == 4);
    constexpr int YST = YDB ? RPB : 64;
    int tid_ = threadIdx.x; asm volatile("" : "+v"(tid_));
    const int tid = tid_, lane = tid & 63, wid = __builtin_amdgcn_readfirstlane(tid >> 6);
    const int L = seq_len(s), base = seq_base(s), Ltot = L + 16, nchunk = (Ltot + 63) / 64;
    unsigned char* ws = P->ws;
    const bf16* Rb = (const bf16*)(ws + WS_R); const bf16* KAb = (const bf16*)(ws + WS_KA); const bf16* VAb = (const bf16*)(ws + WS_VA); const bf16* Lb = (const bf16*)(ws + WS_L);
    float* CB = (float*)(ws + WS_CB); bf16* YD = (bf16*)((unsigned char*)P->out + 64 * MiB) + (size_t)d * NMAIN * 512;
    LAS float* fS = (LAS float*)lds; LAS float* fV = (LAS float*)(lds + 81920); LAS float* fY = (LAS float*)(lds + SC_Y); LAS float* fMU = (LAS float*)(lds + SC_MU);
#define SCI(sl_, a_, c_) ((sl_) * 320 + (a_) * 64 + (c_))
    for (int i = tid; i < 832; i += NTHREADS) {
        float v;
        if (i < 640) { const int which = i / 320, jj = i % 320, a = jj >> 6, c = jj & 63; const int gi = a < 3 ? a * 512 + h * 64 + c : 1536 + (a - 3) * 64 + c; v = P->in[which ? I_MUN : I_MUP][gi]; }
        else { const int a = (i - 640) >> 6, c = (i - 640) & 63; v = P->in[a == 0 ? I_KK : a == 1 ? I_KA : I_RK][h * 64 + c]; }
        fMU[i] = v;
    }
    const int mat = wid >> 2, ntile = wid & 3;
    const bf16* Wt = (const bf16*)(ws + WS_LORA + (mat ? 131072 : 0)) + ((size_t)d * 512 + h * 64 + ntile * 16 + (lane & 15)) * 64 + (lane >> 4) * 8;
    const bf16x8 bfr0 = *(const bf16x8*)Wt, bfr1 = *(const bf16x8*)(Wt + 32);
    const float bias = P->in[mat ? I_A0 : I_W0][d * 512 + h * 64 + ntile * 16 + (lane & 15)];
    float S[CPL];
#pragma unroll
    for (int j = 0; j < CPL; ++j) S[j] = 0.f;
    const int rowl = lane / LPR, kg = lane % LPR, srow = rp * RPB + wid * RPW + rowl;
    const int slot = tid >> 3, cg8 = (tid & 7) * 8;
    u32x4 raw[5][3];
#define SC_META(c) (d ? ((c) == nchunk - 1) : ((c) == 0))
    const unsigned char* HALO0 = ws + WS_HALO + (size_t)(base >> 6) * 2 * HALO_ROW;
#define SC_LOAD(c) do { const int i_ = 64 * (c) + slot; const bool ok_ = i_ < Ltot; const int p_ = d ? Ltot - 1 - i_ : i_; \
        const unsigned zr_ = (unsigned)(METAROW + 64); \
        if (!SC_META(c)) { const unsigned rc_ = ok_ ? (unsigned)(base + p_ - 16) : zr_; \
            _Pragma("unroll") for (int a_ = 0; a_ < 5; ++a_) { const unsigned char* B_ = (const unsigned char*)(a_ == 0 ? Rb : a_ == 1 ? KAb : a_ == 2 ? VAb : Lb); const unsigned ld_ = a_ < 3 ? 1024u : 512u; \
                const unsigned co_ = (unsigned)(((a_ < 3 ? h * 64 : (a_ - 3) * 64) + cg8) * 2); raw[a_][1] = *(const u32x4*)(B_ + (rc_ * ld_ + co_)); } \
        } else { const bool me_ = ok_ && p_ < 16; const bool hn_ = me_ && p_ == 15; \
            const unsigned rc_ = ok_ ? (unsigned)pos_row(base, p_) : zr_, rp_ = (me_ && p_ > 0) ? (unsigned)(METAROW + p_ - 1) : zr_, rn_ = (me_ && p_ < 15) ? (unsigned)(METAROW + p_ + 1) : zr_; \
            _Pragma("unroll") for (int a_ = 0; a_ < 5; ++a_) { const unsigned char* B_ = (const unsigned char*)(a_ == 0 ? Rb : a_ == 1 ? KAb : a_ == 2 ? VAb : Lb); const unsigned ld_ = a_ < 3 ? 1024u : 512u; \
                const unsigned co_ = (unsigned)(((a_ < 3 ? h * 64 : (a_ - 3) * 64) + cg8) * 2); \
                const unsigned ho_ = (unsigned)(((a_ < 3 ? a_ * 512 + h * 64 : 1536 + (a_ - 3) * 64) + cg8) * 2); \
                raw[a_][0] = *(const u32x4*)(B_ + (rp_ * ld_ + co_)); raw[a_][1] = *(const u32x4*)(B_ + (rc_ * ld_ + co_)); \
                const unsigned char* np_ = hn_ ? HALO0 + ho_ : B_ + (rn_ * ld_ + co_); raw[a_][2] = *(const u32x4*)np_; } } } while (0)
    SC_LOAD(0);
    BAR_LDS();
    for (int c = 0; c < nchunk; ++c) {
        const int nvalid = (Ltot - 64 * c) < 64 ? (Ltot - 64 * c) : 64;
        float rv[8], kv[8];
        if (!SC_META(c)) {
            float vv8[8]; unpack8(raw[0][1], rv); unpack8(raw[1][1], kv); unpack8(raw[2][1], vv8);
            { LAS float* dst = fS + SCI(slot, 4, cg8); *(LAS f32x4*)dst = (f32x4){rv[0], rv[1], rv[2], rv[3]}; *(LAS f32x4*)(dst + 4) = (f32x4){rv[4], rv[5], rv[6], rv[7]}; }
            { LAS float* dst = fV + slot * 64 + cg8; *(LAS f32x4*)dst = (f32x4){vv8[0], vv8[1], vv8[2], vv8[3]}; *(LAS f32x4*)(dst + 4) = (f32x4){vv8[4], vv8[5], vv8[6], vv8[7]}; }
            *(LAS u32x4*)(lds + SC_TW + slot * 144 + cg8 * 2) = raw[3][1];
            *(LAS u32x4*)(lds + SC_AD + slot * 144 + cg8 * 2) = raw[4][1];
        } else {
            const int i1 = 64 * c + slot; const int p1 = d ? Ltot - 1 - i1 : i1; const bool me1 = i1 < Ltot && p1 < 16; const float fm = me1 ? 1.0f : 0.0f;
#pragma unroll
            for (int a = 0; a < 5; ++a) {
                float pv[8], cv[8], nv[8], o[8]; unpack8(raw[a][0], pv); unpack8(raw[a][1], cv); unpack8(raw[a][2], nv);
                const f32x4 mp0 = *(const LAS f32x4*)(fMU + a * 64 + cg8), mp1 = *(const LAS f32x4*)(fMU + a * 64 + cg8 + 4), mn0 = *(const LAS f32x4*)(fMU + 320 + a * 64 + cg8), mn1 = *(const LAS f32x4*)(fMU + 320 + a * 64 + cg8 + 4);
#pragma unroll
                for (int e = 0; e < 8; ++e) { const float mp = fm * (e < 4 ? mp0[e & 3] : mp1[e & 3]), mn = fm * (e < 4 ? mn0[e & 3] : mn1[e & 3]); o[e] = cv[e] + mp * (pv[e] - cv[e]) + mn * (nv[e] - cv[e]); }
                if (a == 0) {
#pragma unroll
                    for (int e = 0; e < 8; ++e) rv[e] = o[e];
                    LAS float* dst = fS + SCI(slot, 4, cg8); *(LAS f32x4*)dst = (f32x4){o[0], o[1], o[2], o[3]}; *(LAS f32x4*)(dst + 4) = (f32x4){o[4], o[5], o[6], o[7]};
                } else if (a == 1) {
#pragma unroll
                    for (int e = 0; e < 8; ++e) kv[e] = o[e];
                } else if (a == 2) {
                    LAS float* dst = fV + slot * 64 + cg8; *(LAS f32x4*)dst = (f32x4){o[0], o[1], o[2], o[3]}; *(LAS f32x4*)(dst + 4) = (f32x4){o[4], o[5], o[6], o[7]};
                } else {
                    if (a == 3) {
#pragma unroll
                        for (int e = 0; e < 8; ++e) o[e] = me1 ? fast_tanh(o[e]) : o[e];
                    }
                    u32x4 w; w.x = cvtpk(o[0], o[1]); w.y = cvtpk(o[2], o[3]); w.z = cvtpk(o[4], o[5]); w.w = cvtpk(o[6], o[7]);
                    *(LAS u32x4*)(lds + (a == 3 ? SC_TW : SC_AD) + slot * 144 + cg8 * 2) = w;
                }
            }
        }
        BAR_LDS();
        if (c + 1 < nchunk) SC_LOAD(c + 1);
        {
            const LAS unsigned char* Ab = lds + (mat ? SC_AD : SC_TW); LAS float* fWB = fS + (mat ? 128 : 64);
#pragma unroll
            for (int mt = 0; mt < 4; ++mt) {
                const bf16x8 a0 = *(const LAS bf16x8*)(Ab + (mt * 16 + (lane & 15)) * 144 + (lane >> 4) * 16);
                const bf16x8 a1 = *(const LAS bf16x8*)(Ab + (mt * 16 + (lane & 15)) * 144 + 64 + (lane >> 4) * 16);
                f32x4 acc = {0.f, 0.f, 0.f, 0.f};
                acc = __builtin_amdgcn_mfma_f32_16x16x32_bf16(a0, bfr0, acc, 0, 0, 0);
                acc = __builtin_amdgcn_mfma_f32_16x16x32_bf16(a1, bfr1, acc, 0, 0, 0);
#pragma unroll
                for (int rg = 0; rg < 4; ++rg) {
                    const int sl = mt * 16 + (lane >> 4) * 4 + rg, col = ntile * 16 + (lane & 15);
                    const float sg = fast_sigmoid(acc[rg] + bias); const float dc = __builtin_amdgcn_exp2f(-0.6065306597126334f * LOG2E * sg);
                    fWB[sl * 320 + col] = mat ? sg : dc;
                }
            }
        }
        BAR_LDS();
        {
            const f32x4 a0 = *(const LAS f32x4*)(fS + SCI(slot, 2, cg8)), a1 = *(const LAS f32x4*)(fS + SCI(slot, 2, cg8 + 4));
            const f32x4 kk0 = *(const LAS f32x4*)(fMU + 640 + cg8), kk1 = *(const LAS f32x4*)(fMU + 640 + cg8 + 4), ka0 = *(const LAS f32x4*)(fMU + 704 + cg8), ka1 = *(const LAS f32x4*)(fMU + 704 + cg8 + 4);
            const f32x4 rk0 = *(const LAS f32x4*)(fMU + 768 + cg8), rk1 = *(const LAS f32x4*)(fMU + 768 + cg8 + 4);
            float kkv[8], kd[8], av[8]; float ssq = 0.f, cs = 0.f;
#pragma unroll
            for (int e = 0; e < 8; ++e) {
                av[e] = e < 4 ? a0[e & 3] : a1[e & 3];
                kkv[e] = kv[e] * (e < 4 ? kk0[e & 3] : kk1[e & 3]); ssq = fmaf(kkv[e], kkv[e], ssq);
                kd[e] = kv[e] * (1.0f + (av[e] - 1.0f) * (e < 4 ? ka0[e & 3] : ka1[e & 3])); cs = fmaf(rv[e] * kd[e], e < 4 ? rk0[e & 3] : rk1[e & 3], cs);
            }
            ssq = grp_sum<8>(ssq); cs = grp_sum<8>(cs);
            const float rs = rsqrtf(fmaxf(ssq, 1e-24f));
#pragma unroll
            for (int e = 0; e < 8; ++e) { kkv[e] *= rs; av[e] *= kkv[e]; }
            LAS float* o1 = fS + SCI(slot, 0, cg8); *(LAS f32x4*)o1 = (f32x4){kkv[0], kkv[1], kkv[2], kkv[3]}; *(LAS f32x4*)(o1 + 4) = (f32x4){kkv[4], kkv[5], kkv[6], kkv[7]};
            LAS float* o2 = fS + SCI(slot, 2, cg8); *(LAS f32x4*)o2 = (f32x4){av[0], av[1], av[2], av[3]}; *(LAS f32x4*)(o2 + 4) = (f32x4){av[4], av[5], av[6], av[7]};
            LAS float* o3 = fS + SCI(slot, 3, cg8); *(LAS f32x4*)o3 = (f32x4){kd[0], kd[1], kd[2], kd[3]}; *(LAS f32x4*)(o3 + 4) = (f32x4){kd[4], kd[5], kd[6], kd[7]};
            if (cg8 == 0 && rp == 0 && slot < nvalid) { const int i2 = 64 * c + slot; const int p2 = d ? Ltot - 1 - i2 : i2; CB[((size_t)d * ROWS + pos_row(base, p2)) * 8 + h] = cs; }
        }
        BAR_LDS();
#define SC_STORE_Y(cc_) do { const int t5_ = tid - 256; if (t5_ >= 0 && t5_ < 128) { const int sl5_ = t5_ >> 1, hf_ = t5_ & 1; const int i5_ = 64 * (cc_) + sl5_; const int p5_ = d ? Ltot - 1 - i5_ : i5_; \
            if (i5_ < Ltot && p5_ >= 16) { const LAS float* yp_ = fY + ((cc_) & 1) * 1024 + sl5_ * 16 + hf_ * 8; const f32x4 y0_ = *(const LAS f32x4*)yp_, y1_ = *(const LAS f32x4*)(yp_ + 4); \
                *(u32x4*)(YD + (size_t)(base + p5_ - 16) * 512 + h * 64 + rp * 16 + hf_ * 8) = pack8(y0_, y1_); } } } while (0)
        if (YDB && wid >= NSW && c > 0) SC_STORE_Y(c - 1);
        if (wid < NSW) {
            typedef float f32x2_ __attribute__((ext_vector_type(2)));
            constexpr int C4 = CPL / 4;
            const LAS float* ps = fS + kg * CPL; const LAS float* pv = fV + srow;
            LAS float* py = YDB ? fY + (c & 1) * 1024 + (srow - rp * RPB) : fY + srow;
            f32x4 nk[C4], nw[C4], nb[C4], nd[C4], nr[C4]; float nv;
#define SC_FETCH(sl_) do { _Pragma("unroll") for (int j_ = 0; j_ < C4; ++j_) { nk[j_] = *(const LAS f32x4*)(ps + (sl_) * 320 + 4 * j_); nw[j_] = *(const LAS f32x4*)(ps + (sl_) * 320 + 64 + 4 * j_); \
                nb[j_] = *(const LAS f32x4*)(ps + (sl_) * 320 + 128 + 4 * j_); nd[j_] = *(const LAS f32x4*)(ps + (sl_) * 320 + 192 + 4 * j_); nr[j_] = *(const LAS f32x4*)(ps + (sl_) * 320 + 256 + 4 * j_); } nv = pv[(sl_) * 64]; } while (0)
            SC_FETCH(0);
            f32x4 rp4[C4];
#pragma unroll
            for (int j = 0; j < C4; ++j) rp4[j] = (f32x4){0.f, 0.f, 0.f, 0.f};
#pragma unroll 16
            for (int sl = 0; sl < nvalid; ++sl) {
                f32x4 ck[C4], cw[C4], cb[C4], cd[C4], cr[C4];
#pragma unroll
                for (int j = 0; j < C4; ++j) { ck[j] = nk[j]; cw[j] = nw[j]; cb[j] = nb[j]; cd[j] = nd[j]; cr[j] = nr[j]; }
                const float vv = nv;
                SC_FETCH(sl + 1 < 64 ? sl + 1 : 63);
                f32x2_ pa = {0.f, 0.f}, ya = {0.f, 0.f};
#pragma unroll
                for (int j = 0; j < C4; ++j)
#pragma unroll
                    for (int e = 0; e < 4; e += 2) { const f32x2_ s2 = {S[4 * j + e], S[4 * j + e + 1]}, k2 = {ck[j][e], ck[j][e + 1]}, r2 = {rp4[j][e], rp4[j][e + 1]}; pa = pa + s2 * k2; ya = ya + s2 * r2; }
                float pp = pa.x + pa.y, yy = ya.x + ya.y;
                pp = dpp_add(pp, 0); yy = dpp_add(yy, 0); pp = dpp_add(pp, 1); yy = dpp_add(yy, 1); pp = dpp_add(pp, 2); yy = dpp_add(yy, 2);
                if (LPR == 16) { pp = dpp_add(pp, 3); yy = dpp_add(yy, 3); }
                py[(sl > 0 ? sl - 1 : 0) * YST] = yy;
#pragma unroll
                for (int j = 0; j < C4; ++j)
#pragma unroll
                    for (int e = 0; e < 4; e += 2) {
                        const f32x2_ b2 = {cb[j][e], cb[j][e + 1]}, d2 = {cd[j][e], cd[j][e + 1]}, w2 = {cw[j][e], cw[j][e + 1]}; f32x2_ s2 = {S[4 * j + e], S[4 * j + e + 1]};
                        const f32x2_ t2 = d2 * vv - b2 * pp; s2 = s2 * w2 + t2; S[4 * j + e] = s2.x; S[4 * j + e + 1] = s2.y; }
#pragma unroll
                for (int j = 0; j < C4; ++j) rp4[j] = cr[j];
            }
            {
                f32x2_ ya = {0.f, 0.f};
#pragma unroll
                for (int j = 0; j < C4; ++j)
#pragma unroll
                    for (int e = 0; e < 4; e += 2) { const f32x2_ s2 = {S[4 * j + e], S[4 * j + e + 1]}, r2 = {rp4[j][e], rp4[j][e + 1]}; ya = ya + s2 * r2; }
                const float yy = grp_sum<LPR>(ya.x + ya.y);
                py[(nvalid - 1) * YST] = yy;
            }
#undef SC_FETCH
        }
        BAR_LDS();
        {
            const int i2 = 64 * c + slot; const int p2 = d ? Ltot - 1 - i2 : i2;
            if (!YDB && slot < nvalid && p2 >= 16 && (cg8 / RPB) == rp) {
                const LAS float* yp = fY + slot * 64 + cg8; const f32x4 y0 = *(const LAS f32x4*)yp, y1 = *(const LAS f32x4*)(yp + 4);
                *(u32x4*)(YD + (size_t)(base + p2 - 16) * 512 + h * 64 + cg8) = pack8(y0, y1);
            }
        }
    }
    if (YDB) SC_STORE_Y(nchunk - 1);
#undef SC_STORE_Y
#undef SC_LOAD
#undef SC_META
#undef SCI
}

constexpr int SL_FV = 81920, SL_FY = 86016, SL_TW = 90112, SL_AD = 94720, SL_AS = 99328, SL_MU = 107520;
__device__ __forceinline__ void scan_long(LAS unsigned char* lds, KP P, int s, int d, int h, int rp) {
    int tid_ = threadIdx.x; asm volatile("" : "+v"(tid_));
    const int tid = tid_, lane = tid & 63, wid = __builtin_amdgcn_readfirstlane(tid >> 6);
    const int L = seq_len(s), base = seq_base(s), Ltot = L + 16, nhalf = (Ltot + 31) / 32;
    unsigned char* ws = P->ws;
    const bf16* Rb = (const bf16*)(ws + WS_R); const bf16* KAb = (const bf16*)(ws + WS_KA); const bf16* VAb = (const bf16*)(ws + WS_VA); const bf16* Lb = (const bf16*)(ws + WS_L);
    float* CB = (float*)(ws + WS_CB); bf16* YD = (bf16*)((unsigned char*)P->out + 64 * MiB) + (size_t)d * NMAIN * 512;
    LAS float* fS = (LAS float*)lds; LAS float* fV = (LAS float*)(lds + SL_FV); LAS float* fY = (LAS float*)(lds + SL_FY); LAS float* fAS = (LAS float*)(lds + SL_AS); LAS float* fMU = (LAS float*)(lds + SL_MU);
    for (int i = tid; i < 832; i += NTHREADS) {
        float v;
        if (i < 640) { const int which = i / 320, jj = i % 320, a = jj >> 6, c = jj & 63; const int gi = a < 3 ? a * 512 + h * 64 + c : 1536 + (a - 3) * 64 + c; v = P->in[which ? I_MUN : I_MUP][gi]; }
        else { const int a = (i - 640) >> 6, c = (i - 640) & 63; v = P->in[a == 0 ? I_KK : a == 1 ? I_KA : I_RK][h * 64 + c]; }
        fMU[i] = v;
    }
    const bool scanner = wid < 4; const int pw = wid & 3;
    const int sl8 = lane >> 3, cg8 = (lane & 7) * 8, slot = pw * 8 + sl8;
    const int rowl = lane >> 4, kg = lane & 15, srl = pw * 4 + rowl;
    const unsigned char* HALO0 = ws + WS_HALO + (size_t)(base >> 6) * 2 * HALO_ROW;
    u32x4 raw[5][3];
#define SL_META(hc) (d ? ((hc) == nhalf - 1) : ((hc) == 0))
#define SL_LOAD(hc) do { const int i_ = 32 * (hc) + slot; const bool ok_ = i_ < Ltot; const int p_ = d ? Ltot - 1 - i_ : i_; \
        const unsigned zr_ = (unsigned)(METAROW + 64); \
        if (!SL_META(hc)) { const unsigned rc_ = ok_ ? (unsigned)(base + p_ - 16) : zr_; \
            _Pragma("unroll") for (int a_ = 0; a_ < 5; ++a_) { const unsigned char* B_ = (const unsigned char*)(a_ == 0 ? Rb : a_ == 1 ? KAb : a_ == 2 ? VAb : Lb); const unsigned ld_ = a_ < 3 ? 1024u : 512u; \
                const unsigned co_ = (unsigned)(((a_ < 3 ? h * 64 : (a_ - 3) * 64) + cg8) * 2); raw[a_][1] = *(const u32x4*)(B_ + (rc_ * ld_ + co_)); } \
        } else { const bool me_ = ok_ && p_ < 16; const bool hn_ = me_ && p_ == 15; \
            const unsigned rc_ = ok_ ? (unsigned)pos_row(base, p_) : zr_, rp_ = (me_ && p_ > 0) ? (unsigned)(METAROW + p_ - 1) : zr_, rn_ = (me_ && p_ < 15) ? (unsigned)(METAROW + p_ + 1) : zr_; \
            _Pragma("unroll") for (int a_ = 0; a_ < 5; ++a_) { const unsigned char* B_ = (const unsigned char*)(a_ == 0 ? Rb : a_ == 1 ? KAb : a_ == 2 ? VAb : Lb); const unsigned ld_ = a_ < 3 ? 1024u : 512u; \
                const unsigned co_ = (unsigned)(((a_ < 3 ? h * 64 : (a_ - 3) * 64) + cg8) * 2); \
                const unsigned ho_ = (unsigned)(((a_ < 3 ? a_ * 512 + h * 64 : 1536 + (a_ - 3) * 64) + cg8) * 2); \
                raw[a_][0] = *(const u32x4*)(B_ + (rp_ * ld_ + co_)); raw[a_][1] = *(const u32x4*)(B_ + (rc_ * ld_ + co_)); \
                const unsigned char* np_ = hn_ ? HALO0 + ho_ : B_ + (rn_ * ld_ + co_); raw[a_][2] = *(const u32x4*)np_; } } } while (0)
    constexpr int SL_WB = 110848;
    for (int i = tid; i < 1024; i += NTHREADS) { const int m2 = i >> 9, n = (i >> 3) & 63, ch = i & 7;
        *(LAS u32x4*)(lds + SL_WB + m2 * 9216 + n * 144 + ch * 16) = *(const u32x4*)((const bf16*)(ws + WS_LORA + (m2 ? 131072 : 0)) + ((size_t)d * 512 + h * 64 + n) * 64 + ch * 8); }
    float bias[2][4];
#pragma unroll
    for (int mt_ = 0; mt_ < 2; ++mt_)
#pragma unroll
        for (int nt = 0; nt < 4; ++nt) bias[mt_][nt] = P->in[mt_ ? I_A0 : I_W0][d * 512 + h * 64 + nt * 16 + (lane & 15)];
    float S[4] = {0.f, 0.f, 0.f, 0.f};
#define SL_PREP(hc, buf) do { \
        const bool meta_ = SL_META(hc); const int i1_ = 32 * (hc) + slot; const int p1_ = d ? Ltot - 1 - i1_ : i1_; const bool ok1_ = i1_ < Ltot; \
        LAS float* fSb_ = fS + (buf) * 10240 + slot * 320; float rv[8], kv[8]; \
        if (!meta_) { float vv8[8]; unpack8(raw[0][1], rv); unpack8(raw[1][1], kv); unpack8(raw[2][1], vv8); \
            *(LAS f32x4*)(fSb_ + 256 + cg8) = (f32x4){rv[0], rv[1], rv[2], rv[3]}; *(LAS f32x4*)(fSb_ + 256 + cg8 + 4) = (f32x4){rv[4], rv[5], rv[6], rv[7]}; \
            if ((cg8 >> 4) == rp) { LAS float* dv_ = fV + (buf) * 512 + slot * 16 + (cg8 & 15); *(LAS f32x4*)dv_ = (f32x4){vv8[0], vv8[1], vv8[2], vv8[3]}; *(LAS f32x4*)(dv_ + 4) = (f32x4){vv8[4], vv8[5], vv8[6], vv8[7]}; } \
            *(LAS u32x4*)(lds + SL_TW + slot * 144 + cg8 * 2) = raw[3][1]; *(LAS u32x4*)(lds + SL_AD + slot * 144 + cg8 * 2) = raw[4][1]; \
        } else { const bool me1_ = ok1_ && p1_ < 16; const float fm_ = me1_ ? 1.0f : 0.0f; \
            _Pragma("unroll") for (int a = 0; a < 5; ++a) { \
                float pv_[8], cv_[8], nv_[8], o_[8]; unpack8(raw[a][0], pv_); unpack8(raw[a][1], cv_); unpack8(raw[a][2], nv_); \
                _Pragma("unroll") for (int e = 0; e < 8; ++e) { const float mp_ = fm_ * fMU[a * 64 + cg8 + e], mn_ = fm_ * fMU[320 + a * 64 + cg8 + e]; o_[e] = cv_[e] + mp_ * (pv_[e] - cv_[e]) + mn_ * (nv_[e] - cv_[e]); } \
                if (a == 0) { _Pragma("unroll") for (int e = 0; e < 8; ++e) rv[e] = o_[e]; \
                    *(LAS f32x4*)(fSb_ + 256 + cg8) = (f32x4){o_[0], o_[1], o_[2], o_[3]}; *(LAS f32x4*)(fSb_ + 256 + cg8 + 4) = (f32x4){o_[4], o_[5], o_[6], o_[7]}; } \
                else if (a == 1) { _Pragma("unroll") for (int e = 0; e < 8; ++e) kv[e] = o_[e]; } \
                else if (a == 2) { if ((cg8 >> 4) == rp) { LAS float* dv_ = fV + (buf) * 512 + slot * 16 + (cg8 & 15); *(LAS f32x4*)dv_ = (f32x4){o_[0], o_[1], o_[2], o_[3]}; *(LAS f32x4*)(dv_ + 4) = (f32x4){o_[4], o_[5], o_[6], o_[7]}; } } \
                else { if (a == 3) { _Pragma("unroll") for (int e = 0; e < 8; ++e) o_[e] = me1_ ? fast_tanh(o_[e]) : o_[e]; } \
                    u32x4 w_; w_.x = cvtpk(o_[0], o_[1]); w_.y = cvtpk(o_[2], o_[3]); w_.z = cvtpk(o_[4], o_[5]); w_.w = cvtpk(o_[6], o_[7]); \
                    *(LAS u32x4*)(lds + (a == 3 ? SL_TW : SL_AD) + slot * 144 + cg8 * 2) = w_; } } } \
        asm volatile("s_waitcnt lgkmcnt(0)" ::: "memory"); \
          \
        { f32x4 acc_[2][4]; \
          _Pragma("unroll") for (int m2 = 0; m2 < 2; ++m2) { const LAS unsigned char* Ab_ = lds + (m2 ? SL_AD : SL_TW) + (pw * 8 + (lane & 15)) * 144 + (lane >> 4) * 16; \
              const bf16x8 a0_ = *(const LAS bf16x8*)Ab_, a1_ = *(const LAS bf16x8*)(Ab_ + 64); \
              _Pragma("unroll") for (int nt = 0; nt < 4; ++nt) { f32x4 z_ = {0.f, 0.f, 0.f, 0.f}; const LAS unsigned char* Bb_ = lds + SL_WB + m2 * 9216 + (nt * 16 + (lane & 15)) * 144 + (lane >> 4) * 16; \
                  z_ = __builtin_amdgcn_mfma_f32_16x16x32_bf16(a0_, *(const LAS bf16x8*)Bb_, z_, 0, 0, 0); acc_[m2][nt] = __builtin_amdgcn_mfma_f32_16x16x32_bf16(a1_, *(const LAS bf16x8*)(Bb_ + 64), z_, 0, 0, 0); } } \
          if (lane < 32) { \
              _Pragma("unroll") for (int nt = 0; nt < 4; ++nt) _Pragma("unroll") for (int rg = 0; rg < 4; ++rg) { const int row_ = (lane >> 4) * 4 + rg, col_ = nt * 16 + (lane & 15); \
                  const float sw_ = fast_sigmoid(acc_[0][nt][rg] + bias[0][nt]); fS[(buf) * 10240 + (pw * 8 + row_) * 320 + 64 + col_] = __builtin_amdgcn_exp2f(-0.6065306597126334f * LOG2E * sw_); \
                  fAS[pw * 512 + row_ * 64 + col_] = fast_sigmoid(acc_[1][nt][rg] + bias[1][nt]); } } } \
        asm volatile("s_waitcnt lgkmcnt(0)" ::: "memory"); \
          \
        { const f32x4 a0 = *(const LAS f32x4*)(fAS + pw * 512 + sl8 * 64 + cg8), a1 = *(const LAS f32x4*)(fAS + pw * 512 + sl8 * 64 + cg8 + 4); \
          const f32x4 kk0 = *(const LAS f32x4*)(fMU + 640 + cg8), kk1 = *(const LAS f32x4*)(fMU + 640 + cg8 + 4), ka0 = *(const LAS f32x4*)(fMU + 704 + cg8), ka1 = *(const LAS f32x4*)(fMU + 704 + cg8 + 4); \
          const f32x4 rk0 = *(const LAS f32x4*)(fMU + 768 + cg8), rk1 = *(const LAS f32x4*)(fMU + 768 + cg8 + 4); \
          float kkv[8], kd[8], av[8]; float ssq = 0.f, cs = 0.f; \
          _Pragma("unroll") for (int e = 0; e < 8; ++e) { av[e] = e < 4 ? a0[e & 3] : a1[e & 3]; \
              kkv[e] = kv[e] * (e < 4 ? kk0[e & 3] : kk1[e & 3]); ssq = fmaf(kkv[e], kkv[e], ssq); \
              kd[e] = kv[e] * (1.0f + (av[e] - 1.0f) * (e < 4 ? ka0[e & 3] : ka1[e & 3])); cs = fmaf(rv[e] * kd[e], e < 4 ? rk0[e & 3] : rk1[e & 3], cs); } \
          ssq = grp_sum<8>(ssq); cs = grp_sum<8>(cs); \
          const float rs = rsqrtf(fmaxf(ssq, 1e-24f)); \
          _Pragma("unroll") for (int e = 0; e < 8; ++e) { kkv[e] *= rs; av[e] *= kkv[e]; } \
          *(LAS f32x4*)(fSb_ + cg8) = (f32x4){kkv[0], kkv[1], kkv[2], kkv[3]}; *(LAS f32x4*)(fSb_ + cg8 + 4) = (f32x4){kkv[4], kkv[5], kkv[6], kkv[7]}; \
          *(LAS f32x4*)(fSb_ + 128 + cg8) = (f32x4){av[0], av[1], av[2], av[3]}; *(LAS f32x4*)(fSb_ + 128 + cg8 + 4) = (f32x4){av[4], av[5], av[6], av[7]}; \
          *(LAS f32x4*)(fSb_ + 192 + cg8) = (f32x4){kd[0], kd[1], kd[2], kd[3]}; *(LAS f32x4*)(fSb_ + 192 + cg8 + 4) = (f32x4){kd[4], kd[5], kd[6], kd[7]}; \
          if (cg8 == 0 && rp == 0 && ok1_) CB[((size_t)d * ROWS + pos_row(base, p1_)) * 8 + h] = cs; } } while (0)
#define SL_STORE_Y(hc, buf) do { const int sl5_ = lane >> 1, hf_ = lane & 1; const int i5_ = 32 * (hc) + sl5_; const int p5_ = d ? Ltot - 1 - i5_ : i5_; \
        if (i5_ < Ltot && p5_ >= 16) { const LAS float* yp_ = fY + (buf) * 512 + sl5_ * 16 + hf_ * 8; const f32x4 y0_ = *(const LAS f32x4*)yp_, y1_ = *(const LAS f32x4*)(yp_ + 4); \
            *(u32x4*)(YD + (size_t)(base + p5_ - 16) * 512 + h * 64 + rp * 16 + hf_ * 8) = pack8(y0_, y1_); } } while (0)
    BAR_LDS();
    if (!scanner) { SL_LOAD(0); SL_PREP(0, 0); if (nhalf > 1) SL_LOAD(1); }
    BAR_LDS();
#pragma unroll 1
    for (int hc = 0; hc < nhalf; ++hc) {
        if (scanner) {
            typedef float f32x2_ __attribute__((ext_vector_type(2)));
            const int nvalid = (Ltot - 32 * hc) < 32 ? (Ltot - 32 * hc) : 32, buf = hc & 1;
            const LAS float* ps = fS + buf * 10240 + kg * 4; const LAS float* pv = fV + buf * 512 + srl; LAS float* py = fY + buf * 512 + srl;
            f32x4 nk, nw, nb, nd, nr; float nv;
#define SL_FETCH(sl_) do { nk = *(const LAS f32x4*)(ps + (sl_) * 320); nw = *(const LAS f32x4*)(ps + (sl_) * 320 + 64); nb = *(const LAS f32x4*)(ps + (sl_) * 320 + 128); \
                nd = *(const LAS f32x4*)(ps + (sl_) * 320 + 192); nr = *(const LAS f32x4*)(ps + (sl_) * 320 + 256); nv = pv[(sl_) * 16]; } while (0)
            SL_FETCH(0);
            f32x4 rp4 = {0.f, 0.f, 0.f, 0.f};
            if (nvalid == 32) {
#pragma unroll
            for (int sl = 0; sl < 32; ++sl) {
                const f32x4 ck = nk, cw = nw, cb = nb, cd = nd, cr = nr; const float vv = nv;
                SL_FETCH(sl + 1 < 32 ? sl + 1 : 31);
                f32x2_ pa = {0.f, 0.f}, ya = {0.f, 0.f};
#pragma unroll
                for (int e = 0; e < 4; e += 2) { const f32x2_ s2 = {S[e], S[e + 1]}, k2 = {ck[e], ck[e + 1]}, r2 = {rp4[e], rp4[e + 1]}; pa = pa + s2 * k2; ya = ya + s2 * r2; }
                float pp = pa.x + pa.y, yy = ya.x + ya.y;
                pp = dpp_add(pp, 0); yy = dpp_add(yy, 0); pp = dpp_add(pp, 1); yy = dpp_add(yy, 1); pp = dpp_add(pp, 2); yy = dpp_add(yy, 2); pp = dpp_add(pp, 3); yy = dpp_add(yy, 3);
                py[(sl > 0 ? sl - 1 : 0) * 16] = yy;
#pragma unroll
                for (int e = 0; e < 4; e += 2) { const f32x2_ b2 = {cb[e], cb[e + 1]}, d2 = {cd[e], cd[e + 1]}, w2 = {cw[e], cw[e + 1]}; f32x2_ s2 = {S[e], S[e + 1]};
                    const f32x2_ t2 = d2 * vv - b2 * pp; s2 = s2 * w2 + t2; S[e] = s2.x; S[e + 1] = s2.y; }
                rp4 = cr;
            }
            } else {
#pragma unroll 16
            for (int sl = 0; sl < nvalid; ++sl) {
                const f32x4 ck = nk, cw = nw, cb = nb, cd = nd, cr = nr; const float vv = nv;
                SL_FETCH(sl + 1 < 32 ? sl + 1 : 31);
                f32x2_ pa = {0.f, 0.f}, ya = {0.f, 0.f};
#pragma unroll
                for (int e = 0; e < 4; e += 2) { const f32x2_ s2 = {S[e], S[e + 1]}, k2 = {ck[e], ck[e + 1]}, r2 = {rp4[e], rp4[e + 1]}; pa = pa + s2 * k2; ya = ya + s2 * r2; }
                float pp = pa.x + pa.y, yy = ya.x + ya.y;
                pp = dpp_add(pp, 0); yy = dpp_add(yy, 0); pp = dpp_add(pp, 1); yy = dpp_add(yy, 1); pp = dpp_add(pp, 2); yy = dpp_add(yy, 2); pp = dpp_add(pp, 3); yy = dpp_add(yy, 3);
                py[(sl > 0 ? sl - 1 : 0) * 16] = yy;
#pragma unroll
                for (int e = 0; e < 4; e += 2) { const f32x2_ b2 = {cb[e], cb[e + 1]}, d2 = {cd[e], cd[e + 1]}, w2 = {cw[e], cw[e + 1]}; f32x2_ s2 = {S[e], S[e + 1]};
                    const f32x2_ t2 = d2 * vv - b2 * pp; s2 = s2 * w2 + t2; S[e] = s2.x; S[e + 1] = s2.y; }
                rp4 = cr;
            }
            }
            { f32x2_ ya = {0.f, 0.f};
#pragma unroll
              for (int e = 0; e < 4; e += 2) { const f32x2_ s2 = {S[e], S[e + 1]}, r2 = {rp4[e], rp4[e + 1]}; ya = ya + s2 * r2; }
              const float yy = grp_sum<16>(ya.x + ya.y); py[(nvalid - 1) * 16] = yy; }
#undef SL_FETCH
        } else {
            if (hc > 0 && pw == 0) SL_STORE_Y(hc - 1, (hc - 1) & 1);
            if (hc + 1 < nhalf) { SL_PREP(hc + 1, (hc + 1) & 1); if (hc + 2 < nhalf) SL_LOAD(hc + 2); }
        }
        BAR_LDS();
    }
    if (!scanner && pw == 0) SL_STORE_Y(nhalf - 1, (nhalf - 1) & 1);
#undef SL_STORE_Y
#undef SL_PREP
#undef SL_LOAD
#undef SL_META
}

__device__ __forceinline__ void rwkv_colmap(unsigned char* ws, int c0, bf16*& buf, int& ld, int& col) {
    if (c0 < 512) { buf = (bf16*)(ws + WS_R); ld = 512; col = c0; }
    else if (c0 < 1024) { buf = (bf16*)(ws + WS_KA); ld = 512; col = c0 - 512; }
    else if (c0 < 1536) { buf = (bf16*)(ws + WS_VA); ld = 512; col = c0 - 1024; }
    else { buf = (bf16*)(ws + WS_L); ld = 256; col = c0 - 1536; }
}
__device__ __forceinline__ void phase_halo(KP P) {
    const int tid = fresh_tid(), lane = tid & 63, wid = tid >> 6; const int gw = blockIdx.x * 8 + wid, NGW = gridDim.x * 8;
    unsigned char* ws = P->ws;
    for (int r = gw; r < (NMAIN / 64) * 2; r += NGW) {
        const int m = (r >> 1) * 64 + ((r & 1) ? 63 : 0);
        for (int j = lane; j < 224; j += 64) { bf16* buf; int ld, col; rwkv_colmap(ws, j * 8, buf, ld, col);
            *(u32x4*)(ws + WS_HALO + (size_t)r * HALO_ROW + j * 16) = *(const u32x4*)(buf + (size_t)m * ld + col); }
    }
}
__device__ __forceinline__ void phase_shift(LAS unsigned char* lds, KP P) {
    const int tid = fresh_tid(), slot = tid >> 3, cg = tid & 7;
    unsigned char* ws = P->ws; const float* mup = P->in[I_MUP]; const float* mun = P->in[I_MUN];
    for (int tile = blockIdx.x; tile < NMAIN / 64; tile += gridDim.x) {
        const int m0 = tile * 64, m = m0 + slot;
        const int ks = m0 < 16384 ? tile : ((m0 - 16384) & 2047) >> 6; const bool first = ks == 0, last = ks == (m0 < 16384 ? 255 : 31);
        u32x4 stg[7];
#define SH_LOAD(pass_) do { _Pragma("unroll") for (int i = 0; i < 7; ++i) { const int j = cg + 8 * i; bf16* buf; int ld, col; rwkv_colmap(ws, ((pass_) * 56 + j) * 8, buf, ld, col); \
            stg[i] = *(const u32x4*)(buf + (size_t)m * ld + col); } } while (0)
        SH_LOAD(0);
#pragma unroll 1
        for (int pass = 0; pass < 4; ++pass) {
#pragma unroll
            for (int i = 0; i < 7; ++i) { const int j = cg + 8 * i; *(LAS u32x4*)(lds + (slot * 56 + j) * 16) = stg[i]; }
            asm volatile("s_waitcnt lgkmcnt(0)\n\ts_barrier" ::: "memory");
            if (pass < 3) SH_LOAD(pass + 1);
#pragma unroll
            for (int i = 0; i < 7; ++i) {
                const int j = cg + 8 * i, c0 = (pass * 56 + j) * 8; bf16* buf; int ld, col; rwkv_colmap(ws, c0, buf, ld, col);
                const u32x4 z = {0u, 0u, 0u, 0u};
                const u32x4 cu = *(const LAS u32x4*)(lds + (slot * 56 + j) * 16);
                u32x4 pu, nu;
                if (slot > 0) pu = *(const LAS u32x4*)(lds + ((slot - 1) * 56 + j) * 16);
                else pu = first ? *(const u32x4*)(buf + (size_t)(METAROW + 15) * ld + col) : *(const u32x4*)(ws + WS_HALO + (size_t)((tile - 1) * 2 + 1) * HALO_ROW + c0 * 2);
                if (slot < 63) nu = *(const LAS u32x4*)(lds + ((slot + 1) * 56 + j) * 16);
                else nu = last ? z : *(const u32x4*)(ws + WS_HALO + (size_t)((tile + 1) * 2) * HALO_ROW + c0 * 2);
                float pv[8], cv[8], nv[8], o[8]; unpack8(pu, pv); unpack8(cu, cv); unpack8(nu, nv);
                const f32x4 mp0 = *(const f32x4*)(mup + c0), mp1 = *(const f32x4*)(mup + c0 + 4), mn0 = *(const f32x4*)(mun + c0), mn1 = *(const f32x4*)(mun + c0 + 4);
#pragma unroll
                for (int e = 0; e < 8; ++e) { const float mp = e < 4 ? mp0[e & 3] : mp1[e & 3], mn = e < 4 ? mn0[e & 3] : mn1[e & 3]; o[e] = cv[e] + mp * (pv[e] - cv[e]) + mn * (nv[e] - cv[e]); }
                if (c0 >= 1536 && c0 < 1600) {
#pragma unroll
                    for (int e = 0; e < 8; ++e) o[e] = fast_tanh(o[e]);
                }
                u32x4 w; w.x = cvtpk(o[0], o[1]); w.y = cvtpk(o[2], o[3]); w.z = cvtpk(o[4], o[5]); w.w = cvtpk(o[6], o[7]);
                *(u32x4*)(buf + (size_t)m * ld + col) = w;
            }
            asm volatile("s_waitcnt lgkmcnt(0)\n\ts_barrier" ::: "memory");
        }
#undef SH_LOAD
    }
}

__device__ __forceinline__ void phase_post(LAS unsigned char* lds, KP P) {
    const int tid = fresh_tid(), lane = tid & 63, wid = tid >> 6;
    unsigned char* ws = P->ws;
    const bf16* VAb = (const bf16*)(ws + WS_VA); const bf16* Lb = (const bf16*)(ws + WS_L); bf16* Rb = (bf16*)(ws + WS_R);
    const float* CB = (const float*)(ws + WS_CB); const bf16* YD0 = (const bf16*)((const unsigned char*)P->out + 64 * MiB); const bf16* YD1 = YD0 + (size_t)NMAIN * 512;
    const bf16* GT = (const bf16*)(ws + WS_LORA + 262144);
    LAS float* st = (LAS float*)(lds + 17408);
    const float* mup = P->in[I_MUP]; const float* mun = P->in[I_MUN];
    for (int tile = blockIdx.x; tile < NMAIN / 64; tile += gridDim.x) {
        {
            const int row = tid >> 3, hh = tid & 7, m = tile * 64 + row;
            const int t = m < 16384 ? m : (m - 16384) & 2047, Ls = m < 16384 ? 16384 : 2048;
            float sum = 0.f, sq = 0.f;
#pragma unroll
            for (int i = 0; i < 8; ++i) { float a[8], b[8]; unpack8(*(const u32x4*)(YD0 + (size_t)m * 512 + hh * 64 + i * 8), a); unpack8(*(const u32x4*)(YD1 + (size_t)m * 512 + hh * 64 + i * 8), b);
#pragma unroll
                for (int e = 0; e < 8; ++e) { const float y = a[e] + b[e]; sum += y; sq += y * y; } }
            const float mu = sum * (1.0f / 64.0f); const float var = fmaxf(sq * (1.0f / 64.0f) - mu * mu, 0.f);
            st[(row * 8 + hh) * 2] = mu; st[(row * 8 + hh) * 2 + 1] = rsqrtf(var + 64e-5f);
#pragma unroll
            for (int i = 0; i < 2; ++i) {
                const int c0 = 128 + hh * 16 + i * 8; float cv[8], o[8];
                unpack8(*(const u32x4*)(Lb + (size_t)m * 256 + c0), cv);
#pragma unroll
                for (int e = 0; e < 8; ++e) o[e] = sigmoidf_(cv[e]);
                u32x4 w; w.x = cvtpk(o[0], o[1]); w.y = cvtpk(o[2], o[3]); w.z = cvtpk(o[4], o[5]); w.w = cvtpk(o[6], o[7]);
                *(LAS u32x4*)(lds + row * 272 + (hh * 16 + i * 8) * 2) = w;
            }
        }
        __syncthreads();
#pragma unroll 1
        for (int nt = 0; nt < 4; ++nt) {
            const int col = wid * 64 + nt * 16 + (lane & 15);
            bf16x8 bfr[4];
#pragma unroll
            for (int ks = 0; ks < 4; ++ks) bfr[ks] = *(const bf16x8*)(GT + (size_t)col * 128 + ks * 32 + (lane >> 4) * 8);
            const float lw = P->in[I_LNW][col], lb = P->in[I_LNB][col];
            const float mpv = mup[1024 + col], mnv = mun[1024 + col];
#pragma unroll 1
            for (int mt = 0; mt < 4; ++mt) {
                f32x4 acc = {0.f, 0.f, 0.f, 0.f};
#pragma unroll
                for (int ks = 0; ks < 4; ++ks) { const bf16x8 a = *(const LAS bf16x8*)(lds + (mt * 16 + (lane & 15)) * 272 + ks * 64 + (lane >> 4) * 16); acc = __builtin_amdgcn_mfma_f32_16x16x32_bf16(a, bfr[ks], acc, 0, 0, 0); }
#pragma unroll
                for (int rg = 0; rg < 4; ++rg) {
                    const int row = mt * 16 + (lane >> 4) * 4 + rg, m = tile * 64 + row;
                    const int t = m < 16384 ? m : (m - 16384) & 2047, Ls = m < 16384 ? 16384 : 2048;
                    const float y = bf2f(YD0[(size_t)m * 512 + col]) + bf2f(YD1[(size_t)m * 512 + col]);
                    const float yn = (y - st[(row * 8 + wid) * 2]) * st[(row * 8 + wid) * 2 + 1] * lw + lb;
                    const float vs = bf2f(VAb[(size_t)m * 512 + col]);
                    const float cb = CB[(size_t)m * 8 + wid] + CB[((size_t)ROWS + m) * 8 + wid];
                    Rb[(size_t)m * 512 + col] = (bf16)f2bf_rne((yn + cb * vs) * acc[rg]);
                }
            }
        }
        __syncthreads();
    }
}

__device__ __forceinline__ void phase_rms_bf16(KP P) {
    const int tid = fresh_tid(), lane = tid & 63, wid = tid >> 6; const int gw = blockIdx.x * 8 + wid, NGW = gridDim.x * 8;
    bf16* MN = (bf16*)(P->ws + WS_MN);
    for (int m = gw; m < NMAIN; m += NGW) rms_row_bf16(P->out + (size_t)m * DM, P->in[I_GFFN], MN + (size_t)m * DM, lane);
}
__device__ __forceinline__ void phase_final(KP P) {
    const int tid = fresh_tid(), lane = tid & 63, wid = tid >> 6; const int gw = blockIdx.x * 8 + wid, NGW = gridDim.x * 8;
    const f32x4* gr = (const f32x4*)P->in[I_GFIN] + lane;
    for (int m = gw; m < NMAIN; m += NGW) {
        f32x4* xr = (f32x4*)(P->out + (size_t)m * DM) + lane; f32x4 v[4]; float s = 0.f;
#pragma unroll
        for (int j = 0; j < 4; ++j) { v[j] = xr[64 * j]; s += (v[j].x * v[j].x + v[j].y * v[j].y) + (v[j].z * v[j].z + v[j].w * v[j].w); }
        const float rstd = rsqrtf(wave_sum(s) * (1.f / DM) + 1e-6f);
#pragma unroll
        for (int j = 0; j < 4; ++j) xr[64 * j] = v[j] * rstd * gr[64 * j];
    }
}

constexpr int NRP_LONG = 4;
constexpr int N_LONG = 16 * NRP_LONG, N_ATT_P = 512, N_ATT_S = 512, N_SHORT = 128, N_ITEMS = N_LONG + N_ATT_P + N_ATT_S + N_SHORT;

template <class Op> __device__ __forceinline__ void run_gemm(LAS unsigned char* lds, const bf16* A, const bf16* Bt, int M, int N, int K, const Op& op, const bf16* A2 = nullptr, int pm2 = 1 << 30) {
    pg8::Gemm g{A, Bt, M, N, K, A2, pm2}; pg8::StaticOrder S; S.init(M, N, (int)gridDim.x, (int)blockIdx.x);
    Epi8<Op> E{op};
    pg8::gemm_phase<Epi8<Op>, pg8::StaticOrder, true, true>(lds, g, S, E);
}

constexpr size_t WS_XBAR = 16384;
#define XB_TMO      128
#define XB_XCNT(j)  (256  + 64 * (j))
#define XB_XSUB(j)  (1280 + 64 * (j))
#define XB_XGEN(j)  (2304 + 64 * (j))
#define XB_TOP      3328
#define XB_TOPGEN   3392
#define XCD_BAR_WORDS 3456
#define XB_SPIN_CAP (1u << 18)
__device__ __forceinline__ unsigned xb_ld(unsigned* p)              { return __hip_atomic_load(p, __ATOMIC_RELAXED, __HIP_MEMORY_SCOPE_AGENT); }
__device__ __forceinline__ unsigned xb_add(unsigned* p, unsigned v) { return __hip_atomic_fetch_add(p, v, __ATOMIC_RELAXED, __HIP_MEMORY_SCOPE_AGENT); }
__device__ __forceinline__ unsigned xb_xcc_id() { return (unsigned)__builtin_amdgcn_s_getreg((3 << 11) | 20) & 0xFu; }
#define XB_SPIN(cond, bar) do { unsigned _sp = 0; while (cond) { __builtin_amdgcn_s_sleep(1); \
    if ((++_sp & 255u) == 0u) { if (xb_ld(&(bar)[XB_TMO])) break; if (_sp > XB_SPIN_CAP) { atomicAdd(&(bar)[XB_TMO], 1u); break; } } } } while (0)
struct XcdBarrier { unsigned* bar; unsigned x; volatile LAS unsigned* st; };
__device__ __forceinline__ XcdBarrier xcd_barrier_post(unsigned* bar, volatile LAS unsigned* st) {
    XcdBarrier b; b.bar = bar; b.x = xb_xcc_id(); b.st = st;
    if (threadIdx.x == 0) (void)xb_add(&bar[XB_XCNT(b.x)], 1u);
    return b;
}
__device__ __forceinline__ void xcd_barrier_complete(unsigned* bar, unsigned x, unsigned& nloc, unsigned& nx) {
    const unsigned G = gridDim.x * gridDim.y * gridDim.z;
    unsigned sum, cnt, mine, sp = 0u;
    for (;;) {
        sum = 0u; cnt = 0u; mine = 0u;
#pragma unroll
        for (unsigned j = 0; j < 16; ++j) { const unsigned c = xb_ld(&bar[XB_XCNT(j)]); sum += c; cnt += (c > 0u) ? 1u : 0u; mine = (j == x) ? c : mine; }
        if (sum == G) break;
        __builtin_amdgcn_s_sleep(1);
        if ((++sp & 255u) == 0u) { if (xb_ld(&bar[XB_TMO])) break; if (sp > XB_SPIN_CAP) { atomicAdd(&bar[XB_TMO], 1u); break; } }
    }
    nloc = mine > 0u ? mine : 1u; nx = cnt > 0u ? cnt : 1u;
}
__device__ __forceinline__ void xcd_barrier(const XcdBarrier& b) {
    asm volatile("s_waitcnt vmcnt(0)" ::: "memory");
    __syncthreads();
    if (threadIdx.x == 0) {
        unsigned* bar = b.bar;
        __builtin_amdgcn_s_waitcnt(0);
        unsigned nloc = b.st[0], nx = b.st[1];
        if (nloc == 0u) { xcd_barrier_complete(bar, b.x, nloc, nx); b.st[0] = nloc; b.st[1] = nx; }
        const unsigned old = xb_add(&bar[XB_XSUB(b.x)], 1u);
        const unsigned gen = old / nloc;
        if (old + 1u == (gen + 1u) * nloc) {
            __builtin_amdgcn_fence(__ATOMIC_RELEASE, "agent");
            asm volatile("s_waitcnt vmcnt(0)" ::: "memory");
            const unsigned og = xb_add(&bar[XB_TOP], 1u);
            const unsigned tg = og / nx;
            if (og + 1u == (tg + 1u) * nx) xb_add(&bar[XB_TOPGEN], 1u);
            else XB_SPIN(xb_ld(&bar[XB_TOPGEN]) == tg, bar);
            __builtin_amdgcn_fence(__ATOMIC_ACQUIRE, "agent");
            xb_add(&bar[XB_XGEN(b.x)], 1u);
            asm volatile("s_waitcnt vmcnt(0)" ::: "memory");
        } else {
            XB_SPIN(xb_ld(&bar[XB_XGEN(b.x)]) == gen, bar);
            __builtin_amdgcn_fence(__ATOMIC_ACQUIRE, "agent");
            asm volatile("s_waitcnt vmcnt(0)" ::: "memory");
        }
    }
    __syncthreads();
}
#ifndef PROBE_MASK
#define PROBE_MASK 0
#endif
#ifndef PROBE_MUL
#define PROBE_MUL 1
#endif
#define PH_BEGIN(k) unsigned long long t0_##k = 0; if (PROBE_MASK & (1 << (k))) t0_##k = __builtin_amdgcn_s_memrealtime();
#define PH_END(k) if (PROBE_MASK & (1 << (k))) { const unsigned long long t1_ = __builtin_amdgcn_s_memrealtime(); const unsigned long long dt_ = (t1_ - t0_##k) * PROBE_MUL; while (__builtin_amdgcn_s_memrealtime() - t1_ < dt_) __builtin_amdgcn_s_sleep(8); xcd_barrier(xbar); }
__global__ void __launch_bounds__(NTHREADS) fwd_megakernel(Params Pin) {
    extern __shared__ __attribute__((aligned(16))) unsigned char lds_raw[];
    LAS unsigned char* lds = (LAS unsigned char*)lds_raw;
    cg::grid_group grid = cg::this_grid();
    KP P0 = (KP)__builtin_amdgcn_kernarg_segment_ptr();
    volatile LAS unsigned* xst = (volatile LAS unsigned*)(lds + LDS_ITEM_OFF + 4);
    if (threadIdx.x == 0) { xst[0] = 0u; xst[1] = 0u; }
    __syncthreads();
    const XcdBarrier xbar = xcd_barrier_post((unsigned*)(P0->ws + WS_XBAR), xst);
#define NEWPHASE KP P = P0; asm volatile("" : "+s"(P)); unsigned char* ws = P->ws; (void)ws;

    PH_BEGIN(0)
    { NEWPHASE phase_prologue(lds, P); }
    grid.sync();
    PH_END(0)
    PH_BEGIN(1)
    { NEWPHASE run_gemm(lds, (const bf16*)P->out, (const bf16*)(ws + WS_WIN), ROWS, 3328, 1024, OpProj{ws}, (const bf16*)(ws + WS_XNMETA), 128); }
    xcd_barrier(xbar);
    PH_END(1)
    { NEWPHASE phase_halo(P); }
    xcd_barrier(xbar);
    { NEWPHASE phase_shift(lds, P); }
    xcd_barrier(xbar);
    PH_BEGIN(2)
    { NEWPHASE
        const int tid = fresh_tid();
        float lam;
        { const int lane = tid & 63; const float s1 = wave_sum(P->in[I_LQ1][lane] * P->in[I_LK1][lane]), s2 = wave_sum(P->in[I_LQ2][lane] * P->in[I_LK2][lane]); lam = __expf(s1) - __expf(s2) + 0.2f; }
        unsigned* ctr = (unsigned*)(ws + WS_CTL);
        LAS unsigned* slot = (LAS unsigned*)(lds + LDS_ITEM_OFF);
#define FETCH(k, n) if (tid == 0) *slot = atomicAdd(ctr + 64 * (k), 1u); __syncthreads(); const int idx = (int)*slot; __syncthreads(); if (idx >= (n)) break;
#ifndef NO_SCAN
#pragma unroll 1
        for (;;) { FETCH(0, N_LONG) const int u = idx / NRP_LONG; scan_long(lds, P, 0, u >> 3, u & 7, idx % NRP_LONG); }
#endif
#ifndef NO_ATTN
#pragma unroll 1
        for (;;) { FETCH(1, N_ATT_P + N_ATT_S)
            if (idx < N_ATT_P) attn_unit(lds, P, 0, idx >> 7, idx & 127, lam);
            else { const int a = idx - N_ATT_P; attn_unit(lds, P, 1 + (a >> 6), (a >> 4) & 3, a & 15, lam); } }
#endif
#ifndef NO_SCAN
#pragma unroll 1
        for (;;) { FETCH(2, N_SHORT) scan_unit<1, 8>(lds, P, 1 + (idx >> 4), (idx >> 3) & 1, idx & 7, 0); }
#endif
#undef FETCH
    }
    xcd_barrier(xbar);
    PH_END(2)
#ifndef NO_POST
    PH_BEGIN(3)
    { NEWPHASE phase_post(lds, P); }
#endif
    xcd_barrier(xbar);
    PH_END(3)
    PH_BEGIN(4)
    { NEWPHASE run_gemm(lds, (const bf16*)P->out, (const bf16*)(ws + WS_WIN) + (size_t)3328 * 1024, NMAIN, 1024, 1024, OpGate{(bf16*)(ws + WS_GA)}); }
    { NEWPHASE run_gemm(lds, (const bf16*)P->out, (const bf16*)(ws + WS_WIN) + (size_t)4352 * 1024, NMAIN, 1024, 1024, OpGate{(bf16*)(ws + WS_GB)}); }

    PH_END(4)
    PH_BEGIN(5)
    { NEWPHASE run_gemm(lds, (const bf16*)(ws + WS_R), (const bf16*)(ws + WS_WUPA), NMAIN, 1024, 512, OpUpA{ws}); }
    PH_END(5)
    PH_BEGIN(6)
    { NEWPHASE run_gemm(lds, (const bf16*)(ws + WS_Q), (const bf16*)(ws + WS_WUPB), NMAIN, 1024, 512, OpUpB{ws}); }
    xcd_barrier(xbar);
    PH_END(6)
    PH_BEGIN(7)
    { NEWPHASE run_gemm(lds, (const bf16*)(ws + WS_GB), (const bf16*)(ws + WS_WOUT), NMAIN, 1024, 1024, OpOut{P->in[I_XP], P->in[I_XS], P->out, P->in[I_GFFN], (bf16*)(ws + WS_MN), (float*)(ws + WS_SS)}); }
    xcd_barrier(xbar);
    PH_END(7)
    PH_BEGIN(9)
    { NEWPHASE run_gemm(lds, (const bf16*)(ws + WS_MN), (const bf16*)(ws + WS_WFF1), 16384, DFF, 1024, OpFF1{(bf16*)(ws + WS_HID), (const float*)(ws + WS_SS)}); }
    xcd_barrier(xbar);
    PH_END(9)
    PH_BEGIN(10)
    { NEWPHASE run_gemm(lds, (const bf16*)(ws + WS_HID), (const bf16*)(ws + WS_WFF2), 16384, 1024, DFF, OpFF2{P->out}); }
    xcd_barrier(xbar);
    PH_END(10)
    PH_BEGIN(11)
    { NEWPHASE run_gemm(lds, (const bf16*)(ws + WS_MN) + (size_t)16384 * DM, (const bf16*)(ws + WS_WFF1), 16384, DFF, 1024, OpFF1{(bf16*)(ws + WS_HID), (const float*)(ws + WS_SS) + 16384}); }
    xcd_barrier(xbar);
    PH_END(11)
    PH_BEGIN(12)
    { NEWPHASE run_gemm(lds, (const bf16*)(ws + WS_HID), (const bf16*)(ws + WS_WFF2), 16384, 1024, DFF, OpFF2{P->out + (size_t)16384 * DM}); }
    xcd_barrier(xbar);
    PH_END(12)
    PH_BEGIN(13)
    { NEWPHASE phase_final(P); }
}

extern "C" void kernel_launch(void* const* d_in, const int* in_sizes, int n_in, void* d_out, int out_size, void* d_ws, size_t ws_size, hipStream_t stream) {
    static int grid_blocks = 0;
    if (grid_blocks == 0) {
        int dev = 0, cus = 0, per_cu = 0;
        hipGetDevice(&dev);
        hipDeviceGetAttribute(&cus, hipDeviceAttributeMultiprocessorCount, dev);
        hipFuncSetAttribute((const void*)fwd_megakernel, hipFuncAttributeMaxDynamicSharedMemorySize, LDS_BYTES);
        hipOccupancyMaxActiveBlocksPerMultiprocessor(&per_cu, (const void*)fwd_megakernel, NTHREADS, LDS_BYTES);
        if (per_cu < 1) { fprintf(stderr, "kernel_launch: occupancy query says %d blocks per CU\n", per_cu); per_cu = 1; }
        grid_blocks = cus * per_cu;
        if (n_in != 29 || ws_size < WS_END) fprintf(stderr, "kernel_launch: unexpected n_in %d / ws_size %zu\n", n_in, ws_size);
    }
    hipMemsetAsync((unsigned char*)d_ws + WS_CTL, 0, 196608, stream);
    Params p{};
    for (int i = 0; i < 29; ++i) p.in[i] = (const float*)d_in[i];
    p.out = (float*)d_out; p.ws = (unsigned char*)d_ws;
    void* args[] = {&p};
    hipError_t e = hipLaunchCooperativeKernel((const void*)fwd_megakernel, dim3(grid_blocks), dim3(NTHREADS), args, LDS_BYTES, stream);
    if (e != hipSuccess) fprintf(stderr, "cooperative launch failed: %s (grid %d)\n", hipGetErrorString(e), grid_blocks);
}
```

```cpp
#include <hip/hip_runtime.h>
#include <hip/hip_cooperative_groups.h>
#include <cstdio>
#include <cstdint>
#include <cmath>
namespace cg = cooperative_groups;
__device__ __forceinline__ int fresh_tid() { int t = threadIdx.x; asm volatile("" : "+v"(t)); return t; }
namespace pg8 {
#define PG8_LAS __attribute__((address_space(3)))
typedef unsigned short bf16_t;
typedef short bf16x8 __attribute__((ext_vector_type(8)));
typedef float f32x4 __attribute__((ext_vector_type(4)));
typedef unsigned u32x4 __attribute__((ext_vector_type(4)));
constexpr int BM = 256, BK = 64, HALF = 128, HTB = HALF * BK * 2  , STAGE_BYTES = 8 * HTB, NXCD = 8, WGM = 8;

__host__ __device__ __forceinline__ int lds_byte(int r, int c) { const int st = (r >> 4) * 2 + (c >> 5), rr = r & 15, cc = c & 31, ob = rr * 64 + cc * 2; return st * 1024 + (ob ^ (((ob >> 9) & 1) << 5)); }
__host__ __device__ __forceinline__ void stage_rc(int b, int& R, int& C) { const int st = b / 1024, sb = b % 1024, swz = sb ^ (((sb >> 9) & 1) << 5); R = (st >> 1) * 16 + swz / 64; C = (st & 1) * 32 + (swz % 64) / 2; }
__host__ __device__ __forceinline__ int perm32(int rho) { const int n = rho >> 4, i = rho & 15; return 8 * (i >> 2) + 4 * n + (i & 3); }

struct Unit { int pm, pn; };
struct Gemm { const bf16_t* A; const bf16_t* Bt; int M, N, K; const bf16_t* A2; int pm2; };
__device__ __forceinline__ const char* gemm_abase(const Gemm& g, int pm, size_t tstep) { return pm >= g.pm2 ? (const char*)g.A2 + (size_t)(pm - g.pm2) * tstep : (const char*)g.A + (size_t)pm * tstep; }

struct StaticOrder {
    int nM, nN, nwg, G, c;
    __host__ __device__ void init(int M, int N, int G_, int c_) { nM = M / BM; nN = N / BM; nwg = nM * nN; G = G_; c = c_; }
    __host__ __device__ bool next(int i, Unit& u) const {
        const long L = (long)i * G + c; if (L >= nwg) return false;
        int wgid = (int)L; { const int q = nwg / NXCD, r = nwg % NXCD, xcd = wgid % NXCD, off = wgid / NXCD; wgid = (xcd < r ? xcd * (q + 1) : r * (q + 1) + (xcd - r) * q) + off; }
        const int nig = WGM * nN, gid = wgid / nig, fm = gid * WGM, gsz = (nM - fm) < WGM ? (nM - fm) : WGM;
        u.pm = fm + ((wgid % nig) % gsz); u.pn = (wgid % nig) / gsz; return true;
    }
    __device__ __forceinline__ void a_ready(const Unit&) const {}
    __device__ __forceinline__ void done(const Unit&) const {}
};


template <class Epi, class Sched, bool ALIGN_EPI = false, bool SP2 = false>
__device__ __forceinline__ void gemm_phase(PG8_LAS unsigned char* lds, const Gemm g, const Sched& S, const Epi& E) {
    const int tid = fresh_tid(), wid = __builtin_amdgcn_readfirstlane(tid >> 6), lane = tid & 63, wr = wid >> 2, wc = wid & 3, fr = lane & 15, fq = lane >> 4;
    const int K = g.K, nt = K / BK;
    unsigned voffA[2], voffB[2];
#pragma unroll
    for (int i = 0; i < 2; ++i) { int R, C; stage_rc(tid * 16 + i * 8192, R, C); const int Rb = Epi::PERM ? ((R & ~31) + perm32(R & 31)) : R;
        voffA[i] = (unsigned)(R * K + C) * 2u; voffB[i] = (unsigned)(Rb * K + C) * 2u; }
    const size_t kstep = (size_t)(BK * 2);
    const size_t hstep = (size_t)HALF * K * 2;
    const size_t tstep = 2 * hstep;
    const unsigned ldsw = (unsigned)wid * 1024u;
    const int aoff = lds_byte(wr * 64 + fr, fq * 8), boff = lds_byte(wc * 32 + fr, fq * 8);
#define PG8_SA(b, h) (((b) * 2 + (h)) * HTB)
#define PG8_SB(b, h) ((4 + (b) * 2 + (h)) * HTB)
#define PG8_STAGE(bufoff, gbase, voff) do { _Pragma("unroll") for (int _i = 0; _i < 2; ++_i) \
        __builtin_amdgcn_global_load_lds((const unsigned*)((const char*)(gbase) + (voff)[_i]), (PG8_LAS unsigned*)(lds + (bufoff) + ldsw + _i * 8192), 16, 0, 0); } while (0)
#define PG8_LDA(dst, b, h) do { _Pragma("unroll") for (int m = 0; m < 4; ++m) _Pragma("unroll") for (int k = 0; k < 2; ++k) dst[m][k] = *(const PG8_LAS bf16x8*)(lds + PG8_SA(b, h) + aoff + m * 2048 + k * 1024); } while (0)
#define PG8_LDB(dst, b, h) do { _Pragma("unroll") for (int n = 0; n < 2; ++n) _Pragma("unroll") for (int k = 0; k < 2; ++k) dst[n][k] = *(const PG8_LAS bf16x8*)(lds + PG8_SB(b, h) + boff + n * 2048 + k * 1024); } while (0)
#define PG8_MMA(ai, bj, At, Bt) do { __builtin_amdgcn_s_setprio(1); _Pragma("unroll") for (int m = 0; m < 4; ++m) _Pragma("unroll") for (int n = 0; n < 2; ++n) _Pragma("unroll") for (int k = 0; k < 2; ++k) \
        acc[ai][bj][m][n] = __builtin_amdgcn_mfma_f32_16x16x32_bf16(Bt[n][k], At[m][k], acc[ai][bj][m][n], 0, 0, 0); __builtin_amdgcn_s_setprio(0); } while (0)
#define PG8_WAIT_V(n) asm volatile("s_waitcnt vmcnt(" #n ")" ::: "memory")
#define PG8_WAIT_L(n) asm volatile("s_waitcnt lgkmcnt(" #n ")" ::: "memory")
#define PG8_BAR __builtin_amdgcn_s_barrier()
#define PG8_SCHED __builtin_amdgcn_sched_barrier(0)
    Unit cur, nxt; int ui = 0;
    if (!S.next(0, cur)) return;
    f32x4 acc[2][2][4][2];
#pragma unroll
    for (int a = 0; a < 2; ++a)
#pragma unroll
        for (int b = 0; b < 2; ++b)
#pragma unroll
            for (int m = 0; m < 4; ++m)
#pragma unroll
                for (int n = 0; n < 2; ++n) acc[a][b][m][n] = (f32x4){0.f, 0.f, 0.f, 0.f};
    bf16x8 At[4][2], B0[2][2], B1[2][2];
    const char* cA = gemm_abase(g, cur.pm, tstep); const char* cB = (const char*)g.Bt + (size_t)cur.pn * tstep;
    S.a_ready(cur);
    if constexpr (SP2) {
        PG8_STAGE(PG8_SB(0, 0), cB, voffB); PG8_STAGE(PG8_SB(0, 1), cB + hstep, voffB); PG8_STAGE(PG8_SA(0, 0), cA, voffA); PG8_STAGE(PG8_SA(0, 1), cA + hstep, voffA);
        if (wr == 1) PG8_BAR;
        PG8_WAIT_V(2); PG8_BAR;
        PG8_STAGE(PG8_SB(1, 0), cB + kstep, voffB); PG8_STAGE(PG8_SA(1, 0), cA + kstep, voffA); PG8_STAGE(PG8_SB(1, 1), cB + hstep + kstep, voffB);
        PG8_WAIT_V(6); PG8_BAR;
    } else {
        PG8_STAGE(PG8_SB(0, 0), cB, voffB); PG8_STAGE(PG8_SA(0, 0), cA, voffA); PG8_STAGE(PG8_SB(0, 1), cB + hstep, voffB); PG8_STAGE(PG8_SA(0, 1), cA + hstep, voffA);
        if (wr == 1) PG8_BAR;
        PG8_WAIT_V(4); PG8_BAR;
        PG8_STAGE(PG8_SB(1, 0), cB + kstep, voffB); PG8_STAGE(PG8_SA(1, 0), cA + kstep, voffA); PG8_STAGE(PG8_SB(1, 1), cB + hstep + kstep, voffB);
        PG8_WAIT_V(6); PG8_BAR;
    }
    for (;;) {
        const bool has_next = S.next(ui + 1, nxt);
        const char* nA = has_next ? gemm_abase(g, nxt.pm, tstep) : cA; const char* nB = has_next ? (const char*)g.Bt + (size_t)nxt.pn * tstep : cB;
        for (int t = 0; t < nt; t += 2) {
            const bool last = (t == nt - 2);
            const char* a1 = cA + (size_t)(t + 1) * kstep;
            const char* a2 = last ? nA : cA + (size_t)(t + 2) * kstep; const char* b2 = last ? nB : cB + (size_t)(t + 2) * kstep;
            const char* a3 = a2 + kstep; const char* b3 = b2 + kstep;
            if (last && has_next) S.a_ready(nxt);
            if constexpr (SP2) {
            PG8_LDB(B0, 0, 0); PG8_LDB(B1, 0, 1); PG8_SCHED; PG8_LDA(At, 0, 0); PG8_STAGE(PG8_SA(1, 1), a1 + hstep, voffA);
            PG8_WAIT_V(8); PG8_WAIT_L(0); PG8_BAR; PG8_MMA(0, 0, At, B0); PG8_MMA(0, 1, At, B1); PG8_BAR; PG8_SCHED;
            PG8_LDA(At, 0, 1); PG8_STAGE(PG8_SB(0, 0), b2, voffB); PG8_STAGE(PG8_SB(0, 1), b2 + hstep, voffB); PG8_STAGE(PG8_SA(0, 0), a2, voffA);
            PG8_WAIT_V(8); PG8_WAIT_L(0); PG8_BAR; PG8_MMA(1, 0, At, B0); PG8_MMA(1, 1, At, B1); PG8_BAR; PG8_SCHED;
            PG8_LDB(B0, 1, 0); PG8_LDB(B1, 1, 1); PG8_SCHED; PG8_LDA(At, 1, 0); PG8_STAGE(PG8_SA(0, 1), a2 + hstep, voffA);
            PG8_WAIT_V(8); PG8_WAIT_L(0); PG8_BAR; PG8_MMA(0, 0, At, B0); PG8_MMA(0, 1, At, B1); PG8_BAR; PG8_SCHED;
            PG8_LDA(At, 1, 1); PG8_STAGE(PG8_SB(1, 0), b3, voffB); PG8_STAGE(PG8_SB(1, 1), b3 + hstep, voffB); PG8_STAGE(PG8_SA(1, 0), a3, voffA);
            PG8_WAIT_V(8); PG8_WAIT_L(0); PG8_BAR; PG8_MMA(1, 0, At, B0); PG8_MMA(1, 1, At, B1); PG8_BAR; PG8_SCHED;
            } else {
            PG8_LDB(B0, 0, 0); PG8_SCHED; PG8_LDA(At, 0, 0); PG8_STAGE(PG8_SA(1, 1), a1 + hstep, voffA);
            PG8_WAIT_L(8); PG8_BAR; PG8_WAIT_L(0); PG8_MMA(0, 0, At, B0); PG8_BAR; PG8_SCHED;
            PG8_LDB(B1, 0, 1); PG8_STAGE(PG8_SB(0, 0), b2, voffB);
            PG8_BAR; PG8_WAIT_L(0); PG8_MMA(0, 1, At, B1); PG8_BAR;
            PG8_LDA(At, 0, 1); PG8_STAGE(PG8_SA(0, 0), a2, voffA);
            PG8_BAR; PG8_WAIT_L(0); PG8_MMA(1, 0, At, B0); PG8_BAR; PG8_SCHED;
            PG8_STAGE(PG8_SB(0, 1), b2 + hstep, voffB);
            PG8_WAIT_V(6); PG8_BAR; PG8_MMA(1, 1, At, B1); PG8_BAR;
            PG8_LDB(B0, 1, 0); PG8_SCHED; PG8_LDA(At, 1, 0); PG8_STAGE(PG8_SA(0, 1), a2 + hstep, voffA);
            PG8_WAIT_L(8); PG8_BAR; PG8_WAIT_L(0); PG8_MMA(0, 0, At, B0); PG8_BAR; PG8_SCHED;
            PG8_LDB(B1, 1, 1); PG8_STAGE(PG8_SB(1, 0), b3, voffB);
            PG8_BAR; PG8_WAIT_L(0); PG8_MMA(0, 1, At, B1); PG8_BAR;
            PG8_LDA(At, 1, 1); PG8_STAGE(PG8_SA(1, 0), a3, voffA);
            PG8_BAR; PG8_WAIT_L(0); PG8_MMA(1, 0, At, B0); PG8_BAR; PG8_SCHED;
            PG8_STAGE(PG8_SB(1, 1), b3 + hstep, voffB);
            PG8_WAIT_V(6); PG8_BAR; PG8_MMA(1, 1, At, B1); PG8_BAR;
            }
        }
        if constexpr (ALIGN_EPI) { if (wr == 0) PG8_BAR; }
        if constexpr (!Epi::AFTER_DRAIN) { E(acc, cur, wr, wc, fr, fq); S.done(cur); }
        if (!has_next) break;
#pragma unroll
        for (int a = 0; a < 2; ++a)
#pragma unroll
            for (int b = 0; b < 2; ++b)
#pragma unroll
                for (int m = 0; m < 4; ++m)
#pragma unroll
                    for (int n = 0; n < 2; ++n) acc[a][b][m][n] = (f32x4){0.f, 0.f, 0.f, 0.f};
        cur = nxt; cA = nA; cB = nB; ++ui;
        if constexpr (ALIGN_EPI) { if (wr == 1) PG8_BAR; }
    }
    PG8_WAIT_V(0);
    if constexpr (!ALIGN_EPI) { if (wr == 0) PG8_BAR; }
    PG8_BAR;
    if constexpr (Epi::AFTER_DRAIN) { E.fused(acc, cur, wr, wc, fr, fq, lds, wid, lane); S.done(cur); }
#undef PG8_SA
#undef PG8_SB
#undef PG8_STAGE
#undef PG8_LDA
#undef PG8_LDB
#undef PG8_MMA
#undef PG8_WAIT_V
#undef PG8_WAIT_L
#undef PG8_BAR
#undef PG8_SCHED
}
}

#ifndef PG8_SP2
#define PG8_SP2 true
#endif

#define LAS __attribute__((address_space(3)))
typedef unsigned short bf16;
typedef short bf16x8 __attribute__((ext_vector_type(8)));
typedef float f32x4 __attribute__((ext_vector_type(4)));
typedef float f32x16 __attribute__((ext_vector_type(16)));
typedef unsigned u32x4 __attribute__((ext_vector_type(4)));
typedef unsigned u32x2 __attribute__((ext_vector_type(2)));

constexpr int DM = 1024, NMAIN = 32768, ROWS = 33024, METAROW = 32768, DFF = 4096;
constexpr int NTHREADS = 512;
constexpr int LDS_BYTES = 147456;
constexpr int LDS_ITEM_OFF = LDS_BYTES - 16;
constexpr size_t MiB = 1u << 20;
constexpr size_t WS_CTL = 0, WS_WIN = 1 * MiB, WS_WUPA = 12 * MiB, WS_WUPB = 13 * MiB, WS_WOUT = 14 * MiB, WS_WFF1 = 16 * MiB, WS_WFF2 = 24 * MiB;
constexpr size_t WS_LORA = 32 * MiB, WS_XNMETA = 32 * MiB + 512 * 1024, WS_CB = 33 * MiB, WS_ACT = 36 * MiB;
constexpr size_t ACT_SZ = (size_t)ROWS * 512 * 2, L_SZ = (size_t)ROWS * 256 * 2;
constexpr size_t WS_R = WS_ACT, WS_KA = WS_R + ACT_SZ, WS_VA = WS_KA + ACT_SZ, WS_L = WS_VA + ACT_SZ, WS_Q = WS_L + L_SZ, WS_KB = WS_Q + ACT_SZ, WS_VT = WS_KB + ACT_SZ, WS_END = WS_VT + ACT_SZ;
constexpr size_t WS_GA = WS_KA, WS_GB = WS_KB, WS_MN = WS_ACT, WS_HID = WS_ACT + 64 * MiB;
constexpr size_t WS_SS = 65536;
constexpr size_t WS_HALO = WS_END;
constexpr int HALO_ROW = 3584;
static_assert(WS_HALO + (size_t)(NMAIN / 64) * 2 * HALO_ROW <= 256 * MiB, "halo buffer");
static_assert(WS_END <= 256 * MiB && WS_HID + 128 * MiB <= 256 * MiB && WS_CB + (size_t)2 * ROWS * 8 * 4 <= WS_ACT, "ws map");
constexpr float LOG2E = 1.4426950408889634f;
constexpr float QSCALE = 0.125f * LOG2E;

struct Params { const float* in[29]; float* out; unsigned char* ws; };
typedef const __attribute__((address_space(4))) Params* KP;
enum { I_XP = 0, I_XS, I_META, I_GMIX, I_WIN, I_MUP, I_MUN, I_W0, I_WUP, I_A0, I_AUP, I_GUP, I_KK, I_KA, I_RK, I_LNW, I_LNB, I_LQ1, I_LK1, I_LQ2, I_LK2, I_SUBG, I_UPA, I_UPB, I_WOUT, I_GFFN, I_FF1, I_FF2, I_GFIN };

typedef float cvt_f32x2 __attribute__((ext_vector_type(2))); typedef __bf16 cvt_bf16x2 __attribute__((ext_vector_type(2)));
__device__ __forceinline__ unsigned cvtpk(float lo, float hi) { const cvt_f32x2 v = {lo, hi}; const cvt_bf16x2 b = __builtin_convertvector(v, cvt_bf16x2); return __builtin_bit_cast(unsigned, b); }
__device__ __forceinline__ float bf2f(unsigned short b) { return __uint_as_float(((unsigned)b) << 16); }
__device__ __forceinline__ float bflo(unsigned w) { return __uint_as_float(w << 16); }
__device__ __forceinline__ float bfhi(unsigned w) { return __uint_as_float(w & 0xffff0000u); }
__device__ __forceinline__ void unpack8(const u32x4 v, float* o) { o[0] = bflo(v.x); o[1] = bfhi(v.x); o[2] = bflo(v.y); o[3] = bfhi(v.y); o[4] = bflo(v.z); o[5] = bfhi(v.z); o[6] = bflo(v.w); o[7] = bfhi(v.w); }
__device__ __forceinline__ float wave_sum(float v) {
#pragma unroll
    for (int o = 1; o < 64; o <<= 1) v += __shfl_xor(v, o);
    return v;
}
__device__ __forceinline__ float sigmoidf_(float x) { return __builtin_amdgcn_rcpf(1.0f + __builtin_amdgcn_exp2f(-LOG2E * x)); }
__device__ __forceinline__ int seq_base(int s) { return s == 0 ? 0 : 16384 + (s - 1) * 2048; }
__device__ __forceinline__ int seq_len(int s) { return s == 0 ? 16384 : 2048; }
__device__ __forceinline__ int pos_row(int base, int p) { return p < 16 ? METAROW + p : base + p - 16; }

template <class Op> struct Epi8 {
    static constexpr bool PERM = true, AFTER_DRAIN = false;
    Op op;
    __device__ __forceinline__ void operator()(const pg8::f32x4 (&acc)[2][2][4][2], const pg8::Unit& u, int wr, int wc, int fr, int fq) const {
        const int row0 = u.pm * 256 + wr * 64 + fr, col0 = u.pn * 256 + wc * 32 + 8 * fq;
#pragma unroll
        for (int ai = 0; ai < 2; ++ai)
#pragma unroll
            for (int m = 0; m < 4; ++m)
#pragma unroll
                for (int bj = 0; bj < 2; ++bj) { op.apply(row0 + ai * 128 + m * 16, col0 + bj * 128, u.pn, acc[ai][bj][m][0], acc[ai][bj][m][1]); asm volatile("" ::: "memory"); }
    }
};
__device__ __forceinline__ u32x4 pack8(const f32x4 a, const f32x4 b) { u32x4 w; w.x = cvtpk(a[0], a[1]); w.y = cvtpk(a[2], a[3]); w.z = cvtpk(b[0], b[1]); w.w = cvtpk(b[2], b[3]); return w; }

constexpr int CW_KN = 320;
__device__ __forceinline__ float dpp_max16(float v) {
    int x = __float_as_int(v);
    v = fmaxf(v, __int_as_float(__builtin_amdgcn_update_dpp(0, x, 0xB1, 0xf, 0xf, true))); x = __float_as_int(v);
    v = fmaxf(v, __int_as_float(__builtin_amdgcn_update_dpp(0, x, 0x4E, 0xf, 0xf, true))); x = __float_as_int(v);
    v = fmaxf(v, __int_as_float(__builtin_amdgcn_update_dpp(0, x, 0x141, 0xf, 0xf, true))); x = __float_as_int(v);
    v = fmaxf(v, __int_as_float(__builtin_amdgcn_update_dpp(0, x, 0x140, 0xf, 0xf, true)));
    return v;
}
struct OpProj {
    unsigned char* ws;
    __device__ __forceinline__ void apply(int row, int col, int pn, f32x4 v0, f32x4 v1) const {
        if (pn >= 11) {
            bf16* VT = (bf16*)(ws + WS_VT); const int c = col - 11 * 256;
#pragma unroll
            for (int e = 0; e < 4; ++e) { bf16* vt = VT + ((size_t)(row >> 6) * 512 + c) * 64 + (row & 63);
                vt[e * 64] = (bf16)(cvtpk(v0[e], 0.f) & 0xffffu); vt[(4 + e) * 64] = (bf16)(cvtpk(v1[e], 0.f) & 0xffffu); }
            return;
        }
        bf16* O; int ldc = 512, c;
        if (pn < 2) { O = (bf16*)(ws + WS_R); c = col; }
        else if (pn < 4) { O = (bf16*)(ws + WS_KA); c = col - 512; }
        else if (pn < 6) { O = (bf16*)(ws + WS_VA); c = col - 1024; }
        else if (pn < 7) { O = (bf16*)(ws + WS_L); c = col - 1536; ldc = 256; }
        else if (pn < 9) { O = (bf16*)(ws + WS_Q); c = col - 1792; v0 = v0 * QSCALE; v1 = v1 * QSCALE; }
        else { O = (bf16*)(ws + WS_KB); c = col - 2304; }
        const u32x4 w = pack8(v0, v1);
        *(u32x4*)(O + (size_t)row * ldc + c) = w;
        if (pn >= 9) {
            float k8[8]; unpack8(w, k8); float ss = 0.f;
#pragma unroll
            for (int e = 0; e < 8; ++e) ss = fmaf(k8[e], k8[e], ss);
            ss = dpp_max16(ss);
            if ((threadIdx.x & 15) == 0) { const int sidx = row < 16384 ? 0 : row < NMAIN ? 1 + ((row - 16384) >> 11) : 9;
                atomicMax((unsigned*)(ws + WS_CTL) + CW_KN + sidx * 64 + (c >> 3), __float_as_uint(ss)); }
        }
    }
};
struct OpGate {
    bf16* O;
    __device__ __forceinline__ void apply(int row, int col, int pn, f32x4 v0, f32x4 v1) const {
        const int c = col;
#pragma unroll
        for (int e = 0; e < 4; ++e) { v0[e] = sigmoidf_(v0[e]); v1[e] = sigmoidf_(v1[e]); }
        *(u32x4*)(O + (size_t)row * 1024 + c) = pack8(v0, v1);
    }
};
struct OpUpA {
    unsigned char* ws;
    __device__ __forceinline__ void apply(int row, int col, int pn, f32x4 v0, f32x4 v1) const {
        u32x4* p = (u32x4*)((bf16*)(ws + WS_GA) + (size_t)row * 1024 + col); float g[8]; unpack8(*p, g);
#pragma unroll
        for (int e = 0; e < 4; ++e) { v0[e] *= g[e]; v1[e] *= g[4 + e]; }
        *p = pack8(v0, v1);
    }
};
struct OpUpB {
    unsigned char* ws;
    __device__ __forceinline__ void apply(int row, int col, int pn, f32x4 v0, f32x4 v1) const {
        u32x4* p = (u32x4*)((bf16*)(ws + WS_GB) + (size_t)row * 1024 + col); float g[8], a[8]; unpack8(*p, g);
        unpack8(*(const u32x4*)((const bf16*)(ws + WS_GA) + (size_t)row * 1024 + col), a);
#pragma unroll
        for (int e = 0; e < 4; ++e) { v0[e] = a[e] + v0[e] * g[e]; v1[e] = a[4 + e] + v1[e] * g[4 + e]; }
        *p = pack8(v0, v1);
    }
};
struct OpOut {
    const float* xp; const float* xs; float* out; const float* gf; bf16* mn; float* ss;
    __device__ __forceinline__ void apply(int row, int col, int pn, f32x4 v0, f32x4 v1) const {
        const float* x = (row < 16384 ? xp + (size_t)row * DM : xs + (size_t)(row - 16384) * DM) + col;
        float* o = out + (size_t)row * DM + col;
        const f32x4 h0 = *(const f32x4*)x + v0, h1 = *(const f32x4*)(x + 4) + v1;
        *(f32x4*)o = h0; *(f32x4*)(o + 4) = h1;
        const f32x4 g0 = *(const f32x4*)(gf + col), g1 = *(const f32x4*)(gf + col + 4);
        *(u32x4*)(mn + (size_t)row * DM + col) = pack8(h0 * g0, h1 * g1);
        float q = (h0[0] * h0[0] + h0[1] * h0[1]) + (h0[2] * h0[2] + h0[3] * h0[3]) + (h1[0] * h1[0] + h1[1] * h1[1]) + (h1[2] * h1[2] + h1[3] * h1[3]);
        { const auto r = __builtin_amdgcn_permlane16_swap(__float_as_uint(q), __float_as_uint(q), false, false); q = __uint_as_float(r[0]) + __uint_as_float(r[1]); }
        { const auto r = __builtin_amdgcn_permlane32_swap(__float_as_uint(q), __float_as_uint(q), false, false); q = __uint_as_float(r[0]) + __uint_as_float(r[1]); }
        if ((threadIdx.x & 63) < 16) atomicAdd(ss + row, q);
    }
};
struct OpFF1 {
    bf16* hid; const float* ss;
    __device__ __forceinline__ void apply(int row, int col, int pn, f32x4 v0, f32x4 v1) const {
        const float rs2 = __builtin_amdgcn_rcpf(ss[row] * (1.0f / DM) + 1e-6f);
#pragma unroll
        for (int e = 0; e < 4; ++e) { const float a = fmaxf(v0[e], 0.f), b = fmaxf(v1[e], 0.f); v0[e] = a * a * rs2; v1[e] = b * b * rs2; }
        *(u32x4*)(hid + (size_t)row * DFF + col) = pack8(v0, v1);
    }
};
struct OpFF2 {
    float* out;
    __device__ __forceinline__ void apply(int row, int col, int pn, f32x4 v0, f32x4 v1) const {
        float* o = out + (size_t)row * DM + col;
        *(f32x4*)o = *(const f32x4*)o + v0; *(f32x4*)(o + 4) = *(const f32x4*)(o + 4) + v1;
    }
};

__device__ __forceinline__ unsigned f2bf_rne(float f) { return cvtpk(f, 0.f) & 0xffffu; }
__device__ __forceinline__ void transpose_item(const float* W, int K, int N, bf16* WT, LAS float* scr, int item, int lane) {
    const int nblk = N / 32, kb = item / nblk, nb = item % nblk, k0 = 64 * kb, n0 = 32 * nb;
#pragma unroll 8
    for (int i = 0; i < 32; ++i) { const int kk = 2 * i + (lane >> 5); scr[kk * 33 + (lane & 31)] = W[(size_t)(k0 + kk) * N + n0 + (lane & 31)]; }
    asm volatile("s_waitcnt vmcnt(0) lgkmcnt(0)" ::: "memory");
    const int c = lane & 7;
#pragma unroll
    for (int j = 0; j < 4; ++j) { const int n = (lane >> 3) + 8 * j; const LAS float* s = scr + (8 * c) * 33 + n;
        u32x4 o; o.x = cvtpk(s[0 * 33], s[1 * 33]); o.y = cvtpk(s[2 * 33], s[3 * 33]); o.z = cvtpk(s[4 * 33], s[5 * 33]); o.w = cvtpk(s[6 * 33], s[7 * 33]);
        *(u32x4*)(WT + (size_t)(n0 + n) * K + k0 + 8 * c) = o; }
    asm volatile("s_waitcnt lgkmcnt(0)" ::: "memory");
}
__device__ __forceinline__ void rms_row_bf16(const float* src, const float* g, bf16* dst, int lane) {
    unsigned long long* o8 = (unsigned long long*)dst + lane;
    if (!src) {
#pragma unroll
        for (int j = 0; j < 4; ++j) o8[64 * j] = 0ull;
        return; }
    const f32x4* xr = (const f32x4*)src + lane; const f32x4* gr = (const f32x4*)g + lane;
    f32x4 v[4]; float s = 0.f;
#pragma unroll
    for (int j = 0; j < 4; ++j) { v[j] = xr[64 * j]; s += (v[j].x * v[j].x + v[j].y * v[j].y) + (v[j].z * v[j].z + v[j].w * v[j].w); }
    const float rstd = rsqrtf(wave_sum(s) * (1.f / DM) + 1e-6f);
#pragma unroll
    for (int j = 0; j < 4; ++j) { const f32x4 gg = gr[64 * j]; const f32x4 y = v[j] * rstd * gg;
        o8[64 * j] = (unsigned long long)cvtpk(y.x, y.y) | ((unsigned long long)cvtpk(y.z, y.w) << 32); }
}
__device__ __forceinline__ void phase_prologue(LAS unsigned char* lds, KP P) {
    const int tid = fresh_tid(), lane = tid & 63, wid = tid >> 6;
    LAS float* scr = (LAS float*)(lds + wid * 16384);
    const int gw = blockIdx.x * 8 + wid, NGW = gridDim.x * 8;
    unsigned char* ws = P->ws;
    constexpr int I_IN = (1024 / 64) * (5376 / 32), I_UP = (512 / 64) * (1024 / 32), I_O = (1024 / 64) * (1024 / 32), I_1 = (1024 / 64) * (4096 / 32), I_2 = (4096 / 64) * (1024 / 32);
    constexpr int I_LW = (64 / 64) * (512 / 32), I_G = (128 / 64) * (512 / 32);
    constexpr int NITEMS = I_IN + 2 * I_UP + I_O + I_1 + I_2 + 4 * I_LW + I_G;
    for (int it = gw; it < NITEMS; it += NGW) {
        int r = it;
        if (r < I_IN) { transpose_item(P->in[I_WIN], 1024, 5376, (bf16*)(ws + WS_WIN), scr, r, lane); continue; } r -= I_IN;
        if (r < I_UP) { transpose_item(P->in[I_UPA], 512, 1024, (bf16*)(ws + WS_WUPA), scr, r, lane); continue; } r -= I_UP;
        if (r < I_UP) { transpose_item(P->in[I_UPB], 512, 1024, (bf16*)(ws + WS_WUPB), scr, r, lane); continue; } r -= I_UP;
        if (r < I_O) { transpose_item(P->in[I_WOUT], 1024, 1024, (bf16*)(ws + WS_WOUT), scr, r, lane); continue; } r -= I_O;
        if (r < I_1) { transpose_item(P->in[I_FF1], 1024, 4096, (bf16*)(ws + WS_WFF1), scr, r, lane); continue; } r -= I_1;
        if (r < I_2) { transpose_item(P->in[I_FF2], 4096, 1024, (bf16*)(ws + WS_WFF2), scr, r, lane); continue; } r -= I_2;
        if (r < 2 * I_LW) { const int d = r / I_LW; transpose_item(P->in[I_WUP] + (size_t)d * 64 * 512, 64, 512, (bf16*)(ws + WS_LORA) + (size_t)d * 512 * 64, scr, r % I_LW, lane); continue; } r -= 2 * I_LW;
        if (r < 2 * I_LW) { const int d = r / I_LW; transpose_item(P->in[I_AUP] + (size_t)d * 64 * 512, 64, 512, (bf16*)(ws + WS_LORA + 131072) + (size_t)d * 512 * 64, scr, r % I_LW, lane); continue; } r -= 2 * I_LW;
        transpose_item(P->in[I_GUP], 128, 512, (bf16*)(ws + WS_LORA + 262144), scr, r, lane);
    }
    bf16* XN = (bf16*)P->out; bf16* XM = (bf16*)(ws + WS_XNMETA);
    for (int m = gw; m < ROWS; m += NGW) {
        const float* src = m < 16384 ? P->in[I_XP] + (size_t)m * DM : m < NMAIN ? P->in[I_XS] + (size_t)(m - 16384) * DM : (m - NMAIN < 16 ? P->in[I_META] + (size_t)(m - NMAIN) * DM : nullptr);
        bf16* dst = m < NMAIN ? XN + (size_t)m * DM : XM + (size_t)(m - NMAIN) * DM;
        rms_row_bf16(src, P->in[I_GMIX], dst, lane);
    }
}

constexpr int AT_KSTR = 272, AT_VSTR = 144, AT_KSZ = 64 * AT_KSTR, AT_BUF = AT_KSZ + 128 * AT_VSTR;
__device__ __forceinline__ f32x16 mfma32(bf16x8 a, bf16x8 b, f32x16 c) { return __builtin_amdgcn_mfma_f32_32x32x16_bf16(a, b, c, 0, 0, 0); }
__device__ __forceinline__ void attn_unit(LAS unsigned char* lds, KP P, int s, int h, int qb, float lam) {
    int tid_ = threadIdx.x; asm volatile("" : "+v"(tid_));
    const int tid = tid_, lane = tid & 63, r32 = lane & 31, hi = lane >> 5, wid = __builtin_amdgcn_readfirstlane(tid >> 6), rg = wid & 3, mp = wid >> 2;
    const int L = seq_len(s), base = seq_base(s), NT = 1 + L / 64;
    unsigned char* ws = P->ws;
    const bf16* KB = (const bf16*)(ws + WS_KB); const bf16* VT = (const bf16*)(ws + WS_VT); bf16* Q = (bf16*)(ws + WS_Q);
    const int qrow = base + qb * 128 + rg * 32 + r32;
    bf16x8 q[4];
#pragma unroll
    for (int d0 = 0; d0 < 4; ++d0) q[d0] = *(const bf16x8*)(Q + (size_t)qrow * 512 + h * 128 + mp * 64 + d0 * 16 + hi * 8);
    f32x16 O[4];
#pragma unroll
    for (int b = 0; b < 4; ++b)
#pragma unroll
        for (int r = 0; r < 16; ++r) O[b][r] = 0.f;
    float mx = -INFINITY, ls = 0.f;
    const float qh = (float)(16 + qb * 128 + rg * 32 + r32 - 4 * hi);
    const float nslope = -exp2f(-2.0f * (float)(h + 1)) * LOG2E;
    const int kr0 = tid >> 4, kc = tid & 15, vn0 = tid >> 3, vc = tid & 7;
    u32x4 kreg[2], vreg[2];
    const unsigned kgo = (unsigned)((kr0 * 512 + h * 128 + kc * 8) * 2), vgo = (unsigned)(((h * 128 + vn0) * 64 + vc * 8) * 2);
    const unsigned klo = (unsigned)(kr0 * AT_KSTR + kc * 16), vlo = (unsigned)(AT_KSZ + vn0 * AT_VSTR + vc * 16);
#define AT_GLOAD(j) do { const int m0_ = (j) == 0 ? METAROW : base + 64 * ((j) - 1); \
        const unsigned char* kt_ = (const unsigned char*)KB + (size_t)m0_ * 1024; const unsigned char* vt_ = (const unsigned char*)VT + (size_t)(m0_ >> 6) * (512 * 64 * 2); \
        kreg[0] = *(const u32x4*)(kt_ + kgo); kreg[1] = *(const u32x4*)(kt_ + 32 * 1024 + kgo); \
        vreg[0] = *(const u32x4*)(vt_ + vgo); vreg[1] = *(const u32x4*)(vt_ + 64 * 64 * 2 + vgo); } while (0)
#define AT_LSTORE(buf) do { LAS unsigned char* kb_ = lds + (buf) * AT_BUF; \
        *(LAS u32x4*)(kb_ + klo) = kreg[0]; *(LAS u32x4*)(kb_ + klo + 32 * AT_KSTR) = kreg[1]; \
        *(LAS u32x4*)(kb_ + vlo) = vreg[0]; *(LAS u32x4*)(kb_ + vlo + 64 * AT_VSTR) = vreg[1]; } while (0)
    float qn, kn;
    { float ssq = 0.f;
#pragma unroll
      for (int d0 = 0; d0 < 4; ++d0) { float t[8]; unpack8(__builtin_bit_cast(u32x4, q[d0]), t);
#pragma unroll
        for (int e = 0; e < 8; ++e) ssq = fmaf(t[e], t[e], ssq); }
      ssq += __shfl_xor(ssq, 32); qn = sqrtf(ssq) * 1.002f;
      const unsigned* KN = (const unsigned*)(ws + WS_CTL) + CW_KN; float ks = 0.f;
#pragma unroll
      for (int g = 0; g < 8; ++g) ks += fmaxf(__uint_as_float(__hip_atomic_load(KN + s * 64 + h * 16 + mp * 8 + g, __ATOMIC_RELAXED, __HIP_MEMORY_SCOPE_AGENT)), __uint_as_float(__hip_atomic_load(KN + 9 * 64 + h * 16 + mp * 8 + g, __ATOMIC_RELAXED, __HIP_MEMORY_SCOPE_AGENT)));
      kn = sqrtf(ks) * 1.002f; }
    const int jc0 = 1 + qb * 2;
    int jlo = jc0, jhi = jc0 + 1;
    LAS float* red = (LAS float*)(lds + 2 * AT_BUF);
#pragma unroll 1
    for (int ph = 0; ph < 2; ++ph) {
        int nleft, ntl;
        if (ph == 0) { nleft = 0; ntl = 2; }
        else {
            float dneed = (qn * kn - mx + 40.0f) / (-nslope);
#pragma unroll
            for (int o = 1; o < 64; o <<= 1) dneed = fmaxf(dneed, __shfl_xor(dneed, o));
            if (lane == 0) red[wid] = dneed;
            __syncthreads();
            float dm = red[0];
#pragma unroll
            for (int w8 = 1; w8 < 8; ++w8) dm = fmaxf(dm, red[w8]);
            dm = fminf(fmaxf(dm, 0.f), 1.0e6f);
            const int dmax = (int)dm + 1, q0 = 16 + qb * 128;
            const int plo = q0 - dmax, phi = q0 + 127 + dmax;
            jlo = plo < 16 ? 0 : 1 + ((plo - 16) >> 6); jhi = phi >= L + 16 ? NT - 1 : 1 + ((phi - 16) >> 6);
            if (jlo > jc0) jlo = jc0; if (jhi < jc0 + 1) jhi = jc0 + 1;
            nleft = jc0 - jlo; ntl = nleft + (jhi - jc0 - 1);
        }
        if (ntl > 0) {
#define AT_J(t) (ph == 0 ? jc0 + (t) : ((t) < nleft ? jlo + (t) : jc0 + 2 + ((t) - nleft)))
        { const int jf = AT_J(0); AT_GLOAD(jf); } AT_LSTORE(0); __syncthreads();
#pragma unroll 1
        for (int t = 0; t < ntl; ++t) {
            const int j = AT_J(t);
            if (t + 1 < ntl) { const int jn = AT_J(t + 1); AT_GLOAD(jn); }
            const LAS unsigned char* Kb = lds + (t & 1) * AT_BUF + mp * 128; const LAS unsigned char* Vb = lds + (t & 1) * AT_BUF + AT_KSZ;
            const float dq = qh - (float)(j == 0 ? 0 : 64 * j - 48);
            f32x16 p0, p1;
#pragma unroll
            for (int r = 0; r < 16; ++r) { p0[r] = 0.f; p1[r] = 0.f; }
            {
                bf16x8 ka[4], kb[4];
#pragma unroll
                for (int d0 = 0; d0 < 4; ++d0) { ka[d0] = *(const LAS bf16x8*)(Kb + r32 * AT_KSTR + d0 * 32 + hi * 16); kb[d0] = *(const LAS bf16x8*)(Kb + (32 + r32) * AT_KSTR + d0 * 32 + hi * 16); }
                __builtin_amdgcn_sched_barrier(0);
#pragma unroll
                for (int d0 = 0; d0 < 4; ++d0) { p0 = mfma32(ka[d0], q[d0], p0); p1 = mfma32(kb[d0], q[d0], p1); }
            }
#pragma unroll
            for (int r = 0; r < 16; ++r) { const float dd = dq - (float)((r & 3) + 8 * (r >> 2)); p0[r] = fmaf(fabsf(dd), nslope, p0[r]); p1[r] = fmaf(fabsf(dd - 32.f), nslope, p1[r]); }
            if (j == 0) {
#pragma unroll
                for (int r = 0; r < 16; ++r) { if ((r & 3) + 8 * (r >> 2) + 4 * hi >= 16) p0[r] = -INFINITY; p1[r] = -INFINITY; }
            }
            float rm = fmaxf(p0[0], p1[0]);
#pragma unroll
            for (int r = 1; r < 16; ++r) rm = fmaxf(rm, fmaxf(p0[r], p1[r]));
            rm = fmaxf(rm, __shfl_xor(rm, 32));
            if (__any(rm > mx - 38.0f)) {
            const float mn = fmaxf(mx, rm);
            if (__any(mn > mx)) {
                const float f = __builtin_amdgcn_exp2f(mx - mn); ls *= f; mx = mn;
#pragma unroll
                for (int b = 0; b < 4; ++b)
#pragma unroll
                    for (int r = 0; r < 16; ++r) O[b][r] *= f;
            }
            float sum = 0.f;
#pragma unroll
            for (int r = 0; r < 16; ++r) { p0[r] = __builtin_amdgcn_exp2f(p0[r] - mx); p1[r] = __builtin_amdgcn_exp2f(p1[r] - mx); sum += p0[r] + p1[r]; }
            ls += sum;
            bf16x8 pf[4];
#pragma unroll
            for (int k2 = 0; k2 < 2; ++k2) {
                u32x4 w0, w1;
                w0.x = cvtpk(p0[8 * k2 + 0], p0[8 * k2 + 1]); w0.y = cvtpk(p0[8 * k2 + 2], p0[8 * k2 + 3]); w0.z = cvtpk(p0[8 * k2 + 4], p0[8 * k2 + 5]); w0.w = cvtpk(p0[8 * k2 + 6], p0[8 * k2 + 7]);
                w1.x = cvtpk(p1[8 * k2 + 0], p1[8 * k2 + 1]); w1.y = cvtpk(p1[8 * k2 + 2], p1[8 * k2 + 3]); w1.z = cvtpk(p1[8 * k2 + 4], p1[8 * k2 + 5]); w1.w = cvtpk(p1[8 * k2 + 6], p1[8 * k2 + 7]);
                pf[k2] = __builtin_bit_cast(bf16x8, w0); pf[2 + k2] = __builtin_bit_cast(bf16x8, w1);
            }
            {
                u32x4 vcur[4], vnxt[4];
#define AT_VLOAD(dst, ks_) do { _Pragma("unroll") for (int b_ = 0; b_ < 4; ++b_) { const LAS unsigned char* vp_ = Vb + (b_ * 32 + r32) * AT_VSTR + (ks_) * 32 + hi * 8; \
                    const u32x2 lo_ = *(const LAS u32x2*)vp_, hh_ = *(const LAS u32x2*)(vp_ + 16); dst[b_].x = lo_.x; dst[b_].y = lo_.y; dst[b_].z = hh_.x; dst[b_].w = hh_.y; } } while (0)
                AT_VLOAD(vcur, 0);
#pragma unroll
                for (int ks = 0; ks < 4; ++ks) {
                    if (ks < 3) AT_VLOAD(vnxt, ks + 1);
                    __builtin_amdgcn_sched_barrier(0);
#pragma unroll
                    for (int b = 0; b < 4; ++b) O[b] = mfma32(__builtin_bit_cast(bf16x8, vcur[b]), pf[ks], O[b]);
                    __builtin_amdgcn_sched_barrier(0);
#pragma unroll
                    for (int b = 0; b < 4; ++b) vcur[b] = vnxt[b];
                }
#undef AT_VLOAD
            }
            }
            if (t + 1 < ntl) AT_LSTORE((t + 1) & 1);
            __syncthreads();
        }
#undef AT_J
        }
    }
#undef AT_GLOAD
#undef AT_LSTORE
    const float lt = ls + __shfl_xor(ls, 32);
    const float inv = (mp ? lam : 1.0f) / lt;
    int lane2 = lane; asm volatile("" : "+v"(lane2));
    const int r32e = lane2 & 31, hie = lane2 >> 5;
    LAS float* ex = (LAS float*)lds + rg * (128 * 32) + hie * 128 + r32e;
    if (mp == 1) {
#pragma unroll
        for (int b = 0; b < 4; ++b)
#pragma unroll
            for (int r = 0; r < 16; ++r) ex[(32 * b + (r & 3) + 8 * (r >> 2)) * 32] = O[b][r] * inv;
    }
    __syncthreads();
    if (mp == 0) {
        float ss = 0.f;
#pragma unroll
        for (int b = 0; b < 4; ++b)
#pragma unroll
            for (int r = 0; r < 16; ++r) { const float o = O[b][r] * inv - ex[(32 * b + (r & 3) + 8 * (r >> 2)) * 32]; O[b][r] = o; ss += o * o; }
        ss += __shfl_xor(ss, 32);
        const float rstd = rsqrtf(ss * (1.0f / 128.0f) + 1e-5f) * 0.8f;
        const float* sg = P->in[I_SUBG] + 4 * hie; bf16* Qo = Q + (size_t)(base + qb * 128 + rg * 32 + r32e) * 512 + h * 128 + 4 * hie;
#pragma unroll
        for (int b = 0; b < 4; ++b)
#pragma unroll
            for (int r4 = 0; r4 < 4; ++r4) {
                const int n = 32 * b + 8 * r4; const f32x4 g = *(const f32x4*)(sg + n);
                u32x2 w; w.x = cvtpk(O[b][4 * r4 + 0] * rstd * g.x, O[b][4 * r4 + 1] * rstd * g.y); w.y = cvtpk(O[b][4 * r4 + 2] * rstd * g.z, O[b][4 * r4 + 3] * rstd * g.w);
                *(u32x2*)(Qo + n) = w;
            }
    }
    __syncthreads();
}

constexpr int SC_R = 0, SC_K = 16384, SC_V = 32768, SC_W = 49152, SC_B = 65536, SC_KK = 81920, SC_Y = 98304, SC_TW = 114688, SC_AD = 123904, SC_MU = 133120;
__device__ __forceinline__ float dpp_add(float v, int ctrl_id) {
    const int x = __float_as_int(v); int y;
    if (ctrl_id == 0) y = __builtin_amdgcn_update_dpp(0, x, 0xB1, 0xf, 0xf, true);
    else if (ctrl_id == 1) y = __builtin_amdgcn_update_dpp(0, x, 0x4E, 0xf, 0xf, true);
    else if (ctrl_id == 2) y = __builtin_amdgcn_update_dpp(0, x, 0x141, 0xf, 0xf, true);
    else y = __builtin_amdgcn_update_dpp(0, x, 0x140, 0xf, 0xf, true);
    return v + __int_as_float(y);
}
template <int LPR> __device__ __forceinline__ float grp_sum(float v) {
    v = dpp_add(v, 0); v = dpp_add(v, 1); v = dpp_add(v, 2);
    if (LPR == 16) v = dpp_add(v, 3);
    return v;
}
#define BAR_LDS() asm volatile("s_waitcnt lgkmcnt(0)\n\ts_barrier" ::: "memory")
__device__ __forceinline__ float fast_sigmoid(float x) { return __builtin_amdgcn_rcpf(1.0f + __builtin_amdgcn_exp2f(-LOG2E * x)); }
__device__ __forceinline__ float fast_tanh(float x) { return 1.0f - 2.0f * __builtin_amdgcn_rcpf(1.0f + __builtin_amdgcn_exp2f(2.0f * LOG2E * x)); }
template <int NRP, int NSW>
__device__ __forceinline__ void scan_unit(LAS unsigned char* lds, KP P, int s, int d, int h, int rp) {
    constexpr int RPB = 64 / NRP, RPW = RPB / NSW, LPR = 64 / RPW, CPL = 64 / LPR;
    static_assert(LPR == 8 || LPR == 16, "scan geometry");
    constexpr bool YDB = (RPB == 16) && (NSW == 4);
    constexpr int YST = YDB ? RPB : 64;
    int tid_ = threadIdx.x; asm volatile("" : "+v"(tid_));
    const int tid = tid_, lane = tid & 63, wid = __builtin_amdgcn_readfirstlane(tid >> 6);
    const int L = seq_len(s), base = seq_base(s), Ltot = L + 16, nchunk = (Ltot + 63) / 64;
    unsigned char* ws = P->ws;
    const bf16* Rb = (const bf16*)(ws + WS_R); const bf16* KAb = (const bf16*)(ws + WS_KA); const bf16* VAb = (const bf16*)(ws + WS_VA); const bf16* Lb = (const bf16*)(ws + WS_L);
    float* CB = (float*)(ws + WS_CB); bf16* YD = (bf16*)((unsigned char*)P->out + 64 * MiB) + (size_t)d * NMAIN * 512;
    LAS float* fS = (LAS float*)lds; LAS float* fV = (LAS float*)(lds + 81920); LAS float* fY = (LAS float*)(lds + SC_Y); LAS float* fMU = (LAS float*)(lds + SC_MU);
#define SCI(sl_, a_, c_) ((sl_) * 320 + (a_) * 64 + (c_))
    for (int i = tid; i < 832; i += NTHREADS) {
        float v;
        if (i < 640) { const int which = i / 320, jj = i % 320, a = jj >> 6, c = jj & 63; const int gi = a < 3 ? a * 512 + h * 64 + c : 1536 + (a - 3) * 64 + c; v = P->in[which ? I_MUN : I_MUP][gi]; }
        else { const int a = (i - 640) >> 6, c = (i - 640) & 63; v = P->in[a == 0 ? I_KK : a == 1 ? I_KA : I_RK][h * 64 + c]; }
        fMU[i] = v;
    }
    const int mat = wid >> 2, ntile = wid & 3;
    const bf16* Wt = (const bf16*)(ws + WS_LORA + (mat ? 131072 : 0)) + ((size_t)d * 512 + h * 64 + ntile * 16 + (lane & 15)) * 64 + (lane >> 4) * 8;
    const bf16x8 bfr0 = *(const bf16x8*)Wt, bfr1 = *(const bf16x8*)(Wt + 32);
    const float bias = P->in[mat ? I_A0 : I_W0][d * 512 + h * 64 + ntile * 16 + (lane & 15)];
    float S[CPL];
#pragma unroll
    for (int j = 0; j < CPL; ++j) S[j] = 0.f;
    const int rowl = lane / LPR, kg = lane % LPR, srow = rp * RPB + wid * RPW + rowl;
    const int slot = tid >> 3, cg8 = (tid & 7) * 8;
    u32x4 raw[5][3];
#define SC_META(c) (d ? ((c) == nchunk - 1) : ((c) == 0))
    const unsigned char* HALO0 = ws + WS_HALO + (size_t)(base >> 6) * 2 * HALO_ROW;
#define SC_LOAD(c) do { const int i_ = 64 * (c) + slot; const bool ok_ = i_ < Ltot; const int p_ = d ? Ltot - 1 - i_ : i_; \
        const unsigned zr_ = (unsigned)(METAROW + 64); \
        if (!SC_META(c)) { const unsigned rc_ = ok_ ? (unsigned)(base + p_ - 16) : zr_; \
            _Pragma("unroll") for (int a_ = 0; a_ < 5; ++a_) { const unsigned char* B_ = (const unsigned char*)(a_ == 0 ? Rb : a_ == 1 ? KAb : a_ == 2 ? VAb : Lb); const unsigned ld_ = a_ < 3 ? 1024u : 512u; \
                const unsigned co_ = (unsigned)(((a_ < 3 ? h * 64 : (a_ - 3) * 64) + cg8) * 2); raw[a_][1] = *(const u32x4*)(B_ + (rc_ * ld_ + co_)); } \
        } else { const bool me_ = ok_ && p_ < 16; const bool hn_ = me_ && p_ == 15; \
            const unsigned rc_ = ok_ ? (unsigned)pos_row(base, p_) : zr_, rp_ = (me_ && p_ > 0) ? (unsigned)(METAROW + p_ - 1) : zr_, rn_ = (me_ && p_ < 15) ? (unsigned)(METAROW + p_ + 1) : zr_; \
            _Pragma("unroll") for (int a_ = 0; a_ < 5; ++a_) { const unsigned char* B_ = (const unsigned char*)(a_ == 0 ? Rb : a_ == 1 ? KAb : a_ == 2 ? VAb : Lb); const unsigned ld_ = a_ < 3 ? 1024u : 512u; \
                const unsigned co_ = (unsigned)(((a_ < 3 ? h * 64 : (a_ - 3) * 64) + cg8) * 2); \
                const unsigned ho_ = (unsigned)(((a_ < 3 ? a_ * 512 + h * 64 : 1536 + (a_ - 3) * 64) + cg8) * 2); \
                raw[a_][0] = *(const u32x4*)(B_ + (rp_ * ld_ + co_)); raw[a_][1] = *(const u32x4*)(B_ + (rc_ * ld_ + co_)); \
                const unsigned char* np_ = hn_ ? HALO0 + ho_ : B_ + (rn_ * ld_ + co_); raw[a_][2] = *(const u32x4*)np_; } } } while (0)
    SC_LOAD(0);
    BAR_LDS();
    for (int c = 0; c < nchunk; ++c) {
        const int nvalid = (Ltot - 64 * c) < 64 ? (Ltot - 64 * c) : 64;
        float rv[8], kv[8];
        if (!SC_META(c)) {
            float vv8[8]; unpack8(raw[0][1], rv); unpack8(raw[1][1], kv); unpack8(raw[2][1], vv8);
            { LAS float* dst = fS + SCI(slot, 4, cg8); *(LAS f32x4*)dst = (f32x4){rv[0], rv[1], rv[2], rv[3]}; *(LAS f32x4*)(dst + 4) = (f32x4){rv[4], rv[5], rv[6], rv[7]}; }
            { LAS float* dst = fV + slot * 64 + cg8; *(LAS f32x4*)dst = (f32x4){vv8[0], vv8[1], vv8[2], vv8[3]}; *(LAS f32x4*)(dst + 4) = (f32x4){vv8[4], vv8[5], vv8[6], vv8[7]}; }
            *(LAS u32x4*)(lds + SC_TW + slot * 144 + cg8 * 2) = raw[3][1];
            *(LAS u32x4*)(lds + SC_AD + slot * 144 + cg8 * 2) = raw[4][1];
        } else {
            const int i1 = 64 * c + slot; const int p1 = d ? Ltot - 1 - i1 : i1; const bool me1 = i1 < Ltot && p1 < 16; const float fm = me1 ? 1.0f : 0.0f;
#pragma unroll
            for (int a = 0; a < 5; ++a) {
                float pv[8], cv[8], nv[8], o[8]; unpack8(raw[a][0], pv); unpack8(raw[a][1], cv); unpack8(raw[a][2], nv);
                const f32x4 mp0 = *(const LAS f32x4*)(fMU + a * 64 + cg8), mp1 = *(const LAS f32x4*)(fMU + a * 64 + cg8 + 4), mn0 = *(const LAS f32x4*)(fMU + 320 + a * 64 + cg8), mn1 = *(const LAS f32x4*)(fMU + 320 + a * 64 + cg8 + 4);
#pragma unroll
                for (int e = 0; e < 8; ++e) { const float mp = fm * (e < 4 ? mp0[e & 3] : mp1[e & 3]), mn = fm * (e < 4 ? mn0[e & 3] : mn1[e & 3]); o[e] = cv[e] + mp * (pv[e] - cv[e]) + mn * (nv[e] - cv[e]); }
                if (a == 0) {
#pragma unroll
                    for (int e = 0; e < 8; ++e) rv[e] = o[e];
                    LAS float* dst = fS + SCI(slot, 4, cg8); *(LAS f32x4*)dst = (f32x4){o[0], o[1], o[2], o[3]}; *(LAS f32x4*)(dst + 4) = (f32x4){o[4], o[5], o[6], o[7]};
                } else if (a == 1) {
#pragma unroll
                    for (int e = 0; e < 8; ++e) kv[e] = o[e];
                } else if (a == 2) {
                    LAS float* dst = fV + slot * 64 + cg8; *(LAS f32x4*)dst = (f32x4){o[0], o[1], o[2], o[3]}; *(LAS f32x4*)(dst + 4) = (f32x4){o[4], o[5], o[6], o[7]};
                } else {
                    if (a == 3) {
#pragma unroll
                        for (int e = 0; e < 8; ++e) o[e] = me1 ? fast_tanh(o[e]) : o[e];
                    }
                    u32x4 w; w.x = cvtpk(o[0], o[1]); w.y = cvtpk(o[2], o[3]); w.z = cvtpk(o[4], o[5]); w.w = cvtpk(o[6], o[7]);
                    *(LAS u32x4*)(lds + (a == 3 ? SC_TW : SC_AD) + slot * 144 + cg8 * 2) = w;
                }
            }
        }
        BAR_LDS();
        if (c + 1 < nchunk) SC_LOAD(c + 1);
        {
            const LAS unsigned char* Ab = lds + (mat ? SC_AD : SC_TW); LAS float* fWB = fS + (mat ? 128 : 64);
#pragma unroll
            for (int mt = 0; mt < 4; ++mt) {
                const bf16x8 a0 = *(const LAS bf16x8*)(Ab + (mt * 16 + (lane & 15)) * 144 + (lane >> 4) * 16);
                const bf16x8 a1 = *(const LAS bf16x8*)(Ab + (mt * 16 + (lane & 15)) * 144 + 64 + (lane >> 4) * 16);
                f32x4 acc = {0.f, 0.f, 0.f, 0.f};
                acc = __builtin_amdgcn_mfma_f32_16x16x32_bf16(a0, bfr0, acc, 0, 0, 0);
                acc = __builtin_amdgcn_mfma_f32_16x16x32_bf16(a1, bfr1, acc, 0, 0, 0);
#pragma unroll
                for (int rg = 0; rg < 4; ++rg) {
                    const int sl = mt * 16 + (lane >> 4) * 4 + rg, col = ntile * 16 + (lane & 15);
                    const float sg = fast_sigmoid(acc[rg] + bias); const float dc = __builtin_amdgcn_exp2f(-0.6065306597126334f * LOG2E * sg);
                    fWB[sl * 320 + col] = mat ? sg : dc;
                }
            }
        }
        BAR_LDS();
        {
            const f32x4 a0 = *(const LAS f32x4*)(fS + SCI(slot, 2, cg8)), a1 = *(const LAS f32x4*)(fS + SCI(slot, 2, cg8 + 4));
            const f32x4 kk0 = *(const LAS f32x4*)(fMU + 640 + cg8), kk1 = *(const LAS f32x4*)(fMU + 640 + cg8 + 4), ka0 = *(const LAS f32x4*)(fMU + 704 + cg8), ka1 = *(const LAS f32x4*)(fMU + 704 + cg8 + 4);
            const f32x4 rk0 = *(const LAS f32x4*)(fMU + 768 + cg8), rk1 = *(const LAS f32x4*)(fMU + 768 + cg8 + 4);
            float kkv[8], kd[8], av[8]; float ssq = 0.f, cs = 0.f;
#pragma unroll
            for (int e = 0; e < 8; ++e) {
                av[e] = e < 4 ? a0[e & 3] : a1[e & 3];
                kkv[e] = kv[e] * (e < 4 ? kk0[e & 3] : kk1[e & 3]); ssq = fmaf(kkv[e], kkv[e], ssq);
                kd[e] = kv[e] * (1.0f + (av[e] - 1.0f) * (e < 4 ? ka0[e & 3] : ka1[e & 3])); cs = fmaf(rv[e] * kd[e], e < 4 ? rk0[e & 3] : rk1[e & 3], cs);
            }
            ssq = grp_sum<8>(ssq); cs = grp_sum<8>(cs);
            const float rs = rsqrtf(fmaxf(ssq, 1e-24f));
#pragma unroll
            for (int e = 0; e < 8; ++e) { kkv[e] *= rs; av[e] *= kkv[e]; }
            LAS float* o1 = fS + SCI(slot, 0, cg8); *(LAS f32x4*)o1 = (f32x4){kkv[0], kkv[1], kkv[2], kkv[3]}; *(LAS f32x4*)(o1 + 4) = (f32x4){kkv[4], kkv[5], kkv[6], kkv[7]};
            LAS float* o2 = fS + SCI(slot, 2, cg8); *(LAS f32x4*)o2 = (f32x4){av[0], av[1], av[2], av[3]}; *(LAS f32x4*)(o2 + 4) = (f32x4){av[4], av[5], av[6], av[7]};
            LAS float* o3 = fS + SCI(slot, 3, cg8); *(LAS f32x4*)o3 = (f32x4){kd[0], kd[1], kd[2], kd[3]}; *(LAS f32x4*)(o3 + 4) = (f32x4){kd[4], kd[5], kd[6], kd[7]};
            if (cg8 == 0 && rp == 0 && slot < nvalid) { const int i2 = 64 * c + slot; const int p2 = d ? Ltot - 1 - i2 : i2; CB[((size_t)d * ROWS + pos_row(base, p2)) * 8 + h] = cs; }
        }
        BAR_LDS();
#define SC_STORE_Y(cc_) do { const int t5_ = tid - 256; if (t5_ >= 0 && t5_ < 128) { const int sl5_ = t5_ >> 1, hf_ = t5_ & 1; const int i5_ = 64 * (cc_) + sl5_; const int p5_ = d ? Ltot - 1 - i5_ : i5_; \
            if (i5_ < Ltot && p5_ >= 16) { const LAS float* yp_ = fY + ((cc_) & 1) * 1024 + sl5_ * 16 + hf_ * 8; const f32x4 y0_ = *(const LAS f32x4*)yp_, y1_ = *(const LAS f32x4*)(yp_ + 4); \
                *(u32x4*)(YD + (size_t)(base + p5_ - 16) * 512 + h * 64 + rp * 16 + hf_ * 8) = pack8(y0_, y1_); } } } while (0)
        if (YDB && wid >= NSW && c > 0) SC_STORE_Y(c - 1);
        if (wid < NSW) {
            typedef float f32x2_ __attribute__((ext_vector_type(2)));
            constexpr int C4 = CPL / 4;
            const LAS float* ps = fS + kg * CPL; const LAS float* pv = fV + srow;
            LAS float* py = YDB ? fY + (c & 1) * 1024 + (srow - rp * RPB) : fY + srow;
            f32x4 nk[C4], nw[C4], nb[C4], nd[C4], nr[C4]; float nv;
#define SC_FETCH(sl_) do { _Pragma("unroll") for (int j_ = 0; j_ < C4; ++j_) { nk[j_] = *(const LAS f32x4*)(ps + (sl_) * 320 + 4 * j_); nw[j_] = *(const LAS f32x4*)(ps + (sl_) * 320 + 64 + 4 * j_); \
                nb[j_] = *(const LAS f32x4*)(ps + (sl_) * 320 + 128 + 4 * j_); nd[j_] = *(const LAS f32x4*)(ps + (sl_) * 320 + 192 + 4 * j_); nr[j_] = *(const LAS f32x4*)(ps + (sl_) * 320 + 256 + 4 * j_); } nv = pv[(sl_) * 64]; } while (0)
            SC_FETCH(0);
            f32x4 rp4[C4];
#pragma unroll
            for (int j = 0; j < C4; ++j) rp4[j] = (f32x4){0.f, 0.f, 0.f, 0.f};
#pragma unroll 16
            for (int sl = 0; sl < nvalid; ++sl) {
                f32x4 ck[C4], cw[C4], cb[C4], cd[C4], cr[C4];
#pragma unroll
                for (int j = 0; j < C4; ++j) { ck[j] = nk[j]; cw[j] = nw[j]; cb[j] = nb[j]; cd[j] = nd[j]; cr[j] = nr[j]; }
                const float vv = nv;
                SC_FETCH(sl + 1 < 64 ? sl + 1 : 63);
                f32x2_ pa = {0.f, 0.f}, ya = {0.f, 0.f};
#pragma unroll
                for (int j = 0; j < C4; ++j)
#pragma unroll
                    for (int e = 0; e < 4; e += 2) { const f32x2_ s2 = {S[4 * j + e], S[4 * j + e + 1]}, k2 = {ck[j][e], ck[j][e + 1]}, r2 = {rp4[j][e], rp4[j][e + 1]}; pa = pa + s2 * k2; ya = ya + s2 * r2; }
                float pp = pa.x + pa.y, yy = ya.x + ya.y;
                pp = dpp_add(pp, 0); yy = dpp_add(yy, 0); pp = dpp_add(pp, 1); yy = dpp_add(yy, 1); pp = dpp_add(pp, 2); yy = dpp_add(yy, 2);
                if (LPR == 16) { pp = dpp_add(pp, 3); yy = dpp_add(yy, 3); }
                py[(sl > 0 ? sl - 1 : 0) * YST] = yy;
#pragma unroll
                for (int j = 0; j < C4; ++j)
#pragma unroll
                    for (int e = 0; e < 4; e += 2) {
                        const f32x2_ b2 = {cb[j][e], cb[j][e + 1]}, d2 = {cd[j][e], cd[j][e + 1]}, w2 = {cw[j][e], cw[j][e + 1]}; f32x2_ s2 = {S[4 * j + e], S[4 * j + e + 1]};
                        const f32x2_ t2 = d2 * vv - b2 * pp; s2 = s2 * w2 + t2; S[4 * j + e] = s2.x; S[4 * j + e + 1] = s2.y; }
#pragma unroll
                for (int j = 0; j < C4; ++j) rp4[j] = cr[j];
            }
            {
                f32x2_ ya = {0.f, 0.f};
#pragma unroll
                for (int j = 0; j < C4; ++j)
#pragma unroll
                    for (int e = 0; e < 4; e += 2) { const f32x2_ s2 = {S[4 * j + e], S[4 * j + e + 1]}, r2 = {rp4[j][e], rp4[j][e + 1]}; ya = ya + s2 * r2; }
                const float yy = grp_sum<LPR>(ya.x + ya.y);
                py[(nvalid - 1) * YST] = yy;
            }
#undef SC_FETCH
        }
        BAR_LDS();
        {
            const int i2 = 64 * c + slot; const int p2 = d ? Ltot - 1 - i2 : i2;
            if (!YDB && slot < nvalid && p2 >= 16 && (cg8 / RPB) == rp) {
                const LAS float* yp = fY + slot * 64 + cg8; const f32x4 y0 = *(const LAS f32x4*)yp, y1 = *(const LAS f32x4*)(yp + 4);
                *(u32x4*)(YD + (size_t)(base + p2 - 16) * 512 + h * 64 + cg8) = pack8(y0, y1);
            }
        }
    }
    if (YDB) SC_STORE_Y(nchunk - 1);
#undef SC_STORE_Y
#undef SC_LOAD
#undef SC_META
#undef SCI
}

constexpr int SL_FV = 81920, SL_FY = 86016, SL_TW = 90112, SL_AD = 94720, SL_AS = 99328, SL_MU = 107520;
__device__ __forceinline__ void scan_long(LAS unsigned char* lds, KP P, int s, int d, int h, int rp) {
    int tid_ = threadIdx.x; asm volatile("" : "+v"(tid_));
    const int tid = tid_, lane = tid & 63, wid = __builtin_amdgcn_readfirstlane(tid >> 6);
    const int L = seq_len(s), base = seq_base(s), Ltot = L + 16, nhalf = (Ltot + 31) / 32;
    unsigned char* ws = P->ws;
    const bf16* Rb = (const bf16*)(ws + WS_R); const bf16* KAb = (const bf16*)(ws + WS_KA); const bf16* VAb = (const bf16*)(ws + WS_VA); const bf16* Lb = (const bf16*)(ws + WS_L);
    float* CB = (float*)(ws + WS_CB); bf16* YD = (bf16*)((unsigned char*)P->out + 64 * MiB) + (size_t)d * NMAIN * 512;
    LAS float* fS = (LAS float*)lds; LAS float* fV = (LAS float*)(lds + SL_FV); LAS float* fY = (LAS float*)(lds + SL_FY); LAS float* fAS = (LAS float*)(lds + SL_AS); LAS float* fMU = (LAS float*)(lds + SL_MU);
    for (int i = tid; i < 832; i += NTHREADS) {
        float v;
        if (i < 640) { const int which = i / 320, jj = i % 320, a = jj >> 6, c = jj & 63; const int gi = a < 3 ? a * 512 + h * 64 + c : 1536 + (a - 3) * 64 + c; v = P->in[which ? I_MUN : I_MUP][gi]; }
        else { const int a = (i - 640) >> 6, c = (i - 640) & 63; v = P->in[a == 0 ? I_KK : a == 1 ? I_KA : I_RK][h * 64 + c]; }
        fMU[i] = v;
    }
    const bool scanner = wid < 4; const int pw = wid & 3;
    const int sl8 = lane >> 3, cg8 = (lane & 7) * 8, slot = pw * 8 + sl8;
    const int rowl = lane >> 4, kg = lane & 15, srl = pw * 4 + rowl;
    const unsigned char* HALO0 = ws + WS_HALO + (size_t)(base >> 6) * 2 * HALO_ROW;
    u32x4 raw[5][3];
#define SL_META(hc) (d ? ((hc) == nhalf - 1) : ((hc) == 0))
#define SL_LOAD(hc) do { const int i_ = 32 * (hc) + slot; const bool ok_ = i_ < Ltot; const int p_ = d ? Ltot - 1 - i_ : i_; \
        const unsigned zr_ = (unsigned)(METAROW + 64); \
        if (!SL_META(hc)) { const unsigned rc_ = ok_ ? (unsigned)(base + p_ - 16) : zr_; \
            _Pragma("unroll") for (int a_ = 0; a_ < 5; ++a_) { const unsigned char* B_ = (const unsigned char*)(a_ == 0 ? Rb : a_ == 1 ? KAb : a_ == 2 ? VAb : Lb); const unsigned ld_ = a_ < 3 ? 1024u : 512u; \
                const unsigned co_ = (unsigned)(((a_ < 3 ? h * 64 : (a_ - 3) * 64) + cg8) * 2); raw[a_][1] = *(const u32x4*)(B_ + (rc_ * ld_ + co_)); } \
        } else { const bool me_ = ok_ && p_ < 16; const bool hn_ = me_ && p_ == 15; \
            const unsigned rc_ = ok_ ? (unsigned)pos_row(base, p_) : zr_, rp_ = (me_ && p_ > 0) ? (unsigned)(METAROW + p_ - 1) : zr_, rn_ = (me_ && p_ < 15) ? (unsigned)(METAROW + p_ + 1) : zr_; \
            _Pragma("unroll") for (int a_ = 0; a_ < 5; ++a_) { const unsigned char* B_ = (const unsigned char*)(a_ == 0 ? Rb : a_ == 1 ? KAb : a_ == 2 ? VAb : Lb); const unsigned ld_ = a_ < 3 ? 1024u : 512u; \
                const unsigned co_ = (unsigned)(((a_ < 3 ? h * 64 : (a_ - 3) * 64) + cg8) * 2); \
                const unsigned ho_ = (unsigned)(((a_ < 3 ? a_ * 512 + h * 64 : 1536 + (a_ - 3) * 64) + cg8) * 2); \
                raw[a_][0] = *(const u32x4*)(B_ + (rp_ * ld_ + co_)); raw[a_][1] = *(const u32x4*)(B_ + (rc_ * ld_ + co_)); \
                const unsigned char* np_ = hn_ ? HALO0 + ho_ : B_ + (rn_ * ld_ + co_); raw[a_][2] = *(const u32x4*)np_; } } } while (0)
    constexpr int SL_WB = 110848;
    for (int i = tid; i < 1024; i += NTHREADS) { const int m2 = i >> 9, n = (i >> 3) & 63, ch = i & 7;
        *(LAS u32x4*)(lds + SL_WB + m2 * 9216 + n * 144 + ch * 16) = *(const u32x4*)((const bf16*)(ws + WS_LORA + (m2 ? 131072 : 0)) + ((size_t)d * 512 + h * 64 + n) * 64 + ch * 8); }
    float bias[2][4];
#pragma unroll
    for (int mt_ = 0; mt_ < 2; ++mt_)
#pragma unroll
        for (int nt = 0; nt < 4; ++nt) bias[mt_][nt] = P->in[mt_ ? I_A0 : I_W0][d * 512 + h * 64 + nt * 16 + (lane & 15)];
    float S[4] = {0.f, 0.f, 0.f, 0.f};
#define SL_PREP(hc, buf) do { \
        const bool meta_ = SL_META(hc); const int i1_ = 32 * (hc) + slot; const int p1_ = d ? Ltot - 1 - i1_ : i1_; const bool ok1_ = i1_ < Ltot; \
        LAS float* fSb_ = fS + (buf) * 10240 + slot * 320; float rv[8], kv[8]; \
        if (!meta_) { float vv8[8]; unpack8(raw[0][1], rv); unpack8(raw[1][1], kv); unpack8(raw[2][1], vv8); \
            *(LAS f32x4*)(fSb_ + 256 + cg8) = (f32x4){rv[0], rv[1], rv[2], rv[3]}; *(LAS f32x4*)(fSb_ + 256 + cg8 + 4) = (f32x4){rv[4], rv[5], rv[6], rv[7]}; \
            if ((cg8 >> 4) == rp) { LAS float* dv_ = fV + (buf) * 512 + slot * 16 + (cg8 & 15); *(LAS f32x4*)dv_ = (f32x4){vv8[0], vv8[1], vv8[2], vv8[3]}; *(LAS f32x4*)(dv_ + 4) = (f32x4){vv8[4], vv8[5], vv8[6], vv8[7]}; } \
            *(LAS u32x4*)(lds + SL_TW + slot * 144 + cg8 * 2) = raw[3][1]; *(LAS u32x4*)(lds + SL_AD + slot * 144 + cg8 * 2) = raw[4][1]; \
        } else { const bool me1_ = ok1_ && p1_ < 16; const float fm_ = me1_ ? 1.0f : 0.0f; \
            _Pragma("unroll") for (int a = 0; a < 5; ++a) { \
                float pv_[8], cv_[8], nv_[8], o_[8]; unpack8(raw[a][0], pv_); unpack8(raw[a][1], cv_); unpack8(raw[a][2], nv_); \
                _Pragma("unroll") for (int e = 0; e < 8; ++e) { const float mp_ = fm_ * fMU[a * 64 + cg8 + e], mn_ = fm_ * fMU[320 + a * 64 + cg8 + e]; o_[e] = cv_[e] + mp_ * (pv_[e] - cv_[e]) + mn_ * (nv_[e] - cv_[e]); } \
                if (a == 0) { _Pragma("unroll") for (int e = 0; e < 8; ++e) rv[e] = o_[e]; \
                    *(LAS f32x4*)(fSb_ + 256 + cg8) = (f32x4){o_[0], o_[1], o_[2], o_[3]}; *(LAS f32x4*)(fSb_ + 256 + cg8 + 4) = (f32x4){o_[4], o_[5], o_[6], o_[7]}; } \
                else if (a == 1) { _Pragma("unroll") for (int e = 0; e < 8; ++e) kv[e] = o_[e]; } \
                else if (a == 2) { if ((cg8 >> 4) == rp) { LAS float* dv_ = fV + (buf) * 512 + slot * 16 + (cg8 & 15); *(LAS f32x4*)dv_ = (f32x4){o_[0], o_[1], o_[2], o_[3]}; *(LAS f32x4*)(dv_ + 4) = (f32x4){o_[4], o_[5], o_[6], o_[7]}; } } \
                else { if (a == 3) { _Pragma("unroll") for (int e = 0; e < 8; ++e) o_[e] = me1_ ? fast_tanh(o_[e]) : o_[e]; } \
                    u32x4 w_; w_.x = cvtpk(o_[0], o_[1]); w_.y = cvtpk(o_[2], o_[3]); w_.z = cvtpk(o_[4], o_[5]); w_.w = cvtpk(o_[6], o_[7]); \
                    *(LAS u32x4*)(lds + (a == 3 ? SL_TW : SL_AD) + slot * 144 + cg8 * 2) = w_; } } } \
        asm volatile("s_waitcnt lgkmcnt(0)" ::: "memory"); \
          \
        { f32x4 acc_[2][4]; \
          _Pragma("unroll") for (int m2 = 0; m2 < 2; ++m2) { const LAS unsigned char* Ab_ = lds + (m2 ? SL_AD : SL_TW) + (pw * 8 + (lane & 15)) * 144 + (lane >> 4) * 16; \
              const bf16x8 a0_ = *(const LAS bf16x8*)Ab_, a1_ = *(const LAS bf16x8*)(Ab_ + 64); \
              _Pragma("unroll") for (int nt = 0; nt < 4; ++nt) { f32x4 z_ = {0.f, 0.f, 0.f, 0.f}; const LAS unsigned char* Bb_ = lds + SL_WB + m2 * 9216 + (nt * 16 + (lane & 15)) * 144 + (lane >> 4) * 16; \
                  z_ = __builtin_amdgcn_mfma_f32_16x16x32_bf16(a0_, *(const LAS bf16x8*)Bb_, z_, 0, 0, 0); acc_[m2][nt] = __builtin_amdgcn_mfma_f32_16x16x32_bf16(a1_, *(const LAS bf16x8*)(Bb_ + 64), z_, 0, 0, 0); } } \
          if (lane < 32) { \
              _Pragma("unroll") for (int nt = 0; nt < 4; ++nt) _Pragma("unroll") for (int rg = 0; rg < 4; ++rg) { const int row_ = (lane >> 4) * 4 + rg, col_ = nt * 16 + (lane & 15); \
                  const float sw_ = fast_sigmoid(acc_[0][nt][rg] + bias[0][nt]); fS[(buf) * 10240 + (pw * 8 + row_) * 320 + 64 + col_] = __builtin_amdgcn_exp2f(-0.6065306597126334f * LOG2E * sw_); \
                  fAS[pw * 512 + row_ * 64 + col_] = fast_sigmoid(acc_[1][nt][rg] + bias[1][nt]); } } } \
        asm volatile("s_waitcnt lgkmcnt(0)" ::: "memory"); \
          \
        { const f32x4 a0 = *(const LAS f32x4*)(fAS + pw * 512 + sl8 * 64 + cg8), a1 = *(const LAS f32x4*)(fAS + pw * 512 + sl8 * 64 + cg8 + 4); \
          const f32x4 kk0 = *(const LAS f32x4*)(fMU + 640 + cg8), kk1 = *(const LAS f32x4*)(fMU + 640 + cg8 + 4), ka0 = *(const LAS f32x4*)(fMU + 704 + cg8), ka1 = *(const LAS f32x4*)(fMU + 704 + cg8 + 4); \
          const f32x4 rk0 = *(const LAS f32x4*)(fMU + 768 + cg8), rk1 = *(const LAS f32x4*)(fMU + 768 + cg8 + 4); \
          float kkv[8], kd[8], av[8]; float ssq = 0.f, cs = 0.f; \
          _Pragma("unroll") for (int e = 0; e < 8; ++e) { av[e] = e < 4 ? a0[e & 3] : a1[e & 3]; \
              kkv[e] = kv[e] * (e < 4 ? kk0[e & 3] : kk1[e & 3]); ssq = fmaf(kkv[e], kkv[e], ssq); \
              kd[e] = kv[e] * (1.0f + (av[e] - 1.0f) * (e < 4 ? ka0[e & 3] : ka1[e & 3])); cs = fmaf(rv[e] * kd[e], e < 4 ? rk0[e & 3] : rk1[e & 3], cs); } \
          ssq = grp_sum<8>(ssq); cs = grp_sum<8>(cs); \
          const float rs = rsqrtf(fmaxf(ssq, 1e-24f)); \
          _Pragma("unroll") for (int e = 0; e < 8; ++e) { kkv[e] *= rs; av[e] *= kkv[e]; } \
          *(LAS f32x4*)(fSb_ + cg8) = (f32x4){kkv[0], kkv[1], kkv[2], kkv[3]}; *(LAS f32x4*)(fSb_ + cg8 + 4) = (f32x4){kkv[4], kkv[5], kkv[6], kkv[7]}; \
          *(LAS f32x4*)(fSb_ + 128 + cg8) = (f32x4){av[0], av[1], av[2], av[3]}; *(LAS f32x4*)(fSb_ + 128 + cg8 + 4) = (f32x4){av[4], av[5], av[6], av[7]}; \
          *(LAS f32x4*)(fSb_ + 192 + cg8) = (f32x4){kd[0], kd[1], kd[2], kd[3]}; *(LAS f32x4*)(fSb_ + 192 + cg8 + 4) = (f32x4){kd[4], kd[5], kd[6], kd[7]}; \
          if (cg8 == 0 && rp == 0 && ok1_) CB[((size_t)d * ROWS + pos_row(base, p1_)) * 8 + h] = cs; } } while (0)
#define SL_STORE_Y(hc, buf) do { const int sl5_ = lane >> 1, hf_ = lane & 1; const int i5_ = 32 * (hc) + sl5_; const int p5_ = d ? Ltot - 1 - i5_ : i5_; \
        if (i5_ < Ltot && p5_ >= 16) { const LAS float* yp_ = fY + (buf) * 512 + sl5_ * 16 + hf_ * 8; const f32x4 y0_ = *(const LAS f32x4*)yp_, y1_ = *(const LAS f32x4*)(yp_ + 4); \
            *(u32x4*)(YD + (size_t)(base + p5_ - 16) * 512 + h * 64 + rp * 16 + hf_ * 8) = pack8(y0_, y1_); } } while (0)
    BAR_LDS();
    if (!scanner) { SL_LOAD(0); SL_PREP(0, 0); if (nhalf > 1) SL_LOAD(1); }
    BAR_LDS();
#pragma unroll 1
    for (int hc = 0; hc < nhalf; ++hc) {
        if (scanner) {
            typedef float f32x2_ __attribute__((ext_vector_type(2)));
            const int nvalid = (Ltot - 32 * hc) < 32 ? (Ltot - 32 * hc) : 32, buf = hc & 1;
            const LAS float* ps = fS + buf * 10240 + kg * 4; const LAS float* pv = fV + buf * 512 + srl; LAS float* py = fY + buf * 512 + srl;
            f32x4 nk, nw, nb, nd, nr; float nv;
#define SL_FETCH(sl_) do { nk = *(const LAS f32x4*)(ps + (sl_) * 320); nw = *(const LAS f32x4*)(ps + (sl_) * 320 + 64); nb = *(const LAS f32x4*)(ps + (sl_) * 320 + 128); \
                nd = *(const LAS f32x4*)(ps + (sl_) * 320 + 192); nr = *(const LAS f32x4*)(ps + (sl_) * 320 + 256); nv = pv[(sl_) * 16]; } while (0)
            SL_FETCH(0);
            f32x4 rp4 = {0.f, 0.f, 0.f, 0.f};
            if (nvalid == 32) {
#pragma unroll
            for (int sl = 0; sl < 32; ++sl) {
                const f32x4 ck = nk, cw = nw, cb = nb, cd = nd, cr = nr; const float vv = nv;
                SL_FETCH(sl + 1 < 32 ? sl + 1 : 31);
                f32x2_ pa = {0.f, 0.f}, ya = {0.f, 0.f};
#pragma unroll
                for (int e = 0; e < 4; e += 2) { const f32x2_ s2 = {S[e], S[e + 1]}, k2 = {ck[e], ck[e + 1]}, r2 = {rp4[e], rp4[e + 1]}; pa = pa + s2 * k2; ya = ya + s2 * r2; }
                float pp = pa.x + pa.y, yy = ya.x + ya.y;
                pp = dpp_add(pp, 0); yy = dpp_add(yy, 0); pp = dpp_add(pp, 1); yy = dpp_add(yy, 1); pp = dpp_add(pp, 2); yy = dpp_add(yy, 2); pp = dpp_add(pp, 3); yy = dpp_add(yy, 3);
                py[(sl > 0 ? sl - 1 : 0) * 16] = yy;
#pragma unroll
                for (int e = 0; e < 4; e += 2) { const f32x2_ b2 = {cb[e], cb[e + 1]}, d2 = {cd[e], cd[e + 1]}, w2 = {cw[e], cw[e + 1]}; f32x2_ s2 = {S[e], S[e + 1]};
                    const f32x2_ t2 = d2 * vv - b2 * pp; s2 = s2 * w2 + t2; S[e] = s2.x; S[e + 1] = s2.y; }
                rp4 = cr;
            }
            } else {
#pragma unroll 16
            for (int sl = 0; sl < nvalid; ++sl) {
                const f32x4 ck = nk, cw = nw, cb = nb, cd = nd, cr = nr; const float vv = nv;
                SL_FETCH(sl + 1 < 32 ? sl + 1 : 31);
                f32x2_ pa = {0.f, 0.f}, ya = {0.f, 0.f};
#pragma unroll
                for (int e = 0; e < 4; e += 2) { const f32x2_ s2 = {S[e], S[e + 1]}, k2 = {ck[e], ck[e + 1]}, r2 = {rp4[e], rp4[e + 1]}; pa = pa + s2 * k2; ya = ya + s2 * r2; }
                float pp = pa.x + pa.y, yy = ya.x + ya.y;
                pp = dpp_add(pp, 0); yy = dpp_add(yy, 0); pp = dpp_add(pp, 1); yy = dpp_add(yy, 1); pp = dpp_add(pp, 2); yy = dpp_add(yy, 2); pp = dpp_add(pp, 3); yy = dpp_add(yy, 3);
                py[(sl > 0 ? sl - 1 : 0) * 16] = yy;
#pragma unroll
                for (int e = 0; e < 4; e += 2) { const f32x2_ b2 = {cb[e], cb[e + 1]}, d2 = {cd[e], cd[e + 1]}, w2 = {cw[e], cw[e + 1]}; f32x2_ s2 = {S[e], S[e + 1]};
                    const f32x2_ t2 = d2 * vv - b2 * pp; s2 = s2 * w2 + t2; S[e] = s2.x; S[e + 1] = s2.y; }
                rp4 = cr;
            }
            }
            { f32x2_ ya = {0.f, 0.f};
#pragma unroll
              for (int e = 0; e < 4; e += 2) { const f32x2_ s2 = {S[e], S[e + 1]}, r2 = {rp4[e], rp4[e + 1]}; ya = ya + s2 * r2; }
              const float yy = grp_sum<16>(ya.x + ya.y); py[(nvalid - 1) * 16] = yy; }
#undef SL_FETCH
        } else {
            if (hc > 0 && pw == 0) SL_STORE_Y(hc - 1, (hc - 1) & 1);
            if (hc + 1 < nhalf) { SL_PREP(hc + 1, (hc + 1) & 1); if (hc + 2 < nhalf) SL_LOAD(hc + 2); }
        }
        BAR_LDS();
    }
    if (!scanner && pw == 0) SL_STORE_Y(nhalf - 1, (nhalf - 1) & 1);
#undef SL_STORE_Y
#undef SL_PREP
#undef SL_LOAD
#undef SL_META
}

__device__ __forceinline__ void rwkv_colmap(unsigned char* ws, int c0, bf16*& buf, int& ld, int& col) {
    if (c0 < 512) { buf = (bf16*)(ws + WS_R); ld = 512; col = c0; }
    else if (c0 < 1024) { buf = (bf16*)(ws + WS_KA); ld = 512; col = c0 - 512; }
    else if (c0 < 1536) { buf = (bf16*)(ws + WS_VA); ld = 512; col = c0 - 1024; }
    else { buf = (bf16*)(ws + WS_L); ld = 256; col = c0 - 1536; }
}
__device__ __forceinline__ void phase_halo(KP P) {
    const int tid = fresh_tid(), lane = tid & 63, wid = tid >> 6; const int gw = blockIdx.x * 8 + wid, NGW = gridDim.x * 8;
    unsigned char* ws = P->ws;
    for (int r = gw; r < (NMAIN / 64) * 2; r += NGW) {
        const int m = (r >> 1) * 64 + ((r & 1) ? 63 : 0);
        for (int j = lane; j < 224; j += 64) { bf16* buf; int ld, col; rwkv_colmap(ws, j * 8, buf, ld, col);
            *(u32x4*)(ws + WS_HALO + (size_t)r * HALO_ROW + j * 16) = *(const u32x4*)(buf + (size_t)m * ld + col); }
    }
}
__device__ __forceinline__ void phase_shift(LAS unsigned char* lds, KP P) {
    const int tid = fresh_tid(), slot = tid >> 3, cg = tid & 7;
    unsigned char* ws = P->ws; const float* mup = P->in[I_MUP]; const float* mun = P->in[I_MUN];
    for (int tile = blockIdx.x; tile < NMAIN / 64; tile += gridDim.x) {
        const int m0 = tile * 64, m = m0 + slot;
        const int ks = m0 < 16384 ? tile : ((m0 - 16384) & 2047) >> 6; const bool first = ks == 0, last = ks == (m0 < 16384 ? 255 : 31);
        u32x4 stg[7];
#define SH_LOAD(pass_) do { _Pragma("unroll") for (int i = 0; i < 7; ++i) { const int j = cg + 8 * i; bf16* buf; int ld, col; rwkv_colmap(ws, ((pass_) * 56 + j) * 8, buf, ld, col); \
            stg[i] = *(const u32x4*)(buf + (size_t)m * ld + col); } } while (0)
        SH_LOAD(0);
#pragma unroll 1
        for (int pass = 0; pass < 4; ++pass) {
#pragma unroll
            for (int i = 0; i < 7; ++i) { const int j = cg + 8 * i; *(LAS u32x4*)(lds + (slot * 56 + j) * 16) = stg[i]; }
            asm volatile("s_waitcnt lgkmcnt(0)\n\ts_barrier" ::: "memory");
            if (pass < 3) SH_LOAD(pass + 1);
#pragma unroll
            for (int i = 0; i < 7; ++i) {
                const int j = cg + 8 * i, c0 = (pass * 56 + j) * 8; bf16* buf; int ld, col; rwkv_colmap(ws, c0, buf, ld, col);
                const u32x4 z = {0u, 0u, 0u, 0u};
                const u32x4 cu = *(const LAS u32x4*)(lds + (slot * 56 + j) * 16);
                u32x4 pu, nu;
                if (slot > 0) pu = *(const LAS u32x4*)(lds + ((slot - 1) * 56 + j) * 16);
                else pu = first ? *(const u32x4*)(buf + (size_t)(METAROW + 15) * ld + col) : *(const u32x4*)(ws + WS_HALO + (size_t)((tile - 1) * 2 + 1) * HALO_ROW + c0 * 2);
                if (slot < 63) nu = *(const LAS u32x4*)(lds + ((slot + 1) * 56 + j) * 16);
                else nu = last ? z : *(const u32x4*)(ws + WS_HALO + (size_t)((tile + 1) * 2) * HALO_ROW + c0 * 2);
                float pv[8], cv[8], nv[8], o[8]; unpack8(pu, pv); unpack8(cu, cv); unpack8(nu, nv);
                const f32x4 mp0 = *(const f32x4*)(mup + c0), mp1 = *(const f32x4*)(mup + c0 + 4), mn0 = *(const f32x4*)(mun + c0), mn1 = *(const f32x4*)(mun + c0 + 4);
#pragma unroll
                for (int e = 0; e < 8; ++e) { const float mp = e < 4 ? mp0[e & 3] : mp1[e & 3], mn = e < 4 ? mn0[e & 3] : mn1[e & 3]; o[e] = cv[e] + mp * (pv[e] - cv[e]) + mn * (nv[e] - cv[e]); }
                if (c0 >= 1536 && c0 < 1600) {
#pragma unroll
                    for (int e = 0; e < 8; ++e) o[e] = fast_tanh(o[e]);
                }
                u32x4 w; w.x = cvtpk(o[0], o[1]); w.y = cvtpk(o[2], o[3]); w.z = cvtpk(o[4], o[5]); w.w = cvtpk(o[6], o[7]);
                *(u32x4*)(buf + (size_t)m * ld + col) = w;
            }
            asm volatile("s_waitcnt lgkmcnt(0)\n\ts_barrier" ::: "memory");
        }
#undef SH_LOAD
    }
}

__device__ __forceinline__ void phase_post(LAS unsigned char* lds, KP P) {
    const int tid = fresh_tid(), lane = tid & 63, wid = tid >> 6;
    unsigned char* ws = P->ws;
    const bf16* VAb = (const bf16*)(ws + WS_VA); const bf16* Lb = (const bf16*)(ws + WS_L); bf16* Rb = (bf16*)(ws + WS_R);
    const float* CB = (const float*)(ws + WS_CB); const bf16* YD0 = (const bf16*)((const unsigned char*)P->out + 64 * MiB); const bf16* YD1 = YD0 + (size_t)NMAIN * 512;
    const bf16* GT = (const bf16*)(ws + WS_LORA + 262144);
    LAS float* st = (LAS float*)(lds + 17408);
    const float* mup = P->in[I_MUP]; const float* mun = P->in[I_MUN];
    for (int tile = blockIdx.x; tile < NMAIN / 64; tile += gridDim.x) {
        {
            const int row = tid >> 3, hh = tid & 7, m = tile * 64 + row;
            const int t = m < 16384 ? m : (m - 16384) & 2047, Ls = m < 16384 ? 16384 : 2048;
            float sum = 0.f, sq = 0.f;
#pragma unroll
            for (int i = 0; i < 8; ++i) { float a[8], b[8]; unpack8(*(const u32x4*)(YD0 + (size_t)m * 512 + hh * 64 + i * 8), a); unpack8(*(const u32x4*)(YD1 + (size_t)m * 512 + hh * 64 + i * 8), b);
#pragma unroll
                for (int e = 0; e < 8; ++e) { const float y = a[e] + b[e]; sum += y; sq += y * y; } }
            const float mu = sum * (1.0f / 64.0f); const float var = fmaxf(sq * (1.0f / 64.0f) - mu * mu, 0.f);
            st[(row * 8 + hh) * 2] = mu; st[(row * 8 + hh) * 2 + 1] = rsqrtf(var + 64e-5f);
#pragma unroll
            for (int i = 0; i < 2; ++i) {
                const int c0 = 128 + hh * 16 + i * 8; float cv[8], o[8];
                unpack8(*(const u32x4*)(Lb + (size_t)m * 256 + c0), cv);
#pragma unroll
                for (int e = 0; e < 8; ++e) o[e] = sigmoidf_(cv[e]);
                u32x4 w; w.x = cvtpk(o[0], o[1]); w.y = cvtpk(o[2], o[3]); w.z = cvtpk(o[4], o[5]); w.w = cvtpk(o[6], o[7]);
                *(LAS u32x4*)(lds + row * 272 + (hh * 16 + i * 8) * 2) = w;
            }
        }
        __syncthreads();
#pragma unroll 1
        for (int nt = 0; nt < 4; ++nt) {
            const int col = wid * 64 + nt * 16 + (lane & 15);
            bf16x8 bfr[4];
#pragma unroll
            for (int ks = 0; ks < 4; ++ks) bfr[ks] = *(const bf16x8*)(GT + (size_t)col * 128 + ks * 32 + (lane >> 4) * 8);
            const float lw = P->in[I_LNW][col], lb = P->in[I_LNB][col];
            const float mpv = mup[1024 + col], mnv = mun[1024 + col];
#pragma unroll 1
            for (int mt = 0; mt < 4; ++mt) {
                f32x4 acc = {0.f, 0.f, 0.f, 0.f};
#pragma unroll
                for (int ks = 0; ks < 4; ++ks) { const bf16x8 a = *(const LAS bf16x8*)(lds + (mt * 16 + (lane & 15)) * 272 + ks * 64 + (lane >> 4) * 16); acc = __builtin_amdgcn_mfma_f32_16x16x32_bf16(a, bfr[ks], acc, 0, 0, 0); }
#pragma unroll
                for (int rg = 0; rg < 4; ++rg) {
                    const int row = mt * 16 + (lane >> 4) * 4 + rg, m = tile * 64 + row;
                    const int t = m < 16384 ? m : (m - 16384) & 2047, Ls = m < 16384 ? 16384 : 2048;
                    const float y = bf2f(YD0[(size_t)m * 512 + col]) + bf2f(YD1[(size_t)m * 512 + col]);
                    const float yn = (y - st[(row * 8 + wid) * 2]) * st[(row * 8 + wid) * 2 + 1] * lw + lb;
                    const float vs = bf2f(VAb[(size_t)m * 512 + col]);
                    const float cb = CB[(size_t)m * 8 + wid] + CB[((size_t)ROWS + m) * 8 + wid];
                    Rb[(size_t)m * 512 + col] = (bf16)f2bf_rne((yn + cb * vs) * acc[rg]);
                }
            }
        }
        asm volatile("s_waitcnt lgkmcnt(0)\n\ts_barrier" ::: "memory");
    }
}

__device__ __forceinline__ void phase_rms_bf16(KP P) {
    const int tid = fresh_tid(), lane = tid & 63, wid = tid >> 6; const int gw = blockIdx.x * 8 + wid, NGW = gridDim.x * 8;
    bf16* MN = (bf16*)(P->ws + WS_MN);
    for (int m = gw; m < NMAIN; m += NGW) rms_row_bf16(P->out + (size_t)m * DM, P->in[I_GFFN], MN + (size_t)m * DM, lane);
}
__device__ __forceinline__ void phase_final(KP P) {
    const int tid = fresh_tid(), lane = tid & 63, wid = tid >> 6; const int gw = blockIdx.x * 8 + wid, NGW = gridDim.x * 8;
    const f32x4* gr = (const f32x4*)P->in[I_GFIN] + lane;
    for (int m = gw; m < NMAIN; m += 2 * NGW) {
        const int m2 = m + NGW; const bool ok2 = m2 < NMAIN;
        f32x4* xr = (f32x4*)(P->out + (size_t)m * DM) + lane; f32x4* xr2 = (f32x4*)(P->out + (size_t)(ok2 ? m2 : m) * DM) + lane;
        f32x4 v[4], w[4]; float s = 0.f, s2 = 0.f;
#pragma unroll
        for (int j = 0; j < 4; ++j) { v[j] = xr[64 * j]; w[j] = xr2[64 * j]; }
#pragma unroll
        for (int j = 0; j < 4; ++j) { s += (v[j].x * v[j].x + v[j].y * v[j].y) + (v[j].z * v[j].z + v[j].w * v[j].w); s2 += (w[j].x * w[j].x + w[j].y * w[j].y) + (w[j].z * w[j].z + w[j].w * w[j].w); }
        const float rstd = rsqrtf(wave_sum(s) * (1.f / DM) + 1e-6f), rstd2 = rsqrtf(wave_sum(s2) * (1.f / DM) + 1e-6f);
#pragma unroll
        for (int j = 0; j < 4; ++j) { const f32x4 gg = gr[64 * j]; xr[64 * j] = v[j] * rstd * gg; if (ok2) xr2[64 * j] = w[j] * rstd2 * gg; }
    }
}

constexpr int NRP_LONG = 4;
constexpr int N_LONG = 16 * NRP_LONG, N_ATT_P = 512, N_ATT_S = 512, N_SHORT = 128, N_ITEMS = N_LONG + N_ATT_P + N_ATT_S + N_SHORT;

template <class Op> __device__ __forceinline__ void run_gemm(LAS unsigned char* lds, const bf16* A, const bf16* Bt, int M, int N, int K, const Op& op, const bf16* A2 = nullptr, int pm2 = 1 << 30) {
    pg8::Gemm g{A, Bt, M, N, K, A2, pm2}; pg8::StaticOrder S; S.init(M, N, (int)gridDim.x, (int)blockIdx.x);
    Epi8<Op> E{op};
    pg8::gemm_phase<Epi8<Op>, pg8::StaticOrder, true, true>(lds, g, S, E);
}

constexpr size_t WS_XBAR = 16384;
#define XB_TMO      128
#define XB_XCNT(j)  (256  + 64 * (j))
#define XB_XSUB(j)  (1280 + 64 * (j))
#define XB_XGEN(j)  (2304 + 64 * (j))
#define XB_TOP      3328
#define XB_TOPGEN   3392
#define XCD_BAR_WORDS 3456
#define XB_SPIN_CAP (1u << 18)
__device__ __forceinline__ unsigned xb_ld(unsigned* p)              { return __hip_atomic_load(p, __ATOMIC_RELAXED, __HIP_MEMORY_SCOPE_AGENT); }
__device__ __forceinline__ unsigned xb_add(unsigned* p, unsigned v) { return __hip_atomic_fetch_add(p, v, __ATOMIC_RELAXED, __HIP_MEMORY_SCOPE_AGENT); }
__device__ __forceinline__ unsigned xb_xcc_id() { return (unsigned)__builtin_amdgcn_s_getreg((3 << 11) | 20) & 0xFu; }
#define XB_SPIN(cond, bar) do { unsigned _sp = 0; while (cond) { __builtin_amdgcn_s_sleep(1); \
    if ((++_sp & 255u) == 0u) { if (xb_ld(&(bar)[XB_TMO])) break; if (_sp > XB_SPIN_CAP) { atomicAdd(&(bar)[XB_TMO], 1u); break; } } } } while (0)
struct XcdBarrier { unsigned* bar; unsigned x; volatile LAS unsigned* st; };
__device__ __forceinline__ XcdBarrier xcd_barrier_post(unsigned* bar, volatile LAS unsigned* st) {
    XcdBarrier b; b.bar = bar; b.x = xb_xcc_id(); b.st = st;
    if (threadIdx.x == 0) (void)xb_add(&bar[XB_XCNT(b.x)], 1u);
    return b;
}
__device__ __forceinline__ void xcd_barrier_complete(unsigned* bar, unsigned x, unsigned& nloc, unsigned& nx) {
    const unsigned G = gridDim.x * gridDim.y * gridDim.z;
    unsigned sum, cnt, mine, sp = 0u;
    for (;;) {
        sum = 0u; cnt = 0u; mine = 0u;
#pragma unroll
        for (unsigned j = 0; j < 16; ++j) { const unsigned c = xb_ld(&bar[XB_XCNT(j)]); sum += c; cnt += (c > 0u) ? 1u : 0u; mine = (j == x) ? c : mine; }
        if (sum == G) break;
        __builtin_amdgcn_s_sleep(1);
        if ((++sp & 255u) == 0u) { if (xb_ld(&bar[XB_TMO])) break; if (sp > XB_SPIN_CAP) { atomicAdd(&bar[XB_TMO], 1u); break; } }
    }
    nloc = mine > 0u ? mine : 1u; nx = cnt > 0u ? cnt : 1u;
}
__device__ __forceinline__ void xcd_barrier(const XcdBarrier& b) {
    asm volatile("s_waitcnt vmcnt(0)" ::: "memory");
    __syncthreads();
    if (threadIdx.x == 0) {
        unsigned* bar = b.bar;
        __builtin_amdgcn_s_waitcnt(0);
        unsigned nloc = b.st[0], nx = b.st[1];
        if (nloc == 0u) { xcd_barrier_complete(bar, b.x, nloc, nx); b.st[0] = nloc; b.st[1] = nx; }
        const unsigned old = xb_add(&bar[XB_XSUB(b.x)], 1u);
        const unsigned gen = old / nloc;
        if (old + 1u == (gen + 1u) * nloc) {
            __builtin_amdgcn_fence(__ATOMIC_RELEASE, "agent");
            asm volatile("s_waitcnt vmcnt(0)" ::: "memory");
            const unsigned og = xb_add(&bar[XB_TOP], 1u);
            const unsigned tg = og / nx;
            if (og + 1u == (tg + 1u) * nx) xb_add(&bar[XB_TOPGEN], 1u);
            else XB_SPIN(xb_ld(&bar[XB_TOPGEN]) == tg, bar);
            __builtin_amdgcn_fence(__ATOMIC_ACQUIRE, "agent");
            xb_add(&bar[XB_XGEN(b.x)], 1u);
            asm volatile("s_waitcnt vmcnt(0)" ::: "memory");
        } else {
            XB_SPIN(xb_ld(&bar[XB_XGEN(b.x)]) == gen, bar);
            __builtin_amdgcn_fence(__ATOMIC_ACQUIRE, "agent");
            asm volatile("s_waitcnt vmcnt(0)" ::: "memory");
        }
    }
    __syncthreads();
}
#ifndef PROBE_MASK
#define PROBE_MASK 0
#endif
#ifndef PROBE_MUL
#define PROBE_MUL 1
#endif
#define PH_BEGIN(k) unsigned long long t0_##k = 0; if (PROBE_MASK & (1 << (k))) t0_##k = __builtin_amdgcn_s_memrealtime();
#define PH_END(k) if (PROBE_MASK & (1 << (k))) { const unsigned long long t1_ = __builtin_amdgcn_s_memrealtime(); const unsigned long long dt_ = (t1_ - t0_##k) * PROBE_MUL; while (__builtin_amdgcn_s_memrealtime() - t1_ < dt_) __builtin_amdgcn_s_sleep(8); xcd_barrier(xbar); }
__global__ void __launch_bounds__(NTHREADS) fwd_megakernel(Params Pin) {
    extern __shared__ __attribute__((aligned(16))) unsigned char lds_raw[];
    LAS unsigned char* lds = (LAS unsigned char*)lds_raw;
    cg::grid_group grid = cg::this_grid();
    KP P0 = (KP)__builtin_amdgcn_kernarg_segment_ptr();
    volatile LAS unsigned* xst = (volatile LAS unsigned*)(lds + LDS_ITEM_OFF + 4);
    if (threadIdx.x == 0) { xst[0] = 0u; xst[1] = 0u; }
    __syncthreads();
    const XcdBarrier xbar = xcd_barrier_post((unsigned*)(P0->ws + WS_XBAR), xst);
#define NEWPHASE KP P = P0; asm volatile("" : "+s"(P)); unsigned char* ws = P->ws; (void)ws;

    PH_BEGIN(0)
    { NEWPHASE phase_prologue(lds, P); }
    grid.sync();
    PH_END(0)
    PH_BEGIN(1)
    { NEWPHASE run_gemm(lds, (const bf16*)P->out, (const bf16*)(ws + WS_WIN), ROWS, 3328, 1024, OpProj{ws}, (const bf16*)(ws + WS_XNMETA), 128); }
    xcd_barrier(xbar);
    PH_END(1)
    { NEWPHASE phase_halo(P); }
    xcd_barrier(xbar);
    { NEWPHASE phase_shift(lds, P); }
    xcd_barrier(xbar);
    PH_BEGIN(2)
    { NEWPHASE
        const int tid = fresh_tid();
        float lam;
        { const int lane = tid & 63; const float s1 = wave_sum(P->in[I_LQ1][lane] * P->in[I_LK1][lane]), s2 = wave_sum(P->in[I_LQ2][lane] * P->in[I_LK2][lane]); lam = __expf(s1) - __expf(s2) + 0.2f; }
        unsigned* ctr = (unsigned*)(ws + WS_CTL);
        LAS unsigned* slot = (LAS unsigned*)(lds + LDS_ITEM_OFF);
#define FETCH(k, n) if (tid == 0) *slot = atomicAdd(ctr + 64 * (k), 1u); __syncthreads(); const int idx = (int)*slot; __syncthreads(); if (idx >= (n)) break;
#ifndef NO_SCAN
#pragma unroll 1
        for (;;) { FETCH(0, N_LONG) const int u = idx / NRP_LONG; scan_long(lds, P, 0, u >> 3, u & 7, idx % NRP_LONG); }
#endif
#ifndef NO_ATTN
#pragma unroll 1
        for (;;) { FETCH(1, N_ATT_P + N_ATT_S)
            if (idx < N_ATT_P) attn_unit(lds, P, 0, idx >> 7, idx & 127, lam);
            else { const int a = idx - N_ATT_P; attn_unit(lds, P, 1 + (a >> 6), (a >> 4) & 3, a & 15, lam); } }
#endif
#ifndef NO_SCAN
#pragma unroll 1
        for (;;) { FETCH(2, N_SHORT) scan_unit<1, 8>(lds, P, 1 + (idx >> 4), (idx >> 3) & 1, idx & 7, 0); }
#endif
#undef FETCH
    }
    xcd_barrier(xbar);
    PH_END(2)
#ifndef NO_POST
    PH_BEGIN(3)
    { NEWPHASE phase_post(lds, P); }
#endif
    xcd_barrier(xbar);
    PH_END(3)
    PH_BEGIN(4)
    { NEWPHASE run_gemm(lds, (const bf16*)P->out, (const bf16*)(ws + WS_WIN) + (size_t)3328 * 1024, NMAIN, 1024, 1024, OpGate{(bf16*)(ws + WS_GA)}); }
    { NEWPHASE run_gemm(lds, (const bf16*)P->out, (const bf16*)(ws + WS_WIN) + (size_t)4352 * 1024, NMAIN, 1024, 1024, OpGate{(bf16*)(ws + WS_GB)}); }

    PH_END(4)
    PH_BEGIN(5)
    { NEWPHASE run_gemm(lds, (const bf16*)(ws + WS_R), (const bf16*)(ws + WS_WUPA), NMAIN, 1024, 512, OpUpA{ws}); }
    PH_END(5)
    PH_BEGIN(6)
    { NEWPHASE run_gemm(lds, (const bf16*)(ws + WS_Q), (const bf16*)(ws + WS_WUPB), NMAIN, 1024, 512, OpUpB{ws}); }
    xcd_barrier(xbar);
    PH_END(6)
    PH_BEGIN(7)
    { NEWPHASE run_gemm(lds, (const bf16*)(ws + WS_GB), (const bf16*)(ws + WS_WOUT), NMAIN, 1024, 1024, OpOut{P->in[I_XP], P->in[I_XS], P->out, P->in[I_GFFN], (bf16*)(ws + WS_MN), (float*)(ws + WS_SS)}); }
    xcd_barrier(xbar);
    PH_END(7)
    PH_BEGIN(9)
    { NEWPHASE run_gemm(lds, (const bf16*)(ws + WS_MN), (const bf16*)(ws + WS_WFF1), 16384, DFF, 1024, OpFF1{(bf16*)(ws + WS_HID), (const float*)(ws + WS_SS)}); }
    xcd_barrier(xbar);
    PH_END(9)
    PH_BEGIN(10)
    { NEWPHASE run_gemm(lds, (const bf16*)(ws + WS_HID), (const bf16*)(ws + WS_WFF2), 16384, 1024, DFF, OpFF2{P->out}); }
    xcd_barrier(xbar);
    PH_END(10)
    PH_BEGIN(11)
    { NEWPHASE run_gemm(lds, (const bf16*)(ws + WS_MN) + (size_t)16384 * DM, (const bf16*)(ws + WS_WFF1), 16384, DFF, 1024, OpFF1{(bf16*)(ws + WS_HID), (const float*)(ws + WS_SS) + 16384}); }
    xcd_barrier(xbar);
    PH_END(11)
    PH_BEGIN(12)
    { NEWPHASE run_gemm(lds, (const bf16*)(ws + WS_HID), (const bf16*)(ws + WS_WFF2), 16384, 1024, DFF, OpFF2{P->out + (size_t)16384 * DM}); }
    xcd_barrier(xbar);
    PH_END(12)
    PH_BEGIN(13)
    { NEWPHASE phase_final(P); }
}

extern "C" void kernel_launch(void* const* d_in, const int* in_sizes, int n_in, void* d_out, int out_size, void* d_ws, size_t ws_size, hipStream_t stream) {
    static int grid_blocks = 0;
    if (grid_blocks == 0) {
        int dev = 0, cus = 0, per_cu = 0;
        hipGetDevice(&dev);
        hipDeviceGetAttribute(&cus, hipDeviceAttributeMultiprocessorCount, dev);
        hipFuncSetAttribute((const void*)fwd_megakernel, hipFuncAttributeMaxDynamicSharedMemorySize, LDS_BYTES);
        hipOccupancyMaxActiveBlocksPerMultiprocessor(&per_cu, (const void*)fwd_megakernel, NTHREADS, LDS_BYTES);
        if (per_cu < 1) { fprintf(stderr, "kernel_launch: occupancy query says %d blocks per CU\n", per_cu); per_cu = 1; }
        grid_blocks = cus * per_cu;
        if (n_in != 29 || ws_size < WS_END) fprintf(stderr, "kernel_launch: unexpected n_in %d / ws_size %zu\n", n_in, ws_size);
    }
    hipMemsetAsync((unsigned char*)d_ws + WS_CTL, 0, 196608, stream);
    Params p{};
    for (int i = 0; i < 29; ++i) p.in[i] = (const float*)d_in[i];
    p.out = (float*)d_out; p.ws = (unsigned char*)d_ws;
    void* args[] = {&p};
    hipError_t e = hipLaunchCooperativeKernel((const void*)fwd_megakernel, dim3(grid_blocks), dim3(NTHREADS), args, LDS_BYTES, stream);
    if (e != hipSuccess) fprintf(stderr, "cooperative launch failed: %s (grid %d)\n", hipGetErrorString(e), grid_blocks);
}
```

```cpp
#include <hip/hip_runtime.h>
#include <hip/hip_cooperative_groups.h>
#include <cstdio>
#include <cstdint>
#include <cmath>
namespace cg = cooperative_groups;
__device__ __forceinline__ int fresh_tid() { int t = threadIdx.x; asm volatile("" : "+v"(t)); return t; }
namespace pg8 {
#define PG8_LAS __attribute__((address_space(3)))
typedef unsigned short bf16_t;
typedef short bf16x8 __attribute__((ext_vector_type(8)));
typedef float f32x4 __attribute__((ext_vector_type(4)));
typedef unsigned u32x4 __attribute__((ext_vector_type(4)));
constexpr int BM = 256, BK = 64, HALF = 128, HTB = HALF * BK * 2  , STAGE_BYTES = 8 * HTB, NXCD = 8, WGM = 8;

__host__ __device__ __forceinline__ int lds_byte(int r, int c) { const int st = (r >> 4) * 2 + (c >> 5), rr = r & 15, cc = c & 31, ob = rr * 64 + cc * 2; return st * 1024 + (ob ^ (((ob >> 9) & 1) << 5)); }
__host__ __device__ __forceinline__ void stage_rc(int b, int& R, int& C) { const int st = b / 1024, sb = b % 1024, swz = sb ^ (((sb >> 9) & 1) << 5); R = (st >> 1) * 16 + swz / 64; C = (st & 1) * 32 + (swz % 64) / 2; }
__host__ __device__ __forceinline__ int perm32(int rho) { const int n = rho >> 4, i = rho & 15; return 8 * (i >> 2) + 4 * n + (i & 3); }

struct Unit { int pm, pn; };
struct Gemm { const bf16_t* A; const bf16_t* Bt; int M, N, K; const bf16_t* A2; int pm2; };
__device__ __forceinline__ const char* gemm_abase(const Gemm& g, int pm, size_t tstep) { return pm >= g.pm2 ? (const char*)g.A2 + (size_t)(pm - g.pm2) * tstep : (const char*)g.A + (size_t)pm * tstep; }

struct StaticOrder {
    int nM, nN, nwg, G, c;
    __host__ __device__ void init(int M, int N, int G_, int c_) { nM = M / BM; nN = N / BM; nwg = nM * nN; G = G_; c = c_; }
    __host__ __device__ bool next(int i, Unit& u) const {
        const long L = (long)i * G + c; if (L >= nwg) return false;
        int wgid = (int)L; { const int q = nwg / NXCD, r = nwg % NXCD, xcd = wgid % NXCD, off = wgid / NXCD; wgid = (xcd < r ? xcd * (q + 1) : r * (q + 1) + (xcd - r) * q) + off; }
        const int nig = WGM * nN, gid = wgid / nig, fm = gid * WGM, gsz = (nM - fm) < WGM ? (nM - fm) : WGM;
        u.pm = fm + ((wgid % nig) % gsz); u.pn = (wgid % nig) / gsz; return true;
    }
    __device__ __forceinline__ void a_ready(const Unit&) const {}
    __device__ __forceinline__ void done(const Unit&) const {}
};


template <class Epi, class Sched, bool ALIGN_EPI = false, bool SP2 = false>
__device__ __forceinline__ void gemm_phase(PG8_LAS unsigned char* lds, const Gemm g, const Sched& S, const Epi& E) {
    const int tid = fresh_tid(), wid = __builtin_amdgcn_readfirstlane(tid >> 6), lane = tid & 63, wr = wid >> 2, wc = wid & 3, fr = lane & 15, fq = lane >> 4;
    const int K = g.K, nt = K / BK;
    unsigned voffA[2], voffB[2];
#pragma unroll
    for (int i = 0; i < 2; ++i) { int R, C; stage_rc(tid * 16 + i * 8192, R, C); const int Rb = Epi::PERM ? ((R & ~31) + perm32(R & 31)) : R;
        voffA[i] = (unsigned)(R * K + C) * 2u; voffB[i] = (unsigned)(Rb * K + C) * 2u; }
    const size_t kstep = (size_t)(BK * 2);
    const size_t hstep = (size_t)HALF * K * 2;
    const size_t tstep = 2 * hstep;
    const unsigned ldsw = (unsigned)wid * 1024u;
    const int aoff = lds_byte(wr * 64 + fr, fq * 8), boff = lds_byte(wc * 32 + fr, fq * 8);
#define PG8_SA(b, h) (((b) * 2 + (h)) * HTB)
#define PG8_SB(b, h) ((4 + (b) * 2 + (h)) * HTB)
#define PG8_STAGE(bufoff, gbase, voff) do { _Pragma("unroll") for (int _i = 0; _i < 2; ++_i) \
        __builtin_amdgcn_global_load_lds((const unsigned*)((const char*)(gbase) + (voff)[_i]), (PG8_LAS unsigned*)(lds + (bufoff) + ldsw + _i * 8192), 16, 0, 0); } while (0)
#define PG8_LDA(dst, b, h) do { _Pragma("unroll") for (int m = 0; m < 4; ++m) _Pragma("unroll") for (int k = 0; k < 2; ++k) dst[m][k] = *(const PG8_LAS bf16x8*)(lds + PG8_SA(b, h) + aoff + m * 2048 + k * 1024); } while (0)
#define PG8_LDB(dst, b, h) do { _Pragma("unroll") for (int n = 0; n < 2; ++n) _Pragma("unroll") for (int k = 0; k < 2; ++k) dst[n][k] = *(const PG8_LAS bf16x8*)(lds + PG8_SB(b, h) + boff + n * 2048 + k * 1024); } while (0)
#define PG8_MMA(ai, bj, At, Bt) do { __builtin_amdgcn_s_setprio(1); _Pragma("unroll") for (int m = 0; m < 4; ++m) _Pragma("unroll") for (int n = 0; n < 2; ++n) _Pragma("unroll") for (int k = 0; k < 2; ++k) \
        acc[ai][bj][m][n] = __builtin_amdgcn_mfma_f32_16x16x32_bf16(Bt[n][k], At[m][k], acc[ai][bj][m][n], 0, 0, 0); __builtin_amdgcn_s_setprio(0); } while (0)
#define PG8_WAIT_V(n) asm volatile("s_waitcnt vmcnt(" #n ")" ::: "memory")
#define PG8_WAIT_L(n) asm volatile("s_waitcnt lgkmcnt(" #n ")" ::: "memory")
#define PG8_BAR __builtin_amdgcn_s_barrier()
#define PG8_SCHED __builtin_amdgcn_sched_barrier(0)
    Unit cur, nxt; int ui = 0;
    if (!S.next(0, cur)) return;
    f32x4 acc[2][2][4][2];
#pragma unroll
    for (int a = 0; a < 2; ++a)
#pragma unroll
        for (int b = 0; b < 2; ++b)
#pragma unroll
            for (int m = 0; m < 4; ++m)
#pragma unroll
                for (int n = 0; n < 2; ++n) acc[a][b][m][n] = (f32x4){0.f, 0.f, 0.f, 0.f};
    bf16x8 At[4][2], B0[2][2], B1[2][2];
    const char* cA = gemm_abase(g, cur.pm, tstep); const char* cB = (const char*)g.Bt + (size_t)cur.pn * tstep;
    S.a_ready(cur);
    if constexpr (SP2) {
        PG8_STAGE(PG8_SB(0, 0), cB, voffB); PG8_STAGE(PG8_SB(0, 1), cB + hstep, voffB); PG8_STAGE(PG8_SA(0, 0), cA, voffA); PG8_STAGE(PG8_SA(0, 1), cA + hstep, voffA);
        if (wr == 1) PG8_BAR;
        PG8_WAIT_V(2); PG8_BAR;
        PG8_STAGE(PG8_SB(1, 0), cB + kstep, voffB); PG8_STAGE(PG8_SA(1, 0), cA + kstep, voffA); PG8_STAGE(PG8_SB(1, 1), cB + hstep + kstep, voffB);
        PG8_WAIT_V(6); PG8_BAR;
    } else {
        PG8_STAGE(PG8_SB(0, 0), cB, voffB); PG8_STAGE(PG8_SA(0, 0), cA, voffA); PG8_STAGE(PG8_SB(0, 1), cB + hstep, voffB); PG8_STAGE(PG8_SA(0, 1), cA + hstep, voffA);
        if (wr == 1) PG8_BAR;
        PG8_WAIT_V(4); PG8_BAR;
        PG8_STAGE(PG8_SB(1, 0), cB + kstep, voffB); PG8_STAGE(PG8_SA(1, 0), cA + kstep, voffA); PG8_STAGE(PG8_SB(1, 1), cB + hstep + kstep, voffB);
        PG8_WAIT_V(6); PG8_BAR;
    }
    for (;;) {
        const bool has_next = S.next(ui + 1, nxt);
        const char* nA = has_next ? gemm_abase(g, nxt.pm, tstep) : cA; const char* nB = has_next ? (const char*)g.Bt + (size_t)nxt.pn * tstep : cB;
        for (int t = 0; t < nt; t += 2) {
            const bool last = (t == nt - 2);
            const char* a1 = cA + (size_t)(t + 1) * kstep;
            const char* a2 = last ? nA : cA + (size_t)(t + 2) * kstep; const char* b2 = last ? nB : cB + (size_t)(t + 2) * kstep;
            const char* a3 = a2 + kstep; const char* b3 = b2 + kstep;
            if (last && has_next) S.a_ready(nxt);
            if constexpr (SP2) {
            PG8_LDB(B0, 0, 0); PG8_LDB(B1, 0, 1); PG8_SCHED; PG8_LDA(At, 0, 0); PG8_STAGE(PG8_SA(1, 1), a1 + hstep, voffA);
            PG8_WAIT_V(8); PG8_WAIT_L(0); PG8_BAR; PG8_MMA(0, 0, At, B0); PG8_MMA(0, 1, At, B1); PG8_BAR; PG8_SCHED;
            PG8_LDA(At, 0, 1); PG8_STAGE(PG8_SB(0, 0), b2, voffB); PG8_STAGE(PG8_SB(0, 1), b2 + hstep, voffB); PG8_STAGE(PG8_SA(0, 0), a2, voffA);
            PG8_WAIT_V(8); PG8_WAIT_L(0); PG8_BAR; PG8_MMA(1, 0, At, B0); PG8_MMA(1, 1, At, B1); PG8_BAR; PG8_SCHED;
            PG8_LDB(B0, 1, 0); PG8_LDB(B1, 1, 1); PG8_SCHED; PG8_LDA(At, 1, 0); PG8_STAGE(PG8_SA(0, 1), a2 + hstep, voffA);
            PG8_WAIT_V(8); PG8_WAIT_L(0); PG8_BAR; PG8_MMA(0, 0, At, B0); PG8_MMA(0, 1, At, B1); PG8_BAR; PG8_SCHED;
            PG8_LDA(At, 1, 1); PG8_STAGE(PG8_SB(1, 0), b3, voffB); PG8_STAGE(PG8_SB(1, 1), b3 + hstep, voffB); PG8_STAGE(PG8_SA(1, 0), a3, voffA);
            PG8_WAIT_V(8); PG8_WAIT_L(0); PG8_BAR; PG8_MMA(1, 0, At, B0); PG8_MMA(1, 1, At, B1); PG8_BAR; PG8_SCHED;
            } else {
            PG8_LDB(B0, 0, 0); PG8_SCHED; PG8_LDA(At, 0, 0); PG8_STAGE(PG8_SA(1, 1), a1 + hstep, voffA);
            PG8_WAIT_L(8); PG8_BAR; PG8_WAIT_L(0); PG8_MMA(0, 0, At, B0); PG8_BAR; PG8_SCHED;
            PG8_LDB(B1, 0, 1); PG8_STAGE(PG8_SB(0, 0), b2, voffB);
            PG8_BAR; PG8_WAIT_L(0); PG8_MMA(0, 1, At, B1); PG8_BAR;
            PG8_LDA(At, 0, 1); PG8_STAGE(PG8_SA(0, 0), a2, voffA);
            PG8_BAR; PG8_WAIT_L(0); PG8_MMA(1, 0, At, B0); PG8_BAR; PG8_SCHED;
            PG8_STAGE(PG8_SB(0, 1), b2 + hstep, voffB);
            PG8_WAIT_V(6); PG8_BAR; PG8_MMA(1, 1, At, B1); PG8_BAR;
            PG8_LDB(B0, 1, 0); PG8_SCHED; PG8_LDA(At, 1, 0); PG8_STAGE(PG8_SA(0, 1), a2 + hstep, voffA);
            PG8_WAIT_L(8); PG8_BAR; PG8_WAIT_L(0); PG8_MMA(0, 0, At, B0); PG8_BAR; PG8_SCHED;
            PG8_LDB(B1, 1, 1); PG8_STAGE(PG8_SB(1, 0), b3, voffB);
            PG8_BAR; PG8_WAIT_L(0); PG8_MMA(0, 1, At, B1); PG8_BAR;
            PG8_LDA(At, 1, 1); PG8_STAGE(PG8_SA(1, 0), a3, voffA);
            PG8_BAR; PG8_WAIT_L(0); PG8_MMA(1, 0, At, B0); PG8_BAR; PG8_SCHED;
            PG8_STAGE(PG8_SB(1, 1), b3 + hstep, voffB);
            PG8_WAIT_V(6); PG8_BAR; PG8_MMA(1, 1, At, B1); PG8_BAR;
            }
        }
        if constexpr (ALIGN_EPI) { if (wr == 0) PG8_BAR; }
        if constexpr (!Epi::AFTER_DRAIN) { E(acc, cur, wr, wc, fr, fq); S.done(cur); }
        if (!has_next) break;
#pragma unroll
        for (int a = 0; a < 2; ++a)
#pragma unroll
            for (int b = 0; b < 2; ++b)
#pragma unroll
                for (int m = 0; m < 4; ++m)
#pragma unroll
                    for (int n = 0; n < 2; ++n) acc[a][b][m][n] = (f32x4){0.f, 0.f, 0.f, 0.f};
        cur = nxt; cA = nA; cB = nB; ++ui;
        if constexpr (ALIGN_EPI) { if (wr == 1) PG8_BAR; }
    }
    PG8_WAIT_V(0);
    if constexpr (!ALIGN_EPI) { if (wr == 0) PG8_BAR; }
    PG8_BAR;
    if constexpr (Epi::AFTER_DRAIN) { E.fused(acc, cur, wr, wc, fr, fq, lds, wid, lane); S.done(cur); }
#undef PG8_SA
#undef PG8_SB
#undef PG8_STAGE
#undef PG8_LDA
#undef PG8_LDB
#undef PG8_MMA
#undef PG8_WAIT_V
#undef PG8_WAIT_L
#undef PG8_BAR
#undef PG8_SCHED
}
}

#ifndef PG8_SP2
#define PG8_SP2 true
#endif

#define LAS __attribute__((address_space(3)))
typedef unsigned short bf16;
typedef short bf16x8 __attribute__((ext_vector_type(8)));
typedef float f32x4 __attribute__((ext_vector_type(4)));
typedef float f32x16 __attribute__((ext_vector_type(16)));
typedef unsigned u32x4 __attribute__((ext_vector_type(4)));
typedef unsigned u32x2 __attribute__((ext_vector_type(2)));

constexpr int DM = 1024, NMAIN = 32768, ROWS = 33024, METAROW = 32768, DFF = 4096;
constexpr int NTHREADS = 512;
constexpr int LDS_BYTES = 147456;
constexpr int LDS_ITEM_OFF = LDS_BYTES - 16;
constexpr size_t MiB = 1u << 20;
constexpr size_t WS_CTL = 0, WS_WIN = 1 * MiB, WS_WUPA = 12 * MiB, WS_WUPB = 13 * MiB, WS_WOUT = 14 * MiB, WS_WFF1 = 16 * MiB, WS_WFF2 = 24 * MiB;
constexpr size_t WS_LORA = 32 * MiB, WS_XNMETA = 32 * MiB + 512 * 1024, WS_CB = 33 * MiB, WS_ACT = 36 * MiB;
constexpr size_t ACT_SZ = (size_t)ROWS * 512 * 2, L_SZ = (size_t)ROWS * 256 * 2;
constexpr size_t WS_R = WS_ACT, WS_KA = WS_R + ACT_SZ, WS_VA = WS_KA + ACT_SZ, WS_L = WS_VA + ACT_SZ, WS_Q = WS_L + L_SZ, WS_KB = WS_Q + ACT_SZ, WS_VT = WS_KB + ACT_SZ, WS_END = WS_VT + ACT_SZ;
constexpr size_t WS_GA = WS_KA, WS_GB = WS_KB, WS_MN = WS_ACT, WS_HID = WS_ACT + 64 * MiB;
constexpr size_t WS_SS = 65536;
constexpr size_t WS_HALO = WS_END;
constexpr int HALO_ROW = 3584;
static_assert(WS_HALO + (size_t)(NMAIN / 64) * 2 * HALO_ROW <= 256 * MiB, "halo buffer");
static_assert(WS_END <= 256 * MiB && WS_HID + 128 * MiB <= 256 * MiB && WS_CB + (size_t)2 * ROWS * 8 * 4 <= WS_ACT, "ws map");
constexpr float LOG2E = 1.4426950408889634f;
constexpr float QSCALE = 0.125f * LOG2E;

struct Params { const float* in[29]; float* out; unsigned char* ws; };
typedef const __attribute__((address_space(4))) Params* KP;
enum { I_XP = 0, I_XS, I_META, I_GMIX, I_WIN, I_MUP, I_MUN, I_W0, I_WUP, I_A0, I_AUP, I_GUP, I_KK, I_KA, I_RK, I_LNW, I_LNB, I_LQ1, I_LK1, I_LQ2, I_LK2, I_SUBG, I_UPA, I_UPB, I_WOUT, I_GFFN, I_FF1, I_FF2, I_GFIN };

typedef float cvt_f32x2 __attribute__((ext_vector_type(2))); typedef __bf16 cvt_bf16x2 __attribute__((ext_vector_type(2)));
__device__ __forceinline__ unsigned cvtpk(float lo, float hi) { const cvt_f32x2 v = {lo, hi}; const cvt_bf16x2 b = __builtin_convertvector(v, cvt_bf16x2); return __builtin_bit_cast(unsigned, b); }
__device__ __forceinline__ float bf2f(unsigned short b) { return __uint_as_float(((unsigned)b) << 16); }
__device__ __forceinline__ float bflo(unsigned w) { return __uint_as_float(w << 16); }
__device__ __forceinline__ float bfhi(unsigned w) { return __uint_as_float(w & 0xffff0000u); }
__device__ __forceinline__ void unpack8(const u32x4 v, float* o) { o[0] = bflo(v.x); o[1] = bfhi(v.x); o[2] = bflo(v.y); o[3] = bfhi(v.y); o[4] = bflo(v.z); o[5] = bfhi(v.z); o[6] = bflo(v.w); o[7] = bfhi(v.w); }
__device__ __forceinline__ float wave_sum(float v) {
#pragma unroll
    for (int o = 1; o < 64; o <<= 1) v += __shfl_xor(v, o);
    return v;
}
__device__ __forceinline__ float sigmoidf_(float x) { return __builtin_amdgcn_rcpf(1.0f + __builtin_amdgcn_exp2f(-LOG2E * x)); }
__device__ __forceinline__ int seq_base(int s) { return s == 0 ? 0 : 16384 + (s - 1) * 2048; }
__device__ __forceinline__ int seq_len(int s) { return s == 0 ? 16384 : 2048; }
__device__ __forceinline__ int pos_row(int base, int p) { return p < 16 ? METAROW + p : base + p - 16; }

template <class Op> struct Epi8 {
    static constexpr bool PERM = true, AFTER_DRAIN = false;
    Op op;
    __device__ __forceinline__ void operator()(const pg8::f32x4 (&acc)[2][2][4][2], const pg8::Unit& u, int wr, int wc, int fr, int fq) const {
        const int row0 = u.pm * 256 + wr * 64 + fr, col0 = u.pn * 256 + wc * 32 + 8 * fq;
#pragma unroll
        for (int ai = 0; ai < 2; ++ai)
#pragma unroll
            for (int m = 0; m < 4; ++m)
#pragma unroll
                for (int bj = 0; bj < 2; ++bj) { op.apply(row0 + ai * 128 + m * 16, col0 + bj * 128, u.pn, acc[ai][bj][m][0], acc[ai][bj][m][1]); asm volatile("" ::: "memory"); }
    }
};
__device__ __forceinline__ u32x4 pack8(const f32x4 a, const f32x4 b) { u32x4 w; w.x = cvtpk(a[0], a[1]); w.y = cvtpk(a[2], a[3]); w.z = cvtpk(b[0], b[1]); w.w = cvtpk(b[2], b[3]); return w; }

constexpr int CW_KN = 320;
__device__ __forceinline__ float dpp_max16(float v) {
    int x = __float_as_int(v);
    v = fmaxf(v, __int_as_float(__builtin_amdgcn_update_dpp(0, x, 0xB1, 0xf, 0xf, true))); x = __float_as_int(v);
    v = fmaxf(v, __int_as_float(__builtin_amdgcn_update_dpp(0, x, 0x4E, 0xf, 0xf, true))); x = __float_as_int(v);
    v = fmaxf(v, __int_as_float(__builtin_amdgcn_update_dpp(0, x, 0x141, 0xf, 0xf, true))); x = __float_as_int(v);
    v = fmaxf(v, __int_as_float(__builtin_amdgcn_update_dpp(0, x, 0x140, 0xf, 0xf, true)));
    return v;
}
struct OpProj {
    unsigned char* ws;
    __device__ __forceinline__ void apply(int row, int col, int pn, f32x4 v0, f32x4 v1) const {
        if (pn >= 11) {
            bf16* VT = (bf16*)(ws + WS_VT); const int c = col - 11 * 256;
#pragma unroll
            for (int e = 0; e < 4; ++e) { bf16* vt = VT + ((size_t)(row >> 6) * 512 + c) * 64 + (row & 63);
                vt[e * 64] = (bf16)(cvtpk(v0[e], 0.f) & 0xffffu); vt[(4 + e) * 64] = (bf16)(cvtpk(v1[e], 0.f) & 0xffffu); }
            return;
        }
        bf16* O; int ldc = 512, c;
        if (pn < 2) { O = (bf16*)(ws + WS_R); c = col; }
        else if (pn < 4) { O = (bf16*)(ws + WS_KA); c = col - 512; }
        else if (pn < 6) { O = (bf16*)(ws + WS_VA); c = col - 1024; }
        else if (pn < 7) { O = (bf16*)(ws + WS_L); c = col - 1536; ldc = 256; }
        else if (pn < 9) { O = (bf16*)(ws + WS_Q); c = col - 1792; v0 = v0 * QSCALE; v1 = v1 * QSCALE; }
        else { O = (bf16*)(ws + WS_KB); c = col - 2304; }
        const u32x4 w = pack8(v0, v1);
        *(u32x4*)(O + (size_t)row * ldc + c) = w;
        if (pn >= 9) {
            float k8[8]; unpack8(w, k8); float ss = 0.f;
#pragma unroll
            for (int e = 0; e < 8; ++e) ss = fmaf(k8[e], k8[e], ss);
            ss = dpp_max16(ss);
            if ((threadIdx.x & 15) == 0) { const int sidx = row < 16384 ? 0 : row < NMAIN ? 1 + ((row - 16384) >> 11) : 9;
                atomicMax((unsigned*)(ws + WS_CTL) + CW_KN + sidx * 64 + (c >> 3), __float_as_uint(ss)); }
        }
    }
};
struct OpGate {
    bf16* O;
    __device__ __forceinline__ void apply(int row, int col, int pn, f32x4 v0, f32x4 v1) const {
        const int c = col;
#pragma unroll
        for (int e = 0; e < 4; ++e) { v0[e] = sigmoidf_(v0[e]); v1[e] = sigmoidf_(v1[e]); }
        *(u32x4*)(O + (size_t)row * 1024 + c) = pack8(v0, v1);
    }
};
struct OpUpA {
    unsigned char* ws;
    __device__ __forceinline__ void apply(int row, int col, int pn, f32x4 v0, f32x4 v1) const {
        u32x4* p = (u32x4*)((bf16*)(ws + WS_GA) + (size_t)row * 1024 + col); float g[8]; unpack8(*p, g);
#pragma unroll
        for (int e = 0; e < 4; ++e) { v0[e] *= g[e]; v1[e] *= g[4 + e]; }
        *p = pack8(v0, v1);
    }
};
struct OpUpB {
    unsigned char* ws;
    __device__ __forceinline__ void apply(int row, int col, int pn, f32x4 v0, f32x4 v1) const {
        u32x4* p = (u32x4*)((bf16*)(ws + WS_GB) + (size_t)row * 1024 + col); float g[8], a[8]; unpack8(*p, g);
        unpack8(*(const u32x4*)((const bf16*)(ws + WS_GA) + (size_t)row * 1024 + col), a);
#pragma unroll
        for (int e = 0; e < 4; ++e) { v0[e] = a[e] + v0[e] * g[e]; v1[e] = a[4 + e] + v1[e] * g[4 + e]; }
        *p = pack8(v0, v1);
    }
};
struct OpOut {
    const float* xp; const float* xs; float* out; const float* gf; bf16* mn; float* ss;
    __device__ __forceinline__ void apply(int row, int col, int pn, f32x4 v0, f32x4 v1) const {
        const float* x = (row < 16384 ? xp + (size_t)row * DM : xs + (size_t)(row - 16384) * DM) + col;
        float* o = out + (size_t)row * DM + col;
        const f32x4 h0 = *(const f32x4*)x + v0, h1 = *(const f32x4*)(x + 4) + v1;
        *(f32x4*)o = h0; *(f32x4*)(o + 4) = h1;
        const f32x4 g0 = *(const f32x4*)(gf + col), g1 = *(const f32x4*)(gf + col + 4);
        *(u32x4*)(mn + (size_t)row * DM + col) = pack8(h0 * g0, h1 * g1);
        float q = (h0[0] * h0[0] + h0[1] * h0[1]) + (h0[2] * h0[2] + h0[3] * h0[3]) + (h1[0] * h1[0] + h1[1] * h1[1]) + (h1[2] * h1[2] + h1[3] * h1[3]);
        { const auto r = __builtin_amdgcn_permlane16_swap(__float_as_uint(q), __float_as_uint(q), false, false); q = __uint_as_float(r[0]) + __uint_as_float(r[1]); }
        { const auto r = __builtin_amdgcn_permlane32_swap(__float_as_uint(q), __float_as_uint(q), false, false); q = __uint_as_float(r[0]) + __uint_as_float(r[1]); }
        if ((threadIdx.x & 63) < 16) atomicAdd(ss + row, q);
    }
};
struct OpFF1 {
    bf16* hid; const float* ss;
    __device__ __forceinline__ void apply(int row, int col, int pn, f32x4 v0, f32x4 v1) const {
        const float rs2 = __builtin_amdgcn_rcpf(ss[row] * (1.0f / DM) + 1e-6f);
#pragma unroll
        for (int e = 0; e < 4; ++e) { const float a = fmaxf(v0[e], 0.f), b = fmaxf(v1[e], 0.f); v0[e] = a * a * rs2; v1[e] = b * b * rs2; }
        *(u32x4*)(hid + (size_t)row * DFF + col) = pack8(v0, v1);
    }
};
struct OpFF2 {
    float* out;
    __device__ __forceinline__ void apply(int row, int col, int pn, f32x4 v0, f32x4 v1) const {
        float* o = out + (size_t)row * DM + col;
        *(f32x4*)o = *(const f32x4*)o + v0; *(f32x4*)(o + 4) = *(const f32x4*)(o + 4) + v1;
    }
};

__device__ __forceinline__ unsigned f2bf_rne(float f) { return cvtpk(f, 0.f) & 0xffffu; }
__device__ __forceinline__ void transpose_item(const float* W, int K, int N, bf16* WT, LAS float* scr, int item, int lane) {
    const int nblk = N / 32, kb = item / nblk, nb = item % nblk, k0 = 64 * kb, n0 = 32 * nb;
#pragma unroll 8
    for (int i = 0; i < 32; ++i) { const int kk = 2 * i + (lane >> 5); scr[kk * 33 + (lane & 31)] = W[(size_t)(k0 + kk) * N + n0 + (lane & 31)]; }
    asm volatile("s_waitcnt vmcnt(0) lgkmcnt(0)" ::: "memory");
    const int c = lane & 7;
#pragma unroll
    for (int j = 0; j < 4; ++j) { const int n = (lane >> 3) + 8 * j; const LAS float* s = scr + (8 * c) * 33 + n;
        u32x4 o; o.x = cvtpk(s[0 * 33], s[1 * 33]); o.y = cvtpk(s[2 * 33], s[3 * 33]); o.z = cvtpk(s[4 * 33], s[5 * 33]); o.w = cvtpk(s[6 * 33], s[7 * 33]);
        *(u32x4*)(WT + (size_t)(n0 + n) * K + k0 + 8 * c) = o; }
    asm volatile("s_waitcnt lgkmcnt(0)" ::: "memory");
}
__device__ __forceinline__ void rms_row_bf16(const float* src, const float* g, bf16* dst, int lane) {
    unsigned long long* o8 = (unsigned long long*)dst + lane;
    if (!src) {
#pragma unroll
        for (int j = 0; j < 4; ++j) o8[64 * j] = 0ull;
        return; }
    const f32x4* xr = (const f32x4*)src + lane; const f32x4* gr = (const f32x4*)g + lane;
    f32x4 v[4]; float s = 0.f;
#pragma unroll
    for (int j = 0; j < 4; ++j) { v[j] = xr[64 * j]; s += (v[j].x * v[j].x + v[j].y * v[j].y) + (v[j].z * v[j].z + v[j].w * v[j].w); }
    const float rstd = rsqrtf(wave_sum(s) * (1.f / DM) + 1e-6f);
#pragma unroll
    for (int j = 0; j < 4; ++j) { const f32x4 gg = gr[64 * j]; const f32x4 y = v[j] * rstd * gg;
        o8[64 * j] = (unsigned long long)cvtpk(y.x, y.y) | ((unsigned long long)cvtpk(y.z, y.w) << 32); }
}
__device__ __forceinline__ void phase_prologue(LAS unsigned char* lds, KP P) {
    const int tid = fresh_tid(), lane = tid & 63, wid = tid >> 6;
    LAS float* scr = (LAS float*)(lds + wid * 16384);
    const int gw = blockIdx.x * 8 + wid, NGW = gridDim.x * 8;
    unsigned char* ws = P->ws;
    constexpr int I_IN = (1024 / 64) * (5376 / 32), I_UP = (512 / 64) * (1024 / 32), I_O = (1024 / 64) * (1024 / 32), I_1 = (1024 / 64) * (4096 / 32), I_2 = (4096 / 64) * (1024 / 32);
    constexpr int I_LW = (64 / 64) * (512 / 32), I_G = (128 / 64) * (512 / 32);
    constexpr int NITEMS = I_IN + 2 * I_UP + I_O + I_1 + I_2 + 4 * I_LW + I_G;
    for (int it = gw; it < NITEMS; it += NGW) {
        int r = it;
        if (r < I_IN) { transpose_item(P->in[I_WIN], 1024, 5376, (bf16*)(ws + WS_WIN), scr, r, lane); continue; } r -= I_IN;
        if (r < I_UP) { transpose_item(P->in[I_UPA], 512, 1024, (bf16*)(ws + WS_WUPA), scr, r, lane); continue; } r -= I_UP;
        if (r < I_UP) { transpose_item(P->in[I_UPB], 512, 1024, (bf16*)(ws + WS_WUPB), scr, r, lane); continue; } r -= I_UP;
        if (r < I_O) { transpose_item(P->in[I_WOUT], 1024, 1024, (bf16*)(ws + WS_WOUT), scr, r, lane); continue; } r -= I_O;
        if (r < I_1) { transpose_item(P->in[I_FF1], 1024, 4096, (bf16*)(ws + WS_WFF1), scr, r, lane); continue; } r -= I_1;
        if (r < I_2) { transpose_item(P->in[I_FF2], 4096, 1024, (bf16*)(ws + WS_WFF2), scr, r, lane); continue; } r -= I_2;
        if (r < 2 * I_LW) { const int d = r / I_LW; transpose_item(P->in[I_WUP] + (size_t)d * 64 * 512, 64, 512, (bf16*)(ws + WS_LORA) + (size_t)d * 512 * 64, scr, r % I_LW, lane); continue; } r -= 2 * I_LW;
        if (r < 2 * I_LW) { const int d = r / I_LW; transpose_item(P->in[I_AUP] + (size_t)d * 64 * 512, 64, 512, (bf16*)(ws + WS_LORA + 131072) + (size_t)d * 512 * 64, scr, r % I_LW, lane); continue; } r -= 2 * I_LW;
        transpose_item(P->in[I_GUP], 128, 512, (bf16*)(ws + WS_LORA + 262144), scr, r, lane);
    }
    bf16* XN = (bf16*)P->out; bf16* XM = (bf16*)(ws + WS_XNMETA);
#define XN_SRC(m_) ((m_) < 16384 ? P->in[I_XP] + (size_t)(m_) * DM : (m_) < NMAIN ? P->in[I_XS] + (size_t)((m_) - 16384) * DM : ((m_) - NMAIN < 16 ? P->in[I_META] + (size_t)((m_) - NMAIN) * DM : nullptr))
#define XN_DST(m_) ((m_) < NMAIN ? XN + (size_t)(m_) * DM : XM + (size_t)((m_) - NMAIN) * DM)
    for (int m = gw; m < ROWS; m += 2 * NGW) {
        const int m2 = m + NGW; const bool ok2 = m2 < ROWS;
        const float* s0 = XN_SRC(m); const float* s1 = ok2 ? XN_SRC(m2) : nullptr;
        if (s0 && s1) {
            const f32x4* x0 = (const f32x4*)s0 + lane; const f32x4* x1 = (const f32x4*)s1 + lane; const f32x4* gr = (const f32x4*)P->in[I_GMIX] + lane;
            unsigned long long* o0 = (unsigned long long*)XN_DST(m) + lane; unsigned long long* o1 = (unsigned long long*)XN_DST(m2) + lane;
            f32x4 v[4], w[4]; float a = 0.f, b = 0.f;
#pragma unroll
            for (int j = 0; j < 4; ++j) { v[j] = x0[64 * j]; w[j] = x1[64 * j]; }
#pragma unroll
            for (int j = 0; j < 4; ++j) { a += (v[j].x * v[j].x + v[j].y * v[j].y) + (v[j].z * v[j].z + v[j].w * v[j].w); b += (w[j].x * w[j].x + w[j].y * w[j].y) + (w[j].z * w[j].z + w[j].w * w[j].w); }
            const float r0 = rsqrtf(wave_sum(a) * (1.f / DM) + 1e-6f), r1 = rsqrtf(wave_sum(b) * (1.f / DM) + 1e-6f);
#pragma unroll
            for (int j = 0; j < 4; ++j) { const f32x4 gg = gr[64 * j]; const f32x4 y = v[j] * r0 * gg, z = w[j] * r1 * gg;
                o0[64 * j] = (unsigned long long)cvtpk(y.x, y.y) | ((unsigned long long)cvtpk(y.z, y.w) << 32);
                o1[64 * j] = (unsigned long long)cvtpk(z.x, z.y) | ((unsigned long long)cvtpk(z.z, z.w) << 32); }
        } else {
            rms_row_bf16(s0, P->in[I_GMIX], XN_DST(m), lane);
            if (ok2) rms_row_bf16(s1, P->in[I_GMIX], XN_DST(m2), lane);
        }
    }
#undef XN_SRC
#undef XN_DST
}

constexpr int AT_KSTR = 272, AT_VSTR = 144, AT_KSZ = 64 * AT_KSTR, AT_BUF = AT_KSZ + 128 * AT_VSTR;
__device__ __forceinline__ f32x16 mfma32(bf16x8 a, bf16x8 b, f32x16 c) { return __builtin_amdgcn_mfma_f32_32x32x16_bf16(a, b, c, 0, 0, 0); }
__device__ __forceinline__ void attn_unit(LAS unsigned char* lds, KP P, int s, int h, int qb, float lam) {
    int tid_ = threadIdx.x; asm volatile("" : "+v"(tid_));
    const int tid = tid_, lane = tid & 63, r32 = lane & 31, hi = lane >> 5, wid = __builtin_amdgcn_readfirstlane(tid >> 6), rg = wid & 3, mp = wid >> 2;
    const int L = seq_len(s), base = seq_base(s), NT = 1 + L / 64;
    unsigned char* ws = P->ws;
    const bf16* KB = (const bf16*)(ws + WS_KB); const bf16* VT = (const bf16*)(ws + WS_VT); bf16* Q = (bf16*)(ws + WS_Q);
    const int qrow = base + qb * 128 + rg * 32 + r32;
    bf16x8 q[4];
#pragma unroll
    for (int d0 = 0; d0 < 4; ++d0) q[d0] = *(const bf16x8*)(Q + (size_t)qrow * 512 + h * 128 + mp * 64 + d0 * 16 + hi * 8);
    f32x16 O[4];
#pragma unroll
    for (int b = 0; b < 4; ++b)
#pragma unroll
        for (int r = 0; r < 16; ++r) O[b][r] = 0.f;
    float mx = -INFINITY, ls = 0.f;
    const float qh = (float)(16 + qb * 128 + rg * 32 + r32 - 4 * hi);
    const float nslope = -exp2f(-2.0f * (float)(h + 1)) * LOG2E;
    const int kr0 = tid >> 4, kc = tid & 15, vn0 = tid >> 3, vc = tid & 7;
    u32x4 kreg[2], vreg[2];
    const unsigned kgo = (unsigned)((kr0 * 512 + h * 128 + kc * 8) * 2), vgo = (unsigned)(((h * 128 + vn0) * 64 + vc * 8) * 2);
    const unsigned klo = (unsigned)(kr0 * AT_KSTR + kc * 16), vlo = (unsigned)(AT_KSZ + vn0 * AT_VSTR + vc * 16);
#define AT_GLOAD(j) do { const int m0_ = (j) == 0 ? METAROW : base + 64 * ((j) - 1); \
        const unsigned char* kt_ = (const unsigned char*)KB + (size_t)m0_ * 1024; const unsigned char* vt_ = (const unsigned char*)VT + (size_t)(m0_ >> 6) * (512 * 64 * 2); \
        kreg[0] = *(const u32x4*)(kt_ + kgo); kreg[1] = *(const u32x4*)(kt_ + 32 * 1024 + kgo); \
        vreg[0] = *(const u32x4*)(vt_ + vgo); vreg[1] = *(const u32x4*)(vt_ + 64 * 64 * 2 + vgo); } while (0)
#define AT_LSTORE(buf) do { LAS unsigned char* kb_ = lds + (buf) * AT_BUF; \
        *(LAS u32x4*)(kb_ + klo) = kreg[0]; *(LAS u32x4*)(kb_ + klo + 32 * AT_KSTR) = kreg[1]; \
        *(LAS u32x4*)(kb_ + vlo) = vreg[0]; *(LAS u32x4*)(kb_ + vlo + 64 * AT_VSTR) = vreg[1]; } while (0)
    float qn, kn;
    { float ssq = 0.f;
#pragma unroll
      for (int d0 = 0; d0 < 4; ++d0) { float t[8]; unpack8(__builtin_bit_cast(u32x4, q[d0]), t);
#pragma unroll
        for (int e = 0; e < 8; ++e) ssq = fmaf(t[e], t[e], ssq); }
      ssq += __shfl_xor(ssq, 32); qn = sqrtf(ssq) * 1.002f;
      const unsigned* KN = (const unsigned*)(ws + WS_CTL) + CW_KN; float ks = 0.f;
#pragma unroll
      for (int g = 0; g < 8; ++g) ks += fmaxf(__uint_as_float(__hip_atomic_load(KN + s * 64 + h * 16 + mp * 8 + g, __ATOMIC_RELAXED, __HIP_MEMORY_SCOPE_AGENT)), __uint_as_float(__hip_atomic_load(KN + 9 * 64 + h * 16 + mp * 8 + g, __ATOMIC_RELAXED, __HIP_MEMORY_SCOPE_AGENT)));
      kn = sqrtf(ks) * 1.002f; }
    const int jc0 = 1 + qb * 2;
    int jlo = jc0, jhi = jc0 + 1;
    LAS float* red = (LAS float*)(lds + 2 * AT_BUF);
#pragma unroll 1
    for (int ph = 0; ph < 2; ++ph) {
        int nleft, ntl;
        if (ph == 0) { nleft = 0; ntl = 2; }
        else {
            float dneed = (qn * kn - mx + 40.0f) / (-nslope);
#pragma unroll
            for (int o = 1; o < 64; o <<= 1) dneed = fmaxf(dneed, __shfl_xor(dneed, o));
            if (lane == 0) red[wid] = dneed;
            __syncthreads();
            float dm = red[0];
#pragma unroll
            for (int w8 = 1; w8 < 8; ++w8) dm = fmaxf(dm, red[w8]);
            dm = fminf(fmaxf(dm, 0.f), 1.0e6f);
            const int dmax = (int)dm + 1, q0 = 16 + qb * 128;
            const int plo = q0 - dmax, phi = q0 + 127 + dmax;
            jlo = plo < 16 ? 0 : 1 + ((plo - 16) >> 6); jhi = phi >= L + 16 ? NT - 1 : 1 + ((phi - 16) >> 6);
            if (jlo > jc0) jlo = jc0; if (jhi < jc0 + 1) jhi = jc0 + 1;
            nleft = jc0 - jlo; ntl = nleft + (jhi - jc0 - 1);
        }
        if (ntl > 0) {
#define AT_J(t) (ph == 0 ? jc0 + (t) : ((t) < nleft ? jlo + (t) : jc0 + 2 + ((t) - nleft)))
        { const int jf = AT_J(0); AT_GLOAD(jf); } AT_LSTORE(0); __syncthreads();
#pragma unroll 1
        for (int t = 0; t < ntl; ++t) {
            const int j = AT_J(t);
            if (t + 1 < ntl) { const int jn = AT_J(t + 1); AT_GLOAD(jn); }
            const LAS unsigned char* Kb = lds + (t & 1) * AT_BUF + mp * 128; const LAS unsigned char* Vb = lds + (t & 1) * AT_BUF + AT_KSZ;
            const float dq = qh - (float)(j == 0 ? 0 : 64 * j - 48);
            f32x16 p0, p1;
#pragma unroll
            for (int r = 0; r < 16; ++r) { p0[r] = 0.f; p1[r] = 0.f; }
            {
                bf16x8 ka[4], kb[4];
#pragma unroll
                for (int d0 = 0; d0 < 4; ++d0) { ka[d0] = *(const LAS bf16x8*)(Kb + r32 * AT_KSTR + d0 * 32 + hi * 16); kb[d0] = *(const LAS bf16x8*)(Kb + (32 + r32) * AT_KSTR + d0 * 32 + hi * 16); }
                __builtin_amdgcn_sched_barrier(0);
#pragma unroll
                for (int d0 = 0; d0 < 4; ++d0) { p0 = mfma32(ka[d0], q[d0], p0); p1 = mfma32(kb[d0], q[d0], p1); }
            }
#pragma unroll
            for (int r = 0; r < 16; ++r) { const float dd = dq - (float)((r & 3) + 8 * (r >> 2)); p0[r] = fmaf(fabsf(dd), nslope, p0[r]); p1[r] = fmaf(fabsf(dd - 32.f), nslope, p1[r]); }
            if (j == 0) {
#pragma unroll
                for (int r = 0; r < 16; ++r) { if ((r & 3) + 8 * (r >> 2) + 4 * hi >= 16) p0[r] = -INFINITY; p1[r] = -INFINITY; }
            }
            float rm = fmaxf(p0[0], p1[0]);
#pragma unroll
            for (int r = 1; r < 16; ++r) rm = fmaxf(rm, fmaxf(p0[r], p1[r]));
            rm = fmaxf(rm, __shfl_xor(rm, 32));
            if (__any(rm > mx - 38.0f)) {
            const float mn = fmaxf(mx, rm);
            if (__any(mn > mx)) {
                const float f = __builtin_amdgcn_exp2f(mx - mn); ls *= f; mx = mn;
#pragma unroll
                for (int b = 0; b < 4; ++b)
#pragma unroll
                    for (int r = 0; r < 16; ++r) O[b][r] *= f;
            }
            float sum = 0.f;
#pragma unroll
            for (int r = 0; r < 16; ++r) { p0[r] = __builtin_amdgcn_exp2f(p0[r] - mx); p1[r] = __builtin_amdgcn_exp2f(p1[r] - mx); sum += p0[r] + p1[r]; }
            ls += sum;
            bf16x8 pf[4];
#pragma unroll
            for (int k2 = 0; k2 < 2; ++k2) {
                u32x4 w0, w1;
                w0.x = cvtpk(p0[8 * k2 + 0], p0[8 * k2 + 1]); w0.y = cvtpk(p0[8 * k2 + 2], p0[8 * k2 + 3]); w0.z = cvtpk(p0[8 * k2 + 4], p0[8 * k2 + 5]); w0.w = cvtpk(p0[8 * k2 + 6], p0[8 * k2 + 7]);
                w1.x = cvtpk(p1[8 * k2 + 0], p1[8 * k2 + 1]); w1.y = cvtpk(p1[8 * k2 + 2], p1[8 * k2 + 3]); w1.z = cvtpk(p1[8 * k2 + 4], p1[8 * k2 + 5]); w1.w = cvtpk(p1[8 * k2 + 6], p1[8 * k2 + 7]);
                pf[k2] = __builtin_bit_cast(bf16x8, w0); pf[2 + k2] = __builtin_bit_cast(bf16x8, w1);
            }
            {
                u32x4 vcur[4], vnxt[4];
#define AT_VLOAD(dst, ks_) do { _Pragma("unroll") for (int b_ = 0; b_ < 4; ++b_) { const LAS unsigned char* vp_ = Vb + (b_ * 32 + r32) * AT_VSTR + (ks_) * 32 + hi * 8; \
                    const u32x2 lo_ = *(const LAS u32x2*)vp_, hh_ = *(const LAS u32x2*)(vp_ + 16); dst[b_].x = lo_.x; dst[b_].y = lo_.y; dst[b_].z = hh_.x; dst[b_].w = hh_.y; } } while (0)
                AT_VLOAD(vcur, 0);
#pragma unroll
                for (int ks = 0; ks < 4; ++ks) {
                    if (ks < 3) AT_VLOAD(vnxt, ks + 1);
                    __builtin_amdgcn_sched_barrier(0);
#pragma unroll
                    for (int b = 0; b < 4; ++b) O[b] = mfma32(__builtin_bit_cast(bf16x8, vcur[b]), pf[ks], O[b]);
                    __builtin_amdgcn_sched_barrier(0);
#pragma unroll
                    for (int b = 0; b < 4; ++b) vcur[b] = vnxt[b];
                }
#undef AT_VLOAD
            }
            }
            if (t + 1 < ntl) AT_LSTORE((t + 1) & 1);
            __syncthreads();
        }
#undef AT_J
        }
    }
#undef AT_GLOAD
#undef AT_LSTORE
    const float lt = ls + __shfl_xor(ls, 32);
    const float inv = (mp ? lam : 1.0f) / lt;
    int lane2 = lane; asm volatile("" : "+v"(lane2));
    const int r32e = lane2 & 31, hie = lane2 >> 5;
    LAS float* ex = (LAS float*)lds + rg * (128 * 32) + hie * 128 + r32e;
    if (mp == 1) {
#pragma unroll
        for (int b = 0; b < 4; ++b)
#pragma unroll
            for (int r = 0; r < 16; ++r) ex[(32 * b + (r & 3) + 8 * (r >> 2)) * 32] = O[b][r] * inv;
    }
    __syncthreads();
    if (mp == 0) {
        float ss = 0.f;
#pragma unroll
        for (int b = 0; b < 4; ++b)
#pragma unroll
            for (int r = 0; r < 16; ++r) { const float o = O[b][r] * inv - ex[(32 * b + (r & 3) + 8 * (r >> 2)) * 32]; O[b][r] = o; ss += o * o; }
        ss += __shfl_xor(ss, 32);
        const float rstd = rsqrtf(ss * (1.0f / 128.0f) + 1e-5f) * 0.8f;
        const float* sg = P->in[I_SUBG] + 4 * hie; bf16* Qo = Q + (size_t)(base + qb * 128 + rg * 32 + r32e) * 512 + h * 128 + 4 * hie;
#pragma unroll
        for (int b = 0; b < 4; ++b)
#pragma unroll
            for (int r4 = 0; r4 < 4; ++r4) {
                const int n = 32 * b + 8 * r4; const f32x4 g = *(const f32x4*)(sg + n);
                u32x2 w; w.x = cvtpk(O[b][4 * r4 + 0] * rstd * g.x, O[b][4 * r4 + 1] * rstd * g.y); w.y = cvtpk(O[b][4 * r4 + 2] * rstd * g.z, O[b][4 * r4 + 3] * rstd * g.w);
                *(u32x2*)(Qo + n) = w;
            }
    }
    __syncthreads();
}

constexpr int SC_R = 0, SC_K = 16384, SC_V = 32768, SC_W = 49152, SC_B = 65536, SC_KK = 81920, SC_Y = 98304, SC_TW = 114688, SC_AD = 123904, SC_MU = 133120;
__device__ __forceinline__ float dpp_add(float v, int ctrl_id) {
    const int x = __float_as_int(v); int y;
    if (ctrl_id == 0) y = __builtin_amdgcn_update_dpp(0, x, 0xB1, 0xf, 0xf, true);
    else if (ctrl_id == 1) y = __builtin_amdgcn_update_dpp(0, x, 0x4E, 0xf, 0xf, true);
    else if (ctrl_id == 2) y = __builtin_amdgcn_update_dpp(0, x, 0x141, 0xf, 0xf, true);
    else y = __builtin_amdgcn_update_dpp(0, x, 0x140, 0xf, 0xf, true);
    return v + __int_as_float(y);
}
template <int LPR> __device__ __forceinline__ float grp_sum(float v) {
    v = dpp_add(v, 0); v = dpp_add(v, 1); v = dpp_add(v, 2);
    if (LPR == 16) v = dpp_add(v, 3);
    return v;
}
#define BAR_LDS() asm volatile("s_waitcnt lgkmcnt(0)\n\ts_barrier" ::: "memory")
__device__ __forceinline__ float fast_sigmoid(float x) { return __builtin_amdgcn_rcpf(1.0f + __builtin_amdgcn_exp2f(-LOG2E * x)); }
__device__ __forceinline__ float fast_tanh(float x) { return 1.0f - 2.0f * __builtin_amdgcn_rcpf(1.0f + __builtin_amdgcn_exp2f(2.0f * LOG2E * x)); }
template <int NRP, int NSW>
__device__ __forceinline__ void scan_unit(LAS unsigned char* lds, KP P, int s, int d, int h, int rp) {
    constexpr int RPB = 64 / NRP, RPW = RPB / NSW, LPR = 64 / RPW, CPL = 64 / LPR;
    static_assert(LPR == 8 || LPR == 16, "scan geometry");
    constexpr bool YDB = (RPB == 16) && (NSW == 4);
    constexpr int YST = YDB ? RPB : 64;
    int tid_ = threadIdx.x; asm volatile("" : "+v"(tid_));
    const int tid = tid_, lane = tid & 63, wid = __builtin_amdgcn_readfirstlane(tid >> 6);
    const int L = seq_len(s), base = seq_base(s), Ltot = L + 16, nchunk = (Ltot + 63) / 64;
    unsigned char* ws = P->ws;
    const bf16* Rb = (const bf16*)(ws + WS_R); const bf16* KAb = (const bf16*)(ws + WS_KA); const bf16* VAb = (const bf16*)(ws + WS_VA); const bf16* Lb = (const bf16*)(ws + WS_L);
    float* CB = (float*)(ws + WS_CB); bf16* YD = (bf16*)((unsigned char*)P->out + 64 * MiB) + (size_t)d * NMAIN * 512;
    LAS float* fS = (LAS float*)lds; LAS float* fV = (LAS float*)(lds + 81920); LAS float* fY = (LAS float*)(lds + SC_Y); LAS float* fMU = (LAS float*)(lds + SC_MU);
#define SCI(sl_, a_, c_) ((sl_) * 320 + (a_) * 64 + (c_))
    for (int i = tid; i < 832; i += NTHREADS) {
        float v;
        if (i < 640) { const int which = i / 320, jj = i % 320, a = jj >> 6, c = jj & 63; const int gi = a < 3 ? a * 512 + h * 64 + c : 1536 + (a - 3) * 64 + c; v = P->in[which ? I_MUN : I_MUP][gi]; }
        else { const int a = (i - 640) >> 6, c = (i - 640) & 63; v = P->in[a == 0 ? I_KK : a == 1 ? I_KA : I_RK][h * 64 + c]; }
        fMU[i] = v;
    }
    const int mat = wid >> 2, ntile = wid & 3;
    const bf16* Wt = (const bf16*)(ws + WS_LORA + (mat ? 131072 : 0)) + ((size_t)d * 512 + h * 64 + ntile * 16 + (lane & 15)) * 64 + (lane >> 4) * 8;
    const bf16x8 bfr0 = *(const bf16x8*)Wt, bfr1 = *(const bf16x8*)(Wt + 32);
    const float bias = P->in[mat ? I_A0 : I_W0][d * 512 + h * 64 + ntile * 16 + (lane & 15)];
    float S[CPL];
#pragma unroll
    for (int j = 0; j < CPL; ++j) S[j] = 0.f;
    const int rowl = lane / LPR, kg = lane % LPR, srow = rp * RPB + wid * RPW + rowl;
    const int slot = tid >> 3, cg8 = (tid & 7) * 8;
    u32x4 raw[5][3];
#define SC_META(c) (d ? ((c) == nchunk - 1) : ((c) == 0))
    const unsigned char* HALO0 = ws + WS_HALO + (size_t)(base >> 6) * 2 * HALO_ROW;
#define SC_LOAD(c) do { const int i_ = 64 * (c) + slot; const bool ok_ = i_ < Ltot; const int p_ = d ? Ltot - 1 - i_ : i_; \
        const unsigned zr_ = (unsigned)(METAROW + 64); \
        if (!SC_META(c)) { const unsigned rc_ = ok_ ? (unsigned)(base + p_ - 16) : zr_; \
            _Pragma("unroll") for (int a_ = 0; a_ < 5; ++a_) { const unsigned char* B_ = (const unsigned char*)(a_ == 0 ? Rb : a_ == 1 ? KAb : a_ == 2 ? VAb : Lb); const unsigned ld_ = a_ < 3 ? 1024u : 512u; \
                const unsigned co_ = (unsigned)(((a_ < 3 ? h * 64 : (a_ - 3) * 64) + cg8) * 2); raw[a_][1] = *(const u32x4*)(B_ + (rc_ * ld_ + co_)); } \
        } else { const bool me_ = ok_ && p_ < 16; const bool hn_ = me_ && p_ == 15; \
            const unsigned rc_ = ok_ ? (unsigned)pos_row(base, p_) : zr_, rp_ = (me_ && p_ > 0) ? (unsigned)(METAROW + p_ - 1) : zr_, rn_ = (me_ && p_ < 15) ? (unsigned)(METAROW + p_ + 1) : zr_; \
            _Pragma("unroll") for (int a_ = 0; a_ < 5; ++a_) { const unsigned char* B_ = (const unsigned char*)(a_ == 0 ? Rb : a_ == 1 ? KAb : a_ == 2 ? VAb : Lb); const unsigned ld_ = a_ < 3 ? 1024u : 512u; \
                const unsigned co_ = (unsigned)(((a_ < 3 ? h * 64 : (a_ - 3) * 64) + cg8) * 2); \
                const unsigned ho_ = (unsigned)(((a_ < 3 ? a_ * 512 + h * 64 : 1536 + (a_ - 3) * 64) + cg8) * 2); \
                raw[a_][0] = *(const u32x4*)(B_ + (rp_ * ld_ + co_)); raw[a_][1] = *(const u32x4*)(B_ + (rc_ * ld_ + co_)); \
                const unsigned char* np_ = hn_ ? HALO0 + ho_ : B_ + (rn_ * ld_ + co_); raw[a_][2] = *(const u32x4*)np_; } } } while (0)
    SC_LOAD(0);
    BAR_LDS();
    for (int c = 0; c < nchunk; ++c) {
        const int nvalid = (Ltot - 64 * c) < 64 ? (Ltot - 64 * c) : 64;
        float rv[8], kv[8];
        if (!SC_META(c)) {
            float vv8[8]; unpack8(raw[0][1], rv); unpack8(raw[1][1], kv); unpack8(raw[2][1], vv8);
            { LAS float* dst = fS + SCI(slot, 4, cg8); *(LAS f32x4*)dst = (f32x4){rv[0], rv[1], rv[2], rv[3]}; *(LAS f32x4*)(dst + 4) = (f32x4){rv[4], rv[5], rv[6], rv[7]}; }
            { LAS float* dst = fV + slot * 64 + cg8; *(LAS f32x4*)dst = (f32x4){vv8[0], vv8[1], vv8[2], vv8[3]}; *(LAS f32x4*)(dst + 4) = (f32x4){vv8[4], vv8[5], vv8[6], vv8[7]}; }
            *(LAS u32x4*)(lds + SC_TW + slot * 144 + cg8 * 2) = raw[3][1];
            *(LAS u32x4*)(lds + SC_AD + slot * 144 + cg8 * 2) = raw[4][1];
        } else {
            const int i1 = 64 * c + slot; const int p1 = d ? Ltot - 1 - i1 : i1; const bool me1 = i1 < Ltot && p1 < 16; const float fm = me1 ? 1.0f : 0.0f;
#pragma unroll
            for (int a = 0; a < 5; ++a) {
                float pv[8], cv[8], nv[8], o[8]; unpack8(raw[a][0], pv); unpack8(raw[a][1], cv); unpack8(raw[a][2], nv);
                const f32x4 mp0 = *(const LAS f32x4*)(fMU + a * 64 + cg8), mp1 = *(const LAS f32x4*)(fMU + a * 64 + cg8 + 4), mn0 = *(const LAS f32x4*)(fMU + 320 + a * 64 + cg8), mn1 = *(const LAS f32x4*)(fMU + 320 + a * 64 + cg8 + 4);
#pragma unroll
                for (int e = 0; e < 8; ++e) { const float mp = fm * (e < 4 ? mp0[e & 3] : mp1[e & 3]), mn = fm * (e < 4 ? mn0[e & 3] : mn1[e & 3]); o[e] = cv[e] + mp * (pv[e] - cv[e]) + mn * (nv[e] - cv[e]); }
                if (a == 0) {
#pragma unroll
                    for (int e = 0; e < 8; ++e) rv[e] = o[e];
                    LAS float* dst = fS + SCI(slot, 4, cg8); *(LAS f32x4*)dst = (f32x4){o[0], o[1], o[2], o[3]}; *(LAS f32x4*)(dst + 4) = (f32x4){o[4], o[5], o[6], o[7]};
                } else if (a == 1) {
#pragma unroll
                    for (int e = 0; e < 8; ++e) kv[e] = o[e];
                } else if (a == 2) {
                    LAS float* dst = fV + slot * 64 + cg8; *(LAS f32x4*)dst = (f32x4){o[0], o[1], o[2], o[3]}; *(LAS f32x4*)(dst + 4) = (f32x4){o[4], o[5], o[6], o[7]};
                } else {
                    if (a == 3) {
#pragma unroll
                        for (int e = 0; e < 8; ++e) o[e] = me1 ? fast_tanh(o[e]) : o[e];
                    }
                    u32x4 w; w.x = cvtpk(o[0], o[1]); w.y = cvtpk(o[2], o[3]); w.z = cvtpk(o[4], o[5]); w.w = cvtpk(o[6], o[7]);
                    *(LAS u32x4*)(lds + (a == 3 ? SC_TW : SC_AD) + slot * 144 + cg8 * 2) = w;
                }
            }
        }
        BAR_LDS();
        if (c + 1 < nchunk) SC_LOAD(c + 1);
        {
            const LAS unsigned char* Ab = lds + (mat ? SC_AD : SC_TW); LAS float* fWB = fS + (mat ? 128 : 64);
#pragma unroll
            for (int mt = 0; mt < 4; ++mt) {
                const bf16x8 a0 = *(const LAS bf16x8*)(Ab + (mt * 16 + (lane & 15)) * 144 + (lane >> 4) * 16);
                const bf16x8 a1 = *(const LAS bf16x8*)(Ab + (mt * 16 + (lane & 15)) * 144 + 64 + (lane >> 4) * 16);
                f32x4 acc = {0.f, 0.f, 0.f, 0.f};
                acc = __builtin_amdgcn_mfma_f32_16x16x32_bf16(a0, bfr0, acc, 0, 0, 0);
                acc = __builtin_amdgcn_mfma_f32_16x16x32_bf16(a1, bfr1, acc, 0, 0, 0);
#pragma unroll
                for (int rg = 0; rg < 4; ++rg) {
                    const int sl = mt * 16 + (lane >> 4) * 4 + rg, col = ntile * 16 + (lane & 15);
                    const float sg = fast_sigmoid(acc[rg] + bias); const float dc = __builtin_amdgcn_exp2f(-0.6065306597126334f * LOG2E * sg);
                    fWB[sl * 320 + col] = mat ? sg : dc;
                }
            }
        }
        BAR_LDS();
        {
            const f32x4 a0 = *(const LAS f32x4*)(fS + SCI(slot, 2, cg8)), a1 = *(const LAS f32x4*)(fS + SCI(slot, 2, cg8 + 4));
            const f32x4 kk0 = *(const LAS f32x4*)(fMU + 640 + cg8), kk1 = *(const LAS f32x4*)(fMU + 640 + cg8 + 4), ka0 = *(const LAS f32x4*)(fMU + 704 + cg8), ka1 = *(const LAS f32x4*)(fMU + 704 + cg8 + 4);
            const f32x4 rk0 = *(const LAS f32x4*)(fMU + 768 + cg8), rk1 = *(const LAS f32x4*)(fMU + 768 + cg8 + 4);
            float kkv[8], kd[8], av[8]; float ssq = 0.f, cs = 0.f;
#pragma unroll
            for (int e = 0; e < 8; ++e) {
                av[e] = e < 4 ? a0[e & 3] : a1[e & 3];
                kkv[e] = kv[e] * (e < 4 ? kk0[e & 3] : kk1[e & 3]); ssq = fmaf(kkv[e], kkv[e], ssq);
                kd[e] = kv[e] * (1.0f + (av[e] - 1.0f) * (e < 4 ? ka0[e & 3] : ka1[e & 3])); cs = fmaf(rv[e] * kd[e], e < 4 ? rk0[e & 3] : rk1[e & 3], cs);
            }
            ssq = grp_sum<8>(ssq); cs = grp_sum<8>(cs);
            const float rs = rsqrtf(fmaxf(ssq, 1e-24f));
#pragma unroll
            for (int e = 0; e < 8; ++e) { kkv[e] *= rs; av[e] *= kkv[e]; }
            LAS float* o1 = fS + SCI(slot, 0, cg8); *(LAS f32x4*)o1 = (f32x4){kkv[0], kkv[1], kkv[2], kkv[3]}; *(LAS f32x4*)(o1 + 4) = (f32x4){kkv[4], kkv[5], kkv[6], kkv[7]};
            LAS float* o2 = fS + SCI(slot, 2, cg8); *(LAS f32x4*)o2 = (f32x4){av[0], av[1], av[2], av[3]}; *(LAS f32x4*)(o2 + 4) = (f32x4){av[4], av[5], av[6], av[7]};
            LAS float* o3 = fS + SCI(slot, 3, cg8); *(LAS f32x4*)o3 = (f32x4){kd[0], kd[1], kd[2], kd[3]}; *(LAS f32x4*)(o3 + 4) = (f32x4){kd[4], kd[5], kd[6], kd[7]};
            if (cg8 == 0 && rp == 0 && slot < nvalid) { const int i2 = 64 * c + slot; const int p2 = d ? Ltot - 1 - i2 : i2; CB[((size_t)d * ROWS + pos_row(base, p2)) * 8 + h] = cs; }
        }
        BAR_LDS();
#define SC_STORE_Y(cc_) do { const int t5_ = tid - 256; if (t5_ >= 0 && t5_ < 128) { const int sl5_ = t5_ >> 1, hf_ = t5_ & 1; const int i5_ = 64 * (cc_) + sl5_; const int p5_ = d ? Ltot - 1 - i5_ : i5_; \
            if (i5_ < Ltot && p5_ >= 16) { const LAS float* yp_ = fY + ((cc_) & 1) * 1024 + sl5_ * 16 + hf_ * 8; const f32x4 y0_ = *(const LAS f32x4*)yp_, y1_ = *(const LAS f32x4*)(yp_ + 4); \
                *(u32x4*)(YD + (size_t)(base + p5_ - 16) * 512 + h * 64 + rp * 16 + hf_ * 8) = pack8(y0_, y1_); } } } while (0)
        if (YDB && wid >= NSW && c > 0) SC_STORE_Y(c - 1);
        if (wid < NSW) {
            typedef float f32x2_ __attribute__((ext_vector_type(2)));
            constexpr int C4 = CPL / 4;
            const LAS float* ps = fS + kg * CPL; const LAS float* pv = fV + srow;
            LAS float* py = YDB ? fY + (c & 1) * 1024 + (srow - rp * RPB) : fY + srow;
            f32x4 nk[C4], nw[C4], nb[C4], nd[C4], nr[C4]; float nv;
#define SC_FETCH(sl_) do { _Pragma("unroll") for (int j_ = 0; j_ < C4; ++j_) { nk[j_] = *(const LAS f32x4*)(ps + (sl_) * 320 + 4 * j_); nw[j_] = *(const LAS f32x4*)(ps + (sl_) * 320 + 64 + 4 * j_); \
                nb[j_] = *(const LAS f32x4*)(ps + (sl_) * 320 + 128 + 4 * j_); nd[j_] = *(const LAS f32x4*)(ps + (sl_) * 320 + 192 + 4 * j_); nr[j_] = *(const LAS f32x4*)(ps + (sl_) * 320 + 256 + 4 * j_); } nv = pv[(sl_) * 64]; } while (0)
            SC_FETCH(0);
            f32x4 rp4[C4];
#pragma unroll
            for (int j = 0; j < C4; ++j) rp4[j] = (f32x4){0.f, 0.f, 0.f, 0.f};
#pragma unroll 16
            for (int sl = 0; sl < nvalid; ++sl) {
                f32x4 ck[C4], cw[C4], cb[C4], cd[C4], cr[C4];
#pragma unroll
                for (int j = 0; j < C4; ++j) { ck[j] = nk[j]; cw[j] = nw[j]; cb[j] = nb[j]; cd[j] = nd[j]; cr[j] = nr[j]; }
                const float vv = nv;
                SC_FETCH(sl + 1 < 64 ? sl + 1 : 63);
                f32x2_ pa = {0.f, 0.f}, ya = {0.f, 0.f};
#pragma unroll
                for (int j = 0; j < C4; ++j)
#pragma unroll
                    for (int e = 0; e < 4; e += 2) { const f32x2_ s2 = {S[4 * j + e], S[4 * j + e + 1]}, k2 = {ck[j][e], ck[j][e + 1]}, r2 = {rp4[j][e], rp4[j][e + 1]}; pa = pa + s2 * k2; ya = ya + s2 * r2; }
                float pp = pa.x + pa.y, yy = ya.x + ya.y;
                pp = dpp_add(pp, 0); yy = dpp_add(yy, 0); pp = dpp_add(pp, 1); yy = dpp_add(yy, 1); pp = dpp_add(pp, 2); yy = dpp_add(yy, 2);
                if (LPR == 16) { pp = dpp_add(pp, 3); yy = dpp_add(yy, 3); }
                py[(sl > 0 ? sl - 1 : 0) * YST] = yy;
#pragma unroll
                for (int j = 0; j < C4; ++j)
#pragma unroll
                    for (int e = 0; e < 4; e += 2) {
                        const f32x2_ b2 = {cb[j][e], cb[j][e + 1]}, d2 = {cd[j][e], cd[j][e + 1]}, w2 = {cw[j][e], cw[j][e + 1]}; f32x2_ s2 = {S[4 * j + e], S[4 * j + e + 1]};
                        const f32x2_ t2 = d2 * vv - b2 * pp; s2 = s2 * w2 + t2; S[4 * j + e] = s2.x; S[4 * j + e + 1] = s2.y; }
#pragma unroll
                for (int j = 0; j < C4; ++j) rp4[j] = cr[j];
            }
            {
                f32x2_ ya = {0.f, 0.f};
#pragma unroll
                for (int j = 0; j < C4; ++j)
#pragma unroll
                    for (int e = 0; e < 4; e += 2) { const f32x2_ s2 = {S[4 * j + e], S[4 * j + e + 1]}, r2 = {rp4[j][e], rp4[j][e + 1]}; ya = ya + s2 * r2; }
                const float yy = grp_sum<LPR>(ya.x + ya.y);
                py[(nvalid - 1) * YST] = yy;
            }
#undef SC_FETCH
        }
        BAR_LDS();
        {
            const int i2 = 64 * c + slot; const int p2 = d ? Ltot - 1 - i2 : i2;
            if (!YDB && slot < nvalid && p2 >= 16 && (cg8 / RPB) == rp) {
                const LAS float* yp = fY + slot * 64 + cg8; const f32x4 y0 = *(const LAS f32x4*)yp, y1 = *(const LAS f32x4*)(yp + 4);
                *(u32x4*)(YD + (size_t)(base + p2 - 16) * 512 + h * 64 + cg8) = pack8(y0, y1);
            }
        }
    }
    if (YDB) SC_STORE_Y(nchunk - 1);
#undef SC_STORE_Y
#undef SC_LOAD
#undef SC_META
#undef SCI
}

constexpr int SL_FV = 81920, SL_FY = 86016, SL_TW = 90112, SL_AD = 94720, SL_AS = 99328, SL_MU = 107520;
__device__ __forceinline__ void scan_long(LAS unsigned char* lds, KP P, int s, int d, int h, int rp) {
    int tid_ = threadIdx.x; asm volatile("" : "+v"(tid_));
    const int tid = tid_, lane = tid & 63, wid = __builtin_amdgcn_readfirstlane(tid >> 6);
    const int L = seq_len(s), base = seq_base(s), Ltot = L + 16, nhalf = (Ltot + 31) / 32;
    unsigned char* ws = P->ws;
    const bf16* Rb = (const bf16*)(ws + WS_R); const bf16* KAb = (const bf16*)(ws + WS_KA); const bf16* VAb = (const bf16*)(ws + WS_VA); const bf16* Lb = (const bf16*)(ws + WS_L);
    float* CB = (float*)(ws + WS_CB); bf16* YD = (bf16*)((unsigned char*)P->out + 64 * MiB) + (size_t)d * NMAIN * 512;
    LAS float* fS = (LAS float*)lds; LAS float* fV = (LAS float*)(lds + SL_FV); LAS float* fY = (LAS float*)(lds + SL_FY); LAS float* fAS = (LAS float*)(lds + SL_AS); LAS float* fMU = (LAS float*)(lds + SL_MU);
    for (int i = tid; i < 832; i += NTHREADS) {
        float v;
        if (i < 640) { const int which = i / 320, jj = i % 320, a = jj >> 6, c = jj & 63; const int gi = a < 3 ? a * 512 + h * 64 + c : 1536 + (a - 3) * 64 + c; v = P->in[which ? I_MUN : I_MUP][gi]; }
        else { const int a = (i - 640) >> 6, c = (i - 640) & 63; v = P->in[a == 0 ? I_KK : a == 1 ? I_KA : I_RK][h * 64 + c]; }
        fMU[i] = v;
    }
    const bool scanner = wid < 4; const int pw = wid & 3;
    const int sl8 = lane >> 3, cg8 = (lane & 7) * 8, slot = pw * 8 + sl8;
    const int rowl = lane >> 4, kg = lane & 15, srl = pw * 4 + rowl;
    const unsigned char* HALO0 = ws + WS_HALO + (size_t)(base >> 6) * 2 * HALO_ROW;
    u32x4 raw[5][3];
#define SL_META(hc) (d ? ((hc) == nhalf - 1) : ((hc) == 0))
#define SL_LOAD(hc) do { const int i_ = 32 * (hc) + slot; const bool ok_ = i_ < Ltot; const int p_ = d ? Ltot - 1 - i_ : i_; \
        const unsigned zr_ = (unsigned)(METAROW + 64); \
        if (!SL_META(hc)) { const unsigned rc_ = ok_ ? (unsigned)(base + p_ - 16) : zr_; \
            _Pragma("unroll") for (int a_ = 0; a_ < 5; ++a_) { const unsigned char* B_ = (const unsigned char*)(a_ == 0 ? Rb : a_ == 1 ? KAb : a_ == 2 ? VAb : Lb); const unsigned ld_ = a_ < 3 ? 1024u : 512u; \
                const unsigned co_ = (unsigned)(((a_ < 3 ? h * 64 : (a_ - 3) * 64) + cg8) * 2); raw[a_][1] = *(const u32x4*)(B_ + (rc_ * ld_ + co_)); } \
        } else { const bool me_ = ok_ && p_ < 16; const bool hn_ = me_ && p_ == 15; \
            const unsigned rc_ = ok_ ? (unsigned)pos_row(base, p_) : zr_, rp_ = (me_ && p_ > 0) ? (unsigned)(METAROW + p_ - 1) : zr_, rn_ = (me_ && p_ < 15) ? (unsigned)(METAROW + p_ + 1) : zr_; \
            _Pragma("unroll") for (int a_ = 0; a_ < 5; ++a_) { const unsigned char* B_ = (const unsigned char*)(a_ == 0 ? Rb : a_ == 1 ? KAb : a_ == 2 ? VAb : Lb); const unsigned ld_ = a_ < 3 ? 1024u : 512u; \
                const unsigned co_ = (unsigned)(((a_ < 3 ? h * 64 : (a_ - 3) * 64) + cg8) * 2); \
                const unsigned ho_ = (unsigned)(((a_ < 3 ? a_ * 512 + h * 64 : 1536 + (a_ - 3) * 64) + cg8) * 2); \
                raw[a_][0] = *(const u32x4*)(B_ + (rp_ * ld_ + co_)); raw[a_][1] = *(const u32x4*)(B_ + (rc_ * ld_ + co_)); \
                const unsigned char* np_ = hn_ ? HALO0 + ho_ : B_ + (rn_ * ld_ + co_); raw[a_][2] = *(const u32x4*)np_; } } } while (0)
    constexpr int SL_WB = 110848;
    for (int i = tid; i < 1024; i += NTHREADS) { const int m2 = i >> 9, n = (i >> 3) & 63, ch = i & 7;
        *(LAS u32x4*)(lds + SL_WB + m2 * 9216 + n * 144 + ch * 16) = *(const u32x4*)((const bf16*)(ws + WS_LORA + (m2 ? 131072 : 0)) + ((size_t)d * 512 + h * 64 + n) * 64 + ch * 8); }
    float bias[2][4];
#pragma unroll
    for (int mt_ = 0; mt_ < 2; ++mt_)
#pragma unroll
        for (int nt = 0; nt < 4; ++nt) bias[mt_][nt] = P->in[mt_ ? I_A0 : I_W0][d * 512 + h * 64 + nt * 16 + (lane & 15)];
    float S[4] = {0.f, 0.f, 0.f, 0.f};
#define SL_PREP(hc, buf) do { \
        const bool meta_ = SL_META(hc); const int i1_ = 32 * (hc) + slot; const int p1_ = d ? Ltot - 1 - i1_ : i1_; const bool ok1_ = i1_ < Ltot; \
        LAS float* fSb_ = fS + (buf) * 10240 + slot * 320; float rv[8], kv[8]; \
        if (!meta_) { float vv8[8]; unpack8(raw[0][1], rv); unpack8(raw[1][1], kv); unpack8(raw[2][1], vv8); \
            *(LAS f32x4*)(fSb_ + 256 + cg8) = (f32x4){rv[0], rv[1], rv[2], rv[3]}; *(LAS f32x4*)(fSb_ + 256 + cg8 + 4) = (f32x4){rv[4], rv[5], rv[6], rv[7]}; \
            if ((cg8 >> 4) == rp) { LAS float* dv_ = fV + (buf) * 512 + slot * 16 + (cg8 & 15); *(LAS f32x4*)dv_ = (f32x4){vv8[0], vv8[1], vv8[2], vv8[3]}; *(LAS f32x4*)(dv_ + 4) = (f32x4){vv8[4], vv8[5], vv8[6], vv8[7]}; } \
            *(LAS u32x4*)(lds + SL_TW + slot * 144 + cg8 * 2) = raw[3][1]; *(LAS u32x4*)(lds + SL_AD + slot * 144 + cg8 * 2) = raw[4][1]; \
        } else { const bool me1_ = ok1_ && p1_ < 16; const float fm_ = me1_ ? 1.0f : 0.0f; \
            _Pragma("unroll") for (int a = 0; a < 5; ++a) { \
                float pv_[8], cv_[8], nv_[8], o_[8]; unpack8(raw[a][0], pv_); unpack8(raw[a][1], cv_); unpack8(raw[a][2], nv_); \
                _Pragma("unroll") for (int e = 0; e < 8; ++e) { const float mp_ = fm_ * fMU[a * 64 + cg8 + e], mn_ = fm_ * fMU[320 + a * 64 + cg8 + e]; o_[e] = cv_[e] + mp_ * (pv_[e] - cv_[e]) + mn_ * (nv_[e] - cv_[e]); } \
                if (a == 0) { _Pragma("unroll") for (int e = 0; e < 8; ++e) rv[e] = o_[e]; \
                    *(LAS f32x4*)(fSb_ + 256 + cg8) = (f32x4){o_[0], o_[1], o_[2], o_[3]}; *(LAS f32x4*)(fSb_ + 256 + cg8 + 4) = (f32x4){o_[4], o_[5], o_[6], o_[7]}; } \
                else if (a == 1) { _Pragma("unroll") for (int e = 0; e < 8; ++e) kv[e] = o_[e]; } \
                else if (a == 2) { if ((cg8 >> 4) == rp) { LAS float* dv_ = fV + (buf) * 512 + slot * 16 + (cg8 & 15); *(LAS f32x4*)dv_ = (f32x4){o_[0], o_[1], o_[2], o_[3]}; *(LAS f32x4*)(dv_ + 4) = (f32x4){o_[4], o_[5], o_[6], o_[7]}; } } \
                else { if (a == 3) { _Pragma("unroll") for (int e = 0; e < 8; ++e) o_[e] = me1_ ? fast_tanh(o_[e]) : o_[e]; } \
                    u32x4 w_; w_.x = cvtpk(o_[0], o_[1]); w_.y = cvtpk(o_[2], o_[3]); w_.z = cvtpk(o_[4], o_[5]); w_.w = cvtpk(o_[6], o_[7]); \
                    *(LAS u32x4*)(lds + (a == 3 ? SL_TW : SL_AD) + slot * 144 + cg8 * 2) = w_; } } } \
        asm volatile("s_waitcnt lgkmcnt(0)" ::: "memory"); \
          \
        { f32x4 acc_[2][4]; \
          _Pragma("unroll") for (int m2 = 0; m2 < 2; ++m2) { const LAS unsigned char* Ab_ = lds + (m2 ? SL_AD : SL_TW) + (pw * 8 + (lane & 15)) * 144 + (lane >> 4) * 16; \
              const bf16x8 a0_ = *(const LAS bf16x8*)Ab_, a1_ = *(const LAS bf16x8*)(Ab_ + 64); \
              _Pragma("unroll") for (int nt = 0; nt < 4; ++nt) { f32x4 z_ = {0.f, 0.f, 0.f, 0.f}; const LAS unsigned char* Bb_ = lds + SL_WB + m2 * 9216 + (nt * 16 + (lane & 15)) * 144 + (lane >> 4) * 16; \
                  z_ = __builtin_amdgcn_mfma_f32_16x16x32_bf16(a0_, *(const LAS bf16x8*)Bb_, z_, 0, 0, 0); acc_[m2][nt] = __builtin_amdgcn_mfma_f32_16x16x32_bf16(a1_, *(const LAS bf16x8*)(Bb_ + 64), z_, 0, 0, 0); } } \
          if (lane < 32) { \
              _Pragma("unroll") for (int nt = 0; nt < 4; ++nt) _Pragma("unroll") for (int rg = 0; rg < 4; ++rg) { const int row_ = (lane >> 4) * 4 + rg, col_ = nt * 16 + (lane & 15); \
                  const float sw_ = fast_sigmoid(acc_[0][nt][rg] + bias[0][nt]); fS[(buf) * 10240 + (pw * 8 + row_) * 320 + 64 + col_] = __builtin_amdgcn_exp2f(-0.6065306597126334f * LOG2E * sw_); \
                  fAS[pw * 512 + row_ * 64 + col_] = fast_sigmoid(acc_[1][nt][rg] + bias[1][nt]); } } } \
        asm volatile("s_waitcnt lgkmcnt(0)" ::: "memory"); \
          \
        { const f32x4 a0 = *(const LAS f32x4*)(fAS + pw * 512 + sl8 * 64 + cg8), a1 = *(const LAS f32x4*)(fAS + pw * 512 + sl8 * 64 + cg8 + 4); \
          const f32x4 kk0 = *(const LAS f32x4*)(fMU + 640 + cg8), kk1 = *(const LAS f32x4*)(fMU + 640 + cg8 + 4), ka0 = *(const LAS f32x4*)(fMU + 704 + cg8), ka1 = *(const LAS f32x4*)(fMU + 704 + cg8 + 4); \
          const f32x4 rk0 = *(const LAS f32x4*)(fMU + 768 + cg8), rk1 = *(const LAS f32x4*)(fMU + 768 + cg8 + 4); \
          float kkv[8], kd[8], av[8]; float ssq = 0.f, cs = 0.f; \
          _Pragma("unroll") for (int e = 0; e < 8; ++e) { av[e] = e < 4 ? a0[e & 3] : a1[e & 3]; \
              kkv[e] = kv[e] * (e < 4 ? kk0[e & 3] : kk1[e & 3]); ssq = fmaf(kkv[e], kkv[e], ssq); \
              kd[e] = kv[e] * (1.0f + (av[e] - 1.0f) * (e < 4 ? ka0[e & 3] : ka1[e & 3])); cs = fmaf(rv[e] * kd[e], e < 4 ? rk0[e & 3] : rk1[e & 3], cs); } \
          ssq = grp_sum<8>(ssq); cs = grp_sum<8>(cs); \
          const float rs = rsqrtf(fmaxf(ssq, 1e-24f)); \
          _Pragma("unroll") for (int e = 0; e < 8; ++e) { kkv[e] *= rs; av[e] *= kkv[e]; } \
          *(LAS f32x4*)(fSb_ + cg8) = (f32x4){kkv[0], kkv[1], kkv[2], kkv[3]}; *(LAS f32x4*)(fSb_ + cg8 + 4) = (f32x4){kkv[4], kkv[5], kkv[6], kkv[7]}; \
          *(LAS f32x4*)(fSb_ + 128 + cg8) = (f32x4){av[0], av[1], av[2], av[3]}; *(LAS f32x4*)(fSb_ + 128 + cg8 + 4) = (f32x4){av[4], av[5], av[6], av[7]}; \
          *(LAS f32x4*)(fSb_ + 192 + cg8) = (f32x4){kd[0], kd[1], kd[2], kd[3]}; *(LAS f32x4*)(fSb_ + 192 + cg8 + 4) = (f32x4){kd[4], kd[5], kd[6], kd[7]}; \
          if (cg8 == 0 && rp == 0 && ok1_) CB[((size_t)d * ROWS + pos_row(base, p1_)) * 8 + h] = cs; } } while (0)
#define SL_STORE_Y(hc, buf) do { const int sl5_ = lane >> 1, hf_ = lane & 1; const int i5_ = 32 * (hc) + sl5_; const int p5_ = d ? Ltot - 1 - i5_ : i5_; \
        if (i5_ < Ltot && p5_ >= 16) { const LAS float* yp_ = fY + (buf) * 512 + sl5_ * 16 + hf_ * 8; const f32x4 y0_ = *(const LAS f32x4*)yp_, y1_ = *(const LAS f32x4*)(yp_ + 4); \
            *(u32x4*)(YD + (size_t)(base + p5_ - 16) * 512 + h * 64 + rp * 16 + hf_ * 8) = pack8(y0_, y1_); } } while (0)
    BAR_LDS();
    if (!scanner) { SL_LOAD(0); SL_PREP(0, 0); if (nhalf > 1) SL_LOAD(1); }
    BAR_LDS();
#pragma unroll 1
    for (int hc = 0; hc < nhalf; ++hc) {
        if (scanner) {
            typedef float f32x2_ __attribute__((ext_vector_type(2)));
            const int nvalid = (Ltot - 32 * hc) < 32 ? (Ltot - 32 * hc) : 32, buf = hc & 1;
            const LAS float* ps = fS + buf * 10240 + kg * 4; const LAS float* pv = fV + buf * 512 + srl; LAS float* py = fY + buf * 512 + srl;
            f32x4 nk, nw, nb, nd, nr; float nv;
#define SL_FETCH(sl_) do { nk = *(const LAS f32x4*)(ps + (sl_) * 320); nw = *(const LAS f32x4*)(ps + (sl_) * 320 + 64); nb = *(const LAS f32x4*)(ps + (sl_) * 320 + 128); \
                nd = *(const LAS f32x4*)(ps + (sl_) * 320 + 192); nr = *(const LAS f32x4*)(ps + (sl_) * 320 + 256); nv = pv[(sl_) * 16]; } while (0)
            SL_FETCH(0);
            f32x4 rp4 = {0.f, 0.f, 0.f, 0.f};
            if (nvalid == 32) {
#pragma unroll
            for (int sl = 0; sl < 32; ++sl) {
                const f32x4 ck = nk, cw = nw, cb = nb, cd = nd, cr = nr; const float vv = nv;
                SL_FETCH(sl + 1 < 32 ? sl + 1 : 31);
                f32x2_ pa = {0.f, 0.f}, ya = {0.f, 0.f};
#pragma unroll
                for (int e = 0; e < 4; e += 2) { const f32x2_ s2 = {S[e], S[e + 1]}, k2 = {ck[e], ck[e + 1]}, r2 = {rp4[e], rp4[e + 1]}; pa = pa + s2 * k2; ya = ya + s2 * r2; }
                float pp = pa.x + pa.y, yy = ya.x + ya.y;
                pp = dpp_add(pp, 0); yy = dpp_add(yy, 0); pp = dpp_add(pp, 1); yy = dpp_add(yy, 1); pp = dpp_add(pp, 2); yy = dpp_add(yy, 2); pp = dpp_add(pp, 3); yy = dpp_add(yy, 3);
                py[(sl > 0 ? sl - 1 : 0) * 16] = yy;
#pragma unroll
                for (int e = 0; e < 4; e += 2) { const f32x2_ b2 = {cb[e], cb[e + 1]}, d2 = {cd[e], cd[e + 1]}, w2 = {cw[e], cw[e + 1]}; f32x2_ s2 = {S[e], S[e + 1]};
                    const f32x2_ t2 = d2 * vv - b2 * pp; s2 = s2 * w2 + t2; S[e] = s2.x; S[e + 1] = s2.y; }
                rp4 = cr;
            }
            } else {
#pragma unroll 16
            for (int sl = 0; sl < nvalid; ++sl) {
                const f32x4 ck = nk, cw = nw, cb = nb, cd = nd, cr = nr; const float vv = nv;
                SL_FETCH(sl + 1 < 32 ? sl + 1 : 31);
                f32x2_ pa = {0.f, 0.f}, ya = {0.f, 0.f};
#pragma unroll
                for (int e = 0; e < 4; e += 2) { const f32x2_ s2 = {S[e], S[e + 1]}, k2 = {ck[e], ck[e + 1]}, r2 = {rp4[e], rp4[e + 1]}; pa = pa + s2 * k2; ya = ya + s2 * r2; }
                float pp = pa.x + pa.y, yy = ya.x + ya.y;
                pp = dpp_add(pp, 0); yy = dpp_add(yy, 0); pp = dpp_add(pp, 1); yy = dpp_add(yy, 1); pp = dpp_add(pp, 2); yy = dpp_add(yy, 2); pp = dpp_add(pp, 3); yy = dpp_add(yy, 3);
                py[(sl > 0 ? sl - 1 : 0) * 16] = yy;
#pragma unroll
                for (int e = 0; e < 4; e += 2) { const f32x2_ b2 = {cb[e], cb[e + 1]}, d2 = {cd[e], cd[e + 1]}, w2 = {cw[e], cw[e + 1]}; f32x2_ s2 = {S[e], S[e + 1]};
                    const f32x2_ t2 = d2 * vv - b2 * pp; s2 = s2 * w2 + t2; S[e] = s2.x; S[e + 1] = s2.y; }
                rp4 = cr;
            }
            }
            { f32x2_ ya = {0.f, 0.f};
#pragma unroll
              for (int e = 0; e < 4; e += 2) { const f32x2_ s2 = {S[e], S[e + 1]}, r2 = {rp4[e], rp4[e + 1]}; ya = ya + s2 * r2; }
              const float yy = grp_sum<16>(ya.x + ya.y); py[(nvalid - 1) * 16] = yy; }
#undef SL_FETCH
        } else {
            if (hc > 0 && pw == 0) SL_STORE_Y(hc - 1, (hc - 1) & 1);
            if (hc + 1 < nhalf) { SL_PREP(hc + 1, (hc + 1) & 1); if (hc + 2 < nhalf) SL_LOAD(hc + 2); }
        }
        BAR_LDS();
    }
    if (!scanner && pw == 0) SL_STORE_Y(nhalf - 1, (nhalf - 1) & 1);
#undef SL_STORE_Y
#undef SL_PREP
#undef SL_LOAD
#undef SL_META
}

__device__ __forceinline__ void rwkv_colmap(unsigned char* ws, int c0, bf16*& buf, int& ld, int& col) {
    if (c0 < 512) { buf = (bf16*)(ws + WS_R); ld = 512; col = c0; }
    else if (c0 < 1024) { buf = (bf16*)(ws + WS_KA); ld = 512; col = c0 - 512; }
    else if (c0 < 1536) { buf = (bf16*)(ws + WS_VA); ld = 512; col = c0 - 1024; }
    else { buf = (bf16*)(ws + WS_L); ld = 256; col = c0 - 1536; }
}
__device__ __forceinline__ void phase_halo(KP P) {
    const int tid = fresh_tid(), lane = tid & 63, wid = tid >> 6; const int gw = blockIdx.x * 8 + wid, NGW = gridDim.x * 8;
    unsigned char* ws = P->ws;
    for (int r = gw; r < (NMAIN / 64) * 2; r += NGW) {
        const int m = (r >> 1) * 64 + ((r & 1) ? 63 : 0);
        for (int j = lane; j < 224; j += 64) { bf16* buf; int ld, col; rwkv_colmap(ws, j * 8, buf, ld, col);
            *(u32x4*)(ws + WS_HALO + (size_t)r * HALO_ROW + j * 16) = *(const u32x4*)(buf + (size_t)m * ld + col); }
    }
}
__device__ __forceinline__ void phase_shift(LAS unsigned char* lds, KP P) {
    const int tid = fresh_tid(), slot = tid >> 3, cg = tid & 7;
    unsigned char* ws = P->ws; const float* mup = P->in[I_MUP]; const float* mun = P->in[I_MUN];
    for (int tile = blockIdx.x; tile < NMAIN / 64; tile += gridDim.x) {
        const int m0 = tile * 64, m = m0 + slot;
        const int ks = m0 < 16384 ? tile : ((m0 - 16384) & 2047) >> 6; const bool first = ks == 0, last = ks == (m0 < 16384 ? 255 : 31);
        u32x4 stg[7];
#define SH_LOAD(pass_) do { _Pragma("unroll") for (int i = 0; i < 7; ++i) { const int j = cg + 8 * i; bf16* buf; int ld, col; rwkv_colmap(ws, ((pass_) * 56 + j) * 8, buf, ld, col); \
            stg[i] = *(const u32x4*)(buf + (size_t)m * ld + col); } } while (0)
        SH_LOAD(0);
#pragma unroll 1
        for (int pass = 0; pass < 4; ++pass) {
#pragma unroll
            for (int i = 0; i < 7; ++i) { const int j = cg + 8 * i; *(LAS u32x4*)(lds + (slot * 56 + j) * 16) = stg[i]; }
            asm volatile("s_waitcnt lgkmcnt(0)\n\ts_barrier" ::: "memory");
            if (pass < 3) SH_LOAD(pass + 1);
#pragma unroll
            for (int i = 0; i < 7; ++i) {
                const int j = cg + 8 * i, c0 = (pass * 56 + j) * 8; bf16* buf; int ld, col; rwkv_colmap(ws, c0, buf, ld, col);
                const u32x4 z = {0u, 0u, 0u, 0u};
                const u32x4 cu = *(const LAS u32x4*)(lds + (slot * 56 + j) * 16);
                u32x4 pu, nu;
                if (slot > 0) pu = *(const LAS u32x4*)(lds + ((slot - 1) * 56 + j) * 16);
                else pu = first ? *(const u32x4*)(buf + (size_t)(METAROW + 15) * ld + col) : *(const u32x4*)(ws + WS_HALO + (size_t)((tile - 1) * 2 + 1) * HALO_ROW + c0 * 2);
                if (slot < 63) nu = *(const LAS u32x4*)(lds + ((slot + 1) * 56 + j) * 16);
                else nu = last ? z : *(const u32x4*)(ws + WS_HALO + (size_t)((tile + 1) * 2) * HALO_ROW + c0 * 2);
                float pv[8], cv[8], nv[8], o[8]; unpack8(pu, pv); unpack8(cu, cv); unpack8(nu, nv);
                const f32x4 mp0 = *(const f32x4*)(mup + c0), mp1 = *(const f32x4*)(mup + c0 + 4), mn0 = *(const f32x4*)(mun + c0), mn1 = *(const f32x4*)(mun + c0 + 4);
#pragma unroll
                for (int e = 0; e < 8; ++e) { const float mp = e < 4 ? mp0[e & 3] : mp1[e & 3], mn = e < 4 ? mn0[e & 3] : mn1[e & 3]; o[e] = cv[e] + mp * (pv[e] - cv[e]) + mn * (nv[e] - cv[e]); }
                if (c0 >= 1536 && c0 < 1600) {
#pragma unroll
                    for (int e = 0; e < 8; ++e) o[e] = fast_tanh(o[e]);
                }
                u32x4 w; w.x = cvtpk(o[0], o[1]); w.y = cvtpk(o[2], o[3]); w.z = cvtpk(o[4], o[5]); w.w = cvtpk(o[6], o[7]);
                *(u32x4*)(buf + (size_t)m * ld + col) = w;
            }
            asm volatile("s_waitcnt lgkmcnt(0)\n\ts_barrier" ::: "memory");
        }
#undef SH_LOAD
    }
}

__device__ __forceinline__ void phase_post(LAS unsigned char* lds, KP P) {
    const int tid = fresh_tid(), lane = tid & 63, wid = tid >> 6;
    unsigned char* ws = P->ws;
    const bf16* VAb = (const bf16*)(ws + WS_VA); const bf16* Lb = (const bf16*)(ws + WS_L); bf16* Rb = (bf16*)(ws + WS_R);
    const float* CB = (const float*)(ws + WS_CB); const bf16* YD0 = (const bf16*)((const unsigned char*)P->out + 64 * MiB); const bf16* YD1 = YD0 + (size_t)NMAIN * 512;
    const bf16* GT = (const bf16*)(ws + WS_LORA + 262144);
    LAS float* st = (LAS float*)(lds + 17408);
    const float* mup = P->in[I_MUP]; const float* mun = P->in[I_MUN];
    for (int tile = blockIdx.x; tile < NMAIN / 64; tile += gridDim.x) {
        {
            const int row = tid >> 3, hh = tid & 7, m = tile * 64 + row;
            const int t = m < 16384 ? m : (m - 16384) & 2047, Ls = m < 16384 ? 16384 : 2048;
            float sum = 0.f, sq = 0.f;
#pragma unroll
            for (int i = 0; i < 8; ++i) { float a[8], b[8]; unpack8(*(const u32x4*)(YD0 + (size_t)m * 512 + hh * 64 + i * 8), a); unpack8(*(const u32x4*)(YD1 + (size_t)m * 512 + hh * 64 + i * 8), b);
#pragma unroll
                for (int e = 0; e < 8; ++e) { const float y = a[e] + b[e]; sum += y; sq += y * y; } }
            const float mu = sum * (1.0f / 64.0f); const float var = fmaxf(sq * (1.0f / 64.0f) - mu * mu, 0.f);
            st[(row * 8 + hh) * 2] = mu; st[(row * 8 + hh) * 2 + 1] = rsqrtf(var + 64e-5f);
#pragma unroll
            for (int i = 0; i < 2; ++i) {
                const int c0 = 128 + hh * 16 + i * 8; float cv[8], o[8];
                unpack8(*(const u32x4*)(Lb + (size_t)m * 256 + c0), cv);
#pragma unroll
                for (int e = 0; e < 8; ++e) o[e] = sigmoidf_(cv[e]);
                u32x4 w; w.x = cvtpk(o[0], o[1]); w.y = cvtpk(o[2], o[3]); w.z = cvtpk(o[4], o[5]); w.w = cvtpk(o[6], o[7]);
                *(LAS u32x4*)(lds + row * 272 + (hh * 16 + i * 8) * 2) = w;
            }
        }
        __syncthreads();
#pragma unroll 1
        for (int nt = 0; nt < 4; ++nt) {
            const int col = wid * 64 + nt * 16 + (lane & 15);
            bf16x8 bfr[4];
#pragma unroll
            for (int ks = 0; ks < 4; ++ks) bfr[ks] = *(const bf16x8*)(GT + (size_t)col * 128 + ks * 32 + (lane >> 4) * 8);
            const float lw = P->in[I_LNW][col], lb = P->in[I_LNB][col];
            const float mpv = mup[1024 + col], mnv = mun[1024 + col];
#pragma unroll 1
            for (int mt = 0; mt < 4; ++mt) {
                f32x4 acc = {0.f, 0.f, 0.f, 0.f};
#pragma unroll
                for (int ks = 0; ks < 4; ++ks) { const bf16x8 a = *(const LAS bf16x8*)(lds + (mt * 16 + (lane & 15)) * 272 + ks * 64 + (lane >> 4) * 16); acc = __builtin_amdgcn_mfma_f32_16x16x32_bf16(a, bfr[ks], acc, 0, 0, 0); }
#pragma unroll
                for (int rg = 0; rg < 4; ++rg) {
                    const int row = mt * 16 + (lane >> 4) * 4 + rg, m = tile * 64 + row;
                    const int t = m < 16384 ? m : (m - 16384) & 2047, Ls = m < 16384 ? 16384 : 2048;
                    const float y = bf2f(YD0[(size_t)m * 512 + col]) + bf2f(YD1[(size_t)m * 512 + col]);
                    const float yn = (y - st[(row * 8 + wid) * 2]) * st[(row * 8 + wid) * 2 + 1] * lw + lb;
                    const float vs = bf2f(VAb[(size_t)m * 512 + col]);
                    const float cb = CB[(size_t)m * 8 + wid] + CB[((size_t)ROWS + m) * 8 + wid];
                    Rb[(size_t)m * 512 + col] = (bf16)f2bf_rne((yn + cb * vs) * acc[rg]);
                }
            }
        }
        asm volatile("s_waitcnt lgkmcnt(0)\n\ts_barrier" ::: "memory");
    }
}

__device__ __forceinline__ void phase_rms_bf16(KP P) {
    const int tid = fresh_tid(), lane = tid & 63, wid = tid >> 6; const int gw = blockIdx.x * 8 + wid, NGW = gridDim.x * 8;
    bf16* MN = (bf16*)(P->ws + WS_MN);
    for (int m = gw; m < NMAIN; m += NGW) rms_row_bf16(P->out + (size_t)m * DM, P->in[I_GFFN], MN + (size_t)m * DM, lane);
}
__device__ __forceinline__ void phase_final(KP P) {
    const int tid = fresh_tid(), lane = tid & 63, wid = tid >> 6; const int gw = blockIdx.x * 8 + wid, NGW = gridDim.x * 8;
    const f32x4* gr = (const f32x4*)P->in[I_GFIN] + lane;
    for (int m = gw; m < NMAIN; m += 2 * NGW) {
        const int m2 = m + NGW; const bool ok2 = m2 < NMAIN;
        f32x4* xr = (f32x4*)(P->out + (size_t)m * DM) + lane; f32x4* xr2 = (f32x4*)(P->out + (size_t)(ok2 ? m2 : m) * DM) + lane;
        f32x4 v[4], w[4]; float s = 0.f, s2 = 0.f;
#pragma unroll
        for (int j = 0; j < 4; ++j) { v[j] = xr[64 * j]; w[j] = xr2[64 * j]; }
#pragma unroll
        for (int j = 0; j < 4; ++j) { s += (v[j].x * v[j].x + v[j].y * v[j].y) + (v[j].z * v[j].z + v[j].w * v[j].w); s2 += (w[j].x * w[j].x + w[j].y * w[j].y) + (w[j].z * w[j].z + w[j].w * w[j].w); }
        const float rstd = rsqrtf(wave_sum(s) * (1.f / DM) + 1e-6f), rstd2 = rsqrtf(wave_sum(s2) * (1.f / DM) + 1e-6f);
#pragma unroll
        for (int j = 0; j < 4; ++j) { const f32x4 gg = gr[64 * j]; xr[64 * j] = v[j] * rstd * gg; if (ok2) xr2[64 * j] = w[j] * rstd2 * gg; }
    }
}

constexpr int NRP_LONG = 4;
constexpr int N_LONG = 16 * NRP_LONG, N_ATT_P = 512, N_ATT_S = 512, N_SHORT = 128, N_ITEMS = N_LONG + N_ATT_P + N_ATT_S + N_SHORT;

template <class Op> __device__ __forceinline__ void run_gemm(LAS unsigned char* lds, const bf16* A, const bf16* Bt, int M, int N, int K, const Op& op, const bf16* A2 = nullptr, int pm2 = 1 << 30) {
    pg8::Gemm g{A, Bt, M, N, K, A2, pm2}; pg8::StaticOrder S; S.init(M, N, (int)gridDim.x, (int)blockIdx.x);
    Epi8<Op> E{op};
    pg8::gemm_phase<Epi8<Op>, pg8::StaticOrder, true, true>(lds, g, S, E);
}

constexpr size_t WS_XBAR = 16384;
#define XB_TMO      128
#define XB_XCNT(j)  (256  + 64 * (j))
#define XB_XSUB(j)  (1280 + 64 * (j))
#define XB_XGEN(j)  (2304 + 64 * (j))
#define XB_TOP      3328
#define XB_TOPGEN   3392
#define XCD_BAR_WORDS 3456
#define XB_SPIN_CAP (1u << 18)
__device__ __forceinline__ unsigned xb_ld(unsigned* p)              { return __hip_atomic_load(p, __ATOMIC_RELAXED, __HIP_MEMORY_SCOPE_AGENT); }
__device__ __forceinline__ unsigned xb_add(unsigned* p, unsigned v) { return __hip_atomic_fetch_add(p, v, __ATOMIC_RELAXED, __HIP_MEMORY_SCOPE_AGENT); }
__device__ __forceinline__ unsigned xb_xcc_id() { return (unsigned)__builtin_amdgcn_s_getreg((3 << 11) | 20) & 0xFu; }
#define XB_SPIN(cond, bar) do { unsigned _sp = 0; while (cond) { __builtin_amdgcn_s_sleep(1); \
    if ((++_sp & 255u) == 0u) { if (xb_ld(&(bar)[XB_TMO])) break; if (_sp > XB_SPIN_CAP) { atomicAdd(&(bar)[XB_TMO], 1u); break; } } } } while (0)
struct XcdBarrier { unsigned* bar; unsigned x; volatile LAS unsigned* st; };
__device__ __forceinline__ XcdBarrier xcd_barrier_post(unsigned* bar, volatile LAS unsigned* st) {
    XcdBarrier b; b.bar = bar; b.x = xb_xcc_id(); b.st = st;
    if (threadIdx.x == 0) (void)xb_add(&bar[XB_XCNT(b.x)], 1u);
    return b;
}
__device__ __forceinline__ void xcd_barrier_complete(unsigned* bar, unsigned x, unsigned& nloc, unsigned& nx) {
    const unsigned G = gridDim.x * gridDim.y * gridDim.z;
    unsigned sum, cnt, mine, sp = 0u;
    for (;;) {
        sum = 0u; cnt = 0u; mine = 0u;
#pragma unroll
        for (unsigned j = 0; j < 16; ++j) { const unsigned c = xb_ld(&bar[XB_XCNT(j)]); sum += c; cnt += (c > 0u) ? 1u : 0u; mine = (j == x) ? c : mine; }
        if (sum == G) break;
        __builtin_amdgcn_s_sleep(1);
        if ((++sp & 255u) == 0u) { if (xb_ld(&bar[XB_TMO])) break; if (sp > XB_SPIN_CAP) { atomicAdd(&bar[XB_TMO], 1u); break; } }
    }
    nloc = mine > 0u ? mine : 1u; nx = cnt > 0u ? cnt : 1u;
}
__device__ __forceinline__ void xcd_barrier(const XcdBarrier& b) {
    asm volatile("s_waitcnt vmcnt(0)" ::: "memory");
    __syncthreads();
    if (threadIdx.x == 0) {
        unsigned* bar = b.bar;
        __builtin_amdgcn_s_waitcnt(0);
        unsigned nloc = b.st[0], nx = b.st[1];
        if (nloc == 0u) { xcd_barrier_complete(bar, b.x, nloc, nx); b.st[0] = nloc; b.st[1] = nx; }
        const unsigned old = xb_add(&bar[XB_XSUB(b.x)], 1u);
        const unsigned gen = old / nloc;
        if (old + 1u == (gen + 1u) * nloc) {
            __builtin_amdgcn_fence(__ATOMIC_RELEASE, "agent");
            asm volatile("s_waitcnt vmcnt(0)" ::: "memory");
            const unsigned og = xb_add(&bar[XB_TOP], 1u);
            const unsigned tg = og / nx;
            if (og + 1u == (tg + 1u) * nx) xb_add(&bar[XB_TOPGEN], 1u);
            else XB_SPIN(xb_ld(&bar[XB_TOPGEN]) == tg, bar);
            __builtin_amdgcn_fence(__ATOMIC_ACQUIRE, "agent");
            xb_add(&bar[XB_XGEN(b.x)], 1u);
            asm volatile("s_waitcnt vmcnt(0)" ::: "memory");
        } else {
            XB_SPIN(xb_ld(&bar[XB_XGEN(b.x)]) == gen, bar);
            __builtin_amdgcn_fence(__ATOMIC_ACQUIRE, "agent");
            asm volatile("s_waitcnt vmcnt(0)" ::: "memory");
        }
    }
    __syncthreads();
}
#ifndef PROBE_MASK
#define PROBE_MASK 0
#endif
#ifndef PROBE_MUL
#define PROBE_MUL 1
#endif
#define PH_BEGIN(k) unsigned long long t0_##k = 0; if (PROBE_MASK & (1 << (k))) t0_##k = __builtin_amdgcn_s_memrealtime();
#define PH_END(k) if (PROBE_MASK & (1 << (k))) { const unsigned long long t1_ = __builtin_amdgcn_s_memrealtime(); const unsigned long long dt_ = (t1_ - t0_##k) * PROBE_MUL; while (__builtin_amdgcn_s_memrealtime() - t1_ < dt_) __builtin_amdgcn_s_sleep(8); xcd_barrier(xbar); }
__global__ void __launch_bounds__(NTHREADS) fwd_megakernel(Params Pin) {
    extern __shared__ __attribute__((aligned(16))) unsigned char lds_raw[];
    LAS unsigned char* lds = (LAS unsigned char*)lds_raw;
    cg::grid_group grid = cg::this_grid();
    KP P0 = (KP)__builtin_amdgcn_kernarg_segment_ptr();
    volatile LAS unsigned* xst = (volatile LAS unsigned*)(lds + LDS_ITEM_OFF + 4);
    if (threadIdx.x == 0) { xst[0] = 0u; xst[1] = 0u; }
    __syncthreads();
    const XcdBarrier xbar = xcd_barrier_post((unsigned*)(P0->ws + WS_XBAR), xst);
#define NEWPHASE KP P = P0; asm volatile("" : "+s"(P)); unsigned char* ws = P->ws; (void)ws;

    PH_BEGIN(0)
    { NEWPHASE phase_prologue(lds, P); }
    grid.sync();
    PH_END(0)
    PH_BEGIN(1)
    { NEWPHASE run_gemm(lds, (const bf16*)P->out, (const bf16*)(ws + WS_WIN), ROWS, 3328, 1024, OpProj{ws}, (const bf16*)(ws + WS_XNMETA), 128); }
    xcd_barrier(xbar);
    PH_END(1)
    { NEWPHASE phase_halo(P); }
    xcd_barrier(xbar);
    { NEWPHASE phase_shift(lds, P); }
    xcd_barrier(xbar);
    PH_BEGIN(2)
    { NEWPHASE
        const int tid = fresh_tid();
        float lam;
        { const int lane = tid & 63; const float s1 = wave_sum(P->in[I_LQ1][lane] * P->in[I_LK1][lane]), s2 = wave_sum(P->in[I_LQ2][lane] * P->in[I_LK2][lane]); lam = __expf(s1) - __expf(s2) + 0.2f; }
        unsigned* ctr = (unsigned*)(ws + WS_CTL);
        LAS unsigned* slot = (LAS unsigned*)(lds + LDS_ITEM_OFF);
#define FETCH(k, n) if (tid == 0) *slot = atomicAdd(ctr + 64 * (k), 1u); __syncthreads(); const int idx = (int)*slot; __syncthreads(); if (idx >= (n)) break;
#ifndef NO_SCAN
#pragma unroll 1
        for (;;) { FETCH(0, N_LONG) const int u = idx / NRP_LONG; scan_long(lds, P, 0, u >> 3, u & 7, idx % NRP_LONG); }
#endif
#ifndef NO_ATTN
#pragma unroll 1
        for (;;) { FETCH(1, N_ATT_P + N_ATT_S)
            if (idx < N_ATT_P) attn_unit(lds, P, 0, idx >> 7, idx & 127, lam);
            else { const int a = idx - N_ATT_P; attn_unit(lds, P, 1 + (a >> 6), (a >> 4) & 3, a & 15, lam); } }
#endif
#ifndef NO_SCAN
#pragma unroll 1
        for (;;) { FETCH(2, N_SHORT) scan_unit<1, 8>(lds, P, 1 + (idx >> 4), (idx >> 3) & 1, idx & 7, 0); }
#endif
#undef FETCH
    }
    xcd_barrier(xbar);
    PH_END(2)
#ifndef NO_POST
    PH_BEGIN(3)
    { NEWPHASE phase_post(lds, P); }
#endif
    xcd_barrier(xbar);
    PH_END(3)
    PH_BEGIN(4)
    { NEWPHASE run_gemm(lds, (const bf16*)P->out, (const bf16*)(ws + WS_WIN) + (size_t)3328 * 1024, NMAIN, 1024, 1024, OpGate{(bf16*)(ws + WS_GA)}); }
    { NEWPHASE run_gemm(lds, (const bf16*)P->out, (const bf16*)(ws + WS_WIN) + (size_t)4352 * 1024, NMAIN, 1024, 1024, OpGate{(bf16*)(ws + WS_GB)}); }

    PH_END(4)
    PH_BEGIN(5)
    { NEWPHASE run_gemm(lds, (const bf16*)(ws + WS_R), (const bf16*)(ws + WS_WUPA), NMAIN, 1024, 512, OpUpA{ws}); }
    PH_END(5)
    PH_BEGIN(6)
    { NEWPHASE run_gemm(lds, (const bf16*)(ws + WS_Q), (const bf16*)(ws + WS_WUPB), NMAIN, 1024, 512, OpUpB{ws}); }
    xcd_barrier(xbar);
    PH_END(6)
    PH_BEGIN(7)
    { NEWPHASE run_gemm(lds, (const bf16*)(ws + WS_GB), (const bf16*)(ws + WS_WOUT), NMAIN, 1024, 1024, OpOut{P->in[I_XP], P->in[I_XS], P->out, P->in[I_GFFN], (bf16*)(ws + WS_MN), (float*)(ws + WS_SS)}); }
    xcd_barrier(xbar);
    PH_END(7)
    PH_BEGIN(9)
    { NEWPHASE run_gemm(lds, (const bf16*)(ws + WS_MN), (const bf16*)(ws + WS_WFF1), 16384, DFF, 1024, OpFF1{(bf16*)(ws + WS_HID), (const float*)(ws + WS_SS)}); }
    xcd_barrier(xbar);
    PH_END(9)
    PH_BEGIN(10)
    { NEWPHASE run_gemm(lds, (const bf16*)(ws + WS_HID), (const bf16*)(ws + WS_WFF2), 16384, 1024, DFF, OpFF2{P->out}); }
    xcd_barrier(xbar);
    PH_END(10)
    PH_BEGIN(11)
    { NEWPHASE run_gemm(lds, (const bf16*)(ws + WS_MN) + (size_t)16384 * DM, (const bf16*)(ws + WS_WFF1), 16384, DFF, 1024, OpFF1{(bf16*)(ws + WS_HID), (const float*)(ws + WS_SS) + 16384}); }
    xcd_barrier(xbar);
    PH_END(11)
    PH_BEGIN(12)
    { NEWPHASE run_gemm(lds, (const bf16*)(ws + WS_HID), (const bf16*)(ws + WS_WFF2), 16384, 1024, DFF, OpFF2{P->out + (size_t)16384 * DM}); }
    xcd_barrier(xbar);
    PH_END(12)
    PH_BEGIN(13)
    { NEWPHASE phase_final(P); }
}

extern "C" void kernel_launch(void* const* d_in, const int* in_sizes, int n_in, void* d_out, int out_size, void* d_ws, size_t ws_size, hipStream_t stream) {
    static int grid_blocks = 0;
    if (grid_blocks == 0) {
        int dev = 0, cus = 0, per_cu = 0;
        hipGetDevice(&dev);
        hipDeviceGetAttribute(&cus, hipDeviceAttributeMultiprocessorCount, dev);
        hipFuncSetAttribute((const void*)fwd_megakernel, hipFuncAttributeMaxDynamicSharedMemorySize, LDS_BYTES);
        hipOccupancyMaxActiveBlocksPerMultiprocessor(&per_cu, (const void*)fwd_megakernel, NTHREADS, LDS_BYTES);
        if (per_cu < 1) { fprintf(stderr, "kernel_launch: occupancy query says %d blocks per CU\n", per_cu); per_cu = 1; }
        grid_blocks = cus * per_cu;
        if (n_in != 29 || ws_size < WS_END) fprintf(stderr, "kernel_launch: unexpected n_in %d / ws_size %zu\n", n_in, ws_size);
    }
    hipMemsetAsync((unsigned char*)d_ws + WS_CTL, 0, 196608, stream);
    Params p{};
    for (int i = 0; i < 29; ++i) p.in[i] = (const float*)d_in[i];
    p.out = (float*)d_out; p.ws = (unsigned char*)d_ws;
    void* args[] = {&p};
    hipError_t e = hipLaunchCooperativeKernel((const void*)fwd_megakernel, dim3(grid_blocks), dim3(NTHREADS), args, LDS_BYTES, stream);
    if (e != hipSuccess) fprintf(stderr, "cooperative launch failed: %s (grid %d)\n", hipGetErrorString(e), grid_blocks);
}
```
